# Optimizing an MI355X kernel written in HIP

```python
import math
import jax
import jax.numpy as jnp
from jax import lax
import numpy as np

D_MODEL = 1024
BATCH = 2
SEQ = 16384
DEPTH = 4

PLE_DIM = 256
N_EVEN = (DEPTH + 1) // 2
N_ODD = DEPTH // 2
RMS_EPS = 1e-6
Q_BLOCK = 128

FOX_HEADS = 8
FOX_HEAD_DIM = 64
MLA_HEADS = 8
MLA_Q_LORA = 384
MLA_KV_LORA = 256
MLA_NOPE = 64
MLA_ROPE = 32
MLA_V = 64
ROPE_THETA = 10000.0
EVEN_SPLITS = (FOX_HEADS * FOX_HEAD_DIM, FOX_HEADS * FOX_HEAD_DIM, FOX_HEADS * FOX_HEAD_DIM,
               FOX_HEADS, MLA_Q_LORA, MLA_KV_LORA, MLA_ROPE)
EVEN_IN = sum(EVEN_SPLITS)
EVEN_MIX = FOX_HEADS * FOX_HEAD_DIM + MLA_HEADS * MLA_V

S5_CH = 512
S5_GROUP_CH = 16
S5_GROUPS = S5_CH // S5_GROUP_CH
S5_STATE = 64
GDN_HEADS = 4
GDN_HEAD_DIM = 128
GDN_W = GDN_HEADS * GDN_HEAD_DIM
GDN_CONV = 4
GDN_CHUNK = 64
ODD_SPLITS = (S5_CH, 3 * GDN_W, GDN_HEADS, GDN_HEADS, GDN_W)
ODD_IN = sum(ODD_SPLITS)
ODD_MIX = S5_CH + GDN_W

MOE_GROUPS = 4
MOE_PER_GROUP = 8
N_EXPERTS = MOE_GROUPS * MOE_PER_GROUP
MOE_TOP_K = 2
MOE_FF = 512
MOE_BLOCK = 128

kernel_name = 'hybrid_fox_mla_s5_gdn_hmoe'


def _split(x, sizes):
    idx = [int(v) for v in np.cumsum(sizes)[:-1]]
    return jnp.split(x, idx, axis=-1)


def _rms_norm(x, g):
    x32 = x.astype(jnp.float32)
    y = x32 * lax.rsqrt(jnp.mean(x32 * x32, axis=-1, keepdims=True) + RMS_EPS)
    return (y * g.astype(jnp.float32)).astype(x.dtype)


def _l2norm(x):
    x32 = x.astype(jnp.float32)
    return x32 * lax.rsqrt(jnp.sum(x32 * x32, axis=-1, keepdims=True) + RMS_EPS)


def _rope(x, positions):
    r = x.shape[-1]
    half = r // 2
    inv = ROPE_THETA ** (-jnp.arange(half, dtype=jnp.float32) * 2.0 / r)
    ang = positions.astype(jnp.float32)[:, :, None] * inv
    cos = jnp.cos(ang)[:, :, None, :]
    sin = jnp.sin(ang)[:, :, None, :]
    x32 = x.astype(jnp.float32)
    x1, x2 = x32[..., :half], x32[..., half:]
    return jnp.concatenate([x1 * cos - x2 * sin, x1 * sin + x2 * cos], axis=-1).astype(x.dtype)


def _causal_block_attention(q, k, v, scale, cum_logf=None):
    b, s, h, dk = q.shape
    dv = v.shape[-1]
    nb = s // Q_BLOCK
    key_pos = jnp.arange(s)
    q_blocks = q.reshape(b, nb, Q_BLOCK, h, dk).swapaxes(0, 1)
    if cum_logf is not None:
        cum_keys = cum_logf.transpose(0, 2, 1)
        f_blocks = cum_logf.reshape(b, nb, Q_BLOCK, h).swapaxes(0, 1)

    def one_block(args):
        i, q_blk = args[0], args[1]
        sc = jnp.einsum('bqhd,bkhd->bhqk', q_blk, k, preferred_element_type=jnp.float32) * scale
        if cum_logf is not None:
            f_q = args[2].transpose(0, 2, 1)
            sc = sc + (f_q[..., :, None] - cum_keys[:, :, None, :])
        q_pos = i * Q_BLOCK + jnp.arange(Q_BLOCK)
        causal = key_pos[None, :] <= q_pos[:, None]
        sc = jnp.where(causal, sc, -jnp.inf)
        pr = jax.nn.softmax(sc, axis=-1).astype(v.dtype)
        return jnp.einsum('bhqk,bkhd->bqhd', pr, v)

    if cum_logf is None:
        xs = (jnp.arange(nb), q_blocks)
    else:
        xs = (jnp.arange(nb), q_blocks, f_blocks)
    out = lax.map(one_block, xs)
    return out.swapaxes(0, 1).reshape(b, s, h, dv)


def _even_mixer(a, positions, w_in, b_f, fox_qn, fox_kn, q_a_norm, w_q_up, kv_a_norm, w_kv_up,
                mla_qn, mla_kn, w_out):
    b, s, _ = a.shape
    fq, fk, fv, f_logit, c_q, c_kv, k_rope = _split(a @ w_in, EVEN_SPLITS)
    fq = _rms_norm(fq.reshape(b, s, FOX_HEADS, FOX_HEAD_DIM), fox_qn)
    fk = _rms_norm(fk.reshape(b, s, FOX_HEADS, FOX_HEAD_DIM), fox_kn)
    fv = fv.reshape(b, s, FOX_HEADS, FOX_HEAD_DIM)
    log_f = jax.nn.log_sigmoid(f_logit.astype(jnp.float32) + b_f)
    cum = jnp.cumsum(log_f, axis=1)
    o_fox = _causal_block_attention(fq, fk, fv, FOX_HEAD_DIM ** -0.5, cum)
    q = (_rms_norm(c_q, q_a_norm) @ w_q_up).reshape(b, s, MLA_HEADS, MLA_NOPE + MLA_ROPE)
    kv = (_rms_norm(c_kv, kv_a_norm) @ w_kv_up).reshape(b, s, MLA_HEADS, MLA_NOPE + MLA_V)
    k_nope, v = kv[..., :MLA_NOPE], kv[..., MLA_NOPE:]
    k = jnp.concatenate([k_nope, jnp.broadcast_to(k_rope[:, :, None, :], (b, s, MLA_HEADS, MLA_ROPE))], axis=-1)
    q = _rms_norm(q, mla_qn)
    k = _rms_norm(k, mla_kn)
    q = jnp.concatenate([q[..., :MLA_NOPE], _rope(q[..., MLA_NOPE:], positions)], axis=-1)
    k = jnp.concatenate([k[..., :MLA_NOPE], _rope(k[..., MLA_NOPE:], positions)], axis=-1)
    o_mla = _causal_block_attention(q, k, v, (MLA_NOPE + MLA_ROPE) ** -0.5)
    o = jnp.concatenate([o_fox.reshape(b, s, -1), o_mla.reshape(b, s, -1)], axis=-1)
    return o @ w_out


def _s5_glu(u, a_re, a_im, b_re, b_im, c_re, c_im, d_skip, log_step, w_glu, b_glu):
    b, s, _ = u.shape
    u32 = u.astype(jnp.float32)
    ug = u32.reshape(b, s, S5_GROUPS, S5_GROUP_CH)
    lam_re = jnp.minimum(a_re.astype(jnp.float32), -1e-4)
    lam_im = a_im.astype(jnp.float32)
    dt = jnp.exp(log_step.astype(jnp.float32))[:, None]
    mag = jnp.exp(lam_re * dt)
    ab_re = mag * jnp.cos(lam_im * dt)
    ab_im = mag * jnp.sin(lam_im * dt)
    den = lam_re * lam_re + lam_im * lam_im
    nr, ni = ab_re - 1.0, ab_im
    gam_re = (nr * lam_re + ni * lam_im) / den
    gam_im = (ni * lam_re - nr * lam_im) / den
    bb_re = gam_re[..., None] * b_re - gam_im[..., None] * b_im
    bb_im = gam_re[..., None] * b_im + gam_im[..., None] * b_re
    bu_re = jnp.einsum('bsgc,gpc->bsgp', ug, bb_re)
    bu_im = jnp.einsum('bsgc,gpc->bsgp', ug, bb_im)
    ar = jnp.broadcast_to(ab_re, bu_re.shape)
    ai = jnp.broadcast_to(ab_im, bu_re.shape)

    def combine(e1, e2):
        a1r, a1i, b1r, b1i = e1
        a2r, a2i, b2r, b2i = e2
        return (a2r * a1r - a2i * a1i, a2r * a1i + a2i * a1r,
                a2r * b1r - a2i * b1i + b2r, a2r * b1i + a2i * b1r + b2i)

    _, _, xr, xi = lax.associative_scan(combine, (ar, ai, bu_re, bu_im), axis=1)
    y = jnp.einsum('bsgp,gcp->bsgc', xr, c_re) - jnp.einsum('bsgp,gcp->bsgc', xi, c_im)
    y = y.reshape(b, s, S5_CH) + d_skip * u32
    hg = jax.nn.gelu(y)
    out = hg * jax.nn.sigmoid(hg @ w_glu + b_glu)
    return out.astype(u.dtype)


def _causal_conv(x, w):
    c = x.shape[-1]
    return lax.conv_general_dilated(x, w[:, None, :].astype(x.dtype), window_strides=(1,),
                                    padding=[(w.shape[0] - 1, 0)],
                                    dimension_numbers=('NWC', 'WIO', 'NWC'),
                                    feature_group_count=c)


def _gated_delta_chunked(q, k, v, g, beta):
    b, s, h, dk = q.shape
    dv = v.shape[-1]
    c = GDN_CHUNK
    nc = s // c
    f32 = jnp.float32

    def to_chunks(t):
        return t.astype(f32).transpose(0, 2, 1, 3).reshape(b, h, nc, c, t.shape[-1])

    qc, kc, vc = to_chunks(q), to_chunks(k), to_chunks(v)
    gc = jnp.cumsum(g.astype(f32).transpose(0, 2, 1).reshape(b, h, nc, c), axis=-1)
    bc = beta.astype(f32).transpose(0, 2, 1).reshape(b, h, nc, c)
    incl = jnp.tril(jnp.ones((c, c), bool))
    strict = jnp.tril(jnp.ones((c, c), bool), -1)
    diff = gc[..., :, None] - gc[..., None, :]
    decay = jnp.where(incl, jnp.exp(jnp.where(incl, diff, 0.0)), 0.0)
    k_beta = kc * bc[..., None]
    a_mat = jnp.where(strict, jnp.einsum('bhnid,bhnjd->bhnij', k_beta, kc) * decay, 0.0)
    eye = jnp.eye(c, dtype=f32)
    t_mat = lax.linalg.triangular_solve(eye + a_mat, jnp.broadcast_to(eye, a_mat.shape),
                                        left_side=True, lower=True)
    u = t_mat @ (vc * bc[..., None])
    w = t_mat @ (k_beta * jnp.exp(gc)[..., None])
    intra = jnp.einsum('bhnid,bhnjd->bhnij', qc, kc) * decay
    q_dec = qc * jnp.exp(gc)[..., None]
    g_last = gc[..., -1]
    k_dec = kc * jnp.exp(g_last[..., None] - gc)[..., None]

    def step(state, xs):
        q_i, a_i, u_i, w_i, k_i, gl = xs
        v_new = u_i - jnp.einsum('bhck,bhkv->bhcv', w_i, state)
        o = jnp.einsum('bhck,bhkv->bhcv', q_i, state) + jnp.einsum('bhij,bhjv->bhiv', a_i, v_new)
        state = state * jnp.exp(gl)[..., None, None] + jnp.einsum('bhck,bhcv->bhkv', k_i, v_new)
        return state, o

    xs = tuple(jnp.moveaxis(t, 2, 0) for t in (q_dec, intra, u, w, k_dec, g_last))
    _, o = lax.scan(step, jnp.zeros((b, h, dk, dv), f32), xs)
    return o.transpose(1, 0, 3, 2, 4).reshape(b, s, h, dv)


def _odd_mixer(a, w_in, a_re, a_im, b_re, b_im, c_re, c_im, d_skip, log_step, w_glu, b_glu,
               conv_w, a_log, dt_bias, o_norm, w_out):
    b, s, _ = a.shape
    u, qkv, g_in, beta_in, z = _split(a @ w_in, ODD_SPLITS)
    y_ssm = _s5_glu(u, a_re, a_im, b_re, b_im, c_re, c_im, d_skip, log_step, w_glu, b_glu)
    qkv = jax.nn.silu(_causal_conv(qkv, conv_w))
    q, k, v = jnp.split(qkv, 3, axis=-1)
    q = _l2norm(q.reshape(b, s, GDN_HEADS, GDN_HEAD_DIM)) * (GDN_HEAD_DIM ** -0.5)
    k = _l2norm(k.reshape(b, s, GDN_HEADS, GDN_HEAD_DIM))
    v = v.reshape(b, s, GDN_HEADS, GDN_HEAD_DIM)
    beta = jax.nn.sigmoid(beta_in.astype(jnp.float32))
    g = -jnp.exp(a_log.astype(jnp.float32)) * jax.nn.softplus(g_in.astype(jnp.float32) + dt_bias)
    o = _gated_delta_chunked(q, k, v, g, beta).astype(a.dtype)
    o = _rms_norm(o, o_norm) * jax.nn.silu(z.reshape(b, s, GDN_HEADS, GDN_HEAD_DIM))
    return jnp.concatenate([y_ssm, o.reshape(b, s, -1)], axis=-1) @ w_out


def _expert_dispatch(xf, experts, weights, w_gate, w_up, w_down):
    n, d = xf.shape
    n_assign = n * MOE_TOP_K
    flat_e = experts.reshape(-1).astype(jnp.int32)
    flat_tok = jnp.arange(n_assign, dtype=jnp.int32) // MOE_TOP_K
    flat_w = weights.reshape(-1)
    order = jnp.argsort(flat_e)
    sorted_e = flat_e[order]
    counts = jnp.bincount(flat_e, length=N_EXPERTS)
    start = jnp.cumsum(counts) - counts
    padded = (counts + MOE_BLOCK - 1) // MOE_BLOCK * MOE_BLOCK
    pad_end = jnp.cumsum(padded)
    pad_start = pad_end - padded
    dest = pad_start[sorted_e] + jnp.arange(n_assign, dtype=jnp.int32) - start[sorted_e]
    n_blocks = -(-n_assign // MOE_BLOCK) + N_EXPERTS
    cap = n_blocks * MOE_BLOCK
    buf_tok = jnp.full((cap,), n, jnp.int32).at[dest].set(flat_tok[order])
    buf_w = jnp.zeros((cap,), xf.dtype).at[dest].set(flat_w[order].astype(xf.dtype))
    blk_e = jnp.minimum(jnp.searchsorted(pad_end, jnp.arange(n_blocks, dtype=jnp.int32) * MOE_BLOCK,
                                         side='right'), N_EXPERTS - 1)
    x_pad = jnp.concatenate([xf, jnp.zeros((1, d), xf.dtype)], axis=0)

    def expert_block(args):
        tok, e = args
        xb = x_pad[tok]
        hb = jax.nn.silu(xb @ w_gate[e]) * (xb @ w_up[e])
        return hb @ w_down[e]

    yb = lax.map(expert_block, (buf_tok.reshape(n_blocks, MOE_BLOCK), blk_e))
    y = jnp.zeros((n + 1, d), yb.dtype).at[buf_tok].add(yb.reshape(cap, d) * buf_w[:, None].astype(yb.dtype))
    return y[:n]


def _hier_moe(m, w_group, b_group, w_expert, b_expert, w_gate, w_up, w_down):
    b, s, d = m.shape
    xf = m.reshape(-1, d)
    n = xf.shape[0]
    g_prob = jax.nn.softmax((xf @ w_group).astype(jnp.float32) + b_group, axis=-1)
    g_w, g_idx = lax.top_k(g_prob, 1)
    e_logits = ((xf @ w_expert).astype(jnp.float32) + b_expert).reshape(n, MOE_GROUPS, MOE_PER_GROUP)
    e_logits = e_logits[jnp.arange(n), g_idx[:, 0]]
    e_prob = jax.nn.softmax(e_logits, axis=-1)
    e_w, e_idx = lax.top_k(e_prob, MOE_TOP_K)
    weights = g_w * e_w / jnp.sum(e_w, axis=-1, keepdims=True)
    experts = g_idx * MOE_PER_GROUP + e_idx
    return _expert_dispatch(xf, experts, weights, w_gate, w_up, w_down).reshape(b, s, d)


def _per_layer_embedding(h, p_i, w_proj, norm_g, w_gate, b_gate):
    gate = jax.nn.sigmoid(_rms_norm(h, norm_g) @ w_gate + b_gate)
    return gate * (p_i @ w_proj)


def setup_inputs(seed: int = 0) -> dict:
    key = jax.random.key(seed)
    ks = iter(jax.random.split(key, 64))
    f32 = jnp.float32

    def nrm(shape, scale):
        return jax.random.normal(next(ks), shape, f32) * scale

    def gain(shape):
        return 1.0 + nrm(shape, 0.02)

    def unif(shape, lo, hi):
        return jax.random.uniform(next(ks), shape, f32, minval=lo, maxval=hi)

    x = nrm((BATCH, SEQ, D_MODEL), 1.0)
    p = nrm((DEPTH, BATCH, SEQ, PLE_DIM), 1.0)
    positions = jnp.broadcast_to(jnp.arange(SEQ, dtype=jnp.int32), (BATCH, SEQ))
    n_idx = jnp.arange(S5_STATE, dtype=f32)
    log_lo, log_hi = math.log(0.001), math.log(0.1)
    dt = jnp.exp(unif((N_ODD, GDN_HEADS), log_lo, log_hi))
    return {
        'x': x,
        'p': p,
        'positions': positions,
        'norm_mix': gain((DEPTH, D_MODEL)),
        'norm_ffn': gain((DEPTH, D_MODEL)),
        'ev_w_in': nrm((N_EVEN, D_MODEL, EVEN_IN), D_MODEL ** -0.5),
        'fox_b_f': unif((N_EVEN, FOX_HEADS), 1.0, 5.0),
        'fox_q_norm': gain((N_EVEN, FOX_HEAD_DIM)),
        'fox_k_norm': gain((N_EVEN, FOX_HEAD_DIM)),
        'mla_q_a_norm': gain((N_EVEN, MLA_Q_LORA)),
        'mla_w_q_up': nrm((N_EVEN, MLA_Q_LORA, MLA_HEADS * (MLA_NOPE + MLA_ROPE)), MLA_Q_LORA ** -0.5),
        'mla_kv_a_norm': gain((N_EVEN, MLA_KV_LORA)),
        'mla_w_kv_up': nrm((N_EVEN, MLA_KV_LORA, MLA_HEADS * (MLA_NOPE + MLA_V)), MLA_KV_LORA ** -0.5),
        'mla_q_norm': gain((N_EVEN, MLA_NOPE + MLA_ROPE)),
        'mla_k_norm': gain((N_EVEN, MLA_NOPE + MLA_ROPE)),
        'ev_w_out': nrm((N_EVEN, EVEN_MIX, D_MODEL), EVEN_MIX ** -0.5),
        'od_w_in': nrm((N_ODD, D_MODEL, ODD_IN), D_MODEL ** -0.5),
        's5_a_re': -0.5 + nrm((N_ODD, S5_GROUPS, S5_STATE), 0.01),
        's5_a_im': math.pi * n_idx + nrm((N_ODD, S5_GROUPS, S5_STATE), 0.01),
        's5_b_re': nrm((N_ODD, S5_GROUPS, S5_STATE, S5_GROUP_CH), (2 * S5_GROUP_CH) ** -0.5),
        's5_b_im': nrm((N_ODD, S5_GROUPS, S5_STATE, S5_GROUP_CH), (2 * S5_GROUP_CH) ** -0.5),
        's5_c_re': nrm((N_ODD, S5_GROUPS, S5_GROUP_CH, S5_STATE), 0.25),
        's5_c_im': nrm((N_ODD, S5_GROUPS, S5_GROUP_CH, S5_STATE), 0.25),
        's5_d': nrm((N_ODD, S5_CH), 0.5),
        's5_log_step': unif((N_ODD, S5_GROUPS), log_lo, log_hi),
        's5_w_glu': nrm((N_ODD, S5_CH, S5_CH), S5_CH ** -0.5),
        's5_b_glu': nrm((N_ODD, S5_CH), 0.01),
        'gdn_conv_w': nrm((N_ODD, GDN_CONV, 3 * GDN_W), 0.5),
        'gdn_a_log': jnp.log(unif((N_ODD, GDN_HEADS), 1.0, 16.0)),
        'gdn_dt_bias': dt + jnp.log(-jnp.expm1(-dt)),
        'gdn_o_norm': gain((N_ODD, GDN_HEAD_DIM)),
        'od_w_out': nrm((N_ODD, ODD_MIX, D_MODEL), ODD_MIX ** -0.5),
        'moe_w_group': nrm((DEPTH, D_MODEL, MOE_GROUPS), D_MODEL ** -0.5),
        'moe_b_group': nrm((DEPTH, MOE_GROUPS), 0.01),
        'moe_w_expert': nrm((DEPTH, D_MODEL, N_EXPERTS), D_MODEL ** -0.5),
        'moe_b_expert': nrm((DEPTH, N_EXPERTS), 0.01),
        'moe_w_gate': nrm((DEPTH, N_EXPERTS, D_MODEL, MOE_FF), D_MODEL ** -0.5),
        'moe_w_up': nrm((DEPTH, N_EXPERTS, D_MODEL, MOE_FF), D_MODEL ** -0.5),
        'moe_w_down': nrm((DEPTH, N_EXPERTS, MOE_FF, D_MODEL), MOE_FF ** -0.5),
        'ple_w_proj': nrm((DEPTH, PLE_DIM, D_MODEL), PLE_DIM ** -0.5),
        'ple_norm': gain((DEPTH, D_MODEL)),
        'ple_w_gate': nrm((DEPTH, D_MODEL, D_MODEL), D_MODEL ** -0.5),
        'ple_b_gate': nrm((DEPTH, D_MODEL), 0.01),
    }


def reference(x, p, positions, norm_mix, norm_ffn, ev_w_in, fox_b_f, fox_q_norm, fox_k_norm,
              mla_q_a_norm, mla_w_q_up, mla_kv_a_norm, mla_w_kv_up, mla_q_norm, mla_k_norm, ev_w_out,
              od_w_in, s5_a_re, s5_a_im, s5_b_re, s5_b_im, s5_c_re, s5_c_im, s5_d, s5_log_step,
              s5_w_glu, s5_b_glu, gdn_conv_w, gdn_a_log, gdn_dt_bias, gdn_o_norm, od_w_out,
              moe_w_group, moe_b_group, moe_w_expert, moe_b_expert, moe_w_gate, moe_w_up, moe_w_down,
              ple_w_proj, ple_norm, ple_w_gate, ple_b_gate):
    h = x
    for i in range(DEPTH):
        a = _rms_norm(h, norm_mix[i])
        j = i // 2
        if i % 2 == 0:
            h = h + _even_mixer(a, positions, ev_w_in[j], fox_b_f[j], fox_q_norm[j], fox_k_norm[j],
                                mla_q_a_norm[j], mla_w_q_up[j], mla_kv_a_norm[j], mla_w_kv_up[j],
                                mla_q_norm[j], mla_k_norm[j], ev_w_out[j])
        else:
            h = h + _odd_mixer(a, od_w_in[j], s5_a_re[j], s5_a_im[j], s5_b_re[j], s5_b_im[j],
                               s5_c_re[j], s5_c_im[j], s5_d[j], s5_log_step[j], s5_w_glu[j], s5_b_glu[j],
                               gdn_conv_w[j], gdn_a_log[j], gdn_dt_bias[j], gdn_o_norm[j], od_w_out[j])
        h = h + _hier_moe(_rms_norm(h, norm_ffn[i]), moe_w_group[i], moe_b_group[i], moe_w_expert[i],
                          moe_b_expert[i], moe_w_gate[i], moe_w_up[i], moe_w_down[i])
        h = h + _per_layer_embedding(h, p[i], ple_w_proj[i], ple_norm[i], ple_w_gate[i], ple_b_gate[i])
    return h
```

```cpp
#include <hip/hip_runtime.h>
#include <cstdio>
#include <cstdint>
#define MK_MODE 0
namespace pg8 {
#define PG8_LAS __attribute__((address_space(3)))
typedef unsigned short bf16_t;
typedef short bf16x8 __attribute__((ext_vector_type(8)));
typedef float f32x4 __attribute__((ext_vector_type(4)));
typedef float f32x2 __attribute__((ext_vector_type(2)));
typedef unsigned u32x4 __attribute__((ext_vector_type(4)));
typedef unsigned u32x2 __attribute__((ext_vector_type(2)));
constexpr int BM = 256, BK = 64, HALF = 128, HTB = HALF * BK * 2  , STAGE_BYTES = 8 * HTB, NXCD = 8, WGM = 8;

__host__ __device__ __forceinline__ int lds_byte(int r, int c) { const int st = (r >> 4) * 2 + (c >> 5), rr = r & 15, cc = c & 31, ob = rr * 64 + cc * 2; return st * 1024 + (ob ^ (((ob >> 9) & 1) << 5)); }
__host__ __device__ __forceinline__ void stage_rc(int b, int& R, int& C) { const int st = b / 1024, sb = b % 1024, swz = sb ^ (((sb >> 9) & 1) << 5); R = (st >> 1) * 16 + swz / 64; C = (st & 1) * 32 + (swz % 64) / 2; }
__host__ __device__ __forceinline__ int perm32(int rho) { const int n = rho >> 4, i = rho & 15; return 8 * (i >> 2) + 4 * n + (i & 3); }

struct Unit { int pm, pn, aux; };
struct Gemm { const bf16_t* A; const bf16_t* Bt; int K, lda, ldb; };

struct StaticOrder {
    int nM, nN, nwg, G, c;
    __device__ void init(int M, int N, int G_, int c_) { nM = M / BM; nN = N / BM; nwg = nM * nN; G = G_; c = c_; }
    __device__ bool next(int i, Unit& u) const {
        const long L = (long)i * G + c; if (L >= nwg) return false;
        int wgid = (int)L; { const int q = nwg / NXCD, r = nwg % NXCD, xcd = wgid % NXCD, off = wgid / NXCD; wgid = (xcd < r ? xcd * (q + 1) : r * (q + 1) + (xcd - r) * q) + off; }
        const int nig = WGM * nN, gid = wgid / nig, fm = gid * WGM, gsz = (nM - fm) < WGM ? (nM - fm) : WGM;
        u.pm = fm + ((wgid % nig) % gsz); u.pn = (wgid % nig) / gsz; u.aux = 0; return true;
    }
    __device__ __forceinline__ const char* a_base(const Gemm& g, const Unit& u) const { return (const char*)g.A + (size_t)u.pm * BM * g.lda * 2; }
    __device__ __forceinline__ const char* b_base(const Gemm& g, const Unit& u) const { return (const char*)g.Bt + (size_t)u.pn * BM * g.ldb * 2; }
};

__device__ __forceinline__ unsigned cvt_pk_bf16(float lo, float hi) { unsigned r; asm volatile("v_cvt_pk_bf16_f32 %0, %1, %2" : "=v"(r) : "v"(lo), "v"(hi)); return r; }
__device__ __forceinline__ float bf_lo(unsigned w) { return __uint_as_float(w << 16); }
__device__ __forceinline__ float bf_hi(unsigned w) { return __uint_as_float(w & 0xffff0000u); }

struct EpiBf16 {
    static constexpr bool PERM = true;
    bf16_t* O; int ldc;
    __device__ __forceinline__ void operator()(const f32x4 (&acc)[2][2][4][2], const Unit& u, int wr, int wc, int fr, int fq) const {
        const int row0 = u.pm * BM + wr * 64 + fr; const int col0 = u.pn * BM + wc * 32 + 8 * fq;
#pragma unroll
        for (int ai = 0; ai < 2; ++ai)
#pragma unroll
            for (int m = 0; m < 4; ++m) { bf16_t* rowp = O + (size_t)(row0 + ai * HALF + m * 16) * ldc + col0;
#pragma unroll
                for (int bj = 0; bj < 2; ++bj) { const f32x4 v0 = acc[ai][bj][m][0], v1 = acc[ai][bj][m][1];
                    u32x4 w; w.x = cvt_pk_bf16(v0[0], v0[1]); w.y = cvt_pk_bf16(v0[2], v0[3]); w.z = cvt_pk_bf16(v1[0], v1[1]); w.w = cvt_pk_bf16(v1[2], v1[3]);
                    *(u32x4*)(rowp + bj * HALF) = w; } }
    }
};
struct EpiResAdd {
    static constexpr bool PERM = false;
    float* H; int ldc;
    __device__ __forceinline__ void operator()(const f32x4 (&acc)[2][2][4][2], const Unit& u, int wr, int wc, int fr, int fq) const {
        const int row0 = u.pm * BM + wr * 64 + fr; const int col0 = u.pn * BM + wc * 32 + 4 * fq;
#pragma unroll
        for (int ai = 0; ai < 2; ++ai)
#pragma unroll
            for (int m = 0; m < 4; ++m) { float* rowp = H + (size_t)(row0 + ai * HALF + m * 16) * ldc + col0;
#pragma unroll
                for (int bj = 0; bj < 2; ++bj)
#pragma unroll
                    for (int n = 0; n < 2; ++n) { f32x4* p = (f32x4*)(rowp + bj * HALF + n * 16); *p = *p + acc[ai][bj][m][n]; } }
    }
};
__device__ __forceinline__ float sigmoidf_(float x) { return 1.0f / (1.0f + __expf(-x)); }
struct EpiPle {
    static constexpr bool PERM = false;
    float* H; const bf16_t* PP; const float* bias; int ldc;
    __device__ __forceinline__ void operator()(const f32x4 (&acc)[2][2][4][2], const Unit& u, int wr, int wc, int fr, int fq) const {
        const int row0 = u.pm * BM + wr * 64 + fr; const int col0 = u.pn * BM + wc * 32 + 4 * fq;
#pragma unroll
        for (int ai = 0; ai < 2; ++ai)
#pragma unroll
            for (int m = 0; m < 4; ++m) { const size_t ro = (size_t)(row0 + ai * HALF + m * 16) * ldc + col0;
#pragma unroll
                for (int bj = 0; bj < 2; ++bj)
#pragma unroll
                    for (int n = 0; n < 2; ++n) { const int co = bj * HALF + n * 16; f32x4* p = (f32x4*)(H + ro + co); const u32x2 pw = *(const u32x2*)(PP + ro + co);
                        const f32x4 bv = *(const f32x4*)(bias + col0 + co); const f32x4 a = acc[ai][bj][m][n] + bv; f32x4 h = *p;
                        h[0] += sigmoidf_(a[0]) * bf_lo(pw.x); h[1] += sigmoidf_(a[1]) * bf_hi(pw.x); h[2] += sigmoidf_(a[2]) * bf_lo(pw.y); h[3] += sigmoidf_(a[3]) * bf_hi(pw.y); *p = h; } }
    }
};
struct EpiGlu {
    static constexpr bool PERM = true;
    bf16_t* O; int ldo; const bf16_t* HG; int ldh; const float* bias;
    __device__ __forceinline__ void operator()(const f32x4 (&acc)[2][2][4][2], const Unit& u, int wr, int wc, int fr, int fq) const {
        const int row0 = u.pm * BM + wr * 64 + fr; const int col0 = u.pn * BM + wc * 32 + 8 * fq;
#pragma unroll
        for (int ai = 0; ai < 2; ++ai)
#pragma unroll
            for (int m = 0; m < 4; ++m) { const size_t r = (size_t)(row0 + ai * HALF + m * 16);
#pragma unroll
                for (int bj = 0; bj < 2; ++bj) { const int c = col0 + bj * HALF; const u32x4 hw = *(const u32x4*)(HG + r * ldh + c);
                    const f32x4 b0 = *(const f32x4*)(bias + c), b1 = *(const f32x4*)(bias + c + 4); const f32x4 v0 = acc[ai][bj][m][0] + b0, v1 = acc[ai][bj][m][1] + b1;
                    u32x4 w; w.x = cvt_pk_bf16(bf_lo(hw.x) * sigmoidf_(v0[0]), bf_hi(hw.x) * sigmoidf_(v0[1])); w.y = cvt_pk_bf16(bf_lo(hw.y) * sigmoidf_(v0[2]), bf_hi(hw.y) * sigmoidf_(v0[3]));
                    w.z = cvt_pk_bf16(bf_lo(hw.z) * sigmoidf_(v1[0]), bf_hi(hw.z) * sigmoidf_(v1[1])); w.w = cvt_pk_bf16(bf_lo(hw.w) * sigmoidf_(v1[2]), bf_hi(hw.w) * sigmoidf_(v1[3]));
                    *(u32x4*)(O + r * ldo + c) = w; } }
    }
};
struct EpiSwiglu {
    static constexpr bool PERM = true;
    bf16_t* HB; int ldc;
    __device__ __forceinline__ void operator()(const f32x4 (&acc)[2][2][4][2], const Unit& u, int wr, int wc, int fr, int fq) const {
        const int row0 = u.pm * BM + wr * 64 + fr; const int col0 = u.pn * HALF + wc * 32 + 8 * fq;
#pragma unroll
        for (int ai = 0; ai < 2; ++ai)
#pragma unroll
            for (int m = 0; m < 4; ++m) { bf16_t* rowp = HB + (size_t)(row0 + ai * HALF + m * 16) * ldc + col0;
                const f32x4 g0 = acc[ai][0][m][0], g1 = acc[ai][0][m][1], u0 = acc[ai][1][m][0], u1 = acc[ai][1][m][1];
                u32x4 w; w.x = cvt_pk_bf16(g0[0] * sigmoidf_(g0[0]) * u0[0], g0[1] * sigmoidf_(g0[1]) * u0[1]); w.y = cvt_pk_bf16(g0[2] * sigmoidf_(g0[2]) * u0[2], g0[3] * sigmoidf_(g0[3]) * u0[3]);
                w.z = cvt_pk_bf16(g1[0] * sigmoidf_(g1[0]) * u1[0], g1[1] * sigmoidf_(g1[1]) * u1[1]); w.w = cvt_pk_bf16(g1[2] * sigmoidf_(g1[2]) * u1[2], g1[3] * sigmoidf_(g1[3]) * u1[3]);
                *(u32x4*)rowp = w; }
    }
};

template <class Epi, class Sched, bool ALIGN_EPI = true, bool SP2 = true>
__device__ __forceinline__ void gemm_phase(PG8_LAS unsigned char* lds, const Gemm g, const Sched& S, const Epi& E, const int tid) {
    const int wid = __builtin_amdgcn_readfirstlane(tid >> 6), lane = tid & 63, wr = wid >> 2, wc = wid & 3, fr = lane & 15, fq = lane >> 4;
    int K = g.K; asm volatile("" : "+s"(K));
    const int nt = K / BK;
    unsigned voffA[2], voffB[2];
#pragma unroll
    for (int i = 0; i < 2; ++i) { int R, C; stage_rc(tid * 16 + i * 8192, R, C); const int Rb = Epi::PERM ? ((R & ~31) + perm32(R & 31)) : R;
        voffA[i] = (unsigned)(R * g.lda + C) * 2u; voffB[i] = (unsigned)(Rb * g.ldb + C) * 2u; }
    const size_t kstep = (size_t)(BK * 2);
    const size_t hstepA = (size_t)HALF * g.lda * 2, hstepB = (size_t)HALF * g.ldb * 2;
    const unsigned ldsw = (unsigned)wid * 1024u;
    const int aoff = lds_byte(wr * 64 + fr, fq * 8), boff = lds_byte(wc * 32 + fr, fq * 8);
#define PG8_SA(b, h) (((b) * 2 + (h)) * HTB)
#define PG8_SB(b, h) ((4 + (b) * 2 + (h)) * HTB)
#define PG8_STAGE(bufoff, gbase, voff) do { _Pragma("unroll") for (int _i = 0; _i < 2; ++_i) \
        __builtin_amdgcn_global_load_lds((const unsigned*)((const char*)(gbase) + (voff)[_i]), (PG8_LAS unsigned*)(lds + (bufoff) + ldsw + _i * 8192), 16, 0, 0); } while (0)
#define PG8_LDA(dst, b, h) do { _Pragma("unroll") for (int m = 0; m < 4; ++m) _Pragma("unroll") for (int k = 0; k < 2; ++k) dst[m][k] = *(const PG8_LAS bf16x8*)(lds + PG8_SA(b, h) + aoff + m * 2048 + k * 1024); } while (0)
#define PG8_LDB(dst, b, h) do { _Pragma("unroll") for (int n = 0; n < 2; ++n) _Pragma("unroll") for (int k = 0; k < 2; ++k) dst[n][k] = *(const PG8_LAS bf16x8*)(lds + PG8_SB(b, h) + boff + n * 2048 + k * 1024); } while (0)
#define PG8_MMA(ai, bj, At, Bt) do { __builtin_amdgcn_s_setprio(1); _Pragma("unroll") for (int m = 0; m < 4; ++m) _Pragma("unroll") for (int n = 0; n < 2; ++n) _Pragma("unroll") for (int k = 0; k < 2; ++k) \
        acc[ai][bj][m][n] = __builtin_amdgcn_mfma_f32_16x16x32_bf16(Bt[n][k], At[m][k], acc[ai][bj][m][n], 0, 0, 0); __builtin_amdgcn_s_setprio(0); } while (0)
#define PG8_WAIT_V(n) asm volatile("s_waitcnt vmcnt(" #n ")" ::: "memory")
#define PG8_WAIT_L(n) asm volatile("s_waitcnt lgkmcnt(" #n ")" ::: "memory")
#define PG8_BAR __builtin_amdgcn_s_barrier()
#define PG8_SCHED __builtin_amdgcn_sched_barrier(0)
    Unit cur, nxt; int ui = 0;
    if (!S.next(0, cur)) return;
    f32x4 acc[2][2][4][2];
#pragma unroll
    for (int a = 0; a < 2; ++a)
#pragma unroll
        for (int b = 0; b < 2; ++b)
#pragma unroll
            for (int m = 0; m < 4; ++m)
#pragma unroll
                for (int n = 0; n < 2; ++n) acc[a][b][m][n] = (f32x4){0.f, 0.f, 0.f, 0.f};
    bf16x8 At[4][2], B0[2][2], B1[2][2];
    const char* cA = S.a_base(g, cur); const char* cB = S.b_base(g, cur);
    if constexpr (SP2) {
        PG8_STAGE(PG8_SB(0, 0), cB, voffB); PG8_STAGE(PG8_SB(0, 1), cB + hstepB, voffB); PG8_STAGE(PG8_SA(0, 0), cA, voffA); PG8_STAGE(PG8_SA(0, 1), cA + hstepA, voffA);
        if (wr == 1) PG8_BAR;
        PG8_WAIT_V(2); PG8_BAR;
        PG8_STAGE(PG8_SB(1, 0), cB + kstep, voffB); PG8_STAGE(PG8_SA(1, 0), cA + kstep, voffA); PG8_STAGE(PG8_SB(1, 1), cB + hstepB + kstep, voffB);
        PG8_WAIT_V(6); PG8_BAR;
    } else {
        PG8_STAGE(PG8_SB(0, 0), cB, voffB); PG8_STAGE(PG8_SA(0, 0), cA, voffA); PG8_STAGE(PG8_SB(0, 1), cB + hstepB, voffB); PG8_STAGE(PG8_SA(0, 1), cA + hstepA, voffA);
        if (wr == 1) PG8_BAR;
        PG8_WAIT_V(4); PG8_BAR;
        PG8_STAGE(PG8_SB(1, 0), cB + kstep, voffB); PG8_STAGE(PG8_SA(1, 0), cA + kstep, voffA); PG8_STAGE(PG8_SB(1, 1), cB + hstepB + kstep, voffB);
        PG8_WAIT_V(6); PG8_BAR;
    }
    for (;;) {
        const bool has_next = S.next(ui + 1, nxt);
        const char* nA = has_next ? S.a_base(g, nxt) : cA; const char* nB = has_next ? S.b_base(g, nxt) : cB;
        for (int t = 0; t < nt; t += 2) {
            const bool last = (t == nt - 2);
            const char* a1 = cA + (size_t)(t + 1) * kstep;
            const char* a2 = last ? nA : cA + (size_t)(t + 2) * kstep; const char* b2 = last ? nB : cB + (size_t)(t + 2) * kstep;
            const char* a3 = a2 + kstep; const char* b3 = b2 + kstep;
            if constexpr (SP2) {
            PG8_LDB(B0, 0, 0); PG8_LDB(B1, 0, 1); PG8_SCHED; PG8_LDA(At, 0, 0); PG8_STAGE(PG8_SA(1, 1), a1 + hstepA, voffA);
            PG8_WAIT_V(8); PG8_WAIT_L(0); PG8_BAR; PG8_MMA(0, 0, At, B0); PG8_MMA(0, 1, At, B1); PG8_BAR; PG8_SCHED;
            PG8_LDA(At, 0, 1); PG8_STAGE(PG8_SB(0, 0), b2, voffB); PG8_STAGE(PG8_SB(0, 1), b2 + hstepB, voffB); PG8_STAGE(PG8_SA(0, 0), a2, voffA);
            PG8_WAIT_V(8); PG8_WAIT_L(0); PG8_BAR; PG8_MMA(1, 0, At, B0); PG8_MMA(1, 1, At, B1); PG8_BAR; PG8_SCHED;
            PG8_LDB(B0, 1, 0); PG8_LDB(B1, 1, 1); PG8_SCHED; PG8_LDA(At, 1, 0); PG8_STAGE(PG8_SA(0, 1), a2 + hstepA, voffA);
            PG8_WAIT_V(8); PG8_WAIT_L(0); PG8_BAR; PG8_MMA(0, 0, At, B0); PG8_MMA(0, 1, At, B1); PG8_BAR; PG8_SCHED;
            PG8_LDA(At, 1, 1); PG8_STAGE(PG8_SB(1, 0), b3, voffB); PG8_STAGE(PG8_SB(1, 1), b3 + hstepB, voffB); PG8_STAGE(PG8_SA(1, 0), a3, voffA);
            PG8_WAIT_V(8); PG8_WAIT_L(0); PG8_BAR; PG8_MMA(1, 0, At, B0); PG8_MMA(1, 1, At, B1); PG8_BAR; PG8_SCHED;
            } else {
            PG8_LDB(B0, 0, 0); PG8_SCHED; PG8_LDA(At, 0, 0); PG8_STAGE(PG8_SA(1, 1), a1 + hstepA, voffA);
            PG8_WAIT_L(8); PG8_BAR; PG8_WAIT_L(0); PG8_MMA(0, 0, At, B0); PG8_BAR; PG8_SCHED;
            PG8_LDB(B1, 0, 1); PG8_STAGE(PG8_SB(0, 0), b2, voffB);
            PG8_BAR; PG8_WAIT_L(0); PG8_MMA(0, 1, At, B1); PG8_BAR;
            PG8_LDA(At, 0, 1); PG8_STAGE(PG8_SA(0, 0), a2, voffA);
            PG8_BAR; PG8_WAIT_L(0); PG8_MMA(1, 0, At, B0); PG8_BAR; PG8_SCHED;
            PG8_STAGE(PG8_SB(0, 1), b2 + hstepB, voffB);
            PG8_WAIT_V(6); PG8_BAR; PG8_MMA(1, 1, At, B1); PG8_BAR;
            PG8_LDB(B0, 1, 0); PG8_SCHED; PG8_LDA(At, 1, 0); PG8_STAGE(PG8_SA(0, 1), a2 + hstepA, voffA);
            PG8_WAIT_L(8); PG8_BAR; PG8_WAIT_L(0); PG8_MMA(0, 0, At, B0); PG8_BAR; PG8_SCHED;
            PG8_LDB(B1, 1, 1); PG8_STAGE(PG8_SB(1, 0), b3, voffB);
            PG8_BAR; PG8_WAIT_L(0); PG8_MMA(0, 1, At, B1); PG8_BAR;
            PG8_LDA(At, 1, 1); PG8_STAGE(PG8_SA(1, 0), a3, voffA);
            PG8_BAR; PG8_WAIT_L(0); PG8_MMA(1, 0, At, B0); PG8_BAR; PG8_SCHED;
            PG8_STAGE(PG8_SB(1, 1), b3 + hstepB, voffB);
            PG8_WAIT_V(6); PG8_BAR; PG8_MMA(1, 1, At, B1); PG8_BAR;
            }
        }
        if constexpr (ALIGN_EPI) { if (wr == 0) PG8_BAR; }
        E(acc, cur, wr, wc, fr, fq);
        if (!has_next) break;
#pragma unroll
        for (int a = 0; a < 2; ++a)
#pragma unroll
            for (int b = 0; b < 2; ++b)
#pragma unroll
                for (int m = 0; m < 4; ++m)
#pragma unroll
                    for (int n = 0; n < 2; ++n) acc[a][b][m][n] = (f32x4){0.f, 0.f, 0.f, 0.f};
        cur = nxt; cA = nA; cB = nB; ++ui;
        if constexpr (ALIGN_EPI) { if (wr == 1) PG8_BAR; }
    }
    PG8_WAIT_V(0);
    if constexpr (!ALIGN_EPI) { if (wr == 0) PG8_BAR; }
    PG8_BAR;
#undef PG8_SA
#undef PG8_SB
#undef PG8_STAGE
#undef PG8_LDA
#undef PG8_LDB
#undef PG8_MMA
#undef PG8_WAIT_V
#undef PG8_WAIT_L
#undef PG8_BAR
#undef PG8_SCHED
}
}
#define LAS __attribute__((address_space(3)))
#define XB_TMO      128
#define XB_XCNT(j)  (256  + 64 * (j))
#define XB_XSUB(j)  (1280 + 64 * (j))
#define XB_XGEN(j)  (2304 + 64 * (j))
#define XB_TOP      3328
#define XB_TOPGEN   3392
#define XCD_BAR_WORDS 3456
#define XB_SPIN_CAP (1u << 22)

__device__ __forceinline__ unsigned xb_ld(unsigned* p)              { return __hip_atomic_load(p, __ATOMIC_RELAXED, __HIP_MEMORY_SCOPE_AGENT); }
__device__ __forceinline__ unsigned xb_add(unsigned* p, unsigned v) { return __hip_atomic_fetch_add(p, v, __ATOMIC_RELAXED, __HIP_MEMORY_SCOPE_AGENT); }
__device__ __forceinline__ unsigned xb_xcc_id() { return (unsigned)__builtin_amdgcn_s_getreg((3 << 11) | 20) & 0xFu; }
#define XB_SPIN(cond, bar) do { unsigned _sp = 0; while (cond) { __builtin_amdgcn_s_sleep(1); \
    if ((++_sp & 255u) == 0u) { if (xb_ld(&(bar)[XB_TMO])) break; if (_sp > XB_SPIN_CAP) { atomicAdd(&(bar)[XB_TMO], 1u); break; } } } } while (0)

struct XcdBarrier {
    unsigned* bar; unsigned x;
    volatile LAS unsigned* st;
};

__device__ __forceinline__ XcdBarrier xcd_barrier_post(unsigned* bar, volatile LAS unsigned* st) {
    XcdBarrier b; b.bar = bar; b.x = xb_xcc_id(); b.st = st;
    if (threadIdx.x == 0) (void)xb_add(&bar[XB_XCNT(b.x)], 1u);
    return b;
}
__device__ __forceinline__ void xcd_barrier_complete(unsigned* bar, unsigned x, unsigned& nloc, unsigned& nx) {
    const unsigned G = gridDim.x * gridDim.y * gridDim.z;
    unsigned sum, cnt, mine, sp = 0u;
    for (;;) {
        sum = 0u; cnt = 0u; mine = 0u;
#pragma unroll
        for (unsigned j = 0; j < 16; ++j) { const unsigned c = xb_ld(&bar[XB_XCNT(j)]); sum += c; cnt += (c > 0u) ? 1u : 0u; mine = (j == x) ? c : mine; }
        if (sum == G) break;
        __builtin_amdgcn_s_sleep(1);
        if ((++sp & 255u) == 0u) { if (xb_ld(&bar[XB_TMO])) break; if (sp > XB_SPIN_CAP) { atomicAdd(&bar[XB_TMO], 1u); break; } }
    }
    nloc = mine > 0u ? mine : 1u; nx = cnt > 0u ? cnt : 1u;
}

__device__ __forceinline__ void xcd_barrier(const XcdBarrier& b) {
    asm volatile("s_waitcnt vmcnt(0)" ::: "memory");
    __syncthreads();
    if (threadIdx.x == 0) {
        unsigned* bar = b.bar;
        __builtin_amdgcn_s_waitcnt(0);
        unsigned nloc = b.st[0], nx = b.st[1];
        if (nloc == 0u) { xcd_barrier_complete(bar, b.x, nloc, nx); b.st[0] = nloc; b.st[1] = nx; }
        const unsigned old = xb_add(&bar[XB_XSUB(b.x)], 1u);
        const unsigned gen = old / nloc;
        if (old + 1u == (gen + 1u) * nloc) {
            __builtin_amdgcn_fence(__ATOMIC_RELEASE, "agent");
            asm volatile("s_waitcnt vmcnt(0)" ::: "memory");
            const unsigned og = xb_add(&bar[XB_TOP], 1u);
            const unsigned tg = og / nx;
            if (og + 1u == (tg + 1u) * nx) xb_add(&bar[XB_TOPGEN], 1u);
            else XB_SPIN(xb_ld(&bar[XB_TOPGEN]) == tg, bar);
            __builtin_amdgcn_fence(__ATOMIC_ACQUIRE, "agent");
            xb_add(&bar[XB_XGEN(b.x)], 1u);
            asm volatile("s_waitcnt vmcnt(0)" ::: "memory");
        } else {
            XB_SPIN(xb_ld(&bar[XB_XGEN(b.x)]) == gen, bar);
            __builtin_amdgcn_fence(__ATOMIC_ACQUIRE, "agent");
            asm volatile("s_waitcnt vmcnt(0)" ::: "memory");
        }
    }
    __syncthreads();
}
#undef LAS
constexpr int NWAVES = 8;
constexpr int BATCH = 2, SEQ = 16384, NTOK = BATCH * SEQ, DM = 1024, DEPTH = 4, PLE = 256;
constexpr int EVEN_IN = 2216, EVEN_INP = 2304, ODD_IN = 2568, ODD_INP = 2816;
constexpr int E_FQ = 0, E_FK = 512, E_FV = 1024, E_FLOG = 1536, E_CQ = 1544, E_CKV = 1928, E_KROPE = 2184;
constexpr int O_U = 0, O_Q = 512, O_K = 1024, O_V = 1536, O_GIN = 2048, O_BETA = 2052, O_Z = 2056;
constexpr float RMS_EPS = 1e-6f;
constexpr int MOE_CAP = 65536 + 32 * 256;
constexpr int MOE_MAXT = MOE_CAP / 256;

enum { I_X = 0, I_P, I_POS, I_NORM_MIX, I_NORM_FFN, I_EV_W_IN, I_FOX_BF, I_FOX_QN, I_FOX_KN, I_MLA_QAN, I_MLA_WQUP, I_MLA_KVAN, I_MLA_WKVUP, I_MLA_QN, I_MLA_KN, I_EV_W_OUT,
       I_OD_W_IN, I_S5_ARE, I_S5_AIM, I_S5_BRE, I_S5_BIM, I_S5_CRE, I_S5_CIM, I_S5_D, I_S5_LS, I_S5_WGLU, I_S5_BGLU, I_GDN_CONV, I_GDN_ALOG, I_GDN_DTB, I_GDN_ONORM, I_OD_W_OUT,
       I_MOE_WGRP, I_MOE_BGRP, I_MOE_WEXP, I_MOE_BEXP, I_MOE_WG, I_MOE_WU, I_MOE_WD, I_PLE_WP, I_PLE_NORM, I_PLE_WG, I_PLE_BG, N_IN };

constexpr size_t MiB = 1u << 20;
constexpr size_t WS_CTL = 0, CTL_ZERO_BYTES = 1 * MiB;
constexpr size_t WS_W_EVIN = 4 * MiB;
constexpr size_t WS_W_ODIN = WS_W_EVIN + 9 * MiB;
constexpr size_t WS_W_QUP = WS_W_ODIN + 11 * MiB;
constexpr size_t WS_W_KVUP = WS_W_QUP + 2 * MiB;
constexpr size_t WS_W_EVOUT = WS_W_KVUP + 1 * MiB;
constexpr size_t WS_W_ODOUT = WS_W_EVOUT + 4 * MiB;
constexpr size_t WS_W_GLU = WS_W_ODOUT + 4 * MiB;
constexpr size_t WS_W_PLEP = WS_W_GLU + 1 * MiB;
constexpr size_t WS_W_PLEG = WS_W_PLEP + 2 * MiB;
constexpr size_t WS_W_MOEGU = WS_W_PLEG + 8 * MiB;
constexpr size_t WS_W_MOED = WS_W_MOEGU + 64 * MiB;
constexpr size_t WS_ABF = WS_W_MOED + 32 * MiB;
constexpr size_t WS_PP = WS_ABF + 64 * MiB;
constexpr size_t WS_PBF = WS_PP + 64 * MiB;
constexpr size_t WS_PROJ = WS_PBF + 16 * MiB;
constexpr size_t WS_MIX = WS_PROJ + 176 * MiB;
constexpr size_t WS_R1 = WS_MIX + 64 * MiB;
constexpr size_t WS_QM = WS_R1, WS_KVB = WS_QM + 48 * MiB, WS_KM = WS_KVB + 64 * MiB, WS_CQN = WS_KM + 48 * MiB, WS_CKVN = WS_CQN + 24 * MiB, WS_LOGF = WS_CKVN + 16 * MiB, WS_CUM = WS_LOGF + 1 * MiB;
constexpr size_t WS_HG = WS_R1, WS_QG = WS_HG + 32 * MiB, WS_KG = WS_QG + 64 * MiB, WS_VG = WS_KG + 64 * MiB, WS_OG = WS_VG + 64 * MiB;
constexpr size_t WS_R2 = WS_R1 + 288 * MiB;
constexpr size_t WS_GB = WS_R2, WS_BETA = WS_GB + 1 * MiB;
constexpr size_t WS_TOKE = WS_R2 + 2 * MiB, WS_TOKW = WS_TOKE + 1 * MiB, WS_ROWS = WS_TOKW + 1 * MiB;
constexpr size_t WS_XG = WS_R1;
constexpr size_t WS_HB = WS_XG + 144 * MiB;
constexpr size_t WS_Y2 = WS_R2 + 8 * MiB;
constexpr size_t WS_END = WS_Y2 + 144 * MiB;
static_assert(WS_HB + 72 * MiB <= WS_R2, "moe overlay");
static_assert(WS_OG + 64 * MiB <= WS_R2, "odd overlay");
static_assert(WS_END <= 1100 * MiB, "workspace budget");

constexpr int CW_BAR = 4096;
constexpr int CW_CNT = 1024;

constexpr int RING_OFF = 0, RING_BYTES = 131072;
constexpr int LDSCTL_OFF = RING_BYTES;
constexpr int LDS_BYTES = 147456;
constexpr int LC_BARST = 32;
constexpr int LC_MOE = 256;

#define GAS __attribute__((address_space(1)))
#define LAS __attribute__((address_space(3)))
typedef unsigned short bf16;
typedef unsigned v4u __attribute__((ext_vector_type(4)));
typedef unsigned v2u __attribute__((ext_vector_type(2)));
typedef float f32x4 __attribute__((ext_vector_type(4)));
#define LDS_WAIT() asm volatile("s_waitcnt lgkmcnt(0)" ::: "memory")
#define VM_WAIT() asm volatile("s_waitcnt vmcnt(0)" ::: "memory")
__device__ __forceinline__ unsigned f2bf(float f) { unsigned u = __builtin_bit_cast(unsigned, f); return (u + 0x7fffu + ((u >> 16) & 1u)) >> 16; }
__device__ __forceinline__ unsigned pk2(float lo, float hi) { return f2bf(lo) | (f2bf(hi) << 16); }
__device__ __forceinline__ float bflo(unsigned w) { return __uint_as_float(w << 16); }
__device__ __forceinline__ float bfhi(unsigned w) { return __uint_as_float(w & 0xffff0000u); }
__device__ __forceinline__ float bf2f(bf16 h) { return __uint_as_float((unsigned)h << 16); }
__device__ __forceinline__ float wave_sum(float v) {
#pragma unroll
    for (int o = 1; o < 64; o <<= 1) v += __shfl_xor(v, o);
    return v;
}
__device__ __forceinline__ float sigm(float x) { return 1.0f / (1.0f + expf(-x)); }
__device__ __forceinline__ float softplusf_(float x) { return fmaxf(x, 0.f) + log1pf(expf(-fabsf(x))); }
__device__ __forceinline__ float gelu_tanh(float x) { return 0.5f * x * (1.0f + tanhf(0.7978845608028654f * (x + 0.044715f * x * x * x))); }

struct Args { const float* in[N_IN]; float* out; unsigned char* ws; int ph_lo, ph_hi; };
#define CAS __attribute__((address_space(4)))
__device__ __forceinline__ const float* kin(int i) { asm volatile("" : "+s"(i)); const CAS char* kp = (const CAS char*)__builtin_amdgcn_kernarg_segment_ptr(); return *(const float* const CAS*)(kp + 8 * i); }
__device__ __forceinline__ float* kout() { int i = N_IN; asm volatile("" : "+s"(i)); const CAS char* kp = (const CAS char*)__builtin_amdgcn_kernarg_segment_ptr(); return *(float* const CAS*)(kp + 8 * i); }
__device__ __forceinline__ unsigned char* kws() { int i = N_IN + 1; asm volatile("" : "+s"(i)); const CAS char* kp = (const CAS char*)__builtin_amdgcn_kernarg_segment_ptr(); return *(unsigned char* const CAS*)(kp + 8 * i); }

struct Frame {
    LAS unsigned char* lds;
    unsigned char* ws;
    unsigned* ctl;
    int tid, lane, wave, G, bid;
};

__device__ __forceinline__ void transpose_item(const float* W, int K, int N, bf16* WT, int drow0, LAS float* scr, int k0, int n0, int lane) {
    const int nn = n0 + (lane & 31); const bool ok = nn < N;
#pragma unroll 8
    for (int i = 0; i < 32; ++i) { const int kk = 2 * i + (lane >> 5); scr[kk * 33 + (lane & 31)] = ok ? W[(size_t)(k0 + kk) * N + nn] : 0.f; }
    LDS_WAIT(); asm volatile("" ::: "memory");
    const int c = lane & 7;
#pragma unroll
    for (int j = 0; j < 4; ++j) { const int n = (lane >> 3) + 8 * j; const LAS float* s = scr + (8 * c) * 33 + n;
        v4u o; o.x = pk2(s[0 * 33], s[1 * 33]); o.y = pk2(s[2 * 33], s[3 * 33]); o.z = pk2(s[4 * 33], s[5 * 33]); o.w = pk2(s[6 * 33], s[7 * 33]);
        *(v4u*)(WT + (size_t)(drow0 + n) * K + k0 + 8 * c) = o; }
    LDS_WAIT(); asm volatile("" ::: "memory");
}
__device__ __forceinline__ void transpose_set(Frame& F, const float* W, int nmat, int K, int N, int NP, bf16* WT, int& itbase) {
    LAS float* scr = (LAS float*)(F.lds + RING_OFF + F.wave * 16384);
    const int gw = F.bid * NWAVES + F.wave, NGW = F.G * NWAVES;
    const int nkb = K / 64, nnb = NP / 32, per = nkb * nnb, total = nmat * per;
    int first = (gw - (itbase % NGW) + NGW) % NGW;
    for (int it = first; it < total; it += NGW) { const int mi = it / per, r = it % per, kb = r / nnb, nb = r % nnb;
        transpose_item(W + (size_t)mi * K * N, K, N, WT + (size_t)mi * NP * K, nb * 32, scr, kb * 64, nb * 32, F.lane); }
    itbase += total;
}
__device__ __forceinline__ void prologue_weights(Frame& F) {
 int itb = 0;
    transpose_set(F, kin(I_EV_W_IN), 2, 1024, EVEN_IN, EVEN_INP, (bf16*)(F.ws + WS_W_EVIN), itb);
    transpose_set(F, kin(I_OD_W_IN), 2, 1024, ODD_IN, ODD_INP, (bf16*)(F.ws + WS_W_ODIN), itb);
    transpose_set(F, kin(I_MLA_WQUP), 2, 384, 768, 768, (bf16*)(F.ws + WS_W_QUP), itb);
    transpose_set(F, kin(I_MLA_WKVUP), 2, 256, 1024, 1024, (bf16*)(F.ws + WS_W_KVUP), itb);
    transpose_set(F, kin(I_EV_W_OUT), 2, 1024, 1024, 1024, (bf16*)(F.ws + WS_W_EVOUT), itb);
    transpose_set(F, kin(I_OD_W_OUT), 2, 1024, 1024, 1024, (bf16*)(F.ws + WS_W_ODOUT), itb);
    transpose_set(F, kin(I_S5_WGLU), 2, 512, 512, 512, (bf16*)(F.ws + WS_W_GLU), itb);
    transpose_set(F, kin(I_PLE_WP), 4, 256, 1024, 1024, (bf16*)(F.ws + WS_W_PLEP), itb);
    transpose_set(F, kin(I_PLE_WG), 4, 1024, 1024, 1024, (bf16*)(F.ws + WS_W_PLEG), itb);
}
__device__ __forceinline__ void moe_weights(Frame& F, int layer) {

    LAS float* scr = (LAS float*)(F.lds + RING_OFF + F.wave * 16384);
    const int gw = F.bid * NWAVES + F.wave, NGW = F.G * NWAVES;
    const float* wg = kin(I_MOE_WG) + (size_t)layer * 32 * 1024 * 512; const float* wu = kin(I_MOE_WU) + (size_t)layer * 32 * 1024 * 512; const float* wd = kin(I_MOE_WD) + (size_t)layer * 32 * 512 * 1024;
    bf16* WGU = (bf16*)(F.ws + WS_W_MOEGU); bf16* WD = (bf16*)(F.ws + WS_W_MOED);
    for (int it = gw; it < 2 * 32 * 256; it += NGW) { const int which = it / (32 * 256), r0 = it % (32 * 256), e = r0 / 256, r = r0 % 256, kb = r / 16, nb = r % 16, n0 = nb * 32;
        const int drow = 256 * (n0 / 128) + (n0 % 128) + which * 128;
        transpose_item((which ? wu : wg) + (size_t)e * 1024 * 512, 1024, 512, WGU + (size_t)e * 1024 * 1024, drow, scr, kb * 64, n0, F.lane); }
    for (int it = gw; it < 32 * 256; it += NGW) { const int e = it / 256, r = it % 256, kb = r / 32, nb = r % 32;
        transpose_item(wd + (size_t)e * 512 * 1024, 512, 1024, WD + (size_t)e * 1024 * 512, nb * 32, scr, kb * 64, nb * 32, F.lane); }
}

__device__ __forceinline__ void rms_row_to_bf16(const float* xrow, const float* gain, bf16* orow, float* copy, int lane) {
    const f32x4* xr = (const f32x4*)xrow + lane; f32x4 v[4]; float s = 0.f;
#pragma unroll
    for (int j = 0; j < 4; ++j) { v[j] = xr[64 * j]; s += (v[j].x * v[j].x + v[j].y * v[j].y) + (v[j].z * v[j].z + v[j].w * v[j].w); }
    const float r = 1.0f / sqrtf(wave_sum(s) * (1.f / 1024.f) + RMS_EPS);
    if (copy) {
#pragma unroll
        for (int j = 0; j < 4; ++j) ((f32x4*)copy + lane)[64 * j] = v[j]; }
    unsigned long long* o8 = (unsigned long long*)orow + lane;
#pragma unroll
    for (int j = 0; j < 4; ++j) { const f32x4 g = ((const f32x4*)gain + lane)[64 * j];
        o8[64 * j] = (unsigned long long)pk2(v[j].x * r * g.x, v[j].y * r * g.y) | ((unsigned long long)pk2(v[j].z * r * g.z, v[j].w * r * g.w) << 32); }
}
__device__ __forceinline__ void phase_norm(Frame& F, const float* src, const float* gain, float* copy) {
    bf16* ABF = (bf16*)(F.ws + WS_ABF);
    const int gw = F.bid * NWAVES + F.wave, NGW = F.G * NWAVES;
    for (int m = gw; m < NTOK; m += NGW) rms_row_to_bf16(src + (size_t)m * DM, gain, ABF + (size_t)m * DM, copy ? copy + (size_t)m * DM : nullptr, F.lane);
}
__device__ __forceinline__ void phase_pconv(Frame& F, int layer) {
    const float* p = kin(I_P) + (size_t)layer * NTOK * PLE; bf16* PBF = (bf16*)(F.ws + WS_PBF);
    const size_t n4 = (size_t)NTOK * PLE / 4; const size_t gt = (size_t)F.bid * 512 + F.tid, NT = (size_t)F.G * 512;
    for (size_t i = gt; i < n4; i += NT) { const f32x4 v = ((const f32x4*)p)[i]; v2u o; o.x = pk2(v.x, v.y); o.y = pk2(v.z, v.w); ((v2u*)PBF)[i] = o; }
}

__device__ __forceinline__ void phase_even_post(Frame& F, int j) {

    bf16* PROJ = (bf16*)(F.ws + WS_PROJ); bf16* CQN = (bf16*)(F.ws + WS_CQN); bf16* CKVN = (bf16*)(F.ws + WS_CKVN); float* LOGF = (float*)(F.ws + WS_LOGF);
    const float* qn = kin(I_FOX_QN) + j * 64; const float* kn = kin(I_FOX_KN) + j * 64; const float* bfv = kin(I_FOX_BF) + j * 8;
    const float* qan = kin(I_MLA_QAN) + j * 384; const float* kvan = kin(I_MLA_KVAN) + j * 256;
    const int gw = F.bid * NWAVES + F.wave, NGW = F.G * NWAVES, lane = F.lane;
    for (int m = gw; m < NTOK; m += NGW) {
        bf16* row = PROJ + (size_t)m * EVEN_INP;
#pragma unroll
        for (int w = 0; w < 2; ++w) {
            v4u* p = (v4u*)(row + (w ? E_FK : E_FQ)) + lane; const v4u x = *p;
            float f[8] = {bflo(x.x), bfhi(x.x), bflo(x.y), bfhi(x.y), bflo(x.z), bfhi(x.z), bflo(x.w), bfhi(x.w)};
            float s = 0.f;
#pragma unroll
            for (int i = 0; i < 8; ++i) s += f[i] * f[i];
            s += __shfl_xor(s, 1); s += __shfl_xor(s, 2); s += __shfl_xor(s, 4);
            const float r = 1.0f / sqrtf(s * (1.f / 64.f) + RMS_EPS); const float* g = (w ? kn : qn) + (lane & 7) * 8;
            v4u o; o.x = pk2(f[0] * r * g[0], f[1] * r * g[1]); o.y = pk2(f[2] * r * g[2], f[3] * r * g[3]); o.z = pk2(f[4] * r * g[4], f[5] * r * g[5]); o.w = pk2(f[6] * r * g[6], f[7] * r * g[7]);
            *p = o;
        }
        if (lane < 8) { const float z = bf2f(row[E_FLOG + lane]) + bfv[lane]; LOGF[(size_t)m * 8 + lane] = -softplusf_(-z); }
        {
            float f[6]; float s = 0.f;
#pragma unroll
            for (int i = 0; i < 3; ++i) { const unsigned x = *((const unsigned*)(row + E_CQ) + lane + 64 * i); f[2 * i] = bflo(x); f[2 * i + 1] = bfhi(x); s += f[2 * i] * f[2 * i] + f[2 * i + 1] * f[2 * i + 1]; }
            const float r = 1.0f / sqrtf(wave_sum(s) * (1.f / 384.f) + RMS_EPS);
#pragma unroll
            for (int i = 0; i < 3; ++i) { const int c = 2 * (lane + 64 * i); *((unsigned*)(CQN + (size_t)m * 384) + lane + 64 * i) = pk2(f[2 * i] * r * qan[c], f[2 * i + 1] * r * qan[c + 1]); }
        }
        {
            float f[4]; float s = 0.f;
#pragma unroll
            for (int i = 0; i < 2; ++i) { const unsigned x = *((const unsigned*)(row + E_CKV) + lane + 64 * i); f[2 * i] = bflo(x); f[2 * i + 1] = bfhi(x); s += f[2 * i] * f[2 * i] + f[2 * i + 1] * f[2 * i + 1]; }
            const float r = 1.0f / sqrtf(wave_sum(s) * (1.f / 256.f) + RMS_EPS);
#pragma unroll
            for (int i = 0; i < 2; ++i) { const int c = 2 * (lane + 64 * i); *((unsigned*)(CKVN + (size_t)m * 256) + lane + 64 * i) = pk2(f[2 * i] * r * kvan[c], f[2 * i + 1] * r * kvan[c + 1]); }
        }
    }
}
__device__ __forceinline__ void phase_cumsum(Frame& F) {
    if (F.bid >= 16) return;
    const float* LOGF = (const float*)(F.ws + WS_LOGF); float* CUM = (float*)(F.ws + WS_CUM);
    const int b = F.bid >> 3, h = F.bid & 7, t0 = F.tid * 32;
    LAS double* part = (LAS double*)(F.lds + RING_OFF);
    float v[32]; double s = 0.0;
#pragma unroll
    for (int i = 0; i < 32; ++i) { v[i] = LOGF[((size_t)b * SEQ + t0 + i) * 8 + h]; s += (double)v[i]; }
    part[F.tid] = s; __syncthreads();
    if (F.tid == 0) { double run = 0.0; for (int i = 0; i < 512; ++i) { const double x = part[i]; part[i] = run; run += x; } }
    __syncthreads();
    double run = part[F.tid];
#pragma unroll
    for (int i = 0; i < 32; ++i) { run += (double)v[i]; CUM[((size_t)b * SEQ + t0 + i) * 8 + h] = (float)run; }
    __syncthreads();
}
__device__ __forceinline__ void phase_mla_post(Frame& F, int j) {

    const bf16* PROJ = (const bf16*)(F.ws + WS_PROJ); bf16* QM = (bf16*)(F.ws + WS_QM); const bf16* KVB = (const bf16*)(F.ws + WS_KVB); bf16* KM = (bf16*)(F.ws + WS_KM);
    const float* qn = kin(I_MLA_QN) + j * 96; const float* kn = kin(I_MLA_KN) + j * 96; const int* pos = (const int*)kin(I_POS);
    const int gw = F.bid * NWAVES + F.wave, NGW = F.G * NWAVES, lane = F.lane, l32 = lane & 31, hh = lane >> 5;
    const int fi = l32 & 15; const float inv = expf(-(float)fi * (1.0f / 16.0f) * 9.210340371976184f);
    for (int m = gw; m < NTOK; m += NGW) {
        const float ang = (float)pos[m] * inv; float sn, cs; sincosf(ang, &sn, &cs);
        const float krope = bf2f(PROJ[(size_t)m * EVEN_INP + E_KROPE + l32]);
#pragma unroll
        for (int hp = 0; hp < 4; ++hp) { const int h = hp * 2 + hh;
#pragma unroll
            for (int w = 0; w < 2; ++w) {
                float f[3];
                if (w == 0) { const bf16* q = QM + (size_t)m * 768 + h * 96; f[0] = bf2f(q[l32]); f[1] = bf2f(q[l32 + 32]); f[2] = bf2f(q[l32 + 64]); }
                else { const bf16* k = KVB + (size_t)m * 1024 + h * 128; f[0] = bf2f(k[l32]); f[1] = bf2f(k[l32 + 32]); f[2] = krope; }
                float s = f[0] * f[0] + f[1] * f[1] + f[2] * f[2];
                s += __shfl_xor(s, 1); s += __shfl_xor(s, 2); s += __shfl_xor(s, 4); s += __shfl_xor(s, 8); s += __shfl_xor(s, 16);
                const float r = 1.0f / sqrtf(s * (1.f / 96.f) + RMS_EPS); const float* g = w ? kn : qn;
                f[0] *= r * g[l32]; f[1] *= r * g[l32 + 32]; f[2] *= r * g[l32 + 64];
                const float other = __shfl_xor(f[2], 16);
                const float rot = (l32 < 16) ? (f[2] * cs - other * sn) : (other * sn + f[2] * cs);
                bf16* o = (w ? KM : QM) + (size_t)m * 768 + h * 96;
                o[l32] = (bf16)f2bf(f[0]); o[l32 + 32] = (bf16)f2bf(f[1]); o[l32 + 64] = (bf16)f2bf(rot);
            }
        }
    }
}
template <int DK> __device__ __forceinline__ void attn_naive_unit(Frame& F, const bf16* Qp, int qld, const bf16* Kp, int kld, const bf16* Vp, int vld, const float* cum  , float scale, bf16* Op, int qb) {
    LAS float* Ks = (LAS float*)(F.lds + RING_OFF); LAS float* Vs = Ks + 64 * DK; LAS float* Cs = Vs + 64 * 64;
    const int t = qb * 512 + F.wave * 64 + F.lane; const int tmax_w = qb * 512 + F.wave * 64 + 63;
    float q[DK];
#pragma unroll
    for (int d = 0; d < DK; d += 8) { const v4u x = *(const v4u*)(Qp + (size_t)t * qld + d);
        q[d] = bflo(x.x) * scale; q[d + 1] = bfhi(x.x) * scale; q[d + 2] = bflo(x.y) * scale; q[d + 3] = bfhi(x.y) * scale; q[d + 4] = bflo(x.z) * scale; q[d + 5] = bfhi(x.z) * scale; q[d + 6] = bflo(x.w) * scale; q[d + 7] = bfhi(x.w) * scale; }
    const float cq = cum ? cum[(size_t)t * 8] : 0.f;
    float acc[64];
#pragma unroll
    for (int d = 0; d < 64; ++d) acc[d] = 0.f;
    float mx = -1e30f, l = 0.f;
    const int nkb = (qb * 512 + 512) / 64;
    for (int kb = 0; kb < nkb; ++kb) {
        __syncthreads();
        for (int i = F.tid; i < 64 * DK / 8; i += 512) { const int key = i / (DK / 8), c = (i % (DK / 8)) * 8; const v4u x = *(const v4u*)(Kp + (size_t)(kb * 64 + key) * kld + c);
            LAS float* d = Ks + key * DK + c; d[0] = bflo(x.x); d[1] = bfhi(x.x); d[2] = bflo(x.y); d[3] = bfhi(x.y); d[4] = bflo(x.z); d[5] = bfhi(x.z); d[6] = bflo(x.w); d[7] = bfhi(x.w); }
        { const int i = F.tid; const int key = i / 8, c = (i % 8) * 8; const v4u x = *(const v4u*)(Vp + (size_t)(kb * 64 + key) * vld + c);
            LAS float* d = Vs + key * 64 + c; d[0] = bflo(x.x); d[1] = bfhi(x.x); d[2] = bflo(x.y); d[3] = bfhi(x.y); d[4] = bflo(x.z); d[5] = bfhi(x.z); d[6] = bflo(x.w); d[7] = bfhi(x.w); }
        if (F.tid < 64) Cs[F.tid] = cum ? cum[(size_t)(kb * 64 + F.tid) * 8] : 0.f;
        __syncthreads();
        if (kb * 64 > tmax_w) continue;
        for (int jk = 0; jk < 64; ++jk) {
            const int s = kb * 64 + jk; if (s > tmax_w) break;
            const LAS float* kr = Ks + jk * DK; float dot = 0.f;
#pragma unroll
            for (int d = 0; d < DK; d += 4) { const f32x4 kv = *(const LAS f32x4*)(kr + d); dot += q[d] * kv.x + q[d + 1] * kv.y + q[d + 2] * kv.z + q[d + 3] * kv.w; }
            float logit = dot + (cq - Cs[jk]); if (s > t) logit = -1e30f;
            if (__any(logit > mx)) { const float mn = fmaxf(mx, logit); const float corr = expf(mx - mn); l *= corr;
#pragma unroll
                for (int d = 0; d < 64; ++d) acc[d] *= corr;
                mx = mn; }
            const float p = (s > t) ? 0.f : expf(logit - mx); l += p;
            const LAS float* vr = Vs + jk * 64;
#pragma unroll
            for (int d = 0; d < 64; d += 4) { const f32x4 vv = *(const LAS f32x4*)(vr + d); acc[d] += p * vv.x; acc[d + 1] += p * vv.y; acc[d + 2] += p * vv.z; acc[d + 3] += p * vv.w; }
        }
    }
    const float il = 1.0f / l; bf16* o = Op + (size_t)t * DM;
#pragma unroll
    for (int d = 0; d < 64; d += 8) { v4u w; w.x = pk2(acc[d] * il, acc[d + 1] * il); w.y = pk2(acc[d + 2] * il, acc[d + 3] * il); w.z = pk2(acc[d + 4] * il, acc[d + 5] * il); w.w = pk2(acc[d + 6] * il, acc[d + 7] * il); *(v4u*)(o + d) = w; }
}
__device__ __forceinline__ void phase_attn_naive(Frame& F) {
    const bf16* PROJ = (const bf16*)(F.ws + WS_PROJ); const bf16* QM = (const bf16*)(F.ws + WS_QM); const bf16* KVB = (const bf16*)(F.ws + WS_KVB); const bf16* KM = (const bf16*)(F.ws + WS_KM);
    const float* CUM = (const float*)(F.ws + WS_CUM); bf16* MIX = (bf16*)(F.ws + WS_MIX);
    for (int p = F.bid; p < 512; p += F.G) {
        const int combo = p >> 4, qq = p & 15; const int type = combo >> 4, b = (combo >> 3) & 1, h = combo & 7;
#pragma unroll 1
        for (int half = 0; half < 2; ++half) { const int qb = half ? 31 - qq : qq; const size_t rb = (size_t)b * SEQ;
            if (type == 0) attn_naive_unit<64>(F, PROJ + rb * EVEN_INP + E_FQ + h * 64, EVEN_INP, PROJ + rb * EVEN_INP + E_FK + h * 64, EVEN_INP, PROJ + rb * EVEN_INP + E_FV + h * 64, EVEN_INP, CUM + rb * 8 + h, 0.125f, MIX + rb * DM + h * 64, qb);
            else attn_naive_unit<96>(F, QM + rb * 768 + h * 96, 768, KM + rb * 768 + h * 96, 768, KVB + rb * 1024 + h * 128 + 64, 1024, nullptr, 0.10206207261596575f, MIX + rb * DM + 512 + h * 64, qb);
        }
    }
    __syncthreads();
}

__device__ __forceinline__ void s5_scan_wave(Frame& F, int j, int b, int g) {
 const int p = F.lane;
    const bf16* PROJ = (const bf16*)(F.ws + WS_PROJ); bf16* HG = (bf16*)(F.ws + WS_HG);
    const float lr = fminf(kin(I_S5_ARE)[(j * 32 + g) * 64 + p], -1e-4f), li = kin(I_S5_AIM)[(j * 32 + g) * 64 + p];
    const float dt = expf(kin(I_S5_LS)[j * 32 + g]);
    const float mag = expf(lr * dt); const float abr = mag * cosf(li * dt), abi = mag * sinf(li * dt);
    const float den = lr * lr + li * li, nr = abr - 1.0f, ni = abi;
    const float gr = (nr * lr + ni * li) / den, gi = (ni * lr - nr * li) / den;
    float bbr[16], bbi[16], cr[16], ci[16], dsk[16];
#pragma unroll
    for (int c = 0; c < 16; ++c) { const float br = kin(I_S5_BRE)[((size_t)(j * 32 + g) * 64 + p) * 16 + c], bi = kin(I_S5_BIM)[((size_t)(j * 32 + g) * 64 + p) * 16 + c];
        bbr[c] = gr * br - gi * bi; bbi[c] = gr * bi + gi * br;
        cr[c] = kin(I_S5_CRE)[((size_t)(j * 32 + g) * 16 + c) * 64 + p]; ci[c] = kin(I_S5_CIM)[((size_t)(j * 32 + g) * 16 + c) * 64 + p];
        dsk[c] = kin(I_S5_D)[j * 512 + g * 16 + c]; }
    float xr = 0.f, xi = 0.f;
    const bf16* up = PROJ + (size_t)b * SEQ * ODD_INP + O_U + g * 16;
    v4u cur0[4], cur1[4], nx0[4], nx1[4];
#pragma unroll
    for (int i = 0; i < 4; ++i) { cur0[i] = *(const v4u*)(up + (size_t)i * ODD_INP); cur1[i] = *(const v4u*)(up + (size_t)i * ODD_INP + 8); }
    for (int t0 = 0; t0 < SEQ; t0 += 4) {
        const int tn = (t0 + 4 < SEQ) ? t0 + 4 : t0;
#pragma unroll
        for (int i = 0; i < 4; ++i) { nx0[i] = *(const v4u*)(up + (size_t)(tn + i) * ODD_INP); nx1[i] = *(const v4u*)(up + (size_t)(tn + i) * ODD_INP + 8); }
#pragma unroll
        for (int i = 0; i < 4; ++i) {
            float u[16] = {bflo(cur0[i].x), bfhi(cur0[i].x), bflo(cur0[i].y), bfhi(cur0[i].y), bflo(cur0[i].z), bfhi(cur0[i].z), bflo(cur0[i].w), bfhi(cur0[i].w),
                           bflo(cur1[i].x), bfhi(cur1[i].x), bflo(cur1[i].y), bfhi(cur1[i].y), bflo(cur1[i].z), bfhi(cur1[i].z), bflo(cur1[i].w), bfhi(cur1[i].w)};
            float bur = 0.f, bui = 0.f;
#pragma unroll
            for (int c = 0; c < 16; ++c) { bur += bbr[c] * u[c]; bui += bbi[c] * u[c]; }
            const float nxr = abr * xr - abi * xi + bur, nxi = abr * xi + abi * xr + bui; xr = nxr; xi = nxi;
            float y[16];
#pragma unroll
            for (int c = 0; c < 16; ++c) y[c] = wave_sum(cr[c] * xr - ci[c] * xi);
            if (p < 16) { float yy = 0.f, uu = 0.f, dd = 0.f;
#pragma unroll
                for (int c = 0; c < 16; ++c) if (p == c) { yy = y[c]; uu = u[c]; dd = dsk[c]; }
                HG[((size_t)b * SEQ + t0 + i) * 512 + g * 16 + p] = (bf16)f2bf(gelu_tanh(yy + dd * uu)); }
        }
#pragma unroll
        for (int i = 0; i < 4; ++i) { cur0[i] = nx0[i]; cur1[i] = nx1[i]; }
    }
}
__device__ __forceinline__ void gdn_prep_token(Frame& F, int j, int m) {
 const int lane = F.lane;
    const bf16* PROJ = (const bf16*)(F.ws + WS_PROJ); float* QG = (float*)(F.ws + WS_QG); float* KG = (float*)(F.ws + WS_KG); float* VG = (float*)(F.ws + WS_VG);
    float* GB = (float*)(F.ws + WS_GB); float* BETA = (float*)(F.ws + WS_BETA);
    const float* cw = kin(I_GDN_CONV) + (size_t)j * 4 * 1536;
    const int s = m % SEQ;
#pragma unroll
    for (int w = 0; w < 3; ++w) {
        const int ch0 = w * 512 + lane * 8; float acc[8];
#pragma unroll
        for (int i = 0; i < 8; ++i) acc[i] = 0.f;
#pragma unroll
        for (int tap = 0; tap < 4; ++tap) { const int ss = s - 3 + tap; if (ss < 0) continue;
            const v4u x = *(const v4u*)(PROJ + (size_t)(m - 3 + tap) * ODD_INP + O_Q + ch0); const float* wv = cw + tap * 1536 + ch0;
            acc[0] += wv[0] * bflo(x.x); acc[1] += wv[1] * bfhi(x.x); acc[2] += wv[2] * bflo(x.y); acc[3] += wv[3] * bfhi(x.y); acc[4] += wv[4] * bflo(x.z); acc[5] += wv[5] * bfhi(x.z); acc[6] += wv[6] * bflo(x.w); acc[7] += wv[7] * bfhi(x.w); }
        float ss2 = 0.f;
#pragma unroll
        for (int i = 0; i < 8; ++i) { acc[i] = acc[i] * sigm(acc[i]); ss2 += acc[i] * acc[i]; }
        float sc = 1.0f;
        if (w < 2) { ss2 += __shfl_xor(ss2, 1); ss2 += __shfl_xor(ss2, 2); ss2 += __shfl_xor(ss2, 4); ss2 += __shfl_xor(ss2, 8); sc = 1.0f / sqrtf(ss2 + RMS_EPS); if (w == 0) sc *= 0.08838834764831845f; }
        float* dst = (w == 0 ? QG : (w == 1 ? KG : VG)) + (size_t)m * 512 + lane * 8;
        *(f32x4*)dst = (f32x4){acc[0] * sc, acc[1] * sc, acc[2] * sc, acc[3] * sc}; *(f32x4*)(dst + 4) = (f32x4){acc[4] * sc, acc[5] * sc, acc[6] * sc, acc[7] * sc};
    }
    if (lane < 4) { const float gin = bf2f(PROJ[(size_t)m * ODD_INP + O_GIN + lane]), bin = bf2f(PROJ[(size_t)m * ODD_INP + O_BETA + lane]);
        GB[(size_t)m * 4 + lane] = -expf(kin(I_GDN_ALOG)[j * 4 + lane]) * softplusf_(gin + kin(I_GDN_DTB)[j * 4 + lane]); BETA[(size_t)m * 4 + lane] = sigm(bin); }
}
__device__ __forceinline__ void phase_odd_a(Frame& F, int j) {
    if (F.wave == 0 && F.bid < 64) { s5_scan_wave(F, j, F.bid >> 5, F.bid & 31); return; }
    const int nbusy = (F.G < 64 ? F.G : 64);
    const int widx = (F.bid < 64) ? F.bid * 7 + (F.wave - 1) : nbusy * 7 + (F.bid - 64) * 8 + F.wave;
    const int nw = nbusy * 7 + (F.G > 64 ? (F.G - 64) * 8 : 0);
    for (int m = widx; m < NTOK; m += nw) gdn_prep_token(F, j, m);
}
__device__ __forceinline__ void phase_gdn_naive(Frame& F) {
    const float* QG = (const float*)(F.ws + WS_QG); const float* KG = (const float*)(F.ws + WS_KG); const float* VG = (const float*)(F.ws + WS_VG);
    const float* GB = (const float*)(F.ws + WS_GB); const float* BETA = (const float*)(F.ws + WS_BETA); float* OG = (float*)(F.ws + WS_OG);
    const int lane = F.lane; const int NGW = F.G * NWAVES;
    for (int u = F.wave * F.G + F.bid; u < 1024; u += NGW) {
        const int b = u >> 9, h = (u >> 7) & 3, c = u & 127; const size_t rb = (size_t)b * SEQ;
        const float* kq = KG + rb * 512 + h * 128 + lane; const float* qq = QG + rb * 512 + h * 128 + lane; const float* vq = VG + rb * 512 + h * 128 + c;
        const float* gq = GB + rb * 4 + h; const float* bq = BETA + rb * 4 + h; float* oq = OG + rb * 512 + h * 128 + c;
        float s0 = 0.f, s1 = 0.f;
        float k0[8], k1[8], q0[8], q1[8], vv[8], gg[8], bb[8], nk0[8], nk1[8], nq0[8], nq1[8], nv[8], ng[8], nb[8];
#pragma unroll
        for (int i = 0; i < 8; ++i) { k0[i] = kq[(size_t)i * 512]; k1[i] = kq[(size_t)i * 512 + 64]; q0[i] = qq[(size_t)i * 512]; q1[i] = qq[(size_t)i * 512 + 64]; vv[i] = vq[(size_t)i * 512]; gg[i] = gq[i * 4]; bb[i] = bq[i * 4]; }
        for (int t0 = 0; t0 < SEQ; t0 += 8) {
            const int tn = (t0 + 8 < SEQ) ? t0 + 8 : t0;
#pragma unroll
            for (int i = 0; i < 8; ++i) { const size_t o = (size_t)(tn + i) * 512; nk0[i] = kq[o]; nk1[i] = kq[o + 64]; nq0[i] = qq[o]; nq1[i] = qq[o + 64]; nv[i] = vq[o]; ng[i] = gq[(tn + i) * 4]; nb[i] = bq[(tn + i) * 4]; }
#pragma unroll
            for (int i = 0; i < 8; ++i) {
                const float ks = wave_sum(k0[i] * s0 + k1[i] * s1); const float eg = expf(gg[i]); const float be = bb[i];
                s0 = eg * (s0 - be * k0[i] * ks) + be * k0[i] * vv[i]; s1 = eg * (s1 - be * k1[i] * ks) + be * k1[i] * vv[i];
                const float o = wave_sum(q0[i] * s0 + q1[i] * s1);
                if (lane == 0) oq[(size_t)(t0 + i) * 512] = o;
            }
#pragma unroll
            for (int i = 0; i < 8; ++i) { k0[i] = nk0[i]; k1[i] = nk1[i]; q0[i] = nq0[i]; q1[i] = nq1[i]; vv[i] = nv[i]; gg[i] = ng[i]; bb[i] = nb[i]; }
        }
    }
}
__device__ __forceinline__ void phase_gdn_out(Frame& F, int j) {
 const float* OG = (const float*)(F.ws + WS_OG); const bf16* PROJ = (const bf16*)(F.ws + WS_PROJ); bf16* MIX = (bf16*)(F.ws + WS_MIX);
    const float* on = kin(I_GDN_ONORM) + j * 128; const int lane = F.lane;
    const int gw = F.bid * NWAVES + F.wave, NGW = F.G * NWAVES;
    for (int m = gw; m < NTOK; m += NGW) {
        const f32x4 a = *(const f32x4*)(OG + (size_t)m * 512 + lane * 8), b = *(const f32x4*)(OG + (size_t)m * 512 + lane * 8 + 4);
        float f[8] = {a.x, a.y, a.z, a.w, b.x, b.y, b.z, b.w}; float s = 0.f;
#pragma unroll
        for (int i = 0; i < 8; ++i) s += f[i] * f[i];
        s += __shfl_xor(s, 1); s += __shfl_xor(s, 2); s += __shfl_xor(s, 4); s += __shfl_xor(s, 8);
        const float r = 1.0f / sqrtf(s * (1.f / 128.f) + RMS_EPS);
        const bf16* z = PROJ + (size_t)m * ODD_INP + O_Z + lane * 8; const float* g = on + (lane & 15) * 8; float o[8];
#pragma unroll
        for (int i = 0; i < 8; ++i) { const float zz = bf2f(z[i]); o[i] = f[i] * r * g[i] * (zz * sigm(zz)); }
        v4u w; w.x = pk2(o[0], o[1]); w.y = pk2(o[2], o[3]); w.z = pk2(o[4], o[5]); w.w = pk2(o[6], o[7]);
        *(v4u*)(MIX + (size_t)m * DM + 512 + lane * 8) = w;
    }
}

__device__ __forceinline__ void phase_router(Frame& F, int layer) {
 const float* H = kout(); bf16* ABF = (bf16*)(F.ws + WS_ABF);
    const float* gain = kin(I_NORM_FFN) + layer * DM; const float* wgr = kin(I_MOE_WGRP) + (size_t)layer * DM * 4; const float* bgr = kin(I_MOE_BGRP) + layer * 4;
    const float* wex = kin(I_MOE_WEXP) + (size_t)layer * DM * 32; const float* bex = kin(I_MOE_BEXP) + layer * 32;
    int* TOKE = (int*)(F.ws + WS_TOKE); float* TOKW = (float*)(F.ws + WS_TOKW);
    LAS int* lcnt = (LAS int*)(F.lds + LDSCTL_OFF + LC_MOE + 512); LAS int* gbase = (LAS int*)(F.lds + LDSCTL_OFF + LC_MOE + 640);
    const int lane = F.lane; const int per = NTOK / F.G;
    LAS int* lasg = (LAS int*)(F.lds + RING_OFF);
    if (F.tid < 32) lcnt[F.tid] = 0;
    __syncthreads();
    for (int tl = F.wave; tl < per; tl += NWAVES) {
        const int m = F.bid * per + tl;
        const f32x4* xr = (const f32x4*)(H + (size_t)m * DM) + lane; f32x4 v[4]; float s = 0.f;
#pragma unroll
        for (int q = 0; q < 4; ++q) { v[q] = xr[64 * q]; s += (v[q].x * v[q].x + v[q].y * v[q].y) + (v[q].z * v[q].z + v[q].w * v[q].w); }
        const float r = 1.0f / sqrtf(wave_sum(s) * (1.f / 1024.f) + RMS_EPS);
        unsigned long long* o8 = (unsigned long long*)(ABF + (size_t)m * DM) + lane;
#pragma unroll
        for (int q = 0; q < 4; ++q) { const f32x4 g = ((const f32x4*)gain + lane)[64 * q]; v[q].x *= r * g.x; v[q].y *= r * g.y; v[q].z *= r * g.z; v[q].w *= r * g.w;
            o8[64 * q] = (unsigned long long)pk2(v[q].x, v[q].y) | ((unsigned long long)pk2(v[q].z, v[q].w) << 32); }
        float lg[4] = {0.f, 0.f, 0.f, 0.f};
#pragma unroll
        for (int q = 0; q < 4; ++q) { const int k0 = 4 * lane + 256 * q;
#pragma unroll
            for (int e = 0; e < 4; ++e) { const f32x4 w = *(const f32x4*)(wgr + (size_t)(k0 + e) * 4); const float x = v[q][e]; lg[0] += x * w.x; lg[1] += x * w.y; lg[2] += x * w.z; lg[3] += x * w.w; } }
#pragma unroll
        for (int g = 0; g < 4; ++g) lg[g] = wave_sum(lg[g]) + bgr[g];
        int gi = 0; float gm = lg[0];
#pragma unroll
        for (int g = 1; g < 4; ++g) if (lg[g] > gm) { gm = lg[g]; gi = g; }
        float gden = 0.f;
#pragma unroll
        for (int g = 0; g < 4; ++g) gden += expf(lg[g] - gm);
        const float gw_ = 1.0f / gden;
        float le[8] = {0.f, 0.f, 0.f, 0.f, 0.f, 0.f, 0.f, 0.f};
#pragma unroll
        for (int q = 0; q < 4; ++q) { const int k0 = 4 * lane + 256 * q;
#pragma unroll
            for (int e = 0; e < 4; ++e) { const float* wp = wex + (size_t)(k0 + e) * 32 + gi * 8; const f32x4 w0 = *(const f32x4*)wp, w1 = *(const f32x4*)(wp + 4); const float x = v[q][e];
                le[0] += x * w0.x; le[1] += x * w0.y; le[2] += x * w0.z; le[3] += x * w0.w; le[4] += x * w1.x; le[5] += x * w1.y; le[6] += x * w1.z; le[7] += x * w1.w; } }
#pragma unroll
        for (int e = 0; e < 8; ++e) le[e] = wave_sum(le[e]) + bex[gi * 8 + e];
        int i0 = 0; float m0 = le[0];
#pragma unroll
        for (int e = 1; e < 8; ++e) if (le[e] > m0) { m0 = le[e]; i0 = e; }
        int i1 = -1; float m1 = -3.0e38f;
#pragma unroll
        for (int e = 0; e < 8; ++e) if (e != i0 && le[e] > m1) { m1 = le[e]; i1 = e; }
        const float e1 = expf(m1 - m0); const float w0 = gw_ / (1.0f + e1), w1 = gw_ * e1 / (1.0f + e1);
        if (lane == 0) { const int ea = gi * 8 + i0, eb = gi * 8 + i1;
            const int pa = __hip_atomic_fetch_add(lcnt + ea, 1, __ATOMIC_RELAXED, __HIP_MEMORY_SCOPE_WORKGROUP), pb = __hip_atomic_fetch_add(lcnt + eb, 1, __ATOMIC_RELAXED, __HIP_MEMORY_SCOPE_WORKGROUP);
            lasg[tl * 2] = ea | (pa << 8); lasg[tl * 2 + 1] = eb | (pb << 8);
            TOKW[(size_t)m * 2] = w0; TOKW[(size_t)m * 2 + 1] = w1; }
    }
    __syncthreads();
    if (F.tid < 32) gbase[F.tid] = (int)__hip_atomic_fetch_add(F.ctl + CW_CNT + 64 * layer + F.tid, (unsigned)lcnt[F.tid], __ATOMIC_RELAXED, __HIP_MEMORY_SCOPE_AGENT);
    __syncthreads();
    for (int i = F.tid; i < per * 2; i += 512) { const int a = lasg[i], e = a & 255, lp = a >> 8; TOKE[(size_t)F.bid * per * 2 + i] = e | ((gbase[e] + lp) << 8); }
    __syncthreads();
}
__device__ __forceinline__ void moe_tables(Frame& F, int layer) {
    LAS int* rowbase = (LAS int*)(F.lds + LDSCTL_OFF + LC_MOE); LAS unsigned char* tile_e = (LAS unsigned char*)(F.lds + LDSCTL_OFF + LC_MOE + 192);
    if (F.tid == 0) { int rb = 0;
#pragma unroll 1
        for (int e = 0; e < 32; ++e) { const int c = (int)__hip_atomic_load(F.ctl + CW_CNT + 64 * layer + e, __ATOMIC_RELAXED, __HIP_MEMORY_SCOPE_AGENT); rowbase[e] = rb; const int nt = (c + 255) >> 8;
            for (int i = 0; i < nt; ++i) tile_e[(rb >> 8) + i] = (unsigned char)e; rb += nt << 8; }
        rowbase[32] = rb; rowbase[34] = rb >> 8; }
    __syncthreads();
}
__device__ __forceinline__ void phase_moe_scatter(Frame& F, int layer) {
    moe_tables(F, layer);
    const LAS int* rowbase = (const LAS int*)(F.lds + LDSCTL_OFF + LC_MOE);
    const bf16* ABF = (const bf16*)(F.ws + WS_ABF); bf16* XG = (bf16*)(F.ws + WS_XG); const int* TOKE = (const int*)(F.ws + WS_TOKE); int* ROWS = (int*)(F.ws + WS_ROWS);
    const int gw = F.bid * NWAVES + F.wave, NGW = F.G * NWAVES, lane = F.lane;
    for (int m = gw; m < NTOK; m += NGW) {
        const v4u a = *((const v4u*)(ABF + (size_t)m * DM) + lane), b = *((const v4u*)(ABF + (size_t)m * DM) + 64 + lane);
#pragma unroll
        for (int k = 0; k < 2; ++k) { const int te = TOKE[(size_t)m * 2 + k]; const int row = rowbase[te & 255] + (te >> 8);
            *((v4u*)(XG + (size_t)row * DM) + lane) = a; *((v4u*)(XG + (size_t)row * DM) + 64 + lane) = b;
            if (lane == 0) ROWS[(size_t)m * 2 + k] = row; }
    }
}
struct MoeOrder {
    int ntiles, nN, G, c; const LAS unsigned char* tile_e; size_t bstride;
    __device__ bool next(int i, pg8::Unit& u) const { const long L = (long)i * G + c; if (L >= (long)ntiles * nN) return false; u.pm = (int)(L / nN); u.pn = (int)(L % nN); u.aux = __builtin_amdgcn_readfirstlane((int)tile_e[u.pm]); return true; }
    __device__ __forceinline__ const char* a_base(const pg8::Gemm& g, const pg8::Unit& u) const { return (const char*)g.A + (size_t)u.pm * 256 * g.lda * 2; }
    __device__ __forceinline__ const char* b_base(const pg8::Gemm& g, const pg8::Unit& u) const { return (const char*)g.Bt + (size_t)u.aux * bstride + (size_t)u.pn * 256 * g.ldb * 2; }
};
__device__ __forceinline__ void phase_moe_combine(Frame& F, int layer) {
 float* H = kout(); bf16* ABF = (bf16*)(F.ws + WS_ABF); const bf16* Y2 = (const bf16*)(F.ws + WS_Y2);
    const int* ROWS = (const int*)(F.ws + WS_ROWS); const float* TOKW = (const float*)(F.ws + WS_TOKW); const float* gain = kin(I_PLE_NORM) + layer * DM;
    const int gw = F.bid * NWAVES + F.wave, NGW = F.G * NWAVES, lane = F.lane;
    for (int m = gw; m < NTOK; m += NGW) {
        const int r0 = ROWS[(size_t)m * 2], r1 = ROWS[(size_t)m * 2 + 1]; const float w0 = TOKW[(size_t)m * 2], w1 = TOKW[(size_t)m * 2 + 1];
        f32x4* hr = (f32x4*)(H + (size_t)m * DM) + lane; f32x4 v[4]; float s = 0.f;
#pragma unroll
        for (int q = 0; q < 4; ++q) { v[q] = hr[64 * q]; const v2u ya = *((const v2u*)(Y2 + (size_t)r0 * DM) + lane + 64 * q), yb = *((const v2u*)(Y2 + (size_t)r1 * DM) + lane + 64 * q);
            v[q].x += w0 * bflo(ya.x) + w1 * bflo(yb.x); v[q].y += w0 * bfhi(ya.x) + w1 * bfhi(yb.x); v[q].z += w0 * bflo(ya.y) + w1 * bflo(yb.y); v[q].w += w0 * bfhi(ya.y) + w1 * bfhi(yb.y);
            hr[64 * q] = v[q]; s += (v[q].x * v[q].x + v[q].y * v[q].y) + (v[q].z * v[q].z + v[q].w * v[q].w); }
        const float r = 1.0f / sqrtf(wave_sum(s) * (1.f / 1024.f) + RMS_EPS);
        unsigned long long* o8 = (unsigned long long*)(ABF + (size_t)m * DM) + lane;
#pragma unroll
        for (int q = 0; q < 4; ++q) { const f32x4 g = ((const f32x4*)gain + lane)[64 * q];
            o8[64 * q] = (unsigned long long)pk2(v[q].x * r * g.x, v[q].y * r * g.y) | ((unsigned long long)pk2(v[q].z * r * g.z, v[q].w * r * g.w) << 32); }
    }
}
constexpr int LSTEPS = 16;
constexpr int STEP_END = 1 + DEPTH * LSTEPS;
struct KArgs { Args a; int li, pad; };

#define FRAME Frame F; { int wv_ = wave0; asm volatile("" : "+s"(wv_)); int t_ = wv_ * 64 + (int)__builtin_amdgcn_mbcnt_hi(~0u, __builtin_amdgcn_mbcnt_lo(~0u, 0u)); asm volatile("" : "+v"(t_)); unsigned char* w_ = kws(); F.lds = lds0; F.ws = w_; F.ctl = (unsigned*)(w_ + WS_CTL); \
        F.tid = t_; F.lane = t_ & 63; F.wave = __builtin_amdgcn_readfirstlane(t_ >> 6); { int g_ = gridDim.x, b_ = blockIdx.x; asm volatile("" : "+s"(g_), "+s"(b_)); F.G = g_; F.bid = b_; } } unsigned char* const ws = F.ws; (void)ws
#ifndef PH_MASK
#define PH_MASK 0xffffffffu
#endif
#define EN(k) (((PH_MASK) >> (k)) & 1u)
#define STEP(s) if (lo <= (s) && (s) < hi)
#define ENDSTEP(s) do { if ((s) + 1 < hi) xcd_barrier(bar); } while (0)
#define LAUNDER_WS do {} while (0)


template <int layer> __device__ __forceinline__ void layer_body(const XcdBarrier& bar, const int lo, const int hi, LAS unsigned char* const lds0, const int wave0) {
        constexpr int sb = 1 + layer * LSTEPS, j = layer >> 1; constexpr bool even = (layer & 1) == 0;
        STEP(sb + 0) if constexpr (EN(0)) { FRAME;
            phase_norm(F, layer == 0 ? kin(I_X) : kout(), kin(I_NORM_MIX) + layer * DM, layer == 0 ? kout() : nullptr);
            moe_weights(F, layer); phase_pconv(F, layer);
            ENDSTEP(sb + 0);
        }
        STEP(sb + 1) if constexpr (EN(1)) { FRAME;
            { LAUNDER_WS; const int NP = even ? EVEN_INP : ODD_INP; const bf16* W = even ? (const bf16*)(ws + WS_W_EVIN) + (size_t)j * EVEN_INP * 1024 : (const bf16*)(ws + WS_W_ODIN) + (size_t)j * ODD_INP * 1024;
              pg8::Gemm g{(const bf16*)(ws + WS_ABF), W, 1024, 1024, 1024}; pg8::StaticOrder S; S.init(NTOK, NP, F.G, F.bid); pg8::EpiBf16 E{(bf16*)(ws + WS_PROJ), NP};
              pg8::gemm_phase<pg8::EpiBf16, pg8::StaticOrder>(F.lds + RING_OFF, g, S, E, F.tid); }
            { LAUNDER_WS; pg8::Gemm g{(const bf16*)(ws + WS_PBF), (const bf16*)(ws + WS_W_PLEP) + (size_t)layer * 1024 * 256, 256, 256, 256}; pg8::StaticOrder S; S.init(NTOK, 1024, F.G, F.bid); pg8::EpiBf16 E{(bf16*)(ws + WS_PP), 1024};
              pg8::gemm_phase<pg8::EpiBf16, pg8::StaticOrder>(F.lds + RING_OFF, g, S, E, F.tid); }
            ENDSTEP(sb + 1);
        }
        if constexpr (even) {
            STEP(sb + 2) if constexpr (EN(2)) { FRAME; phase_even_post(F, j); ENDSTEP(sb + 2); }
            STEP(sb + 3) if constexpr (EN(3)) { FRAME;
#ifndef NO_QUP
                { LAUNDER_WS; pg8::Gemm g{(const bf16*)(ws + WS_CQN), (const bf16*)(ws + WS_W_QUP) + (size_t)j * 768 * 384, 384, 384, 384}; pg8::StaticOrder S; S.init(NTOK, 768, F.G, F.bid); pg8::EpiBf16 E{(bf16*)(ws + WS_QM), 768};
                  pg8::gemm_phase<pg8::EpiBf16, pg8::StaticOrder>(F.lds + RING_OFF, g, S, E, F.tid); }
#endif
#ifndef NO_KVUP
                { LAUNDER_WS; pg8::Gemm g{(const bf16*)(ws + WS_CKVN), (const bf16*)(ws + WS_W_KVUP) + (size_t)j * 1024 * 256, 256, 256, 256}; pg8::StaticOrder S; S.init(NTOK, 1024, F.G, F.bid); pg8::EpiBf16 E{(bf16*)(ws + WS_KVB), 1024};
                  pg8::gemm_phase<pg8::EpiBf16, pg8::StaticOrder>(F.lds + RING_OFF, g, S, E, F.tid); }
#endif
#ifndef NO_CUMSUM
                phase_cumsum(F);
#endif
                ENDSTEP(sb + 3);
            }
            STEP(sb + 4) if constexpr (EN(4)) { FRAME; phase_mla_post(F, j); ENDSTEP(sb + 4); }
            STEP(sb + 5) if constexpr (EN(5)) { FRAME; phase_attn_naive(F); ENDSTEP(sb + 5); }
        } else {
            STEP(sb + 2) if constexpr (EN(2)) { FRAME; phase_odd_a(F, j); ENDSTEP(sb + 2); }
            STEP(sb + 3) if constexpr (EN(3)) { FRAME;
#ifndef NO_GLU
                { LAUNDER_WS; pg8::Gemm g{(const bf16*)(ws + WS_HG), (const bf16*)(ws + WS_W_GLU) + (size_t)j * 512 * 512, 512, 512, 512}; pg8::StaticOrder S; S.init(NTOK, 512, F.G, F.bid);
                  pg8::EpiGlu E{(bf16*)(ws + WS_MIX), 1024, (const bf16*)(ws + WS_HG), 512, kin(I_S5_BGLU) + j * 512};
                  pg8::gemm_phase<pg8::EpiGlu, pg8::StaticOrder>(F.lds + RING_OFF, g, S, E, F.tid); }
#endif
#ifndef NO_GDN
                phase_gdn_naive(F);
#endif
                ENDSTEP(sb + 3);
            }
            STEP(sb + 4) if constexpr (EN(4)) { FRAME; phase_gdn_out(F, j); ENDSTEP(sb + 4); }
        }
        STEP(sb + 6) if constexpr (EN(6)) { FRAME;
            LAUNDER_WS; const bf16* W = even ? (const bf16*)(ws + WS_W_EVOUT) + (size_t)j * 1024 * 1024 : (const bf16*)(ws + WS_W_ODOUT) + (size_t)j * 1024 * 1024;
            pg8::Gemm g{(const bf16*)(ws + WS_MIX), W, 1024, 1024, 1024}; pg8::StaticOrder S; S.init(NTOK, 1024, F.G, F.bid); pg8::EpiResAdd E{kout(), 1024};
            pg8::gemm_phase<pg8::EpiResAdd, pg8::StaticOrder>(F.lds + RING_OFF, g, S, E, F.tid);
            ENDSTEP(sb + 6);
        }
        STEP(sb + 7) if constexpr (EN(7)) { FRAME; phase_router(F, layer); ENDSTEP(sb + 7); }
        STEP(sb + 8) if constexpr (EN(8)) { FRAME; phase_moe_scatter(F, layer); ENDSTEP(sb + 8); }
        STEP(sb + 9) if constexpr (EN(9)) { FRAME;
            LAUNDER_WS; moe_tables(F, layer);
            const LAS int* rowbase = (const LAS int*)(F.lds + LDSCTL_OFF + LC_MOE);
            MoeOrder S{__builtin_amdgcn_readfirstlane(rowbase[34]), 4, F.G, F.bid, (const LAS unsigned char*)(F.lds + LDSCTL_OFF + LC_MOE + 192), (size_t)1024 * 1024 * 2};
            pg8::Gemm g{(const bf16*)(ws + WS_XG), (const bf16*)(ws + WS_W_MOEGU), 1024, 1024, 1024}; pg8::EpiSwiglu E{(bf16*)(ws + WS_HB), 512};
            pg8::gemm_phase<pg8::EpiSwiglu, MoeOrder>(F.lds + RING_OFF, g, S, E, F.tid);
            ENDSTEP(sb + 9);
        }
        STEP(sb + 10) if constexpr (EN(10)) { FRAME;
            LAUNDER_WS; moe_tables(F, layer);
            const LAS int* rowbase = (const LAS int*)(F.lds + LDSCTL_OFF + LC_MOE);
            MoeOrder S{__builtin_amdgcn_readfirstlane(rowbase[34]), 4, F.G, F.bid, (const LAS unsigned char*)(F.lds + LDSCTL_OFF + LC_MOE + 192), (size_t)1024 * 512 * 2};
            pg8::Gemm g{(const bf16*)(ws + WS_HB), (const bf16*)(ws + WS_W_MOED), 512, 512, 512}; pg8::EpiBf16 E{(bf16*)(ws + WS_Y2), 1024};
            pg8::gemm_phase<pg8::EpiBf16, MoeOrder>(F.lds + RING_OFF, g, S, E, F.tid);
            ENDSTEP(sb + 10);
        }
        STEP(sb + 11) if constexpr (EN(11)) { FRAME; phase_moe_combine(F, layer); ENDSTEP(sb + 11); }
        STEP(sb + 12) if constexpr (EN(12)) { FRAME;
            LAUNDER_WS; pg8::Gemm g{(const bf16*)(ws + WS_ABF), (const bf16*)(ws + WS_W_PLEG) + (size_t)layer * 1024 * 1024, 1024, 1024, 1024}; pg8::StaticOrder S; S.init(NTOK, 1024, F.G, F.bid);
            pg8::EpiPle E{kout(), (const bf16*)(ws + WS_PP), kin(I_PLE_BG) + layer * DM, 1024};
            pg8::gemm_phase<pg8::EpiPle, pg8::StaticOrder>(F.lds + RING_OFF, g, S, E, F.tid);
            ENDSTEP(sb + 12);
        }
    }
__global__ void __launch_bounds__(NWAVES * 64, 2) mega_fwd(KArgs ka) {
    extern __shared__ __attribute__((aligned(16))) unsigned char lds_raw[];
    const Args& args = ka.a;
    LAS unsigned char* const lds0 = (LAS unsigned char*)lds_raw;
    const int wave0 = __builtin_amdgcn_readfirstlane((int)threadIdx.x >> 6);
    for (int u = threadIdx.x; u < (LDS_BYTES - LDSCTL_OFF) / 4; u += NWAVES * 64) ((LAS unsigned*)(lds0 + LDSCTL_OFF))[u] = 0u;
    __syncthreads();
    XcdBarrier bar = xcd_barrier_post((unsigned*)(kws() + WS_CTL) + CW_BAR + ka.li * XCD_BAR_WORDS, (volatile LAS unsigned*)(lds0 + LDSCTL_OFF + LC_BARST));
    const int lo = args.ph_lo, hi = args.ph_hi;
    STEP(0) if constexpr (EN(13)) { FRAME; prologue_weights(F); ENDSTEP(0); }
    layer_body<0>(bar, lo, hi, lds0, wave0); layer_body<1>(bar, lo, hi, lds0, wave0); layer_body<2>(bar, lo, hi, lds0, wave0); layer_body<3>(bar, lo, hi, lds0, wave0);
#undef STEP
#undef ENDSTEP
}

#ifndef MK_MODE
#define MK_MODE 0
#endif
extern "C" void kernel_launch(void* const* d_in, const int* in_sizes, int n_in, void* d_out, int out_size, void* d_ws, size_t ws_size, hipStream_t stream) {
    static int ready = 0;
    if (ready == 0) {
        if (n_in != N_IN || out_size != NTOK * DM || ws_size < WS_END) { fprintf(stderr, "kernel_launch: unexpected shapes n_in %d out %d ws %zu (need %zu)\n", n_in, out_size, ws_size, (size_t)WS_END); ready = -1; return; }
        if (hipFuncSetAttribute((const void*)mega_fwd, hipFuncAttributeMaxDynamicSharedMemorySize, LDS_BYTES) != hipSuccess) { fprintf(stderr, "kernel_launch: hipFuncSetAttribute failed\n"); ready = -1; return; }
        int per_cu = 0; (void)hipOccupancyMaxActiveBlocksPerMultiprocessor(&per_cu, (const void*)mega_fwd, NWAVES * 64, LDS_BYTES); (void)hipGetLastError();
        ready = 1;
    }
    if (ready < 0) return;
    (void)hipMemsetAsync((char*)d_ws + WS_CTL, 0, CTL_ZERO_BYTES, stream);
    KArgs ka{};
    for (int i = 0; i < N_IN; ++i) ka.a.in[i] = (const float*)d_in[i];
    ka.a.out = (float*)d_out; ka.a.ws = (unsigned char*)d_ws; ka.li = 0; ka.pad = 0;
    const int grid = 256;
#if MK_MODE == 1
    ka.a.ph_lo = 0; ka.a.ph_hi = STEP_END;
    hipLaunchKernelGGL(mega_fwd, dim3(grid), dim3(NWAVES * 64), LDS_BYTES, stream, ka);
#else
    for (int s = 0; s < STEP_END; ++s) {
        if (s > 0) { const int k = (s - 1) % LSTEPS, layer = (s - 1) / LSTEPS; const bool even = (layer & 1) == 0;
            if (k > 12) continue; if (k == 5 && !even) continue; }
        ka.a.ph_lo = s; ka.a.ph_hi = s + 1;
        hipLaunchKernelGGL(mega_fwd, dim3(grid), dim3(NWAVES * 64), LDS_BYTES, stream, ka);
    }
#endif
}
```

```cpp
#include <hip/hip_runtime.h>
#include <cstdio>
#include <cstdint>
#define MK_MODE 1
namespace pg8 {
#define PG8_LAS __attribute__((address_space(3)))
typedef unsigned short bf16_t;
typedef short bf16x8 __attribute__((ext_vector_type(8)));
typedef float f32x4 __attribute__((ext_vector_type(4)));
typedef float f32x2 __attribute__((ext_vector_type(2)));
typedef unsigned u32x4 __attribute__((ext_vector_type(4)));
typedef unsigned u32x2 __attribute__((ext_vector_type(2)));
constexpr int BM = 256, BK = 64, HALF = 128, HTB = HALF * BK * 2  , STAGE_BYTES = 8 * HTB, NXCD = 8, WGM = 8;

__host__ __device__ __forceinline__ int lds_byte(int r, int c) { const int st = (r >> 4) * 2 + (c >> 5), rr = r & 15, cc = c & 31, ob = rr * 64 + cc * 2; return st * 1024 + (ob ^ (((ob >> 9) & 1) << 5)); }
__host__ __device__ __forceinline__ void stage_rc(int b, int& R, int& C) { const int st = b / 1024, sb = b % 1024, swz = sb ^ (((sb >> 9) & 1) << 5); R = (st >> 1) * 16 + swz / 64; C = (st & 1) * 32 + (swz % 64) / 2; }
__host__ __device__ __forceinline__ int perm32(int rho) { const int n = rho >> 4, i = rho & 15; return 8 * (i >> 2) + 4 * n + (i & 3); }

struct Unit { int pm, pn, aux; };
struct Gemm { const bf16_t* A; const bf16_t* Bt; int K, lda, ldb; };

struct StaticOrder {
    int nM, nN, nwg, G, c;
    __device__ void init(int M, int N, int G_, int c_) { nM = M / BM; nN = N / BM; nwg = nM * nN; G = G_; c = c_; }
    __device__ bool next(int i, Unit& u) const {
        const long L = (long)i * G + c; if (L >= nwg) return false;
        int wgid = (int)L; { const int q = nwg / NXCD, r = nwg % NXCD, xcd = wgid % NXCD, off = wgid / NXCD; wgid = (xcd < r ? xcd * (q + 1) : r * (q + 1) + (xcd - r) * q) + off; }
        const int nig = WGM * nN, gid = wgid / nig, fm = gid * WGM, gsz = (nM - fm) < WGM ? (nM - fm) : WGM;
        u.pm = fm + ((wgid % nig) % gsz); u.pn = (wgid % nig) / gsz; u.aux = 0; return true;
    }
    __device__ __forceinline__ const char* a_base(const Gemm& g, const Unit& u) const { return (const char*)g.A + (size_t)u.pm * BM * g.lda * 2; }
    __device__ __forceinline__ const char* b_base(const Gemm& g, const Unit& u) const { return (const char*)g.Bt + (size_t)u.pn * BM * g.ldb * 2; }
};

__device__ __forceinline__ unsigned cvt_pk_bf16(float lo, float hi) { unsigned r; asm volatile("v_cvt_pk_bf16_f32 %0, %1, %2" : "=v"(r) : "v"(lo), "v"(hi)); return r; }
__device__ __forceinline__ float bf_lo(unsigned w) { return __uint_as_float(w << 16); }
__device__ __forceinline__ float bf_hi(unsigned w) { return __uint_as_float(w & 0xffff0000u); }

struct EpiBf16 {
    static constexpr bool PERM = true;
    bf16_t* O; int ldc;
    __device__ __forceinline__ void operator()(const f32x4 (&acc)[2][2][4][2], const Unit& u, int wr, int wc, int fr, int fq) const {
        const int row0 = u.pm * BM + wr * 64 + fr; const int col0 = u.pn * BM + wc * 32 + 8 * fq;
#pragma unroll
        for (int ai = 0; ai < 2; ++ai)
#pragma unroll
            for (int m = 0; m < 4; ++m) { bf16_t* rowp = O + (size_t)(row0 + ai * HALF + m * 16) * ldc + col0;
#pragma unroll
                for (int bj = 0; bj < 2; ++bj) { const f32x4 v0 = acc[ai][bj][m][0], v1 = acc[ai][bj][m][1];
                    u32x4 w; w.x = cvt_pk_bf16(v0[0], v0[1]); w.y = cvt_pk_bf16(v0[2], v0[3]); w.z = cvt_pk_bf16(v1[0], v1[1]); w.w = cvt_pk_bf16(v1[2], v1[3]);
                    *(u32x4*)(rowp + bj * HALF) = w; } }
    }
};
struct EpiResAdd {
    static constexpr bool PERM = false;
    float* H; int ldc;
    __device__ __forceinline__ void operator()(const f32x4 (&acc)[2][2][4][2], const Unit& u, int wr, int wc, int fr, int fq) const {
        const int row0 = u.pm * BM + wr * 64 + fr; const int col0 = u.pn * BM + wc * 32 + 4 * fq;
#pragma unroll
        for (int ai = 0; ai < 2; ++ai)
#pragma unroll
            for (int m = 0; m < 4; ++m) { float* rowp = H + (size_t)(row0 + ai * HALF + m * 16) * ldc + col0;
#pragma unroll
                for (int bj = 0; bj < 2; ++bj)
#pragma unroll
                    for (int n = 0; n < 2; ++n) { f32x4* p = (f32x4*)(rowp + bj * HALF + n * 16); *p = *p + acc[ai][bj][m][n]; } }
    }
};
__device__ __forceinline__ float sigmoidf_(float x) { return 1.0f / (1.0f + __expf(-x)); }
struct EpiPle {
    static constexpr bool PERM = false;
    float* H; const bf16_t* PP; const float* bias; int ldc;
    __device__ __forceinline__ void operator()(const f32x4 (&acc)[2][2][4][2], const Unit& u, int wr, int wc, int fr, int fq) const {
        const int row0 = u.pm * BM + wr * 64 + fr; const int col0 = u.pn * BM + wc * 32 + 4 * fq;
#pragma unroll
        for (int ai = 0; ai < 2; ++ai)
#pragma unroll
            for (int m = 0; m < 4; ++m) { const size_t ro = (size_t)(row0 + ai * HALF + m * 16) * ldc + col0;
#pragma unroll
                for (int bj = 0; bj < 2; ++bj)
#pragma unroll
                    for (int n = 0; n < 2; ++n) { const int co = bj * HALF + n * 16; f32x4* p = (f32x4*)(H + ro + co); const u32x2 pw = *(const u32x2*)(PP + ro + co);
                        const f32x4 bv = *(const f32x4*)(bias + col0 + co); const f32x4 a = acc[ai][bj][m][n] + bv; f32x4 h = *p;
                        h[0] += sigmoidf_(a[0]) * bf_lo(pw.x); h[1] += sigmoidf_(a[1]) * bf_hi(pw.x); h[2] += sigmoidf_(a[2]) * bf_lo(pw.y); h[3] += sigmoidf_(a[3]) * bf_hi(pw.y); *p = h; } }
    }
};
struct EpiGlu {
    static constexpr bool PERM = true;
    bf16_t* O; int ldo; const bf16_t* HG; int ldh; const float* bias;
    __device__ __forceinline__ void operator()(const f32x4 (&acc)[2][2][4][2], const Unit& u, int wr, int wc, int fr, int fq) const {
        const int row0 = u.pm * BM + wr * 64 + fr; const int col0 = u.pn * BM + wc * 32 + 8 * fq;
#pragma unroll
        for (int ai = 0; ai < 2; ++ai)
#pragma unroll
            for (int m = 0; m < 4; ++m) { const size_t r = (size_t)(row0 + ai * HALF + m * 16);
#pragma unroll
                for (int bj = 0; bj < 2; ++bj) { const int c = col0 + bj * HALF; const u32x4 hw = *(const u32x4*)(HG + r * ldh + c);
                    const f32x4 b0 = *(const f32x4*)(bias + c), b1 = *(const f32x4*)(bias + c + 4); const f32x4 v0 = acc[ai][bj][m][0] + b0, v1 = acc[ai][bj][m][1] + b1;
                    u32x4 w; w.x = cvt_pk_bf16(bf_lo(hw.x) * sigmoidf_(v0[0]), bf_hi(hw.x) * sigmoidf_(v0[1])); w.y = cvt_pk_bf16(bf_lo(hw.y) * sigmoidf_(v0[2]), bf_hi(hw.y) * sigmoidf_(v0[3]));
                    w.z = cvt_pk_bf16(bf_lo(hw.z) * sigmoidf_(v1[0]), bf_hi(hw.z) * sigmoidf_(v1[1])); w.w = cvt_pk_bf16(bf_lo(hw.w) * sigmoidf_(v1[2]), bf_hi(hw.w) * sigmoidf_(v1[3]));
                    *(u32x4*)(O + r * ldo + c) = w; } }
    }
};
struct EpiSwiglu {
    static constexpr bool PERM = true;
    bf16_t* HB; int ldc;
    __device__ __forceinline__ void operator()(const f32x4 (&acc)[2][2][4][2], const Unit& u, int wr, int wc, int fr, int fq) const {
        const int row0 = u.pm * BM + wr * 64 + fr; const int col0 = u.pn * HALF + wc * 32 + 8 * fq;
#pragma unroll
        for (int ai = 0; ai < 2; ++ai)
#pragma unroll
            for (int m = 0; m < 4; ++m) { bf16_t* rowp = HB + (size_t)(row0 + ai * HALF + m * 16) * ldc + col0;
                const f32x4 g0 = acc[ai][0][m][0], g1 = acc[ai][0][m][1], u0 = acc[ai][1][m][0], u1 = acc[ai][1][m][1];
                u32x4 w; w.x = cvt_pk_bf16(g0[0] * sigmoidf_(g0[0]) * u0[0], g0[1] * sigmoidf_(g0[1]) * u0[1]); w.y = cvt_pk_bf16(g0[2] * sigmoidf_(g0[2]) * u0[2], g0[3] * sigmoidf_(g0[3]) * u0[3]);
                w.z = cvt_pk_bf16(g1[0] * sigmoidf_(g1[0]) * u1[0], g1[1] * sigmoidf_(g1[1]) * u1[1]); w.w = cvt_pk_bf16(g1[2] * sigmoidf_(g1[2]) * u1[2], g1[3] * sigmoidf_(g1[3]) * u1[3]);
                *(u32x4*)rowp = w; }
    }
};

template <class Epi, class Sched, bool ALIGN_EPI = true, bool SP2 = true>
__device__ __forceinline__ void gemm_phase(PG8_LAS unsigned char* lds, const Gemm g, const Sched& S, const Epi& E, const int tid) {
    const int wid = __builtin_amdgcn_readfirstlane(tid >> 6), lane = tid & 63, wr = wid >> 2, wc = wid & 3, fr = lane & 15, fq = lane >> 4;
    int K = g.K; asm volatile("" : "+s"(K));
    const int nt = K / BK;
    unsigned voffA[2], voffB[2];
#pragma unroll
    for (int i = 0; i < 2; ++i) { int R, C; stage_rc(tid * 16 + i * 8192, R, C); const int Rb = Epi::PERM ? ((R & ~31) + perm32(R & 31)) : R;
        voffA[i] = (unsigned)(R * g.lda + C) * 2u; voffB[i] = (unsigned)(Rb * g.ldb + C) * 2u; }
    const size_t kstep = (size_t)(BK * 2);
    const size_t hstepA = (size_t)HALF * g.lda * 2, hstepB = (size_t)HALF * g.ldb * 2;
    const unsigned ldsw = (unsigned)wid * 1024u;
    const int aoff = lds_byte(wr * 64 + fr, fq * 8), boff = lds_byte(wc * 32 + fr, fq * 8);
#define PG8_SA(b, h) (((b) * 2 + (h)) * HTB)
#define PG8_SB(b, h) ((4 + (b) * 2 + (h)) * HTB)
#define PG8_STAGE(bufoff, gbase, voff) do { _Pragma("unroll") for (int _i = 0; _i < 2; ++_i) \
        __builtin_amdgcn_global_load_lds((const unsigned*)((const char*)(gbase) + (voff)[_i]), (PG8_LAS unsigned*)(lds + (bufoff) + ldsw + _i * 8192), 16, 0, 0); } while (0)
#define PG8_LDA(dst, b, h) do { _Pragma("unroll") for (int m = 0; m < 4; ++m) _Pragma("unroll") for (int k = 0; k < 2; ++k) dst[m][k] = *(const PG8_LAS bf16x8*)(lds + PG8_SA(b, h) + aoff + m * 2048 + k * 1024); } while (0)
#define PG8_LDB(dst, b, h) do { _Pragma("unroll") for (int n = 0; n < 2; ++n) _Pragma("unroll") for (int k = 0; k < 2; ++k) dst[n][k] = *(const PG8_LAS bf16x8*)(lds + PG8_SB(b, h) + boff + n * 2048 + k * 1024); } while (0)
#define PG8_MMA(ai, bj, At, Bt) do { __builtin_amdgcn_s_setprio(1); _Pragma("unroll") for (int m = 0; m < 4; ++m) _Pragma("unroll") for (int n = 0; n < 2; ++n) _Pragma("unroll") for (int k = 0; k < 2; ++k) \
        acc[ai][bj][m][n] = __builtin_amdgcn_mfma_f32_16x16x32_bf16(Bt[n][k], At[m][k], acc[ai][bj][m][n], 0, 0, 0); __builtin_amdgcn_s_setprio(0); } while (0)
#define PG8_WAIT_V(n) asm volatile("s_waitcnt vmcnt(" #n ")" ::: "memory")
#define PG8_WAIT_L(n) asm volatile("s_waitcnt lgkmcnt(" #n ")" ::: "memory")
#define PG8_BAR __builtin_amdgcn_s_barrier()
#define PG8_SCHED __builtin_amdgcn_sched_barrier(0)
    Unit cur, nxt; int ui = 0;
    if (!S.next(0, cur)) return;
    f32x4 acc[2][2][4][2];
#pragma unroll
    for (int a = 0; a < 2; ++a)
#pragma unroll
        for (int b = 0; b < 2; ++b)
#pragma unroll
            for (int m = 0; m < 4; ++m)
#pragma unroll
                for (int n = 0; n < 2; ++n) acc[a][b][m][n] = (f32x4){0.f, 0.f, 0.f, 0.f};
    bf16x8 At[4][2], B0[2][2], B1[2][2];
    const char* cA = S.a_base(g, cur); const char* cB = S.b_base(g, cur);
    if constexpr (SP2) {
        PG8_STAGE(PG8_SB(0, 0), cB, voffB); PG8_STAGE(PG8_SB(0, 1), cB + hstepB, voffB); PG8_STAGE(PG8_SA(0, 0), cA, voffA); PG8_STAGE(PG8_SA(0, 1), cA + hstepA, voffA);
        if (wr == 1) PG8_BAR;
        PG8_WAIT_V(2); PG8_BAR;
        PG8_STAGE(PG8_SB(1, 0), cB + kstep, voffB); PG8_STAGE(PG8_SA(1, 0), cA + kstep, voffA); PG8_STAGE(PG8_SB(1, 1), cB + hstepB + kstep, voffB);
        PG8_WAIT_V(6); PG8_BAR;
    } else {
        PG8_STAGE(PG8_SB(0, 0), cB, voffB); PG8_STAGE(PG8_SA(0, 0), cA, voffA); PG8_STAGE(PG8_SB(0, 1), cB + hstepB, voffB); PG8_STAGE(PG8_SA(0, 1), cA + hstepA, voffA);
        if (wr == 1) PG8_BAR;
        PG8_WAIT_V(4); PG8_BAR;
        PG8_STAGE(PG8_SB(1, 0), cB + kstep, voffB); PG8_STAGE(PG8_SA(1, 0), cA + kstep, voffA); PG8_STAGE(PG8_SB(1, 1), cB + hstepB + kstep, voffB);
        PG8_WAIT_V(6); PG8_BAR;
    }
    for (;;) {
        const bool has_next = S.next(ui + 1, nxt);
        const char* nA = has_next ? S.a_base(g, nxt) : cA; const char* nB = has_next ? S.b_base(g, nxt) : cB;
        for (int t = 0; t < nt; t += 2) {
            const bool last = (t == nt - 2);
            const char* a1 = cA + (size_t)(t + 1) * kstep;
            const char* a2 = last ? nA : cA + (size_t)(t + 2) * kstep; const char* b2 = last ? nB : cB + (size_t)(t + 2) * kstep;
            const char* a3 = a2 + kstep; const char* b3 = b2 + kstep;
            if constexpr (SP2) {
            PG8_LDB(B0, 0, 0); PG8_LDB(B1, 0, 1); PG8_SCHED; PG8_LDA(At, 0, 0); PG8_STAGE(PG8_SA(1, 1), a1 + hstepA, voffA);
            PG8_WAIT_V(8); PG8_WAIT_L(0); PG8_BAR; PG8_MMA(0, 0, At, B0); PG8_MMA(0, 1, At, B1); PG8_BAR; PG8_SCHED;
            PG8_LDA(At, 0, 1); PG8_STAGE(PG8_SB(0, 0), b2, voffB); PG8_STAGE(PG8_SB(0, 1), b2 + hstepB, voffB); PG8_STAGE(PG8_SA(0, 0), a2, voffA);
            PG8_WAIT_V(8); PG8_WAIT_L(0); PG8_BAR; PG8_MMA(1, 0, At, B0); PG8_MMA(1, 1, At, B1); PG8_BAR; PG8_SCHED;
            PG8_LDB(B0, 1, 0); PG8_LDB(B1, 1, 1); PG8_SCHED; PG8_LDA(At, 1, 0); PG8_STAGE(PG8_SA(0, 1), a2 + hstepA, voffA);
            PG8_WAIT_V(8); PG8_WAIT_L(0); PG8_BAR; PG8_MMA(0, 0, At, B0); PG8_MMA(0, 1, At, B1); PG8_BAR; PG8_SCHED;
            PG8_LDA(At, 1, 1); PG8_STAGE(PG8_SB(1, 0), b3, voffB); PG8_STAGE(PG8_SB(1, 1), b3 + hstepB, voffB); PG8_STAGE(PG8_SA(1, 0), a3, voffA);
            PG8_WAIT_V(8); PG8_WAIT_L(0); PG8_BAR; PG8_MMA(1, 0, At, B0); PG8_MMA(1, 1, At, B1); PG8_BAR; PG8_SCHED;
            } else {
            PG8_LDB(B0, 0, 0); PG8_SCHED; PG8_LDA(At, 0, 0); PG8_STAGE(PG8_SA(1, 1), a1 + hstepA, voffA);
            PG8_WAIT_L(8); PG8_BAR; PG8_WAIT_L(0); PG8_MMA(0, 0, At, B0); PG8_BAR; PG8_SCHED;
            PG8_LDB(B1, 0, 1); PG8_STAGE(PG8_SB(0, 0), b2, voffB);
            PG8_BAR; PG8_WAIT_L(0); PG8_MMA(0, 1, At, B1); PG8_BAR;
            PG8_LDA(At, 0, 1); PG8_STAGE(PG8_SA(0, 0), a2, voffA);
            PG8_BAR; PG8_WAIT_L(0); PG8_MMA(1, 0, At, B0); PG8_BAR; PG8_SCHED;
            PG8_STAGE(PG8_SB(0, 1), b2 + hstepB, voffB);
            PG8_WAIT_V(6); PG8_BAR; PG8_MMA(1, 1, At, B1); PG8_BAR;
            PG8_LDB(B0, 1, 0); PG8_SCHED; PG8_LDA(At, 1, 0); PG8_STAGE(PG8_SA(0, 1), a2 + hstepA, voffA);
            PG8_WAIT_L(8); PG8_BAR; PG8_WAIT_L(0); PG8_MMA(0, 0, At, B0); PG8_BAR; PG8_SCHED;
            PG8_LDB(B1, 1, 1); PG8_STAGE(PG8_SB(1, 0), b3, voffB);
            PG8_BAR; PG8_WAIT_L(0); PG8_MMA(0, 1, At, B1); PG8_BAR;
            PG8_LDA(At, 1, 1); PG8_STAGE(PG8_SA(1, 0), a3, voffA);
            PG8_BAR; PG8_WAIT_L(0); PG8_MMA(1, 0, At, B0); PG8_BAR; PG8_SCHED;
            PG8_STAGE(PG8_SB(1, 1), b3 + hstepB, voffB);
            PG8_WAIT_V(6); PG8_BAR; PG8_MMA(1, 1, At, B1); PG8_BAR;
            }
        }
        if constexpr (ALIGN_EPI) { if (wr == 0) PG8_BAR; }
        E(acc, cur, wr, wc, fr, fq);
        if (!has_next) break;
#pragma unroll
        for (int a = 0; a < 2; ++a)
#pragma unroll
            for (int b = 0; b < 2; ++b)
#pragma unroll
                for (int m = 0; m < 4; ++m)
#pragma unroll
                    for (int n = 0; n < 2; ++n) acc[a][b][m][n] = (f32x4){0.f, 0.f, 0.f, 0.f};
        cur = nxt; cA = nA; cB = nB; ++ui;
        if constexpr (ALIGN_EPI) { if (wr == 1) PG8_BAR; }
    }
    PG8_WAIT_V(0);
    if constexpr (!ALIGN_EPI) { if (wr == 0) PG8_BAR; }
    PG8_BAR;
#undef PG8_SA
#undef PG8_SB
#undef PG8_STAGE
#undef PG8_LDA
#undef PG8_LDB
#undef PG8_MMA
#undef PG8_WAIT_V
#undef PG8_WAIT_L
#undef PG8_BAR
#undef PG8_SCHED
}
}
#define LAS __attribute__((address_space(3)))
#define XB_TMO      128
#define XB_XCNT(j)  (256  + 64 * (j))
#define XB_XSUB(j)  (1280 + 64 * (j))
#define XB_XGEN(j)  (2304 + 64 * (j))
#define XB_TOP      3328
#define XB_TOPGEN   3392
#define XCD_BAR_WORDS 3456
#define XB_SPIN_CAP (1u << 22)

__device__ __forceinline__ unsigned xb_ld(unsigned* p)              { return __hip_atomic_load(p, __ATOMIC_RELAXED, __HIP_MEMORY_SCOPE_AGENT); }
__device__ __forceinline__ unsigned xb_add(unsigned* p, unsigned v) { return __hip_atomic_fetch_add(p, v, __ATOMIC_RELAXED, __HIP_MEMORY_SCOPE_AGENT); }
__device__ __forceinline__ unsigned xb_xcc_id() { return (unsigned)__builtin_amdgcn_s_getreg((3 << 11) | 20) & 0xFu; }
#define XB_SPIN(cond, bar) do { unsigned _sp = 0; while (cond) { __builtin_amdgcn_s_sleep(1); \
    if ((++_sp & 255u) == 0u) { if (xb_ld(&(bar)[XB_TMO])) break; if (_sp > XB_SPIN_CAP) { atomicAdd(&(bar)[XB_TMO], 1u); break; } } } } while (0)

struct XcdBarrier {
    unsigned* bar; unsigned x;
    volatile LAS unsigned* st;
};

__device__ __forceinline__ XcdBarrier xcd_barrier_post(unsigned* bar, volatile LAS unsigned* st) {
    XcdBarrier b; b.bar = bar; b.x = xb_xcc_id(); b.st = st;
    if (threadIdx.x == 0) (void)xb_add(&bar[XB_XCNT(b.x)], 1u);
    return b;
}
__device__ __forceinline__ void xcd_barrier_complete(unsigned* bar, unsigned x, unsigned& nloc, unsigned& nx) {
    const unsigned G = gridDim.x * gridDim.y * gridDim.z;
    unsigned sum, cnt, mine, sp = 0u;
    for (;;) {
        sum = 0u; cnt = 0u; mine = 0u;
#pragma unroll
        for (unsigned j = 0; j < 16; ++j) { const unsigned c = xb_ld(&bar[XB_XCNT(j)]); sum += c; cnt += (c > 0u) ? 1u : 0u; mine = (j == x) ? c : mine; }
        if (sum == G) break;
        __builtin_amdgcn_s_sleep(1);
        if ((++sp & 255u) == 0u) { if (xb_ld(&bar[XB_TMO])) break; if (sp > XB_SPIN_CAP) { atomicAdd(&bar[XB_TMO], 1u); break; } }
    }
    nloc = mine > 0u ? mine : 1u; nx = cnt > 0u ? cnt : 1u;
}

__device__ __forceinline__ void xcd_barrier(const XcdBarrier& b) {
    asm volatile("s_waitcnt vmcnt(0)" ::: "memory");
    __syncthreads();
    if (threadIdx.x == 0) {
        unsigned* bar = b.bar;
        __builtin_amdgcn_s_waitcnt(0);
        unsigned nloc = b.st[0], nx = b.st[1];
        if (nloc == 0u) { xcd_barrier_complete(bar, b.x, nloc, nx); b.st[0] = nloc; b.st[1] = nx; }
        const unsigned old = xb_add(&bar[XB_XSUB(b.x)], 1u);
        const unsigned gen = old / nloc;
        if (old + 1u == (gen + 1u) * nloc) {
            __builtin_amdgcn_fence(__ATOMIC_RELEASE, "agent");
            asm volatile("s_waitcnt vmcnt(0)" ::: "memory");
            const unsigned og = xb_add(&bar[XB_TOP], 1u);
            const unsigned tg = og / nx;
            if (og + 1u == (tg + 1u) * nx) xb_add(&bar[XB_TOPGEN], 1u);
            else XB_SPIN(xb_ld(&bar[XB_TOPGEN]) == tg, bar);
            __builtin_amdgcn_fence(__ATOMIC_ACQUIRE, "agent");
            xb_add(&bar[XB_XGEN(b.x)], 1u);
            asm volatile("s_waitcnt vmcnt(0)" ::: "memory");
        } else {
            XB_SPIN(xb_ld(&bar[XB_XGEN(b.x)]) == gen, bar);
            __builtin_amdgcn_fence(__ATOMIC_ACQUIRE, "agent");
            asm volatile("s_waitcnt vmcnt(0)" ::: "memory");
        }
    }
    __syncthreads();
}
#undef LAS
constexpr int NWAVES = 8;
constexpr int BATCH = 2, SEQ = 16384, NTOK = BATCH * SEQ, DM = 1024, DEPTH = 4, PLE = 256;
constexpr int EVEN_IN = 2216, EVEN_INP = 2304, ODD_IN = 2568, ODD_INP = 2816;
constexpr int E_FQ = 0, E_FK = 512, E_FV = 1024, E_FLOG = 1536, E_CQ = 1544, E_CKV = 1928, E_KROPE = 2184;
constexpr int O_U = 0, O_Q = 512, O_K = 1024, O_V = 1536, O_GIN = 2048, O_BETA = 2052, O_Z = 2056;
constexpr float RMS_EPS = 1e-6f;
constexpr int MOE_CAP = 65536 + 32 * 256;
constexpr int MOE_MAXT = MOE_CAP / 256;

enum { I_X = 0, I_P, I_POS, I_NORM_MIX, I_NORM_FFN, I_EV_W_IN, I_FOX_BF, I_FOX_QN, I_FOX_KN, I_MLA_QAN, I_MLA_WQUP, I_MLA_KVAN, I_MLA_WKVUP, I_MLA_QN, I_MLA_KN, I_EV_W_OUT,
       I_OD_W_IN, I_S5_ARE, I_S5_AIM, I_S5_BRE, I_S5_BIM, I_S5_CRE, I_S5_CIM, I_S5_D, I_S5_LS, I_S5_WGLU, I_S5_BGLU, I_GDN_CONV, I_GDN_ALOG, I_GDN_DTB, I_GDN_ONORM, I_OD_W_OUT,
       I_MOE_WGRP, I_MOE_BGRP, I_MOE_WEXP, I_MOE_BEXP, I_MOE_WG, I_MOE_WU, I_MOE_WD, I_PLE_WP, I_PLE_NORM, I_PLE_WG, I_PLE_BG, N_IN };

constexpr size_t MiB = 1u << 20;
constexpr size_t WS_CTL = 0, CTL_ZERO_BYTES = 1 * MiB;
constexpr size_t WS_W_EVIN = 4 * MiB;
constexpr size_t WS_W_ODIN = WS_W_EVIN + 9 * MiB;
constexpr size_t WS_W_QUP = WS_W_ODIN + 11 * MiB;
constexpr size_t WS_W_KVUP = WS_W_QUP + 2 * MiB;
constexpr size_t WS_W_EVOUT = WS_W_KVUP + 1 * MiB;
constexpr size_t WS_W_ODOUT = WS_W_EVOUT + 4 * MiB;
constexpr size_t WS_W_GLU = WS_W_ODOUT + 4 * MiB;
constexpr size_t WS_W_PLEP = WS_W_GLU + 1 * MiB;
constexpr size_t WS_W_PLEG = WS_W_PLEP + 2 * MiB;
constexpr size_t WS_W_MOEGU = WS_W_PLEG + 8 * MiB;
constexpr size_t WS_W_MOED = WS_W_MOEGU + 64 * MiB;
constexpr size_t WS_ABF = WS_W_MOED + 32 * MiB;
constexpr size_t WS_PP = WS_ABF + 64 * MiB;
constexpr size_t WS_PBF = WS_PP + 64 * MiB;
constexpr size_t WS_PROJ = WS_PBF + 16 * MiB;
constexpr size_t WS_MIX = WS_PROJ + 176 * MiB;
constexpr size_t WS_R1 = WS_MIX + 64 * MiB;
constexpr size_t WS_QM = WS_R1, WS_KVB = WS_QM + 48 * MiB, WS_KM = WS_KVB + 64 * MiB, WS_CQN = WS_KM + 48 * MiB, WS_CKVN = WS_CQN + 24 * MiB, WS_LOGF = WS_CKVN + 16 * MiB, WS_CUM = WS_LOGF + 1 * MiB;
constexpr size_t WS_HG = WS_R1, WS_QG = WS_HG + 32 * MiB, WS_KG = WS_QG + 64 * MiB, WS_VG = WS_KG + 64 * MiB, WS_OG = WS_VG + 64 * MiB;
constexpr size_t WS_R2 = WS_R1 + 288 * MiB;
constexpr size_t WS_GB = WS_R2, WS_BETA = WS_GB + 1 * MiB;
constexpr size_t WS_TOKE = WS_R2 + 2 * MiB, WS_TOKW = WS_TOKE + 1 * MiB, WS_ROWS = WS_TOKW + 1 * MiB;
constexpr size_t WS_XG = WS_R1;
constexpr size_t WS_HB = WS_XG + 144 * MiB;
constexpr size_t WS_Y2 = WS_R2 + 8 * MiB;
constexpr size_t WS_END = WS_Y2 + 144 * MiB;
static_assert(WS_HB + 72 * MiB <= WS_R2, "moe overlay");
static_assert(WS_OG + 64 * MiB <= WS_R2, "odd overlay");
static_assert(WS_END <= 1100 * MiB, "workspace budget");

constexpr int CW_BAR = 4096;
constexpr int CW_CNT = 1024;

constexpr int RING_OFF = 0, RING_BYTES = 131072;
constexpr int LDSCTL_OFF = RING_BYTES;
constexpr int LDS_BYTES = 147456;
constexpr int LC_BARST = 32;
constexpr int LC_MOE = 256;

#define GAS __attribute__((address_space(1)))
#define LAS __attribute__((address_space(3)))
typedef unsigned short bf16;
typedef unsigned v4u __attribute__((ext_vector_type(4)));
typedef unsigned v2u __attribute__((ext_vector_type(2)));
typedef float f32x4 __attribute__((ext_vector_type(4)));
#define LDS_WAIT() asm volatile("s_waitcnt lgkmcnt(0)" ::: "memory")
#define VM_WAIT() asm volatile("s_waitcnt vmcnt(0)" ::: "memory")
__device__ __forceinline__ unsigned f2bf(float f) { unsigned u = __builtin_bit_cast(unsigned, f); return (u + 0x7fffu + ((u >> 16) & 1u)) >> 16; }
__device__ __forceinline__ unsigned pk2(float lo, float hi) { return f2bf(lo) | (f2bf(hi) << 16); }
__device__ __forceinline__ float bflo(unsigned w) { return __uint_as_float(w << 16); }
__device__ __forceinline__ float bfhi(unsigned w) { return __uint_as_float(w & 0xffff0000u); }
__device__ __forceinline__ float bf2f(bf16 h) { return __uint_as_float((unsigned)h << 16); }
__device__ __forceinline__ float wave_sum(float v) {
#pragma unroll
    for (int o = 1; o < 64; o <<= 1) v += __shfl_xor(v, o);
    return v;
}
__device__ __forceinline__ float sigm(float x) { return 1.0f / (1.0f + expf(-x)); }
__device__ __forceinline__ float softplusf_(float x) { return fmaxf(x, 0.f) + log1pf(expf(-fabsf(x))); }
__device__ __forceinline__ float gelu_tanh(float x) { return 0.5f * x * (1.0f + tanhf(0.7978845608028654f * (x + 0.044715f * x * x * x))); }

struct Args { const float* in[N_IN]; float* out; unsigned char* ws; int ph_lo, ph_hi; };
#define CAS __attribute__((address_space(4)))
__device__ __forceinline__ const float* kin(int i) { asm volatile("" : "+s"(i)); const CAS char* kp = (const CAS char*)__builtin_amdgcn_kernarg_segment_ptr(); return *(const float* const CAS*)(kp + 8 * i); }
__device__ __forceinline__ float* kout() { int i = N_IN; asm volatile("" : "+s"(i)); const CAS char* kp = (const CAS char*)__builtin_amdgcn_kernarg_segment_ptr(); return *(float* const CAS*)(kp + 8 * i); }
__device__ __forceinline__ unsigned char* kws() { int i = N_IN + 1; asm volatile("" : "+s"(i)); const CAS char* kp = (const CAS char*)__builtin_amdgcn_kernarg_segment_ptr(); return *(unsigned char* const CAS*)(kp + 8 * i); }

struct Frame {
    LAS unsigned char* lds;
    unsigned char* ws;
    unsigned* ctl;
    int tid, lane, wave, G, bid;
};

__device__ __forceinline__ void transpose_item(const float* W, int K, int N, bf16* WT, int drow0, LAS float* scr, int k0, int n0, int lane) {
    const int nn = n0 + (lane & 31); const bool ok = nn < N;
#pragma unroll 8
    for (int i = 0; i < 32; ++i) { const int kk = 2 * i + (lane >> 5); scr[kk * 33 + (lane & 31)] = ok ? W[(size_t)(k0 + kk) * N + nn] : 0.f; }
    LDS_WAIT(); asm volatile("" ::: "memory");
    const int c = lane & 7;
#pragma unroll
    for (int j = 0; j < 4; ++j) { const int n = (lane >> 3) + 8 * j; const LAS float* s = scr + (8 * c) * 33 + n;
        v4u o; o.x = pk2(s[0 * 33], s[1 * 33]); o.y = pk2(s[2 * 33], s[3 * 33]); o.z = pk2(s[4 * 33], s[5 * 33]); o.w = pk2(s[6 * 33], s[7 * 33]);
        *(v4u*)(WT + (size_t)(drow0 + n) * K + k0 + 8 * c) = o; }
    LDS_WAIT(); asm volatile("" ::: "memory");
}
__device__ __forceinline__ void transpose_set(Frame& F, const float* W, int nmat, int K, int N, int NP, bf16* WT, int& itbase) {
    LAS float* scr = (LAS float*)(F.lds + RING_OFF + F.wave * 16384);
    const int gw = F.bid * NWAVES + F.wave, NGW = F.G * NWAVES;
    const int nkb = K / 64, nnb = NP / 32, per = nkb * nnb, total = nmat * per;
    int first = (gw - (itbase % NGW) + NGW) % NGW;
    for (int it = first; it < total; it += NGW) { const int mi = it / per, r = it % per, kb = r / nnb, nb = r % nnb;
        transpose_item(W + (size_t)mi * K * N, K, N, WT + (size_t)mi * NP * K, nb * 32, scr, kb * 64, nb * 32, F.lane); }
    itbase += total;
}
__device__ __forceinline__ void prologue_weights(Frame& F) {
 int itb = 0;
    transpose_set(F, kin(I_EV_W_IN), 2, 1024, EVEN_IN, EVEN_INP, (bf16*)(F.ws + WS_W_EVIN), itb);
    transpose_set(F, kin(I_OD_W_IN), 2, 1024, ODD_IN, ODD_INP, (bf16*)(F.ws + WS_W_ODIN), itb);
    transpose_set(F, kin(I_MLA_WQUP), 2, 384, 768, 768, (bf16*)(F.ws + WS_W_QUP), itb);
    transpose_set(F, kin(I_MLA_WKVUP), 2, 256, 1024, 1024, (bf16*)(F.ws + WS_W_KVUP), itb);
    transpose_set(F, kin(I_EV_W_OUT), 2, 1024, 1024, 1024, (bf16*)(F.ws + WS_W_EVOUT), itb);
    transpose_set(F, kin(I_OD_W_OUT), 2, 1024, 1024, 1024, (bf16*)(F.ws + WS_W_ODOUT), itb);
    transpose_set(F, kin(I_S5_WGLU), 2, 512, 512, 512, (bf16*)(F.ws + WS_W_GLU), itb);
    transpose_set(F, kin(I_PLE_WP), 4, 256, 1024, 1024, (bf16*)(F.ws + WS_W_PLEP), itb);
    transpose_set(F, kin(I_PLE_WG), 4, 1024, 1024, 1024, (bf16*)(F.ws + WS_W_PLEG), itb);
}
__device__ __forceinline__ void moe_weights(Frame& F, int layer) {

    LAS float* scr = (LAS float*)(F.lds + RING_OFF + F.wave * 16384);
    const int gw = F.bid * NWAVES + F.wave, NGW = F.G * NWAVES;
    const float* wg = kin(I_MOE_WG) + (size_t)layer * 32 * 1024 * 512; const float* wu = kin(I_MOE_WU) + (size_t)layer * 32 * 1024 * 512; const float* wd = kin(I_MOE_WD) + (size_t)layer * 32 * 512 * 1024;
    bf16* WGU = (bf16*)(F.ws + WS_W_MOEGU); bf16* WD = (bf16*)(F.ws + WS_W_MOED);
    for (int it = gw; it < 2 * 32 * 256; it += NGW) { const int which = it / (32 * 256), r0 = it % (32 * 256), e = r0 / 256, r = r0 % 256, kb = r / 16, nb = r % 16, n0 = nb * 32;
        const int drow = 256 * (n0 / 128) + (n0 % 128) + which * 128;
        transpose_item((which ? wu : wg) + (size_t)e * 1024 * 512, 1024, 512, WGU + (size_t)e * 1024 * 1024, drow, scr, kb * 64, n0, F.lane); }
    for (int it = gw; it < 32 * 256; it += NGW) { const int e = it / 256, r = it % 256, kb = r / 32, nb = r % 32;
        transpose_item(wd + (size_t)e * 512 * 1024, 512, 1024, WD + (size_t)e * 1024 * 512, nb * 32, scr, kb * 64, nb * 32, F.lane); }
}

__device__ __forceinline__ void rms_row_to_bf16(const float* xrow, const float* gain, bf16* orow, float* copy, int lane) {
    const f32x4* xr = (const f32x4*)xrow + lane; f32x4 v[4]; float s = 0.f;
#pragma unroll
    for (int j = 0; j < 4; ++j) { v[j] = xr[64 * j]; s += (v[j].x * v[j].x + v[j].y * v[j].y) + (v[j].z * v[j].z + v[j].w * v[j].w); }
    const float r = 1.0f / sqrtf(wave_sum(s) * (1.f / 1024.f) + RMS_EPS);
    if (copy) {
#pragma unroll
        for (int j = 0; j < 4; ++j) ((f32x4*)copy + lane)[64 * j] = v[j]; }
    unsigned long long* o8 = (unsigned long long*)orow + lane;
#pragma unroll
    for (int j = 0; j < 4; ++j) { const f32x4 g = ((const f32x4*)gain + lane)[64 * j];
        o8[64 * j] = (unsigned long long)pk2(v[j].x * r * g.x, v[j].y * r * g.y) | ((unsigned long long)pk2(v[j].z * r * g.z, v[j].w * r * g.w) << 32); }
}
__device__ __forceinline__ void phase_norm(Frame& F, const float* src, const float* gain, float* copy) {
    bf16* ABF = (bf16*)(F.ws + WS_ABF);
    const int gw = F.bid * NWAVES + F.wave, NGW = F.G * NWAVES;
    for (int m = gw; m < NTOK; m += NGW) rms_row_to_bf16(src + (size_t)m * DM, gain, ABF + (size_t)m * DM, copy ? copy + (size_t)m * DM : nullptr, F.lane);
}
__device__ __forceinline__ void phase_pconv(Frame& F, int layer) {
    const float* p = kin(I_P) + (size_t)layer * NTOK * PLE; bf16* PBF = (bf16*)(F.ws + WS_PBF);
    const size_t n4 = (size_t)NTOK * PLE / 4; const size_t gt = (size_t)F.bid * 512 + F.tid, NT = (size_t)F.G * 512;
    for (size_t i = gt; i < n4; i += NT) { const f32x4 v = ((const f32x4*)p)[i]; v2u o; o.x = pk2(v.x, v.y); o.y = pk2(v.z, v.w); ((v2u*)PBF)[i] = o; }
}

__device__ __forceinline__ void phase_even_post(Frame& F, int j) {

    bf16* PROJ = (bf16*)(F.ws + WS_PROJ); bf16* CQN = (bf16*)(F.ws + WS_CQN); bf16* CKVN = (bf16*)(F.ws + WS_CKVN); float* LOGF = (float*)(F.ws + WS_LOGF);
    const float* qn = kin(I_FOX_QN) + j * 64; const float* kn = kin(I_FOX_KN) + j * 64; const float* bfv = kin(I_FOX_BF) + j * 8;
    const float* qan = kin(I_MLA_QAN) + j * 384; const float* kvan = kin(I_MLA_KVAN) + j * 256;
    const int gw = F.bid * NWAVES + F.wave, NGW = F.G * NWAVES, lane = F.lane;
    for (int m = gw; m < NTOK; m += NGW) {
        bf16* row = PROJ + (size_t)m * EVEN_INP;
#pragma unroll
        for (int w = 0; w < 2; ++w) {
            v4u* p = (v4u*)(row + (w ? E_FK : E_FQ)) + lane; const v4u x = *p;
            float f[8] = {bflo(x.x), bfhi(x.x), bflo(x.y), bfhi(x.y), bflo(x.z), bfhi(x.z), bflo(x.w), bfhi(x.w)};
            float s = 0.f;
#pragma unroll
            for (int i = 0; i < 8; ++i) s += f[i] * f[i];
            s += __shfl_xor(s, 1); s += __shfl_xor(s, 2); s += __shfl_xor(s, 4);
            const float r = 1.0f / sqrtf(s * (1.f / 64.f) + RMS_EPS); const float* g = (w ? kn : qn) + (lane & 7) * 8;
            v4u o; o.x = pk2(f[0] * r * g[0], f[1] * r * g[1]); o.y = pk2(f[2] * r * g[2], f[3] * r * g[3]); o.z = pk2(f[4] * r * g[4], f[5] * r * g[5]); o.w = pk2(f[6] * r * g[6], f[7] * r * g[7]);
            *p = o;
        }
        if (lane < 8) { const float z = bf2f(row[E_FLOG + lane]) + bfv[lane]; LOGF[(size_t)m * 8 + lane] = -softplusf_(-z); }
        {
            float f[6]; float s = 0.f;
#pragma unroll
            for (int i = 0; i < 3; ++i) { const unsigned x = *((const unsigned*)(row + E_CQ) + lane + 64 * i); f[2 * i] = bflo(x); f[2 * i + 1] = bfhi(x); s += f[2 * i] * f[2 * i] + f[2 * i + 1] * f[2 * i + 1]; }
            const float r = 1.0f / sqrtf(wave_sum(s) * (1.f / 384.f) + RMS_EPS);
#pragma unroll
            for (int i = 0; i < 3; ++i) { const int c = 2 * (lane + 64 * i); *((unsigned*)(CQN + (size_t)m * 384) + lane + 64 * i) = pk2(f[2 * i] * r * qan[c], f[2 * i + 1] * r * qan[c + 1]); }
        }
        {
            float f[4]; float s = 0.f;
#pragma unroll
            for (int i = 0; i < 2; ++i) { const unsigned x = *((const unsigned*)(row + E_CKV) + lane + 64 * i); f[2 * i] = bflo(x); f[2 * i + 1] = bfhi(x); s += f[2 * i] * f[2 * i] + f[2 * i + 1] * f[2 * i + 1]; }
            const float r = 1.0f / sqrtf(wave_sum(s) * (1.f / 256.f) + RMS_EPS);
#pragma unroll
            for (int i = 0; i < 2; ++i) { const int c = 2 * (lane + 64 * i); *((unsigned*)(CKVN + (size_t)m * 256) + lane + 64 * i) = pk2(f[2 * i] * r * kvan[c], f[2 * i + 1] * r * kvan[c + 1]); }
        }
    }
}
__device__ __forceinline__ void phase_cumsum(Frame& F) {
    if (F.bid >= 16) return;
    const float* LOGF = (const float*)(F.ws + WS_LOGF); float* CUM = (float*)(F.ws + WS_CUM);
    const int b = F.bid >> 3, h = F.bid & 7, t0 = F.tid * 32;
    LAS double* part = (LAS double*)(F.lds + RING_OFF);
    float v[32]; double s = 0.0;
#pragma unroll
    for (int i = 0; i < 32; ++i) { v[i] = LOGF[((size_t)b * SEQ + t0 + i) * 8 + h]; s += (double)v[i]; }
    part[F.tid] = s; __syncthreads();
    if (F.tid == 0) { double run = 0.0; for (int i = 0; i < 512; ++i) { const double x = part[i]; part[i] = run; run += x; } }
    __syncthreads();
    double run = part[F.tid];
#pragma unroll
    for (int i = 0; i < 32; ++i) { run += (double)v[i]; CUM[((size_t)b * SEQ + t0 + i) * 8 + h] = (float)run; }
    __syncthreads();
}
__device__ __forceinline__ void phase_mla_post(Frame& F, int j) {

    const bf16* PROJ = (const bf16*)(F.ws + WS_PROJ); bf16* QM = (bf16*)(F.ws + WS_QM); const bf16* KVB = (const bf16*)(F.ws + WS_KVB); bf16* KM = (bf16*)(F.ws + WS_KM);
    const float* qn = kin(I_MLA_QN) + j * 96; const float* kn = kin(I_MLA_KN) + j * 96; const int* pos = (const int*)kin(I_POS);
    const int gw = F.bid * NWAVES + F.wave, NGW = F.G * NWAVES, lane = F.lane, l32 = lane & 31, hh = lane >> 5;
    const int fi = l32 & 15; const float inv = expf(-(float)fi * (1.0f / 16.0f) * 9.210340371976184f);
    for (int m = gw; m < NTOK; m += NGW) {
        const float ang = (float)pos[m] * inv; float sn, cs; sincosf(ang, &sn, &cs);
        const float krope = bf2f(PROJ[(size_t)m * EVEN_INP + E_KROPE + l32]);
#pragma unroll
        for (int hp = 0; hp < 4; ++hp) { const int h = hp * 2 + hh;
#pragma unroll
            for (int w = 0; w < 2; ++w) {
                float f[3];
                if (w == 0) { const bf16* q = QM + (size_t)m * 768 + h * 96; f[0] = bf2f(q[l32]); f[1] = bf2f(q[l32 + 32]); f[2] = bf2f(q[l32 + 64]); }
                else { const bf16* k = KVB + (size_t)m * 1024 + h * 128; f[0] = bf2f(k[l32]); f[1] = bf2f(k[l32 + 32]); f[2] = krope; }
                float s = f[0] * f[0] + f[1] * f[1] + f[2] * f[2];
                s += __shfl_xor(s, 1); s += __shfl_xor(s, 2); s += __shfl_xor(s, 4); s += __shfl_xor(s, 8); s += __shfl_xor(s, 16);
                const float r = 1.0f / sqrtf(s * (1.f / 96.f) + RMS_EPS); const float* g = w ? kn : qn;
                f[0] *= r * g[l32]; f[1] *= r * g[l32 + 32]; f[2] *= r * g[l32 + 64];
                const float other = __shfl_xor(f[2], 16);
                const float rot = (l32 < 16) ? (f[2] * cs - other * sn) : (other * sn + f[2] * cs);
                bf16* o = (w ? KM : QM) + (size_t)m * 768 + h * 96;
                o[l32] = (bf16)f2bf(f[0]); o[l32 + 32] = (bf16)f2bf(f[1]); o[l32 + 64] = (bf16)f2bf(rot);
            }
        }
    }
}
template <int DK> __device__ __forceinline__ void attn_naive_unit(Frame& F, const bf16* Qp, int qld, const bf16* Kp, int kld, const bf16* Vp, int vld, const float* cum  , float scale, bf16* Op, int qb) {
    LAS float* Ks = (LAS float*)(F.lds + RING_OFF); LAS float* Vs = Ks + 64 * DK; LAS float* Cs = Vs + 64 * 64;
    const int t = qb * 512 + F.wave * 64 + F.lane; const int tmax_w = qb * 512 + F.wave * 64 + 63;
    float q[DK];
#pragma unroll
    for (int d = 0; d < DK; d += 8) { const v4u x = *(const v4u*)(Qp + (size_t)t * qld + d);
        q[d] = bflo(x.x) * scale; q[d + 1] = bfhi(x.x) * scale; q[d + 2] = bflo(x.y) * scale; q[d + 3] = bfhi(x.y) * scale; q[d + 4] = bflo(x.z) * scale; q[d + 5] = bfhi(x.z) * scale; q[d + 6] = bflo(x.w) * scale; q[d + 7] = bfhi(x.w) * scale; }
    const float cq = cum ? cum[(size_t)t * 8] : 0.f;
    float acc[64];
#pragma unroll
    for (int d = 0; d < 64; ++d) acc[d] = 0.f;
    float mx = -1e30f, l = 0.f;
    const int nkb = (qb * 512 + 512) / 64;
    for (int kb = 0; kb < nkb; ++kb) {
        __syncthreads();
        for (int i = F.tid; i < 64 * DK / 8; i += 512) { const int key = i / (DK / 8), c = (i % (DK / 8)) * 8; const v4u x = *(const v4u*)(Kp + (size_t)(kb * 64 + key) * kld + c);
            LAS float* d = Ks + key * DK + c; d[0] = bflo(x.x); d[1] = bfhi(x.x); d[2] = bflo(x.y); d[3] = bfhi(x.y); d[4] = bflo(x.z); d[5] = bfhi(x.z); d[6] = bflo(x.w); d[7] = bfhi(x.w); }
        { const int i = F.tid; const int key = i / 8, c = (i % 8) * 8; const v4u x = *(const v4u*)(Vp + (size_t)(kb * 64 + key) * vld + c);
            LAS float* d = Vs + key * 64 + c; d[0] = bflo(x.x); d[1] = bfhi(x.x); d[2] = bflo(x.y); d[3] = bfhi(x.y); d[4] = bflo(x.z); d[5] = bfhi(x.z); d[6] = bflo(x.w); d[7] = bfhi(x.w); }
        if (F.tid < 64) Cs[F.tid] = cum ? cum[(size_t)(kb * 64 + F.tid) * 8] : 0.f;
        __syncthreads();
        if (kb * 64 > tmax_w) continue;
        for (int jk = 0; jk < 64; ++jk) {
            const int s = kb * 64 + jk; if (s > tmax_w) break;
            const LAS float* kr = Ks + jk * DK; float dot = 0.f;
#pragma unroll
            for (int d = 0; d < DK; d += 4) { const f32x4 kv = *(const LAS f32x4*)(kr + d); dot += q[d] * kv.x + q[d + 1] * kv.y + q[d + 2] * kv.z + q[d + 3] * kv.w; }
            float logit = dot + (cq - Cs[jk]); if (s > t) logit = -1e30f;
            if (__any(logit > mx)) { const float mn = fmaxf(mx, logit); const float corr = expf(mx - mn); l *= corr;
#pragma unroll
                for (int d = 0; d < 64; ++d) acc[d] *= corr;
                mx = mn; }
            const float p = (s > t) ? 0.f : expf(logit - mx); l += p;
            const LAS float* vr = Vs + jk * 64;
#pragma unroll
            for (int d = 0; d < 64; d += 4) { const f32x4 vv = *(const LAS f32x4*)(vr + d); acc[d] += p * vv.x; acc[d + 1] += p * vv.y; acc[d + 2] += p * vv.z; acc[d + 3] += p * vv.w; }
        }
    }
    const float il = 1.0f / l; bf16* o = Op + (size_t)t * DM;
#pragma unroll
    for (int d = 0; d < 64; d += 8) { v4u w; w.x = pk2(acc[d] * il, acc[d + 1] * il); w.y = pk2(acc[d + 2] * il, acc[d + 3] * il); w.z = pk2(acc[d + 4] * il, acc[d + 5] * il); w.w = pk2(acc[d + 6] * il, acc[d + 7] * il); *(v4u*)(o + d) = w; }
}
__device__ __forceinline__ void phase_attn_naive(Frame& F) {
    const bf16* PROJ = (const bf16*)(F.ws + WS_PROJ); const bf16* QM = (const bf16*)(F.ws + WS_QM); const bf16* KVB = (const bf16*)(F.ws + WS_KVB); const bf16* KM = (const bf16*)(F.ws + WS_KM);
    const float* CUM = (const float*)(F.ws + WS_CUM); bf16* MIX = (bf16*)(F.ws + WS_MIX);
    for (int p = F.bid; p < 512; p += F.G) {
        const int combo = p >> 4, qq = p & 15; const int type = combo >> 4, b = (combo >> 3) & 1, h = combo & 7;
#pragma unroll 1
        for (int half = 0; half < 2; ++half) { const int qb = half ? 31 - qq : qq; const size_t rb = (size_t)b * SEQ;
            if (type == 0) attn_naive_unit<64>(F, PROJ + rb * EVEN_INP + E_FQ + h * 64, EVEN_INP, PROJ + rb * EVEN_INP + E_FK + h * 64, EVEN_INP, PROJ + rb * EVEN_INP + E_FV + h * 64, EVEN_INP, CUM + rb * 8 + h, 0.125f, MIX + rb * DM + h * 64, qb);
            else attn_naive_unit<96>(F, QM + rb * 768 + h * 96, 768, KM + rb * 768 + h * 96, 768, KVB + rb * 1024 + h * 128 + 64, 1024, nullptr, 0.10206207261596575f, MIX + rb * DM + 512 + h * 64, qb);
        }
    }
    __syncthreads();
}

__device__ __forceinline__ void s5_scan_wave(Frame& F, int j, int b, int g) {
 const int p = F.lane;
    const bf16* PROJ = (const bf16*)(F.ws + WS_PROJ); bf16* HG = (bf16*)(F.ws + WS_HG);
    const float lr = fminf(kin(I_S5_ARE)[(j * 32 + g) * 64 + p], -1e-4f), li = kin(I_S5_AIM)[(j * 32 + g) * 64 + p];
    const float dt = expf(kin(I_S5_LS)[j * 32 + g]);
    const float mag = expf(lr * dt); const float abr = mag * cosf(li * dt), abi = mag * sinf(li * dt);
    const float den = lr * lr + li * li, nr = abr - 1.0f, ni = abi;
    const float gr = (nr * lr + ni * li) / den, gi = (ni * lr - nr * li) / den;
    float bbr[16], bbi[16], cr[16], ci[16], dsk[16];
#pragma unroll
    for (int c = 0; c < 16; ++c) { const float br = kin(I_S5_BRE)[((size_t)(j * 32 + g) * 64 + p) * 16 + c], bi = kin(I_S5_BIM)[((size_t)(j * 32 + g) * 64 + p) * 16 + c];
        bbr[c] = gr * br - gi * bi; bbi[c] = gr * bi + gi * br;
        cr[c] = kin(I_S5_CRE)[((size_t)(j * 32 + g) * 16 + c) * 64 + p]; ci[c] = kin(I_S5_CIM)[((size_t)(j * 32 + g) * 16 + c) * 64 + p];
        dsk[c] = kin(I_S5_D)[j * 512 + g * 16 + c]; }
    float xr = 0.f, xi = 0.f;
    const bf16* up = PROJ + (size_t)b * SEQ * ODD_INP + O_U + g * 16;
    v4u cur0[4], cur1[4], nx0[4], nx1[4];
#pragma unroll
    for (int i = 0; i < 4; ++i) { cur0[i] = *(const v4u*)(up + (size_t)i * ODD_INP); cur1[i] = *(const v4u*)(up + (size_t)i * ODD_INP + 8); }
    for (int t0 = 0; t0 < SEQ; t0 += 4) {
        const int tn = (t0 + 4 < SEQ) ? t0 + 4 : t0;
#pragma unroll
        for (int i = 0; i < 4; ++i) { nx0[i] = *(const v4u*)(up + (size_t)(tn + i) * ODD_INP); nx1[i] = *(const v4u*)(up + (size_t)(tn + i) * ODD_INP + 8); }
#pragma unroll
        for (int i = 0; i < 4; ++i) {
            float u[16] = {bflo(cur0[i].x), bfhi(cur0[i].x), bflo(cur0[i].y), bfhi(cur0[i].y), bflo(cur0[i].z), bfhi(cur0[i].z), bflo(cur0[i].w), bfhi(cur0[i].w),
                           bflo(cur1[i].x), bfhi(cur1[i].x), bflo(cur1[i].y), bfhi(cur1[i].y), bflo(cur1[i].z), bfhi(cur1[i].z), bflo(cur1[i].w), bfhi(cur1[i].w)};
            float bur = 0.f, bui = 0.f;
#pragma unroll
            for (int c = 0; c < 16; ++c) { bur += bbr[c] * u[c]; bui += bbi[c] * u[c]; }
            const float nxr = abr * xr - abi * xi + bur, nxi = abr * xi + abi * xr + bui; xr = nxr; xi = nxi;
            float y[16];
#pragma unroll
            for (int c = 0; c < 16; ++c) y[c] = wave_sum(cr[c] * xr - ci[c] * xi);
            if (p < 16) { float yy = 0.f, uu = 0.f, dd = 0.f;
#pragma unroll
                for (int c = 0; c < 16; ++c) if (p == c) { yy = y[c]; uu = u[c]; dd = dsk[c]; }
                HG[((size_t)b * SEQ + t0 + i) * 512 + g * 16 + p] = (bf16)f2bf(gelu_tanh(yy + dd * uu)); }
        }
#pragma unroll
        for (int i = 0; i < 4; ++i) { cur0[i] = nx0[i]; cur1[i] = nx1[i]; }
    }
}
__device__ __forceinline__ void gdn_prep_token(Frame& F, int j, int m) {
 const int lane = F.lane;
    const bf16* PROJ = (const bf16*)(F.ws + WS_PROJ); float* QG = (float*)(F.ws + WS_QG); float* KG = (float*)(F.ws + WS_KG); float* VG = (float*)(F.ws + WS_VG);
    float* GB = (float*)(F.ws + WS_GB); float* BETA = (float*)(F.ws + WS_BETA);
    const float* cw = kin(I_GDN_CONV) + (size_t)j * 4 * 1536;
    const int s = m % SEQ;
#pragma unroll
    for (int w = 0; w < 3; ++w) {
        const int ch0 = w * 512 + lane * 8; float acc[8];
#pragma unroll
        for (int i = 0; i < 8; ++i) acc[i] = 0.f;
#pragma unroll
        for (int tap = 0; tap < 4; ++tap) { const int ss = s - 3 + tap; if (ss < 0) continue;
            const v4u x = *(const v4u*)(PROJ + (size_t)(m - 3 + tap) * ODD_INP + O_Q + ch0); const float* wv = cw + tap * 1536 + ch0;
            acc[0] += wv[0] * bflo(x.x); acc[1] += wv[1] * bfhi(x.x); acc[2] += wv[2] * bflo(x.y); acc[3] += wv[3] * bfhi(x.y); acc[4] += wv[4] * bflo(x.z); acc[5] += wv[5] * bfhi(x.z); acc[6] += wv[6] * bflo(x.w); acc[7] += wv[7] * bfhi(x.w); }
        float ss2 = 0.f;
#pragma unroll
        for (int i = 0; i < 8; ++i) { acc[i] = acc[i] * sigm(acc[i]); ss2 += acc[i] * acc[i]; }
        float sc = 1.0f;
        if (w < 2) { ss2 += __shfl_xor(ss2, 1); ss2 += __shfl_xor(ss2, 2); ss2 += __shfl_xor(ss2, 4); ss2 += __shfl_xor(ss2, 8); sc = 1.0f / sqrtf(ss2 + RMS_EPS); if (w == 0) sc *= 0.08838834764831845f; }
        float* dst = (w == 0 ? QG : (w == 1 ? KG : VG)) + (size_t)m * 512 + lane * 8;
        *(f32x4*)dst = (f32x4){acc[0] * sc, acc[1] * sc, acc[2] * sc, acc[3] * sc}; *(f32x4*)(dst + 4) = (f32x4){acc[4] * sc, acc[5] * sc, acc[6] * sc, acc[7] * sc};
    }
    if (lane < 4) { const float gin = bf2f(PROJ[(size_t)m * ODD_INP + O_GIN + lane]), bin = bf2f(PROJ[(size_t)m * ODD_INP + O_BETA + lane]);
        GB[(size_t)m * 4 + lane] = -expf(kin(I_GDN_ALOG)[j * 4 + lane]) * softplusf_(gin + kin(I_GDN_DTB)[j * 4 + lane]); BETA[(size_t)m * 4 + lane] = sigm(bin); }
}
__device__ __forceinline__ void phase_odd_a(Frame& F, int j) {
    if (F.wave == 0 && F.bid < 64) { s5_scan_wave(F, j, F.bid >> 5, F.bid & 31); return; }
    const int nbusy = (F.G < 64 ? F.G : 64);
    const int widx = (F.bid < 64) ? F.bid * 7 + (F.wave - 1) : nbusy * 7 + (F.bid - 64) * 8 + F.wave;
    const int nw = nbusy * 7 + (F.G > 64 ? (F.G - 64) * 8 : 0);
    for (int m = widx; m < NTOK; m += nw) gdn_prep_token(F, j, m);
}
__device__ __forceinline__ void phase_gdn_naive(Frame& F) {
    const float* QG = (const float*)(F.ws + WS_QG); const float* KG = (const float*)(F.ws + WS_KG); const float* VG = (const float*)(F.ws + WS_VG);
    const float* GB = (const float*)(F.ws + WS_GB); const float* BETA = (const float*)(F.ws + WS_BETA); float* OG = (float*)(F.ws + WS_OG);
    const int lane = F.lane; const int NGW = F.G * NWAVES;
    for (int u = F.wave * F.G + F.bid; u < 1024; u += NGW) {
        const int b = u >> 9, h = (u >> 7) & 3, c = u & 127; const size_t rb = (size_t)b * SEQ;
        const float* kq = KG + rb * 512 + h * 128 + lane; const float* qq = QG + rb * 512 + h * 128 + lane; const float* vq = VG + rb * 512 + h * 128 + c;
        const float* gq = GB + rb * 4 + h; const float* bq = BETA + rb * 4 + h; float* oq = OG + rb * 512 + h * 128 + c;
        float s0 = 0.f, s1 = 0.f;
        float k0[8], k1[8], q0[8], q1[8], vv[8], gg[8], bb[8], nk0[8], nk1[8], nq0[8], nq1[8], nv[8], ng[8], nb[8];
#pragma unroll
        for (int i = 0; i < 8; ++i) { k0[i] = kq[(size_t)i * 512]; k1[i] = kq[(size_t)i * 512 + 64]; q0[i] = qq[(size_t)i * 512]; q1[i] = qq[(size_t)i * 512 + 64]; vv[i] = vq[(size_t)i * 512]; gg[i] = gq[i * 4]; bb[i] = bq[i * 4]; }
        for (int t0 = 0; t0 < SEQ; t0 += 8) {
            const int tn = (t0 + 8 < SEQ) ? t0 + 8 : t0;
#pragma unroll
            for (int i = 0; i < 8; ++i) { const size_t o = (size_t)(tn + i) * 512; nk0[i] = kq[o]; nk1[i] = kq[o + 64]; nq0[i] = qq[o]; nq1[i] = qq[o + 64]; nv[i] = vq[o]; ng[i] = gq[(tn + i) * 4]; nb[i] = bq[(tn + i) * 4]; }
#pragma unroll
            for (int i = 0; i < 8; ++i) {
                const float ks = wave_sum(k0[i] * s0 + k1[i] * s1); const float eg = expf(gg[i]); const float be = bb[i];
                s0 = eg * (s0 - be * k0[i] * ks) + be * k0[i] * vv[i]; s1 = eg * (s1 - be * k1[i] * ks) + be * k1[i] * vv[i];
                const float o = wave_sum(q0[i] * s0 + q1[i] * s1);
                if (lane == 0) oq[(size_t)(t0 + i) * 512] = o;
            }
#pragma unroll
            for (int i = 0; i < 8; ++i) { k0[i] = nk0[i]; k1[i] = nk1[i]; q0[i] = nq0[i]; q1[i] = nq1[i]; vv[i] = nv[i]; gg[i] = ng[i]; bb[i] = nb[i]; }
        }
    }
}
__device__ __forceinline__ void phase_gdn_out(Frame& F, int j) {
 const float* OG = (const float*)(F.ws + WS_OG); const bf16* PROJ = (const bf16*)(F.ws + WS_PROJ); bf16* MIX = (bf16*)(F.ws + WS_MIX);
    const float* on = kin(I_GDN_ONORM) + j * 128; const int lane = F.lane;
    const int gw = F.bid * NWAVES + F.wave, NGW = F.G * NWAVES;
    for (int m = gw; m < NTOK; m += NGW) {
        const f32x4 a = *(const f32x4*)(OG + (size_t)m * 512 + lane * 8), b = *(const f32x4*)(OG + (size_t)m * 512 + lane * 8 + 4);
        float f[8] = {a.x, a.y, a.z, a.w, b.x, b.y, b.z, b.w}; float s = 0.f;
#pragma unroll
        for (int i = 0; i < 8; ++i) s += f[i] * f[i];
        s += __shfl_xor(s, 1); s += __shfl_xor(s, 2); s += __shfl_xor(s, 4); s += __shfl_xor(s, 8);
        const float r = 1.0f / sqrtf(s * (1.f / 128.f) + RMS_EPS);
        const bf16* z = PROJ + (size_t)m * ODD_INP + O_Z + lane * 8; const float* g = on + (lane & 15) * 8; float o[8];
#pragma unroll
        for (int i = 0; i < 8; ++i) { const float zz = bf2f(z[i]); o[i] = f[i] * r * g[i] * (zz * sigm(zz)); }
        v4u w; w.x = pk2(o[0], o[1]); w.y = pk2(o[2], o[3]); w.z = pk2(o[4], o[5]); w.w = pk2(o[6], o[7]);
        *(v4u*)(MIX + (size_t)m * DM + 512 + lane * 8) = w;
    }
}

__device__ __forceinline__ void phase_router(Frame& F, int layer) {
 const float* H = kout(); bf16* ABF = (bf16*)(F.ws + WS_ABF);
    const float* gain = kin(I_NORM_FFN) + layer * DM; const float* wgr = kin(I_MOE_WGRP) + (size_t)layer * DM * 4; const float* bgr = kin(I_MOE_BGRP) + layer * 4;
    const float* wex = kin(I_MOE_WEXP) + (size_t)layer * DM * 32; const float* bex = kin(I_MOE_BEXP) + layer * 32;
    int* TOKE = (int*)(F.ws + WS_TOKE); float* TOKW = (float*)(F.ws + WS_TOKW);
    LAS int* lcnt = (LAS int*)(F.lds + LDSCTL_OFF + LC_MOE + 512); LAS int* gbase = (LAS int*)(F.lds + LDSCTL_OFF + LC_MOE + 640);
    const int lane = F.lane; const int per = NTOK / F.G;
    LAS int* lasg = (LAS int*)(F.lds + RING_OFF);
    if (F.tid < 32) lcnt[F.tid] = 0;
    __syncthreads();
    for (int tl = F.wave; tl < per; tl += NWAVES) {
        const int m = F.bid * per + tl;
        const f32x4* xr = (const f32x4*)(H + (size_t)m * DM) + lane; f32x4 v[4]; float s = 0.f;
#pragma unroll
        for (int q = 0; q < 4; ++q) { v[q] = xr[64 * q]; s += (v[q].x * v[q].x + v[q].y * v[q].y) + (v[q].z * v[q].z + v[q].w * v[q].w); }
        const float r = 1.0f / sqrtf(wave_sum(s) * (1.f / 1024.f) + RMS_EPS);
        unsigned long long* o8 = (unsigned long long*)(ABF + (size_t)m * DM) + lane;
#pragma unroll
        for (int q = 0; q < 4; ++q) { const f32x4 g = ((const f32x4*)gain + lane)[64 * q]; v[q].x *= r * g.x; v[q].y *= r * g.y; v[q].z *= r * g.z; v[q].w *= r * g.w;
            o8[64 * q] = (unsigned long long)pk2(v[q].x, v[q].y) | ((unsigned long long)pk2(v[q].z, v[q].w) << 32); }
        float lg[4] = {0.f, 0.f, 0.f, 0.f};
#pragma unroll
        for (int q = 0; q < 4; ++q) { const int k0 = 4 * lane + 256 * q;
#pragma unroll
            for (int e = 0; e < 4; ++e) { const f32x4 w = *(const f32x4*)(wgr + (size_t)(k0 + e) * 4); const float x = v[q][e]; lg[0] += x * w.x; lg[1] += x * w.y; lg[2] += x * w.z; lg[3] += x * w.w; } }
#pragma unroll
        for (int g = 0; g < 4; ++g) lg[g] = wave_sum(lg[g]) + bgr[g];
        int gi = 0; float gm = lg[0];
#pragma unroll
        for (int g = 1; g < 4; ++g) if (lg[g] > gm) { gm = lg[g]; gi = g; }
        float gden = 0.f;
#pragma unroll
        for (int g = 0; g < 4; ++g) gden += expf(lg[g] - gm);
        const float gw_ = 1.0f / gden;
        float le[8] = {0.f, 0.f, 0.f, 0.f, 0.f, 0.f, 0.f, 0.f};
#pragma unroll
        for (int q = 0; q < 4; ++q) { const int k0 = 4 * lane + 256 * q;
#pragma unroll
            for (int e = 0; e < 4; ++e) { const float* wp = wex + (size_t)(k0 + e) * 32 + gi * 8; const f32x4 w0 = *(const f32x4*)wp, w1 = *(const f32x4*)(wp + 4); const float x = v[q][e];
                le[0] += x * w0.x; le[1] += x * w0.y; le[2] += x * w0.z; le[3] += x * w0.w; le[4] += x * w1.x; le[5] += x * w1.y; le[6] += x * w1.z; le[7] += x * w1.w; } }
#pragma unroll
        for (int e = 0; e < 8; ++e) le[e] = wave_sum(le[e]) + bex[gi * 8 + e];
        int i0 = 0; float m0 = le[0];
#pragma unroll
        for (int e = 1; e < 8; ++e) if (le[e] > m0) { m0 = le[e]; i0 = e; }
        int i1 = -1; float m1 = -3.0e38f;
#pragma unroll
        for (int e = 0; e < 8; ++e) if (e != i0 && le[e] > m1) { m1 = le[e]; i1 = e; }
        const float e1 = expf(m1 - m0); const float w0 = gw_ / (1.0f + e1), w1 = gw_ * e1 / (1.0f + e1);
        if (lane == 0) { const int ea = gi * 8 + i0, eb = gi * 8 + i1;
            const int pa = __hip_atomic_fetch_add(lcnt + ea, 1, __ATOMIC_RELAXED, __HIP_MEMORY_SCOPE_WORKGROUP), pb = __hip_atomic_fetch_add(lcnt + eb, 1, __ATOMIC_RELAXED, __HIP_MEMORY_SCOPE_WORKGROUP);
            lasg[tl * 2] = ea | (pa << 8); lasg[tl * 2 + 1] = eb | (pb << 8);
            TOKW[(size_t)m * 2] = w0; TOKW[(size_t)m * 2 + 1] = w1; }
    }
    __syncthreads();
    if (F.tid < 32) gbase[F.tid] = (int)__hip_atomic_fetch_add(F.ctl + CW_CNT + 64 * layer + F.tid, (unsigned)lcnt[F.tid], __ATOMIC_RELAXED, __HIP_MEMORY_SCOPE_AGENT);
    __syncthreads();
    for (int i = F.tid; i < per * 2; i += 512) { const int a = lasg[i], e = a & 255, lp = a >> 8; TOKE[(size_t)F.bid * per * 2 + i] = e | ((gbase[e] + lp) << 8); }
    __syncthreads();
}
__device__ __forceinline__ void moe_tables(Frame& F, int layer) {
    LAS int* rowbase = (LAS int*)(F.lds + LDSCTL_OFF + LC_MOE); LAS unsigned char* tile_e = (LAS unsigned char*)(F.lds + LDSCTL_OFF + LC_MOE + 192);
    if (F.tid == 0) { int rb = 0;
#pragma unroll 1
        for (int e = 0; e < 32; ++e) { const int c = (int)__hip_atomic_load(F.ctl + CW_CNT + 64 * layer + e, __ATOMIC_RELAXED, __HIP_MEMORY_SCOPE_AGENT); rowbase[e] = rb; const int nt = (c + 255) >> 8;
            for (int i = 0; i < nt; ++i) tile_e[(rb >> 8) + i] = (unsigned char)e; rb += nt << 8; }
        rowbase[32] = rb; rowbase[34] = rb >> 8; }
    __syncthreads();
}
__device__ __forceinline__ void phase_moe_scatter(Frame& F, int layer) {
    moe_tables(F, layer);
    const LAS int* rowbase = (const LAS int*)(F.lds + LDSCTL_OFF + LC_MOE);
    const bf16* ABF = (const bf16*)(F.ws + WS_ABF); bf16* XG = (bf16*)(F.ws + WS_XG); const int* TOKE = (const int*)(F.ws + WS_TOKE); int* ROWS = (int*)(F.ws + WS_ROWS);
    const int gw = F.bid * NWAVES + F.wave, NGW = F.G * NWAVES, lane = F.lane;
    for (int m = gw; m < NTOK; m += NGW) {
        const v4u a = *((const v4u*)(ABF + (size_t)m * DM) + lane), b = *((const v4u*)(ABF + (size_t)m * DM) + 64 + lane);
#pragma unroll
        for (int k = 0; k < 2; ++k) { const int te = TOKE[(size_t)m * 2 + k]; const int row = rowbase[te & 255] + (te >> 8);
            *((v4u*)(XG + (size_t)row * DM) + lane) = a; *((v4u*)(XG + (size_t)row * DM) + 64 + lane) = b;
            if (lane == 0) ROWS[(size_t)m * 2 + k] = row; }
    }
}
struct MoeOrder {
    int ntiles, nN, G, c; const LAS unsigned char* tile_e; size_t bstride;
    __device__ bool next(int i, pg8::Unit& u) const { const long L = (long)i * G + c; if (L >= (long)ntiles * nN) return false; u.pm = (int)(L / nN); u.pn = (int)(L % nN); u.aux = __builtin_amdgcn_readfirstlane((int)tile_e[u.pm]); return true; }
    __device__ __forceinline__ const char* a_base(const pg8::Gemm& g, const pg8::Unit& u) const { return (const char*)g.A + (size_t)u.pm * 256 * g.lda * 2; }
    __device__ __forceinline__ const char* b_base(const pg8::Gemm& g, const pg8::Unit& u) const { return (const char*)g.Bt + (size_t)u.aux * bstride + (size_t)u.pn * 256 * g.ldb * 2; }
};
__device__ __forceinline__ void phase_moe_combine(Frame& F, int layer) {
 float* H = kout(); bf16* ABF = (bf16*)(F.ws + WS_ABF); const bf16* Y2 = (const bf16*)(F.ws + WS_Y2);
    const int* ROWS = (const int*)(F.ws + WS_ROWS); const float* TOKW = (const float*)(F.ws + WS_TOKW); const float* gain = kin(I_PLE_NORM) + layer * DM;
    const int gw = F.bid * NWAVES + F.wave, NGW = F.G * NWAVES, lane = F.lane;
    for (int m = gw; m < NTOK; m += NGW) {
        const int r0 = ROWS[(size_t)m * 2], r1 = ROWS[(size_t)m * 2 + 1]; const float w0 = TOKW[(size_t)m * 2], w1 = TOKW[(size_t)m * 2 + 1];
        f32x4* hr = (f32x4*)(H + (size_t)m * DM) + lane; f32x4 v[4]; float s = 0.f;
#pragma unroll
        for (int q = 0; q < 4; ++q) { v[q] = hr[64 * q]; const v2u ya = *((const v2u*)(Y2 + (size_t)r0 * DM) + lane + 64 * q), yb = *((const v2u*)(Y2 + (size_t)r1 * DM) + lane + 64 * q);
            v[q].x += w0 * bflo(ya.x) + w1 * bflo(yb.x); v[q].y += w0 * bfhi(ya.x) + w1 * bfhi(yb.x); v[q].z += w0 * bflo(ya.y) + w1 * bflo(yb.y); v[q].w += w0 * bfhi(ya.y) + w1 * bfhi(yb.y);
            hr[64 * q] = v[q]; s += (v[q].x * v[q].x + v[q].y * v[q].y) + (v[q].z * v[q].z + v[q].w * v[q].w); }
        const float r = 1.0f / sqrtf(wave_sum(s) * (1.f / 1024.f) + RMS_EPS);
        unsigned long long* o8 = (unsigned long long*)(ABF + (size_t)m * DM) + lane;
#pragma unroll
        for (int q = 0; q < 4; ++q) { const f32x4 g = ((const f32x4*)gain + lane)[64 * q];
            o8[64 * q] = (unsigned long long)pk2(v[q].x * r * g.x, v[q].y * r * g.y) | ((unsigned long long)pk2(v[q].z * r * g.z, v[q].w * r * g.w) << 32); }
    }
}
constexpr int LSTEPS = 16;
constexpr int STEP_END = 1 + DEPTH * LSTEPS;
struct KArgs { Args a; int li, pad; };

#define FRAME Frame F; { int wv_ = wave0; asm volatile("" : "+s"(wv_)); int t_ = wv_ * 64 + (int)__builtin_amdgcn_mbcnt_hi(~0u, __builtin_amdgcn_mbcnt_lo(~0u, 0u)); asm volatile("" : "+v"(t_)); unsigned char* w_ = kws(); F.lds = lds0; F.ws = w_; F.ctl = (unsigned*)(w_ + WS_CTL); \
        F.tid = t_; F.lane = t_ & 63; F.wave = __builtin_amdgcn_readfirstlane(t_ >> 6); { int g_ = gridDim.x, b_ = blockIdx.x; asm volatile("" : "+s"(g_), "+s"(b_)); F.G = g_; F.bid = b_; } } unsigned char* const ws = F.ws; (void)ws
#ifndef PH_MASK
#define PH_MASK 0xffffffffu
#endif
#define EN(k) (((PH_MASK) >> (k)) & 1u)
#define STEP(s) if (lo <= (s) && (s) < hi)
#define ENDSTEP(s) do { if ((s) + 1 < hi) xcd_barrier(bar); } while (0)
#define LAUNDER_WS do {} while (0)


template <int layer> __device__ __forceinline__ void layer_body(const XcdBarrier& bar, const int lo, const int hi, LAS unsigned char* const lds0, const int wave0) {
        constexpr int sb = 1 + layer * LSTEPS, j = layer >> 1; constexpr bool even = (layer & 1) == 0;
        STEP(sb + 0) if constexpr (EN(0)) { FRAME;
            phase_norm(F, layer == 0 ? kin(I_X) : kout(), kin(I_NORM_MIX) + layer * DM, layer == 0 ? kout() : nullptr);
            moe_weights(F, layer); phase_pconv(F, layer);
            ENDSTEP(sb + 0);
        }
        STEP(sb + 1) if constexpr (EN(1)) { FRAME;
            { LAUNDER_WS; const int NP = even ? EVEN_INP : ODD_INP; const bf16* W = even ? (const bf16*)(ws + WS_W_EVIN) + (size_t)j * EVEN_INP * 1024 : (const bf16*)(ws + WS_W_ODIN) + (size_t)j * ODD_INP * 1024;
              pg8::Gemm g{(const bf16*)(ws + WS_ABF), W, 1024, 1024, 1024}; pg8::StaticOrder S; S.init(NTOK, NP, F.G, F.bid); pg8::EpiBf16 E{(bf16*)(ws + WS_PROJ), NP};
              pg8::gemm_phase<pg8::EpiBf16, pg8::StaticOrder>(F.lds + RING_OFF, g, S, E, F.tid); }
            { LAUNDER_WS; pg8::Gemm g{(const bf16*)(ws + WS_PBF), (const bf16*)(ws + WS_W_PLEP) + (size_t)layer * 1024 * 256, 256, 256, 256}; pg8::StaticOrder S; S.init(NTOK, 1024, F.G, F.bid); pg8::EpiBf16 E{(bf16*)(ws + WS_PP), 1024};
              pg8::gemm_phase<pg8::EpiBf16, pg8::StaticOrder>(F.lds + RING_OFF, g, S, E, F.tid); }
            ENDSTEP(sb + 1);
        }
        if constexpr (even) {
            STEP(sb + 2) if constexpr (EN(2)) { FRAME; phase_even_post(F, j); ENDSTEP(sb + 2); }
            STEP(sb + 3) if constexpr (EN(3)) { FRAME;
#ifndef NO_QUP
                { LAUNDER_WS; pg8::Gemm g{(const bf16*)(ws + WS_CQN), (const bf16*)(ws + WS_W_QUP) + (size_t)j * 768 * 384, 384, 384, 384}; pg8::StaticOrder S; S.init(NTOK, 768, F.G, F.bid); pg8::EpiBf16 E{(bf16*)(ws + WS_QM), 768};
                  pg8::gemm_phase<pg8::EpiBf16, pg8::StaticOrder>(F.lds + RING_OFF, g, S, E, F.tid); }
#endif
#ifndef NO_KVUP
                { LAUNDER_WS; pg8::Gemm g{(const bf16*)(ws + WS_CKVN), (const bf16*)(ws + WS_W_KVUP) + (size_t)j * 1024 * 256, 256, 256, 256}; pg8::StaticOrder S; S.init(NTOK, 1024, F.G, F.bid); pg8::EpiBf16 E{(bf16*)(ws + WS_KVB), 1024};
                  pg8::gemm_phase<pg8::EpiBf16, pg8::StaticOrder>(F.lds + RING_OFF, g, S, E, F.tid); }
#endif
#ifndef NO_CUMSUM
                phase_cumsum(F);
#endif
                ENDSTEP(sb + 3);
            }
            STEP(sb + 4) if constexpr (EN(4)) { FRAME; phase_mla_post(F, j); ENDSTEP(sb + 4); }
            STEP(sb + 5) if constexpr (EN(5)) { FRAME; phase_attn_naive(F); ENDSTEP(sb + 5); }
        } else {
            STEP(sb + 2) if constexpr (EN(2)) { FRAME; phase_odd_a(F, j); ENDSTEP(sb + 2); }
            STEP(sb + 3) if constexpr (EN(3)) { FRAME;
#ifndef NO_GLU
                { LAUNDER_WS; pg8::Gemm g{(const bf16*)(ws + WS_HG), (const bf16*)(ws + WS_W_GLU) + (size_t)j * 512 * 512, 512, 512, 512}; pg8::StaticOrder S; S.init(NTOK, 512, F.G, F.bid);
                  pg8::EpiGlu E{(bf16*)(ws + WS_MIX), 1024, (const bf16*)(ws + WS_HG), 512, kin(I_S5_BGLU) + j * 512};
                  pg8::gemm_phase<pg8::EpiGlu, pg8::StaticOrder>(F.lds + RING_OFF, g, S, E, F.tid); }
#endif
#ifndef NO_GDN
                phase_gdn_naive(F);
#endif
                ENDSTEP(sb + 3);
            }
            STEP(sb + 4) if constexpr (EN(4)) { FRAME; phase_gdn_out(F, j); ENDSTEP(sb + 4); }
        }
        STEP(sb + 6) if constexpr (EN(6)) { FRAME;
            LAUNDER_WS; const bf16* W = even ? (const bf16*)(ws + WS_W_EVOUT) + (size_t)j * 1024 * 1024 : (const bf16*)(ws + WS_W_ODOUT) + (size_t)j * 1024 * 1024;
            pg8::Gemm g{(const bf16*)(ws + WS_MIX), W, 1024, 1024, 1024}; pg8::StaticOrder S; S.init(NTOK, 1024, F.G, F.bid); pg8::EpiResAdd E{kout(), 1024};
            pg8::gemm_phase<pg8::EpiResAdd, pg8::StaticOrder>(F.lds + RING_OFF, g, S, E, F.tid);
            ENDSTEP(sb + 6);
        }
        STEP(sb + 7) if constexpr (EN(7)) { FRAME; phase_router(F, layer); ENDSTEP(sb + 7); }
        STEP(sb + 8) if constexpr (EN(8)) { FRAME; phase_moe_scatter(F, layer); ENDSTEP(sb + 8); }
        STEP(sb + 9) if constexpr (EN(9)) { FRAME;
            LAUNDER_WS; moe_tables(F, layer);
            const LAS int* rowbase = (const LAS int*)(F.lds + LDSCTL_OFF + LC_MOE);
            MoeOrder S{__builtin_amdgcn_readfirstlane(rowbase[34]), 4, F.G, F.bid, (const LAS unsigned char*)(F.lds + LDSCTL_OFF + LC_MOE + 192), (size_t)1024 * 1024 * 2};
            pg8::Gemm g{(const bf16*)(ws + WS_XG), (const bf16*)(ws + WS_W_MOEGU), 1024, 1024, 1024}; pg8::EpiSwiglu E{(bf16*)(ws + WS_HB), 512};
            pg8::gemm_phase<pg8::EpiSwiglu, MoeOrder>(F.lds + RING_OFF, g, S, E, F.tid);
            ENDSTEP(sb + 9);
        }
        STEP(sb + 10) if constexpr (EN(10)) { FRAME;
            LAUNDER_WS; moe_tables(F, layer);
            const LAS int* rowbase = (const LAS int*)(F.lds + LDSCTL_OFF + LC_MOE);
            MoeOrder S{__builtin_amdgcn_readfirstlane(rowbase[34]), 4, F.G, F.bid, (const LAS unsigned char*)(F.lds + LDSCTL_OFF + LC_MOE + 192), (size_t)1024 * 512 * 2};
            pg8::Gemm g{(const bf16*)(ws + WS_HB), (const bf16*)(ws + WS_W_MOED), 512, 512, 512}; pg8::EpiBf16 E{(bf16*)(ws + WS_Y2), 1024};
            pg8::gemm_phase<pg8::EpiBf16, MoeOrder>(F.lds + RING_OFF, g, S, E, F.tid);
            ENDSTEP(sb + 10);
        }
        STEP(sb + 11) if constexpr (EN(11)) { FRAME; phase_moe_combine(F, layer); ENDSTEP(sb + 11); }
        STEP(sb + 12) if constexpr (EN(12)) { FRAME;
            LAUNDER_WS; pg8::Gemm g{(const bf16*)(ws + WS_ABF), (const bf16*)(ws + WS_W_PLEG) + (size_t)layer * 1024 * 1024, 1024, 1024, 1024}; pg8::StaticOrder S; S.init(NTOK, 1024, F.G, F.bid);
            pg8::EpiPle E{kout(), (const bf16*)(ws + WS_PP), kin(I_PLE_BG) + layer * DM, 1024};
            pg8::gemm_phase<pg8::EpiPle, pg8::StaticOrder>(F.lds + RING_OFF, g, S, E, F.tid);
            ENDSTEP(sb + 12);
        }
    }
__global__ void __launch_bounds__(NWAVES * 64, 2) mega_fwd(KArgs ka) {
    extern __shared__ __attribute__((aligned(16))) unsigned char lds_raw[];
    const Args& args = ka.a;
    LAS unsigned char* const lds0 = (LAS unsigned char*)lds_raw;
    const int wave0 = __builtin_amdgcn_readfirstlane((int)threadIdx.x >> 6);
    for (int u = threadIdx.x; u < (LDS_BYTES - LDSCTL_OFF) / 4; u += NWAVES * 64) ((LAS unsigned*)(lds0 + LDSCTL_OFF))[u] = 0u;
    __syncthreads();
    XcdBarrier bar = xcd_barrier_post((unsigned*)(kws() + WS_CTL) + CW_BAR + ka.li * XCD_BAR_WORDS, (volatile LAS unsigned*)(lds0 + LDSCTL_OFF + LC_BARST));
    const int lo = args.ph_lo, hi = args.ph_hi;
    STEP(0) if constexpr (EN(13)) { FRAME; prologue_weights(F); ENDSTEP(0); }
    layer_body<0>(bar, lo, hi, lds0, wave0); layer_body<1>(bar, lo, hi, lds0, wave0); layer_body<2>(bar, lo, hi, lds0, wave0); layer_body<3>(bar, lo, hi, lds0, wave0);
#undef STEP
#undef ENDSTEP
}

#ifndef MK_MODE
#define MK_MODE 0
#endif
extern "C" void kernel_launch(void* const* d_in, const int* in_sizes, int n_in, void* d_out, int out_size, void* d_ws, size_t ws_size, hipStream_t stream) {
    static int ready = 0;
    if (ready == 0) {
        if (n_in != N_IN || out_size != NTOK * DM || ws_size < WS_END) { fprintf(stderr, "kernel_launch: unexpected shapes n_in %d out %d ws %zu (need %zu)\n", n_in, out_size, ws_size, (size_t)WS_END); ready = -1; return; }
        if (hipFuncSetAttribute((const void*)mega_fwd, hipFuncAttributeMaxDynamicSharedMemorySize, LDS_BYTES) != hipSuccess) { fprintf(stderr, "kernel_launch: hipFuncSetAttribute failed\n"); ready = -1; return; }
        int per_cu = 0; (void)hipOccupancyMaxActiveBlocksPerMultiprocessor(&per_cu, (const void*)mega_fwd, NWAVES * 64, LDS_BYTES); (void)hipGetLastError();
        ready = 1;
    }
    if (ready < 0) return;
    (void)hipMemsetAsync((char*)d_ws + WS_CTL, 0, CTL_ZERO_BYTES, stream);
    KArgs ka{};
    for (int i = 0; i < N_IN; ++i) ka.a.in[i] = (const float*)d_in[i];
    ka.a.out = (float*)d_out; ka.a.ws = (unsigned char*)d_ws; ka.li = 0; ka.pad = 0;
    const int grid = 256;
#if MK_MODE == 1
    ka.a.ph_lo = 0; ka.a.ph_hi = STEP_END;
    hipLaunchKernelGGL(mega_fwd, dim3(grid), dim3(NWAVES * 64), LDS_BYTES, stream, ka);
#else
    for (int s = 0; s < STEP_END; ++s) {
        if (s > 0) { const int k = (s - 1) % LSTEPS, layer = (s - 1) / LSTEPS; const bool even = (layer & 1) == 0;
            if (k > 12) continue; if (k == 5 && !even) continue; }
        ka.a.ph_lo = s; ka.a.ph_hi = s + 1;
        hipLaunchKernelGGL(mega_fwd, dim3(grid), dim3(NWAVES * 64), LDS_BYTES, stream, ka);
    }
#endif
}
```

```cpp
#include <hip/hip_runtime.h>
#include <cstdio>
#include <cstdint>
#define MK_MODE 1
namespace pg8 {
#define PG8_LAS __attribute__((address_space(3)))
typedef unsigned short bf16_t;
typedef short bf16x8 __attribute__((ext_vector_type(8)));
typedef float f32x4 __attribute__((ext_vector_type(4)));
typedef float f32x2 __attribute__((ext_vector_type(2)));
typedef unsigned u32x4 __attribute__((ext_vector_type(4)));
typedef unsigned u32x2 __attribute__((ext_vector_type(2)));
constexpr int BM = 256, BK = 64, HALF = 128, HTB = HALF * BK * 2  , STAGE_BYTES = 8 * HTB, NXCD = 8, WGM = 8;

__host__ __device__ __forceinline__ int lds_byte(int r, int c) { const int st = (r >> 4) * 2 + (c >> 5), rr = r & 15, cc = c & 31, ob = rr * 64 + cc * 2; return st * 1024 + (ob ^ (((ob >> 9) & 1) << 5)); }
__host__ __device__ __forceinline__ void stage_rc(int b, int& R, int& C) { const int st = b / 1024, sb = b % 1024, swz = sb ^ (((sb >> 9) & 1) << 5); R = (st >> 1) * 16 + swz / 64; C = (st & 1) * 32 + (swz % 64) / 2; }
__host__ __device__ __forceinline__ int perm32(int rho) { const int n = rho >> 4, i = rho & 15; return 8 * (i >> 2) + 4 * n + (i & 3); }

struct Unit { int pm, pn, aux; };
struct Gemm { const bf16_t* A; const bf16_t* Bt; int K, lda, ldb; };

struct StaticOrder {
    int nM, nN, nwg, G, c;
    __device__ void init(int M, int N, int G_, int c_) { nM = M / BM; nN = N / BM; nwg = nM * nN; G = G_; c = c_; }
    __device__ bool next(int i, Unit& u) const {
        const long L = (long)i * G + c; if (L >= nwg) return false;
        int wgid = (int)L; { const int q = nwg / NXCD, r = nwg % NXCD, xcd = wgid % NXCD, off = wgid / NXCD; wgid = (xcd < r ? xcd * (q + 1) : r * (q + 1) + (xcd - r) * q) + off; }
        const int nig = WGM * nN, gid = wgid / nig, fm = gid * WGM, gsz = (nM - fm) < WGM ? (nM - fm) : WGM;
        u.pm = fm + ((wgid % nig) % gsz); u.pn = (wgid % nig) / gsz; u.aux = 0; return true;
    }
    __device__ __forceinline__ const char* a_base(const Gemm& g, const Unit& u) const { return (const char*)g.A + (size_t)u.pm * BM * g.lda * 2; }
    __device__ __forceinline__ const char* b_base(const Gemm& g, const Unit& u) const { return (const char*)g.Bt + (size_t)u.pn * BM * g.ldb * 2; }
};

__device__ __forceinline__ unsigned cvt_pk_bf16(float lo, float hi) { unsigned r; asm volatile("v_cvt_pk_bf16_f32 %0, %1, %2" : "=v"(r) : "v"(lo), "v"(hi)); return r; }
__device__ __forceinline__ float bf_lo(unsigned w) { return __uint_as_float(w << 16); }
__device__ __forceinline__ float bf_hi(unsigned w) { return __uint_as_float(w & 0xffff0000u); }

struct EpiBf16 {
    static constexpr bool PERM = true;
    bf16_t* O; int ldc;
    __device__ __forceinline__ void operator()(const f32x4 (&acc)[2][2][4][2], const Unit& u, int wr, int wc, int fr, int fq) const {
        const int row0 = u.pm * BM + wr * 64 + fr; const int col0 = u.pn * BM + wc * 32 + 8 * fq;
#pragma unroll
        for (int ai = 0; ai < 2; ++ai)
#pragma unroll
            for (int m = 0; m < 4; ++m) { bf16_t* rowp = O + (size_t)(row0 + ai * HALF + m * 16) * ldc + col0;
#pragma unroll
                for (int bj = 0; bj < 2; ++bj) { const f32x4 v0 = acc[ai][bj][m][0], v1 = acc[ai][bj][m][1];
                    u32x4 w; w.x = cvt_pk_bf16(v0[0], v0[1]); w.y = cvt_pk_bf16(v0[2], v0[3]); w.z = cvt_pk_bf16(v1[0], v1[1]); w.w = cvt_pk_bf16(v1[2], v1[3]);
                    *(u32x4*)(rowp + bj * HALF) = w; } }
    }
};
struct EpiResAdd {
    static constexpr bool PERM = false;
    float* H; int ldc;
    __device__ __forceinline__ void operator()(const f32x4 (&acc)[2][2][4][2], const Unit& u, int wr, int wc, int fr, int fq) const {
        const int row0 = u.pm * BM + wr * 64 + fr; const int col0 = u.pn * BM + wc * 32 + 4 * fq;
#pragma unroll
        for (int ai = 0; ai < 2; ++ai)
#pragma unroll
            for (int m = 0; m < 4; ++m) { float* rowp = H + (size_t)(row0 + ai * HALF + m * 16) * ldc + col0;
#pragma unroll
                for (int bj = 0; bj < 2; ++bj)
#pragma unroll
                    for (int n = 0; n < 2; ++n) { f32x4* p = (f32x4*)(rowp + bj * HALF + n * 16); *p = *p + acc[ai][bj][m][n]; } }
    }
};
__device__ __forceinline__ float sigmoidf_(float x) { return 1.0f / (1.0f + __expf(-x)); }
struct EpiPle {
    static constexpr bool PERM = false;
    float* H; const bf16_t* PP; const float* bias; int ldc;
    __device__ __forceinline__ void operator()(const f32x4 (&acc)[2][2][4][2], const Unit& u, int wr, int wc, int fr, int fq) const {
        const int row0 = u.pm * BM + wr * 64 + fr; const int col0 = u.pn * BM + wc * 32 + 4 * fq;
#pragma unroll
        for (int ai = 0; ai < 2; ++ai)
#pragma unroll
            for (int m = 0; m < 4; ++m) { const size_t ro = (size_t)(row0 + ai * HALF + m * 16) * ldc + col0;
#pragma unroll
                for (int bj = 0; bj < 2; ++bj)
#pragma unroll
                    for (int n = 0; n < 2; ++n) { const int co = bj * HALF + n * 16; f32x4* p = (f32x4*)(H + ro + co); const u32x2 pw = *(const u32x2*)(PP + ro + co);
                        const f32x4 bv = *(const f32x4*)(bias + col0 + co); const f32x4 a = acc[ai][bj][m][n] + bv; f32x4 h = *p;
                        h[0] += sigmoidf_(a[0]) * bf_lo(pw.x); h[1] += sigmoidf_(a[1]) * bf_hi(pw.x); h[2] += sigmoidf_(a[2]) * bf_lo(pw.y); h[3] += sigmoidf_(a[3]) * bf_hi(pw.y); *p = h; } }
    }
};
struct EpiGlu {
    static constexpr bool PERM = true;
    bf16_t* O; int ldo; const bf16_t* HG; int ldh; const float* bias;
    __device__ __forceinline__ void operator()(const f32x4 (&acc)[2][2][4][2], const Unit& u, int wr, int wc, int fr, int fq) const {
        const int row0 = u.pm * BM + wr * 64 + fr; const int col0 = u.pn * BM + wc * 32 + 8 * fq;
#pragma unroll
        for (int ai = 0; ai < 2; ++ai)
#pragma unroll
            for (int m = 0; m < 4; ++m) { const size_t r = (size_t)(row0 + ai * HALF + m * 16);
#pragma unroll
                for (int bj = 0; bj < 2; ++bj) { const int c = col0 + bj * HALF; const u32x4 hw = *(const u32x4*)(HG + r * ldh + c);
                    const f32x4 b0 = *(const f32x4*)(bias + c), b1 = *(const f32x4*)(bias + c + 4); const f32x4 v0 = acc[ai][bj][m][0] + b0, v1 = acc[ai][bj][m][1] + b1;
                    u32x4 w; w.x = cvt_pk_bf16(bf_lo(hw.x) * sigmoidf_(v0[0]), bf_hi(hw.x) * sigmoidf_(v0[1])); w.y = cvt_pk_bf16(bf_lo(hw.y) * sigmoidf_(v0[2]), bf_hi(hw.y) * sigmoidf_(v0[3]));
                    w.z = cvt_pk_bf16(bf_lo(hw.z) * sigmoidf_(v1[0]), bf_hi(hw.z) * sigmoidf_(v1[1])); w.w = cvt_pk_bf16(bf_lo(hw.w) * sigmoidf_(v1[2]), bf_hi(hw.w) * sigmoidf_(v1[3]));
                    *(u32x4*)(O + r * ldo + c) = w; } }
    }
};
struct EpiSwiglu {
    static constexpr bool PERM = true;
    bf16_t* HB; int ldc;
    __device__ __forceinline__ void operator()(const f32x4 (&acc)[2][2][4][2], const Unit& u, int wr, int wc, int fr, int fq) const {
        const int row0 = u.pm * BM + wr * 64 + fr; const int col0 = u.pn * HALF + wc * 32 + 8 * fq;
#pragma unroll
        for (int ai = 0; ai < 2; ++ai)
#pragma unroll
            for (int m = 0; m < 4; ++m) { bf16_t* rowp = HB + (size_t)(row0 + ai * HALF + m * 16) * ldc + col0;
                const f32x4 g0 = acc[ai][0][m][0], g1 = acc[ai][0][m][1], u0 = acc[ai][1][m][0], u1 = acc[ai][1][m][1];
                u32x4 w; w.x = cvt_pk_bf16(g0[0] * sigmoidf_(g0[0]) * u0[0], g0[1] * sigmoidf_(g0[1]) * u0[1]); w.y = cvt_pk_bf16(g0[2] * sigmoidf_(g0[2]) * u0[2], g0[3] * sigmoidf_(g0[3]) * u0[3]);
                w.z = cvt_pk_bf16(g1[0] * sigmoidf_(g1[0]) * u1[0], g1[1] * sigmoidf_(g1[1]) * u1[1]); w.w = cvt_pk_bf16(g1[2] * sigmoidf_(g1[2]) * u1[2], g1[3] * sigmoidf_(g1[3]) * u1[3]);
                *(u32x4*)rowp = w; }
    }
};

template <class Epi, class Sched, bool ALIGN_EPI = true, bool SP2 = true>
__device__ __forceinline__ void gemm_phase(PG8_LAS unsigned char* lds, const Gemm g, const Sched& S, const Epi& E, const int tid) {
    const int wid = __builtin_amdgcn_readfirstlane(tid >> 6), lane = tid & 63, wr = wid >> 2, wc = wid & 3, fr = lane & 15, fq = lane >> 4;
    int K = g.K; asm volatile("" : "+s"(K));
    const int nt = K / BK;
    unsigned voffA[2], voffB[2];
#pragma unroll
    for (int i = 0; i < 2; ++i) { int R, C; stage_rc(tid * 16 + i * 8192, R, C); const int Rb = Epi::PERM ? ((R & ~31) + perm32(R & 31)) : R;
        voffA[i] = (unsigned)(R * g.lda + C) * 2u; voffB[i] = (unsigned)(Rb * g.ldb + C) * 2u; }
    const size_t kstep = (size_t)(BK * 2);
    const size_t hstepA = (size_t)HALF * g.lda * 2, hstepB = (size_t)HALF * g.ldb * 2;
    const unsigned ldsw = (unsigned)wid * 1024u;
    const int aoff = lds_byte(wr * 64 + fr, fq * 8), boff = lds_byte(wc * 32 + fr, fq * 8);
#define PG8_SA(b, h) (((b) * 2 + (h)) * HTB)
#define PG8_SB(b, h) ((4 + (b) * 2 + (h)) * HTB)
#define PG8_STAGE(bufoff, gbase, voff) do { _Pragma("unroll") for (int _i = 0; _i < 2; ++_i) \
        __builtin_amdgcn_global_load_lds((const unsigned*)((const char*)(gbase) + (voff)[_i]), (PG8_LAS unsigned*)(lds + (bufoff) + ldsw + _i * 8192), 16, 0, 0); } while (0)
#define PG8_LDA(dst, b, h) do { _Pragma("unroll") for (int m = 0; m < 4; ++m) _Pragma("unroll") for (int k = 0; k < 2; ++k) dst[m][k] = *(const PG8_LAS bf16x8*)(lds + PG8_SA(b, h) + aoff + m * 2048 + k * 1024); } while (0)
#define PG8_LDB(dst, b, h) do { _Pragma("unroll") for (int n = 0; n < 2; ++n) _Pragma("unroll") for (int k = 0; k < 2; ++k) dst[n][k] = *(const PG8_LAS bf16x8*)(lds + PG8_SB(b, h) + boff + n * 2048 + k * 1024); } while (0)
#define PG8_MMA(ai, bj, At, Bt) do { __builtin_amdgcn_s_setprio(1); _Pragma("unroll") for (int m = 0; m < 4; ++m) _Pragma("unroll") for (int n = 0; n < 2; ++n) _Pragma("unroll") for (int k = 0; k < 2; ++k) \
        acc[ai][bj][m][n] = __builtin_amdgcn_mfma_f32_16x16x32_bf16(Bt[n][k], At[m][k], acc[ai][bj][m][n], 0, 0, 0); __builtin_amdgcn_s_setprio(0); } while (0)
#define PG8_WAIT_V(n) asm volatile("s_waitcnt vmcnt(" #n ")" ::: "memory")
#define PG8_WAIT_L(n) asm volatile("s_waitcnt lgkmcnt(" #n ")" ::: "memory")
#define PG8_BAR __builtin_amdgcn_s_barrier()
#define PG8_SCHED __builtin_amdgcn_sched_barrier(0)
    Unit cur, nxt; int ui = 0;
    if (!S.next(0, cur)) return;
    f32x4 acc[2][2][4][2];
#pragma unroll
    for (int a = 0; a < 2; ++a)
#pragma unroll
        for (int b = 0; b < 2; ++b)
#pragma unroll
            for (int m = 0; m < 4; ++m)
#pragma unroll
                for (int n = 0; n < 2; ++n) acc[a][b][m][n] = (f32x4){0.f, 0.f, 0.f, 0.f};
    bf16x8 At[4][2], B0[2][2], B1[2][2];
    const char* cA = S.a_base(g, cur); const char* cB = S.b_base(g, cur);
    if constexpr (SP2) {
        PG8_STAGE(PG8_SB(0, 0), cB, voffB); PG8_STAGE(PG8_SB(0, 1), cB + hstepB, voffB); PG8_STAGE(PG8_SA(0, 0), cA, voffA); PG8_STAGE(PG8_SA(0, 1), cA + hstepA, voffA);
        if (wr == 1) PG8_BAR;
        PG8_WAIT_V(2); PG8_BAR;
        PG8_STAGE(PG8_SB(1, 0), cB + kstep, voffB); PG8_STAGE(PG8_SA(1, 0), cA + kstep, voffA); PG8_STAGE(PG8_SB(1, 1), cB + hstepB + kstep, voffB);
        PG8_WAIT_V(6); PG8_BAR;
    } else {
        PG8_STAGE(PG8_SB(0, 0), cB, voffB); PG8_STAGE(PG8_SA(0, 0), cA, voffA); PG8_STAGE(PG8_SB(0, 1), cB + hstepB, voffB); PG8_STAGE(PG8_SA(0, 1), cA + hstepA, voffA);
        if (wr == 1) PG8_BAR;
        PG8_WAIT_V(4); PG8_BAR;
        PG8_STAGE(PG8_SB(1, 0), cB + kstep, voffB); PG8_STAGE(PG8_SA(1, 0), cA + kstep, voffA); PG8_STAGE(PG8_SB(1, 1), cB + hstepB + kstep, voffB);
        PG8_WAIT_V(6); PG8_BAR;
    }
    for (;;) {
        const bool has_next = S.next(ui + 1, nxt);
        const char* nA = has_next ? S.a_base(g, nxt) : cA; const char* nB = has_next ? S.b_base(g, nxt) : cB;
        for (int t = 0; t < nt; t += 2) {
            const bool last = (t == nt - 2);
            const char* a1 = cA + (size_t)(t + 1) * kstep;
            const char* a2 = last ? nA : cA + (size_t)(t + 2) * kstep; const char* b2 = last ? nB : cB + (size_t)(t + 2) * kstep;
            const char* a3 = a2 + kstep; const char* b3 = b2 + kstep;
            if constexpr (SP2) {
            PG8_LDB(B0, 0, 0); PG8_LDB(B1, 0, 1); PG8_SCHED; PG8_LDA(At, 0, 0); PG8_STAGE(PG8_SA(1, 1), a1 + hstepA, voffA);
            PG8_WAIT_V(8); PG8_WAIT_L(0); PG8_BAR; PG8_MMA(0, 0, At, B0); PG8_MMA(0, 1, At, B1); PG8_BAR; PG8_SCHED;
            PG8_LDA(At, 0, 1); PG8_STAGE(PG8_SB(0, 0), b2, voffB); PG8_STAGE(PG8_SB(0, 1), b2 + hstepB, voffB); PG8_STAGE(PG8_SA(0, 0), a2, voffA);
            PG8_WAIT_V(8); PG8_WAIT_L(0); PG8_BAR; PG8_MMA(1, 0, At, B0); PG8_MMA(1, 1, At, B1); PG8_BAR; PG8_SCHED;
            PG8_LDB(B0, 1, 0); PG8_LDB(B1, 1, 1); PG8_SCHED; PG8_LDA(At, 1, 0); PG8_STAGE(PG8_SA(0, 1), a2 + hstepA, voffA);
            PG8_WAIT_V(8); PG8_WAIT_L(0); PG8_BAR; PG8_MMA(0, 0, At, B0); PG8_MMA(0, 1, At, B1); PG8_BAR; PG8_SCHED;
            PG8_LDA(At, 1, 1); PG8_STAGE(PG8_SB(1, 0), b3, voffB); PG8_STAGE(PG8_SB(1, 1), b3 + hstepB, voffB); PG8_STAGE(PG8_SA(1, 0), a3, voffA);
            PG8_WAIT_V(8); PG8_WAIT_L(0); PG8_BAR; PG8_MMA(1, 0, At, B0); PG8_MMA(1, 1, At, B1); PG8_BAR; PG8_SCHED;
            } else {
            PG8_LDB(B0, 0, 0); PG8_SCHED; PG8_LDA(At, 0, 0); PG8_STAGE(PG8_SA(1, 1), a1 + hstepA, voffA);
            PG8_WAIT_L(8); PG8_BAR; PG8_WAIT_L(0); PG8_MMA(0, 0, At, B0); PG8_BAR; PG8_SCHED;
            PG8_LDB(B1, 0, 1); PG8_STAGE(PG8_SB(0, 0), b2, voffB);
            PG8_BAR; PG8_WAIT_L(0); PG8_MMA(0, 1, At, B1); PG8_BAR;
            PG8_LDA(At, 0, 1); PG8_STAGE(PG8_SA(0, 0), a2, voffA);
            PG8_BAR; PG8_WAIT_L(0); PG8_MMA(1, 0, At, B0); PG8_BAR; PG8_SCHED;
            PG8_STAGE(PG8_SB(0, 1), b2 + hstepB, voffB);
            PG8_WAIT_V(6); PG8_BAR; PG8_MMA(1, 1, At, B1); PG8_BAR;
            PG8_LDB(B0, 1, 0); PG8_SCHED; PG8_LDA(At, 1, 0); PG8_STAGE(PG8_SA(0, 1), a2 + hstepA, voffA);
            PG8_WAIT_L(8); PG8_BAR; PG8_WAIT_L(0); PG8_MMA(0, 0, At, B0); PG8_BAR; PG8_SCHED;
            PG8_LDB(B1, 1, 1); PG8_STAGE(PG8_SB(1, 0), b3, voffB);
            PG8_BAR; PG8_WAIT_L(0); PG8_MMA(0, 1, At, B1); PG8_BAR;
            PG8_LDA(At, 1, 1); PG8_STAGE(PG8_SA(1, 0), a3, voffA);
            PG8_BAR; PG8_WAIT_L(0); PG8_MMA(1, 0, At, B0); PG8_BAR; PG8_SCHED;
            PG8_STAGE(PG8_SB(1, 1), b3 + hstepB, voffB);
            PG8_WAIT_V(6); PG8_BAR; PG8_MMA(1, 1, At, B1); PG8_BAR;
            }
        }
        if constexpr (ALIGN_EPI) { if (wr == 0) PG8_BAR; }
        E(acc, cur, wr, wc, fr, fq);
        if (!has_next) break;
#pragma unroll
        for (int a = 0; a < 2; ++a)
#pragma unroll
            for (int b = 0; b < 2; ++b)
#pragma unroll
                for (int m = 0; m < 4; ++m)
#pragma unroll
                    for (int n = 0; n < 2; ++n) acc[a][b][m][n] = (f32x4){0.f, 0.f, 0.f, 0.f};
        cur = nxt; cA = nA; cB = nB; ++ui;
        if constexpr (ALIGN_EPI) { if (wr == 1) PG8_BAR; }
    }
    PG8_WAIT_V(0);
    if constexpr (!ALIGN_EPI) { if (wr == 0) PG8_BAR; }
    PG8_BAR;
#undef PG8_SA
#undef PG8_SB
#undef PG8_STAGE
#undef PG8_LDA
#undef PG8_LDB
#undef PG8_MMA
#undef PG8_WAIT_V
#undef PG8_WAIT_L
#undef PG8_BAR
#undef PG8_SCHED
}
}
#define LAS __attribute__((address_space(3)))
#define XB_TMO      128
#define XB_XCNT(j)  (256  + 64 * (j))
#define XB_XSUB(j)  (1280 + 64 * (j))
#define XB_XGEN(j)  (2304 + 64 * (j))
#define XB_TOP      3328
#define XB_TOPGEN   3392
#define XCD_BAR_WORDS 3456
#define XB_SPIN_CAP (1u << 22)

__device__ __forceinline__ unsigned xb_ld(unsigned* p)              { return __hip_atomic_load(p, __ATOMIC_RELAXED, __HIP_MEMORY_SCOPE_AGENT); }
__device__ __forceinline__ unsigned xb_add(unsigned* p, unsigned v) { return __hip_atomic_fetch_add(p, v, __ATOMIC_RELAXED, __HIP_MEMORY_SCOPE_AGENT); }
__device__ __forceinline__ unsigned xb_xcc_id() { return (unsigned)__builtin_amdgcn_s_getreg((3 << 11) | 20) & 0xFu; }
#define XB_SPIN(cond, bar) do { unsigned _sp = 0; while (cond) { __builtin_amdgcn_s_sleep(1); \
    if ((++_sp & 255u) == 0u) { if (xb_ld(&(bar)[XB_TMO])) break; if (_sp > XB_SPIN_CAP) { atomicAdd(&(bar)[XB_TMO], 1u); break; } } } } while (0)

struct XcdBarrier {
    unsigned* bar; unsigned x;
    volatile LAS unsigned* st;
};

__device__ __forceinline__ XcdBarrier xcd_barrier_post(unsigned* bar, volatile LAS unsigned* st) {
    XcdBarrier b; b.bar = bar; b.x = xb_xcc_id(); b.st = st;
    if (threadIdx.x == 0) (void)xb_add(&bar[XB_XCNT(b.x)], 1u);
    return b;
}
__device__ __forceinline__ void xcd_barrier_complete(unsigned* bar, unsigned x, unsigned& nloc, unsigned& nx) {
    const unsigned G = gridDim.x * gridDim.y * gridDim.z;
    unsigned sum, cnt, mine, sp = 0u;
    for (;;) {
        sum = 0u; cnt = 0u; mine = 0u;
#pragma unroll
        for (unsigned j = 0; j < 16; ++j) { const unsigned c = xb_ld(&bar[XB_XCNT(j)]); sum += c; cnt += (c > 0u) ? 1u : 0u; mine = (j == x) ? c : mine; }
        if (sum == G) break;
        __builtin_amdgcn_s_sleep(1);
        if ((++sp & 255u) == 0u) { if (xb_ld(&bar[XB_TMO])) break; if (sp > XB_SPIN_CAP) { atomicAdd(&bar[XB_TMO], 1u); break; } }
    }
    nloc = mine > 0u ? mine : 1u; nx = cnt > 0u ? cnt : 1u;
}

__device__ __forceinline__ void xcd_barrier(const XcdBarrier& b) {
    asm volatile("s_waitcnt vmcnt(0)" ::: "memory");
    __syncthreads();
    if (threadIdx.x == 0) {
        unsigned* bar = b.bar;
        __builtin_amdgcn_s_waitcnt(0);
        unsigned nloc = b.st[0], nx = b.st[1];
        if (nloc == 0u) { xcd_barrier_complete(bar, b.x, nloc, nx); b.st[0] = nloc; b.st[1] = nx; }
        const unsigned old = xb_add(&bar[XB_XSUB(b.x)], 1u);
        const unsigned gen = old / nloc;
        if (old + 1u == (gen + 1u) * nloc) {
            __builtin_amdgcn_fence(__ATOMIC_RELEASE, "agent");
            asm volatile("s_waitcnt vmcnt(0)" ::: "memory");
            const unsigned og = xb_add(&bar[XB_TOP], 1u);
            const unsigned tg = og / nx;
            if (og + 1u == (tg + 1u) * nx) xb_add(&bar[XB_TOPGEN], 1u);
            else XB_SPIN(xb_ld(&bar[XB_TOPGEN]) == tg, bar);
            __builtin_amdgcn_fence(__ATOMIC_ACQUIRE, "agent");
            xb_add(&bar[XB_XGEN(b.x)], 1u);
            asm volatile("s_waitcnt vmcnt(0)" ::: "memory");
        } else {
            XB_SPIN(xb_ld(&bar[XB_XGEN(b.x)]) == gen, bar);
            __builtin_amdgcn_fence(__ATOMIC_ACQUIRE, "agent");
            asm volatile("s_waitcnt vmcnt(0)" ::: "memory");
        }
    }
    __syncthreads();
}
#undef LAS
constexpr int NWAVES = 8;
constexpr int BATCH = 2, SEQ = 16384, NTOK = BATCH * SEQ, DM = 1024, DEPTH = 4, PLE = 256;
constexpr int EVEN_IN = 2216, EVEN_INP = 2304, ODD_IN = 2568, ODD_INP = 2816;
constexpr int E_FQ = 0, E_FK = 512, E_FV = 1024, E_FLOG = 1536, E_CQ = 1544, E_CKV = 1928, E_KROPE = 2184;
constexpr int O_U = 0, O_Q = 512, O_K = 1024, O_V = 1536, O_GIN = 2048, O_BETA = 2052, O_Z = 2056;
constexpr float RMS_EPS = 1e-6f;
constexpr float LOG2E = 1.4426950408889634f, LN2 = 0.6931471805599453f;
constexpr float C2_FOX = 0.125f * LOG2E, C2_MLA = 0.10206207261596575f * LOG2E;
constexpr int MOE_CAP = 65536 + 32 * 256;
constexpr int MOE_MAXT = MOE_CAP / 256;

enum { I_X = 0, I_P, I_POS, I_NORM_MIX, I_NORM_FFN, I_EV_W_IN, I_FOX_BF, I_FOX_QN, I_FOX_KN, I_MLA_QAN, I_MLA_WQUP, I_MLA_KVAN, I_MLA_WKVUP, I_MLA_QN, I_MLA_KN, I_EV_W_OUT,
       I_OD_W_IN, I_S5_ARE, I_S5_AIM, I_S5_BRE, I_S5_BIM, I_S5_CRE, I_S5_CIM, I_S5_D, I_S5_LS, I_S5_WGLU, I_S5_BGLU, I_GDN_CONV, I_GDN_ALOG, I_GDN_DTB, I_GDN_ONORM, I_OD_W_OUT,
       I_MOE_WGRP, I_MOE_BGRP, I_MOE_WEXP, I_MOE_BEXP, I_MOE_WG, I_MOE_WU, I_MOE_WD, I_PLE_WP, I_PLE_NORM, I_PLE_WG, I_PLE_BG, N_IN };

constexpr size_t MiB = 1u << 20;
constexpr size_t WS_CTL = 0, CTL_ZERO_BYTES = 1 * MiB;
constexpr size_t WS_W_EVIN = 4 * MiB;
constexpr size_t WS_W_ODIN = WS_W_EVIN + 9 * MiB;
constexpr size_t WS_W_QUP = WS_W_ODIN + 11 * MiB;
constexpr size_t WS_W_KVUP = WS_W_QUP + 2 * MiB;
constexpr size_t WS_W_EVOUT = WS_W_KVUP + 1 * MiB;
constexpr size_t WS_W_ODOUT = WS_W_EVOUT + 4 * MiB;
constexpr size_t WS_W_GLU = WS_W_ODOUT + 4 * MiB;
constexpr size_t WS_W_PLEP = WS_W_GLU + 1 * MiB;
constexpr size_t WS_W_PLEG = WS_W_PLEP + 2 * MiB;
constexpr size_t WS_W_MOEGU = WS_W_PLEG + 8 * MiB;
constexpr size_t WS_W_MOED = WS_W_MOEGU + 64 * MiB;
constexpr size_t WS_ABF = WS_W_MOED + 32 * MiB;
constexpr size_t WS_PP = WS_ABF + 64 * MiB;
constexpr size_t WS_PBF = WS_PP + 64 * MiB;
constexpr size_t WS_PROJ = WS_PBF + 16 * MiB;
constexpr size_t WS_MIX = WS_PROJ + 176 * MiB;
constexpr size_t WS_R1 = WS_MIX + 64 * MiB;
constexpr size_t WS_QM = WS_R1, WS_KVB = WS_QM + 48 * MiB, WS_KM = WS_KVB + 64 * MiB, WS_CQN = WS_KM + 48 * MiB, WS_CKVN = WS_CQN + 24 * MiB, WS_LOGF = WS_CKVN + 16 * MiB, WS_CUM = WS_LOGF + 1 * MiB;
constexpr size_t WS_HG = WS_R1, WS_QG = WS_HG + 32 * MiB, WS_KG = WS_QG + 64 * MiB, WS_VG = WS_KG + 64 * MiB, WS_OG = WS_VG + 64 * MiB;
constexpr size_t WS_R2 = WS_R1 + 288 * MiB;
constexpr size_t WS_GB = WS_R2, WS_BETA = WS_GB + 1 * MiB;
constexpr size_t WS_TOKE = WS_R2 + 2 * MiB, WS_TOKW = WS_TOKE + 1 * MiB, WS_ROWS = WS_TOKW + 1 * MiB;
constexpr size_t WS_XG = WS_R1;
constexpr size_t WS_HB = WS_XG + 144 * MiB;
constexpr size_t WS_Y2 = WS_R2 + 8 * MiB;
constexpr size_t WS_END = WS_Y2 + 144 * MiB;
static_assert(WS_HB + 72 * MiB <= WS_R2, "moe overlay");
static_assert(WS_OG + 64 * MiB <= WS_R2, "odd overlay");
static_assert(WS_END <= 1100 * MiB, "workspace budget");

constexpr int CW_BAR = 4096;
constexpr int CW_CNT = 1024;

constexpr int RING_OFF = 0, RING_BYTES = 131072;
constexpr int LDSCTL_OFF = RING_BYTES;
constexpr int LDS_BYTES = 147456;
constexpr int LC_BARST = 32;
constexpr int LC_MOE = 256;

#define GAS __attribute__((address_space(1)))
#define LAS __attribute__((address_space(3)))
typedef unsigned short bf16;
typedef unsigned v4u __attribute__((ext_vector_type(4)));
typedef unsigned v2u __attribute__((ext_vector_type(2)));
typedef float f32x4 __attribute__((ext_vector_type(4)));
#define LDS_WAIT() asm volatile("s_waitcnt lgkmcnt(0)" ::: "memory")
#define VM_WAIT() asm volatile("s_waitcnt vmcnt(0)" ::: "memory")
__device__ __forceinline__ unsigned f2bf(float f) { unsigned u = __builtin_bit_cast(unsigned, f); return (u + 0x7fffu + ((u >> 16) & 1u)) >> 16; }
__device__ __forceinline__ unsigned pk2(float lo, float hi) { return f2bf(lo) | (f2bf(hi) << 16); }
__device__ __forceinline__ float bflo(unsigned w) { return __uint_as_float(w << 16); }
__device__ __forceinline__ float bfhi(unsigned w) { return __uint_as_float(w & 0xffff0000u); }
__device__ __forceinline__ float bf2f(bf16 h) { return __uint_as_float((unsigned)h << 16); }
__device__ __forceinline__ float wave_sum(float v) {
#pragma unroll
    for (int o = 1; o < 64; o <<= 1) v += __shfl_xor(v, o);
    return v;
}
__device__ __forceinline__ float sigm(float x) { return 1.0f / (1.0f + expf(-x)); }
__device__ __forceinline__ float softplusf_(float x) { return fmaxf(x, 0.f) + log1pf(expf(-fabsf(x))); }
__device__ __forceinline__ float gelu_tanh(float x) { return 0.5f * x * (1.0f + tanhf(0.7978845608028654f * (x + 0.044715f * x * x * x))); }

struct Args { const float* in[N_IN]; float* out; unsigned char* ws; int ph_lo, ph_hi; };
#define CAS __attribute__((address_space(4)))
__device__ __forceinline__ const float* kin(int i) { asm volatile("" : "+s"(i)); const CAS char* kp = (const CAS char*)__builtin_amdgcn_kernarg_segment_ptr(); return *(const float* const CAS*)(kp + 8 * i); }
__device__ __forceinline__ float* kout() { int i = N_IN; asm volatile("" : "+s"(i)); const CAS char* kp = (const CAS char*)__builtin_amdgcn_kernarg_segment_ptr(); return *(float* const CAS*)(kp + 8 * i); }
__device__ __forceinline__ unsigned char* kws() { int i = N_IN + 1; asm volatile("" : "+s"(i)); const CAS char* kp = (const CAS char*)__builtin_amdgcn_kernarg_segment_ptr(); return *(unsigned char* const CAS*)(kp + 8 * i); }

struct Frame {
    LAS unsigned char* lds;
    unsigned char* ws;
    unsigned* ctl;
    int tid, lane, wave, G, bid;
};

__device__ __forceinline__ void transpose_item(const float* W, int K, int N, bf16* WT, int drow0, LAS float* scr, int k0, int n0, int lane) {
    const int nn = n0 + (lane & 31); const bool ok = nn < N;
#pragma unroll 8
    for (int i = 0; i < 32; ++i) { const int kk = 2 * i + (lane >> 5); scr[kk * 33 + (lane & 31)] = ok ? W[(size_t)(k0 + kk) * N + nn] : 0.f; }
    LDS_WAIT(); asm volatile("" ::: "memory");
    const int c = lane & 7;
#pragma unroll
    for (int j = 0; j < 4; ++j) { const int n = (lane >> 3) + 8 * j; const LAS float* s = scr + (8 * c) * 33 + n;
        v4u o; o.x = pk2(s[0 * 33], s[1 * 33]); o.y = pk2(s[2 * 33], s[3 * 33]); o.z = pk2(s[4 * 33], s[5 * 33]); o.w = pk2(s[6 * 33], s[7 * 33]);
        *(v4u*)(WT + (size_t)(drow0 + n) * K + k0 + 8 * c) = o; }
    LDS_WAIT(); asm volatile("" ::: "memory");
}
__device__ __forceinline__ void transpose_set(Frame& F, const float* W, int nmat, int K, int N, int NP, bf16* WT, int& itbase) {
    LAS float* scr = (LAS float*)(F.lds + RING_OFF + F.wave * 16384);
    const int gw = F.bid * NWAVES + F.wave, NGW = F.G * NWAVES;
    const int nkb = K / 64, nnb = NP / 32, per = nkb * nnb, total = nmat * per;
    int first = (gw - (itbase % NGW) + NGW) % NGW;
    for (int it = first; it < total; it += NGW) { const int mi = it / per, r = it % per, kb = r / nnb, nb = r % nnb;
        transpose_item(W + (size_t)mi * K * N, K, N, WT + (size_t)mi * NP * K, nb * 32, scr, kb * 64, nb * 32, F.lane); }
    itbase += total;
}
__device__ __forceinline__ void prologue_weights(Frame& F) {
 int itb = 0;
    transpose_set(F, kin(I_EV_W_IN), 2, 1024, EVEN_IN, EVEN_INP, (bf16*)(F.ws + WS_W_EVIN), itb);
    transpose_set(F, kin(I_OD_W_IN), 2, 1024, ODD_IN, ODD_INP, (bf16*)(F.ws + WS_W_ODIN), itb);
    transpose_set(F, kin(I_MLA_WQUP), 2, 384, 768, 768, (bf16*)(F.ws + WS_W_QUP), itb);
    transpose_set(F, kin(I_MLA_WKVUP), 2, 256, 1024, 1024, (bf16*)(F.ws + WS_W_KVUP), itb);
    transpose_set(F, kin(I_EV_W_OUT), 2, 1024, 1024, 1024, (bf16*)(F.ws + WS_W_EVOUT), itb);
    transpose_set(F, kin(I_OD_W_OUT), 2, 1024, 1024, 1024, (bf16*)(F.ws + WS_W_ODOUT), itb);
    transpose_set(F, kin(I_S5_WGLU), 2, 512, 512, 512, (bf16*)(F.ws + WS_W_GLU), itb);
    transpose_set(F, kin(I_PLE_WP), 4, 256, 1024, 1024, (bf16*)(F.ws + WS_W_PLEP), itb);
    transpose_set(F, kin(I_PLE_WG), 4, 1024, 1024, 1024, (bf16*)(F.ws + WS_W_PLEG), itb);
}
__device__ __forceinline__ void moe_weights(Frame& F, int layer) {

    LAS float* scr = (LAS float*)(F.lds + RING_OFF + F.wave * 16384);
    const int gw = F.bid * NWAVES + F.wave, NGW = F.G * NWAVES;
    const float* wg = kin(I_MOE_WG) + (size_t)layer * 32 * 1024 * 512; const float* wu = kin(I_MOE_WU) + (size_t)layer * 32 * 1024 * 512; const float* wd = kin(I_MOE_WD) + (size_t)layer * 32 * 512 * 1024;
    bf16* WGU = (bf16*)(F.ws + WS_W_MOEGU); bf16* WD = (bf16*)(F.ws + WS_W_MOED);
    for (int it = gw; it < 2 * 32 * 256; it += NGW) { const int which = it / (32 * 256), r0 = it % (32 * 256), e = r0 / 256, r = r0 % 256, kb = r / 16, nb = r % 16, n0 = nb * 32;
        const int drow = 256 * (n0 / 128) + (n0 % 128) + which * 128;
        transpose_item((which ? wu : wg) + (size_t)e * 1024 * 512, 1024, 512, WGU + (size_t)e * 1024 * 1024, drow, scr, kb * 64, n0, F.lane); }
    for (int it = gw; it < 32 * 256; it += NGW) { const int e = it / 256, r = it % 256, kb = r / 32, nb = r % 32;
        transpose_item(wd + (size_t)e * 512 * 1024, 512, 1024, WD + (size_t)e * 1024 * 512, nb * 32, scr, kb * 64, nb * 32, F.lane); }
}

__device__ __forceinline__ void rms_row_to_bf16(const float* xrow, const float* gain, bf16* orow, float* copy, int lane) {
    const f32x4* xr = (const f32x4*)xrow + lane; f32x4 v[4]; float s = 0.f;
#pragma unroll
    for (int j = 0; j < 4; ++j) { v[j] = xr[64 * j]; s += (v[j].x * v[j].x + v[j].y * v[j].y) + (v[j].z * v[j].z + v[j].w * v[j].w); }
    const float r = 1.0f / sqrtf(wave_sum(s) * (1.f / 1024.f) + RMS_EPS);
    if (copy) {
#pragma unroll
        for (int j = 0; j < 4; ++j) ((f32x4*)copy + lane)[64 * j] = v[j]; }
    unsigned long long* o8 = (unsigned long long*)orow + lane;
#pragma unroll
    for (int j = 0; j < 4; ++j) { const f32x4 g = ((const f32x4*)gain + lane)[64 * j];
        o8[64 * j] = (unsigned long long)pk2(v[j].x * r * g.x, v[j].y * r * g.y) | ((unsigned long long)pk2(v[j].z * r * g.z, v[j].w * r * g.w) << 32); }
}
__device__ __forceinline__ void phase_norm(Frame& F, const float* src, const float* gain, float* copy) {
    bf16* ABF = (bf16*)(F.ws + WS_ABF);
    const int gw = F.bid * NWAVES + F.wave, NGW = F.G * NWAVES;
    for (int m = gw; m < NTOK; m += NGW) rms_row_to_bf16(src + (size_t)m * DM, gain, ABF + (size_t)m * DM, copy ? copy + (size_t)m * DM : nullptr, F.lane);
}
__device__ __forceinline__ void phase_pconv(Frame& F, int layer) {
    const float* p = kin(I_P) + (size_t)layer * NTOK * PLE; bf16* PBF = (bf16*)(F.ws + WS_PBF);
    const size_t n4 = (size_t)NTOK * PLE / 4; const size_t gt = (size_t)F.bid * 512 + F.tid, NT = (size_t)F.G * 512;
    for (size_t i = gt; i < n4; i += NT) { const f32x4 v = ((const f32x4*)p)[i]; v2u o; o.x = pk2(v.x, v.y); o.y = pk2(v.z, v.w); ((v2u*)PBF)[i] = o; }
}

__device__ __forceinline__ void phase_even_post(Frame& F, int j) {

    bf16* PROJ = (bf16*)(F.ws + WS_PROJ); bf16* CQN = (bf16*)(F.ws + WS_CQN); bf16* CKVN = (bf16*)(F.ws + WS_CKVN); float* LOGF = (float*)(F.ws + WS_LOGF);
    const float* qn = kin(I_FOX_QN) + j * 64; const float* kn = kin(I_FOX_KN) + j * 64; const float* bfv = kin(I_FOX_BF) + j * 8;
    const float* qan = kin(I_MLA_QAN) + j * 384; const float* kvan = kin(I_MLA_KVAN) + j * 256;
    const int gw = F.bid * NWAVES + F.wave, NGW = F.G * NWAVES, lane = F.lane;
    for (int m = gw; m < NTOK; m += NGW) {
        bf16* row = PROJ + (size_t)m * EVEN_INP;
#pragma unroll
        for (int w = 0; w < 2; ++w) {
            v4u* p = (v4u*)(row + (w ? E_FK : E_FQ)) + lane; const v4u x = *p;
            float f[8] = {bflo(x.x), bfhi(x.x), bflo(x.y), bfhi(x.y), bflo(x.z), bfhi(x.z), bflo(x.w), bfhi(x.w)};
            float s = 0.f;
#pragma unroll
            for (int i = 0; i < 8; ++i) s += f[i] * f[i];
            s += __shfl_xor(s, 1); s += __shfl_xor(s, 2); s += __shfl_xor(s, 4);
            const float r = (1.0f / sqrtf(s * (1.f / 64.f) + RMS_EPS)) * (w ? 1.0f : C2_FOX); const float* g = (w ? kn : qn) + (lane & 7) * 8;
            v4u o; o.x = pk2(f[0] * r * g[0], f[1] * r * g[1]); o.y = pk2(f[2] * r * g[2], f[3] * r * g[3]); o.z = pk2(f[4] * r * g[4], f[5] * r * g[5]); o.w = pk2(f[6] * r * g[6], f[7] * r * g[7]);
            *p = o;
        }
        if (lane < 8) { const float z = bf2f(row[E_FLOG + lane]) + bfv[lane]; LOGF[(size_t)m * 8 + lane] = -softplusf_(-z); }
        {
            float f[6]; float s = 0.f;
#pragma unroll
            for (int i = 0; i < 3; ++i) { const unsigned x = *((const unsigned*)(row + E_CQ) + lane + 64 * i); f[2 * i] = bflo(x); f[2 * i + 1] = bfhi(x); s += f[2 * i] * f[2 * i] + f[2 * i + 1] * f[2 * i + 1]; }
            const float r = 1.0f / sqrtf(wave_sum(s) * (1.f / 384.f) + RMS_EPS);
#pragma unroll
            for (int i = 0; i < 3; ++i) { const int c = 2 * (lane + 64 * i); *((unsigned*)(CQN + (size_t)m * 384) + lane + 64 * i) = pk2(f[2 * i] * r * qan[c], f[2 * i + 1] * r * qan[c + 1]); }
        }
        {
            float f[4]; float s = 0.f;
#pragma unroll
            for (int i = 0; i < 2; ++i) { const unsigned x = *((const unsigned*)(row + E_CKV) + lane + 64 * i); f[2 * i] = bflo(x); f[2 * i + 1] = bfhi(x); s += f[2 * i] * f[2 * i] + f[2 * i + 1] * f[2 * i + 1]; }
            const float r = 1.0f / sqrtf(wave_sum(s) * (1.f / 256.f) + RMS_EPS);
#pragma unroll
            for (int i = 0; i < 2; ++i) { const int c = 2 * (lane + 64 * i); *((unsigned*)(CKVN + (size_t)m * 256) + lane + 64 * i) = pk2(f[2 * i] * r * kvan[c], f[2 * i + 1] * r * kvan[c + 1]); }
        }
    }
}
__device__ __forceinline__ void phase_cumsum(Frame& F) {
    if (F.bid >= 16) return;
    const float* LOGF = (const float*)(F.ws + WS_LOGF); float* CUM = (float*)(F.ws + WS_CUM);
    const int b = F.bid >> 3, h = F.bid & 7, t0 = F.tid * 32;
    LAS double* part = (LAS double*)(F.lds + RING_OFF);
    float v[32]; double s = 0.0;
#pragma unroll
    for (int i = 0; i < 32; ++i) { v[i] = LOGF[((size_t)b * SEQ + t0 + i) * 8 + h]; s += (double)v[i]; }
    part[F.tid] = s; __syncthreads();
    if (F.tid == 0) { double run = 0.0; for (int i = 0; i < 512; ++i) { const double x = part[i]; part[i] = run; run += x; } }
    __syncthreads();
    double run = part[F.tid];
#pragma unroll
    for (int i = 0; i < 32; ++i) { run += (double)v[i]; CUM[((size_t)b * SEQ + t0 + i) * 8 + h] = (float)run; }
    __syncthreads();
}
__device__ __forceinline__ void phase_mla_post(Frame& F, int j) {

    const bf16* PROJ = (const bf16*)(F.ws + WS_PROJ); bf16* QM = (bf16*)(F.ws + WS_QM); const bf16* KVB = (const bf16*)(F.ws + WS_KVB); bf16* KM = (bf16*)(F.ws + WS_KM);
    const float* qn = kin(I_MLA_QN) + j * 96; const float* kn = kin(I_MLA_KN) + j * 96; const int* pos = (const int*)kin(I_POS);
    const int gw = F.bid * NWAVES + F.wave, NGW = F.G * NWAVES, lane = F.lane, l32 = lane & 31, hh = lane >> 5;
    const int fi = l32 & 15; const float inv = expf(-(float)fi * (1.0f / 16.0f) * 9.210340371976184f);
    for (int m = gw; m < NTOK; m += NGW) {
        const float ang = (float)pos[m] * inv; float sn, cs; sincosf(ang, &sn, &cs);
        const float krope = bf2f(PROJ[(size_t)m * EVEN_INP + E_KROPE + l32]);
#pragma unroll
        for (int hp = 0; hp < 4; ++hp) { const int h = hp * 2 + hh;
#pragma unroll
            for (int w = 0; w < 2; ++w) {
                float f[3];
                if (w == 0) { const bf16* q = QM + (size_t)m * 768 + h * 96; f[0] = bf2f(q[l32]); f[1] = bf2f(q[l32 + 32]); f[2] = bf2f(q[l32 + 64]); }
                else { const bf16* k = KVB + (size_t)m * 1024 + h * 128; f[0] = bf2f(k[l32]); f[1] = bf2f(k[l32 + 32]); f[2] = krope; }
                float s = f[0] * f[0] + f[1] * f[1] + f[2] * f[2];
                s += __shfl_xor(s, 1); s += __shfl_xor(s, 2); s += __shfl_xor(s, 4); s += __shfl_xor(s, 8); s += __shfl_xor(s, 16);
                const float r = 1.0f / sqrtf(s * (1.f / 96.f) + RMS_EPS); const float* g = w ? kn : qn;
                f[0] *= r * g[l32]; f[1] *= r * g[l32 + 32]; f[2] *= r * g[l32 + 64];
                const float other = __shfl_xor(f[2], 16);
                const float rot = (l32 < 16) ? (f[2] * cs - other * sn) : (other * sn + f[2] * cs);
                bf16* o = (w ? KM : QM) + (size_t)m * 768 + h * 96; const float qs = w ? 1.0f : C2_MLA;
                o[l32] = (bf16)f2bf(f[0] * qs); o[l32 + 32] = (bf16)f2bf(f[1] * qs); o[l32 + 64] = (bf16)f2bf(rot * qs);
            }
        }
    }
}
template <int DK> __device__ __forceinline__ void attn_naive_unit(Frame& F, const bf16* Qp, int qld, const bf16* Kp, int kld, const bf16* Vp, int vld, const float* cum  , float scale, bf16* Op, int qb) {
    LAS float* Ks = (LAS float*)(F.lds + RING_OFF); LAS float* Vs = Ks + 64 * DK; LAS float* Cs = Vs + 64 * 64;
    const int t = qb * 512 + F.wave * 64 + F.lane; const int tmax_w = qb * 512 + F.wave * 64 + 63;
    float q[DK];
#pragma unroll
    for (int d = 0; d < DK; d += 8) { const v4u x = *(const v4u*)(Qp + (size_t)t * qld + d);
        q[d] = bflo(x.x) * scale; q[d + 1] = bfhi(x.x) * scale; q[d + 2] = bflo(x.y) * scale; q[d + 3] = bfhi(x.y) * scale; q[d + 4] = bflo(x.z) * scale; q[d + 5] = bfhi(x.z) * scale; q[d + 6] = bflo(x.w) * scale; q[d + 7] = bfhi(x.w) * scale; }
    const float cq = cum ? cum[(size_t)t * 8] : 0.f;
    float acc[64];
#pragma unroll
    for (int d = 0; d < 64; ++d) acc[d] = 0.f;
    float mx = -1e30f, l = 0.f;
    const int nkb = (qb * 512 + 512) / 64;
    for (int kb = 0; kb < nkb; ++kb) {
        __syncthreads();
        for (int i = F.tid; i < 64 * DK / 8; i += 512) { const int key = i / (DK / 8), c = (i % (DK / 8)) * 8; const v4u x = *(const v4u*)(Kp + (size_t)(kb * 64 + key) * kld + c);
            LAS float* d = Ks + key * DK + c; d[0] = bflo(x.x); d[1] = bfhi(x.x); d[2] = bflo(x.y); d[3] = bfhi(x.y); d[4] = bflo(x.z); d[5] = bfhi(x.z); d[6] = bflo(x.w); d[7] = bfhi(x.w); }
        { const int i = F.tid; const int key = i / 8, c = (i % 8) * 8; const v4u x = *(const v4u*)(Vp + (size_t)(kb * 64 + key) * vld + c);
            LAS float* d = Vs + key * 64 + c; d[0] = bflo(x.x); d[1] = bfhi(x.x); d[2] = bflo(x.y); d[3] = bfhi(x.y); d[4] = bflo(x.z); d[5] = bfhi(x.z); d[6] = bflo(x.w); d[7] = bfhi(x.w); }
        if (F.tid < 64) Cs[F.tid] = cum ? cum[(size_t)(kb * 64 + F.tid) * 8] : 0.f;
        __syncthreads();
        if (kb * 64 > tmax_w) continue;
        for (int jk = 0; jk < 64; ++jk) {
            const int s = kb * 64 + jk; if (s > tmax_w) break;
            const LAS float* kr = Ks + jk * DK; float dot = 0.f;
#pragma unroll
            for (int d = 0; d < DK; d += 4) { const f32x4 kv = *(const LAS f32x4*)(kr + d); dot += q[d] * kv.x + q[d + 1] * kv.y + q[d + 2] * kv.z + q[d + 3] * kv.w; }
            float logit = dot + (cq - Cs[jk]); if (s > t) logit = -1e30f;
            if (__any(logit > mx)) { const float mn = fmaxf(mx, logit); const float corr = expf(mx - mn); l *= corr;
#pragma unroll
                for (int d = 0; d < 64; ++d) acc[d] *= corr;
                mx = mn; }
            const float p = (s > t) ? 0.f : expf(logit - mx); l += p;
            const LAS float* vr = Vs + jk * 64;
#pragma unroll
            for (int d = 0; d < 64; d += 4) { const f32x4 vv = *(const LAS f32x4*)(vr + d); acc[d] += p * vv.x; acc[d + 1] += p * vv.y; acc[d + 2] += p * vv.z; acc[d + 3] += p * vv.w; }
        }
    }
    const float il = 1.0f / l; bf16* o = Op + (size_t)t * DM;
#pragma unroll
    for (int d = 0; d < 64; d += 8) { v4u w; w.x = pk2(acc[d] * il, acc[d + 1] * il); w.y = pk2(acc[d + 2] * il, acc[d + 3] * il); w.z = pk2(acc[d + 4] * il, acc[d + 5] * il); w.w = pk2(acc[d + 6] * il, acc[d + 7] * il); *(v4u*)(o + d) = w; }
}
__device__ __forceinline__ void phase_attn_naive(Frame& F) {
    const bf16* PROJ = (const bf16*)(F.ws + WS_PROJ); const bf16* QM = (const bf16*)(F.ws + WS_QM); const bf16* KVB = (const bf16*)(F.ws + WS_KVB); const bf16* KM = (const bf16*)(F.ws + WS_KM);
    const float* CUM = (const float*)(F.ws + WS_CUM); bf16* MIX = (bf16*)(F.ws + WS_MIX);
    for (int p = F.bid; p < 512; p += F.G) {
        const int combo = p >> 4, qq = p & 15; const int type = combo >> 4, b = (combo >> 3) & 1, h = combo & 7;
#pragma unroll 1
        for (int half = 0; half < 2; ++half) { const int qb = half ? 31 - qq : qq; const size_t rb = (size_t)b * SEQ;
            if (type == 0) attn_naive_unit<64>(F, PROJ + rb * EVEN_INP + E_FQ + h * 64, EVEN_INP, PROJ + rb * EVEN_INP + E_FK + h * 64, EVEN_INP, PROJ + rb * EVEN_INP + E_FV + h * 64, EVEN_INP, CUM + rb * 8 + h, LN2, MIX + rb * DM + h * 64, qb);
            else attn_naive_unit<96>(F, QM + rb * 768 + h * 96, 768, KM + rb * 768 + h * 96, 768, KVB + rb * 1024 + h * 128 + 64, 1024, nullptr, LN2, MIX + rb * DM + 512 + h * 64, qb);
        }
    }
    __syncthreads();
}

__device__ __forceinline__ void s5_scan_wave(Frame& F, int j, int b, int g) {
 const int p = F.lane;
    const bf16* PROJ = (const bf16*)(F.ws + WS_PROJ); bf16* HG = (bf16*)(F.ws + WS_HG);
    const float lr = fminf(kin(I_S5_ARE)[(j * 32 + g) * 64 + p], -1e-4f), li = kin(I_S5_AIM)[(j * 32 + g) * 64 + p];
    const float dt = expf(kin(I_S5_LS)[j * 32 + g]);
    const float mag = expf(lr * dt); const float abr = mag * cosf(li * dt), abi = mag * sinf(li * dt);
    const float den = lr * lr + li * li, nr = abr - 1.0f, ni = abi;
    const float gr = (nr * lr + ni * li) / den, gi = (ni * lr - nr * li) / den;
    float bbr[16], bbi[16], cr[16], ci[16], dsk[16];
#pragma unroll
    for (int c = 0; c < 16; ++c) { const float br = kin(I_S5_BRE)[((size_t)(j * 32 + g) * 64 + p) * 16 + c], bi = kin(I_S5_BIM)[((size_t)(j * 32 + g) * 64 + p) * 16 + c];
        bbr[c] = gr * br - gi * bi; bbi[c] = gr * bi + gi * br;
        cr[c] = kin(I_S5_CRE)[((size_t)(j * 32 + g) * 16 + c) * 64 + p]; ci[c] = kin(I_S5_CIM)[((size_t)(j * 32 + g) * 16 + c) * 64 + p];
        dsk[c] = kin(I_S5_D)[j * 512 + g * 16 + c]; }
    float xr = 0.f, xi = 0.f;
    const bf16* up = PROJ + (size_t)b * SEQ * ODD_INP + O_U + g * 16;
    v4u cur0[4], cur1[4], nx0[4], nx1[4];
#pragma unroll
    for (int i = 0; i < 4; ++i) { cur0[i] = *(const v4u*)(up + (size_t)i * ODD_INP); cur1[i] = *(const v4u*)(up + (size_t)i * ODD_INP + 8); }
    for (int t0 = 0; t0 < SEQ; t0 += 4) {
        const int tn = (t0 + 4 < SEQ) ? t0 + 4 : t0;
#pragma unroll
        for (int i = 0; i < 4; ++i) { nx0[i] = *(const v4u*)(up + (size_t)(tn + i) * ODD_INP); nx1[i] = *(const v4u*)(up + (size_t)(tn + i) * ODD_INP + 8); }
#pragma unroll
        for (int i = 0; i < 4; ++i) {
            float u[16] = {bflo(cur0[i].x), bfhi(cur0[i].x), bflo(cur0[i].y), bfhi(cur0[i].y), bflo(cur0[i].z), bfhi(cur0[i].z), bflo(cur0[i].w), bfhi(cur0[i].w),
                           bflo(cur1[i].x), bfhi(cur1[i].x), bflo(cur1[i].y), bfhi(cur1[i].y), bflo(cur1[i].z), bfhi(cur1[i].z), bflo(cur1[i].w), bfhi(cur1[i].w)};
            float bur = 0.f, bui = 0.f;
#pragma unroll
            for (int c = 0; c < 16; ++c) { bur += bbr[c] * u[c]; bui += bbi[c] * u[c]; }
            const float nxr = abr * xr - abi * xi + bur, nxi = abr * xi + abi * xr + bui; xr = nxr; xi = nxi;
            float y[16];
#pragma unroll
            for (int c = 0; c < 16; ++c) y[c] = wave_sum(cr[c] * xr - ci[c] * xi);
            if (p < 16) { float yy = 0.f, uu = 0.f, dd = 0.f;
#pragma unroll
                for (int c = 0; c < 16; ++c) if (p == c) { yy = y[c]; uu = u[c]; dd = dsk[c]; }
                HG[((size_t)b * SEQ + t0 + i) * 512 + g * 16 + p] = (bf16)f2bf(gelu_tanh(yy + dd * uu)); }
        }
#pragma unroll
        for (int i = 0; i < 4; ++i) { cur0[i] = nx0[i]; cur1[i] = nx1[i]; }
    }
}
__device__ __forceinline__ void gdn_prep_token(Frame& F, int j, int m) {
 const int lane = F.lane;
    const bf16* PROJ = (const bf16*)(F.ws + WS_PROJ); float* QG = (float*)(F.ws + WS_QG); float* KG = (float*)(F.ws + WS_KG); float* VG = (float*)(F.ws + WS_VG);
    float* GB = (float*)(F.ws + WS_GB); float* BETA = (float*)(F.ws + WS_BETA);
    const float* cw = kin(I_GDN_CONV) + (size_t)j * 4 * 1536;
    const int s = m % SEQ;
#pragma unroll
    for (int w = 0; w < 3; ++w) {
        const int ch0 = w * 512 + lane * 8; float acc[8];
#pragma unroll
        for (int i = 0; i < 8; ++i) acc[i] = 0.f;
#pragma unroll
        for (int tap = 0; tap < 4; ++tap) { const int ss = s - 3 + tap; if (ss < 0) continue;
            const v4u x = *(const v4u*)(PROJ + (size_t)(m - 3 + tap) * ODD_INP + O_Q + ch0); const float* wv = cw + tap * 1536 + ch0;
            acc[0] += wv[0] * bflo(x.x); acc[1] += wv[1] * bfhi(x.x); acc[2] += wv[2] * bflo(x.y); acc[3] += wv[3] * bfhi(x.y); acc[4] += wv[4] * bflo(x.z); acc[5] += wv[5] * bfhi(x.z); acc[6] += wv[6] * bflo(x.w); acc[7] += wv[7] * bfhi(x.w); }
        float ss2 = 0.f;
#pragma unroll
        for (int i = 0; i < 8; ++i) { acc[i] = acc[i] * sigm(acc[i]); ss2 += acc[i] * acc[i]; }
        float sc = 1.0f;
        if (w < 2) { ss2 += __shfl_xor(ss2, 1); ss2 += __shfl_xor(ss2, 2); ss2 += __shfl_xor(ss2, 4); ss2 += __shfl_xor(ss2, 8); sc = 1.0f / sqrtf(ss2 + RMS_EPS); if (w == 0) sc *= 0.08838834764831845f; }
        float* dst = (w == 0 ? QG : (w == 1 ? KG : VG)) + (size_t)m * 512 + lane * 8;
        *(f32x4*)dst = (f32x4){acc[0] * sc, acc[1] * sc, acc[2] * sc, acc[3] * sc}; *(f32x4*)(dst + 4) = (f32x4){acc[4] * sc, acc[5] * sc, acc[6] * sc, acc[7] * sc};
    }
    if (lane < 4) { const float gin = bf2f(PROJ[(size_t)m * ODD_INP + O_GIN + lane]), bin = bf2f(PROJ[(size_t)m * ODD_INP + O_BETA + lane]);
        GB[(size_t)m * 4 + lane] = -expf(kin(I_GDN_ALOG)[j * 4 + lane]) * softplusf_(gin + kin(I_GDN_DTB)[j * 4 + lane]); BETA[(size_t)m * 4 + lane] = sigm(bin); }
}
__device__ __forceinline__ void phase_odd_a(Frame& F, int j) {
    if (F.wave == 0 && F.bid < 64) { s5_scan_wave(F, j, F.bid >> 5, F.bid & 31); return; }
    const int nbusy = (F.G < 64 ? F.G : 64);
    const int widx = (F.bid < 64) ? F.bid * 7 + (F.wave - 1) : nbusy * 7 + (F.bid - 64) * 8 + F.wave;
    const int nw = nbusy * 7 + (F.G > 64 ? (F.G - 64) * 8 : 0);
    for (int m = widx; m < NTOK; m += nw) gdn_prep_token(F, j, m);
}
__device__ __forceinline__ void phase_gdn_naive(Frame& F) {
    const float* QG = (const float*)(F.ws + WS_QG); const float* KG = (const float*)(F.ws + WS_KG); const float* VG = (const float*)(F.ws + WS_VG);
    const float* GB = (const float*)(F.ws + WS_GB); const float* BETA = (const float*)(F.ws + WS_BETA); float* OG = (float*)(F.ws + WS_OG);
    const int lane = F.lane; const int NGW = F.G * NWAVES;
    for (int u = F.wave * F.G + F.bid; u < 1024; u += NGW) {
        const int b = u >> 9, h = (u >> 7) & 3, c = u & 127; const size_t rb = (size_t)b * SEQ;
        const float* kq = KG + rb * 512 + h * 128 + lane; const float* qq = QG + rb * 512 + h * 128 + lane; const float* vq = VG + rb * 512 + h * 128 + c;
        const float* gq = GB + rb * 4 + h; const float* bq = BETA + rb * 4 + h; float* oq = OG + rb * 512 + h * 128 + c;
        float s0 = 0.f, s1 = 0.f;
        float k0[8], k1[8], q0[8], q1[8], vv[8], gg[8], bb[8], nk0[8], nk1[8], nq0[8], nq1[8], nv[8], ng[8], nb[8];
#pragma unroll
        for (int i = 0; i < 8; ++i) { k0[i] = kq[(size_t)i * 512]; k1[i] = kq[(size_t)i * 512 + 64]; q0[i] = qq[(size_t)i * 512]; q1[i] = qq[(size_t)i * 512 + 64]; vv[i] = vq[(size_t)i * 512]; gg[i] = gq[i * 4]; bb[i] = bq[i * 4]; }
        for (int t0 = 0; t0 < SEQ; t0 += 8) {
            const int tn = (t0 + 8 < SEQ) ? t0 + 8 : t0;
#pragma unroll
            for (int i = 0; i < 8; ++i) { const size_t o = (size_t)(tn + i) * 512; nk0[i] = kq[o]; nk1[i] = kq[o + 64]; nq0[i] = qq[o]; nq1[i] = qq[o + 64]; nv[i] = vq[o]; ng[i] = gq[(tn + i) * 4]; nb[i] = bq[(tn + i) * 4]; }
#pragma unroll
            for (int i = 0; i < 8; ++i) {
                const float ks = wave_sum(k0[i] * s0 + k1[i] * s1); const float eg = expf(gg[i]); const float be = bb[i];
                s0 = eg * (s0 - be * k0[i] * ks) + be * k0[i] * vv[i]; s1 = eg * (s1 - be * k1[i] * ks) + be * k1[i] * vv[i];
                const float o = wave_sum(q0[i] * s0 + q1[i] * s1);
                if (lane == 0) oq[(size_t)(t0 + i) * 512] = o;
            }
#pragma unroll
            for (int i = 0; i < 8; ++i) { k0[i] = nk0[i]; k1[i] = nk1[i]; q0[i] = nq0[i]; q1[i] = nq1[i]; vv[i] = nv[i]; gg[i] = ng[i]; bb[i] = nb[i]; }
        }
    }
}
__device__ __forceinline__ void phase_gdn_out(Frame& F, int j) {
 const float* OG = (const float*)(F.ws + WS_OG); const bf16* PROJ = (const bf16*)(F.ws + WS_PROJ); bf16* MIX = (bf16*)(F.ws + WS_MIX);
    const float* on = kin(I_GDN_ONORM) + j * 128; const int lane = F.lane;
    const int gw = F.bid * NWAVES + F.wave, NGW = F.G * NWAVES;
    for (int m = gw; m < NTOK; m += NGW) {
        const f32x4 a = *(const f32x4*)(OG + (size_t)m * 512 + lane * 8), b = *(const f32x4*)(OG + (size_t)m * 512 + lane * 8 + 4);
        float f[8] = {a.x, a.y, a.z, a.w, b.x, b.y, b.z, b.w}; float s = 0.f;
#pragma unroll
        for (int i = 0; i < 8; ++i) s += f[i] * f[i];
        s += __shfl_xor(s, 1); s += __shfl_xor(s, 2); s += __shfl_xor(s, 4); s += __shfl_xor(s, 8);
        const float r = 1.0f / sqrtf(s * (1.f / 128.f) + RMS_EPS);
        const bf16* z = PROJ + (size_t)m * ODD_INP + O_Z + lane * 8; const float* g = on + (lane & 15) * 8; float o[8];
#pragma unroll
        for (int i = 0; i < 8; ++i) { const float zz = bf2f(z[i]); o[i] = f[i] * r * g[i] * (zz * sigm(zz)); }
        v4u w; w.x = pk2(o[0], o[1]); w.y = pk2(o[2], o[3]); w.z = pk2(o[4], o[5]); w.w = pk2(o[6], o[7]);
        *(v4u*)(MIX + (size_t)m * DM + 512 + lane * 8) = w;
    }
}

__device__ __forceinline__ void phase_router(Frame& F, int layer) {
 const float* H = kout(); bf16* ABF = (bf16*)(F.ws + WS_ABF);
    const float* gain = kin(I_NORM_FFN) + layer * DM; const float* wgr = kin(I_MOE_WGRP) + (size_t)layer * DM * 4; const float* bgr = kin(I_MOE_BGRP) + layer * 4;
    const float* wex = kin(I_MOE_WEXP) + (size_t)layer * DM * 32; const float* bex = kin(I_MOE_BEXP) + layer * 32;
    int* TOKE = (int*)(F.ws + WS_TOKE); float* TOKW = (float*)(F.ws + WS_TOKW);
    LAS int* lcnt = (LAS int*)(F.lds + LDSCTL_OFF + LC_MOE + 512); LAS int* gbase = (LAS int*)(F.lds + LDSCTL_OFF + LC_MOE + 640);
    const int lane = F.lane; const int per = NTOK / F.G;
    LAS int* lasg = (LAS int*)(F.lds + RING_OFF);
    if (F.tid < 32) lcnt[F.tid] = 0;
    __syncthreads();
    for (int tl = F.wave; tl < per; tl += NWAVES) {
        const int m = F.bid * per + tl;
        const f32x4* xr = (const f32x4*)(H + (size_t)m * DM) + lane; f32x4 v[4]; float s = 0.f;
#pragma unroll
        for (int q = 0; q < 4; ++q) { v[q] = xr[64 * q]; s += (v[q].x * v[q].x + v[q].y * v[q].y) + (v[q].z * v[q].z + v[q].w * v[q].w); }
        const float r = 1.0f / sqrtf(wave_sum(s) * (1.f / 1024.f) + RMS_EPS);
        unsigned long long* o8 = (unsigned long long*)(ABF + (size_t)m * DM) + lane;
#pragma unroll
        for (int q = 0; q < 4; ++q) { const f32x4 g = ((const f32x4*)gain + lane)[64 * q]; v[q].x *= r * g.x; v[q].y *= r * g.y; v[q].z *= r * g.z; v[q].w *= r * g.w;
            o8[64 * q] = (unsigned long long)pk2(v[q].x, v[q].y) | ((unsigned long long)pk2(v[q].z, v[q].w) << 32); }
        float lg[4] = {0.f, 0.f, 0.f, 0.f};
#pragma unroll
        for (int q = 0; q < 4; ++q) { const int k0 = 4 * lane + 256 * q;
#pragma unroll
            for (int e = 0; e < 4; ++e) { const f32x4 w = *(const f32x4*)(wgr + (size_t)(k0 + e) * 4); const float x = v[q][e]; lg[0] += x * w.x; lg[1] += x * w.y; lg[2] += x * w.z; lg[3] += x * w.w; } }
#pragma unroll
        for (int g = 0; g < 4; ++g) lg[g] = wave_sum(lg[g]) + bgr[g];
        int gi = 0; float gm = lg[0];
#pragma unroll
        for (int g = 1; g < 4; ++g) if (lg[g] > gm) { gm = lg[g]; gi = g; }
        float gden = 0.f;
#pragma unroll
        for (int g = 0; g < 4; ++g) gden += expf(lg[g] - gm);
        const float gw_ = 1.0f / gden;
        float le[8] = {0.f, 0.f, 0.f, 0.f, 0.f, 0.f, 0.f, 0.f};
#pragma unroll
        for (int q = 0; q < 4; ++q) { const int k0 = 4 * lane + 256 * q;
#pragma unroll
            for (int e = 0; e < 4; ++e) { const float* wp = wex + (size_t)(k0 + e) * 32 + gi * 8; const f32x4 w0 = *(const f32x4*)wp, w1 = *(const f32x4*)(wp + 4); const float x = v[q][e];
                le[0] += x * w0.x; le[1] += x * w0.y; le[2] += x * w0.z; le[3] += x * w0.w; le[4] += x * w1.x; le[5] += x * w1.y; le[6] += x * w1.z; le[7] += x * w1.w; } }
#pragma unroll
        for (int e = 0; e < 8; ++e) le[e] = wave_sum(le[e]) + bex[gi * 8 + e];
        int i0 = 0; float m0 = le[0];
#pragma unroll
        for (int e = 1; e < 8; ++e) if (le[e] > m0) { m0 = le[e]; i0 = e; }
        int i1 = -1; float m1 = -3.0e38f;
#pragma unroll
        for (int e = 0; e < 8; ++e) if (e != i0 && le[e] > m1) { m1 = le[e]; i1 = e; }
        const float e1 = expf(m1 - m0); const float w0 = gw_ / (1.0f + e1), w1 = gw_ * e1 / (1.0f + e1);
        if (lane == 0) { const int ea = gi * 8 + i0, eb = gi * 8 + i1;
            const int pa = __hip_atomic_fetch_add(lcnt + ea, 1, __ATOMIC_RELAXED, __HIP_MEMORY_SCOPE_WORKGROUP), pb = __hip_atomic_fetch_add(lcnt + eb, 1, __ATOMIC_RELAXED, __HIP_MEMORY_SCOPE_WORKGROUP);
            lasg[tl * 2] = ea | (pa << 8); lasg[tl * 2 + 1] = eb | (pb << 8);
            TOKW[(size_t)m * 2] = w0; TOKW[(size_t)m * 2 + 1] = w1; }
    }
    __syncthreads();
    if (F.tid < 32) gbase[F.tid] = (int)__hip_atomic_fetch_add(F.ctl + CW_CNT + 64 * layer + F.tid, (unsigned)lcnt[F.tid], __ATOMIC_RELAXED, __HIP_MEMORY_SCOPE_AGENT);
    __syncthreads();
    for (int i = F.tid; i < per * 2; i += 512) { const int a = lasg[i], e = a & 255, lp = a >> 8; TOKE[(size_t)F.bid * per * 2 + i] = e | ((gbase[e] + lp) << 8); }
    __syncthreads();
}
__device__ __forceinline__ void moe_tables(Frame& F, int layer) {
    LAS int* rowbase = (LAS int*)(F.lds + LDSCTL_OFF + LC_MOE); LAS unsigned char* tile_e = (LAS unsigned char*)(F.lds + LDSCTL_OFF + LC_MOE + 192);
    if (F.tid == 0) { int rb = 0;
#pragma unroll 1
        for (int e = 0; e < 32; ++e) { const int c = (int)__hip_atomic_load(F.ctl + CW_CNT + 64 * layer + e, __ATOMIC_RELAXED, __HIP_MEMORY_SCOPE_AGENT); rowbase[e] = rb; const int nt = (c + 255) >> 8;
            for (int i = 0; i < nt; ++i) tile_e[(rb >> 8) + i] = (unsigned char)e; rb += nt << 8; }
        rowbase[32] = rb; rowbase[34] = rb >> 8; }
    __syncthreads();
}
__device__ __forceinline__ void phase_moe_scatter(Frame& F, int layer) {
    moe_tables(F, layer);
    const LAS int* rowbase = (const LAS int*)(F.lds + LDSCTL_OFF + LC_MOE);
    const bf16* ABF = (const bf16*)(F.ws + WS_ABF); bf16* XG = (bf16*)(F.ws + WS_XG); const int* TOKE = (const int*)(F.ws + WS_TOKE); int* ROWS = (int*)(F.ws + WS_ROWS);
    const int gw = F.bid * NWAVES + F.wave, NGW = F.G * NWAVES, lane = F.lane;
    for (int m = gw; m < NTOK; m += NGW) {
        const v4u a = *((const v4u*)(ABF + (size_t)m * DM) + lane), b = *((const v4u*)(ABF + (size_t)m * DM) + 64 + lane);
#pragma unroll
        for (int k = 0; k < 2; ++k) { const int te = TOKE[(size_t)m * 2 + k]; const int row = rowbase[te & 255] + (te >> 8);
            *((v4u*)(XG + (size_t)row * DM) + lane) = a; *((v4u*)(XG + (size_t)row * DM) + 64 + lane) = b;
            if (lane == 0) ROWS[(size_t)m * 2 + k] = row; }
    }
}
struct MoeOrder {
    int ntiles, nN, G, c; const LAS unsigned char* tile_e; size_t bstride;
    __device__ bool next(int i, pg8::Unit& u) const { const long L = (long)i * G + c; if (L >= (long)ntiles * nN) return false; u.pm = (int)(L / nN); u.pn = (int)(L % nN); u.aux = __builtin_amdgcn_readfirstlane((int)tile_e[u.pm]); return true; }
    __device__ __forceinline__ const char* a_base(const pg8::Gemm& g, const pg8::Unit& u) const { return (const char*)g.A + (size_t)u.pm * 256 * g.lda * 2; }
    __device__ __forceinline__ const char* b_base(const pg8::Gemm& g, const pg8::Unit& u) const { return (const char*)g.Bt + (size_t)u.aux * bstride + (size_t)u.pn * 256 * g.ldb * 2; }
};
__device__ __forceinline__ void phase_moe_combine(Frame& F, int layer) {
 float* H = kout(); bf16* ABF = (bf16*)(F.ws + WS_ABF); const bf16* Y2 = (const bf16*)(F.ws + WS_Y2);
    const int* ROWS = (const int*)(F.ws + WS_ROWS); const float* TOKW = (const float*)(F.ws + WS_TOKW); const float* gain = kin(I_PLE_NORM) + layer * DM;
    const int gw = F.bid * NWAVES + F.wave, NGW = F.G * NWAVES, lane = F.lane;
    for (int m = gw; m < NTOK; m += NGW) {
        const int r0 = ROWS[(size_t)m * 2], r1 = ROWS[(size_t)m * 2 + 1]; const float w0 = TOKW[(size_t)m * 2], w1 = TOKW[(size_t)m * 2 + 1];
        f32x4* hr = (f32x4*)(H + (size_t)m * DM) + lane; f32x4 v[4]; float s = 0.f;
#pragma unroll
        for (int q = 0; q < 4; ++q) { v[q] = hr[64 * q]; const v2u ya = *((const v2u*)(Y2 + (size_t)r0 * DM) + lane + 64 * q), yb = *((const v2u*)(Y2 + (size_t)r1 * DM) + lane + 64 * q);
            v[q].x += w0 * bflo(ya.x) + w1 * bflo(yb.x); v[q].y += w0 * bfhi(ya.x) + w1 * bfhi(yb.x); v[q].z += w0 * bflo(ya.y) + w1 * bflo(yb.y); v[q].w += w0 * bfhi(ya.y) + w1 * bfhi(yb.y);
            hr[64 * q] = v[q]; s += (v[q].x * v[q].x + v[q].y * v[q].y) + (v[q].z * v[q].z + v[q].w * v[q].w); }
        const float r = 1.0f / sqrtf(wave_sum(s) * (1.f / 1024.f) + RMS_EPS);
        unsigned long long* o8 = (unsigned long long*)(ABF + (size_t)m * DM) + lane;
#pragma unroll
        for (int q = 0; q < 4; ++q) { const f32x4 g = ((const f32x4*)gain + lane)[64 * q];
            o8[64 * q] = (unsigned long long)pk2(v[q].x * r * g.x, v[q].y * r * g.y) | ((unsigned long long)pk2(v[q].z * r * g.z, v[q].w * r * g.w) << 32); }
    }
}
namespace att {
using bf16x8 = __attribute__((ext_vector_type(8))) short;
using s16x4 = __attribute__((ext_vector_type(4))) short;
using f32x16 = __attribute__((ext_vector_type(16))) float;
using u32x4 = __attribute__((ext_vector_type(4))) unsigned;
typedef float f32x2_t __attribute__((ext_vector_type(2))); typedef __bf16 bf16x2_t __attribute__((ext_vector_type(2)));
constexpr int KSLOT = 16384, VSLOT = 8192;
constexpr int L_K = 0, L_V = 2 * KSLOT, L_B = L_V + 2 * VSLOT, L_WS = L_B + 512, L_OST = L_WS + 8 * 256, L_BYTES = L_OST + 8 * 4096;
__device__ __forceinline__ int crow(int r, int hi) { return (r & 3) + 8 * (r >> 2) + 4 * hi; }
__device__ __forceinline__ void glds16(const void* gsrc, unsigned lds_dst) { unsigned keep;
    asm volatile("s_mov_b32 %0, m0\n\ts_mov_b32 m0, %2\n\ts_nop 0\n\tglobal_load_lds_dwordx4 %1, off\n\ts_mov_b32 m0, %0" : "=&s"(keep) : "v"(gsrc), "s"(lds_dst) : "memory"); }
__device__ __forceinline__ unsigned cvtpk(float lo, float hi) { f32x2_t v = {lo, hi}; bf16x2_t b = __builtin_convertvector(v, bf16x2_t); return __builtin_bit_cast(unsigned, b); }
#define ATT_WAIT_BAR() asm volatile("s_waitcnt vmcnt(0) lgkmcnt(0)\n\ts_barrier" ::: "memory")

template <int DK, bool BIAS>
__device__ __forceinline__ void attn_unit(const int tid, const int qb, const bf16* Qh, const int qp, const bf16* Kh, const int kp, const bf16* Vh, const int vp, const float* cumh  , bf16* Oh  , char* shm) {
    constexpr int ND = DK / 16, KCH = DK / 8;
    const int lane = tid & 63, r32 = lane & 31, hi = lane >> 5; const int wid = __builtin_amdgcn_readfirstlane(tid >> 6);
    const int q0 = qb * 256;
    const unsigned lds0 = (unsigned)(uintptr_t)shm;
    float* wsf = (float*)(shm + L_WS) + wid * 64;
    float* Bs = (float*)(shm + L_B);
    const bf16* ksrc = Kh + (size_t)lane * kp + wid * 8;
    const bf16* vsrc = Vh + (size_t)(16 * (wid & 3) + (lane >> 2)) * vp + (wid >> 2) * 32 + (lane & 3) * 8;
    const unsigned kdst = lds0 + L_K + wid * 1024, vdst = lds0 + L_V + wid * 1024;
    const int NT = (q0 + 256) / 64;
    const float cref = BIAS ? cumh[(size_t)q0 * 8] : 0.f;
#define ATT_DMA(t, slot) do { glds16(ksrc + (size_t)(t) * 64 * kp, (unsigned)__builtin_amdgcn_readfirstlane(kdst + (slot) * KSLOT)); \
        if (KCH > 8) glds16(ksrc + (size_t)(t) * 64 * kp + 64, (unsigned)__builtin_amdgcn_readfirstlane(kdst + (slot) * KSLOT + 8192)); \
        glds16(vsrc + (size_t)(t) * 64 * vp, (unsigned)__builtin_amdgcn_readfirstlane(vdst + (slot) * VSLOT)); } while (0)
    ATT_DMA(0, 0);
    if (BIAS && wid == 0) Bs[lane] = (cref - cumh[(size_t)lane * 8]) * 1.4426950408889634f;
    bf16x8 qr[ND];
#pragma unroll
    for (int d0 = 0; d0 < ND; ++d0) qr[d0] = *reinterpret_cast<const bf16x8*>(Qh + (size_t)(q0 + wid * 32 + r32) * qp + d0 * 16 + hi * 8);
    float mhat = 0.f, l_reg = 0.f; f32x16 o[2]; o[0] = f32x16{}; o[1] = f32x16{}; f32x16 negm = f32x16{};
    const int qrel = wid * 32 + r32;
    const int vb0 = (int)(lds0 + L_V) + ((lane >> 4) & 1) * 32 + (lane & 3) * 8 + (4 * hi + ((lane & 15) >> 2)) * 64;
    ATT_WAIT_BAR();
    for (int t = 0; t < NT; ++t) {
        const int cur = t & 1;
        float bnext = 0.f;
        if (t + 1 < NT) { ATT_DMA(t + 1, cur ^ 1); if (BIAS && wid == 0) bnext = cumh[(size_t)((t + 1) * 64 + lane) * 8]; }
        f32x16 p0, p1;
        { const char* kb = shm + L_K + cur * KSLOT + hi * 1024 + r32 * 16;
#pragma unroll
          for (int d0 = 0; d0 < ND; ++d0) { const bf16x8 b0 = *reinterpret_cast<const bf16x8*>(kb + d0 * 2048); const bf16x8 b1 = *reinterpret_cast<const bf16x8*>(kb + d0 * 2048 + 512);
            if (d0 == 0) { p0 = __builtin_amdgcn_mfma_f32_32x32x16_bf16(b0, qr[0], negm, 0, 0, 0); p1 = __builtin_amdgcn_mfma_f32_32x32x16_bf16(b1, qr[0], negm, 0, 0, 0); }
            else { p0 = __builtin_amdgcn_mfma_f32_32x32x16_bf16(b0, qr[d0], p0, 0, 0, 0); p1 = __builtin_amdgcn_mfma_f32_32x32x16_bf16(b1, qr[d0], p1, 0, 0, 0); } } }
        if (BIAS) { const float* bb = Bs + cur * 64 + 4 * hi;
#pragma unroll
            for (int g = 0; g < 4; ++g) { const f32x4 x0 = *(const f32x4*)(bb + 8 * g), x1 = *(const f32x4*)(bb + 32 + 8 * g);
#pragma unroll
                for (int e = 0; e < 4; ++e) { p0[4 * g + e] += x0[e]; p1[4 * g + e] += x1[e]; } } }
        if (t >= NT - 4) { const int kb0 = 64 * (t - (NT - 4)) + 4 * hi;
#pragma unroll
            for (int r = 0; r < 16; ++r) { const int kv = kb0 + (r & 3) + 8 * (r >> 2); if (kv > qrel) p0[r] = -INFINITY; if (kv + 32 > qrel) p1[r] = -INFINITY; } }
        float rm = fmaxf(p0[0], p1[0]);
#pragma unroll
        for (int r = 1; r < 16; ++r) rm = fmaxf(rm, fmaxf(p0[r], p1[r]));
        { auto rr = __builtin_amdgcn_permlane32_swap(__float_as_uint(rm), __float_as_uint(rm), false, false); rm = fmaxf(__uint_as_float(rr[0]), __uint_as_float(rr[1])); }
        bool resc = false;
        if (t == 0) { mhat = rm;
#pragma unroll
            for (int r = 0; r < 16; ++r) { p0[r] -= rm; p1[r] -= rm; }
#pragma unroll
            for (int r = 0; r < 16; ++r) negm[r] = -mhat;
        } else if (__any(rm > 8.0f)) { const float dl = fmaxf(rm, 0.f); mhat += dl;
#pragma unroll
            for (int r = 0; r < 16; ++r) { p0[r] -= dl; p1[r] -= dl; }
#pragma unroll
            for (int r = 0; r < 16; ++r) negm[r] = -mhat;
            const float f = __builtin_amdgcn_exp2f(-dl); l_reg *= f; if (hi == 0) wsf[r32] = f; resc = true; }
        float sacc = 0.f;
#pragma unroll
        for (int r = 0; r < 16; ++r) { p0[r] = __builtin_amdgcn_exp2f(p0[r]); p1[r] = __builtin_amdgcn_exp2f(p1[r]); sacc += p0[r] + p1[r]; }
        l_reg += sacc;
        u32x4 pw0, pw1, pw2, pw3;
        pw0 = (u32x4){cvtpk(p0[0], p0[1]), cvtpk(p0[2], p0[3]), cvtpk(p0[4], p0[5]), cvtpk(p0[6], p0[7])}; pw1 = (u32x4){cvtpk(p0[8], p0[9]), cvtpk(p0[10], p0[11]), cvtpk(p0[12], p0[13]), cvtpk(p0[14], p0[15])};
        pw2 = (u32x4){cvtpk(p1[0], p1[1]), cvtpk(p1[2], p1[3]), cvtpk(p1[4], p1[5]), cvtpk(p1[6], p1[7])}; pw3 = (u32x4){cvtpk(p1[8], p1[9]), cvtpk(p1[10], p1[11]), cvtpk(p1[12], p1[13]), cvtpk(p1[14], p1[15])};
        if (resc) { asm volatile("s_waitcnt lgkmcnt(0)" ::: "memory");
#pragma unroll
            for (int d_ = 0; d_ < 2; ++d_)
#pragma unroll
                for (int r = 0; r < 16; ++r) o[d_][r] *= wsf[crow(r, hi)]; }
        { const int vb = vb0 + cur * VSLOT;
#pragma unroll
          for (int d0 = 0; d0 < 2; ++d0) { s16x4 lo[4], hh[4];
#pragma unroll
            for (int ks = 0; ks < 4; ++ks) {
                asm volatile("ds_read_b64_tr_b16 %0,%1 offset:%c2" : "=&v"(lo[ks]) : "v"(vb), "i"(d0 * 4096 + ks * 1024) : "memory");
                asm volatile("ds_read_b64_tr_b16 %0,%1 offset:%c2" : "=&v"(hh[ks]) : "v"(vb), "i"(d0 * 4096 + ks * 1024 + 512) : "memory"); }
            asm volatile("s_waitcnt lgkmcnt(0)" ::: "memory"); __builtin_amdgcn_sched_barrier(0);
#define ATT_PK(k) (bf16x8){lo[k][0], lo[k][1], lo[k][2], lo[k][3], hh[k][0], hh[k][1], hh[k][2], hh[k][3]}
            o[d0] = __builtin_amdgcn_mfma_f32_32x32x16_bf16(__builtin_bit_cast(bf16x8, pw0), ATT_PK(0), o[d0], 0, 0, 0);
            o[d0] = __builtin_amdgcn_mfma_f32_32x32x16_bf16(__builtin_bit_cast(bf16x8, pw1), ATT_PK(1), o[d0], 0, 0, 0);
            o[d0] = __builtin_amdgcn_mfma_f32_32x32x16_bf16(__builtin_bit_cast(bf16x8, pw2), ATT_PK(2), o[d0], 0, 0, 0);
            o[d0] = __builtin_amdgcn_mfma_f32_32x32x16_bf16(__builtin_bit_cast(bf16x8, pw3), ATT_PK(3), o[d0], 0, 0, 0);
#undef ATT_PK
          } }
        if (BIAS && wid == 0 && t + 1 < NT) Bs[(cur ^ 1) * 64 + lane] = (cref - bnext) * 1.4426950408889634f;
        ATT_WAIT_BAR();
    }
    { auto rr = __builtin_amdgcn_permlane32_swap(__float_as_uint(l_reg), __float_as_uint(l_reg), false, false); l_reg = __uint_as_float(rr[0]) + __uint_as_float(rr[1]); }
    if (hi == 0) wsf[32 + r32] = l_reg; asm volatile("s_waitcnt lgkmcnt(0)" ::: "memory");
    float rli[16];
#pragma unroll
    for (int r = 0; r < 16; ++r) rli[r] = __builtin_amdgcn_rcpf(wsf[32 + crow(r, hi)]);
    bf16* Ow = Oh + (size_t)(q0 + wid * 32) * DM;
    { bf16* stg = (bf16*)(shm + L_OST) + wid * 2048;
#pragma unroll
      for (int r = 0; r < 16; ++r) { const int orow = crow(r, hi);
#pragma unroll
        for (int d0 = 0; d0 < 2; ++d0) stg[orow * 64 + d0 * 32 + r32] = (bf16)f2bf(o[d0][r] * rli[r]); }
      asm volatile("s_waitcnt lgkmcnt(0)" ::: "memory");
#pragma unroll
      for (int i = 0; i < 4; ++i) { const int row = i * 8 + (lane >> 3), ch = lane & 7; const u32x4 v = *(const u32x4*)(stg + row * 64 + ch * 8); *(u32x4*)(Ow + (size_t)row * DM + ch * 8) = v; } }
    asm volatile("s_waitcnt lgkmcnt(0)\n\ts_barrier" ::: "memory");
#undef ATT_DMA
}
}

__device__ __forceinline__ void phase_attn_mfma(Frame& F) {
    const bf16* PROJ = (const bf16*)(F.ws + WS_PROJ); const bf16* QM = (const bf16*)(F.ws + WS_QM); const bf16* KVB = (const bf16*)(F.ws + WS_KVB); const bf16* KM = (const bf16*)(F.ws + WS_KM);
    const float* CUM = (const float*)(F.ws + WS_CUM); bf16* MIX = (bf16*)(F.ws + WS_MIX);
    char* shm = (char*)(F.lds + RING_OFF);
    const int vcu = (F.G % 8 == 0) ? (F.bid % 8) * (F.G / 8) + F.bid / 8 : F.bid;
#pragma unroll 1
    for (int p = vcu; p < 512; p += F.G) { const int combo = p >> 5, s = p & 31, b = combo >> 3, h = combo & 7; const size_t rb = (size_t)b * SEQ;
#pragma unroll 1
        for (int half = 0; half < 2; ++half) { const int qb = half ? 63 - s : s;
            att::attn_unit<64, true>(F.tid, qb, PROJ + rb * EVEN_INP + E_FQ + h * 64, EVEN_INP, PROJ + rb * EVEN_INP + E_FK + h * 64, EVEN_INP, PROJ + rb * EVEN_INP + E_FV + h * 64, EVEN_INP, CUM + rb * 8 + h, MIX + rb * DM + h * 64, shm); } }
#pragma unroll 1
    for (int p = vcu; p < 512; p += F.G) { const int combo = p >> 5, s = p & 31, b = combo >> 3, h = combo & 7; const size_t rb = (size_t)b * SEQ;
#pragma unroll 1
        for (int half = 0; half < 2; ++half) { const int qb = half ? 63 - s : s;
            att::attn_unit<96, false>(F.tid, qb, QM + rb * 768 + h * 96, 768, KM + rb * 768 + h * 96, 768, KVB + rb * 1024 + h * 128 + 64, 1024, nullptr, MIX + rb * DM + 512 + h * 64, shm); } }
}
constexpr int LSTEPS = 16;
constexpr int STEP_END = 1 + DEPTH * LSTEPS;
struct KArgs { Args a; int li, pad; };

#define FRAME Frame F; { int wv_ = wave0; asm volatile("" : "+s"(wv_)); int t_ = wv_ * 64 + (int)__builtin_amdgcn_mbcnt_hi(~0u, __builtin_amdgcn_mbcnt_lo(~0u, 0u)); asm volatile("" : "+v"(t_)); unsigned char* w_ = kws(); F.lds = lds0; F.ws = w_; F.ctl = (unsigned*)(w_ + WS_CTL); \
        F.tid = t_; F.lane = t_ & 63; F.wave = __builtin_amdgcn_readfirstlane(t_ >> 6); { int g_ = gridDim.x, b_ = blockIdx.x; asm volatile("" : "+s"(g_), "+s"(b_)); F.G = g_; F.bid = b_; } } unsigned char* const ws = F.ws; (void)ws
#ifndef PH_MASK
#define PH_MASK 0xffffffffu
#endif
#define EN(k) (((PH_MASK) >> (k)) & 1u)
#define STEP(s) if (lo <= (s) && (s) < hi)
#define ENDSTEP(s) do { if ((s) + 1 < hi) xcd_barrier(bar); } while (0)
#define LAUNDER_WS do {} while (0)


template <int layer> __device__ __forceinline__ void layer_body(const XcdBarrier& bar, const int lo, const int hi, LAS unsigned char* const lds0, const int wave0) {
        constexpr int sb = 1 + layer * LSTEPS, j = layer >> 1; constexpr bool even = (layer & 1) == 0;
        STEP(sb + 0) if constexpr (EN(0)) { FRAME;
            phase_norm(F, layer == 0 ? kin(I_X) : kout(), kin(I_NORM_MIX) + layer * DM, layer == 0 ? kout() : nullptr);
            moe_weights(F, layer); phase_pconv(F, layer);
            ENDSTEP(sb + 0);
        }
        STEP(sb + 1) if constexpr (EN(1)) { FRAME;
            { LAUNDER_WS; const int NP = even ? EVEN_INP : ODD_INP; const bf16* W = even ? (const bf16*)(ws + WS_W_EVIN) + (size_t)j * EVEN_INP * 1024 : (const bf16*)(ws + WS_W_ODIN) + (size_t)j * ODD_INP * 1024;
              pg8::Gemm g{(const bf16*)(ws + WS_ABF), W, 1024, 1024, 1024}; pg8::StaticOrder S; S.init(NTOK, NP, F.G, F.bid); pg8::EpiBf16 E{(bf16*)(ws + WS_PROJ), NP};
              pg8::gemm_phase<pg8::EpiBf16, pg8::StaticOrder>(F.lds + RING_OFF, g, S, E, F.tid); }
            { LAUNDER_WS; pg8::Gemm g{(const bf16*)(ws + WS_PBF), (const bf16*)(ws + WS_W_PLEP) + (size_t)layer * 1024 * 256, 256, 256, 256}; pg8::StaticOrder S; S.init(NTOK, 1024, F.G, F.bid); pg8::EpiBf16 E{(bf16*)(ws + WS_PP), 1024};
              pg8::gemm_phase<pg8::EpiBf16, pg8::StaticOrder>(F.lds + RING_OFF, g, S, E, F.tid); }
            ENDSTEP(sb + 1);
        }
        if constexpr (even) {
            STEP(sb + 2) if constexpr (EN(2)) { FRAME; phase_even_post(F, j); ENDSTEP(sb + 2); }
            STEP(sb + 3) if constexpr (EN(3)) { FRAME;
#ifndef NO_QUP
                { LAUNDER_WS; pg8::Gemm g{(const bf16*)(ws + WS_CQN), (const bf16*)(ws + WS_W_QUP) + (size_t)j * 768 * 384, 384, 384, 384}; pg8::StaticOrder S; S.init(NTOK, 768, F.G, F.bid); pg8::EpiBf16 E{(bf16*)(ws + WS_QM), 768};
                  pg8::gemm_phase<pg8::EpiBf16, pg8::StaticOrder>(F.lds + RING_OFF, g, S, E, F.tid); }
#endif
#ifndef NO_KVUP
                { LAUNDER_WS; pg8::Gemm g{(const bf16*)(ws + WS_CKVN), (const bf16*)(ws + WS_W_KVUP) + (size_t)j * 1024 * 256, 256, 256, 256}; pg8::StaticOrder S; S.init(NTOK, 1024, F.G, F.bid); pg8::EpiBf16 E{(bf16*)(ws + WS_KVB), 1024};
                  pg8::gemm_phase<pg8::EpiBf16, pg8::StaticOrder>(F.lds + RING_OFF, g, S, E, F.tid); }
#endif
#ifndef NO_CUMSUM
                phase_cumsum(F);
#endif
                ENDSTEP(sb + 3);
            }
            STEP(sb + 4) if constexpr (EN(4)) { FRAME; phase_mla_post(F, j); ENDSTEP(sb + 4); }
            STEP(sb + 5) if constexpr (EN(5)) { FRAME;
#ifdef ATTN_NAIVE
                phase_attn_naive(F);
#else
                phase_attn_mfma(F);
#endif
                ENDSTEP(sb + 5); }
        } else {
            STEP(sb + 2) if constexpr (EN(2)) { FRAME; phase_odd_a(F, j); ENDSTEP(sb + 2); }
            STEP(sb + 3) if constexpr (EN(3)) { FRAME;
#ifndef NO_GLU
                { LAUNDER_WS; pg8::Gemm g{(const bf16*)(ws + WS_HG), (const bf16*)(ws + WS_W_GLU) + (size_t)j * 512 * 512, 512, 512, 512}; pg8::StaticOrder S; S.init(NTOK, 512, F.G, F.bid);
                  pg8::EpiGlu E{(bf16*)(ws + WS_MIX), 1024, (const bf16*)(ws + WS_HG), 512, kin(I_S5_BGLU) + j * 512};
                  pg8::gemm_phase<pg8::EpiGlu, pg8::StaticOrder>(F.lds + RING_OFF, g, S, E, F.tid); }
#endif
#ifndef NO_GDN
                phase_gdn_naive(F);
#endif
                ENDSTEP(sb + 3);
            }
            STEP(sb + 4) if constexpr (EN(4)) { FRAME; phase_gdn_out(F, j); ENDSTEP(sb + 4); }
        }
        STEP(sb + 6) if constexpr (EN(6)) { FRAME;
            LAUNDER_WS; const bf16* W = even ? (const bf16*)(ws + WS_W_EVOUT) + (size_t)j * 1024 * 1024 : (const bf16*)(ws + WS_W_ODOUT) + (size_t)j * 1024 * 1024;
            pg8::Gemm g{(const bf16*)(ws + WS_MIX), W, 1024, 1024, 1024}; pg8::StaticOrder S; S.init(NTOK, 1024, F.G, F.bid); pg8::EpiResAdd E{kout(), 1024};
            pg8::gemm_phase<pg8::EpiResAdd, pg8::StaticOrder>(F.lds + RING_OFF, g, S, E, F.tid);
            ENDSTEP(sb + 6);
        }
        STEP(sb + 7) if constexpr (EN(7)) { FRAME; phase_router(F, layer); ENDSTEP(sb + 7); }
        STEP(sb + 8) if constexpr (EN(8)) { FRAME; phase_moe_scatter(F, layer); ENDSTEP(sb + 8); }
        STEP(sb + 9) if constexpr (EN(9)) { FRAME;
            LAUNDER_WS; moe_tables(F, layer);
            const LAS int* rowbase = (const LAS int*)(F.lds + LDSCTL_OFF + LC_MOE);
            MoeOrder S{__builtin_amdgcn_readfirstlane(rowbase[34]), 4, F.G, F.bid, (const LAS unsigned char*)(F.lds + LDSCTL_OFF + LC_MOE + 192), (size_t)1024 * 1024 * 2};
            pg8::Gemm g{(const bf16*)(ws + WS_XG), (const bf16*)(ws + WS_W_MOEGU), 1024, 1024, 1024}; pg8::EpiSwiglu E{(bf16*)(ws + WS_HB), 512};
            pg8::gemm_phase<pg8::EpiSwiglu, MoeOrder>(F.lds + RING_OFF, g, S, E, F.tid);
            ENDSTEP(sb + 9);
        }
        STEP(sb + 10) if constexpr (EN(10)) { FRAME;
            LAUNDER_WS; moe_tables(F, layer);
            const LAS int* rowbase = (const LAS int*)(F.lds + LDSCTL_OFF + LC_MOE);
            MoeOrder S{__builtin_amdgcn_readfirstlane(rowbase[34]), 4, F.G, F.bid, (const LAS unsigned char*)(F.lds + LDSCTL_OFF + LC_MOE + 192), (size_t)1024 * 512 * 2};
            pg8::Gemm g{(const bf16*)(ws + WS_HB), (const bf16*)(ws + WS_W_MOED), 512, 512, 512}; pg8::EpiBf16 E{(bf16*)(ws + WS_Y2), 1024};
            pg8::gemm_phase<pg8::EpiBf16, MoeOrder>(F.lds + RING_OFF, g, S, E, F.tid);
            ENDSTEP(sb + 10);
        }
        STEP(sb + 11) if constexpr (EN(11)) { FRAME; phase_moe_combine(F, layer); ENDSTEP(sb + 11); }
        STEP(sb + 12) if constexpr (EN(12)) { FRAME;
            LAUNDER_WS; pg8::Gemm g{(const bf16*)(ws + WS_ABF), (const bf16*)(ws + WS_W_PLEG) + (size_t)layer * 1024 * 1024, 1024, 1024, 1024}; pg8::StaticOrder S; S.init(NTOK, 1024, F.G, F.bid);
            pg8::EpiPle E{kout(), (const bf16*)(ws + WS_PP), kin(I_PLE_BG) + layer * DM, 1024};
            pg8::gemm_phase<pg8::EpiPle, pg8::StaticOrder>(F.lds + RING_OFF, g, S, E, F.tid);
            ENDSTEP(sb + 12);
        }
    }
__global__ void __launch_bounds__(NWAVES * 64, 2) mega_fwd(KArgs ka) {
    extern __shared__ __attribute__((aligned(16))) unsigned char lds_raw[];
    const Args& args = ka.a;
    LAS unsigned char* const lds0 = (LAS unsigned char*)lds_raw;
    const int wave0 = __builtin_amdgcn_readfirstlane((int)threadIdx.x >> 6);
    for (int u = threadIdx.x; u < (LDS_BYTES - LDSCTL_OFF) / 4; u += NWAVES * 64) ((LAS unsigned*)(lds0 + LDSCTL_OFF))[u] = 0u;
    __syncthreads();
    XcdBarrier bar = xcd_barrier_post((unsigned*)(kws() + WS_CTL) + CW_BAR + ka.li * XCD_BAR_WORDS, (volatile LAS unsigned*)(lds0 + LDSCTL_OFF + LC_BARST));
    const int lo = args.ph_lo, hi = args.ph_hi;
    STEP(0) if constexpr (EN(13)) { FRAME; prologue_weights(F); ENDSTEP(0); }
    layer_body<0>(bar, lo, hi, lds0, wave0); layer_body<1>(bar, lo, hi, lds0, wave0); layer_body<2>(bar, lo, hi, lds0, wave0); layer_body<3>(bar, lo, hi, lds0, wave0);
#undef STEP
#undef ENDSTEP
}

#ifndef MK_MODE
#define MK_MODE 0
#endif
extern "C" void kernel_launch(void* const* d_in, const int* in_sizes, int n_in, void* d_out, int out_size, void* d_ws, size_t ws_size, hipStream_t stream) {
    static int ready = 0;
    if (ready == 0) {
        if (n_in != N_IN || out_size != NTOK * DM || ws_size < WS_END) { fprintf(stderr, "kernel_launch: unexpected shapes n_in %d out %d ws %zu (need %zu)\n", n_in, out_size, ws_size, (size_t)WS_END); ready = -1; return; }
        if (hipFuncSetAttribute((const void*)mega_fwd, hipFuncAttributeMaxDynamicSharedMemorySize, LDS_BYTES) != hipSuccess) { fprintf(stderr, "kernel_launch: hipFuncSetAttribute failed\n"); ready = -1; return; }
        int per_cu = 0; (void)hipOccupancyMaxActiveBlocksPerMultiprocessor(&per_cu, (const void*)mega_fwd, NWAVES * 64, LDS_BYTES); (void)hipGetLastError();
        ready = 1;
    }
    if (ready < 0) return;
    (void)hipMemsetAsync((char*)d_ws + WS_CTL, 0, CTL_ZERO_BYTES, stream);
    KArgs ka{};
    for (int i = 0; i < N_IN; ++i) ka.a.in[i] = (const float*)d_in[i];
    ka.a.out = (float*)d_out; ka.a.ws = (unsigned char*)d_ws; ka.li = 0; ka.pad = 0;
    const int grid = 256;
#if MK_MODE == 1
    ka.a.ph_lo = 0; ka.a.ph_hi = STEP_END;
    hipLaunchKernelGGL(mega_fwd, dim3(grid), dim3(NWAVES * 64), LDS_BYTES, stream, ka);
#else
    for (int s = 0; s < STEP_END; ++s) {
        if (s > 0) { const int k = (s - 1) % LSTEPS, layer = (s - 1) / LSTEPS; const bool even = (layer & 1) == 0;
            if (k > 12) continue; if (k == 5 && !even) continue; }
        ka.a.ph_lo = s; ka.a.ph_hi = s + 1;
        hipLaunchKernelGGL(mega_fwd, dim3(grid), dim3(NWAVES * 64), LDS_BYTES, stream, ka);
    }
#endif
}
```

```cpp
#include <hip/hip_runtime.h>
#include <cstdio>
#include <cstdint>
#define MK_MODE 1
namespace pg8 {
#define PG8_LAS __attribute__((address_space(3)))
typedef unsigned short bf16_t;
typedef short bf16x8 __attribute__((ext_vector_type(8)));
typedef float f32x4 __attribute__((ext_vector_type(4)));
typedef float f32x2 __attribute__((ext_vector_type(2)));
typedef unsigned u32x4 __attribute__((ext_vector_type(4)));
typedef unsigned u32x2 __attribute__((ext_vector_type(2)));
constexpr int BM = 256, BK = 64, HALF = 128, HTB = HALF * BK * 2  , STAGE_BYTES = 8 * HTB, NXCD = 8, WGM = 8;

__host__ __device__ __forceinline__ int lds_byte(int r, int c) { const int st = (r >> 4) * 2 + (c >> 5), rr = r & 15, cc = c & 31, ob = rr * 64 + cc * 2; return st * 1024 + (ob ^ (((ob >> 9) & 1) << 5)); }
__host__ __device__ __forceinline__ void stage_rc(int b, int& R, int& C) { const int st = b / 1024, sb = b % 1024, swz = sb ^ (((sb >> 9) & 1) << 5); R = (st >> 1) * 16 + swz / 64; C = (st & 1) * 32 + (swz % 64) / 2; }
__host__ __device__ __forceinline__ int perm32(int rho) { const int n = rho >> 4, i = rho & 15; return 8 * (i >> 2) + 4 * n + (i & 3); }

struct Unit { int pm, pn, aux; };
struct Gemm { const bf16_t* A; const bf16_t* Bt; int K, lda, ldb; };

struct StaticOrder {
    int nM, nN, nwg, G, c;
    __device__ void init(int M, int N, int G_, int c_) { nM = M / BM; nN = N / BM; nwg = nM * nN; G = G_; c = c_; }
    __device__ bool next(int i, Unit& u) const {
        const long L = (long)i * G + c; if (L >= nwg) return false;
        int wgid = (int)L; { const int q = nwg / NXCD, r = nwg % NXCD, xcd = wgid % NXCD, off = wgid / NXCD; wgid = (xcd < r ? xcd * (q + 1) : r * (q + 1) + (xcd - r) * q) + off; }
        const int nig = WGM * nN, gid = wgid / nig, fm = gid * WGM, gsz = (nM - fm) < WGM ? (nM - fm) : WGM;
        u.pm = fm + ((wgid % nig) % gsz); u.pn = (wgid % nig) / gsz; u.aux = 0; return true;
    }
    __device__ __forceinline__ const char* a_base(const Gemm& g, const Unit& u) const { return (const char*)g.A + (size_t)u.pm * BM * g.lda * 2; }
    __device__ __forceinline__ const char* b_base(const Gemm& g, const Unit& u) const { return (const char*)g.Bt + (size_t)u.pn * BM * g.ldb * 2; }
};

__device__ __forceinline__ unsigned cvt_pk_bf16(float lo, float hi) { unsigned r; asm volatile("v_cvt_pk_bf16_f32 %0, %1, %2" : "=v"(r) : "v"(lo), "v"(hi)); return r; }
__device__ __forceinline__ float bf_lo(unsigned w) { return __uint_as_float(w << 16); }
__device__ __forceinline__ float bf_hi(unsigned w) { return __uint_as_float(w & 0xffff0000u); }

struct EpiBf16 {
    static constexpr bool PERM = true;
    bf16_t* O; int ldc;
    __device__ __forceinline__ void operator()(const f32x4 (&acc)[2][2][4][2], const Unit& u, int wr, int wc, int fr, int fq) const {
        const int row0 = u.pm * BM + wr * 64 + fr; const int col0 = u.pn * BM + wc * 32 + 8 * fq;
#pragma unroll
        for (int ai = 0; ai < 2; ++ai)
#pragma unroll
            for (int m = 0; m < 4; ++m) { bf16_t* rowp = O + (size_t)(row0 + ai * HALF + m * 16) * ldc + col0;
#pragma unroll
                for (int bj = 0; bj < 2; ++bj) { const f32x4 v0 = acc[ai][bj][m][0], v1 = acc[ai][bj][m][1];
                    u32x4 w; w.x = cvt_pk_bf16(v0[0], v0[1]); w.y = cvt_pk_bf16(v0[2], v0[3]); w.z = cvt_pk_bf16(v1[0], v1[1]); w.w = cvt_pk_bf16(v1[2], v1[3]);
                    *(u32x4*)(rowp + bj * HALF) = w; } }
    }
};
struct EpiResAdd {
    static constexpr bool PERM = false;
    float* H; int ldc;
    __device__ __forceinline__ void operator()(const f32x4 (&acc)[2][2][4][2], const Unit& u, int wr, int wc, int fr, int fq) const {
        const int row0 = u.pm * BM + wr * 64 + fr; const int col0 = u.pn * BM + wc * 32 + 4 * fq;
#pragma unroll
        for (int ai = 0; ai < 2; ++ai)
#pragma unroll
            for (int m = 0; m < 4; ++m) { float* rowp = H + (size_t)(row0 + ai * HALF + m * 16) * ldc + col0;
#pragma unroll
                for (int bj = 0; bj < 2; ++bj)
#pragma unroll
                    for (int n = 0; n < 2; ++n) { f32x4* p = (f32x4*)(rowp + bj * HALF + n * 16); *p = *p + acc[ai][bj][m][n]; } }
    }
};
__device__ __forceinline__ float sigmoidf_(float x) { return 1.0f / (1.0f + __expf(-x)); }
struct EpiPle {
    static constexpr bool PERM = false;
    float* H; const bf16_t* PP; const float* bias; int ldc;
    __device__ __forceinline__ void operator()(const f32x4 (&acc)[2][2][4][2], const Unit& u, int wr, int wc, int fr, int fq) const {
        const int row0 = u.pm * BM + wr * 64 + fr; const int col0 = u.pn * BM + wc * 32 + 4 * fq;
#pragma unroll
        for (int ai = 0; ai < 2; ++ai)
#pragma unroll
            for (int m = 0; m < 4; ++m) { const size_t ro = (size_t)(row0 + ai * HALF + m * 16) * ldc + col0;
#pragma unroll
                for (int bj = 0; bj < 2; ++bj)
#pragma unroll
                    for (int n = 0; n < 2; ++n) { const int co = bj * HALF + n * 16; f32x4* p = (f32x4*)(H + ro + co); const u32x2 pw = *(const u32x2*)(PP + ro + co);
                        const f32x4 bv = *(const f32x4*)(bias + col0 + co); const f32x4 a = acc[ai][bj][m][n] + bv; f32x4 h = *p;
                        h[0] += sigmoidf_(a[0]) * bf_lo(pw.x); h[1] += sigmoidf_(a[1]) * bf_hi(pw.x); h[2] += sigmoidf_(a[2]) * bf_lo(pw.y); h[3] += sigmoidf_(a[3]) * bf_hi(pw.y); *p = h; } }
    }
};
struct EpiGlu {
    static constexpr bool PERM = true;
    bf16_t* O; int ldo; const bf16_t* HG; int ldh; const float* bias;
    __device__ __forceinline__ void operator()(const f32x4 (&acc)[2][2][4][2], const Unit& u, int wr, int wc, int fr, int fq) const {
        const int row0 = u.pm * BM + wr * 64 + fr; const int col0 = u.pn * BM + wc * 32 + 8 * fq;
#pragma unroll
        for (int ai = 0; ai < 2; ++ai)
#pragma unroll
            for (int m = 0; m < 4; ++m) { const size_t r = (size_t)(row0 + ai * HALF + m * 16);
#pragma unroll
                for (int bj = 0; bj < 2; ++bj) { const int c = col0 + bj * HALF; const u32x4 hw = *(const u32x4*)(HG + r * ldh + c);
                    const f32x4 b0 = *(const f32x4*)(bias + c), b1 = *(const f32x4*)(bias + c + 4); const f32x4 v0 = acc[ai][bj][m][0] + b0, v1 = acc[ai][bj][m][1] + b1;
                    u32x4 w; w.x = cvt_pk_bf16(bf_lo(hw.x) * sigmoidf_(v0[0]), bf_hi(hw.x) * sigmoidf_(v0[1])); w.y = cvt_pk_bf16(bf_lo(hw.y) * sigmoidf_(v0[2]), bf_hi(hw.y) * sigmoidf_(v0[3]));
                    w.z = cvt_pk_bf16(bf_lo(hw.z) * sigmoidf_(v1[0]), bf_hi(hw.z) * sigmoidf_(v1[1])); w.w = cvt_pk_bf16(bf_lo(hw.w) * sigmoidf_(v1[2]), bf_hi(hw.w) * sigmoidf_(v1[3]));
                    *(u32x4*)(O + r * ldo + c) = w; } }
    }
};
struct EpiSwiglu {
    static constexpr bool PERM = true;
    bf16_t* HB; int ldc;
    __device__ __forceinline__ void operator()(const f32x4 (&acc)[2][2][4][2], const Unit& u, int wr, int wc, int fr, int fq) const {
        const int row0 = u.pm * BM + wr * 64 + fr; const int col0 = u.pn * HALF + wc * 32 + 8 * fq;
#pragma unroll
        for (int ai = 0; ai < 2; ++ai)
#pragma unroll
            for (int m = 0; m < 4; ++m) { bf16_t* rowp = HB + (size_t)(row0 + ai * HALF + m * 16) * ldc + col0;
                const f32x4 g0 = acc[ai][0][m][0], g1 = acc[ai][0][m][1], u0 = acc[ai][1][m][0], u1 = acc[ai][1][m][1];
                u32x4 w; w.x = cvt_pk_bf16(g0[0] * sigmoidf_(g0[0]) * u0[0], g0[1] * sigmoidf_(g0[1]) * u0[1]); w.y = cvt_pk_bf16(g0[2] * sigmoidf_(g0[2]) * u0[2], g0[3] * sigmoidf_(g0[3]) * u0[3]);
                w.z = cvt_pk_bf16(g1[0] * sigmoidf_(g1[0]) * u1[0], g1[1] * sigmoidf_(g1[1]) * u1[1]); w.w = cvt_pk_bf16(g1[2] * sigmoidf_(g1[2]) * u1[2], g1[3] * sigmoidf_(g1[3]) * u1[3]);
                *(u32x4*)rowp = w; }
    }
};

template <class Epi, class Sched, bool ALIGN_EPI = true, bool SP2 = true>
__device__ __forceinline__ void gemm_phase(PG8_LAS unsigned char* lds, const Gemm g, const Sched& S, const Epi& E, const int tid) {
    const int wid = __builtin_amdgcn_readfirstlane(tid >> 6), lane = tid & 63, wr = wid >> 2, wc = wid & 3, fr = lane & 15, fq = lane >> 4;
    int K = g.K; asm volatile("" : "+s"(K));
    const int nt = K / BK;
    unsigned voffA[2], voffB[2];
#pragma unroll
    for (int i = 0; i < 2; ++i) { int R, C; stage_rc(tid * 16 + i * 8192, R, C); const int Rb = Epi::PERM ? ((R & ~31) + perm32(R & 31)) : R;
        voffA[i] = (unsigned)(R * g.lda + C) * 2u; voffB[i] = (unsigned)(Rb * g.ldb + C) * 2u; }
    const size_t kstep = (size_t)(BK * 2);
    const size_t hstepA = (size_t)HALF * g.lda * 2, hstepB = (size_t)HALF * g.ldb * 2;
    const unsigned ldsw = (unsigned)wid * 1024u;
    const int aoff = lds_byte(wr * 64 + fr, fq * 8), boff = lds_byte(wc * 32 + fr, fq * 8);
#define PG8_SA(b, h) (((b) * 2 + (h)) * HTB)
#define PG8_SB(b, h) ((4 + (b) * 2 + (h)) * HTB)
#define PG8_STAGE(bufoff, gbase, voff) do { _Pragma("unroll") for (int _i = 0; _i < 2; ++_i) \
        __builtin_amdgcn_global_load_lds((const unsigned*)((const char*)(gbase) + (voff)[_i]), (PG8_LAS unsigned*)(lds + (bufoff) + ldsw + _i * 8192), 16, 0, 0); } while (0)
#define PG8_LDA(dst, b, h) do { _Pragma("unroll") for (int m = 0; m < 4; ++m) _Pragma("unroll") for (int k = 0; k < 2; ++k) dst[m][k] = *(const PG8_LAS bf16x8*)(lds + PG8_SA(b, h) + aoff + m * 2048 + k * 1024); } while (0)
#define PG8_LDB(dst, b, h) do { _Pragma("unroll") for (int n = 0; n < 2; ++n) _Pragma("unroll") for (int k = 0; k < 2; ++k) dst[n][k] = *(const PG8_LAS bf16x8*)(lds + PG8_SB(b, h) + boff + n * 2048 + k * 1024); } while (0)
#define PG8_MMA(ai, bj, At, Bt) do { __builtin_amdgcn_s_setprio(1); _Pragma("unroll") for (int m = 0; m < 4; ++m) _Pragma("unroll") for (int n = 0; n < 2; ++n) _Pragma("unroll") for (int k = 0; k < 2; ++k) \
        acc[ai][bj][m][n] = __builtin_amdgcn_mfma_f32_16x16x32_bf16(Bt[n][k], At[m][k], acc[ai][bj][m][n], 0, 0, 0); __builtin_amdgcn_s_setprio(0); } while (0)
#define PG8_WAIT_V(n) asm volatile("s_waitcnt vmcnt(" #n ")" ::: "memory")
#define PG8_WAIT_L(n) asm volatile("s_waitcnt lgkmcnt(" #n ")" ::: "memory")
#define PG8_BAR __builtin_amdgcn_s_barrier()
#define PG8_SCHED __builtin_amdgcn_sched_barrier(0)
    Unit cur, nxt; int ui = 0;
    if (!S.next(0, cur)) return;
    f32x4 acc[2][2][4][2];
#pragma unroll
    for (int a = 0; a < 2; ++a)
#pragma unroll
        for (int b = 0; b < 2; ++b)
#pragma unroll
            for (int m = 0; m < 4; ++m)
#pragma unroll
                for (int n = 0; n < 2; ++n) acc[a][b][m][n] = (f32x4){0.f, 0.f, 0.f, 0.f};
    bf16x8 At[4][2], B0[2][2], B1[2][2];
    const char* cA = S.a_base(g, cur); const char* cB = S.b_base(g, cur);
    if constexpr (SP2) {
        PG8_STAGE(PG8_SB(0, 0), cB, voffB); PG8_STAGE(PG8_SB(0, 1), cB + hstepB, voffB); PG8_STAGE(PG8_SA(0, 0), cA, voffA); PG8_STAGE(PG8_SA(0, 1), cA + hstepA, voffA);
        if (wr == 1) PG8_BAR;
        PG8_WAIT_V(2); PG8_BAR;
        PG8_STAGE(PG8_SB(1, 0), cB + kstep, voffB); PG8_STAGE(PG8_SA(1, 0), cA + kstep, voffA); PG8_STAGE(PG8_SB(1, 1), cB + hstepB + kstep, voffB);
        PG8_WAIT_V(6); PG8_BAR;
    } else {
        PG8_STAGE(PG8_SB(0, 0), cB, voffB); PG8_STAGE(PG8_SA(0, 0), cA, voffA); PG8_STAGE(PG8_SB(0, 1), cB + hstepB, voffB); PG8_STAGE(PG8_SA(0, 1), cA + hstepA, voffA);
        if (wr == 1) PG8_BAR;
        PG8_WAIT_V(4); PG8_BAR;
        PG8_STAGE(PG8_SB(1, 0), cB + kstep, voffB); PG8_STAGE(PG8_SA(1, 0), cA + kstep, voffA); PG8_STAGE(PG8_SB(1, 1), cB + hstepB + kstep, voffB);
        PG8_WAIT_V(6); PG8_BAR;
    }
    for (;;) {
        const bool has_next = S.next(ui + 1, nxt);
        const char* nA = has_next ? S.a_base(g, nxt) : cA; const char* nB = has_next ? S.b_base(g, nxt) : cB;
        for (int t = 0; t < nt; t += 2) {
            const bool last = (t == nt - 2);
            const char* a1 = cA + (size_t)(t + 1) * kstep;
            const char* a2 = last ? nA : cA + (size_t)(t + 2) * kstep; const char* b2 = last ? nB : cB + (size_t)(t + 2) * kstep;
            const char* a3 = a2 + kstep; const char* b3 = b2 + kstep;
            if constexpr (SP2) {
            PG8_LDB(B0, 0, 0); PG8_LDB(B1, 0, 1); PG8_SCHED; PG8_LDA(At, 0, 0); PG8_STAGE(PG8_SA(1, 1), a1 + hstepA, voffA);
            PG8_WAIT_V(8); PG8_WAIT_L(0); PG8_BAR; PG8_MMA(0, 0, At, B0); PG8_MMA(0, 1, At, B1); PG8_BAR; PG8_SCHED;
            PG8_LDA(At, 0, 1); PG8_STAGE(PG8_SB(0, 0), b2, voffB); PG8_STAGE(PG8_SB(0, 1), b2 + hstepB, voffB); PG8_STAGE(PG8_SA(0, 0), a2, voffA);
            PG8_WAIT_V(8); PG8_WAIT_L(0); PG8_BAR; PG8_MMA(1, 0, At, B0); PG8_MMA(1, 1, At, B1); PG8_BAR; PG8_SCHED;
            PG8_LDB(B0, 1, 0); PG8_LDB(B1, 1, 1); PG8_SCHED; PG8_LDA(At, 1, 0); PG8_STAGE(PG8_SA(0, 1), a2 + hstepA, voffA);
            PG8_WAIT_V(8); PG8_WAIT_L(0); PG8_BAR; PG8_MMA(0, 0, At, B0); PG8_MMA(0, 1, At, B1); PG8_BAR; PG8_SCHED;
            PG8_LDA(At, 1, 1); PG8_STAGE(PG8_SB(1, 0), b3, voffB); PG8_STAGE(PG8_SB(1, 1), b3 + hstepB, voffB); PG8_STAGE(PG8_SA(1, 0), a3, voffA);
            PG8_WAIT_V(8); PG8_WAIT_L(0); PG8_BAR; PG8_MMA(1, 0, At, B0); PG8_MMA(1, 1, At, B1); PG8_BAR; PG8_SCHED;
            } else {
            PG8_LDB(B0, 0, 0); PG8_SCHED; PG8_LDA(At, 0, 0); PG8_STAGE(PG8_SA(1, 1), a1 + hstepA, voffA);
            PG8_WAIT_L(8); PG8_BAR; PG8_WAIT_L(0); PG8_MMA(0, 0, At, B0); PG8_BAR; PG8_SCHED;
            PG8_LDB(B1, 0, 1); PG8_STAGE(PG8_SB(0, 0), b2, voffB);
            PG8_BAR; PG8_WAIT_L(0); PG8_MMA(0, 1, At, B1); PG8_BAR;
            PG8_LDA(At, 0, 1); PG8_STAGE(PG8_SA(0, 0), a2, voffA);
            PG8_BAR; PG8_WAIT_L(0); PG8_MMA(1, 0, At, B0); PG8_BAR; PG8_SCHED;
            PG8_STAGE(PG8_SB(0, 1), b2 + hstepB, voffB);
            PG8_WAIT_V(6); PG8_BAR; PG8_MMA(1, 1, At, B1); PG8_BAR;
            PG8_LDB(B0, 1, 0); PG8_SCHED; PG8_LDA(At, 1, 0); PG8_STAGE(PG8_SA(0, 1), a2 + hstepA, voffA);
            PG8_WAIT_L(8); PG8_BAR; PG8_WAIT_L(0); PG8_MMA(0, 0, At, B0); PG8_BAR; PG8_SCHED;
            PG8_LDB(B1, 1, 1); PG8_STAGE(PG8_SB(1, 0), b3, voffB);
            PG8_BAR; PG8_WAIT_L(0); PG8_MMA(0, 1, At, B1); PG8_BAR;
            PG8_LDA(At, 1, 1); PG8_STAGE(PG8_SA(1, 0), a3, voffA);
            PG8_BAR; PG8_WAIT_L(0); PG8_MMA(1, 0, At, B0); PG8_BAR; PG8_SCHED;
            PG8_STAGE(PG8_SB(1, 1), b3 + hstepB, voffB);
            PG8_WAIT_V(6); PG8_BAR; PG8_MMA(1, 1, At, B1); PG8_BAR;
            }
        }
        if constexpr (ALIGN_EPI) { if (wr == 0) PG8_BAR; }
        E(acc, cur, wr, wc, fr, fq);
        if (!has_next) break;
#pragma unroll
        for (int a = 0; a < 2; ++a)
#pragma unroll
            for (int b = 0; b < 2; ++b)
#pragma unroll
                for (int m = 0; m < 4; ++m)
#pragma unroll
                    for (int n = 0; n < 2; ++n) acc[a][b][m][n] = (f32x4){0.f, 0.f, 0.f, 0.f};
        cur = nxt; cA = nA; cB = nB; ++ui;
        if constexpr (ALIGN_EPI) { if (wr == 1) PG8_BAR; }
    }
    PG8_WAIT_V(0);
    if constexpr (!ALIGN_EPI) { if (wr == 0) PG8_BAR; }
    PG8_BAR;
#undef PG8_SA
#undef PG8_SB
#undef PG8_STAGE
#undef PG8_LDA
#undef PG8_LDB
#undef PG8_MMA
#undef PG8_WAIT_V
#undef PG8_WAIT_L
#undef PG8_BAR
#undef PG8_SCHED
}
}
#define LAS __attribute__((address_space(3)))
#define XB_TMO      128
#define XB_XCNT(j)  (256  + 64 * (j))
#define XB_XSUB(j)  (1280 + 64 * (j))
#define XB_XGEN(j)  (2304 + 64 * (j))
#define XB_TOP      3328
#define XB_TOPGEN   3392
#define XCD_BAR_WORDS 3456
#define XB_SPIN_CAP (1u << 22)

__device__ __forceinline__ unsigned xb_ld(unsigned* p)              { return __hip_atomic_load(p, __ATOMIC_RELAXED, __HIP_MEMORY_SCOPE_AGENT); }
__device__ __forceinline__ unsigned xb_add(unsigned* p, unsigned v) { return __hip_atomic_fetch_add(p, v, __ATOMIC_RELAXED, __HIP_MEMORY_SCOPE_AGENT); }
__device__ __forceinline__ unsigned xb_xcc_id() { return (unsigned)__builtin_amdgcn_s_getreg((3 << 11) | 20) & 0xFu; }
#define XB_SPIN(cond, bar) do { unsigned _sp = 0; while (cond) { __builtin_amdgcn_s_sleep(1); \
    if ((++_sp & 255u) == 0u) { if (xb_ld(&(bar)[XB_TMO])) break; if (_sp > XB_SPIN_CAP) { atomicAdd(&(bar)[XB_TMO], 1u); break; } } } } while (0)

struct XcdBarrier {
    unsigned* bar; unsigned x;
    volatile LAS unsigned* st;
};

__device__ __forceinline__ XcdBarrier xcd_barrier_post(unsigned* bar, volatile LAS unsigned* st) {
    XcdBarrier b; b.bar = bar; b.x = xb_xcc_id(); b.st = st;
    if (threadIdx.x == 0) (void)xb_add(&bar[XB_XCNT(b.x)], 1u);
    return b;
}
__device__ __forceinline__ void xcd_barrier_complete(unsigned* bar, unsigned x, unsigned& nloc, unsigned& nx) {
    const unsigned G = gridDim.x * gridDim.y * gridDim.z;
    unsigned sum, cnt, mine, sp = 0u;
    for (;;) {
        sum = 0u; cnt = 0u; mine = 0u;
#pragma unroll
        for (unsigned j = 0; j < 16; ++j) { const unsigned c = xb_ld(&bar[XB_XCNT(j)]); sum += c; cnt += (c > 0u) ? 1u : 0u; mine = (j == x) ? c : mine; }
        if (sum == G) break;
        __builtin_amdgcn_s_sleep(1);
        if ((++sp & 255u) == 0u) { if (xb_ld(&bar[XB_TMO])) break; if (sp > XB_SPIN_CAP) { atomicAdd(&bar[XB_TMO], 1u); break; } }
    }
    nloc = mine > 0u ? mine : 1u; nx = cnt > 0u ? cnt : 1u;
}

__device__ __forceinline__ void xcd_barrier(const XcdBarrier& b) {
    asm volatile("s_waitcnt vmcnt(0)" ::: "memory");
    __syncthreads();
    if (threadIdx.x == 0) {
        unsigned* bar = b.bar;
        __builtin_amdgcn_s_waitcnt(0);
        unsigned nloc = b.st[0], nx = b.st[1];
        if (nloc == 0u) { xcd_barrier_complete(bar, b.x, nloc, nx); b.st[0] = nloc; b.st[1] = nx; }
        const unsigned old = xb_add(&bar[XB_XSUB(b.x)], 1u);
        const unsigned gen = old / nloc;
        if (old + 1u == (gen + 1u) * nloc) {
            __builtin_amdgcn_fence(__ATOMIC_RELEASE, "agent");
            asm volatile("s_waitcnt vmcnt(0)" ::: "memory");
            const unsigned og = xb_add(&bar[XB_TOP], 1u);
            const unsigned tg = og / nx;
            if (og + 1u == (tg + 1u) * nx) xb_add(&bar[XB_TOPGEN], 1u);
            else XB_SPIN(xb_ld(&bar[XB_TOPGEN]) == tg, bar);
            __builtin_amdgcn_fence(__ATOMIC_ACQUIRE, "agent");
            xb_add(&bar[XB_XGEN(b.x)], 1u);
            asm volatile("s_waitcnt vmcnt(0)" ::: "memory");
        } else {
            XB_SPIN(xb_ld(&bar[XB_XGEN(b.x)]) == gen, bar);
            __builtin_amdgcn_fence(__ATOMIC_ACQUIRE, "agent");
            asm volatile("s_waitcnt vmcnt(0)" ::: "memory");
        }
    }
    __syncthreads();
}
#undef LAS
constexpr int NWAVES = 8;
constexpr int BATCH = 2, SEQ = 16384, NTOK = BATCH * SEQ, DM = 1024, DEPTH = 4, PLE = 256;
constexpr int EVEN_IN = 2216, EVEN_INP = 2304, ODD_IN = 2568, ODD_INP = 2816;
constexpr int E_FQ = 0, E_FK = 512, E_FV = 1024, E_FLOG = 1536, E_CQ = 1544, E_CKV = 1928, E_KROPE = 2184;
constexpr int O_U = 0, O_Q = 512, O_K = 1024, O_V = 1536, O_GIN = 2048, O_BETA = 2052, O_Z = 2056;
constexpr float RMS_EPS = 1e-6f;
constexpr float LOG2E = 1.4426950408889634f, LN2 = 0.6931471805599453f;
constexpr float C2_FOX = 0.125f * LOG2E, C2_MLA = 0.10206207261596575f * LOG2E;
constexpr int MOE_CAP = 65536 + 32 * 256;
constexpr int MOE_MAXT = MOE_CAP / 256;

enum { I_X = 0, I_P, I_POS, I_NORM_MIX, I_NORM_FFN, I_EV_W_IN, I_FOX_BF, I_FOX_QN, I_FOX_KN, I_MLA_QAN, I_MLA_WQUP, I_MLA_KVAN, I_MLA_WKVUP, I_MLA_QN, I_MLA_KN, I_EV_W_OUT,
       I_OD_W_IN, I_S5_ARE, I_S5_AIM, I_S5_BRE, I_S5_BIM, I_S5_CRE, I_S5_CIM, I_S5_D, I_S5_LS, I_S5_WGLU, I_S5_BGLU, I_GDN_CONV, I_GDN_ALOG, I_GDN_DTB, I_GDN_ONORM, I_OD_W_OUT,
       I_MOE_WGRP, I_MOE_BGRP, I_MOE_WEXP, I_MOE_BEXP, I_MOE_WG, I_MOE_WU, I_MOE_WD, I_PLE_WP, I_PLE_NORM, I_PLE_WG, I_PLE_BG, N_IN };

constexpr size_t MiB = 1u << 20;
constexpr size_t WS_CTL = 0, CTL_ZERO_BYTES = 1 * MiB;
constexpr size_t WS_W_EVIN = 4 * MiB;
constexpr size_t WS_W_ODIN = WS_W_EVIN + 9 * MiB;
constexpr size_t WS_W_QUP = WS_W_ODIN + 11 * MiB;
constexpr size_t WS_W_KVUP = WS_W_QUP + 2 * MiB;
constexpr size_t WS_W_EVOUT = WS_W_KVUP + 1 * MiB;
constexpr size_t WS_W_ODOUT = WS_W_EVOUT + 4 * MiB;
constexpr size_t WS_W_GLU = WS_W_ODOUT + 4 * MiB;
constexpr size_t WS_W_PLEP = WS_W_GLU + 1 * MiB;
constexpr size_t WS_W_PLEG = WS_W_PLEP + 2 * MiB;
constexpr size_t WS_W_MOEGU = WS_W_PLEG + 8 * MiB;
constexpr size_t WS_W_MOED = WS_W_MOEGU + 64 * MiB;
constexpr size_t WS_ABF = WS_W_MOED + 32 * MiB;
constexpr size_t WS_PP = WS_ABF + 64 * MiB;
constexpr size_t WS_PBF = WS_PP + 64 * MiB;
constexpr size_t WS_PROJ = WS_PBF + 16 * MiB;
constexpr size_t WS_MIX = WS_PROJ + 176 * MiB;
constexpr size_t WS_R1 = WS_MIX + 64 * MiB;
constexpr size_t WS_QM = WS_R1, WS_KVB = WS_QM + 48 * MiB, WS_KM = WS_KVB + 64 * MiB, WS_CQN = WS_KM + 48 * MiB, WS_CKVN = WS_CQN + 24 * MiB, WS_LOGF = WS_CKVN + 16 * MiB, WS_CUM = WS_LOGF + 1 * MiB;
constexpr size_t WS_HG = WS_R1, WS_QG = WS_HG + 32 * MiB, WS_KG = WS_QG + 64 * MiB, WS_VG = WS_KG + 64 * MiB, WS_OG = WS_VG + 64 * MiB;
constexpr size_t WS_R2 = WS_R1 + 288 * MiB;
constexpr size_t WS_GB = WS_R2, WS_BETA = WS_GB + 1 * MiB;
constexpr size_t WS_TOKE = WS_R2 + 2 * MiB, WS_TOKW = WS_TOKE + 1 * MiB, WS_ROWS = WS_TOKW + 1 * MiB;
constexpr size_t WS_XG = WS_R1;
constexpr size_t WS_HB = WS_XG + 144 * MiB;
constexpr size_t WS_Y2 = WS_R2 + 8 * MiB;
constexpr size_t WS_END = WS_Y2 + 144 * MiB;
static_assert(WS_HB + 72 * MiB <= WS_R2, "moe overlay");
static_assert(WS_OG + 64 * MiB <= WS_R2, "odd overlay");
static_assert(WS_END <= 1100 * MiB, "workspace budget");

constexpr int CW_BAR = 4096;
constexpr int CW_CNT = 1024;

constexpr int RING_OFF = 0, RING_BYTES = 131072;
constexpr int LDSCTL_OFF = RING_BYTES;
constexpr int LDS_BYTES = 147456;
constexpr int LC_BARST = 32;
constexpr int LC_MOE = 256;

#define GAS __attribute__((address_space(1)))
#define LAS __attribute__((address_space(3)))
typedef unsigned short bf16;
typedef unsigned v4u __attribute__((ext_vector_type(4)));
typedef unsigned v2u __attribute__((ext_vector_type(2)));
typedef float f32x4 __attribute__((ext_vector_type(4)));
#define LDS_WAIT() asm volatile("s_waitcnt lgkmcnt(0)" ::: "memory")
#define VM_WAIT() asm volatile("s_waitcnt vmcnt(0)" ::: "memory")
__device__ __forceinline__ unsigned f2bf(float f) { unsigned u = __builtin_bit_cast(unsigned, f); return (u + 0x7fffu + ((u >> 16) & 1u)) >> 16; }
__device__ __forceinline__ unsigned pk2(float lo, float hi) { return f2bf(lo) | (f2bf(hi) << 16); }
__device__ __forceinline__ float bflo(unsigned w) { return __uint_as_float(w << 16); }
__device__ __forceinline__ float bfhi(unsigned w) { return __uint_as_float(w & 0xffff0000u); }
__device__ __forceinline__ float bf2f(bf16 h) { return __uint_as_float((unsigned)h << 16); }
__device__ __forceinline__ float wave_sum(float v) {
#pragma unroll
    for (int o = 1; o < 64; o <<= 1) v += __shfl_xor(v, o);
    return v;
}
__device__ __forceinline__ float sigm(float x) { return 1.0f / (1.0f + expf(-x)); }
__device__ __forceinline__ float softplusf_(float x) { return fmaxf(x, 0.f) + log1pf(expf(-fabsf(x))); }
__device__ __forceinline__ float gelu_tanh(float x) { return 0.5f * x * (1.0f + tanhf(0.7978845608028654f * (x + 0.044715f * x * x * x))); }

struct Args { const float* in[N_IN]; float* out; unsigned char* ws; int ph_lo, ph_hi; };
#define CAS __attribute__((address_space(4)))
__device__ __forceinline__ const float* kin(int i) { asm volatile("" : "+s"(i)); const CAS char* kp = (const CAS char*)__builtin_amdgcn_kernarg_segment_ptr(); return *(const float* const CAS*)(kp + 8 * i); }
__device__ __forceinline__ float* kout() { int i = N_IN; asm volatile("" : "+s"(i)); const CAS char* kp = (const CAS char*)__builtin_amdgcn_kernarg_segment_ptr(); return *(float* const CAS*)(kp + 8 * i); }
__device__ __forceinline__ unsigned char* kws() { int i = N_IN + 1; asm volatile("" : "+s"(i)); const CAS char* kp = (const CAS char*)__builtin_amdgcn_kernarg_segment_ptr(); return *(unsigned char* const CAS*)(kp + 8 * i); }

struct Frame {
    LAS unsigned char* lds;
    unsigned char* ws;
    unsigned* ctl;
    int tid, lane, wave, G, bid;
};

__device__ __forceinline__ void transpose_item(const float* W, int K, int N, bf16* WT, int drow0, LAS float* scr, int k0, int n0, int lane) {
    const int nn = n0 + (lane & 31); const bool ok = nn < N;
#pragma unroll 8
    for (int i = 0; i < 32; ++i) { const int kk = 2 * i + (lane >> 5); scr[kk * 33 + (lane & 31)] = ok ? W[(size_t)(k0 + kk) * N + nn] : 0.f; }
    LDS_WAIT(); asm volatile("" ::: "memory");
    const int c = lane & 7;
#pragma unroll
    for (int j = 0; j < 4; ++j) { const int n = (lane >> 3) + 8 * j; const LAS float* s = scr + (8 * c) * 33 + n;
        v4u o; o.x = pk2(s[0 * 33], s[1 * 33]); o.y = pk2(s[2 * 33], s[3 * 33]); o.z = pk2(s[4 * 33], s[5 * 33]); o.w = pk2(s[6 * 33], s[7 * 33]);
        *(v4u*)(WT + (size_t)(drow0 + n) * K + k0 + 8 * c) = o; }
    LDS_WAIT(); asm volatile("" ::: "memory");
}
__device__ __forceinline__ void transpose_set(Frame& F, const float* W, int nmat, int K, int N, int NP, bf16* WT, int& itbase) {
    LAS float* scr = (LAS float*)(F.lds + RING_OFF + F.wave * 16384);
    const int gw = F.bid * NWAVES + F.wave, NGW = F.G * NWAVES;
    const int nkb = K / 64, nnb = NP / 32, per = nkb * nnb, total = nmat * per;
    int first = (gw - (itbase % NGW) + NGW) % NGW;
    for (int it = first; it < total; it += NGW) { const int mi = it / per, r = it % per, kb = r / nnb, nb = r % nnb;
        transpose_item(W + (size_t)mi * K * N, K, N, WT + (size_t)mi * NP * K, nb * 32, scr, kb * 64, nb * 32, F.lane); }
    itbase += total;
}
__device__ __forceinline__ void prologue_weights(Frame& F) {
 int itb = 0;
    transpose_set(F, kin(I_EV_W_IN), 2, 1024, EVEN_IN, EVEN_INP, (bf16*)(F.ws + WS_W_EVIN), itb);
    transpose_set(F, kin(I_OD_W_IN), 2, 1024, ODD_IN, ODD_INP, (bf16*)(F.ws + WS_W_ODIN), itb);
    transpose_set(F, kin(I_MLA_WQUP), 2, 384, 768, 768, (bf16*)(F.ws + WS_W_QUP), itb);
    transpose_set(F, kin(I_MLA_WKVUP), 2, 256, 1024, 1024, (bf16*)(F.ws + WS_W_KVUP), itb);
    transpose_set(F, kin(I_EV_W_OUT), 2, 1024, 1024, 1024, (bf16*)(F.ws + WS_W_EVOUT), itb);
    transpose_set(F, kin(I_OD_W_OUT), 2, 1024, 1024, 1024, (bf16*)(F.ws + WS_W_ODOUT), itb);
    transpose_set(F, kin(I_S5_WGLU), 2, 512, 512, 512, (bf16*)(F.ws + WS_W_GLU), itb);
    transpose_set(F, kin(I_PLE_WP), 4, 256, 1024, 1024, (bf16*)(F.ws + WS_W_PLEP), itb);
    transpose_set(F, kin(I_PLE_WG), 4, 1024, 1024, 1024, (bf16*)(F.ws + WS_W_PLEG), itb);
}
__device__ __forceinline__ void moe_weights(Frame& F, int layer) {

    LAS float* scr = (LAS float*)(F.lds + RING_OFF + F.wave * 16384);
    const int gw = F.bid * NWAVES + F.wave, NGW = F.G * NWAVES;
    const float* wg = kin(I_MOE_WG) + (size_t)layer * 32 * 1024 * 512; const float* wu = kin(I_MOE_WU) + (size_t)layer * 32 * 1024 * 512; const float* wd = kin(I_MOE_WD) + (size_t)layer * 32 * 512 * 1024;
    bf16* WGU = (bf16*)(F.ws + WS_W_MOEGU); bf16* WD = (bf16*)(F.ws + WS_W_MOED);
    for (int it = gw; it < 2 * 32 * 256; it += NGW) { const int which = it / (32 * 256), r0 = it % (32 * 256), e = r0 / 256, r = r0 % 256, kb = r / 16, nb = r % 16, n0 = nb * 32;
        const int drow = 256 * (n0 / 128) + (n0 % 128) + which * 128;
        transpose_item((which ? wu : wg) + (size_t)e * 1024 * 512, 1024, 512, WGU + (size_t)e * 1024 * 1024, drow, scr, kb * 64, n0, F.lane); }
    for (int it = gw; it < 32 * 256; it += NGW) { const int e = it / 256, r = it % 256, kb = r / 32, nb = r % 32;
        transpose_item(wd + (size_t)e * 512 * 1024, 512, 1024, WD + (size_t)e * 1024 * 512, nb * 32, scr, kb * 64, nb * 32, F.lane); }
}

__device__ __forceinline__ void rms_row_to_bf16(const float* xrow, const float* gain, bf16* orow, float* copy, int lane) {
    const f32x4* xr = (const f32x4*)xrow + lane; f32x4 v[4]; float s = 0.f;
#pragma unroll
    for (int j = 0; j < 4; ++j) { v[j] = xr[64 * j]; s += (v[j].x * v[j].x + v[j].y * v[j].y) + (v[j].z * v[j].z + v[j].w * v[j].w); }
    const float r = 1.0f / sqrtf(wave_sum(s) * (1.f / 1024.f) + RMS_EPS);
    if (copy) {
#pragma unroll
        for (int j = 0; j < 4; ++j) ((f32x4*)copy + lane)[64 * j] = v[j]; }
    unsigned long long* o8 = (unsigned long long*)orow + lane;
#pragma unroll
    for (int j = 0; j < 4; ++j) { const f32x4 g = ((const f32x4*)gain + lane)[64 * j];
        o8[64 * j] = (unsigned long long)pk2(v[j].x * r * g.x, v[j].y * r * g.y) | ((unsigned long long)pk2(v[j].z * r * g.z, v[j].w * r * g.w) << 32); }
}
__device__ __forceinline__ void phase_norm(Frame& F, const float* src, const float* gain, float* copy) {
    bf16* ABF = (bf16*)(F.ws + WS_ABF);
    const int gw = F.bid * NWAVES + F.wave, NGW = F.G * NWAVES;
    for (int m = gw; m < NTOK; m += NGW) rms_row_to_bf16(src + (size_t)m * DM, gain, ABF + (size_t)m * DM, copy ? copy + (size_t)m * DM : nullptr, F.lane);
}
__device__ __forceinline__ void phase_pconv(Frame& F, int layer) {
    const float* p = kin(I_P) + (size_t)layer * NTOK * PLE; bf16* PBF = (bf16*)(F.ws + WS_PBF);
    const size_t n4 = (size_t)NTOK * PLE / 4; const size_t gt = (size_t)F.bid * 512 + F.tid, NT = (size_t)F.G * 512;
    for (size_t i = gt; i < n4; i += NT) { const f32x4 v = ((const f32x4*)p)[i]; v2u o; o.x = pk2(v.x, v.y); o.y = pk2(v.z, v.w); ((v2u*)PBF)[i] = o; }
}

__device__ __forceinline__ void phase_even_post(Frame& F, int j) {

    bf16* PROJ = (bf16*)(F.ws + WS_PROJ); bf16* CQN = (bf16*)(F.ws + WS_CQN); bf16* CKVN = (bf16*)(F.ws + WS_CKVN); float* LOGF = (float*)(F.ws + WS_LOGF);
    const float* qn = kin(I_FOX_QN) + j * 64; const float* kn = kin(I_FOX_KN) + j * 64; const float* bfv = kin(I_FOX_BF) + j * 8;
    const float* qan = kin(I_MLA_QAN) + j * 384; const float* kvan = kin(I_MLA_KVAN) + j * 256;
    const int gw = F.bid * NWAVES + F.wave, NGW = F.G * NWAVES, lane = F.lane;
    for (int m = gw; m < NTOK; m += NGW) {
        bf16* row = PROJ + (size_t)m * EVEN_INP;
#pragma unroll
        for (int w = 0; w < 2; ++w) {
            v4u* p = (v4u*)(row + (w ? E_FK : E_FQ)) + lane; const v4u x = *p;
            float f[8] = {bflo(x.x), bfhi(x.x), bflo(x.y), bfhi(x.y), bflo(x.z), bfhi(x.z), bflo(x.w), bfhi(x.w)};
            float s = 0.f;
#pragma unroll
            for (int i = 0; i < 8; ++i) s += f[i] * f[i];
            s += __shfl_xor(s, 1); s += __shfl_xor(s, 2); s += __shfl_xor(s, 4);
            const float r = (1.0f / sqrtf(s * (1.f / 64.f) + RMS_EPS)) * (w ? 1.0f : C2_FOX); const float* g = (w ? kn : qn) + (lane & 7) * 8;
            v4u o; o.x = pk2(f[0] * r * g[0], f[1] * r * g[1]); o.y = pk2(f[2] * r * g[2], f[3] * r * g[3]); o.z = pk2(f[4] * r * g[4], f[5] * r * g[5]); o.w = pk2(f[6] * r * g[6], f[7] * r * g[7]);
            *p = o;
        }
        if (lane < 8) { const float z = bf2f(row[E_FLOG + lane]) + bfv[lane]; LOGF[(size_t)m * 8 + lane] = -softplusf_(-z); }
        {
            float f[6]; float s = 0.f;
#pragma unroll
            for (int i = 0; i < 3; ++i) { const unsigned x = *((const unsigned*)(row + E_CQ) + lane + 64 * i); f[2 * i] = bflo(x); f[2 * i + 1] = bfhi(x); s += f[2 * i] * f[2 * i] + f[2 * i + 1] * f[2 * i + 1]; }
            const float r = 1.0f / sqrtf(wave_sum(s) * (1.f / 384.f) + RMS_EPS);
#pragma unroll
            for (int i = 0; i < 3; ++i) { const int c = 2 * (lane + 64 * i); *((unsigned*)(CQN + (size_t)m * 384) + lane + 64 * i) = pk2(f[2 * i] * r * qan[c], f[2 * i + 1] * r * qan[c + 1]); }
        }
        {
            float f[4]; float s = 0.f;
#pragma unroll
            for (int i = 0; i < 2; ++i) { const unsigned x = *((const unsigned*)(row + E_CKV) + lane + 64 * i); f[2 * i] = bflo(x); f[2 * i + 1] = bfhi(x); s += f[2 * i] * f[2 * i] + f[2 * i + 1] * f[2 * i + 1]; }
            const float r = 1.0f / sqrtf(wave_sum(s) * (1.f / 256.f) + RMS_EPS);
#pragma unroll
            for (int i = 0; i < 2; ++i) { const int c = 2 * (lane + 64 * i); *((unsigned*)(CKVN + (size_t)m * 256) + lane + 64 * i) = pk2(f[2 * i] * r * kvan[c], f[2 * i + 1] * r * kvan[c + 1]); }
        }
    }
}
__device__ __forceinline__ void phase_cumsum(Frame& F) {
    if (F.bid >= 16) return;
    const float* LOGF = (const float*)(F.ws + WS_LOGF); float* CUM = (float*)(F.ws + WS_CUM);
    const int b = F.bid >> 3, h = F.bid & 7, t0 = F.tid * 32;
    LAS double* part = (LAS double*)(F.lds + RING_OFF);
    float v[32]; double s = 0.0;
#pragma unroll
    for (int i = 0; i < 32; ++i) { v[i] = LOGF[((size_t)b * SEQ + t0 + i) * 8 + h]; s += (double)v[i]; }
    part[F.tid] = s; __syncthreads();
    if (F.tid == 0) { double run = 0.0; for (int i = 0; i < 512; ++i) { const double x = part[i]; part[i] = run; run += x; } }
    __syncthreads();
    double run = part[F.tid];
#pragma unroll
    for (int i = 0; i < 32; ++i) { run += (double)v[i]; CUM[((size_t)b * SEQ + t0 + i) * 8 + h] = (float)run; }
    __syncthreads();
}
__device__ __forceinline__ void phase_mla_post(Frame& F, int j) {

    const bf16* PROJ = (const bf16*)(F.ws + WS_PROJ); bf16* QM = (bf16*)(F.ws + WS_QM); const bf16* KVB = (const bf16*)(F.ws + WS_KVB); bf16* KM = (bf16*)(F.ws + WS_KM);
    const float* qn = kin(I_MLA_QN) + j * 96; const float* kn = kin(I_MLA_KN) + j * 96; const int* pos = (const int*)kin(I_POS);
    const int gw = F.bid * NWAVES + F.wave, NGW = F.G * NWAVES, lane = F.lane, l32 = lane & 31, hh = lane >> 5;
    const int fi = l32 & 15; const float inv = expf(-(float)fi * (1.0f / 16.0f) * 9.210340371976184f);
    for (int m = gw; m < NTOK; m += NGW) {
        const float ang = (float)pos[m] * inv; float sn, cs; sincosf(ang, &sn, &cs);
        const float krope = bf2f(PROJ[(size_t)m * EVEN_INP + E_KROPE + l32]);
#pragma unroll
        for (int hp = 0; hp < 4; ++hp) { const int h = hp * 2 + hh;
#pragma unroll
            for (int w = 0; w < 2; ++w) {
                float f[3];
                if (w == 0) { const bf16* q = QM + (size_t)m * 768 + h * 96; f[0] = bf2f(q[l32]); f[1] = bf2f(q[l32 + 32]); f[2] = bf2f(q[l32 + 64]); }
                else { const bf16* k = KVB + (size_t)m * 1024 + h * 128; f[0] = bf2f(k[l32]); f[1] = bf2f(k[l32 + 32]); f[2] = krope; }
                float s = f[0] * f[0] + f[1] * f[1] + f[2] * f[2];
                s += __shfl_xor(s, 1); s += __shfl_xor(s, 2); s += __shfl_xor(s, 4); s += __shfl_xor(s, 8); s += __shfl_xor(s, 16);
                const float r = 1.0f / sqrtf(s * (1.f / 96.f) + RMS_EPS); const float* g = w ? kn : qn;
                f[0] *= r * g[l32]; f[1] *= r * g[l32 + 32]; f[2] *= r * g[l32 + 64];
                const float other = __shfl_xor(f[2], 16);
                const float rot = (l32 < 16) ? (f[2] * cs - other * sn) : (other * sn + f[2] * cs);
                bf16* o = (w ? KM : QM) + (size_t)m * 768 + h * 96; const float qs = w ? 1.0f : C2_MLA;
                o[l32] = (bf16)f2bf(f[0] * qs); o[l32 + 32] = (bf16)f2bf(f[1] * qs); o[l32 + 64] = (bf16)f2bf(rot * qs);
            }
        }
    }
}
template <int DK> __device__ __forceinline__ void attn_naive_unit(Frame& F, const bf16* Qp, int qld, const bf16* Kp, int kld, const bf16* Vp, int vld, const float* cum  , float scale, bf16* Op, int qb) {
    LAS float* Ks = (LAS float*)(F.lds + RING_OFF); LAS float* Vs = Ks + 64 * DK; LAS float* Cs = Vs + 64 * 64;
    const int t = qb * 512 + F.wave * 64 + F.lane; const int tmax_w = qb * 512 + F.wave * 64 + 63;
    float q[DK];
#pragma unroll
    for (int d = 0; d < DK; d += 8) { const v4u x = *(const v4u*)(Qp + (size_t)t * qld + d);
        q[d] = bflo(x.x) * scale; q[d + 1] = bfhi(x.x) * scale; q[d + 2] = bflo(x.y) * scale; q[d + 3] = bfhi(x.y) * scale; q[d + 4] = bflo(x.z) * scale; q[d + 5] = bfhi(x.z) * scale; q[d + 6] = bflo(x.w) * scale; q[d + 7] = bfhi(x.w) * scale; }
    const float cq = cum ? cum[(size_t)t * 8] : 0.f;
    float acc[64];
#pragma unroll
    for (int d = 0; d < 64; ++d) acc[d] = 0.f;
    float mx = -1e30f, l = 0.f;
    const int nkb = (qb * 512 + 512) / 64;
    for (int kb = 0; kb < nkb; ++kb) {
        __syncthreads();
        for (int i = F.tid; i < 64 * DK / 8; i += 512) { const int key = i / (DK / 8), c = (i % (DK / 8)) * 8; const v4u x = *(const v4u*)(Kp + (size_t)(kb * 64 + key) * kld + c);
            LAS float* d = Ks + key * DK + c; d[0] = bflo(x.x); d[1] = bfhi(x.x); d[2] = bflo(x.y); d[3] = bfhi(x.y); d[4] = bflo(x.z); d[5] = bfhi(x.z); d[6] = bflo(x.w); d[7] = bfhi(x.w); }
        { const int i = F.tid; const int key = i / 8, c = (i % 8) * 8; const v4u x = *(const v4u*)(Vp + (size_t)(kb * 64 + key) * vld + c);
            LAS float* d = Vs + key * 64 + c; d[0] = bflo(x.x); d[1] = bfhi(x.x); d[2] = bflo(x.y); d[3] = bfhi(x.y); d[4] = bflo(x.z); d[5] = bfhi(x.z); d[6] = bflo(x.w); d[7] = bfhi(x.w); }
        if (F.tid < 64) Cs[F.tid] = cum ? cum[(size_t)(kb * 64 + F.tid) * 8] : 0.f;
        __syncthreads();
        if (kb * 64 > tmax_w) continue;
        for (int jk = 0; jk < 64; ++jk) {
            const int s = kb * 64 + jk; if (s > tmax_w) break;
            const LAS float* kr = Ks + jk * DK; float dot = 0.f;
#pragma unroll
            for (int d = 0; d < DK; d += 4) { const f32x4 kv = *(const LAS f32x4*)(kr + d); dot += q[d] * kv.x + q[d + 1] * kv.y + q[d + 2] * kv.z + q[d + 3] * kv.w; }
            float logit = dot + (cq - Cs[jk]); if (s > t) logit = -1e30f;
            if (__any(logit > mx)) { const float mn = fmaxf(mx, logit); const float corr = expf(mx - mn); l *= corr;
#pragma unroll
                for (int d = 0; d < 64; ++d) acc[d] *= corr;
                mx = mn; }
            const float p = (s > t) ? 0.f : expf(logit - mx); l += p;
            const LAS float* vr = Vs + jk * 64;
#pragma unroll
            for (int d = 0; d < 64; d += 4) { const f32x4 vv = *(const LAS f32x4*)(vr + d); acc[d] += p * vv.x; acc[d + 1] += p * vv.y; acc[d + 2] += p * vv.z; acc[d + 3] += p * vv.w; }
        }
    }
    const float il = 1.0f / l; bf16* o = Op + (size_t)t * DM;
#pragma unroll
    for (int d = 0; d < 64; d += 8) { v4u w; w.x = pk2(acc[d] * il, acc[d + 1] * il); w.y = pk2(acc[d + 2] * il, acc[d + 3] * il); w.z = pk2(acc[d + 4] * il, acc[d + 5] * il); w.w = pk2(acc[d + 6] * il, acc[d + 7] * il); *(v4u*)(o + d) = w; }
}
__device__ __forceinline__ void phase_attn_naive(Frame& F) {
    const bf16* PROJ = (const bf16*)(F.ws + WS_PROJ); const bf16* QM = (const bf16*)(F.ws + WS_QM); const bf16* KVB = (const bf16*)(F.ws + WS_KVB); const bf16* KM = (const bf16*)(F.ws + WS_KM);
    const float* CUM = (const float*)(F.ws + WS_CUM); bf16* MIX = (bf16*)(F.ws + WS_MIX);
    for (int p = F.bid; p < 512; p += F.G) {
        const int combo = p >> 4, qq = p & 15; const int type = combo >> 4, b = (combo >> 3) & 1, h = combo & 7;
#pragma unroll 1
        for (int half = 0; half < 2; ++half) { const int qb = half ? 31 - qq : qq; const size_t rb = (size_t)b * SEQ;
            if (type == 0) attn_naive_unit<64>(F, PROJ + rb * EVEN_INP + E_FQ + h * 64, EVEN_INP, PROJ + rb * EVEN_INP + E_FK + h * 64, EVEN_INP, PROJ + rb * EVEN_INP + E_FV + h * 64, EVEN_INP, CUM + rb * 8 + h, LN2, MIX + rb * DM + h * 64, qb);
            else attn_naive_unit<96>(F, QM + rb * 768 + h * 96, 768, KM + rb * 768 + h * 96, 768, KVB + rb * 1024 + h * 128 + 64, 1024, nullptr, LN2, MIX + rb * DM + 512 + h * 64, qb);
        }
    }
    __syncthreads();
}

__device__ __forceinline__ void s5_scan_wave(Frame& F, int j, int b, int g) {
 const int p = F.lane;
    const bf16* PROJ = (const bf16*)(F.ws + WS_PROJ); bf16* HG = (bf16*)(F.ws + WS_HG);
    const float lr = fminf(kin(I_S5_ARE)[(j * 32 + g) * 64 + p], -1e-4f), li = kin(I_S5_AIM)[(j * 32 + g) * 64 + p];
    const float dt = expf(kin(I_S5_LS)[j * 32 + g]);
    const float mag = expf(lr * dt); const float abr = mag * cosf(li * dt), abi = mag * sinf(li * dt);
    const float den = lr * lr + li * li, nr = abr - 1.0f, ni = abi;
    const float gr = (nr * lr + ni * li) / den, gi = (ni * lr - nr * li) / den;
    float bbr[16], bbi[16], cr[16], ci[16], dsk[16];
#pragma unroll
    for (int c = 0; c < 16; ++c) { const float br = kin(I_S5_BRE)[((size_t)(j * 32 + g) * 64 + p) * 16 + c], bi = kin(I_S5_BIM)[((size_t)(j * 32 + g) * 64 + p) * 16 + c];
        bbr[c] = gr * br - gi * bi; bbi[c] = gr * bi + gi * br;
        cr[c] = kin(I_S5_CRE)[((size_t)(j * 32 + g) * 16 + c) * 64 + p]; ci[c] = kin(I_S5_CIM)[((size_t)(j * 32 + g) * 16 + c) * 64 + p];
        dsk[c] = kin(I_S5_D)[j * 512 + g * 16 + c]; }
    float xr = 0.f, xi = 0.f;
    const bf16* up = PROJ + (size_t)b * SEQ * ODD_INP + O_U + g * 16;
    v4u cur0[4], cur1[4], nx0[4], nx1[4];
#pragma unroll
    for (int i = 0; i < 4; ++i) { cur0[i] = *(const v4u*)(up + (size_t)i * ODD_INP); cur1[i] = *(const v4u*)(up + (size_t)i * ODD_INP + 8); }
    for (int t0 = 0; t0 < SEQ; t0 += 4) {
        const int tn = (t0 + 4 < SEQ) ? t0 + 4 : t0;
#pragma unroll
        for (int i = 0; i < 4; ++i) { nx0[i] = *(const v4u*)(up + (size_t)(tn + i) * ODD_INP); nx1[i] = *(const v4u*)(up + (size_t)(tn + i) * ODD_INP + 8); }
#pragma unroll
        for (int i = 0; i < 4; ++i) {
            float u[16] = {bflo(cur0[i].x), bfhi(cur0[i].x), bflo(cur0[i].y), bfhi(cur0[i].y), bflo(cur0[i].z), bfhi(cur0[i].z), bflo(cur0[i].w), bfhi(cur0[i].w),
                           bflo(cur1[i].x), bfhi(cur1[i].x), bflo(cur1[i].y), bfhi(cur1[i].y), bflo(cur1[i].z), bfhi(cur1[i].z), bflo(cur1[i].w), bfhi(cur1[i].w)};
            float bur = 0.f, bui = 0.f;
#pragma unroll
            for (int c = 0; c < 16; ++c) { bur += bbr[c] * u[c]; bui += bbi[c] * u[c]; }
            const float nxr = abr * xr - abi * xi + bur, nxi = abr * xi + abi * xr + bui; xr = nxr; xi = nxi;
            float y[16];
#pragma unroll
            for (int c = 0; c < 16; ++c) y[c] = wave_sum(cr[c] * xr - ci[c] * xi);
            if (p < 16) { float yy = 0.f, uu = 0.f, dd = 0.f;
#pragma unroll
                for (int c = 0; c < 16; ++c) if (p == c) { yy = y[c]; uu = u[c]; dd = dsk[c]; }
                HG[((size_t)b * SEQ + t0 + i) * 512 + g * 16 + p] = (bf16)f2bf(gelu_tanh(yy + dd * uu)); }
        }
#pragma unroll
        for (int i = 0; i < 4; ++i) { cur0[i] = nx0[i]; cur1[i] = nx1[i]; }
    }
}
__device__ __forceinline__ void gdn_prep_token(Frame& F, int j, int m) {
 const int lane = F.lane;
    const bf16* PROJ = (const bf16*)(F.ws + WS_PROJ); float* QG = (float*)(F.ws + WS_QG); float* KG = (float*)(F.ws + WS_KG); float* VG = (float*)(F.ws + WS_VG);
    float* GB = (float*)(F.ws + WS_GB); float* BETA = (float*)(F.ws + WS_BETA);
    const float* cw = kin(I_GDN_CONV) + (size_t)j * 4 * 1536;
    const int s = m % SEQ;
#pragma unroll
    for (int w = 0; w < 3; ++w) {
        const int ch0 = w * 512 + lane * 8; float acc[8];
#pragma unroll
        for (int i = 0; i < 8; ++i) acc[i] = 0.f;
#pragma unroll
        for (int tap = 0; tap < 4; ++tap) { const int ss = s - 3 + tap; if (ss < 0) continue;
            const v4u x = *(const v4u*)(PROJ + (size_t)(m - 3 + tap) * ODD_INP + O_Q + ch0); const float* wv = cw + tap * 1536 + ch0;
            acc[0] += wv[0] * bflo(x.x); acc[1] += wv[1] * bfhi(x.x); acc[2] += wv[2] * bflo(x.y); acc[3] += wv[3] * bfhi(x.y); acc[4] += wv[4] * bflo(x.z); acc[5] += wv[5] * bfhi(x.z); acc[6] += wv[6] * bflo(x.w); acc[7] += wv[7] * bfhi(x.w); }
        float ss2 = 0.f;
#pragma unroll
        for (int i = 0; i < 8; ++i) { acc[i] = acc[i] * sigm(acc[i]); ss2 += acc[i] * acc[i]; }
        float sc = 1.0f;
        if (w < 2) { ss2 += __shfl_xor(ss2, 1); ss2 += __shfl_xor(ss2, 2); ss2 += __shfl_xor(ss2, 4); ss2 += __shfl_xor(ss2, 8); sc = 1.0f / sqrtf(ss2 + RMS_EPS); if (w == 0) sc *= 0.08838834764831845f; }
        float* dst = (w == 0 ? QG : (w == 1 ? KG : VG)) + (size_t)m * 512 + lane * 8;
        *(f32x4*)dst = (f32x4){acc[0] * sc, acc[1] * sc, acc[2] * sc, acc[3] * sc}; *(f32x4*)(dst + 4) = (f32x4){acc[4] * sc, acc[5] * sc, acc[6] * sc, acc[7] * sc};
    }
    if (lane < 4) { const float gin = bf2f(PROJ[(size_t)m * ODD_INP + O_GIN + lane]), bin = bf2f(PROJ[(size_t)m * ODD_INP + O_BETA + lane]);
        GB[(size_t)m * 4 + lane] = -expf(kin(I_GDN_ALOG)[j * 4 + lane]) * softplusf_(gin + kin(I_GDN_DTB)[j * 4 + lane]); BETA[(size_t)m * 4 + lane] = sigm(bin); }
}
__device__ __forceinline__ void phase_gdn_prep(Frame& F, int j) {
    const int gw = F.bid * NWAVES + F.wave, NGW = F.G * NWAVES;
    for (int m = gw; m < NTOK; m += NGW) gdn_prep_token(F, j, m);
}
__device__ __forceinline__ void phase_odd_a(Frame& F, int j) {
    if (F.wave == 0 && F.bid < 64) { s5_scan_wave(F, j, F.bid >> 5, F.bid & 31); return; }
    const int nbusy = (F.G < 64 ? F.G : 64);
    const int widx = (F.bid < 64) ? F.bid * 7 + (F.wave - 1) : nbusy * 7 + (F.bid - 64) * 8 + F.wave;
    const int nw = nbusy * 7 + (F.G > 64 ? (F.G - 64) * 8 : 0);
    for (int m = widx; m < NTOK; m += nw) gdn_prep_token(F, j, m);
}
__device__ __forceinline__ void phase_gdn_naive(Frame& F) {
    const float* QG = (const float*)(F.ws + WS_QG); const float* KG = (const float*)(F.ws + WS_KG); const float* VG = (const float*)(F.ws + WS_VG);
    const float* GB = (const float*)(F.ws + WS_GB); const float* BETA = (const float*)(F.ws + WS_BETA); float* OG = (float*)(F.ws + WS_OG);
    const int lane = F.lane; const int NGW = F.G * NWAVES;
    for (int u = F.wave * F.G + F.bid; u < 1024; u += NGW) {
        const int b = u >> 9, h = (u >> 7) & 3, c = u & 127; const size_t rb = (size_t)b * SEQ;
        const float* kq = KG + rb * 512 + h * 128 + lane; const float* qq = QG + rb * 512 + h * 128 + lane; const float* vq = VG + rb * 512 + h * 128 + c;
        const float* gq = GB + rb * 4 + h; const float* bq = BETA + rb * 4 + h; float* oq = OG + rb * 512 + h * 128 + c;
        float s0 = 0.f, s1 = 0.f;
        float k0[8], k1[8], q0[8], q1[8], vv[8], gg[8], bb[8], nk0[8], nk1[8], nq0[8], nq1[8], nv[8], ng[8], nb[8];
#pragma unroll
        for (int i = 0; i < 8; ++i) { k0[i] = kq[(size_t)i * 512]; k1[i] = kq[(size_t)i * 512 + 64]; q0[i] = qq[(size_t)i * 512]; q1[i] = qq[(size_t)i * 512 + 64]; vv[i] = vq[(size_t)i * 512]; gg[i] = gq[i * 4]; bb[i] = bq[i * 4]; }
        for (int t0 = 0; t0 < SEQ; t0 += 8) {
            const int tn = (t0 + 8 < SEQ) ? t0 + 8 : t0;
#pragma unroll
            for (int i = 0; i < 8; ++i) { const size_t o = (size_t)(tn + i) * 512; nk0[i] = kq[o]; nk1[i] = kq[o + 64]; nq0[i] = qq[o]; nq1[i] = qq[o + 64]; nv[i] = vq[o]; ng[i] = gq[(tn + i) * 4]; nb[i] = bq[(tn + i) * 4]; }
#pragma unroll
            for (int i = 0; i < 8; ++i) {
                const float ks = wave_sum(k0[i] * s0 + k1[i] * s1); const float eg = expf(gg[i]); const float be = bb[i];
                s0 = eg * (s0 - be * k0[i] * ks) + be * k0[i] * vv[i]; s1 = eg * (s1 - be * k1[i] * ks) + be * k1[i] * vv[i];
                const float o = wave_sum(q0[i] * s0 + q1[i] * s1);
                if (lane == 0) oq[(size_t)(t0 + i) * 512] = o;
            }
#pragma unroll
            for (int i = 0; i < 8; ++i) { k0[i] = nk0[i]; k1[i] = nk1[i]; q0[i] = nq0[i]; q1[i] = nq1[i]; vv[i] = nv[i]; gg[i] = ng[i]; bb[i] = nb[i]; }
        }
    }
}
__device__ __forceinline__ void phase_gdn_out(Frame& F, int j) {
 const float* OG = (const float*)(F.ws + WS_OG); const bf16* PROJ = (const bf16*)(F.ws + WS_PROJ); bf16* MIX = (bf16*)(F.ws + WS_MIX);
    const float* on = kin(I_GDN_ONORM) + j * 128; const int lane = F.lane;
    const int gw = F.bid * NWAVES + F.wave, NGW = F.G * NWAVES;
    for (int m = gw; m < NTOK; m += NGW) {
        const f32x4 a = *(const f32x4*)(OG + (size_t)m * 512 + lane * 8), b = *(const f32x4*)(OG + (size_t)m * 512 + lane * 8 + 4);
        float f[8] = {a.x, a.y, a.z, a.w, b.x, b.y, b.z, b.w}; float s = 0.f;
#pragma unroll
        for (int i = 0; i < 8; ++i) s += f[i] * f[i];
        s += __shfl_xor(s, 1); s += __shfl_xor(s, 2); s += __shfl_xor(s, 4); s += __shfl_xor(s, 8);
        const float r = 1.0f / sqrtf(s * (1.f / 128.f) + RMS_EPS);
        const bf16* z = PROJ + (size_t)m * ODD_INP + O_Z + lane * 8; const float* g = on + (lane & 15) * 8; float o[8];
#pragma unroll
        for (int i = 0; i < 8; ++i) { const float zz = bf2f(z[i]); o[i] = f[i] * r * g[i] * (zz * sigm(zz)); }
        v4u w; w.x = pk2(o[0], o[1]); w.y = pk2(o[2], o[3]); w.z = pk2(o[4], o[5]); w.w = pk2(o[6], o[7]);
        *(v4u*)(MIX + (size_t)m * DM + 512 + lane * 8) = w;
    }
}

__device__ __forceinline__ void phase_router(Frame& F, int layer) {
 const float* H = kout(); bf16* ABF = (bf16*)(F.ws + WS_ABF);
    const float* gain = kin(I_NORM_FFN) + layer * DM; const float* wgr = kin(I_MOE_WGRP) + (size_t)layer * DM * 4; const float* bgr = kin(I_MOE_BGRP) + layer * 4;
    const float* wex = kin(I_MOE_WEXP) + (size_t)layer * DM * 32; const float* bex = kin(I_MOE_BEXP) + layer * 32;
    int* TOKE = (int*)(F.ws + WS_TOKE); float* TOKW = (float*)(F.ws + WS_TOKW);
    LAS int* lcnt = (LAS int*)(F.lds + LDSCTL_OFF + LC_MOE + 512); LAS int* gbase = (LAS int*)(F.lds + LDSCTL_OFF + LC_MOE + 640);
    const int lane = F.lane; const int per = NTOK / F.G;
    LAS int* lasg = (LAS int*)(F.lds + RING_OFF);
    if (F.tid < 32) lcnt[F.tid] = 0;
    __syncthreads();
    for (int tl = F.wave; tl < per; tl += NWAVES) {
        const int m = F.bid * per + tl;
        const f32x4* xr = (const f32x4*)(H + (size_t)m * DM) + lane; f32x4 v[4]; float s = 0.f;
#pragma unroll
        for (int q = 0; q < 4; ++q) { v[q] = xr[64 * q]; s += (v[q].x * v[q].x + v[q].y * v[q].y) + (v[q].z * v[q].z + v[q].w * v[q].w); }
        const float r = 1.0f / sqrtf(wave_sum(s) * (1.f / 1024.f) + RMS_EPS);
        unsigned long long* o8 = (unsigned long long*)(ABF + (size_t)m * DM) + lane;
#pragma unroll
        for (int q = 0; q < 4; ++q) { const f32x4 g = ((const f32x4*)gain + lane)[64 * q]; v[q].x *= r * g.x; v[q].y *= r * g.y; v[q].z *= r * g.z; v[q].w *= r * g.w;
            o8[64 * q] = (unsigned long long)pk2(v[q].x, v[q].y) | ((unsigned long long)pk2(v[q].z, v[q].w) << 32); }
        float lg[4] = {0.f, 0.f, 0.f, 0.f};
#pragma unroll
        for (int q = 0; q < 4; ++q) { const int k0 = 4 * lane + 256 * q;
#pragma unroll
            for (int e = 0; e < 4; ++e) { const f32x4 w = *(const f32x4*)(wgr + (size_t)(k0 + e) * 4); const float x = v[q][e]; lg[0] += x * w.x; lg[1] += x * w.y; lg[2] += x * w.z; lg[3] += x * w.w; } }
#pragma unroll
        for (int g = 0; g < 4; ++g) lg[g] = wave_sum(lg[g]) + bgr[g];
        int gi = 0; float gm = lg[0];
#pragma unroll
        for (int g = 1; g < 4; ++g) if (lg[g] > gm) { gm = lg[g]; gi = g; }
        float gden = 0.f;
#pragma unroll
        for (int g = 0; g < 4; ++g) gden += expf(lg[g] - gm);
        const float gw_ = 1.0f / gden;
        float le[8] = {0.f, 0.f, 0.f, 0.f, 0.f, 0.f, 0.f, 0.f};
#pragma unroll
        for (int q = 0; q < 4; ++q) { const int k0 = 4 * lane + 256 * q;
#pragma unroll
            for (int e = 0; e < 4; ++e) { const float* wp = wex + (size_t)(k0 + e) * 32 + gi * 8; const f32x4 w0 = *(const f32x4*)wp, w1 = *(const f32x4*)(wp + 4); const float x = v[q][e];
                le[0] += x * w0.x; le[1] += x * w0.y; le[2] += x * w0.z; le[3] += x * w0.w; le[4] += x * w1.x; le[5] += x * w1.y; le[6] += x * w1.z; le[7] += x * w1.w; } }
#pragma unroll
        for (int e = 0; e < 8; ++e) le[e] = wave_sum(le[e]) + bex[gi * 8 + e];
        int i0 = 0; float m0 = le[0];
#pragma unroll
        for (int e = 1; e < 8; ++e) if (le[e] > m0) { m0 = le[e]; i0 = e; }
        int i1 = -1; float m1 = -3.0e38f;
#pragma unroll
        for (int e = 0; e < 8; ++e) if (e != i0 && le[e] > m1) { m1 = le[e]; i1 = e; }
        const float e1 = expf(m1 - m0); const float w0 = gw_ / (1.0f + e1), w1 = gw_ * e1 / (1.0f + e1);
        if (lane == 0) { const int ea = gi * 8 + i0, eb = gi * 8 + i1;
            const int pa = __hip_atomic_fetch_add(lcnt + ea, 1, __ATOMIC_RELAXED, __HIP_MEMORY_SCOPE_WORKGROUP), pb = __hip_atomic_fetch_add(lcnt + eb, 1, __ATOMIC_RELAXED, __HIP_MEMORY_SCOPE_WORKGROUP);
            lasg[tl * 2] = ea | (pa << 8); lasg[tl * 2 + 1] = eb | (pb << 8);
            TOKW[(size_t)m * 2] = w0; TOKW[(size_t)m * 2 + 1] = w1; }
    }
    __syncthreads();
    if (F.tid < 32) gbase[F.tid] = (int)__hip_atomic_fetch_add(F.ctl + CW_CNT + 64 * layer + F.tid, (unsigned)lcnt[F.tid], __ATOMIC_RELAXED, __HIP_MEMORY_SCOPE_AGENT);
    __syncthreads();
    for (int i = F.tid; i < per * 2; i += 512) { const int a = lasg[i], e = a & 255, lp = a >> 8; TOKE[(size_t)F.bid * per * 2 + i] = e | ((gbase[e] + lp) << 8); }
    __syncthreads();
}
__device__ __forceinline__ void moe_tables(Frame& F, int layer) {
    LAS int* rowbase = (LAS int*)(F.lds + LDSCTL_OFF + LC_MOE); LAS unsigned char* tile_e = (LAS unsigned char*)(F.lds + LDSCTL_OFF + LC_MOE + 192);
    if (F.tid == 0) { int rb = 0;
#pragma unroll 1
        for (int e = 0; e < 32; ++e) { const int c = (int)__hip_atomic_load(F.ctl + CW_CNT + 64 * layer + e, __ATOMIC_RELAXED, __HIP_MEMORY_SCOPE_AGENT); rowbase[e] = rb; const int nt = (c + 255) >> 8;
            for (int i = 0; i < nt; ++i) tile_e[(rb >> 8) + i] = (unsigned char)e; rb += nt << 8; }
        rowbase[32] = rb; rowbase[34] = rb >> 8; }
    __syncthreads();
}
__device__ __forceinline__ void phase_moe_scatter(Frame& F, int layer) {
    moe_tables(F, layer);
    const LAS int* rowbase = (const LAS int*)(F.lds + LDSCTL_OFF + LC_MOE);
    const bf16* ABF = (const bf16*)(F.ws + WS_ABF); bf16* XG = (bf16*)(F.ws + WS_XG); const int* TOKE = (const int*)(F.ws + WS_TOKE); int* ROWS = (int*)(F.ws + WS_ROWS);
    const int gw = F.bid * NWAVES + F.wave, NGW = F.G * NWAVES, lane = F.lane;
    for (int m = gw; m < NTOK; m += NGW) {
        const v4u a = *((const v4u*)(ABF + (size_t)m * DM) + lane), b = *((const v4u*)(ABF + (size_t)m * DM) + 64 + lane);
#pragma unroll
        for (int k = 0; k < 2; ++k) { const int te = TOKE[(size_t)m * 2 + k]; const int row = rowbase[te & 255] + (te >> 8);
            *((v4u*)(XG + (size_t)row * DM) + lane) = a; *((v4u*)(XG + (size_t)row * DM) + 64 + lane) = b;
            if (lane == 0) ROWS[(size_t)m * 2 + k] = row; }
    }
}
struct MoeOrder {
    int ntiles, nN, G, c; const LAS unsigned char* tile_e; size_t bstride;
    __device__ bool next(int i, pg8::Unit& u) const { const long L = (long)i * G + c; if (L >= (long)ntiles * nN) return false; u.pm = (int)(L / nN); u.pn = (int)(L % nN); u.aux = __builtin_amdgcn_readfirstlane((int)tile_e[u.pm]); return true; }
    __device__ __forceinline__ const char* a_base(const pg8::Gemm& g, const pg8::Unit& u) const { return (const char*)g.A + (size_t)u.pm * 256 * g.lda * 2; }
    __device__ __forceinline__ const char* b_base(const pg8::Gemm& g, const pg8::Unit& u) const { return (const char*)g.Bt + (size_t)u.aux * bstride + (size_t)u.pn * 256 * g.ldb * 2; }
};
__device__ __forceinline__ void phase_moe_combine(Frame& F, int layer) {
 float* H = kout(); bf16* ABF = (bf16*)(F.ws + WS_ABF); const bf16* Y2 = (const bf16*)(F.ws + WS_Y2);
    const int* ROWS = (const int*)(F.ws + WS_ROWS); const float* TOKW = (const float*)(F.ws + WS_TOKW); const float* gain = kin(I_PLE_NORM) + layer * DM;
    const int gw = F.bid * NWAVES + F.wave, NGW = F.G * NWAVES, lane = F.lane;
    for (int m = gw; m < NTOK; m += NGW) {
        const int r0 = ROWS[(size_t)m * 2], r1 = ROWS[(size_t)m * 2 + 1]; const float w0 = TOKW[(size_t)m * 2], w1 = TOKW[(size_t)m * 2 + 1];
        f32x4* hr = (f32x4*)(H + (size_t)m * DM) + lane; f32x4 v[4]; float s = 0.f;
#pragma unroll
        for (int q = 0; q < 4; ++q) { v[q] = hr[64 * q]; const v2u ya = *((const v2u*)(Y2 + (size_t)r0 * DM) + lane + 64 * q), yb = *((const v2u*)(Y2 + (size_t)r1 * DM) + lane + 64 * q);
            v[q].x += w0 * bflo(ya.x) + w1 * bflo(yb.x); v[q].y += w0 * bfhi(ya.x) + w1 * bfhi(yb.x); v[q].z += w0 * bflo(ya.y) + w1 * bflo(yb.y); v[q].w += w0 * bfhi(ya.y) + w1 * bfhi(yb.y);
            hr[64 * q] = v[q]; s += (v[q].x * v[q].x + v[q].y * v[q].y) + (v[q].z * v[q].z + v[q].w * v[q].w); }
        const float r = 1.0f / sqrtf(wave_sum(s) * (1.f / 1024.f) + RMS_EPS);
        unsigned long long* o8 = (unsigned long long*)(ABF + (size_t)m * DM) + lane;
#pragma unroll
        for (int q = 0; q < 4; ++q) { const f32x4 g = ((const f32x4*)gain + lane)[64 * q];
            o8[64 * q] = (unsigned long long)pk2(v[q].x * r * g.x, v[q].y * r * g.y) | ((unsigned long long)pk2(v[q].z * r * g.z, v[q].w * r * g.w) << 32); }
    }
}
namespace att {
using bf16x8 = __attribute__((ext_vector_type(8))) short;
using s16x4 = __attribute__((ext_vector_type(4))) short;
using f32x16 = __attribute__((ext_vector_type(16))) float;
using u32x4 = __attribute__((ext_vector_type(4))) unsigned;
typedef float f32x2_t __attribute__((ext_vector_type(2))); typedef __bf16 bf16x2_t __attribute__((ext_vector_type(2)));
constexpr int KSLOT = 16384, VSLOT = 8192;
constexpr int L_K = 0, L_V = 2 * KSLOT, L_B = L_V + 2 * VSLOT, L_WS = L_B + 512, L_OST = L_WS + 8 * 256, L_BYTES = L_OST + 8 * 4096;
__device__ __forceinline__ int crow(int r, int hi) { return (r & 3) + 8 * (r >> 2) + 4 * hi; }
__device__ __forceinline__ void glds16(const void* gsrc, unsigned lds_dst) { unsigned keep;
    asm volatile("s_mov_b32 %0, m0\n\ts_mov_b32 m0, %2\n\ts_nop 0\n\tglobal_load_lds_dwordx4 %1, off\n\ts_mov_b32 m0, %0" : "=&s"(keep) : "v"(gsrc), "s"(lds_dst) : "memory"); }
__device__ __forceinline__ unsigned cvtpk(float lo, float hi) { f32x2_t v = {lo, hi}; bf16x2_t b = __builtin_convertvector(v, bf16x2_t); return __builtin_bit_cast(unsigned, b); }
#define ATT_WAIT_BAR() asm volatile("s_waitcnt vmcnt(0) lgkmcnt(0)\n\ts_barrier" ::: "memory")

template <int DK, bool BIAS>
__device__ __forceinline__ void attn_unit(const int tid, const int qb, const bf16* Qh, const int qp, const bf16* Kh, const int kp, const bf16* Vh, const int vp, const float* cumh  , bf16* Oh  , char* shm) {
    constexpr int ND = DK / 16, KCH = DK / 8;
    const int lane = tid & 63, r32 = lane & 31, hi = lane >> 5; const int wid = __builtin_amdgcn_readfirstlane(tid >> 6);
    const int q0 = qb * 256;
    const unsigned lds0 = (unsigned)(uintptr_t)shm;
    float* wsf = (float*)(shm + L_WS) + wid * 64;
    float* Bs = (float*)(shm + L_B);
    const bf16* ksrc = Kh + (size_t)lane * kp + wid * 8;
    const bf16* vsrc = Vh + (size_t)(16 * (wid & 3) + (lane >> 2)) * vp + (wid >> 2) * 32 + (lane & 3) * 8;
    const unsigned kdst = lds0 + L_K + wid * 1024, vdst = lds0 + L_V + wid * 1024;
    const int NT = (q0 + 256) / 64;
    const float cref = BIAS ? cumh[(size_t)q0 * 8] : 0.f;
#define ATT_DMA(t, slot) do { glds16(ksrc + (size_t)(t) * 64 * kp, (unsigned)__builtin_amdgcn_readfirstlane(kdst + (slot) * KSLOT)); \
        if (KCH > 8) glds16(ksrc + (size_t)(t) * 64 * kp + 64, (unsigned)__builtin_amdgcn_readfirstlane(kdst + (slot) * KSLOT + 8192)); \
        glds16(vsrc + (size_t)(t) * 64 * vp, (unsigned)__builtin_amdgcn_readfirstlane(vdst + (slot) * VSLOT)); } while (0)
    ATT_DMA(0, 0);
    if (BIAS && wid == 0) Bs[lane] = (cref - cumh[(size_t)lane * 8]) * 1.4426950408889634f;
    bf16x8 qr[ND];
#pragma unroll
    for (int d0 = 0; d0 < ND; ++d0) qr[d0] = *reinterpret_cast<const bf16x8*>(Qh + (size_t)(q0 + wid * 32 + r32) * qp + d0 * 16 + hi * 8);
    float mhat = 0.f, l_reg = 0.f; f32x16 o[2]; o[0] = f32x16{}; o[1] = f32x16{}; f32x16 negm = f32x16{};
    const int qrel = wid * 32 + r32;
    const int vb0 = (int)(lds0 + L_V) + ((lane >> 4) & 1) * 32 + (lane & 3) * 8 + (4 * hi + ((lane & 15) >> 2)) * 64;
    ATT_WAIT_BAR();
    for (int t = 0; t < NT; ++t) {
        const int cur = t & 1;
        float bnext = 0.f;
        if (t + 1 < NT) { ATT_DMA(t + 1, cur ^ 1); if (BIAS && wid == 0) bnext = cumh[(size_t)((t + 1) * 64 + lane) * 8]; }
        f32x16 p0, p1;
        { const char* kb = shm + L_K + cur * KSLOT + hi * 1024 + r32 * 16;
#pragma unroll
          for (int d0 = 0; d0 < ND; ++d0) { const bf16x8 b0 = *reinterpret_cast<const bf16x8*>(kb + d0 * 2048); const bf16x8 b1 = *reinterpret_cast<const bf16x8*>(kb + d0 * 2048 + 512);
            if (d0 == 0) { p0 = __builtin_amdgcn_mfma_f32_32x32x16_bf16(b0, qr[0], negm, 0, 0, 0); p1 = __builtin_amdgcn_mfma_f32_32x32x16_bf16(b1, qr[0], negm, 0, 0, 0); }
            else { p0 = __builtin_amdgcn_mfma_f32_32x32x16_bf16(b0, qr[d0], p0, 0, 0, 0); p1 = __builtin_amdgcn_mfma_f32_32x32x16_bf16(b1, qr[d0], p1, 0, 0, 0); } } }
        if (BIAS) { const float* bb = Bs + cur * 64 + 4 * hi;
#pragma unroll
            for (int g = 0; g < 4; ++g) { const f32x4 x0 = *(const f32x4*)(bb + 8 * g), x1 = *(const f32x4*)(bb + 32 + 8 * g);
#pragma unroll
                for (int e = 0; e < 4; ++e) { p0[4 * g + e] += x0[e]; p1[4 * g + e] += x1[e]; } } }
        if (t >= NT - 4) { const int kb0 = 64 * (t - (NT - 4)) + 4 * hi;
#pragma unroll
            for (int r = 0; r < 16; ++r) { const int kv = kb0 + (r & 3) + 8 * (r >> 2); if (kv > qrel) p0[r] = -INFINITY; if (kv + 32 > qrel) p1[r] = -INFINITY; } }
        float rm = fmaxf(p0[0], p1[0]);
#pragma unroll
        for (int r = 1; r < 16; ++r) rm = fmaxf(rm, fmaxf(p0[r], p1[r]));
        { auto rr = __builtin_amdgcn_permlane32_swap(__float_as_uint(rm), __float_as_uint(rm), false, false); rm = fmaxf(__uint_as_float(rr[0]), __uint_as_float(rr[1])); }
        bool resc = false;
        if (t == 0) { mhat = rm;
#pragma unroll
            for (int r = 0; r < 16; ++r) { p0[r] -= rm; p1[r] -= rm; }
#pragma unroll
            for (int r = 0; r < 16; ++r) negm[r] = -mhat;
        } else if (__any(rm > 8.0f)) { const float dl = fmaxf(rm, 0.f); mhat += dl;
#pragma unroll
            for (int r = 0; r < 16; ++r) { p0[r] -= dl; p1[r] -= dl; }
#pragma unroll
            for (int r = 0; r < 16; ++r) negm[r] = -mhat;
            const float f = __builtin_amdgcn_exp2f(-dl); l_reg *= f; if (hi == 0) wsf[r32] = f; resc = true; }
        float sacc = 0.f;
#pragma unroll
        for (int r = 0; r < 16; ++r) { p0[r] = __builtin_amdgcn_exp2f(p0[r]); p1[r] = __builtin_amdgcn_exp2f(p1[r]); sacc += p0[r] + p1[r]; }
        l_reg += sacc;
        u32x4 pw0, pw1, pw2, pw3;
        pw0 = (u32x4){cvtpk(p0[0], p0[1]), cvtpk(p0[2], p0[3]), cvtpk(p0[4], p0[5]), cvtpk(p0[6], p0[7])}; pw1 = (u32x4){cvtpk(p0[8], p0[9]), cvtpk(p0[10], p0[11]), cvtpk(p0[12], p0[13]), cvtpk(p0[14], p0[15])};
        pw2 = (u32x4){cvtpk(p1[0], p1[1]), cvtpk(p1[2], p1[3]), cvtpk(p1[4], p1[5]), cvtpk(p1[6], p1[7])}; pw3 = (u32x4){cvtpk(p1[8], p1[9]), cvtpk(p1[10], p1[11]), cvtpk(p1[12], p1[13]), cvtpk(p1[14], p1[15])};
        if (resc) { asm volatile("s_waitcnt lgkmcnt(0)" ::: "memory");
#pragma unroll
            for (int d_ = 0; d_ < 2; ++d_)
#pragma unroll
                for (int r = 0; r < 16; ++r) o[d_][r] *= wsf[crow(r, hi)]; }
        { const int vb = vb0 + cur * VSLOT;
#pragma unroll
          for (int d0 = 0; d0 < 2; ++d0) { s16x4 lo[4], hh[4];
#pragma unroll
            for (int ks = 0; ks < 4; ++ks) {
                asm volatile("ds_read_b64_tr_b16 %0,%1 offset:%c2" : "=&v"(lo[ks]) : "v"(vb), "i"(d0 * 4096 + ks * 1024) : "memory");
                asm volatile("ds_read_b64_tr_b16 %0,%1 offset:%c2" : "=&v"(hh[ks]) : "v"(vb), "i"(d0 * 4096 + ks * 1024 + 512) : "memory"); }
            asm volatile("s_waitcnt lgkmcnt(0)" ::: "memory"); __builtin_amdgcn_sched_barrier(0);
#define ATT_PK(k) (bf16x8){lo[k][0], lo[k][1], lo[k][2], lo[k][3], hh[k][0], hh[k][1], hh[k][2], hh[k][3]}
            o[d0] = __builtin_amdgcn_mfma_f32_32x32x16_bf16(__builtin_bit_cast(bf16x8, pw0), ATT_PK(0), o[d0], 0, 0, 0);
            o[d0] = __builtin_amdgcn_mfma_f32_32x32x16_bf16(__builtin_bit_cast(bf16x8, pw1), ATT_PK(1), o[d0], 0, 0, 0);
            o[d0] = __builtin_amdgcn_mfma_f32_32x32x16_bf16(__builtin_bit_cast(bf16x8, pw2), ATT_PK(2), o[d0], 0, 0, 0);
            o[d0] = __builtin_amdgcn_mfma_f32_32x32x16_bf16(__builtin_bit_cast(bf16x8, pw3), ATT_PK(3), o[d0], 0, 0, 0);
#undef ATT_PK
          } }
        if (BIAS && wid == 0 && t + 1 < NT) Bs[(cur ^ 1) * 64 + lane] = (cref - bnext) * 1.4426950408889634f;
        ATT_WAIT_BAR();
    }
    { auto rr = __builtin_amdgcn_permlane32_swap(__float_as_uint(l_reg), __float_as_uint(l_reg), false, false); l_reg = __uint_as_float(rr[0]) + __uint_as_float(rr[1]); }
    if (hi == 0) wsf[32 + r32] = l_reg; asm volatile("s_waitcnt lgkmcnt(0)" ::: "memory");
    float rli[16];
#pragma unroll
    for (int r = 0; r < 16; ++r) rli[r] = __builtin_amdgcn_rcpf(wsf[32 + crow(r, hi)]);
    bf16* Ow = Oh + (size_t)(q0 + wid * 32) * DM;
    { bf16* stg = (bf16*)(shm + L_OST) + wid * 2048;
#pragma unroll
      for (int r = 0; r < 16; ++r) { const int orow = crow(r, hi);
#pragma unroll
        for (int d0 = 0; d0 < 2; ++d0) stg[orow * 64 + d0 * 32 + r32] = (bf16)f2bf(o[d0][r] * rli[r]); }
      asm volatile("s_waitcnt lgkmcnt(0)" ::: "memory");
#pragma unroll
      for (int i = 0; i < 4; ++i) { const int row = i * 8 + (lane >> 3), ch = lane & 7; const u32x4 v = *(const u32x4*)(stg + row * 64 + ch * 8); *(u32x4*)(Ow + (size_t)row * DM + ch * 8) = v; } }
    asm volatile("s_waitcnt lgkmcnt(0)\n\ts_barrier" ::: "memory");
#undef ATT_DMA
}
}

__device__ __forceinline__ void phase_attn_mfma(Frame& F) {
    const bf16* PROJ = (const bf16*)(F.ws + WS_PROJ); const bf16* QM = (const bf16*)(F.ws + WS_QM); const bf16* KVB = (const bf16*)(F.ws + WS_KVB); const bf16* KM = (const bf16*)(F.ws + WS_KM);
    const float* CUM = (const float*)(F.ws + WS_CUM); bf16* MIX = (bf16*)(F.ws + WS_MIX);
    char* shm = (char*)(F.lds + RING_OFF);
    const int vcu = (F.G % 8 == 0) ? (F.bid % 8) * (F.G / 8) + F.bid / 8 : F.bid;
#pragma unroll 1
    for (int p = vcu; p < 512; p += F.G) { const int combo = p >> 5, s = p & 31, b = combo >> 3, h = combo & 7; const size_t rb = (size_t)b * SEQ;
#pragma unroll 1
        for (int half = 0; half < 2; ++half) { const int qb = half ? 63 - s : s;
            att::attn_unit<64, true>(F.tid, qb, PROJ + rb * EVEN_INP + E_FQ + h * 64, EVEN_INP, PROJ + rb * EVEN_INP + E_FK + h * 64, EVEN_INP, PROJ + rb * EVEN_INP + E_FV + h * 64, EVEN_INP, CUM + rb * 8 + h, MIX + rb * DM + h * 64, shm); } }
#pragma unroll 1
    for (int p = vcu; p < 512; p += F.G) { const int combo = p >> 5, s = p & 31, b = combo >> 3, h = combo & 7; const size_t rb = (size_t)b * SEQ;
#pragma unroll 1
        for (int half = 0; half < 2; ++half) { const int qb = half ? 63 - s : s;
            att::attn_unit<96, false>(F.tid, qb, QM + rb * 768 + h * 96, 768, KM + rb * 768 + h * 96, 768, KVB + rb * 1024 + h * 128 + 64, 1024, nullptr, MIX + rb * DM + 512 + h * 64, shm); } }
}
constexpr size_t WS_S5_MT = WS_Y2;
constexpr size_t WS_S5_PT = WS_S5_MT + 72 * MiB;
constexpr size_t WS_S5_AX = WS_S5_PT + 16 * MiB;
constexpr size_t WS_S5_XLOC = WS_S5_AX + 36 * MiB;
static_assert(WS_S5_XLOC + 8 * MiB <= WS_Y2 + 144 * MiB, "s5 overlay");

__device__ __forceinline__ void s5_build(Frame& F, int j) {
    if (F.bid >= 256) return;
    const int g = F.bid >> 3, part = F.bid & 7, tid = F.tid, lane = F.lane, wave = F.wave;
    LAS float* pwr = (LAS float*)(F.lds + RING_OFF);
    LAS float* pwi = pwr + 65 * 64;
    LAS float* bbr = pwi + 65 * 64;
    LAS float* bbi = bbr + 1024;
    LAS float* crs = bbi + 1024;
    LAS float* cis = crs + 1024;
    LAS bf16* ktab = (LAS bf16*)(cis + 1024);
    const float dt = expf(kin(I_S5_LS)[j * 32 + g]);
    const float* are = kin(I_S5_ARE) + (size_t)(j * 32 + g) * 64; const float* aim = kin(I_S5_AIM) + (size_t)(j * 32 + g) * 64;
    for (int e = tid; e < 65 * 64; e += 512) { const int d = e >> 6, p = e & 63; const float lr = fminf(are[p], -1e-4f), li = aim[p];
        const float mag = expf(lr * dt * (float)d); float sn, cs; sincosf(li * dt * (float)d, &sn, &cs); pwr[e] = mag * cs; pwi[e] = mag * sn; }
    for (int e = tid; e < 1024; e += 512) { const int p = e >> 4, c = e & 15; const float lr = fminf(are[p], -1e-4f), li = aim[p];
        const float mag = expf(lr * dt); float sn, cs; sincosf(li * dt, &sn, &cs); const float abr = mag * cs, abi = mag * sn;
        const float den = lr * lr + li * li, nr = abr - 1.0f, ni = abi; const float gr = (nr * lr + ni * li) / den, gi = (ni * lr - nr * li) / den;
        const float br = kin(I_S5_BRE)[((size_t)(j * 32 + g) * 64 + p) * 16 + c], bi = kin(I_S5_BIM)[((size_t)(j * 32 + g) * 64 + p) * 16 + c];
        bbr[e] = gr * br - gi * bi; bbi[e] = gr * bi + gi * br; }
    for (int e = tid; e < 1024; e += 512) { crs[e] = kin(I_S5_CRE)[(size_t)(j * 32 + g) * 1024 + e]; cis[e] = kin(I_S5_CIM)[(size_t)(j * 32 + g) * 1024 + e]; }
    __syncthreads();
    { const int cc = tid >> 1, c = cc >> 4, c2 = cc & 15, ph = tid & 1;
      float er[32], ei[32];
#pragma unroll
      for (int pp = 0; pp < 32; ++pp) { const int p = 32 * ph + pp; const float xr = crs[c * 64 + p], xi = cis[c * 64 + p], yr = bbr[p * 16 + c2], yi = bbi[p * 16 + c2]; er[pp] = xr * yr - xi * yi; ei[pp] = xr * yi + xi * yr; }
#pragma unroll 1
      for (int d = 0; d < 64; ++d) { float s = 0.f; const LAS float* wr_ = pwr + d * 64 + 32 * ph; const LAS float* wi_ = pwi + d * 64 + 32 * ph;
#pragma unroll
          for (int pp = 0; pp < 32; ++pp) s += wr_[pp] * er[pp] - wi_[pp] * ei[pp];
          s += __shfl_xor(s, 1);
          if (ph == 0) ktab[(d * 16 + c) * 16 + c2] = (bf16)f2bf(s); } }
    __syncthreads();
    bf16* MT = (bf16*)(F.ws + WS_S5_MT) + (size_t)g * 1024 * 1152;
#pragma unroll 1
    for (int rr = wave; rr < 128; rr += 8) { const int i = part * 8 + (rr >> 4), c = rr & 15; bf16* row = MT + (size_t)(i * 16 + c) * 1152;
        v4u a = {0u, 0u, 0u, 0u}, b = {0u, 0u, 0u, 0u};
        if (lane <= i) { const LAS v4u* src = (const LAS v4u*)(ktab + ((i - lane) * 16 + c) * 16); a = src[0]; b = src[1]; }
        *(v4u*)(row + lane * 16) = a; *(v4u*)(row + lane * 16 + 8) = b;
        { const int p = lane; const float xr = crs[c * 64 + p], xi = cis[c * 64 + p], wr_ = pwr[(i + 1) * 64 + p], wi_ = pwi[(i + 1) * 64 + p];
          row[1024 + p] = (bf16)f2bf(xr * wr_ - xi * wi_); row[1088 + p] = (bf16)f2bf(-(xr * wi_ + xi * wr_)); } }
    bf16* PT = (bf16*)(F.ws + WS_S5_PT) + (size_t)g * 256 * 1024;
#pragma unroll 1
    for (int rr = wave; rr < 32; rr += 8) { const int n = part * 32 + rr; bf16* row = PT + (size_t)n * 1024 + lane * 16;
        unsigned o[8];
        if (n < 128) { const int p = n & 63, im = n >> 6; const float wr_ = pwr[(63 - lane) * 64 + p], wi_ = pwi[(63 - lane) * 64 + p];
#pragma unroll
            for (int q = 0; q < 8; ++q) { const float y0r = bbr[p * 16 + 2 * q], y0i = bbi[p * 16 + 2 * q], y1r = bbr[p * 16 + 2 * q + 1], y1i = bbi[p * 16 + 2 * q + 1];
                const float v0 = im ? (wr_ * y0i + wi_ * y0r) : (wr_ * y0r - wi_ * y0i), v1 = im ? (wr_ * y1i + wi_ * y1r) : (wr_ * y1r - wi_ * y1i); o[q] = pk2(v0, v1); }
        } else {
#pragma unroll
            for (int q = 0; q < 8; ++q) o[q] = 0u; }
        *(v4u*)row = (v4u){o[0], o[1], o[2], o[3]}; *(v4u*)(row + 8) = (v4u){o[4], o[5], o[6], o[7]}; }
    __syncthreads();
}
__device__ __forceinline__ void s5_repack(Frame& F) {
    const bf16* PROJ = (const bf16*)(F.ws + WS_PROJ); bf16* AX = (bf16*)(F.ws + WS_S5_AX);
    const int gt = F.bid * 512 + F.tid, NT = F.G * 512;
    for (int e = gt; e < NTOK * 32; e += NT) { const int m = e >> 5, g = e & 31; const int b = m / SEQ, t = m % SEQ, n = t >> 6, s = t & 63;
        const v4u* src = (const v4u*)(PROJ + (size_t)m * ODD_INP + O_U + g * 16); v4u* dst = (v4u*)(AX + ((size_t)g * 512 + b * 256 + n) * 1152 + s * 16);
        const v4u x0 = src[0], x1 = src[1]; dst[0] = x0; dst[1] = x1; }
}
struct S5POrder {
    int G, c;
    __device__ bool next(int i, pg8::Unit& u) const { const int L = i * G + c; if (L >= 64) return false; u.aux = L >> 1; u.pm = L & 1; u.pn = 0; return true; }
    __device__ __forceinline__ const char* a_base(const pg8::Gemm& g, const pg8::Unit& u) const { return (const char*)g.A + ((size_t)u.aux * 512 + u.pm * 256) * 1152 * 2; }
    __device__ __forceinline__ const char* b_base(const pg8::Gemm& g, const pg8::Unit& u) const { return (const char*)g.Bt + (size_t)u.aux * 256 * 1024 * 2; }
};
struct S5PEpi {
    static constexpr bool PERM = false;
    float* X;
    __device__ __forceinline__ void operator()(const pg8::f32x4 (&acc)[2][2][4][2], const pg8::Unit& u, int wr, int wc, int fr, int fq) const {
        const int row0 = u.pm * 256 + wr * 64 + fr; const int col0 = wc * 32 + 4 * fq;
#pragma unroll
        for (int ai = 0; ai < 2; ++ai)
#pragma unroll
            for (int m = 0; m < 4; ++m) { float* rowp = X + ((size_t)u.aux * 512 + row0 + ai * 128 + m * 16) * 128 + col0;
#pragma unroll
                for (int n = 0; n < 2; ++n) *(pg8::f32x4*)(rowp + n * 16) = acc[ai][0][m][n]; }
    }
};
__device__ __forceinline__ void s5_scan(Frame& F, int j) {
    const int gw = F.bid * NWAVES + F.wave; if (gw >= 64) return;
    const int g = gw >> 1, b = gw & 1, p = F.lane;
    const float lr = fminf(kin(I_S5_ARE)[(size_t)(j * 32 + g) * 64 + p], -1e-4f), li = kin(I_S5_AIM)[(size_t)(j * 32 + g) * 64 + p]; const float dt = expf(kin(I_S5_LS)[j * 32 + g]);
    const float mag = expf(lr * dt * 64.f); float sn, cs; sincosf(li * dt * 64.f, &sn, &cs); const float ar = mag * cs, ai = mag * sn;
    const float* X = (const float*)(F.ws + WS_S5_XLOC) + ((size_t)g * 512 + b * 256) * 128; bf16* AX = (bf16*)(F.ws + WS_S5_AX) + ((size_t)g * 512 + b * 256) * 1152 + 1024;
    float xr = 0.f, xi = 0.f; float cr[8], ci[8], nr[8], ni[8];
#pragma unroll
    for (int q = 0; q < 8; ++q) { cr[q] = X[(size_t)q * 128 + p]; ci[q] = X[(size_t)q * 128 + 64 + p]; }
    for (int n0 = 0; n0 < 256; n0 += 8) { const int nn = (n0 + 8 < 256) ? n0 + 8 : n0;
#pragma unroll
        for (int q = 0; q < 8; ++q) { nr[q] = X[(size_t)(nn + q) * 128 + p]; ni[q] = X[(size_t)(nn + q) * 128 + 64 + p]; }
#pragma unroll
        for (int q = 0; q < 8; ++q) { AX[(size_t)(n0 + q) * 1152 + p] = (bf16)f2bf(xr); AX[(size_t)(n0 + q) * 1152 + 64 + p] = (bf16)f2bf(xi);
            const float tr = ar * xr - ai * xi + cr[q], ti = ar * xi + ai * xr + ci[q]; xr = tr; xi = ti; }
#pragma unroll
        for (int q = 0; q < 8; ++q) { cr[q] = nr[q]; ci[q] = ni[q]; } }
}
struct S5MOrder {
    int G, c;
    __device__ bool next(int i, pg8::Unit& u) const { const int L = i * G + c; if (L >= 256) return false; u.aux = L >> 3; u.pm = (L >> 2) & 1; u.pn = L & 3; return true; }
    __device__ __forceinline__ const char* a_base(const pg8::Gemm& g, const pg8::Unit& u) const { return (const char*)g.A + ((size_t)u.aux * 512 + u.pm * 256) * 1152 * 2; }
    __device__ __forceinline__ const char* b_base(const pg8::Gemm& g, const pg8::Unit& u) const { return (const char*)g.Bt + ((size_t)u.aux * 1024 + u.pn * 256) * 1152 * 2; }
};
struct S5MEpi {
    static constexpr bool PERM = true;
    bf16* HG; const bf16* PROJ; const float* dsk;
    __device__ __forceinline__ void operator()(const pg8::f32x4 (&acc)[2][2][4][2], const pg8::Unit& u, int wr, int wc, int fr, int fq) const {
        const int g = u.aux; const int row0 = u.pm * 256 + wr * 64 + fr; const int col0 = u.pn * 256 + wc * 32 + 8 * fq;
        const pg8::f32x4 d0 = *(const pg8::f32x4*)(dsk + g * 16 + (col0 & 15)), d1 = *(const pg8::f32x4*)(dsk + g * 16 + (col0 & 15) + 4);
#pragma unroll
        for (int ai = 0; ai < 2; ++ai)
#pragma unroll
            for (int m = 0; m < 4; ++m) { const int rg = row0 + ai * 128 + m * 16; const int b = rg >> 8, n = rg & 255;
#pragma unroll
                for (int bj = 0; bj < 2; ++bj) { const int col = col0 + bj * 128; const int i = col >> 4, c0 = col & 15; const size_t tok = (size_t)b * SEQ + n * 64 + i;
                    const pg8::u32x4 uw = *(const pg8::u32x4*)(PROJ + tok * ODD_INP + O_U + g * 16 + c0); const pg8::f32x4 v0 = acc[ai][bj][m][0], v1 = acc[ai][bj][m][1];
                    pg8::u32x4 w; w.x = pk2(gelu_tanh(v0[0] + d0[0] * bflo(uw.x)), gelu_tanh(v0[1] + d0[1] * bfhi(uw.x))); w.y = pk2(gelu_tanh(v0[2] + d0[2] * bflo(uw.y)), gelu_tanh(v0[3] + d0[3] * bfhi(uw.y)));
                    w.z = pk2(gelu_tanh(v1[0] + d1[0] * bflo(uw.z)), gelu_tanh(v1[1] + d1[1] * bfhi(uw.z))); w.w = pk2(gelu_tanh(v1[2] + d1[2] * bflo(uw.w)), gelu_tanh(v1[3] + d1[3] * bfhi(uw.w)));
                    *(pg8::u32x4*)(HG + tok * 512 + g * 16 + c0) = w; } }
    }
};
constexpr int LSTEPS = 16;
constexpr int STEP_END = 1 + DEPTH * LSTEPS;
struct KArgs { Args a; int li, pad; };

#define FRAME Frame F; { int wv_ = wave0; asm volatile("" : "+s"(wv_)); int t_ = wv_ * 64 + (int)__builtin_amdgcn_mbcnt_hi(~0u, __builtin_amdgcn_mbcnt_lo(~0u, 0u)); asm volatile("" : "+v"(t_)); unsigned char* w_ = kws(); F.lds = lds0; F.ws = w_; F.ctl = (unsigned*)(w_ + WS_CTL); \
        F.tid = t_; F.lane = t_ & 63; F.wave = __builtin_amdgcn_readfirstlane(t_ >> 6); { int g_ = gridDim.x, b_ = blockIdx.x; asm volatile("" : "+s"(g_), "+s"(b_)); F.G = g_; F.bid = b_; } } unsigned char* const ws = F.ws; (void)ws
#ifndef PH_MASK
#define PH_MASK 0xffffffffu
#endif
#define EN(k) (((PH_MASK) >> (k)) & 1u)
#define STEP(s) if (lo <= (s) && (s) < hi)
#define ENDSTEP(s) do { if ((s) + 1 < hi) xcd_barrier(bar); } while (0)
#define LAUNDER_WS do {} while (0)


template <int layer> __device__ __forceinline__ void layer_body(const XcdBarrier& bar, const int lo, const int hi, LAS unsigned char* const lds0, const int wave0) {
        constexpr int sb = 1 + layer * LSTEPS, j = layer >> 1; constexpr bool even = (layer & 1) == 0;
        STEP(sb + 0) if constexpr (EN(0)) { FRAME;
            phase_norm(F, layer == 0 ? kin(I_X) : kout(), kin(I_NORM_MIX) + layer * DM, layer == 0 ? kout() : nullptr);
            moe_weights(F, layer); phase_pconv(F, layer);
            if constexpr (!even) { __syncthreads(); s5_build(F, j); }
            ENDSTEP(sb + 0);
        }
        STEP(sb + 1) if constexpr (EN(1)) { FRAME;
            { LAUNDER_WS; const int NP = even ? EVEN_INP : ODD_INP; const bf16* W = even ? (const bf16*)(ws + WS_W_EVIN) + (size_t)j * EVEN_INP * 1024 : (const bf16*)(ws + WS_W_ODIN) + (size_t)j * ODD_INP * 1024;
              pg8::Gemm g{(const bf16*)(ws + WS_ABF), W, 1024, 1024, 1024}; pg8::StaticOrder S; S.init(NTOK, NP, F.G, F.bid); pg8::EpiBf16 E{(bf16*)(ws + WS_PROJ), NP};
              pg8::gemm_phase<pg8::EpiBf16, pg8::StaticOrder>(F.lds + RING_OFF, g, S, E, F.tid); }
            { LAUNDER_WS; pg8::Gemm g{(const bf16*)(ws + WS_PBF), (const bf16*)(ws + WS_W_PLEP) + (size_t)layer * 1024 * 256, 256, 256, 256}; pg8::StaticOrder S; S.init(NTOK, 1024, F.G, F.bid); pg8::EpiBf16 E{(bf16*)(ws + WS_PP), 1024};
              pg8::gemm_phase<pg8::EpiBf16, pg8::StaticOrder>(F.lds + RING_OFF, g, S, E, F.tid); }
            ENDSTEP(sb + 1);
        }
        if constexpr (even) {
            STEP(sb + 2) if constexpr (EN(2)) { FRAME; phase_even_post(F, j); ENDSTEP(sb + 2); }
            STEP(sb + 3) if constexpr (EN(3)) { FRAME;
#ifndef NO_QUP
                { LAUNDER_WS; pg8::Gemm g{(const bf16*)(ws + WS_CQN), (const bf16*)(ws + WS_W_QUP) + (size_t)j * 768 * 384, 384, 384, 384}; pg8::StaticOrder S; S.init(NTOK, 768, F.G, F.bid); pg8::EpiBf16 E{(bf16*)(ws + WS_QM), 768};
                  pg8::gemm_phase<pg8::EpiBf16, pg8::StaticOrder>(F.lds + RING_OFF, g, S, E, F.tid); }
#endif
#ifndef NO_KVUP
                { LAUNDER_WS; pg8::Gemm g{(const bf16*)(ws + WS_CKVN), (const bf16*)(ws + WS_W_KVUP) + (size_t)j * 1024 * 256, 256, 256, 256}; pg8::StaticOrder S; S.init(NTOK, 1024, F.G, F.bid); pg8::EpiBf16 E{(bf16*)(ws + WS_KVB), 1024};
                  pg8::gemm_phase<pg8::EpiBf16, pg8::StaticOrder>(F.lds + RING_OFF, g, S, E, F.tid); }
#endif
#ifndef NO_CUMSUM
                phase_cumsum(F);
#endif
                ENDSTEP(sb + 3);
            }
            STEP(sb + 4) if constexpr (EN(4)) { FRAME; phase_mla_post(F, j); ENDSTEP(sb + 4); }
            STEP(sb + 5) if constexpr (EN(5)) { FRAME;
#ifdef ATTN_NAIVE
                phase_attn_naive(F);
#else
                phase_attn_mfma(F);
#ifdef DUP_ATTN
                phase_attn_mfma(F);
#endif
#endif
                ENDSTEP(sb + 5); }
        } else {
            STEP(sb + 2) if constexpr (EN(2)) { FRAME; s5_repack(F); phase_gdn_prep(F, j); ENDSTEP(sb + 2); }
            STEP(sb + 3) if constexpr (EN(3)) { FRAME;
                { pg8::Gemm g{(const bf16*)(ws + WS_S5_AX), (const bf16*)(ws + WS_S5_PT), 1024, 1152, 1024}; S5POrder S{F.G, F.bid}; S5PEpi E{(float*)(ws + WS_S5_XLOC)};
                  pg8::gemm_phase<S5PEpi, S5POrder>(F.lds + RING_OFF, g, S, E, F.tid); }
                phase_gdn_naive(F);
                ENDSTEP(sb + 3);
            }
            STEP(sb + 4) if constexpr (EN(4)) { FRAME; s5_scan(F, j); phase_gdn_out(F, j); ENDSTEP(sb + 4); }
            STEP(sb + 5) if constexpr (EN(5)) { FRAME;
                pg8::Gemm g{(const bf16*)(ws + WS_S5_AX), (const bf16*)(ws + WS_S5_MT), 1152, 1152, 1152}; S5MOrder S{F.G, F.bid}; S5MEpi E{(bf16*)(ws + WS_HG), (const bf16*)(ws + WS_PROJ), kin(I_S5_D) + j * 512};
                pg8::gemm_phase<S5MEpi, S5MOrder>(F.lds + RING_OFF, g, S, E, F.tid);
                ENDSTEP(sb + 5);
            }
            STEP(sb + 6) if constexpr (EN(6)) { FRAME;
                pg8::Gemm g{(const bf16*)(ws + WS_HG), (const bf16*)(ws + WS_W_GLU) + (size_t)j * 512 * 512, 512, 512, 512}; pg8::StaticOrder S; S.init(NTOK, 512, F.G, F.bid);
                pg8::EpiGlu E{(bf16*)(ws + WS_MIX), 1024, (const bf16*)(ws + WS_HG), 512, kin(I_S5_BGLU) + j * 512};
                pg8::gemm_phase<pg8::EpiGlu, pg8::StaticOrder>(F.lds + RING_OFF, g, S, E, F.tid);
                ENDSTEP(sb + 6);
            }
        }
        STEP(sb + 7) if constexpr (EN(7)) { FRAME;
            LAUNDER_WS; const bf16* W = even ? (const bf16*)(ws + WS_W_EVOUT) + (size_t)j * 1024 * 1024 : (const bf16*)(ws + WS_W_ODOUT) + (size_t)j * 1024 * 1024;
            pg8::Gemm g{(const bf16*)(ws + WS_MIX), W, 1024, 1024, 1024}; pg8::StaticOrder S; S.init(NTOK, 1024, F.G, F.bid); pg8::EpiResAdd E{kout(), 1024};
            pg8::gemm_phase<pg8::EpiResAdd, pg8::StaticOrder>(F.lds + RING_OFF, g, S, E, F.tid);
            ENDSTEP(sb + 7);
        }
        STEP(sb + 8) if constexpr (EN(8)) { FRAME; phase_router(F, layer); ENDSTEP(sb + 8); }
        STEP(sb + 9) if constexpr (EN(9)) { FRAME; phase_moe_scatter(F, layer); ENDSTEP(sb + 9); }
        STEP(sb + 10) if constexpr (EN(10)) { FRAME;
            LAUNDER_WS; moe_tables(F, layer);
            const LAS int* rowbase = (const LAS int*)(F.lds + LDSCTL_OFF + LC_MOE);
            MoeOrder S{__builtin_amdgcn_readfirstlane(rowbase[34]), 4, F.G, F.bid, (const LAS unsigned char*)(F.lds + LDSCTL_OFF + LC_MOE + 192), (size_t)1024 * 1024 * 2};
            pg8::Gemm g{(const bf16*)(ws + WS_XG), (const bf16*)(ws + WS_W_MOEGU), 1024, 1024, 1024}; pg8::EpiSwiglu E{(bf16*)(ws + WS_HB), 512};
            pg8::gemm_phase<pg8::EpiSwiglu, MoeOrder>(F.lds + RING_OFF, g, S, E, F.tid);
            ENDSTEP(sb + 10);
        }
        STEP(sb + 11) if constexpr (EN(11)) { FRAME;
            LAUNDER_WS; moe_tables(F, layer);
            const LAS int* rowbase = (const LAS int*)(F.lds + LDSCTL_OFF + LC_MOE);
            MoeOrder S{__builtin_amdgcn_readfirstlane(rowbase[34]), 4, F.G, F.bid, (const LAS unsigned char*)(F.lds + LDSCTL_OFF + LC_MOE + 192), (size_t)1024 * 512 * 2};
            pg8::Gemm g{(const bf16*)(ws + WS_HB), (const bf16*)(ws + WS_W_MOED), 512, 512, 512}; pg8::EpiBf16 E{(bf16*)(ws + WS_Y2), 1024};
            pg8::gemm_phase<pg8::EpiBf16, MoeOrder>(F.lds + RING_OFF, g, S, E, F.tid);
            ENDSTEP(sb + 11);
        }
        STEP(sb + 12) if constexpr (EN(12)) { FRAME; phase_moe_combine(F, layer); ENDSTEP(sb + 12); }
        STEP(sb + 13) if constexpr (EN(13)) { FRAME;
            LAUNDER_WS; pg8::Gemm g{(const bf16*)(ws + WS_ABF), (const bf16*)(ws + WS_W_PLEG) + (size_t)layer * 1024 * 1024, 1024, 1024, 1024}; pg8::StaticOrder S; S.init(NTOK, 1024, F.G, F.bid);
            pg8::EpiPle E{kout(), (const bf16*)(ws + WS_PP), kin(I_PLE_BG) + layer * DM, 1024};
            pg8::gemm_phase<pg8::EpiPle, pg8::StaticOrder>(F.lds + RING_OFF, g, S, E, F.tid);
            ENDSTEP(sb + 13);
        }
    }
__global__ void __launch_bounds__(NWAVES * 64, 2) mega_fwd(KArgs ka) {
    extern __shared__ __attribute__((aligned(16))) unsigned char lds_raw[];
    const Args& args = ka.a;
    LAS unsigned char* const lds0 = (LAS unsigned char*)lds_raw;
    const int wave0 = __builtin_amdgcn_readfirstlane((int)threadIdx.x >> 6);
    for (int u = threadIdx.x; u < (LDS_BYTES - LDSCTL_OFF) / 4; u += NWAVES * 64) ((LAS unsigned*)(lds0 + LDSCTL_OFF))[u] = 0u;
    __syncthreads();
    XcdBarrier bar = xcd_barrier_post((unsigned*)(kws() + WS_CTL) + CW_BAR + ka.li * XCD_BAR_WORDS, (volatile LAS unsigned*)(lds0 + LDSCTL_OFF + LC_BARST));
    const int lo = args.ph_lo, hi = args.ph_hi;
    STEP(0) if constexpr (EN(15)) { FRAME; prologue_weights(F); ENDSTEP(0); }
    layer_body<0>(bar, lo, hi, lds0, wave0); layer_body<1>(bar, lo, hi, lds0, wave0); layer_body<2>(bar, lo, hi, lds0, wave0); layer_body<3>(bar, lo, hi, lds0, wave0);
#undef STEP
#undef ENDSTEP
}

#ifndef MK_MODE
#define MK_MODE 0
#endif
extern "C" void kernel_launch(void* const* d_in, const int* in_sizes, int n_in, void* d_out, int out_size, void* d_ws, size_t ws_size, hipStream_t stream) {
    static int ready = 0;
    if (ready == 0) {
        if (n_in != N_IN || out_size != NTOK * DM || ws_size < WS_END) { fprintf(stderr, "kernel_launch: unexpected shapes n_in %d out %d ws %zu (need %zu)\n", n_in, out_size, ws_size, (size_t)WS_END); ready = -1; return; }
        if (hipFuncSetAttribute((const void*)mega_fwd, hipFuncAttributeMaxDynamicSharedMemorySize, LDS_BYTES) != hipSuccess) { fprintf(stderr, "kernel_launch: hipFuncSetAttribute failed\n"); ready = -1; return; }
        int per_cu = 0; (void)hipOccupancyMaxActiveBlocksPerMultiprocessor(&per_cu, (const void*)mega_fwd, NWAVES * 64, LDS_BYTES); (void)hipGetLastError();
        ready = 1;
    }
    if (ready < 0) return;
    (void)hipMemsetAsync((char*)d_ws + WS_CTL, 0, CTL_ZERO_BYTES, stream);
    KArgs ka{};
    for (int i = 0; i < N_IN; ++i) ka.a.in[i] = (const float*)d_in[i];
    ka.a.out = (float*)d_out; ka.a.ws = (unsigned char*)d_ws; ka.li = 0; ka.pad = 0;
    const int grid = 256;
#if MK_MODE == 1
    ka.a.ph_lo = 0; ka.a.ph_hi = STEP_END;
    hipLaunchKernelGGL(mega_fwd, dim3(grid), dim3(NWAVES * 64), LDS_BYTES, stream, ka);
#else
    for (int s = 0; s < STEP_END; ++s) {
        if (s > 0) { const int k = (s - 1) % LSTEPS, layer = (s - 1) / LSTEPS; const bool even = (layer & 1) == 0;
            if (k > 13) continue; if (k == 6 && even) continue; }
        ka.a.ph_lo = s; ka.a.ph_hi = s + 1;
        hipLaunchKernelGGL(mega_fwd, dim3(grid), dim3(NWAVES * 64), LDS_BYTES, stream, ka);
    }
#endif
}
```

```cpp
#include <hip/hip_runtime.h>
#include <cstdio>
#include <cstdint>
#define MK_MODE 1
namespace pg8 {
#define PG8_LAS __attribute__((address_space(3)))
typedef unsigned short bf16_t;
typedef short bf16x8 __attribute__((ext_vector_type(8)));
typedef float f32x4 __attribute__((ext_vector_type(4)));
typedef float f32x2 __attribute__((ext_vector_type(2)));
typedef unsigned u32x4 __attribute__((ext_vector_type(4)));
typedef unsigned u32x2 __attribute__((ext_vector_type(2)));
constexpr int BM = 256, BK = 64, HALF = 128, HTB = HALF * BK * 2  , STAGE_BYTES = 8 * HTB, NXCD = 8, WGM = 8;

__host__ __device__ __forceinline__ int lds_byte(int r, int c) { const int st = (r >> 4) * 2 + (c >> 5), rr = r & 15, cc = c & 31, ob = rr * 64 + cc * 2; return st * 1024 + (ob ^ (((ob >> 9) & 1) << 5)); }
__host__ __device__ __forceinline__ void stage_rc(int b, int& R, int& C) { const int st = b / 1024, sb = b % 1024, swz = sb ^ (((sb >> 9) & 1) << 5); R = (st >> 1) * 16 + swz / 64; C = (st & 1) * 32 + (swz % 64) / 2; }
__host__ __device__ __forceinline__ int perm32(int rho) { const int n = rho >> 4, i = rho & 15; return 8 * (i >> 2) + 4 * n + (i & 3); }

struct Unit { int pm, pn, aux; };
struct Gemm { const bf16_t* A; const bf16_t* Bt; int K, lda, ldb; };

struct StaticOrder {
    int nM, nN, nwg, G, c;
    __device__ void init(int M, int N, int G_, int c_) { nM = M / BM; nN = N / BM; nwg = nM * nN; G = G_; c = c_; }
    __device__ bool next(int i, Unit& u) const {
        const long L = (long)i * G + c; if (L >= nwg) return false;
        int wgid = (int)L; { const int q = nwg / NXCD, r = nwg % NXCD, xcd = wgid % NXCD, off = wgid / NXCD; wgid = (xcd < r ? xcd * (q + 1) : r * (q + 1) + (xcd - r) * q) + off; }
        const int nig = WGM * nN, gid = wgid / nig, fm = gid * WGM, gsz = (nM - fm) < WGM ? (nM - fm) : WGM;
        u.pm = fm + ((wgid % nig) % gsz); u.pn = (wgid % nig) / gsz; u.aux = 0; return true;
    }
    __device__ __forceinline__ const char* a_base(const Gemm& g, const Unit& u) const { return (const char*)g.A + (size_t)u.pm * BM * g.lda * 2; }
    __device__ __forceinline__ const char* b_base(const Gemm& g, const Unit& u) const { return (const char*)g.Bt + (size_t)u.pn * BM * g.ldb * 2; }
};

__device__ __forceinline__ unsigned cvt_pk_bf16(float lo, float hi) { unsigned r; asm volatile("v_cvt_pk_bf16_f32 %0, %1, %2" : "=v"(r) : "v"(lo), "v"(hi)); return r; }
__device__ __forceinline__ float bf_lo(unsigned w) { return __uint_as_float(w << 16); }
__device__ __forceinline__ float bf_hi(unsigned w) { return __uint_as_float(w & 0xffff0000u); }

struct EpiBf16 {
    static constexpr bool PERM = true;
    bf16_t* O; int ldc;
    __device__ __forceinline__ void operator()(const f32x4 (&acc)[2][2][4][2], const Unit& u, int wr, int wc, int fr, int fq) const {
        const int row0 = u.pm * BM + wr * 64 + fr; const int col0 = u.pn * BM + wc * 32 + 8 * fq;
#pragma unroll
        for (int ai = 0; ai < 2; ++ai)
#pragma unroll
            for (int m = 0; m < 4; ++m) { bf16_t* rowp = O + (size_t)(row0 + ai * HALF + m * 16) * ldc + col0;
#pragma unroll
                for (int bj = 0; bj < 2; ++bj) { const f32x4 v0 = acc[ai][bj][m][0], v1 = acc[ai][bj][m][1];
                    u32x4 w; w.x = cvt_pk_bf16(v0[0], v0[1]); w.y = cvt_pk_bf16(v0[2], v0[3]); w.z = cvt_pk_bf16(v1[0], v1[1]); w.w = cvt_pk_bf16(v1[2], v1[3]);
                    *(u32x4*)(rowp + bj * HALF) = w; } }
    }
};
struct EpiResAdd {
    static constexpr bool PERM = false;
    float* H; int ldc;
    __device__ __forceinline__ void operator()(const f32x4 (&acc)[2][2][4][2], const Unit& u, int wr, int wc, int fr, int fq) const {
        const int row0 = u.pm * BM + wr * 64 + fr; const int col0 = u.pn * BM + wc * 32 + 4 * fq;
#pragma unroll
        for (int ai = 0; ai < 2; ++ai)
#pragma unroll
            for (int m = 0; m < 4; ++m) { float* rowp = H + (size_t)(row0 + ai * HALF + m * 16) * ldc + col0;
#pragma unroll
                for (int bj = 0; bj < 2; ++bj)
#pragma unroll
                    for (int n = 0; n < 2; ++n) { f32x4* p = (f32x4*)(rowp + bj * HALF + n * 16); *p = *p + acc[ai][bj][m][n]; } }
    }
};
__device__ __forceinline__ float sigmoidf_(float x) { return 1.0f / (1.0f + __expf(-x)); }
struct EpiPle {
    static constexpr bool PERM = false;
    float* H; const bf16_t* PP; const float* bias; int ldc;
    __device__ __forceinline__ void operator()(const f32x4 (&acc)[2][2][4][2], const Unit& u, int wr, int wc, int fr, int fq) const {
        const int row0 = u.pm * BM + wr * 64 + fr; const int col0 = u.pn * BM + wc * 32 + 4 * fq;
#pragma unroll
        for (int ai = 0; ai < 2; ++ai)
#pragma unroll
            for (int m = 0; m < 4; ++m) { const size_t ro = (size_t)(row0 + ai * HALF + m * 16) * ldc + col0;
#pragma unroll
                for (int bj = 0; bj < 2; ++bj)
#pragma unroll
                    for (int n = 0; n < 2; ++n) { const int co = bj * HALF + n * 16; f32x4* p = (f32x4*)(H + ro + co); const u32x2 pw = *(const u32x2*)(PP + ro + co);
                        const f32x4 bv = *(const f32x4*)(bias + col0 + co); const f32x4 a = acc[ai][bj][m][n] + bv; f32x4 h = *p;
                        h[0] += sigmoidf_(a[0]) * bf_lo(pw.x); h[1] += sigmoidf_(a[1]) * bf_hi(pw.x); h[2] += sigmoidf_(a[2]) * bf_lo(pw.y); h[3] += sigmoidf_(a[3]) * bf_hi(pw.y); *p = h; } }
    }
};
struct EpiGlu {
    static constexpr bool PERM = true;
    bf16_t* O; int ldo; const bf16_t* HG; int ldh; const float* bias;
    __device__ __forceinline__ void operator()(const f32x4 (&acc)[2][2][4][2], const Unit& u, int wr, int wc, int fr, int fq) const {
        const int row0 = u.pm * BM + wr * 64 + fr; const int col0 = u.pn * BM + wc * 32 + 8 * fq;
#pragma unroll
        for (int ai = 0; ai < 2; ++ai)
#pragma unroll
            for (int m = 0; m < 4; ++m) { const size_t r = (size_t)(row0 + ai * HALF + m * 16);
#pragma unroll
                for (int bj = 0; bj < 2; ++bj) { const int c = col0 + bj * HALF; const u32x4 hw = *(const u32x4*)(HG + r * ldh + c);
                    const f32x4 b0 = *(const f32x4*)(bias + c), b1 = *(const f32x4*)(bias + c + 4); const f32x4 v0 = acc[ai][bj][m][0] + b0, v1 = acc[ai][bj][m][1] + b1;
                    u32x4 w; w.x = cvt_pk_bf16(bf_lo(hw.x) * sigmoidf_(v0[0]), bf_hi(hw.x) * sigmoidf_(v0[1])); w.y = cvt_pk_bf16(bf_lo(hw.y) * sigmoidf_(v0[2]), bf_hi(hw.y) * sigmoidf_(v0[3]));
                    w.z = cvt_pk_bf16(bf_lo(hw.z) * sigmoidf_(v1[0]), bf_hi(hw.z) * sigmoidf_(v1[1])); w.w = cvt_pk_bf16(bf_lo(hw.w) * sigmoidf_(v1[2]), bf_hi(hw.w) * sigmoidf_(v1[3]));
                    *(u32x4*)(O + r * ldo + c) = w; } }
    }
};
struct EpiSwiglu {
    static constexpr bool PERM = true;
    bf16_t* HB; int ldc;
    __device__ __forceinline__ void operator()(const f32x4 (&acc)[2][2][4][2], const Unit& u, int wr, int wc, int fr, int fq) const {
        const int row0 = u.pm * BM + wr * 64 + fr; const int col0 = u.pn * HALF + wc * 32 + 8 * fq;
#pragma unroll
        for (int ai = 0; ai < 2; ++ai)
#pragma unroll
            for (int m = 0; m < 4; ++m) { bf16_t* rowp = HB + (size_t)(row0 + ai * HALF + m * 16) * ldc + col0;
                const f32x4 g0 = acc[ai][0][m][0], g1 = acc[ai][0][m][1], u0 = acc[ai][1][m][0], u1 = acc[ai][1][m][1];
                u32x4 w; w.x = cvt_pk_bf16(g0[0] * sigmoidf_(g0[0]) * u0[0], g0[1] * sigmoidf_(g0[1]) * u0[1]); w.y = cvt_pk_bf16(g0[2] * sigmoidf_(g0[2]) * u0[2], g0[3] * sigmoidf_(g0[3]) * u0[3]);
                w.z = cvt_pk_bf16(g1[0] * sigmoidf_(g1[0]) * u1[0], g1[1] * sigmoidf_(g1[1]) * u1[1]); w.w = cvt_pk_bf16(g1[2] * sigmoidf_(g1[2]) * u1[2], g1[3] * sigmoidf_(g1[3]) * u1[3]);
                *(u32x4*)rowp = w; }
    }
};

template <class Epi, class Sched, bool ALIGN_EPI = true, bool SP2 = true>
__device__ __forceinline__ void gemm_phase(PG8_LAS unsigned char* lds, const Gemm g, const Sched& S, const Epi& E, const int tid) {
    const int wid = __builtin_amdgcn_readfirstlane(tid >> 6), lane = tid & 63, wr = wid >> 2, wc = wid & 3, fr = lane & 15, fq = lane >> 4;
    int K = g.K; asm volatile("" : "+s"(K));
    const int nt = K / BK;
    unsigned voffA[2], voffB[2];
#pragma unroll
    for (int i = 0; i < 2; ++i) { int R, C; stage_rc(tid * 16 + i * 8192, R, C); const int Rb = Epi::PERM ? ((R & ~31) + perm32(R & 31)) : R;
        voffA[i] = (unsigned)(R * g.lda + C) * 2u; voffB[i] = (unsigned)(Rb * g.ldb + C) * 2u; }
    const size_t kstep = (size_t)(BK * 2);
    const size_t hstepA = (size_t)HALF * g.lda * 2, hstepB = (size_t)HALF * g.ldb * 2;
    const unsigned ldsw = (unsigned)wid * 1024u;
    const int aoff = lds_byte(wr * 64 + fr, fq * 8), boff = lds_byte(wc * 32 + fr, fq * 8);
#define PG8_SA(b, h) (((b) * 2 + (h)) * HTB)
#define PG8_SB(b, h) ((4 + (b) * 2 + (h)) * HTB)
#define PG8_STAGE(bufoff, gbase, voff) do { _Pragma("unroll") for (int _i = 0; _i < 2; ++_i) \
        __builtin_amdgcn_global_load_lds((const unsigned*)((const char*)(gbase) + (voff)[_i]), (PG8_LAS unsigned*)(lds + (bufoff) + ldsw + _i * 8192), 16, 0, 0); } while (0)
#define PG8_LDA(dst, b, h) do { _Pragma("unroll") for (int m = 0; m < 4; ++m) _Pragma("unroll") for (int k = 0; k < 2; ++k) dst[m][k] = *(const PG8_LAS bf16x8*)(lds + PG8_SA(b, h) + aoff + m * 2048 + k * 1024); } while (0)
#define PG8_LDB(dst, b, h) do { _Pragma("unroll") for (int n = 0; n < 2; ++n) _Pragma("unroll") for (int k = 0; k < 2; ++k) dst[n][k] = *(const PG8_LAS bf16x8*)(lds + PG8_SB(b, h) + boff + n * 2048 + k * 1024); } while (0)
#define PG8_MMA(ai, bj, At, Bt) do { __builtin_amdgcn_s_setprio(1); _Pragma("unroll") for (int m = 0; m < 4; ++m) _Pragma("unroll") for (int n = 0; n < 2; ++n) _Pragma("unroll") for (int k = 0; k < 2; ++k) \
        acc[ai][bj][m][n] = __builtin_amdgcn_mfma_f32_16x16x32_bf16(Bt[n][k], At[m][k], acc[ai][bj][m][n], 0, 0, 0); __builtin_amdgcn_s_setprio(0); } while (0)
#define PG8_WAIT_V(n) asm volatile("s_waitcnt vmcnt(" #n ")" ::: "memory")
#define PG8_WAIT_L(n) asm volatile("s_waitcnt lgkmcnt(" #n ")" ::: "memory")
#define PG8_BAR __builtin_amdgcn_s_barrier()
#define PG8_SCHED __builtin_amdgcn_sched_barrier(0)
    Unit cur, nxt; int ui = 0;
    if (!S.next(0, cur)) return;
    f32x4 acc[2][2][4][2];
#pragma unroll
    for (int a = 0; a < 2; ++a)
#pragma unroll
        for (int b = 0; b < 2; ++b)
#pragma unroll
            for (int m = 0; m < 4; ++m)
#pragma unroll
                for (int n = 0; n < 2; ++n) acc[a][b][m][n] = (f32x4){0.f, 0.f, 0.f, 0.f};
    bf16x8 At[4][2], B0[2][2], B1[2][2];
    const char* cA = S.a_base(g, cur); const char* cB = S.b_base(g, cur);
    if constexpr (SP2) {
        PG8_STAGE(PG8_SB(0, 0), cB, voffB); PG8_STAGE(PG8_SB(0, 1), cB + hstepB, voffB); PG8_STAGE(PG8_SA(0, 0), cA, voffA); PG8_STAGE(PG8_SA(0, 1), cA + hstepA, voffA);
        if (wr == 1) PG8_BAR;
        PG8_WAIT_V(2); PG8_BAR;
        PG8_STAGE(PG8_SB(1, 0), cB + kstep, voffB); PG8_STAGE(PG8_SA(1, 0), cA + kstep, voffA); PG8_STAGE(PG8_SB(1, 1), cB + hstepB + kstep, voffB);
        PG8_WAIT_V(6); PG8_BAR;
    } else {
        PG8_STAGE(PG8_SB(0, 0), cB, voffB); PG8_STAGE(PG8_SA(0, 0), cA, voffA); PG8_STAGE(PG8_SB(0, 1), cB + hstepB, voffB); PG8_STAGE(PG8_SA(0, 1), cA + hstepA, voffA);
        if (wr == 1) PG8_BAR;
        PG8_WAIT_V(4); PG8_BAR;
        PG8_STAGE(PG8_SB(1, 0), cB + kstep, voffB); PG8_STAGE(PG8_SA(1, 0), cA + kstep, voffA); PG8_STAGE(PG8_SB(1, 1), cB + hstepB + kstep, voffB);
        PG8_WAIT_V(6); PG8_BAR;
    }
    for (;;) {
        const bool has_next = S.next(ui + 1, nxt);
        const char* nA = has_next ? S.a_base(g, nxt) : cA; const char* nB = has_next ? S.b_base(g, nxt) : cB;
        for (int t = 0; t < nt; t += 2) {
            const bool last = (t == nt - 2);
            const char* a1 = cA + (size_t)(t + 1) * kstep;
            const char* a2 = last ? nA : cA + (size_t)(t + 2) * kstep; const char* b2 = last ? nB : cB + (size_t)(t + 2) * kstep;
            const char* a3 = a2 + kstep; const char* b3 = b2 + kstep;
            if constexpr (SP2) {
            PG8_LDB(B0, 0, 0); PG8_LDB(B1, 0, 1); PG8_SCHED; PG8_LDA(At, 0, 0); PG8_STAGE(PG8_SA(1, 1), a1 + hstepA, voffA);
            PG8_WAIT_V(8); PG8_WAIT_L(0); PG8_BAR; PG8_MMA(0, 0, At, B0); PG8_MMA(0, 1, At, B1); PG8_BAR; PG8_SCHED;
            PG8_LDA(At, 0, 1); PG8_STAGE(PG8_SB(0, 0), b2, voffB); PG8_STAGE(PG8_SB(0, 1), b2 + hstepB, voffB); PG8_STAGE(PG8_SA(0, 0), a2, voffA);
            PG8_WAIT_V(8); PG8_WAIT_L(0); PG8_BAR; PG8_MMA(1, 0, At, B0); PG8_MMA(1, 1, At, B1); PG8_BAR; PG8_SCHED;
            PG8_LDB(B0, 1, 0); PG8_LDB(B1, 1, 1); PG8_SCHED; PG8_LDA(At, 1, 0); PG8_STAGE(PG8_SA(0, 1), a2 + hstepA, voffA);
            PG8_WAIT_V(8); PG8_WAIT_L(0); PG8_BAR; PG8_MMA(0, 0, At, B0); PG8_MMA(0, 1, At, B1); PG8_BAR; PG8_SCHED;
            PG8_LDA(At, 1, 1); PG8_STAGE(PG8_SB(1, 0), b3, voffB); PG8_STAGE(PG8_SB(1, 1), b3 + hstepB, voffB); PG8_STAGE(PG8_SA(1, 0), a3, voffA);
            PG8_WAIT_V(8); PG8_WAIT_L(0); PG8_BAR; PG8_MMA(1, 0, At, B0); PG8_MMA(1, 1, At, B1); PG8_BAR; PG8_SCHED;
            } else {
            PG8_LDB(B0, 0, 0); PG8_SCHED; PG8_LDA(At, 0, 0); PG8_STAGE(PG8_SA(1, 1), a1 + hstepA, voffA);
            PG8_WAIT_L(8); PG8_BAR; PG8_WAIT_L(0); PG8_MMA(0, 0, At, B0); PG8_BAR; PG8_SCHED;
            PG8_LDB(B1, 0, 1); PG8_STAGE(PG8_SB(0, 0), b2, voffB);
            PG8_BAR; PG8_WAIT_L(0); PG8_MMA(0, 1, At, B1); PG8_BAR;
            PG8_LDA(At, 0, 1); PG8_STAGE(PG8_SA(0, 0), a2, voffA);
            PG8_BAR; PG8_WAIT_L(0); PG8_MMA(1, 0, At, B0); PG8_BAR; PG8_SCHED;
            PG8_STAGE(PG8_SB(0, 1), b2 + hstepB, voffB);
            PG8_WAIT_V(6); PG8_BAR; PG8_MMA(1, 1, At, B1); PG8_BAR;
            PG8_LDB(B0, 1, 0); PG8_SCHED; PG8_LDA(At, 1, 0); PG8_STAGE(PG8_SA(0, 1), a2 + hstepA, voffA);
            PG8_WAIT_L(8); PG8_BAR; PG8_WAIT_L(0); PG8_MMA(0, 0, At, B0); PG8_BAR; PG8_SCHED;
            PG8_LDB(B1, 1, 1); PG8_STAGE(PG8_SB(1, 0), b3, voffB);
            PG8_BAR; PG8_WAIT_L(0); PG8_MMA(0, 1, At, B1); PG8_BAR;
            PG8_LDA(At, 1, 1); PG8_STAGE(PG8_SA(1, 0), a3, voffA);
            PG8_BAR; PG8_WAIT_L(0); PG8_MMA(1, 0, At, B0); PG8_BAR; PG8_SCHED;
            PG8_STAGE(PG8_SB(1, 1), b3 + hstepB, voffB);
            PG8_WAIT_V(6); PG8_BAR; PG8_MMA(1, 1, At, B1); PG8_BAR;
            }
        }
        if constexpr (ALIGN_EPI) { if (wr == 0) PG8_BAR; }
        E(acc, cur, wr, wc, fr, fq);
        if (!has_next) break;
#pragma unroll
        for (int a = 0; a < 2; ++a)
#pragma unroll
            for (int b = 0; b < 2; ++b)
#pragma unroll
                for (int m = 0; m < 4; ++m)
#pragma unroll
                    for (int n = 0; n < 2; ++n) acc[a][b][m][n] = (f32x4){0.f, 0.f, 0.f, 0.f};
        cur = nxt; cA = nA; cB = nB; ++ui;
        if constexpr (ALIGN_EPI) { if (wr == 1) PG8_BAR; }
    }
    PG8_WAIT_V(0);
    if constexpr (!ALIGN_EPI) { if (wr == 0) PG8_BAR; }
    PG8_BAR;
#undef PG8_SA
#undef PG8_SB
#undef PG8_STAGE
#undef PG8_LDA
#undef PG8_LDB
#undef PG8_MMA
#undef PG8_WAIT_V
#undef PG8_WAIT_L
#undef PG8_BAR
#undef PG8_SCHED
}
}
#define LAS __attribute__((address_space(3)))
#define XB_TMO      128
#define XB_XCNT(j)  (256  + 64 * (j))
#define XB_XSUB(j)  (1280 + 64 * (j))
#define XB_XGEN(j)  (2304 + 64 * (j))
#define XB_TOP      3328
#define XB_TOPGEN   3392
#define XCD_BAR_WORDS 3456
#define XB_SPIN_CAP (1u << 22)

__device__ __forceinline__ unsigned xb_ld(unsigned* p)              { return __hip_atomic_load(p, __ATOMIC_RELAXED, __HIP_MEMORY_SCOPE_AGENT); }
__device__ __forceinline__ unsigned xb_add(unsigned* p, unsigned v) { return __hip_atomic_fetch_add(p, v, __ATOMIC_RELAXED, __HIP_MEMORY_SCOPE_AGENT); }
__device__ __forceinline__ unsigned xb_xcc_id() { return (unsigned)__builtin_amdgcn_s_getreg((3 << 11) | 20) & 0xFu; }
#define XB_SPIN(cond, bar) do { unsigned _sp = 0; while (cond) { __builtin_amdgcn_s_sleep(1); \
    if ((++_sp & 255u) == 0u) { if (xb_ld(&(bar)[XB_TMO])) break; if (_sp > XB_SPIN_CAP) { atomicAdd(&(bar)[XB_TMO], 1u); break; } } } } while (0)

struct XcdBarrier {
    unsigned* bar; unsigned x;
    volatile LAS unsigned* st;
};

__device__ __forceinline__ XcdBarrier xcd_barrier_post(unsigned* bar, volatile LAS unsigned* st) {
    XcdBarrier b; b.bar = bar; b.x = xb_xcc_id(); b.st = st;
    if (threadIdx.x == 0) (void)xb_add(&bar[XB_XCNT(b.x)], 1u);
    return b;
}
__device__ __forceinline__ void xcd_barrier_complete(unsigned* bar, unsigned x, unsigned& nloc, unsigned& nx) {
    const unsigned G = gridDim.x * gridDim.y * gridDim.z;
    unsigned sum, cnt, mine, sp = 0u;
    for (;;) {
        sum = 0u; cnt = 0u; mine = 0u;
#pragma unroll
        for (unsigned j = 0; j < 16; ++j) { const unsigned c = xb_ld(&bar[XB_XCNT(j)]); sum += c; cnt += (c > 0u) ? 1u : 0u; mine = (j == x) ? c : mine; }
        if (sum == G) break;
        __builtin_amdgcn_s_sleep(1);
        if ((++sp & 255u) == 0u) { if (xb_ld(&bar[XB_TMO])) break; if (sp > XB_SPIN_CAP) { atomicAdd(&bar[XB_TMO], 1u); break; } }
    }
    nloc = mine > 0u ? mine : 1u; nx = cnt > 0u ? cnt : 1u;
}

__device__ __forceinline__ void xcd_barrier(const XcdBarrier& b) {
    asm volatile("s_waitcnt vmcnt(0)" ::: "memory");
    __syncthreads();
    if (threadIdx.x == 0) {
        unsigned* bar = b.bar;
        __builtin_amdgcn_s_waitcnt(0);
        unsigned nloc = b.st[0], nx = b.st[1];
        if (nloc == 0u) { xcd_barrier_complete(bar, b.x, nloc, nx); b.st[0] = nloc; b.st[1] = nx; }
        const unsigned old = xb_add(&bar[XB_XSUB(b.x)], 1u);
        const unsigned gen = old / nloc;
        if (old + 1u == (gen + 1u) * nloc) {
            __builtin_amdgcn_fence(__ATOMIC_RELEASE, "agent");
            asm volatile("s_waitcnt vmcnt(0)" ::: "memory");
            const unsigned og = xb_add(&bar[XB_TOP], 1u);
            const unsigned tg = og / nx;
            if (og + 1u == (tg + 1u) * nx) xb_add(&bar[XB_TOPGEN], 1u);
            else XB_SPIN(xb_ld(&bar[XB_TOPGEN]) == tg, bar);
            __builtin_amdgcn_fence(__ATOMIC_ACQUIRE, "agent");
            xb_add(&bar[XB_XGEN(b.x)], 1u);
            asm volatile("s_waitcnt vmcnt(0)" ::: "memory");
        } else {
            XB_SPIN(xb_ld(&bar[XB_XGEN(b.x)]) == gen, bar);
            __builtin_amdgcn_fence(__ATOMIC_ACQUIRE, "agent");
            asm volatile("s_waitcnt vmcnt(0)" ::: "memory");
        }
    }
    __syncthreads();
}
#undef LAS
constexpr int NWAVES = 8;
constexpr int BATCH = 2, SEQ = 16384, NTOK = BATCH * SEQ, DM = 1024, DEPTH = 4, PLE = 256;
constexpr int EVEN_IN = 2216, EVEN_INP = 2304, ODD_IN = 2568, ODD_INP = 2816;
constexpr int E_FQ = 0, E_FK = 512, E_FV = 1024, E_FLOG = 1536, E_CQ = 1544, E_CKV = 1928, E_KROPE = 2184;
constexpr int O_U = 0, O_Q = 512, O_K = 1024, O_V = 1536, O_GIN = 2048, O_BETA = 2052, O_Z = 2056;
constexpr float RMS_EPS = 1e-6f;
constexpr float LOG2E = 1.4426950408889634f, LN2 = 0.6931471805599453f;
constexpr float C2_FOX = 0.125f * LOG2E, C2_MLA = 0.10206207261596575f * LOG2E;
constexpr int MOE_CAP = 65536 + 32 * 256;
constexpr int MOE_MAXT = MOE_CAP / 256;

enum { I_X = 0, I_P, I_POS, I_NORM_MIX, I_NORM_FFN, I_EV_W_IN, I_FOX_BF, I_FOX_QN, I_FOX_KN, I_MLA_QAN, I_MLA_WQUP, I_MLA_KVAN, I_MLA_WKVUP, I_MLA_QN, I_MLA_KN, I_EV_W_OUT,
       I_OD_W_IN, I_S5_ARE, I_S5_AIM, I_S5_BRE, I_S5_BIM, I_S5_CRE, I_S5_CIM, I_S5_D, I_S5_LS, I_S5_WGLU, I_S5_BGLU, I_GDN_CONV, I_GDN_ALOG, I_GDN_DTB, I_GDN_ONORM, I_OD_W_OUT,
       I_MOE_WGRP, I_MOE_BGRP, I_MOE_WEXP, I_MOE_BEXP, I_MOE_WG, I_MOE_WU, I_MOE_WD, I_PLE_WP, I_PLE_NORM, I_PLE_WG, I_PLE_BG, N_IN };

constexpr size_t MiB = 1u << 20;
constexpr size_t WS_CTL = 0, CTL_ZERO_BYTES = 1 * MiB;
constexpr size_t WS_W_EVIN = 4 * MiB;
constexpr size_t WS_W_ODIN = WS_W_EVIN + 9 * MiB;
constexpr size_t WS_W_QUP = WS_W_ODIN + 11 * MiB;
constexpr size_t WS_W_KVUP = WS_W_QUP + 2 * MiB;
constexpr size_t WS_W_EVOUT = WS_W_KVUP + 1 * MiB;
constexpr size_t WS_W_ODOUT = WS_W_EVOUT + 4 * MiB;
constexpr size_t WS_W_GLU = WS_W_ODOUT + 4 * MiB;
constexpr size_t WS_W_PLEP = WS_W_GLU + 1 * MiB;
constexpr size_t WS_W_PLEG = WS_W_PLEP + 2 * MiB;
constexpr size_t WS_W_MOEGU = WS_W_PLEG + 8 * MiB;
constexpr size_t WS_W_MOED = WS_W_MOEGU + 64 * MiB;
constexpr size_t WS_ABF = WS_W_MOED + 32 * MiB;
constexpr size_t WS_PP = WS_ABF + 64 * MiB;
constexpr size_t WS_PBF = WS_PP + 64 * MiB;
constexpr size_t WS_PROJ = WS_PBF + 16 * MiB;
constexpr size_t WS_MIX = WS_PROJ + 176 * MiB;
constexpr size_t WS_R1 = WS_MIX + 64 * MiB;
constexpr size_t WS_QM = WS_R1, WS_KVB = WS_QM + 48 * MiB, WS_KM = WS_KVB + 64 * MiB, WS_CQN = WS_KM + 48 * MiB, WS_CKVN = WS_CQN + 24 * MiB, WS_LOGF = WS_CKVN + 16 * MiB, WS_CUM = WS_LOGF + 1 * MiB;
constexpr size_t WS_HG = WS_R1, WS_QG = WS_HG + 32 * MiB, WS_KG = WS_QG + 64 * MiB, WS_VG = WS_KG + 64 * MiB, WS_OG = WS_VG + 64 * MiB;
constexpr size_t WS_R2 = WS_R1 + 288 * MiB;
constexpr size_t WS_GB = WS_R2, WS_BETA = WS_GB + 1 * MiB;
constexpr size_t WS_TOKE = WS_R2 + 2 * MiB, WS_TOKW = WS_TOKE + 1 * MiB, WS_ROWS = WS_TOKW + 1 * MiB;
constexpr size_t WS_XG = WS_R1;
constexpr size_t WS_HB = WS_XG + 144 * MiB;
constexpr size_t WS_Y2 = WS_R2 + 8 * MiB;
constexpr size_t WS_END = WS_Y2 + 144 * MiB;
static_assert(WS_HB + 72 * MiB <= WS_R2, "moe overlay");
static_assert(WS_OG + 64 * MiB <= WS_R2, "odd overlay");
static_assert(WS_END <= 1100 * MiB, "workspace budget");

constexpr int CW_BAR = 4096;
constexpr int CW_CNT = 1024;

constexpr int RING_OFF = 0, RING_BYTES = 131072;
constexpr int LDSCTL_OFF = RING_BYTES;
constexpr int LDS_BYTES = 147456;
constexpr int LC_BARST = 32;
constexpr int LC_MOE = 256;

#define GAS __attribute__((address_space(1)))
#define LAS __attribute__((address_space(3)))
typedef unsigned short bf16;
typedef unsigned v4u __attribute__((ext_vector_type(4)));
typedef unsigned v2u __attribute__((ext_vector_type(2)));
typedef float f32x4 __attribute__((ext_vector_type(4)));
#define LDS_WAIT() asm volatile("s_waitcnt lgkmcnt(0)" ::: "memory")
#define VM_WAIT() asm volatile("s_waitcnt vmcnt(0)" ::: "memory")
__device__ __forceinline__ unsigned f2bf(float f) { unsigned u = __builtin_bit_cast(unsigned, f); return (u + 0x7fffu + ((u >> 16) & 1u)) >> 16; }
__device__ __forceinline__ unsigned pk2(float lo, float hi) { return f2bf(lo) | (f2bf(hi) << 16); }
__device__ __forceinline__ float bflo(unsigned w) { return __uint_as_float(w << 16); }
__device__ __forceinline__ float bfhi(unsigned w) { return __uint_as_float(w & 0xffff0000u); }
__device__ __forceinline__ float bf2f(bf16 h) { return __uint_as_float((unsigned)h << 16); }
__device__ __forceinline__ float wave_sum(float v) {
#pragma unroll
    for (int o = 1; o < 64; o <<= 1) v += __shfl_xor(v, o);
    return v;
}
__device__ __forceinline__ float sigm(float x) { return 1.0f / (1.0f + expf(-x)); }
__device__ __forceinline__ float softplusf_(float x) { return fmaxf(x, 0.f) + log1pf(expf(-fabsf(x))); }
__device__ __forceinline__ float gelu_tanh(float x) { return 0.5f * x * (1.0f + tanhf(0.7978845608028654f * (x + 0.044715f * x * x * x))); }

struct Args { const float* in[N_IN]; float* out; unsigned char* ws; int ph_lo, ph_hi; };
#define CAS __attribute__((address_space(4)))
__device__ __forceinline__ const float* kin(int i) { asm volatile("" : "+s"(i)); const CAS char* kp = (const CAS char*)__builtin_amdgcn_kernarg_segment_ptr(); return *(const float* const CAS*)(kp + 8 * i); }
__device__ __forceinline__ float* kout() { int i = N_IN; asm volatile("" : "+s"(i)); const CAS char* kp = (const CAS char*)__builtin_amdgcn_kernarg_segment_ptr(); return *(float* const CAS*)(kp + 8 * i); }
__device__ __forceinline__ unsigned char* kws() { int i = N_IN + 1; asm volatile("" : "+s"(i)); const CAS char* kp = (const CAS char*)__builtin_amdgcn_kernarg_segment_ptr(); return *(unsigned char* const CAS*)(kp + 8 * i); }

struct Frame {
    LAS unsigned char* lds;
    unsigned char* ws;
    unsigned* ctl;
    int tid, lane, wave, G, bid;
};

__device__ __forceinline__ void transpose_item(const float* W, int K, int N, bf16* WT, int drow0, LAS float* scr, int k0, int n0, int lane) {
    const int nn = n0 + (lane & 31); const bool ok = nn < N;
#pragma unroll 8
    for (int i = 0; i < 32; ++i) { const int kk = 2 * i + (lane >> 5); scr[kk * 33 + (lane & 31)] = ok ? W[(size_t)(k0 + kk) * N + nn] : 0.f; }
    LDS_WAIT(); asm volatile("" ::: "memory");
    const int c = lane & 7;
#pragma unroll
    for (int j = 0; j < 4; ++j) { const int n = (lane >> 3) + 8 * j; const LAS float* s = scr + (8 * c) * 33 + n;
        v4u o; o.x = pk2(s[0 * 33], s[1 * 33]); o.y = pk2(s[2 * 33], s[3 * 33]); o.z = pk2(s[4 * 33], s[5 * 33]); o.w = pk2(s[6 * 33], s[7 * 33]);
        *(v4u*)(WT + (size_t)(drow0 + n) * K + k0 + 8 * c) = o; }
    LDS_WAIT(); asm volatile("" ::: "memory");
}
__device__ __forceinline__ void transpose_set(Frame& F, const float* W, int nmat, int K, int N, int NP, bf16* WT, int& itbase) {
    LAS float* scr = (LAS float*)(F.lds + RING_OFF + F.wave * 16384);
    const int gw = F.bid * NWAVES + F.wave, NGW = F.G * NWAVES;
    const int nkb = K / 64, nnb = NP / 32, per = nkb * nnb, total = nmat * per;
    int first = (gw - (itbase % NGW) + NGW) % NGW;
    for (int it = first; it < total; it += NGW) { const int mi = it / per, r = it % per, kb = r / nnb, nb = r % nnb;
        transpose_item(W + (size_t)mi * K * N, K, N, WT + (size_t)mi * NP * K, nb * 32, scr, kb * 64, nb * 32, F.lane); }
    itbase += total;
}
__device__ __forceinline__ void prologue_weights(Frame& F) {
 int itb = 0;
    transpose_set(F, kin(I_EV_W_IN), 2, 1024, EVEN_IN, EVEN_INP, (bf16*)(F.ws + WS_W_EVIN), itb);
    transpose_set(F, kin(I_OD_W_IN), 2, 1024, ODD_IN, ODD_INP, (bf16*)(F.ws + WS_W_ODIN), itb);
    transpose_set(F, kin(I_MLA_WQUP), 2, 384, 768, 768, (bf16*)(F.ws + WS_W_QUP), itb);
    transpose_set(F, kin(I_MLA_WKVUP), 2, 256, 1024, 1024, (bf16*)(F.ws + WS_W_KVUP), itb);
    transpose_set(F, kin(I_EV_W_OUT), 2, 1024, 1024, 1024, (bf16*)(F.ws + WS_W_EVOUT), itb);
    transpose_set(F, kin(I_OD_W_OUT), 2, 1024, 1024, 1024, (bf16*)(F.ws + WS_W_ODOUT), itb);
    transpose_set(F, kin(I_S5_WGLU), 2, 512, 512, 512, (bf16*)(F.ws + WS_W_GLU), itb);
    transpose_set(F, kin(I_PLE_WP), 4, 256, 1024, 1024, (bf16*)(F.ws + WS_W_PLEP), itb);
    transpose_set(F, kin(I_PLE_WG), 4, 1024, 1024, 1024, (bf16*)(F.ws + WS_W_PLEG), itb);
}
__device__ __forceinline__ void moe_weights(Frame& F, int layer) {

    LAS float* scr = (LAS float*)(F.lds + RING_OFF + F.wave * 16384);
    const int gw = F.bid * NWAVES + F.wave, NGW = F.G * NWAVES;
    const float* wg = kin(I_MOE_WG) + (size_t)layer * 32 * 1024 * 512; const float* wu = kin(I_MOE_WU) + (size_t)layer * 32 * 1024 * 512; const float* wd = kin(I_MOE_WD) + (size_t)layer * 32 * 512 * 1024;
    bf16* WGU = (bf16*)(F.ws + WS_W_MOEGU); bf16* WD = (bf16*)(F.ws + WS_W_MOED);
    for (int it = gw; it < 2 * 32 * 256; it += NGW) { const int which = it / (32 * 256), r0 = it % (32 * 256), e = r0 / 256, r = r0 % 256, kb = r / 16, nb = r % 16, n0 = nb * 32;
        const int drow = 256 * (n0 / 128) + (n0 % 128) + which * 128;
        transpose_item((which ? wu : wg) + (size_t)e * 1024 * 512, 1024, 512, WGU + (size_t)e * 1024 * 1024, drow, scr, kb * 64, n0, F.lane); }
    for (int it = gw; it < 32 * 256; it += NGW) { const int e = it / 256, r = it % 256, kb = r / 32, nb = r % 32;
        transpose_item(wd + (size_t)e * 512 * 1024, 512, 1024, WD + (size_t)e * 1024 * 512, nb * 32, scr, kb * 64, nb * 32, F.lane); }
}

__device__ __forceinline__ void rms_row_to_bf16(const float* xrow, const float* gain, bf16* orow, float* copy, int lane) {
    const f32x4* xr = (const f32x4*)xrow + lane; f32x4 v[4]; float s = 0.f;
#pragma unroll
    for (int j = 0; j < 4; ++j) { v[j] = xr[64 * j]; s += (v[j].x * v[j].x + v[j].y * v[j].y) + (v[j].z * v[j].z + v[j].w * v[j].w); }
    const float r = 1.0f / sqrtf(wave_sum(s) * (1.f / 1024.f) + RMS_EPS);
    if (copy) {
#pragma unroll
        for (int j = 0; j < 4; ++j) ((f32x4*)copy + lane)[64 * j] = v[j]; }
    unsigned long long* o8 = (unsigned long long*)orow + lane;
#pragma unroll
    for (int j = 0; j < 4; ++j) { const f32x4 g = ((const f32x4*)gain + lane)[64 * j];
        o8[64 * j] = (unsigned long long)pk2(v[j].x * r * g.x, v[j].y * r * g.y) | ((unsigned long long)pk2(v[j].z * r * g.z, v[j].w * r * g.w) << 32); }
}
__device__ __forceinline__ void phase_norm(Frame& F, const float* src, const float* gain, float* copy) {
    bf16* ABF = (bf16*)(F.ws + WS_ABF);
    const int gw = F.bid * NWAVES + F.wave, NGW = F.G * NWAVES;
    for (int m = gw; m < NTOK; m += NGW) rms_row_to_bf16(src + (size_t)m * DM, gain, ABF + (size_t)m * DM, copy ? copy + (size_t)m * DM : nullptr, F.lane);
}
__device__ __forceinline__ void phase_pconv(Frame& F, int layer) {
    const float* p = kin(I_P) + (size_t)layer * NTOK * PLE; bf16* PBF = (bf16*)(F.ws + WS_PBF);
    const size_t n4 = (size_t)NTOK * PLE / 4; const size_t gt = (size_t)F.bid * 512 + F.tid, NT = (size_t)F.G * 512;
    for (size_t i = gt; i < n4; i += NT) { const f32x4 v = ((const f32x4*)p)[i]; v2u o; o.x = pk2(v.x, v.y); o.y = pk2(v.z, v.w); ((v2u*)PBF)[i] = o; }
}

__device__ __forceinline__ void phase_even_post(Frame& F, int j) {

    bf16* PROJ = (bf16*)(F.ws + WS_PROJ); bf16* CQN = (bf16*)(F.ws + WS_CQN); bf16* CKVN = (bf16*)(F.ws + WS_CKVN); float* LOGF = (float*)(F.ws + WS_LOGF);
    const float* qn = kin(I_FOX_QN) + j * 64; const float* kn = kin(I_FOX_KN) + j * 64; const float* bfv = kin(I_FOX_BF) + j * 8;
    const float* qan = kin(I_MLA_QAN) + j * 384; const float* kvan = kin(I_MLA_KVAN) + j * 256;
    const int gw = F.bid * NWAVES + F.wave, NGW = F.G * NWAVES, lane = F.lane;
    for (int m = gw; m < NTOK; m += NGW) {
        bf16* row = PROJ + (size_t)m * EVEN_INP;
#pragma unroll
        for (int w = 0; w < 2; ++w) {
            v4u* p = (v4u*)(row + (w ? E_FK : E_FQ)) + lane; const v4u x = *p;
            float f[8] = {bflo(x.x), bfhi(x.x), bflo(x.y), bfhi(x.y), bflo(x.z), bfhi(x.z), bflo(x.w), bfhi(x.w)};
            float s = 0.f;
#pragma unroll
            for (int i = 0; i < 8; ++i) s += f[i] * f[i];
            s += __shfl_xor(s, 1); s += __shfl_xor(s, 2); s += __shfl_xor(s, 4);
            const float r = (1.0f / sqrtf(s * (1.f / 64.f) + RMS_EPS)) * (w ? 1.0f : C2_FOX); const float* g = (w ? kn : qn) + (lane & 7) * 8;
            v4u o; o.x = pk2(f[0] * r * g[0], f[1] * r * g[1]); o.y = pk2(f[2] * r * g[2], f[3] * r * g[3]); o.z = pk2(f[4] * r * g[4], f[5] * r * g[5]); o.w = pk2(f[6] * r * g[6], f[7] * r * g[7]);
            *p = o;
        }
        if (lane < 8) { const float z = bf2f(row[E_FLOG + lane]) + bfv[lane]; LOGF[(size_t)m * 8 + lane] = -softplusf_(-z); }
        {
            float f[6]; float s = 0.f;
#pragma unroll
            for (int i = 0; i < 3; ++i) { const unsigned x = *((const unsigned*)(row + E_CQ) + lane + 64 * i); f[2 * i] = bflo(x); f[2 * i + 1] = bfhi(x); s += f[2 * i] * f[2 * i] + f[2 * i + 1] * f[2 * i + 1]; }
            const float r = 1.0f / sqrtf(wave_sum(s) * (1.f / 384.f) + RMS_EPS);
#pragma unroll
            for (int i = 0; i < 3; ++i) { const int c = 2 * (lane + 64 * i); *((unsigned*)(CQN + (size_t)m * 384) + lane + 64 * i) = pk2(f[2 * i] * r * qan[c], f[2 * i + 1] * r * qan[c + 1]); }
        }
        {
            float f[4]; float s = 0.f;
#pragma unroll
            for (int i = 0; i < 2; ++i) { const unsigned x = *((const unsigned*)(row + E_CKV) + lane + 64 * i); f[2 * i] = bflo(x); f[2 * i + 1] = bfhi(x); s += f[2 * i] * f[2 * i] + f[2 * i + 1] * f[2 * i + 1]; }
            const float r = 1.0f / sqrtf(wave_sum(s) * (1.f / 256.f) + RMS_EPS);
#pragma unroll
            for (int i = 0; i < 2; ++i) { const int c = 2 * (lane + 64 * i); *((unsigned*)(CKVN + (size_t)m * 256) + lane + 64 * i) = pk2(f[2 * i] * r * kvan[c], f[2 * i + 1] * r * kvan[c + 1]); }
        }
    }
}
__device__ __forceinline__ void phase_cumsum(Frame& F) {
    if (F.bid >= 16) return;
    const float* LOGF = (const float*)(F.ws + WS_LOGF); float* CUM = (float*)(F.ws + WS_CUM);
    const int b = F.bid >> 3, h = F.bid & 7, t0 = F.tid * 32;
    LAS double* part = (LAS double*)(F.lds + RING_OFF);
    float v[32]; double s = 0.0;
#pragma unroll
    for (int i = 0; i < 32; ++i) { v[i] = LOGF[((size_t)b * SEQ + t0 + i) * 8 + h]; s += (double)v[i]; }
    part[F.tid] = s; __syncthreads();
    if (F.tid == 0) { double run = 0.0; for (int i = 0; i < 512; ++i) { const double x = part[i]; part[i] = run; run += x; } }
    __syncthreads();
    double run = part[F.tid];
#pragma unroll
    for (int i = 0; i < 32; ++i) { run += (double)v[i]; CUM[((size_t)b * SEQ + t0 + i) * 8 + h] = (float)run; }
    __syncthreads();
}
__device__ __forceinline__ void phase_mla_post(Frame& F, int j) {

    const bf16* PROJ = (const bf16*)(F.ws + WS_PROJ); bf16* QM = (bf16*)(F.ws + WS_QM); const bf16* KVB = (const bf16*)(F.ws + WS_KVB); bf16* KM = (bf16*)(F.ws + WS_KM);
    const float* qn = kin(I_MLA_QN) + j * 96; const float* kn = kin(I_MLA_KN) + j * 96; const int* pos = (const int*)kin(I_POS);
    const int gw = F.bid * NWAVES + F.wave, NGW = F.G * NWAVES, lane = F.lane, l32 = lane & 31, hh = lane >> 5;
    const int fi = l32 & 15; const float inv = expf(-(float)fi * (1.0f / 16.0f) * 9.210340371976184f);
    for (int m = gw; m < NTOK; m += NGW) {
        const float ang = (float)pos[m] * inv; float sn, cs; sincosf(ang, &sn, &cs);
        const float krope = bf2f(PROJ[(size_t)m * EVEN_INP + E_KROPE + l32]);
#pragma unroll
        for (int hp = 0; hp < 4; ++hp) { const int h = hp * 2 + hh;
#pragma unroll
            for (int w = 0; w < 2; ++w) {
                float f[3];
                if (w == 0) { const bf16* q = QM + (size_t)m * 768 + h * 96; f[0] = bf2f(q[l32]); f[1] = bf2f(q[l32 + 32]); f[2] = bf2f(q[l32 + 64]); }
                else { const bf16* k = KVB + (size_t)m * 1024 + h * 128; f[0] = bf2f(k[l32]); f[1] = bf2f(k[l32 + 32]); f[2] = krope; }
                float s = f[0] * f[0] + f[1] * f[1] + f[2] * f[2];
                s += __shfl_xor(s, 1); s += __shfl_xor(s, 2); s += __shfl_xor(s, 4); s += __shfl_xor(s, 8); s += __shfl_xor(s, 16);
                const float r = 1.0f / sqrtf(s * (1.f / 96.f) + RMS_EPS); const float* g = w ? kn : qn;
                f[0] *= r * g[l32]; f[1] *= r * g[l32 + 32]; f[2] *= r * g[l32 + 64];
                const float other = __shfl_xor(f[2], 16);
                const float rot = (l32 < 16) ? (f[2] * cs - other * sn) : (other * sn + f[2] * cs);
                bf16* o = (w ? KM : QM) + (size_t)m * 768 + h * 96; const float qs = w ? 1.0f : C2_MLA;
                o[l32] = (bf16)f2bf(f[0] * qs); o[l32 + 32] = (bf16)f2bf(f[1] * qs); o[l32 + 64] = (bf16)f2bf(rot * qs);
            }
        }
    }
}
template <int DK> __device__ __forceinline__ void attn_naive_unit(Frame& F, const bf16* Qp, int qld, const bf16* Kp, int kld, const bf16* Vp, int vld, const float* cum  , float scale, bf16* Op, int qb) {
    LAS float* Ks = (LAS float*)(F.lds + RING_OFF); LAS float* Vs = Ks + 64 * DK; LAS float* Cs = Vs + 64 * 64;
    const int t = qb * 512 + F.wave * 64 + F.lane; const int tmax_w = qb * 512 + F.wave * 64 + 63;
    float q[DK];
#pragma unroll
    for (int d = 0; d < DK; d += 8) { const v4u x = *(const v4u*)(Qp + (size_t)t * qld + d);
        q[d] = bflo(x.x) * scale; q[d + 1] = bfhi(x.x) * scale; q[d + 2] = bflo(x.y) * scale; q[d + 3] = bfhi(x.y) * scale; q[d + 4] = bflo(x.z) * scale; q[d + 5] = bfhi(x.z) * scale; q[d + 6] = bflo(x.w) * scale; q[d + 7] = bfhi(x.w) * scale; }
    const float cq = cum ? cum[(size_t)t * 8] : 0.f;
    float acc[64];
#pragma unroll
    for (int d = 0; d < 64; ++d) acc[d] = 0.f;
    float mx = -1e30f, l = 0.f;
    const int nkb = (qb * 512 + 512) / 64;
    for (int kb = 0; kb < nkb; ++kb) {
        __syncthreads();
        for (int i = F.tid; i < 64 * DK / 8; i += 512) { const int key = i / (DK / 8), c = (i % (DK / 8)) * 8; const v4u x = *(const v4u*)(Kp + (size_t)(kb * 64 + key) * kld + c);
            LAS float* d = Ks + key * DK + c; d[0] = bflo(x.x); d[1] = bfhi(x.x); d[2] = bflo(x.y); d[3] = bfhi(x.y); d[4] = bflo(x.z); d[5] = bfhi(x.z); d[6] = bflo(x.w); d[7] = bfhi(x.w); }
        { const int i = F.tid; const int key = i / 8, c = (i % 8) * 8; const v4u x = *(const v4u*)(Vp + (size_t)(kb * 64 + key) * vld + c);
            LAS float* d = Vs + key * 64 + c; d[0] = bflo(x.x); d[1] = bfhi(x.x); d[2] = bflo(x.y); d[3] = bfhi(x.y); d[4] = bflo(x.z); d[5] = bfhi(x.z); d[6] = bflo(x.w); d[7] = bfhi(x.w); }
        if (F.tid < 64) Cs[F.tid] = cum ? cum[(size_t)(kb * 64 + F.tid) * 8] : 0.f;
        __syncthreads();
        if (kb * 64 > tmax_w) continue;
        for (int jk = 0; jk < 64; ++jk) {
            const int s = kb * 64 + jk; if (s > tmax_w) break;
            const LAS float* kr = Ks + jk * DK; float dot = 0.f;
#pragma unroll
            for (int d = 0; d < DK; d += 4) { const f32x4 kv = *(const LAS f32x4*)(kr + d); dot += q[d] * kv.x + q[d + 1] * kv.y + q[d + 2] * kv.z + q[d + 3] * kv.w; }
            float logit = dot + (cq - Cs[jk]); if (s > t) logit = -1e30f;
            if (__any(logit > mx)) { const float mn = fmaxf(mx, logit); const float corr = expf(mx - mn); l *= corr;
#pragma unroll
                for (int d = 0; d < 64; ++d) acc[d] *= corr;
                mx = mn; }
            const float p = (s > t) ? 0.f : expf(logit - mx); l += p;
            const LAS float* vr = Vs + jk * 64;
#pragma unroll
            for (int d = 0; d < 64; d += 4) { const f32x4 vv = *(const LAS f32x4*)(vr + d); acc[d] += p * vv.x; acc[d + 1] += p * vv.y; acc[d + 2] += p * vv.z; acc[d + 3] += p * vv.w; }
        }
    }
    const float il = 1.0f / l; bf16* o = Op + (size_t)t * DM;
#pragma unroll
    for (int d = 0; d < 64; d += 8) { v4u w; w.x = pk2(acc[d] * il, acc[d + 1] * il); w.y = pk2(acc[d + 2] * il, acc[d + 3] * il); w.z = pk2(acc[d + 4] * il, acc[d + 5] * il); w.w = pk2(acc[d + 6] * il, acc[d + 7] * il); *(v4u*)(o + d) = w; }
}
__device__ __forceinline__ void phase_attn_naive(Frame& F) {
    const bf16* PROJ = (const bf16*)(F.ws + WS_PROJ); const bf16* QM = (const bf16*)(F.ws + WS_QM); const bf16* KVB = (const bf16*)(F.ws + WS_KVB); const bf16* KM = (const bf16*)(F.ws + WS_KM);
    const float* CUM = (const float*)(F.ws + WS_CUM); bf16* MIX = (bf16*)(F.ws + WS_MIX);
    for (int p = F.bid; p < 512; p += F.G) {
        const int combo = p >> 4, qq = p & 15; const int type = combo >> 4, b = (combo >> 3) & 1, h = combo & 7;
#pragma unroll 1
        for (int half = 0; half < 2; ++half) { const int qb = half ? 31 - qq : qq; const size_t rb = (size_t)b * SEQ;
            if (type == 0) attn_naive_unit<64>(F, PROJ + rb * EVEN_INP + E_FQ + h * 64, EVEN_INP, PROJ + rb * EVEN_INP + E_FK + h * 64, EVEN_INP, PROJ + rb * EVEN_INP + E_FV + h * 64, EVEN_INP, CUM + rb * 8 + h, LN2, MIX + rb * DM + h * 64, qb);
            else attn_naive_unit<96>(F, QM + rb * 768 + h * 96, 768, KM + rb * 768 + h * 96, 768, KVB + rb * 1024 + h * 128 + 64, 1024, nullptr, LN2, MIX + rb * DM + 512 + h * 64, qb);
        }
    }
    __syncthreads();
}

__device__ __forceinline__ void s5_scan_wave(Frame& F, int j, int b, int g) {
 const int p = F.lane;
    const bf16* PROJ = (const bf16*)(F.ws + WS_PROJ); bf16* HG = (bf16*)(F.ws + WS_HG);
    const float lr = fminf(kin(I_S5_ARE)[(j * 32 + g) * 64 + p], -1e-4f), li = kin(I_S5_AIM)[(j * 32 + g) * 64 + p];
    const float dt = expf(kin(I_S5_LS)[j * 32 + g]);
    const float mag = expf(lr * dt); const float abr = mag * cosf(li * dt), abi = mag * sinf(li * dt);
    const float den = lr * lr + li * li, nr = abr - 1.0f, ni = abi;
    const float gr = (nr * lr + ni * li) / den, gi = (ni * lr - nr * li) / den;
    float bbr[16], bbi[16], cr[16], ci[16], dsk[16];
#pragma unroll
    for (int c = 0; c < 16; ++c) { const float br = kin(I_S5_BRE)[((size_t)(j * 32 + g) * 64 + p) * 16 + c], bi = kin(I_S5_BIM)[((size_t)(j * 32 + g) * 64 + p) * 16 + c];
        bbr[c] = gr * br - gi * bi; bbi[c] = gr * bi + gi * br;
        cr[c] = kin(I_S5_CRE)[((size_t)(j * 32 + g) * 16 + c) * 64 + p]; ci[c] = kin(I_S5_CIM)[((size_t)(j * 32 + g) * 16 + c) * 64 + p];
        dsk[c] = kin(I_S5_D)[j * 512 + g * 16 + c]; }
    float xr = 0.f, xi = 0.f;
    const bf16* up = PROJ + (size_t)b * SEQ * ODD_INP + O_U + g * 16;
    v4u cur0[4], cur1[4], nx0[4], nx1[4];
#pragma unroll
    for (int i = 0; i < 4; ++i) { cur0[i] = *(const v4u*)(up + (size_t)i * ODD_INP); cur1[i] = *(const v4u*)(up + (size_t)i * ODD_INP + 8); }
    for (int t0 = 0; t0 < SEQ; t0 += 4) {
        const int tn = (t0 + 4 < SEQ) ? t0 + 4 : t0;
#pragma unroll
        for (int i = 0; i < 4; ++i) { nx0[i] = *(const v4u*)(up + (size_t)(tn + i) * ODD_INP); nx1[i] = *(const v4u*)(up + (size_t)(tn + i) * ODD_INP + 8); }
#pragma unroll
        for (int i = 0; i < 4; ++i) {
            float u[16] = {bflo(cur0[i].x), bfhi(cur0[i].x), bflo(cur0[i].y), bfhi(cur0[i].y), bflo(cur0[i].z), bfhi(cur0[i].z), bflo(cur0[i].w), bfhi(cur0[i].w),
                           bflo(cur1[i].x), bfhi(cur1[i].x), bflo(cur1[i].y), bfhi(cur1[i].y), bflo(cur1[i].z), bfhi(cur1[i].z), bflo(cur1[i].w), bfhi(cur1[i].w)};
            float bur = 0.f, bui = 0.f;
#pragma unroll
            for (int c = 0; c < 16; ++c) { bur += bbr[c] * u[c]; bui += bbi[c] * u[c]; }
            const float nxr = abr * xr - abi * xi + bur, nxi = abr * xi + abi * xr + bui; xr = nxr; xi = nxi;
            float y[16];
#pragma unroll
            for (int c = 0; c < 16; ++c) y[c] = wave_sum(cr[c] * xr - ci[c] * xi);
            if (p < 16) { float yy = 0.f, uu = 0.f, dd = 0.f;
#pragma unroll
                for (int c = 0; c < 16; ++c) if (p == c) { yy = y[c]; uu = u[c]; dd = dsk[c]; }
                HG[((size_t)b * SEQ + t0 + i) * 512 + g * 16 + p] = (bf16)f2bf(gelu_tanh(yy + dd * uu)); }
        }
#pragma unroll
        for (int i = 0; i < 4; ++i) { cur0[i] = nx0[i]; cur1[i] = nx1[i]; }
    }
}
__device__ __forceinline__ void gdn_prep_token(Frame& F, int j, int m) {
 const int lane = F.lane;
    const bf16* PROJ = (const bf16*)(F.ws + WS_PROJ); float* QG = (float*)(F.ws + WS_QG); float* KG = (float*)(F.ws + WS_KG); float* VG = (float*)(F.ws + WS_VG);
    float* GB = (float*)(F.ws + WS_GB); float* BETA = (float*)(F.ws + WS_BETA);
    const float* cw = kin(I_GDN_CONV) + (size_t)j * 4 * 1536;
    const int s = m % SEQ;
#pragma unroll
    for (int w = 0; w < 3; ++w) {
        const int ch0 = w * 512 + lane * 8; float acc[8];
#pragma unroll
        for (int i = 0; i < 8; ++i) acc[i] = 0.f;
#pragma unroll
        for (int tap = 0; tap < 4; ++tap) { const int ss = s - 3 + tap; if (ss < 0) continue;
            const v4u x = *(const v4u*)(PROJ + (size_t)(m - 3 + tap) * ODD_INP + O_Q + ch0); const float* wv = cw + tap * 1536 + ch0;
            acc[0] += wv[0] * bflo(x.x); acc[1] += wv[1] * bfhi(x.x); acc[2] += wv[2] * bflo(x.y); acc[3] += wv[3] * bfhi(x.y); acc[4] += wv[4] * bflo(x.z); acc[5] += wv[5] * bfhi(x.z); acc[6] += wv[6] * bflo(x.w); acc[7] += wv[7] * bfhi(x.w); }
        float ss2 = 0.f;
#pragma unroll
        for (int i = 0; i < 8; ++i) { acc[i] = acc[i] * sigm(acc[i]); ss2 += acc[i] * acc[i]; }
        float sc = 1.0f;
        if (w < 2) { ss2 += __shfl_xor(ss2, 1); ss2 += __shfl_xor(ss2, 2); ss2 += __shfl_xor(ss2, 4); ss2 += __shfl_xor(ss2, 8); sc = 1.0f / sqrtf(ss2 + RMS_EPS); if (w == 0) sc *= 0.08838834764831845f; }
        float* dst = (w == 0 ? QG : (w == 1 ? KG : VG)) + (size_t)m * 512 + lane * 8;
        *(f32x4*)dst = (f32x4){acc[0] * sc, acc[1] * sc, acc[2] * sc, acc[3] * sc}; *(f32x4*)(dst + 4) = (f32x4){acc[4] * sc, acc[5] * sc, acc[6] * sc, acc[7] * sc};
    }
    if (lane < 4) { const float gin = bf2f(PROJ[(size_t)m * ODD_INP + O_GIN + lane]), bin = bf2f(PROJ[(size_t)m * ODD_INP + O_BETA + lane]);
        GB[(size_t)m * 4 + lane] = -expf(kin(I_GDN_ALOG)[j * 4 + lane]) * softplusf_(gin + kin(I_GDN_DTB)[j * 4 + lane]); BETA[(size_t)m * 4 + lane] = sigm(bin); }
}
__device__ __forceinline__ void phase_gdn_prep(Frame& F, int j) {
    const int gw = F.bid * NWAVES + F.wave, NGW = F.G * NWAVES;
    for (int m = gw; m < NTOK; m += NGW) gdn_prep_token(F, j, m);
}
__device__ __forceinline__ void phase_odd_a(Frame& F, int j) {
    if (F.wave == 0 && F.bid < 64) { s5_scan_wave(F, j, F.bid >> 5, F.bid & 31); return; }
    const int nbusy = (F.G < 64 ? F.G : 64);
    const int widx = (F.bid < 64) ? F.bid * 7 + (F.wave - 1) : nbusy * 7 + (F.bid - 64) * 8 + F.wave;
    const int nw = nbusy * 7 + (F.G > 64 ? (F.G - 64) * 8 : 0);
    for (int m = widx; m < NTOK; m += nw) gdn_prep_token(F, j, m);
}
__device__ __forceinline__ void phase_gdn_naive(Frame& F) {
    const float* QG = (const float*)(F.ws + WS_QG); const float* KG = (const float*)(F.ws + WS_KG); const float* VG = (const float*)(F.ws + WS_VG);
    const float* GB = (const float*)(F.ws + WS_GB); const float* BETA = (const float*)(F.ws + WS_BETA); float* OG = (float*)(F.ws + WS_OG);
    const int lane = F.lane; const int NGW = F.G * NWAVES;
    for (int u = F.wave * F.G + F.bid; u < 1024; u += NGW) {
        const int b = u >> 9, h = (u >> 7) & 3, c = u & 127; const size_t rb = (size_t)b * SEQ;
        const float* kq = KG + rb * 512 + h * 128 + lane; const float* qq = QG + rb * 512 + h * 128 + lane; const float* vq = VG + rb * 512 + h * 128 + c;
        const float* gq = GB + rb * 4 + h; const float* bq = BETA + rb * 4 + h; float* oq = OG + rb * 512 + h * 128 + c;
        float s0 = 0.f, s1 = 0.f;
        float k0[8], k1[8], q0[8], q1[8], vv[8], gg[8], bb[8], nk0[8], nk1[8], nq0[8], nq1[8], nv[8], ng[8], nb[8];
#pragma unroll
        for (int i = 0; i < 8; ++i) { k0[i] = kq[(size_t)i * 512]; k1[i] = kq[(size_t)i * 512 + 64]; q0[i] = qq[(size_t)i * 512]; q1[i] = qq[(size_t)i * 512 + 64]; vv[i] = vq[(size_t)i * 512]; gg[i] = gq[i * 4]; bb[i] = bq[i * 4]; }
        for (int t0 = 0; t0 < SEQ; t0 += 8) {
            const int tn = (t0 + 8 < SEQ) ? t0 + 8 : t0;
#pragma unroll
            for (int i = 0; i < 8; ++i) { const size_t o = (size_t)(tn + i) * 512; nk0[i] = kq[o]; nk1[i] = kq[o + 64]; nq0[i] = qq[o]; nq1[i] = qq[o + 64]; nv[i] = vq[o]; ng[i] = gq[(tn + i) * 4]; nb[i] = bq[(tn + i) * 4]; }
#pragma unroll
            for (int i = 0; i < 8; ++i) {
                const float ks = wave_sum(k0[i] * s0 + k1[i] * s1); const float eg = expf(gg[i]); const float be = bb[i];
                s0 = eg * (s0 - be * k0[i] * ks) + be * k0[i] * vv[i]; s1 = eg * (s1 - be * k1[i] * ks) + be * k1[i] * vv[i];
                const float o = wave_sum(q0[i] * s0 + q1[i] * s1);
                if (lane == 0) oq[(size_t)(t0 + i) * 512] = o;
            }
#pragma unroll
            for (int i = 0; i < 8; ++i) { k0[i] = nk0[i]; k1[i] = nk1[i]; q0[i] = nq0[i]; q1[i] = nq1[i]; vv[i] = nv[i]; gg[i] = ng[i]; bb[i] = nb[i]; }
        }
    }
}
__device__ __forceinline__ void phase_gdn_out(Frame& F, int j) {
 const float* OG = (const float*)(F.ws + WS_OG); const bf16* PROJ = (const bf16*)(F.ws + WS_PROJ); bf16* MIX = (bf16*)(F.ws + WS_MIX);
    const float* on = kin(I_GDN_ONORM) + j * 128; const int lane = F.lane;
    const int gw = F.bid * NWAVES + F.wave, NGW = F.G * NWAVES;
    for (int m = gw; m < NTOK; m += NGW) {
        const f32x4 a = *(const f32x4*)(OG + (size_t)m * 512 + lane * 8), b = *(const f32x4*)(OG + (size_t)m * 512 + lane * 8 + 4);
        float f[8] = {a.x, a.y, a.z, a.w, b.x, b.y, b.z, b.w}; float s = 0.f;
#pragma unroll
        for (int i = 0; i < 8; ++i) s += f[i] * f[i];
        s += __shfl_xor(s, 1); s += __shfl_xor(s, 2); s += __shfl_xor(s, 4); s += __shfl_xor(s, 8);
        const float r = 1.0f / sqrtf(s * (1.f / 128.f) + RMS_EPS);
        const bf16* z = PROJ + (size_t)m * ODD_INP + O_Z + lane * 8; const float* g = on + (lane & 15) * 8; float o[8];
#pragma unroll
        for (int i = 0; i < 8; ++i) { const float zz = bf2f(z[i]); o[i] = f[i] * r * g[i] * (zz * sigm(zz)); }
        v4u w; w.x = pk2(o[0], o[1]); w.y = pk2(o[2], o[3]); w.z = pk2(o[4], o[5]); w.w = pk2(o[6], o[7]);
        *(v4u*)(MIX + (size_t)m * DM + 512 + lane * 8) = w;
    }
}

__device__ __forceinline__ void phase_router(Frame& F, int layer) {
 const float* H = kout(); bf16* ABF = (bf16*)(F.ws + WS_ABF);
    const float* gain = kin(I_NORM_FFN) + layer * DM; const float* wgr = kin(I_MOE_WGRP) + (size_t)layer * DM * 4; const float* bgr = kin(I_MOE_BGRP) + layer * 4;
    const float* wex = kin(I_MOE_WEXP) + (size_t)layer * DM * 32; const float* bex = kin(I_MOE_BEXP) + layer * 32;
    int* TOKE = (int*)(F.ws + WS_TOKE); float* TOKW = (float*)(F.ws + WS_TOKW);
    LAS int* lcnt = (LAS int*)(F.lds + LDSCTL_OFF + LC_MOE + 512); LAS int* gbase = (LAS int*)(F.lds + LDSCTL_OFF + LC_MOE + 640);
    const int lane = F.lane; const int per = NTOK / F.G;
    LAS int* lasg = (LAS int*)(F.lds + RING_OFF);
    if (F.tid < 32) lcnt[F.tid] = 0;
    __syncthreads();
    for (int tl = F.wave; tl < per; tl += NWAVES) {
        const int m = F.bid * per + tl;
        const f32x4* xr = (const f32x4*)(H + (size_t)m * DM) + lane; f32x4 v[4]; float s = 0.f;
#pragma unroll
        for (int q = 0; q < 4; ++q) { v[q] = xr[64 * q]; s += (v[q].x * v[q].x + v[q].y * v[q].y) + (v[q].z * v[q].z + v[q].w * v[q].w); }
        const float r = 1.0f / sqrtf(wave_sum(s) * (1.f / 1024.f) + RMS_EPS);
        unsigned long long* o8 = (unsigned long long*)(ABF + (size_t)m * DM) + lane;
#pragma unroll
        for (int q = 0; q < 4; ++q) { const f32x4 g = ((const f32x4*)gain + lane)[64 * q]; v[q].x *= r * g.x; v[q].y *= r * g.y; v[q].z *= r * g.z; v[q].w *= r * g.w;
            o8[64 * q] = (unsigned long long)pk2(v[q].x, v[q].y) | ((unsigned long long)pk2(v[q].z, v[q].w) << 32); }
        float lg[4] = {0.f, 0.f, 0.f, 0.f};
#pragma unroll
        for (int q = 0; q < 4; ++q) { const int k0 = 4 * lane + 256 * q;
#pragma unroll
            for (int e = 0; e < 4; ++e) { const f32x4 w = *(const f32x4*)(wgr + (size_t)(k0 + e) * 4); const float x = v[q][e]; lg[0] += x * w.x; lg[1] += x * w.y; lg[2] += x * w.z; lg[3] += x * w.w; } }
#pragma unroll
        for (int g = 0; g < 4; ++g) lg[g] = wave_sum(lg[g]) + bgr[g];
        int gi = 0; float gm = lg[0];
#pragma unroll
        for (int g = 1; g < 4; ++g) if (lg[g] > gm) { gm = lg[g]; gi = g; }
        float gden = 0.f;
#pragma unroll
        for (int g = 0; g < 4; ++g) gden += expf(lg[g] - gm);
        const float gw_ = 1.0f / gden;
        float le[8] = {0.f, 0.f, 0.f, 0.f, 0.f, 0.f, 0.f, 0.f};
#pragma unroll
        for (int q = 0; q < 4; ++q) { const int k0 = 4 * lane + 256 * q;
#pragma unroll
            for (int e = 0; e < 4; ++e) { const float* wp = wex + (size_t)(k0 + e) * 32 + gi * 8; const f32x4 w0 = *(const f32x4*)wp, w1 = *(const f32x4*)(wp + 4); const float x = v[q][e];
                le[0] += x * w0.x; le[1] += x * w0.y; le[2] += x * w0.z; le[3] += x * w0.w; le[4] += x * w1.x; le[5] += x * w1.y; le[6] += x * w1.z; le[7] += x * w1.w; } }
#pragma unroll
        for (int e = 0; e < 8; ++e) le[e] = wave_sum(le[e]) + bex[gi * 8 + e];
        int i0 = 0; float m0 = le[0];
#pragma unroll
        for (int e = 1; e < 8; ++e) if (le[e] > m0) { m0 = le[e]; i0 = e; }
        int i1 = -1; float m1 = -3.0e38f;
#pragma unroll
        for (int e = 0; e < 8; ++e) if (e != i0 && le[e] > m1) { m1 = le[e]; i1 = e; }
        const float e1 = expf(m1 - m0); const float w0 = gw_ / (1.0f + e1), w1 = gw_ * e1 / (1.0f + e1);
        if (lane == 0) { const int ea = gi * 8 + i0, eb = gi * 8 + i1;
            const int pa = __hip_atomic_fetch_add(lcnt + ea, 1, __ATOMIC_RELAXED, __HIP_MEMORY_SCOPE_WORKGROUP), pb = __hip_atomic_fetch_add(lcnt + eb, 1, __ATOMIC_RELAXED, __HIP_MEMORY_SCOPE_WORKGROUP);
            lasg[tl * 2] = ea | (pa << 8); lasg[tl * 2 + 1] = eb | (pb << 8);
            TOKW[(size_t)m * 2] = w0; TOKW[(size_t)m * 2 + 1] = w1; }
    }
    __syncthreads();
    if (F.tid < 32) gbase[F.tid] = (int)__hip_atomic_fetch_add(F.ctl + CW_CNT + 64 * layer + F.tid, (unsigned)lcnt[F.tid], __ATOMIC_RELAXED, __HIP_MEMORY_SCOPE_AGENT);
    __syncthreads();
    for (int i = F.tid; i < per * 2; i += 512) { const int a = lasg[i], e = a & 255, lp = a >> 8; TOKE[(size_t)F.bid * per * 2 + i] = e | ((gbase[e] + lp) << 8); }
    __syncthreads();
}
__device__ __forceinline__ void moe_tables(Frame& F, int layer) {
    LAS int* rowbase = (LAS int*)(F.lds + LDSCTL_OFF + LC_MOE); LAS unsigned char* tile_e = (LAS unsigned char*)(F.lds + LDSCTL_OFF + LC_MOE + 192);
    if (F.tid == 0) { int rb = 0;
#pragma unroll 1
        for (int e = 0; e < 32; ++e) { const int c = (int)__hip_atomic_load(F.ctl + CW_CNT + 64 * layer + e, __ATOMIC_RELAXED, __HIP_MEMORY_SCOPE_AGENT); rowbase[e] = rb; const int nt = (c + 255) >> 8;
            for (int i = 0; i < nt; ++i) tile_e[(rb >> 8) + i] = (unsigned char)e; rb += nt << 8; }
        rowbase[32] = rb; rowbase[34] = rb >> 8; }
    __syncthreads();
}
__device__ __forceinline__ void phase_moe_scatter(Frame& F, int layer) {
    moe_tables(F, layer);
    const LAS int* rowbase = (const LAS int*)(F.lds + LDSCTL_OFF + LC_MOE);
    const bf16* ABF = (const bf16*)(F.ws + WS_ABF); bf16* XG = (bf16*)(F.ws + WS_XG); const int* TOKE = (const int*)(F.ws + WS_TOKE); int* ROWS = (int*)(F.ws + WS_ROWS);
    const int gw = F.bid * NWAVES + F.wave, NGW = F.G * NWAVES, lane = F.lane;
    for (int m = gw; m < NTOK; m += NGW) {
        const v4u a = *((const v4u*)(ABF + (size_t)m * DM) + lane), b = *((const v4u*)(ABF + (size_t)m * DM) + 64 + lane);
#pragma unroll
        for (int k = 0; k < 2; ++k) { const int te = TOKE[(size_t)m * 2 + k]; const int row = rowbase[te & 255] + (te >> 8);
            *((v4u*)(XG + (size_t)row * DM) + lane) = a; *((v4u*)(XG + (size_t)row * DM) + 64 + lane) = b;
            if (lane == 0) ROWS[(size_t)m * 2 + k] = row; }
    }
}
struct MoeOrder {
    int ntiles, nN, G, c; const LAS unsigned char* tile_e; size_t bstride;
    __device__ bool next(int i, pg8::Unit& u) const { const long L = (long)i * G + c; if (L >= (long)ntiles * nN) return false; u.pm = (int)(L / nN); u.pn = (int)(L % nN); u.aux = __builtin_amdgcn_readfirstlane((int)tile_e[u.pm]); return true; }
    __device__ __forceinline__ const char* a_base(const pg8::Gemm& g, const pg8::Unit& u) const { return (const char*)g.A + (size_t)u.pm * 256 * g.lda * 2; }
    __device__ __forceinline__ const char* b_base(const pg8::Gemm& g, const pg8::Unit& u) const { return (const char*)g.Bt + (size_t)u.aux * bstride + (size_t)u.pn * 256 * g.ldb * 2; }
};
__device__ __forceinline__ void phase_moe_combine(Frame& F, int layer) {
 float* H = kout(); bf16* ABF = (bf16*)(F.ws + WS_ABF); const bf16* Y2 = (const bf16*)(F.ws + WS_Y2);
    const int* ROWS = (const int*)(F.ws + WS_ROWS); const float* TOKW = (const float*)(F.ws + WS_TOKW); const float* gain = kin(I_PLE_NORM) + layer * DM;
    const int gw = F.bid * NWAVES + F.wave, NGW = F.G * NWAVES, lane = F.lane;
    for (int m = gw; m < NTOK; m += NGW) {
        const int r0 = ROWS[(size_t)m * 2], r1 = ROWS[(size_t)m * 2 + 1]; const float w0 = TOKW[(size_t)m * 2], w1 = TOKW[(size_t)m * 2 + 1];
        f32x4* hr = (f32x4*)(H + (size_t)m * DM) + lane; f32x4 v[4]; float s = 0.f;
#pragma unroll
        for (int q = 0; q < 4; ++q) { v[q] = hr[64 * q]; const v2u ya = *((const v2u*)(Y2 + (size_t)r0 * DM) + lane + 64 * q), yb = *((const v2u*)(Y2 + (size_t)r1 * DM) + lane + 64 * q);
            v[q].x += w0 * bflo(ya.x) + w1 * bflo(yb.x); v[q].y += w0 * bfhi(ya.x) + w1 * bfhi(yb.x); v[q].z += w0 * bflo(ya.y) + w1 * bflo(yb.y); v[q].w += w0 * bfhi(ya.y) + w1 * bfhi(yb.y);
            hr[64 * q] = v[q]; s += (v[q].x * v[q].x + v[q].y * v[q].y) + (v[q].z * v[q].z + v[q].w * v[q].w); }
        const float r = 1.0f / sqrtf(wave_sum(s) * (1.f / 1024.f) + RMS_EPS);
        unsigned long long* o8 = (unsigned long long*)(ABF + (size_t)m * DM) + lane;
#pragma unroll
        for (int q = 0; q < 4; ++q) { const f32x4 g = ((const f32x4*)gain + lane)[64 * q];
            o8[64 * q] = (unsigned long long)pk2(v[q].x * r * g.x, v[q].y * r * g.y) | ((unsigned long long)pk2(v[q].z * r * g.z, v[q].w * r * g.w) << 32); }
    }
}
namespace att {
using bf16x8 = __attribute__((ext_vector_type(8))) short;
using s16x4 = __attribute__((ext_vector_type(4))) short;
using f32x16 = __attribute__((ext_vector_type(16))) float;
using u32x4 = __attribute__((ext_vector_type(4))) unsigned;
typedef float f32x2_t __attribute__((ext_vector_type(2))); typedef __bf16 bf16x2_t __attribute__((ext_vector_type(2)));
constexpr int KSLOT = 16384, VSLOT = 8192;
constexpr int L_K = 0, L_V = 2 * KSLOT, L_B = L_V + 2 * VSLOT, L_WS = L_B + 512, L_OST = L_WS + 8 * 256, L_BYTES = L_OST + 8 * 4096;
__device__ __forceinline__ int crow(int r, int hi) { return (r & 3) + 8 * (r >> 2) + 4 * hi; }
__device__ __forceinline__ void glds16(const void* gsrc, unsigned lds_dst) { unsigned keep;
    asm volatile("s_mov_b32 %0, m0\n\ts_mov_b32 m0, %2\n\ts_nop 0\n\tglobal_load_lds_dwordx4 %1, off\n\ts_mov_b32 m0, %0" : "=&s"(keep) : "v"(gsrc), "s"(lds_dst) : "memory"); }
__device__ __forceinline__ unsigned cvtpk(float lo, float hi) { f32x2_t v = {lo, hi}; bf16x2_t b = __builtin_convertvector(v, bf16x2_t); return __builtin_bit_cast(unsigned, b); }
#define ATT_WAIT_BAR() asm volatile("s_waitcnt vmcnt(0) lgkmcnt(0)\n\ts_barrier" ::: "memory")

template <int DK, bool BIAS>
__device__ __forceinline__ void attn_unit(const int tid, const int qb, const bf16* Qh, const int qp, const bf16* Kh, const int kp, const bf16* Vh, const int vp, const float* cumh  , bf16* Oh  , char* shm) {
    constexpr int ND = DK / 16, KCH = DK / 8;
    const int lane = tid & 63, r32 = lane & 31, hi = lane >> 5; const int wid = __builtin_amdgcn_readfirstlane(tid >> 6);
    const int q0 = qb * 256;
    const unsigned lds0 = (unsigned)(uintptr_t)shm;
    float* wsf = (float*)(shm + L_WS) + wid * 64;
    float* Bs = (float*)(shm + L_B);
    const bf16* ksrc = Kh + (size_t)lane * kp + wid * 8;
    const bf16* vsrc = Vh + (size_t)(16 * (wid & 3) + (lane >> 2)) * vp + (wid >> 2) * 32 + (lane & 3) * 8;
    const unsigned kdst = lds0 + L_K + wid * 1024, vdst = lds0 + L_V + wid * 1024;
    const int NT = (q0 + 256) / 64;
    const float cref = BIAS ? cumh[(size_t)q0 * 8] : 0.f;
#define ATT_DMA(t, slot) do { glds16(ksrc + (size_t)(t) * 64 * kp, (unsigned)__builtin_amdgcn_readfirstlane(kdst + (slot) * KSLOT)); \
        if (KCH > 8) glds16(ksrc + (size_t)(t) * 64 * kp + 64, (unsigned)__builtin_amdgcn_readfirstlane(kdst + (slot) * KSLOT + 8192)); \
        glds16(vsrc + (size_t)(t) * 64 * vp, (unsigned)__builtin_amdgcn_readfirstlane(vdst + (slot) * VSLOT)); } while (0)
    ATT_DMA(0, 0);
    if (BIAS && wid == 0) Bs[lane] = (cref - cumh[(size_t)lane * 8]) * 1.4426950408889634f;
    bf16x8 qr[ND];
#pragma unroll
    for (int d0 = 0; d0 < ND; ++d0) qr[d0] = *reinterpret_cast<const bf16x8*>(Qh + (size_t)(q0 + wid * 32 + r32) * qp + d0 * 16 + hi * 8);
    float mhat = 0.f, l_reg = 0.f; f32x16 o[2]; o[0] = f32x16{}; o[1] = f32x16{}; f32x16 negm = f32x16{};
    const int qrel = wid * 32 + r32;
    const int vb0 = (int)(lds0 + L_V) + ((lane >> 4) & 1) * 32 + (lane & 3) * 8 + (4 * hi + ((lane & 15) >> 2)) * 64;
    ATT_WAIT_BAR();
    for (int t = 0; t < NT; ++t) {
        const int cur = t & 1;
        float bnext = 0.f;
        if (t + 1 < NT) { ATT_DMA(t + 1, cur ^ 1); if (BIAS && wid == 0) bnext = cumh[(size_t)((t + 1) * 64 + lane) * 8]; }
        f32x16 p0, p1;
        { const char* kb = shm + L_K + cur * KSLOT + hi * 1024 + r32 * 16;
#pragma unroll
          for (int d0 = 0; d0 < ND; ++d0) { const bf16x8 b0 = *reinterpret_cast<const bf16x8*>(kb + d0 * 2048); const bf16x8 b1 = *reinterpret_cast<const bf16x8*>(kb + d0 * 2048 + 512);
            if (d0 == 0) { p0 = __builtin_amdgcn_mfma_f32_32x32x16_bf16(b0, qr[0], negm, 0, 0, 0); p1 = __builtin_amdgcn_mfma_f32_32x32x16_bf16(b1, qr[0], negm, 0, 0, 0); }
            else { p0 = __builtin_amdgcn_mfma_f32_32x32x16_bf16(b0, qr[d0], p0, 0, 0, 0); p1 = __builtin_amdgcn_mfma_f32_32x32x16_bf16(b1, qr[d0], p1, 0, 0, 0); } } }
        if (BIAS) { const float* bb = Bs + cur * 64 + 4 * hi;
#pragma unroll
            for (int g = 0; g < 4; ++g) { const f32x4 x0 = *(const f32x4*)(bb + 8 * g), x1 = *(const f32x4*)(bb + 32 + 8 * g);
#pragma unroll
                for (int e = 0; e < 4; ++e) { p0[4 * g + e] += x0[e]; p1[4 * g + e] += x1[e]; } } }
        if (t >= NT - 4) { const int kb0 = 64 * (t - (NT - 4)) + 4 * hi;
#pragma unroll
            for (int r = 0; r < 16; ++r) { const int kv = kb0 + (r & 3) + 8 * (r >> 2); if (kv > qrel) p0[r] = -INFINITY; if (kv + 32 > qrel) p1[r] = -INFINITY; } }
        float rm = fmaxf(p0[0], p1[0]);
#pragma unroll
        for (int r = 1; r < 16; ++r) rm = fmaxf(rm, fmaxf(p0[r], p1[r]));
        { auto rr = __builtin_amdgcn_permlane32_swap(__float_as_uint(rm), __float_as_uint(rm), false, false); rm = fmaxf(__uint_as_float(rr[0]), __uint_as_float(rr[1])); }
        bool resc = false;
        if (t == 0) { mhat = rm;
#pragma unroll
            for (int r = 0; r < 16; ++r) { p0[r] -= rm; p1[r] -= rm; }
#pragma unroll
            for (int r = 0; r < 16; ++r) negm[r] = -mhat;
        } else if (__any(rm > 8.0f)) { const float dl = fmaxf(rm, 0.f); mhat += dl;
#pragma unroll
            for (int r = 0; r < 16; ++r) { p0[r] -= dl; p1[r] -= dl; }
#pragma unroll
            for (int r = 0; r < 16; ++r) negm[r] = -mhat;
            const float f = __builtin_amdgcn_exp2f(-dl); l_reg *= f; if (hi == 0) wsf[r32] = f; resc = true; }
        float sacc = 0.f;
#pragma unroll
        for (int r = 0; r < 16; ++r) { p0[r] = __builtin_amdgcn_exp2f(p0[r]); p1[r] = __builtin_amdgcn_exp2f(p1[r]); sacc += p0[r] + p1[r]; }
        l_reg += sacc;
        u32x4 pw0, pw1, pw2, pw3;
        pw0 = (u32x4){cvtpk(p0[0], p0[1]), cvtpk(p0[2], p0[3]), cvtpk(p0[4], p0[5]), cvtpk(p0[6], p0[7])}; pw1 = (u32x4){cvtpk(p0[8], p0[9]), cvtpk(p0[10], p0[11]), cvtpk(p0[12], p0[13]), cvtpk(p0[14], p0[15])};
        pw2 = (u32x4){cvtpk(p1[0], p1[1]), cvtpk(p1[2], p1[3]), cvtpk(p1[4], p1[5]), cvtpk(p1[6], p1[7])}; pw3 = (u32x4){cvtpk(p1[8], p1[9]), cvtpk(p1[10], p1[11]), cvtpk(p1[12], p1[13]), cvtpk(p1[14], p1[15])};
        if (resc) { asm volatile("s_waitcnt lgkmcnt(0)" ::: "memory");
#pragma unroll
            for (int d_ = 0; d_ < 2; ++d_)
#pragma unroll
                for (int r = 0; r < 16; ++r) o[d_][r] *= wsf[crow(r, hi)]; }
        { const int vb = vb0 + cur * VSLOT;
#pragma unroll
          for (int d0 = 0; d0 < 2; ++d0) { s16x4 lo[4], hh[4];
#pragma unroll
            for (int ks = 0; ks < 4; ++ks) {
                asm volatile("ds_read_b64_tr_b16 %0,%1 offset:%c2" : "=&v"(lo[ks]) : "v"(vb), "i"(d0 * 4096 + ks * 1024) : "memory");
                asm volatile("ds_read_b64_tr_b16 %0,%1 offset:%c2" : "=&v"(hh[ks]) : "v"(vb), "i"(d0 * 4096 + ks * 1024 + 512) : "memory"); }
            asm volatile("s_waitcnt lgkmcnt(0)" ::: "memory"); __builtin_amdgcn_sched_barrier(0);
#define ATT_PK(k) (bf16x8){lo[k][0], lo[k][1], lo[k][2], lo[k][3], hh[k][0], hh[k][1], hh[k][2], hh[k][3]}
            o[d0] = __builtin_amdgcn_mfma_f32_32x32x16_bf16(__builtin_bit_cast(bf16x8, pw0), ATT_PK(0), o[d0], 0, 0, 0);
            o[d0] = __builtin_amdgcn_mfma_f32_32x32x16_bf16(__builtin_bit_cast(bf16x8, pw1), ATT_PK(1), o[d0], 0, 0, 0);
            o[d0] = __builtin_amdgcn_mfma_f32_32x32x16_bf16(__builtin_bit_cast(bf16x8, pw2), ATT_PK(2), o[d0], 0, 0, 0);
            o[d0] = __builtin_amdgcn_mfma_f32_32x32x16_bf16(__builtin_bit_cast(bf16x8, pw3), ATT_PK(3), o[d0], 0, 0, 0);
#undef ATT_PK
          } }
        if (BIAS && wid == 0 && t + 1 < NT) Bs[(cur ^ 1) * 64 + lane] = (cref - bnext) * 1.4426950408889634f;
        ATT_WAIT_BAR();
    }
    { auto rr = __builtin_amdgcn_permlane32_swap(__float_as_uint(l_reg), __float_as_uint(l_reg), false, false); l_reg = __uint_as_float(rr[0]) + __uint_as_float(rr[1]); }
    if (hi == 0) wsf[32 + r32] = l_reg; asm volatile("s_waitcnt lgkmcnt(0)" ::: "memory");
    float rli[16];
#pragma unroll
    for (int r = 0; r < 16; ++r) rli[r] = __builtin_amdgcn_rcpf(wsf[32 + crow(r, hi)]);
    bf16* Ow = Oh + (size_t)(q0 + wid * 32) * DM;
    { bf16* stg = (bf16*)(shm + L_OST) + wid * 2048;
#pragma unroll
      for (int r = 0; r < 16; ++r) { const int orow = crow(r, hi);
#pragma unroll
        for (int d0 = 0; d0 < 2; ++d0) stg[orow * 64 + d0 * 32 + r32] = (bf16)f2bf(o[d0][r] * rli[r]); }
      asm volatile("s_waitcnt lgkmcnt(0)" ::: "memory");
#pragma unroll
      for (int i = 0; i < 4; ++i) { const int row = i * 8 + (lane >> 3), ch = lane & 7; const u32x4 v = *(const u32x4*)(stg + row * 64 + ch * 8); *(u32x4*)(Ow + (size_t)row * DM + ch * 8) = v; } }
    asm volatile("s_waitcnt lgkmcnt(0)\n\ts_barrier" ::: "memory");
#undef ATT_DMA
}
}

__device__ __forceinline__ void phase_attn_mfma(Frame& F) {
    const bf16* PROJ = (const bf16*)(F.ws + WS_PROJ); const bf16* QM = (const bf16*)(F.ws + WS_QM); const bf16* KVB = (const bf16*)(F.ws + WS_KVB); const bf16* KM = (const bf16*)(F.ws + WS_KM);
    const float* CUM = (const float*)(F.ws + WS_CUM); bf16* MIX = (bf16*)(F.ws + WS_MIX);
    char* shm = (char*)(F.lds + RING_OFF);
    const int vcu = (F.G % 8 == 0) ? (F.bid % 8) * (F.G / 8) + F.bid / 8 : F.bid;
#pragma unroll 1
    for (int p = vcu; p < 512; p += F.G) { const int combo = p >> 5, s = p & 31, b = combo >> 3, h = combo & 7; const size_t rb = (size_t)b * SEQ;
#pragma unroll 1
        for (int half = 0; half < 2; ++half) { const int qb = half ? 63 - s : s;
            att::attn_unit<64, true>(F.tid, qb, PROJ + rb * EVEN_INP + E_FQ + h * 64, EVEN_INP, PROJ + rb * EVEN_INP + E_FK + h * 64, EVEN_INP, PROJ + rb * EVEN_INP + E_FV + h * 64, EVEN_INP, CUM + rb * 8 + h, MIX + rb * DM + h * 64, shm); } }
#pragma unroll 1
    for (int p = vcu; p < 512; p += F.G) { const int combo = p >> 5, s = p & 31, b = combo >> 3, h = combo & 7; const size_t rb = (size_t)b * SEQ;
#pragma unroll 1
        for (int half = 0; half < 2; ++half) { const int qb = half ? 63 - s : s;
            att::attn_unit<96, false>(F.tid, qb, QM + rb * 768 + h * 96, 768, KM + rb * 768 + h * 96, 768, KVB + rb * 1024 + h * 128 + 64, 1024, nullptr, MIX + rb * DM + 512 + h * 64, shm); } }
}
constexpr size_t WS_S5_MT = WS_Y2;
constexpr size_t WS_S5_PT = WS_S5_MT + 72 * MiB;
constexpr size_t WS_S5_AX = WS_S5_PT + 16 * MiB;
constexpr size_t WS_S5_XLOC = WS_S5_AX + 36 * MiB;
static_assert(WS_S5_XLOC + 8 * MiB <= WS_Y2 + 144 * MiB, "s5 overlay");

__device__ __forceinline__ void s5_build(Frame& F, int j) {
    if (F.bid >= 256) return;
    const int g = F.bid >> 3, part = F.bid & 7, tid = F.tid, lane = F.lane, wave = F.wave;
    LAS float* pwr = (LAS float*)(F.lds + RING_OFF);
    LAS float* pwi = pwr + 65 * 64;
    LAS float* bbr = pwi + 65 * 64;
    LAS float* bbi = bbr + 1024;
    LAS float* crs = bbi + 1024;
    LAS float* cis = crs + 1024;
    LAS bf16* ktab = (LAS bf16*)(cis + 1024);
    const float dt = expf(kin(I_S5_LS)[j * 32 + g]);
    const float* are = kin(I_S5_ARE) + (size_t)(j * 32 + g) * 64; const float* aim = kin(I_S5_AIM) + (size_t)(j * 32 + g) * 64;
    for (int e = tid; e < 65 * 64; e += 512) { const int d = e >> 6, p = e & 63; const float lr = fminf(are[p], -1e-4f), li = aim[p];
        const float mag = expf(lr * dt * (float)d); float sn, cs; sincosf(li * dt * (float)d, &sn, &cs); pwr[e] = mag * cs; pwi[e] = mag * sn; }
    for (int e = tid; e < 1024; e += 512) { const int p = e >> 4, c = e & 15; const float lr = fminf(are[p], -1e-4f), li = aim[p];
        const float mag = expf(lr * dt); float sn, cs; sincosf(li * dt, &sn, &cs); const float abr = mag * cs, abi = mag * sn;
        const float den = lr * lr + li * li, nr = abr - 1.0f, ni = abi; const float gr = (nr * lr + ni * li) / den, gi = (ni * lr - nr * li) / den;
        const float br = kin(I_S5_BRE)[((size_t)(j * 32 + g) * 64 + p) * 16 + c], bi = kin(I_S5_BIM)[((size_t)(j * 32 + g) * 64 + p) * 16 + c];
        bbr[e] = gr * br - gi * bi; bbi[e] = gr * bi + gi * br; }
    for (int e = tid; e < 1024; e += 512) { crs[e] = kin(I_S5_CRE)[(size_t)(j * 32 + g) * 1024 + e]; cis[e] = kin(I_S5_CIM)[(size_t)(j * 32 + g) * 1024 + e]; }
    __syncthreads();
    { const int cc = tid >> 1, c = cc >> 4, c2 = cc & 15, ph = tid & 1;
      float er[32], ei[32];
#pragma unroll
      for (int pp = 0; pp < 32; ++pp) { const int p = 32 * ph + pp; const float xr = crs[c * 64 + p], xi = cis[c * 64 + p], yr = bbr[p * 16 + c2], yi = bbi[p * 16 + c2]; er[pp] = xr * yr - xi * yi; ei[pp] = xr * yi + xi * yr; }
#pragma unroll 1
      for (int d = 0; d < 64; ++d) { float s = 0.f; const LAS float* wr_ = pwr + d * 64 + 32 * ph; const LAS float* wi_ = pwi + d * 64 + 32 * ph;
#pragma unroll
          for (int pp = 0; pp < 32; ++pp) s += wr_[pp] * er[pp] - wi_[pp] * ei[pp];
          s += __shfl_xor(s, 1);
          if (ph == 0) ktab[(d * 16 + c) * 16 + c2] = (bf16)f2bf(s); } }
    __syncthreads();
    bf16* MT = (bf16*)(F.ws + WS_S5_MT) + (size_t)g * 1024 * 1152;
#pragma unroll 1
    for (int rr = wave; rr < 128; rr += 8) { const int i = part * 8 + (rr >> 4), c = rr & 15; bf16* row = MT + (size_t)(i * 16 + c) * 1152;
        v4u a = {0u, 0u, 0u, 0u}, b = {0u, 0u, 0u, 0u};
        if (lane <= i) { const LAS v4u* src = (const LAS v4u*)(ktab + ((i - lane) * 16 + c) * 16); a = src[0]; b = src[1]; }
        *(v4u*)(row + lane * 16) = a; *(v4u*)(row + lane * 16 + 8) = b;
        { const int p = lane; const float xr = crs[c * 64 + p], xi = cis[c * 64 + p], wr_ = pwr[(i + 1) * 64 + p], wi_ = pwi[(i + 1) * 64 + p];
          row[1024 + p] = (bf16)f2bf(xr * wr_ - xi * wi_); row[1088 + p] = (bf16)f2bf(-(xr * wi_ + xi * wr_)); } }
    bf16* PT = (bf16*)(F.ws + WS_S5_PT) + (size_t)g * 256 * 1024;
#pragma unroll 1
    for (int rr = wave; rr < 32; rr += 8) { const int n = part * 32 + rr; bf16* row = PT + (size_t)n * 1024 + lane * 16;
        unsigned o[8];
        if (n < 128) { const int p = n & 63, im = n >> 6; const float wr_ = pwr[(63 - lane) * 64 + p], wi_ = pwi[(63 - lane) * 64 + p];
#pragma unroll
            for (int q = 0; q < 8; ++q) { const float y0r = bbr[p * 16 + 2 * q], y0i = bbi[p * 16 + 2 * q], y1r = bbr[p * 16 + 2 * q + 1], y1i = bbi[p * 16 + 2 * q + 1];
                const float v0 = im ? (wr_ * y0i + wi_ * y0r) : (wr_ * y0r - wi_ * y0i), v1 = im ? (wr_ * y1i + wi_ * y1r) : (wr_ * y1r - wi_ * y1i); o[q] = pk2(v0, v1); }
        } else {
#pragma unroll
            for (int q = 0; q < 8; ++q) o[q] = 0u; }
        *(v4u*)row = (v4u){o[0], o[1], o[2], o[3]}; *(v4u*)(row + 8) = (v4u){o[4], o[5], o[6], o[7]}; }
    __syncthreads();
}
__device__ __forceinline__ void s5_repack(Frame& F) {
    const bf16* PROJ = (const bf16*)(F.ws + WS_PROJ); bf16* AX = (bf16*)(F.ws + WS_S5_AX);
    const int gt = F.bid * 512 + F.tid, NT = F.G * 512;
    for (int e = gt; e < NTOK * 32; e += NT) { const int m = e >> 5, g = e & 31; const int b = m / SEQ, t = m % SEQ, n = t >> 6, s = t & 63;
        const v4u* src = (const v4u*)(PROJ + (size_t)m * ODD_INP + O_U + g * 16); v4u* dst = (v4u*)(AX + ((size_t)g * 512 + b * 256 + n) * 1152 + s * 16);
        const v4u x0 = src[0], x1 = src[1]; dst[0] = x0; dst[1] = x1; }
}
struct S5POrder {
    int G, c;
    __device__ bool next(int i, pg8::Unit& u) const { const int L = i * G + c; if (L >= 64) return false; u.aux = L >> 1; u.pm = L & 1; u.pn = 0; return true; }
    __device__ __forceinline__ const char* a_base(const pg8::Gemm& g, const pg8::Unit& u) const { return (const char*)g.A + ((size_t)u.aux * 512 + u.pm * 256) * 1152 * 2; }
    __device__ __forceinline__ const char* b_base(const pg8::Gemm& g, const pg8::Unit& u) const { return (const char*)g.Bt + (size_t)u.aux * 256 * 1024 * 2; }
};
struct S5PEpi {
    static constexpr bool PERM = false;
    float* X;
    __device__ __forceinline__ void operator()(const pg8::f32x4 (&acc)[2][2][4][2], const pg8::Unit& u, int wr, int wc, int fr, int fq) const {
        const int row0 = u.pm * 256 + wr * 64 + fr; const int col0 = wc * 32 + 4 * fq;
#pragma unroll
        for (int ai = 0; ai < 2; ++ai)
#pragma unroll
            for (int m = 0; m < 4; ++m) { float* rowp = X + ((size_t)u.aux * 512 + row0 + ai * 128 + m * 16) * 128 + col0;
#pragma unroll
                for (int n = 0; n < 2; ++n) *(pg8::f32x4*)(rowp + n * 16) = acc[ai][0][m][n]; }
    }
};
__device__ __forceinline__ void s5_scan(Frame& F, int j) {
    const int gw = F.bid * NWAVES + F.wave; if (gw >= 64) return;
    const int g = gw >> 1, b = gw & 1, p = F.lane;
    const float lr = fminf(kin(I_S5_ARE)[(size_t)(j * 32 + g) * 64 + p], -1e-4f), li = kin(I_S5_AIM)[(size_t)(j * 32 + g) * 64 + p]; const float dt = expf(kin(I_S5_LS)[j * 32 + g]);
    const float mag = expf(lr * dt * 64.f); float sn, cs; sincosf(li * dt * 64.f, &sn, &cs); const float ar = mag * cs, ai = mag * sn;
    const float* X = (const float*)(F.ws + WS_S5_XLOC) + ((size_t)g * 512 + b * 256) * 128; bf16* AX = (bf16*)(F.ws + WS_S5_AX) + ((size_t)g * 512 + b * 256) * 1152 + 1024;
    float xr = 0.f, xi = 0.f; float cr[8], ci[8], nr[8], ni[8];
#pragma unroll
    for (int q = 0; q < 8; ++q) { cr[q] = X[(size_t)q * 128 + p]; ci[q] = X[(size_t)q * 128 + 64 + p]; }
    for (int n0 = 0; n0 < 256; n0 += 8) { const int nn = (n0 + 8 < 256) ? n0 + 8 : n0;
#pragma unroll
        for (int q = 0; q < 8; ++q) { nr[q] = X[(size_t)(nn + q) * 128 + p]; ni[q] = X[(size_t)(nn + q) * 128 + 64 + p]; }
#pragma unroll
        for (int q = 0; q < 8; ++q) { AX[(size_t)(n0 + q) * 1152 + p] = (bf16)f2bf(xr); AX[(size_t)(n0 + q) * 1152 + 64 + p] = (bf16)f2bf(xi);
            const float tr = ar * xr - ai * xi + cr[q], ti = ar * xi + ai * xr + ci[q]; xr = tr; xi = ti; }
#pragma unroll
        for (int q = 0; q < 8; ++q) { cr[q] = nr[q]; ci[q] = ni[q]; } }
}
struct S5MOrder {
    int G, c;
    __device__ bool next(int i, pg8::Unit& u) const { const int L = i * G + c; if (L >= 256) return false; u.aux = L >> 3; u.pm = (L >> 2) & 1; u.pn = L & 3; return true; }
    __device__ __forceinline__ const char* a_base(const pg8::Gemm& g, const pg8::Unit& u) const { return (const char*)g.A + ((size_t)u.aux * 512 + u.pm * 256) * 1152 * 2; }
    __device__ __forceinline__ const char* b_base(const pg8::Gemm& g, const pg8::Unit& u) const { return (const char*)g.Bt + ((size_t)u.aux * 1024 + u.pn * 256) * 1152 * 2; }
};
struct S5MEpi {
    static constexpr bool PERM = true;
    bf16* HG; const bf16* PROJ; const float* dsk;
    __device__ __forceinline__ void operator()(const pg8::f32x4 (&acc)[2][2][4][2], const pg8::Unit& u, int wr, int wc, int fr, int fq) const {
        const int g = u.aux; const int row0 = u.pm * 256 + wr * 64 + fr; const int col0 = u.pn * 256 + wc * 32 + 8 * fq;
        const pg8::f32x4 d0 = *(const pg8::f32x4*)(dsk + g * 16 + (col0 & 15)), d1 = *(const pg8::f32x4*)(dsk + g * 16 + (col0 & 15) + 4);
#pragma unroll
        for (int ai = 0; ai < 2; ++ai)
#pragma unroll
            for (int m = 0; m < 4; ++m) { const int rg = row0 + ai * 128 + m * 16; const int b = rg >> 8, n = rg & 255;
#pragma unroll
                for (int bj = 0; bj < 2; ++bj) { const int col = col0 + bj * 128; const int i = col >> 4, c0 = col & 15; const size_t tok = (size_t)b * SEQ + n * 64 + i;
                    const pg8::u32x4 uw = *(const pg8::u32x4*)(PROJ + tok * ODD_INP + O_U + g * 16 + c0); const pg8::f32x4 v0 = acc[ai][bj][m][0], v1 = acc[ai][bj][m][1];
                    pg8::u32x4 w; w.x = pk2(gelu_tanh(v0[0] + d0[0] * bflo(uw.x)), gelu_tanh(v0[1] + d0[1] * bfhi(uw.x))); w.y = pk2(gelu_tanh(v0[2] + d0[2] * bflo(uw.y)), gelu_tanh(v0[3] + d0[3] * bfhi(uw.y)));
                    w.z = pk2(gelu_tanh(v1[0] + d1[0] * bflo(uw.z)), gelu_tanh(v1[1] + d1[1] * bfhi(uw.z))); w.w = pk2(gelu_tanh(v1[2] + d1[2] * bflo(uw.w)), gelu_tanh(v1[3] + d1[3] * bfhi(uw.w)));
                    *(pg8::u32x4*)(HG + tok * 512 + g * 16 + c0) = w; } }
    }
};
namespace gdn {
typedef short s16x4 __attribute__((ext_vector_type(4)));
#define GDN_MFMA(a, b, c) __builtin_amdgcn_mfma_f32_16x16x16bf16_1k(a, b, c, 0, 0, 0)
__device__ __forceinline__ float fsig(float x) { return __builtin_amdgcn_rcpf(1.0f + __expf(-x)); }
__device__ __forceinline__ float bperm(float v, int src_lane) { return __int_as_float(__builtin_amdgcn_ds_bpermute(src_lane << 2, __float_as_int(v))); }
__device__ __forceinline__ s16x4 pack4(float a, float b, float c, float d) { v2u w; w.x = pk2(a, b); w.y = pk2(c, d); return __builtin_bit_cast(s16x4, w); }
constexpr int NITEM = BATCH * 4 * (SEQ / 16);
constexpr int IMG_STRIDE = 144;
constexpr int WAVE_LDS = 1024 + 1024 + 3 * 16 * IMG_STRIDE * 2;
}
constexpr size_t WS_GDN_UB = WS_QG;
constexpr size_t WS_GDN_WT = WS_KG;
constexpr size_t WS_GDN_QD = WS_KG + 32 * MiB;
constexpr size_t WS_GDN_KD = WS_VG;
constexpr size_t WS_GDN_IT = WS_VG + 32 * MiB;
constexpr size_t WS_GDN_EGL = WS_VG + 40 * MiB;

__device__ __forceinline__ void phase_gdn_g1(Frame& F, int j) {
    using namespace gdn;
    const bf16* PROJ = (const bf16*)(F.ws + WS_PROJ);
    const float* cw = kin(I_GDN_CONV) + (size_t)j * 4 * 1536;
    float* UB = (float*)(F.ws + WS_GDN_UB); bf16* WT = (bf16*)(F.ws + WS_GDN_WT); bf16* QD = (bf16*)(F.ws + WS_GDN_QD); bf16* KD = (bf16*)(F.ws + WS_GDN_KD); bf16* IT = (bf16*)(F.ws + WS_GDN_IT); float* EGL = (float*)(F.ws + WS_GDN_EGL);
    LAS float* Am = (LAS float*)(F.lds + RING_OFF + F.wave * WAVE_LDS); LAS float* Tm = Am + 256; LAS bf16* img = (LAS bf16*)(Tm + 256);
    const int gw = F.bid * NWAVES + F.wave, NGW = F.G * NWAVES;
#pragma unroll 1
    for (int item = gw; item < NITEM; item += NGW) {
        int lane = F.lane; asm volatile("" : "+v"(lane));
        const int tok = lane & 15, g4 = lane >> 4;
        const int b = item >> 12, h = (item >> 10) & 3, n = item & 1023; const int s0 = 16 * n + tok; const size_t m = (size_t)b * SEQ + s0;
        const size_t it = (size_t)item;
        const float gin = bf2f(PROJ[m * ODD_INP + O_GIN + h]), bin = bf2f(PROJ[m * ODD_INP + O_BETA + h]);
        const float gt = -expf(kin(I_GDN_ALOG)[j * 4 + h]) * softplusf_(gin + kin(I_GDN_DTB)[j * 4 + h]); const float beta = fsig(bin);
        float gc = gt;
#pragma unroll
        for (int off = 1; off < 16; off <<= 1) { const float t = bperm(gc, tok >= off ? lane - off : lane); if (tok >= off) gc += t; }
        const float glast = bperm(gc, lane | 15); const float eg = expf(gc), ekd = expf(glast - gc);
        LAS bf16* img2 = img + 16 * IMG_STRIDE; LAS bf16* img3 = img2 + 16 * IMG_STRIDE;
#define GDN_CONV(WSEL, X) do { _Pragma("unroll") for (int db = 0; db < 8; ++db) { const int ch = (WSEL) * 512 + h * 128 + 16 * db + 4 * g4; float a0 = 0.f, a1 = 0.f, a2 = 0.f, a3 = 0.f; \
            _Pragma("unroll") for (int tap = 0; tap < 4; ++tap) { if (s0 - 3 + tap >= 0) { const v2u x = *(const v2u*)(PROJ + (m - 3 + tap) * ODD_INP + O_Q + ch); const f32x4 wv = *(const f32x4*)(cw + tap * 1536 + ch); \
                a0 += wv.x * bflo(x.x); a1 += wv.y * bfhi(x.x); a2 += wv.z * bflo(x.y); a3 += wv.w * bfhi(x.y); } } \
            X[db][0] = a0 * fsig(a0); X[db][1] = a1 * fsig(a1); X[db][2] = a2 * fsig(a2); X[db][3] = a3 * fsig(a3); \
            if ((db & 3) == 3) asm volatile("" ::: "memory"); } } while (0)
        { float xv[8][4]; GDN_CONV(2, xv);
#pragma unroll
          for (int db = 0; db < 8; ++db) *(LAS s16x4*)(img + tok * IMG_STRIDE + 16 * db + 4 * g4) = pack4(xv[db][0] * beta, xv[db][1] * beta, xv[db][2] * beta, xv[db][3] * beta); }
        s16x4 Kf[8];
        { float xk[8][4]; GDN_CONV(1, xk); float sk = 0.f;
#pragma unroll
          for (int db = 0; db < 8; ++db)
#pragma unroll
              for (int e = 0; e < 4; ++e) sk += xk[db][e] * xk[db][e];
          sk += bperm(sk, lane ^ 16); sk += bperm(sk, lane ^ 32);
          const float rk = 1.0f / sqrtf(sk + RMS_EPS); const float s2 = rk * beta * eg, s3 = rk * ekd;
#pragma unroll
          for (int db = 0; db < 8; ++db) { const int o = tok * IMG_STRIDE + 16 * db + 4 * g4;
              *(LAS s16x4*)(img2 + o) = pack4(xk[db][0] * s2, xk[db][1] * s2, xk[db][2] * s2, xk[db][3] * s2);
              *(LAS s16x4*)(img3 + o) = pack4(xk[db][0] * s3, xk[db][1] * s3, xk[db][2] * s3, xk[db][3] * s3);
              Kf[db] = pack4(xk[db][0] * rk, xk[db][1] * rk, xk[db][2] * rk, xk[db][3] * rk); } }
        f32x4 Gacc = {0.f, 0.f, 0.f, 0.f}, Pacc = {0.f, 0.f, 0.f, 0.f};
        { float xqq[8][4]; GDN_CONV(0, xqq); float sq = 0.f;
#pragma unroll
          for (int db = 0; db < 8; ++db)
#pragma unroll
              for (int e = 0; e < 4; ++e) sq += xqq[db][e] * xqq[db][e];
          sq += bperm(sq, lane ^ 16); sq += bperm(sq, lane ^ 32);
          const float rq = (1.0f / sqrtf(sq + RMS_EPS)) * 0.08838834764831845f;
#pragma unroll
          for (int db = 0; db < 8; ++db) {
              *(s16x4*)(QD + ((it * 8 + db) * 64 + lane) * 4) = pack4(xqq[db][0] * rq * eg, xqq[db][1] * rq * eg, xqq[db][2] * rq * eg, xqq[db][3] * rq * eg);
              const s16x4 Qf = pack4(xqq[db][0] * rq, xqq[db][1] * rq, xqq[db][2] * rq, xqq[db][3] * rq);
              Gacc = GDN_MFMA(Kf[db], Kf[db], Gacc); Pacc = GDN_MFMA(Kf[db], Qf, Pacc); } }
#undef GDN_CONV
        { float itv[4];
#pragma unroll
          for (int r = 0; r < 4; ++r) { const int i = 4 * g4 + r; const float gci = bperm(gc, i), bi = bperm(beta, i);
              const float da = (tok < i) ? expf(gci - gc) : 0.f;
              Am[i * 16 + tok] = bi * Gacc[r] * da;
              const float dp = (i <= tok) ? expf(gc - gci) : 0.f;
              itv[r] = Pacc[r] * dp; }
          *(s16x4*)(IT + (it * 64 + lane) * 4) = pack4(itv[0], itv[1], itv[2], itv[3]); }
        if (lane == 0) EGL[it] = expf(glast);
        LDS_WAIT();
        float Tc[16];
#pragma unroll
        for (int i = 0; i < 16; ++i) { float s = (i == tok) ? 1.f : 0.f;
#pragma unroll
            for (int jj = 0; jj < i; ++jj) s -= Am[i * 16 + jj] * Tc[jj];
            Tc[i] = s; }
#pragma unroll
        for (int r = 0; r < 4; ++r) Tm[(4 * g4 + r) * 16 + tok] = (g4 == 0) ? Tc[r] : (g4 == 1) ? Tc[4 + r] : (g4 == 2) ? Tc[8 + r] : Tc[12 + r];
        LDS_WAIT();
        const f32x4 trow = *(const LAS f32x4*)(Tm + tok * 16 + 4 * g4);
        const s16x4 Tf = pack4(trow.x, trow.y, trow.z, trow.w);
        const int traddr = (int)(uintptr_t)img + ((4 * g4 + ((lane & 15) >> 2)) * IMG_STRIDE + 4 * (lane & 3)) * 2;
#pragma unroll
        for (int cb = 0; cb < 8; ++cb) { s16x4 vf; asm volatile("ds_read_b64_tr_b16 %0, %1 offset:%c2\n\ts_waitcnt lgkmcnt(0)" : "=&v"(vf) : "v"(traddr), "i"(cb * 32) : "memory");
            const f32x4 z = {0.f, 0.f, 0.f, 0.f}; const f32x4 u = GDN_MFMA(Tf, vf, z);
            *(f32x4*)(UB + ((it * 8 + cb) * 64 + lane) * 4) = u; }
#pragma unroll
        for (int db = 0; db < 8; ++db) { s16x4 kf; asm volatile("ds_read_b64_tr_b16 %0, %1 offset:%c2\n\ts_waitcnt lgkmcnt(0)" : "=&v"(kf) : "v"(traddr), "i"(16 * IMG_STRIDE * 2 + db * 32) : "memory");
            const f32x4 z = {0.f, 0.f, 0.f, 0.f}; const f32x4 w = GDN_MFMA(kf, Tf, z);
            *(s16x4*)(WT + ((it * 8 + db) * 64 + lane) * 4) = pack4(-w.x, -w.y, -w.z, -w.w); }
#pragma unroll
        for (int db = 0; db < 8; ++db) { s16x4 kf; asm volatile("ds_read_b64_tr_b16 %0, %1 offset:%c2\n\ts_waitcnt lgkmcnt(0)" : "=&v"(kf) : "v"(traddr), "i"(32 * IMG_STRIDE * 2 + db * 32) : "memory");
            *(s16x4*)(KD + ((it * 8 + db) * 64 + lane) * 4) = kf; }
        LDS_WAIT();
    }
}

__device__ __forceinline__ void phase_gdn_g2(Frame& F) {
    using namespace gdn;
    if (F.bid >= 64 || F.wave != 0) return;
    const float* UB = (const float*)(F.ws + WS_GDN_UB); const bf16* WT = (const bf16*)(F.ws + WS_GDN_WT); const bf16* QD = (const bf16*)(F.ws + WS_GDN_QD); const bf16* KD = (const bf16*)(F.ws + WS_GDN_KD);
    const bf16* IT = (const bf16*)(F.ws + WS_GDN_IT); const float* EGL = (const float*)(F.ws + WS_GDN_EGL); float* OG = (float*)(F.ws + WS_OG);
    const int lane = F.lane, bh = F.bid & 7, sl = F.bid >> 3, b = bh >> 2, h = bh & 3;
    f32x4 S[8];
#pragma unroll
    for (int db = 0; db < 8; ++db) S[db] = (f32x4){0.f, 0.f, 0.f, 0.f};
    const size_t it0 = (size_t)bh * 1024;
    f32x4 u_c, u_n; s16x4 wt_c[8], wt_n[8], qd_c[8], qd_n[8], kd_c[8], kd_n[8], it_c, it_n; float egl_c, egl_n;
#define GDN_LOAD(itx, U_, WT_, QD_, KD_, IT_, EG_) do { const size_t i_ = (itx); U_ = *(const f32x4*)(UB + ((i_ * 8 + sl) * 64 + lane) * 4); IT_ = *(const s16x4*)(IT + (i_ * 64 + lane) * 4); EG_ = EGL[i_]; \
        _Pragma("unroll") for (int db = 0; db < 8; ++db) { WT_[db] = *(const s16x4*)(WT + ((i_ * 8 + db) * 64 + lane) * 4); QD_[db] = *(const s16x4*)(QD + ((i_ * 8 + db) * 64 + lane) * 4); KD_[db] = *(const s16x4*)(KD + ((i_ * 8 + db) * 64 + lane) * 4); } } while (0)
    GDN_LOAD(it0, u_c, wt_c, qd_c, kd_c, it_c, egl_c);
#pragma unroll 1
    for (int n = 0; n < 1024; ++n) {
        const int nn = (n + 1 < 1024) ? n + 1 : n;
        GDN_LOAD(it0 + nn, u_n, wt_n, qd_n, kd_n, it_n, egl_n);
        s16x4 Sb[8];
#pragma unroll
        for (int db = 0; db < 8; ++db) Sb[db] = pack4(S[db].x, S[db].y, S[db].z, S[db].w);
        f32x4 va = u_c, vb2 = {0.f, 0.f, 0.f, 0.f};
#pragma unroll
        for (int db = 0; db < 8; db += 2) { va = GDN_MFMA(wt_c[db], Sb[db], va); vb2 = GDN_MFMA(wt_c[db + 1], Sb[db + 1], vb2); }
        va = va + vb2;
        const s16x4 vb = pack4(va.x, va.y, va.z, va.w);
        f32x4 oa = {0.f, 0.f, 0.f, 0.f}, ob = {0.f, 0.f, 0.f, 0.f};
        oa = GDN_MFMA(it_c, vb, oa);
#pragma unroll
        for (int db = 0; db < 8; db += 2) { oa = GDN_MFMA(qd_c[db], Sb[db], oa); ob = GDN_MFMA(qd_c[db + 1], Sb[db + 1], ob); }
        oa = oa + ob;
#pragma unroll
        for (int db = 0; db < 8; ++db) { const f32x4 sc = S[db] * egl_c; S[db] = GDN_MFMA(kd_c[db], vb, sc); }
        { float* op = OG + ((size_t)b * SEQ + 16 * n + 4 * (lane >> 4)) * 512 + h * 128 + 16 * sl + (lane & 15);
          op[0] = oa.x; op[512] = oa.y; op[1024] = oa.z; op[1536] = oa.w; }
        u_c = u_n; it_c = it_n; egl_c = egl_n;
#pragma unroll
        for (int db = 0; db < 8; ++db) { wt_c[db] = wt_n[db]; qd_c[db] = qd_n[db]; kd_c[db] = kd_n[db]; }
    }
#undef GDN_LOAD
}
constexpr int LSTEPS = 16;
constexpr int STEP_END = 1 + DEPTH * LSTEPS;
struct KArgs { Args a; int li, pad; };

#define FRAME Frame F; { int wv_ = wave0; asm volatile("" : "+s"(wv_)); int t_ = wv_ * 64 + (int)__builtin_amdgcn_mbcnt_hi(~0u, __builtin_amdgcn_mbcnt_lo(~0u, 0u)); asm volatile("" : "+v"(t_)); unsigned char* w_ = kws(); F.lds = lds0; F.ws = w_; F.ctl = (unsigned*)(w_ + WS_CTL); \
        F.tid = t_; F.lane = t_ & 63; F.wave = __builtin_amdgcn_readfirstlane(t_ >> 6); { int g_ = gridDim.x, b_ = blockIdx.x; asm volatile("" : "+s"(g_), "+s"(b_)); F.G = g_; F.bid = b_; } } unsigned char* const ws = F.ws; (void)ws
#ifndef PH_MASK
#define PH_MASK 0xffffffffu
#endif
#define EN(k) (((PH_MASK) >> (k)) & 1u)
#define STEP(s) if (lo <= (s) && (s) < hi)
#define ENDSTEP(s) do { if ((s) + 1 < hi) xcd_barrier(bar); } while (0)
#define LAUNDER_WS do {} while (0)


template <int layer> __device__ __forceinline__ void layer_body(const XcdBarrier& bar, const int lo, const int hi, LAS unsigned char* const lds0, const int wave0) {
        constexpr int sb = 1 + layer * LSTEPS, j = layer >> 1; constexpr bool even = (layer & 1) == 0;
        STEP(sb + 0) if constexpr (EN(0)) { FRAME;
            phase_norm(F, layer == 0 ? kin(I_X) : kout(), kin(I_NORM_MIX) + layer * DM, layer == 0 ? kout() : nullptr);
            moe_weights(F, layer); phase_pconv(F, layer);
            if constexpr (!even) { __syncthreads(); s5_build(F, j); }
            ENDSTEP(sb + 0);
        }
        STEP(sb + 1) if constexpr (EN(1)) { FRAME;
            { LAUNDER_WS; const int NP = even ? EVEN_INP : ODD_INP; const bf16* W = even ? (const bf16*)(ws + WS_W_EVIN) + (size_t)j * EVEN_INP * 1024 : (const bf16*)(ws + WS_W_ODIN) + (size_t)j * ODD_INP * 1024;
              pg8::Gemm g{(const bf16*)(ws + WS_ABF), W, 1024, 1024, 1024}; pg8::StaticOrder S; S.init(NTOK, NP, F.G, F.bid); pg8::EpiBf16 E{(bf16*)(ws + WS_PROJ), NP};
              pg8::gemm_phase<pg8::EpiBf16, pg8::StaticOrder>(F.lds + RING_OFF, g, S, E, F.tid); }
            { LAUNDER_WS; pg8::Gemm g{(const bf16*)(ws + WS_PBF), (const bf16*)(ws + WS_W_PLEP) + (size_t)layer * 1024 * 256, 256, 256, 256}; pg8::StaticOrder S; S.init(NTOK, 1024, F.G, F.bid); pg8::EpiBf16 E{(bf16*)(ws + WS_PP), 1024};
              pg8::gemm_phase<pg8::EpiBf16, pg8::StaticOrder>(F.lds + RING_OFF, g, S, E, F.tid); }
            ENDSTEP(sb + 1);
        }
        if constexpr (even) {
            STEP(sb + 2) if constexpr (EN(2)) { FRAME; phase_even_post(F, j); ENDSTEP(sb + 2); }
            STEP(sb + 3) if constexpr (EN(3)) { FRAME;
#ifndef NO_QUP
                { LAUNDER_WS; pg8::Gemm g{(const bf16*)(ws + WS_CQN), (const bf16*)(ws + WS_W_QUP) + (size_t)j * 768 * 384, 384, 384, 384}; pg8::StaticOrder S; S.init(NTOK, 768, F.G, F.bid); pg8::EpiBf16 E{(bf16*)(ws + WS_QM), 768};
                  pg8::gemm_phase<pg8::EpiBf16, pg8::StaticOrder>(F.lds + RING_OFF, g, S, E, F.tid); }
#endif
#ifndef NO_KVUP
                { LAUNDER_WS; pg8::Gemm g{(const bf16*)(ws + WS_CKVN), (const bf16*)(ws + WS_W_KVUP) + (size_t)j * 1024 * 256, 256, 256, 256}; pg8::StaticOrder S; S.init(NTOK, 1024, F.G, F.bid); pg8::EpiBf16 E{(bf16*)(ws + WS_KVB), 1024};
                  pg8::gemm_phase<pg8::EpiBf16, pg8::StaticOrder>(F.lds + RING_OFF, g, S, E, F.tid); }
#endif
#ifndef NO_CUMSUM
                phase_cumsum(F);
#endif
                ENDSTEP(sb + 3);
            }
            STEP(sb + 4) if constexpr (EN(4)) { FRAME; phase_mla_post(F, j); ENDSTEP(sb + 4); }
            STEP(sb + 5) if constexpr (EN(5)) { FRAME;
#ifdef ATTN_NAIVE
                phase_attn_naive(F);
#else
                phase_attn_mfma(F);
#ifdef DUP_ATTN
                phase_attn_mfma(F);
#endif
#endif
                ENDSTEP(sb + 5); }
        } else {
            STEP(sb + 2) if constexpr (EN(2)) { FRAME; s5_repack(F);
#ifdef GDN_NAIVE
                phase_gdn_prep(F, j);
#else
                phase_gdn_g1(F, j);
#endif
                ENDSTEP(sb + 2); }
            STEP(sb + 3) if constexpr (EN(3)) { FRAME;
                { pg8::Gemm g{(const bf16*)(ws + WS_S5_AX), (const bf16*)(ws + WS_S5_PT), 1024, 1152, 1024}; S5POrder S{F.G, F.bid}; S5PEpi E{(float*)(ws + WS_S5_XLOC)};
                  pg8::gemm_phase<S5PEpi, S5POrder>(F.lds + RING_OFF, g, S, E, F.tid); }
#ifdef GDN_NAIVE
                phase_gdn_naive(F);
#else
                phase_gdn_g2(F);
#endif
                ENDSTEP(sb + 3);
            }
            STEP(sb + 4) if constexpr (EN(4)) { FRAME; s5_scan(F, j); phase_gdn_out(F, j); ENDSTEP(sb + 4); }
            STEP(sb + 5) if constexpr (EN(5)) { FRAME;
                pg8::Gemm g{(const bf16*)(ws + WS_S5_AX), (const bf16*)(ws + WS_S5_MT), 1152, 1152, 1152}; S5MOrder S{F.G, F.bid}; S5MEpi E{(bf16*)(ws + WS_HG), (const bf16*)(ws + WS_PROJ), kin(I_S5_D) + j * 512};
                pg8::gemm_phase<S5MEpi, S5MOrder>(F.lds + RING_OFF, g, S, E, F.tid);
                ENDSTEP(sb + 5);
            }
            STEP(sb + 6) if constexpr (EN(6)) { FRAME;
                pg8::Gemm g{(const bf16*)(ws + WS_HG), (const bf16*)(ws + WS_W_GLU) + (size_t)j * 512 * 512, 512, 512, 512}; pg8::StaticOrder S; S.init(NTOK, 512, F.G, F.bid);
                pg8::EpiGlu E{(bf16*)(ws + WS_MIX), 1024, (const bf16*)(ws + WS_HG), 512, kin(I_S5_BGLU) + j * 512};
                pg8::gemm_phase<pg8::EpiGlu, pg8::StaticOrder>(F.lds + RING_OFF, g, S, E, F.tid);
                ENDSTEP(sb + 6);
            }
        }
        STEP(sb + 7) if constexpr (EN(7)) { FRAME;
            LAUNDER_WS; const bf16* W = even ? (const bf16*)(ws + WS_W_EVOUT) + (size_t)j * 1024 * 1024 : (const bf16*)(ws + WS_W_ODOUT) + (size_t)j * 1024 * 1024;
            pg8::Gemm g{(const bf16*)(ws + WS_MIX), W, 1024, 1024, 1024}; pg8::StaticOrder S; S.init(NTOK, 1024, F.G, F.bid); pg8::EpiResAdd E{kout(), 1024};
            pg8::gemm_phase<pg8::EpiResAdd, pg8::StaticOrder>(F.lds + RING_OFF, g, S, E, F.tid);
            ENDSTEP(sb + 7);
        }
        STEP(sb + 8) if constexpr (EN(8)) { FRAME; phase_router(F, layer); ENDSTEP(sb + 8); }
        STEP(sb + 9) if constexpr (EN(9)) { FRAME; phase_moe_scatter(F, layer); ENDSTEP(sb + 9); }
        STEP(sb + 10) if constexpr (EN(10)) { FRAME;
            LAUNDER_WS; moe_tables(F, layer);
            const LAS int* rowbase = (const LAS int*)(F.lds + LDSCTL_OFF + LC_MOE);
            MoeOrder S{__builtin_amdgcn_readfirstlane(rowbase[34]), 4, F.G, F.bid, (const LAS unsigned char*)(F.lds + LDSCTL_OFF + LC_MOE + 192), (size_t)1024 * 1024 * 2};
            pg8::Gemm g{(const bf16*)(ws + WS_XG), (const bf16*)(ws + WS_W_MOEGU), 1024, 1024, 1024}; pg8::EpiSwiglu E{(bf16*)(ws + WS_HB), 512};
            pg8::gemm_phase<pg8::EpiSwiglu, MoeOrder>(F.lds + RING_OFF, g, S, E, F.tid);
            ENDSTEP(sb + 10);
        }
        STEP(sb + 11) if constexpr (EN(11)) { FRAME;
            LAUNDER_WS; moe_tables(F, layer);
            const LAS int* rowbase = (const LAS int*)(F.lds + LDSCTL_OFF + LC_MOE);
            MoeOrder S{__builtin_amdgcn_readfirstlane(rowbase[34]), 4, F.G, F.bid, (const LAS unsigned char*)(F.lds + LDSCTL_OFF + LC_MOE + 192), (size_t)1024 * 512 * 2};
            pg8::Gemm g{(const bf16*)(ws + WS_HB), (const bf16*)(ws + WS_W_MOED), 512, 512, 512}; pg8::EpiBf16 E{(bf16*)(ws + WS_Y2), 1024};
            pg8::gemm_phase<pg8::EpiBf16, MoeOrder>(F.lds + RING_OFF, g, S, E, F.tid);
            ENDSTEP(sb + 11);
        }
        STEP(sb + 12) if constexpr (EN(12)) { FRAME; phase_moe_combine(F, layer); ENDSTEP(sb + 12); }
        STEP(sb + 13) if constexpr (EN(13)) { FRAME;
            LAUNDER_WS; pg8::Gemm g{(const bf16*)(ws + WS_ABF), (const bf16*)(ws + WS_W_PLEG) + (size_t)layer * 1024 * 1024, 1024, 1024, 1024}; pg8::StaticOrder S; S.init(NTOK, 1024, F.G, F.bid);
            pg8::EpiPle E{kout(), (const bf16*)(ws + WS_PP), kin(I_PLE_BG) + layer * DM, 1024};
            pg8::gemm_phase<pg8::EpiPle, pg8::StaticOrder>(F.lds + RING_OFF, g, S, E, F.tid);
            ENDSTEP(sb + 13);
        }
    }
__global__ void __launch_bounds__(NWAVES * 64, 2) mega_fwd(KArgs ka) {
    extern __shared__ __attribute__((aligned(16))) unsigned char lds_raw[];
    const Args& args = ka.a;
    LAS unsigned char* const lds0 = (LAS unsigned char*)lds_raw;
    const int wave0 = __builtin_amdgcn_readfirstlane((int)threadIdx.x >> 6);
    for (int u = threadIdx.x; u < (LDS_BYTES - LDSCTL_OFF) / 4; u += NWAVES * 64) ((LAS unsigned*)(lds0 + LDSCTL_OFF))[u] = 0u;
    __syncthreads();
    XcdBarrier bar = xcd_barrier_post((unsigned*)(kws() + WS_CTL) + CW_BAR + ka.li * XCD_BAR_WORDS, (volatile LAS unsigned*)(lds0 + LDSCTL_OFF + LC_BARST));
    const int lo = args.ph_lo, hi = args.ph_hi;
    STEP(0) if constexpr (EN(15)) { FRAME; prologue_weights(F); ENDSTEP(0); }
    layer_body<0>(bar, lo, hi, lds0, wave0); layer_body<1>(bar, lo, hi, lds0, wave0); layer_body<2>(bar, lo, hi, lds0, wave0); layer_body<3>(bar, lo, hi, lds0, wave0);
#undef STEP
#undef ENDSTEP
}

#ifndef MK_MODE
#define MK_MODE 0
#endif
extern "C" void kernel_launch(void* const* d_in, const int* in_sizes, int n_in, void* d_out, int out_size, void* d_ws, size_t ws_size, hipStream_t stream) {
    static int ready = 0;
    if (ready == 0) {
        if (n_in != N_IN || out_size != NTOK * DM || ws_size < WS_END) { fprintf(stderr, "kernel_launch: unexpected shapes n_in %d out %d ws %zu (need %zu)\n", n_in, out_size, ws_size, (size_t)WS_END); ready = -1; return; }
        if (hipFuncSetAttribute((const void*)mega_fwd, hipFuncAttributeMaxDynamicSharedMemorySize, LDS_BYTES) != hipSuccess) { fprintf(stderr, "kernel_launch: hipFuncSetAttribute failed\n"); ready = -1; return; }
        int per_cu = 0; (void)hipOccupancyMaxActiveBlocksPerMultiprocessor(&per_cu, (const void*)mega_fwd, NWAVES * 64, LDS_BYTES); (void)hipGetLastError();
        ready = 1;
    }
    if (ready < 0) return;
    (void)hipMemsetAsync((char*)d_ws + WS_CTL, 0, CTL_ZERO_BYTES, stream);
    KArgs ka{};
    for (int i = 0; i < N_IN; ++i) ka.a.in[i] = (const float*)d_in[i];
    ka.a.out = (float*)d_out; ka.a.ws = (unsigned char*)d_ws; ka.li = 0; ka.pad = 0;
    const int grid = 256;
#if MK_MODE == 1
    ka.a.ph_lo = 0; ka.a.ph_hi = STEP_END;
    hipLaunchKernelGGL(mega_fwd, dim3(grid), dim3(NWAVES * 64), LDS_BYTES, stream, ka);
#else
    for (int s = 0; s < STEP_END; ++s) {
        if (s > 0) { const int k = (s - 1) % LSTEPS, layer = (s - 1) / LSTEPS; const bool even = (layer & 1) == 0;
            if (k > 13) continue; if (k == 6 && even) continue; }
        ka.a.ph_lo = s; ka.a.ph_hi = s + 1;
        hipLaunchKernelGGL(mega_fwd, dim3(grid), dim3(NWAVES * 64), LDS_BYTES, stream, ka);
    }
#endif
}
```

```cpp
#include <hip/hip_runtime.h>
#include <cstdio>
#include <cstdint>
#define MK_MODE 1
namespace pg8 {
#define PG8_LAS __attribute__((address_space(3)))
typedef unsigned short bf16_t;
typedef short bf16x8 __attribute__((ext_vector_type(8)));
typedef float f32x4 __attribute__((ext_vector_type(4)));
typedef float f32x2 __attribute__((ext_vector_type(2)));
typedef unsigned u32x4 __attribute__((ext_vector_type(4)));
typedef unsigned u32x2 __attribute__((ext_vector_type(2)));
constexpr int BM = 256, BK = 64, HALF = 128, HTB = HALF * BK * 2  , STAGE_BYTES = 8 * HTB, NXCD = 8, WGM = 8;

__host__ __device__ __forceinline__ int lds_byte(int r, int c) { const int st = (r >> 4) * 2 + (c >> 5), rr = r & 15, cc = c & 31, ob = rr * 64 + cc * 2; return st * 1024 + (ob ^ (((ob >> 9) & 1) << 5)); }
__host__ __device__ __forceinline__ void stage_rc(int b, int& R, int& C) { const int st = b / 1024, sb = b % 1024, swz = sb ^ (((sb >> 9) & 1) << 5); R = (st >> 1) * 16 + swz / 64; C = (st & 1) * 32 + (swz % 64) / 2; }
__host__ __device__ __forceinline__ int perm32(int rho) { const int n = rho >> 4, i = rho & 15; return 8 * (i >> 2) + 4 * n + (i & 3); }

struct Unit { int pm, pn, aux; };
struct Gemm { const bf16_t* A; const bf16_t* Bt; int K, lda, ldb; };

struct StaticOrder {
    int nM, nN, nwg, G, c;
    __device__ void init(int M, int N, int G_, int c_) { nM = M / BM; nN = N / BM; nwg = nM * nN; G = G_; c = c_; }
    __device__ bool next(int i, Unit& u) const {
        const long L = (long)i * G + c; if (L >= nwg) return false;
        int wgid = (int)L; { const int q = nwg / NXCD, r = nwg % NXCD, xcd = wgid % NXCD, off = wgid / NXCD; wgid = (xcd < r ? xcd * (q + 1) : r * (q + 1) + (xcd - r) * q) + off; }
        const int nig = WGM * nN, gid = wgid / nig, fm = gid * WGM, gsz = (nM - fm) < WGM ? (nM - fm) : WGM;
        u.pm = fm + ((wgid % nig) % gsz); u.pn = (wgid % nig) / gsz; u.aux = 0; return true;
    }
    __device__ __forceinline__ const char* a_base(const Gemm& g, const Unit& u) const { return (const char*)g.A + (size_t)u.pm * BM * g.lda * 2; }
    __device__ __forceinline__ const char* b_base(const Gemm& g, const Unit& u) const { return (const char*)g.Bt + (size_t)u.pn * BM * g.ldb * 2; }
};

__device__ __forceinline__ unsigned cvt_pk_bf16(float lo, float hi) { unsigned r; asm volatile("v_cvt_pk_bf16_f32 %0, %1, %2" : "=v"(r) : "v"(lo), "v"(hi)); return r; }
__device__ __forceinline__ float bf_lo(unsigned w) { return __uint_as_float(w << 16); }
__device__ __forceinline__ float bf_hi(unsigned w) { return __uint_as_float(w & 0xffff0000u); }

struct EpiBf16 {
    static constexpr bool PERM = true;
    bf16_t* O; int ldc;
    __device__ __forceinline__ void operator()(const f32x4 (&acc)[2][2][4][2], const Unit& u, int wr, int wc, int fr, int fq) const {
        const int row0 = u.pm * BM + wr * 64 + fr; const int col0 = u.pn * BM + wc * 32 + 8 * fq;
#pragma unroll
        for (int ai = 0; ai < 2; ++ai)
#pragma unroll
            for (int m = 0; m < 4; ++m) { bf16_t* rowp = O + (size_t)(row0 + ai * HALF + m * 16) * ldc + col0;
#pragma unroll
                for (int bj = 0; bj < 2; ++bj) { const f32x4 v0 = acc[ai][bj][m][0], v1 = acc[ai][bj][m][1];
                    u32x4 w; w.x = cvt_pk_bf16(v0[0], v0[1]); w.y = cvt_pk_bf16(v0[2], v0[3]); w.z = cvt_pk_bf16(v1[0], v1[1]); w.w = cvt_pk_bf16(v1[2], v1[3]);
                    *(u32x4*)(rowp + bj * HALF) = w; } }
    }
};
struct EpiResAdd {
    static constexpr bool PERM = false;
    float* H; int ldc;
    __device__ __forceinline__ void operator()(const f32x4 (&acc)[2][2][4][2], const Unit& u, int wr, int wc, int fr, int fq) const {
        const int row0 = u.pm * BM + wr * 64 + fr; const int col0 = u.pn * BM + wc * 32 + 4 * fq;
#pragma unroll
        for (int ai = 0; ai < 2; ++ai)
#pragma unroll
            for (int m = 0; m < 4; ++m) { float* rowp = H + (size_t)(row0 + ai * HALF + m * 16) * ldc + col0;
#pragma unroll
                for (int bj = 0; bj < 2; ++bj)
#pragma unroll
                    for (int n = 0; n < 2; ++n) { f32x4* p = (f32x4*)(rowp + bj * HALF + n * 16); *p = *p + acc[ai][bj][m][n]; } }
    }
};
__device__ __forceinline__ float sigmoidf_(float x) { return 1.0f / (1.0f + __expf(-x)); }
struct EpiPle {
    static constexpr bool PERM = false;
    float* H; const bf16_t* PP; const float* bias; int ldc;
    __device__ __forceinline__ void operator()(const f32x4 (&acc)[2][2][4][2], const Unit& u, int wr, int wc, int fr, int fq) const {
        const int row0 = u.pm * BM + wr * 64 + fr; const int col0 = u.pn * BM + wc * 32 + 4 * fq;
#pragma unroll
        for (int ai = 0; ai < 2; ++ai)
#pragma unroll
            for (int m = 0; m < 4; ++m) { const size_t ro = (size_t)(row0 + ai * HALF + m * 16) * ldc + col0;
#pragma unroll
                for (int bj = 0; bj < 2; ++bj)
#pragma unroll
                    for (int n = 0; n < 2; ++n) { const int co = bj * HALF + n * 16; f32x4* p = (f32x4*)(H + ro + co); const u32x2 pw = *(const u32x2*)(PP + ro + co);
                        const f32x4 bv = *(const f32x4*)(bias + col0 + co); const f32x4 a = acc[ai][bj][m][n] + bv; f32x4 h = *p;
                        h[0] += sigmoidf_(a[0]) * bf_lo(pw.x); h[1] += sigmoidf_(a[1]) * bf_hi(pw.x); h[2] += sigmoidf_(a[2]) * bf_lo(pw.y); h[3] += sigmoidf_(a[3]) * bf_hi(pw.y); *p = h; } }
    }
};
struct EpiGlu {
    static constexpr bool PERM = true;
    bf16_t* O; int ldo; const bf16_t* HG; int ldh; const float* bias;
    __device__ __forceinline__ void operator()(const f32x4 (&acc)[2][2][4][2], const Unit& u, int wr, int wc, int fr, int fq) const {
        const int row0 = u.pm * BM + wr * 64 + fr; const int col0 = u.pn * BM + wc * 32 + 8 * fq;
#pragma unroll
        for (int ai = 0; ai < 2; ++ai)
#pragma unroll
            for (int m = 0; m < 4; ++m) { const size_t r = (size_t)(row0 + ai * HALF + m * 16);
#pragma unroll
                for (int bj = 0; bj < 2; ++bj) { const int c = col0 + bj * HALF; const u32x4 hw = *(const u32x4*)(HG + r * ldh + c);
                    const f32x4 b0 = *(const f32x4*)(bias + c), b1 = *(const f32x4*)(bias + c + 4); const f32x4 v0 = acc[ai][bj][m][0] + b0, v1 = acc[ai][bj][m][1] + b1;
                    u32x4 w; w.x = cvt_pk_bf16(bf_lo(hw.x) * sigmoidf_(v0[0]), bf_hi(hw.x) * sigmoidf_(v0[1])); w.y = cvt_pk_bf16(bf_lo(hw.y) * sigmoidf_(v0[2]), bf_hi(hw.y) * sigmoidf_(v0[3]));
                    w.z = cvt_pk_bf16(bf_lo(hw.z) * sigmoidf_(v1[0]), bf_hi(hw.z) * sigmoidf_(v1[1])); w.w = cvt_pk_bf16(bf_lo(hw.w) * sigmoidf_(v1[2]), bf_hi(hw.w) * sigmoidf_(v1[3]));
                    *(u32x4*)(O + r * ldo + c) = w; } }
    }
};
struct EpiSwiglu {
    static constexpr bool PERM = true;
    bf16_t* HB; int ldc;
    __device__ __forceinline__ void operator()(const f32x4 (&acc)[2][2][4][2], const Unit& u, int wr, int wc, int fr, int fq) const {
        const int row0 = u.pm * BM + wr * 64 + fr; const int col0 = u.pn * HALF + wc * 32 + 8 * fq;
#pragma unroll
        for (int ai = 0; ai < 2; ++ai)
#pragma unroll
            for (int m = 0; m < 4; ++m) { bf16_t* rowp = HB + (size_t)(row0 + ai * HALF + m * 16) * ldc + col0;
                const f32x4 g0 = acc[ai][0][m][0], g1 = acc[ai][0][m][1], u0 = acc[ai][1][m][0], u1 = acc[ai][1][m][1];
                u32x4 w; w.x = cvt_pk_bf16(g0[0] * sigmoidf_(g0[0]) * u0[0], g0[1] * sigmoidf_(g0[1]) * u0[1]); w.y = cvt_pk_bf16(g0[2] * sigmoidf_(g0[2]) * u0[2], g0[3] * sigmoidf_(g0[3]) * u0[3]);
                w.z = cvt_pk_bf16(g1[0] * sigmoidf_(g1[0]) * u1[0], g1[1] * sigmoidf_(g1[1]) * u1[1]); w.w = cvt_pk_bf16(g1[2] * sigmoidf_(g1[2]) * u1[2], g1[3] * sigmoidf_(g1[3]) * u1[3]);
                *(u32x4*)rowp = w; }
    }
};

template <class Epi, class Sched, bool ALIGN_EPI = true, bool SP2 = true>
__device__ __forceinline__ void gemm_phase(PG8_LAS unsigned char* lds, const Gemm g, const Sched& S, const Epi& E, const int tid) {
    const int wid = __builtin_amdgcn_readfirstlane(tid >> 6), lane = tid & 63, wr = wid >> 2, wc = wid & 3, fr = lane & 15, fq = lane >> 4;
    int K = g.K; asm volatile("" : "+s"(K));
    const int nt = K / BK;
    unsigned voffA[2], voffB[2];
#pragma unroll
    for (int i = 0; i < 2; ++i) { int R, C; stage_rc(tid * 16 + i * 8192, R, C); const int Rb = Epi::PERM ? ((R & ~31) + perm32(R & 31)) : R;
        voffA[i] = (unsigned)(R * g.lda + C) * 2u; voffB[i] = (unsigned)(Rb * g.ldb + C) * 2u; }
    const size_t kstep = (size_t)(BK * 2);
    const size_t hstepA = (size_t)HALF * g.lda * 2, hstepB = (size_t)HALF * g.ldb * 2;
    const unsigned ldsw = (unsigned)wid * 1024u;
    const int aoff = lds_byte(wr * 64 + fr, fq * 8), boff = lds_byte(wc * 32 + fr, fq * 8);
#define PG8_SA(b, h) (((b) * 2 + (h)) * HTB)
#define PG8_SB(b, h) ((4 + (b) * 2 + (h)) * HTB)
#define PG8_STAGE(bufoff, gbase, voff) do { _Pragma("unroll") for (int _i = 0; _i < 2; ++_i) \
        __builtin_amdgcn_global_load_lds((const unsigned*)((const char*)(gbase) + (voff)[_i]), (PG8_LAS unsigned*)(lds + (bufoff) + ldsw + _i * 8192), 16, 0, 0); } while (0)
#define PG8_LDA(dst, b, h) do { _Pragma("unroll") for (int m = 0; m < 4; ++m) _Pragma("unroll") for (int k = 0; k < 2; ++k) dst[m][k] = *(const PG8_LAS bf16x8*)(lds + PG8_SA(b, h) + aoff + m * 2048 + k * 1024); } while (0)
#define PG8_LDB(dst, b, h) do { _Pragma("unroll") for (int n = 0; n < 2; ++n) _Pragma("unroll") for (int k = 0; k < 2; ++k) dst[n][k] = *(const PG8_LAS bf16x8*)(lds + PG8_SB(b, h) + boff + n * 2048 + k * 1024); } while (0)
#define PG8_MMA(ai, bj, At, Bt) do { __builtin_amdgcn_s_setprio(1); _Pragma("unroll") for (int m = 0; m < 4; ++m) _Pragma("unroll") for (int n = 0; n < 2; ++n) _Pragma("unroll") for (int k = 0; k < 2; ++k) \
        acc[ai][bj][m][n] = __builtin_amdgcn_mfma_f32_16x16x32_bf16(Bt[n][k], At[m][k], acc[ai][bj][m][n], 0, 0, 0); __builtin_amdgcn_s_setprio(0); } while (0)
#define PG8_WAIT_V(n) asm volatile("s_waitcnt vmcnt(" #n ")" ::: "memory")
#define PG8_WAIT_L(n) asm volatile("s_waitcnt lgkmcnt(" #n ")" ::: "memory")
#define PG8_BAR __builtin_amdgcn_s_barrier()
#define PG8_SCHED __builtin_amdgcn_sched_barrier(0)
    Unit cur, nxt; int ui = 0;
    if (!S.next(0, cur)) return;
    f32x4 acc[2][2][4][2];
#pragma unroll
    for (int a = 0; a < 2; ++a)
#pragma unroll
        for (int b = 0; b < 2; ++b)
#pragma unroll
            for (int m = 0; m < 4; ++m)
#pragma unroll
                for (int n = 0; n < 2; ++n) acc[a][b][m][n] = (f32x4){0.f, 0.f, 0.f, 0.f};
    bf16x8 At[4][2], B0[2][2], B1[2][2];
    const char* cA = S.a_base(g, cur); const char* cB = S.b_base(g, cur);
    if constexpr (SP2) {
        PG8_STAGE(PG8_SB(0, 0), cB, voffB); PG8_STAGE(PG8_SB(0, 1), cB + hstepB, voffB); PG8_STAGE(PG8_SA(0, 0), cA, voffA); PG8_STAGE(PG8_SA(0, 1), cA + hstepA, voffA);
        if (wr == 1) PG8_BAR;
        PG8_WAIT_V(2); PG8_BAR;
        PG8_STAGE(PG8_SB(1, 0), cB + kstep, voffB); PG8_STAGE(PG8_SA(1, 0), cA + kstep, voffA); PG8_STAGE(PG8_SB(1, 1), cB + hstepB + kstep, voffB);
        PG8_WAIT_V(6); PG8_BAR;
    } else {
        PG8_STAGE(PG8_SB(0, 0), cB, voffB); PG8_STAGE(PG8_SA(0, 0), cA, voffA); PG8_STAGE(PG8_SB(0, 1), cB + hstepB, voffB); PG8_STAGE(PG8_SA(0, 1), cA + hstepA, voffA);
        if (wr == 1) PG8_BAR;
        PG8_WAIT_V(4); PG8_BAR;
        PG8_STAGE(PG8_SB(1, 0), cB + kstep, voffB); PG8_STAGE(PG8_SA(1, 0), cA + kstep, voffA); PG8_STAGE(PG8_SB(1, 1), cB + hstepB + kstep, voffB);
        PG8_WAIT_V(6); PG8_BAR;
    }
    for (;;) {
        const bool has_next = S.next(ui + 1, nxt);
        const char* nA = has_next ? S.a_base(g, nxt) : cA; const char* nB = has_next ? S.b_base(g, nxt) : cB;
        for (int t = 0; t < nt; t += 2) {
            const bool last = (t == nt - 2);
            const char* a1 = cA + (size_t)(t + 1) * kstep;
            const char* a2 = last ? nA : cA + (size_t)(t + 2) * kstep; const char* b2 = last ? nB : cB + (size_t)(t + 2) * kstep;
            const char* a3 = a2 + kstep; const char* b3 = b2 + kstep;
            if constexpr (SP2) {
            PG8_LDB(B0, 0, 0); PG8_LDB(B1, 0, 1); PG8_SCHED; PG8_LDA(At, 0, 0); PG8_STAGE(PG8_SA(1, 1), a1 + hstepA, voffA);
            PG8_WAIT_V(8); PG8_WAIT_L(0); PG8_BAR; PG8_MMA(0, 0, At, B0); PG8_MMA(0, 1, At, B1); PG8_BAR; PG8_SCHED;
            PG8_LDA(At, 0, 1); PG8_STAGE(PG8_SB(0, 0), b2, voffB); PG8_STAGE(PG8_SB(0, 1), b2 + hstepB, voffB); PG8_STAGE(PG8_SA(0, 0), a2, voffA);
            PG8_WAIT_V(8); PG8_WAIT_L(0); PG8_BAR; PG8_MMA(1, 0, At, B0); PG8_MMA(1, 1, At, B1); PG8_BAR; PG8_SCHED;
            PG8_LDB(B0, 1, 0); PG8_LDB(B1, 1, 1); PG8_SCHED; PG8_LDA(At, 1, 0); PG8_STAGE(PG8_SA(0, 1), a2 + hstepA, voffA);
            PG8_WAIT_V(8); PG8_WAIT_L(0); PG8_BAR; PG8_MMA(0, 0, At, B0); PG8_MMA(0, 1, At, B1); PG8_BAR; PG8_SCHED;
            PG8_LDA(At, 1, 1); PG8_STAGE(PG8_SB(1, 0), b3, voffB); PG8_STAGE(PG8_SB(1, 1), b3 + hstepB, voffB); PG8_STAGE(PG8_SA(1, 0), a3, voffA);
            PG8_WAIT_V(8); PG8_WAIT_L(0); PG8_BAR; PG8_MMA(1, 0, At, B0); PG8_MMA(1, 1, At, B1); PG8_BAR; PG8_SCHED;
            } else {
            PG8_LDB(B0, 0, 0); PG8_SCHED; PG8_LDA(At, 0, 0); PG8_STAGE(PG8_SA(1, 1), a1 + hstepA, voffA);
            PG8_WAIT_L(8); PG8_BAR; PG8_WAIT_L(0); PG8_MMA(0, 0, At, B0); PG8_BAR; PG8_SCHED;
            PG8_LDB(B1, 0, 1); PG8_STAGE(PG8_SB(0, 0), b2, voffB);
            PG8_BAR; PG8_WAIT_L(0); PG8_MMA(0, 1, At, B1); PG8_BAR;
            PG8_LDA(At, 0, 1); PG8_STAGE(PG8_SA(0, 0), a2, voffA);
            PG8_BAR; PG8_WAIT_L(0); PG8_MMA(1, 0, At, B0); PG8_BAR; PG8_SCHED;
            PG8_STAGE(PG8_SB(0, 1), b2 + hstepB, voffB);
            PG8_WAIT_V(6); PG8_BAR; PG8_MMA(1, 1, At, B1); PG8_BAR;
            PG8_LDB(B0, 1, 0); PG8_SCHED; PG8_LDA(At, 1, 0); PG8_STAGE(PG8_SA(0, 1), a2 + hstepA, voffA);
            PG8_WAIT_L(8); PG8_BAR; PG8_WAIT_L(0); PG8_MMA(0, 0, At, B0); PG8_BAR; PG8_SCHED;
            PG8_LDB(B1, 1, 1); PG8_STAGE(PG8_SB(1, 0), b3, voffB);
            PG8_BAR; PG8_WAIT_L(0); PG8_MMA(0, 1, At, B1); PG8_BAR;
            PG8_LDA(At, 1, 1); PG8_STAGE(PG8_SA(1, 0), a3, voffA);
            PG8_BAR; PG8_WAIT_L(0); PG8_MMA(1, 0, At, B0); PG8_BAR; PG8_SCHED;
            PG8_STAGE(PG8_SB(1, 1), b3 + hstepB, voffB);
            PG8_WAIT_V(6); PG8_BAR; PG8_MMA(1, 1, At, B1); PG8_BAR;
            }
        }
        if constexpr (ALIGN_EPI) { if (wr == 0) PG8_BAR; }
        E(acc, cur, wr, wc, fr, fq);
        if (!has_next) break;
#pragma unroll
        for (int a = 0; a < 2; ++a)
#pragma unroll
            for (int b = 0; b < 2; ++b)
#pragma unroll
                for (int m = 0; m < 4; ++m)
#pragma unroll
                    for (int n = 0; n < 2; ++n) acc[a][b][m][n] = (f32x4){0.f, 0.f, 0.f, 0.f};
        cur = nxt; cA = nA; cB = nB; ++ui;
        if constexpr (ALIGN_EPI) { if (wr == 1) PG8_BAR; }
    }
    PG8_WAIT_V(0);
    if constexpr (!ALIGN_EPI) { if (wr == 0) PG8_BAR; }
    PG8_BAR;
#undef PG8_SA
#undef PG8_SB
#undef PG8_STAGE
#undef PG8_LDA
#undef PG8_LDB
#undef PG8_MMA
#undef PG8_WAIT_V
#undef PG8_WAIT_L
#undef PG8_BAR
#undef PG8_SCHED
}
}
#define LAS __attribute__((address_space(3)))
#define XB_TMO      128
#define XB_XCNT(j)  (256  + 64 * (j))
#define XB_XSUB(j)  (1280 + 64 * (j))
#define XB_XGEN(j)  (2304 + 64 * (j))
#define XB_TOP      3328
#define XB_TOPGEN   3392
#define XCD_BAR_WORDS 3456
#define XB_SPIN_CAP (1u << 22)

__device__ __forceinline__ unsigned xb_ld(unsigned* p)              { return __hip_atomic_load(p, __ATOMIC_RELAXED, __HIP_MEMORY_SCOPE_AGENT); }
__device__ __forceinline__ unsigned xb_add(unsigned* p, unsigned v) { return __hip_atomic_fetch_add(p, v, __ATOMIC_RELAXED, __HIP_MEMORY_SCOPE_AGENT); }
__device__ __forceinline__ unsigned xb_xcc_id() { return (unsigned)__builtin_amdgcn_s_getreg((3 << 11) | 20) & 0xFu; }
#define XB_SPIN(cond, bar) do { unsigned _sp = 0; while (cond) { __builtin_amdgcn_s_sleep(1); \
    if ((++_sp & 255u) == 0u) { if (xb_ld(&(bar)[XB_TMO])) break; if (_sp > XB_SPIN_CAP) { atomicAdd(&(bar)[XB_TMO], 1u); break; } } } } while (0)

struct XcdBarrier {
    unsigned* bar; unsigned x;
    volatile LAS unsigned* st;
};

__device__ __forceinline__ XcdBarrier xcd_barrier_post(unsigned* bar, volatile LAS unsigned* st) {
    XcdBarrier b; b.bar = bar; b.x = xb_xcc_id(); b.st = st;
    if (threadIdx.x == 0) (void)xb_add(&bar[XB_XCNT(b.x)], 1u);
    return b;
}
__device__ __forceinline__ void xcd_barrier_complete(unsigned* bar, unsigned x, unsigned& nloc, unsigned& nx) {
    const unsigned G = gridDim.x * gridDim.y * gridDim.z;
    unsigned sum, cnt, mine, sp = 0u;
    for (;;) {
        sum = 0u; cnt = 0u; mine = 0u;
#pragma unroll
        for (unsigned j = 0; j < 16; ++j) { const unsigned c = xb_ld(&bar[XB_XCNT(j)]); sum += c; cnt += (c > 0u) ? 1u : 0u; mine = (j == x) ? c : mine; }
        if (sum == G) break;
        __builtin_amdgcn_s_sleep(1);
        if ((++sp & 255u) == 0u) { if (xb_ld(&bar[XB_TMO])) break; if (sp > XB_SPIN_CAP) { atomicAdd(&bar[XB_TMO], 1u); break; } }
    }
    nloc = mine > 0u ? mine : 1u; nx = cnt > 0u ? cnt : 1u;
}

__device__ __forceinline__ void xcd_barrier(const XcdBarrier& b) {
    asm volatile("s_waitcnt vmcnt(0)" ::: "memory");
    __syncthreads();
    if (threadIdx.x == 0) {
        unsigned* bar = b.bar;
        __builtin_amdgcn_s_waitcnt(0);
        unsigned nloc = b.st[0], nx = b.st[1];
        if (nloc == 0u) { xcd_barrier_complete(bar, b.x, nloc, nx); b.st[0] = nloc; b.st[1] = nx; }
        const unsigned old = xb_add(&bar[XB_XSUB(b.x)], 1u);
        const unsigned gen = old / nloc;
        if (old + 1u == (gen + 1u) * nloc) {
            __builtin_amdgcn_fence(__ATOMIC_RELEASE, "agent");
            asm volatile("s_waitcnt vmcnt(0)" ::: "memory");
            const unsigned og = xb_add(&bar[XB_TOP], 1u);
            const unsigned tg = og / nx;
            if (og + 1u == (tg + 1u) * nx) xb_add(&bar[XB_TOPGEN], 1u);
            else XB_SPIN(xb_ld(&bar[XB_TOPGEN]) == tg, bar);
            __builtin_amdgcn_fence(__ATOMIC_ACQUIRE, "agent");
            xb_add(&bar[XB_XGEN(b.x)], 1u);
            asm volatile("s_waitcnt vmcnt(0)" ::: "memory");
        } else {
            XB_SPIN(xb_ld(&bar[XB_XGEN(b.x)]) == gen, bar);
            __builtin_amdgcn_fence(__ATOMIC_ACQUIRE, "agent");
            asm volatile("s_waitcnt vmcnt(0)" ::: "memory");
        }
    }
    __syncthreads();
}
#undef LAS
constexpr int NWAVES = 8;
constexpr int BATCH = 2, SEQ = 16384, NTOK = BATCH * SEQ, DM = 1024, DEPTH = 4, PLE = 256;
constexpr int EVEN_IN = 2216, EVEN_INP = 2304, ODD_IN = 2568, ODD_INP = 2816;
constexpr int E_FQ = 0, E_FK = 512, E_FV = 1024, E_FLOG = 1536, E_CQ = 1544, E_CKV = 1928, E_KROPE = 2184;
constexpr int O_U = 0, O_Q = 512, O_K = 1024, O_V = 1536, O_GIN = 2048, O_BETA = 2052, O_Z = 2056;
constexpr float RMS_EPS = 1e-6f;
constexpr float LOG2E = 1.4426950408889634f, LN2 = 0.6931471805599453f;
constexpr float C2_FOX = 0.125f * LOG2E, C2_MLA = 0.10206207261596575f * LOG2E;
constexpr int MOE_CAP = 65536 + 32 * 256;
constexpr int MOE_MAXT = MOE_CAP / 256;

enum { I_X = 0, I_P, I_POS, I_NORM_MIX, I_NORM_FFN, I_EV_W_IN, I_FOX_BF, I_FOX_QN, I_FOX_KN, I_MLA_QAN, I_MLA_WQUP, I_MLA_KVAN, I_MLA_WKVUP, I_MLA_QN, I_MLA_KN, I_EV_W_OUT,
       I_OD_W_IN, I_S5_ARE, I_S5_AIM, I_S5_BRE, I_S5_BIM, I_S5_CRE, I_S5_CIM, I_S5_D, I_S5_LS, I_S5_WGLU, I_S5_BGLU, I_GDN_CONV, I_GDN_ALOG, I_GDN_DTB, I_GDN_ONORM, I_OD_W_OUT,
       I_MOE_WGRP, I_MOE_BGRP, I_MOE_WEXP, I_MOE_BEXP, I_MOE_WG, I_MOE_WU, I_MOE_WD, I_PLE_WP, I_PLE_NORM, I_PLE_WG, I_PLE_BG, N_IN };

constexpr size_t MiB = 1u << 20;
constexpr size_t WS_CTL = 0, CTL_ZERO_BYTES = 1 * MiB;
constexpr size_t WS_W_EVIN = 4 * MiB;
constexpr size_t WS_W_ODIN = WS_W_EVIN + 9 * MiB;
constexpr size_t WS_W_QUP = WS_W_ODIN + 11 * MiB;
constexpr size_t WS_W_KVUP = WS_W_QUP + 2 * MiB;
constexpr size_t WS_W_EVOUT = WS_W_KVUP + 1 * MiB;
constexpr size_t WS_W_ODOUT = WS_W_EVOUT + 4 * MiB;
constexpr size_t WS_W_GLU = WS_W_ODOUT + 4 * MiB;
constexpr size_t WS_W_PLEP = WS_W_GLU + 1 * MiB;
constexpr size_t WS_W_PLEG = WS_W_PLEP + 2 * MiB;
constexpr size_t WS_W_MOEGU = WS_W_PLEG + 8 * MiB;
constexpr size_t WS_W_MOED = WS_W_MOEGU + 64 * MiB;
constexpr size_t WS_ABF = WS_W_MOED + 32 * MiB;
constexpr size_t WS_PP = WS_ABF + 64 * MiB;
constexpr size_t WS_PBF = WS_PP + 64 * MiB;
constexpr size_t WS_PROJ = WS_PBF + 16 * MiB;
constexpr size_t WS_MIX = WS_PROJ + 176 * MiB;
constexpr size_t WS_R1 = WS_MIX + 64 * MiB;
constexpr size_t WS_QM = WS_R1, WS_KVB = WS_QM + 48 * MiB, WS_KM = WS_KVB + 64 * MiB, WS_CQN = WS_KM + 48 * MiB, WS_CKVN = WS_CQN + 24 * MiB, WS_LOGF = WS_CKVN + 16 * MiB, WS_CUM = WS_LOGF + 1 * MiB;
constexpr size_t WS_HG = WS_R1, WS_QG = WS_HG + 32 * MiB, WS_KG = WS_QG + 64 * MiB, WS_VG = WS_KG + 64 * MiB, WS_OG = WS_VG + 64 * MiB;
constexpr size_t WS_R2 = WS_R1 + 288 * MiB;
constexpr size_t WS_GB = WS_R2, WS_BETA = WS_GB + 1 * MiB;
constexpr size_t WS_TOKE = WS_R2 + 2 * MiB, WS_TOKW = WS_TOKE + 1 * MiB, WS_ROWS = WS_TOKW + 1 * MiB;
constexpr size_t WS_XG = WS_R1;
constexpr size_t WS_HB = WS_XG + 144 * MiB;
constexpr size_t WS_Y2 = WS_R2 + 8 * MiB;
constexpr size_t WS_END = WS_Y2 + 144 * MiB;
static_assert(WS_HB + 72 * MiB <= WS_R2, "moe overlay");
static_assert(WS_OG + 64 * MiB <= WS_R2, "odd overlay");
constexpr size_t WS_DUMMY = WS_END;
static_assert(WS_DUMMY + 128 * MiB <= 1100 * MiB, "workspace budget");

constexpr int CW_BAR = 4096;
constexpr int CW_CNT = 1024;

constexpr int RING_OFF = 0, RING_BYTES = 131072;
constexpr int LDSCTL_OFF = RING_BYTES;
constexpr int LDS_BYTES = 147456;
constexpr int LC_BARST = 32;
constexpr int LC_MOE = 256;

#define GAS __attribute__((address_space(1)))
#define LAS __attribute__((address_space(3)))
typedef unsigned short bf16;
typedef unsigned v4u __attribute__((ext_vector_type(4)));
typedef unsigned v2u __attribute__((ext_vector_type(2)));
typedef float f32x4 __attribute__((ext_vector_type(4)));
#define LDS_WAIT() asm volatile("s_waitcnt lgkmcnt(0)" ::: "memory")
#define VM_WAIT() asm volatile("s_waitcnt vmcnt(0)" ::: "memory")
__device__ __forceinline__ unsigned f2bf(float f) { unsigned u = __builtin_bit_cast(unsigned, f); return (u + 0x7fffu + ((u >> 16) & 1u)) >> 16; }
__device__ __forceinline__ unsigned pk2(float lo, float hi) { return f2bf(lo) | (f2bf(hi) << 16); }
__device__ __forceinline__ float bflo(unsigned w) { return __uint_as_float(w << 16); }
__device__ __forceinline__ float bfhi(unsigned w) { return __uint_as_float(w & 0xffff0000u); }
__device__ __forceinline__ float bf2f(bf16 h) { return __uint_as_float((unsigned)h << 16); }
__device__ __forceinline__ float wave_sum(float v) {
#pragma unroll
    for (int o = 1; o < 64; o <<= 1) v += __shfl_xor(v, o);
    return v;
}
__device__ __forceinline__ float sigm(float x) { return 1.0f / (1.0f + expf(-x)); }
__device__ __forceinline__ float softplusf_(float x) { return fmaxf(x, 0.f) + log1pf(expf(-fabsf(x))); }
__device__ __forceinline__ float gelu_tanh(float x) { return 0.5f * x * (1.0f + tanhf(0.7978845608028654f * (x + 0.044715f * x * x * x))); }

struct Args { const float* in[N_IN]; float* out; unsigned char* ws; int ph_lo, ph_hi; };
#define CAS __attribute__((address_space(4)))
__device__ __forceinline__ const float* kin(int i) { asm volatile("" : "+s"(i)); const CAS char* kp = (const CAS char*)__builtin_amdgcn_kernarg_segment_ptr(); return *(const float* const CAS*)(kp + 8 * i); }
__device__ __forceinline__ float* kout() { int i = N_IN; asm volatile("" : "+s"(i)); const CAS char* kp = (const CAS char*)__builtin_amdgcn_kernarg_segment_ptr(); return *(float* const CAS*)(kp + 8 * i); }
__device__ __forceinline__ unsigned char* kws() { int i = N_IN + 1; asm volatile("" : "+s"(i)); const CAS char* kp = (const CAS char*)__builtin_amdgcn_kernarg_segment_ptr(); return *(unsigned char* const CAS*)(kp + 8 * i); }

struct Frame {
    LAS unsigned char* lds;
    unsigned char* ws;
    unsigned* ctl;
    int tid, lane, wave, G, bid;
};

__device__ __forceinline__ void transpose_item(const float* W, int K, int N, bf16* WT, int drow0, LAS float* scr, int k0, int n0, int lane) {
    const int nn = n0 + (lane & 31); const bool ok = nn < N;
#pragma unroll 8
    for (int i = 0; i < 32; ++i) { const int kk = 2 * i + (lane >> 5); scr[kk * 33 + (lane & 31)] = ok ? W[(size_t)(k0 + kk) * N + nn] : 0.f; }
    LDS_WAIT(); asm volatile("" ::: "memory");
    const int c = lane & 7;
#pragma unroll
    for (int j = 0; j < 4; ++j) { const int n = (lane >> 3) + 8 * j; const LAS float* s = scr + (8 * c) * 33 + n;
        v4u o; o.x = pk2(s[0 * 33], s[1 * 33]); o.y = pk2(s[2 * 33], s[3 * 33]); o.z = pk2(s[4 * 33], s[5 * 33]); o.w = pk2(s[6 * 33], s[7 * 33]);
        *(v4u*)(WT + (size_t)(drow0 + n) * K + k0 + 8 * c) = o; }
    LDS_WAIT(); asm volatile("" ::: "memory");
}
__device__ __forceinline__ void transpose_set(Frame& F, const float* W, int nmat, int K, int N, int NP, bf16* WT, int& itbase) {
    LAS float* scr = (LAS float*)(F.lds + RING_OFF + F.wave * 16384);
    const int gw = F.bid * NWAVES + F.wave, NGW = F.G * NWAVES;
    const int nkb = K / 64, nnb = NP / 32, per = nkb * nnb, total = nmat * per;
    int first = (gw - (itbase % NGW) + NGW) % NGW;
    for (int it = first; it < total; it += NGW) { const int mi = it / per, r = it % per, kb = r / nnb, nb = r % nnb;
        transpose_item(W + (size_t)mi * K * N, K, N, WT + (size_t)mi * NP * K, nb * 32, scr, kb * 64, nb * 32, F.lane); }
    itbase += total;
}
__device__ __forceinline__ void prologue_weights(Frame& F) {
 int itb = 0;
    transpose_set(F, kin(I_EV_W_IN), 2, 1024, EVEN_IN, EVEN_INP, (bf16*)(F.ws + WS_W_EVIN), itb);
    transpose_set(F, kin(I_OD_W_IN), 2, 1024, ODD_IN, ODD_INP, (bf16*)(F.ws + WS_W_ODIN), itb);
    transpose_set(F, kin(I_MLA_WQUP), 2, 384, 768, 768, (bf16*)(F.ws + WS_W_QUP), itb);
    transpose_set(F, kin(I_MLA_WKVUP), 2, 256, 1024, 1024, (bf16*)(F.ws + WS_W_KVUP), itb);
    transpose_set(F, kin(I_EV_W_OUT), 2, 1024, 1024, 1024, (bf16*)(F.ws + WS_W_EVOUT), itb);
    transpose_set(F, kin(I_OD_W_OUT), 2, 1024, 1024, 1024, (bf16*)(F.ws + WS_W_ODOUT), itb);
    transpose_set(F, kin(I_S5_WGLU), 2, 512, 512, 512, (bf16*)(F.ws + WS_W_GLU), itb);
    transpose_set(F, kin(I_PLE_WP), 4, 256, 1024, 1024, (bf16*)(F.ws + WS_W_PLEP), itb);
    transpose_set(F, kin(I_PLE_WG), 4, 1024, 1024, 1024, (bf16*)(F.ws + WS_W_PLEG), itb);
}
__device__ __forceinline__ void moe_weights(Frame& F, int layer) {

    LAS float* scr = (LAS float*)(F.lds + RING_OFF + F.wave * 16384);
    const int gw = F.bid * NWAVES + F.wave, NGW = F.G * NWAVES;
    const float* wg = kin(I_MOE_WG) + (size_t)layer * 32 * 1024 * 512; const float* wu = kin(I_MOE_WU) + (size_t)layer * 32 * 1024 * 512; const float* wd = kin(I_MOE_WD) + (size_t)layer * 32 * 512 * 1024;
    bf16* WGU = (bf16*)(F.ws + WS_W_MOEGU); bf16* WD = (bf16*)(F.ws + WS_W_MOED);
    for (int it = gw; it < 2 * 32 * 256; it += NGW) { const int which = it / (32 * 256), r0 = it % (32 * 256), e = r0 / 256, r = r0 % 256, kb = r / 16, nb = r % 16, n0 = nb * 32;
        const int drow = 256 * (n0 / 128) + (n0 % 128) + which * 128;
        transpose_item((which ? wu : wg) + (size_t)e * 1024 * 512, 1024, 512, WGU + (size_t)e * 1024 * 1024, drow, scr, kb * 64, n0, F.lane); }
    for (int it = gw; it < 32 * 256; it += NGW) { const int e = it / 256, r = it % 256, kb = r / 32, nb = r % 32;
        transpose_item(wd + (size_t)e * 512 * 1024, 512, 1024, WD + (size_t)e * 1024 * 512, nb * 32, scr, kb * 64, nb * 32, F.lane); }
}

__device__ __forceinline__ void rms_row_to_bf16(const float* xrow, const float* gain, bf16* orow, float* copy, int lane) {
    const f32x4* xr = (const f32x4*)xrow + lane; f32x4 v[4]; float s = 0.f;
#pragma unroll
    for (int j = 0; j < 4; ++j) { v[j] = xr[64 * j]; s += (v[j].x * v[j].x + v[j].y * v[j].y) + (v[j].z * v[j].z + v[j].w * v[j].w); }
    const float r = 1.0f / sqrtf(wave_sum(s) * (1.f / 1024.f) + RMS_EPS);
    if (copy) {
#pragma unroll
        for (int j = 0; j < 4; ++j) ((f32x4*)copy + lane)[64 * j] = v[j]; }
    unsigned long long* o8 = (unsigned long long*)orow + lane;
#pragma unroll
    for (int j = 0; j < 4; ++j) { const f32x4 g = ((const f32x4*)gain + lane)[64 * j];
        o8[64 * j] = (unsigned long long)pk2(v[j].x * r * g.x, v[j].y * r * g.y) | ((unsigned long long)pk2(v[j].z * r * g.z, v[j].w * r * g.w) << 32); }
}
__device__ __forceinline__ void phase_norm(Frame& F, const float* src, const float* gain, float* copy) {
    bf16* ABF = (bf16*)(F.ws + WS_ABF);
    const int gw = F.bid * NWAVES + F.wave, NGW = F.G * NWAVES;
    for (int m = gw; m < NTOK; m += NGW) rms_row_to_bf16(src + (size_t)m * DM, gain, ABF + (size_t)m * DM, copy ? copy + (size_t)m * DM : nullptr, F.lane);
}
__device__ __forceinline__ void phase_pconv(Frame& F, int layer) {
    const float* p = kin(I_P) + (size_t)layer * NTOK * PLE; bf16* PBF = (bf16*)(F.ws + WS_PBF);
    const size_t n4 = (size_t)NTOK * PLE / 4; const size_t gt = (size_t)F.bid * 512 + F.tid, NT = (size_t)F.G * 512;
    for (size_t i = gt; i < n4; i += NT) { const f32x4 v = ((const f32x4*)p)[i]; v2u o; o.x = pk2(v.x, v.y); o.y = pk2(v.z, v.w); ((v2u*)PBF)[i] = o; }
}

__device__ __forceinline__ void phase_even_post(Frame& F, int j, bool dry = false) {

    bf16* PROJ = (bf16*)(F.ws + WS_PROJ); bf16* CQN = (bf16*)(F.ws + WS_CQN); bf16* CKVN = (bf16*)(F.ws + WS_CKVN); float* LOGF = (float*)(F.ws + WS_LOGF);
    const float* qn = kin(I_FOX_QN) + j * 64; const float* kn = kin(I_FOX_KN) + j * 64; const float* bfv = kin(I_FOX_BF) + j * 8;
    const float* qan = kin(I_MLA_QAN) + j * 384; const float* kvan = kin(I_MLA_KVAN) + j * 256;
    const int gw = F.bid * NWAVES + F.wave, NGW = F.G * NWAVES, lane = F.lane;
    for (int m = gw; m < NTOK; m += NGW) {
        bf16* row = PROJ + (size_t)m * EVEN_INP;
#pragma unroll
        for (int w = 0; w < 2; ++w) {
            v4u* p = (v4u*)(row + (w ? E_FK : E_FQ)) + lane; const v4u x = *p;
            float f[8] = {bflo(x.x), bfhi(x.x), bflo(x.y), bfhi(x.y), bflo(x.z), bfhi(x.z), bflo(x.w), bfhi(x.w)};
            float s = 0.f;
#pragma unroll
            for (int i = 0; i < 8; ++i) s += f[i] * f[i];
            s += __shfl_xor(s, 1); s += __shfl_xor(s, 2); s += __shfl_xor(s, 4);
            const float r = (1.0f / sqrtf(s * (1.f / 64.f) + RMS_EPS)) * (w ? 1.0f : C2_FOX); const float* g = (w ? kn : qn) + (lane & 7) * 8;
            v4u o; o.x = pk2(f[0] * r * g[0], f[1] * r * g[1]); o.y = pk2(f[2] * r * g[2], f[3] * r * g[3]); o.z = pk2(f[4] * r * g[4], f[5] * r * g[5]); o.w = pk2(f[6] * r * g[6], f[7] * r * g[7]);
            *(dry ? (v4u*)(F.ws + WS_DUMMY) + (size_t)m * 128 + w * 64 + lane : p) = o;
        }
        if (lane < 8) { const float z = bf2f(row[E_FLOG + lane]) + bfv[lane]; LOGF[(size_t)m * 8 + lane] = -softplusf_(-z); }
        {
            float f[6]; float s = 0.f;
#pragma unroll
            for (int i = 0; i < 3; ++i) { const unsigned x = *((const unsigned*)(row + E_CQ) + lane + 64 * i); f[2 * i] = bflo(x); f[2 * i + 1] = bfhi(x); s += f[2 * i] * f[2 * i] + f[2 * i + 1] * f[2 * i + 1]; }
            const float r = 1.0f / sqrtf(wave_sum(s) * (1.f / 384.f) + RMS_EPS);
#pragma unroll
            for (int i = 0; i < 3; ++i) { const int c = 2 * (lane + 64 * i); *((unsigned*)(CQN + (size_t)m * 384) + lane + 64 * i) = pk2(f[2 * i] * r * qan[c], f[2 * i + 1] * r * qan[c + 1]); }
        }
        {
            float f[4]; float s = 0.f;
#pragma unroll
            for (int i = 0; i < 2; ++i) { const unsigned x = *((const unsigned*)(row + E_CKV) + lane + 64 * i); f[2 * i] = bflo(x); f[2 * i + 1] = bfhi(x); s += f[2 * i] * f[2 * i] + f[2 * i + 1] * f[2 * i + 1]; }
            const float r = 1.0f / sqrtf(wave_sum(s) * (1.f / 256.f) + RMS_EPS);
#pragma unroll
            for (int i = 0; i < 2; ++i) { const int c = 2 * (lane + 64 * i); *((unsigned*)(CKVN + (size_t)m * 256) + lane + 64 * i) = pk2(f[2 * i] * r * kvan[c], f[2 * i + 1] * r * kvan[c + 1]); }
        }
    }
}
__device__ __forceinline__ void phase_cumsum(Frame& F) {
    if (F.bid >= 16) return;
    const float* LOGF = (const float*)(F.ws + WS_LOGF); float* CUM = (float*)(F.ws + WS_CUM);
    const int b = F.bid >> 3, h = F.bid & 7, t0 = F.tid * 32;
    LAS double* part = (LAS double*)(F.lds + RING_OFF);
    float v[32]; double s = 0.0;
#pragma unroll
    for (int i = 0; i < 32; ++i) { v[i] = LOGF[((size_t)b * SEQ + t0 + i) * 8 + h]; s += (double)v[i]; }
    part[F.tid] = s; __syncthreads();
    if (F.tid == 0) { double run = 0.0; for (int i = 0; i < 512; ++i) { const double x = part[i]; part[i] = run; run += x; } }
    __syncthreads();
    double run = part[F.tid];
#pragma unroll
    for (int i = 0; i < 32; ++i) { run += (double)v[i]; CUM[((size_t)b * SEQ + t0 + i) * 8 + h] = (float)run; }
    __syncthreads();
}
__device__ __forceinline__ void phase_mla_post(Frame& F, int j, bool dry = false) {

    const bf16* PROJ = (const bf16*)(F.ws + WS_PROJ); bf16* QM = (bf16*)(F.ws + WS_QM); const bf16* KVB = (const bf16*)(F.ws + WS_KVB); bf16* KM = (bf16*)(F.ws + WS_KM);
    const float* qn = kin(I_MLA_QN) + j * 96; const float* kn = kin(I_MLA_KN) + j * 96; const int* pos = (const int*)kin(I_POS);
    const int gw = F.bid * NWAVES + F.wave, NGW = F.G * NWAVES, lane = F.lane, l32 = lane & 31, hh = lane >> 5;
    const int fi = l32 & 15; const float inv = expf(-(float)fi * (1.0f / 16.0f) * 9.210340371976184f);
    for (int m = gw; m < NTOK; m += NGW) {
        const float ang = (float)pos[m] * inv; float sn, cs; sincosf(ang, &sn, &cs);
        const float krope = bf2f(PROJ[(size_t)m * EVEN_INP + E_KROPE + l32]);
#pragma unroll
        for (int hp = 0; hp < 4; ++hp) { const int h = hp * 2 + hh;
#pragma unroll
            for (int w = 0; w < 2; ++w) {
                float f[3];
                if (w == 0) { const bf16* q = QM + (size_t)m * 768 + h * 96; f[0] = bf2f(q[l32]); f[1] = bf2f(q[l32 + 32]); f[2] = bf2f(q[l32 + 64]); }
                else { const bf16* k = KVB + (size_t)m * 1024 + h * 128; f[0] = bf2f(k[l32]); f[1] = bf2f(k[l32 + 32]); f[2] = krope; }
                float s = f[0] * f[0] + f[1] * f[1] + f[2] * f[2];
                s += __shfl_xor(s, 1); s += __shfl_xor(s, 2); s += __shfl_xor(s, 4); s += __shfl_xor(s, 8); s += __shfl_xor(s, 16);
                const float r = 1.0f / sqrtf(s * (1.f / 96.f) + RMS_EPS); const float* g = w ? kn : qn;
                f[0] *= r * g[l32]; f[1] *= r * g[l32 + 32]; f[2] *= r * g[l32 + 64];
                const float other = __shfl_xor(f[2], 16);
                const float rot = (l32 < 16) ? (f[2] * cs - other * sn) : (other * sn + f[2] * cs);
                bf16* o = (w ? KM : (dry ? (bf16*)(F.ws + WS_DUMMY) : QM)) + (size_t)m * 768 + h * 96; const float qs = w ? 1.0f : C2_MLA;
                o[l32] = (bf16)f2bf(f[0] * qs); o[l32 + 32] = (bf16)f2bf(f[1] * qs); o[l32 + 64] = (bf16)f2bf(rot * qs);
            }
        }
    }
}
template <int DK> __device__ __forceinline__ void attn_naive_unit(Frame& F, const bf16* Qp, int qld, const bf16* Kp, int kld, const bf16* Vp, int vld, const float* cum  , float scale, bf16* Op, int qb) {
    LAS float* Ks = (LAS float*)(F.lds + RING_OFF); LAS float* Vs = Ks + 64 * DK; LAS float* Cs = Vs + 64 * 64;
    const int t = qb * 512 + F.wave * 64 + F.lane; const int tmax_w = qb * 512 + F.wave * 64 + 63;
    float q[DK];
#pragma unroll
    for (int d = 0; d < DK; d += 8) { const v4u x = *(const v4u*)(Qp + (size_t)t * qld + d);
        q[d] = bflo(x.x) * scale; q[d + 1] = bfhi(x.x) * scale; q[d + 2] = bflo(x.y) * scale; q[d + 3] = bfhi(x.y) * scale; q[d + 4] = bflo(x.z) * scale; q[d + 5] = bfhi(x.z) * scale; q[d + 6] = bflo(x.w) * scale; q[d + 7] = bfhi(x.w) * scale; }
    const float cq = cum ? cum[(size_t)t * 8] : 0.f;
    float acc[64];
#pragma unroll
    for (int d = 0; d < 64; ++d) acc[d] = 0.f;
    float mx = -1e30f, l = 0.f;
    const int nkb = (qb * 512 + 512) / 64;
    for (int kb = 0; kb < nkb; ++kb) {
        __syncthreads();
        for (int i = F.tid; i < 64 * DK / 8; i += 512) { const int key = i / (DK / 8), c = (i % (DK / 8)) * 8; const v4u x = *(const v4u*)(Kp + (size_t)(kb * 64 + key) * kld + c);
            LAS float* d = Ks + key * DK + c; d[0] = bflo(x.x); d[1] = bfhi(x.x); d[2] = bflo(x.y); d[3] = bfhi(x.y); d[4] = bflo(x.z); d[5] = bfhi(x.z); d[6] = bflo(x.w); d[7] = bfhi(x.w); }
        { const int i = F.tid; const int key = i / 8, c = (i % 8) * 8; const v4u x = *(const v4u*)(Vp + (size_t)(kb * 64 + key) * vld + c);
            LAS float* d = Vs + key * 64 + c; d[0] = bflo(x.x); d[1] = bfhi(x.x); d[2] = bflo(x.y); d[3] = bfhi(x.y); d[4] = bflo(x.z); d[5] = bfhi(x.z); d[6] = bflo(x.w); d[7] = bfhi(x.w); }
        if (F.tid < 64) Cs[F.tid] = cum ? cum[(size_t)(kb * 64 + F.tid) * 8] : 0.f;
        __syncthreads();
        if (kb * 64 > tmax_w) continue;
        for (int jk = 0; jk < 64; ++jk) {
            const int s = kb * 64 + jk; if (s > tmax_w) break;
            const LAS float* kr = Ks + jk * DK; float dot = 0.f;
#pragma unroll
            for (int d = 0; d < DK; d += 4) { const f32x4 kv = *(const LAS f32x4*)(kr + d); dot += q[d] * kv.x + q[d + 1] * kv.y + q[d + 2] * kv.z + q[d + 3] * kv.w; }
            float logit = dot + (cq - Cs[jk]); if (s > t) logit = -1e30f;
            if (__any(logit > mx)) { const float mn = fmaxf(mx, logit); const float corr = expf(mx - mn); l *= corr;
#pragma unroll
                for (int d = 0; d < 64; ++d) acc[d] *= corr;
                mx = mn; }
            const float p = (s > t) ? 0.f : expf(logit - mx); l += p;
            const LAS float* vr = Vs + jk * 64;
#pragma unroll
            for (int d = 0; d < 64; d += 4) { const f32x4 vv = *(const LAS f32x4*)(vr + d); acc[d] += p * vv.x; acc[d + 1] += p * vv.y; acc[d + 2] += p * vv.z; acc[d + 3] += p * vv.w; }
        }
    }
    const float il = 1.0f / l; bf16* o = Op + (size_t)t * DM;
#pragma unroll
    for (int d = 0; d < 64; d += 8) { v4u w; w.x = pk2(acc[d] * il, acc[d + 1] * il); w.y = pk2(acc[d + 2] * il, acc[d + 3] * il); w.z = pk2(acc[d + 4] * il, acc[d + 5] * il); w.w = pk2(acc[d + 6] * il, acc[d + 7] * il); *(v4u*)(o + d) = w; }
}
__device__ __forceinline__ void phase_attn_naive(Frame& F) {
    const bf16* PROJ = (const bf16*)(F.ws + WS_PROJ); const bf16* QM = (const bf16*)(F.ws + WS_QM); const bf16* KVB = (const bf16*)(F.ws + WS_KVB); const bf16* KM = (const bf16*)(F.ws + WS_KM);
    const float* CUM = (const float*)(F.ws + WS_CUM); bf16* MIX = (bf16*)(F.ws + WS_MIX);
    for (int p = F.bid; p < 512; p += F.G) {
        const int combo = p >> 4, qq = p & 15; const int type = combo >> 4, b = (combo >> 3) & 1, h = combo & 7;
#pragma unroll 1
        for (int half = 0; half < 2; ++half) { const int qb = half ? 31 - qq : qq; const size_t rb = (size_t)b * SEQ;
            if (type == 0) attn_naive_unit<64>(F, PROJ + rb * EVEN_INP + E_FQ + h * 64, EVEN_INP, PROJ + rb * EVEN_INP + E_FK + h * 64, EVEN_INP, PROJ + rb * EVEN_INP + E_FV + h * 64, EVEN_INP, CUM + rb * 8 + h, LN2, MIX + rb * DM + h * 64, qb);
            else attn_naive_unit<96>(F, QM + rb * 768 + h * 96, 768, KM + rb * 768 + h * 96, 768, KVB + rb * 1024 + h * 128 + 64, 1024, nullptr, LN2, MIX + rb * DM + 512 + h * 64, qb);
        }
    }
    __syncthreads();
}

__device__ __forceinline__ void s5_scan_wave(Frame& F, int j, int b, int g) {
 const int p = F.lane;
    const bf16* PROJ = (const bf16*)(F.ws + WS_PROJ); bf16* HG = (bf16*)(F.ws + WS_HG);
    const float lr = fminf(kin(I_S5_ARE)[(j * 32 + g) * 64 + p], -1e-4f), li = kin(I_S5_AIM)[(j * 32 + g) * 64 + p];
    const float dt = expf(kin(I_S5_LS)[j * 32 + g]);
    const float mag = expf(lr * dt); const float abr = mag * cosf(li * dt), abi = mag * sinf(li * dt);
    const float den = lr * lr + li * li, nr = abr - 1.0f, ni = abi;
    const float gr = (nr * lr + ni * li) / den, gi = (ni * lr - nr * li) / den;
    float bbr[16], bbi[16], cr[16], ci[16], dsk[16];
#pragma unroll
    for (int c = 0; c < 16; ++c) { const float br = kin(I_S5_BRE)[((size_t)(j * 32 + g) * 64 + p) * 16 + c], bi = kin(I_S5_BIM)[((size_t)(j * 32 + g) * 64 + p) * 16 + c];
        bbr[c] = gr * br - gi * bi; bbi[c] = gr * bi + gi * br;
        cr[c] = kin(I_S5_CRE)[((size_t)(j * 32 + g) * 16 + c) * 64 + p]; ci[c] = kin(I_S5_CIM)[((size_t)(j * 32 + g) * 16 + c) * 64 + p];
        dsk[c] = kin(I_S5_D)[j * 512 + g * 16 + c]; }
    float xr = 0.f, xi = 0.f;
    const bf16* up = PROJ + (size_t)b * SEQ * ODD_INP + O_U + g * 16;
    v4u cur0[4], cur1[4], nx0[4], nx1[4];
#pragma unroll
    for (int i = 0; i < 4; ++i) { cur0[i] = *(const v4u*)(up + (size_t)i * ODD_INP); cur1[i] = *(const v4u*)(up + (size_t)i * ODD_INP + 8); }
    for (int t0 = 0; t0 < SEQ; t0 += 4) {
        const int tn = (t0 + 4 < SEQ) ? t0 + 4 : t0;
#pragma unroll
        for (int i = 0; i < 4; ++i) { nx0[i] = *(const v4u*)(up + (size_t)(tn + i) * ODD_INP); nx1[i] = *(const v4u*)(up + (size_t)(tn + i) * ODD_INP + 8); }
#pragma unroll
        for (int i = 0; i < 4; ++i) {
            float u[16] = {bflo(cur0[i].x), bfhi(cur0[i].x), bflo(cur0[i].y), bfhi(cur0[i].y), bflo(cur0[i].z), bfhi(cur0[i].z), bflo(cur0[i].w), bfhi(cur0[i].w),
                           bflo(cur1[i].x), bfhi(cur1[i].x), bflo(cur1[i].y), bfhi(cur1[i].y), bflo(cur1[i].z), bfhi(cur1[i].z), bflo(cur1[i].w), bfhi(cur1[i].w)};
            float bur = 0.f, bui = 0.f;
#pragma unroll
            for (int c = 0; c < 16; ++c) { bur += bbr[c] * u[c]; bui += bbi[c] * u[c]; }
            const float nxr = abr * xr - abi * xi + bur, nxi = abr * xi + abi * xr + bui; xr = nxr; xi = nxi;
            float y[16];
#pragma unroll
            for (int c = 0; c < 16; ++c) y[c] = wave_sum(cr[c] * xr - ci[c] * xi);
            if (p < 16) { float yy = 0.f, uu = 0.f, dd = 0.f;
#pragma unroll
                for (int c = 0; c < 16; ++c) if (p == c) { yy = y[c]; uu = u[c]; dd = dsk[c]; }
                HG[((size_t)b * SEQ + t0 + i) * 512 + g * 16 + p] = (bf16)f2bf(gelu_tanh(yy + dd * uu)); }
        }
#pragma unroll
        for (int i = 0; i < 4; ++i) { cur0[i] = nx0[i]; cur1[i] = nx1[i]; }
    }
}
__device__ __forceinline__ void gdn_prep_token(Frame& F, int j, int m) {
 const int lane = F.lane;
    const bf16* PROJ = (const bf16*)(F.ws + WS_PROJ); float* QG = (float*)(F.ws + WS_QG); float* KG = (float*)(F.ws + WS_KG); float* VG = (float*)(F.ws + WS_VG);
    float* GB = (float*)(F.ws + WS_GB); float* BETA = (float*)(F.ws + WS_BETA);
    const float* cw = kin(I_GDN_CONV) + (size_t)j * 4 * 1536;
    const int s = m % SEQ;
#pragma unroll
    for (int w = 0; w < 3; ++w) {
        const int ch0 = w * 512 + lane * 8; float acc[8];
#pragma unroll
        for (int i = 0; i < 8; ++i) acc[i] = 0.f;
#pragma unroll
        for (int tap = 0; tap < 4; ++tap) { const int ss = s - 3 + tap; if (ss < 0) continue;
            const v4u x = *(const v4u*)(PROJ + (size_t)(m - 3 + tap) * ODD_INP + O_Q + ch0); const float* wv = cw + tap * 1536 + ch0;
            acc[0] += wv[0] * bflo(x.x); acc[1] += wv[1] * bfhi(x.x); acc[2] += wv[2] * bflo(x.y); acc[3] += wv[3] * bfhi(x.y); acc[4] += wv[4] * bflo(x.z); acc[5] += wv[5] * bfhi(x.z); acc[6] += wv[6] * bflo(x.w); acc[7] += wv[7] * bfhi(x.w); }
        float ss2 = 0.f;
#pragma unroll
        for (int i = 0; i < 8; ++i) { acc[i] = acc[i] * sigm(acc[i]); ss2 += acc[i] * acc[i]; }
        float sc = 1.0f;
        if (w < 2) { ss2 += __shfl_xor(ss2, 1); ss2 += __shfl_xor(ss2, 2); ss2 += __shfl_xor(ss2, 4); ss2 += __shfl_xor(ss2, 8); sc = 1.0f / sqrtf(ss2 + RMS_EPS); if (w == 0) sc *= 0.08838834764831845f; }
        float* dst = (w == 0 ? QG : (w == 1 ? KG : VG)) + (size_t)m * 512 + lane * 8;
        *(f32x4*)dst = (f32x4){acc[0] * sc, acc[1] * sc, acc[2] * sc, acc[3] * sc}; *(f32x4*)(dst + 4) = (f32x4){acc[4] * sc, acc[5] * sc, acc[6] * sc, acc[7] * sc};
    }
    if (lane < 4) { const float gin = bf2f(PROJ[(size_t)m * ODD_INP + O_GIN + lane]), bin = bf2f(PROJ[(size_t)m * ODD_INP + O_BETA + lane]);
        GB[(size_t)m * 4 + lane] = -expf(kin(I_GDN_ALOG)[j * 4 + lane]) * softplusf_(gin + kin(I_GDN_DTB)[j * 4 + lane]); BETA[(size_t)m * 4 + lane] = sigm(bin); }
}
__device__ __forceinline__ void phase_gdn_prep(Frame& F, int j) {
    const int gw = F.bid * NWAVES + F.wave, NGW = F.G * NWAVES;
    for (int m = gw; m < NTOK; m += NGW) gdn_prep_token(F, j, m);
}
__device__ __forceinline__ void phase_odd_a(Frame& F, int j) {
    if (F.wave == 0 && F.bid < 64) { s5_scan_wave(F, j, F.bid >> 5, F.bid & 31); return; }
    const int nbusy = (F.G < 64 ? F.G : 64);
    const int widx = (F.bid < 64) ? F.bid * 7 + (F.wave - 1) : nbusy * 7 + (F.bid - 64) * 8 + F.wave;
    const int nw = nbusy * 7 + (F.G > 64 ? (F.G - 64) * 8 : 0);
    for (int m = widx; m < NTOK; m += nw) gdn_prep_token(F, j, m);
}
__device__ __forceinline__ void phase_gdn_naive(Frame& F) {
    const float* QG = (const float*)(F.ws + WS_QG); const float* KG = (const float*)(F.ws + WS_KG); const float* VG = (const float*)(F.ws + WS_VG);
    const float* GB = (const float*)(F.ws + WS_GB); const float* BETA = (const float*)(F.ws + WS_BETA); float* OG = (float*)(F.ws + WS_OG);
    const int lane = F.lane; const int NGW = F.G * NWAVES;
    for (int u = F.wave * F.G + F.bid; u < 1024; u += NGW) {
        const int b = u >> 9, h = (u >> 7) & 3, c = u & 127; const size_t rb = (size_t)b * SEQ;
        const float* kq = KG + rb * 512 + h * 128 + lane; const float* qq = QG + rb * 512 + h * 128 + lane; const float* vq = VG + rb * 512 + h * 128 + c;
        const float* gq = GB + rb * 4 + h; const float* bq = BETA + rb * 4 + h; float* oq = OG + rb * 512 + h * 128 + c;
        float s0 = 0.f, s1 = 0.f;
        float k0[8], k1[8], q0[8], q1[8], vv[8], gg[8], bb[8], nk0[8], nk1[8], nq0[8], nq1[8], nv[8], ng[8], nb[8];
#pragma unroll
        for (int i = 0; i < 8; ++i) { k0[i] = kq[(size_t)i * 512]; k1[i] = kq[(size_t)i * 512 + 64]; q0[i] = qq[(size_t)i * 512]; q1[i] = qq[(size_t)i * 512 + 64]; vv[i] = vq[(size_t)i * 512]; gg[i] = gq[i * 4]; bb[i] = bq[i * 4]; }
        for (int t0 = 0; t0 < SEQ; t0 += 8) {
            const int tn = (t0 + 8 < SEQ) ? t0 + 8 : t0;
#pragma unroll
            for (int i = 0; i < 8; ++i) { const size_t o = (size_t)(tn + i) * 512; nk0[i] = kq[o]; nk1[i] = kq[o + 64]; nq0[i] = qq[o]; nq1[i] = qq[o + 64]; nv[i] = vq[o]; ng[i] = gq[(tn + i) * 4]; nb[i] = bq[(tn + i) * 4]; }
#pragma unroll
            for (int i = 0; i < 8; ++i) {
                const float ks = wave_sum(k0[i] * s0 + k1[i] * s1); const float eg = expf(gg[i]); const float be = bb[i];
                s0 = eg * (s0 - be * k0[i] * ks) + be * k0[i] * vv[i]; s1 = eg * (s1 - be * k1[i] * ks) + be * k1[i] * vv[i];
                const float o = wave_sum(q0[i] * s0 + q1[i] * s1);
                if (lane == 0) oq[(size_t)(t0 + i) * 512] = o;
            }
#pragma unroll
            for (int i = 0; i < 8; ++i) { k0[i] = nk0[i]; k1[i] = nk1[i]; q0[i] = nq0[i]; q1[i] = nq1[i]; vv[i] = nv[i]; gg[i] = ng[i]; bb[i] = nb[i]; }
        }
    }
}
__device__ __forceinline__ void phase_gdn_out(Frame& F, int j) {
 const float* OG = (const float*)(F.ws + WS_OG); const bf16* PROJ = (const bf16*)(F.ws + WS_PROJ); bf16* MIX = (bf16*)(F.ws + WS_MIX);
    const float* on = kin(I_GDN_ONORM) + j * 128; const int lane = F.lane;
    const int gw = F.bid * NWAVES + F.wave, NGW = F.G * NWAVES;
    for (int m = gw; m < NTOK; m += NGW) {
        const f32x4 a = *(const f32x4*)(OG + (size_t)m * 512 + lane * 8), b = *(const f32x4*)(OG + (size_t)m * 512 + lane * 8 + 4);
        float f[8] = {a.x, a.y, a.z, a.w, b.x, b.y, b.z, b.w}; float s = 0.f;
#pragma unroll
        for (int i = 0; i < 8; ++i) s += f[i] * f[i];
        s += __shfl_xor(s, 1); s += __shfl_xor(s, 2); s += __shfl_xor(s, 4); s += __shfl_xor(s, 8);
        const float r = 1.0f / sqrtf(s * (1.f / 128.f) + RMS_EPS);
        const bf16* z = PROJ + (size_t)m * ODD_INP + O_Z + lane * 8; const float* g = on + (lane & 15) * 8; float o[8];
#pragma unroll
        for (int i = 0; i < 8; ++i) { const float zz = bf2f(z[i]); o[i] = f[i] * r * g[i] * (zz * sigm(zz)); }
        v4u w; w.x = pk2(o[0], o[1]); w.y = pk2(o[2], o[3]); w.z = pk2(o[4], o[5]); w.w = pk2(o[6], o[7]);
        *(v4u*)(MIX + (size_t)m * DM + 512 + lane * 8) = w;
    }
}

__device__ __forceinline__ void phase_router(Frame& F, int layer, bool dry = false) {
 const float* H = kout(); bf16* ABF = (bf16*)(F.ws + WS_ABF);
    const float* gain = kin(I_NORM_FFN) + layer * DM; const float* wgr = kin(I_MOE_WGRP) + (size_t)layer * DM * 4; const float* bgr = kin(I_MOE_BGRP) + layer * 4;
    const float* wex = kin(I_MOE_WEXP) + (size_t)layer * DM * 32; const float* bex = kin(I_MOE_BEXP) + layer * 32;
    int* TOKE = (int*)(F.ws + WS_TOKE); float* TOKW = (float*)(F.ws + WS_TOKW);
    LAS int* lcnt = (LAS int*)(F.lds + LDSCTL_OFF + LC_MOE + 512); LAS int* gbase = (LAS int*)(F.lds + LDSCTL_OFF + LC_MOE + 640);
    const int lane = F.lane; const int per = NTOK / F.G;
    LAS int* lasg = (LAS int*)(F.lds + RING_OFF);
    if (F.tid < 32) lcnt[F.tid] = 0;
    __syncthreads();
    for (int tl = F.wave; tl < per; tl += NWAVES) {
        const int m = F.bid * per + tl;
        const f32x4* xr = (const f32x4*)(H + (size_t)m * DM) + lane; f32x4 v[4]; float s = 0.f;
#pragma unroll
        for (int q = 0; q < 4; ++q) { v[q] = xr[64 * q]; s += (v[q].x * v[q].x + v[q].y * v[q].y) + (v[q].z * v[q].z + v[q].w * v[q].w); }
        const float r = 1.0f / sqrtf(wave_sum(s) * (1.f / 1024.f) + RMS_EPS);
        unsigned long long* o8 = (unsigned long long*)(ABF + (size_t)m * DM) + lane;
#pragma unroll
        for (int q = 0; q < 4; ++q) { const f32x4 g = ((const f32x4*)gain + lane)[64 * q]; v[q].x *= r * g.x; v[q].y *= r * g.y; v[q].z *= r * g.z; v[q].w *= r * g.w;
            o8[64 * q] = (unsigned long long)pk2(v[q].x, v[q].y) | ((unsigned long long)pk2(v[q].z, v[q].w) << 32); }
        float lg[4] = {0.f, 0.f, 0.f, 0.f};
#pragma unroll
        for (int q = 0; q < 4; ++q) { const int k0 = 4 * lane + 256 * q;
#pragma unroll
            for (int e = 0; e < 4; ++e) { const f32x4 w = *(const f32x4*)(wgr + (size_t)(k0 + e) * 4); const float x = v[q][e]; lg[0] += x * w.x; lg[1] += x * w.y; lg[2] += x * w.z; lg[3] += x * w.w; } }
#pragma unroll
        for (int g = 0; g < 4; ++g) lg[g] = wave_sum(lg[g]) + bgr[g];
        int gi = 0; float gm = lg[0];
#pragma unroll
        for (int g = 1; g < 4; ++g) if (lg[g] > gm) { gm = lg[g]; gi = g; }
        float gden = 0.f;
#pragma unroll
        for (int g = 0; g < 4; ++g) gden += expf(lg[g] - gm);
        const float gw_ = 1.0f / gden;
        float le[8] = {0.f, 0.f, 0.f, 0.f, 0.f, 0.f, 0.f, 0.f};
#pragma unroll
        for (int q = 0; q < 4; ++q) { const int k0 = 4 * lane + 256 * q;
#pragma unroll
            for (int e = 0; e < 4; ++e) { const float* wp = wex + (size_t)(k0 + e) * 32 + gi * 8; const f32x4 w0 = *(const f32x4*)wp, w1 = *(const f32x4*)(wp + 4); const float x = v[q][e];
                le[0] += x * w0.x; le[1] += x * w0.y; le[2] += x * w0.z; le[3] += x * w0.w; le[4] += x * w1.x; le[5] += x * w1.y; le[6] += x * w1.z; le[7] += x * w1.w; } }
#pragma unroll
        for (int e = 0; e < 8; ++e) le[e] = wave_sum(le[e]) + bex[gi * 8 + e];
        int i0 = 0; float m0 = le[0];
#pragma unroll
        for (int e = 1; e < 8; ++e) if (le[e] > m0) { m0 = le[e]; i0 = e; }
        int i1 = -1; float m1 = -3.0e38f;
#pragma unroll
        for (int e = 0; e < 8; ++e) if (e != i0 && le[e] > m1) { m1 = le[e]; i1 = e; }
        const float e1 = expf(m1 - m0); const float w0 = gw_ / (1.0f + e1), w1 = gw_ * e1 / (1.0f + e1);
        if (lane == 0 && !dry) { const int ea = gi * 8 + i0, eb = gi * 8 + i1;
            const int pa = __hip_atomic_fetch_add(lcnt + ea, 1, __ATOMIC_RELAXED, __HIP_MEMORY_SCOPE_WORKGROUP), pb = __hip_atomic_fetch_add(lcnt + eb, 1, __ATOMIC_RELAXED, __HIP_MEMORY_SCOPE_WORKGROUP);
            lasg[tl * 2] = ea | (pa << 8); lasg[tl * 2 + 1] = eb | (pb << 8);
            TOKW[(size_t)m * 2] = w0; TOKW[(size_t)m * 2 + 1] = w1; }
    }
    __syncthreads();
    if (dry) return;
    if (F.tid < 32) gbase[F.tid] = (int)__hip_atomic_fetch_add(F.ctl + CW_CNT + 64 * layer + F.tid, (unsigned)lcnt[F.tid], __ATOMIC_RELAXED, __HIP_MEMORY_SCOPE_AGENT);
    __syncthreads();
    for (int i = F.tid; i < per * 2; i += 512) { const int a = lasg[i], e = a & 255, lp = a >> 8; TOKE[(size_t)F.bid * per * 2 + i] = e | ((gbase[e] + lp) << 8); }
    __syncthreads();
}
__device__ __forceinline__ void moe_tables(Frame& F, int layer) {
    LAS int* rowbase = (LAS int*)(F.lds + LDSCTL_OFF + LC_MOE); LAS unsigned char* tile_e = (LAS unsigned char*)(F.lds + LDSCTL_OFF + LC_MOE + 192);
    if (F.tid == 0) { int rb = 0;
#pragma unroll 1
        for (int e = 0; e < 32; ++e) { const int c = (int)__hip_atomic_load(F.ctl + CW_CNT + 64 * layer + e, __ATOMIC_RELAXED, __HIP_MEMORY_SCOPE_AGENT); rowbase[e] = rb; const int nt = (c + 255) >> 8;
            for (int i = 0; i < nt; ++i) tile_e[(rb >> 8) + i] = (unsigned char)e; rb += nt << 8; }
        rowbase[32] = rb; rowbase[34] = rb >> 8; }
    __syncthreads();
}
__device__ __forceinline__ void phase_moe_scatter(Frame& F, int layer) {
    moe_tables(F, layer);
    const LAS int* rowbase = (const LAS int*)(F.lds + LDSCTL_OFF + LC_MOE);
    const bf16* ABF = (const bf16*)(F.ws + WS_ABF); bf16* XG = (bf16*)(F.ws + WS_XG); const int* TOKE = (const int*)(F.ws + WS_TOKE); int* ROWS = (int*)(F.ws + WS_ROWS);
    const int gw = F.bid * NWAVES + F.wave, NGW = F.G * NWAVES, lane = F.lane;
    for (int m = gw; m < NTOK; m += NGW) {
        const v4u a = *((const v4u*)(ABF + (size_t)m * DM) + lane), b = *((const v4u*)(ABF + (size_t)m * DM) + 64 + lane);
#pragma unroll
        for (int k = 0; k < 2; ++k) { const int te = TOKE[(size_t)m * 2 + k]; const int row = rowbase[te & 255] + (te >> 8);
            *((v4u*)(XG + (size_t)row * DM) + lane) = a; *((v4u*)(XG + (size_t)row * DM) + 64 + lane) = b;
            if (lane == 0) ROWS[(size_t)m * 2 + k] = row; }
    }
}
struct MoeOrder {
    int ntiles, nN, G, c; const LAS unsigned char* tile_e; size_t bstride;
    __device__ bool next(int i, pg8::Unit& u) const { const long L = (long)i * G + c; if (L >= (long)ntiles * nN) return false; u.pm = (int)(L / nN); u.pn = (int)(L % nN); u.aux = __builtin_amdgcn_readfirstlane((int)tile_e[u.pm]); return true; }
    __device__ __forceinline__ const char* a_base(const pg8::Gemm& g, const pg8::Unit& u) const { return (const char*)g.A + (size_t)u.pm * 256 * g.lda * 2; }
    __device__ __forceinline__ const char* b_base(const pg8::Gemm& g, const pg8::Unit& u) const { return (const char*)g.Bt + (size_t)u.aux * bstride + (size_t)u.pn * 256 * g.ldb * 2; }
};
__device__ __forceinline__ void phase_moe_combine(Frame& F, int layer, bool dry = false) {
    float* H = kout(); float* Ho = dry ? (float*)(F.ws + WS_DUMMY) : H; bf16* ABF = (bf16*)(F.ws + WS_ABF); const bf16* Y2 = (const bf16*)(F.ws + WS_Y2);
    const int* ROWS = (const int*)(F.ws + WS_ROWS); const float* TOKW = (const float*)(F.ws + WS_TOKW); const float* gain = kin(I_PLE_NORM) + layer * DM;
    const int gw = F.bid * NWAVES + F.wave, NGW = F.G * NWAVES, lane = F.lane;
    for (int m = gw; m < NTOK; m += NGW) {
        const int r0 = ROWS[(size_t)m * 2], r1 = ROWS[(size_t)m * 2 + 1]; const float w0 = TOKW[(size_t)m * 2], w1 = TOKW[(size_t)m * 2 + 1];
        f32x4* hr = (f32x4*)(H + (size_t)m * DM) + lane; f32x4* ho = (f32x4*)(Ho + (size_t)m * DM) + lane; f32x4 v[4]; float s = 0.f;
#pragma unroll
        for (int q = 0; q < 4; ++q) { v[q] = hr[64 * q]; const v2u ya = *((const v2u*)(Y2 + (size_t)r0 * DM) + lane + 64 * q), yb = *((const v2u*)(Y2 + (size_t)r1 * DM) + lane + 64 * q);
            v[q].x += w0 * bflo(ya.x) + w1 * bflo(yb.x); v[q].y += w0 * bfhi(ya.x) + w1 * bfhi(yb.x); v[q].z += w0 * bflo(ya.y) + w1 * bflo(yb.y); v[q].w += w0 * bfhi(ya.y) + w1 * bfhi(yb.y);
            ho[64 * q] = v[q]; s += (v[q].x * v[q].x + v[q].y * v[q].y) + (v[q].z * v[q].z + v[q].w * v[q].w); }
        const float r = 1.0f / sqrtf(wave_sum(s) * (1.f / 1024.f) + RMS_EPS);
        unsigned long long* o8 = (unsigned long long*)(ABF + (size_t)m * DM) + lane;
#pragma unroll
        for (int q = 0; q < 4; ++q) { const f32x4 g = ((const f32x4*)gain + lane)[64 * q];
            o8[64 * q] = (unsigned long long)pk2(v[q].x * r * g.x, v[q].y * r * g.y) | ((unsigned long long)pk2(v[q].z * r * g.z, v[q].w * r * g.w) << 32); }
    }
}
namespace att {
using bf16x8 = __attribute__((ext_vector_type(8))) short;
using s16x4 = __attribute__((ext_vector_type(4))) short;
using f32x16 = __attribute__((ext_vector_type(16))) float;
using u32x4 = __attribute__((ext_vector_type(4))) unsigned;
typedef float f32x2_t __attribute__((ext_vector_type(2))); typedef __bf16 bf16x2_t __attribute__((ext_vector_type(2)));
constexpr int KSLOT = 16384, VSLOT = 8192;
constexpr int L_K = 0, L_V = 2 * KSLOT, L_B = L_V + 2 * VSLOT, L_WS = L_B + 512, L_OST = L_WS + 8 * 256, L_BYTES = L_OST + 8 * 4096;
__device__ __forceinline__ int crow(int r, int hi) { return (r & 3) + 8 * (r >> 2) + 4 * hi; }
__device__ __forceinline__ void glds16(const void* gsrc, unsigned lds_dst) { unsigned keep;
    asm volatile("s_mov_b32 %0, m0\n\ts_mov_b32 m0, %2\n\ts_nop 0\n\tglobal_load_lds_dwordx4 %1, off\n\ts_mov_b32 m0, %0" : "=&s"(keep) : "v"(gsrc), "s"(lds_dst) : "memory"); }
__device__ __forceinline__ unsigned cvtpk(float lo, float hi) { f32x2_t v = {lo, hi}; bf16x2_t b = __builtin_convertvector(v, bf16x2_t); return __builtin_bit_cast(unsigned, b); }
#define ATT_WAIT_BAR() asm volatile("s_waitcnt vmcnt(0) lgkmcnt(0)\n\ts_barrier" ::: "memory")

template <int DK, bool BIAS>
__device__ __forceinline__ void attn_unit(const int tid, const int qb, const bf16* Qh, const int qp, const bf16* Kh, const int kp, const bf16* Vh, const int vp, const float* cumh  , bf16* Oh  , char* shm, const float skip_margin  ) {
    constexpr int ND = DK / 16, KCH = DK / 8;
    const int lane = tid & 63, r32 = lane & 31, hi = lane >> 5; const int wid = __builtin_amdgcn_readfirstlane(tid >> 6);
    const int q0 = qb * 256;
    const unsigned lds0 = (unsigned)(uintptr_t)shm;
    float* wsf = (float*)(shm + L_WS) + wid * 64;
    float* Bs = (float*)(shm + L_B);
    const bf16* ksrc = Kh + (size_t)lane * kp + wid * 8;
    const bf16* vsrc = Vh + (size_t)(16 * (wid & 3) + (lane >> 2)) * vp + (wid >> 2) * 32 + (lane & 3) * 8;
    const unsigned kdst = lds0 + L_K + wid * 1024, vdst = lds0 + L_V + wid * 1024;
    const int NT = (q0 + 256) / 64;
    const float cref = BIAS ? cumh[(size_t)q0 * 8] : 0.f;
    int T0 = 0;
    if (BIAS) { for (int base = 0; base < NT; base += 64) { const int tq = base + lane; bool ok = false;
            if (tq < NT) ok = ((cref - cumh[(size_t)(64 * tq + 63) * 8]) * 1.4426950408889634f + skip_margin >= -150.0f);
            const unsigned long long mk = __ballot(ok); if (mk) { T0 = base + (int)__builtin_ctzll(mk); break; } T0 = NT - 4; }
        T0 = __builtin_amdgcn_readfirstlane(T0); if (T0 > NT - 4) T0 = NT - 4; if (T0 & 1) T0 -= 1; }
#define ATT_DMA(t, slot) do { glds16(ksrc + (size_t)(t) * 64 * kp, (unsigned)__builtin_amdgcn_readfirstlane(kdst + (slot) * KSLOT)); \
        if (KCH > 8) glds16(ksrc + (size_t)(t) * 64 * kp + 64, (unsigned)__builtin_amdgcn_readfirstlane(kdst + (slot) * KSLOT + 8192)); \
        glds16(vsrc + (size_t)(t) * 64 * vp, (unsigned)__builtin_amdgcn_readfirstlane(vdst + (slot) * VSLOT)); } while (0)
    ATT_DMA(T0, 0);
    if (BIAS && wid == 0) Bs[lane] = (cref - cumh[(size_t)(T0 * 64 + lane) * 8]) * 1.4426950408889634f;
    bf16x8 qr[ND];
#pragma unroll
    for (int d0 = 0; d0 < ND; ++d0) qr[d0] = *reinterpret_cast<const bf16x8*>(Qh + (size_t)(q0 + wid * 32 + r32) * qp + d0 * 16 + hi * 8);
    float mhat = 0.f, l_reg = 0.f; f32x16 o[2]; o[0] = f32x16{}; o[1] = f32x16{}; f32x16 negm = f32x16{};
    const int qrel = wid * 32 + r32;
    const int vb0 = (int)(lds0 + L_V) + ((lane >> 4) & 1) * 32 + (lane & 3) * 8 + (4 * hi + ((lane & 15) >> 2)) * 64;
    ATT_WAIT_BAR();
    for (int t = T0; t < NT; ++t) {
        const int cur = t & 1;
        float bnext = 0.f;
        if (t + 1 < NT) { ATT_DMA(t + 1, cur ^ 1); if (BIAS && wid == 0) bnext = cumh[(size_t)((t + 1) * 64 + lane) * 8]; }
        f32x16 p0, p1;
        { const char* kb = shm + L_K + cur * KSLOT + hi * 1024 + r32 * 16;
#pragma unroll
          for (int d0 = 0; d0 < ND; ++d0) { const bf16x8 b0 = *reinterpret_cast<const bf16x8*>(kb + d0 * 2048); const bf16x8 b1 = *reinterpret_cast<const bf16x8*>(kb + d0 * 2048 + 512);
            if (d0 == 0) { p0 = __builtin_amdgcn_mfma_f32_32x32x16_bf16(b0, qr[0], negm, 0, 0, 0); p1 = __builtin_amdgcn_mfma_f32_32x32x16_bf16(b1, qr[0], negm, 0, 0, 0); }
            else { p0 = __builtin_amdgcn_mfma_f32_32x32x16_bf16(b0, qr[d0], p0, 0, 0, 0); p1 = __builtin_amdgcn_mfma_f32_32x32x16_bf16(b1, qr[d0], p1, 0, 0, 0); } } }
        if (BIAS) { const float* bb = Bs + cur * 64 + 4 * hi;
#pragma unroll
            for (int g = 0; g < 4; ++g) { const f32x4 x0 = *(const f32x4*)(bb + 8 * g), x1 = *(const f32x4*)(bb + 32 + 8 * g);
#pragma unroll
                for (int e = 0; e < 4; ++e) { p0[4 * g + e] += x0[e]; p1[4 * g + e] += x1[e]; } } }
        if (t >= NT - 4) { const int kb0 = 64 * (t - (NT - 4)) + 4 * hi;
#pragma unroll
            for (int r = 0; r < 16; ++r) { const int kv = kb0 + (r & 3) + 8 * (r >> 2); if (kv > qrel) p0[r] = -INFINITY; if (kv + 32 > qrel) p1[r] = -INFINITY; } }
        float rm = fmaxf(p0[0], p1[0]);
#pragma unroll
        for (int r = 1; r < 16; ++r) rm = fmaxf(rm, fmaxf(p0[r], p1[r]));
        { auto rr = __builtin_amdgcn_permlane32_swap(__float_as_uint(rm), __float_as_uint(rm), false, false); rm = fmaxf(__uint_as_float(rr[0]), __uint_as_float(rr[1])); }
        bool resc = false;
        if (t == T0) { mhat = rm;
#pragma unroll
            for (int r = 0; r < 16; ++r) { p0[r] -= rm; p1[r] -= rm; }
#pragma unroll
            for (int r = 0; r < 16; ++r) negm[r] = -mhat;
        } else if (__any(rm > 8.0f)) { const float dl = fmaxf(rm, 0.f); mhat += dl;
#pragma unroll
            for (int r = 0; r < 16; ++r) { p0[r] -= dl; p1[r] -= dl; }
#pragma unroll
            for (int r = 0; r < 16; ++r) negm[r] = -mhat;
            const float f = __builtin_amdgcn_exp2f(-dl); l_reg *= f; if (hi == 0) wsf[r32] = f; resc = true; }
        float sacc = 0.f;
#pragma unroll
        for (int r = 0; r < 16; ++r) { p0[r] = __builtin_amdgcn_exp2f(p0[r]); p1[r] = __builtin_amdgcn_exp2f(p1[r]); sacc += p0[r] + p1[r]; }
        l_reg += sacc;
        u32x4 pw0, pw1, pw2, pw3;
        pw0 = (u32x4){cvtpk(p0[0], p0[1]), cvtpk(p0[2], p0[3]), cvtpk(p0[4], p0[5]), cvtpk(p0[6], p0[7])}; pw1 = (u32x4){cvtpk(p0[8], p0[9]), cvtpk(p0[10], p0[11]), cvtpk(p0[12], p0[13]), cvtpk(p0[14], p0[15])};
        pw2 = (u32x4){cvtpk(p1[0], p1[1]), cvtpk(p1[2], p1[3]), cvtpk(p1[4], p1[5]), cvtpk(p1[6], p1[7])}; pw3 = (u32x4){cvtpk(p1[8], p1[9]), cvtpk(p1[10], p1[11]), cvtpk(p1[12], p1[13]), cvtpk(p1[14], p1[15])};
        if (resc) { asm volatile("s_waitcnt lgkmcnt(0)" ::: "memory");
#pragma unroll
            for (int d_ = 0; d_ < 2; ++d_)
#pragma unroll
                for (int r = 0; r < 16; ++r) o[d_][r] *= wsf[crow(r, hi)]; }
        { const int vb = vb0 + cur * VSLOT;
#pragma unroll
          for (int d0 = 0; d0 < 2; ++d0) { s16x4 lo[4], hh[4];
#pragma unroll
            for (int ks = 0; ks < 4; ++ks) {
                asm volatile("ds_read_b64_tr_b16 %0,%1 offset:%c2" : "=&v"(lo[ks]) : "v"(vb), "i"(d0 * 4096 + ks * 1024) : "memory");
                asm volatile("ds_read_b64_tr_b16 %0,%1 offset:%c2" : "=&v"(hh[ks]) : "v"(vb), "i"(d0 * 4096 + ks * 1024 + 512) : "memory"); }
            asm volatile("s_waitcnt lgkmcnt(0)" ::: "memory"); __builtin_amdgcn_sched_barrier(0);
#define ATT_PK(k) (bf16x8){lo[k][0], lo[k][1], lo[k][2], lo[k][3], hh[k][0], hh[k][1], hh[k][2], hh[k][3]}
            o[d0] = __builtin_amdgcn_mfma_f32_32x32x16_bf16(__builtin_bit_cast(bf16x8, pw0), ATT_PK(0), o[d0], 0, 0, 0);
            o[d0] = __builtin_amdgcn_mfma_f32_32x32x16_bf16(__builtin_bit_cast(bf16x8, pw1), ATT_PK(1), o[d0], 0, 0, 0);
            o[d0] = __builtin_amdgcn_mfma_f32_32x32x16_bf16(__builtin_bit_cast(bf16x8, pw2), ATT_PK(2), o[d0], 0, 0, 0);
            o[d0] = __builtin_amdgcn_mfma_f32_32x32x16_bf16(__builtin_bit_cast(bf16x8, pw3), ATT_PK(3), o[d0], 0, 0, 0);
#undef ATT_PK
          } }
        if (BIAS && wid == 0 && t + 1 < NT) Bs[(cur ^ 1) * 64 + lane] = (cref - bnext) * 1.4426950408889634f;
        ATT_WAIT_BAR();
    }
    { auto rr = __builtin_amdgcn_permlane32_swap(__float_as_uint(l_reg), __float_as_uint(l_reg), false, false); l_reg = __uint_as_float(rr[0]) + __uint_as_float(rr[1]); }
    if (hi == 0) wsf[32 + r32] = l_reg; asm volatile("s_waitcnt lgkmcnt(0)" ::: "memory");
    float rli[16];
#pragma unroll
    for (int r = 0; r < 16; ++r) rli[r] = __builtin_amdgcn_rcpf(wsf[32 + crow(r, hi)]);
    bf16* Ow = Oh + (size_t)(q0 + wid * 32) * DM;
    { bf16* stg = (bf16*)(shm + L_OST) + wid * 2048;
#pragma unroll
      for (int r = 0; r < 16; ++r) { const int orow = crow(r, hi);
#pragma unroll
        for (int d0 = 0; d0 < 2; ++d0) stg[orow * 64 + d0 * 32 + r32] = (bf16)f2bf(o[d0][r] * rli[r]); }
      asm volatile("s_waitcnt lgkmcnt(0)" ::: "memory");
#pragma unroll
      for (int i = 0; i < 4; ++i) { const int row = i * 8 + (lane >> 3), ch = lane & 7; const u32x4 v = *(const u32x4*)(stg + row * 64 + ch * 8); *(u32x4*)(Ow + (size_t)row * DM + ch * 8) = v; } }
    asm volatile("s_waitcnt lgkmcnt(0)\n\ts_barrier" ::: "memory");
#undef ATT_DMA
}
}

constexpr int CW_AQ = 2048;
__device__ __forceinline__ void phase_attn_mfma(Frame& F, int j) {
    const bf16* PROJ = (const bf16*)(F.ws + WS_PROJ); const bf16* QM = (const bf16*)(F.ws + WS_QM); const bf16* KVB = (const bf16*)(F.ws + WS_KVB); const bf16* KM = (const bf16*)(F.ws + WS_KM);
    const float* CUM = (const float*)(F.ws + WS_CUM); bf16* MIX = (bf16*)(F.ws + WS_MIX);
    char* shm = (char*)(F.lds + RING_OFF);
    const int vcu = (F.G % 8 == 0) ? (F.bid % 8) * (F.G / 8) + F.bid / 8 : F.bid;
#pragma unroll 1
    for (int p = vcu; p < 512; p += F.G) { const int combo = p >> 5, s = p & 31, b = combo >> 3, h = combo & 7; const size_t rb = (size_t)b * SEQ;
#pragma unroll 1
        for (int half = 0; half < 2; ++half) { const int qb = half ? 63 - s : s;
            att::attn_unit<96, false>(F.tid, qb, QM + rb * 768 + h * 96, 768, KM + rb * 768 + h * 96, 768, KVB + rb * 1024 + h * 128 + 64, 1024, nullptr, MIX + rb * DM + 512 + h * 64, shm, 0.f); } }
    float gq = fabsf(kin(I_FOX_QN)[j * 64 + F.lane]), gk = fabsf(kin(I_FOX_KN)[j * 64 + F.lane]);
#pragma unroll
    for (int o = 1; o < 64; o <<= 1) { gq = fmaxf(gq, __shfl_xor(gq, o)); gk = fmaxf(gk, __shfl_xor(gk, o)); }
    const float margin = 2.0f * 1.02f * 64.0f * gq * gk * C2_FOX;
    LAS int* qslot = (LAS int*)(F.lds + LDSCTL_OFF + 64);
#pragma unroll 1
    for (;;) {
        if (F.tid == 0) *qslot = (int)__hip_atomic_fetch_add(F.ctl + CW_AQ + 64 * j, 1u, __ATOMIC_RELAXED, __HIP_MEMORY_SCOPE_AGENT);
        __syncthreads(); const int u = __builtin_amdgcn_readfirstlane(*qslot); __syncthreads();
        if (u >= 1024) break;
        const int qb = 63 - (u >> 4), combo = u & 15, b = combo >> 3, h = combo & 7; const size_t rb = (size_t)b * SEQ;
        att::attn_unit<64, true>(F.tid, qb, PROJ + rb * EVEN_INP + E_FQ + h * 64, EVEN_INP, PROJ + rb * EVEN_INP + E_FK + h * 64, EVEN_INP, PROJ + rb * EVEN_INP + E_FV + h * 64, EVEN_INP, CUM + rb * 8 + h, MIX + rb * DM + h * 64, shm, margin);
    }
}
constexpr size_t WS_S5_MT = WS_Y2;
constexpr size_t WS_S5_PT = WS_S5_MT + 72 * MiB;
constexpr size_t WS_S5_AX = WS_S5_PT + 16 * MiB;
constexpr size_t WS_S5_XLOC = WS_S5_AX + 36 * MiB;
static_assert(WS_S5_XLOC + 8 * MiB <= WS_Y2 + 144 * MiB, "s5 overlay");

__device__ __forceinline__ void s5_build(Frame& F, int j) {
    if (F.bid >= 256) return;
    const int g = F.bid >> 3, part = F.bid & 7, tid = F.tid, lane = F.lane, wave = F.wave;
    LAS float* pwr = (LAS float*)(F.lds + RING_OFF);
    LAS float* pwi = pwr + 65 * 64;
    LAS float* bbr = pwi + 65 * 64;
    LAS float* bbi = bbr + 1024;
    LAS float* crs = bbi + 1024;
    LAS float* cis = crs + 1024;
    LAS bf16* ktab = (LAS bf16*)(cis + 1024);
    const float dt = expf(kin(I_S5_LS)[j * 32 + g]);
    const float* are = kin(I_S5_ARE) + (size_t)(j * 32 + g) * 64; const float* aim = kin(I_S5_AIM) + (size_t)(j * 32 + g) * 64;
    for (int e = tid; e < 65 * 64; e += 512) { const int d = e >> 6, p = e & 63; const float lr = fminf(are[p], -1e-4f), li = aim[p];
        const float mag = expf(lr * dt * (float)d); float sn, cs; sincosf(li * dt * (float)d, &sn, &cs); pwr[e] = mag * cs; pwi[e] = mag * sn; }
    for (int e = tid; e < 1024; e += 512) { const int p = e >> 4, c = e & 15; const float lr = fminf(are[p], -1e-4f), li = aim[p];
        const float mag = expf(lr * dt); float sn, cs; sincosf(li * dt, &sn, &cs); const float abr = mag * cs, abi = mag * sn;
        const float den = lr * lr + li * li, nr = abr - 1.0f, ni = abi; const float gr = (nr * lr + ni * li) / den, gi = (ni * lr - nr * li) / den;
        const float br = kin(I_S5_BRE)[((size_t)(j * 32 + g) * 64 + p) * 16 + c], bi = kin(I_S5_BIM)[((size_t)(j * 32 + g) * 64 + p) * 16 + c];
        bbr[e] = gr * br - gi * bi; bbi[e] = gr * bi + gi * br; }
    for (int e = tid; e < 1024; e += 512) { crs[e] = kin(I_S5_CRE)[(size_t)(j * 32 + g) * 1024 + e]; cis[e] = kin(I_S5_CIM)[(size_t)(j * 32 + g) * 1024 + e]; }
    __syncthreads();
    { const int cc = tid >> 1, c = cc >> 4, c2 = cc & 15, ph = tid & 1;
      float er[32], ei[32];
#pragma unroll
      for (int pp = 0; pp < 32; ++pp) { const int p = 32 * ph + pp; const float xr = crs[c * 64 + p], xi = cis[c * 64 + p], yr = bbr[p * 16 + c2], yi = bbi[p * 16 + c2]; er[pp] = xr * yr - xi * yi; ei[pp] = xr * yi + xi * yr; }
#pragma unroll 1
      for (int d = 0; d < 64; ++d) { float s = 0.f; const LAS float* wr_ = pwr + d * 64 + 32 * ph; const LAS float* wi_ = pwi + d * 64 + 32 * ph;
#pragma unroll
          for (int pp = 0; pp < 32; ++pp) s += wr_[pp] * er[pp] - wi_[pp] * ei[pp];
          s += __shfl_xor(s, 1);
          if (ph == 0) ktab[(d * 16 + c) * 16 + c2] = (bf16)f2bf(s); } }
    __syncthreads();
    bf16* MT = (bf16*)(F.ws + WS_S5_MT) + (size_t)g * 1024 * 1152;
#pragma unroll 1
    for (int rr = wave; rr < 128; rr += 8) { const int i = part * 8 + (rr >> 4), c = rr & 15; bf16* row = MT + (size_t)(i * 16 + c) * 1152;
        v4u a = {0u, 0u, 0u, 0u}, b = {0u, 0u, 0u, 0u};
        if (lane <= i) { const LAS v4u* src = (const LAS v4u*)(ktab + ((i - lane) * 16 + c) * 16); a = src[0]; b = src[1]; }
        *(v4u*)(row + lane * 16) = a; *(v4u*)(row + lane * 16 + 8) = b;
        { const int p = lane; const float xr = crs[c * 64 + p], xi = cis[c * 64 + p], wr_ = pwr[(i + 1) * 64 + p], wi_ = pwi[(i + 1) * 64 + p];
          row[1024 + p] = (bf16)f2bf(xr * wr_ - xi * wi_); row[1088 + p] = (bf16)f2bf(-(xr * wi_ + xi * wr_)); } }
    bf16* PT = (bf16*)(F.ws + WS_S5_PT) + (size_t)g * 256 * 1024;
#pragma unroll 1
    for (int rr = wave; rr < 32; rr += 8) { const int n = part * 32 + rr; bf16* row = PT + (size_t)n * 1024 + lane * 16;
        unsigned o[8];
        if (n < 128) { const int p = n & 63, im = n >> 6; const float wr_ = pwr[(63 - lane) * 64 + p], wi_ = pwi[(63 - lane) * 64 + p];
#pragma unroll
            for (int q = 0; q < 8; ++q) { const float y0r = bbr[p * 16 + 2 * q], y0i = bbi[p * 16 + 2 * q], y1r = bbr[p * 16 + 2 * q + 1], y1i = bbi[p * 16 + 2 * q + 1];
                const float v0 = im ? (wr_ * y0i + wi_ * y0r) : (wr_ * y0r - wi_ * y0i), v1 = im ? (wr_ * y1i + wi_ * y1r) : (wr_ * y1r - wi_ * y1i); o[q] = pk2(v0, v1); }
        } else {
#pragma unroll
            for (int q = 0; q < 8; ++q) o[q] = 0u; }
        *(v4u*)row = (v4u){o[0], o[1], o[2], o[3]}; *(v4u*)(row + 8) = (v4u){o[4], o[5], o[6], o[7]}; }
    __syncthreads();
}
__device__ __forceinline__ void s5_repack(Frame& F) {
    const bf16* PROJ = (const bf16*)(F.ws + WS_PROJ); bf16* AX = (bf16*)(F.ws + WS_S5_AX);
    const int gt = F.bid * 512 + F.tid, NT = F.G * 512;
    for (int e = gt; e < NTOK * 32; e += NT) { const int m = e >> 5, g = e & 31; const int b = m / SEQ, t = m % SEQ, n = t >> 6, s = t & 63;
        const v4u* src = (const v4u*)(PROJ + (size_t)m * ODD_INP + O_U + g * 16); v4u* dst = (v4u*)(AX + ((size_t)g * 512 + b * 256 + n) * 1152 + s * 16);
        const v4u x0 = src[0], x1 = src[1]; dst[0] = x0; dst[1] = x1; }
}
struct S5POrder {
    int G, c;
    __device__ bool next(int i, pg8::Unit& u) const { const int L = i * G + c; if (L >= 64) return false; u.aux = L >> 1; u.pm = L & 1; u.pn = 0; return true; }
    __device__ __forceinline__ const char* a_base(const pg8::Gemm& g, const pg8::Unit& u) const { return (const char*)g.A + ((size_t)u.aux * 512 + u.pm * 256) * 1152 * 2; }
    __device__ __forceinline__ const char* b_base(const pg8::Gemm& g, const pg8::Unit& u) const { return (const char*)g.Bt + (size_t)u.aux * 256 * 1024 * 2; }
};
struct S5PEpi {
    static constexpr bool PERM = false;
    float* X;
    __device__ __forceinline__ void operator()(const pg8::f32x4 (&acc)[2][2][4][2], const pg8::Unit& u, int wr, int wc, int fr, int fq) const {
        const int row0 = u.pm * 256 + wr * 64 + fr; const int col0 = wc * 32 + 4 * fq;
#pragma unroll
        for (int ai = 0; ai < 2; ++ai)
#pragma unroll
            for (int m = 0; m < 4; ++m) { float* rowp = X + ((size_t)u.aux * 512 + row0 + ai * 128 + m * 16) * 128 + col0;
#pragma unroll
                for (int n = 0; n < 2; ++n) *(pg8::f32x4*)(rowp + n * 16) = acc[ai][0][m][n]; }
    }
};
__device__ __forceinline__ void s5_scan(Frame& F, int j) {
    const int gw = F.bid * NWAVES + F.wave; if (gw >= 64) return;
    const int g = gw >> 1, b = gw & 1, p = F.lane;
    const float lr = fminf(kin(I_S5_ARE)[(size_t)(j * 32 + g) * 64 + p], -1e-4f), li = kin(I_S5_AIM)[(size_t)(j * 32 + g) * 64 + p]; const float dt = expf(kin(I_S5_LS)[j * 32 + g]);
    const float mag = expf(lr * dt * 64.f); float sn, cs; sincosf(li * dt * 64.f, &sn, &cs); const float ar = mag * cs, ai = mag * sn;
    const float* X = (const float*)(F.ws + WS_S5_XLOC) + ((size_t)g * 512 + b * 256) * 128; bf16* AX = (bf16*)(F.ws + WS_S5_AX) + ((size_t)g * 512 + b * 256) * 1152 + 1024;
    float xr = 0.f, xi = 0.f; float cr[8], ci[8], nr[8], ni[8];
#pragma unroll
    for (int q = 0; q < 8; ++q) { cr[q] = X[(size_t)q * 128 + p]; ci[q] = X[(size_t)q * 128 + 64 + p]; }
    for (int n0 = 0; n0 < 256; n0 += 8) { const int nn = (n0 + 8 < 256) ? n0 + 8 : n0;
#pragma unroll
        for (int q = 0; q < 8; ++q) { nr[q] = X[(size_t)(nn + q) * 128 + p]; ni[q] = X[(size_t)(nn + q) * 128 + 64 + p]; }
#pragma unroll
        for (int q = 0; q < 8; ++q) { AX[(size_t)(n0 + q) * 1152 + p] = (bf16)f2bf(xr); AX[(size_t)(n0 + q) * 1152 + 64 + p] = (bf16)f2bf(xi);
            const float tr = ar * xr - ai * xi + cr[q], ti = ar * xi + ai * xr + ci[q]; xr = tr; xi = ti; }
#pragma unroll
        for (int q = 0; q < 8; ++q) { cr[q] = nr[q]; ci[q] = ni[q]; } }
}
struct S5MOrder {
    int G, c;
    __device__ bool next(int i, pg8::Unit& u) const { const int L = i * G + c; if (L >= 256) return false; u.aux = L >> 3; u.pm = (L >> 2) & 1; u.pn = L & 3; return true; }
    __device__ __forceinline__ const char* a_base(const pg8::Gemm& g, const pg8::Unit& u) const { return (const char*)g.A + ((size_t)u.aux * 512 + u.pm * 256) * 1152 * 2; }
    __device__ __forceinline__ const char* b_base(const pg8::Gemm& g, const pg8::Unit& u) const { return (const char*)g.Bt + ((size_t)u.aux * 1024 + u.pn * 256) * 1152 * 2; }
};
struct S5MEpi {
    static constexpr bool PERM = true;
    bf16* HG; const bf16* PROJ; const float* dsk;
    __device__ __forceinline__ void operator()(const pg8::f32x4 (&acc)[2][2][4][2], const pg8::Unit& u, int wr, int wc, int fr, int fq) const {
        const int g = u.aux; const int row0 = u.pm * 256 + wr * 64 + fr; const int col0 = u.pn * 256 + wc * 32 + 8 * fq;
        const pg8::f32x4 d0 = *(const pg8::f32x4*)(dsk + g * 16 + (col0 & 15)), d1 = *(const pg8::f32x4*)(dsk + g * 16 + (col0 & 15) + 4);
#pragma unroll
        for (int ai = 0; ai < 2; ++ai)
#pragma unroll
            for (int m = 0; m < 4; ++m) { const int rg = row0 + ai * 128 + m * 16; const int b = rg >> 8, n = rg & 255;
#pragma unroll
                for (int bj = 0; bj < 2; ++bj) { const int col = col0 + bj * 128; const int i = col >> 4, c0 = col & 15; const size_t tok = (size_t)b * SEQ + n * 64 + i;
                    const pg8::u32x4 uw = *(const pg8::u32x4*)(PROJ + tok * ODD_INP + O_U + g * 16 + c0); const pg8::f32x4 v0 = acc[ai][bj][m][0], v1 = acc[ai][bj][m][1];
                    pg8::u32x4 w; w.x = pk2(gelu_tanh(v0[0] + d0[0] * bflo(uw.x)), gelu_tanh(v0[1] + d0[1] * bfhi(uw.x))); w.y = pk2(gelu_tanh(v0[2] + d0[2] * bflo(uw.y)), gelu_tanh(v0[3] + d0[3] * bfhi(uw.y)));
                    w.z = pk2(gelu_tanh(v1[0] + d1[0] * bflo(uw.z)), gelu_tanh(v1[1] + d1[1] * bfhi(uw.z))); w.w = pk2(gelu_tanh(v1[2] + d1[2] * bflo(uw.w)), gelu_tanh(v1[3] + d1[3] * bfhi(uw.w)));
                    *(pg8::u32x4*)(HG + tok * 512 + g * 16 + c0) = w; } }
    }
};
namespace gdn {
typedef short s16x4 __attribute__((ext_vector_type(4)));
#define GDN_MFMA(a, b, c) __builtin_amdgcn_mfma_f32_16x16x16bf16_1k(a, b, c, 0, 0, 0)
__device__ __forceinline__ float fsig(float x) { return __builtin_amdgcn_rcpf(1.0f + __expf(-x)); }
__device__ __forceinline__ float bperm(float v, int src_lane) { return __int_as_float(__builtin_amdgcn_ds_bpermute(src_lane << 2, __float_as_int(v))); }
__device__ __forceinline__ s16x4 pack4(float a, float b, float c, float d) { v2u w; w.x = pk2(a, b); w.y = pk2(c, d); return __builtin_bit_cast(s16x4, w); }
constexpr int NITEM = BATCH * 4 * (SEQ / 16);
constexpr int IMG_STRIDE = 144;
constexpr int WAVE_LDS = 1024 + 1024 + 3 * 16 * IMG_STRIDE * 2;
}
constexpr size_t WS_GDN_UB = WS_QG;
constexpr size_t WS_GDN_WT = WS_KG;
constexpr size_t WS_GDN_QD = WS_KG + 32 * MiB;
constexpr size_t WS_GDN_KD = WS_VG;
constexpr size_t WS_GDN_IT = WS_VG + 32 * MiB;
constexpr size_t WS_GDN_EGL = WS_VG + 40 * MiB;

__device__ __forceinline__ void phase_gdn_g1(Frame& F, int j) {
    using namespace gdn;
    const bf16* PROJ = (const bf16*)(F.ws + WS_PROJ);
    const float* cw = kin(I_GDN_CONV) + (size_t)j * 4 * 1536;
    float* UB = (float*)(F.ws + WS_GDN_UB); bf16* WT = (bf16*)(F.ws + WS_GDN_WT); bf16* QD = (bf16*)(F.ws + WS_GDN_QD); bf16* KD = (bf16*)(F.ws + WS_GDN_KD); bf16* IT = (bf16*)(F.ws + WS_GDN_IT); float* EGL = (float*)(F.ws + WS_GDN_EGL);
    LAS float* Am = (LAS float*)(F.lds + RING_OFF + F.wave * WAVE_LDS); LAS float* Tm = Am + 256; LAS bf16* img = (LAS bf16*)(Tm + 256);
    const int gw = F.bid * NWAVES + F.wave, NGW = F.G * NWAVES;
#pragma unroll 1
    for (int item = gw; item < NITEM; item += NGW) {
        int lane = F.lane; asm volatile("" : "+v"(lane));
        const int tok = lane & 15, g4 = lane >> 4;
        const int b = item >> 12, h = (item >> 10) & 3, n = item & 1023; const int s0 = 16 * n + tok; const size_t m = (size_t)b * SEQ + s0;
        const size_t it = (size_t)item;
        const float gin = bf2f(PROJ[m * ODD_INP + O_GIN + h]), bin = bf2f(PROJ[m * ODD_INP + O_BETA + h]);
        const float gt = -expf(kin(I_GDN_ALOG)[j * 4 + h]) * softplusf_(gin + kin(I_GDN_DTB)[j * 4 + h]); const float beta = fsig(bin);
        float gc = gt;
#pragma unroll
        for (int off = 1; off < 16; off <<= 1) { const float t = bperm(gc, tok >= off ? lane - off : lane); if (tok >= off) gc += t; }
        const float glast = bperm(gc, lane | 15); const float eg = expf(gc), ekd = expf(glast - gc);
        LAS bf16* img2 = img + 16 * IMG_STRIDE; LAS bf16* img3 = img2 + 16 * IMG_STRIDE;
#define GDN_CONV(WSEL, X) do { _Pragma("unroll") for (int db = 0; db < 8; ++db) { const int ch = (WSEL) * 512 + h * 128 + 16 * db + 4 * g4; float a0 = 0.f, a1 = 0.f, a2 = 0.f, a3 = 0.f; \
            _Pragma("unroll") for (int tap = 0; tap < 4; ++tap) { if (s0 - 3 + tap >= 0) { const v2u x = *(const v2u*)(PROJ + (m - 3 + tap) * ODD_INP + O_Q + ch); const f32x4 wv = *(const f32x4*)(cw + tap * 1536 + ch); \
                a0 += wv.x * bflo(x.x); a1 += wv.y * bfhi(x.x); a2 += wv.z * bflo(x.y); a3 += wv.w * bfhi(x.y); } } \
            X[db][0] = a0 * fsig(a0); X[db][1] = a1 * fsig(a1); X[db][2] = a2 * fsig(a2); X[db][3] = a3 * fsig(a3); \
            if ((db & 3) == 3) asm volatile("" ::: "memory"); } } while (0)
        { float xv[8][4]; GDN_CONV(2, xv);
#pragma unroll
          for (int db = 0; db < 8; ++db) *(LAS s16x4*)(img + tok * IMG_STRIDE + 16 * db + 4 * g4) = pack4(xv[db][0] * beta, xv[db][1] * beta, xv[db][2] * beta, xv[db][3] * beta); }
        s16x4 Kf[8];
        { float xk[8][4]; GDN_CONV(1, xk); float sk = 0.f;
#pragma unroll
          for (int db = 0; db < 8; ++db)
#pragma unroll
              for (int e = 0; e < 4; ++e) sk += xk[db][e] * xk[db][e];
          sk += bperm(sk, lane ^ 16); sk += bperm(sk, lane ^ 32);
          const float rk = 1.0f / sqrtf(sk + RMS_EPS); const float s2 = rk * beta * eg, s3 = rk * ekd;
#pragma unroll
          for (int db = 0; db < 8; ++db) { const int o = tok * IMG_STRIDE + 16 * db + 4 * g4;
              *(LAS s16x4*)(img2 + o) = pack4(xk[db][0] * s2, xk[db][1] * s2, xk[db][2] * s2, xk[db][3] * s2);
              *(LAS s16x4*)(img3 + o) = pack4(xk[db][0] * s3, xk[db][1] * s3, xk[db][2] * s3, xk[db][3] * s3);
              Kf[db] = pack4(xk[db][0] * rk, xk[db][1] * rk, xk[db][2] * rk, xk[db][3] * rk); } }
        f32x4 Gacc = {0.f, 0.f, 0.f, 0.f}, Pacc = {0.f, 0.f, 0.f, 0.f};
        { float xqq[8][4]; GDN_CONV(0, xqq); float sq = 0.f;
#pragma unroll
          for (int db = 0; db < 8; ++db)
#pragma unroll
              for (int e = 0; e < 4; ++e) sq += xqq[db][e] * xqq[db][e];
          sq += bperm(sq, lane ^ 16); sq += bperm(sq, lane ^ 32);
          const float rq = (1.0f / sqrtf(sq + RMS_EPS)) * 0.08838834764831845f;
#pragma unroll
          for (int db = 0; db < 8; ++db) {
              *(s16x4*)(QD + ((it * 8 + db) * 64 + lane) * 4) = pack4(xqq[db][0] * rq * eg, xqq[db][1] * rq * eg, xqq[db][2] * rq * eg, xqq[db][3] * rq * eg);
              const s16x4 Qf = pack4(xqq[db][0] * rq, xqq[db][1] * rq, xqq[db][2] * rq, xqq[db][3] * rq);
              Gacc = GDN_MFMA(Kf[db], Kf[db], Gacc); Pacc = GDN_MFMA(Kf[db], Qf, Pacc); } }
#undef GDN_CONV
        { float itv[4];
#pragma unroll
          for (int r = 0; r < 4; ++r) { const int i = 4 * g4 + r; const float gci = bperm(gc, i), bi = bperm(beta, i);
              const float da = (tok < i) ? expf(gci - gc) : 0.f;
              Am[i * 16 + tok] = bi * Gacc[r] * da;
              const float dp = (i <= tok) ? expf(gc - gci) : 0.f;
              itv[r] = Pacc[r] * dp; }
          *(s16x4*)(IT + (it * 64 + lane) * 4) = pack4(itv[0], itv[1], itv[2], itv[3]); }
        if (lane == 0) EGL[it] = expf(glast);
        LDS_WAIT();
        float Tc[16];
#pragma unroll
        for (int i = 0; i < 16; ++i) { float s = (i == tok) ? 1.f : 0.f;
#pragma unroll
            for (int jj = 0; jj < i; ++jj) s -= Am[i * 16 + jj] * Tc[jj];
            Tc[i] = s; }
#pragma unroll
        for (int r = 0; r < 4; ++r) Tm[(4 * g4 + r) * 16 + tok] = (g4 == 0) ? Tc[r] : (g4 == 1) ? Tc[4 + r] : (g4 == 2) ? Tc[8 + r] : Tc[12 + r];
        LDS_WAIT();
        const f32x4 trow = *(const LAS f32x4*)(Tm + tok * 16 + 4 * g4);
        const s16x4 Tf = pack4(trow.x, trow.y, trow.z, trow.w);
        const int traddr = (int)(uintptr_t)img + ((4 * g4 + ((lane & 15) >> 2)) * IMG_STRIDE + 4 * (lane & 3)) * 2;
#pragma unroll
        for (int cb = 0; cb < 8; ++cb) { s16x4 vf; asm volatile("ds_read_b64_tr_b16 %0, %1 offset:%c2\n\ts_waitcnt lgkmcnt(0)" : "=&v"(vf) : "v"(traddr), "i"(cb * 32) : "memory");
            const f32x4 z = {0.f, 0.f, 0.f, 0.f}; const f32x4 u = GDN_MFMA(Tf, vf, z);
            *(f32x4*)(UB + ((it * 8 + cb) * 64 + lane) * 4) = u; }
#pragma unroll
        for (int db = 0; db < 8; ++db) { s16x4 kf; asm volatile("ds_read_b64_tr_b16 %0, %1 offset:%c2\n\ts_waitcnt lgkmcnt(0)" : "=&v"(kf) : "v"(traddr), "i"(16 * IMG_STRIDE * 2 + db * 32) : "memory");
            const f32x4 z = {0.f, 0.f, 0.f, 0.f}; const f32x4 w = GDN_MFMA(kf, Tf, z);
            *(s16x4*)(WT + ((it * 8 + db) * 64 + lane) * 4) = pack4(-w.x, -w.y, -w.z, -w.w); }
#pragma unroll
        for (int db = 0; db < 8; ++db) { s16x4 kf; asm volatile("ds_read_b64_tr_b16 %0, %1 offset:%c2\n\ts_waitcnt lgkmcnt(0)" : "=&v"(kf) : "v"(traddr), "i"(32 * IMG_STRIDE * 2 + db * 32) : "memory");
            *(s16x4*)(KD + ((it * 8 + db) * 64 + lane) * 4) = kf; }
        LDS_WAIT();
    }
}

__device__ __forceinline__ void phase_gdn_g2(Frame& F) {
    using namespace gdn;
    if (F.bid >= 64 || F.wave != 0) return;
    const float* UB = (const float*)(F.ws + WS_GDN_UB); const bf16* WT = (const bf16*)(F.ws + WS_GDN_WT); const bf16* QD = (const bf16*)(F.ws + WS_GDN_QD); const bf16* KD = (const bf16*)(F.ws + WS_GDN_KD);
    const bf16* IT = (const bf16*)(F.ws + WS_GDN_IT); const float* EGL = (const float*)(F.ws + WS_GDN_EGL); float* OG = (float*)(F.ws + WS_OG);
    const int lane = F.lane, bh = F.bid & 7, sl = F.bid >> 3, b = bh >> 2, h = bh & 3;
    f32x4 S[8];
#pragma unroll
    for (int db = 0; db < 8; ++db) S[db] = (f32x4){0.f, 0.f, 0.f, 0.f};
    const size_t it0 = (size_t)bh * 1024;
    f32x4 u_c, u_n; s16x4 wt_c[8], wt_n[8], qd_c[8], qd_n[8], kd_c[8], kd_n[8], it_c, it_n; float egl_c, egl_n;
#define GDN_LOAD(itx, U_, WT_, QD_, KD_, IT_, EG_) do { const size_t i_ = (itx); U_ = *(const f32x4*)(UB + ((i_ * 8 + sl) * 64 + lane) * 4); IT_ = *(const s16x4*)(IT + (i_ * 64 + lane) * 4); EG_ = EGL[i_]; \
        _Pragma("unroll") for (int db = 0; db < 8; ++db) { WT_[db] = *(const s16x4*)(WT + ((i_ * 8 + db) * 64 + lane) * 4); QD_[db] = *(const s16x4*)(QD + ((i_ * 8 + db) * 64 + lane) * 4); KD_[db] = *(const s16x4*)(KD + ((i_ * 8 + db) * 64 + lane) * 4); } } while (0)
    GDN_LOAD(it0, u_c, wt_c, qd_c, kd_c, it_c, egl_c);
#pragma unroll 1
    for (int n = 0; n < 1024; ++n) {
        const int nn = (n + 1 < 1024) ? n + 1 : n;
        GDN_LOAD(it0 + nn, u_n, wt_n, qd_n, kd_n, it_n, egl_n);
        s16x4 Sb[8];
#pragma unroll
        for (int db = 0; db < 8; ++db) Sb[db] = pack4(S[db].x, S[db].y, S[db].z, S[db].w);
        f32x4 va = u_c, vb2 = {0.f, 0.f, 0.f, 0.f};
#pragma unroll
        for (int db = 0; db < 8; db += 2) { va = GDN_MFMA(wt_c[db], Sb[db], va); vb2 = GDN_MFMA(wt_c[db + 1], Sb[db + 1], vb2); }
        va = va + vb2;
        const s16x4 vb = pack4(va.x, va.y, va.z, va.w);
        f32x4 oa = {0.f, 0.f, 0.f, 0.f}, ob = {0.f, 0.f, 0.f, 0.f};
        oa = GDN_MFMA(it_c, vb, oa);
#pragma unroll
        for (int db = 0; db < 8; db += 2) { oa = GDN_MFMA(qd_c[db], Sb[db], oa); ob = GDN_MFMA(qd_c[db + 1], Sb[db + 1], ob); }
        oa = oa + ob;
#pragma unroll
        for (int db = 0; db < 8; ++db) { const f32x4 sc = S[db] * egl_c; S[db] = GDN_MFMA(kd_c[db], vb, sc); }
        { float* op = OG + ((size_t)b * SEQ + 16 * n + 4 * (lane >> 4)) * 512 + h * 128 + 16 * sl + (lane & 15);
          op[0] = oa.x; op[512] = oa.y; op[1024] = oa.z; op[1536] = oa.w; }
        u_c = u_n; it_c = it_n; egl_c = egl_n;
#pragma unroll
        for (int db = 0; db < 8; ++db) { wt_c[db] = wt_n[db]; qd_c[db] = qd_n[db]; kd_c[db] = kd_n[db]; }
    }
#undef GDN_LOAD
}
constexpr int LSTEPS = 16;
constexpr int STEP_END = 1 + DEPTH * LSTEPS;
struct KArgs { Args a; int li, pad; };

#define FRAME Frame F; { int wv_ = wave0; asm volatile("" : "+s"(wv_)); int t_ = wv_ * 64 + (int)__builtin_amdgcn_mbcnt_hi(~0u, __builtin_amdgcn_mbcnt_lo(~0u, 0u)); asm volatile("" : "+v"(t_)); unsigned char* w_ = kws(); F.lds = lds0; F.ws = w_; F.ctl = (unsigned*)(w_ + WS_CTL); \
        F.tid = t_; F.lane = t_ & 63; F.wave = __builtin_amdgcn_readfirstlane(t_ >> 6); { int g_ = gridDim.x, b_ = blockIdx.x; asm volatile("" : "+s"(g_), "+s"(b_)); F.G = g_; F.bid = b_; } } unsigned char* const ws = F.ws; (void)ws
#ifndef PH_MASK
#define PH_MASK 0xffffffffu
#endif
#define EN(k) (((PH_MASK) >> (k)) & 1u)
#ifndef DUP_E
#define DUP_E 0u
#endif
#ifndef DUP_O
#define DUP_O 0u
#endif
#define NREP(s) ((((s) >= 1) && (((((((s) - 1) / LSTEPS) & 1) ? (DUP_O) : (DUP_E)) >> (((s) + LSTEPS - 1) % LSTEPS)) & 1u)) ? 2 : 1)
#define STEP(s) if (lo <= (s) && (s) < hi) for (int rep_ = 0; rep_ < NREP(s); ++rep_)
#define DRY(s) (NREP(s) == 2 && rep_ == 0)
#define ENDSTEP(s) do { if ((s) + 1 < hi) xcd_barrier(bar); } while (0)
#define LAUNDER_WS do {} while (0)


template <int layer> __device__ __forceinline__ void layer_body(const XcdBarrier& bar, const int lo, const int hi, LAS unsigned char* const lds0, const int wave0) {
        constexpr int sb = 1 + layer * LSTEPS, j = layer >> 1; constexpr bool even = (layer & 1) == 0;
        STEP(sb + 0) if constexpr (EN(0)) { FRAME;
            phase_norm(F, layer == 0 ? kin(I_X) : kout(), kin(I_NORM_MIX) + layer * DM, layer == 0 ? kout() : nullptr);
            moe_weights(F, layer); phase_pconv(F, layer);
            if constexpr (!even) { __syncthreads(); s5_build(F, j); }
            ENDSTEP(sb + 0);
        }
        STEP(sb + 1) if constexpr (EN(1)) { FRAME;
            { LAUNDER_WS; const int NP = even ? EVEN_INP : ODD_INP; const bf16* W = even ? (const bf16*)(ws + WS_W_EVIN) + (size_t)j * EVEN_INP * 1024 : (const bf16*)(ws + WS_W_ODIN) + (size_t)j * ODD_INP * 1024;
              pg8::Gemm g{(const bf16*)(ws + WS_ABF), W, 1024, 1024, 1024}; pg8::StaticOrder S; S.init(NTOK, NP, F.G, F.bid); pg8::EpiBf16 E{(bf16*)(ws + WS_PROJ), NP};
              pg8::gemm_phase<pg8::EpiBf16, pg8::StaticOrder>(F.lds + RING_OFF, g, S, E, F.tid); }
            { LAUNDER_WS; pg8::Gemm g{(const bf16*)(ws + WS_PBF), (const bf16*)(ws + WS_W_PLEP) + (size_t)layer * 1024 * 256, 256, 256, 256}; pg8::StaticOrder S; S.init(NTOK, 1024, F.G, F.bid); pg8::EpiBf16 E{(bf16*)(ws + WS_PP), 1024};
              pg8::gemm_phase<pg8::EpiBf16, pg8::StaticOrder>(F.lds + RING_OFF, g, S, E, F.tid); }
            ENDSTEP(sb + 1);
        }
        if constexpr (even) {
            STEP(sb + 2) if constexpr (EN(2)) { FRAME; phase_even_post(F, j, DRY(sb + 2)); ENDSTEP(sb + 2); }
            STEP(sb + 3) if constexpr (EN(3)) { FRAME;
#ifndef NO_QUP
                { LAUNDER_WS; pg8::Gemm g{(const bf16*)(ws + WS_CQN), (const bf16*)(ws + WS_W_QUP) + (size_t)j * 768 * 384, 384, 384, 384}; pg8::StaticOrder S; S.init(NTOK, 768, F.G, F.bid); pg8::EpiBf16 E{(bf16*)(ws + WS_QM), 768};
                  pg8::gemm_phase<pg8::EpiBf16, pg8::StaticOrder>(F.lds + RING_OFF, g, S, E, F.tid); }
#endif
#ifndef NO_KVUP
                { LAUNDER_WS; pg8::Gemm g{(const bf16*)(ws + WS_CKVN), (const bf16*)(ws + WS_W_KVUP) + (size_t)j * 1024 * 256, 256, 256, 256}; pg8::StaticOrder S; S.init(NTOK, 1024, F.G, F.bid); pg8::EpiBf16 E{(bf16*)(ws + WS_KVB), 1024};
                  pg8::gemm_phase<pg8::EpiBf16, pg8::StaticOrder>(F.lds + RING_OFF, g, S, E, F.tid); }
#endif
#ifndef NO_CUMSUM
                phase_cumsum(F);
#endif
                ENDSTEP(sb + 3);
            }
            STEP(sb + 4) if constexpr (EN(4)) { FRAME; phase_mla_post(F, j, DRY(sb + 4)); ENDSTEP(sb + 4); }
            STEP(sb + 5) if constexpr (EN(5)) { FRAME;
#ifdef ATTN_NAIVE
                phase_attn_naive(F);
#else
                phase_attn_mfma(F, j);
#endif
                ENDSTEP(sb + 5); }
        } else {
            STEP(sb + 2) if constexpr (EN(2)) { FRAME; s5_repack(F);
#ifdef GDN_NAIVE
                phase_gdn_prep(F, j);
#else
                phase_gdn_g1(F, j);
#endif
                ENDSTEP(sb + 2); }
            STEP(sb + 3) if constexpr (EN(3)) { FRAME;
                { pg8::Gemm g{(const bf16*)(ws + WS_S5_AX), (const bf16*)(ws + WS_S5_PT), 1024, 1152, 1024}; S5POrder S{F.G, F.bid}; S5PEpi E{(float*)(ws + WS_S5_XLOC)};
                  pg8::gemm_phase<S5PEpi, S5POrder>(F.lds + RING_OFF, g, S, E, F.tid); }
#ifdef GDN_NAIVE
                phase_gdn_naive(F);
#else
                phase_gdn_g2(F);
#endif
                ENDSTEP(sb + 3);
            }
            STEP(sb + 4) if constexpr (EN(4)) { FRAME; s5_scan(F, j); phase_gdn_out(F, j); ENDSTEP(sb + 4); }
            STEP(sb + 5) if constexpr (EN(5)) { FRAME;
                pg8::Gemm g{(const bf16*)(ws + WS_S5_AX), (const bf16*)(ws + WS_S5_MT), 1152, 1152, 1152}; S5MOrder S{F.G, F.bid}; S5MEpi E{(bf16*)(ws + WS_HG), (const bf16*)(ws + WS_PROJ), kin(I_S5_D) + j * 512};
                pg8::gemm_phase<S5MEpi, S5MOrder>(F.lds + RING_OFF, g, S, E, F.tid);
                ENDSTEP(sb + 5);
            }
            STEP(sb + 6) if constexpr (EN(6)) { FRAME;
                pg8::Gemm g{(const bf16*)(ws + WS_HG), (const bf16*)(ws + WS_W_GLU) + (size_t)j * 512 * 512, 512, 512, 512}; pg8::StaticOrder S; S.init(NTOK, 512, F.G, F.bid);
                pg8::EpiGlu E{(bf16*)(ws + WS_MIX), 1024, (const bf16*)(ws + WS_HG), 512, kin(I_S5_BGLU) + j * 512};
                pg8::gemm_phase<pg8::EpiGlu, pg8::StaticOrder>(F.lds + RING_OFF, g, S, E, F.tid);
                ENDSTEP(sb + 6);
            }
        }
        STEP(sb + 7) if constexpr (EN(7)) { FRAME;
            LAUNDER_WS; const bf16* W = even ? (const bf16*)(ws + WS_W_EVOUT) + (size_t)j * 1024 * 1024 : (const bf16*)(ws + WS_W_ODOUT) + (size_t)j * 1024 * 1024;
            pg8::Gemm g{(const bf16*)(ws + WS_MIX), W, 1024, 1024, 1024}; pg8::StaticOrder S; S.init(NTOK, 1024, F.G, F.bid); pg8::EpiResAdd E{DRY(sb + 7) ? (float*)(ws + WS_DUMMY) : kout(), 1024};
            pg8::gemm_phase<pg8::EpiResAdd, pg8::StaticOrder>(F.lds + RING_OFF, g, S, E, F.tid);
            ENDSTEP(sb + 7);
        }
        STEP(sb + 8) if constexpr (EN(8)) { FRAME; phase_router(F, layer, DRY(sb + 8)); ENDSTEP(sb + 8); }
        STEP(sb + 9) if constexpr (EN(9)) { FRAME; phase_moe_scatter(F, layer); ENDSTEP(sb + 9); }
        STEP(sb + 10) if constexpr (EN(10)) { FRAME;
            LAUNDER_WS; moe_tables(F, layer);
            const LAS int* rowbase = (const LAS int*)(F.lds + LDSCTL_OFF + LC_MOE);
            MoeOrder S{__builtin_amdgcn_readfirstlane(rowbase[34]), 4, F.G, F.bid, (const LAS unsigned char*)(F.lds + LDSCTL_OFF + LC_MOE + 192), (size_t)1024 * 1024 * 2};
            pg8::Gemm g{(const bf16*)(ws + WS_XG), (const bf16*)(ws + WS_W_MOEGU), 1024, 1024, 1024}; pg8::EpiSwiglu E{(bf16*)(ws + WS_HB), 512};
            pg8::gemm_phase<pg8::EpiSwiglu, MoeOrder>(F.lds + RING_OFF, g, S, E, F.tid);
            ENDSTEP(sb + 10);
        }
        STEP(sb + 11) if constexpr (EN(11)) { FRAME;
            LAUNDER_WS; moe_tables(F, layer);
            const LAS int* rowbase = (const LAS int*)(F.lds + LDSCTL_OFF + LC_MOE);
            MoeOrder S{__builtin_amdgcn_readfirstlane(rowbase[34]), 4, F.G, F.bid, (const LAS unsigned char*)(F.lds + LDSCTL_OFF + LC_MOE + 192), (size_t)1024 * 512 * 2};
            pg8::Gemm g{(const bf16*)(ws + WS_HB), (const bf16*)(ws + WS_W_MOED), 512, 512, 512}; pg8::EpiBf16 E{(bf16*)(ws + WS_Y2), 1024};
            pg8::gemm_phase<pg8::EpiBf16, MoeOrder>(F.lds + RING_OFF, g, S, E, F.tid);
            ENDSTEP(sb + 11);
        }
        STEP(sb + 12) if constexpr (EN(12)) { FRAME; phase_moe_combine(F, layer, DRY(sb + 12)); ENDSTEP(sb + 12); }
        STEP(sb + 13) if constexpr (EN(13)) { FRAME;
            LAUNDER_WS; pg8::Gemm g{(const bf16*)(ws + WS_ABF), (const bf16*)(ws + WS_W_PLEG) + (size_t)layer * 1024 * 1024, 1024, 1024, 1024}; pg8::StaticOrder S; S.init(NTOK, 1024, F.G, F.bid);
            pg8::EpiPle E{DRY(sb + 13) ? (float*)(ws + WS_DUMMY) : kout(), (const bf16*)(ws + WS_PP), kin(I_PLE_BG) + layer * DM, 1024};
            pg8::gemm_phase<pg8::EpiPle, pg8::StaticOrder>(F.lds + RING_OFF, g, S, E, F.tid);
            ENDSTEP(sb + 13);
        }
    }
__global__ void __launch_bounds__(NWAVES * 64, 2) mega_fwd(KArgs ka) {
    extern __shared__ __attribute__((aligned(16))) unsigned char lds_raw[];
    const Args& args = ka.a;
    LAS unsigned char* const lds0 = (LAS unsigned char*)lds_raw;
    const int wave0 = __builtin_amdgcn_readfirstlane((int)threadIdx.x >> 6);
    for (int u = threadIdx.x; u < (LDS_BYTES - LDSCTL_OFF) / 4; u += NWAVES * 64) ((LAS unsigned*)(lds0 + LDSCTL_OFF))[u] = 0u;
    __syncthreads();
    XcdBarrier bar = xcd_barrier_post((unsigned*)(kws() + WS_CTL) + CW_BAR + ka.li * XCD_BAR_WORDS, (volatile LAS unsigned*)(lds0 + LDSCTL_OFF + LC_BARST));
    const int lo = args.ph_lo, hi = args.ph_hi;
    STEP(0) if constexpr (EN(15)) { FRAME; prologue_weights(F); ENDSTEP(0); }
    layer_body<0>(bar, lo, hi, lds0, wave0); layer_body<1>(bar, lo, hi, lds0, wave0); layer_body<2>(bar, lo, hi, lds0, wave0); layer_body<3>(bar, lo, hi, lds0, wave0);
#undef STEP
#undef ENDSTEP
}

#ifndef MK_MODE
#define MK_MODE 0
#endif
extern "C" void kernel_launch(void* const* d_in, const int* in_sizes, int n_in, void* d_out, int out_size, void* d_ws, size_t ws_size, hipStream_t stream) {
    static int ready = 0;
    if (ready == 0) {
        if (n_in != N_IN || out_size != NTOK * DM || ws_size < WS_END) { fprintf(stderr, "kernel_launch: unexpected shapes n_in %d out %d ws %zu (need %zu)\n", n_in, out_size, ws_size, (size_t)WS_END); ready = -1; return; }
        if (hipFuncSetAttribute((const void*)mega_fwd, hipFuncAttributeMaxDynamicSharedMemorySize, LDS_BYTES) != hipSuccess) { fprintf(stderr, "kernel_launch: hipFuncSetAttribute failed\n"); ready = -1; return; }
        int per_cu = 0; (void)hipOccupancyMaxActiveBlocksPerMultiprocessor(&per_cu, (const void*)mega_fwd, NWAVES * 64, LDS_BYTES); (void)hipGetLastError();
        ready = 1;
    }
    if (ready < 0) return;
    (void)hipMemsetAsync((char*)d_ws + WS_CTL, 0, CTL_ZERO_BYTES, stream);
    KArgs ka{};
    for (int i = 0; i < N_IN; ++i) ka.a.in[i] = (const float*)d_in[i];
    ka.a.out = (float*)d_out; ka.a.ws = (unsigned char*)d_ws; ka.li = 0; ka.pad = 0;
    const int grid = 256;
#if MK_MODE == 1
    ka.a.ph_lo = 0; ka.a.ph_hi = STEP_END;
    hipLaunchKernelGGL(mega_fwd, dim3(grid), dim3(NWAVES * 64), LDS_BYTES, stream, ka);
#else
    for (int s = 0; s < STEP_END; ++s) {
        if (s > 0) { const int k = (s - 1) % LSTEPS, layer = (s - 1) / LSTEPS; const bool even = (layer & 1) == 0;
            if (k > 13) continue; if (k == 6 && even) continue; }
        ka.a.ph_lo = s; ka.a.ph_hi = s + 1;
        hipLaunchKernelGGL(mega_fwd, dim3(grid), dim3(NWAVES * 64), LDS_BYTES, stream, ka);
    }
#endif
}
```

```cpp
#include <hip/hip_runtime.h>
#include <cstdio>
#include <cstdint>
#define MK_MODE 1
namespace pg8 {
#define PG8_LAS __attribute__((address_space(3)))
typedef unsigned short bf16_t;
typedef short bf16x8 __attribute__((ext_vector_type(8)));
typedef float f32x4 __attribute__((ext_vector_type(4)));
typedef float f32x2 __attribute__((ext_vector_type(2)));
typedef unsigned u32x4 __attribute__((ext_vector_type(4)));
typedef unsigned u32x2 __attribute__((ext_vector_type(2)));
constexpr int BM = 256, BK = 64, HALF = 128, HTB = HALF * BK * 2  , STAGE_BYTES = 8 * HTB, NXCD = 8, WGM = 8;

__host__ __device__ __forceinline__ int lds_byte(int r, int c) { const int st = (r >> 4) * 2 + (c >> 5), rr = r & 15, cc = c & 31, ob = rr * 64 + cc * 2; return st * 1024 + (ob ^ (((ob >> 9) & 1) << 5)); }
__host__ __device__ __forceinline__ void stage_rc(int b, int& R, int& C) { const int st = b / 1024, sb = b % 1024, swz = sb ^ (((sb >> 9) & 1) << 5); R = (st >> 1) * 16 + swz / 64; C = (st & 1) * 32 + (swz % 64) / 2; }
__host__ __device__ __forceinline__ int perm32(int rho) { const int n = rho >> 4, i = rho & 15; return 8 * (i >> 2) + 4 * n + (i & 3); }

struct Unit { int pm, pn, aux; };
struct Gemm { const bf16_t* A; const bf16_t* Bt; int K, lda, ldb; };

struct StaticOrder {
    int nM, nN, nwg, G, c;
    __device__ void init(int M, int N, int G_, int c_) { nM = M / BM; nN = N / BM; nwg = nM * nN; G = G_; c = c_; }
    __device__ bool next(int i, Unit& u) const {
        const long L = (long)i * G + c; if (L >= nwg) return false;
        int wgid = (int)L; { const int q = nwg / NXCD, r = nwg % NXCD, xcd = wgid % NXCD, off = wgid / NXCD; wgid = (xcd < r ? xcd * (q + 1) : r * (q + 1) + (xcd - r) * q) + off; }
        const int nig = WGM * nN, gid = wgid / nig, fm = gid * WGM, gsz = (nM - fm) < WGM ? (nM - fm) : WGM;
        u.pm = fm + ((wgid % nig) % gsz); u.pn = (wgid % nig) / gsz; u.aux = 0; return true;
    }
    __device__ __forceinline__ const char* a_base(const Gemm& g, const Unit& u) const { return (const char*)g.A + (size_t)u.pm * BM * g.lda * 2; }
    __device__ __forceinline__ const char* b_base(const Gemm& g, const Unit& u) const { return (const char*)g.Bt + (size_t)u.pn * BM * g.ldb * 2; }
};

__device__ __forceinline__ unsigned cvt_pk_bf16(float lo, float hi) { unsigned r; asm volatile("v_cvt_pk_bf16_f32 %0, %1, %2" : "=v"(r) : "v"(lo), "v"(hi)); return r; }
__device__ __forceinline__ float bf_lo(unsigned w) { return __uint_as_float(w << 16); }
__device__ __forceinline__ float bf_hi(unsigned w) { return __uint_as_float(w & 0xffff0000u); }

struct EpiBf16 {
    static constexpr bool PERM = true;
    bf16_t* O; int ldc;
    __device__ __forceinline__ void operator()(const f32x4 (&acc)[2][2][4][2], const Unit& u, int wr, int wc, int fr, int fq) const {
        const int row0 = u.pm * BM + wr * 64 + fr; const int col0 = u.pn * BM + wc * 32 + 8 * fq;
#pragma unroll
        for (int ai = 0; ai < 2; ++ai)
#pragma unroll
            for (int m = 0; m < 4; ++m) { bf16_t* rowp = O + (size_t)(row0 + ai * HALF + m * 16) * ldc + col0;
#pragma unroll
                for (int bj = 0; bj < 2; ++bj) { const f32x4 v0 = acc[ai][bj][m][0], v1 = acc[ai][bj][m][1];
                    u32x4 w; w.x = cvt_pk_bf16(v0[0], v0[1]); w.y = cvt_pk_bf16(v0[2], v0[3]); w.z = cvt_pk_bf16(v1[0], v1[1]); w.w = cvt_pk_bf16(v1[2], v1[3]);
                    *(u32x4*)(rowp + bj * HALF) = w; } }
    }
};
struct EpiResAdd {
    static constexpr bool PERM = false;
    float* H; int ldc;
    __device__ __forceinline__ void operator()(const f32x4 (&acc)[2][2][4][2], const Unit& u, int wr, int wc, int fr, int fq) const {
        const int row0 = u.pm * BM + wr * 64 + fr; const int col0 = u.pn * BM + wc * 32 + 4 * fq;
#pragma unroll
        for (int ai = 0; ai < 2; ++ai)
#pragma unroll
            for (int m = 0; m < 4; ++m) { float* rowp = H + (size_t)(row0 + ai * HALF + m * 16) * ldc + col0;
#pragma unroll
                for (int bj = 0; bj < 2; ++bj)
#pragma unroll
                    for (int n = 0; n < 2; ++n) { f32x4* p = (f32x4*)(rowp + bj * HALF + n * 16); *p = *p + acc[ai][bj][m][n]; } }
    }
};
__device__ __forceinline__ float sigmoidf_(float x) { return 1.0f / (1.0f + __expf(-x)); }
struct EpiPle {
    static constexpr bool PERM = false;
    float* H; const bf16_t* PP; const float* bias; int ldc;
    __device__ __forceinline__ void operator()(const f32x4 (&acc)[2][2][4][2], const Unit& u, int wr, int wc, int fr, int fq) const {
        const int row0 = u.pm * BM + wr * 64 + fr; const int col0 = u.pn * BM + wc * 32 + 4 * fq;
#pragma unroll
        for (int ai = 0; ai < 2; ++ai)
#pragma unroll
            for (int m = 0; m < 4; ++m) { const size_t ro = (size_t)(row0 + ai * HALF + m * 16) * ldc + col0;
#pragma unroll
                for (int bj = 0; bj < 2; ++bj)
#pragma unroll
                    for (int n = 0; n < 2; ++n) { const int co = bj * HALF + n * 16; f32x4* p = (f32x4*)(H + ro + co); const u32x2 pw = *(const u32x2*)(PP + ro + co);
                        const f32x4 bv = *(const f32x4*)(bias + col0 + co); const f32x4 a = acc[ai][bj][m][n] + bv; f32x4 h = *p;
                        h[0] += sigmoidf_(a[0]) * bf_lo(pw.x); h[1] += sigmoidf_(a[1]) * bf_hi(pw.x); h[2] += sigmoidf_(a[2]) * bf_lo(pw.y); h[3] += sigmoidf_(a[3]) * bf_hi(pw.y); *p = h; } }
    }
};
struct EpiGlu {
    static constexpr bool PERM = true;
    bf16_t* O; int ldo; const bf16_t* HG; int ldh; const float* bias;
    __device__ __forceinline__ void operator()(const f32x4 (&acc)[2][2][4][2], const Unit& u, int wr, int wc, int fr, int fq) const {
        const int row0 = u.pm * BM + wr * 64 + fr; const int col0 = u.pn * BM + wc * 32 + 8 * fq;
#pragma unroll
        for (int ai = 0; ai < 2; ++ai)
#pragma unroll
            for (int m = 0; m < 4; ++m) { const size_t r = (size_t)(row0 + ai * HALF + m * 16);
#pragma unroll
                for (int bj = 0; bj < 2; ++bj) { const int c = col0 + bj * HALF; const u32x4 hw = *(const u32x4*)(HG + r * ldh + c);
                    const f32x4 b0 = *(const f32x4*)(bias + c), b1 = *(const f32x4*)(bias + c + 4); const f32x4 v0 = acc[ai][bj][m][0] + b0, v1 = acc[ai][bj][m][1] + b1;
                    u32x4 w; w.x = cvt_pk_bf16(bf_lo(hw.x) * sigmoidf_(v0[0]), bf_hi(hw.x) * sigmoidf_(v0[1])); w.y = cvt_pk_bf16(bf_lo(hw.y) * sigmoidf_(v0[2]), bf_hi(hw.y) * sigmoidf_(v0[3]));
                    w.z = cvt_pk_bf16(bf_lo(hw.z) * sigmoidf_(v1[0]), bf_hi(hw.z) * sigmoidf_(v1[1])); w.w = cvt_pk_bf16(bf_lo(hw.w) * sigmoidf_(v1[2]), bf_hi(hw.w) * sigmoidf_(v1[3]));
                    *(u32x4*)(O + r * ldo + c) = w; } }
    }
};
struct EpiSwiglu {
    static constexpr bool PERM = true;
    bf16_t* HB; int ldc;
    __device__ __forceinline__ void operator()(const f32x4 (&acc)[2][2][4][2], const Unit& u, int wr, int wc, int fr, int fq) const {
        const int row0 = u.pm * BM + wr * 64 + fr; const int col0 = u.pn * HALF + wc * 32 + 8 * fq;
#pragma unroll
        for (int ai = 0; ai < 2; ++ai)
#pragma unroll
            for (int m = 0; m < 4; ++m) { bf16_t* rowp = HB + (size_t)(row0 + ai * HALF + m * 16) * ldc + col0;
                const f32x4 g0 = acc[ai][0][m][0], g1 = acc[ai][0][m][1], u0 = acc[ai][1][m][0], u1 = acc[ai][1][m][1];
                u32x4 w; w.x = cvt_pk_bf16(g0[0] * sigmoidf_(g0[0]) * u0[0], g0[1] * sigmoidf_(g0[1]) * u0[1]); w.y = cvt_pk_bf16(g0[2] * sigmoidf_(g0[2]) * u0[2], g0[3] * sigmoidf_(g0[3]) * u0[3]);
                w.z = cvt_pk_bf16(g1[0] * sigmoidf_(g1[0]) * u1[0], g1[1] * sigmoidf_(g1[1]) * u1[1]); w.w = cvt_pk_bf16(g1[2] * sigmoidf_(g1[2]) * u1[2], g1[3] * sigmoidf_(g1[3]) * u1[3]);
                *(u32x4*)rowp = w; }
    }
};

template <class Epi, class Sched, bool ALIGN_EPI = true, bool SP2 = true>
__device__ __forceinline__ void gemm_phase(PG8_LAS unsigned char* lds, const Gemm g, const Sched& S, const Epi& E, const int tid) {
    const int wid = __builtin_amdgcn_readfirstlane(tid >> 6), lane = tid & 63, wr = wid >> 2, wc = wid & 3, fr = lane & 15, fq = lane >> 4;
    int K = g.K; asm volatile("" : "+s"(K));
    const int nt = K / BK;
    unsigned voffA[2], voffB[2];
#pragma unroll
    for (int i = 0; i < 2; ++i) { int R, C; stage_rc(tid * 16 + i * 8192, R, C); const int Rb = Epi::PERM ? ((R & ~31) + perm32(R & 31)) : R;
        voffA[i] = (unsigned)(R * g.lda + C) * 2u; voffB[i] = (unsigned)(Rb * g.ldb + C) * 2u; }
    const size_t kstep = (size_t)(BK * 2);
    const size_t hstepA = (size_t)HALF * g.lda * 2, hstepB = (size_t)HALF * g.ldb * 2;
    const unsigned ldsw = (unsigned)wid * 1024u;
    const int aoff = lds_byte(wr * 64 + fr, fq * 8), boff = lds_byte(wc * 32 + fr, fq * 8);
#define PG8_SA(b, h) (((b) * 2 + (h)) * HTB)
#define PG8_SB(b, h) ((4 + (b) * 2 + (h)) * HTB)
#define PG8_STAGE(bufoff, gbase, voff) do { _Pragma("unroll") for (int _i = 0; _i < 2; ++_i) \
        __builtin_amdgcn_global_load_lds((const unsigned*)((const char*)(gbase) + (voff)[_i]), (PG8_LAS unsigned*)(lds + (bufoff) + ldsw + _i * 8192), 16, 0, 0); } while (0)
#define PG8_LDA(dst, b, h) do { _Pragma("unroll") for (int m = 0; m < 4; ++m) _Pragma("unroll") for (int k = 0; k < 2; ++k) dst[m][k] = *(const PG8_LAS bf16x8*)(lds + PG8_SA(b, h) + aoff + m * 2048 + k * 1024); } while (0)
#define PG8_LDB(dst, b, h) do { _Pragma("unroll") for (int n = 0; n < 2; ++n) _Pragma("unroll") for (int k = 0; k < 2; ++k) dst[n][k] = *(const PG8_LAS bf16x8*)(lds + PG8_SB(b, h) + boff + n * 2048 + k * 1024); } while (0)
#define PG8_MMA(ai, bj, At, Bt) do { __builtin_amdgcn_s_setprio(1); _Pragma("unroll") for (int m = 0; m < 4; ++m) _Pragma("unroll") for (int n = 0; n < 2; ++n) _Pragma("unroll") for (int k = 0; k < 2; ++k) \
        acc[ai][bj][m][n] = __builtin_amdgcn_mfma_f32_16x16x32_bf16(Bt[n][k], At[m][k], acc[ai][bj][m][n], 0, 0, 0); __builtin_amdgcn_s_setprio(0); } while (0)
#define PG8_WAIT_V(n) asm volatile("s_waitcnt vmcnt(" #n ")" ::: "memory")
#define PG8_WAIT_L(n) asm volatile("s_waitcnt lgkmcnt(" #n ")" ::: "memory")
#define PG8_BAR __builtin_amdgcn_s_barrier()
#define PG8_SCHED __builtin_amdgcn_sched_barrier(0)
    Unit cur, nxt; int ui = 0;
    if (!S.next(0, cur)) return;
    f32x4 acc[2][2][4][2];
#pragma unroll
    for (int a = 0; a < 2; ++a)
#pragma unroll
        for (int b = 0; b < 2; ++b)
#pragma unroll
            for (int m = 0; m < 4; ++m)
#pragma unroll
                for (int n = 0; n < 2; ++n) acc[a][b][m][n] = (f32x4){0.f, 0.f, 0.f, 0.f};
    bf16x8 At[4][2], B0[2][2], B1[2][2];
    const char* cA = S.a_base(g, cur); const char* cB = S.b_base(g, cur);
    if constexpr (SP2) {
        PG8_STAGE(PG8_SB(0, 0), cB, voffB); PG8_STAGE(PG8_SB(0, 1), cB + hstepB, voffB); PG8_STAGE(PG8_SA(0, 0), cA, voffA); PG8_STAGE(PG8_SA(0, 1), cA + hstepA, voffA);
        if (wr == 1) PG8_BAR;
        PG8_WAIT_V(2); PG8_BAR;
        PG8_STAGE(PG8_SB(1, 0), cB + kstep, voffB); PG8_STAGE(PG8_SA(1, 0), cA + kstep, voffA); PG8_STAGE(PG8_SB(1, 1), cB + hstepB + kstep, voffB);
        PG8_WAIT_V(6); PG8_BAR;
    } else {
        PG8_STAGE(PG8_SB(0, 0), cB, voffB); PG8_STAGE(PG8_SA(0, 0), cA, voffA); PG8_STAGE(PG8_SB(0, 1), cB + hstepB, voffB); PG8_STAGE(PG8_SA(0, 1), cA + hstepA, voffA);
        if (wr == 1) PG8_BAR;
        PG8_WAIT_V(4); PG8_BAR;
        PG8_STAGE(PG8_SB(1, 0), cB + kstep, voffB); PG8_STAGE(PG8_SA(1, 0), cA + kstep, voffA); PG8_STAGE(PG8_SB(1, 1), cB + hstepB + kstep, voffB);
        PG8_WAIT_V(6); PG8_BAR;
    }
    for (;;) {
        const bool has_next = S.next(ui + 1, nxt);
        const char* nA = has_next ? S.a_base(g, nxt) : cA; const char* nB = has_next ? S.b_base(g, nxt) : cB;
        for (int t = 0; t < nt; t += 2) {
            const bool last = (t == nt - 2);
            const char* a1 = cA + (size_t)(t + 1) * kstep;
            const char* a2 = last ? nA : cA + (size_t)(t + 2) * kstep; const char* b2 = last ? nB : cB + (size_t)(t + 2) * kstep;
            const char* a3 = a2 + kstep; const char* b3 = b2 + kstep;
            if constexpr (SP2) {
            PG8_LDB(B0, 0, 0); PG8_LDB(B1, 0, 1); PG8_SCHED; PG8_LDA(At, 0, 0); PG8_STAGE(PG8_SA(1, 1), a1 + hstepA, voffA);
            PG8_WAIT_V(8); PG8_WAIT_L(0); PG8_BAR; PG8_MMA(0, 0, At, B0); PG8_MMA(0, 1, At, B1); PG8_BAR; PG8_SCHED;
            PG8_LDA(At, 0, 1); PG8_STAGE(PG8_SB(0, 0), b2, voffB); PG8_STAGE(PG8_SB(0, 1), b2 + hstepB, voffB); PG8_STAGE(PG8_SA(0, 0), a2, voffA);
            PG8_WAIT_V(8); PG8_WAIT_L(0); PG8_BAR; PG8_MMA(1, 0, At, B0); PG8_MMA(1, 1, At, B1); PG8_BAR; PG8_SCHED;
            PG8_LDB(B0, 1, 0); PG8_LDB(B1, 1, 1); PG8_SCHED; PG8_LDA(At, 1, 0); PG8_STAGE(PG8_SA(0, 1), a2 + hstepA, voffA);
            PG8_WAIT_V(8); PG8_WAIT_L(0); PG8_BAR; PG8_MMA(0, 0, At, B0); PG8_MMA(0, 1, At, B1); PG8_BAR; PG8_SCHED;
            PG8_LDA(At, 1, 1); PG8_STAGE(PG8_SB(1, 0), b3, voffB); PG8_STAGE(PG8_SB(1, 1), b3 + hstepB, voffB); PG8_STAGE(PG8_SA(1, 0), a3, voffA);
            PG8_WAIT_V(8); PG8_WAIT_L(0); PG8_BAR; PG8_MMA(1, 0, At, B0); PG8_MMA(1, 1, At, B1); PG8_BAR; PG8_SCHED;
            } else {
            PG8_LDB(B0, 0, 0); PG8_SCHED; PG8_LDA(At, 0, 0); PG8_STAGE(PG8_SA(1, 1), a1 + hstepA, voffA);
            PG8_WAIT_L(8); PG8_BAR; PG8_WAIT_L(0); PG8_MMA(0, 0, At, B0); PG8_BAR; PG8_SCHED;
            PG8_LDB(B1, 0, 1); PG8_STAGE(PG8_SB(0, 0), b2, voffB);
            PG8_BAR; PG8_WAIT_L(0); PG8_MMA(0, 1, At, B1); PG8_BAR;
            PG8_LDA(At, 0, 1); PG8_STAGE(PG8_SA(0, 0), a2, voffA);
            PG8_BAR; PG8_WAIT_L(0); PG8_MMA(1, 0, At, B0); PG8_BAR; PG8_SCHED;
            PG8_STAGE(PG8_SB(0, 1), b2 + hstepB, voffB);
            PG8_WAIT_V(6); PG8_BAR; PG8_MMA(1, 1, At, B1); PG8_BAR;
            PG8_LDB(B0, 1, 0); PG8_SCHED; PG8_LDA(At, 1, 0); PG8_STAGE(PG8_SA(0, 1), a2 + hstepA, voffA);
            PG8_WAIT_L(8); PG8_BAR; PG8_WAIT_L(0); PG8_MMA(0, 0, At, B0); PG8_BAR; PG8_SCHED;
            PG8_LDB(B1, 1, 1); PG8_STAGE(PG8_SB(1, 0), b3, voffB);
            PG8_BAR; PG8_WAIT_L(0); PG8_MMA(0, 1, At, B1); PG8_BAR;
            PG8_LDA(At, 1, 1); PG8_STAGE(PG8_SA(1, 0), a3, voffA);
            PG8_BAR; PG8_WAIT_L(0); PG8_MMA(1, 0, At, B0); PG8_BAR; PG8_SCHED;
            PG8_STAGE(PG8_SB(1, 1), b3 + hstepB, voffB);
            PG8_WAIT_V(6); PG8_BAR; PG8_MMA(1, 1, At, B1); PG8_BAR;
            }
        }
        if constexpr (ALIGN_EPI) { if (wr == 0) PG8_BAR; }
        E(acc, cur, wr, wc, fr, fq);
        if (!has_next) break;
#pragma unroll
        for (int a = 0; a < 2; ++a)
#pragma unroll
            for (int b = 0; b < 2; ++b)
#pragma unroll
                for (int m = 0; m < 4; ++m)
#pragma unroll
                    for (int n = 0; n < 2; ++n) acc[a][b][m][n] = (f32x4){0.f, 0.f, 0.f, 0.f};
        cur = nxt; cA = nA; cB = nB; ++ui;
        if constexpr (ALIGN_EPI) { if (wr == 1) PG8_BAR; }
    }
    PG8_WAIT_V(0);
    if constexpr (!ALIGN_EPI) { if (wr == 0) PG8_BAR; }
    PG8_BAR;
#undef PG8_SA
#undef PG8_SB
#undef PG8_STAGE
#undef PG8_LDA
#undef PG8_LDB
#undef PG8_MMA
#undef PG8_WAIT_V
#undef PG8_WAIT_L
#undef PG8_BAR
#undef PG8_SCHED
}
}
#define LAS __attribute__((address_space(3)))
#define XB_TMO      128
#define XB_XCNT(j)  (256  + 64 * (j))
#define XB_XSUB(j)  (1280 + 64 * (j))
#define XB_XGEN(j)  (2304 + 64 * (j))
#define XB_TOP      3328
#define XB_TOPGEN   3392
#define XCD_BAR_WORDS 3456
#define XB_SPIN_CAP (1u << 22)

__device__ __forceinline__ unsigned xb_ld(unsigned* p)              { return __hip_atomic_load(p, __ATOMIC_RELAXED, __HIP_MEMORY_SCOPE_AGENT); }
__device__ __forceinline__ unsigned xb_add(unsigned* p, unsigned v) { return __hip_atomic_fetch_add(p, v, __ATOMIC_RELAXED, __HIP_MEMORY_SCOPE_AGENT); }
__device__ __forceinline__ unsigned xb_xcc_id() { return (unsigned)__builtin_amdgcn_s_getreg((3 << 11) | 20) & 0xFu; }
#define XB_SPIN(cond, bar) do { unsigned _sp = 0; while (cond) { __builtin_amdgcn_s_sleep(1); \
    if ((++_sp & 255u) == 0u) { if (xb_ld(&(bar)[XB_TMO])) break; if (_sp > XB_SPIN_CAP) { atomicAdd(&(bar)[XB_TMO], 1u); break; } } } } while (0)

struct XcdBarrier {
    unsigned* bar; unsigned x;
    volatile LAS unsigned* st;
};

__device__ __forceinline__ XcdBarrier xcd_barrier_post(unsigned* bar, volatile LAS unsigned* st) {
    XcdBarrier b; b.bar = bar; b.x = xb_xcc_id(); b.st = st;
    if (threadIdx.x == 0) (void)xb_add(&bar[XB_XCNT(b.x)], 1u);
    return b;
}
__device__ __forceinline__ void xcd_barrier_complete(unsigned* bar, unsigned x, unsigned& nloc, unsigned& nx) {
    const unsigned G = gridDim.x * gridDim.y * gridDim.z;
    unsigned sum, cnt, mine, sp = 0u;
    for (;;) {
        sum = 0u; cnt = 0u; mine = 0u;
#pragma unroll
        for (unsigned j = 0; j < 16; ++j) { const unsigned c = xb_ld(&bar[XB_XCNT(j)]); sum += c; cnt += (c > 0u) ? 1u : 0u; mine = (j == x) ? c : mine; }
        if (sum == G) break;
        __builtin_amdgcn_s_sleep(1);
        if ((++sp & 255u) == 0u) { if (xb_ld(&bar[XB_TMO])) break; if (sp > XB_SPIN_CAP) { atomicAdd(&bar[XB_TMO], 1u); break; } }
    }
    nloc = mine > 0u ? mine : 1u; nx = cnt > 0u ? cnt : 1u;
}

__device__ __forceinline__ void xcd_barrier(const XcdBarrier& b) {
    asm volatile("s_waitcnt vmcnt(0)" ::: "memory");
    __syncthreads();
    if (threadIdx.x == 0) {
        unsigned* bar = b.bar;
        __builtin_amdgcn_s_waitcnt(0);
        unsigned nloc = b.st[0], nx = b.st[1];
        if (nloc == 0u) { xcd_barrier_complete(bar, b.x, nloc, nx); b.st[0] = nloc; b.st[1] = nx; }
        const unsigned old = xb_add(&bar[XB_XSUB(b.x)], 1u);
        const unsigned gen = old / nloc;
        if (old + 1u == (gen + 1u) * nloc) {
            __builtin_amdgcn_fence(__ATOMIC_RELEASE, "agent");
            asm volatile("s_waitcnt vmcnt(0)" ::: "memory");
            const unsigned og = xb_add(&bar[XB_TOP], 1u);
            const unsigned tg = og / nx;
            if (og + 1u == (tg + 1u) * nx) xb_add(&bar[XB_TOPGEN], 1u);
            else XB_SPIN(xb_ld(&bar[XB_TOPGEN]) == tg, bar);
            __builtin_amdgcn_fence(__ATOMIC_ACQUIRE, "agent");
            xb_add(&bar[XB_XGEN(b.x)], 1u);
            asm volatile("s_waitcnt vmcnt(0)" ::: "memory");
        } else {
            XB_SPIN(xb_ld(&bar[XB_XGEN(b.x)]) == gen, bar);
            __builtin_amdgcn_fence(__ATOMIC_ACQUIRE, "agent");
            asm volatile("s_waitcnt vmcnt(0)" ::: "memory");
        }
    }
    __syncthreads();
}
#undef LAS
constexpr int NWAVES = 8;
constexpr int BATCH = 2, SEQ = 16384, NTOK = BATCH * SEQ, DM = 1024, DEPTH = 4, PLE = 256;
constexpr int EVEN_IN = 2216, EVEN_INP = 2304, ODD_IN = 2568, ODD_INP = 2816;
constexpr int E_FQ = 0, E_FK = 512, E_FV = 1024, E_FLOG = 1536, E_CQ = 1544, E_CKV = 1928, E_KROPE = 2184;
constexpr int O_U = 0, O_Q = 512, O_K = 1024, O_V = 1536, O_GIN = 2048, O_BETA = 2052, O_Z = 2056;
constexpr float RMS_EPS = 1e-6f;
constexpr float LOG2E = 1.4426950408889634f, LN2 = 0.6931471805599453f;
constexpr float C2_FOX = 0.125f * LOG2E, C2_MLA = 0.10206207261596575f * LOG2E;
constexpr int MOE_CAP = 65536 + 32 * 256;
constexpr int MOE_MAXT = MOE_CAP / 256;

enum { I_X = 0, I_P, I_POS, I_NORM_MIX, I_NORM_FFN, I_EV_W_IN, I_FOX_BF, I_FOX_QN, I_FOX_KN, I_MLA_QAN, I_MLA_WQUP, I_MLA_KVAN, I_MLA_WKVUP, I_MLA_QN, I_MLA_KN, I_EV_W_OUT,
       I_OD_W_IN, I_S5_ARE, I_S5_AIM, I_S5_BRE, I_S5_BIM, I_S5_CRE, I_S5_CIM, I_S5_D, I_S5_LS, I_S5_WGLU, I_S5_BGLU, I_GDN_CONV, I_GDN_ALOG, I_GDN_DTB, I_GDN_ONORM, I_OD_W_OUT,
       I_MOE_WGRP, I_MOE_BGRP, I_MOE_WEXP, I_MOE_BEXP, I_MOE_WG, I_MOE_WU, I_MOE_WD, I_PLE_WP, I_PLE_NORM, I_PLE_WG, I_PLE_BG, N_IN };

constexpr size_t MiB = 1u << 20;
constexpr size_t WS_CTL = 0, CTL_ZERO_BYTES = 1 * MiB;
constexpr size_t WS_W_EVIN = 4 * MiB;
constexpr size_t WS_W_ODIN = WS_W_EVIN + 9 * MiB;
constexpr size_t WS_W_QUP = WS_W_ODIN + 11 * MiB;
constexpr size_t WS_W_KVUP = WS_W_QUP + 2 * MiB;
constexpr size_t WS_W_EVOUT = WS_W_KVUP + 1 * MiB;
constexpr size_t WS_W_ODOUT = WS_W_EVOUT + 4 * MiB;
constexpr size_t WS_W_GLU = WS_W_ODOUT + 4 * MiB;
constexpr size_t WS_W_PLEP = WS_W_GLU + 1 * MiB;
constexpr size_t WS_W_PLEG = WS_W_PLEP + 2 * MiB;
constexpr size_t WS_W_MOEGU = WS_W_PLEG + 8 * MiB;
constexpr size_t WS_W_MOED = WS_W_MOEGU + 64 * MiB;
constexpr size_t WS_ABF = WS_W_MOED + 32 * MiB;
constexpr size_t WS_PP = WS_ABF + 64 * MiB;
constexpr size_t WS_PBF = WS_PP + 64 * MiB;
constexpr size_t WS_PROJ = WS_PBF + 16 * MiB;
constexpr size_t WS_MIX = WS_PROJ + 176 * MiB;
constexpr size_t WS_R1 = WS_MIX + 64 * MiB;
constexpr size_t WS_QM = WS_R1, WS_KVB = WS_QM + 48 * MiB, WS_KM = WS_KVB + 64 * MiB, WS_CQN = WS_KM + 48 * MiB, WS_CKVN = WS_CQN + 24 * MiB, WS_LOGF = WS_CKVN + 16 * MiB, WS_CUM = WS_LOGF + 1 * MiB;
constexpr size_t WS_HG = WS_R1, WS_QG = WS_HG + 32 * MiB, WS_KG = WS_QG + 64 * MiB, WS_VG = WS_KG + 64 * MiB, WS_OG = WS_VG + 64 * MiB;
constexpr size_t WS_R2 = WS_R1 + 288 * MiB;
constexpr size_t WS_GB = WS_R2, WS_BETA = WS_GB + 1 * MiB;
constexpr size_t WS_TOKE = WS_R2 + 2 * MiB, WS_TOKW = WS_TOKE + 1 * MiB, WS_ROWS = WS_TOKW + 1 * MiB;
constexpr size_t WS_XG = WS_R1;
constexpr size_t WS_HB = WS_XG + 144 * MiB;
constexpr size_t WS_Y2 = WS_R2 + 8 * MiB;
constexpr size_t WS_END = WS_Y2 + 144 * MiB;
static_assert(WS_HB + 72 * MiB <= WS_R2, "moe overlay");
static_assert(WS_OG + 64 * MiB <= WS_R2, "odd overlay");
constexpr size_t WS_DUMMY = WS_END;
static_assert(WS_DUMMY + 128 * MiB <= 1100 * MiB, "workspace budget");

constexpr int CW_BAR = 4096;
constexpr int CW_CNT = 1024;

constexpr int RING_OFF = 0, RING_BYTES = 131072;
constexpr int LDSCTL_OFF = RING_BYTES;
constexpr int LDS_BYTES = 147456;
constexpr int LC_BARST = 32;
constexpr int LC_MOE = 256;

#define GAS __attribute__((address_space(1)))
#define LAS __attribute__((address_space(3)))
typedef unsigned short bf16;
typedef unsigned v4u __attribute__((ext_vector_type(4)));
typedef unsigned v2u __attribute__((ext_vector_type(2)));
typedef float f32x4 __attribute__((ext_vector_type(4)));
#define LDS_WAIT() asm volatile("s_waitcnt lgkmcnt(0)" ::: "memory")
#define VM_WAIT() asm volatile("s_waitcnt vmcnt(0)" ::: "memory")
__device__ __forceinline__ unsigned f2bf(float f) { unsigned u = __builtin_bit_cast(unsigned, f); return (u + 0x7fffu + ((u >> 16) & 1u)) >> 16; }
__device__ __forceinline__ unsigned pk2(float lo, float hi) { return f2bf(lo) | (f2bf(hi) << 16); }
__device__ __forceinline__ float bflo(unsigned w) { return __uint_as_float(w << 16); }
__device__ __forceinline__ float bfhi(unsigned w) { return __uint_as_float(w & 0xffff0000u); }
__device__ __forceinline__ float bf2f(bf16 h) { return __uint_as_float((unsigned)h << 16); }
__device__ __forceinline__ float wave_sum(float v) {
#pragma unroll
    for (int o = 1; o < 64; o <<= 1) v += __shfl_xor(v, o);
    return v;
}
__device__ __forceinline__ float sigm(float x) { return 1.0f / (1.0f + expf(-x)); }
__device__ __forceinline__ float softplusf_(float x) { return fmaxf(x, 0.f) + log1pf(expf(-fabsf(x))); }
__device__ __forceinline__ float gelu_tanh(float x) { return 0.5f * x * (1.0f + tanhf(0.7978845608028654f * (x + 0.044715f * x * x * x))); }

struct Args { const float* in[N_IN]; float* out; unsigned char* ws; int ph_lo, ph_hi; };
#define CAS __attribute__((address_space(4)))
__device__ __forceinline__ const float* kin(int i) { asm volatile("" : "+s"(i)); const CAS char* kp = (const CAS char*)__builtin_amdgcn_kernarg_segment_ptr(); return *(const float* const CAS*)(kp + 8 * i); }
__device__ __forceinline__ float* kout() { int i = N_IN; asm volatile("" : "+s"(i)); const CAS char* kp = (const CAS char*)__builtin_amdgcn_kernarg_segment_ptr(); return *(float* const CAS*)(kp + 8 * i); }
__device__ __forceinline__ unsigned char* kws() { int i = N_IN + 1; asm volatile("" : "+s"(i)); const CAS char* kp = (const CAS char*)__builtin_amdgcn_kernarg_segment_ptr(); return *(unsigned char* const CAS*)(kp + 8 * i); }

struct Frame {
    LAS unsigned char* lds;
    unsigned char* ws;
    unsigned* ctl;
    int tid, lane, wave, G, bid;
};

__device__ __forceinline__ void transpose_item(const float* W, int K, int N, bf16* WT, int drow0, LAS float* scr, int k0, int n0, int lane) {
    const int nn = n0 + (lane & 31); const bool ok = nn < N;
#pragma unroll 8
    for (int i = 0; i < 32; ++i) { const int kk = 2 * i + (lane >> 5); scr[kk * 33 + (lane & 31)] = ok ? W[(size_t)(k0 + kk) * N + nn] : 0.f; }
    LDS_WAIT(); asm volatile("" ::: "memory");
    const int c = lane & 7;
#pragma unroll
    for (int j = 0; j < 4; ++j) { const int n = (lane >> 3) + 8 * j; const LAS float* s = scr + (8 * c) * 33 + n;
        v4u o; o.x = pk2(s[0 * 33], s[1 * 33]); o.y = pk2(s[2 * 33], s[3 * 33]); o.z = pk2(s[4 * 33], s[5 * 33]); o.w = pk2(s[6 * 33], s[7 * 33]);
        *(v4u*)(WT + (size_t)(drow0 + n) * K + k0 + 8 * c) = o; }
    LDS_WAIT(); asm volatile("" ::: "memory");
}
__device__ __forceinline__ void transpose_set(Frame& F, const float* W, int nmat, int K, int N, int NP, bf16* WT, int& itbase) {
    LAS float* scr = (LAS float*)(F.lds + RING_OFF + F.wave * 16384);
    const int gw = F.bid * NWAVES + F.wave, NGW = F.G * NWAVES;
    const int nkb = K / 64, nnb = NP / 32, per = nkb * nnb, total = nmat * per;
    int first = (gw - (itbase % NGW) + NGW) % NGW;
    for (int it = first; it < total; it += NGW) { const int mi = it / per, r = it % per, kb = r / nnb, nb = r % nnb;
        transpose_item(W + (size_t)mi * K * N, K, N, WT + (size_t)mi * NP * K, nb * 32, scr, kb * 64, nb * 32, F.lane); }
    itbase += total;
}
__device__ __forceinline__ void prologue_weights(Frame& F) {
 int itb = 0;
    transpose_set(F, kin(I_EV_W_IN), 2, 1024, EVEN_IN, EVEN_INP, (bf16*)(F.ws + WS_W_EVIN), itb);
    transpose_set(F, kin(I_OD_W_IN), 2, 1024, ODD_IN, ODD_INP, (bf16*)(F.ws + WS_W_ODIN), itb);
    transpose_set(F, kin(I_MLA_WQUP), 2, 384, 768, 768, (bf16*)(F.ws + WS_W_QUP), itb);
    transpose_set(F, kin(I_MLA_WKVUP), 2, 256, 1024, 1024, (bf16*)(F.ws + WS_W_KVUP), itb);
    transpose_set(F, kin(I_EV_W_OUT), 2, 1024, 1024, 1024, (bf16*)(F.ws + WS_W_EVOUT), itb);
    transpose_set(F, kin(I_OD_W_OUT), 2, 1024, 1024, 1024, (bf16*)(F.ws + WS_W_ODOUT), itb);
    transpose_set(F, kin(I_S5_WGLU), 2, 512, 512, 512, (bf16*)(F.ws + WS_W_GLU), itb);
    transpose_set(F, kin(I_PLE_WP), 4, 256, 1024, 1024, (bf16*)(F.ws + WS_W_PLEP), itb);
    transpose_set(F, kin(I_PLE_WG), 4, 1024, 1024, 1024, (bf16*)(F.ws + WS_W_PLEG), itb);
}
__device__ __forceinline__ void moe_weights(Frame& F, int layer) {

    LAS float* scr = (LAS float*)(F.lds + RING_OFF + F.wave * 16384);
    const int gw = F.bid * NWAVES + F.wave, NGW = F.G * NWAVES;
    const float* wg = kin(I_MOE_WG) + (size_t)layer * 32 * 1024 * 512; const float* wu = kin(I_MOE_WU) + (size_t)layer * 32 * 1024 * 512; const float* wd = kin(I_MOE_WD) + (size_t)layer * 32 * 512 * 1024;
    bf16* WGU = (bf16*)(F.ws + WS_W_MOEGU); bf16* WD = (bf16*)(F.ws + WS_W_MOED);
    for (int it = gw; it < 2 * 32 * 256; it += NGW) { const int which = it / (32 * 256), r0 = it % (32 * 256), e = r0 / 256, r = r0 % 256, kb = r / 16, nb = r % 16, n0 = nb * 32;
        const int drow = 256 * (n0 / 128) + (n0 % 128) + which * 128;
        transpose_item((which ? wu : wg) + (size_t)e * 1024 * 512, 1024, 512, WGU + (size_t)e * 1024 * 1024, drow, scr, kb * 64, n0, F.lane); }
    for (int it = gw; it < 32 * 256; it += NGW) { const int e = it / 256, r = it % 256, kb = r / 32, nb = r % 32;
        transpose_item(wd + (size_t)e * 512 * 1024, 512, 1024, WD + (size_t)e * 1024 * 512, nb * 32, scr, kb * 64, nb * 32, F.lane); }
}

__device__ __forceinline__ void rms_row_to_bf16(const float* xrow, const float* gain, bf16* orow, float* copy, int lane) {
    const f32x4* xr = (const f32x4*)xrow + lane; f32x4 v[4]; float s = 0.f;
#pragma unroll
    for (int j = 0; j < 4; ++j) { v[j] = xr[64 * j]; s += (v[j].x * v[j].x + v[j].y * v[j].y) + (v[j].z * v[j].z + v[j].w * v[j].w); }
    const float r = 1.0f / sqrtf(wave_sum(s) * (1.f / 1024.f) + RMS_EPS);
    if (copy) {
#pragma unroll
        for (int j = 0; j < 4; ++j) ((f32x4*)copy + lane)[64 * j] = v[j]; }
    unsigned long long* o8 = (unsigned long long*)orow + lane;
#pragma unroll
    for (int j = 0; j < 4; ++j) { const f32x4 g = ((const f32x4*)gain + lane)[64 * j];
        o8[64 * j] = (unsigned long long)pk2(v[j].x * r * g.x, v[j].y * r * g.y) | ((unsigned long long)pk2(v[j].z * r * g.z, v[j].w * r * g.w) << 32); }
}
__device__ __forceinline__ void phase_norm(Frame& F, const float* src, const float* gain, float* copy) {
    bf16* ABF = (bf16*)(F.ws + WS_ABF);
    const int gw = F.bid * NWAVES + F.wave, NGW = F.G * NWAVES;
    for (int m = gw; m < NTOK; m += NGW) rms_row_to_bf16(src + (size_t)m * DM, gain, ABF + (size_t)m * DM, copy ? copy + (size_t)m * DM : nullptr, F.lane);
}
__device__ __forceinline__ void phase_pconv(Frame& F, int layer) {
    const float* p = kin(I_P) + (size_t)layer * NTOK * PLE; bf16* PBF = (bf16*)(F.ws + WS_PBF);
    const size_t n4 = (size_t)NTOK * PLE / 4; const size_t gt = (size_t)F.bid * 512 + F.tid, NT = (size_t)F.G * 512;
    for (size_t i = gt; i < n4; i += NT) { const f32x4 v = ((const f32x4*)p)[i]; v2u o; o.x = pk2(v.x, v.y); o.y = pk2(v.z, v.w); ((v2u*)PBF)[i] = o; }
}

__device__ __forceinline__ void phase_even_post(Frame& F, int j, bool dry = false) {

    bf16* PROJ = (bf16*)(F.ws + WS_PROJ); bf16* CQN = (bf16*)(F.ws + WS_CQN); bf16* CKVN = (bf16*)(F.ws + WS_CKVN); float* LOGF = (float*)(F.ws + WS_LOGF);
    const float* qn = kin(I_FOX_QN) + j * 64; const float* kn = kin(I_FOX_KN) + j * 64; const float* bfv = kin(I_FOX_BF) + j * 8;
    const float* qan = kin(I_MLA_QAN) + j * 384; const float* kvan = kin(I_MLA_KVAN) + j * 256;
    const int gw = F.bid * NWAVES + F.wave, NGW = F.G * NWAVES, lane = F.lane;
    for (int m = gw; m < NTOK; m += NGW) {
        bf16* row = PROJ + (size_t)m * EVEN_INP;
#pragma unroll
        for (int w = 0; w < 2; ++w) {
            v4u* p = (v4u*)(row + (w ? E_FK : E_FQ)) + lane; const v4u x = *p;
            float f[8] = {bflo(x.x), bfhi(x.x), bflo(x.y), bfhi(x.y), bflo(x.z), bfhi(x.z), bflo(x.w), bfhi(x.w)};
            float s = 0.f;
#pragma unroll
            for (int i = 0; i < 8; ++i) s += f[i] * f[i];
            s += __shfl_xor(s, 1); s += __shfl_xor(s, 2); s += __shfl_xor(s, 4);
            const float r = (1.0f / sqrtf(s * (1.f / 64.f) + RMS_EPS)) * (w ? 1.0f : C2_FOX); const float* g = (w ? kn : qn) + (lane & 7) * 8;
            v4u o; o.x = pk2(f[0] * r * g[0], f[1] * r * g[1]); o.y = pk2(f[2] * r * g[2], f[3] * r * g[3]); o.z = pk2(f[4] * r * g[4], f[5] * r * g[5]); o.w = pk2(f[6] * r * g[6], f[7] * r * g[7]);
            *(dry ? (v4u*)(F.ws + WS_DUMMY) + (size_t)m * 128 + w * 64 + lane : p) = o;
        }
        if (lane < 8) { const float z = bf2f(row[E_FLOG + lane]) + bfv[lane]; LOGF[(size_t)m * 8 + lane] = -softplusf_(-z); }
        {
            float f[6]; float s = 0.f;
#pragma unroll
            for (int i = 0; i < 3; ++i) { const unsigned x = *((const unsigned*)(row + E_CQ) + lane + 64 * i); f[2 * i] = bflo(x); f[2 * i + 1] = bfhi(x); s += f[2 * i] * f[2 * i] + f[2 * i + 1] * f[2 * i + 1]; }
            const float r = 1.0f / sqrtf(wave_sum(s) * (1.f / 384.f) + RMS_EPS);
#pragma unroll
            for (int i = 0; i < 3; ++i) { const int c = 2 * (lane + 64 * i); *((unsigned*)(CQN + (size_t)m * 384) + lane + 64 * i) = pk2(f[2 * i] * r * qan[c], f[2 * i + 1] * r * qan[c + 1]); }
        }
        {
            float f[4]; float s = 0.f;
#pragma unroll
            for (int i = 0; i < 2; ++i) { const unsigned x = *((const unsigned*)(row + E_CKV) + lane + 64 * i); f[2 * i] = bflo(x); f[2 * i + 1] = bfhi(x); s += f[2 * i] * f[2 * i] + f[2 * i + 1] * f[2 * i + 1]; }
            const float r = 1.0f / sqrtf(wave_sum(s) * (1.f / 256.f) + RMS_EPS);
#pragma unroll
            for (int i = 0; i < 2; ++i) { const int c = 2 * (lane + 64 * i); *((unsigned*)(CKVN + (size_t)m * 256) + lane + 64 * i) = pk2(f[2 * i] * r * kvan[c], f[2 * i + 1] * r * kvan[c + 1]); }
        }
    }
}
__device__ __forceinline__ void phase_cumsum(Frame& F) {
    if (F.bid >= 16) return;
    const float* LOGF = (const float*)(F.ws + WS_LOGF); float* CUM = (float*)(F.ws + WS_CUM);
    const int b = F.bid >> 3, h = F.bid & 7, t0 = F.tid * 32;
    LAS double* part = (LAS double*)(F.lds + RING_OFF);
    float v[32]; double s = 0.0;
#pragma unroll
    for (int i = 0; i < 32; ++i) { v[i] = LOGF[((size_t)b * SEQ + t0 + i) * 8 + h]; s += (double)v[i]; }
    part[F.tid] = s; __syncthreads();
    if (F.tid == 0) { double run = 0.0; for (int i = 0; i < 512; ++i) { const double x = part[i]; part[i] = run; run += x; } }
    __syncthreads();
    double run = part[F.tid];
#pragma unroll
    for (int i = 0; i < 32; ++i) { run += (double)v[i]; CUM[((size_t)b * SEQ + t0 + i) * 8 + h] = (float)run; }
    __syncthreads();
}
__device__ __forceinline__ void phase_mla_post(Frame& F, int j, bool dry = false) {

    const bf16* PROJ = (const bf16*)(F.ws + WS_PROJ); bf16* QM = (bf16*)(F.ws + WS_QM); const bf16* KVB = (const bf16*)(F.ws + WS_KVB); bf16* KM = (bf16*)(F.ws + WS_KM);
    const float* qn = kin(I_MLA_QN) + j * 96; const float* kn = kin(I_MLA_KN) + j * 96; const int* pos = (const int*)kin(I_POS);
    const int gw = F.bid * NWAVES + F.wave, NGW = F.G * NWAVES, lane = F.lane, l32 = lane & 31, hh = lane >> 5;
    const int fi = l32 & 15; const float inv = expf(-(float)fi * (1.0f / 16.0f) * 9.210340371976184f);
    for (int m = gw; m < NTOK; m += NGW) {
        const float ang = (float)pos[m] * inv; float sn, cs; sincosf(ang, &sn, &cs);
        const float krope = bf2f(PROJ[(size_t)m * EVEN_INP + E_KROPE + l32]);
#pragma unroll
        for (int hp = 0; hp < 4; ++hp) { const int h = hp * 2 + hh;
#pragma unroll
            for (int w = 0; w < 2; ++w) {
                float f[3];
                if (w == 0) { const bf16* q = QM + (size_t)m * 768 + h * 96; f[0] = bf2f(q[l32]); f[1] = bf2f(q[l32 + 32]); f[2] = bf2f(q[l32 + 64]); }
                else { const bf16* k = KVB + (size_t)m * 1024 + h * 128; f[0] = bf2f(k[l32]); f[1] = bf2f(k[l32 + 32]); f[2] = krope; }
                float s = f[0] * f[0] + f[1] * f[1] + f[2] * f[2];
                s += __shfl_xor(s, 1); s += __shfl_xor(s, 2); s += __shfl_xor(s, 4); s += __shfl_xor(s, 8); s += __shfl_xor(s, 16);
                const float r = 1.0f / sqrtf(s * (1.f / 96.f) + RMS_EPS); const float* g = w ? kn : qn;
                f[0] *= r * g[l32]; f[1] *= r * g[l32 + 32]; f[2] *= r * g[l32 + 64];
                const float other = __shfl_xor(f[2], 16);
                const float rot = (l32 < 16) ? (f[2] * cs - other * sn) : (other * sn + f[2] * cs);
                bf16* o = (w ? KM : (dry ? (bf16*)(F.ws + WS_DUMMY) : QM)) + (size_t)m * 768 + h * 96; const float qs = w ? 1.0f : C2_MLA;
                o[l32] = (bf16)f2bf(f[0] * qs); o[l32 + 32] = (bf16)f2bf(f[1] * qs); o[l32 + 64] = (bf16)f2bf(rot * qs);
            }
        }
    }
}
template <int DK> __device__ __forceinline__ void attn_naive_unit(Frame& F, const bf16* Qp, int qld, const bf16* Kp, int kld, const bf16* Vp, int vld, const float* cum  , float scale, bf16* Op, int qb) {
    LAS float* Ks = (LAS float*)(F.lds + RING_OFF); LAS float* Vs = Ks + 64 * DK; LAS float* Cs = Vs + 64 * 64;
    const int t = qb * 512 + F.wave * 64 + F.lane; const int tmax_w = qb * 512 + F.wave * 64 + 63;
    float q[DK];
#pragma unroll
    for (int d = 0; d < DK; d += 8) { const v4u x = *(const v4u*)(Qp + (size_t)t * qld + d);
        q[d] = bflo(x.x) * scale; q[d + 1] = bfhi(x.x) * scale; q[d + 2] = bflo(x.y) * scale; q[d + 3] = bfhi(x.y) * scale; q[d + 4] = bflo(x.z) * scale; q[d + 5] = bfhi(x.z) * scale; q[d + 6] = bflo(x.w) * scale; q[d + 7] = bfhi(x.w) * scale; }
    const float cq = cum ? cum[(size_t)t * 8] : 0.f;
    float acc[64];
#pragma unroll
    for (int d = 0; d < 64; ++d) acc[d] = 0.f;
    float mx = -1e30f, l = 0.f;
    const int nkb = (qb * 512 + 512) / 64;
    for (int kb = 0; kb < nkb; ++kb) {
        __syncthreads();
        for (int i = F.tid; i < 64 * DK / 8; i += 512) { const int key = i / (DK / 8), c = (i % (DK / 8)) * 8; const v4u x = *(const v4u*)(Kp + (size_t)(kb * 64 + key) * kld + c);
            LAS float* d = Ks + key * DK + c; d[0] = bflo(x.x); d[1] = bfhi(x.x); d[2] = bflo(x.y); d[3] = bfhi(x.y); d[4] = bflo(x.z); d[5] = bfhi(x.z); d[6] = bflo(x.w); d[7] = bfhi(x.w); }
        { const int i = F.tid; const int key = i / 8, c = (i % 8) * 8; const v4u x = *(const v4u*)(Vp + (size_t)(kb * 64 + key) * vld + c);
            LAS float* d = Vs + key * 64 + c; d[0] = bflo(x.x); d[1] = bfhi(x.x); d[2] = bflo(x.y); d[3] = bfhi(x.y); d[4] = bflo(x.z); d[5] = bfhi(x.z); d[6] = bflo(x.w); d[7] = bfhi(x.w); }
        if (F.tid < 64) Cs[F.tid] = cum ? cum[(size_t)(kb * 64 + F.tid) * 8] : 0.f;
        __syncthreads();
        if (kb * 64 > tmax_w) continue;
        for (int jk = 0; jk < 64; ++jk) {
            const int s = kb * 64 + jk; if (s > tmax_w) break;
            const LAS float* kr = Ks + jk * DK; float dot = 0.f;
#pragma unroll
            for (int d = 0; d < DK; d += 4) { const f32x4 kv = *(const LAS f32x4*)(kr + d); dot += q[d] * kv.x + q[d + 1] * kv.y + q[d + 2] * kv.z + q[d + 3] * kv.w; }
            float logit = dot + (cq - Cs[jk]); if (s > t) logit = -1e30f;
            if (__any(logit > mx)) { const float mn = fmaxf(mx, logit); const float corr = expf(mx - mn); l *= corr;
#pragma unroll
                for (int d = 0; d < 64; ++d) acc[d] *= corr;
                mx = mn; }
            const float p = (s > t) ? 0.f : expf(logit - mx); l += p;
            const LAS float* vr = Vs + jk * 64;
#pragma unroll
            for (int d = 0; d < 64; d += 4) { const f32x4 vv = *(const LAS f32x4*)(vr + d); acc[d] += p * vv.x; acc[d + 1] += p * vv.y; acc[d + 2] += p * vv.z; acc[d + 3] += p * vv.w; }
        }
    }
    const float il = 1.0f / l; bf16* o = Op + (size_t)t * DM;
#pragma unroll
    for (int d = 0; d < 64; d += 8) { v4u w; w.x = pk2(acc[d] * il, acc[d + 1] * il); w.y = pk2(acc[d + 2] * il, acc[d + 3] * il); w.z = pk2(acc[d + 4] * il, acc[d + 5] * il); w.w = pk2(acc[d + 6] * il, acc[d + 7] * il); *(v4u*)(o + d) = w; }
}
__device__ __forceinline__ void phase_attn_naive(Frame& F) {
    const bf16* PROJ = (const bf16*)(F.ws + WS_PROJ); const bf16* QM = (const bf16*)(F.ws + WS_QM); const bf16* KVB = (const bf16*)(F.ws + WS_KVB); const bf16* KM = (const bf16*)(F.ws + WS_KM);
    const float* CUM = (const float*)(F.ws + WS_CUM); bf16* MIX = (bf16*)(F.ws + WS_MIX);
    for (int p = F.bid; p < 512; p += F.G) {
        const int combo = p >> 4, qq = p & 15; const int type = combo >> 4, b = (combo >> 3) & 1, h = combo & 7;
#pragma unroll 1
        for (int half = 0; half < 2; ++half) { const int qb = half ? 31 - qq : qq; const size_t rb = (size_t)b * SEQ;
            if (type == 0) attn_naive_unit<64>(F, PROJ + rb * EVEN_INP + E_FQ + h * 64, EVEN_INP, PROJ + rb * EVEN_INP + E_FK + h * 64, EVEN_INP, PROJ + rb * EVEN_INP + E_FV + h * 64, EVEN_INP, CUM + rb * 8 + h, LN2, MIX + rb * DM + h * 64, qb);
            else attn_naive_unit<96>(F, QM + rb * 768 + h * 96, 768, KM + rb * 768 + h * 96, 768, KVB + rb * 1024 + h * 128 + 64, 1024, nullptr, LN2, MIX + rb * DM + 512 + h * 64, qb);
        }
    }
    __syncthreads();
}

__device__ __forceinline__ void s5_scan_wave(Frame& F, int j, int b, int g) {
 const int p = F.lane;
    const bf16* PROJ = (const bf16*)(F.ws + WS_PROJ); bf16* HG = (bf16*)(F.ws + WS_HG);
    const float lr = fminf(kin(I_S5_ARE)[(j * 32 + g) * 64 + p], -1e-4f), li = kin(I_S5_AIM)[(j * 32 + g) * 64 + p];
    const float dt = expf(kin(I_S5_LS)[j * 32 + g]);
    const float mag = expf(lr * dt); const float abr = mag * cosf(li * dt), abi = mag * sinf(li * dt);
    const float den = lr * lr + li * li, nr = abr - 1.0f, ni = abi;
    const float gr = (nr * lr + ni * li) / den, gi = (ni * lr - nr * li) / den;
    float bbr[16], bbi[16], cr[16], ci[16], dsk[16];
#pragma unroll
    for (int c = 0; c < 16; ++c) { const float br = kin(I_S5_BRE)[((size_t)(j * 32 + g) * 64 + p) * 16 + c], bi = kin(I_S5_BIM)[((size_t)(j * 32 + g) * 64 + p) * 16 + c];
        bbr[c] = gr * br - gi * bi; bbi[c] = gr * bi + gi * br;
        cr[c] = kin(I_S5_CRE)[((size_t)(j * 32 + g) * 16 + c) * 64 + p]; ci[c] = kin(I_S5_CIM)[((size_t)(j * 32 + g) * 16 + c) * 64 + p];
        dsk[c] = kin(I_S5_D)[j * 512 + g * 16 + c]; }
    float xr = 0.f, xi = 0.f;
    const bf16* up = PROJ + (size_t)b * SEQ * ODD_INP + O_U + g * 16;
    v4u cur0[4], cur1[4], nx0[4], nx1[4];
#pragma unroll
    for (int i = 0; i < 4; ++i) { cur0[i] = *(const v4u*)(up + (size_t)i * ODD_INP); cur1[i] = *(const v4u*)(up + (size_t)i * ODD_INP + 8); }
    for (int t0 = 0; t0 < SEQ; t0 += 4) {
        const int tn = (t0 + 4 < SEQ) ? t0 + 4 : t0;
#pragma unroll
        for (int i = 0; i < 4; ++i) { nx0[i] = *(const v4u*)(up + (size_t)(tn + i) * ODD_INP); nx1[i] = *(const v4u*)(up + (size_t)(tn + i) * ODD_INP + 8); }
#pragma unroll
        for (int i = 0; i < 4; ++i) {
            float u[16] = {bflo(cur0[i].x), bfhi(cur0[i].x), bflo(cur0[i].y), bfhi(cur0[i].y), bflo(cur0[i].z), bfhi(cur0[i].z), bflo(cur0[i].w), bfhi(cur0[i].w),
                           bflo(cur1[i].x), bfhi(cur1[i].x), bflo(cur1[i].y), bfhi(cur1[i].y), bflo(cur1[i].z), bfhi(cur1[i].z), bflo(cur1[i].w), bfhi(cur1[i].w)};
            float bur = 0.f, bui = 0.f;
#pragma unroll
            for (int c = 0; c < 16; ++c) { bur += bbr[c] * u[c]; bui += bbi[c] * u[c]; }
            const float nxr = abr * xr - abi * xi + bur, nxi = abr * xi + abi * xr + bui; xr = nxr; xi = nxi;
            float y[16];
#pragma unroll
            for (int c = 0; c < 16; ++c) y[c] = wave_sum(cr[c] * xr - ci[c] * xi);
            if (p < 16) { float yy = 0.f, uu = 0.f, dd = 0.f;
#pragma unroll
                for (int c = 0; c < 16; ++c) if (p == c) { yy = y[c]; uu = u[c]; dd = dsk[c]; }
                HG[((size_t)b * SEQ + t0 + i) * 512 + g * 16 + p] = (bf16)f2bf(gelu_tanh(yy + dd * uu)); }
        }
#pragma unroll
        for (int i = 0; i < 4; ++i) { cur0[i] = nx0[i]; cur1[i] = nx1[i]; }
    }
}
__device__ __forceinline__ void gdn_prep_token(Frame& F, int j, int m) {
 const int lane = F.lane;
    const bf16* PROJ = (const bf16*)(F.ws + WS_PROJ); float* QG = (float*)(F.ws + WS_QG); float* KG = (float*)(F.ws + WS_KG); float* VG = (float*)(F.ws + WS_VG);
    float* GB = (float*)(F.ws + WS_GB); float* BETA = (float*)(F.ws + WS_BETA);
    const float* cw = kin(I_GDN_CONV) + (size_t)j * 4 * 1536;
    const int s = m % SEQ;
#pragma unroll
    for (int w = 0; w < 3; ++w) {
        const int ch0 = w * 512 + lane * 8; float acc[8];
#pragma unroll
        for (int i = 0; i < 8; ++i) acc[i] = 0.f;
#pragma unroll
        for (int tap = 0; tap < 4; ++tap) { const int ss = s - 3 + tap; if (ss < 0) continue;
            const v4u x = *(const v4u*)(PROJ + (size_t)(m - 3 + tap) * ODD_INP + O_Q + ch0); const float* wv = cw + tap * 1536 + ch0;
            acc[0] += wv[0] * bflo(x.x); acc[1] += wv[1] * bfhi(x.x); acc[2] += wv[2] * bflo(x.y); acc[3] += wv[3] * bfhi(x.y); acc[4] += wv[4] * bflo(x.z); acc[5] += wv[5] * bfhi(x.z); acc[6] += wv[6] * bflo(x.w); acc[7] += wv[7] * bfhi(x.w); }
        float ss2 = 0.f;
#pragma unroll
        for (int i = 0; i < 8; ++i) { acc[i] = acc[i] * sigm(acc[i]); ss2 += acc[i] * acc[i]; }
        float sc = 1.0f;
        if (w < 2) { ss2 += __shfl_xor(ss2, 1); ss2 += __shfl_xor(ss2, 2); ss2 += __shfl_xor(ss2, 4); ss2 += __shfl_xor(ss2, 8); sc = 1.0f / sqrtf(ss2 + RMS_EPS); if (w == 0) sc *= 0.08838834764831845f; }
        float* dst = (w == 0 ? QG : (w == 1 ? KG : VG)) + (size_t)m * 512 + lane * 8;
        *(f32x4*)dst = (f32x4){acc[0] * sc, acc[1] * sc, acc[2] * sc, acc[3] * sc}; *(f32x4*)(dst + 4) = (f32x4){acc[4] * sc, acc[5] * sc, acc[6] * sc, acc[7] * sc};
    }
    if (lane < 4) { const float gin = bf2f(PROJ[(size_t)m * ODD_INP + O_GIN + lane]), bin = bf2f(PROJ[(size_t)m * ODD_INP + O_BETA + lane]);
        GB[(size_t)m * 4 + lane] = -expf(kin(I_GDN_ALOG)[j * 4 + lane]) * softplusf_(gin + kin(I_GDN_DTB)[j * 4 + lane]); BETA[(size_t)m * 4 + lane] = sigm(bin); }
}
__device__ __forceinline__ void phase_gdn_prep(Frame& F, int j) {
    const int gw = F.bid * NWAVES + F.wave, NGW = F.G * NWAVES;
    for (int m = gw; m < NTOK; m += NGW) gdn_prep_token(F, j, m);
}
__device__ __forceinline__ void phase_odd_a(Frame& F, int j) {
    if (F.wave == 0 && F.bid < 64) { s5_scan_wave(F, j, F.bid >> 5, F.bid & 31); return; }
    const int nbusy = (F.G < 64 ? F.G : 64);
    const int widx = (F.bid < 64) ? F.bid * 7 + (F.wave - 1) : nbusy * 7 + (F.bid - 64) * 8 + F.wave;
    const int nw = nbusy * 7 + (F.G > 64 ? (F.G - 64) * 8 : 0);
    for (int m = widx; m < NTOK; m += nw) gdn_prep_token(F, j, m);
}
__device__ __forceinline__ void phase_gdn_naive(Frame& F) {
    const float* QG = (const float*)(F.ws + WS_QG); const float* KG = (const float*)(F.ws + WS_KG); const float* VG = (const float*)(F.ws + WS_VG);
    const float* GB = (const float*)(F.ws + WS_GB); const float* BETA = (const float*)(F.ws + WS_BETA); float* OG = (float*)(F.ws + WS_OG);
    const int lane = F.lane; const int NGW = F.G * NWAVES;
    for (int u = F.wave * F.G + F.bid; u < 1024; u += NGW) {
        const int b = u >> 9, h = (u >> 7) & 3, c = u & 127; const size_t rb = (size_t)b * SEQ;
        const float* kq = KG + rb * 512 + h * 128 + lane; const float* qq = QG + rb * 512 + h * 128 + lane; const float* vq = VG + rb * 512 + h * 128 + c;
        const float* gq = GB + rb * 4 + h; const float* bq = BETA + rb * 4 + h; float* oq = OG + rb * 512 + h * 128 + c;
        float s0 = 0.f, s1 = 0.f;
        float k0[8], k1[8], q0[8], q1[8], vv[8], gg[8], bb[8], nk0[8], nk1[8], nq0[8], nq1[8], nv[8], ng[8], nb[8];
#pragma unroll
        for (int i = 0; i < 8; ++i) { k0[i] = kq[(size_t)i * 512]; k1[i] = kq[(size_t)i * 512 + 64]; q0[i] = qq[(size_t)i * 512]; q1[i] = qq[(size_t)i * 512 + 64]; vv[i] = vq[(size_t)i * 512]; gg[i] = gq[i * 4]; bb[i] = bq[i * 4]; }
        for (int t0 = 0; t0 < SEQ; t0 += 8) {
            const int tn = (t0 + 8 < SEQ) ? t0 + 8 : t0;
#pragma unroll
            for (int i = 0; i < 8; ++i) { const size_t o = (size_t)(tn + i) * 512; nk0[i] = kq[o]; nk1[i] = kq[o + 64]; nq0[i] = qq[o]; nq1[i] = qq[o + 64]; nv[i] = vq[o]; ng[i] = gq[(tn + i) * 4]; nb[i] = bq[(tn + i) * 4]; }
#pragma unroll
            for (int i = 0; i < 8; ++i) {
                const float ks = wave_sum(k0[i] * s0 + k1[i] * s1); const float eg = expf(gg[i]); const float be = bb[i];
                s0 = eg * (s0 - be * k0[i] * ks) + be * k0[i] * vv[i]; s1 = eg * (s1 - be * k1[i] * ks) + be * k1[i] * vv[i];
                const float o = wave_sum(q0[i] * s0 + q1[i] * s1);
                if (lane == 0) oq[(size_t)(t0 + i) * 512] = o;
            }
#pragma unroll
            for (int i = 0; i < 8; ++i) { k0[i] = nk0[i]; k1[i] = nk1[i]; q0[i] = nq0[i]; q1[i] = nq1[i]; vv[i] = nv[i]; gg[i] = ng[i]; bb[i] = nb[i]; }
        }
    }
}
__device__ __forceinline__ void phase_gdn_out(Frame& F, int j) {
 const float* OG = (const float*)(F.ws + WS_OG); const bf16* PROJ = (const bf16*)(F.ws + WS_PROJ); bf16* MIX = (bf16*)(F.ws + WS_MIX);
    const float* on = kin(I_GDN_ONORM) + j * 128; const int lane = F.lane;
    const int gw = F.bid * NWAVES + F.wave, NGW = F.G * NWAVES;
    for (int m = gw; m < NTOK; m += NGW) {
        const f32x4 a = *(const f32x4*)(OG + (size_t)m * 512 + lane * 8), b = *(const f32x4*)(OG + (size_t)m * 512 + lane * 8 + 4);
        float f[8] = {a.x, a.y, a.z, a.w, b.x, b.y, b.z, b.w}; float s = 0.f;
#pragma unroll
        for (int i = 0; i < 8; ++i) s += f[i] * f[i];
        s += __shfl_xor(s, 1); s += __shfl_xor(s, 2); s += __shfl_xor(s, 4); s += __shfl_xor(s, 8);
        const float r = 1.0f / sqrtf(s * (1.f / 128.f) + RMS_EPS);
        const bf16* z = PROJ + (size_t)m * ODD_INP + O_Z + lane * 8; const float* g = on + (lane & 15) * 8; float o[8];
#pragma unroll
        for (int i = 0; i < 8; ++i) { const float zz = bf2f(z[i]); o[i] = f[i] * r * g[i] * (zz * sigm(zz)); }
        v4u w; w.x = pk2(o[0], o[1]); w.y = pk2(o[2], o[3]); w.z = pk2(o[4], o[5]); w.w = pk2(o[6], o[7]);
        *(v4u*)(MIX + (size_t)m * DM + 512 + lane * 8) = w;
    }
}

__device__ __forceinline__ void phase_router(Frame& F, int layer, bool dry = false) {
 const float* H = kout(); bf16* ABF = (bf16*)(F.ws + WS_ABF);
    const float* gain = kin(I_NORM_FFN) + layer * DM; const float* wgr = kin(I_MOE_WGRP) + (size_t)layer * DM * 4; const float* bgr = kin(I_MOE_BGRP) + layer * 4;
    const float* wex = kin(I_MOE_WEXP) + (size_t)layer * DM * 32; const float* bex = kin(I_MOE_BEXP) + layer * 32;
    int* TOKE = (int*)(F.ws + WS_TOKE); float* TOKW = (float*)(F.ws + WS_TOKW);
    LAS int* lcnt = (LAS int*)(F.lds + LDSCTL_OFF + LC_MOE + 512); LAS int* gbase = (LAS int*)(F.lds + LDSCTL_OFF + LC_MOE + 640);
    const int lane = F.lane; const int per = NTOK / F.G;
    LAS int* lasg = (LAS int*)(F.lds + RING_OFF);
    if (F.tid < 32) lcnt[F.tid] = 0;
    __syncthreads();
    for (int tl = F.wave; tl < per; tl += NWAVES) {
        const int m = F.bid * per + tl;
        const f32x4* xr = (const f32x4*)(H + (size_t)m * DM) + lane; f32x4 v[4]; float s = 0.f;
#pragma unroll
        for (int q = 0; q < 4; ++q) { v[q] = xr[64 * q]; s += (v[q].x * v[q].x + v[q].y * v[q].y) + (v[q].z * v[q].z + v[q].w * v[q].w); }
        const float r = 1.0f / sqrtf(wave_sum(s) * (1.f / 1024.f) + RMS_EPS);
        unsigned long long* o8 = (unsigned long long*)(ABF + (size_t)m * DM) + lane;
#pragma unroll
        for (int q = 0; q < 4; ++q) { const f32x4 g = ((const f32x4*)gain + lane)[64 * q]; v[q].x *= r * g.x; v[q].y *= r * g.y; v[q].z *= r * g.z; v[q].w *= r * g.w;
            o8[64 * q] = (unsigned long long)pk2(v[q].x, v[q].y) | ((unsigned long long)pk2(v[q].z, v[q].w) << 32); }
        float lg[4] = {0.f, 0.f, 0.f, 0.f};
#pragma unroll
        for (int q = 0; q < 4; ++q) { const int k0 = 4 * lane + 256 * q;
#pragma unroll
            for (int e = 0; e < 4; ++e) { const f32x4 w = *(const f32x4*)(wgr + (size_t)(k0 + e) * 4); const float x = v[q][e]; lg[0] += x * w.x; lg[1] += x * w.y; lg[2] += x * w.z; lg[3] += x * w.w; } }
#pragma unroll
        for (int g = 0; g < 4; ++g) lg[g] = wave_sum(lg[g]) + bgr[g];
        int gi = 0; float gm = lg[0];
#pragma unroll
        for (int g = 1; g < 4; ++g) if (lg[g] > gm) { gm = lg[g]; gi = g; }
        float gden = 0.f;
#pragma unroll
        for (int g = 0; g < 4; ++g) gden += expf(lg[g] - gm);
        const float gw_ = 1.0f / gden;
        float le[8] = {0.f, 0.f, 0.f, 0.f, 0.f, 0.f, 0.f, 0.f};
#pragma unroll
        for (int q = 0; q < 4; ++q) { const int k0 = 4 * lane + 256 * q;
#pragma unroll
            for (int e = 0; e < 4; ++e) { const float* wp = wex + (size_t)(k0 + e) * 32 + gi * 8; const f32x4 w0 = *(const f32x4*)wp, w1 = *(const f32x4*)(wp + 4); const float x = v[q][e];
                le[0] += x * w0.x; le[1] += x * w0.y; le[2] += x * w0.z; le[3] += x * w0.w; le[4] += x * w1.x; le[5] += x * w1.y; le[6] += x * w1.z; le[7] += x * w1.w; } }
#pragma unroll
        for (int e = 0; e < 8; ++e) le[e] = wave_sum(le[e]) + bex[gi * 8 + e];
        int i0 = 0; float m0 = le[0];
#pragma unroll
        for (int e = 1; e < 8; ++e) if (le[e] > m0) { m0 = le[e]; i0 = e; }
        int i1 = -1; float m1 = -3.0e38f;
#pragma unroll
        for (int e = 0; e < 8; ++e) if (e != i0 && le[e] > m1) { m1 = le[e]; i1 = e; }
        const float e1 = expf(m1 - m0); const float w0 = gw_ / (1.0f + e1), w1 = gw_ * e1 / (1.0f + e1);
        if (lane == 0 && !dry) { const int ea = gi * 8 + i0, eb = gi * 8 + i1;
            const int pa = __hip_atomic_fetch_add(lcnt + ea, 1, __ATOMIC_RELAXED, __HIP_MEMORY_SCOPE_WORKGROUP), pb = __hip_atomic_fetch_add(lcnt + eb, 1, __ATOMIC_RELAXED, __HIP_MEMORY_SCOPE_WORKGROUP);
            lasg[tl * 2] = ea | (pa << 8); lasg[tl * 2 + 1] = eb | (pb << 8);
            TOKW[(size_t)m * 2] = w0; TOKW[(size_t)m * 2 + 1] = w1; }
    }
    __syncthreads();
    if (dry) return;
    if (F.tid < 32) gbase[F.tid] = (int)__hip_atomic_fetch_add(F.ctl + CW_CNT + 64 * layer + F.tid, (unsigned)lcnt[F.tid], __ATOMIC_RELAXED, __HIP_MEMORY_SCOPE_AGENT);
    __syncthreads();
    for (int i = F.tid; i < per * 2; i += 512) { const int a = lasg[i], e = a & 255, lp = a >> 8; TOKE[(size_t)F.bid * per * 2 + i] = e | ((gbase[e] + lp) << 8); }
    __syncthreads();
}
__device__ __forceinline__ void moe_tables(Frame& F, int layer) {
    LAS int* rowbase = (LAS int*)(F.lds + LDSCTL_OFF + LC_MOE); LAS unsigned char* tile_e = (LAS unsigned char*)(F.lds + LDSCTL_OFF + LC_MOE + 192);
    if (F.tid == 0) { int rb = 0;
#pragma unroll 1
        for (int e = 0; e < 32; ++e) { const int c = (int)__hip_atomic_load(F.ctl + CW_CNT + 64 * layer + e, __ATOMIC_RELAXED, __HIP_MEMORY_SCOPE_AGENT); rowbase[e] = rb; const int nt = (c + 255) >> 8;
            for (int i = 0; i < nt; ++i) tile_e[(rb >> 8) + i] = (unsigned char)e; rb += nt << 8; }
        rowbase[32] = rb; rowbase[34] = rb >> 8; }
    __syncthreads();
}
__device__ __forceinline__ void phase_moe_scatter(Frame& F, int layer) {
    moe_tables(F, layer);
    const LAS int* rowbase = (const LAS int*)(F.lds + LDSCTL_OFF + LC_MOE);
    const bf16* ABF = (const bf16*)(F.ws + WS_ABF); bf16* XG = (bf16*)(F.ws + WS_XG); const int* TOKE = (const int*)(F.ws + WS_TOKE); int* ROWS = (int*)(F.ws + WS_ROWS);
    const int gw = F.bid * NWAVES + F.wave, NGW = F.G * NWAVES, lane = F.lane;
    for (int m = gw; m < NTOK; m += NGW) {
        const v4u a = *((const v4u*)(ABF + (size_t)m * DM) + lane), b = *((const v4u*)(ABF + (size_t)m * DM) + 64 + lane);
#pragma unroll
        for (int k = 0; k < 2; ++k) { const int te = TOKE[(size_t)m * 2 + k]; const int row = rowbase[te & 255] + (te >> 8);
            *((v4u*)(XG + (size_t)row * DM) + lane) = a; *((v4u*)(XG + (size_t)row * DM) + 64 + lane) = b;
            if (lane == 0) ROWS[(size_t)m * 2 + k] = row; }
    }
}
struct MoeOrder {
    int ntiles, nN, G, c; const LAS unsigned char* tile_e; size_t bstride;
    __device__ bool next(int i, pg8::Unit& u) const { const long L = (long)i * G + c; if (L >= (long)ntiles * nN) return false; u.pm = (int)(L / nN); u.pn = (int)(L % nN); u.aux = __builtin_amdgcn_readfirstlane((int)tile_e[u.pm]); return true; }
    __device__ __forceinline__ const char* a_base(const pg8::Gemm& g, const pg8::Unit& u) const { return (const char*)g.A + (size_t)u.pm * 256 * g.lda * 2; }
    __device__ __forceinline__ const char* b_base(const pg8::Gemm& g, const pg8::Unit& u) const { return (const char*)g.Bt + (size_t)u.aux * bstride + (size_t)u.pn * 256 * g.ldb * 2; }
};
__device__ __forceinline__ void phase_moe_combine(Frame& F, int layer, bool dry = false) {
    float* H = kout(); float* Ho = dry ? (float*)(F.ws + WS_DUMMY) : H; bf16* ABF = (bf16*)(F.ws + WS_ABF); const bf16* Y2 = (const bf16*)(F.ws + WS_Y2);
    const int* ROWS = (const int*)(F.ws + WS_ROWS); const float* TOKW = (const float*)(F.ws + WS_TOKW); const float* gain = kin(I_PLE_NORM) + layer * DM;
    const int gw = F.bid * NWAVES + F.wave, NGW = F.G * NWAVES, lane = F.lane;
    for (int m = gw; m < NTOK; m += NGW) {
        const int r0 = ROWS[(size_t)m * 2], r1 = ROWS[(size_t)m * 2 + 1]; const float w0 = TOKW[(size_t)m * 2], w1 = TOKW[(size_t)m * 2 + 1];
        f32x4* hr = (f32x4*)(H + (size_t)m * DM) + lane; f32x4* ho = (f32x4*)(Ho + (size_t)m * DM) + lane; f32x4 v[4]; float s = 0.f;
#pragma unroll
        for (int q = 0; q < 4; ++q) { v[q] = hr[64 * q]; const v2u ya = *((const v2u*)(Y2 + (size_t)r0 * DM) + lane + 64 * q), yb = *((const v2u*)(Y2 + (size_t)r1 * DM) + lane + 64 * q);
            v[q].x += w0 * bflo(ya.x) + w1 * bflo(yb.x); v[q].y += w0 * bfhi(ya.x) + w1 * bfhi(yb.x); v[q].z += w0 * bflo(ya.y) + w1 * bflo(yb.y); v[q].w += w0 * bfhi(ya.y) + w1 * bfhi(yb.y);
            ho[64 * q] = v[q]; s += (v[q].x * v[q].x + v[q].y * v[q].y) + (v[q].z * v[q].z + v[q].w * v[q].w); }
        const float r = 1.0f / sqrtf(wave_sum(s) * (1.f / 1024.f) + RMS_EPS);
        unsigned long long* o8 = (unsigned long long*)(ABF + (size_t)m * DM) + lane;
#pragma unroll
        for (int q = 0; q < 4; ++q) { const f32x4 g = ((const f32x4*)gain + lane)[64 * q];
            o8[64 * q] = (unsigned long long)pk2(v[q].x * r * g.x, v[q].y * r * g.y) | ((unsigned long long)pk2(v[q].z * r * g.z, v[q].w * r * g.w) << 32); }
    }
}
namespace att {
using bf16x8 = __attribute__((ext_vector_type(8))) short;
using s16x4 = __attribute__((ext_vector_type(4))) short;
using f32x16 = __attribute__((ext_vector_type(16))) float;
using u32x4 = __attribute__((ext_vector_type(4))) unsigned;
typedef float f32x2_t __attribute__((ext_vector_type(2))); typedef __bf16 bf16x2_t __attribute__((ext_vector_type(2)));
constexpr int KSLOT = 16384, VSLOT = 8192;
constexpr int L_K = 0, L_V = 2 * KSLOT, L_B = L_V + 2 * VSLOT, L_WS = L_B + 512, L_OST = L_WS + 8 * 256, L_BYTES = L_OST + 8 * 4096;
__device__ __forceinline__ int crow(int r, int hi) { return (r & 3) + 8 * (r >> 2) + 4 * hi; }
__device__ __forceinline__ void glds16(const void* gsrc, unsigned lds_dst) { unsigned keep;
    asm volatile("s_mov_b32 %0, m0\n\ts_mov_b32 m0, %2\n\ts_nop 0\n\tglobal_load_lds_dwordx4 %1, off\n\ts_mov_b32 m0, %0" : "=&s"(keep) : "v"(gsrc), "s"(lds_dst) : "memory"); }
__device__ __forceinline__ unsigned cvtpk(float lo, float hi) { f32x2_t v = {lo, hi}; bf16x2_t b = __builtin_convertvector(v, bf16x2_t); return __builtin_bit_cast(unsigned, b); }
#define ATT_WAIT_BAR() asm volatile("s_waitcnt vmcnt(0) lgkmcnt(0)\n\ts_barrier" ::: "memory")

template <int DK, bool BIAS>
__device__ __forceinline__ void attn_unit(const int tid, const int qb, const bf16* Qh, const int qp, const bf16* Kh, const int kp, const bf16* Vh, const int vp, const float* cumh  , bf16* Oh  , char* shm, const float skip_margin  ) {
    constexpr int ND = DK / 16, KCH = DK / 8;
    const int lane = tid & 63, r32 = lane & 31, hi = lane >> 5; const int wid = __builtin_amdgcn_readfirstlane(tid >> 6);
    const int q0 = qb * 256;
    const unsigned lds0 = (unsigned)(uintptr_t)shm;
    float* wsf = (float*)(shm + L_WS) + wid * 64;
    float* Bs = (float*)(shm + L_B);
    const bf16* ksrc = Kh + (size_t)lane * kp + wid * 8;
    const bf16* vsrc = Vh + (size_t)(16 * (wid & 3) + (lane >> 2)) * vp + (wid >> 2) * 32 + (lane & 3) * 8;
    const unsigned kdst = lds0 + L_K + wid * 1024, vdst = lds0 + L_V + wid * 1024;
    const int NT = (q0 + 256) / 64;
    const float cref = BIAS ? cumh[(size_t)q0 * 8] : 0.f;
    int T0 = 0;
    if (BIAS) { for (int base = 0; base < NT; base += 64) { const int tq = base + lane; bool ok = false;
            if (tq < NT) ok = ((cref - cumh[(size_t)(64 * tq + 63) * 8]) * 1.4426950408889634f + skip_margin >= -150.0f);
            const unsigned long long mk = __ballot(ok); if (mk) { T0 = base + (int)__builtin_ctzll(mk); break; } T0 = NT - 4; }
        T0 = __builtin_amdgcn_readfirstlane(T0); if (T0 > NT - 4) T0 = NT - 4; if (T0 & 1) T0 -= 1; }
#define ATT_DMA(t, slot) do { glds16(ksrc + (size_t)(t) * 64 * kp, (unsigned)__builtin_amdgcn_readfirstlane(kdst + (slot) * KSLOT)); \
        if (KCH > 8) glds16(ksrc + (size_t)(t) * 64 * kp + 64, (unsigned)__builtin_amdgcn_readfirstlane(kdst + (slot) * KSLOT + 8192)); \
        glds16(vsrc + (size_t)(t) * 64 * vp, (unsigned)__builtin_amdgcn_readfirstlane(vdst + (slot) * VSLOT)); } while (0)
    ATT_DMA(T0, 0);
    if (BIAS && wid == 0) Bs[lane] = (cref - cumh[(size_t)(T0 * 64 + lane) * 8]) * 1.4426950408889634f;
    bf16x8 qr[ND];
#pragma unroll
    for (int d0 = 0; d0 < ND; ++d0) qr[d0] = *reinterpret_cast<const bf16x8*>(Qh + (size_t)(q0 + wid * 32 + r32) * qp + d0 * 16 + hi * 8);
    float mhat = 0.f, l_reg = 0.f; f32x16 o[2]; o[0] = f32x16{}; o[1] = f32x16{}; f32x16 negm = f32x16{};
    const int qrel = wid * 32 + r32;
    const int vb0 = (int)(lds0 + L_V) + ((lane >> 4) & 1) * 32 + (lane & 3) * 8 + (4 * hi + ((lane & 15) >> 2)) * 64;
    ATT_WAIT_BAR();
    for (int t = T0; t < NT; ++t) {
        const int cur = t & 1;
        float bnext = 0.f;
        if (t + 1 < NT) { ATT_DMA(t + 1, cur ^ 1); if (BIAS && wid == 0) bnext = cumh[(size_t)((t + 1) * 64 + lane) * 8]; }
        f32x16 p0, p1;
        { const char* kb = shm + L_K + cur * KSLOT + hi * 1024 + r32 * 16;
#pragma unroll
          for (int d0 = 0; d0 < ND; ++d0) { const bf16x8 b0 = *reinterpret_cast<const bf16x8*>(kb + d0 * 2048); const bf16x8 b1 = *reinterpret_cast<const bf16x8*>(kb + d0 * 2048 + 512);
            if (d0 == 0) { p0 = __builtin_amdgcn_mfma_f32_32x32x16_bf16(b0, qr[0], negm, 0, 0, 0); p1 = __builtin_amdgcn_mfma_f32_32x32x16_bf16(b1, qr[0], negm, 0, 0, 0); }
            else { p0 = __builtin_amdgcn_mfma_f32_32x32x16_bf16(b0, qr[d0], p0, 0, 0, 0); p1 = __builtin_amdgcn_mfma_f32_32x32x16_bf16(b1, qr[d0], p1, 0, 0, 0); } } }
        if (BIAS) { const float* bb = Bs + cur * 64 + 4 * hi;
#pragma unroll
            for (int g = 0; g < 4; ++g) { const f32x4 x0 = *(const f32x4*)(bb + 8 * g), x1 = *(const f32x4*)(bb + 32 + 8 * g);
#pragma unroll
                for (int e = 0; e < 4; ++e) { p0[4 * g + e] += x0[e]; p1[4 * g + e] += x1[e]; } } }
        if (t >= NT - 4) { const int kb0 = 64 * (t - (NT - 4)) + 4 * hi;
#pragma unroll
            for (int r = 0; r < 16; ++r) { const int kv = kb0 + (r & 3) + 8 * (r >> 2); if (kv > qrel) p0[r] = -INFINITY; if (kv + 32 > qrel) p1[r] = -INFINITY; } }
        float rm = fmaxf(p0[0], p1[0]);
#pragma unroll
        for (int r = 1; r < 16; ++r) rm = fmaxf(rm, fmaxf(p0[r], p1[r]));
        { auto rr = __builtin_amdgcn_permlane32_swap(__float_as_uint(rm), __float_as_uint(rm), false, false); rm = fmaxf(__uint_as_float(rr[0]), __uint_as_float(rr[1])); }
        bool resc = false;
        if (t == T0) { mhat = rm;
#pragma unroll
            for (int r = 0; r < 16; ++r) { p0[r] -= rm; p1[r] -= rm; }
#pragma unroll
            for (int r = 0; r < 16; ++r) negm[r] = -mhat;
        } else if (__any(rm > 8.0f)) { const float dl = fmaxf(rm, 0.f); mhat += dl;
#pragma unroll
            for (int r = 0; r < 16; ++r) { p0[r] -= dl; p1[r] -= dl; }
#pragma unroll
            for (int r = 0; r < 16; ++r) negm[r] = -mhat;
            const float f = __builtin_amdgcn_exp2f(-dl); l_reg *= f; if (hi == 0) wsf[r32] = f; resc = true; }
        float sacc = 0.f;
#pragma unroll
        for (int r = 0; r < 16; ++r) { p0[r] = __builtin_amdgcn_exp2f(p0[r]); p1[r] = __builtin_amdgcn_exp2f(p1[r]); sacc += p0[r] + p1[r]; }
        l_reg += sacc;
        u32x4 pw0, pw1, pw2, pw3;
        pw0 = (u32x4){cvtpk(p0[0], p0[1]), cvtpk(p0[2], p0[3]), cvtpk(p0[4], p0[5]), cvtpk(p0[6], p0[7])}; pw1 = (u32x4){cvtpk(p0[8], p0[9]), cvtpk(p0[10], p0[11]), cvtpk(p0[12], p0[13]), cvtpk(p0[14], p0[15])};
        pw2 = (u32x4){cvtpk(p1[0], p1[1]), cvtpk(p1[2], p1[3]), cvtpk(p1[4], p1[5]), cvtpk(p1[6], p1[7])}; pw3 = (u32x4){cvtpk(p1[8], p1[9]), cvtpk(p1[10], p1[11]), cvtpk(p1[12], p1[13]), cvtpk(p1[14], p1[15])};
        if (resc) { asm volatile("s_waitcnt lgkmcnt(0)" ::: "memory");
#pragma unroll
            for (int d_ = 0; d_ < 2; ++d_)
#pragma unroll
                for (int r = 0; r < 16; ++r) o[d_][r] *= wsf[crow(r, hi)]; }
        { const int vb = vb0 + cur * VSLOT;
#pragma unroll
          for (int d0 = 0; d0 < 2; ++d0) { s16x4 lo[4], hh[4];
#pragma unroll
            for (int ks = 0; ks < 4; ++ks) {
                asm volatile("ds_read_b64_tr_b16 %0,%1 offset:%c2" : "=&v"(lo[ks]) : "v"(vb), "i"(d0 * 4096 + ks * 1024) : "memory");
                asm volatile("ds_read_b64_tr_b16 %0,%1 offset:%c2" : "=&v"(hh[ks]) : "v"(vb), "i"(d0 * 4096 + ks * 1024 + 512) : "memory"); }
            asm volatile("s_waitcnt lgkmcnt(0)" ::: "memory"); __builtin_amdgcn_sched_barrier(0);
#define ATT_PK(k) (bf16x8){lo[k][0], lo[k][1], lo[k][2], lo[k][3], hh[k][0], hh[k][1], hh[k][2], hh[k][3]}
            o[d0] = __builtin_amdgcn_mfma_f32_32x32x16_bf16(__builtin_bit_cast(bf16x8, pw0), ATT_PK(0), o[d0], 0, 0, 0);
            o[d0] = __builtin_amdgcn_mfma_f32_32x32x16_bf16(__builtin_bit_cast(bf16x8, pw1), ATT_PK(1), o[d0], 0, 0, 0);
            o[d0] = __builtin_amdgcn_mfma_f32_32x32x16_bf16(__builtin_bit_cast(bf16x8, pw2), ATT_PK(2), o[d0], 0, 0, 0);
            o[d0] = __builtin_amdgcn_mfma_f32_32x32x16_bf16(__builtin_bit_cast(bf16x8, pw3), ATT_PK(3), o[d0], 0, 0, 0);
#undef ATT_PK
          } }
        if (BIAS && wid == 0 && t + 1 < NT) Bs[(cur ^ 1) * 64 + lane] = (cref - bnext) * 1.4426950408889634f;
        ATT_WAIT_BAR();
    }
    { auto rr = __builtin_amdgcn_permlane32_swap(__float_as_uint(l_reg), __float_as_uint(l_reg), false, false); l_reg = __uint_as_float(rr[0]) + __uint_as_float(rr[1]); }
    if (hi == 0) wsf[32 + r32] = l_reg; asm volatile("s_waitcnt lgkmcnt(0)" ::: "memory");
    float rli[16];
#pragma unroll
    for (int r = 0; r < 16; ++r) rli[r] = __builtin_amdgcn_rcpf(wsf[32 + crow(r, hi)]);
    bf16* Ow = Oh + (size_t)(q0 + wid * 32) * DM;
    { bf16* stg = (bf16*)(shm + L_OST) + wid * 2048;
#pragma unroll
      for (int r = 0; r < 16; ++r) { const int orow = crow(r, hi);
#pragma unroll
        for (int d0 = 0; d0 < 2; ++d0) stg[orow * 64 + d0 * 32 + r32] = (bf16)f2bf(o[d0][r] * rli[r]); }
      asm volatile("s_waitcnt lgkmcnt(0)" ::: "memory");
#pragma unroll
      for (int i = 0; i < 4; ++i) { const int row = i * 8 + (lane >> 3), ch = lane & 7; const u32x4 v = *(const u32x4*)(stg + row * 64 + ch * 8); *(u32x4*)(Ow + (size_t)row * DM + ch * 8) = v; } }
    asm volatile("s_waitcnt lgkmcnt(0)\n\ts_barrier" ::: "memory");
#undef ATT_DMA
}
}

constexpr int CW_AQ = 2048;
__device__ __forceinline__ void phase_attn_mfma(Frame& F, int j) {
    const bf16* PROJ = (const bf16*)(F.ws + WS_PROJ); const bf16* QM = (const bf16*)(F.ws + WS_QM); const bf16* KVB = (const bf16*)(F.ws + WS_KVB); const bf16* KM = (const bf16*)(F.ws + WS_KM);
    const float* CUM = (const float*)(F.ws + WS_CUM); bf16* MIX = (bf16*)(F.ws + WS_MIX);
    char* shm = (char*)(F.lds + RING_OFF);
    const int vcu = (F.G % 8 == 0) ? (F.bid % 8) * (F.G / 8) + F.bid / 8 : F.bid;
#pragma unroll 1
    for (int p = vcu; p < 512; p += F.G) { const int combo = p >> 5, s = p & 31, b = combo >> 3, h = combo & 7; const size_t rb = (size_t)b * SEQ;
#pragma unroll 1
        for (int half = 0; half < 2; ++half) { const int qb = half ? 63 - s : s;
            att::attn_unit<96, false>(F.tid, qb, QM + rb * 768 + h * 96, 768, KM + rb * 768 + h * 96, 768, KVB + rb * 1024 + h * 128 + 64, 1024, nullptr, MIX + rb * DM + 512 + h * 64, shm, 0.f); } }
    float gq = fabsf(kin(I_FOX_QN)[j * 64 + F.lane]), gk = fabsf(kin(I_FOX_KN)[j * 64 + F.lane]);
#pragma unroll
    for (int o = 1; o < 64; o <<= 1) { gq = fmaxf(gq, __shfl_xor(gq, o)); gk = fmaxf(gk, __shfl_xor(gk, o)); }
    const float margin = 2.0f * 1.02f * 64.0f * gq * gk * C2_FOX;
    LAS int* qslot = (LAS int*)(F.lds + LDSCTL_OFF + 64);
#pragma unroll 1
    for (;;) {
        if (F.tid == 0) *qslot = (int)__hip_atomic_fetch_add(F.ctl + CW_AQ + 64 * j, 1u, __ATOMIC_RELAXED, __HIP_MEMORY_SCOPE_AGENT);
        __syncthreads(); const int u = __builtin_amdgcn_readfirstlane(*qslot); __syncthreads();
        if (u >= 1024) break;
        const int qb = 63 - (u >> 4), combo = u & 15, b = combo >> 3, h = combo & 7; const size_t rb = (size_t)b * SEQ;
        att::attn_unit<64, true>(F.tid, qb, PROJ + rb * EVEN_INP + E_FQ + h * 64, EVEN_INP, PROJ + rb * EVEN_INP + E_FK + h * 64, EVEN_INP, PROJ + rb * EVEN_INP + E_FV + h * 64, EVEN_INP, CUM + rb * 8 + h, MIX + rb * DM + h * 64, shm, margin);
    }
}
constexpr size_t WS_S5_MT = WS_Y2;
constexpr size_t WS_S5_PT = WS_S5_MT + 72 * MiB;
constexpr size_t WS_S5_AX = WS_S5_PT + 16 * MiB;
constexpr size_t WS_S5_XLOC = WS_S5_AX + 36 * MiB;
static_assert(WS_S5_XLOC + 8 * MiB <= WS_Y2 + 144 * MiB, "s5 overlay");

__device__ __forceinline__ void s5_build(Frame& F, int j) {
    if (F.bid >= 256) return;
    const int g = F.bid >> 3, part = F.bid & 7, tid = F.tid, lane = F.lane, wave = F.wave;
    LAS float* pwr = (LAS float*)(F.lds + RING_OFF);
    LAS float* pwi = pwr + 65 * 64;
    LAS float* bbr = pwi + 65 * 64;
    LAS float* bbi = bbr + 1024;
    LAS float* crs = bbi + 1024;
    LAS float* cis = crs + 1024;
    LAS bf16* ktab = (LAS bf16*)(cis + 1024);
    const float dt = expf(kin(I_S5_LS)[j * 32 + g]);
    const float* are = kin(I_S5_ARE) + (size_t)(j * 32 + g) * 64; const float* aim = kin(I_S5_AIM) + (size_t)(j * 32 + g) * 64;
    for (int e = tid; e < 65 * 64; e += 512) { const int d = e >> 6, p = e & 63; const float lr = fminf(are[p], -1e-4f), li = aim[p];
        const float mag = expf(lr * dt * (float)d); float sn, cs; sincosf(li * dt * (float)d, &sn, &cs); pwr[e] = mag * cs; pwi[e] = mag * sn; }
    for (int e = tid; e < 1024; e += 512) { const int p = e >> 4, c = e & 15; const float lr = fminf(are[p], -1e-4f), li = aim[p];
        const float mag = expf(lr * dt); float sn, cs; sincosf(li * dt, &sn, &cs); const float abr = mag * cs, abi = mag * sn;
        const float den = lr * lr + li * li, nr = abr - 1.0f, ni = abi; const float gr = (nr * lr + ni * li) / den, gi = (ni * lr - nr * li) / den;
        const float br = kin(I_S5_BRE)[((size_t)(j * 32 + g) * 64 + p) * 16 + c], bi = kin(I_S5_BIM)[((size_t)(j * 32 + g) * 64 + p) * 16 + c];
        bbr[e] = gr * br - gi * bi; bbi[e] = gr * bi + gi * br; }
    for (int e = tid; e < 1024; e += 512) { crs[e] = kin(I_S5_CRE)[(size_t)(j * 32 + g) * 1024 + e]; cis[e] = kin(I_S5_CIM)[(size_t)(j * 32 + g) * 1024 + e]; }
    __syncthreads();
    { const int cc = tid >> 1, c = cc >> 4, c2 = cc & 15, ph = tid & 1;
      float er[32], ei[32];
#pragma unroll
      for (int pp = 0; pp < 32; ++pp) { const int p = 32 * ph + pp; const float xr = crs[c * 64 + p], xi = cis[c * 64 + p], yr = bbr[p * 16 + c2], yi = bbi[p * 16 + c2]; er[pp] = xr * yr - xi * yi; ei[pp] = xr * yi + xi * yr; }
#pragma unroll 1
      for (int d = 0; d < 64; ++d) { float s = 0.f; const LAS float* wr_ = pwr + d * 64 + 32 * ph; const LAS float* wi_ = pwi + d * 64 + 32 * ph;
#pragma unroll
          for (int pp = 0; pp < 32; ++pp) s += wr_[pp] * er[pp] - wi_[pp] * ei[pp];
          s += __shfl_xor(s, 1);
          if (ph == 0) ktab[(d * 16 + c) * 16 + c2] = (bf16)f2bf(s); } }
    __syncthreads();
    bf16* MT = (bf16*)(F.ws + WS_S5_MT) + (size_t)g * 1024 * 1152;
#pragma unroll 1
    for (int rr = wave; rr < 128; rr += 8) { const int i = part * 8 + (rr >> 4), c = rr & 15; bf16* row = MT + (size_t)(i * 16 + c) * 1152;
        v4u a = {0u, 0u, 0u, 0u}, b = {0u, 0u, 0u, 0u};
        if (lane <= i) { const LAS v4u* src = (const LAS v4u*)(ktab + ((i - lane) * 16 + c) * 16); a = src[0]; b = src[1]; }
        *(v4u*)(row + lane * 16) = a; *(v4u*)(row + lane * 16 + 8) = b;
        { const int p = lane; const float xr = crs[c * 64 + p], xi = cis[c * 64 + p], wr_ = pwr[(i + 1) * 64 + p], wi_ = pwi[(i + 1) * 64 + p];
          row[1024 + p] = (bf16)f2bf(xr * wr_ - xi * wi_); row[1088 + p] = (bf16)f2bf(-(xr * wi_ + xi * wr_)); } }
    bf16* PT = (bf16*)(F.ws + WS_S5_PT) + (size_t)g * 256 * 1024;
#pragma unroll 1
    for (int rr = wave; rr < 32; rr += 8) { const int n = part * 32 + rr; bf16* row = PT + (size_t)n * 1024 + lane * 16;
        unsigned o[8];
        if (n < 128) { const int p = n & 63, im = n >> 6; const float wr_ = pwr[(63 - lane) * 64 + p], wi_ = pwi[(63 - lane) * 64 + p];
#pragma unroll
            for (int q = 0; q < 8; ++q) { const float y0r = bbr[p * 16 + 2 * q], y0i = bbi[p * 16 + 2 * q], y1r = bbr[p * 16 + 2 * q + 1], y1i = bbi[p * 16 + 2 * q + 1];
                const float v0 = im ? (wr_ * y0i + wi_ * y0r) : (wr_ * y0r - wi_ * y0i), v1 = im ? (wr_ * y1i + wi_ * y1r) : (wr_ * y1r - wi_ * y1i); o[q] = pk2(v0, v1); }
        } else {
#pragma unroll
            for (int q = 0; q < 8; ++q) o[q] = 0u; }
        *(v4u*)row = (v4u){o[0], o[1], o[2], o[3]}; *(v4u*)(row + 8) = (v4u){o[4], o[5], o[6], o[7]}; }
    __syncthreads();
}
__device__ __forceinline__ void s5_repack(Frame& F) {
    const bf16* PROJ = (const bf16*)(F.ws + WS_PROJ); bf16* AX = (bf16*)(F.ws + WS_S5_AX);
    const int gt = F.bid * 512 + F.tid, NT = F.G * 512;
    for (int e = gt; e < NTOK * 32; e += NT) { const int m = e >> 5, g = e & 31; const int b = m / SEQ, t = m % SEQ, n = t >> 6, s = t & 63;
        const v4u* src = (const v4u*)(PROJ + (size_t)m * ODD_INP + O_U + g * 16); v4u* dst = (v4u*)(AX + ((size_t)g * 512 + b * 256 + n) * 1152 + s * 16);
        const v4u x0 = src[0], x1 = src[1]; dst[0] = x0; dst[1] = x1; }
}
struct S5POrder {
    int G, c;
    __device__ bool next(int i, pg8::Unit& u) const { const int L = i * G + c; if (L >= 64) return false; u.aux = L >> 1; u.pm = L & 1; u.pn = 0; return true; }
    __device__ __forceinline__ const char* a_base(const pg8::Gemm& g, const pg8::Unit& u) const { return (const char*)g.A + ((size_t)u.aux * 512 + u.pm * 256) * 1152 * 2; }
    __device__ __forceinline__ const char* b_base(const pg8::Gemm& g, const pg8::Unit& u) const { return (const char*)g.Bt + (size_t)u.aux * 256 * 1024 * 2; }
};
struct S5PEpi {
    static constexpr bool PERM = false;
    float* X;
    __device__ __forceinline__ void operator()(const pg8::f32x4 (&acc)[2][2][4][2], const pg8::Unit& u, int wr, int wc, int fr, int fq) const {
        const int row0 = u.pm * 256 + wr * 64 + fr; const int col0 = wc * 32 + 4 * fq;
#pragma unroll
        for (int ai = 0; ai < 2; ++ai)
#pragma unroll
            for (int m = 0; m < 4; ++m) { float* rowp = X + ((size_t)u.aux * 512 + row0 + ai * 128 + m * 16) * 128 + col0;
#pragma unroll
                for (int n = 0; n < 2; ++n) *(pg8::f32x4*)(rowp + n * 16) = acc[ai][0][m][n]; }
    }
};
__device__ __forceinline__ void s5_scan(Frame& F, int j) {
    const int gw = F.bid * NWAVES + F.wave; if (gw >= 64) return;
    const int g = gw >> 1, b = gw & 1, p = F.lane;
    const float lr = fminf(kin(I_S5_ARE)[(size_t)(j * 32 + g) * 64 + p], -1e-4f), li = kin(I_S5_AIM)[(size_t)(j * 32 + g) * 64 + p]; const float dt = expf(kin(I_S5_LS)[j * 32 + g]);
    const float mag = expf(lr * dt * 64.f); float sn, cs; sincosf(li * dt * 64.f, &sn, &cs); const float ar = mag * cs, ai = mag * sn;
    const float* X = (const float*)(F.ws + WS_S5_XLOC) + ((size_t)g * 512 + b * 256) * 128; bf16* AX = (bf16*)(F.ws + WS_S5_AX) + ((size_t)g * 512 + b * 256) * 1152 + 1024;
    float xr = 0.f, xi = 0.f; float cr[8], ci[8], nr[8], ni[8];
#pragma unroll
    for (int q = 0; q < 8; ++q) { cr[q] = X[(size_t)q * 128 + p]; ci[q] = X[(size_t)q * 128 + 64 + p]; }
    for (int n0 = 0; n0 < 256; n0 += 8) { const int nn = (n0 + 8 < 256) ? n0 + 8 : n0;
#pragma unroll
        for (int q = 0; q < 8; ++q) { nr[q] = X[(size_t)(nn + q) * 128 + p]; ni[q] = X[(size_t)(nn + q) * 128 + 64 + p]; }
#pragma unroll
        for (int q = 0; q < 8; ++q) { AX[(size_t)(n0 + q) * 1152 + p] = (bf16)f2bf(xr); AX[(size_t)(n0 + q) * 1152 + 64 + p] = (bf16)f2bf(xi);
            const float tr = ar * xr - ai * xi + cr[q], ti = ar * xi + ai * xr + ci[q]; xr = tr; xi = ti; }
#pragma unroll
        for (int q = 0; q < 8; ++q) { cr[q] = nr[q]; ci[q] = ni[q]; } }
}
struct S5MOrder {
    int G, c;
    __device__ bool next(int i, pg8::Unit& u) const { const int L = i * G + c; if (L >= 256) return false; u.aux = L >> 3; u.pm = (L >> 2) & 1; u.pn = L & 3; return true; }
    __device__ __forceinline__ const char* a_base(const pg8::Gemm& g, const pg8::Unit& u) const { return (const char*)g.A + ((size_t)u.aux * 512 + u.pm * 256) * 1152 * 2; }
    __device__ __forceinline__ const char* b_base(const pg8::Gemm& g, const pg8::Unit& u) const { return (const char*)g.Bt + ((size_t)u.aux * 1024 + u.pn * 256) * 1152 * 2; }
};
struct S5MEpi {
    static constexpr bool PERM = true;
    bf16* HG; const bf16* PROJ; const float* dsk;
    __device__ __forceinline__ void operator()(const pg8::f32x4 (&acc)[2][2][4][2], const pg8::Unit& u, int wr, int wc, int fr, int fq) const {
        const int g = u.aux; const int row0 = u.pm * 256 + wr * 64 + fr; const int col0 = u.pn * 256 + wc * 32 + 8 * fq;
        const pg8::f32x4 d0 = *(const pg8::f32x4*)(dsk + g * 16 + (col0 & 15)), d1 = *(const pg8::f32x4*)(dsk + g * 16 + (col0 & 15) + 4);
#pragma unroll
        for (int ai = 0; ai < 2; ++ai)
#pragma unroll
            for (int m = 0; m < 4; ++m) { const int rg = row0 + ai * 128 + m * 16; const int b = rg >> 8, n = rg & 255;
#pragma unroll
                for (int bj = 0; bj < 2; ++bj) { const int col = col0 + bj * 128; const int i = col >> 4, c0 = col & 15; const size_t tok = (size_t)b * SEQ + n * 64 + i;
                    const pg8::u32x4 uw = *(const pg8::u32x4*)(PROJ + tok * ODD_INP + O_U + g * 16 + c0); const pg8::f32x4 v0 = acc[ai][bj][m][0], v1 = acc[ai][bj][m][1];
                    pg8::u32x4 w; w.x = pk2(gelu_tanh(v0[0] + d0[0] * bflo(uw.x)), gelu_tanh(v0[1] + d0[1] * bfhi(uw.x))); w.y = pk2(gelu_tanh(v0[2] + d0[2] * bflo(uw.y)), gelu_tanh(v0[3] + d0[3] * bfhi(uw.y)));
                    w.z = pk2(gelu_tanh(v1[0] + d1[0] * bflo(uw.z)), gelu_tanh(v1[1] + d1[1] * bfhi(uw.z))); w.w = pk2(gelu_tanh(v1[2] + d1[2] * bflo(uw.w)), gelu_tanh(v1[3] + d1[3] * bfhi(uw.w)));
                    *(pg8::u32x4*)(HG + tok * 512 + g * 16 + c0) = w; } }
    }
};
namespace gdn {
typedef short s16x4 __attribute__((ext_vector_type(4)));
#define GDN_MFMA(a, b, c) __builtin_amdgcn_mfma_f32_16x16x16bf16_1k(a, b, c, 0, 0, 0)
__device__ __forceinline__ float fsig(float x) { return __builtin_amdgcn_rcpf(1.0f + __expf(-x)); }
__device__ __forceinline__ float bperm(float v, int src_lane) { return __int_as_float(__builtin_amdgcn_ds_bpermute(src_lane << 2, __float_as_int(v))); }
__device__ __forceinline__ s16x4 pack4(float a, float b, float c, float d) { v2u w; w.x = pk2(a, b); w.y = pk2(c, d); return __builtin_bit_cast(s16x4, w); }
constexpr int NITEM = BATCH * 4 * (SEQ / 16);
constexpr int IMG_STRIDE = 144;
constexpr int WAVE_LDS = 1024 + 1024 + 3 * 16 * IMG_STRIDE * 2;
}
constexpr size_t WS_GDN_UB = WS_QG;
constexpr size_t WS_GDN_WT = WS_KG;
constexpr size_t WS_GDN_QD = WS_KG + 32 * MiB;
constexpr size_t WS_GDN_KD = WS_VG;
constexpr size_t WS_GDN_IT = WS_VG + 32 * MiB;

__device__ __forceinline__ void phase_gdn_g1(Frame& F, int j) {
    using namespace gdn;
    const bf16* PROJ = (const bf16*)(F.ws + WS_PROJ);
    const float* cw = kin(I_GDN_CONV) + (size_t)j * 4 * 1536;
    float* UB = (float*)(F.ws + WS_GDN_UB); bf16* WT = (bf16*)(F.ws + WS_GDN_WT); bf16* QD = (bf16*)(F.ws + WS_GDN_QD); bf16* KD = (bf16*)(F.ws + WS_GDN_KD); unsigned* ITE = (unsigned*)(F.ws + WS_GDN_IT);
    LAS float* Am = (LAS float*)(F.lds + RING_OFF + F.wave * WAVE_LDS); LAS float* Tm = Am + 256; LAS bf16* img = (LAS bf16*)(Tm + 256);
    const int gw = F.bid * NWAVES + F.wave, NGW = F.G * NWAVES;
#pragma unroll 1
    for (int item = gw; item < NITEM; item += NGW) {
        int lane = F.lane; asm volatile("" : "+v"(lane));
        const int tok = lane & 15, g4 = lane >> 4;
        const int b = item >> 12, h = (item >> 10) & 3, n = item & 1023; const int s0 = 16 * n + tok; const size_t m = (size_t)b * SEQ + s0;
        const size_t it = (size_t)item;
        const float gin = bf2f(PROJ[m * ODD_INP + O_GIN + h]), bin = bf2f(PROJ[m * ODD_INP + O_BETA + h]);
        const float gt = -expf(kin(I_GDN_ALOG)[j * 4 + h]) * softplusf_(gin + kin(I_GDN_DTB)[j * 4 + h]); const float beta = fsig(bin);
        float gc = gt;
#pragma unroll
        for (int off = 1; off < 16; off <<= 1) { const float t = bperm(gc, tok >= off ? lane - off : lane); if (tok >= off) gc += t; }
        const float glast = bperm(gc, lane | 15); const float eg = expf(gc), ekd = expf(glast - gc);
        LAS bf16* img2 = img + 16 * IMG_STRIDE; LAS bf16* img3 = img2 + 16 * IMG_STRIDE;
#define GDN_CONV(WSEL, X) do { _Pragma("unroll") for (int db = 0; db < 8; ++db) { const int ch = (WSEL) * 512 + h * 128 + 16 * db + 4 * g4; float a0 = 0.f, a1 = 0.f, a2 = 0.f, a3 = 0.f; \
            _Pragma("unroll") for (int tap = 0; tap < 4; ++tap) { if (s0 - 3 + tap >= 0) { const v2u x = *(const v2u*)(PROJ + (m - 3 + tap) * ODD_INP + O_Q + ch); const f32x4 wv = *(const f32x4*)(cw + tap * 1536 + ch); \
                a0 += wv.x * bflo(x.x); a1 += wv.y * bfhi(x.x); a2 += wv.z * bflo(x.y); a3 += wv.w * bfhi(x.y); } } \
            X[db][0] = a0 * fsig(a0); X[db][1] = a1 * fsig(a1); X[db][2] = a2 * fsig(a2); X[db][3] = a3 * fsig(a3); \
            if ((db & 3) == 3) asm volatile("" ::: "memory"); } } while (0)
        { float xv[8][4]; GDN_CONV(2, xv);
#pragma unroll
          for (int db = 0; db < 8; ++db) *(LAS s16x4*)(img + tok * IMG_STRIDE + 16 * db + 4 * g4) = pack4(xv[db][0] * beta, xv[db][1] * beta, xv[db][2] * beta, xv[db][3] * beta); }
        s16x4 Kf[8];
        { float xk[8][4]; GDN_CONV(1, xk); float sk = 0.f;
#pragma unroll
          for (int db = 0; db < 8; ++db)
#pragma unroll
              for (int e = 0; e < 4; ++e) sk += xk[db][e] * xk[db][e];
          sk += bperm(sk, lane ^ 16); sk += bperm(sk, lane ^ 32);
          const float rk = 1.0f / sqrtf(sk + RMS_EPS); const float s2 = rk * beta * eg, s3 = rk * ekd;
#pragma unroll
          for (int db = 0; db < 8; ++db) { const int o = tok * IMG_STRIDE + 16 * db + 4 * g4;
              *(LAS s16x4*)(img2 + o) = pack4(xk[db][0] * s2, xk[db][1] * s2, xk[db][2] * s2, xk[db][3] * s2);
              *(LAS s16x4*)(img3 + o) = pack4(xk[db][0] * s3, xk[db][1] * s3, xk[db][2] * s3, xk[db][3] * s3);
              Kf[db] = pack4(xk[db][0] * rk, xk[db][1] * rk, xk[db][2] * rk, xk[db][3] * rk); } }
        f32x4 Gacc = {0.f, 0.f, 0.f, 0.f}, Pacc = {0.f, 0.f, 0.f, 0.f};
        { float xqq[8][4]; GDN_CONV(0, xqq); float sq = 0.f;
#pragma unroll
          for (int db = 0; db < 8; ++db)
#pragma unroll
              for (int e = 0; e < 4; ++e) sq += xqq[db][e] * xqq[db][e];
          sq += bperm(sq, lane ^ 16); sq += bperm(sq, lane ^ 32);
          const float rq = (1.0f / sqrtf(sq + RMS_EPS)) * 0.08838834764831845f;
#pragma unroll
          for (int db = 0; db < 8; ++db) {
              *(s16x4*)(QD + ((it * 4 + (db >> 1)) * 64 + lane) * 8 + (db & 1) * 4) = pack4(xqq[db][0] * rq * eg, xqq[db][1] * rq * eg, xqq[db][2] * rq * eg, xqq[db][3] * rq * eg);
              const s16x4 Qf = pack4(xqq[db][0] * rq, xqq[db][1] * rq, xqq[db][2] * rq, xqq[db][3] * rq);
              Gacc = GDN_MFMA(Kf[db], Kf[db], Gacc); Pacc = GDN_MFMA(Kf[db], Qf, Pacc); } }
#undef GDN_CONV
        { float itv[4];
#pragma unroll
          for (int r = 0; r < 4; ++r) { const int i = 4 * g4 + r; const float gci = bperm(gc, i), bi = bperm(beta, i);
              const float da = (tok < i) ? expf(gci - gc) : 0.f;
              Am[i * 16 + tok] = bi * Gacc[r] * da;
              const float dp = (i <= tok) ? expf(gc - gci) : 0.f;
              itv[r] = Pacc[r] * dp; }
          v4u ite; ite.x = pk2(itv[0], itv[1]); ite.y = pk2(itv[2], itv[3]); ite.z = __float_as_uint(expf(glast)); ite.w = 0u;
          *(v4u*)(ITE + (it * 64 + lane) * 4) = ite; }
        LDS_WAIT();
        float Tc[16];
#pragma unroll
        for (int i = 0; i < 16; ++i) { float s = (i == tok) ? 1.f : 0.f;
#pragma unroll
            for (int jj = 0; jj < i; ++jj) s -= Am[i * 16 + jj] * Tc[jj];
            Tc[i] = s; }
#pragma unroll
        for (int r = 0; r < 4; ++r) Tm[(4 * g4 + r) * 16 + tok] = (g4 == 0) ? Tc[r] : (g4 == 1) ? Tc[4 + r] : (g4 == 2) ? Tc[8 + r] : Tc[12 + r];
        LDS_WAIT();
        const f32x4 trow = *(const LAS f32x4*)(Tm + tok * 16 + 4 * g4);
        const s16x4 Tf = pack4(trow.x, trow.y, trow.z, trow.w);
        const int traddr = (int)(uintptr_t)img + ((4 * g4 + ((lane & 15) >> 2)) * IMG_STRIDE + 4 * (lane & 3)) * 2;
#pragma unroll
        for (int cb = 0; cb < 8; ++cb) { s16x4 vf; asm volatile("ds_read_b64_tr_b16 %0, %1 offset:%c2\n\ts_waitcnt lgkmcnt(0)" : "=&v"(vf) : "v"(traddr), "i"(cb * 32) : "memory");
            const f32x4 z = {0.f, 0.f, 0.f, 0.f}; const f32x4 u = GDN_MFMA(Tf, vf, z);
            *(f32x4*)(UB + ((it * 8 + cb) * 64 + lane) * 4) = u; }
#pragma unroll
        for (int db = 0; db < 8; ++db) { s16x4 kf; asm volatile("ds_read_b64_tr_b16 %0, %1 offset:%c2\n\ts_waitcnt lgkmcnt(0)" : "=&v"(kf) : "v"(traddr), "i"(16 * IMG_STRIDE * 2 + db * 32) : "memory");
            const f32x4 z = {0.f, 0.f, 0.f, 0.f}; const f32x4 w = GDN_MFMA(kf, Tf, z);
            *(s16x4*)(WT + ((it * 4 + (db >> 1)) * 64 + lane) * 8 + (db & 1) * 4) = pack4(-w.x, -w.y, -w.z, -w.w); }
#pragma unroll
        for (int db = 0; db < 8; ++db) { s16x4 kf; asm volatile("ds_read_b64_tr_b16 %0, %1 offset:%c2\n\ts_waitcnt lgkmcnt(0)" : "=&v"(kf) : "v"(traddr), "i"(32 * IMG_STRIDE * 2 + db * 32) : "memory");
            *(s16x4*)(KD + ((it * 4 + (db >> 1)) * 64 + lane) * 8 + (db & 1) * 4) = kf; }
        LDS_WAIT();
    }
}

__device__ __forceinline__ void phase_gdn_g2(Frame& F) {
    using namespace gdn;
    if (F.bid >= 64 || F.wave != 0) return;
    const char* UB = (const char*)(F.ws + WS_GDN_UB); const char* WT = (const char*)(F.ws + WS_GDN_WT); const char* QD = (const char*)(F.ws + WS_GDN_QD); const char* KD = (const char*)(F.ws + WS_GDN_KD);
    const char* ITE = (const char*)(F.ws + WS_GDN_IT); float* OGN = (float*)(F.ws + WS_OG);
    const int lane = F.lane, bh = F.bid & 7, sl = F.bid >> 3;
    constexpr int SLOT = 14 * 1024, NSLOT = 5, AHEAD = 4;
    const unsigned ring = (unsigned)(uintptr_t)(F.lds + RING_OFF);
    const size_t it0 = (size_t)bh * 1024; const size_t lo16 = (size_t)lane * 16;
#define GDN_DMA(step) do { const size_t i_ = it0 + (step); const unsigned d_ = ring + (unsigned)(((step) % NSLOT) * SLOT); \
        att::glds16(UB + ((i_ * 8 + sl) * 64) * 16 + lo16, (unsigned)__builtin_amdgcn_readfirstlane(d_)); \
        _Pragma("unroll") for (int q_ = 0; q_ < 4; ++q_) { att::glds16(WT + ((i_ * 4 + q_) * 64) * 16 + lo16, (unsigned)__builtin_amdgcn_readfirstlane(d_ + (1 + q_) * 1024)); \
            att::glds16(QD + ((i_ * 4 + q_) * 64) * 16 + lo16, (unsigned)__builtin_amdgcn_readfirstlane(d_ + (5 + q_) * 1024)); \
            att::glds16(KD + ((i_ * 4 + q_) * 64) * 16 + lo16, (unsigned)__builtin_amdgcn_readfirstlane(d_ + (9 + q_) * 1024)); } \
        att::glds16(ITE + (i_ * 64) * 16 + lo16, (unsigned)__builtin_amdgcn_readfirstlane(d_ + 13 * 1024)); } while (0)
    f32x4 S[8];
#pragma unroll
    for (int db = 0; db < 8; ++db) S[db] = (f32x4){0.f, 0.f, 0.f, 0.f};
#pragma unroll 1
    for (int s = 0; s < AHEAD; ++s) GDN_DMA(s);
#pragma unroll 1
    for (int n = 0; n < 1024; ++n) {
        asm volatile("s_waitcnt lgkmcnt(0)" ::: "memory");
        if (n + AHEAD < 1024) { GDN_DMA(n + AHEAD); asm volatile("s_waitcnt vmcnt(56)" ::: "memory"); }
        else asm volatile("s_waitcnt vmcnt(0)" ::: "memory");
        const LAS char* sp = (const LAS char*)(F.lds + RING_OFF) + (n % NSLOT) * SLOT + lane * 16;
        const f32x4 u_c = *(const LAS f32x4*)sp; const v4u ite = *(const LAS v4u*)(sp + 13 * 1024);
        v4u wt[4], qd[4], kd[4];
#pragma unroll
        for (int q = 0; q < 4; ++q) { wt[q] = *(const LAS v4u*)(sp + (1 + q) * 1024); qd[q] = *(const LAS v4u*)(sp + (5 + q) * 1024); kd[q] = *(const LAS v4u*)(sp + (9 + q) * 1024); }
#define FR(v, h) __builtin_bit_cast(s16x4, (v2u){(h) ? (v).z : (v).x, (h) ? (v).w : (v).y})
        const float egl = __uint_as_float(ite.z); const s16x4 itf = __builtin_bit_cast(s16x4, (v2u){ite.x, ite.y});
        s16x4 Sb[8];
#pragma unroll
        for (int db = 0; db < 8; ++db) Sb[db] = pack4(S[db].x, S[db].y, S[db].z, S[db].w);
        f32x4 va = u_c, vb2 = {0.f, 0.f, 0.f, 0.f};
#pragma unroll
        for (int q = 0; q < 4; ++q) { va = GDN_MFMA(FR(wt[q], 0), Sb[2 * q], va); vb2 = GDN_MFMA(FR(wt[q], 1), Sb[2 * q + 1], vb2); }
        va = va + vb2;
        const s16x4 vb = pack4(va.x, va.y, va.z, va.w);
        f32x4 oa = {0.f, 0.f, 0.f, 0.f}, ob = {0.f, 0.f, 0.f, 0.f};
        oa = GDN_MFMA(itf, vb, oa);
#pragma unroll
        for (int q = 0; q < 4; ++q) { oa = GDN_MFMA(FR(qd[q], 0), Sb[2 * q], oa); ob = GDN_MFMA(FR(qd[q], 1), Sb[2 * q + 1], ob); }
        oa = oa + ob;
#pragma unroll
        for (int q = 0; q < 4; ++q) { const f32x4 s0 = S[2 * q] * egl, s1 = S[2 * q + 1] * egl; S[2 * q] = GDN_MFMA(FR(kd[q], 0), vb, s0); S[2 * q + 1] = GDN_MFMA(FR(kd[q], 1), vb, s1); }
        *(f32x4*)(OGN + (((it0 + n) * 8 + sl) * 64 + lane) * 4) = oa;
#undef FR
    }
#undef GDN_DMA
}
__device__ __forceinline__ void phase_gdn_out2(Frame& F, int j) {
    using namespace gdn;
    const float* OGN = (const float*)(F.ws + WS_OG); const bf16* PROJ = (const bf16*)(F.ws + WS_PROJ); bf16* MIX = (bf16*)(F.ws + WS_MIX);
    const float* on = kin(I_GDN_ONORM) + j * 128; const int lane = F.lane, c = lane & 15, g4 = lane >> 4;
    const int gw = F.bid * NWAVES + F.wave, NGW = F.G * NWAVES;
#pragma unroll 1
    for (int item = gw; item < NITEM; item += NGW) { const int b = item >> 12, h = (item >> 10) & 3, n = item & 1023;
        f32x4 o[8]; float ss[4] = {0.f, 0.f, 0.f, 0.f};
#pragma unroll
        for (int sl = 0; sl < 8; ++sl) { o[sl] = *(const f32x4*)(OGN + (((size_t)item * 8 + sl) * 64 + lane) * 4);
#pragma unroll
            for (int r = 0; r < 4; ++r) ss[r] += o[sl][r] * o[sl][r]; }
#pragma unroll
        for (int r = 0; r < 4; ++r) { ss[r] += __shfl_xor(ss[r], 1); ss[r] += __shfl_xor(ss[r], 2); ss[r] += __shfl_xor(ss[r], 4); ss[r] += __shfl_xor(ss[r], 8); ss[r] = 1.0f / sqrtf(ss[r] * (1.f / 128.f) + RMS_EPS); }
#pragma unroll
        for (int r = 0; r < 4; ++r) { const size_t tok = (size_t)b * SEQ + 16 * n + 4 * g4 + r;
#pragma unroll
            for (int sl = 0; sl < 8; ++sl) { const int col = 16 * sl + c; const float zz = bf2f(PROJ[tok * ODD_INP + O_Z + h * 128 + col]);
                MIX[tok * DM + 512 + h * 128 + col] = (bf16)f2bf(o[sl][r] * ss[r] * on[col] * (zz * fsig(zz))); } }
    }
}
constexpr int LSTEPS = 16;
constexpr int STEP_END = 1 + DEPTH * LSTEPS;
struct KArgs { Args a; int li, pad; };

#define FRAME Frame F; { int wv_ = wave0; asm volatile("" : "+s"(wv_)); int t_ = wv_ * 64 + (int)__builtin_amdgcn_mbcnt_hi(~0u, __builtin_amdgcn_mbcnt_lo(~0u, 0u)); asm volatile("" : "+v"(t_)); unsigned char* w_ = kws(); F.lds = lds0; F.ws = w_; F.ctl = (unsigned*)(w_ + WS_CTL); \
        F.tid = t_; F.lane = t_ & 63; F.wave = __builtin_amdgcn_readfirstlane(t_ >> 6); { int g_ = gridDim.x, b_ = blockIdx.x; asm volatile("" : "+s"(g_), "+s"(b_)); F.G = g_; F.bid = b_; } } unsigned char* const ws = F.ws; (void)ws
#ifndef PH_MASK
#define PH_MASK 0xffffffffu
#endif
#define EN(k) (((PH_MASK) >> (k)) & 1u)
#ifndef DUP_E
#define DUP_E 0u
#endif
#ifndef DUP_O
#define DUP_O 0u
#endif
#define NREP(s) ((((s) >= 1) && (((((((s) - 1) / LSTEPS) & 1) ? (DUP_O) : (DUP_E)) >> (((s) + LSTEPS - 1) % LSTEPS)) & 1u)) ? 2 : 1)
#define STEP(s) if (lo <= (s) && (s) < hi) for (int rep_ = 0; rep_ < NREP(s); ++rep_)
#define DRY(s) (NREP(s) == 2 && rep_ == 0)
#define ENDSTEP(s) do { if ((s) + 1 < hi) xcd_barrier(bar); } while (0)
#define LAUNDER_WS do {} while (0)


template <int layer> __device__ __forceinline__ void layer_body(const XcdBarrier& bar, const int lo, const int hi, LAS unsigned char* const lds0, const int wave0) {
        constexpr int sb = 1 + layer * LSTEPS, j = layer >> 1; constexpr bool even = (layer & 1) == 0;
        STEP(sb + 0) if constexpr (EN(0)) { FRAME;
            phase_norm(F, layer == 0 ? kin(I_X) : kout(), kin(I_NORM_MIX) + layer * DM, layer == 0 ? kout() : nullptr);
            moe_weights(F, layer); phase_pconv(F, layer);
            if constexpr (!even) { __syncthreads(); s5_build(F, j); }
            ENDSTEP(sb + 0);
        }
        STEP(sb + 1) if constexpr (EN(1)) { FRAME;
            { LAUNDER_WS; const int NP = even ? EVEN_INP : ODD_INP; const bf16* W = even ? (const bf16*)(ws + WS_W_EVIN) + (size_t)j * EVEN_INP * 1024 : (const bf16*)(ws + WS_W_ODIN) + (size_t)j * ODD_INP * 1024;
              pg8::Gemm g{(const bf16*)(ws + WS_ABF), W, 1024, 1024, 1024}; pg8::StaticOrder S; S.init(NTOK, NP, F.G, F.bid); pg8::EpiBf16 E{(bf16*)(ws + WS_PROJ), NP};
              pg8::gemm_phase<pg8::EpiBf16, pg8::StaticOrder>(F.lds + RING_OFF, g, S, E, F.tid); }
            { LAUNDER_WS; pg8::Gemm g{(const bf16*)(ws + WS_PBF), (const bf16*)(ws + WS_W_PLEP) + (size_t)layer * 1024 * 256, 256, 256, 256}; pg8::StaticOrder S; S.init(NTOK, 1024, F.G, F.bid); pg8::EpiBf16 E{(bf16*)(ws + WS_PP), 1024};
              pg8::gemm_phase<pg8::EpiBf16, pg8::StaticOrder>(F.lds + RING_OFF, g, S, E, F.tid); }
            ENDSTEP(sb + 1);
        }
        if constexpr (even) {
            STEP(sb + 2) if constexpr (EN(2)) { FRAME; phase_even_post(F, j, DRY(sb + 2)); ENDSTEP(sb + 2); }
            STEP(sb + 3) if constexpr (EN(3)) { FRAME;
#ifndef NO_QUP
                { LAUNDER_WS; pg8::Gemm g{(const bf16*)(ws + WS_CQN), (const bf16*)(ws + WS_W_QUP) + (size_t)j * 768 * 384, 384, 384, 384}; pg8::StaticOrder S; S.init(NTOK, 768, F.G, F.bid); pg8::EpiBf16 E{(bf16*)(ws + WS_QM), 768};
                  pg8::gemm_phase<pg8::EpiBf16, pg8::StaticOrder>(F.lds + RING_OFF, g, S, E, F.tid); }
#endif
#ifndef NO_KVUP
                { LAUNDER_WS; pg8::Gemm g{(const bf16*)(ws + WS_CKVN), (const bf16*)(ws + WS_W_KVUP) + (size_t)j * 1024 * 256, 256, 256, 256}; pg8::StaticOrder S; S.init(NTOK, 1024, F.G, F.bid); pg8::EpiBf16 E{(bf16*)(ws + WS_KVB), 1024};
                  pg8::gemm_phase<pg8::EpiBf16, pg8::StaticOrder>(F.lds + RING_OFF, g, S, E, F.tid); }
#endif
#ifndef NO_CUMSUM
                phase_cumsum(F);
#endif
                ENDSTEP(sb + 3);
            }
            STEP(sb + 4) if constexpr (EN(4)) { FRAME; phase_mla_post(F, j, DRY(sb + 4)); ENDSTEP(sb + 4); }
            STEP(sb + 5) if constexpr (EN(5)) { FRAME;
#ifdef ATTN_NAIVE
                phase_attn_naive(F);
#else
                phase_attn_mfma(F, j);
#endif
                ENDSTEP(sb + 5); }
        } else {
            STEP(sb + 2) if constexpr (EN(2)) { FRAME; s5_repack(F);
#ifdef GDN_NAIVE
                phase_gdn_prep(F, j);
#else
                phase_gdn_g1(F, j);
#endif
                ENDSTEP(sb + 2); }
            STEP(sb + 3) if constexpr (EN(3)) { FRAME;
                { pg8::Gemm g{(const bf16*)(ws + WS_S5_AX), (const bf16*)(ws + WS_S5_PT), 1024, 1152, 1024}; S5POrder S{F.G, F.bid}; S5PEpi E{(float*)(ws + WS_S5_XLOC)};
                  pg8::gemm_phase<S5PEpi, S5POrder>(F.lds + RING_OFF, g, S, E, F.tid); }
#ifdef GDN_NAIVE
                phase_gdn_naive(F);
#else
                phase_gdn_g2(F);
#endif
                ENDSTEP(sb + 3);
            }
            STEP(sb + 4) if constexpr (EN(4)) { FRAME; s5_scan(F, j);
#ifdef GDN_NAIVE
                phase_gdn_out(F, j);
#else
                phase_gdn_out2(F, j);
#endif
                ENDSTEP(sb + 4); }
            STEP(sb + 5) if constexpr (EN(5)) { FRAME;
                pg8::Gemm g{(const bf16*)(ws + WS_S5_AX), (const bf16*)(ws + WS_S5_MT), 1152, 1152, 1152}; S5MOrder S{F.G, F.bid}; S5MEpi E{(bf16*)(ws + WS_HG), (const bf16*)(ws + WS_PROJ), kin(I_S5_D) + j * 512};
                pg8::gemm_phase<S5MEpi, S5MOrder>(F.lds + RING_OFF, g, S, E, F.tid);
                ENDSTEP(sb + 5);
            }
            STEP(sb + 6) if constexpr (EN(6)) { FRAME;
                pg8::Gemm g{(const bf16*)(ws + WS_HG), (const bf16*)(ws + WS_W_GLU) + (size_t)j * 512 * 512, 512, 512, 512}; pg8::StaticOrder S; S.init(NTOK, 512, F.G, F.bid);
                pg8::EpiGlu E{(bf16*)(ws + WS_MIX), 1024, (const bf16*)(ws + WS_HG), 512, kin(I_S5_BGLU) + j * 512};
                pg8::gemm_phase<pg8::EpiGlu, pg8::StaticOrder>(F.lds + RING_OFF, g, S, E, F.tid);
                ENDSTEP(sb + 6);
            }
        }
        STEP(sb + 7) if constexpr (EN(7)) { FRAME;
            LAUNDER_WS; const bf16* W = even ? (const bf16*)(ws + WS_W_EVOUT) + (size_t)j * 1024 * 1024 : (const bf16*)(ws + WS_W_ODOUT) + (size_t)j * 1024 * 1024;
            pg8::Gemm g{(const bf16*)(ws + WS_MIX), W, 1024, 1024, 1024}; pg8::StaticOrder S; S.init(NTOK, 1024, F.G, F.bid); pg8::EpiResAdd E{DRY(sb + 7) ? (float*)(ws + WS_DUMMY) : kout(), 1024};
            pg8::gemm_phase<pg8::EpiResAdd, pg8::StaticOrder>(F.lds + RING_OFF, g, S, E, F.tid);
            ENDSTEP(sb + 7);
        }
        STEP(sb + 8) if constexpr (EN(8)) { FRAME; phase_router(F, layer, DRY(sb + 8)); ENDSTEP(sb + 8); }
        STEP(sb + 9) if constexpr (EN(9)) { FRAME; phase_moe_scatter(F, layer); ENDSTEP(sb + 9); }
        STEP(sb + 10) if constexpr (EN(10)) { FRAME;
            LAUNDER_WS; moe_tables(F, layer);
            const LAS int* rowbase = (const LAS int*)(F.lds + LDSCTL_OFF + LC_MOE);
            MoeOrder S{__builtin_amdgcn_readfirstlane(rowbase[34]), 4, F.G, F.bid, (const LAS unsigned char*)(F.lds + LDSCTL_OFF + LC_MOE + 192), (size_t)1024 * 1024 * 2};
            pg8::Gemm g{(const bf16*)(ws + WS_XG), (const bf16*)(ws + WS_W_MOEGU), 1024, 1024, 1024}; pg8::EpiSwiglu E{(bf16*)(ws + WS_HB), 512};
            pg8::gemm_phase<pg8::EpiSwiglu, MoeOrder>(F.lds + RING_OFF, g, S, E, F.tid);
            ENDSTEP(sb + 10);
        }
        STEP(sb + 11) if constexpr (EN(11)) { FRAME;
            LAUNDER_WS; moe_tables(F, layer);
            const LAS int* rowbase = (const LAS int*)(F.lds + LDSCTL_OFF + LC_MOE);
            MoeOrder S{__builtin_amdgcn_readfirstlane(rowbase[34]), 4, F.G, F.bid, (const LAS unsigned char*)(F.lds + LDSCTL_OFF + LC_MOE + 192), (size_t)1024 * 512 * 2};
            pg8::Gemm g{(const bf16*)(ws + WS_HB), (const bf16*)(ws + WS_W_MOED), 512, 512, 512}; pg8::EpiBf16 E{(bf16*)(ws + WS_Y2), 1024};
            pg8::gemm_phase<pg8::EpiBf16, MoeOrder>(F.lds + RING_OFF, g, S, E, F.tid);
            ENDSTEP(sb + 11);
        }
        STEP(sb + 12) if constexpr (EN(12)) { FRAME; phase_moe_combine(F, layer, DRY(sb + 12)); ENDSTEP(sb + 12); }
        STEP(sb + 13) if constexpr (EN(13)) { FRAME;
            LAUNDER_WS; pg8::Gemm g{(const bf16*)(ws + WS_ABF), (const bf16*)(ws + WS_W_PLEG) + (size_t)layer * 1024 * 1024, 1024, 1024, 1024}; pg8::StaticOrder S; S.init(NTOK, 1024, F.G, F.bid);
            pg8::EpiPle E{DRY(sb + 13) ? (float*)(ws + WS_DUMMY) : kout(), (const bf16*)(ws + WS_PP), kin(I_PLE_BG) + layer * DM, 1024};
            pg8::gemm_phase<pg8::EpiPle, pg8::StaticOrder>(F.lds + RING_OFF, g, S, E, F.tid);
            ENDSTEP(sb + 13);
        }
    }
__global__ void __launch_bounds__(NWAVES * 64, 2) mega_fwd(KArgs ka) {
    extern __shared__ __attribute__((aligned(16))) unsigned char lds_raw[];
    const Args& args = ka.a;
    LAS unsigned char* const lds0 = (LAS unsigned char*)lds_raw;
    const int wave0 = __builtin_amdgcn_readfirstlane((int)threadIdx.x >> 6);
    for (int u = threadIdx.x; u < (LDS_BYTES - LDSCTL_OFF) / 4; u += NWAVES * 64) ((LAS unsigned*)(lds0 + LDSCTL_OFF))[u] = 0u;
    __syncthreads();
    XcdBarrier bar = xcd_barrier_post((unsigned*)(kws() + WS_CTL) + CW_BAR + ka.li * XCD_BAR_WORDS, (volatile LAS unsigned*)(lds0 + LDSCTL_OFF + LC_BARST));
    const int lo = args.ph_lo, hi = args.ph_hi;
    STEP(0) if constexpr (EN(15)) { FRAME; prologue_weights(F); ENDSTEP(0); }
    layer_body<0>(bar, lo, hi, lds0, wave0); layer_body<1>(bar, lo, hi, lds0, wave0); layer_body<2>(bar, lo, hi, lds0, wave0); layer_body<3>(bar, lo, hi, lds0, wave0);
#undef STEP
#undef ENDSTEP
}

#ifndef MK_MODE
#define MK_MODE 0
#endif
extern "C" void kernel_launch(void* const* d_in, const int* in_sizes, int n_in, void* d_out, int out_size, void* d_ws, size_t ws_size, hipStream_t stream) {
    static int ready = 0;
    if (ready == 0) {
        if (n_in != N_IN || out_size != NTOK * DM || ws_size < WS_END) { fprintf(stderr, "kernel_launch: unexpected shapes n_in %d out %d ws %zu (need %zu)\n", n_in, out_size, ws_size, (size_t)WS_END); ready = -1; return; }
        if (hipFuncSetAttribute((const void*)mega_fwd, hipFuncAttributeMaxDynamicSharedMemorySize, LDS_BYTES) != hipSuccess) { fprintf(stderr, "kernel_launch: hipFuncSetAttribute failed\n"); ready = -1; return; }
        int per_cu = 0; (void)hipOccupancyMaxActiveBlocksPerMultiprocessor(&per_cu, (const void*)mega_fwd, NWAVES * 64, LDS_BYTES); (void)hipGetLastError();
        ready = 1;
    }
    if (ready < 0) return;
    (void)hipMemsetAsync((char*)d_ws + WS_CTL, 0, CTL_ZERO_BYTES, stream);
    KArgs ka{};
    for (int i = 0; i < N_IN; ++i) ka.a.in[i] = (const float*)d_in[i];
    ka.a.out = (float*)d_out; ka.a.ws = (unsigned char*)d_ws; ka.li = 0; ka.pad = 0;
    const int grid = 256;
#if MK_MODE == 1
    ka.a.ph_lo = 0; ka.a.ph_hi = STEP_END;
    hipLaunchKernelGGL(mega_fwd, dim3(grid), dim3(NWAVES * 64), LDS_BYTES, stream, ka);
#else
    for (int s = 0; s < STEP_END; ++s) {
        if (s > 0) { const int k = (s - 1) % LSTEPS, layer = (s - 1) / LSTEPS; const bool even = (layer & 1) == 0;
            if (k > 13) continue; if (k == 6 && even) continue; }
        ka.a.ph_lo = s; ka.a.ph_hi = s + 1;
        hipLaunchKernelGGL(mega_fwd, dim3(grid), dim3(NWAVES * 64), LDS_BYTES, stream, ka);
    }
#endif
}
```

```cpp
#include <hip/hip_runtime.h>
#include <cstdio>
#include <cstdint>
#define MK_MODE 1
namespace pg8 {
#define PG8_LAS __attribute__((address_space(3)))
typedef unsigned short bf16_t;
typedef short bf16x8 __attribute__((ext_vector_type(8)));
typedef float f32x4 __attribute__((ext_vector_type(4)));
typedef float f32x2 __attribute__((ext_vector_type(2)));
typedef unsigned u32x4 __attribute__((ext_vector_type(4)));
typedef unsigned u32x2 __attribute__((ext_vector_type(2)));
constexpr int BM = 256, BK = 64, HALF = 128, HTB = HALF * BK * 2  , STAGE_BYTES = 8 * HTB, NXCD = 8, WGM = 8;

__host__ __device__ __forceinline__ int lds_byte(int r, int c) { const int st = (r >> 4) * 2 + (c >> 5), rr = r & 15, cc = c & 31, ob = rr * 64 + cc * 2; return st * 1024 + (ob ^ (((ob >> 9) & 1) << 5)); }
__host__ __device__ __forceinline__ void stage_rc(int b, int& R, int& C) { const int st = b / 1024, sb = b % 1024, swz = sb ^ (((sb >> 9) & 1) << 5); R = (st >> 1) * 16 + swz / 64; C = (st & 1) * 32 + (swz % 64) / 2; }
__host__ __device__ __forceinline__ int perm32(int rho) { const int n = rho >> 4, i = rho & 15; return 8 * (i >> 2) + 4 * n + (i & 3); }

struct Unit { int pm, pn, aux; };
struct Gemm { const bf16_t* A; const bf16_t* Bt; int K, lda, ldb; };

struct StaticOrder {
    int nM, nN, nwg, G, c;
    __device__ void init(int M, int N, int G_, int c_) { nM = M / BM; nN = N / BM; nwg = nM * nN; G = G_; c = c_; }
    __device__ bool next(int i, Unit& u) const {
        const long L = (long)i * G + c; if (L >= nwg) return false;
        int wgid = (int)L; { const int q = nwg / NXCD, r = nwg % NXCD, xcd = wgid % NXCD, off = wgid / NXCD; wgid = (xcd < r ? xcd * (q + 1) : r * (q + 1) + (xcd - r) * q) + off; }
        const int nig = WGM * nN, gid = wgid / nig, fm = gid * WGM, gsz = (nM - fm) < WGM ? (nM - fm) : WGM;
        u.pm = fm + ((wgid % nig) % gsz); u.pn = (wgid % nig) / gsz; u.aux = 0; return true;
    }
    __device__ __forceinline__ const char* a_base(const Gemm& g, const Unit& u) const { return (const char*)g.A + (size_t)u.pm * BM * g.lda * 2; }
    __device__ __forceinline__ const char* b_base(const Gemm& g, const Unit& u) const { return (const char*)g.Bt + (size_t)u.pn * BM * g.ldb * 2; }
};

__device__ __forceinline__ unsigned cvt_pk_bf16(float lo, float hi) { unsigned r; asm volatile("v_cvt_pk_bf16_f32 %0, %1, %2" : "=v"(r) : "v"(lo), "v"(hi)); return r; }
__device__ __forceinline__ float bf_lo(unsigned w) { return __uint_as_float(w << 16); }
__device__ __forceinline__ float bf_hi(unsigned w) { return __uint_as_float(w & 0xffff0000u); }

struct EpiBf16 {
    static constexpr bool PERM = true;
    bf16_t* O; int ldc;
    __device__ __forceinline__ void operator()(const f32x4 (&acc)[2][2][4][2], const Unit& u, int wr, int wc, int fr, int fq) const {
        const int row0 = u.pm * BM + wr * 64 + fr; const int col0 = u.pn * BM + wc * 32 + 8 * fq;
#pragma unroll
        for (int ai = 0; ai < 2; ++ai)
#pragma unroll
            for (int m = 0; m < 4; ++m) { bf16_t* rowp = O + (size_t)(row0 + ai * HALF + m * 16) * ldc + col0;
#pragma unroll
                for (int bj = 0; bj < 2; ++bj) { const f32x4 v0 = acc[ai][bj][m][0], v1 = acc[ai][bj][m][1];
                    u32x4 w; w.x = cvt_pk_bf16(v0[0], v0[1]); w.y = cvt_pk_bf16(v0[2], v0[3]); w.z = cvt_pk_bf16(v1[0], v1[1]); w.w = cvt_pk_bf16(v1[2], v1[3]);
                    *(u32x4*)(rowp + bj * HALF) = w; } }
    }
};
struct EpiResAdd {
    static constexpr bool PERM = false;
    float* H; int ldc;
    __device__ __forceinline__ void operator()(const f32x4 (&acc)[2][2][4][2], const Unit& u, int wr, int wc, int fr, int fq) const {
        const int row0 = u.pm * BM + wr * 64 + fr; const int col0 = u.pn * BM + wc * 32 + 4 * fq;
#pragma unroll
        for (int ai = 0; ai < 2; ++ai)
#pragma unroll
            for (int m = 0; m < 4; ++m) { float* rowp = H + (size_t)(row0 + ai * HALF + m * 16) * ldc + col0;
#pragma unroll
                for (int bj = 0; bj < 2; ++bj)
#pragma unroll
                    for (int n = 0; n < 2; ++n) { f32x4* p = (f32x4*)(rowp + bj * HALF + n * 16); *p = *p + acc[ai][bj][m][n]; } }
    }
};
__device__ __forceinline__ float sigmoidf_(float x) { return 1.0f / (1.0f + __expf(-x)); }
struct EpiPle {
    static constexpr bool PERM = false;
    float* H; const bf16_t* PP; const float* bias; int ldc;
    __device__ __forceinline__ void operator()(const f32x4 (&acc)[2][2][4][2], const Unit& u, int wr, int wc, int fr, int fq) const {
        const int row0 = u.pm * BM + wr * 64 + fr; const int col0 = u.pn * BM + wc * 32 + 4 * fq;
#pragma unroll
        for (int ai = 0; ai < 2; ++ai)
#pragma unroll
            for (int m = 0; m < 4; ++m) { const size_t ro = (size_t)(row0 + ai * HALF + m * 16) * ldc + col0;
#pragma unroll
                for (int bj = 0; bj < 2; ++bj)
#pragma unroll
                    for (int n = 0; n < 2; ++n) { const int co = bj * HALF + n * 16; f32x4* p = (f32x4*)(H + ro + co); const u32x2 pw = *(const u32x2*)(PP + ro + co);
                        const f32x4 bv = *(const f32x4*)(bias + col0 + co); const f32x4 a = acc[ai][bj][m][n] + bv; f32x4 h = *p;
                        h[0] += sigmoidf_(a[0]) * bf_lo(pw.x); h[1] += sigmoidf_(a[1]) * bf_hi(pw.x); h[2] += sigmoidf_(a[2]) * bf_lo(pw.y); h[3] += sigmoidf_(a[3]) * bf_hi(pw.y); *p = h; } }
    }
};
struct EpiGlu {
    static constexpr bool PERM = true;
    bf16_t* O; int ldo; const bf16_t* HG; int ldh; const float* bias;
    __device__ __forceinline__ void operator()(const f32x4 (&acc)[2][2][4][2], const Unit& u, int wr, int wc, int fr, int fq) const {
        const int row0 = u.pm * BM + wr * 64 + fr; const int col0 = u.pn * BM + wc * 32 + 8 * fq;
#pragma unroll
        for (int ai = 0; ai < 2; ++ai)
#pragma unroll
            for (int m = 0; m < 4; ++m) { const size_t r = (size_t)(row0 + ai * HALF + m * 16);
#pragma unroll
                for (int bj = 0; bj < 2; ++bj) { const int c = col0 + bj * HALF; const u32x4 hw = *(const u32x4*)(HG + r * ldh + c);
                    const f32x4 b0 = *(const f32x4*)(bias + c), b1 = *(const f32x4*)(bias + c + 4); const f32x4 v0 = acc[ai][bj][m][0] + b0, v1 = acc[ai][bj][m][1] + b1;
                    u32x4 w; w.x = cvt_pk_bf16(bf_lo(hw.x) * sigmoidf_(v0[0]), bf_hi(hw.x) * sigmoidf_(v0[1])); w.y = cvt_pk_bf16(bf_lo(hw.y) * sigmoidf_(v0[2]), bf_hi(hw.y) * sigmoidf_(v0[3]));
                    w.z = cvt_pk_bf16(bf_lo(hw.z) * sigmoidf_(v1[0]), bf_hi(hw.z) * sigmoidf_(v1[1])); w.w = cvt_pk_bf16(bf_lo(hw.w) * sigmoidf_(v1[2]), bf_hi(hw.w) * sigmoidf_(v1[3]));
                    *(u32x4*)(O + r * ldo + c) = w; } }
    }
};
struct EpiSwiglu {
    static constexpr bool PERM = true;
    bf16_t* HB; int ldc;
    __device__ __forceinline__ void operator()(const f32x4 (&acc)[2][2][4][2], const Unit& u, int wr, int wc, int fr, int fq) const {
        const int row0 = u.pm * BM + wr * 64 + fr; const int col0 = u.pn * HALF + wc * 32 + 8 * fq;
#pragma unroll
        for (int ai = 0; ai < 2; ++ai)
#pragma unroll
            for (int m = 0; m < 4; ++m) { bf16_t* rowp = HB + (size_t)(row0 + ai * HALF + m * 16) * ldc + col0;
                const f32x4 g0 = acc[ai][0][m][0], g1 = acc[ai][0][m][1], u0 = acc[ai][1][m][0], u1 = acc[ai][1][m][1];
                u32x4 w; w.x = cvt_pk_bf16(g0[0] * sigmoidf_(g0[0]) * u0[0], g0[1] * sigmoidf_(g0[1]) * u0[1]); w.y = cvt_pk_bf16(g0[2] * sigmoidf_(g0[2]) * u0[2], g0[3] * sigmoidf_(g0[3]) * u0[3]);
                w.z = cvt_pk_bf16(g1[0] * sigmoidf_(g1[0]) * u1[0], g1[1] * sigmoidf_(g1[1]) * u1[1]); w.w = cvt_pk_bf16(g1[2] * sigmoidf_(g1[2]) * u1[2], g1[3] * sigmoidf_(g1[3]) * u1[3]);
                *(u32x4*)rowp = w; }
    }
};

template <class Epi, class Sched, bool ALIGN_EPI = true, bool SP2 = true>
__device__ __forceinline__ void gemm_phase(PG8_LAS unsigned char* lds, const Gemm g, const Sched& S, const Epi& E, const int tid) {
    const int wid = __builtin_amdgcn_readfirstlane(tid >> 6), lane = tid & 63, wr = wid >> 2, wc = wid & 3, fr = lane & 15, fq = lane >> 4;
    int K = g.K; asm volatile("" : "+s"(K));
    const int nt = K / BK;
    unsigned voffA[2], voffB[2];
#pragma unroll
    for (int i = 0; i < 2; ++i) { int R, C; stage_rc(tid * 16 + i * 8192, R, C); const int Rb = Epi::PERM ? ((R & ~31) + perm32(R & 31)) : R;
        voffA[i] = (unsigned)(R * g.lda + C) * 2u; voffB[i] = (unsigned)(Rb * g.ldb + C) * 2u; }
    const size_t kstep = (size_t)(BK * 2);
    const size_t hstepA = (size_t)HALF * g.lda * 2, hstepB = (size_t)HALF * g.ldb * 2;
    const unsigned ldsw = (unsigned)wid * 1024u;
    const int aoff = lds_byte(wr * 64 + fr, fq * 8), boff = lds_byte(wc * 32 + fr, fq * 8);
#define PG8_SA(b, h) (((b) * 2 + (h)) * HTB)
#define PG8_SB(b, h) ((4 + (b) * 2 + (h)) * HTB)
#define PG8_STAGE(bufoff, gbase, voff) do { _Pragma("unroll") for (int _i = 0; _i < 2; ++_i) \
        __builtin_amdgcn_global_load_lds((const unsigned*)((const char*)(gbase) + (voff)[_i]), (PG8_LAS unsigned*)(lds + (bufoff) + ldsw + _i * 8192), 16, 0, 0); } while (0)
#define PG8_LDA(dst, b, h) do { _Pragma("unroll") for (int m = 0; m < 4; ++m) _Pragma("unroll") for (int k = 0; k < 2; ++k) dst[m][k] = *(const PG8_LAS bf16x8*)(lds + PG8_SA(b, h) + aoff + m * 2048 + k * 1024); } while (0)
#define PG8_LDB(dst, b, h) do { _Pragma("unroll") for (int n = 0; n < 2; ++n) _Pragma("unroll") for (int k = 0; k < 2; ++k) dst[n][k] = *(const PG8_LAS bf16x8*)(lds + PG8_SB(b, h) + boff + n * 2048 + k * 1024); } while (0)
#define PG8_MMA(ai, bj, At, Bt) do { __builtin_amdgcn_s_setprio(1); _Pragma("unroll") for (int m = 0; m < 4; ++m) _Pragma("unroll") for (int n = 0; n < 2; ++n) _Pragma("unroll") for (int k = 0; k < 2; ++k) \
        acc[ai][bj][m][n] = __builtin_amdgcn_mfma_f32_16x16x32_bf16(Bt[n][k], At[m][k], acc[ai][bj][m][n], 0, 0, 0); __builtin_amdgcn_s_setprio(0); } while (0)
#define PG8_WAIT_V(n) asm volatile("s_waitcnt vmcnt(" #n ")" ::: "memory")
#define PG8_WAIT_L(n) asm volatile("s_waitcnt lgkmcnt(" #n ")" ::: "memory")
#define PG8_BAR __builtin_amdgcn_s_barrier()
#define PG8_SCHED __builtin_amdgcn_sched_barrier(0)
    Unit cur, nxt; int ui = 0;
    if (!S.next(0, cur)) return;
    f32x4 acc[2][2][4][2];
#pragma unroll
    for (int a = 0; a < 2; ++a)
#pragma unroll
        for (int b = 0; b < 2; ++b)
#pragma unroll
            for (int m = 0; m < 4; ++m)
#pragma unroll
                for (int n = 0; n < 2; ++n) acc[a][b][m][n] = (f32x4){0.f, 0.f, 0.f, 0.f};
    bf16x8 At[4][2], B0[2][2], B1[2][2];
    const char* cA = S.a_base(g, cur); const char* cB = S.b_base(g, cur);
    if constexpr (SP2) {
        PG8_STAGE(PG8_SB(0, 0), cB, voffB); PG8_STAGE(PG8_SB(0, 1), cB + hstepB, voffB); PG8_STAGE(PG8_SA(0, 0), cA, voffA); PG8_STAGE(PG8_SA(0, 1), cA + hstepA, voffA);
        if (wr == 1) PG8_BAR;
        PG8_WAIT_V(2); PG8_BAR;
        PG8_STAGE(PG8_SB(1, 0), cB + kstep, voffB); PG8_STAGE(PG8_SA(1, 0), cA + kstep, voffA); PG8_STAGE(PG8_SB(1, 1), cB + hstepB + kstep, voffB);
        PG8_WAIT_V(6); PG8_BAR;
    } else {
        PG8_STAGE(PG8_SB(0, 0), cB, voffB); PG8_STAGE(PG8_SA(0, 0), cA, voffA); PG8_STAGE(PG8_SB(0, 1), cB + hstepB, voffB); PG8_STAGE(PG8_SA(0, 1), cA + hstepA, voffA);
        if (wr == 1) PG8_BAR;
        PG8_WAIT_V(4); PG8_BAR;
        PG8_STAGE(PG8_SB(1, 0), cB + kstep, voffB); PG8_STAGE(PG8_SA(1, 0), cA + kstep, voffA); PG8_STAGE(PG8_SB(1, 1), cB + hstepB + kstep, voffB);
        PG8_WAIT_V(6); PG8_BAR;
    }
    for (;;) {
        const bool has_next = S.next(ui + 1, nxt);
        const char* nA = has_next ? S.a_base(g, nxt) : cA; const char* nB = has_next ? S.b_base(g, nxt) : cB;
        for (int t = 0; t < nt; t += 2) {
            const bool last = (t == nt - 2);
            const char* a1 = cA + (size_t)(t + 1) * kstep;
            const char* a2 = last ? nA : cA + (size_t)(t + 2) * kstep; const char* b2 = last ? nB : cB + (size_t)(t + 2) * kstep;
            const char* a3 = a2 + kstep; const char* b3 = b2 + kstep;
            if constexpr (SP2) {
            PG8_LDB(B0, 0, 0); PG8_LDB(B1, 0, 1); PG8_SCHED; PG8_LDA(At, 0, 0); PG8_STAGE(PG8_SA(1, 1), a1 + hstepA, voffA);
            PG8_WAIT_V(8); PG8_WAIT_L(0); PG8_BAR; PG8_MMA(0, 0, At, B0); PG8_MMA(0, 1, At, B1); PG8_BAR; PG8_SCHED;
            PG8_LDA(At, 0, 1); PG8_STAGE(PG8_SB(0, 0), b2, voffB); PG8_STAGE(PG8_SB(0, 1), b2 + hstepB, voffB); PG8_STAGE(PG8_SA(0, 0), a2, voffA);
            PG8_WAIT_V(8); PG8_WAIT_L(0); PG8_BAR; PG8_MMA(1, 0, At, B0); PG8_MMA(1, 1, At, B1); PG8_BAR; PG8_SCHED;
            PG8_LDB(B0, 1, 0); PG8_LDB(B1, 1, 1); PG8_SCHED; PG8_LDA(At, 1, 0); PG8_STAGE(PG8_SA(0, 1), a2 + hstepA, voffA);
            PG8_WAIT_V(8); PG8_WAIT_L(0); PG8_BAR; PG8_MMA(0, 0, At, B0); PG8_MMA(0, 1, At, B1); PG8_BAR; PG8_SCHED;
            PG8_LDA(At, 1, 1); PG8_STAGE(PG8_SB(1, 0), b3, voffB); PG8_STAGE(PG8_SB(1, 1), b3 + hstepB, voffB); PG8_STAGE(PG8_SA(1, 0), a3, voffA);
            PG8_WAIT_V(8); PG8_WAIT_L(0); PG8_BAR; PG8_MMA(1, 0, At, B0); PG8_MMA(1, 1, At, B1); PG8_BAR; PG8_SCHED;
            } else {
            PG8_LDB(B0, 0, 0); PG8_SCHED; PG8_LDA(At, 0, 0); PG8_STAGE(PG8_SA(1, 1), a1 + hstepA, voffA);
            PG8_WAIT_L(8); PG8_BAR; PG8_WAIT_L(0); PG8_MMA(0, 0, At, B0); PG8_BAR; PG8_SCHED;
            PG8_LDB(B1, 0, 1); PG8_STAGE(PG8_SB(0, 0), b2, voffB);
            PG8_BAR; PG8_WAIT_L(0); PG8_MMA(0, 1, At, B1); PG8_BAR;
            PG8_LDA(At, 0, 1); PG8_STAGE(PG8_SA(0, 0), a2, voffA);
            PG8_BAR; PG8_WAIT_L(0); PG8_MMA(1, 0, At, B0); PG8_BAR; PG8_SCHED;
            PG8_STAGE(PG8_SB(0, 1), b2 + hstepB, voffB);
            PG8_WAIT_V(6); PG8_BAR; PG8_MMA(1, 1, At, B1); PG8_BAR;
            PG8_LDB(B0, 1, 0); PG8_SCHED; PG8_LDA(At, 1, 0); PG8_STAGE(PG8_SA(0, 1), a2 + hstepA, voffA);
            PG8_WAIT_L(8); PG8_BAR; PG8_WAIT_L(0); PG8_MMA(0, 0, At, B0); PG8_BAR; PG8_SCHED;
            PG8_LDB(B1, 1, 1); PG8_STAGE(PG8_SB(1, 0), b3, voffB);
            PG8_BAR; PG8_WAIT_L(0); PG8_MMA(0, 1, At, B1); PG8_BAR;
            PG8_LDA(At, 1, 1); PG8_STAGE(PG8_SA(1, 0), a3, voffA);
            PG8_BAR; PG8_WAIT_L(0); PG8_MMA(1, 0, At, B0); PG8_BAR; PG8_SCHED;
            PG8_STAGE(PG8_SB(1, 1), b3 + hstepB, voffB);
            PG8_WAIT_V(6); PG8_BAR; PG8_MMA(1, 1, At, B1); PG8_BAR;
            }
        }
        if constexpr (ALIGN_EPI) { if (wr == 0) PG8_BAR; }
        E(acc, cur, wr, wc, fr, fq);
        if (!has_next) break;
#pragma unroll
        for (int a = 0; a < 2; ++a)
#pragma unroll
            for (int b = 0; b < 2; ++b)
#pragma unroll
                for (int m = 0; m < 4; ++m)
#pragma unroll
                    for (int n = 0; n < 2; ++n) acc[a][b][m][n] = (f32x4){0.f, 0.f, 0.f, 0.f};
        cur = nxt; cA = nA; cB = nB; ++ui;
        if constexpr (ALIGN_EPI) { if (wr == 1) PG8_BAR; }
    }
    PG8_WAIT_V(0);
    if constexpr (!ALIGN_EPI) { if (wr == 0) PG8_BAR; }
    PG8_BAR;
#undef PG8_SA
#undef PG8_SB
#undef PG8_STAGE
#undef PG8_LDA
#undef PG8_LDB
#undef PG8_MMA
#undef PG8_WAIT_V
#undef PG8_WAIT_L
#undef PG8_BAR
#undef PG8_SCHED
}
}
#define LAS __attribute__((address_space(3)))
#define XB_TMO      128
#define XB_XCNT(j)  (256  + 64 * (j))
#define XB_XSUB(j)  (1280 + 64 * (j))
#define XB_XGEN(j)  (2304 + 64 * (j))
#define XB_TOP      3328
#define XB_TOPGEN   3392
#define XCD_BAR_WORDS 3456
#define XB_SPIN_CAP (1u << 22)

__device__ __forceinline__ unsigned xb_ld(unsigned* p)              { return __hip_atomic_load(p, __ATOMIC_RELAXED, __HIP_MEMORY_SCOPE_AGENT); }
__device__ __forceinline__ unsigned xb_add(unsigned* p, unsigned v) { return __hip_atomic_fetch_add(p, v, __ATOMIC_RELAXED, __HIP_MEMORY_SCOPE_AGENT); }
__device__ __forceinline__ unsigned xb_xcc_id() { return (unsigned)__builtin_amdgcn_s_getreg((3 << 11) | 20) & 0xFu; }
#define XB_SPIN(cond, bar) do { unsigned _sp = 0; while (cond) { __builtin_amdgcn_s_sleep(1); \
    if ((++_sp & 255u) == 0u) { if (xb_ld(&(bar)[XB_TMO])) break; if (_sp > XB_SPIN_CAP) { atomicAdd(&(bar)[XB_TMO], 1u); break; } } } } while (0)

struct XcdBarrier {
    unsigned* bar; unsigned x;
    volatile LAS unsigned* st;
};

__device__ __forceinline__ XcdBarrier xcd_barrier_post(unsigned* bar, volatile LAS unsigned* st) {
    XcdBarrier b; b.bar = bar; b.x = xb_xcc_id(); b.st = st;
    if (threadIdx.x == 0) (void)xb_add(&bar[XB_XCNT(b.x)], 1u);
    return b;
}
__device__ __forceinline__ void xcd_barrier_complete(unsigned* bar, unsigned x, unsigned& nloc, unsigned& nx) {
    const unsigned G = gridDim.x * gridDim.y * gridDim.z;
    unsigned sum, cnt, mine, sp = 0u;
    for (;;) {
        sum = 0u; cnt = 0u; mine = 0u;
#pragma unroll
        for (unsigned j = 0; j < 16; ++j) { const unsigned c = xb_ld(&bar[XB_XCNT(j)]); sum += c; cnt += (c > 0u) ? 1u : 0u; mine = (j == x) ? c : mine; }
        if (sum == G) break;
        __builtin_amdgcn_s_sleep(1);
        if ((++sp & 255u) == 0u) { if (xb_ld(&bar[XB_TMO])) break; if (sp > XB_SPIN_CAP) { atomicAdd(&bar[XB_TMO], 1u); break; } }
    }
    nloc = mine > 0u ? mine : 1u; nx = cnt > 0u ? cnt : 1u;
}

__device__ __forceinline__ void xcd_barrier(const XcdBarrier& b) {
    asm volatile("s_waitcnt vmcnt(0)" ::: "memory");
    __syncthreads();
    if (threadIdx.x == 0) {
        unsigned* bar = b.bar;
        __builtin_amdgcn_s_waitcnt(0);
        unsigned nloc = b.st[0], nx = b.st[1];
        if (nloc == 0u) { xcd_barrier_complete(bar, b.x, nloc, nx); b.st[0] = nloc; b.st[1] = nx; }
        const unsigned old = xb_add(&bar[XB_XSUB(b.x)], 1u);
        const unsigned gen = old / nloc;
        if (old + 1u == (gen + 1u) * nloc) {
            __builtin_amdgcn_fence(__ATOMIC_RELEASE, "agent");
            asm volatile("s_waitcnt vmcnt(0)" ::: "memory");
            const unsigned og = xb_add(&bar[XB_TOP], 1u);
            const unsigned tg = og / nx;
            if (og + 1u == (tg + 1u) * nx) xb_add(&bar[XB_TOPGEN], 1u);
            else XB_SPIN(xb_ld(&bar[XB_TOPGEN]) == tg, bar);
            __builtin_amdgcn_fence(__ATOMIC_ACQUIRE, "agent");
            xb_add(&bar[XB_XGEN(b.x)], 1u);
            asm volatile("s_waitcnt vmcnt(0)" ::: "memory");
        } else {
            XB_SPIN(xb_ld(&bar[XB_XGEN(b.x)]) == gen, bar);
            __builtin_amdgcn_fence(__ATOMIC_ACQUIRE, "agent");
            asm volatile("s_waitcnt vmcnt(0)" ::: "memory");
        }
    }
    __syncthreads();
}
#undef LAS
constexpr int NWAVES = 8;
constexpr int BATCH = 2, SEQ = 16384, NTOK = BATCH * SEQ, DM = 1024, DEPTH = 4, PLE = 256;
constexpr int EVEN_IN = 2216, EVEN_INP = 2304, ODD_IN = 2568, ODD_INP = 2816;
constexpr int E_FQ = 0, E_FK = 512, E_FV = 1024, E_FLOG = 1536, E_CQ = 1544, E_CKV = 1928, E_KROPE = 2184;
constexpr int O_U = 0, O_Q = 512, O_K = 1024, O_V = 1536, O_GIN = 2048, O_BETA = 2052, O_Z = 2056;
constexpr float RMS_EPS = 1e-6f;
constexpr float LOG2E = 1.4426950408889634f, LN2 = 0.6931471805599453f;
constexpr float C2_FOX = 0.125f * LOG2E, C2_MLA = 0.10206207261596575f * LOG2E;
constexpr int MOE_CAP = 65536 + 32 * 256;
constexpr int MOE_MAXT = MOE_CAP / 256;

enum { I_X = 0, I_P, I_POS, I_NORM_MIX, I_NORM_FFN, I_EV_W_IN, I_FOX_BF, I_FOX_QN, I_FOX_KN, I_MLA_QAN, I_MLA_WQUP, I_MLA_KVAN, I_MLA_WKVUP, I_MLA_QN, I_MLA_KN, I_EV_W_OUT,
       I_OD_W_IN, I_S5_ARE, I_S5_AIM, I_S5_BRE, I_S5_BIM, I_S5_CRE, I_S5_CIM, I_S5_D, I_S5_LS, I_S5_WGLU, I_S5_BGLU, I_GDN_CONV, I_GDN_ALOG, I_GDN_DTB, I_GDN_ONORM, I_OD_W_OUT,
       I_MOE_WGRP, I_MOE_BGRP, I_MOE_WEXP, I_MOE_BEXP, I_MOE_WG, I_MOE_WU, I_MOE_WD, I_PLE_WP, I_PLE_NORM, I_PLE_WG, I_PLE_BG, N_IN };

constexpr size_t MiB = 1u << 20;
constexpr size_t WS_CTL = 0, CTL_ZERO_BYTES = 1 * MiB;
constexpr size_t WS_W_EVIN = 4 * MiB;
constexpr size_t WS_W_ODIN = WS_W_EVIN + 9 * MiB;
constexpr size_t WS_W_QUP = WS_W_ODIN + 11 * MiB;
constexpr size_t WS_W_KVUP = WS_W_QUP + 2 * MiB;
constexpr size_t WS_W_EVOUT = WS_W_KVUP + 1 * MiB;
constexpr size_t WS_W_ODOUT = WS_W_EVOUT + 4 * MiB;
constexpr size_t WS_W_GLU = WS_W_ODOUT + 4 * MiB;
constexpr size_t WS_W_PLEP = WS_W_GLU + 1 * MiB;
constexpr size_t WS_W_PLEG = WS_W_PLEP + 2 * MiB;
constexpr size_t WS_W_MOEGU = WS_W_PLEG + 8 * MiB;
constexpr size_t WS_W_MOED = WS_W_MOEGU + 64 * MiB;
constexpr size_t WS_ABF = WS_W_MOED + 32 * MiB;
constexpr size_t WS_PP = WS_ABF + 64 * MiB;
constexpr size_t WS_PBF = WS_PP + 64 * MiB;
constexpr size_t WS_PROJ = WS_PBF + 16 * MiB;
constexpr size_t WS_MIX = WS_PROJ + 176 * MiB;
constexpr size_t WS_R1 = WS_MIX + 64 * MiB;
constexpr size_t WS_QM = WS_R1, WS_KVB = WS_QM + 48 * MiB, WS_KM = WS_KVB + 64 * MiB, WS_CQN = WS_KM + 48 * MiB, WS_CKVN = WS_CQN + 24 * MiB, WS_LOGF = WS_CKVN + 16 * MiB, WS_CUM = WS_LOGF + 1 * MiB;
constexpr size_t WS_HG = WS_R1, WS_QG = WS_HG + 32 * MiB, WS_KG = WS_QG + 64 * MiB, WS_VG = WS_KG + 64 * MiB, WS_OG = WS_VG + 64 * MiB;
constexpr size_t WS_R2 = WS_R1 + 288 * MiB;
constexpr size_t WS_GB = WS_R2, WS_BETA = WS_GB + 1 * MiB;
constexpr size_t WS_TOKE = WS_R2 + 2 * MiB, WS_TOKW = WS_TOKE + 1 * MiB, WS_ROWS = WS_TOKW + 1 * MiB;
constexpr size_t WS_XG = WS_R1;
constexpr size_t WS_HB = WS_XG + 144 * MiB;
constexpr size_t WS_Y2 = WS_R2 + 8 * MiB;
constexpr size_t WS_END = WS_Y2 + 144 * MiB;
static_assert(WS_HB + 72 * MiB <= WS_R2, "moe overlay");
static_assert(WS_OG + 64 * MiB <= WS_R2, "odd overlay");
constexpr size_t WS_DUMMY = WS_END;
static_assert(WS_DUMMY + 128 * MiB <= 1100 * MiB, "workspace budget");

constexpr int CW_BAR = 4096;
constexpr int CW_CNT = 1024;

constexpr int RING_OFF = 0, RING_BYTES = 131072;
constexpr int LDSCTL_OFF = RING_BYTES;
constexpr int LDS_BYTES = 147456;
constexpr int LC_BARST = 32;
constexpr int LC_MOE = 256;

#define GAS __attribute__((address_space(1)))
#define LAS __attribute__((address_space(3)))
typedef unsigned short bf16;
typedef unsigned v4u __attribute__((ext_vector_type(4)));
typedef unsigned v2u __attribute__((ext_vector_type(2)));
typedef float f32x4 __attribute__((ext_vector_type(4)));
#define LDS_WAIT() asm volatile("s_waitcnt lgkmcnt(0)" ::: "memory")
#define VM_WAIT() asm volatile("s_waitcnt vmcnt(0)" ::: "memory")
__device__ __forceinline__ unsigned f2bf(float f) { unsigned u = __builtin_bit_cast(unsigned, f); return (u + 0x7fffu + ((u >> 16) & 1u)) >> 16; }
__device__ __forceinline__ unsigned pk2(float lo, float hi) { return f2bf(lo) | (f2bf(hi) << 16); }
__device__ __forceinline__ float bflo(unsigned w) { return __uint_as_float(w << 16); }
__device__ __forceinline__ float bfhi(unsigned w) { return __uint_as_float(w & 0xffff0000u); }
__device__ __forceinline__ float bf2f(bf16 h) { return __uint_as_float((unsigned)h << 16); }
__device__ __forceinline__ float wave_sum(float v) {
#pragma unroll
    for (int o = 1; o < 64; o <<= 1) v += __shfl_xor(v, o);
    return v;
}
__device__ __forceinline__ float sigm(float x) { return 1.0f / (1.0f + expf(-x)); }
__device__ __forceinline__ float softplusf_(float x) { return fmaxf(x, 0.f) + log1pf(expf(-fabsf(x))); }
__device__ __forceinline__ float gelu_tanh(float x) { return 0.5f * x * (1.0f + tanhf(0.7978845608028654f * (x + 0.044715f * x * x * x))); }

struct Args { const float* in[N_IN]; float* out; unsigned char* ws; int ph_lo, ph_hi; };
#define CAS __attribute__((address_space(4)))
__device__ __forceinline__ const float* kin(int i) { asm volatile("" : "+s"(i)); const CAS char* kp = (const CAS char*)__builtin_amdgcn_kernarg_segment_ptr(); return *(const float* const CAS*)(kp + 8 * i); }
__device__ __forceinline__ float* kout() { int i = N_IN; asm volatile("" : "+s"(i)); const CAS char* kp = (const CAS char*)__builtin_amdgcn_kernarg_segment_ptr(); return *(float* const CAS*)(kp + 8 * i); }
__device__ __forceinline__ unsigned char* kws() { int i = N_IN + 1; asm volatile("" : "+s"(i)); const CAS char* kp = (const CAS char*)__builtin_amdgcn_kernarg_segment_ptr(); return *(unsigned char* const CAS*)(kp + 8 * i); }

struct Frame {
    LAS unsigned char* lds;
    unsigned char* ws;
    unsigned* ctl;
    int tid, lane, wave, G, bid;
};

__device__ __forceinline__ void transpose_item(const float* W, int K, int N, bf16* WT, int drow0, LAS float* scr, int k0, int n0, int lane) {
    const int nn = n0 + (lane & 31); const bool ok = nn < N;
#pragma unroll 8
    for (int i = 0; i < 32; ++i) { const int kk = 2 * i + (lane >> 5); scr[kk * 33 + (lane & 31)] = ok ? W[(size_t)(k0 + kk) * N + nn] : 0.f; }
    LDS_WAIT(); asm volatile("" ::: "memory");
    const int c = lane & 7;
#pragma unroll
    for (int j = 0; j < 4; ++j) { const int n = (lane >> 3) + 8 * j; const LAS float* s = scr + (8 * c) * 33 + n;
        v4u o; o.x = pk2(s[0 * 33], s[1 * 33]); o.y = pk2(s[2 * 33], s[3 * 33]); o.z = pk2(s[4 * 33], s[5 * 33]); o.w = pk2(s[6 * 33], s[7 * 33]);
        *(v4u*)(WT + (size_t)(drow0 + n) * K + k0 + 8 * c) = o; }
    LDS_WAIT(); asm volatile("" ::: "memory");
}
__device__ __forceinline__ void transpose_set(Frame& F, const float* W, int nmat, int K, int N, int NP, bf16* WT, int& itbase) {
    LAS float* scr = (LAS float*)(F.lds + RING_OFF + F.wave * 16384);
    const int gw = F.bid * NWAVES + F.wave, NGW = F.G * NWAVES;
    const int nkb = K / 64, nnb = NP / 32, per = nkb * nnb, total = nmat * per;
    int first = (gw - (itbase % NGW) + NGW) % NGW;
    for (int it = first; it < total; it += NGW) { const int mi = it / per, r = it % per, kb = r / nnb, nb = r % nnb;
        transpose_item(W + (size_t)mi * K * N, K, N, WT + (size_t)mi * NP * K, nb * 32, scr, kb * 64, nb * 32, F.lane); }
    itbase += total;
}
__device__ __forceinline__ void prologue_weights(Frame& F) {
 int itb = 0;
    transpose_set(F, kin(I_EV_W_IN), 2, 1024, EVEN_IN, EVEN_INP, (bf16*)(F.ws + WS_W_EVIN), itb);
    transpose_set(F, kin(I_OD_W_IN), 2, 1024, ODD_IN, ODD_INP, (bf16*)(F.ws + WS_W_ODIN), itb);
    transpose_set(F, kin(I_MLA_WQUP), 2, 384, 768, 768, (bf16*)(F.ws + WS_W_QUP), itb);
    transpose_set(F, kin(I_MLA_WKVUP), 2, 256, 1024, 1024, (bf16*)(F.ws + WS_W_KVUP), itb);
    transpose_set(F, kin(I_EV_W_OUT), 2, 1024, 1024, 1024, (bf16*)(F.ws + WS_W_EVOUT), itb);
    transpose_set(F, kin(I_OD_W_OUT), 2, 1024, 1024, 1024, (bf16*)(F.ws + WS_W_ODOUT), itb);
    transpose_set(F, kin(I_S5_WGLU), 2, 512, 512, 512, (bf16*)(F.ws + WS_W_GLU), itb);
    transpose_set(F, kin(I_PLE_WP), 4, 256, 1024, 1024, (bf16*)(F.ws + WS_W_PLEP), itb);
    transpose_set(F, kin(I_PLE_WG), 4, 1024, 1024, 1024, (bf16*)(F.ws + WS_W_PLEG), itb);
}
__device__ __forceinline__ void moe_weights(Frame& F, int layer) {

    LAS float* scr = (LAS float*)(F.lds + RING_OFF + F.wave * 16384);
    const int gw = F.bid * NWAVES + F.wave, NGW = F.G * NWAVES;
    const float* wg = kin(I_MOE_WG) + (size_t)layer * 32 * 1024 * 512; const float* wu = kin(I_MOE_WU) + (size_t)layer * 32 * 1024 * 512; const float* wd = kin(I_MOE_WD) + (size_t)layer * 32 * 512 * 1024;
    bf16* WGU = (bf16*)(F.ws + WS_W_MOEGU); bf16* WD = (bf16*)(F.ws + WS_W_MOED);
    for (int it = gw; it < 2 * 32 * 256; it += NGW) { const int which = it / (32 * 256), r0 = it % (32 * 256), e = r0 / 256, r = r0 % 256, kb = r / 16, nb = r % 16, n0 = nb * 32;
        const int drow = 256 * (n0 / 128) + (n0 % 128) + which * 128;
        transpose_item((which ? wu : wg) + (size_t)e * 1024 * 512, 1024, 512, WGU + (size_t)e * 1024 * 1024, drow, scr, kb * 64, n0, F.lane); }
    for (int it = gw; it < 32 * 256; it += NGW) { const int e = it / 256, r = it % 256, kb = r / 32, nb = r % 32;
        transpose_item(wd + (size_t)e * 512 * 1024, 512, 1024, WD + (size_t)e * 1024 * 512, nb * 32, scr, kb * 64, nb * 32, F.lane); }
}

__device__ __forceinline__ void rms_row_to_bf16(const float* xrow, const float* gain, bf16* orow, float* copy, int lane) {
    const f32x4* xr = (const f32x4*)xrow + lane; f32x4 v[4]; float s = 0.f;
#pragma unroll
    for (int j = 0; j < 4; ++j) { v[j] = xr[64 * j]; s += (v[j].x * v[j].x + v[j].y * v[j].y) + (v[j].z * v[j].z + v[j].w * v[j].w); }
    const float r = 1.0f / sqrtf(wave_sum(s) * (1.f / 1024.f) + RMS_EPS);
    if (copy) {
#pragma unroll
        for (int j = 0; j < 4; ++j) ((f32x4*)copy + lane)[64 * j] = v[j]; }
    unsigned long long* o8 = (unsigned long long*)orow + lane;
#pragma unroll
    for (int j = 0; j < 4; ++j) { const f32x4 g = ((const f32x4*)gain + lane)[64 * j];
        o8[64 * j] = (unsigned long long)pk2(v[j].x * r * g.x, v[j].y * r * g.y) | ((unsigned long long)pk2(v[j].z * r * g.z, v[j].w * r * g.w) << 32); }
}
__device__ __forceinline__ void phase_norm(Frame& F, const float* src, const float* gain, float* copy) {
    bf16* ABF = (bf16*)(F.ws + WS_ABF);
    const int gw = F.bid * NWAVES + F.wave, NGW = F.G * NWAVES;
    for (int m = gw; m < NTOK; m += NGW) rms_row_to_bf16(src + (size_t)m * DM, gain, ABF + (size_t)m * DM, copy ? copy + (size_t)m * DM : nullptr, F.lane);
}
__device__ __forceinline__ void phase_pconv(Frame& F, int layer) {
    const float* p = kin(I_P) + (size_t)layer * NTOK * PLE; bf16* PBF = (bf16*)(F.ws + WS_PBF);
    const size_t n4 = (size_t)NTOK * PLE / 4; const size_t gt = (size_t)F.bid * 512 + F.tid, NT = (size_t)F.G * 512;
    for (size_t i = gt; i < n4; i += NT) { const f32x4 v = ((const f32x4*)p)[i]; v2u o; o.x = pk2(v.x, v.y); o.y = pk2(v.z, v.w); ((v2u*)PBF)[i] = o; }
}

__device__ __forceinline__ void phase_even_post(Frame& F, int j, bool dry = false) {

    bf16* PROJ = (bf16*)(F.ws + WS_PROJ); bf16* CQN = (bf16*)(F.ws + WS_CQN); bf16* CKVN = (bf16*)(F.ws + WS_CKVN); float* LOGF = (float*)(F.ws + WS_LOGF);
    const float* qn = kin(I_FOX_QN) + j * 64; const float* kn = kin(I_FOX_KN) + j * 64; const float* bfv = kin(I_FOX_BF) + j * 8;
    const float* qan = kin(I_MLA_QAN) + j * 384; const float* kvan = kin(I_MLA_KVAN) + j * 256;
    const int gw = F.bid * NWAVES + F.wave, NGW = F.G * NWAVES, lane = F.lane;
    for (int m = gw; m < NTOK; m += NGW) {
        bf16* row = PROJ + (size_t)m * EVEN_INP;
#pragma unroll
        for (int w = 0; w < 2; ++w) {
            v4u* p = (v4u*)(row + (w ? E_FK : E_FQ)) + lane; const v4u x = *p;
            float f[8] = {bflo(x.x), bfhi(x.x), bflo(x.y), bfhi(x.y), bflo(x.z), bfhi(x.z), bflo(x.w), bfhi(x.w)};
            float s = 0.f;
#pragma unroll
            for (int i = 0; i < 8; ++i) s += f[i] * f[i];
            s += __shfl_xor(s, 1); s += __shfl_xor(s, 2); s += __shfl_xor(s, 4);
            const float r = (1.0f / sqrtf(s * (1.f / 64.f) + RMS_EPS)) * (w ? 1.0f : C2_FOX); const float* g = (w ? kn : qn) + (lane & 7) * 8;
            v4u o; o.x = pk2(f[0] * r * g[0], f[1] * r * g[1]); o.y = pk2(f[2] * r * g[2], f[3] * r * g[3]); o.z = pk2(f[4] * r * g[4], f[5] * r * g[5]); o.w = pk2(f[6] * r * g[6], f[7] * r * g[7]);
            *(dry ? (v4u*)(F.ws + WS_DUMMY) + (size_t)m * 128 + w * 64 + lane : p) = o;
        }
        if (lane < 8) { const float z = bf2f(row[E_FLOG + lane]) + bfv[lane]; LOGF[(size_t)m * 8 + lane] = -softplusf_(-z); }
        {
            float f[6]; float s = 0.f;
#pragma unroll
            for (int i = 0; i < 3; ++i) { const unsigned x = *((const unsigned*)(row + E_CQ) + lane + 64 * i); f[2 * i] = bflo(x); f[2 * i + 1] = bfhi(x); s += f[2 * i] * f[2 * i] + f[2 * i + 1] * f[2 * i + 1]; }
            const float r = 1.0f / sqrtf(wave_sum(s) * (1.f / 384.f) + RMS_EPS);
#pragma unroll
            for (int i = 0; i < 3; ++i) { const int c = 2 * (lane + 64 * i); *((unsigned*)(CQN + (size_t)m * 384) + lane + 64 * i) = pk2(f[2 * i] * r * qan[c], f[2 * i + 1] * r * qan[c + 1]); }
        }
        {
            float f[4]; float s = 0.f;
#pragma unroll
            for (int i = 0; i < 2; ++i) { const unsigned x = *((const unsigned*)(row + E_CKV) + lane + 64 * i); f[2 * i] = bflo(x); f[2 * i + 1] = bfhi(x); s += f[2 * i] * f[2 * i] + f[2 * i + 1] * f[2 * i + 1]; }
            const float r = 1.0f / sqrtf(wave_sum(s) * (1.f / 256.f) + RMS_EPS);
#pragma unroll
            for (int i = 0; i < 2; ++i) { const int c = 2 * (lane + 64 * i); *((unsigned*)(CKVN + (size_t)m * 256) + lane + 64 * i) = pk2(f[2 * i] * r * kvan[c], f[2 * i + 1] * r * kvan[c + 1]); }
        }
    }
}
__device__ __forceinline__ void phase_cumsum(Frame& F) {
    if (F.bid >= 16) return;
    const float* LOGF = (const float*)(F.ws + WS_LOGF); float* CUM = (float*)(F.ws + WS_CUM);
    const int b = F.bid >> 3, h = F.bid & 7, t0 = F.tid * 32;
    LAS double* part = (LAS double*)(F.lds + RING_OFF);
    float v[32]; double s = 0.0;
#pragma unroll
    for (int i = 0; i < 32; ++i) { v[i] = LOGF[((size_t)b * SEQ + t0 + i) * 8 + h]; s += (double)v[i]; }
    part[F.tid] = s; __syncthreads();
    if (F.tid == 0) { double run = 0.0; for (int i = 0; i < 512; ++i) { const double x = part[i]; part[i] = run; run += x; } }
    __syncthreads();
    double run = part[F.tid];
#pragma unroll
    for (int i = 0; i < 32; ++i) { run += (double)v[i]; CUM[((size_t)b * SEQ + t0 + i) * 8 + h] = (float)run; }
    __syncthreads();
}
__device__ __forceinline__ void phase_mla_post(Frame& F, int j, bool dry = false) {

    const bf16* PROJ = (const bf16*)(F.ws + WS_PROJ); bf16* QM = (bf16*)(F.ws + WS_QM); const bf16* KVB = (const bf16*)(F.ws + WS_KVB); bf16* KM = (bf16*)(F.ws + WS_KM);
    const float* qn = kin(I_MLA_QN) + j * 96; const float* kn = kin(I_MLA_KN) + j * 96; const int* pos = (const int*)kin(I_POS);
    const int gw = F.bid * NWAVES + F.wave, NGW = F.G * NWAVES, lane = F.lane, l32 = lane & 31, hh = lane >> 5;
    const int fi = l32 & 15; const float inv = expf(-(float)fi * (1.0f / 16.0f) * 9.210340371976184f);
    for (int m = gw; m < NTOK; m += NGW) {
        const float ang = (float)pos[m] * inv; float sn, cs; sincosf(ang, &sn, &cs);
        const float krope = bf2f(PROJ[(size_t)m * EVEN_INP + E_KROPE + l32]);
#pragma unroll
        for (int hp = 0; hp < 4; ++hp) { const int h = hp * 2 + hh;
#pragma unroll
            for (int w = 0; w < 2; ++w) {
                float f[3];
                if (w == 0) { const bf16* q = QM + (size_t)m * 768 + h * 96; f[0] = bf2f(q[l32]); f[1] = bf2f(q[l32 + 32]); f[2] = bf2f(q[l32 + 64]); }
                else { const bf16* k = KVB + (size_t)m * 1024 + h * 128; f[0] = bf2f(k[l32]); f[1] = bf2f(k[l32 + 32]); f[2] = krope; }
                float s = f[0] * f[0] + f[1] * f[1] + f[2] * f[2];
                s += __shfl_xor(s, 1); s += __shfl_xor(s, 2); s += __shfl_xor(s, 4); s += __shfl_xor(s, 8); s += __shfl_xor(s, 16);
                const float r = 1.0f / sqrtf(s * (1.f / 96.f) + RMS_EPS); const float* g = w ? kn : qn;
                f[0] *= r * g[l32]; f[1] *= r * g[l32 + 32]; f[2] *= r * g[l32 + 64];
                const float other = __shfl_xor(f[2], 16);
                const float rot = (l32 < 16) ? (f[2] * cs - other * sn) : (other * sn + f[2] * cs);
                bf16* o = (w ? KM : (dry ? (bf16*)(F.ws + WS_DUMMY) : QM)) + (size_t)m * 768 + h * 96; const float qs = w ? 1.0f : C2_MLA;
                o[l32] = (bf16)f2bf(f[0] * qs); o[l32 + 32] = (bf16)f2bf(f[1] * qs); o[l32 + 64] = (bf16)f2bf(rot * qs);
            }
        }
    }
}
template <int DK> __device__ __forceinline__ void attn_naive_unit(Frame& F, const bf16* Qp, int qld, const bf16* Kp, int kld, const bf16* Vp, int vld, const float* cum  , float scale, bf16* Op, int qb) {
    LAS float* Ks = (LAS float*)(F.lds + RING_OFF); LAS float* Vs = Ks + 64 * DK; LAS float* Cs = Vs + 64 * 64;
    const int t = qb * 512 + F.wave * 64 + F.lane; const int tmax_w = qb * 512 + F.wave * 64 + 63;
    float q[DK];
#pragma unroll
    for (int d = 0; d < DK; d += 8) { const v4u x = *(const v4u*)(Qp + (size_t)t * qld + d);
        q[d] = bflo(x.x) * scale; q[d + 1] = bfhi(x.x) * scale; q[d + 2] = bflo(x.y) * scale; q[d + 3] = bfhi(x.y) * scale; q[d + 4] = bflo(x.z) * scale; q[d + 5] = bfhi(x.z) * scale; q[d + 6] = bflo(x.w) * scale; q[d + 7] = bfhi(x.w) * scale; }
    const float cq = cum ? cum[(size_t)t * 8] : 0.f;
    float acc[64];
#pragma unroll
    for (int d = 0; d < 64; ++d) acc[d] = 0.f;
    float mx = -1e30f, l = 0.f;
    const int nkb = (qb * 512 + 512) / 64;
    for (int kb = 0; kb < nkb; ++kb) {
        __syncthreads();
        for (int i = F.tid; i < 64 * DK / 8; i += 512) { const int key = i / (DK / 8), c = (i % (DK / 8)) * 8; const v4u x = *(const v4u*)(Kp + (size_t)(kb * 64 + key) * kld + c);
            LAS float* d = Ks + key * DK + c; d[0] = bflo(x.x); d[1] = bfhi(x.x); d[2] = bflo(x.y); d[3] = bfhi(x.y); d[4] = bflo(x.z); d[5] = bfhi(x.z); d[6] = bflo(x.w); d[7] = bfhi(x.w); }
        { const int i = F.tid; const int key = i / 8, c = (i % 8) * 8; const v4u x = *(const v4u*)(Vp + (size_t)(kb * 64 + key) * vld + c);
            LAS float* d = Vs + key * 64 + c; d[0] = bflo(x.x); d[1] = bfhi(x.x); d[2] = bflo(x.y); d[3] = bfhi(x.y); d[4] = bflo(x.z); d[5] = bfhi(x.z); d[6] = bflo(x.w); d[7] = bfhi(x.w); }
        if (F.tid < 64) Cs[F.tid] = cum ? cum[(size_t)(kb * 64 + F.tid) * 8] : 0.f;
        __syncthreads();
        if (kb * 64 > tmax_w) continue;
        for (int jk = 0; jk < 64; ++jk) {
            const int s = kb * 64 + jk; if (s > tmax_w) break;
            const LAS float* kr = Ks + jk * DK; float dot = 0.f;
#pragma unroll
            for (int d = 0; d < DK; d += 4) { const f32x4 kv = *(const LAS f32x4*)(kr + d); dot += q[d] * kv.x + q[d + 1] * kv.y + q[d + 2] * kv.z + q[d + 3] * kv.w; }
            float logit = dot + (cq - Cs[jk]); if (s > t) logit = -1e30f;
            if (__any(logit > mx)) { const float mn = fmaxf(mx, logit); const float corr = expf(mx - mn); l *= corr;
#pragma unroll
                for (int d = 0; d < 64; ++d) acc[d] *= corr;
                mx = mn; }
            const float p = (s > t) ? 0.f : expf(logit - mx); l += p;
            const LAS float* vr = Vs + jk * 64;
#pragma unroll
            for (int d = 0; d < 64; d += 4) { const f32x4 vv = *(const LAS f32x4*)(vr + d); acc[d] += p * vv.x; acc[d + 1] += p * vv.y; acc[d + 2] += p * vv.z; acc[d + 3] += p * vv.w; }
        }
    }
    const float il = 1.0f / l; bf16* o = Op + (size_t)t * DM;
#pragma unroll
    for (int d = 0; d < 64; d += 8) { v4u w; w.x = pk2(acc[d] * il, acc[d + 1] * il); w.y = pk2(acc[d + 2] * il, acc[d + 3] * il); w.z = pk2(acc[d + 4] * il, acc[d + 5] * il); w.w = pk2(acc[d + 6] * il, acc[d + 7] * il); *(v4u*)(o + d) = w; }
}
__device__ __forceinline__ void phase_attn_naive(Frame& F) {
    const bf16* PROJ = (const bf16*)(F.ws + WS_PROJ); const bf16* QM = (const bf16*)(F.ws + WS_QM); const bf16* KVB = (const bf16*)(F.ws + WS_KVB); const bf16* KM = (const bf16*)(F.ws + WS_KM);
    const float* CUM = (const float*)(F.ws + WS_CUM); bf16* MIX = (bf16*)(F.ws + WS_MIX);
    for (int p = F.bid; p < 512; p += F.G) {
        const int combo = p >> 4, qq = p & 15; const int type = combo >> 4, b = (combo >> 3) & 1, h = combo & 7;
#pragma unroll 1
        for (int half = 0; half < 2; ++half) { const int qb = half ? 31 - qq : qq; const size_t rb = (size_t)b * SEQ;
            if (type == 0) attn_naive_unit<64>(F, PROJ + rb * EVEN_INP + E_FQ + h * 64, EVEN_INP, PROJ + rb * EVEN_INP + E_FK + h * 64, EVEN_INP, PROJ + rb * EVEN_INP + E_FV + h * 64, EVEN_INP, CUM + rb * 8 + h, LN2, MIX + rb * DM + h * 64, qb);
            else attn_naive_unit<96>(F, QM + rb * 768 + h * 96, 768, KM + rb * 768 + h * 96, 768, KVB + rb * 1024 + h * 128 + 64, 1024, nullptr, LN2, MIX + rb * DM + 512 + h * 64, qb);
        }
    }
    __syncthreads();
}

__device__ __forceinline__ void s5_scan_wave(Frame& F, int j, int b, int g) {
 const int p = F.lane;
    const bf16* PROJ = (const bf16*)(F.ws + WS_PROJ); bf16* HG = (bf16*)(F.ws + WS_HG);
    const float lr = fminf(kin(I_S5_ARE)[(j * 32 + g) * 64 + p], -1e-4f), li = kin(I_S5_AIM)[(j * 32 + g) * 64 + p];
    const float dt = expf(kin(I_S5_LS)[j * 32 + g]);
    const float mag = expf(lr * dt); const float abr = mag * cosf(li * dt), abi = mag * sinf(li * dt);
    const float den = lr * lr + li * li, nr = abr - 1.0f, ni = abi;
    const float gr = (nr * lr + ni * li) / den, gi = (ni * lr - nr * li) / den;
    float bbr[16], bbi[16], cr[16], ci[16], dsk[16];
#pragma unroll
    for (int c = 0; c < 16; ++c) { const float br = kin(I_S5_BRE)[((size_t)(j * 32 + g) * 64 + p) * 16 + c], bi = kin(I_S5_BIM)[((size_t)(j * 32 + g) * 64 + p) * 16 + c];
        bbr[c] = gr * br - gi * bi; bbi[c] = gr * bi + gi * br;
        cr[c] = kin(I_S5_CRE)[((size_t)(j * 32 + g) * 16 + c) * 64 + p]; ci[c] = kin(I_S5_CIM)[((size_t)(j * 32 + g) * 16 + c) * 64 + p];
        dsk[c] = kin(I_S5_D)[j * 512 + g * 16 + c]; }
    float xr = 0.f, xi = 0.f;
    const bf16* up = PROJ + (size_t)b * SEQ * ODD_INP + O_U + g * 16;
    v4u cur0[4], cur1[4], nx0[4], nx1[4];
#pragma unroll
    for (int i = 0; i < 4; ++i) { cur0[i] = *(const v4u*)(up + (size_t)i * ODD_INP); cur1[i] = *(const v4u*)(up + (size_t)i * ODD_INP + 8); }
    for (int t0 = 0; t0 < SEQ; t0 += 4) {
        const int tn = (t0 + 4 < SEQ) ? t0 + 4 : t0;
#pragma unroll
        for (int i = 0; i < 4; ++i) { nx0[i] = *(const v4u*)(up + (size_t)(tn + i) * ODD_INP); nx1[i] = *(const v4u*)(up + (size_t)(tn + i) * ODD_INP + 8); }
#pragma unroll
        for (int i = 0; i < 4; ++i) {
            float u[16] = {bflo(cur0[i].x), bfhi(cur0[i].x), bflo(cur0[i].y), bfhi(cur0[i].y), bflo(cur0[i].z), bfhi(cur0[i].z), bflo(cur0[i].w), bfhi(cur0[i].w),
                           bflo(cur1[i].x), bfhi(cur1[i].x), bflo(cur1[i].y), bfhi(cur1[i].y), bflo(cur1[i].z), bfhi(cur1[i].z), bflo(cur1[i].w), bfhi(cur1[i].w)};
            float bur = 0.f, bui = 0.f;
#pragma unroll
            for (int c = 0; c < 16; ++c) { bur += bbr[c] * u[c]; bui += bbi[c] * u[c]; }
            const float nxr = abr * xr - abi * xi + bur, nxi = abr * xi + abi * xr + bui; xr = nxr; xi = nxi;
            float y[16];
#pragma unroll
            for (int c = 0; c < 16; ++c) y[c] = wave_sum(cr[c] * xr - ci[c] * xi);
            if (p < 16) { float yy = 0.f, uu = 0.f, dd = 0.f;
#pragma unroll
                for (int c = 0; c < 16; ++c) if (p == c) { yy = y[c]; uu = u[c]; dd = dsk[c]; }
                HG[((size_t)b * SEQ + t0 + i) * 512 + g * 16 + p] = (bf16)f2bf(gelu_tanh(yy + dd * uu)); }
        }
#pragma unroll
        for (int i = 0; i < 4; ++i) { cur0[i] = nx0[i]; cur1[i] = nx1[i]; }
    }
}
__device__ __forceinline__ void gdn_prep_token(Frame& F, int j, int m) {
 const int lane = F.lane;
    const bf16* PROJ = (const bf16*)(F.ws + WS_PROJ); float* QG = (float*)(F.ws + WS_QG); float* KG = (float*)(F.ws + WS_KG); float* VG = (float*)(F.ws + WS_VG);
    float* GB = (float*)(F.ws + WS_GB); float* BETA = (float*)(F.ws + WS_BETA);
    const float* cw = kin(I_GDN_CONV) + (size_t)j * 4 * 1536;
    const int s = m % SEQ;
#pragma unroll
    for (int w = 0; w < 3; ++w) {
        const int ch0 = w * 512 + lane * 8; float acc[8];
#pragma unroll
        for (int i = 0; i < 8; ++i) acc[i] = 0.f;
#pragma unroll
        for (int tap = 0; tap < 4; ++tap) { const int ss = s - 3 + tap; if (ss < 0) continue;
            const v4u x = *(const v4u*)(PROJ + (size_t)(m - 3 + tap) * ODD_INP + O_Q + ch0); const float* wv = cw + tap * 1536 + ch0;
            acc[0] += wv[0] * bflo(x.x); acc[1] += wv[1] * bfhi(x.x); acc[2] += wv[2] * bflo(x.y); acc[3] += wv[3] * bfhi(x.y); acc[4] += wv[4] * bflo(x.z); acc[5] += wv[5] * bfhi(x.z); acc[6] += wv[6] * bflo(x.w); acc[7] += wv[7] * bfhi(x.w); }
        float ss2 = 0.f;
#pragma unroll
        for (int i = 0; i < 8; ++i) { acc[i] = acc[i] * sigm(acc[i]); ss2 += acc[i] * acc[i]; }
        float sc = 1.0f;
        if (w < 2) { ss2 += __shfl_xor(ss2, 1); ss2 += __shfl_xor(ss2, 2); ss2 += __shfl_xor(ss2, 4); ss2 += __shfl_xor(ss2, 8); sc = 1.0f / sqrtf(ss2 + RMS_EPS); if (w == 0) sc *= 0.08838834764831845f; }
        float* dst = (w == 0 ? QG : (w == 1 ? KG : VG)) + (size_t)m * 512 + lane * 8;
        *(f32x4*)dst = (f32x4){acc[0] * sc, acc[1] * sc, acc[2] * sc, acc[3] * sc}; *(f32x4*)(dst + 4) = (f32x4){acc[4] * sc, acc[5] * sc, acc[6] * sc, acc[7] * sc};
    }
    if (lane < 4) { const float gin = bf2f(PROJ[(size_t)m * ODD_INP + O_GIN + lane]), bin = bf2f(PROJ[(size_t)m * ODD_INP + O_BETA + lane]);
        GB[(size_t)m * 4 + lane] = -expf(kin(I_GDN_ALOG)[j * 4 + lane]) * softplusf_(gin + kin(I_GDN_DTB)[j * 4 + lane]); BETA[(size_t)m * 4 + lane] = sigm(bin); }
}
__device__ __forceinline__ void phase_gdn_prep(Frame& F, int j) {
    const int gw = F.bid * NWAVES + F.wave, NGW = F.G * NWAVES;
    for (int m = gw; m < NTOK; m += NGW) gdn_prep_token(F, j, m);
}
__device__ __forceinline__ void phase_odd_a(Frame& F, int j) {
    if (F.wave == 0 && F.bid < 64) { s5_scan_wave(F, j, F.bid >> 5, F.bid & 31); return; }
    const int nbusy = (F.G < 64 ? F.G : 64);
    const int widx = (F.bid < 64) ? F.bid * 7 + (F.wave - 1) : nbusy * 7 + (F.bid - 64) * 8 + F.wave;
    const int nw = nbusy * 7 + (F.G > 64 ? (F.G - 64) * 8 : 0);
    for (int m = widx; m < NTOK; m += nw) gdn_prep_token(F, j, m);
}
__device__ __forceinline__ void phase_gdn_naive(Frame& F) {
    const float* QG = (const float*)(F.ws + WS_QG); const float* KG = (const float*)(F.ws + WS_KG); const float* VG = (const float*)(F.ws + WS_VG);
    const float* GB = (const float*)(F.ws + WS_GB); const float* BETA = (const float*)(F.ws + WS_BETA); float* OG = (float*)(F.ws + WS_OG);
    const int lane = F.lane; const int NGW = F.G * NWAVES;
    for (int u = F.wave * F.G + F.bid; u < 1024; u += NGW) {
        const int b = u >> 9, h = (u >> 7) & 3, c = u & 127; const size_t rb = (size_t)b * SEQ;
        const float* kq = KG + rb * 512 + h * 128 + lane; const float* qq = QG + rb * 512 + h * 128 + lane; const float* vq = VG + rb * 512 + h * 128 + c;
        const float* gq = GB + rb * 4 + h; const float* bq = BETA + rb * 4 + h; float* oq = OG + rb * 512 + h * 128 + c;
        float s0 = 0.f, s1 = 0.f;
        float k0[8], k1[8], q0[8], q1[8], vv[8], gg[8], bb[8], nk0[8], nk1[8], nq0[8], nq1[8], nv[8], ng[8], nb[8];
#pragma unroll
        for (int i = 0; i < 8; ++i) { k0[i] = kq[(size_t)i * 512]; k1[i] = kq[(size_t)i * 512 + 64]; q0[i] = qq[(size_t)i * 512]; q1[i] = qq[(size_t)i * 512 + 64]; vv[i] = vq[(size_t)i * 512]; gg[i] = gq[i * 4]; bb[i] = bq[i * 4]; }
        for (int t0 = 0; t0 < SEQ; t0 += 8) {
            const int tn = (t0 + 8 < SEQ) ? t0 + 8 : t0;
#pragma unroll
            for (int i = 0; i < 8; ++i) { const size_t o = (size_t)(tn + i) * 512; nk0[i] = kq[o]; nk1[i] = kq[o + 64]; nq0[i] = qq[o]; nq1[i] = qq[o + 64]; nv[i] = vq[o]; ng[i] = gq[(tn + i) * 4]; nb[i] = bq[(tn + i) * 4]; }
#pragma unroll
            for (int i = 0; i < 8; ++i) {
                const float ks = wave_sum(k0[i] * s0 + k1[i] * s1); const float eg = expf(gg[i]); const float be = bb[i];
                s0 = eg * (s0 - be * k0[i] * ks) + be * k0[i] * vv[i]; s1 = eg * (s1 - be * k1[i] * ks) + be * k1[i] * vv[i];
                const float o = wave_sum(q0[i] * s0 + q1[i] * s1);
                if (lane == 0) oq[(size_t)(t0 + i) * 512] = o;
            }
#pragma unroll
            for (int i = 0; i < 8; ++i) { k0[i] = nk0[i]; k1[i] = nk1[i]; q0[i] = nq0[i]; q1[i] = nq1[i]; vv[i] = nv[i]; gg[i] = ng[i]; bb[i] = nb[i]; }
        }
    }
}
__device__ __forceinline__ void phase_gdn_out(Frame& F, int j) {
 const float* OG = (const float*)(F.ws + WS_OG); const bf16* PROJ = (const bf16*)(F.ws + WS_PROJ); bf16* MIX = (bf16*)(F.ws + WS_MIX);
    const float* on = kin(I_GDN_ONORM) + j * 128; const int lane = F.lane;
    const int gw = F.bid * NWAVES + F.wave, NGW = F.G * NWAVES;
    for (int m = gw; m < NTOK; m += NGW) {
        const f32x4 a = *(const f32x4*)(OG + (size_t)m * 512 + lane * 8), b = *(const f32x4*)(OG + (size_t)m * 512 + lane * 8 + 4);
        float f[8] = {a.x, a.y, a.z, a.w, b.x, b.y, b.z, b.w}; float s = 0.f;
#pragma unroll
        for (int i = 0; i < 8; ++i) s += f[i] * f[i];
        s += __shfl_xor(s, 1); s += __shfl_xor(s, 2); s += __shfl_xor(s, 4); s += __shfl_xor(s, 8);
        const float r = 1.0f / sqrtf(s * (1.f / 128.f) + RMS_EPS);
        const bf16* z = PROJ + (size_t)m * ODD_INP + O_Z + lane * 8; const float* g = on + (lane & 15) * 8; float o[8];
#pragma unroll
        for (int i = 0; i < 8; ++i) { const float zz = bf2f(z[i]); o[i] = f[i] * r * g[i] * (zz * sigm(zz)); }
        v4u w; w.x = pk2(o[0], o[1]); w.y = pk2(o[2], o[3]); w.z = pk2(o[4], o[5]); w.w = pk2(o[6], o[7]);
        *(v4u*)(MIX + (size_t)m * DM + 512 + lane * 8) = w;
    }
}

__device__ __forceinline__ void phase_router(Frame& F, int layer, bool dry = false) {
 const float* H = kout(); bf16* ABF = (bf16*)(F.ws + WS_ABF);
    const float* gain = kin(I_NORM_FFN) + layer * DM; const float* wgr = kin(I_MOE_WGRP) + (size_t)layer * DM * 4; const float* bgr = kin(I_MOE_BGRP) + layer * 4;
    const float* wex = kin(I_MOE_WEXP) + (size_t)layer * DM * 32; const float* bex = kin(I_MOE_BEXP) + layer * 32;
    int* TOKE = (int*)(F.ws + WS_TOKE); float* TOKW = (float*)(F.ws + WS_TOKW);
    LAS int* lcnt = (LAS int*)(F.lds + LDSCTL_OFF + LC_MOE + 512); LAS int* gbase = (LAS int*)(F.lds + LDSCTL_OFF + LC_MOE + 640);
    const int lane = F.lane; const int per = NTOK / F.G;
    LAS int* lasg = (LAS int*)(F.lds + RING_OFF);
    if (F.tid < 32) lcnt[F.tid] = 0;
    __syncthreads();
    for (int tl = F.wave; tl < per; tl += NWAVES) {
        const int m = F.bid * per + tl;
        const f32x4* xr = (const f32x4*)(H + (size_t)m * DM) + lane; f32x4 v[4]; float s = 0.f;
#pragma unroll
        for (int q = 0; q < 4; ++q) { v[q] = xr[64 * q]; s += (v[q].x * v[q].x + v[q].y * v[q].y) + (v[q].z * v[q].z + v[q].w * v[q].w); }
        const float r = 1.0f / sqrtf(wave_sum(s) * (1.f / 1024.f) + RMS_EPS);
        unsigned long long* o8 = (unsigned long long*)(ABF + (size_t)m * DM) + lane;
#pragma unroll
        for (int q = 0; q < 4; ++q) { const f32x4 g = ((const f32x4*)gain + lane)[64 * q]; v[q].x *= r * g.x; v[q].y *= r * g.y; v[q].z *= r * g.z; v[q].w *= r * g.w;
            o8[64 * q] = (unsigned long long)pk2(v[q].x, v[q].y) | ((unsigned long long)pk2(v[q].z, v[q].w) << 32); }
        float lg[4] = {0.f, 0.f, 0.f, 0.f};
#pragma unroll
        for (int q = 0; q < 4; ++q) { const int k0 = 4 * lane + 256 * q;
#pragma unroll
            for (int e = 0; e < 4; ++e) { const f32x4 w = *(const f32x4*)(wgr + (size_t)(k0 + e) * 4); const float x = v[q][e]; lg[0] += x * w.x; lg[1] += x * w.y; lg[2] += x * w.z; lg[3] += x * w.w; } }
#pragma unroll
        for (int g = 0; g < 4; ++g) lg[g] = wave_sum(lg[g]) + bgr[g];
        int gi = 0; float gm = lg[0];
#pragma unroll
        for (int g = 1; g < 4; ++g) if (lg[g] > gm) { gm = lg[g]; gi = g; }
        float gden = 0.f;
#pragma unroll
        for (int g = 0; g < 4; ++g) gden += expf(lg[g] - gm);
        const float gw_ = 1.0f / gden;
        float le[8] = {0.f, 0.f, 0.f, 0.f, 0.f, 0.f, 0.f, 0.f};
#pragma unroll
        for (int q = 0; q < 4; ++q) { const int k0 = 4 * lane + 256 * q;
#pragma unroll
            for (int e = 0; e < 4; ++e) { const float* wp = wex + (size_t)(k0 + e) * 32 + gi * 8; const f32x4 w0 = *(const f32x4*)wp, w1 = *(const f32x4*)(wp + 4); const float x = v[q][e];
                le[0] += x * w0.x; le[1] += x * w0.y; le[2] += x * w0.z; le[3] += x * w0.w; le[4] += x * w1.x; le[5] += x * w1.y; le[6] += x * w1.z; le[7] += x * w1.w; } }
#pragma unroll
        for (int e = 0; e < 8; ++e) le[e] = wave_sum(le[e]) + bex[gi * 8 + e];
        int i0 = 0; float m0 = le[0];
#pragma unroll
        for (int e = 1; e < 8; ++e) if (le[e] > m0) { m0 = le[e]; i0 = e; }
        int i1 = -1; float m1 = -3.0e38f;
#pragma unroll
        for (int e = 0; e < 8; ++e) if (e != i0 && le[e] > m1) { m1 = le[e]; i1 = e; }
        const float e1 = expf(m1 - m0); const float w0 = gw_ / (1.0f + e1), w1 = gw_ * e1 / (1.0f + e1);
        if (lane == 0 && !dry) { const int ea = gi * 8 + i0, eb = gi * 8 + i1;
            const int pa = __hip_atomic_fetch_add(lcnt + ea, 1, __ATOMIC_RELAXED, __HIP_MEMORY_SCOPE_WORKGROUP), pb = __hip_atomic_fetch_add(lcnt + eb, 1, __ATOMIC_RELAXED, __HIP_MEMORY_SCOPE_WORKGROUP);
            lasg[tl * 2] = ea | (pa << 8); lasg[tl * 2 + 1] = eb | (pb << 8);
            TOKW[(size_t)m * 2] = w0; TOKW[(size_t)m * 2 + 1] = w1; }
    }
    __syncthreads();
    if (dry) return;
    if (F.tid < 32) gbase[F.tid] = (int)__hip_atomic_fetch_add(F.ctl + CW_CNT + 64 * layer + F.tid, (unsigned)lcnt[F.tid], __ATOMIC_RELAXED, __HIP_MEMORY_SCOPE_AGENT);
    __syncthreads();
    for (int i = F.tid; i < per * 2; i += 512) { const int a = lasg[i], e = a & 255, lp = a >> 8; TOKE[(size_t)F.bid * per * 2 + i] = e | ((gbase[e] + lp) << 8); }
    __syncthreads();
}
__device__ __forceinline__ void moe_tables(Frame& F, int layer) {
    LAS int* rowbase = (LAS int*)(F.lds + LDSCTL_OFF + LC_MOE); LAS unsigned char* tile_e = (LAS unsigned char*)(F.lds + LDSCTL_OFF + LC_MOE + 192);
    if (F.tid == 0) { int rb = 0;
#pragma unroll 1
        for (int e = 0; e < 32; ++e) { const int c = (int)__hip_atomic_load(F.ctl + CW_CNT + 64 * layer + e, __ATOMIC_RELAXED, __HIP_MEMORY_SCOPE_AGENT); rowbase[e] = rb; const int nt = (c + 255) >> 8;
            for (int i = 0; i < nt; ++i) tile_e[(rb >> 8) + i] = (unsigned char)e; rb += nt << 8; }
        rowbase[32] = rb; rowbase[34] = rb >> 8; }
    __syncthreads();
}
__device__ __forceinline__ void phase_moe_scatter(Frame& F, int layer) {
    moe_tables(F, layer);
    const LAS int* rowbase = (const LAS int*)(F.lds + LDSCTL_OFF + LC_MOE);
    const bf16* ABF = (const bf16*)(F.ws + WS_ABF); bf16* XG = (bf16*)(F.ws + WS_XG); const int* TOKE = (const int*)(F.ws + WS_TOKE); int* ROWS = (int*)(F.ws + WS_ROWS);
    const int gw = F.bid * NWAVES + F.wave, NGW = F.G * NWAVES, lane = F.lane;
    for (int m = gw; m < NTOK; m += NGW) {
        const v4u a = *((const v4u*)(ABF + (size_t)m * DM) + lane), b = *((const v4u*)(ABF + (size_t)m * DM) + 64 + lane);
#pragma unroll
        for (int k = 0; k < 2; ++k) { const int te = TOKE[(size_t)m * 2 + k]; const int row = rowbase[te & 255] + (te >> 8);
            *((v4u*)(XG + (size_t)row * DM) + lane) = a; *((v4u*)(XG + (size_t)row * DM) + 64 + lane) = b;
            if (lane == 0) ROWS[(size_t)m * 2 + k] = row; }
    }
}
struct MoeOrder {
    int ntiles, nN, G, c; const LAS unsigned char* tile_e; size_t bstride;
    __device__ bool next(int i, pg8::Unit& u) const { const long L = (long)i * G + c; if (L >= (long)ntiles * nN) return false; u.pm = (int)(L / nN); u.pn = (int)(L % nN); u.aux = __builtin_amdgcn_readfirstlane((int)tile_e[u.pm]); return true; }
    __device__ __forceinline__ const char* a_base(const pg8::Gemm& g, const pg8::Unit& u) const { return (const char*)g.A + (size_t)u.pm * 256 * g.lda * 2; }
    __device__ __forceinline__ const char* b_base(const pg8::Gemm& g, const pg8::Unit& u) const { return (const char*)g.Bt + (size_t)u.aux * bstride + (size_t)u.pn * 256 * g.ldb * 2; }
};
__device__ __forceinline__ void phase_moe_combine(Frame& F, int layer, bool dry = false) {
    float* H = kout(); float* Ho = dry ? (float*)(F.ws + WS_DUMMY) : H; bf16* ABF = (bf16*)(F.ws + WS_ABF); const bf16* Y2 = (const bf16*)(F.ws + WS_Y2);
    const int* ROWS = (const int*)(F.ws + WS_ROWS); const float* TOKW = (const float*)(F.ws + WS_TOKW); const float* gain = kin(I_PLE_NORM) + layer * DM;
    const int gw = F.bid * NWAVES + F.wave, NGW = F.G * NWAVES, lane = F.lane;
    for (int m = gw; m < NTOK; m += NGW) {
        const int r0 = ROWS[(size_t)m * 2], r1 = ROWS[(size_t)m * 2 + 1]; const float w0 = TOKW[(size_t)m * 2], w1 = TOKW[(size_t)m * 2 + 1];
        f32x4* hr = (f32x4*)(H + (size_t)m * DM) + lane; f32x4* ho = (f32x4*)(Ho + (size_t)m * DM) + lane; f32x4 v[4]; float s = 0.f;
#pragma unroll
        for (int q = 0; q < 4; ++q) { v[q] = hr[64 * q]; const v2u ya = *((const v2u*)(Y2 + (size_t)r0 * DM) + lane + 64 * q), yb = *((const v2u*)(Y2 + (size_t)r1 * DM) + lane + 64 * q);
            v[q].x += w0 * bflo(ya.x) + w1 * bflo(yb.x); v[q].y += w0 * bfhi(ya.x) + w1 * bfhi(yb.x); v[q].z += w0 * bflo(ya.y) + w1 * bflo(yb.y); v[q].w += w0 * bfhi(ya.y) + w1 * bfhi(yb.y);
            ho[64 * q] = v[q]; s += (v[q].x * v[q].x + v[q].y * v[q].y) + (v[q].z * v[q].z + v[q].w * v[q].w); }
        const float r = 1.0f / sqrtf(wave_sum(s) * (1.f / 1024.f) + RMS_EPS);
        unsigned long long* o8 = (unsigned long long*)(ABF + (size_t)m * DM) + lane;
#pragma unroll
        for (int q = 0; q < 4; ++q) { const f32x4 g = ((const f32x4*)gain + lane)[64 * q];
            o8[64 * q] = (unsigned long long)pk2(v[q].x * r * g.x, v[q].y * r * g.y) | ((unsigned long long)pk2(v[q].z * r * g.z, v[q].w * r * g.w) << 32); }
    }
}
namespace att {
using bf16x8 = __attribute__((ext_vector_type(8))) short;
using s16x4 = __attribute__((ext_vector_type(4))) short;
using f32x16 = __attribute__((ext_vector_type(16))) float;
using u32x4 = __attribute__((ext_vector_type(4))) unsigned;
typedef float f32x2_t __attribute__((ext_vector_type(2))); typedef __bf16 bf16x2_t __attribute__((ext_vector_type(2)));
constexpr int KSLOT = 16384, VSLOT = 8192;
constexpr int L_K = 0, L_V = 2 * KSLOT, L_B = L_V + 2 * VSLOT, L_WS = L_B + 512, L_OST = L_WS + 8 * 256, L_BYTES = L_OST + 8 * 4096;
__device__ __forceinline__ int crow(int r, int hi) { return (r & 3) + 8 * (r >> 2) + 4 * hi; }
__device__ __forceinline__ void glds16(const void* gsrc, unsigned lds_dst) { unsigned keep;
    asm volatile("s_mov_b32 %0, m0\n\ts_mov_b32 m0, %2\n\ts_nop 0\n\tglobal_load_lds_dwordx4 %1, off\n\ts_mov_b32 m0, %0" : "=&s"(keep) : "v"(gsrc), "s"(lds_dst) : "memory"); }
__device__ __forceinline__ unsigned cvtpk(float lo, float hi) { f32x2_t v = {lo, hi}; bf16x2_t b = __builtin_convertvector(v, bf16x2_t); return __builtin_bit_cast(unsigned, b); }
#define ATT_WAIT_BAR() asm volatile("s_waitcnt vmcnt(0) lgkmcnt(0)\n\ts_barrier" ::: "memory")

template <int DK, bool BIAS>
__device__ __forceinline__ void attn_unit(const int tid, const int qb, const bf16* Qh, const int qp, const bf16* Kh, const int kp, const bf16* Vh, const int vp, const float* cumh  , bf16* Oh  , char* shm, const float skip_margin  ) {
    constexpr int ND = DK / 16, KCH = DK / 8;
    const int lane = tid & 63, r32 = lane & 31, hi = lane >> 5; const int wid = __builtin_amdgcn_readfirstlane(tid >> 6);
    const int q0 = qb * 256;
    const unsigned lds0 = (unsigned)(uintptr_t)shm;
    float* wsf = (float*)(shm + L_WS) + wid * 64;
    float* Bs = (float*)(shm + L_B);
    const bf16* ksrc = Kh + (size_t)lane * kp + wid * 8;
    const bf16* vsrc = Vh + (size_t)(16 * (wid & 3) + (lane >> 2)) * vp + (wid >> 2) * 32 + (lane & 3) * 8;
    const unsigned kdst = lds0 + L_K + wid * 1024, vdst = lds0 + L_V + wid * 1024;
    const int NT = (q0 + 256) / 64;
    const float cref = BIAS ? cumh[(size_t)q0 * 8] : 0.f;
    int T0 = 0;
    if (BIAS) { for (int base = 0; base < NT; base += 64) { const int tq = base + lane; bool ok = false;
            if (tq < NT) ok = ((cref - cumh[(size_t)(64 * tq + 63) * 8]) * 1.4426950408889634f + skip_margin >= -150.0f);
            const unsigned long long mk = __ballot(ok); if (mk) { T0 = base + (int)__builtin_ctzll(mk); break; } T0 = NT - 4; }
        T0 = __builtin_amdgcn_readfirstlane(T0); if (T0 > NT - 4) T0 = NT - 4; if (T0 & 1) T0 -= 1; }
#define ATT_DMA(t, slot) do { glds16(ksrc + (size_t)(t) * 64 * kp, (unsigned)__builtin_amdgcn_readfirstlane(kdst + (slot) * KSLOT)); \
        if (KCH > 8) glds16(ksrc + (size_t)(t) * 64 * kp + 64, (unsigned)__builtin_amdgcn_readfirstlane(kdst + (slot) * KSLOT + 8192)); \
        glds16(vsrc + (size_t)(t) * 64 * vp, (unsigned)__builtin_amdgcn_readfirstlane(vdst + (slot) * VSLOT)); } while (0)
    ATT_DMA(T0, 0);
    if (BIAS && wid == 0) Bs[lane] = (cref - cumh[(size_t)(T0 * 64 + lane) * 8]) * 1.4426950408889634f;
    bf16x8 qr[ND];
#pragma unroll
    for (int d0 = 0; d0 < ND; ++d0) qr[d0] = *reinterpret_cast<const bf16x8*>(Qh + (size_t)(q0 + wid * 32 + r32) * qp + d0 * 16 + hi * 8);
    float mhat = 0.f, l_reg = 0.f; f32x16 o[2]; o[0] = f32x16{}; o[1] = f32x16{}; f32x16 negm = f32x16{};
    const int qrel = wid * 32 + r32;
    const int vb0 = (int)(lds0 + L_V) + ((lane >> 4) & 1) * 32 + (lane & 3) * 8 + (4 * hi + ((lane & 15) >> 2)) * 64;
    ATT_WAIT_BAR();
    for (int t = T0; t < NT; ++t) {
        const int cur = t & 1;
        float bnext = 0.f;
        if (t + 1 < NT) { ATT_DMA(t + 1, cur ^ 1); if (BIAS && wid == 0) bnext = cumh[(size_t)((t + 1) * 64 + lane) * 8]; }
        f32x16 p0, p1;
        { const char* kb = shm + L_K + cur * KSLOT + hi * 1024 + r32 * 16;
#pragma unroll
          for (int d0 = 0; d0 < ND; ++d0) { const bf16x8 b0 = *reinterpret_cast<const bf16x8*>(kb + d0 * 2048); const bf16x8 b1 = *reinterpret_cast<const bf16x8*>(kb + d0 * 2048 + 512);
            if (d0 == 0) { p0 = __builtin_amdgcn_mfma_f32_32x32x16_bf16(b0, qr[0], negm, 0, 0, 0); p1 = __builtin_amdgcn_mfma_f32_32x32x16_bf16(b1, qr[0], negm, 0, 0, 0); }
            else { p0 = __builtin_amdgcn_mfma_f32_32x32x16_bf16(b0, qr[d0], p0, 0, 0, 0); p1 = __builtin_amdgcn_mfma_f32_32x32x16_bf16(b1, qr[d0], p1, 0, 0, 0); } } }
        if (BIAS) { const float* bb = Bs + cur * 64 + 4 * hi;
#pragma unroll
            for (int g = 0; g < 4; ++g) { const f32x4 x0 = *(const f32x4*)(bb + 8 * g), x1 = *(const f32x4*)(bb + 32 + 8 * g);
#pragma unroll
                for (int e = 0; e < 4; ++e) { p0[4 * g + e] += x0[e]; p1[4 * g + e] += x1[e]; } } }
        if (t >= NT - 4) { const int kb0 = 64 * (t - (NT - 4)) + 4 * hi;
#pragma unroll
            for (int r = 0; r < 16; ++r) { const int kv = kb0 + (r & 3) + 8 * (r >> 2); if (kv > qrel) p0[r] = -INFINITY; if (kv + 32 > qrel) p1[r] = -INFINITY; } }
        float rm = fmaxf(p0[0], p1[0]);
#pragma unroll
        for (int r = 1; r < 16; ++r) rm = fmaxf(rm, fmaxf(p0[r], p1[r]));
        { auto rr = __builtin_amdgcn_permlane32_swap(__float_as_uint(rm), __float_as_uint(rm), false, false); rm = fmaxf(__uint_as_float(rr[0]), __uint_as_float(rr[1])); }
        bool resc = false;
        if (t == T0) { mhat = rm;
#pragma unroll
            for (int r = 0; r < 16; ++r) { p0[r] -= rm; p1[r] -= rm; }
#pragma unroll
            for (int r = 0; r < 16; ++r) negm[r] = -mhat;
        } else if (__any(rm > 8.0f)) { const float dl = fmaxf(rm, 0.f); mhat += dl;
#pragma unroll
            for (int r = 0; r < 16; ++r) { p0[r] -= dl; p1[r] -= dl; }
#pragma unroll
            for (int r = 0; r < 16; ++r) negm[r] = -mhat;
            const float f = __builtin_amdgcn_exp2f(-dl); l_reg *= f; if (hi == 0) wsf[r32] = f; resc = true; }
        float sacc = 0.f;
#pragma unroll
        for (int r = 0; r < 16; ++r) { p0[r] = __builtin_amdgcn_exp2f(p0[r]); p1[r] = __builtin_amdgcn_exp2f(p1[r]); sacc += p0[r] + p1[r]; }
        l_reg += sacc;
        u32x4 pw0, pw1, pw2, pw3;
        pw0 = (u32x4){cvtpk(p0[0], p0[1]), cvtpk(p0[2], p0[3]), cvtpk(p0[4], p0[5]), cvtpk(p0[6], p0[7])}; pw1 = (u32x4){cvtpk(p0[8], p0[9]), cvtpk(p0[10], p0[11]), cvtpk(p0[12], p0[13]), cvtpk(p0[14], p0[15])};
        pw2 = (u32x4){cvtpk(p1[0], p1[1]), cvtpk(p1[2], p1[3]), cvtpk(p1[4], p1[5]), cvtpk(p1[6], p1[7])}; pw3 = (u32x4){cvtpk(p1[8], p1[9]), cvtpk(p1[10], p1[11]), cvtpk(p1[12], p1[13]), cvtpk(p1[14], p1[15])};
        if (resc) { asm volatile("s_waitcnt lgkmcnt(0)" ::: "memory");
#pragma unroll
            for (int d_ = 0; d_ < 2; ++d_)
#pragma unroll
                for (int r = 0; r < 16; ++r) o[d_][r] *= wsf[crow(r, hi)]; }
        { const int vb = vb0 + cur * VSLOT;
#pragma unroll
          for (int d0 = 0; d0 < 2; ++d0) { s16x4 lo[4], hh[4];
#pragma unroll
            for (int ks = 0; ks < 4; ++ks) {
                asm volatile("ds_read_b64_tr_b16 %0,%1 offset:%c2" : "=&v"(lo[ks]) : "v"(vb), "i"(d0 * 4096 + ks * 1024) : "memory");
                asm volatile("ds_read_b64_tr_b16 %0,%1 offset:%c2" : "=&v"(hh[ks]) : "v"(vb), "i"(d0 * 4096 + ks * 1024 + 512) : "memory"); }
            asm volatile("s_waitcnt lgkmcnt(0)" ::: "memory"); __builtin_amdgcn_sched_barrier(0);
#define ATT_PK(k) (bf16x8){lo[k][0], lo[k][1], lo[k][2], lo[k][3], hh[k][0], hh[k][1], hh[k][2], hh[k][3]}
            o[d0] = __builtin_amdgcn_mfma_f32_32x32x16_bf16(__builtin_bit_cast(bf16x8, pw0), ATT_PK(0), o[d0], 0, 0, 0);
            o[d0] = __builtin_amdgcn_mfma_f32_32x32x16_bf16(__builtin_bit_cast(bf16x8, pw1), ATT_PK(1), o[d0], 0, 0, 0);
            o[d0] = __builtin_amdgcn_mfma_f32_32x32x16_bf16(__builtin_bit_cast(bf16x8, pw2), ATT_PK(2), o[d0], 0, 0, 0);
            o[d0] = __builtin_amdgcn_mfma_f32_32x32x16_bf16(__builtin_bit_cast(bf16x8, pw3), ATT_PK(3), o[d0], 0, 0, 0);
#undef ATT_PK
          } }
        if (BIAS && wid == 0 && t + 1 < NT) Bs[(cur ^ 1) * 64 + lane] = (cref - bnext) * 1.4426950408889634f;
        ATT_WAIT_BAR();
    }
    { auto rr = __builtin_amdgcn_permlane32_swap(__float_as_uint(l_reg), __float_as_uint(l_reg), false, false); l_reg = __uint_as_float(rr[0]) + __uint_as_float(rr[1]); }
    if (hi == 0) wsf[32 + r32] = l_reg; asm volatile("s_waitcnt lgkmcnt(0)" ::: "memory");
    float rli[16];
#pragma unroll
    for (int r = 0; r < 16; ++r) rli[r] = __builtin_amdgcn_rcpf(wsf[32 + crow(r, hi)]);
    bf16* Ow = Oh + (size_t)(q0 + wid * 32) * DM;
    { bf16* stg = (bf16*)(shm + L_OST) + wid * 2048;
#pragma unroll
      for (int r = 0; r < 16; ++r) { const int orow = crow(r, hi);
#pragma unroll
        for (int d0 = 0; d0 < 2; ++d0) stg[orow * 64 + d0 * 32 + r32] = (bf16)f2bf(o[d0][r] * rli[r]); }
      asm volatile("s_waitcnt lgkmcnt(0)" ::: "memory");
#pragma unroll
      for (int i = 0; i < 4; ++i) { const int row = i * 8 + (lane >> 3), ch = lane & 7; const u32x4 v = *(const u32x4*)(stg + row * 64 + ch * 8); *(u32x4*)(Ow + (size_t)row * DM + ch * 8) = v; } }
    asm volatile("s_waitcnt lgkmcnt(0)\n\ts_barrier" ::: "memory");
#undef ATT_DMA
}
}

constexpr int CW_AQ = 2048;
__device__ __forceinline__ void phase_attn_mfma(Frame& F, int j) {
    const bf16* PROJ = (const bf16*)(F.ws + WS_PROJ); const bf16* QM = (const bf16*)(F.ws + WS_QM); const bf16* KVB = (const bf16*)(F.ws + WS_KVB); const bf16* KM = (const bf16*)(F.ws + WS_KM);
    const float* CUM = (const float*)(F.ws + WS_CUM); bf16* MIX = (bf16*)(F.ws + WS_MIX);
    char* shm = (char*)(F.lds + RING_OFF);
    const int vcu = (F.G % 8 == 0) ? (F.bid % 8) * (F.G / 8) + F.bid / 8 : F.bid;
#pragma unroll 1
    for (int p = vcu; p < 512; p += F.G) { const int combo = p >> 5, s = p & 31, b = combo >> 3, h = combo & 7; const size_t rb = (size_t)b * SEQ;
#pragma unroll 1
        for (int half = 0; half < 2; ++half) { const int qb = half ? 63 - s : s;
            att::attn_unit<96, false>(F.tid, qb, QM + rb * 768 + h * 96, 768, KM + rb * 768 + h * 96, 768, KVB + rb * 1024 + h * 128 + 64, 1024, nullptr, MIX + rb * DM + 512 + h * 64, shm, 0.f); } }
    float gq = fabsf(kin(I_FOX_QN)[j * 64 + F.lane]), gk = fabsf(kin(I_FOX_KN)[j * 64 + F.lane]);
#pragma unroll
    for (int o = 1; o < 64; o <<= 1) { gq = fmaxf(gq, __shfl_xor(gq, o)); gk = fmaxf(gk, __shfl_xor(gk, o)); }
    const float margin = 2.0f * 1.02f * 64.0f * gq * gk * C2_FOX;
    LAS int* qslot = (LAS int*)(F.lds + LDSCTL_OFF + 64);
#pragma unroll 1
    for (;;) {
        if (F.tid == 0) *qslot = (int)__hip_atomic_fetch_add(F.ctl + CW_AQ + 64 * j, 1u, __ATOMIC_RELAXED, __HIP_MEMORY_SCOPE_AGENT);
        __syncthreads(); const int u = __builtin_amdgcn_readfirstlane(*qslot); __syncthreads();
        if (u >= 1024) break;
        const int qb = 63 - (u >> 4), combo = u & 15, b = combo >> 3, h = combo & 7; const size_t rb = (size_t)b * SEQ;
        att::attn_unit<64, true>(F.tid, qb, PROJ + rb * EVEN_INP + E_FQ + h * 64, EVEN_INP, PROJ + rb * EVEN_INP + E_FK + h * 64, EVEN_INP, PROJ + rb * EVEN_INP + E_FV + h * 64, EVEN_INP, CUM + rb * 8 + h, MIX + rb * DM + h * 64, shm, margin);
    }
}
constexpr size_t WS_S5_MT = WS_Y2;
constexpr size_t WS_S5_PT = WS_S5_MT + 72 * MiB;
constexpr size_t WS_S5_AX = WS_S5_PT + 16 * MiB;
constexpr size_t WS_S5_XLOC = WS_S5_AX + 36 * MiB;
static_assert(WS_S5_XLOC + 8 * MiB <= WS_Y2 + 144 * MiB, "s5 overlay");

__device__ __forceinline__ void s5_build(Frame& F, int j) {
    if (F.bid >= 256) return;
    const int g = F.bid >> 3, part = F.bid & 7, tid = F.tid, lane = F.lane, wave = F.wave;
    LAS float* pwr = (LAS float*)(F.lds + RING_OFF);
    LAS float* pwi = pwr + 65 * 64;
    LAS float* bbr = pwi + 65 * 64;
    LAS float* bbi = bbr + 1024;
    LAS float* crs = bbi + 1024;
    LAS float* cis = crs + 1024;
    LAS bf16* ktab = (LAS bf16*)(cis + 1024);
    const float dt = expf(kin(I_S5_LS)[j * 32 + g]);
    const float* are = kin(I_S5_ARE) + (size_t)(j * 32 + g) * 64; const float* aim = kin(I_S5_AIM) + (size_t)(j * 32 + g) * 64;
    for (int e = tid; e < 65 * 64; e += 512) { const int d = e >> 6, p = e & 63; const float lr = fminf(are[p], -1e-4f), li = aim[p];
        const float mag = expf(lr * dt * (float)d); float sn, cs; sincosf(li * dt * (float)d, &sn, &cs); pwr[e] = mag * cs; pwi[e] = mag * sn; }
    for (int e = tid; e < 1024; e += 512) { const int p = e >> 4, c = e & 15; const float lr = fminf(are[p], -1e-4f), li = aim[p];
        const float mag = expf(lr * dt); float sn, cs; sincosf(li * dt, &sn, &cs); const float abr = mag * cs, abi = mag * sn;
        const float den = lr * lr + li * li, nr = abr - 1.0f, ni = abi; const float gr = (nr * lr + ni * li) / den, gi = (ni * lr - nr * li) / den;
        const float br = kin(I_S5_BRE)[((size_t)(j * 32 + g) * 64 + p) * 16 + c], bi = kin(I_S5_BIM)[((size_t)(j * 32 + g) * 64 + p) * 16 + c];
        bbr[e] = gr * br - gi * bi; bbi[e] = gr * bi + gi * br; }
    for (int e = tid; e < 1024; e += 512) { crs[e] = kin(I_S5_CRE)[(size_t)(j * 32 + g) * 1024 + e]; cis[e] = kin(I_S5_CIM)[(size_t)(j * 32 + g) * 1024 + e]; }
    __syncthreads();
    { const int cc = tid >> 1, c = cc >> 4, c2 = cc & 15, ph = tid & 1;
      float er[32], ei[32];
#pragma unroll
      for (int pp = 0; pp < 32; ++pp) { const int p = 32 * ph + pp; const float xr = crs[c * 64 + p], xi = cis[c * 64 + p], yr = bbr[p * 16 + c2], yi = bbi[p * 16 + c2]; er[pp] = xr * yr - xi * yi; ei[pp] = xr * yi + xi * yr; }
#pragma unroll 1
      for (int d = 0; d < 64; ++d) { float s = 0.f; const LAS float* wr_ = pwr + d * 64 + 32 * ph; const LAS float* wi_ = pwi + d * 64 + 32 * ph;
#pragma unroll
          for (int pp = 0; pp < 32; ++pp) s += wr_[pp] * er[pp] - wi_[pp] * ei[pp];
          s += __shfl_xor(s, 1);
          if (ph == 0) ktab[(d * 16 + c) * 16 + c2] = (bf16)f2bf(s); } }
    __syncthreads();
    bf16* MT = (bf16*)(F.ws + WS_S5_MT) + (size_t)g * 1024 * 1152;
#pragma unroll 1
    for (int rr = wave; rr < 128; rr += 8) { const int i = part * 8 + (rr >> 4), c = rr & 15; bf16* row = MT + (size_t)(i * 16 + c) * 1152;
        v4u a = {0u, 0u, 0u, 0u}, b = {0u, 0u, 0u, 0u};
        if (lane <= i) { const LAS v4u* src = (const LAS v4u*)(ktab + ((i - lane) * 16 + c) * 16); a = src[0]; b = src[1]; }
        *(v4u*)(row + lane * 16) = a; *(v4u*)(row + lane * 16 + 8) = b;
        { const int p = lane; const float xr = crs[c * 64 + p], xi = cis[c * 64 + p], wr_ = pwr[(i + 1) * 64 + p], wi_ = pwi[(i + 1) * 64 + p];
          row[1024 + p] = (bf16)f2bf(xr * wr_ - xi * wi_); row[1088 + p] = (bf16)f2bf(-(xr * wi_ + xi * wr_)); } }
    bf16* PT = (bf16*)(F.ws + WS_S5_PT) + (size_t)g * 256 * 1024;
#pragma unroll 1
    for (int rr = wave; rr < 32; rr += 8) { const int n = part * 32 + rr; bf16* row = PT + (size_t)n * 1024 + lane * 16;
        unsigned o[8];
        if (n < 128) { const int p = n & 63, im = n >> 6; const float wr_ = pwr[(63 - lane) * 64 + p], wi_ = pwi[(63 - lane) * 64 + p];
#pragma unroll
            for (int q = 0; q < 8; ++q) { const float y0r = bbr[p * 16 + 2 * q], y0i = bbi[p * 16 + 2 * q], y1r = bbr[p * 16 + 2 * q + 1], y1i = bbi[p * 16 + 2 * q + 1];
                const float v0 = im ? (wr_ * y0i + wi_ * y0r) : (wr_ * y0r - wi_ * y0i), v1 = im ? (wr_ * y1i + wi_ * y1r) : (wr_ * y1r - wi_ * y1i); o[q] = pk2(v0, v1); }
        } else {
#pragma unroll
            for (int q = 0; q < 8; ++q) o[q] = 0u; }
        *(v4u*)row = (v4u){o[0], o[1], o[2], o[3]}; *(v4u*)(row + 8) = (v4u){o[4], o[5], o[6], o[7]}; }
    __syncthreads();
}
__device__ __forceinline__ void s5_repack(Frame& F) {
    const bf16* PROJ = (const bf16*)(F.ws + WS_PROJ); bf16* AX = (bf16*)(F.ws + WS_S5_AX);
    const int gt = F.bid * 512 + F.tid, NT = F.G * 512;
    for (int e = gt; e < NTOK * 32; e += NT) { const int m = e >> 5, g = e & 31; const int b = m / SEQ, t = m % SEQ, n = t >> 6, s = t & 63;
        const v4u* src = (const v4u*)(PROJ + (size_t)m * ODD_INP + O_U + g * 16); v4u* dst = (v4u*)(AX + ((size_t)g * 512 + b * 256 + n) * 1152 + s * 16);
        const v4u x0 = src[0], x1 = src[1]; dst[0] = x0; dst[1] = x1; }
}
struct S5POrder {
    int G, c;
    __device__ bool next(int i, pg8::Unit& u) const { const int L = i * G + c; if (L >= 64) return false; u.aux = L >> 1; u.pm = L & 1; u.pn = 0; return true; }
    __device__ __forceinline__ const char* a_base(const pg8::Gemm& g, const pg8::Unit& u) const { return (const char*)g.A + ((size_t)u.aux * 512 + u.pm * 256) * 1152 * 2; }
    __device__ __forceinline__ const char* b_base(const pg8::Gemm& g, const pg8::Unit& u) const { return (const char*)g.Bt + (size_t)u.aux * 256 * 1024 * 2; }
};
struct S5PEpi {
    static constexpr bool PERM = false;
    float* X;
    __device__ __forceinline__ void operator()(const pg8::f32x4 (&acc)[2][2][4][2], const pg8::Unit& u, int wr, int wc, int fr, int fq) const {
        const int row0 = u.pm * 256 + wr * 64 + fr; const int col0 = wc * 32 + 4 * fq;
#pragma unroll
        for (int ai = 0; ai < 2; ++ai)
#pragma unroll
            for (int m = 0; m < 4; ++m) { float* rowp = X + ((size_t)u.aux * 512 + row0 + ai * 128 + m * 16) * 128 + col0;
#pragma unroll
                for (int n = 0; n < 2; ++n) *(pg8::f32x4*)(rowp + n * 16) = acc[ai][0][m][n]; }
    }
};
__device__ __forceinline__ void s5_scan(Frame& F, int j) {
    const int gw = F.bid * NWAVES + F.wave; if (gw >= 64) return;
    const int g = gw >> 1, b = gw & 1, p = F.lane;
    const float lr = fminf(kin(I_S5_ARE)[(size_t)(j * 32 + g) * 64 + p], -1e-4f), li = kin(I_S5_AIM)[(size_t)(j * 32 + g) * 64 + p]; const float dt = expf(kin(I_S5_LS)[j * 32 + g]);
    const float mag = expf(lr * dt * 64.f); float sn, cs; sincosf(li * dt * 64.f, &sn, &cs); const float ar = mag * cs, ai = mag * sn;
    const float* X = (const float*)(F.ws + WS_S5_XLOC) + ((size_t)g * 512 + b * 256) * 128; bf16* AX = (bf16*)(F.ws + WS_S5_AX) + ((size_t)g * 512 + b * 256) * 1152 + 1024;
    float xr = 0.f, xi = 0.f; float cr[8], ci[8], nr[8], ni[8];
#pragma unroll
    for (int q = 0; q < 8; ++q) { cr[q] = X[(size_t)q * 128 + p]; ci[q] = X[(size_t)q * 128 + 64 + p]; }
    for (int n0 = 0; n0 < 256; n0 += 8) { const int nn = (n0 + 8 < 256) ? n0 + 8 : n0;
#pragma unroll
        for (int q = 0; q < 8; ++q) { nr[q] = X[(size_t)(nn + q) * 128 + p]; ni[q] = X[(size_t)(nn + q) * 128 + 64 + p]; }
#pragma unroll
        for (int q = 0; q < 8; ++q) { AX[(size_t)(n0 + q) * 1152 + p] = (bf16)f2bf(xr); AX[(size_t)(n0 + q) * 1152 + 64 + p] = (bf16)f2bf(xi);
            const float tr = ar * xr - ai * xi + cr[q], ti = ar * xi + ai * xr + ci[q]; xr = tr; xi = ti; }
#pragma unroll
        for (int q = 0; q < 8; ++q) { cr[q] = nr[q]; ci[q] = ni[q]; } }
}
struct S5MOrder {
    int G, c;
    __device__ bool next(int i, pg8::Unit& u) const { const int L = i * G + c; if (L >= 256) return false; u.aux = L >> 3; u.pm = (L >> 2) & 1; u.pn = L & 3; return true; }
    __device__ __forceinline__ const char* a_base(const pg8::Gemm& g, const pg8::Unit& u) const { return (const char*)g.A + ((size_t)u.aux * 512 + u.pm * 256) * 1152 * 2; }
    __device__ __forceinline__ const char* b_base(const pg8::Gemm& g, const pg8::Unit& u) const { return (const char*)g.Bt + ((size_t)u.aux * 1024 + u.pn * 256) * 1152 * 2; }
};
struct S5MEpi {
    static constexpr bool PERM = true;
    bf16* HG; const bf16* PROJ; const float* dsk;
    __device__ __forceinline__ void operator()(const pg8::f32x4 (&acc)[2][2][4][2], const pg8::Unit& u, int wr, int wc, int fr, int fq) const {
        const int g = u.aux; const int row0 = u.pm * 256 + wr * 64 + fr; const int col0 = u.pn * 256 + wc * 32 + 8 * fq;
        const pg8::f32x4 d0 = *(const pg8::f32x4*)(dsk + g * 16 + (col0 & 15)), d1 = *(const pg8::f32x4*)(dsk + g * 16 + (col0 & 15) + 4);
#pragma unroll
        for (int ai = 0; ai < 2; ++ai)
#pragma unroll
            for (int m = 0; m < 4; ++m) { const int rg = row0 + ai * 128 + m * 16; const int b = rg >> 8, n = rg & 255;
#pragma unroll
                for (int bj = 0; bj < 2; ++bj) { const int col = col0 + bj * 128; const int i = col >> 4, c0 = col & 15; const size_t tok = (size_t)b * SEQ + n * 64 + i;
                    const pg8::u32x4 uw = *(const pg8::u32x4*)(PROJ + tok * ODD_INP + O_U + g * 16 + c0); const pg8::f32x4 v0 = acc[ai][bj][m][0], v1 = acc[ai][bj][m][1];
                    pg8::u32x4 w; w.x = pk2(gelu_tanh(v0[0] + d0[0] * bflo(uw.x)), gelu_tanh(v0[1] + d0[1] * bfhi(uw.x))); w.y = pk2(gelu_tanh(v0[2] + d0[2] * bflo(uw.y)), gelu_tanh(v0[3] + d0[3] * bfhi(uw.y)));
                    w.z = pk2(gelu_tanh(v1[0] + d1[0] * bflo(uw.z)), gelu_tanh(v1[1] + d1[1] * bfhi(uw.z))); w.w = pk2(gelu_tanh(v1[2] + d1[2] * bflo(uw.w)), gelu_tanh(v1[3] + d1[3] * bfhi(uw.w)));
                    *(pg8::u32x4*)(HG + tok * 512 + g * 16 + c0) = w; } }
    }
};
namespace gdn {
typedef short s16x4 __attribute__((ext_vector_type(4)));
#define GDN_MFMA(a, b, c) __builtin_amdgcn_mfma_f32_16x16x16bf16_1k(a, b, c, 0, 0, 0)
__device__ __forceinline__ float fsig(float x) { return __builtin_amdgcn_rcpf(1.0f + __expf(-x)); }
__device__ __forceinline__ float bperm(float v, int src_lane) { return __int_as_float(__builtin_amdgcn_ds_bpermute(src_lane << 2, __float_as_int(v))); }
__device__ __forceinline__ s16x4 pack4(float a, float b, float c, float d) { v2u w; w.x = pk2(a, b); w.y = pk2(c, d); return __builtin_bit_cast(s16x4, w); }
constexpr int NITEM = BATCH * 4 * (SEQ / 16);
constexpr int IMG_STRIDE = 144;
constexpr int WAVE_LDS = 1024 + 1024 + 3 * 16 * IMG_STRIDE * 2;
}
constexpr size_t WS_GDN_UB = WS_QG;
constexpr size_t WS_GDN_WT = WS_KG;
constexpr size_t WS_GDN_QD = WS_KG + 32 * MiB;
constexpr size_t WS_GDN_KD = WS_VG;
constexpr size_t WS_GDN_IT = WS_VG + 32 * MiB;

__device__ __forceinline__ void phase_gdn_g1(Frame& F, int j) {
    using namespace gdn;
    const bf16* PROJ = (const bf16*)(F.ws + WS_PROJ);
    const float* cw = kin(I_GDN_CONV) + (size_t)j * 4 * 1536;
    float* UB = (float*)(F.ws + WS_GDN_UB); bf16* WT = (bf16*)(F.ws + WS_GDN_WT); bf16* QD = (bf16*)(F.ws + WS_GDN_QD); bf16* KD = (bf16*)(F.ws + WS_GDN_KD); unsigned* ITE = (unsigned*)(F.ws + WS_GDN_IT);
    LAS float* Am = (LAS float*)(F.lds + RING_OFF + F.wave * WAVE_LDS); LAS float* Tm = Am + 256; LAS bf16* img = (LAS bf16*)(Tm + 256);
    const int gw = F.bid * NWAVES + F.wave, NGW = F.G * NWAVES;
#pragma unroll 1
    for (int item = gw; item < NITEM; item += NGW) {
        int lane = F.lane; asm volatile("" : "+v"(lane));
        const int tok = lane & 15, g4 = lane >> 4;
        const int b = item >> 12, h = (item >> 10) & 3, n = item & 1023; const int s0 = 16 * n + tok; const size_t m = (size_t)b * SEQ + s0;
        const size_t it = (size_t)item;
        const float gin = bf2f(PROJ[m * ODD_INP + O_GIN + h]), bin = bf2f(PROJ[m * ODD_INP + O_BETA + h]);
        const float gt = -expf(kin(I_GDN_ALOG)[j * 4 + h]) * softplusf_(gin + kin(I_GDN_DTB)[j * 4 + h]); const float beta = fsig(bin);
        float gc = gt;
#pragma unroll
        for (int off = 1; off < 16; off <<= 1) { const float t = bperm(gc, tok >= off ? lane - off : lane); if (tok >= off) gc += t; }
        const float glast = bperm(gc, lane | 15); const float eg = expf(gc), ekd = expf(glast - gc);
        LAS bf16* img2 = img + 16 * IMG_STRIDE; LAS bf16* img3 = img2 + 16 * IMG_STRIDE;
#define GDN_CONV(WSEL, X) do { _Pragma("unroll") for (int db = 0; db < 8; ++db) { const int ch = (WSEL) * 512 + h * 128 + 16 * db + 4 * g4; float a0 = 0.f, a1 = 0.f, a2 = 0.f, a3 = 0.f; \
            _Pragma("unroll") for (int tap = 0; tap < 4; ++tap) { if (s0 - 3 + tap >= 0) { const v2u x = *(const v2u*)(PROJ + (m - 3 + tap) * ODD_INP + O_Q + ch); const f32x4 wv = *(const f32x4*)(cw + tap * 1536 + ch); \
                a0 += wv.x * bflo(x.x); a1 += wv.y * bfhi(x.x); a2 += wv.z * bflo(x.y); a3 += wv.w * bfhi(x.y); } } \
            X[db][0] = a0 * fsig(a0); X[db][1] = a1 * fsig(a1); X[db][2] = a2 * fsig(a2); X[db][3] = a3 * fsig(a3); \
            if ((db & 3) == 3) asm volatile("" ::: "memory"); } } while (0)
        { float xv[8][4]; GDN_CONV(2, xv);
#pragma unroll
          for (int db = 0; db < 8; ++db) *(LAS s16x4*)(img + tok * IMG_STRIDE + 16 * db + 4 * g4) = pack4(xv[db][0] * beta, xv[db][1] * beta, xv[db][2] * beta, xv[db][3] * beta); }
        s16x4 Kf[8];
        { float xk[8][4]; GDN_CONV(1, xk); float sk = 0.f;
#pragma unroll
          for (int db = 0; db < 8; ++db)
#pragma unroll
              for (int e = 0; e < 4; ++e) sk += xk[db][e] * xk[db][e];
          sk += bperm(sk, lane ^ 16); sk += bperm(sk, lane ^ 32);
          const float rk = 1.0f / sqrtf(sk + RMS_EPS); const float s2 = rk * beta * eg, s3 = rk * ekd;
#pragma unroll
          for (int db = 0; db < 8; ++db) { const int o = tok * IMG_STRIDE + 16 * db + 4 * g4;
              *(LAS s16x4*)(img2 + o) = pack4(xk[db][0] * s2, xk[db][1] * s2, xk[db][2] * s2, xk[db][3] * s2);
              *(LAS s16x4*)(img3 + o) = pack4(xk[db][0] * s3, xk[db][1] * s3, xk[db][2] * s3, xk[db][3] * s3);
              Kf[db] = pack4(xk[db][0] * rk, xk[db][1] * rk, xk[db][2] * rk, xk[db][3] * rk); } }
        f32x4 Gacc = {0.f, 0.f, 0.f, 0.f}, Pacc = {0.f, 0.f, 0.f, 0.f};
        { float xqq[8][4]; GDN_CONV(0, xqq); float sq = 0.f;
#pragma unroll
          for (int db = 0; db < 8; ++db)
#pragma unroll
              for (int e = 0; e < 4; ++e) sq += xqq[db][e] * xqq[db][e];
          sq += bperm(sq, lane ^ 16); sq += bperm(sq, lane ^ 32);
          const float rq = (1.0f / sqrtf(sq + RMS_EPS)) * 0.08838834764831845f;
#pragma unroll
          for (int db = 0; db < 8; ++db) {
              *(s16x4*)(QD + ((it * 4 + (db >> 1)) * 64 + lane) * 8 + (db & 1) * 4) = pack4(xqq[db][0] * rq * eg, xqq[db][1] * rq * eg, xqq[db][2] * rq * eg, xqq[db][3] * rq * eg);
              const s16x4 Qf = pack4(xqq[db][0] * rq, xqq[db][1] * rq, xqq[db][2] * rq, xqq[db][3] * rq);
              Gacc = GDN_MFMA(Kf[db], Kf[db], Gacc); Pacc = GDN_MFMA(Kf[db], Qf, Pacc); } }
#undef GDN_CONV
        { float itv[4];
#pragma unroll
          for (int r = 0; r < 4; ++r) { const int i = 4 * g4 + r; const float gci = bperm(gc, i), bi = bperm(beta, i);
              const float da = (tok < i) ? expf(gci - gc) : 0.f;
              Am[i * 16 + tok] = bi * Gacc[r] * da;
              const float dp = (i <= tok) ? expf(gc - gci) : 0.f;
              itv[r] = Pacc[r] * dp; }
          v4u ite; ite.x = pk2(itv[0], itv[1]); ite.y = pk2(itv[2], itv[3]); ite.z = __float_as_uint(expf(glast)); ite.w = 0u;
          *(v4u*)(ITE + (it * 64 + lane) * 4) = ite; }
        LDS_WAIT();
        float Tc[16];
#pragma unroll
        for (int i = 0; i < 16; ++i) { float s = (i == tok) ? 1.f : 0.f;
#pragma unroll
            for (int jj = 0; jj < i; ++jj) s -= Am[i * 16 + jj] * Tc[jj];
            Tc[i] = s; }
#pragma unroll
        for (int r = 0; r < 4; ++r) Tm[(4 * g4 + r) * 16 + tok] = (g4 == 0) ? Tc[r] : (g4 == 1) ? Tc[4 + r] : (g4 == 2) ? Tc[8 + r] : Tc[12 + r];
        LDS_WAIT();
        const f32x4 trow = *(const LAS f32x4*)(Tm + tok * 16 + 4 * g4);
        const s16x4 Tf = pack4(trow.x, trow.y, trow.z, trow.w);
        const int traddr = (int)(uintptr_t)img + ((4 * g4 + ((lane & 15) >> 2)) * IMG_STRIDE + 4 * (lane & 3)) * 2;
#pragma unroll
        for (int cb = 0; cb < 8; ++cb) { s16x4 vf; asm volatile("ds_read_b64_tr_b16 %0, %1 offset:%c2\n\ts_waitcnt lgkmcnt(0)" : "=&v"(vf) : "v"(traddr), "i"(cb * 32) : "memory");
            const f32x4 z = {0.f, 0.f, 0.f, 0.f}; const f32x4 u = GDN_MFMA(Tf, vf, z);
            *(f32x4*)(UB + ((it * 8 + cb) * 64 + lane) * 4) = u; }
#pragma unroll
        for (int db = 0; db < 8; ++db) { s16x4 kf; asm volatile("ds_read_b64_tr_b16 %0, %1 offset:%c2\n\ts_waitcnt lgkmcnt(0)" : "=&v"(kf) : "v"(traddr), "i"(16 * IMG_STRIDE * 2 + db * 32) : "memory");
            const f32x4 z = {0.f, 0.f, 0.f, 0.f}; const f32x4 w = GDN_MFMA(kf, Tf, z);
            *(s16x4*)(WT + ((it * 4 + (db >> 1)) * 64 + lane) * 8 + (db & 1) * 4) = pack4(-w.x, -w.y, -w.z, -w.w); }
#pragma unroll
        for (int db = 0; db < 8; ++db) { s16x4 kf; asm volatile("ds_read_b64_tr_b16 %0, %1 offset:%c2\n\ts_waitcnt lgkmcnt(0)" : "=&v"(kf) : "v"(traddr), "i"(32 * IMG_STRIDE * 2 + db * 32) : "memory");
            *(s16x4*)(KD + ((it * 4 + (db >> 1)) * 64 + lane) * 8 + (db & 1) * 4) = kf; }
        LDS_WAIT();
    }
}

__device__ __forceinline__ void phase_gdn_g2(Frame& F) {
    using namespace gdn;
    if (F.bid >= 64) return;
    const char* UB = (const char*)(F.ws + WS_GDN_UB); const char* WT = (const char*)(F.ws + WS_GDN_WT); const char* QD = (const char*)(F.ws + WS_GDN_QD); const char* KD = (const char*)(F.ws + WS_GDN_KD);
    const char* ITE = (const char*)(F.ws + WS_GDN_IT); float* OGN = (float*)(F.ws + WS_OG);
    const int lane = F.lane, bh = F.bid & 7, sl = F.bid >> 3, wave = F.wave;
    constexpr int SLOT = 14 * 1024, NSLOT = 8, INFL = 6;
    volatile LAS int* ready = (volatile LAS int*)(F.lds + LDSCTL_OFF + 128);
    volatile LAS int* done = (volatile LAS int*)(F.lds + LDSCTL_OFF + 192);
    if (F.tid < 8) ready[F.tid] = 0; if (F.tid == 8) *done = 0;
    __syncthreads();
    const size_t it0 = (size_t)bh * 1024;
    if (wave != 0) {
        const unsigned ring = (unsigned)(uintptr_t)(F.lds + RING_OFF); const size_t lo16 = (size_t)lane * 16;
        const int p0 = 2 * (wave - 1);
#pragma unroll 1
        for (int s = 0; s < 1024; ++s) {
            if (s >= NSLOT) { unsigned sp_ = 0; while (*done < s - NSLOT + 1) { __builtin_amdgcn_s_sleep(1); if (++sp_ > (1u << 24)) break; } }
            const size_t i_ = it0 + s; const unsigned d_ = ring + (unsigned)((s % NSLOT) * SLOT);
#pragma unroll
            for (int k = 0; k < 2; ++k) { const int pc = p0 + k; const char* src;
                if (pc == 0) src = UB + ((i_ * 8 + sl) * 64) * 16; else if (pc <= 4) src = WT + ((i_ * 4 + (pc - 1)) * 64) * 16; else if (pc <= 8) src = QD + ((i_ * 4 + (pc - 5)) * 64) * 16;
                else if (pc <= 12) src = KD + ((i_ * 4 + (pc - 9)) * 64) * 16; else src = ITE + (i_ * 64) * 16;
                att::glds16(src + lo16, (unsigned)__builtin_amdgcn_readfirstlane(d_ + pc * 1024)); }
            asm volatile("s_waitcnt vmcnt(10)" ::: "memory");
            if (s >= INFL - 1 && lane == 0) ready[wave] = s - (INFL - 1) + 1;
        }
        asm volatile("s_waitcnt vmcnt(0)" ::: "memory"); if (lane == 0) ready[wave] = 1024;
        return;
    }
    f32x4 S[8];
#pragma unroll
    for (int db = 0; db < 8; ++db) S[db] = (f32x4){0.f, 0.f, 0.f, 0.f};
#pragma unroll 1
    for (int n = 0; n < 1024; ++n) {
        { unsigned sp_ = 0; for (;;) { const int r1 = ready[1], r2 = ready[2], r3 = ready[3], r4 = ready[4], r5 = ready[5], r6 = ready[6], r7 = ready[7];
              const int mn = min(min(min(r1, r2), min(r3, r4)), min(min(r5, r6), r7)); if (mn > n) break; __builtin_amdgcn_s_sleep(1); if (++sp_ > (1u << 24)) break; } }
        const LAS char* sp = (const LAS char*)(F.lds + RING_OFF) + (n % NSLOT) * SLOT + lane * 16;
        const f32x4 u_c = *(const LAS f32x4*)sp; const v4u ite = *(const LAS v4u*)(sp + 13 * 1024);
        v4u wt[4], qd[4], kd[4];
#pragma unroll
        for (int q = 0; q < 4; ++q) { wt[q] = *(const LAS v4u*)(sp + (1 + q) * 1024); qd[q] = *(const LAS v4u*)(sp + (5 + q) * 1024); kd[q] = *(const LAS v4u*)(sp + (9 + q) * 1024); }
        asm volatile("s_waitcnt lgkmcnt(0)" ::: "memory");
        if (lane == 0) *done = n + 1;
#define FR(v, h) __builtin_bit_cast(s16x4, (v2u){(h) ? (v).z : (v).x, (h) ? (v).w : (v).y})
        const float egl = __uint_as_float(ite.z); const s16x4 itf = __builtin_bit_cast(s16x4, (v2u){ite.x, ite.y});
        s16x4 Sb[8];
#pragma unroll
        for (int db = 0; db < 8; ++db) Sb[db] = pack4(S[db].x, S[db].y, S[db].z, S[db].w);
        f32x4 va = u_c, vb2 = {0.f, 0.f, 0.f, 0.f};
#pragma unroll
        for (int q = 0; q < 4; ++q) { va = GDN_MFMA(FR(wt[q], 0), Sb[2 * q], va); vb2 = GDN_MFMA(FR(wt[q], 1), Sb[2 * q + 1], vb2); }
        va = va + vb2;
        const s16x4 vb = pack4(va.x, va.y, va.z, va.w);
        f32x4 oa = {0.f, 0.f, 0.f, 0.f}, ob = {0.f, 0.f, 0.f, 0.f};
        oa = GDN_MFMA(itf, vb, oa);
#pragma unroll
        for (int q = 0; q < 4; ++q) { oa = GDN_MFMA(FR(qd[q], 0), Sb[2 * q], oa); ob = GDN_MFMA(FR(qd[q], 1), Sb[2 * q + 1], ob); }
        oa = oa + ob;
#pragma unroll
        for (int q = 0; q < 4; ++q) { const f32x4 s0 = S[2 * q] * egl, s1 = S[2 * q + 1] * egl; S[2 * q] = GDN_MFMA(FR(kd[q], 0), vb, s0); S[2 * q + 1] = GDN_MFMA(FR(kd[q], 1), vb, s1); }
        *(f32x4*)(OGN + (((it0 + n) * 8 + sl) * 64 + lane) * 4) = oa;
#undef FR
    }
}
__device__ __forceinline__ void phase_gdn_out2(Frame& F, int j) {
    using namespace gdn;
    const float* OGN = (const float*)(F.ws + WS_OG); const bf16* PROJ = (const bf16*)(F.ws + WS_PROJ); bf16* MIX = (bf16*)(F.ws + WS_MIX);
    const float* on = kin(I_GDN_ONORM) + j * 128; const int lane = F.lane, c = lane & 15, g4 = lane >> 4;
    const int gw = F.bid * NWAVES + F.wave, NGW = F.G * NWAVES;
#pragma unroll 1
    for (int item = gw; item < NITEM; item += NGW) { const int b = item >> 12, h = (item >> 10) & 3, n = item & 1023;
        f32x4 o[8]; float ss[4] = {0.f, 0.f, 0.f, 0.f};
#pragma unroll
        for (int sl = 0; sl < 8; ++sl) { o[sl] = *(const f32x4*)(OGN + (((size_t)item * 8 + sl) * 64 + lane) * 4);
#pragma unroll
            for (int r = 0; r < 4; ++r) ss[r] += o[sl][r] * o[sl][r]; }
#pragma unroll
        for (int r = 0; r < 4; ++r) { ss[r] += __shfl_xor(ss[r], 1); ss[r] += __shfl_xor(ss[r], 2); ss[r] += __shfl_xor(ss[r], 4); ss[r] += __shfl_xor(ss[r], 8); ss[r] = 1.0f / sqrtf(ss[r] * (1.f / 128.f) + RMS_EPS); }
#pragma unroll
        for (int r = 0; r < 4; ++r) { const size_t tok = (size_t)b * SEQ + 16 * n + 4 * g4 + r;
#pragma unroll
            for (int sl = 0; sl < 8; ++sl) { const int col = 16 * sl + c; const float zz = bf2f(PROJ[tok * ODD_INP + O_Z + h * 128 + col]);
                MIX[tok * DM + 512 + h * 128 + col] = (bf16)f2bf(o[sl][r] * ss[r] * on[col] * (zz * fsig(zz))); } }
    }
}
constexpr int LSTEPS = 16;
constexpr int STEP_END = 1 + DEPTH * LSTEPS;
struct KArgs { Args a; int li, pad; };

#define FRAME Frame F; { int wv_ = wave0; asm volatile("" : "+s"(wv_)); int t_ = wv_ * 64 + (int)__builtin_amdgcn_mbcnt_hi(~0u, __builtin_amdgcn_mbcnt_lo(~0u, 0u)); asm volatile("" : "+v"(t_)); unsigned char* w_ = kws(); F.lds = lds0; F.ws = w_; F.ctl = (unsigned*)(w_ + WS_CTL); \
        F.tid = t_; F.lane = t_ & 63; F.wave = __builtin_amdgcn_readfirstlane(t_ >> 6); { int g_ = gridDim.x, b_ = blockIdx.x; asm volatile("" : "+s"(g_), "+s"(b_)); F.G = g_; F.bid = b_; } } unsigned char* const ws = F.ws; (void)ws
#ifndef PH_MASK
#define PH_MASK 0xffffffffu
#endif
#define EN(k) (((PH_MASK) >> (k)) & 1u)
#ifndef DUP_E
#define DUP_E 0u
#endif
#ifndef DUP_O
#define DUP_O 0u
#endif
#define NREP(s) ((((s) >= 1) && (((((((s) - 1) / LSTEPS) & 1) ? (DUP_O) : (DUP_E)) >> (((s) + LSTEPS - 1) % LSTEPS)) & 1u)) ? 2 : 1)
#define STEP(s) if (lo <= (s) && (s) < hi) for (int rep_ = 0; rep_ < NREP(s); ++rep_)
#define DRY(s) (NREP(s) == 2 && rep_ == 0)
#define ENDSTEP(s) do { if ((s) + 1 < hi) xcd_barrier(bar); } while (0)
#define LAUNDER_WS do {} while (0)


template <int layer> __device__ __forceinline__ void layer_body(const XcdBarrier& bar, const int lo, const int hi, LAS unsigned char* const lds0, const int wave0) {
        constexpr int sb = 1 + layer * LSTEPS, j = layer >> 1; constexpr bool even = (layer & 1) == 0;
        STEP(sb + 0) if constexpr (EN(0)) { FRAME;
            phase_norm(F, layer == 0 ? kin(I_X) : kout(), kin(I_NORM_MIX) + layer * DM, layer == 0 ? kout() : nullptr);
            moe_weights(F, layer); phase_pconv(F, layer);
            if constexpr (!even) { __syncthreads(); s5_build(F, j); }
            ENDSTEP(sb + 0);
        }
        STEP(sb + 1) if constexpr (EN(1)) { FRAME;
            { LAUNDER_WS; const int NP = even ? EVEN_INP : ODD_INP; const bf16* W = even ? (const bf16*)(ws + WS_W_EVIN) + (size_t)j * EVEN_INP * 1024 : (const bf16*)(ws + WS_W_ODIN) + (size_t)j * ODD_INP * 1024;
              pg8::Gemm g{(const bf16*)(ws + WS_ABF), W, 1024, 1024, 1024}; pg8::StaticOrder S; S.init(NTOK, NP, F.G, F.bid); pg8::EpiBf16 E{(bf16*)(ws + WS_PROJ), NP};
              pg8::gemm_phase<pg8::EpiBf16, pg8::StaticOrder>(F.lds + RING_OFF, g, S, E, F.tid); }
            { LAUNDER_WS; pg8::Gemm g{(const bf16*)(ws + WS_PBF), (const bf16*)(ws + WS_W_PLEP) + (size_t)layer * 1024 * 256, 256, 256, 256}; pg8::StaticOrder S; S.init(NTOK, 1024, F.G, F.bid); pg8::EpiBf16 E{(bf16*)(ws + WS_PP), 1024};
              pg8::gemm_phase<pg8::EpiBf16, pg8::StaticOrder>(F.lds + RING_OFF, g, S, E, F.tid); }
            ENDSTEP(sb + 1);
        }
        if constexpr (even) {
            STEP(sb + 2) if constexpr (EN(2)) { FRAME; phase_even_post(F, j, DRY(sb + 2)); ENDSTEP(sb + 2); }
            STEP(sb + 3) if constexpr (EN(3)) { FRAME;
#ifndef NO_QUP
                { LAUNDER_WS; pg8::Gemm g{(const bf16*)(ws + WS_CQN), (const bf16*)(ws + WS_W_QUP) + (size_t)j * 768 * 384, 384, 384, 384}; pg8::StaticOrder S; S.init(NTOK, 768, F.G, F.bid); pg8::EpiBf16 E{(bf16*)(ws + WS_QM), 768};
                  pg8::gemm_phase<pg8::EpiBf16, pg8::StaticOrder>(F.lds + RING_OFF, g, S, E, F.tid); }
#endif
#ifndef NO_KVUP
                { LAUNDER_WS; pg8::Gemm g{(const bf16*)(ws + WS_CKVN), (const bf16*)(ws + WS_W_KVUP) + (size_t)j * 1024 * 256, 256, 256, 256}; pg8::StaticOrder S; S.init(NTOK, 1024, F.G, F.bid); pg8::EpiBf16 E{(bf16*)(ws + WS_KVB), 1024};
                  pg8::gemm_phase<pg8::EpiBf16, pg8::StaticOrder>(F.lds + RING_OFF, g, S, E, F.tid); }
#endif
#ifndef NO_CUMSUM
                phase_cumsum(F);
#endif
                ENDSTEP(sb + 3);
            }
            STEP(sb + 4) if constexpr (EN(4)) { FRAME; phase_mla_post(F, j, DRY(sb + 4)); ENDSTEP(sb + 4); }
            STEP(sb + 5) if constexpr (EN(5)) { FRAME;
#ifdef ATTN_NAIVE
                phase_attn_naive(F);
#else
                phase_attn_mfma(F, j);
#endif
                ENDSTEP(sb + 5); }
        } else {
            STEP(sb + 2) if constexpr (EN(2)) { FRAME; s5_repack(F);
#ifdef GDN_NAIVE
                phase_gdn_prep(F, j);
#else
                phase_gdn_g1(F, j);
#endif
                ENDSTEP(sb + 2); }
            STEP(sb + 3) if constexpr (EN(3)) { FRAME;
                { pg8::Gemm g{(const bf16*)(ws + WS_S5_AX), (const bf16*)(ws + WS_S5_PT), 1024, 1152, 1024}; S5POrder S{F.G, F.bid}; S5PEpi E{(float*)(ws + WS_S5_XLOC)};
                  pg8::gemm_phase<S5PEpi, S5POrder>(F.lds + RING_OFF, g, S, E, F.tid); }
#ifdef GDN_NAIVE
                phase_gdn_naive(F);
#else
                phase_gdn_g2(F);
#endif
                ENDSTEP(sb + 3);
            }
            STEP(sb + 4) if constexpr (EN(4)) { FRAME; s5_scan(F, j);
#ifdef GDN_NAIVE
                phase_gdn_out(F, j);
#else
                phase_gdn_out2(F, j);
#endif
                ENDSTEP(sb + 4); }
            STEP(sb + 5) if constexpr (EN(5)) { FRAME;
                pg8::Gemm g{(const bf16*)(ws + WS_S5_AX), (const bf16*)(ws + WS_S5_MT), 1152, 1152, 1152}; S5MOrder S{F.G, F.bid}; S5MEpi E{(bf16*)(ws + WS_HG), (const bf16*)(ws + WS_PROJ), kin(I_S5_D) + j * 512};
                pg8::gemm_phase<S5MEpi, S5MOrder>(F.lds + RING_OFF, g, S, E, F.tid);
                ENDSTEP(sb + 5);
            }
            STEP(sb + 6) if constexpr (EN(6)) { FRAME;
                pg8::Gemm g{(const bf16*)(ws + WS_HG), (const bf16*)(ws + WS_W_GLU) + (size_t)j * 512 * 512, 512, 512, 512}; pg8::StaticOrder S; S.init(NTOK, 512, F.G, F.bid);
                pg8::EpiGlu E{(bf16*)(ws + WS_MIX), 1024, (const bf16*)(ws + WS_HG), 512, kin(I_S5_BGLU) + j * 512};
                pg8::gemm_phase<pg8::EpiGlu, pg8::StaticOrder>(F.lds + RING_OFF, g, S, E, F.tid);
                ENDSTEP(sb + 6);
            }
        }
        STEP(sb + 7) if constexpr (EN(7)) { FRAME;
            LAUNDER_WS; const bf16* W = even ? (const bf16*)(ws + WS_W_EVOUT) + (size_t)j * 1024 * 1024 : (const bf16*)(ws + WS_W_ODOUT) + (size_t)j * 1024 * 1024;
            pg8::Gemm g{(const bf16*)(ws + WS_MIX), W, 1024, 1024, 1024}; pg8::StaticOrder S; S.init(NTOK, 1024, F.G, F.bid); pg8::EpiResAdd E{DRY(sb + 7) ? (float*)(ws + WS_DUMMY) : kout(), 1024};
            pg8::gemm_phase<pg8::EpiResAdd, pg8::StaticOrder>(F.lds + RING_OFF, g, S, E, F.tid);
            ENDSTEP(sb + 7);
        }
        STEP(sb + 8) if constexpr (EN(8)) { FRAME; phase_router(F, layer, DRY(sb + 8)); ENDSTEP(sb + 8); }
        STEP(sb + 9) if constexpr (EN(9)) { FRAME; phase_moe_scatter(F, layer); ENDSTEP(sb + 9); }
        STEP(sb + 10) if constexpr (EN(10)) { FRAME;
            LAUNDER_WS; moe_tables(F, layer);
            const LAS int* rowbase = (const LAS int*)(F.lds + LDSCTL_OFF + LC_MOE);
            MoeOrder S{__builtin_amdgcn_readfirstlane(rowbase[34]), 4, F.G, F.bid, (const LAS unsigned char*)(F.lds + LDSCTL_OFF + LC_MOE + 192), (size_t)1024 * 1024 * 2};
            pg8::Gemm g{(const bf16*)(ws + WS_XG), (const bf16*)(ws + WS_W_MOEGU), 1024, 1024, 1024}; pg8::EpiSwiglu E{(bf16*)(ws + WS_HB), 512};
            pg8::gemm_phase<pg8::EpiSwiglu, MoeOrder>(F.lds + RING_OFF, g, S, E, F.tid);
            ENDSTEP(sb + 10);
        }
        STEP(sb + 11) if constexpr (EN(11)) { FRAME;
            LAUNDER_WS; moe_tables(F, layer);
            const LAS int* rowbase = (const LAS int*)(F.lds + LDSCTL_OFF + LC_MOE);
            MoeOrder S{__builtin_amdgcn_readfirstlane(rowbase[34]), 4, F.G, F.bid, (const LAS unsigned char*)(F.lds + LDSCTL_OFF + LC_MOE + 192), (size_t)1024 * 512 * 2};
            pg8::Gemm g{(const bf16*)(ws + WS_HB), (const bf16*)(ws + WS_W_MOED), 512, 512, 512}; pg8::EpiBf16 E{(bf16*)(ws + WS_Y2), 1024};
            pg8::gemm_phase<pg8::EpiBf16, MoeOrder>(F.lds + RING_OFF, g, S, E, F.tid);
            ENDSTEP(sb + 11);
        }
        STEP(sb + 12) if constexpr (EN(12)) { FRAME; phase_moe_combine(F, layer, DRY(sb + 12)); ENDSTEP(sb + 12); }
        STEP(sb + 13) if constexpr (EN(13)) { FRAME;
            LAUNDER_WS; pg8::Gemm g{(const bf16*)(ws + WS_ABF), (const bf16*)(ws + WS_W_PLEG) + (size_t)layer * 1024 * 1024, 1024, 1024, 1024}; pg8::StaticOrder S; S.init(NTOK, 1024, F.G, F.bid);
            pg8::EpiPle E{DRY(sb + 13) ? (float*)(ws + WS_DUMMY) : kout(), (const bf16*)(ws + WS_PP), kin(I_PLE_BG) + layer * DM, 1024};
            pg8::gemm_phase<pg8::EpiPle, pg8::StaticOrder>(F.lds + RING_OFF, g, S, E, F.tid);
            ENDSTEP(sb + 13);
        }
    }
__global__ void __launch_bounds__(NWAVES * 64, 2) mega_fwd(KArgs ka) {
    extern __shared__ __attribute__((aligned(16))) unsigned char lds_raw[];
    const Args& args = ka.a;
    LAS unsigned char* const lds0 = (LAS unsigned char*)lds_raw;
    const int wave0 = __builtin_amdgcn_readfirstlane((int)threadIdx.x >> 6);
    for (int u = threadIdx.x; u < (LDS_BYTES - LDSCTL_OFF) / 4; u += NWAVES * 64) ((LAS unsigned*)(lds0 + LDSCTL_OFF))[u] = 0u;
    __syncthreads();
    XcdBarrier bar = xcd_barrier_post((unsigned*)(kws() + WS_CTL) + CW_BAR + ka.li * XCD_BAR_WORDS, (volatile LAS unsigned*)(lds0 + LDSCTL_OFF + LC_BARST));
    const int lo = args.ph_lo, hi = args.ph_hi;
    STEP(0) if constexpr (EN(15)) { FRAME; prologue_weights(F); ENDSTEP(0); }
    layer_body<0>(bar, lo, hi, lds0, wave0); layer_body<1>(bar, lo, hi, lds0, wave0); layer_body<2>(bar, lo, hi, lds0, wave0); layer_body<3>(bar, lo, hi, lds0, wave0);
#undef STEP
#undef ENDSTEP
}

#ifndef MK_MODE
#define MK_MODE 0
#endif
extern "C" void kernel_launch(void* const* d_in, const int* in_sizes, int n_in, void* d_out, int out_size, void* d_ws, size_t ws_size, hipStream_t stream) {
    static int ready = 0;
    if (ready == 0) {
        if (n_in != N_IN || out_size != NTOK * DM || ws_size < WS_END) { fprintf(stderr, "kernel_launch: unexpected shapes n_in %d out %d ws %zu (need %zu)\n", n_in, out_size, ws_size, (size_t)WS_END); ready = -1; return; }
        if (hipFuncSetAttribute((const void*)mega_fwd, hipFuncAttributeMaxDynamicSharedMemorySize, LDS_BYTES) != hipSuccess) { fprintf(stderr, "kernel_launch: hipFuncSetAttribute failed\n"); ready = -1; return; }
        int per_cu = 0; (void)hipOccupancyMaxActiveBlocksPerMultiprocessor(&per_cu, (const void*)mega_fwd, NWAVES * 64, LDS_BYTES); (void)hipGetLastError();
        ready = 1;
    }
    if (ready < 0) return;
    (void)hipMemsetAsync((char*)d_ws + WS_CTL, 0, CTL_ZERO_BYTES, stream);
    KArgs ka{};
    for (int i = 0; i < N_IN; ++i) ka.a.in[i] = (const float*)d_in[i];
    ka.a.out = (float*)d_out; ka.a.ws = (unsigned char*)d_ws; ka.li = 0; ka.pad = 0;
    const int grid = 256;
#if MK_MODE == 1
    ka.a.ph_lo = 0; ka.a.ph_hi = STEP_END;
    hipLaunchKernelGGL(mega_fwd, dim3(grid), dim3(NWAVES * 64), LDS_BYTES, stream, ka);
#else
    for (int s = 0; s < STEP_END; ++s) {
        if (s > 0) { const int k = (s - 1) % LSTEPS, layer = (s - 1) / LSTEPS; const bool even = (layer & 1) == 0;
            if (k > 13) continue; if (k == 6 && even) continue; }
        ka.a.ph_lo = s; ka.a.ph_hi = s + 1;
        hipLaunchKernelGGL(mega_fwd, dim3(grid), dim3(NWAVES * 64), LDS_BYTES, stream, ka);
    }
#endif
}
```

```cpp
#include <hip/hip_runtime.h>
#include <cstdio>
#include <cstdint>
#define MK_MODE 1
namespace pg8 {
#define PG8_LAS __attribute__((address_space(3)))
typedef unsigned short bf16_t;
typedef short bf16x8 __attribute__((ext_vector_type(8)));
typedef float f32x4 __attribute__((ext_vector_type(4)));
typedef float f32x2 __attribute__((ext_vector_type(2)));
typedef unsigned u32x4 __attribute__((ext_vector_type(4)));
typedef unsigned u32x2 __attribute__((ext_vector_type(2)));
constexpr int BM = 256, BK = 64, HALF = 128, HTB = HALF * BK * 2  , STAGE_BYTES = 8 * HTB, NXCD = 8, WGM = 8;

__host__ __device__ __forceinline__ int lds_byte(int r, int c) { const int st = (r >> 4) * 2 + (c >> 5), rr = r & 15, cc = c & 31, ob = rr * 64 + cc * 2; return st * 1024 + (ob ^ (((ob >> 9) & 1) << 5)); }
__host__ __device__ __forceinline__ void stage_rc(int b, int& R, int& C) { const int st = b / 1024, sb = b % 1024, swz = sb ^ (((sb >> 9) & 1) << 5); R = (st >> 1) * 16 + swz / 64; C = (st & 1) * 32 + (swz % 64) / 2; }
__host__ __device__ __forceinline__ int perm32(int rho) { const int n = rho >> 4, i = rho & 15; return 8 * (i >> 2) + 4 * n + (i & 3); }

struct Unit { int pm, pn, aux; };
struct Gemm { const bf16_t* A; const bf16_t* Bt; int K, lda, ldb; };

struct StaticOrder {
    int nM, nN, nwg, G, c;
    __device__ void init(int M, int N, int G_, int c_) { nM = M / BM; nN = N / BM; nwg = nM * nN; G = G_; c = c_; }
    __device__ bool next(int i, Unit& u) const {
        const long L = (long)i * G + c; if (L >= nwg) return false;
        int wgid = (int)L; { const int q = nwg / NXCD, r = nwg % NXCD, xcd = wgid % NXCD, off = wgid / NXCD; wgid = (xcd < r ? xcd * (q + 1) : r * (q + 1) + (xcd - r) * q) + off; }
        const int nig = WGM * nN, gid = wgid / nig, fm = gid * WGM, gsz = (nM - fm) < WGM ? (nM - fm) : WGM;
        u.pm = fm + ((wgid % nig) % gsz); u.pn = (wgid % nig) / gsz; u.aux = 0; return true;
    }
    __device__ __forceinline__ const char* a_base(const Gemm& g, const Unit& u) const { return (const char*)g.A + (size_t)u.pm * BM * g.lda * 2; }
    __device__ __forceinline__ const char* b_base(const Gemm& g, const Unit& u) const { return (const char*)g.Bt + (size_t)u.pn * BM * g.ldb * 2; }
};

__device__ __forceinline__ unsigned cvt_pk_bf16(float lo, float hi) { unsigned r; asm volatile("v_cvt_pk_bf16_f32 %0, %1, %2" : "=v"(r) : "v"(lo), "v"(hi)); return r; }
__device__ __forceinline__ float bf_lo(unsigned w) { return __uint_as_float(w << 16); }
__device__ __forceinline__ float bf_hi(unsigned w) { return __uint_as_float(w & 0xffff0000u); }

struct EpiBf16 {
    static constexpr bool PERM = true;
    bf16_t* O; int ldc;
    __device__ __forceinline__ void operator()(const f32x4 (&acc)[2][2][4][2], const Unit& u, int wr, int wc, int fr, int fq) const {
        const int row0 = u.pm * BM + wr * 64 + fr; const int col0 = u.pn * BM + wc * 32 + 8 * fq;
#pragma unroll
        for (int ai = 0; ai < 2; ++ai)
#pragma unroll
            for (int m = 0; m < 4; ++m) { bf16_t* rowp = O + (size_t)(row0 + ai * HALF + m * 16) * ldc + col0;
#pragma unroll
                for (int bj = 0; bj < 2; ++bj) { const f32x4 v0 = acc[ai][bj][m][0], v1 = acc[ai][bj][m][1];
                    u32x4 w; w.x = cvt_pk_bf16(v0[0], v0[1]); w.y = cvt_pk_bf16(v0[2], v0[3]); w.z = cvt_pk_bf16(v1[0], v1[1]); w.w = cvt_pk_bf16(v1[2], v1[3]);
                    *(u32x4*)(rowp + bj * HALF) = w; } }
    }
};
struct EpiResAdd {
    static constexpr bool PERM = false;
    float* H; int ldc;
    __device__ __forceinline__ void operator()(const f32x4 (&acc)[2][2][4][2], const Unit& u, int wr, int wc, int fr, int fq) const {
        const int row0 = u.pm * BM + wr * 64 + fr; const int col0 = u.pn * BM + wc * 32 + 4 * fq;
#pragma unroll
        for (int ai = 0; ai < 2; ++ai)
#pragma unroll
            for (int m = 0; m < 4; ++m) { float* rowp = H + (size_t)(row0 + ai * HALF + m * 16) * ldc + col0;
#pragma unroll
                for (int bj = 0; bj < 2; ++bj)
#pragma unroll
                    for (int n = 0; n < 2; ++n) { f32x4* p = (f32x4*)(rowp + bj * HALF + n * 16); *p = *p + acc[ai][bj][m][n]; } }
    }
};
__device__ __forceinline__ float sigmoidf_(float x) { return 1.0f / (1.0f + __expf(-x)); }
struct EpiPle {
    static constexpr bool PERM = false;
    float* H; const bf16_t* PP; const float* bias; int ldc;
    __device__ __forceinline__ void operator()(const f32x4 (&acc)[2][2][4][2], const Unit& u, int wr, int wc, int fr, int fq) const {
        const int row0 = u.pm * BM + wr * 64 + fr; const int col0 = u.pn * BM + wc * 32 + 4 * fq;
#pragma unroll
        for (int ai = 0; ai < 2; ++ai)
#pragma unroll
            for (int m = 0; m < 4; ++m) { const size_t ro = (size_t)(row0 + ai * HALF + m * 16) * ldc + col0;
#pragma unroll
                for (int bj = 0; bj < 2; ++bj)
#pragma unroll
                    for (int n = 0; n < 2; ++n) { const int co = bj * HALF + n * 16; f32x4* p = (f32x4*)(H + ro + co); const u32x2 pw = *(const u32x2*)(PP + ro + co);
                        const f32x4 bv = *(const f32x4*)(bias + col0 + co); const f32x4 a = acc[ai][bj][m][n] + bv; f32x4 h = *p;
                        h[0] += sigmoidf_(a[0]) * bf_lo(pw.x); h[1] += sigmoidf_(a[1]) * bf_hi(pw.x); h[2] += sigmoidf_(a[2]) * bf_lo(pw.y); h[3] += sigmoidf_(a[3]) * bf_hi(pw.y); *p = h; } }
    }
};
struct EpiGlu {
    static constexpr bool PERM = true;
    bf16_t* O; int ldo; const bf16_t* HG; int ldh; const float* bias;
    __device__ __forceinline__ void operator()(const f32x4 (&acc)[2][2][4][2], const Unit& u, int wr, int wc, int fr, int fq) const {
        const int row0 = u.pm * BM + wr * 64 + fr; const int col0 = u.pn * BM + wc * 32 + 8 * fq;
#pragma unroll
        for (int ai = 0; ai < 2; ++ai)
#pragma unroll
            for (int m = 0; m < 4; ++m) { const size_t r = (size_t)(row0 + ai * HALF + m * 16);
#pragma unroll
                for (int bj = 0; bj < 2; ++bj) { const int c = col0 + bj * HALF; const u32x4 hw = *(const u32x4*)(HG + r * ldh + c);
                    const f32x4 b0 = *(const f32x4*)(bias + c), b1 = *(const f32x4*)(bias + c + 4); const f32x4 v0 = acc[ai][bj][m][0] + b0, v1 = acc[ai][bj][m][1] + b1;
                    u32x4 w; w.x = cvt_pk_bf16(bf_lo(hw.x) * sigmoidf_(v0[0]), bf_hi(hw.x) * sigmoidf_(v0[1])); w.y = cvt_pk_bf16(bf_lo(hw.y) * sigmoidf_(v0[2]), bf_hi(hw.y) * sigmoidf_(v0[3]));
                    w.z = cvt_pk_bf16(bf_lo(hw.z) * sigmoidf_(v1[0]), bf_hi(hw.z) * sigmoidf_(v1[1])); w.w = cvt_pk_bf16(bf_lo(hw.w) * sigmoidf_(v1[2]), bf_hi(hw.w) * sigmoidf_(v1[3]));
                    *(u32x4*)(O + r * ldo + c) = w; } }
    }
};
struct EpiSwiglu {
    static constexpr bool PERM = true;
    bf16_t* HB; int ldc;
    __device__ __forceinline__ void operator()(const f32x4 (&acc)[2][2][4][2], const Unit& u, int wr, int wc, int fr, int fq) const {
        const int row0 = u.pm * BM + wr * 64 + fr; const int col0 = u.pn * HALF + wc * 32 + 8 * fq;
#pragma unroll
        for (int ai = 0; ai < 2; ++ai)
#pragma unroll
            for (int m = 0; m < 4; ++m) { bf16_t* rowp = HB + (size_t)(row0 + ai * HALF + m * 16) * ldc + col0;
                const f32x4 g0 = acc[ai][0][m][0], g1 = acc[ai][0][m][1], u0 = acc[ai][1][m][0], u1 = acc[ai][1][m][1];
                u32x4 w; w.x = cvt_pk_bf16(g0[0] * sigmoidf_(g0[0]) * u0[0], g0[1] * sigmoidf_(g0[1]) * u0[1]); w.y = cvt_pk_bf16(g0[2] * sigmoidf_(g0[2]) * u0[2], g0[3] * sigmoidf_(g0[3]) * u0[3]);
                w.z = cvt_pk_bf16(g1[0] * sigmoidf_(g1[0]) * u1[0], g1[1] * sigmoidf_(g1[1]) * u1[1]); w.w = cvt_pk_bf16(g1[2] * sigmoidf_(g1[2]) * u1[2], g1[3] * sigmoidf_(g1[3]) * u1[3]);
                *(u32x4*)rowp = w; }
    }
};

template <class Epi, class Sched, bool ALIGN_EPI = true, bool SP2 = true>
__device__ __forceinline__ void gemm_phase(PG8_LAS unsigned char* lds, const Gemm g, const Sched& S, const Epi& E, const int tid) {
    const int wid = __builtin_amdgcn_readfirstlane(tid >> 6), lane = tid & 63, wr = wid >> 2, wc = wid & 3, fr = lane & 15, fq = lane >> 4;
    int K = g.K; asm volatile("" : "+s"(K));
    const int nt = K / BK;
    unsigned voffA[2], voffB[2];
#pragma unroll
    for (int i = 0; i < 2; ++i) { int R, C; stage_rc(tid * 16 + i * 8192, R, C); const int Rb = Epi::PERM ? ((R & ~31) + perm32(R & 31)) : R;
        voffA[i] = (unsigned)(R * g.lda + C) * 2u; voffB[i] = (unsigned)(Rb * g.ldb + C) * 2u; }
    const size_t kstep = (size_t)(BK * 2);
    const size_t hstepA = (size_t)HALF * g.lda * 2, hstepB = (size_t)HALF * g.ldb * 2;
    const unsigned ldsw = (unsigned)wid * 1024u;
    const int aoff = lds_byte(wr * 64 + fr, fq * 8), boff = lds_byte(wc * 32 + fr, fq * 8);
#define PG8_SA(b, h) (((b) * 2 + (h)) * HTB)
#define PG8_SB(b, h) ((4 + (b) * 2 + (h)) * HTB)
#define PG8_STAGE(bufoff, gbase, voff) do { _Pragma("unroll") for (int _i = 0; _i < 2; ++_i) \
        __builtin_amdgcn_global_load_lds((const unsigned*)((const char*)(gbase) + (voff)[_i]), (PG8_LAS unsigned*)(lds + (bufoff) + ldsw + _i * 8192), 16, 0, 0); } while (0)
#define PG8_LDA(dst, b, h) do { _Pragma("unroll") for (int m = 0; m < 4; ++m) _Pragma("unroll") for (int k = 0; k < 2; ++k) dst[m][k] = *(const PG8_LAS bf16x8*)(lds + PG8_SA(b, h) + aoff + m * 2048 + k * 1024); } while (0)
#define PG8_LDB(dst, b, h) do { _Pragma("unroll") for (int n = 0; n < 2; ++n) _Pragma("unroll") for (int k = 0; k < 2; ++k) dst[n][k] = *(const PG8_LAS bf16x8*)(lds + PG8_SB(b, h) + boff + n * 2048 + k * 1024); } while (0)
#define PG8_MMA(ai, bj, At, Bt) do { __builtin_amdgcn_s_setprio(1); _Pragma("unroll") for (int m = 0; m < 4; ++m) _Pragma("unroll") for (int n = 0; n < 2; ++n) _Pragma("unroll") for (int k = 0; k < 2; ++k) \
        acc[ai][bj][m][n] = __builtin_amdgcn_mfma_f32_16x16x32_bf16(Bt[n][k], At[m][k], acc[ai][bj][m][n], 0, 0, 0); __builtin_amdgcn_s_setprio(0); } while (0)
#define PG8_WAIT_V(n) asm volatile("s_waitcnt vmcnt(" #n ")" ::: "memory")
#define PG8_WAIT_L(n) asm volatile("s_waitcnt lgkmcnt(" #n ")" ::: "memory")
#define PG8_BAR __builtin_amdgcn_s_barrier()
#define PG8_SCHED __builtin_amdgcn_sched_barrier(0)
    Unit cur, nxt; int ui = 0;
    if (!S.next(0, cur)) return;
    f32x4 acc[2][2][4][2];
#pragma unroll
    for (int a = 0; a < 2; ++a)
#pragma unroll
        for (int b = 0; b < 2; ++b)
#pragma unroll
            for (int m = 0; m < 4; ++m)
#pragma unroll
                for (int n = 0; n < 2; ++n) acc[a][b][m][n] = (f32x4){0.f, 0.f, 0.f, 0.f};
    bf16x8 At[4][2], B0[2][2], B1[2][2];
    const char* cA = S.a_base(g, cur); const char* cB = S.b_base(g, cur);
    if constexpr (SP2) {
        PG8_STAGE(PG8_SB(0, 0), cB, voffB); PG8_STAGE(PG8_SB(0, 1), cB + hstepB, voffB); PG8_STAGE(PG8_SA(0, 0), cA, voffA); PG8_STAGE(PG8_SA(0, 1), cA + hstepA, voffA);
        if (wr == 1) PG8_BAR;
        PG8_WAIT_V(2); PG8_BAR;
        PG8_STAGE(PG8_SB(1, 0), cB + kstep, voffB); PG8_STAGE(PG8_SA(1, 0), cA + kstep, voffA); PG8_STAGE(PG8_SB(1, 1), cB + hstepB + kstep, voffB);
        PG8_WAIT_V(6); PG8_BAR;
    } else {
        PG8_STAGE(PG8_SB(0, 0), cB, voffB); PG8_STAGE(PG8_SA(0, 0), cA, voffA); PG8_STAGE(PG8_SB(0, 1), cB + hstepB, voffB); PG8_STAGE(PG8_SA(0, 1), cA + hstepA, voffA);
        if (wr == 1) PG8_BAR;
        PG8_WAIT_V(4); PG8_BAR;
        PG8_STAGE(PG8_SB(1, 0), cB + kstep, voffB); PG8_STAGE(PG8_SA(1, 0), cA + kstep, voffA); PG8_STAGE(PG8_SB(1, 1), cB + hstepB + kstep, voffB);
        PG8_WAIT_V(6); PG8_BAR;
    }
    for (;;) {
        const bool has_next = S.next(ui + 1, nxt);
        const char* nA = has_next ? S.a_base(g, nxt) : cA; const char* nB = has_next ? S.b_base(g, nxt) : cB;
        for (int t = 0; t < nt; t += 2) {
            const bool last = (t == nt - 2);
            const char* a1 = cA + (size_t)(t + 1) * kstep;
            const char* a2 = last ? nA : cA + (size_t)(t + 2) * kstep; const char* b2 = last ? nB : cB + (size_t)(t + 2) * kstep;
            const char* a3 = a2 + kstep; const char* b3 = b2 + kstep;
            if constexpr (SP2) {
            PG8_LDB(B0, 0, 0); PG8_LDB(B1, 0, 1); PG8_SCHED; PG8_LDA(At, 0, 0); PG8_STAGE(PG8_SA(1, 1), a1 + hstepA, voffA);
            PG8_WAIT_V(8); PG8_WAIT_L(0); PG8_BAR; PG8_MMA(0, 0, At, B0); PG8_MMA(0, 1, At, B1); PG8_BAR; PG8_SCHED;
            PG8_LDA(At, 0, 1); PG8_STAGE(PG8_SB(0, 0), b2, voffB); PG8_STAGE(PG8_SB(0, 1), b2 + hstepB, voffB); PG8_STAGE(PG8_SA(0, 0), a2, voffA);
            PG8_WAIT_V(8); PG8_WAIT_L(0); PG8_BAR; PG8_MMA(1, 0, At, B0); PG8_MMA(1, 1, At, B1); PG8_BAR; PG8_SCHED;
            PG8_LDB(B0, 1, 0); PG8_LDB(B1, 1, 1); PG8_SCHED; PG8_LDA(At, 1, 0); PG8_STAGE(PG8_SA(0, 1), a2 + hstepA, voffA);
            PG8_WAIT_V(8); PG8_WAIT_L(0); PG8_BAR; PG8_MMA(0, 0, At, B0); PG8_MMA(0, 1, At, B1); PG8_BAR; PG8_SCHED;
            PG8_LDA(At, 1, 1); PG8_STAGE(PG8_SB(1, 0), b3, voffB); PG8_STAGE(PG8_SB(1, 1), b3 + hstepB, voffB); PG8_STAGE(PG8_SA(1, 0), a3, voffA);
            PG8_WAIT_V(8); PG8_WAIT_L(0); PG8_BAR; PG8_MMA(1, 0, At, B0); PG8_MMA(1, 1, At, B1); PG8_BAR; PG8_SCHED;
            } else {
            PG8_LDB(B0, 0, 0); PG8_SCHED; PG8_LDA(At, 0, 0); PG8_STAGE(PG8_SA(1, 1), a1 + hstepA, voffA);
            PG8_WAIT_L(8); PG8_BAR; PG8_WAIT_L(0); PG8_MMA(0, 0, At, B0); PG8_BAR; PG8_SCHED;
            PG8_LDB(B1, 0, 1); PG8_STAGE(PG8_SB(0, 0), b2, voffB);
            PG8_BAR; PG8_WAIT_L(0); PG8_MMA(0, 1, At, B1); PG8_BAR;
            PG8_LDA(At, 0, 1); PG8_STAGE(PG8_SA(0, 0), a2, voffA);
            PG8_BAR; PG8_WAIT_L(0); PG8_MMA(1, 0, At, B0); PG8_BAR; PG8_SCHED;
            PG8_STAGE(PG8_SB(0, 1), b2 + hstepB, voffB);
            PG8_WAIT_V(6); PG8_BAR; PG8_MMA(1, 1, At, B1); PG8_BAR;
            PG8_LDB(B0, 1, 0); PG8_SCHED; PG8_LDA(At, 1, 0); PG8_STAGE(PG8_SA(0, 1), a2 + hstepA, voffA);
            PG8_WAIT_L(8); PG8_BAR; PG8_WAIT_L(0); PG8_MMA(0, 0, At, B0); PG8_BAR; PG8_SCHED;
            PG8_LDB(B1, 1, 1); PG8_STAGE(PG8_SB(1, 0), b3, voffB);
            PG8_BAR; PG8_WAIT_L(0); PG8_MMA(0, 1, At, B1); PG8_BAR;
            PG8_LDA(At, 1, 1); PG8_STAGE(PG8_SA(1, 0), a3, voffA);
            PG8_BAR; PG8_WAIT_L(0); PG8_MMA(1, 0, At, B0); PG8_BAR; PG8_SCHED;
            PG8_STAGE(PG8_SB(1, 1), b3 + hstepB, voffB);
            PG8_WAIT_V(6); PG8_BAR; PG8_MMA(1, 1, At, B1); PG8_BAR;
            }
        }
        if constexpr (ALIGN_EPI) { if (wr == 0) PG8_BAR; }
        E(acc, cur, wr, wc, fr, fq);
        if (!has_next) break;
#pragma unroll
        for (int a = 0; a < 2; ++a)
#pragma unroll
            for (int b = 0; b < 2; ++b)
#pragma unroll
                for (int m = 0; m < 4; ++m)
#pragma unroll
                    for (int n = 0; n < 2; ++n) acc[a][b][m][n] = (f32x4){0.f, 0.f, 0.f, 0.f};
        cur = nxt; cA = nA; cB = nB; ++ui;
        if constexpr (ALIGN_EPI) { if (wr == 1) PG8_BAR; }
    }
    PG8_WAIT_V(0);
    if constexpr (!ALIGN_EPI) { if (wr == 0) PG8_BAR; }
    PG8_BAR;
#undef PG8_SA
#undef PG8_SB
#undef PG8_STAGE
#undef PG8_LDA
#undef PG8_LDB
#undef PG8_MMA
#undef PG8_WAIT_V
#undef PG8_WAIT_L
#undef PG8_BAR
#undef PG8_SCHED
}
}
#define LAS __attribute__((address_space(3)))
#define XB_TMO      128
#define XB_XCNT(j)  (256  + 64 * (j))
#define XB_XSUB(j)  (1280 + 64 * (j))
#define XB_XGEN(j)  (2304 + 64 * (j))
#define XB_TOP      3328
#define XB_TOPGEN   3392
#define XCD_BAR_WORDS 3456
#define XB_SPIN_CAP (1u << 22)

__device__ __forceinline__ unsigned xb_ld(unsigned* p)              { return __hip_atomic_load(p, __ATOMIC_RELAXED, __HIP_MEMORY_SCOPE_AGENT); }
__device__ __forceinline__ unsigned xb_add(unsigned* p, unsigned v) { return __hip_atomic_fetch_add(p, v, __ATOMIC_RELAXED, __HIP_MEMORY_SCOPE_AGENT); }
__device__ __forceinline__ unsigned xb_xcc_id() { return (unsigned)__builtin_amdgcn_s_getreg((3 << 11) | 20) & 0xFu; }
#define XB_SPIN(cond, bar) do { unsigned _sp = 0; while (cond) { __builtin_amdgcn_s_sleep(1); \
    if ((++_sp & 255u) == 0u) { if (xb_ld(&(bar)[XB_TMO])) break; if (_sp > XB_SPIN_CAP) { atomicAdd(&(bar)[XB_TMO], 1u); break; } } } } while (0)

struct XcdBarrier {
    unsigned* bar; unsigned x;
    volatile LAS unsigned* st;
};

__device__ __forceinline__ XcdBarrier xcd_barrier_post(unsigned* bar, volatile LAS unsigned* st) {
    XcdBarrier b; b.bar = bar; b.x = xb_xcc_id(); b.st = st;
    if (threadIdx.x == 0) (void)xb_add(&bar[XB_XCNT(b.x)], 1u);
    return b;
}
__device__ __forceinline__ void xcd_barrier_complete(unsigned* bar, unsigned x, unsigned& nloc, unsigned& nx) {
    const unsigned G = gridDim.x * gridDim.y * gridDim.z;
    unsigned sum, cnt, mine, sp = 0u;
    for (;;) {
        sum = 0u; cnt = 0u; mine = 0u;
#pragma unroll
        for (unsigned j = 0; j < 16; ++j) { const unsigned c = xb_ld(&bar[XB_XCNT(j)]); sum += c; cnt += (c > 0u) ? 1u : 0u; mine = (j == x) ? c : mine; }
        if (sum == G) break;
        __builtin_amdgcn_s_sleep(1);
        if ((++sp & 255u) == 0u) { if (xb_ld(&bar[XB_TMO])) break; if (sp > XB_SPIN_CAP) { atomicAdd(&bar[XB_TMO], 1u); break; } }
    }
    nloc = mine > 0u ? mine : 1u; nx = cnt > 0u ? cnt : 1u;
}

__device__ __forceinline__ void xcd_barrier(const XcdBarrier& b) {
    asm volatile("s_waitcnt vmcnt(0)" ::: "memory");
    __syncthreads();
    if (threadIdx.x == 0) {
        unsigned* bar = b.bar;
        __builtin_amdgcn_s_waitcnt(0);
        unsigned nloc = b.st[0], nx = b.st[1];
        if (nloc == 0u) { xcd_barrier_complete(bar, b.x, nloc, nx); b.st[0] = nloc; b.st[1] = nx; }
        const unsigned old = xb_add(&bar[XB_XSUB(b.x)], 1u);
        const unsigned gen = old / nloc;
        if (old + 1u == (gen + 1u) * nloc) {
            __builtin_amdgcn_fence(__ATOMIC_RELEASE, "agent");
            asm volatile("s_waitcnt vmcnt(0)" ::: "memory");
            const unsigned og = xb_add(&bar[XB_TOP], 1u);
            const unsigned tg = og / nx;
            if (og + 1u == (tg + 1u) * nx) xb_add(&bar[XB_TOPGEN], 1u);
            else XB_SPIN(xb_ld(&bar[XB_TOPGEN]) == tg, bar);
            __builtin_amdgcn_fence(__ATOMIC_ACQUIRE, "agent");
            xb_add(&bar[XB_XGEN(b.x)], 1u);
            asm volatile("s_waitcnt vmcnt(0)" ::: "memory");
        } else {
            XB_SPIN(xb_ld(&bar[XB_XGEN(b.x)]) == gen, bar);
            __builtin_amdgcn_fence(__ATOMIC_ACQUIRE, "agent");
            asm volatile("s_waitcnt vmcnt(0)" ::: "memory");
        }
    }
    __syncthreads();
}
#undef LAS
constexpr int NWAVES = 8;
constexpr int BATCH = 2, SEQ = 16384, NTOK = BATCH * SEQ, DM = 1024, DEPTH = 4, PLE = 256;
constexpr int EVEN_IN = 2216, EVEN_INP = 2304, ODD_IN = 2568, ODD_INP = 2816;
constexpr int E_FQ = 0, E_FK = 512, E_FV = 1024, E_FLOG = 1536, E_CQ = 1544, E_CKV = 1928, E_KROPE = 2184;
constexpr int O_U = 0, O_Q = 512, O_K = 1024, O_V = 1536, O_GIN = 2048, O_BETA = 2052, O_Z = 2056;
constexpr float RMS_EPS = 1e-6f;
constexpr float LOG2E = 1.4426950408889634f, LN2 = 0.6931471805599453f;
constexpr float C2_FOX = 0.125f * LOG2E, C2_MLA = 0.10206207261596575f * LOG2E;
constexpr int MOE_CAP = 65536 + 32 * 256;
constexpr int MOE_MAXT = MOE_CAP / 256;

enum { I_X = 0, I_P, I_POS, I_NORM_MIX, I_NORM_FFN, I_EV_W_IN, I_FOX_BF, I_FOX_QN, I_FOX_KN, I_MLA_QAN, I_MLA_WQUP, I_MLA_KVAN, I_MLA_WKVUP, I_MLA_QN, I_MLA_KN, I_EV_W_OUT,
       I_OD_W_IN, I_S5_ARE, I_S5_AIM, I_S5_BRE, I_S5_BIM, I_S5_CRE, I_S5_CIM, I_S5_D, I_S5_LS, I_S5_WGLU, I_S5_BGLU, I_GDN_CONV, I_GDN_ALOG, I_GDN_DTB, I_GDN_ONORM, I_OD_W_OUT,
       I_MOE_WGRP, I_MOE_BGRP, I_MOE_WEXP, I_MOE_BEXP, I_MOE_WG, I_MOE_WU, I_MOE_WD, I_PLE_WP, I_PLE_NORM, I_PLE_WG, I_PLE_BG, N_IN };

constexpr size_t MiB = 1u << 20;
constexpr size_t WS_CTL = 0, CTL_ZERO_BYTES = 1 * MiB;
constexpr size_t WS_W_EVIN = 4 * MiB;
constexpr size_t WS_W_ODIN = WS_W_EVIN + 9 * MiB;
constexpr size_t WS_W_QUP = WS_W_ODIN + 11 * MiB;
constexpr size_t WS_W_KVUP = WS_W_QUP + 2 * MiB;
constexpr size_t WS_W_EVOUT = WS_W_KVUP + 1 * MiB;
constexpr size_t WS_W_ODOUT = WS_W_EVOUT + 4 * MiB;
constexpr size_t WS_W_GLU = WS_W_ODOUT + 4 * MiB;
constexpr size_t WS_W_PLEP = WS_W_GLU + 1 * MiB;
constexpr size_t WS_W_PLEG = WS_W_PLEP + 2 * MiB;
constexpr size_t WS_W_MOEGU = WS_W_PLEG + 8 * MiB;
constexpr size_t WS_W_MOED = WS_W_MOEGU + 64 * MiB;
constexpr size_t WS_ABF = WS_W_MOED + 32 * MiB;
constexpr size_t WS_PP = WS_ABF + 64 * MiB;
constexpr size_t WS_PBF = WS_PP + 64 * MiB;
constexpr size_t WS_PROJ = WS_PBF + 16 * MiB;
constexpr size_t WS_MIX = WS_PROJ + 176 * MiB;
constexpr size_t WS_R1 = WS_MIX + 64 * MiB;
constexpr size_t WS_QM = WS_R1, WS_KVB = WS_QM + 48 * MiB, WS_KM = WS_KVB + 64 * MiB, WS_CQN = WS_KM + 48 * MiB, WS_CKVN = WS_CQN + 24 * MiB, WS_LOGF = WS_CKVN + 16 * MiB, WS_CUM = WS_LOGF + 1 * MiB;
constexpr size_t WS_HG = WS_R1, WS_QG = WS_HG + 32 * MiB, WS_KG = WS_QG + 64 * MiB, WS_VG = WS_KG + 64 * MiB, WS_OG = WS_VG + 64 * MiB;
constexpr size_t WS_R2 = WS_R1 + 288 * MiB;
constexpr size_t WS_GB = WS_R2, WS_BETA = WS_GB + 1 * MiB;
constexpr size_t WS_TOKE = WS_R2 + 2 * MiB, WS_TOKW = WS_TOKE + 1 * MiB, WS_ROWS = WS_TOKW + 1 * MiB;
constexpr size_t WS_XG = WS_R1;
constexpr size_t WS_HB = WS_XG + 144 * MiB;
constexpr size_t WS_Y2 = WS_R2 + 8 * MiB;
constexpr size_t WS_END = WS_Y2 + 144 * MiB;
static_assert(WS_HB + 72 * MiB <= WS_R2, "moe overlay");
static_assert(WS_OG + 64 * MiB <= WS_R2, "odd overlay");
constexpr size_t WS_DUMMY = WS_END;
static_assert(WS_DUMMY + 128 * MiB <= 1100 * MiB, "workspace budget");

constexpr int CW_BAR = 4096;
constexpr int CW_CNT = 1024;

constexpr int RING_OFF = 0, RING_BYTES = 131072;
constexpr int LDSCTL_OFF = RING_BYTES;
constexpr int LDS_BYTES = 147456;
constexpr int LC_BARST = 32;
constexpr int LC_MOE = 256;

#define GAS __attribute__((address_space(1)))
#define LAS __attribute__((address_space(3)))
typedef unsigned short bf16;
typedef unsigned v4u __attribute__((ext_vector_type(4)));
typedef unsigned v2u __attribute__((ext_vector_type(2)));
typedef float f32x4 __attribute__((ext_vector_type(4)));
#define LDS_WAIT() asm volatile("s_waitcnt lgkmcnt(0)" ::: "memory")
#define VM_WAIT() asm volatile("s_waitcnt vmcnt(0)" ::: "memory")
__device__ __forceinline__ unsigned f2bf(float f) { unsigned u = __builtin_bit_cast(unsigned, f); return (u + 0x7fffu + ((u >> 16) & 1u)) >> 16; }
__device__ __forceinline__ unsigned pk2(float lo, float hi) { return f2bf(lo) | (f2bf(hi) << 16); }
__device__ __forceinline__ float bflo(unsigned w) { return __uint_as_float(w << 16); }
__device__ __forceinline__ float bfhi(unsigned w) { return __uint_as_float(w & 0xffff0000u); }
__device__ __forceinline__ float bf2f(bf16 h) { return __uint_as_float((unsigned)h << 16); }
__device__ __forceinline__ float wave_sum(float v) {
#pragma unroll
    for (int o = 1; o < 64; o <<= 1) v += __shfl_xor(v, o);
    return v;
}
__device__ __forceinline__ float sigm(float x) { return 1.0f / (1.0f + expf(-x)); }
__device__ __forceinline__ float softplusf_(float x) { return fmaxf(x, 0.f) + log1pf(expf(-fabsf(x))); }
__device__ __forceinline__ float gelu_tanh(float x) { return 0.5f * x * (1.0f + tanhf(0.7978845608028654f * (x + 0.044715f * x * x * x))); }

struct Args { const float* in[N_IN]; float* out; unsigned char* ws; int ph_lo, ph_hi; };
#define CAS __attribute__((address_space(4)))
__device__ __forceinline__ const float* kin(int i) { asm volatile("" : "+s"(i)); const CAS char* kp = (const CAS char*)__builtin_amdgcn_kernarg_segment_ptr(); return *(const float* const CAS*)(kp + 8 * i); }
__device__ __forceinline__ float* kout() { int i = N_IN; asm volatile("" : "+s"(i)); const CAS char* kp = (const CAS char*)__builtin_amdgcn_kernarg_segment_ptr(); return *(float* const CAS*)(kp + 8 * i); }
__device__ __forceinline__ unsigned char* kws() { int i = N_IN + 1; asm volatile("" : "+s"(i)); const CAS char* kp = (const CAS char*)__builtin_amdgcn_kernarg_segment_ptr(); return *(unsigned char* const CAS*)(kp + 8 * i); }

struct Frame {
    LAS unsigned char* lds;
    unsigned char* ws;
    unsigned* ctl;
    int tid, lane, wave, G, bid;
};

__device__ __forceinline__ void transpose_item(const float* W, int K, int N, bf16* WT, int drow0, LAS float* scr, int k0, int n0, int lane) {
    const int nn = n0 + (lane & 31); const bool ok = nn < N;
#pragma unroll 8
    for (int i = 0; i < 32; ++i) { const int kk = 2 * i + (lane >> 5); scr[kk * 33 + (lane & 31)] = ok ? W[(size_t)(k0 + kk) * N + nn] : 0.f; }
    LDS_WAIT(); asm volatile("" ::: "memory");
    const int c = lane & 7;
#pragma unroll
    for (int j = 0; j < 4; ++j) { const int n = (lane >> 3) + 8 * j; const LAS float* s = scr + (8 * c) * 33 + n;
        v4u o; o.x = pk2(s[0 * 33], s[1 * 33]); o.y = pk2(s[2 * 33], s[3 * 33]); o.z = pk2(s[4 * 33], s[5 * 33]); o.w = pk2(s[6 * 33], s[7 * 33]);
        *(v4u*)(WT + (size_t)(drow0 + n) * K + k0 + 8 * c) = o; }
    LDS_WAIT(); asm volatile("" ::: "memory");
}
__device__ __forceinline__ void transpose_set(Frame& F, const float* W, int nmat, int K, int N, int NP, bf16* WT, int& itbase) {
    LAS float* scr = (LAS float*)(F.lds + RING_OFF + F.wave * 16384);
    const int gw = F.bid * NWAVES + F.wave, NGW = F.G * NWAVES;
    const int nkb = K / 64, nnb = NP / 32, per = nkb * nnb, total = nmat * per;
    int first = (gw - (itbase % NGW) + NGW) % NGW;
    for (int it = first; it < total; it += NGW) { const int mi = it / per, r = it % per, kb = r / nnb, nb = r % nnb;
        transpose_item(W + (size_t)mi * K * N, K, N, WT + (size_t)mi * NP * K, nb * 32, scr, kb * 64, nb * 32, F.lane); }
    itbase += total;
}
__device__ __forceinline__ void prologue_weights(Frame& F) {
 int itb = 0;
    transpose_set(F, kin(I_EV_W_IN), 2, 1024, EVEN_IN, EVEN_INP, (bf16*)(F.ws + WS_W_EVIN), itb);
    transpose_set(F, kin(I_OD_W_IN), 2, 1024, ODD_IN, ODD_INP, (bf16*)(F.ws + WS_W_ODIN), itb);
    transpose_set(F, kin(I_MLA_WQUP), 2, 384, 768, 768, (bf16*)(F.ws + WS_W_QUP), itb);
    transpose_set(F, kin(I_MLA_WKVUP), 2, 256, 1024, 1024, (bf16*)(F.ws + WS_W_KVUP), itb);
    transpose_set(F, kin(I_EV_W_OUT), 2, 1024, 1024, 1024, (bf16*)(F.ws + WS_W_EVOUT), itb);
    transpose_set(F, kin(I_OD_W_OUT), 2, 1024, 1024, 1024, (bf16*)(F.ws + WS_W_ODOUT), itb);
    transpose_set(F, kin(I_S5_WGLU), 2, 512, 512, 512, (bf16*)(F.ws + WS_W_GLU), itb);
    transpose_set(F, kin(I_PLE_WP), 4, 256, 1024, 1024, (bf16*)(F.ws + WS_W_PLEP), itb);
    transpose_set(F, kin(I_PLE_WG), 4, 1024, 1024, 1024, (bf16*)(F.ws + WS_W_PLEG), itb);
}
__device__ __forceinline__ void moe_weights(Frame& F, int layer) {

    LAS float* scr = (LAS float*)(F.lds + RING_OFF + F.wave * 16384);
    const int gw = F.bid * NWAVES + F.wave, NGW = F.G * NWAVES;
    const float* wg = kin(I_MOE_WG) + (size_t)layer * 32 * 1024 * 512; const float* wu = kin(I_MOE_WU) + (size_t)layer * 32 * 1024 * 512; const float* wd = kin(I_MOE_WD) + (size_t)layer * 32 * 512 * 1024;
    bf16* WGU = (bf16*)(F.ws + WS_W_MOEGU); bf16* WD = (bf16*)(F.ws + WS_W_MOED);
    for (int it = gw; it < 2 * 32 * 256; it += NGW) { const int which = it / (32 * 256), r0 = it % (32 * 256), e = r0 / 256, r = r0 % 256, kb = r / 16, nb = r % 16, n0 = nb * 32;
        const int drow = 256 * (n0 / 128) + (n0 % 128) + which * 128;
        transpose_item((which ? wu : wg) + (size_t)e * 1024 * 512, 1024, 512, WGU + (size_t)e * 1024 * 1024, drow, scr, kb * 64, n0, F.lane); }
    for (int it = gw; it < 32 * 256; it += NGW) { const int e = it / 256, r = it % 256, kb = r / 32, nb = r % 32;
        transpose_item(wd + (size_t)e * 512 * 1024, 512, 1024, WD + (size_t)e * 1024 * 512, nb * 32, scr, kb * 64, nb * 32, F.lane); }
}

__device__ __forceinline__ void rms_row_to_bf16(const float* xrow, const float* gain, bf16* orow, float* copy, int lane) {
    const f32x4* xr = (const f32x4*)xrow + lane; f32x4 v[4]; float s = 0.f;
#pragma unroll
    for (int j = 0; j < 4; ++j) { v[j] = xr[64 * j]; s += (v[j].x * v[j].x + v[j].y * v[j].y) + (v[j].z * v[j].z + v[j].w * v[j].w); }
    const float r = 1.0f / sqrtf(wave_sum(s) * (1.f / 1024.f) + RMS_EPS);
    if (copy) {
#pragma unroll
        for (int j = 0; j < 4; ++j) ((f32x4*)copy + lane)[64 * j] = v[j]; }
    unsigned long long* o8 = (unsigned long long*)orow + lane;
#pragma unroll
    for (int j = 0; j < 4; ++j) { const f32x4 g = ((const f32x4*)gain + lane)[64 * j];
        o8[64 * j] = (unsigned long long)pk2(v[j].x * r * g.x, v[j].y * r * g.y) | ((unsigned long long)pk2(v[j].z * r * g.z, v[j].w * r * g.w) << 32); }
}
__device__ __forceinline__ void phase_norm(Frame& F, const float* src, const float* gain, float* copy) {
    bf16* ABF = (bf16*)(F.ws + WS_ABF);
    const int gw = F.bid * NWAVES + F.wave, NGW = F.G * NWAVES;
    for (int m = gw; m < NTOK; m += NGW) rms_row_to_bf16(src + (size_t)m * DM, gain, ABF + (size_t)m * DM, copy ? copy + (size_t)m * DM : nullptr, F.lane);
}
__device__ __forceinline__ void phase_pconv(Frame& F, int layer) {
    const float* p = kin(I_P) + (size_t)layer * NTOK * PLE; bf16* PBF = (bf16*)(F.ws + WS_PBF);
    const size_t n4 = (size_t)NTOK * PLE / 4; const size_t gt = (size_t)F.bid * 512 + F.tid, NT = (size_t)F.G * 512;
    for (size_t i = gt; i < n4; i += NT) { const f32x4 v = ((const f32x4*)p)[i]; v2u o; o.x = pk2(v.x, v.y); o.y = pk2(v.z, v.w); ((v2u*)PBF)[i] = o; }
}

__device__ __forceinline__ void phase_even_post(Frame& F, int j, bool dry = false) {

    bf16* PROJ = (bf16*)(F.ws + WS_PROJ); bf16* CQN = (bf16*)(F.ws + WS_CQN); bf16* CKVN = (bf16*)(F.ws + WS_CKVN); float* LOGF = (float*)(F.ws + WS_LOGF);
    const float* qn = kin(I_FOX_QN) + j * 64; const float* kn = kin(I_FOX_KN) + j * 64; const float* bfv = kin(I_FOX_BF) + j * 8;
    const float* qan = kin(I_MLA_QAN) + j * 384; const float* kvan = kin(I_MLA_KVAN) + j * 256;
    const int gw = F.bid * NWAVES + F.wave, NGW = F.G * NWAVES, lane = F.lane;
    for (int m = gw; m < NTOK; m += NGW) {
        bf16* row = PROJ + (size_t)m * EVEN_INP;
#pragma unroll
        for (int w = 0; w < 2; ++w) {
            v4u* p = (v4u*)(row + (w ? E_FK : E_FQ)) + lane; const v4u x = *p;
            float f[8] = {bflo(x.x), bfhi(x.x), bflo(x.y), bfhi(x.y), bflo(x.z), bfhi(x.z), bflo(x.w), bfhi(x.w)};
            float s = 0.f;
#pragma unroll
            for (int i = 0; i < 8; ++i) s += f[i] * f[i];
            s += __shfl_xor(s, 1); s += __shfl_xor(s, 2); s += __shfl_xor(s, 4);
            const float r = (1.0f / sqrtf(s * (1.f / 64.f) + RMS_EPS)) * (w ? 1.0f : C2_FOX); const float* g = (w ? kn : qn) + (lane & 7) * 8;
            v4u o; o.x = pk2(f[0] * r * g[0], f[1] * r * g[1]); o.y = pk2(f[2] * r * g[2], f[3] * r * g[3]); o.z = pk2(f[4] * r * g[4], f[5] * r * g[5]); o.w = pk2(f[6] * r * g[6], f[7] * r * g[7]);
            *(dry ? (v4u*)(F.ws + WS_DUMMY) + (size_t)m * 128 + w * 64 + lane : p) = o;
        }
        if (lane < 8) { const float z = bf2f(row[E_FLOG + lane]) + bfv[lane]; LOGF[(size_t)m * 8 + lane] = -softplusf_(-z); }
        {
            float f[6]; float s = 0.f;
#pragma unroll
            for (int i = 0; i < 3; ++i) { const unsigned x = *((const unsigned*)(row + E_CQ) + lane + 64 * i); f[2 * i] = bflo(x); f[2 * i + 1] = bfhi(x); s += f[2 * i] * f[2 * i] + f[2 * i + 1] * f[2 * i + 1]; }
            const float r = 1.0f / sqrtf(wave_sum(s) * (1.f / 384.f) + RMS_EPS);
#pragma unroll
            for (int i = 0; i < 3; ++i) { const int c = 2 * (lane + 64 * i); *((unsigned*)(CQN + (size_t)m * 384) + lane + 64 * i) = pk2(f[2 * i] * r * qan[c], f[2 * i + 1] * r * qan[c + 1]); }
        }
        {
            float f[4]; float s = 0.f;
#pragma unroll
            for (int i = 0; i < 2; ++i) { const unsigned x = *((const unsigned*)(row + E_CKV) + lane + 64 * i); f[2 * i] = bflo(x); f[2 * i + 1] = bfhi(x); s += f[2 * i] * f[2 * i] + f[2 * i + 1] * f[2 * i + 1]; }
            const float r = 1.0f / sqrtf(wave_sum(s) * (1.f / 256.f) + RMS_EPS);
#pragma unroll
            for (int i = 0; i < 2; ++i) { const int c = 2 * (lane + 64 * i); *((unsigned*)(CKVN + (size_t)m * 256) + lane + 64 * i) = pk2(f[2 * i] * r * kvan[c], f[2 * i + 1] * r * kvan[c + 1]); }
        }
    }
}
__device__ __forceinline__ void phase_cumsum(Frame& F) {
    if (F.bid >= 16) return;
    const float* LOGF = (const float*)(F.ws + WS_LOGF); float* CUM = (float*)(F.ws + WS_CUM);
    const int b = F.bid >> 3, h = F.bid & 7, t0 = F.tid * 32;
    LAS double* part = (LAS double*)(F.lds + RING_OFF);
    float v[32]; double s = 0.0;
#pragma unroll
    for (int i = 0; i < 32; ++i) { v[i] = LOGF[((size_t)b * SEQ + t0 + i) * 8 + h]; s += (double)v[i]; }
    part[F.tid] = s; __syncthreads();
    if (F.tid == 0) { double run = 0.0; for (int i = 0; i < 512; ++i) { const double x = part[i]; part[i] = run; run += x; } }
    __syncthreads();
    double run = part[F.tid];
#pragma unroll
    for (int i = 0; i < 32; ++i) { run += (double)v[i]; CUM[((size_t)b * SEQ + t0 + i) * 8 + h] = (float)run; }
    __syncthreads();
}
__device__ __forceinline__ void phase_mla_post(Frame& F, int j, bool dry = false) {

    const bf16* PROJ = (const bf16*)(F.ws + WS_PROJ); bf16* QM = (bf16*)(F.ws + WS_QM); const bf16* KVB = (const bf16*)(F.ws + WS_KVB); bf16* KM = (bf16*)(F.ws + WS_KM);
    const float* qn = kin(I_MLA_QN) + j * 96; const float* kn = kin(I_MLA_KN) + j * 96; const int* pos = (const int*)kin(I_POS);
    const int gw = F.bid * NWAVES + F.wave, NGW = F.G * NWAVES, lane = F.lane, l32 = lane & 31, hh = lane >> 5;
    const int fi = l32 & 15; const float inv = expf(-(float)fi * (1.0f / 16.0f) * 9.210340371976184f);
    for (int m = gw; m < NTOK; m += NGW) {
        const float ang = (float)pos[m] * inv; float sn, cs; sincosf(ang, &sn, &cs);
        const float krope = bf2f(PROJ[(size_t)m * EVEN_INP + E_KROPE + l32]);
#pragma unroll
        for (int hp = 0; hp < 4; ++hp) { const int h = hp * 2 + hh;
#pragma unroll
            for (int w = 0; w < 2; ++w) {
                float f[3];
                if (w == 0) { const bf16* q = QM + (size_t)m * 768 + h * 96; f[0] = bf2f(q[l32]); f[1] = bf2f(q[l32 + 32]); f[2] = bf2f(q[l32 + 64]); }
                else { const bf16* k = KVB + (size_t)m * 1024 + h * 128; f[0] = bf2f(k[l32]); f[1] = bf2f(k[l32 + 32]); f[2] = krope; }
                float s = f[0] * f[0] + f[1] * f[1] + f[2] * f[2];
                s += __shfl_xor(s, 1); s += __shfl_xor(s, 2); s += __shfl_xor(s, 4); s += __shfl_xor(s, 8); s += __shfl_xor(s, 16);
                const float r = 1.0f / sqrtf(s * (1.f / 96.f) + RMS_EPS); const float* g = w ? kn : qn;
                f[0] *= r * g[l32]; f[1] *= r * g[l32 + 32]; f[2] *= r * g[l32 + 64];
                const float other = __shfl_xor(f[2], 16);
                const float rot = (l32 < 16) ? (f[2] * cs - other * sn) : (other * sn + f[2] * cs);
                bf16* o = (w ? KM : (dry ? (bf16*)(F.ws + WS_DUMMY) : QM)) + (size_t)m * 768 + h * 96; const float qs = w ? 1.0f : C2_MLA;
                o[l32] = (bf16)f2bf(f[0] * qs); o[l32 + 32] = (bf16)f2bf(f[1] * qs); o[l32 + 64] = (bf16)f2bf(rot * qs);
            }
        }
    }
}
template <int DK> __device__ __forceinline__ void attn_naive_unit(Frame& F, const bf16* Qp, int qld, const bf16* Kp, int kld, const bf16* Vp, int vld, const float* cum  , float scale, bf16* Op, int qb) {
    LAS float* Ks = (LAS float*)(F.lds + RING_OFF); LAS float* Vs = Ks + 64 * DK; LAS float* Cs = Vs + 64 * 64;
    const int t = qb * 512 + F.wave * 64 + F.lane; const int tmax_w = qb * 512 + F.wave * 64 + 63;
    float q[DK];
#pragma unroll
    for (int d = 0; d < DK; d += 8) { const v4u x = *(const v4u*)(Qp + (size_t)t * qld + d);
        q[d] = bflo(x.x) * scale; q[d + 1] = bfhi(x.x) * scale; q[d + 2] = bflo(x.y) * scale; q[d + 3] = bfhi(x.y) * scale; q[d + 4] = bflo(x.z) * scale; q[d + 5] = bfhi(x.z) * scale; q[d + 6] = bflo(x.w) * scale; q[d + 7] = bfhi(x.w) * scale; }
    const float cq = cum ? cum[(size_t)t * 8] : 0.f;
    float acc[64];
#pragma unroll
    for (int d = 0; d < 64; ++d) acc[d] = 0.f;
    float mx = -1e30f, l = 0.f;
    const int nkb = (qb * 512 + 512) / 64;
    for (int kb = 0; kb < nkb; ++kb) {
        __syncthreads();
        for (int i = F.tid; i < 64 * DK / 8; i += 512) { const int key = i / (DK / 8), c = (i % (DK / 8)) * 8; const v4u x = *(const v4u*)(Kp + (size_t)(kb * 64 + key) * kld + c);
            LAS float* d = Ks + key * DK + c; d[0] = bflo(x.x); d[1] = bfhi(x.x); d[2] = bflo(x.y); d[3] = bfhi(x.y); d[4] = bflo(x.z); d[5] = bfhi(x.z); d[6] = bflo(x.w); d[7] = bfhi(x.w); }
        { const int i = F.tid; const int key = i / 8, c = (i % 8) * 8; const v4u x = *(const v4u*)(Vp + (size_t)(kb * 64 + key) * vld + c);
            LAS float* d = Vs + key * 64 + c; d[0] = bflo(x.x); d[1] = bfhi(x.x); d[2] = bflo(x.y); d[3] = bfhi(x.y); d[4] = bflo(x.z); d[5] = bfhi(x.z); d[6] = bflo(x.w); d[7] = bfhi(x.w); }
        if (F.tid < 64) Cs[F.tid] = cum ? cum[(size_t)(kb * 64 + F.tid) * 8] : 0.f;
        __syncthreads();
        if (kb * 64 > tmax_w) continue;
        for (int jk = 0; jk < 64; ++jk) {
            const int s = kb * 64 + jk; if (s > tmax_w) break;
            const LAS float* kr = Ks + jk * DK; float dot = 0.f;
#pragma unroll
            for (int d = 0; d < DK; d += 4) { const f32x4 kv = *(const LAS f32x4*)(kr + d); dot += q[d] * kv.x + q[d + 1] * kv.y + q[d + 2] * kv.z + q[d + 3] * kv.w; }
            float logit = dot + (cq - Cs[jk]); if (s > t) logit = -1e30f;
            if (__any(logit > mx)) { const float mn = fmaxf(mx, logit); const float corr = expf(mx - mn); l *= corr;
#pragma unroll
                for (int d = 0; d < 64; ++d) acc[d] *= corr;
                mx = mn; }
            const float p = (s > t) ? 0.f : expf(logit - mx); l += p;
            const LAS float* vr = Vs + jk * 64;
#pragma unroll
            for (int d = 0; d < 64; d += 4) { const f32x4 vv = *(const LAS f32x4*)(vr + d); acc[d] += p * vv.x; acc[d + 1] += p * vv.y; acc[d + 2] += p * vv.z; acc[d + 3] += p * vv.w; }
        }
    }
    const float il = 1.0f / l; bf16* o = Op + (size_t)t * DM;
#pragma unroll
    for (int d = 0; d < 64; d += 8) { v4u w; w.x = pk2(acc[d] * il, acc[d + 1] * il); w.y = pk2(acc[d + 2] * il, acc[d + 3] * il); w.z = pk2(acc[d + 4] * il, acc[d + 5] * il); w.w = pk2(acc[d + 6] * il, acc[d + 7] * il); *(v4u*)(o + d) = w; }
}
__device__ __forceinline__ void phase_attn_naive(Frame& F) {
    const bf16* PROJ = (const bf16*)(F.ws + WS_PROJ); const bf16* QM = (const bf16*)(F.ws + WS_QM); const bf16* KVB = (const bf16*)(F.ws + WS_KVB); const bf16* KM = (const bf16*)(F.ws + WS_KM);
    const float* CUM = (const float*)(F.ws + WS_CUM); bf16* MIX = (bf16*)(F.ws + WS_MIX);
    for (int p = F.bid; p < 512; p += F.G) {
        const int combo = p >> 4, qq = p & 15; const int type = combo >> 4, b = (combo >> 3) & 1, h = combo & 7;
#pragma unroll 1
        for (int half = 0; half < 2; ++half) { const int qb = half ? 31 - qq : qq; const size_t rb = (size_t)b * SEQ;
            if (type == 0) attn_naive_unit<64>(F, PROJ + rb * EVEN_INP + E_FQ + h * 64, EVEN_INP, PROJ + rb * EVEN_INP + E_FK + h * 64, EVEN_INP, PROJ + rb * EVEN_INP + E_FV + h * 64, EVEN_INP, CUM + rb * 8 + h, LN2, MIX + rb * DM + h * 64, qb);
            else attn_naive_unit<96>(F, QM + rb * 768 + h * 96, 768, KM + rb * 768 + h * 96, 768, KVB + rb * 1024 + h * 128 + 64, 1024, nullptr, LN2, MIX + rb * DM + 512 + h * 64, qb);
        }
    }
    __syncthreads();
}

__device__ __forceinline__ void s5_scan_wave(Frame& F, int j, int b, int g) {
 const int p = F.lane;
    const bf16* PROJ = (const bf16*)(F.ws + WS_PROJ); bf16* HG = (bf16*)(F.ws + WS_HG);
    const float lr = fminf(kin(I_S5_ARE)[(j * 32 + g) * 64 + p], -1e-4f), li = kin(I_S5_AIM)[(j * 32 + g) * 64 + p];
    const float dt = expf(kin(I_S5_LS)[j * 32 + g]);
    const float mag = expf(lr * dt); const float abr = mag * cosf(li * dt), abi = mag * sinf(li * dt);
    const float den = lr * lr + li * li, nr = abr - 1.0f, ni = abi;
    const float gr = (nr * lr + ni * li) / den, gi = (ni * lr - nr * li) / den;
    float bbr[16], bbi[16], cr[16], ci[16], dsk[16];
#pragma unroll
    for (int c = 0; c < 16; ++c) { const float br = kin(I_S5_BRE)[((size_t)(j * 32 + g) * 64 + p) * 16 + c], bi = kin(I_S5_BIM)[((size_t)(j * 32 + g) * 64 + p) * 16 + c];
        bbr[c] = gr * br - gi * bi; bbi[c] = gr * bi + gi * br;
        cr[c] = kin(I_S5_CRE)[((size_t)(j * 32 + g) * 16 + c) * 64 + p]; ci[c] = kin(I_S5_CIM)[((size_t)(j * 32 + g) * 16 + c) * 64 + p];
        dsk[c] = kin(I_S5_D)[j * 512 + g * 16 + c]; }
    float xr = 0.f, xi = 0.f;
    const bf16* up = PROJ + (size_t)b * SEQ * ODD_INP + O_U + g * 16;
    v4u cur0[4], cur1[4], nx0[4], nx1[4];
#pragma unroll
    for (int i = 0; i < 4; ++i) { cur0[i] = *(const v4u*)(up + (size_t)i * ODD_INP); cur1[i] = *(const v4u*)(up + (size_t)i * ODD_INP + 8); }
    for (int t0 = 0; t0 < SEQ; t0 += 4) {
        const int tn = (t0 + 4 < SEQ) ? t0 + 4 : t0;
#pragma unroll
        for (int i = 0; i < 4; ++i) { nx0[i] = *(const v4u*)(up + (size_t)(tn + i) * ODD_INP); nx1[i] = *(const v4u*)(up + (size_t)(tn + i) * ODD_INP + 8); }
#pragma unroll
        for (int i = 0; i < 4; ++i) {
            float u[16] = {bflo(cur0[i].x), bfhi(cur0[i].x), bflo(cur0[i].y), bfhi(cur0[i].y), bflo(cur0[i].z), bfhi(cur0[i].z), bflo(cur0[i].w), bfhi(cur0[i].w),
                           bflo(cur1[i].x), bfhi(cur1[i].x), bflo(cur1[i].y), bfhi(cur1[i].y), bflo(cur1[i].z), bfhi(cur1[i].z), bflo(cur1[i].w), bfhi(cur1[i].w)};
            float bur = 0.f, bui = 0.f;
#pragma unroll
            for (int c = 0; c < 16; ++c) { bur += bbr[c] * u[c]; bui += bbi[c] * u[c]; }
            const float nxr = abr * xr - abi * xi + bur, nxi = abr * xi + abi * xr + bui; xr = nxr; xi = nxi;
            float y[16];
#pragma unroll
            for (int c = 0; c < 16; ++c) y[c] = wave_sum(cr[c] * xr - ci[c] * xi);
            if (p < 16) { float yy = 0.f, uu = 0.f, dd = 0.f;
#pragma unroll
                for (int c = 0; c < 16; ++c) if (p == c) { yy = y[c]; uu = u[c]; dd = dsk[c]; }
                HG[((size_t)b * SEQ + t0 + i) * 512 + g * 16 + p] = (bf16)f2bf(gelu_tanh(yy + dd * uu)); }
        }
#pragma unroll
        for (int i = 0; i < 4; ++i) { cur0[i] = nx0[i]; cur1[i] = nx1[i]; }
    }
}
__device__ __forceinline__ void gdn_prep_token(Frame& F, int j, int m) {
 const int lane = F.lane;
    const bf16* PROJ = (const bf16*)(F.ws + WS_PROJ); float* QG = (float*)(F.ws + WS_QG); float* KG = (float*)(F.ws + WS_KG); float* VG = (float*)(F.ws + WS_VG);
    float* GB = (float*)(F.ws + WS_GB); float* BETA = (float*)(F.ws + WS_BETA);
    const float* cw = kin(I_GDN_CONV) + (size_t)j * 4 * 1536;
    const int s = m % SEQ;
#pragma unroll
    for (int w = 0; w < 3; ++w) {
        const int ch0 = w * 512 + lane * 8; float acc[8];
#pragma unroll
        for (int i = 0; i < 8; ++i) acc[i] = 0.f;
#pragma unroll
        for (int tap = 0; tap < 4; ++tap) { const int ss = s - 3 + tap; if (ss < 0) continue;
            const v4u x = *(const v4u*)(PROJ + (size_t)(m - 3 + tap) * ODD_INP + O_Q + ch0); const float* wv = cw + tap * 1536 + ch0;
            acc[0] += wv[0] * bflo(x.x); acc[1] += wv[1] * bfhi(x.x); acc[2] += wv[2] * bflo(x.y); acc[3] += wv[3] * bfhi(x.y); acc[4] += wv[4] * bflo(x.z); acc[5] += wv[5] * bfhi(x.z); acc[6] += wv[6] * bflo(x.w); acc[7] += wv[7] * bfhi(x.w); }
        float ss2 = 0.f;
#pragma unroll
        for (int i = 0; i < 8; ++i) { acc[i] = acc[i] * sigm(acc[i]); ss2 += acc[i] * acc[i]; }
        float sc = 1.0f;
        if (w < 2) { ss2 += __shfl_xor(ss2, 1); ss2 += __shfl_xor(ss2, 2); ss2 += __shfl_xor(ss2, 4); ss2 += __shfl_xor(ss2, 8); sc = 1.0f / sqrtf(ss2 + RMS_EPS); if (w == 0) sc *= 0.08838834764831845f; }
        float* dst = (w == 0 ? QG : (w == 1 ? KG : VG)) + (size_t)m * 512 + lane * 8;
        *(f32x4*)dst = (f32x4){acc[0] * sc, acc[1] * sc, acc[2] * sc, acc[3] * sc}; *(f32x4*)(dst + 4) = (f32x4){acc[4] * sc, acc[5] * sc, acc[6] * sc, acc[7] * sc};
    }
    if (lane < 4) { const float gin = bf2f(PROJ[(size_t)m * ODD_INP + O_GIN + lane]), bin = bf2f(PROJ[(size_t)m * ODD_INP + O_BETA + lane]);
        GB[(size_t)m * 4 + lane] = -expf(kin(I_GDN_ALOG)[j * 4 + lane]) * softplusf_(gin + kin(I_GDN_DTB)[j * 4 + lane]); BETA[(size_t)m * 4 + lane] = sigm(bin); }
}
__device__ __forceinline__ void phase_gdn_prep(Frame& F, int j) {
    const int gw = F.bid * NWAVES + F.wave, NGW = F.G * NWAVES;
    for (int m = gw; m < NTOK; m += NGW) gdn_prep_token(F, j, m);
}
__device__ __forceinline__ void phase_odd_a(Frame& F, int j) {
    if (F.wave == 0 && F.bid < 64) { s5_scan_wave(F, j, F.bid >> 5, F.bid & 31); return; }
    const int nbusy = (F.G < 64 ? F.G : 64);
    const int widx = (F.bid < 64) ? F.bid * 7 + (F.wave - 1) : nbusy * 7 + (F.bid - 64) * 8 + F.wave;
    const int nw = nbusy * 7 + (F.G > 64 ? (F.G - 64) * 8 : 0);
    for (int m = widx; m < NTOK; m += nw) gdn_prep_token(F, j, m);
}
__device__ __forceinline__ void phase_gdn_naive(Frame& F) {
    const float* QG = (const float*)(F.ws + WS_QG); const float* KG = (const float*)(F.ws + WS_KG); const float* VG = (const float*)(F.ws + WS_VG);
    const float* GB = (const float*)(F.ws + WS_GB); const float* BETA = (const float*)(F.ws + WS_BETA); float* OG = (float*)(F.ws + WS_OG);
    const int lane = F.lane; const int NGW = F.G * NWAVES;
    for (int u = F.wave * F.G + F.bid; u < 1024; u += NGW) {
        const int b = u >> 9, h = (u >> 7) & 3, c = u & 127; const size_t rb = (size_t)b * SEQ;
        const float* kq = KG + rb * 512 + h * 128 + lane; const float* qq = QG + rb * 512 + h * 128 + lane; const float* vq = VG + rb * 512 + h * 128 + c;
        const float* gq = GB + rb * 4 + h; const float* bq = BETA + rb * 4 + h; float* oq = OG + rb * 512 + h * 128 + c;
        float s0 = 0.f, s1 = 0.f;
        float k0[8], k1[8], q0[8], q1[8], vv[8], gg[8], bb[8], nk0[8], nk1[8], nq0[8], nq1[8], nv[8], ng[8], nb[8];
#pragma unroll
        for (int i = 0; i < 8; ++i) { k0[i] = kq[(size_t)i * 512]; k1[i] = kq[(size_t)i * 512 + 64]; q0[i] = qq[(size_t)i * 512]; q1[i] = qq[(size_t)i * 512 + 64]; vv[i] = vq[(size_t)i * 512]; gg[i] = gq[i * 4]; bb[i] = bq[i * 4]; }
        for (int t0 = 0; t0 < SEQ; t0 += 8) {
            const int tn = (t0 + 8 < SEQ) ? t0 + 8 : t0;
#pragma unroll
            for (int i = 0; i < 8; ++i) { const size_t o = (size_t)(tn + i) * 512; nk0[i] = kq[o]; nk1[i] = kq[o + 64]; nq0[i] = qq[o]; nq1[i] = qq[o + 64]; nv[i] = vq[o]; ng[i] = gq[(tn + i) * 4]; nb[i] = bq[(tn + i) * 4]; }
#pragma unroll
            for (int i = 0; i < 8; ++i) {
                const float ks = wave_sum(k0[i] * s0 + k1[i] * s1); const float eg = expf(gg[i]); const float be = bb[i];
                s0 = eg * (s0 - be * k0[i] * ks) + be * k0[i] * vv[i]; s1 = eg * (s1 - be * k1[i] * ks) + be * k1[i] * vv[i];
                const float o = wave_sum(q0[i] * s0 + q1[i] * s1);
                if (lane == 0) oq[(size_t)(t0 + i) * 512] = o;
            }
#pragma unroll
            for (int i = 0; i < 8; ++i) { k0[i] = nk0[i]; k1[i] = nk1[i]; q0[i] = nq0[i]; q1[i] = nq1[i]; vv[i] = nv[i]; gg[i] = ng[i]; bb[i] = nb[i]; }
        }
    }
}
__device__ __forceinline__ void phase_gdn_out(Frame& F, int j) {
 const float* OG = (const float*)(F.ws + WS_OG); const bf16* PROJ = (const bf16*)(F.ws + WS_PROJ); bf16* MIX = (bf16*)(F.ws + WS_MIX);
    const float* on = kin(I_GDN_ONORM) + j * 128; const int lane = F.lane;
    const int gw = F.bid * NWAVES + F.wave, NGW = F.G * NWAVES;
    for (int m = gw; m < NTOK; m += NGW) {
        const f32x4 a = *(const f32x4*)(OG + (size_t)m * 512 + lane * 8), b = *(const f32x4*)(OG + (size_t)m * 512 + lane * 8 + 4);
        float f[8] = {a.x, a.y, a.z, a.w, b.x, b.y, b.z, b.w}; float s = 0.f;
#pragma unroll
        for (int i = 0; i < 8; ++i) s += f[i] * f[i];
        s += __shfl_xor(s, 1); s += __shfl_xor(s, 2); s += __shfl_xor(s, 4); s += __shfl_xor(s, 8);
        const float r = 1.0f / sqrtf(s * (1.f / 128.f) + RMS_EPS);
        const bf16* z = PROJ + (size_t)m * ODD_INP + O_Z + lane * 8; const float* g = on + (lane & 15) * 8; float o[8];
#pragma unroll
        for (int i = 0; i < 8; ++i) { const float zz = bf2f(z[i]); o[i] = f[i] * r * g[i] * (zz * sigm(zz)); }
        v4u w; w.x = pk2(o[0], o[1]); w.y = pk2(o[2], o[3]); w.z = pk2(o[4], o[5]); w.w = pk2(o[6], o[7]);
        *(v4u*)(MIX + (size_t)m * DM + 512 + lane * 8) = w;
    }
}

__device__ __forceinline__ void phase_router(Frame& F, int layer, bool dry = false) {
 const float* H = kout(); bf16* ABF = (bf16*)(F.ws + WS_ABF);
    const float* gain = kin(I_NORM_FFN) + layer * DM; const float* wgr = kin(I_MOE_WGRP) + (size_t)layer * DM * 4; const float* bgr = kin(I_MOE_BGRP) + layer * 4;
    const float* wex = kin(I_MOE_WEXP) + (size_t)layer * DM * 32; const float* bex = kin(I_MOE_BEXP) + layer * 32;
    int* TOKE = (int*)(F.ws + WS_TOKE); float* TOKW = (float*)(F.ws + WS_TOKW);
    LAS int* lcnt = (LAS int*)(F.lds + LDSCTL_OFF + LC_MOE + 512); LAS int* gbase = (LAS int*)(F.lds + LDSCTL_OFF + LC_MOE + 640);
    const int lane = F.lane; const int per = NTOK / F.G;
    LAS int* lasg = (LAS int*)(F.lds + RING_OFF);
    if (F.tid < 32) lcnt[F.tid] = 0;
    __syncthreads();
    for (int tl = F.wave; tl < per; tl += NWAVES) {
        const int m = F.bid * per + tl;
        const f32x4* xr = (const f32x4*)(H + (size_t)m * DM) + lane; f32x4 v[4]; float s = 0.f;
#pragma unroll
        for (int q = 0; q < 4; ++q) { v[q] = xr[64 * q]; s += (v[q].x * v[q].x + v[q].y * v[q].y) + (v[q].z * v[q].z + v[q].w * v[q].w); }
        const float r = 1.0f / sqrtf(wave_sum(s) * (1.f / 1024.f) + RMS_EPS);
        unsigned long long* o8 = (unsigned long long*)(ABF + (size_t)m * DM) + lane;
#pragma unroll
        for (int q = 0; q < 4; ++q) { const f32x4 g = ((const f32x4*)gain + lane)[64 * q]; v[q].x *= r * g.x; v[q].y *= r * g.y; v[q].z *= r * g.z; v[q].w *= r * g.w;
            o8[64 * q] = (unsigned long long)pk2(v[q].x, v[q].y) | ((unsigned long long)pk2(v[q].z, v[q].w) << 32); }
        float lg[4] = {0.f, 0.f, 0.f, 0.f};
#pragma unroll
        for (int q = 0; q < 4; ++q) { const int k0 = 4 * lane + 256 * q;
#pragma unroll
            for (int e = 0; e < 4; ++e) { const f32x4 w = *(const f32x4*)(wgr + (size_t)(k0 + e) * 4); const float x = v[q][e]; lg[0] += x * w.x; lg[1] += x * w.y; lg[2] += x * w.z; lg[3] += x * w.w; } }
#pragma unroll
        for (int g = 0; g < 4; ++g) lg[g] = wave_sum(lg[g]) + bgr[g];
        int gi = 0; float gm = lg[0];
#pragma unroll
        for (int g = 1; g < 4; ++g) if (lg[g] > gm) { gm = lg[g]; gi = g; }
        float gden = 0.f;
#pragma unroll
        for (int g = 0; g < 4; ++g) gden += expf(lg[g] - gm);
        const float gw_ = 1.0f / gden;
        float le[8] = {0.f, 0.f, 0.f, 0.f, 0.f, 0.f, 0.f, 0.f};
#pragma unroll
        for (int q = 0; q < 4; ++q) { const int k0 = 4 * lane + 256 * q;
#pragma unroll
            for (int e = 0; e < 4; ++e) { const float* wp = wex + (size_t)(k0 + e) * 32 + gi * 8; const f32x4 w0 = *(const f32x4*)wp, w1 = *(const f32x4*)(wp + 4); const float x = v[q][e];
                le[0] += x * w0.x; le[1] += x * w0.y; le[2] += x * w0.z; le[3] += x * w0.w; le[4] += x * w1.x; le[5] += x * w1.y; le[6] += x * w1.z; le[7] += x * w1.w; } }
#pragma unroll
        for (int e = 0; e < 8; ++e) le[e] = wave_sum(le[e]) + bex[gi * 8 + e];
        int i0 = 0; float m0 = le[0];
#pragma unroll
        for (int e = 1; e < 8; ++e) if (le[e] > m0) { m0 = le[e]; i0 = e; }
        int i1 = -1; float m1 = -3.0e38f;
#pragma unroll
        for (int e = 0; e < 8; ++e) if (e != i0 && le[e] > m1) { m1 = le[e]; i1 = e; }
        const float e1 = expf(m1 - m0); const float w0 = gw_ / (1.0f + e1), w1 = gw_ * e1 / (1.0f + e1);
        if (lane == 0 && !dry) { const int ea = gi * 8 + i0, eb = gi * 8 + i1;
            const int pa = __hip_atomic_fetch_add(lcnt + ea, 1, __ATOMIC_RELAXED, __HIP_MEMORY_SCOPE_WORKGROUP), pb = __hip_atomic_fetch_add(lcnt + eb, 1, __ATOMIC_RELAXED, __HIP_MEMORY_SCOPE_WORKGROUP);
            lasg[tl * 2] = ea | (pa << 8); lasg[tl * 2 + 1] = eb | (pb << 8);
            TOKW[(size_t)m * 2] = w0; TOKW[(size_t)m * 2 + 1] = w1; }
    }
    __syncthreads();
    if (dry) return;
    if (F.tid < 32) gbase[F.tid] = (int)__hip_atomic_fetch_add(F.ctl + CW_CNT + 64 * layer + F.tid, (unsigned)lcnt[F.tid], __ATOMIC_RELAXED, __HIP_MEMORY_SCOPE_AGENT);
    __syncthreads();
    for (int i = F.tid; i < per * 2; i += 512) { const int a = lasg[i], e = a & 255, lp = a >> 8; TOKE[(size_t)F.bid * per * 2 + i] = e | ((gbase[e] + lp) << 8); }
    __syncthreads();
}
__device__ __forceinline__ void moe_tables(Frame& F, int layer) {
    LAS int* rowbase = (LAS int*)(F.lds + LDSCTL_OFF + LC_MOE); LAS unsigned char* tile_e = (LAS unsigned char*)(F.lds + LDSCTL_OFF + LC_MOE + 192);
    if (F.tid == 0) { int rb = 0;
#pragma unroll 1
        for (int e = 0; e < 32; ++e) { const int c = (int)__hip_atomic_load(F.ctl + CW_CNT + 64 * layer + e, __ATOMIC_RELAXED, __HIP_MEMORY_SCOPE_AGENT); rowbase[e] = rb; const int nt = (c + 255) >> 8;
            for (int i = 0; i < nt; ++i) tile_e[(rb >> 8) + i] = (unsigned char)e; rb += nt << 8; }
        rowbase[32] = rb; rowbase[34] = rb >> 8; }
    __syncthreads();
}
__device__ __forceinline__ void phase_moe_scatter(Frame& F, int layer) {
    moe_tables(F, layer);
    const LAS int* rowbase = (const LAS int*)(F.lds + LDSCTL_OFF + LC_MOE);
    const bf16* ABF = (const bf16*)(F.ws + WS_ABF); bf16* XG = (bf16*)(F.ws + WS_XG); const int* TOKE = (const int*)(F.ws + WS_TOKE); int* ROWS = (int*)(F.ws + WS_ROWS);
    const int gw = F.bid * NWAVES + F.wave, NGW = F.G * NWAVES, lane = F.lane;
    for (int m = gw; m < NTOK; m += NGW) {
        const v4u a = *((const v4u*)(ABF + (size_t)m * DM) + lane), b = *((const v4u*)(ABF + (size_t)m * DM) + 64 + lane);
#pragma unroll
        for (int k = 0; k < 2; ++k) { const int te = TOKE[(size_t)m * 2 + k]; const int row = rowbase[te & 255] + (te >> 8);
            *((v4u*)(XG + (size_t)row * DM) + lane) = a; *((v4u*)(XG + (size_t)row * DM) + 64 + lane) = b;
            if (lane == 0) ROWS[(size_t)m * 2 + k] = row; }
    }
}
struct MoeOrder {
    int ntiles, nN, G, c; const LAS unsigned char* tile_e; size_t bstride;
    __device__ bool next(int i, pg8::Unit& u) const { const long L = (long)i * G + c; if (L >= (long)ntiles * nN) return false; u.pm = (int)(L / nN); u.pn = (int)(L % nN); u.aux = __builtin_amdgcn_readfirstlane((int)tile_e[u.pm]); return true; }
    __device__ __forceinline__ const char* a_base(const pg8::Gemm& g, const pg8::Unit& u) const { return (const char*)g.A + (size_t)u.pm * 256 * g.lda * 2; }
    __device__ __forceinline__ const char* b_base(const pg8::Gemm& g, const pg8::Unit& u) const { return (const char*)g.Bt + (size_t)u.aux * bstride + (size_t)u.pn * 256 * g.ldb * 2; }
};
__device__ __forceinline__ void phase_moe_combine(Frame& F, int layer, bool dry = false) {
    float* H = kout(); float* Ho = dry ? (float*)(F.ws + WS_DUMMY) : H; bf16* ABF = (bf16*)(F.ws + WS_ABF); const bf16* Y2 = (const bf16*)(F.ws + WS_Y2);
    const int* ROWS = (const int*)(F.ws + WS_ROWS); const float* TOKW = (const float*)(F.ws + WS_TOKW); const float* gain = kin(I_PLE_NORM) + layer * DM;
    const int gw = F.bid * NWAVES + F.wave, NGW = F.G * NWAVES, lane = F.lane;
    for (int m = gw; m < NTOK; m += NGW) {
        const int r0 = ROWS[(size_t)m * 2], r1 = ROWS[(size_t)m * 2 + 1]; const float w0 = TOKW[(size_t)m * 2], w1 = TOKW[(size_t)m * 2 + 1];
        f32x4* hr = (f32x4*)(H + (size_t)m * DM) + lane; f32x4* ho = (f32x4*)(Ho + (size_t)m * DM) + lane; f32x4 v[4]; float s = 0.f;
#pragma unroll
        for (int q = 0; q < 4; ++q) { v[q] = hr[64 * q]; const v2u ya = *((const v2u*)(Y2 + (size_t)r0 * DM) + lane + 64 * q), yb = *((const v2u*)(Y2 + (size_t)r1 * DM) + lane + 64 * q);
            v[q].x += w0 * bflo(ya.x) + w1 * bflo(yb.x); v[q].y += w0 * bfhi(ya.x) + w1 * bfhi(yb.x); v[q].z += w0 * bflo(ya.y) + w1 * bflo(yb.y); v[q].w += w0 * bfhi(ya.y) + w1 * bfhi(yb.y);
            ho[64 * q] = v[q]; s += (v[q].x * v[q].x + v[q].y * v[q].y) + (v[q].z * v[q].z + v[q].w * v[q].w); }
        const float r = 1.0f / sqrtf(wave_sum(s) * (1.f / 1024.f) + RMS_EPS);
        unsigned long long* o8 = (unsigned long long*)(ABF + (size_t)m * DM) + lane;
#pragma unroll
        for (int q = 0; q < 4; ++q) { const f32x4 g = ((const f32x4*)gain + lane)[64 * q];
            o8[64 * q] = (unsigned long long)pk2(v[q].x * r * g.x, v[q].y * r * g.y) | ((unsigned long long)pk2(v[q].z * r * g.z, v[q].w * r * g.w) << 32); }
    }
}
namespace att {
using bf16x8 = __attribute__((ext_vector_type(8))) short;
using s16x4 = __attribute__((ext_vector_type(4))) short;
using f32x16 = __attribute__((ext_vector_type(16))) float;
using u32x4 = __attribute__((ext_vector_type(4))) unsigned;
typedef float f32x2_t __attribute__((ext_vector_type(2))); typedef __bf16 bf16x2_t __attribute__((ext_vector_type(2)));
constexpr int KSLOT = 16384, VSLOT = 8192;
constexpr int L_K = 0, L_V = 2 * KSLOT, L_B = L_V + 3 * VSLOT, L_WS = L_B + 1024, L_OST = L_WS + 8 * 256, L_BYTES = L_OST + 8 * 4096;
__device__ __forceinline__ int crow(int r, int hi) { return (r & 3) + 8 * (r >> 2) + 4 * hi; }
__device__ __forceinline__ void glds16(const void* gsrc, unsigned lds_dst) { unsigned keep;
    asm volatile("s_mov_b32 %0, m0\n\ts_mov_b32 m0, %2\n\ts_nop 0\n\tglobal_load_lds_dwordx4 %1, off\n\ts_mov_b32 m0, %0" : "=&s"(keep) : "v"(gsrc), "s"(lds_dst) : "memory"); }
__device__ __forceinline__ unsigned cvtpk(float lo, float hi) { f32x2_t v = {lo, hi}; bf16x2_t b = __builtin_convertvector(v, bf16x2_t); return __builtin_bit_cast(unsigned, b); }
#define ATT_WAIT_BAR() asm volatile("s_waitcnt vmcnt(0) lgkmcnt(0)\n\ts_barrier" ::: "memory")

template <int DK, bool BIAS>
__device__ __forceinline__ void attn_unit(const int tid, const int qb, const bf16* Qh, const int qp, const bf16* Kh, const int kp, const bf16* Vh, const int vp, const float* cumh  , bf16* Oh  , char* shm, const float skip_margin  ) {
    constexpr int ND = DK / 16, KCH = DK / 8;
    const int lane = tid & 63, r32 = lane & 31, hi = lane >> 5; const int wid = __builtin_amdgcn_readfirstlane(tid >> 6);
    const bool lateh = wid >= 4;
    const int q0 = qb * 256;
    const unsigned lds0 = (unsigned)(uintptr_t)shm;
    float* wsf = (float*)(shm + L_WS) + wid * 64;
    float* Bs = (float*)(shm + L_B);
    const bf16* ksrc = Kh + (size_t)lane * kp + wid * 8;
    const bf16* vsrc = Vh + (size_t)(16 * (wid & 3) + (lane >> 2)) * vp + (wid >> 2) * 32 + (lane & 3) * 8;
    const unsigned kdst = lds0 + L_K + wid * 1024, vdst = lds0 + L_V + wid * 1024;
    const int NT = (q0 + 256) / 64;
    const float cref = BIAS ? cumh[(size_t)q0 * 8] : 0.f;
    int T0 = 0;
    if (BIAS) { for (int base = 0; base < NT; base += 64) { const int tq = base + lane; bool ok = false;
            if (tq < NT) ok = ((cref - cumh[(size_t)(64 * tq + 63) * 8]) * 1.4426950408889634f + skip_margin >= -150.0f);
            const unsigned long long mk = __ballot(ok); if (mk) { T0 = base + (int)__builtin_ctzll(mk); break; } T0 = NT - 4; }
        T0 = __builtin_amdgcn_readfirstlane(T0); if (T0 > NT - 4) T0 = NT - 4; }
#define ATT_DMA(t) do { const int t_ = (t); glds16(ksrc + (size_t)t_ * 64 * kp, (unsigned)__builtin_amdgcn_readfirstlane(kdst + (t_ & 1) * KSLOT)); \
        if (KCH > 8 && wid < KCH - 8) glds16(ksrc + (size_t)t_ * 64 * kp + 64, (unsigned)__builtin_amdgcn_readfirstlane(kdst + (t_ & 1) * KSLOT + 8192)); \
        glds16(vsrc + (size_t)t_ * 64 * vp, (unsigned)__builtin_amdgcn_readfirstlane(vdst + (t_ % 3) * VSLOT)); } while (0)
    ATT_DMA(T0);
    if (BIAS && wid == 0) Bs[(T0 % 3) * 64 + lane] = (cref - cumh[(size_t)(T0 * 64 + lane) * 8]) * 1.4426950408889634f;
    bf16x8 qr[ND];
#pragma unroll
    for (int d0 = 0; d0 < ND; ++d0) qr[d0] = *reinterpret_cast<const bf16x8*>(Qh + (size_t)(q0 + wid * 32 + r32) * qp + d0 * 16 + hi * 8);
    float mhat = 0.f, l_reg = 0.f; f32x16 o[2]; o[0] = f32x16{}; o[1] = f32x16{}; f32x16 negm = f32x16{};
    f32x16 p0 = f32x16{}, p1 = f32x16{};
    const int qrel = wid * 32 + r32;
    const int vb0 = (int)(lds0 + L_V) + ((lane >> 4) & 1) * 32 + (lane & 3) * 8 + (4 * hi + ((lane & 15) >> 2)) * 64;
#define ATT_X(t) do { const char* kb = shm + L_K + ((t) & 1) * KSLOT + hi * 1024 + r32 * 16; \
        _Pragma("unroll") for (int d0 = 0; d0 < ND; ++d0) { const bf16x8 b0 = *reinterpret_cast<const bf16x8*>(kb + d0 * 2048); const bf16x8 b1 = *reinterpret_cast<const bf16x8*>(kb + d0 * 2048 + 512); \
            if (d0 == 0) { p0 = __builtin_amdgcn_mfma_f32_32x32x16_bf16(b0, qr[0], negm, 0, 0, 0); p1 = __builtin_amdgcn_mfma_f32_32x32x16_bf16(b1, qr[0], negm, 0, 0, 0); } \
            else { p0 = __builtin_amdgcn_mfma_f32_32x32x16_bf16(b0, qr[d0], p0, 0, 0, 0); p1 = __builtin_amdgcn_mfma_f32_32x32x16_bf16(b1, qr[d0], p1, 0, 0, 0); } } } while (0)
#define ATT_YZ(tt_) do { const int tt = (tt_); \
        if (BIAS) { const float* bb = Bs + (tt % 3) * 64 + 4 * hi; \
            _Pragma("unroll") for (int g = 0; g < 4; ++g) { const f32x4 x0 = *(const f32x4*)(bb + 8 * g), x1 = *(const f32x4*)(bb + 32 + 8 * g); \
                _Pragma("unroll") for (int e = 0; e < 4; ++e) { p0[4 * g + e] += x0[e]; p1[4 * g + e] += x1[e]; } } } \
        if (tt >= NT - 4) { const int kb0 = 64 * (tt - (NT - 4)) + 4 * hi; \
            _Pragma("unroll") for (int r = 0; r < 16; ++r) { const int kv = kb0 + (r & 3) + 8 * (r >> 2); if (kv > qrel) p0[r] = -INFINITY; if (kv + 32 > qrel) p1[r] = -INFINITY; } } \
        float rm = fmaxf(p0[0], p1[0]); \
        _Pragma("unroll") for (int r = 1; r < 16; ++r) rm = fmaxf(rm, fmaxf(p0[r], p1[r])); \
        { auto rr = __builtin_amdgcn_permlane32_swap(__float_as_uint(rm), __float_as_uint(rm), false, false); rm = fmaxf(__uint_as_float(rr[0]), __uint_as_float(rr[1])); } \
        bool resc = false; \
        if (tt == T0) { mhat = rm; \
            _Pragma("unroll") for (int r = 0; r < 16; ++r) { p0[r] -= rm; p1[r] -= rm; } \
            _Pragma("unroll") for (int r = 0; r < 16; ++r) negm[r] = -mhat; \
        } else if (__any(rm > 8.0f)) { const float dl = fmaxf(rm, 0.f); mhat += dl; \
            _Pragma("unroll") for (int r = 0; r < 16; ++r) { p0[r] -= dl; p1[r] -= dl; } \
            _Pragma("unroll") for (int r = 0; r < 16; ++r) negm[r] = -mhat; \
            const float f = __builtin_amdgcn_exp2f(-dl); l_reg *= f; if (hi == 0) wsf[r32] = f; resc = true; } \
        float sacc = 0.f; \
        _Pragma("unroll") for (int r = 0; r < 16; ++r) { p0[r] = __builtin_amdgcn_exp2f(p0[r]); p1[r] = __builtin_amdgcn_exp2f(p1[r]); sacc += p0[r] + p1[r]; } \
        l_reg += sacc; \
        u32x4 pw0, pw1, pw2, pw3; \
        pw0 = (u32x4){cvtpk(p0[0], p0[1]), cvtpk(p0[2], p0[3]), cvtpk(p0[4], p0[5]), cvtpk(p0[6], p0[7])}; pw1 = (u32x4){cvtpk(p0[8], p0[9]), cvtpk(p0[10], p0[11]), cvtpk(p0[12], p0[13]), cvtpk(p0[14], p0[15])}; \
        pw2 = (u32x4){cvtpk(p1[0], p1[1]), cvtpk(p1[2], p1[3]), cvtpk(p1[4], p1[5]), cvtpk(p1[6], p1[7])}; pw3 = (u32x4){cvtpk(p1[8], p1[9]), cvtpk(p1[10], p1[11]), cvtpk(p1[12], p1[13]), cvtpk(p1[14], p1[15])}; \
        if (resc) { asm volatile("s_waitcnt lgkmcnt(0)" ::: "memory"); \
            _Pragma("unroll") for (int d_ = 0; d_ < 2; ++d_) _Pragma("unroll") for (int r = 0; r < 16; ++r) o[d_][r] *= wsf[crow(r, hi)]; } \
        { const int vb = vb0 + (tt % 3) * VSLOT; \
          _Pragma("unroll") for (int d0 = 0; d0 < 2; ++d0) { s16x4 lo[4], hh[4]; \
            _Pragma("unroll") for (int ks = 0; ks < 4; ++ks) { \
                asm volatile("ds_read_b64_tr_b16 %0,%1 offset:%c2" : "=&v"(lo[ks]) : "v"(vb), "i"(d0 * 4096 + ks * 1024) : "memory"); \
                asm volatile("ds_read_b64_tr_b16 %0,%1 offset:%c2" : "=&v"(hh[ks]) : "v"(vb), "i"(d0 * 4096 + ks * 1024 + 512) : "memory"); } \
            asm volatile("s_waitcnt lgkmcnt(0)" ::: "memory"); __builtin_amdgcn_sched_barrier(0); \
            o[d0] = __builtin_amdgcn_mfma_f32_32x32x16_bf16(__builtin_bit_cast(bf16x8, pw0), ATT_PK(0), o[d0], 0, 0, 0); \
            o[d0] = __builtin_amdgcn_mfma_f32_32x32x16_bf16(__builtin_bit_cast(bf16x8, pw1), ATT_PK(1), o[d0], 0, 0, 0); \
            o[d0] = __builtin_amdgcn_mfma_f32_32x32x16_bf16(__builtin_bit_cast(bf16x8, pw2), ATT_PK(2), o[d0], 0, 0, 0); \
            o[d0] = __builtin_amdgcn_mfma_f32_32x32x16_bf16(__builtin_bit_cast(bf16x8, pw3), ATT_PK(3), o[d0], 0, 0, 0); } } } while (0)
#define ATT_PK(k) (bf16x8){lo[k][0], lo[k][1], lo[k][2], lo[k][3], hh[k][0], hh[k][1], hh[k][2], hh[k][3]}
    ATT_WAIT_BAR();
    if (lateh && T0 + 1 < NT) ATT_DMA(T0 + 1);
#pragma unroll 1
    for (int t = T0; t < NT; ++t) {
        float bnext = 0.f;
        if (!lateh && t + 1 < NT) { ATT_DMA(t + 1); if (BIAS && wid == 0) bnext = cumh[(size_t)((t + 1) * 64 + lane) * 8]; }
        ATT_X(t);
        if (lateh) { ATT_WAIT_BAR(); if (t + 2 < NT) ATT_DMA(t + 2); }
        ATT_YZ(t);
        if (!lateh) { if (BIAS && wid == 0 && t + 1 < NT) Bs[((t + 1) % 3) * 64 + lane] = (cref - bnext) * 1.4426950408889634f; ATT_WAIT_BAR(); }
    }
#undef ATT_PK
#undef ATT_X
#undef ATT_YZ
    { auto rr = __builtin_amdgcn_permlane32_swap(__float_as_uint(l_reg), __float_as_uint(l_reg), false, false); l_reg = __uint_as_float(rr[0]) + __uint_as_float(rr[1]); }
    if (hi == 0) wsf[32 + r32] = l_reg; asm volatile("s_waitcnt lgkmcnt(0)" ::: "memory");
    float rli[16];
#pragma unroll
    for (int r = 0; r < 16; ++r) rli[r] = __builtin_amdgcn_rcpf(wsf[32 + crow(r, hi)]);
    bf16* Ow = Oh + (size_t)(q0 + wid * 32) * DM;
    { bf16* stg = (bf16*)(shm + L_OST) + wid * 2048;
#pragma unroll
      for (int r = 0; r < 16; ++r) { const int orow = crow(r, hi);
#pragma unroll
        for (int d0 = 0; d0 < 2; ++d0) stg[orow * 64 + d0 * 32 + r32] = (bf16)f2bf(o[d0][r] * rli[r]); }
      asm volatile("s_waitcnt lgkmcnt(0)" ::: "memory");
#pragma unroll
      for (int i = 0; i < 4; ++i) { const int row = i * 8 + (lane >> 3), ch = lane & 7; const u32x4 v = *(const u32x4*)(stg + row * 64 + ch * 8); *(u32x4*)(Ow + (size_t)row * DM + ch * 8) = v; } }
    asm volatile("s_waitcnt lgkmcnt(0)\n\ts_barrier" ::: "memory");
#undef ATT_DMA
}
}

constexpr int CW_AQ = 2048;
__device__ __forceinline__ void phase_attn_mfma(Frame& F, int j) {
    const bf16* PROJ = (const bf16*)(F.ws + WS_PROJ); const bf16* QM = (const bf16*)(F.ws + WS_QM); const bf16* KVB = (const bf16*)(F.ws + WS_KVB); const bf16* KM = (const bf16*)(F.ws + WS_KM);
    const float* CUM = (const float*)(F.ws + WS_CUM); bf16* MIX = (bf16*)(F.ws + WS_MIX);
    char* shm = (char*)(F.lds + RING_OFF);
    const int vcu = (F.G % 8 == 0) ? (F.bid % 8) * (F.G / 8) + F.bid / 8 : F.bid;
#pragma unroll 1
    for (int p = vcu; p < 512; p += F.G) { const int combo = p >> 5, s = p & 31, b = combo >> 3, h = combo & 7; const size_t rb = (size_t)b * SEQ;
#pragma unroll 1
        for (int half = 0; half < 2; ++half) { const int qb = half ? 63 - s : s;
            att::attn_unit<96, false>(F.tid, qb, QM + rb * 768 + h * 96, 768, KM + rb * 768 + h * 96, 768, KVB + rb * 1024 + h * 128 + 64, 1024, nullptr, MIX + rb * DM + 512 + h * 64, shm, 0.f); } }
    float gq = fabsf(kin(I_FOX_QN)[j * 64 + F.lane]), gk = fabsf(kin(I_FOX_KN)[j * 64 + F.lane]);
#pragma unroll
    for (int o = 1; o < 64; o <<= 1) { gq = fmaxf(gq, __shfl_xor(gq, o)); gk = fmaxf(gk, __shfl_xor(gk, o)); }
    const float margin = 2.0f * 1.02f * 64.0f * gq * gk * C2_FOX;
    LAS int* qslot = (LAS int*)(F.lds + LDSCTL_OFF + 64);
#pragma unroll 1
    for (;;) {
        if (F.tid == 0) *qslot = (int)__hip_atomic_fetch_add(F.ctl + CW_AQ + 64 * j, 1u, __ATOMIC_RELAXED, __HIP_MEMORY_SCOPE_AGENT);
        __syncthreads(); const int u = __builtin_amdgcn_readfirstlane(*qslot); __syncthreads();
        if (u >= 1024) break;
        const int qb = 63 - (u >> 4), combo = u & 15, b = combo >> 3, h = combo & 7; const size_t rb = (size_t)b * SEQ;
        att::attn_unit<64, true>(F.tid, qb, PROJ + rb * EVEN_INP + E_FQ + h * 64, EVEN_INP, PROJ + rb * EVEN_INP + E_FK + h * 64, EVEN_INP, PROJ + rb * EVEN_INP + E_FV + h * 64, EVEN_INP, CUM + rb * 8 + h, MIX + rb * DM + h * 64, shm, margin);
    }
}
constexpr size_t WS_S5_MT = WS_Y2;
constexpr size_t WS_S5_PT = WS_S5_MT + 72 * MiB;
constexpr size_t WS_S5_AX = WS_S5_PT + 16 * MiB;
constexpr size_t WS_S5_XLOC = WS_S5_AX + 36 * MiB;
static_assert(WS_S5_XLOC + 8 * MiB <= WS_Y2 + 144 * MiB, "s5 overlay");

__device__ __forceinline__ void s5_build(Frame& F, int j) {
    if (F.bid >= 256) return;
    const int g = F.bid >> 3, part = F.bid & 7, tid = F.tid, lane = F.lane, wave = F.wave;
    LAS float* pwr = (LAS float*)(F.lds + RING_OFF);
    LAS float* pwi = pwr + 65 * 64;
    LAS float* bbr = pwi + 65 * 64;
    LAS float* bbi = bbr + 1024;
    LAS float* crs = bbi + 1024;
    LAS float* cis = crs + 1024;
    LAS bf16* ktab = (LAS bf16*)(cis + 1024);
    const float dt = expf(kin(I_S5_LS)[j * 32 + g]);
    const float* are = kin(I_S5_ARE) + (size_t)(j * 32 + g) * 64; const float* aim = kin(I_S5_AIM) + (size_t)(j * 32 + g) * 64;
    for (int e = tid; e < 65 * 64; e += 512) { const int d = e >> 6, p = e & 63; const float lr = fminf(are[p], -1e-4f), li = aim[p];
        const float mag = expf(lr * dt * (float)d); float sn, cs; sincosf(li * dt * (float)d, &sn, &cs); pwr[e] = mag * cs; pwi[e] = mag * sn; }
    for (int e = tid; e < 1024; e += 512) { const int p = e >> 4, c = e & 15; const float lr = fminf(are[p], -1e-4f), li = aim[p];
        const float mag = expf(lr * dt); float sn, cs; sincosf(li * dt, &sn, &cs); const float abr = mag * cs, abi = mag * sn;
        const float den = lr * lr + li * li, nr = abr - 1.0f, ni = abi; const float gr = (nr * lr + ni * li) / den, gi = (ni * lr - nr * li) / den;
        const float br = kin(I_S5_BRE)[((size_t)(j * 32 + g) * 64 + p) * 16 + c], bi = kin(I_S5_BIM)[((size_t)(j * 32 + g) * 64 + p) * 16 + c];
        bbr[e] = gr * br - gi * bi; bbi[e] = gr * bi + gi * br; }
    for (int e = tid; e < 1024; e += 512) { crs[e] = kin(I_S5_CRE)[(size_t)(j * 32 + g) * 1024 + e]; cis[e] = kin(I_S5_CIM)[(size_t)(j * 32 + g) * 1024 + e]; }
    __syncthreads();
    { const int cc = tid >> 1, c = cc >> 4, c2 = cc & 15, ph = tid & 1;
      float er[32], ei[32];
#pragma unroll
      for (int pp = 0; pp < 32; ++pp) { const int p = 32 * ph + pp; const float xr = crs[c * 64 + p], xi = cis[c * 64 + p], yr = bbr[p * 16 + c2], yi = bbi[p * 16 + c2]; er[pp] = xr * yr - xi * yi; ei[pp] = xr * yi + xi * yr; }
#pragma unroll 1
      for (int d = 0; d < 64; ++d) { float s = 0.f; const LAS float* wr_ = pwr + d * 64 + 32 * ph; const LAS float* wi_ = pwi + d * 64 + 32 * ph;
#pragma unroll
          for (int pp = 0; pp < 32; ++pp) s += wr_[pp] * er[pp] - wi_[pp] * ei[pp];
          s += __shfl_xor(s, 1);
          if (ph == 0) ktab[(d * 16 + c) * 16 + c2] = (bf16)f2bf(s); } }
    __syncthreads();
    bf16* MT = (bf16*)(F.ws + WS_S5_MT) + (size_t)g * 1024 * 1152;
#pragma unroll 1
    for (int rr = wave; rr < 128; rr += 8) { const int i = part * 8 + (rr >> 4), c = rr & 15; bf16* row = MT + (size_t)(i * 16 + c) * 1152;
        v4u a = {0u, 0u, 0u, 0u}, b = {0u, 0u, 0u, 0u};
        if (lane <= i) { const LAS v4u* src = (const LAS v4u*)(ktab + ((i - lane) * 16 + c) * 16); a = src[0]; b = src[1]; }
        *(v4u*)(row + lane * 16) = a; *(v4u*)(row + lane * 16 + 8) = b;
        { const int p = lane; const float xr = crs[c * 64 + p], xi = cis[c * 64 + p], wr_ = pwr[(i + 1) * 64 + p], wi_ = pwi[(i + 1) * 64 + p];
          row[1024 + p] = (bf16)f2bf(xr * wr_ - xi * wi_); row[1088 + p] = (bf16)f2bf(-(xr * wi_ + xi * wr_)); } }
    bf16* PT = (bf16*)(F.ws + WS_S5_PT) + (size_t)g * 256 * 1024;
#pragma unroll 1
    for (int rr = wave; rr < 32; rr += 8) { const int n = part * 32 + rr; bf16* row = PT + (size_t)n * 1024 + lane * 16;
        unsigned o[8];
        if (n < 128) { const int p = n & 63, im = n >> 6; const float wr_ = pwr[(63 - lane) * 64 + p], wi_ = pwi[(63 - lane) * 64 + p];
#pragma unroll
            for (int q = 0; q < 8; ++q) { const float y0r = bbr[p * 16 + 2 * q], y0i = bbi[p * 16 + 2 * q], y1r = bbr[p * 16 + 2 * q + 1], y1i = bbi[p * 16 + 2 * q + 1];
                const float v0 = im ? (wr_ * y0i + wi_ * y0r) : (wr_ * y0r - wi_ * y0i), v1 = im ? (wr_ * y1i + wi_ * y1r) : (wr_ * y1r - wi_ * y1i); o[q] = pk2(v0, v1); }
        } else {
#pragma unroll
            for (int q = 0; q < 8; ++q) o[q] = 0u; }
        *(v4u*)row = (v4u){o[0], o[1], o[2], o[3]}; *(v4u*)(row + 8) = (v4u){o[4], o[5], o[6], o[7]}; }
    __syncthreads();
}
__device__ __forceinline__ void s5_repack(Frame& F) {
    const bf16* PROJ = (const bf16*)(F.ws + WS_PROJ); bf16* AX = (bf16*)(F.ws + WS_S5_AX);
    const int gt = F.bid * 512 + F.tid, NT = F.G * 512;
    for (int e = gt; e < NTOK * 32; e += NT) { const int m = e >> 5, g = e & 31; const int b = m / SEQ, t = m % SEQ, n = t >> 6, s = t & 63;
        const v4u* src = (const v4u*)(PROJ + (size_t)m * ODD_INP + O_U + g * 16); v4u* dst = (v4u*)(AX + ((size_t)g * 512 + b * 256 + n) * 1152 + s * 16);
        const v4u x0 = src[0], x1 = src[1]; dst[0] = x0; dst[1] = x1; }
}
struct S5POrder {
    int G, c;
    __device__ bool next(int i, pg8::Unit& u) const { const int L = i * G + c; if (L >= 64) return false; u.aux = L >> 1; u.pm = L & 1; u.pn = 0; return true; }
    __device__ __forceinline__ const char* a_base(const pg8::Gemm& g, const pg8::Unit& u) const { return (const char*)g.A + ((size_t)u.aux * 512 + u.pm * 256) * 1152 * 2; }
    __device__ __forceinline__ const char* b_base(const pg8::Gemm& g, const pg8::Unit& u) const { return (const char*)g.Bt + (size_t)u.aux * 256 * 1024 * 2; }
};
struct S5PEpi {
    static constexpr bool PERM = false;
    float* X;
    __device__ __forceinline__ void operator()(const pg8::f32x4 (&acc)[2][2][4][2], const pg8::Unit& u, int wr, int wc, int fr, int fq) const {
        const int row0 = u.pm * 256 + wr * 64 + fr; const int col0 = wc * 32 + 4 * fq;
#pragma unroll
        for (int ai = 0; ai < 2; ++ai)
#pragma unroll
            for (int m = 0; m < 4; ++m) { float* rowp = X + ((size_t)u.aux * 512 + row0 + ai * 128 + m * 16) * 128 + col0;
#pragma unroll
                for (int n = 0; n < 2; ++n) *(pg8::f32x4*)(rowp + n * 16) = acc[ai][0][m][n]; }
    }
};
__device__ __forceinline__ void s5_scan(Frame& F, int j) {
    const int gw = F.bid * NWAVES + F.wave; if (gw >= 64) return;
    const int g = gw >> 1, b = gw & 1, p = F.lane;
    const float lr = fminf(kin(I_S5_ARE)[(size_t)(j * 32 + g) * 64 + p], -1e-4f), li = kin(I_S5_AIM)[(size_t)(j * 32 + g) * 64 + p]; const float dt = expf(kin(I_S5_LS)[j * 32 + g]);
    const float mag = expf(lr * dt * 64.f); float sn, cs; sincosf(li * dt * 64.f, &sn, &cs); const float ar = mag * cs, ai = mag * sn;
    const float* X = (const float*)(F.ws + WS_S5_XLOC) + ((size_t)g * 512 + b * 256) * 128; bf16* AX = (bf16*)(F.ws + WS_S5_AX) + ((size_t)g * 512 + b * 256) * 1152 + 1024;
    float xr = 0.f, xi = 0.f; float cr[8], ci[8], nr[8], ni[8];
#pragma unroll
    for (int q = 0; q < 8; ++q) { cr[q] = X[(size_t)q * 128 + p]; ci[q] = X[(size_t)q * 128 + 64 + p]; }
    for (int n0 = 0; n0 < 256; n0 += 8) { const int nn = (n0 + 8 < 256) ? n0 + 8 : n0;
#pragma unroll
        for (int q = 0; q < 8; ++q) { nr[q] = X[(size_t)(nn + q) * 128 + p]; ni[q] = X[(size_t)(nn + q) * 128 + 64 + p]; }
#pragma unroll
        for (int q = 0; q < 8; ++q) { AX[(size_t)(n0 + q) * 1152 + p] = (bf16)f2bf(xr); AX[(size_t)(n0 + q) * 1152 + 64 + p] = (bf16)f2bf(xi);
            const float tr = ar * xr - ai * xi + cr[q], ti = ar * xi + ai * xr + ci[q]; xr = tr; xi = ti; }
#pragma unroll
        for (int q = 0; q < 8; ++q) { cr[q] = nr[q]; ci[q] = ni[q]; } }
}
struct S5MOrder {
    int G, c;
    __device__ bool next(int i, pg8::Unit& u) const { const int L = i * G + c; if (L >= 256) return false; u.aux = L >> 3; u.pm = (L >> 2) & 1; u.pn = L & 3; return true; }
    __device__ __forceinline__ const char* a_base(const pg8::Gemm& g, const pg8::Unit& u) const { return (const char*)g.A + ((size_t)u.aux * 512 + u.pm * 256) * 1152 * 2; }
    __device__ __forceinline__ const char* b_base(const pg8::Gemm& g, const pg8::Unit& u) const { return (const char*)g.Bt + ((size_t)u.aux * 1024 + u.pn * 256) * 1152 * 2; }
};
struct S5MEpi {
    static constexpr bool PERM = true;
    bf16* HG; const bf16* PROJ; const float* dsk;
    __device__ __forceinline__ void operator()(const pg8::f32x4 (&acc)[2][2][4][2], const pg8::Unit& u, int wr, int wc, int fr, int fq) const {
        const int g = u.aux; const int row0 = u.pm * 256 + wr * 64 + fr; const int col0 = u.pn * 256 + wc * 32 + 8 * fq;
        const pg8::f32x4 d0 = *(const pg8::f32x4*)(dsk + g * 16 + (col0 & 15)), d1 = *(const pg8::f32x4*)(dsk + g * 16 + (col0 & 15) + 4);
#pragma unroll
        for (int ai = 0; ai < 2; ++ai)
#pragma unroll
            for (int m = 0; m < 4; ++m) { const int rg = row0 + ai * 128 + m * 16; const int b = rg >> 8, n = rg & 255;
#pragma unroll
                for (int bj = 0; bj < 2; ++bj) { const int col = col0 + bj * 128; const int i = col >> 4, c0 = col & 15; const size_t tok = (size_t)b * SEQ + n * 64 + i;
                    const pg8::u32x4 uw = *(const pg8::u32x4*)(PROJ + tok * ODD_INP + O_U + g * 16 + c0); const pg8::f32x4 v0 = acc[ai][bj][m][0], v1 = acc[ai][bj][m][1];
                    pg8::u32x4 w; w.x = pk2(gelu_tanh(v0[0] + d0[0] * bflo(uw.x)), gelu_tanh(v0[1] + d0[1] * bfhi(uw.x))); w.y = pk2(gelu_tanh(v0[2] + d0[2] * bflo(uw.y)), gelu_tanh(v0[3] + d0[3] * bfhi(uw.y)));
                    w.z = pk2(gelu_tanh(v1[0] + d1[0] * bflo(uw.z)), gelu_tanh(v1[1] + d1[1] * bfhi(uw.z))); w.w = pk2(gelu_tanh(v1[2] + d1[2] * bflo(uw.w)), gelu_tanh(v1[3] + d1[3] * bfhi(uw.w)));
                    *(pg8::u32x4*)(HG + tok * 512 + g * 16 + c0) = w; } }
    }
};
namespace gdn {
typedef short s16x4 __attribute__((ext_vector_type(4)));
#define GDN_MFMA(a, b, c) __builtin_amdgcn_mfma_f32_16x16x16bf16_1k(a, b, c, 0, 0, 0)
__device__ __forceinline__ float fsig(float x) { return __builtin_amdgcn_rcpf(1.0f + __expf(-x)); }
__device__ __forceinline__ float bperm(float v, int src_lane) { return __int_as_float(__builtin_amdgcn_ds_bpermute(src_lane << 2, __float_as_int(v))); }
__device__ __forceinline__ s16x4 pack4(float a, float b, float c, float d) { v2u w; w.x = pk2(a, b); w.y = pk2(c, d); return __builtin_bit_cast(s16x4, w); }
constexpr int NITEM = BATCH * 4 * (SEQ / 16);
constexpr int IMG_STRIDE = 144;
constexpr int WAVE_LDS = 1024 + 1024 + 3 * 16 * IMG_STRIDE * 2;
}
constexpr size_t WS_GDN_UB = WS_QG;
constexpr size_t WS_GDN_WT = WS_KG;
constexpr size_t WS_GDN_QD = WS_KG + 32 * MiB;
constexpr size_t WS_GDN_KD = WS_VG;
constexpr size_t WS_GDN_IT = WS_VG + 32 * MiB;

__device__ __forceinline__ void phase_gdn_g1(Frame& F, int j) {
    using namespace gdn;
    const bf16* PROJ = (const bf16*)(F.ws + WS_PROJ);
    const float* cw = kin(I_GDN_CONV) + (size_t)j * 4 * 1536;
    float* UB = (float*)(F.ws + WS_GDN_UB); bf16* WT = (bf16*)(F.ws + WS_GDN_WT); bf16* QD = (bf16*)(F.ws + WS_GDN_QD); bf16* KD = (bf16*)(F.ws + WS_GDN_KD); unsigned* ITE = (unsigned*)(F.ws + WS_GDN_IT);
    LAS float* Am = (LAS float*)(F.lds + RING_OFF + F.wave * WAVE_LDS); LAS float* Tm = Am + 256; LAS bf16* img = (LAS bf16*)(Tm + 256);
    const int gw = F.bid * NWAVES + F.wave, NGW = F.G * NWAVES;
#pragma unroll 1
    for (int item = gw; item < NITEM; item += NGW) {
        int lane = F.lane; asm volatile("" : "+v"(lane));
        const int tok = lane & 15, g4 = lane >> 4;
        const int b = item >> 12, h = (item >> 10) & 3, n = item & 1023; const int s0 = 16 * n + tok; const size_t m = (size_t)b * SEQ + s0;
        const size_t it = (size_t)item;
        const float gin = bf2f(PROJ[m * ODD_INP + O_GIN + h]), bin = bf2f(PROJ[m * ODD_INP + O_BETA + h]);
        const float gt = -expf(kin(I_GDN_ALOG)[j * 4 + h]) * softplusf_(gin + kin(I_GDN_DTB)[j * 4 + h]); const float beta = fsig(bin);
        float gc = gt;
#pragma unroll
        for (int off = 1; off < 16; off <<= 1) { const float t = bperm(gc, tok >= off ? lane - off : lane); if (tok >= off) gc += t; }
        const float glast = bperm(gc, lane | 15); const float eg = expf(gc), ekd = expf(glast - gc);
        LAS bf16* img2 = img + 16 * IMG_STRIDE; LAS bf16* img3 = img2 + 16 * IMG_STRIDE;
#define GDN_CONV(WSEL, X) do { _Pragma("unroll") for (int db = 0; db < 8; ++db) { const int ch = (WSEL) * 512 + h * 128 + 16 * db + 4 * g4; float a0 = 0.f, a1 = 0.f, a2 = 0.f, a3 = 0.f; \
            _Pragma("unroll") for (int tap = 0; tap < 4; ++tap) { if (s0 - 3 + tap >= 0) { const v2u x = *(const v2u*)(PROJ + (m - 3 + tap) * ODD_INP + O_Q + ch); const f32x4 wv = *(const f32x4*)(cw + tap * 1536 + ch); \
                a0 += wv.x * bflo(x.x); a1 += wv.y * bfhi(x.x); a2 += wv.z * bflo(x.y); a3 += wv.w * bfhi(x.y); } } \
            X[db][0] = a0 * fsig(a0); X[db][1] = a1 * fsig(a1); X[db][2] = a2 * fsig(a2); X[db][3] = a3 * fsig(a3); \
            if ((db & 3) == 3) asm volatile("" ::: "memory"); } } while (0)
        { float xv[8][4]; GDN_CONV(2, xv);
#pragma unroll
          for (int db = 0; db < 8; ++db) *(LAS s16x4*)(img + tok * IMG_STRIDE + 16 * db + 4 * g4) = pack4(xv[db][0] * beta, xv[db][1] * beta, xv[db][2] * beta, xv[db][3] * beta); }
        s16x4 Kf[8];
        { float xk[8][4]; GDN_CONV(1, xk); float sk = 0.f;
#pragma unroll
          for (int db = 0; db < 8; ++db)
#pragma unroll
              for (int e = 0; e < 4; ++e) sk += xk[db][e] * xk[db][e];
          sk += bperm(sk, lane ^ 16); sk += bperm(sk, lane ^ 32);
          const float rk = 1.0f / sqrtf(sk + RMS_EPS); const float s2 = rk * beta * eg, s3 = rk * ekd;
#pragma unroll
          for (int db = 0; db < 8; ++db) { const int o = tok * IMG_STRIDE + 16 * db + 4 * g4;
              *(LAS s16x4*)(img2 + o) = pack4(xk[db][0] * s2, xk[db][1] * s2, xk[db][2] * s2, xk[db][3] * s2);
              *(LAS s16x4*)(img3 + o) = pack4(xk[db][0] * s3, xk[db][1] * s3, xk[db][2] * s3, xk[db][3] * s3);
              Kf[db] = pack4(xk[db][0] * rk, xk[db][1] * rk, xk[db][2] * rk, xk[db][3] * rk); } }
        f32x4 Gacc = {0.f, 0.f, 0.f, 0.f}, Pacc = {0.f, 0.f, 0.f, 0.f};
        { float xqq[8][4]; GDN_CONV(0, xqq); float sq = 0.f;
#pragma unroll
          for (int db = 0; db < 8; ++db)
#pragma unroll
              for (int e = 0; e < 4; ++e) sq += xqq[db][e] * xqq[db][e];
          sq += bperm(sq, lane ^ 16); sq += bperm(sq, lane ^ 32);
          const float rq = (1.0f / sqrtf(sq + RMS_EPS)) * 0.08838834764831845f;
#pragma unroll
          for (int db = 0; db < 8; ++db) {
              *(s16x4*)(QD + ((it * 4 + (db >> 1)) * 64 + lane) * 8 + (db & 1) * 4) = pack4(xqq[db][0] * rq * eg, xqq[db][1] * rq * eg, xqq[db][2] * rq * eg, xqq[db][3] * rq * eg);
              const s16x4 Qf = pack4(xqq[db][0] * rq, xqq[db][1] * rq, xqq[db][2] * rq, xqq[db][3] * rq);
              Gacc = GDN_MFMA(Kf[db], Kf[db], Gacc); Pacc = GDN_MFMA(Kf[db], Qf, Pacc); } }
#undef GDN_CONV
        { float itv[4];
#pragma unroll
          for (int r = 0; r < 4; ++r) { const int i = 4 * g4 + r; const float gci = bperm(gc, i), bi = bperm(beta, i);
              const float da = (tok < i) ? expf(gci - gc) : 0.f;
              Am[i * 16 + tok] = bi * Gacc[r] * da;
              const float dp = (i <= tok) ? expf(gc - gci) : 0.f;
              itv[r] = Pacc[r] * dp; }
          v4u ite; ite.x = pk2(itv[0], itv[1]); ite.y = pk2(itv[2], itv[3]); ite.z = __float_as_uint(expf(glast)); ite.w = 0u;
          *(v4u*)(ITE + (it * 64 + lane) * 4) = ite; }
        LDS_WAIT();
        float Tc[16];
#pragma unroll
        for (int i = 0; i < 16; ++i) { float s = (i == tok) ? 1.f : 0.f;
#pragma unroll
            for (int jj = 0; jj < i; ++jj) s -= Am[i * 16 + jj] * Tc[jj];
            Tc[i] = s; }
#pragma unroll
        for (int r = 0; r < 4; ++r) Tm[(4 * g4 + r) * 16 + tok] = (g4 == 0) ? Tc[r] : (g4 == 1) ? Tc[4 + r] : (g4 == 2) ? Tc[8 + r] : Tc[12 + r];
        LDS_WAIT();
        const f32x4 trow = *(const LAS f32x4*)(Tm + tok * 16 + 4 * g4);
        const s16x4 Tf = pack4(trow.x, trow.y, trow.z, trow.w);
        const int traddr = (int)(uintptr_t)img + ((4 * g4 + ((lane & 15) >> 2)) * IMG_STRIDE + 4 * (lane & 3)) * 2;
#pragma unroll
        for (int cb = 0; cb < 8; ++cb) { s16x4 vf; asm volatile("ds_read_b64_tr_b16 %0, %1 offset:%c2\n\ts_waitcnt lgkmcnt(0)" : "=&v"(vf) : "v"(traddr), "i"(cb * 32) : "memory");
            const f32x4 z = {0.f, 0.f, 0.f, 0.f}; const f32x4 u = GDN_MFMA(Tf, vf, z);
            *(f32x4*)(UB + ((it * 8 + cb) * 64 + lane) * 4) = u; }
#pragma unroll
        for (int db = 0; db < 8; ++db) { s16x4 kf; asm volatile("ds_read_b64_tr_b16 %0, %1 offset:%c2\n\ts_waitcnt lgkmcnt(0)" : "=&v"(kf) : "v"(traddr), "i"(16 * IMG_STRIDE * 2 + db * 32) : "memory");
            const f32x4 z = {0.f, 0.f, 0.f, 0.f}; const f32x4 w = GDN_MFMA(kf, Tf, z);
            *(s16x4*)(WT + ((it * 4 + (db >> 1)) * 64 + lane) * 8 + (db & 1) * 4) = pack4(-w.x, -w.y, -w.z, -w.w); }
#pragma unroll
        for (int db = 0; db < 8; ++db) { s16x4 kf; asm volatile("ds_read_b64_tr_b16 %0, %1 offset:%c2\n\ts_waitcnt lgkmcnt(0)" : "=&v"(kf) : "v"(traddr), "i"(32 * IMG_STRIDE * 2 + db * 32) : "memory");
            *(s16x4*)(KD + ((it * 4 + (db >> 1)) * 64 + lane) * 8 + (db & 1) * 4) = kf; }
        LDS_WAIT();
    }
}

__device__ __forceinline__ void phase_gdn_g2(Frame& F) {
    using namespace gdn;
    if (F.bid >= 64) return;
    const char* UB = (const char*)(F.ws + WS_GDN_UB); const char* WT = (const char*)(F.ws + WS_GDN_WT); const char* QD = (const char*)(F.ws + WS_GDN_QD); const char* KD = (const char*)(F.ws + WS_GDN_KD);
    const char* ITE = (const char*)(F.ws + WS_GDN_IT); float* OGN = (float*)(F.ws + WS_OG);
    const int lane = F.lane, bh = F.bid & 7, sl = F.bid >> 3, wave = F.wave;
    constexpr int SLOT = 14 * 1024, NSLOT = 8, INFL = 6;
    volatile LAS int* ready = (volatile LAS int*)(F.lds + LDSCTL_OFF + 128);
    volatile LAS int* done = (volatile LAS int*)(F.lds + LDSCTL_OFF + 192);
    if (F.tid < 8) ready[F.tid] = 0; if (F.tid == 8) *done = 0;
    __syncthreads();
    const size_t it0 = (size_t)bh * 1024;
    if (wave != 0) {
        const unsigned ring = (unsigned)(uintptr_t)(F.lds + RING_OFF); const size_t lo16 = (size_t)lane * 16;
        const int p0 = 2 * (wave - 1);
#pragma unroll 1
        for (int s = 0; s < 1024; ++s) {
            if (s >= NSLOT) { unsigned sp_ = 0; while (*done < s - NSLOT + 1) { __builtin_amdgcn_s_sleep(1); if (++sp_ > (1u << 24)) break; } }
            const size_t i_ = it0 + s; const unsigned d_ = ring + (unsigned)((s % NSLOT) * SLOT);
#pragma unroll
            for (int k = 0; k < 2; ++k) { const int pc = p0 + k; const char* src;
                if (pc == 0) src = UB + ((i_ * 8 + sl) * 64) * 16; else if (pc <= 4) src = WT + ((i_ * 4 + (pc - 1)) * 64) * 16; else if (pc <= 8) src = QD + ((i_ * 4 + (pc - 5)) * 64) * 16;
                else if (pc <= 12) src = KD + ((i_ * 4 + (pc - 9)) * 64) * 16; else src = ITE + (i_ * 64) * 16;
                att::glds16(src + lo16, (unsigned)__builtin_amdgcn_readfirstlane(d_ + pc * 1024)); }
            asm volatile("s_waitcnt vmcnt(10)" ::: "memory");
            if (s >= INFL - 1 && lane == 0) ready[wave] = s - (INFL - 1) + 1;
        }
        asm volatile("s_waitcnt vmcnt(0)" ::: "memory"); if (lane == 0) ready[wave] = 1024;
        return;
    }
    f32x4 S[8];
#pragma unroll
    for (int db = 0; db < 8; ++db) S[db] = (f32x4){0.f, 0.f, 0.f, 0.f};
#pragma unroll 1
    for (int n = 0; n < 1024; ++n) {
        { unsigned sp_ = 0; for (;;) { const int r1 = ready[1], r2 = ready[2], r3 = ready[3], r4 = ready[4], r5 = ready[5], r6 = ready[6], r7 = ready[7];
              const int mn = min(min(min(r1, r2), min(r3, r4)), min(min(r5, r6), r7)); if (mn > n) break; __builtin_amdgcn_s_sleep(1); if (++sp_ > (1u << 24)) break; } }
        const LAS char* sp = (const LAS char*)(F.lds + RING_OFF) + (n % NSLOT) * SLOT + lane * 16;
        const f32x4 u_c = *(const LAS f32x4*)sp; const v4u ite = *(const LAS v4u*)(sp + 13 * 1024);
        v4u wt[4], qd[4], kd[4];
#pragma unroll
        for (int q = 0; q < 4; ++q) { wt[q] = *(const LAS v4u*)(sp + (1 + q) * 1024); qd[q] = *(const LAS v4u*)(sp + (5 + q) * 1024); kd[q] = *(const LAS v4u*)(sp + (9 + q) * 1024); }
        asm volatile("s_waitcnt lgkmcnt(0)" ::: "memory");
        if (lane == 0) *done = n + 1;
#define FR(v, h) __builtin_bit_cast(s16x4, (v2u){(h) ? (v).z : (v).x, (h) ? (v).w : (v).y})
        const float egl = __uint_as_float(ite.z); const s16x4 itf = __builtin_bit_cast(s16x4, (v2u){ite.x, ite.y});
        s16x4 Sb[8];
#pragma unroll
        for (int db = 0; db < 8; ++db) Sb[db] = pack4(S[db].x, S[db].y, S[db].z, S[db].w);
        f32x4 va = u_c, vb2 = {0.f, 0.f, 0.f, 0.f};
#pragma unroll
        for (int q = 0; q < 4; ++q) { va = GDN_MFMA(FR(wt[q], 0), Sb[2 * q], va); vb2 = GDN_MFMA(FR(wt[q], 1), Sb[2 * q + 1], vb2); }
        va = va + vb2;
        const s16x4 vb = pack4(va.x, va.y, va.z, va.w);
#pragma unroll
        for (int q = 0; q < 4; ++q) { const f32x4 s0 = S[2 * q] * egl, s1 = S[2 * q + 1] * egl; S[2 * q] = GDN_MFMA(FR(kd[q], 0), vb, s0); S[2 * q + 1] = GDN_MFMA(FR(kd[q], 1), vb, s1); }
        f32x4 oa = {0.f, 0.f, 0.f, 0.f}, ob = {0.f, 0.f, 0.f, 0.f};
        oa = GDN_MFMA(itf, vb, oa);
#pragma unroll
        for (int q = 0; q < 4; ++q) { oa = GDN_MFMA(FR(qd[q], 0), Sb[2 * q], oa); ob = GDN_MFMA(FR(qd[q], 1), Sb[2 * q + 1], ob); }
        oa = oa + ob;
        *(f32x4*)(OGN + (((it0 + n) * 8 + sl) * 64 + lane) * 4) = oa;
#undef FR
    }
}
__device__ __forceinline__ void phase_gdn_out2(Frame& F, int j) {
    using namespace gdn;
    const float* OGN = (const float*)(F.ws + WS_OG); const bf16* PROJ = (const bf16*)(F.ws + WS_PROJ); bf16* MIX = (bf16*)(F.ws + WS_MIX);
    const float* on = kin(I_GDN_ONORM) + j * 128; const int lane = F.lane, c = lane & 15, g4 = lane >> 4;
    const int gw = F.bid * NWAVES + F.wave, NGW = F.G * NWAVES;
#pragma unroll 1
    for (int item = gw; item < NITEM; item += NGW) { const int b = item >> 12, h = (item >> 10) & 3, n = item & 1023;
        f32x4 o[8]; float ss[4] = {0.f, 0.f, 0.f, 0.f};
#pragma unroll
        for (int sl = 0; sl < 8; ++sl) { o[sl] = *(const f32x4*)(OGN + (((size_t)item * 8 + sl) * 64 + lane) * 4);
#pragma unroll
            for (int r = 0; r < 4; ++r) ss[r] += o[sl][r] * o[sl][r]; }
#pragma unroll
        for (int r = 0; r < 4; ++r) { ss[r] += __shfl_xor(ss[r], 1); ss[r] += __shfl_xor(ss[r], 2); ss[r] += __shfl_xor(ss[r], 4); ss[r] += __shfl_xor(ss[r], 8); ss[r] = 1.0f / sqrtf(ss[r] * (1.f / 128.f) + RMS_EPS); }
#pragma unroll
        for (int r = 0; r < 4; ++r) { const size_t tok = (size_t)b * SEQ + 16 * n + 4 * g4 + r;
#pragma unroll
            for (int sl = 0; sl < 8; ++sl) { const int col = 16 * sl + c; const float zz = bf2f(PROJ[tok * ODD_INP + O_Z + h * 128 + col]);
                MIX[tok * DM + 512 + h * 128 + col] = (bf16)f2bf(o[sl][r] * ss[r] * on[col] * (zz * fsig(zz))); } }
    }
}
constexpr int LSTEPS = 16;
constexpr int STEP_END = 1 + DEPTH * LSTEPS;
struct KArgs { Args a; int li, pad; };

#define FRAME Frame F; { int wv_ = wave0; asm volatile("" : "+s"(wv_)); int t_ = wv_ * 64 + (int)__builtin_amdgcn_mbcnt_hi(~0u, __builtin_amdgcn_mbcnt_lo(~0u, 0u)); asm volatile("" : "+v"(t_)); unsigned char* w_ = kws(); F.lds = lds0; F.ws = w_; F.ctl = (unsigned*)(w_ + WS_CTL); \
        F.tid = t_; F.lane = t_ & 63; F.wave = __builtin_amdgcn_readfirstlane(t_ >> 6); { int g_ = gridDim.x, b_ = blockIdx.x; asm volatile("" : "+s"(g_), "+s"(b_)); F.G = g_; F.bid = b_; } } unsigned char* const ws = F.ws; (void)ws
#ifndef PH_MASK
#define PH_MASK 0xffffffffu
#endif
#define EN(k) (((PH_MASK) >> (k)) & 1u)
#ifndef DUP_E
#define DUP_E 0u
#endif
#ifndef DUP_O
#define DUP_O 0u
#endif
#define NREP(s) ((((s) >= 1) && (((((((s) - 1) / LSTEPS) & 1) ? (DUP_O) : (DUP_E)) >> (((s) + LSTEPS - 1) % LSTEPS)) & 1u)) ? 2 : 1)
#define STEP(s) if (lo <= (s) && (s) < hi) for (int rep_ = 0; rep_ < NREP(s); ++rep_)
#define DRY(s) (NREP(s) == 2 && rep_ == 0)
#define ENDSTEP(s) do { if ((s) + 1 < hi) xcd_barrier(bar); } while (0)
#define LAUNDER_WS do {} while (0)


template <int layer> __device__ __forceinline__ void layer_body(const XcdBarrier& bar, const int lo, const int hi, LAS unsigned char* const lds0, const int wave0) {
        constexpr int sb = 1 + layer * LSTEPS, j = layer >> 1; constexpr bool even = (layer & 1) == 0;
        STEP(sb + 0) if constexpr (EN(0)) { FRAME;
            phase_norm(F, layer == 0 ? kin(I_X) : kout(), kin(I_NORM_MIX) + layer * DM, layer == 0 ? kout() : nullptr);
            moe_weights(F, layer); phase_pconv(F, layer);
            if constexpr (!even) { __syncthreads(); s5_build(F, j); }
            ENDSTEP(sb + 0);
        }
        STEP(sb + 1) if constexpr (EN(1)) { FRAME;
            { LAUNDER_WS; const int NP = even ? EVEN_INP : ODD_INP; const bf16* W = even ? (const bf16*)(ws + WS_W_EVIN) + (size_t)j * EVEN_INP * 1024 : (const bf16*)(ws + WS_W_ODIN) + (size_t)j * ODD_INP * 1024;
              pg8::Gemm g{(const bf16*)(ws + WS_ABF), W, 1024, 1024, 1024}; pg8::StaticOrder S; S.init(NTOK, NP, F.G, F.bid); pg8::EpiBf16 E{(bf16*)(ws + WS_PROJ), NP};
              pg8::gemm_phase<pg8::EpiBf16, pg8::StaticOrder>(F.lds + RING_OFF, g, S, E, F.tid); }
            { LAUNDER_WS; pg8::Gemm g{(const bf16*)(ws + WS_PBF), (const bf16*)(ws + WS_W_PLEP) + (size_t)layer * 1024 * 256, 256, 256, 256}; pg8::StaticOrder S; S.init(NTOK, 1024, F.G, F.bid); pg8::EpiBf16 E{(bf16*)(ws + WS_PP), 1024};
              pg8::gemm_phase<pg8::EpiBf16, pg8::StaticOrder>(F.lds + RING_OFF, g, S, E, F.tid); }
            ENDSTEP(sb + 1);
        }
        if constexpr (even) {
            STEP(sb + 2) if constexpr (EN(2)) { FRAME; phase_even_post(F, j, DRY(sb + 2)); ENDSTEP(sb + 2); }
            STEP(sb + 3) if constexpr (EN(3)) { FRAME;
#ifndef NO_QUP
                { LAUNDER_WS; pg8::Gemm g{(const bf16*)(ws + WS_CQN), (const bf16*)(ws + WS_W_QUP) + (size_t)j * 768 * 384, 384, 384, 384}; pg8::StaticOrder S; S.init(NTOK, 768, F.G, F.bid); pg8::EpiBf16 E{(bf16*)(ws + WS_QM), 768};
                  pg8::gemm_phase<pg8::EpiBf16, pg8::StaticOrder>(F.lds + RING_OFF, g, S, E, F.tid); }
#endif
#ifndef NO_KVUP
                { LAUNDER_WS; pg8::Gemm g{(const bf16*)(ws + WS_CKVN), (const bf16*)(ws + WS_W_KVUP) + (size_t)j * 1024 * 256, 256, 256, 256}; pg8::StaticOrder S; S.init(NTOK, 1024, F.G, F.bid); pg8::EpiBf16 E{(bf16*)(ws + WS_KVB), 1024};
                  pg8::gemm_phase<pg8::EpiBf16, pg8::StaticOrder>(F.lds + RING_OFF, g, S, E, F.tid); }
#endif
#ifndef NO_CUMSUM
                phase_cumsum(F);
#endif
                ENDSTEP(sb + 3);
            }
            STEP(sb + 4) if constexpr (EN(4)) { FRAME; phase_mla_post(F, j, DRY(sb + 4)); ENDSTEP(sb + 4); }
            STEP(sb + 5) if constexpr (EN(5)) { FRAME;
#ifdef ATTN_NAIVE
                phase_attn_naive(F);
#else
                phase_attn_mfma(F, j);
#endif
                ENDSTEP(sb + 5); }
        } else {
            STEP(sb + 2) if constexpr (EN(2)) { FRAME; s5_repack(F);
#ifdef GDN_NAIVE
                phase_gdn_prep(F, j);
#else
                phase_gdn_g1(F, j);
#endif
                ENDSTEP(sb + 2); }
            STEP(sb + 3) if constexpr (EN(3)) { FRAME;
                { pg8::Gemm g{(const bf16*)(ws + WS_S5_AX), (const bf16*)(ws + WS_S5_PT), 1024, 1152, 1024}; S5POrder S{F.G, F.bid}; S5PEpi E{(float*)(ws + WS_S5_XLOC)};
                  pg8::gemm_phase<S5PEpi, S5POrder>(F.lds + RING_OFF, g, S, E, F.tid); }
#ifdef GDN_NAIVE
                phase_gdn_naive(F);
#else
                phase_gdn_g2(F);
#endif
                ENDSTEP(sb + 3);
            }
            STEP(sb + 4) if constexpr (EN(4)) { FRAME; s5_scan(F, j);
#ifdef GDN_NAIVE
                phase_gdn_out(F, j);
#else
                phase_gdn_out2(F, j);
#endif
                ENDSTEP(sb + 4); }
            STEP(sb + 5) if constexpr (EN(5)) { FRAME;
                pg8::Gemm g{(const bf16*)(ws + WS_S5_AX), (const bf16*)(ws + WS_S5_MT), 1152, 1152, 1152}; S5MOrder S{F.G, F.bid}; S5MEpi E{(bf16*)(ws + WS_HG), (const bf16*)(ws + WS_PROJ), kin(I_S5_D) + j * 512};
                pg8::gemm_phase<S5MEpi, S5MOrder>(F.lds + RING_OFF, g, S, E, F.tid);
                ENDSTEP(sb + 5);
            }
            STEP(sb + 6) if constexpr (EN(6)) { FRAME;
                pg8::Gemm g{(const bf16*)(ws + WS_HG), (const bf16*)(ws + WS_W_GLU) + (size_t)j * 512 * 512, 512, 512, 512}; pg8::StaticOrder S; S.init(NTOK, 512, F.G, F.bid);
                pg8::EpiGlu E{(bf16*)(ws + WS_MIX), 1024, (const bf16*)(ws + WS_HG), 512, kin(I_S5_BGLU) + j * 512};
                pg8::gemm_phase<pg8::EpiGlu, pg8::StaticOrder>(F.lds + RING_OFF, g, S, E, F.tid);
                ENDSTEP(sb + 6);
            }
        }
        STEP(sb + 7) if constexpr (EN(7)) { FRAME;
            LAUNDER_WS; const bf16* W = even ? (const bf16*)(ws + WS_W_EVOUT) + (size_t)j * 1024 * 1024 : (const bf16*)(ws + WS_W_ODOUT) + (size_t)j * 1024 * 1024;
            pg8::Gemm g{(const bf16*)(ws + WS_MIX), W, 1024, 1024, 1024}; pg8::StaticOrder S; S.init(NTOK, 1024, F.G, F.bid); pg8::EpiResAdd E{DRY(sb + 7) ? (float*)(ws + WS_DUMMY) : kout(), 1024};
            pg8::gemm_phase<pg8::EpiResAdd, pg8::StaticOrder>(F.lds + RING_OFF, g, S, E, F.tid);
            ENDSTEP(sb + 7);
        }
        STEP(sb + 8) if constexpr (EN(8)) { FRAME; phase_router(F, layer, DRY(sb + 8)); ENDSTEP(sb + 8); }
        STEP(sb + 9) if constexpr (EN(9)) { FRAME; phase_moe_scatter(F, layer); ENDSTEP(sb + 9); }
        STEP(sb + 10) if constexpr (EN(10)) { FRAME;
            LAUNDER_WS; moe_tables(F, layer);
            const LAS int* rowbase = (const LAS int*)(F.lds + LDSCTL_OFF + LC_MOE);
            MoeOrder S{__builtin_amdgcn_readfirstlane(rowbase[34]), 4, F.G, F.bid, (const LAS unsigned char*)(F.lds + LDSCTL_OFF + LC_MOE + 192), (size_t)1024 * 1024 * 2};
            pg8::Gemm g{(const bf16*)(ws + WS_XG), (const bf16*)(ws + WS_W_MOEGU), 1024, 1024, 1024}; pg8::EpiSwiglu E{(bf16*)(ws + WS_HB), 512};
            pg8::gemm_phase<pg8::EpiSwiglu, MoeOrder>(F.lds + RING_OFF, g, S, E, F.tid);
            ENDSTEP(sb + 10);
        }
        STEP(sb + 11) if constexpr (EN(11)) { FRAME;
            LAUNDER_WS; moe_tables(F, layer);
            const LAS int* rowbase = (const LAS int*)(F.lds + LDSCTL_OFF + LC_MOE);
            MoeOrder S{__builtin_amdgcn_readfirstlane(rowbase[34]), 4, F.G, F.bid, (const LAS unsigned char*)(F.lds + LDSCTL_OFF + LC_MOE + 192), (size_t)1024 * 512 * 2};
            pg8::Gemm g{(const bf16*)(ws + WS_HB), (const bf16*)(ws + WS_W_MOED), 512, 512, 512}; pg8::EpiBf16 E{(bf16*)(ws + WS_Y2), 1024};
            pg8::gemm_phase<pg8::EpiBf16, MoeOrder>(F.lds + RING_OFF, g, S, E, F.tid);
            ENDSTEP(sb + 11);
        }
        STEP(sb + 12) if constexpr (EN(12)) { FRAME; phase_moe_combine(F, layer, DRY(sb + 12)); ENDSTEP(sb + 12); }
        STEP(sb + 13) if constexpr (EN(13)) { FRAME;
            LAUNDER_WS; pg8::Gemm g{(const bf16*)(ws + WS_ABF), (const bf16*)(ws + WS_W_PLEG) + (size_t)layer * 1024 * 1024, 1024, 1024, 1024}; pg8::StaticOrder S; S.init(NTOK, 1024, F.G, F.bid);
            pg8::EpiPle E{DRY(sb + 13) ? (float*)(ws + WS_DUMMY) : kout(), (const bf16*)(ws + WS_PP), kin(I_PLE_BG) + layer * DM, 1024};
            pg8::gemm_phase<pg8::EpiPle, pg8::StaticOrder>(F.lds + RING_OFF, g, S, E, F.tid);
            ENDSTEP(sb + 13);
        }
    }
__global__ void __launch_bounds__(NWAVES * 64, 2) mega_fwd(KArgs ka) {
    extern __shared__ __attribute__((aligned(16))) unsigned char lds_raw[];
    const Args& args = ka.a;
    LAS unsigned char* const lds0 = (LAS unsigned char*)lds_raw;
    const int wave0 = __builtin_amdgcn_readfirstlane((int)threadIdx.x >> 6);
    for (int u = threadIdx.x; u < (LDS_BYTES - LDSCTL_OFF) / 4; u += NWAVES * 64) ((LAS unsigned*)(lds0 + LDSCTL_OFF))[u] = 0u;
    __syncthreads();
    XcdBarrier bar = xcd_barrier_post((unsigned*)(kws() + WS_CTL) + CW_BAR + ka.li * XCD_BAR_WORDS, (volatile LAS unsigned*)(lds0 + LDSCTL_OFF + LC_BARST));
    const int lo = args.ph_lo, hi = args.ph_hi;
    STEP(0) if constexpr (EN(15)) { FRAME; prologue_weights(F); ENDSTEP(0); }
    layer_body<0>(bar, lo, hi, lds0, wave0); layer_body<1>(bar, lo, hi, lds0, wave0); layer_body<2>(bar, lo, hi, lds0, wave0); layer_body<3>(bar, lo, hi, lds0, wave0);
#undef STEP
#undef ENDSTEP
}

#ifndef MK_MODE
#define MK_MODE 0
#endif
extern "C" void kernel_launch(void* const* d_in, const int* in_sizes, int n_in, void* d_out, int out_size, void* d_ws, size_t ws_size, hipStream_t stream) {
    static int ready = 0;
    if (ready == 0) {
        if (n_in != N_IN || out_size != NTOK * DM || ws_size < WS_END) { fprintf(stderr, "kernel_launch: unexpected shapes n_in %d out %d ws %zu (need %zu)\n", n_in, out_size, ws_size, (size_t)WS_END); ready = -1; return; }
        if (hipFuncSetAttribute((const void*)mega_fwd, hipFuncAttributeMaxDynamicSharedMemorySize, LDS_BYTES) != hipSuccess) { fprintf(stderr, "kernel_launch: hipFuncSetAttribute failed\n"); ready = -1; return; }
        int per_cu = 0; (void)hipOccupancyMaxActiveBlocksPerMultiprocessor(&per_cu, (const void*)mega_fwd, NWAVES * 64, LDS_BYTES); (void)hipGetLastError();
        ready = 1;
    }
    if (ready < 0) return;
    (void)hipMemsetAsync((char*)d_ws + WS_CTL, 0, CTL_ZERO_BYTES, stream);
    KArgs ka{};
    for (int i = 0; i < N_IN; ++i) ka.a.in[i] = (const float*)d_in[i];
    ka.a.out = (float*)d_out; ka.a.ws = (unsigned char*)d_ws; ka.li = 0; ka.pad = 0;
    const int grid = 256;
#if MK_MODE == 1
    ka.a.ph_lo = 0; ka.a.ph_hi = STEP_END;
    hipLaunchKernelGGL(mega_fwd, dim3(grid), dim3(NWAVES * 64), LDS_BYTES, stream, ka);
#else
    for (int s = 0; s < STEP_END; ++s) {
        if (s > 0) { const int k = (s - 1) % LSTEPS, layer = (s - 1) / LSTEPS; const bool even = (layer & 1) == 0;
            if (k > 13) continue; if (k == 6 && even) continue; }
        ka.a.ph_lo = s; ka.a.ph_hi = s + 1;
        hipLaunchKernelGGL(mega_fwd, dim3(grid), dim3(NWAVES * 64), LDS_BYTES, stream, ka);
    }
#endif
}
```

```cpp
#include <hip/hip_runtime.h>
#include <cstdio>
#include <cstdint>
#define MK_MODE 1
#define ATTN_V2 1
namespace pg8 {
#define PG8_LAS __attribute__((address_space(3)))
typedef unsigned short bf16_t;
typedef short bf16x8 __attribute__((ext_vector_type(8)));
typedef float f32x4 __attribute__((ext_vector_type(4)));
typedef float f32x2 __attribute__((ext_vector_type(2)));
typedef unsigned u32x4 __attribute__((ext_vector_type(4)));
typedef unsigned u32x2 __attribute__((ext_vector_type(2)));
constexpr int BM = 256, BK = 64, HALF = 128, HTB = HALF * BK * 2  , STAGE_BYTES = 8 * HTB, NXCD = 8, WGM = 8;

__host__ __device__ __forceinline__ int lds_byte(int r, int c) { const int st = (r >> 4) * 2 + (c >> 5), rr = r & 15, cc = c & 31, ob = rr * 64 + cc * 2; return st * 1024 + (ob ^ (((ob >> 9) & 1) << 5)); }
__host__ __device__ __forceinline__ void stage_rc(int b, int& R, int& C) { const int st = b / 1024, sb = b % 1024, swz = sb ^ (((sb >> 9) & 1) << 5); R = (st >> 1) * 16 + swz / 64; C = (st & 1) * 32 + (swz % 64) / 2; }
__host__ __device__ __forceinline__ int perm32(int rho) { const int n = rho >> 4, i = rho & 15; return 8 * (i >> 2) + 4 * n + (i & 3); }

struct Unit { int pm, pn, aux; };
struct Gemm { const bf16_t* A; const bf16_t* Bt; int K, lda, ldb; };

struct StaticOrder {
    int nM, nN, nwg, G, c;
    __device__ void init(int M, int N, int G_, int c_) { nM = M / BM; nN = N / BM; nwg = nM * nN; G = G_; c = c_; }
    __device__ bool next(int i, Unit& u) const {
        const long L = (long)i * G + c; if (L >= nwg) return false;
        int wgid = (int)L; { const int q = nwg / NXCD, r = nwg % NXCD, xcd = wgid % NXCD, off = wgid / NXCD; wgid = (xcd < r ? xcd * (q + 1) : r * (q + 1) + (xcd - r) * q) + off; }
        const int nig = WGM * nN, gid = wgid / nig, fm = gid * WGM, gsz = (nM - fm) < WGM ? (nM - fm) : WGM;
        u.pm = fm + ((wgid % nig) % gsz); u.pn = (wgid % nig) / gsz; u.aux = 0; return true;
    }
    __device__ __forceinline__ const char* a_base(const Gemm& g, const Unit& u) const { return (const char*)g.A + (size_t)u.pm * BM * g.lda * 2; }
    __device__ __forceinline__ const char* b_base(const Gemm& g, const Unit& u) const { return (const char*)g.Bt + (size_t)u.pn * BM * g.ldb * 2; }
};

__device__ __forceinline__ unsigned cvt_pk_bf16(float lo, float hi) { unsigned r; asm volatile("v_cvt_pk_bf16_f32 %0, %1, %2" : "=v"(r) : "v"(lo), "v"(hi)); return r; }
__device__ __forceinline__ float bf_lo(unsigned w) { return __uint_as_float(w << 16); }
__device__ __forceinline__ float bf_hi(unsigned w) { return __uint_as_float(w & 0xffff0000u); }

struct EpiBf16 {
    static constexpr bool PERM = true;
    bf16_t* O; int ldc;
    __device__ __forceinline__ void operator()(const f32x4 (&acc)[2][2][4][2], const Unit& u, int wr, int wc, int fr, int fq) const {
        const int row0 = u.pm * BM + wr * 64 + fr; const int col0 = u.pn * BM + wc * 32 + 8 * fq;
#pragma unroll
        for (int ai = 0; ai < 2; ++ai)
#pragma unroll
            for (int m = 0; m < 4; ++m) { bf16_t* rowp = O + (size_t)(row0 + ai * HALF + m * 16) * ldc + col0;
#pragma unroll
                for (int bj = 0; bj < 2; ++bj) { const f32x4 v0 = acc[ai][bj][m][0], v1 = acc[ai][bj][m][1];
                    u32x4 w; w.x = cvt_pk_bf16(v0[0], v0[1]); w.y = cvt_pk_bf16(v0[2], v0[3]); w.z = cvt_pk_bf16(v1[0], v1[1]); w.w = cvt_pk_bf16(v1[2], v1[3]);
                    *(u32x4*)(rowp + bj * HALF) = w; } }
    }
};
struct EpiResAdd {
    static constexpr bool PERM = true;
    bf16_t* H; int ldc;
    __device__ __forceinline__ void operator()(const f32x4 (&acc)[2][2][4][2], const Unit& u, int wr, int wc, int fr, int fq) const {
        const int row0 = u.pm * BM + wr * 64 + fr; const int col0 = u.pn * BM + wc * 32 + 8 * fq;
#pragma unroll
        for (int ai = 0; ai < 2; ++ai) { u32x4 t[4][2];
#pragma unroll
            for (int m = 0; m < 4; ++m)
#pragma unroll
                for (int bj = 0; bj < 2; ++bj) t[m][bj] = *(const u32x4*)(H + (size_t)(row0 + ai * HALF + m * 16) * ldc + col0 + bj * HALF);
#pragma unroll
            for (int m = 0; m < 4; ++m)
#pragma unroll
                for (int bj = 0; bj < 2; ++bj) { const u32x4 h = t[m][bj]; const f32x4 v0 = acc[ai][bj][m][0], v1 = acc[ai][bj][m][1];
                    u32x4 w; w.x = cvt_pk_bf16(bf_lo(h.x) + v0[0], bf_hi(h.x) + v0[1]); w.y = cvt_pk_bf16(bf_lo(h.y) + v0[2], bf_hi(h.y) + v0[3]); w.z = cvt_pk_bf16(bf_lo(h.z) + v1[0], bf_hi(h.z) + v1[1]); w.w = cvt_pk_bf16(bf_lo(h.w) + v1[2], bf_hi(h.w) + v1[3]);
                    *(u32x4*)(H + (size_t)(row0 + ai * HALF + m * 16) * ldc + col0 + bj * HALF) = w; } }
    }
};
__device__ __forceinline__ float sigmoidf_(float x) { return __builtin_amdgcn_rcpf(1.0f + __expf(-x)); }
struct EpiPle {
    static constexpr bool PERM = true;
    bf16_t* H; const bf16_t* PP; const float* bias; int ldc; float* OUT;
    __device__ __forceinline__ void operator()(const f32x4 (&acc)[2][2][4][2], const Unit& u, int wr, int wc, int fr, int fq) const {
        const int row0 = u.pm * BM + wr * 64 + fr; const int col0 = u.pn * BM + wc * 32 + 8 * fq;
        f32x4 bv[2][2];
#pragma unroll
        for (int bj = 0; bj < 2; ++bj)
#pragma unroll
            for (int n = 0; n < 2; ++n) bv[bj][n] = *(const f32x4*)(bias + col0 + bj * HALF + 4 * n);
#pragma unroll
        for (int ai = 0; ai < 2; ++ai)
#pragma unroll
            for (int mp = 0; mp < 2; ++mp) { u32x4 th[2][2], tp[2][2];
#pragma unroll
                for (int mm = 0; mm < 2; ++mm)
#pragma unroll
                    for (int bj = 0; bj < 2; ++bj) { const size_t o = (size_t)(row0 + ai * HALF + (2 * mp + mm) * 16) * ldc + col0 + bj * HALF; th[mm][bj] = *(const u32x4*)(H + o); tp[mm][bj] = *(const u32x4*)(PP + o); }
#pragma unroll
                for (int mm = 0; mm < 2; ++mm)
#pragma unroll
                    for (int bj = 0; bj < 2; ++bj) { const size_t o = (size_t)(row0 + ai * HALF + (2 * mp + mm) * 16) * ldc + col0 + bj * HALF; const u32x4 h = th[mm][bj], q = tp[mm][bj];
                        const f32x4 a0 = acc[ai][bj][2 * mp + mm][0] + bv[bj][0], a1 = acc[ai][bj][2 * mp + mm][1] + bv[bj][1];
                        const float r0 = bf_lo(h.x) + sigmoidf_(a0[0]) * bf_lo(q.x), r1 = bf_hi(h.x) + sigmoidf_(a0[1]) * bf_hi(q.x), r2 = bf_lo(h.y) + sigmoidf_(a0[2]) * bf_lo(q.y), r3 = bf_hi(h.y) + sigmoidf_(a0[3]) * bf_hi(q.y);
                        const float r4 = bf_lo(h.z) + sigmoidf_(a1[0]) * bf_lo(q.z), r5 = bf_hi(h.z) + sigmoidf_(a1[1]) * bf_hi(q.z), r6 = bf_lo(h.w) + sigmoidf_(a1[2]) * bf_lo(q.w), r7 = bf_hi(h.w) + sigmoidf_(a1[3]) * bf_hi(q.w);
                        if (OUT) { *(f32x4*)(OUT + o) = (f32x4){r0, r1, r2, r3}; *(f32x4*)(OUT + o + 4) = (f32x4){r4, r5, r6, r7}; }
                        else { u32x4 w; w.x = cvt_pk_bf16(r0, r1); w.y = cvt_pk_bf16(r2, r3); w.z = cvt_pk_bf16(r4, r5); w.w = cvt_pk_bf16(r6, r7); *(u32x4*)(H + o) = w; } } }
    }
};
struct EpiGlu {
    static constexpr bool PERM = true;
    bf16_t* O; int ldo; const bf16_t* HG; int ldh; const float* bias;
    __device__ __forceinline__ void operator()(const f32x4 (&acc)[2][2][4][2], const Unit& u, int wr, int wc, int fr, int fq) const {
        const int row0 = u.pm * BM + wr * 64 + fr; const int col0 = u.pn * BM + wc * 32 + 8 * fq;
#pragma unroll
        for (int ai = 0; ai < 2; ++ai)
#pragma unroll
            for (int m = 0; m < 4; ++m) { const size_t r = (size_t)(row0 + ai * HALF + m * 16);
#pragma unroll
                for (int bj = 0; bj < 2; ++bj) { const int c = col0 + bj * HALF; const u32x4 hw = *(const u32x4*)(HG + r * ldh + c);
                    const f32x4 b0 = *(const f32x4*)(bias + c), b1 = *(const f32x4*)(bias + c + 4); const f32x4 v0 = acc[ai][bj][m][0] + b0, v1 = acc[ai][bj][m][1] + b1;
                    u32x4 w; w.x = cvt_pk_bf16(bf_lo(hw.x) * sigmoidf_(v0[0]), bf_hi(hw.x) * sigmoidf_(v0[1])); w.y = cvt_pk_bf16(bf_lo(hw.y) * sigmoidf_(v0[2]), bf_hi(hw.y) * sigmoidf_(v0[3]));
                    w.z = cvt_pk_bf16(bf_lo(hw.z) * sigmoidf_(v1[0]), bf_hi(hw.z) * sigmoidf_(v1[1])); w.w = cvt_pk_bf16(bf_lo(hw.w) * sigmoidf_(v1[2]), bf_hi(hw.w) * sigmoidf_(v1[3]));
                    *(u32x4*)(O + r * ldo + c) = w; } }
    }
};
struct EpiSwiglu {
    static constexpr bool PERM = true;
    bf16_t* HB; int ldc;
    __device__ __forceinline__ void operator()(const f32x4 (&acc)[2][2][4][2], const Unit& u, int wr, int wc, int fr, int fq) const {
        const int row0 = u.pm * BM + wr * 64 + fr; const int col0 = u.pn * HALF + wc * 32 + 8 * fq;
#pragma unroll
        for (int ai = 0; ai < 2; ++ai)
#pragma unroll
            for (int m = 0; m < 4; ++m) { bf16_t* rowp = HB + (size_t)(row0 + ai * HALF + m * 16) * ldc + col0;
                const f32x4 g0 = acc[ai][0][m][0], g1 = acc[ai][0][m][1], u0 = acc[ai][1][m][0], u1 = acc[ai][1][m][1];
                u32x4 w; w.x = cvt_pk_bf16(g0[0] * sigmoidf_(g0[0]) * u0[0], g0[1] * sigmoidf_(g0[1]) * u0[1]); w.y = cvt_pk_bf16(g0[2] * sigmoidf_(g0[2]) * u0[2], g0[3] * sigmoidf_(g0[3]) * u0[3]);
                w.z = cvt_pk_bf16(g1[0] * sigmoidf_(g1[0]) * u1[0], g1[1] * sigmoidf_(g1[1]) * u1[1]); w.w = cvt_pk_bf16(g1[2] * sigmoidf_(g1[2]) * u1[2], g1[3] * sigmoidf_(g1[3]) * u1[3]);
                *(u32x4*)rowp = w; }
    }
};

template <class Epi, class Sched, bool ALIGN_EPI = true, bool SP2 = true>
__device__ __forceinline__ void gemm_phase(PG8_LAS unsigned char* lds, const Gemm g, const Sched& S, const Epi& E, const int tid) {
    const int wid = __builtin_amdgcn_readfirstlane(tid >> 6), lane = tid & 63, wr = wid >> 2, wc = wid & 3, fr = lane & 15, fq = lane >> 4;
    int K = g.K; asm volatile("" : "+s"(K));
    const int nt = K / BK;
    unsigned voffA[2], voffB[2];
#pragma unroll
    for (int i = 0; i < 2; ++i) { int R, C; stage_rc(tid * 16 + i * 8192, R, C); const int Rb = Epi::PERM ? ((R & ~31) + perm32(R & 31)) : R;
        voffA[i] = (unsigned)(R * g.lda + C) * 2u; voffB[i] = (unsigned)(Rb * g.ldb + C) * 2u; }
    const size_t kstep = (size_t)(BK * 2);
    const size_t hstepA = (size_t)HALF * g.lda * 2, hstepB = (size_t)HALF * g.ldb * 2;
    const unsigned ldsw = (unsigned)wid * 1024u;
    const int aoff = lds_byte(wr * 64 + fr, fq * 8), boff = lds_byte(wc * 32 + fr, fq * 8);
#define PG8_SA(b, h) (((b) * 2 + (h)) * HTB)
#define PG8_SB(b, h) ((4 + (b) * 2 + (h)) * HTB)
#define PG8_STAGE(bufoff, gbase, voff) do { _Pragma("unroll") for (int _i = 0; _i < 2; ++_i) \
        __builtin_amdgcn_global_load_lds((const unsigned*)((const char*)(gbase) + (voff)[_i]), (PG8_LAS unsigned*)(lds + (bufoff) + ldsw + _i * 8192), 16, 0, 0); } while (0)
#define PG8_LDA(dst, b, h) do { _Pragma("unroll") for (int m = 0; m < 4; ++m) _Pragma("unroll") for (int k = 0; k < 2; ++k) dst[m][k] = *(const PG8_LAS bf16x8*)(lds + PG8_SA(b, h) + aoff + m * 2048 + k * 1024); } while (0)
#define PG8_LDB(dst, b, h) do { _Pragma("unroll") for (int n = 0; n < 2; ++n) _Pragma("unroll") for (int k = 0; k < 2; ++k) dst[n][k] = *(const PG8_LAS bf16x8*)(lds + PG8_SB(b, h) + boff + n * 2048 + k * 1024); } while (0)
#define PG8_MMA(ai, bj, At, Bt) do { __builtin_amdgcn_s_setprio(1); _Pragma("unroll") for (int m = 0; m < 4; ++m) _Pragma("unroll") for (int n = 0; n < 2; ++n) _Pragma("unroll") for (int k = 0; k < 2; ++k) \
        acc[ai][bj][m][n] = __builtin_amdgcn_mfma_f32_16x16x32_bf16(Bt[n][k], At[m][k], acc[ai][bj][m][n], 0, 0, 0); __builtin_amdgcn_s_setprio(0); } while (0)
#define PG8_WAIT_V(n) asm volatile("s_waitcnt vmcnt(" #n ")" ::: "memory")
#define PG8_WAIT_L(n) asm volatile("s_waitcnt lgkmcnt(" #n ")" ::: "memory")
#define PG8_BAR __builtin_amdgcn_s_barrier()
#define PG8_SCHED __builtin_amdgcn_sched_barrier(0)
    Unit cur, nxt; int ui = 0;
    if (!S.next(0, cur)) return;
    f32x4 acc[2][2][4][2];
#pragma unroll
    for (int a = 0; a < 2; ++a)
#pragma unroll
        for (int b = 0; b < 2; ++b)
#pragma unroll
            for (int m = 0; m < 4; ++m)
#pragma unroll
                for (int n = 0; n < 2; ++n) acc[a][b][m][n] = (f32x4){0.f, 0.f, 0.f, 0.f};
    bf16x8 At[4][2], B0[2][2], B1[2][2];
    const char* cA = S.a_base(g, cur); const char* cB = S.b_base(g, cur);
    if constexpr (SP2) {
        PG8_STAGE(PG8_SB(0, 0), cB, voffB); PG8_STAGE(PG8_SB(0, 1), cB + hstepB, voffB); PG8_STAGE(PG8_SA(0, 0), cA, voffA); PG8_STAGE(PG8_SA(0, 1), cA + hstepA, voffA);
        if (wr == 1) PG8_BAR;
        PG8_WAIT_V(2); PG8_BAR;
        PG8_STAGE(PG8_SB(1, 0), cB + kstep, voffB); PG8_STAGE(PG8_SA(1, 0), cA + kstep, voffA); PG8_STAGE(PG8_SB(1, 1), cB + hstepB + kstep, voffB);
        PG8_WAIT_V(6); PG8_BAR;
    } else {
        PG8_STAGE(PG8_SB(0, 0), cB, voffB); PG8_STAGE(PG8_SA(0, 0), cA, voffA); PG8_STAGE(PG8_SB(0, 1), cB + hstepB, voffB); PG8_STAGE(PG8_SA(0, 1), cA + hstepA, voffA);
        if (wr == 1) PG8_BAR;
        PG8_WAIT_V(4); PG8_BAR;
        PG8_STAGE(PG8_SB(1, 0), cB + kstep, voffB); PG8_STAGE(PG8_SA(1, 0), cA + kstep, voffA); PG8_STAGE(PG8_SB(1, 1), cB + hstepB + kstep, voffB);
        PG8_WAIT_V(6); PG8_BAR;
    }
    for (;;) {
        const bool has_next = S.next(ui + 1, nxt);
        const char* nA = has_next ? S.a_base(g, nxt) : cA; const char* nB = has_next ? S.b_base(g, nxt) : cB;
        for (int t = 0; t < nt; t += 2) {
            const bool last = (t == nt - 2);
            const char* a1 = cA + (size_t)(t + 1) * kstep;
            const char* a2 = last ? nA : cA + (size_t)(t + 2) * kstep; const char* b2 = last ? nB : cB + (size_t)(t + 2) * kstep;
            const char* a3 = a2 + kstep; const char* b3 = b2 + kstep;
            if constexpr (SP2) {
            PG8_LDB(B0, 0, 0); PG8_LDB(B1, 0, 1); PG8_SCHED; PG8_LDA(At, 0, 0); PG8_STAGE(PG8_SA(1, 1), a1 + hstepA, voffA);
            PG8_WAIT_V(8); PG8_WAIT_L(0); PG8_BAR; PG8_MMA(0, 0, At, B0); PG8_MMA(0, 1, At, B1); PG8_BAR; PG8_SCHED;
            PG8_LDA(At, 0, 1); PG8_STAGE(PG8_SB(0, 0), b2, voffB); PG8_STAGE(PG8_SB(0, 1), b2 + hstepB, voffB); PG8_STAGE(PG8_SA(0, 0), a2, voffA);
            PG8_WAIT_V(8); PG8_WAIT_L(0); PG8_BAR; PG8_MMA(1, 0, At, B0); PG8_MMA(1, 1, At, B1); PG8_BAR; PG8_SCHED;
            PG8_LDB(B0, 1, 0); PG8_LDB(B1, 1, 1); PG8_SCHED; PG8_LDA(At, 1, 0); PG8_STAGE(PG8_SA(0, 1), a2 + hstepA, voffA);
            PG8_WAIT_V(8); PG8_WAIT_L(0); PG8_BAR; PG8_MMA(0, 0, At, B0); PG8_MMA(0, 1, At, B1); PG8_BAR; PG8_SCHED;
            PG8_LDA(At, 1, 1); PG8_STAGE(PG8_SB(1, 0), b3, voffB); PG8_STAGE(PG8_SB(1, 1), b3 + hstepB, voffB); PG8_STAGE(PG8_SA(1, 0), a3, voffA);
            PG8_WAIT_V(8); PG8_WAIT_L(0); PG8_BAR; PG8_MMA(1, 0, At, B0); PG8_MMA(1, 1, At, B1); PG8_BAR; PG8_SCHED;
            } else {
            PG8_LDB(B0, 0, 0); PG8_SCHED; PG8_LDA(At, 0, 0); PG8_STAGE(PG8_SA(1, 1), a1 + hstepA, voffA);
            PG8_WAIT_L(8); PG8_BAR; PG8_WAIT_L(0); PG8_MMA(0, 0, At, B0); PG8_BAR; PG8_SCHED;
            PG8_LDB(B1, 0, 1); PG8_STAGE(PG8_SB(0, 0), b2, voffB);
            PG8_BAR; PG8_WAIT_L(0); PG8_MMA(0, 1, At, B1); PG8_BAR;
            PG8_LDA(At, 0, 1); PG8_STAGE(PG8_SA(0, 0), a2, voffA);
            PG8_BAR; PG8_WAIT_L(0); PG8_MMA(1, 0, At, B0); PG8_BAR; PG8_SCHED;
            PG8_STAGE(PG8_SB(0, 1), b2 + hstepB, voffB);
            PG8_WAIT_V(6); PG8_BAR; PG8_MMA(1, 1, At, B1); PG8_BAR;
            PG8_LDB(B0, 1, 0); PG8_SCHED; PG8_LDA(At, 1, 0); PG8_STAGE(PG8_SA(0, 1), a2 + hstepA, voffA);
            PG8_WAIT_L(8); PG8_BAR; PG8_WAIT_L(0); PG8_MMA(0, 0, At, B0); PG8_BAR; PG8_SCHED;
            PG8_LDB(B1, 1, 1); PG8_STAGE(PG8_SB(1, 0), b3, voffB);
            PG8_BAR; PG8_WAIT_L(0); PG8_MMA(0, 1, At, B1); PG8_BAR;
            PG8_LDA(At, 1, 1); PG8_STAGE(PG8_SA(1, 0), a3, voffA);
            PG8_BAR; PG8_WAIT_L(0); PG8_MMA(1, 0, At, B0); PG8_BAR; PG8_SCHED;
            PG8_STAGE(PG8_SB(1, 1), b3 + hstepB, voffB);
            PG8_WAIT_V(6); PG8_BAR; PG8_MMA(1, 1, At, B1); PG8_BAR;
            }
        }
        if constexpr (ALIGN_EPI) { if (wr == 0) PG8_BAR; }
        E(acc, cur, wr, wc, fr, fq);
        if (!has_next) break;
#pragma unroll
        for (int a = 0; a < 2; ++a)
#pragma unroll
            for (int b = 0; b < 2; ++b)
#pragma unroll
                for (int m = 0; m < 4; ++m)
#pragma unroll
                    for (int n = 0; n < 2; ++n) acc[a][b][m][n] = (f32x4){0.f, 0.f, 0.f, 0.f};
        cur = nxt; cA = nA; cB = nB; ++ui;
        if constexpr (ALIGN_EPI) { if (wr == 1) PG8_BAR; }
    }
    PG8_WAIT_V(0);
    if constexpr (!ALIGN_EPI) { if (wr == 0) PG8_BAR; }
    PG8_BAR;
#undef PG8_SA
#undef PG8_SB
#undef PG8_STAGE
#undef PG8_LDA
#undef PG8_LDB
#undef PG8_MMA
#undef PG8_WAIT_V
#undef PG8_WAIT_L
#undef PG8_BAR
#undef PG8_SCHED
}
template <class Epi, class Sched>
__device__ __forceinline__ void gemm_phase_gather(PG8_LAS unsigned char* lds, const Gemm g, const Sched& S, const Epi& E, const int tid) {
    const int wid = __builtin_amdgcn_readfirstlane(tid >> 6), lane = tid & 63, wr = wid >> 2, wc = wid & 3, fr = lane & 15, fq = lane >> 4;
    int K = g.K; asm volatile("" : "+s"(K));
    const int nt = K / BK;
    unsigned voffB[2]; int RA[2]; unsigned CA2[2];
#pragma unroll
    for (int i = 0; i < 2; ++i) { int R, C; stage_rc(tid * 16 + i * 8192, R, C); const int Rb = Epi::PERM ? ((R & ~31) + perm32(R & 31)) : R;
        RA[i] = R; CA2[i] = (unsigned)C * 2u; voffB[i] = (unsigned)(Rb * g.ldb + C) * 2u; }
    unsigned vA0[2], vA1[2], nA0[2], nA1[2];
#define PG8_ROWS(u_, d0, d1) do { _Pragma("unroll") for (int i_ = 0; i_ < 2; ++i_) { d0[i_] = S.a_row(u_, RA[i_]) * (unsigned)(g.lda * 2) + CA2[i_]; d1[i_] = S.a_row(u_, HALF + RA[i_]) * (unsigned)(g.lda * 2) + CA2[i_]; } } while (0)
    const size_t kstep = (size_t)(BK * 2);
    const size_t hstepA = (size_t)HALF * g.lda * 2, hstepB = (size_t)HALF * g.ldb * 2;
    const unsigned ldsw = (unsigned)wid * 1024u;
    const int aoff = lds_byte(wr * 64 + fr, fq * 8), boff = lds_byte(wc * 32 + fr, fq * 8);
#define PG8_SA(b, h) (((b) * 2 + (h)) * HTB)
#define PG8_SB(b, h) ((4 + (b) * 2 + (h)) * HTB)
#define PG8_STAGE(bufoff, gbase, voff) do { _Pragma("unroll") for (int _i = 0; _i < 2; ++_i) \
        __builtin_amdgcn_global_load_lds((const unsigned*)((const char*)(gbase) + (voff)[_i]), (PG8_LAS unsigned*)(lds + (bufoff) + ldsw + _i * 8192), 16, 0, 0); } while (0)
#define PG8_LDA(dst, b, h) do { _Pragma("unroll") for (int m = 0; m < 4; ++m) _Pragma("unroll") for (int k = 0; k < 2; ++k) dst[m][k] = *(const PG8_LAS bf16x8*)(lds + PG8_SA(b, h) + aoff + m * 2048 + k * 1024); } while (0)
#define PG8_LDB(dst, b, h) do { _Pragma("unroll") for (int n = 0; n < 2; ++n) _Pragma("unroll") for (int k = 0; k < 2; ++k) dst[n][k] = *(const PG8_LAS bf16x8*)(lds + PG8_SB(b, h) + boff + n * 2048 + k * 1024); } while (0)
#define PG8_MMA(ai, bj, At, Bt) do { __builtin_amdgcn_s_setprio(1); _Pragma("unroll") for (int m = 0; m < 4; ++m) _Pragma("unroll") for (int n = 0; n < 2; ++n) _Pragma("unroll") for (int k = 0; k < 2; ++k) \
        acc[ai][bj][m][n] = __builtin_amdgcn_mfma_f32_16x16x32_bf16(Bt[n][k], At[m][k], acc[ai][bj][m][n], 0, 0, 0); __builtin_amdgcn_s_setprio(0); } while (0)
#define PG8_WAIT_V(n) asm volatile("s_waitcnt vmcnt(" #n ")" ::: "memory")
#define PG8_WAIT_L(n) asm volatile("s_waitcnt lgkmcnt(" #n ")" ::: "memory")
#define PG8_BAR __builtin_amdgcn_s_barrier()
#define PG8_SCHED __builtin_amdgcn_sched_barrier(0)
    Unit cur, nxt; int ui = 0;
    if (!S.next(0, cur)) return;
    f32x4 acc[2][2][4][2];
#pragma unroll
    for (int a = 0; a < 2; ++a)
#pragma unroll
        for (int b = 0; b < 2; ++b)
#pragma unroll
            for (int m = 0; m < 4; ++m)
#pragma unroll
                for (int n = 0; n < 2; ++n) acc[a][b][m][n] = (f32x4){0.f, 0.f, 0.f, 0.f};
    bf16x8 At[4][2], B0[2][2], B1[2][2];
    const char* cA = (const char*)g.A; const char* cB = S.b_base(g, cur);
    PG8_ROWS(cur, vA0, vA1);
    if constexpr (true) {
        PG8_STAGE(PG8_SB(0, 0), cB, voffB); PG8_STAGE(PG8_SB(0, 1), cB + hstepB, voffB); PG8_STAGE(PG8_SA(0, 0), cA, vA0); PG8_STAGE(PG8_SA(0, 1), cA, vA1);
        if (wr == 1) PG8_BAR;
        PG8_WAIT_V(2); PG8_BAR;
        PG8_STAGE(PG8_SB(1, 0), cB + kstep, voffB); PG8_STAGE(PG8_SA(1, 0), cA + kstep, vA0); PG8_STAGE(PG8_SB(1, 1), cB + hstepB + kstep, voffB);
        PG8_WAIT_V(6); PG8_BAR;
    }
    for (;;) {
        const bool has_next = S.next(ui + 1, nxt);
        const char* nA = (const char*)g.A; const char* nB = has_next ? S.b_base(g, nxt) : cB;
        if (has_next) PG8_ROWS(nxt, nA0, nA1); else { nA0[0] = vA0[0]; nA0[1] = vA0[1]; nA1[0] = vA1[0]; nA1[1] = vA1[1]; }
        for (int t = 0; t < nt; t += 2) {
            const bool last = (t == nt - 2);
            const char* a1 = cA + (size_t)(t + 1) * kstep;
            const char* a2 = last ? nA : cA + (size_t)(t + 2) * kstep; const char* b2 = last ? nB : cB + (size_t)(t + 2) * kstep;
            const char* a3 = a2 + kstep; const char* b3 = b2 + kstep;
            unsigned sA0[2], sA1[2]; sA0[0] = last ? nA0[0] : vA0[0]; sA0[1] = last ? nA0[1] : vA0[1]; sA1[0] = last ? nA1[0] : vA1[0]; sA1[1] = last ? nA1[1] : vA1[1];
            if constexpr (true) {
            PG8_LDB(B0, 0, 0); PG8_LDB(B1, 0, 1); PG8_SCHED; PG8_LDA(At, 0, 0); PG8_STAGE(PG8_SA(1, 1), a1, vA1);
            PG8_WAIT_V(8); PG8_WAIT_L(0); PG8_BAR; PG8_MMA(0, 0, At, B0); PG8_MMA(0, 1, At, B1); PG8_BAR; PG8_SCHED;
            PG8_LDA(At, 0, 1); PG8_STAGE(PG8_SB(0, 0), b2, voffB); PG8_STAGE(PG8_SB(0, 1), b2 + hstepB, voffB); PG8_STAGE(PG8_SA(0, 0), a2, sA0);
            PG8_WAIT_V(8); PG8_WAIT_L(0); PG8_BAR; PG8_MMA(1, 0, At, B0); PG8_MMA(1, 1, At, B1); PG8_BAR; PG8_SCHED;
            PG8_LDB(B0, 1, 0); PG8_LDB(B1, 1, 1); PG8_SCHED; PG8_LDA(At, 1, 0); PG8_STAGE(PG8_SA(0, 1), a2, sA1);
            PG8_WAIT_V(8); PG8_WAIT_L(0); PG8_BAR; PG8_MMA(0, 0, At, B0); PG8_MMA(0, 1, At, B1); PG8_BAR; PG8_SCHED;
            PG8_LDA(At, 1, 1); PG8_STAGE(PG8_SB(1, 0), b3, voffB); PG8_STAGE(PG8_SB(1, 1), b3 + hstepB, voffB); PG8_STAGE(PG8_SA(1, 0), a3, sA0);
            PG8_WAIT_V(8); PG8_WAIT_L(0); PG8_BAR; PG8_MMA(1, 0, At, B0); PG8_MMA(1, 1, At, B1); PG8_BAR; PG8_SCHED;
            }
        }
        if constexpr (true) { if (wr == 0) PG8_BAR; }
        E(acc, cur, wr, wc, fr, fq);
        if (!has_next) break;
#pragma unroll
        for (int a = 0; a < 2; ++a)
#pragma unroll
            for (int b = 0; b < 2; ++b)
#pragma unroll
                for (int m = 0; m < 4; ++m)
#pragma unroll
                    for (int n = 0; n < 2; ++n) acc[a][b][m][n] = (f32x4){0.f, 0.f, 0.f, 0.f};
        cur = nxt; cB = nB; ++ui; vA0[0] = nA0[0]; vA0[1] = nA0[1]; vA1[0] = nA1[0]; vA1[1] = nA1[1];
        if constexpr (true) { if (wr == 1) PG8_BAR; }
    }
    PG8_WAIT_V(0);
    if constexpr (false) { if (wr == 0) PG8_BAR; }
    PG8_BAR;
#undef PG8_ROWS
#undef PG8_SA
#undef PG8_SB
#undef PG8_STAGE
#undef PG8_LDA
#undef PG8_LDB
#undef PG8_MMA
#undef PG8_WAIT_V
#undef PG8_WAIT_L
#undef PG8_BAR
#undef PG8_SCHED
}
}
#define LAS __attribute__((address_space(3)))
#define XB_TMO      128
#define XB_XCNT(j)  (256  + 64 * (j))
#define XB_XSUB(j)  (1280 + 64 * (j))
#define XB_XGEN(j)  (2304 + 64 * (j))
#define XB_TOP      3328
#define XB_TOPGEN   3392
#define XCD_BAR_WORDS 3456
#define XB_SPIN_CAP (1u << 22)

__device__ __forceinline__ unsigned xb_ld(unsigned* p)              { return __hip_atomic_load(p, __ATOMIC_RELAXED, __HIP_MEMORY_SCOPE_AGENT); }
__device__ __forceinline__ unsigned xb_add(unsigned* p, unsigned v) { return __hip_atomic_fetch_add(p, v, __ATOMIC_RELAXED, __HIP_MEMORY_SCOPE_AGENT); }
__device__ __forceinline__ unsigned xb_xcc_id() { return (unsigned)__builtin_amdgcn_s_getreg((3 << 11) | 20) & 0xFu; }
#define XB_SPIN(cond, bar) do { unsigned _sp = 0; while (cond) { __builtin_amdgcn_s_sleep(1); \
    if ((++_sp & 255u) == 0u) { if (xb_ld(&(bar)[XB_TMO])) break; if (_sp > XB_SPIN_CAP) { atomicAdd(&(bar)[XB_TMO], 1u); break; } } } } while (0)

struct XcdBarrier {
    unsigned* bar; unsigned x;
    volatile LAS unsigned* st;
};

__device__ __forceinline__ XcdBarrier xcd_barrier_post(unsigned* bar, volatile LAS unsigned* st) {
    XcdBarrier b; b.bar = bar; b.x = xb_xcc_id(); b.st = st;
    if (threadIdx.x == 0) (void)xb_add(&bar[XB_XCNT(b.x)], 1u);
    return b;
}
__device__ __forceinline__ void xcd_barrier_complete(unsigned* bar, unsigned x, unsigned& nloc, unsigned& nx) {
    const unsigned G = gridDim.x * gridDim.y * gridDim.z;
    unsigned sum, cnt, mine, sp = 0u;
    for (;;) {
        sum = 0u; cnt = 0u; mine = 0u;
#pragma unroll
        for (unsigned j = 0; j < 16; ++j) { const unsigned c = xb_ld(&bar[XB_XCNT(j)]); sum += c; cnt += (c > 0u) ? 1u : 0u; mine = (j == x) ? c : mine; }
        if (sum == G) break;
        __builtin_amdgcn_s_sleep(1);
        if ((++sp & 255u) == 0u) { if (xb_ld(&bar[XB_TMO])) break; if (sp > XB_SPIN_CAP) { atomicAdd(&bar[XB_TMO], 1u); break; } }
    }
    nloc = mine > 0u ? mine : 1u; nx = cnt > 0u ? cnt : 1u;
}

__device__ __forceinline__ void xcd_barrier(const XcdBarrier& b) {
    asm volatile("s_waitcnt vmcnt(0)" ::: "memory");
    __syncthreads();
    if (threadIdx.x == 0) {
        unsigned* bar = b.bar;
        __builtin_amdgcn_s_waitcnt(0);
        unsigned nloc = b.st[0], nx = b.st[1];
        if (nloc == 0u) { xcd_barrier_complete(bar, b.x, nloc, nx); b.st[0] = nloc; b.st[1] = nx; }
        const unsigned old = xb_add(&bar[XB_XSUB(b.x)], 1u);
        const unsigned gen = old / nloc;
        if (old + 1u == (gen + 1u) * nloc) {
            __builtin_amdgcn_fence(__ATOMIC_RELEASE, "agent");
            asm volatile("s_waitcnt vmcnt(0)" ::: "memory");
            const unsigned og = xb_add(&bar[XB_TOP], 1u);
            const unsigned tg = og / nx;
            if (og + 1u == (tg + 1u) * nx) xb_add(&bar[XB_TOPGEN], 1u);
            else XB_SPIN(xb_ld(&bar[XB_TOPGEN]) == tg, bar);
            __builtin_amdgcn_fence(__ATOMIC_ACQUIRE, "agent");
            xb_add(&bar[XB_XGEN(b.x)], 1u);
            asm volatile("s_waitcnt vmcnt(0)" ::: "memory");
        } else {
            XB_SPIN(xb_ld(&bar[XB_XGEN(b.x)]) == gen, bar);
            __builtin_amdgcn_fence(__ATOMIC_ACQUIRE, "agent");
            asm volatile("s_waitcnt vmcnt(0)" ::: "memory");
        }
    }
    __syncthreads();
}
#undef LAS
constexpr int NWAVES = 8;
constexpr int BATCH = 2, SEQ = 16384, NTOK = BATCH * SEQ, DM = 1024, DEPTH = 4, PLE = 256;
constexpr int EVEN_IN = 2216, EVEN_INP = 2304, ODD_IN = 2568, ODD_INP = 2816;
constexpr int E_FQ = 0, E_FK = 512, E_FV = 1024, E_FLOG = 1536, E_CQ = 1544, E_CKV = 1928, E_KROPE = 2184;
constexpr int O_U = 0, O_Q = 512, O_K = 1024, O_V = 1536, O_GIN = 2048, O_BETA = 2052, O_Z = 2056;
constexpr float RMS_EPS = 1e-6f;
constexpr float LOG2E = 1.4426950408889634f, LN2 = 0.6931471805599453f;
constexpr float C2_FOX = 0.125f * LOG2E, C2_MLA = 0.10206207261596575f * LOG2E;
constexpr int MOE_CAP = 65536 + 32 * 256;
constexpr int MOE_MAXT = MOE_CAP / 256;

enum { I_X = 0, I_P, I_POS, I_NORM_MIX, I_NORM_FFN, I_EV_W_IN, I_FOX_BF, I_FOX_QN, I_FOX_KN, I_MLA_QAN, I_MLA_WQUP, I_MLA_KVAN, I_MLA_WKVUP, I_MLA_QN, I_MLA_KN, I_EV_W_OUT,
       I_OD_W_IN, I_S5_ARE, I_S5_AIM, I_S5_BRE, I_S5_BIM, I_S5_CRE, I_S5_CIM, I_S5_D, I_S5_LS, I_S5_WGLU, I_S5_BGLU, I_GDN_CONV, I_GDN_ALOG, I_GDN_DTB, I_GDN_ONORM, I_OD_W_OUT,
       I_MOE_WGRP, I_MOE_BGRP, I_MOE_WEXP, I_MOE_BEXP, I_MOE_WG, I_MOE_WU, I_MOE_WD, I_PLE_WP, I_PLE_NORM, I_PLE_WG, I_PLE_BG, N_IN };

constexpr size_t MiB = 1u << 20;
constexpr size_t WS_CTL = 0, CTL_ZERO_BYTES = 1 * MiB;
constexpr size_t WS_W_EVIN = 4 * MiB;
constexpr size_t WS_W_ODIN = WS_W_EVIN + 9 * MiB;
constexpr size_t WS_W_QUP = WS_W_ODIN + 11 * MiB;
constexpr size_t WS_W_KVUP = WS_W_QUP + 2 * MiB;
constexpr size_t WS_W_EVOUT = WS_W_KVUP + 1 * MiB;
constexpr size_t WS_W_ODOUT = WS_W_EVOUT + 4 * MiB;
constexpr size_t WS_W_GLU = WS_W_ODOUT + 4 * MiB;
constexpr size_t WS_W_PLEP = WS_W_GLU + 1 * MiB;
constexpr size_t WS_W_PLEG = WS_W_PLEP + 2 * MiB;
constexpr size_t WS_W_MOEGU = WS_W_PLEG + 8 * MiB;
constexpr size_t WS_W_MOED = WS_W_MOEGU + 64 * MiB;
constexpr size_t WS_ABF = WS_W_MOED + 32 * MiB;
constexpr size_t WS_PP = WS_ABF + 64 * MiB;
constexpr size_t WS_PBF = WS_PP + 64 * MiB;
constexpr size_t WS_PROJ = WS_PBF + 16 * MiB;
constexpr size_t WS_MIX = WS_PROJ + 176 * MiB;
constexpr size_t WS_R1 = WS_MIX + 64 * MiB;
constexpr size_t WS_QM = WS_R1, WS_KVB = WS_QM + 48 * MiB, WS_KM = WS_KVB + 64 * MiB, WS_CQN = WS_KM + 48 * MiB, WS_CKVN = WS_CQN + 24 * MiB, WS_LOGF = WS_CKVN + 16 * MiB, WS_CUM = WS_LOGF + 1 * MiB;
constexpr size_t WS_HG = WS_R1, WS_QG = WS_HG + 32 * MiB, WS_KG = WS_QG + 64 * MiB, WS_VG = WS_KG + 64 * MiB, WS_OG = WS_VG + 64 * MiB;
constexpr size_t WS_R2 = WS_R1 + 288 * MiB;
constexpr size_t WS_GB = WS_R2, WS_BETA = WS_GB + 1 * MiB;
constexpr size_t WS_TOKE = WS_R2 + 2 * MiB, WS_TOKW = WS_TOKE + 1 * MiB, WS_ROWS = WS_TOKW + 1 * MiB;
constexpr size_t WS_P2T = WS_R2 + 4 * MiB;
constexpr size_t WS_XG = WS_R1;
constexpr size_t WS_HB = WS_XG + 144 * MiB;
constexpr size_t WS_Y2 = WS_R2 + 8 * MiB;
constexpr size_t WS_END = WS_Y2 + 144 * MiB;
static_assert(WS_HB + 72 * MiB <= WS_R2, "moe overlay");
static_assert(WS_OG + 64 * MiB <= WS_R2, "odd overlay");
constexpr size_t WS_H16 = WS_END;
constexpr size_t WS_DUMMY = WS_H16 + 64 * MiB;
static_assert(WS_DUMMY + 64 * MiB <= 1100 * MiB, "workspace budget");

constexpr int CW_BAR = 4096;
constexpr int CW_CNT = 1024;

constexpr int RING_OFF = 0, RING_BYTES = 131072;
constexpr int LDSCTL_OFF = RING_BYTES;
constexpr int LDS_BYTES = 147456;
constexpr int LC_BARST = 32;
constexpr int LC_MOE = 256;

#define GAS __attribute__((address_space(1)))
#define LAS __attribute__((address_space(3)))
typedef unsigned short bf16;
typedef unsigned v4u __attribute__((ext_vector_type(4)));
typedef unsigned v2u __attribute__((ext_vector_type(2)));
typedef float f32x4 __attribute__((ext_vector_type(4)));
#define LDS_WAIT() asm volatile("s_waitcnt lgkmcnt(0)" ::: "memory")
#define VM_WAIT() asm volatile("s_waitcnt vmcnt(0)" ::: "memory")
typedef float f32x2_pk __attribute__((ext_vector_type(2))); typedef __bf16 bf16x2_pk __attribute__((ext_vector_type(2)));
__device__ __forceinline__ unsigned pk2(float lo, float hi) { f32x2_pk v = {lo, hi}; bf16x2_pk b = __builtin_convertvector(v, bf16x2_pk); return __builtin_bit_cast(unsigned, b); }
__device__ __forceinline__ unsigned f2bf(float f) { return pk2(f, 0.f) & 0xffffu; }
__device__ __forceinline__ float bflo(unsigned w) { return __uint_as_float(w << 16); }
__device__ __forceinline__ float bfhi(unsigned w) { return __uint_as_float(w & 0xffff0000u); }
__device__ __forceinline__ float bf2f(bf16 h) { return __uint_as_float((unsigned)h << 16); }
__device__ __forceinline__ float wave_sum(float v) {
#pragma unroll
    for (int o = 1; o < 64; o <<= 1) v += __shfl_xor(v, o);
    return v;
}
__device__ __forceinline__ float sigm(float x) { return 1.0f / (1.0f + expf(-x)); }
__device__ __forceinline__ float softplusf_(float x) { return fmaxf(x, 0.f) + log1pf(expf(-fabsf(x))); }
__device__ __forceinline__ float gelu_tanh(float x) { return 0.5f * x * (1.0f + tanhf(0.7978845608028654f * (x + 0.044715f * x * x * x))); }

struct Args { const float* in[N_IN]; float* out; unsigned char* ws; int ph_lo, ph_hi; };
#define CAS __attribute__((address_space(4)))
__device__ __forceinline__ const float* kin(int i) { asm volatile("" : "+s"(i)); const CAS char* kp = (const CAS char*)__builtin_amdgcn_kernarg_segment_ptr(); return *(const float* const CAS*)(kp + 8 * i); }
__device__ __forceinline__ float* kout() { int i = N_IN; asm volatile("" : "+s"(i)); const CAS char* kp = (const CAS char*)__builtin_amdgcn_kernarg_segment_ptr(); return *(float* const CAS*)(kp + 8 * i); }
__device__ __forceinline__ unsigned char* kws() { int i = N_IN + 1; asm volatile("" : "+s"(i)); const CAS char* kp = (const CAS char*)__builtin_amdgcn_kernarg_segment_ptr(); return *(unsigned char* const CAS*)(kp + 8 * i); }

struct Frame {
    LAS unsigned char* lds;
    unsigned char* ws;
    unsigned* ctl;
    int tid, lane, wave, G, bid;
};

__device__ __forceinline__ void transpose_load(const float* W, int N, int k0, int n0, int lane, f32x4 (&v)[8]) {
    const int c4 = 4 * (lane & 7), rr = lane >> 3; const bool ok = n0 + c4 + 3 < N;
#pragma unroll
    for (int i = 0; i < 8; ++i) v[i] = ok ? __builtin_nontemporal_load((const f32x4*)(W + (size_t)(k0 + 8 * i + rr) * N + n0 + c4)) : (f32x4){0.f, 0.f, 0.f, 0.f};
}
__device__ __forceinline__ void transpose_store(const f32x4 (&v)[8], int K, bf16* WT, int drow0, LAS float* scr, int k0, int lane) {
    { const int c4 = 4 * (lane & 7), rr = lane >> 3;
#pragma unroll
      for (int i = 0; i < 8; ++i) { LAS float* d = scr + (8 * i + rr) * 33 + c4; d[0] = v[i][0]; d[1] = v[i][1]; d[2] = v[i][2]; d[3] = v[i][3]; } }
    LDS_WAIT(); asm volatile("" ::: "memory");
    const int c = lane & 7;
#pragma unroll
    for (int j = 0; j < 4; ++j) { const int n = (lane >> 3) + 8 * j; const LAS float* s = scr + (8 * c) * 33 + n;
        v4u o; o.x = pk2(s[0 * 33], s[1 * 33]); o.y = pk2(s[2 * 33], s[3 * 33]); o.z = pk2(s[4 * 33], s[5 * 33]); o.w = pk2(s[6 * 33], s[7 * 33]);
        *(v4u*)(WT + (size_t)(drow0 + n) * K + k0 + 8 * c) = o; }
    LDS_WAIT(); asm volatile("" ::: "memory");
}
__device__ __forceinline__ void transpose_item(const float* W, int K, int N, bf16* WT, int drow0, LAS float* scr, int k0, int n0, int lane) {
    f32x4 v[8]; transpose_load(W, N, k0, n0, lane, v); transpose_store(v, K, WT, drow0, scr, k0, lane);
}
__device__ __forceinline__ void transpose_set(Frame& F, const float* W, int nmat, int K, int N, int NP, bf16* WT, int& itbase) {
    LAS float* scr = (LAS float*)(F.lds + RING_OFF + F.wave * 16384);
    const int gw = F.bid * NWAVES + F.wave, NGW = F.G * NWAVES;
    const int nkb = K / 64, nnb = NP / 32, per = nkb * nnb, total = nmat * per;
    int first = (gw - (itbase % NGW) + NGW) % NGW;
    for (int it = first; it < total; it += NGW) { const int mi = it / per, r = it % per, kb = r / nnb, nb = r % nnb;
        transpose_item(W + (size_t)mi * K * N, K, N, WT + (size_t)mi * NP * K, nb * 32, scr, kb * 64, nb * 32, F.lane); }
    itbase += total;
}
__device__ __forceinline__ void prologue_weights(Frame& F) {
 int itb = 0;
    transpose_set(F, kin(I_EV_W_IN), 2, 1024, EVEN_IN, EVEN_INP, (bf16*)(F.ws + WS_W_EVIN), itb);
    transpose_set(F, kin(I_OD_W_IN), 2, 1024, ODD_IN, ODD_INP, (bf16*)(F.ws + WS_W_ODIN), itb);
    transpose_set(F, kin(I_MLA_WQUP), 2, 384, 768, 768, (bf16*)(F.ws + WS_W_QUP), itb);
    transpose_set(F, kin(I_MLA_WKVUP), 2, 256, 1024, 1024, (bf16*)(F.ws + WS_W_KVUP), itb);
    transpose_set(F, kin(I_EV_W_OUT), 2, 1024, 1024, 1024, (bf16*)(F.ws + WS_W_EVOUT), itb);
    transpose_set(F, kin(I_OD_W_OUT), 2, 1024, 1024, 1024, (bf16*)(F.ws + WS_W_ODOUT), itb);
    transpose_set(F, kin(I_S5_WGLU), 2, 512, 512, 512, (bf16*)(F.ws + WS_W_GLU), itb);
    transpose_set(F, kin(I_PLE_WP), 4, 256, 1024, 1024, (bf16*)(F.ws + WS_W_PLEP), itb);
    transpose_set(F, kin(I_PLE_WG), 4, 1024, 1024, 1024, (bf16*)(F.ws + WS_W_PLEG), itb);
}
__device__ __forceinline__ void moe_weights(Frame& F, int layer, int wg0 = 0, int nwg = -1) {
    if (nwg < 0) nwg = F.G; if (F.bid < wg0 || F.bid >= wg0 + nwg) return;
    LAS float* scr = (LAS float*)(F.lds + RING_OFF + F.wave * 16384);
    const int gw = (F.bid - wg0) * NWAVES + F.wave, NGW = nwg * NWAVES;
    const float* wg = kin(I_MOE_WG) + (size_t)layer * 32 * 1024 * 512; const float* wu = kin(I_MOE_WU) + (size_t)layer * 32 * 1024 * 512; const float* wd = kin(I_MOE_WD) + (size_t)layer * 32 * 512 * 1024;
    bf16* WGU = (bf16*)(F.ws + WS_W_MOEGU); bf16* WD = (bf16*)(F.ws + WS_W_MOED);
#define MW_GU(it_, W_, e_, kb_, n0_, drow_) const int which_ = (it_) / (32 * 256), r0_ = (it_) % (32 * 256), e_ = r0_ / 256, r_ = r0_ % 256, kb_ = r_ / 16, n0_ = (r_ % 16) * 32; \
        const int drow_ = 256 * (n0_ / 128) + (n0_ % 128) + which_ * 128; const float* W_ = (which_ ? wu : wg) + (size_t)e_ * 1024 * 512
    { f32x4 v[8]; int it = gw;
      if (it < 2 * 32 * 256) { MW_GU(it, W0, e0, kb0, n00, d0); (void)d0; transpose_load(W0, 512, kb0 * 64, n00, F.lane, v); }
#pragma unroll 1
      for (; it < 2 * 32 * 256; it += NGW) { f32x4 vn[8]; const int itn = it + NGW;
          if (itn < 2 * 32 * 256) { MW_GU(itn, W1, e1, kb1, n01, d1); (void)d1; transpose_load(W1, 512, kb1 * 64, n01, F.lane, vn); }
          { MW_GU(it, W2, e2, kb2, n02, d2); (void)W2; (void)n02; transpose_store(v, 1024, WGU + (size_t)e2 * 1024 * 1024, d2, scr, kb2 * 64, F.lane); }
#pragma unroll
          for (int i = 0; i < 8; ++i) v[i] = vn[i]; } }
#undef MW_GU
    { f32x4 v[8]; int it = gw;
      if (it < 32 * 256) { const int e = it / 256, r = it % 256; transpose_load(wd + (size_t)e * 512 * 1024, 1024, (r / 32) * 64, (r % 32) * 32, F.lane, v); }
#pragma unroll 1
      for (; it < 32 * 256; it += NGW) { f32x4 vn[8]; const int itn = it + NGW;
          if (itn < 32 * 256) { const int e = itn / 256, r = itn % 256; transpose_load(wd + (size_t)e * 512 * 1024, 1024, (r / 32) * 64, (r % 32) * 32, F.lane, vn); }
          { const int e = it / 256, r = it % 256; transpose_store(v, 512, WD + (size_t)e * 1024 * 512, (r % 32) * 32, scr, (r / 32) * 64, F.lane); }
#pragma unroll
          for (int i = 0; i < 8; ++i) v[i] = vn[i]; } }
}

__device__ __forceinline__ void rms_row_to_bf16(const float* xrow, const float* gain, bf16* orow, float* copy, int lane) {
    const f32x4* xr = (const f32x4*)xrow + lane; f32x4 v[4]; float s = 0.f;
#pragma unroll
    for (int j = 0; j < 4; ++j) { v[j] = xr[64 * j]; s += (v[j].x * v[j].x + v[j].y * v[j].y) + (v[j].z * v[j].z + v[j].w * v[j].w); }
    const float r = 1.0f / sqrtf(wave_sum(s) * (1.f / 1024.f) + RMS_EPS);
    if (copy) {
#pragma unroll
        for (int j = 0; j < 4; ++j) ((f32x4*)copy + lane)[64 * j] = v[j]; }
    unsigned long long* o8 = (unsigned long long*)orow + lane;
#pragma unroll
    for (int j = 0; j < 4; ++j) { const f32x4 g = ((const f32x4*)gain + lane)[64 * j];
        o8[64 * j] = (unsigned long long)pk2(v[j].x * r * g.x, v[j].y * r * g.y) | ((unsigned long long)pk2(v[j].z * r * g.z, v[j].w * r * g.w) << 32); }
}
__device__ __forceinline__ void rms_row16_to_bf16(const bf16* xrow, const float* gain, bf16* orow, int lane) {
    float f[16]; float s = 0.f;
#pragma unroll
    for (int j = 0; j < 2; ++j) { const v4u x = ((const v4u*)xrow + lane)[64 * j]; f[8 * j] = bflo(x.x); f[8 * j + 1] = bfhi(x.x); f[8 * j + 2] = bflo(x.y); f[8 * j + 3] = bfhi(x.y); f[8 * j + 4] = bflo(x.z); f[8 * j + 5] = bfhi(x.z); f[8 * j + 6] = bflo(x.w); f[8 * j + 7] = bfhi(x.w); }
#pragma unroll
    for (int i = 0; i < 16; ++i) s += f[i] * f[i];
    const float r = 1.0f / sqrtf(wave_sum(s) * (1.f / 1024.f) + RMS_EPS);
#pragma unroll
    for (int j = 0; j < 2; ++j) { const float* g = gain + 512 * j + 8 * lane; const f32x4 g0 = *(const f32x4*)g, g1 = *(const f32x4*)(g + 4);
        v4u o; o.x = pk2(f[8 * j] * r * g0.x, f[8 * j + 1] * r * g0.y); o.y = pk2(f[8 * j + 2] * r * g0.z, f[8 * j + 3] * r * g0.w); o.z = pk2(f[8 * j + 4] * r * g1.x, f[8 * j + 5] * r * g1.y); o.w = pk2(f[8 * j + 6] * r * g1.z, f[8 * j + 7] * r * g1.w);
        ((v4u*)orow + lane)[64 * j] = o; }
}
__device__ __forceinline__ void phase_norm(Frame& F, const float* x_or_null, const float* gain) {
    bf16* ABF = (bf16*)(F.ws + WS_ABF); bf16* H16 = (bf16*)(F.ws + WS_H16);
    const int gw = F.bid * NWAVES + F.wave, NGW = F.G * NWAVES, lane = F.lane;
    if (x_or_null) {
        for (int m = gw; m < NTOK; m += NGW) { const f32x4* xr = (const f32x4*)(x_or_null + (size_t)m * DM) + lane; f32x4 v[4]; float s = 0.f;
#pragma unroll
            for (int j = 0; j < 4; ++j) { v[j] = xr[64 * j]; s += (v[j].x * v[j].x + v[j].y * v[j].y) + (v[j].z * v[j].z + v[j].w * v[j].w); }
            const float r = 1.0f / sqrtf(wave_sum(s) * (1.f / 1024.f) + RMS_EPS);
            unsigned long long* o8 = (unsigned long long*)(ABF + (size_t)m * DM) + lane; unsigned long long* h8 = (unsigned long long*)(H16 + (size_t)m * DM) + lane;
#pragma unroll
            for (int j = 0; j < 4; ++j) { const f32x4 g = ((const f32x4*)gain + lane)[64 * j];
                h8[64 * j] = (unsigned long long)pk2(v[j].x, v[j].y) | ((unsigned long long)pk2(v[j].z, v[j].w) << 32);
                o8[64 * j] = (unsigned long long)pk2(v[j].x * r * g.x, v[j].y * r * g.y) | ((unsigned long long)pk2(v[j].z * r * g.z, v[j].w * r * g.w) << 32); } }
    } else {
        for (int m = gw; m < NTOK; m += NGW) rms_row16_to_bf16(H16 + (size_t)m * DM, gain, ABF + (size_t)m * DM, lane);
    }
}
__device__ __forceinline__ void phase_pconv(Frame& F, int layer) {
    const float* p = kin(I_P) + (size_t)layer * NTOK * PLE; bf16* PBF = (bf16*)(F.ws + WS_PBF);
    const size_t n4 = (size_t)NTOK * PLE / 4; const size_t gt = (size_t)F.bid * 512 + F.tid, NT = (size_t)F.G * 512;
#pragma unroll 1
    for (size_t i = gt; i < n4; i += 8 * NT) { f32x4 v[8];
#pragma unroll
        for (int q = 0; q < 8; ++q) { const size_t ix = i + q * NT; v[q] = __builtin_nontemporal_load((const f32x4*)p + (ix < n4 ? ix : i)); }
#pragma unroll
        for (int q = 0; q < 8; ++q) { const size_t ix = i + q * NT; if (ix < n4) { v2u o; o.x = pk2(v[q].x, v[q].y); o.y = pk2(v[q].z, v[q].w); ((v2u*)PBF)[ix] = o; } } }
}

__device__ __forceinline__ void phase_even_post(Frame& F, int j, bool dry = false) {

    bf16* PROJ = (bf16*)(F.ws + WS_PROJ); bf16* CQN = (bf16*)(F.ws + WS_CQN); bf16* CKVN = (bf16*)(F.ws + WS_CKVN); float* LOGF = (float*)(F.ws + WS_LOGF);
    const float* qn = kin(I_FOX_QN) + j * 64; const float* kn = kin(I_FOX_KN) + j * 64; const float* bfv = kin(I_FOX_BF) + j * 8;
    const float* qan = kin(I_MLA_QAN) + j * 384; const float* kvan = kin(I_MLA_KVAN) + j * 256;
    const int gw = F.bid * NWAVES + F.wave, NGW = F.G * NWAVES, lane = F.lane;
    float gq_[8], gk_[8], gqa[6], gkv[4];
#pragma unroll
    for (int i = 0; i < 8; ++i) { gq_[i] = qn[(lane & 7) * 8 + i]; gk_[i] = kn[(lane & 7) * 8 + i]; }
#pragma unroll
    for (int i = 0; i < 3; ++i) { gqa[2 * i] = qan[2 * (lane + 64 * i)]; gqa[2 * i + 1] = qan[2 * (lane + 64 * i) + 1]; }
#pragma unroll
    for (int i = 0; i < 2; ++i) { gkv[2 * i] = kvan[2 * (lane + 64 * i)]; gkv[2 * i + 1] = kvan[2 * (lane + 64 * i) + 1]; }
    const float bfl = bfv[lane & 7];
#pragma unroll 1
    for (int m = gw; m < NTOK; m += NGW) {
        bf16* row = PROJ + (size_t)m * EVEN_INP;
        v4u* pq = (v4u*)(row + E_FQ) + lane; v4u* pk = (v4u*)(row + E_FK) + lane;
        const v4u xq = *pq, xk = *pk; const bf16 zl = row[E_FLOG + (lane & 7)];
        unsigned xc[3], xv[2];
#pragma unroll
        for (int i = 0; i < 3; ++i) xc[i] = *((const unsigned*)(row + E_CQ) + lane + 64 * i);
#pragma unroll
        for (int i = 0; i < 2; ++i) xv[i] = *((const unsigned*)(row + E_CKV) + lane + 64 * i);
        asm volatile("" : "+v"(xc[0]), "+v"(xc[1]), "+v"(xc[2]), "+v"(xv[0]), "+v"(xv[1]));
#pragma unroll
        for (int w = 0; w < 2; ++w) {
            const v4u x = w ? xk : xq;
            float f[8] = {bflo(x.x), bfhi(x.x), bflo(x.y), bfhi(x.y), bflo(x.z), bfhi(x.z), bflo(x.w), bfhi(x.w)};
            float s = 0.f;
#pragma unroll
            for (int i = 0; i < 8; ++i) s += f[i] * f[i];
            s += __shfl_xor(s, 1); s += __shfl_xor(s, 2); s += __shfl_xor(s, 4);
            const float r = (1.0f / sqrtf(s * (1.f / 64.f) + RMS_EPS)) * (w ? 1.0f : C2_FOX); const float* g = w ? gk_ : gq_;
            v4u o; o.x = pk2(f[0] * r * g[0], f[1] * r * g[1]); o.y = pk2(f[2] * r * g[2], f[3] * r * g[3]); o.z = pk2(f[4] * r * g[4], f[5] * r * g[5]); o.w = pk2(f[6] * r * g[6], f[7] * r * g[7]);
            *(dry ? (v4u*)(F.ws + WS_DUMMY) + (size_t)m * 128 + w * 64 + lane : (w ? pk : pq)) = o;
        }
        if (lane < 8) { const float z = bf2f(zl) + bfl; LOGF[(size_t)m * 8 + lane] = -softplusf_(-z); }
        {
            float f[6]; float s = 0.f;
#pragma unroll
            for (int i = 0; i < 3; ++i) { const unsigned x = xc[i]; f[2 * i] = bflo(x); f[2 * i + 1] = bfhi(x); s += f[2 * i] * f[2 * i] + f[2 * i + 1] * f[2 * i + 1]; }
            const float r = 1.0f / sqrtf(wave_sum(s) * (1.f / 384.f) + RMS_EPS);
#pragma unroll
            for (int i = 0; i < 3; ++i) { *((unsigned*)(CQN + (size_t)m * 384) + lane + 64 * i) = pk2(f[2 * i] * r * gqa[2 * i], f[2 * i + 1] * r * gqa[2 * i + 1]); }
        }
        {
            float f[4]; float s = 0.f;
#pragma unroll
            for (int i = 0; i < 2; ++i) { const unsigned x = xv[i]; f[2 * i] = bflo(x); f[2 * i + 1] = bfhi(x); s += f[2 * i] * f[2 * i] + f[2 * i + 1] * f[2 * i + 1]; }
            const float r = 1.0f / sqrtf(wave_sum(s) * (1.f / 256.f) + RMS_EPS);
#pragma unroll
            for (int i = 0; i < 2; ++i) { *((unsigned*)(CKVN + (size_t)m * 256) + lane + 64 * i) = pk2(f[2 * i] * r * gkv[2 * i], f[2 * i + 1] * r * gkv[2 * i + 1]); }
        }
    }
}
__device__ __forceinline__ void phase_cumsum(Frame& F) {
    if (F.bid >= 16) return;
    const float* LOGF = (const float*)(F.ws + WS_LOGF); float* CUM = (float*)(F.ws + WS_CUM);
    const int b = F.bid >> 3, h = F.bid & 7, t0 = F.tid * 32;
    LAS double* part = (LAS double*)(F.lds + RING_OFF);
    float v[32]; double s = 0.0;
#pragma unroll
    for (int i = 0; i < 32; ++i) { v[i] = LOGF[((size_t)b * SEQ + t0 + i) * 8 + h]; s += (double)v[i]; }
    part[F.tid] = s; __syncthreads();
    if (F.wave == 0) { double loc[8], run = 0.0;
#pragma unroll
        for (int i = 0; i < 8; ++i) { loc[i] = part[F.lane * 8 + i]; run += loc[i]; }
        double inc = run;
#pragma unroll
        for (int off = 1; off < 64; off <<= 1) { const double t = __shfl_up(inc, off); if (F.lane >= off) inc += t; }
        double ex = inc - run;
#pragma unroll
        for (int i = 0; i < 8; ++i) { part[F.lane * 8 + i] = ex; ex += loc[i]; } }
    __syncthreads();
    double run = part[F.tid];
#pragma unroll
    for (int i = 0; i < 32; ++i) { run += (double)v[i]; CUM[((size_t)b * SEQ + t0 + i) * 8 + h] = (float)run; }
    __syncthreads();
}
__device__ __forceinline__ void phase_mla_post(Frame& F, int j, bool dry = false) {

    const bf16* PROJ = (const bf16*)(F.ws + WS_PROJ); bf16* QM = (bf16*)(F.ws + WS_QM); const bf16* KVB = (const bf16*)(F.ws + WS_KVB); bf16* KM = (bf16*)(F.ws + WS_KM);
    const float* qn = kin(I_MLA_QN) + j * 96; const float* kn = kin(I_MLA_KN) + j * 96; const int* pos = (const int*)kin(I_POS);
    const int gw = F.bid * NWAVES + F.wave, NGW = F.G * NWAVES, lane = F.lane, l32 = lane & 31, hh = lane >> 5;
    const int fi = l32 & 15; const float inv = expf(-(float)fi * (1.0f / 16.0f) * 9.210340371976184f);
    const float gq0 = qn[l32], gq1 = qn[l32 + 32], gq2 = qn[l32 + 64], gk0 = kn[l32], gk1 = kn[l32 + 32], gk2 = kn[l32 + 64];
#pragma unroll 1
    for (int m = gw; m < NTOK; m += NGW) {
        const int pm = pos[m];
        const bf16 kr = PROJ[(size_t)m * EVEN_INP + E_KROPE + l32];
        bf16 xq[4][3], xk[4][2];
#pragma unroll
        for (int hp = 0; hp < 4; ++hp) { const int h = hp * 2 + hh; const bf16* q = QM + (size_t)m * 768 + h * 96; const bf16* k = KVB + (size_t)m * 1024 + h * 128;
            xq[hp][0] = q[l32]; xq[hp][1] = q[l32 + 32]; xq[hp][2] = q[l32 + 64]; xk[hp][0] = k[l32]; xk[hp][1] = k[l32 + 32]; }
        const float ang = (float)pm * inv; float sn, cs; sincosf(ang, &sn, &cs);
        const float krope = bf2f(kr);
#pragma unroll
        for (int hp = 0; hp < 4; ++hp) { const int h = hp * 2 + hh;
#pragma unroll
            for (int w = 0; w < 2; ++w) {
                float f[3];
                if (w == 0) { f[0] = bf2f(xq[hp][0]); f[1] = bf2f(xq[hp][1]); f[2] = bf2f(xq[hp][2]); }
                else { f[0] = bf2f(xk[hp][0]); f[1] = bf2f(xk[hp][1]); f[2] = krope; }
                float s = f[0] * f[0] + f[1] * f[1] + f[2] * f[2];
                s += __shfl_xor(s, 1); s += __shfl_xor(s, 2); s += __shfl_xor(s, 4); s += __shfl_xor(s, 8); s += __shfl_xor(s, 16);
                const float r = 1.0f / sqrtf(s * (1.f / 96.f) + RMS_EPS);
                f[0] *= r * (w ? gk0 : gq0); f[1] *= r * (w ? gk1 : gq1); f[2] *= r * (w ? gk2 : gq2);
                const float other = __shfl_xor(f[2], 16);
                const float rot = (l32 < 16) ? (f[2] * cs - other * sn) : (other * sn + f[2] * cs);
                bf16* o = (w ? KM : (dry ? (bf16*)(F.ws + WS_DUMMY) : QM)) + (size_t)m * 768 + h * 96; const float qs = w ? 1.0f : C2_MLA;
                o[l32] = (bf16)f2bf(f[0] * qs); o[l32 + 32] = (bf16)f2bf(f[1] * qs); o[l32 + 64] = (bf16)f2bf(rot * qs);
            }
        }
    }
}
template <int DK> __device__ __forceinline__ void attn_naive_unit(Frame& F, const bf16* Qp, int qld, const bf16* Kp, int kld, const bf16* Vp, int vld, const float* cum  , float scale, bf16* Op, int qb) {
    LAS float* Ks = (LAS float*)(F.lds + RING_OFF); LAS float* Vs = Ks + 64 * DK; LAS float* Cs = Vs + 64 * 64;
    const int t = qb * 512 + F.wave * 64 + F.lane; const int tmax_w = qb * 512 + F.wave * 64 + 63;
    float q[DK];
#pragma unroll
    for (int d = 0; d < DK; d += 8) { const v4u x = *(const v4u*)(Qp + (size_t)t * qld + d);
        q[d] = bflo(x.x) * scale; q[d + 1] = bfhi(x.x) * scale; q[d + 2] = bflo(x.y) * scale; q[d + 3] = bfhi(x.y) * scale; q[d + 4] = bflo(x.z) * scale; q[d + 5] = bfhi(x.z) * scale; q[d + 6] = bflo(x.w) * scale; q[d + 7] = bfhi(x.w) * scale; }
    const float cq = cum ? cum[(size_t)t * 8] : 0.f;
    float acc[64];
#pragma unroll
    for (int d = 0; d < 64; ++d) acc[d] = 0.f;
    float mx = -1e30f, l = 0.f;
    const int nkb = (qb * 512 + 512) / 64;
    for (int kb = 0; kb < nkb; ++kb) {
        __syncthreads();
        for (int i = F.tid; i < 64 * DK / 8; i += 512) { const int key = i / (DK / 8), c = (i % (DK / 8)) * 8; const v4u x = *(const v4u*)(Kp + (size_t)(kb * 64 + key) * kld + c);
            LAS float* d = Ks + key * DK + c; d[0] = bflo(x.x); d[1] = bfhi(x.x); d[2] = bflo(x.y); d[3] = bfhi(x.y); d[4] = bflo(x.z); d[5] = bfhi(x.z); d[6] = bflo(x.w); d[7] = bfhi(x.w); }
        { const int i = F.tid; const int key = i / 8, c = (i % 8) * 8; const v4u x = *(const v4u*)(Vp + (size_t)(kb * 64 + key) * vld + c);
            LAS float* d = Vs + key * 64 + c; d[0] = bflo(x.x); d[1] = bfhi(x.x); d[2] = bflo(x.y); d[3] = bfhi(x.y); d[4] = bflo(x.z); d[5] = bfhi(x.z); d[6] = bflo(x.w); d[7] = bfhi(x.w); }
        if (F.tid < 64) Cs[F.tid] = cum ? cum[(size_t)(kb * 64 + F.tid) * 8] : 0.f;
        __syncthreads();
        if (kb * 64 > tmax_w) continue;
        for (int jk = 0; jk < 64; ++jk) {
            const int s = kb * 64 + jk; if (s > tmax_w) break;
            const LAS float* kr = Ks + jk * DK; float dot = 0.f;
#pragma unroll
            for (int d = 0; d < DK; d += 4) { const f32x4 kv = *(const LAS f32x4*)(kr + d); dot += q[d] * kv.x + q[d + 1] * kv.y + q[d + 2] * kv.z + q[d + 3] * kv.w; }
            float logit = dot + (cq - Cs[jk]); if (s > t) logit = -1e30f;
            if (__any(logit > mx)) { const float mn = fmaxf(mx, logit); const float corr = expf(mx - mn); l *= corr;
#pragma unroll
                for (int d = 0; d < 64; ++d) acc[d] *= corr;
                mx = mn; }
            const float p = (s > t) ? 0.f : expf(logit - mx); l += p;
            const LAS float* vr = Vs + jk * 64;
#pragma unroll
            for (int d = 0; d < 64; d += 4) { const f32x4 vv = *(const LAS f32x4*)(vr + d); acc[d] += p * vv.x; acc[d + 1] += p * vv.y; acc[d + 2] += p * vv.z; acc[d + 3] += p * vv.w; }
        }
    }
    const float il = 1.0f / l; bf16* o = Op + (size_t)t * DM;
#pragma unroll
    for (int d = 0; d < 64; d += 8) { v4u w; w.x = pk2(acc[d] * il, acc[d + 1] * il); w.y = pk2(acc[d + 2] * il, acc[d + 3] * il); w.z = pk2(acc[d + 4] * il, acc[d + 5] * il); w.w = pk2(acc[d + 6] * il, acc[d + 7] * il); *(v4u*)(o + d) = w; }
}
__device__ __forceinline__ void phase_attn_naive(Frame& F) {
    const bf16* PROJ = (const bf16*)(F.ws + WS_PROJ); const bf16* QM = (const bf16*)(F.ws + WS_QM); const bf16* KVB = (const bf16*)(F.ws + WS_KVB); const bf16* KM = (const bf16*)(F.ws + WS_KM);
    const float* CUM = (const float*)(F.ws + WS_CUM); bf16* MIX = (bf16*)(F.ws + WS_MIX);
    for (int p = F.bid; p < 512; p += F.G) {
        const int combo = p >> 4, qq = p & 15; const int type = combo >> 4, b = (combo >> 3) & 1, h = combo & 7;
#pragma unroll 1
        for (int half = 0; half < 2; ++half) { const int qb = half ? 31 - qq : qq; const size_t rb = (size_t)b * SEQ;
            if (type == 0) attn_naive_unit<64>(F, PROJ + rb * EVEN_INP + E_FQ + h * 64, EVEN_INP, PROJ + rb * EVEN_INP + E_FK + h * 64, EVEN_INP, PROJ + rb * EVEN_INP + E_FV + h * 64, EVEN_INP, CUM + rb * 8 + h, LN2, MIX + rb * DM + h * 64, qb);
            else attn_naive_unit<96>(F, QM + rb * 768 + h * 96, 768, KM + rb * 768 + h * 96, 768, KVB + rb * 1024 + h * 128 + 64, 1024, nullptr, LN2, MIX + rb * DM + 512 + h * 64, qb);
        }
    }
    __syncthreads();
}

__device__ __forceinline__ void s5_scan_wave(Frame& F, int j, int b, int g) {
 const int p = F.lane;
    const bf16* PROJ = (const bf16*)(F.ws + WS_PROJ); bf16* HG = (bf16*)(F.ws + WS_HG);
    const float lr = fminf(kin(I_S5_ARE)[(j * 32 + g) * 64 + p], -1e-4f), li = kin(I_S5_AIM)[(j * 32 + g) * 64 + p];
    const float dt = expf(kin(I_S5_LS)[j * 32 + g]);
    const float mag = expf(lr * dt); const float abr = mag * cosf(li * dt), abi = mag * sinf(li * dt);
    const float den = lr * lr + li * li, nr = abr - 1.0f, ni = abi;
    const float gr = (nr * lr + ni * li) / den, gi = (ni * lr - nr * li) / den;
    float bbr[16], bbi[16], cr[16], ci[16], dsk[16];
#pragma unroll
    for (int c = 0; c < 16; ++c) { const float br = kin(I_S5_BRE)[((size_t)(j * 32 + g) * 64 + p) * 16 + c], bi = kin(I_S5_BIM)[((size_t)(j * 32 + g) * 64 + p) * 16 + c];
        bbr[c] = gr * br - gi * bi; bbi[c] = gr * bi + gi * br;
        cr[c] = kin(I_S5_CRE)[((size_t)(j * 32 + g) * 16 + c) * 64 + p]; ci[c] = kin(I_S5_CIM)[((size_t)(j * 32 + g) * 16 + c) * 64 + p];
        dsk[c] = kin(I_S5_D)[j * 512 + g * 16 + c]; }
    float xr = 0.f, xi = 0.f;
    const bf16* up = PROJ + (size_t)b * SEQ * ODD_INP + O_U + g * 16;
    v4u cur0[4], cur1[4], nx0[4], nx1[4];
#pragma unroll
    for (int i = 0; i < 4; ++i) { cur0[i] = *(const v4u*)(up + (size_t)i * ODD_INP); cur1[i] = *(const v4u*)(up + (size_t)i * ODD_INP + 8); }
    for (int t0 = 0; t0 < SEQ; t0 += 4) {
        const int tn = (t0 + 4 < SEQ) ? t0 + 4 : t0;
#pragma unroll
        for (int i = 0; i < 4; ++i) { nx0[i] = *(const v4u*)(up + (size_t)(tn + i) * ODD_INP); nx1[i] = *(const v4u*)(up + (size_t)(tn + i) * ODD_INP + 8); }
#pragma unroll
        for (int i = 0; i < 4; ++i) {
            float u[16] = {bflo(cur0[i].x), bfhi(cur0[i].x), bflo(cur0[i].y), bfhi(cur0[i].y), bflo(cur0[i].z), bfhi(cur0[i].z), bflo(cur0[i].w), bfhi(cur0[i].w),
                           bflo(cur1[i].x), bfhi(cur1[i].x), bflo(cur1[i].y), bfhi(cur1[i].y), bflo(cur1[i].z), bfhi(cur1[i].z), bflo(cur1[i].w), bfhi(cur1[i].w)};
            float bur = 0.f, bui = 0.f;
#pragma unroll
            for (int c = 0; c < 16; ++c) { bur += bbr[c] * u[c]; bui += bbi[c] * u[c]; }
            const float nxr = abr * xr - abi * xi + bur, nxi = abr * xi + abi * xr + bui; xr = nxr; xi = nxi;
            float y[16];
#pragma unroll
            for (int c = 0; c < 16; ++c) y[c] = wave_sum(cr[c] * xr - ci[c] * xi);
            if (p < 16) { float yy = 0.f, uu = 0.f, dd = 0.f;
#pragma unroll
                for (int c = 0; c < 16; ++c) if (p == c) { yy = y[c]; uu = u[c]; dd = dsk[c]; }
                HG[((size_t)b * SEQ + t0 + i) * 512 + g * 16 + p] = (bf16)f2bf(gelu_tanh(yy + dd * uu)); }
        }
#pragma unroll
        for (int i = 0; i < 4; ++i) { cur0[i] = nx0[i]; cur1[i] = nx1[i]; }
    }
}
__device__ __forceinline__ void gdn_prep_token(Frame& F, int j, int m) {
 const int lane = F.lane;
    const bf16* PROJ = (const bf16*)(F.ws + WS_PROJ); float* QG = (float*)(F.ws + WS_QG); float* KG = (float*)(F.ws + WS_KG); float* VG = (float*)(F.ws + WS_VG);
    float* GB = (float*)(F.ws + WS_GB); float* BETA = (float*)(F.ws + WS_BETA);
    const float* cw = kin(I_GDN_CONV) + (size_t)j * 4 * 1536;
    const int s = m % SEQ;
#pragma unroll
    for (int w = 0; w < 3; ++w) {
        const int ch0 = w * 512 + lane * 8; float acc[8];
#pragma unroll
        for (int i = 0; i < 8; ++i) acc[i] = 0.f;
#pragma unroll
        for (int tap = 0; tap < 4; ++tap) { const int ss = s - 3 + tap; if (ss < 0) continue;
            const v4u x = *(const v4u*)(PROJ + (size_t)(m - 3 + tap) * ODD_INP + O_Q + ch0); const float* wv = cw + tap * 1536 + ch0;
            acc[0] += wv[0] * bflo(x.x); acc[1] += wv[1] * bfhi(x.x); acc[2] += wv[2] * bflo(x.y); acc[3] += wv[3] * bfhi(x.y); acc[4] += wv[4] * bflo(x.z); acc[5] += wv[5] * bfhi(x.z); acc[6] += wv[6] * bflo(x.w); acc[7] += wv[7] * bfhi(x.w); }
        float ss2 = 0.f;
#pragma unroll
        for (int i = 0; i < 8; ++i) { acc[i] = acc[i] * sigm(acc[i]); ss2 += acc[i] * acc[i]; }
        float sc = 1.0f;
        if (w < 2) { ss2 += __shfl_xor(ss2, 1); ss2 += __shfl_xor(ss2, 2); ss2 += __shfl_xor(ss2, 4); ss2 += __shfl_xor(ss2, 8); sc = 1.0f / sqrtf(ss2 + RMS_EPS); if (w == 0) sc *= 0.08838834764831845f; }
        float* dst = (w == 0 ? QG : (w == 1 ? KG : VG)) + (size_t)m * 512 + lane * 8;
        *(f32x4*)dst = (f32x4){acc[0] * sc, acc[1] * sc, acc[2] * sc, acc[3] * sc}; *(f32x4*)(dst + 4) = (f32x4){acc[4] * sc, acc[5] * sc, acc[6] * sc, acc[7] * sc};
    }
    if (lane < 4) { const float gin = bf2f(PROJ[(size_t)m * ODD_INP + O_GIN + lane]), bin = bf2f(PROJ[(size_t)m * ODD_INP + O_BETA + lane]);
        GB[(size_t)m * 4 + lane] = -expf(kin(I_GDN_ALOG)[j * 4 + lane]) * softplusf_(gin + kin(I_GDN_DTB)[j * 4 + lane]); BETA[(size_t)m * 4 + lane] = sigm(bin); }
}
__device__ __forceinline__ void phase_gdn_prep(Frame& F, int j) {
    const int gw = F.bid * NWAVES + F.wave, NGW = F.G * NWAVES;
    for (int m = gw; m < NTOK; m += NGW) gdn_prep_token(F, j, m);
}
__device__ __forceinline__ void phase_odd_a(Frame& F, int j) {
    if (F.wave == 0 && F.bid < 64) { s5_scan_wave(F, j, F.bid >> 5, F.bid & 31); return; }
    const int nbusy = (F.G < 64 ? F.G : 64);
    const int widx = (F.bid < 64) ? F.bid * 7 + (F.wave - 1) : nbusy * 7 + (F.bid - 64) * 8 + F.wave;
    const int nw = nbusy * 7 + (F.G > 64 ? (F.G - 64) * 8 : 0);
    for (int m = widx; m < NTOK; m += nw) gdn_prep_token(F, j, m);
}
__device__ __forceinline__ void phase_gdn_naive(Frame& F) {
    const float* QG = (const float*)(F.ws + WS_QG); const float* KG = (const float*)(F.ws + WS_KG); const float* VG = (const float*)(F.ws + WS_VG);
    const float* GB = (const float*)(F.ws + WS_GB); const float* BETA = (const float*)(F.ws + WS_BETA); float* OG = (float*)(F.ws + WS_OG);
    const int lane = F.lane; const int NGW = F.G * NWAVES;
    for (int u = F.wave * F.G + F.bid; u < 1024; u += NGW) {
        const int b = u >> 9, h = (u >> 7) & 3, c = u & 127; const size_t rb = (size_t)b * SEQ;
        const float* kq = KG + rb * 512 + h * 128 + lane; const float* qq = QG + rb * 512 + h * 128 + lane; const float* vq = VG + rb * 512 + h * 128 + c;
        const float* gq = GB + rb * 4 + h; const float* bq = BETA + rb * 4 + h; float* oq = OG + rb * 512 + h * 128 + c;
        float s0 = 0.f, s1 = 0.f;
        float k0[8], k1[8], q0[8], q1[8], vv[8], gg[8], bb[8], nk0[8], nk1[8], nq0[8], nq1[8], nv[8], ng[8], nb[8];
#pragma unroll
        for (int i = 0; i < 8; ++i) { k0[i] = kq[(size_t)i * 512]; k1[i] = kq[(size_t)i * 512 + 64]; q0[i] = qq[(size_t)i * 512]; q1[i] = qq[(size_t)i * 512 + 64]; vv[i] = vq[(size_t)i * 512]; gg[i] = gq[i * 4]; bb[i] = bq[i * 4]; }
        for (int t0 = 0; t0 < SEQ; t0 += 8) {
            const int tn = (t0 + 8 < SEQ) ? t0 + 8 : t0;
#pragma unroll
            for (int i = 0; i < 8; ++i) { const size_t o = (size_t)(tn + i) * 512; nk0[i] = kq[o]; nk1[i] = kq[o + 64]; nq0[i] = qq[o]; nq1[i] = qq[o + 64]; nv[i] = vq[o]; ng[i] = gq[(tn + i) * 4]; nb[i] = bq[(tn + i) * 4]; }
#pragma unroll
            for (int i = 0; i < 8; ++i) {
                const float ks = wave_sum(k0[i] * s0 + k1[i] * s1); const float eg = expf(gg[i]); const float be = bb[i];
                s0 = eg * (s0 - be * k0[i] * ks) + be * k0[i] * vv[i]; s1 = eg * (s1 - be * k1[i] * ks) + be * k1[i] * vv[i];
                const float o = wave_sum(q0[i] * s0 + q1[i] * s1);
                if (lane == 0) oq[(size_t)(t0 + i) * 512] = o;
            }
#pragma unroll
            for (int i = 0; i < 8; ++i) { k0[i] = nk0[i]; k1[i] = nk1[i]; q0[i] = nq0[i]; q1[i] = nq1[i]; vv[i] = nv[i]; gg[i] = ng[i]; bb[i] = nb[i]; }
        }
    }
}
__device__ __forceinline__ void phase_gdn_out(Frame& F, int j) {
 const float* OG = (const float*)(F.ws + WS_OG); const bf16* PROJ = (const bf16*)(F.ws + WS_PROJ); bf16* MIX = (bf16*)(F.ws + WS_MIX);
    const float* on = kin(I_GDN_ONORM) + j * 128; const int lane = F.lane;
    const int gw = F.bid * NWAVES + F.wave, NGW = F.G * NWAVES;
    for (int m = gw; m < NTOK; m += NGW) {
        const f32x4 a = *(const f32x4*)(OG + (size_t)m * 512 + lane * 8), b = *(const f32x4*)(OG + (size_t)m * 512 + lane * 8 + 4);
        float f[8] = {a.x, a.y, a.z, a.w, b.x, b.y, b.z, b.w}; float s = 0.f;
#pragma unroll
        for (int i = 0; i < 8; ++i) s += f[i] * f[i];
        s += __shfl_xor(s, 1); s += __shfl_xor(s, 2); s += __shfl_xor(s, 4); s += __shfl_xor(s, 8);
        const float r = 1.0f / sqrtf(s * (1.f / 128.f) + RMS_EPS);
        const bf16* z = PROJ + (size_t)m * ODD_INP + O_Z + lane * 8; const float* g = on + (lane & 15) * 8; float o[8];
#pragma unroll
        for (int i = 0; i < 8; ++i) { const float zz = bf2f(z[i]); o[i] = f[i] * r * g[i] * (zz * sigm(zz)); }
        v4u w; w.x = pk2(o[0], o[1]); w.y = pk2(o[2], o[3]); w.z = pk2(o[4], o[5]); w.w = pk2(o[6], o[7]);
        *(v4u*)(MIX + (size_t)m * DM + 512 + lane * 8) = w;
    }
}

__device__ __forceinline__ void phase_router(Frame& F, int layer, bool dry = false) {
 const float* H = kout(); bf16* ABF = (bf16*)(F.ws + WS_ABF);
    const float* gain = kin(I_NORM_FFN) + layer * DM; const float* wgr = kin(I_MOE_WGRP) + (size_t)layer * DM * 4; const float* bgr = kin(I_MOE_BGRP) + layer * 4;
    const float* wex = kin(I_MOE_WEXP) + (size_t)layer * DM * 32; const float* bex = kin(I_MOE_BEXP) + layer * 32;
    int* TOKE = (int*)(F.ws + WS_TOKE); float* TOKW = (float*)(F.ws + WS_TOKW);
    LAS int* lcnt = (LAS int*)(F.lds + LDSCTL_OFF + LC_MOE + 512); LAS int* gbase = (LAS int*)(F.lds + LDSCTL_OFF + LC_MOE + 640);
    const int lane = F.lane; const int per = NTOK / F.G;
    LAS int* lasg = (LAS int*)(F.lds + RING_OFF);
    if (F.tid < 32) lcnt[F.tid] = 0;
    __syncthreads();
    for (int tl = F.wave; tl < per; tl += NWAVES) {
        const int m = F.bid * per + tl;
        const f32x4* xr = (const f32x4*)(H + (size_t)m * DM) + lane; f32x4 v[4]; float s = 0.f;
#pragma unroll
        for (int q = 0; q < 4; ++q) { v[q] = xr[64 * q]; s += (v[q].x * v[q].x + v[q].y * v[q].y) + (v[q].z * v[q].z + v[q].w * v[q].w); }
        const float r = 1.0f / sqrtf(wave_sum(s) * (1.f / 1024.f) + RMS_EPS);
        unsigned long long* o8 = (unsigned long long*)(ABF + (size_t)m * DM) + lane;
#pragma unroll
        for (int q = 0; q < 4; ++q) { const f32x4 g = ((const f32x4*)gain + lane)[64 * q]; v[q].x *= r * g.x; v[q].y *= r * g.y; v[q].z *= r * g.z; v[q].w *= r * g.w;
            o8[64 * q] = (unsigned long long)pk2(v[q].x, v[q].y) | ((unsigned long long)pk2(v[q].z, v[q].w) << 32); }
        float lg[4] = {0.f, 0.f, 0.f, 0.f};
#pragma unroll
        for (int q = 0; q < 4; ++q) { const int k0 = 4 * lane + 256 * q;
#pragma unroll
            for (int e = 0; e < 4; ++e) { const f32x4 w = *(const f32x4*)(wgr + (size_t)(k0 + e) * 4); const float x = v[q][e]; lg[0] += x * w.x; lg[1] += x * w.y; lg[2] += x * w.z; lg[3] += x * w.w; } }
#pragma unroll
        for (int g = 0; g < 4; ++g) lg[g] = wave_sum(lg[g]) + bgr[g];
        int gi = 0; float gm = lg[0];
#pragma unroll
        for (int g = 1; g < 4; ++g) if (lg[g] > gm) { gm = lg[g]; gi = g; }
        float gden = 0.f;
#pragma unroll
        for (int g = 0; g < 4; ++g) gden += expf(lg[g] - gm);
        const float gw_ = 1.0f / gden;
        float le[8] = {0.f, 0.f, 0.f, 0.f, 0.f, 0.f, 0.f, 0.f};
#pragma unroll
        for (int q = 0; q < 4; ++q) { const int k0 = 4 * lane + 256 * q;
#pragma unroll
            for (int e = 0; e < 4; ++e) { const float* wp = wex + (size_t)(k0 + e) * 32 + gi * 8; const f32x4 w0 = *(const f32x4*)wp, w1 = *(const f32x4*)(wp + 4); const float x = v[q][e];
                le[0] += x * w0.x; le[1] += x * w0.y; le[2] += x * w0.z; le[3] += x * w0.w; le[4] += x * w1.x; le[5] += x * w1.y; le[6] += x * w1.z; le[7] += x * w1.w; } }
#pragma unroll
        for (int e = 0; e < 8; ++e) le[e] = wave_sum(le[e]) + bex[gi * 8 + e];
        int i0 = 0; float m0 = le[0];
#pragma unroll
        for (int e = 1; e < 8; ++e) if (le[e] > m0) { m0 = le[e]; i0 = e; }
        int i1 = -1; float m1 = -3.0e38f;
#pragma unroll
        for (int e = 0; e < 8; ++e) if (e != i0 && le[e] > m1) { m1 = le[e]; i1 = e; }
        const float e1 = expf(m1 - m0); const float w0 = gw_ / (1.0f + e1), w1 = gw_ * e1 / (1.0f + e1);
        if (lane == 0 && !dry) { const int ea = gi * 8 + i0, eb = gi * 8 + i1;
            const int pa = __hip_atomic_fetch_add(lcnt + ea, 1, __ATOMIC_RELAXED, __HIP_MEMORY_SCOPE_WORKGROUP), pb = __hip_atomic_fetch_add(lcnt + eb, 1, __ATOMIC_RELAXED, __HIP_MEMORY_SCOPE_WORKGROUP);
            lasg[tl * 2] = ea | (pa << 8); lasg[tl * 2 + 1] = eb | (pb << 8);
            TOKW[(size_t)m * 2] = w0; TOKW[(size_t)m * 2 + 1] = w1; }
    }
    __syncthreads();
    if (dry) return;
    if (F.tid < 32) gbase[F.tid] = (int)__hip_atomic_fetch_add(F.ctl + CW_CNT + 64 * layer + F.tid, (unsigned)lcnt[F.tid], __ATOMIC_RELAXED, __HIP_MEMORY_SCOPE_AGENT);
    __syncthreads();
    for (int i = F.tid; i < per * 2; i += 512) { const int a = lasg[i], e = a & 255, lp = a >> 8; TOKE[(size_t)F.bid * per * 2 + i] = e | ((gbase[e] + lp) << 8); }
    __syncthreads();
}
__device__ __forceinline__ void moe_tables(Frame& F, int layer) {
    LAS int* rowbase = (LAS int*)(F.lds + LDSCTL_OFF + LC_MOE); LAS unsigned char* tile_e = (LAS unsigned char*)(F.lds + LDSCTL_OFF + LC_MOE + 192);
    if (F.tid == 0) { int rb = 0;
#pragma unroll 1
        for (int e = 0; e < 32; ++e) { const int c = (int)__hip_atomic_load(F.ctl + CW_CNT + 64 * layer + e, __ATOMIC_RELAXED, __HIP_MEMORY_SCOPE_AGENT); rowbase[e] = rb; rowbase[224 + e] = c;   const int nt = (c + 255) >> 8;
            for (int i = 0; i < nt; ++i) tile_e[(rb >> 8) + i] = (unsigned char)e; rb += nt << 8; }
        rowbase[32] = rb; rowbase[34] = rb >> 8; }
    __syncthreads();
}
__device__ __forceinline__ void phase_moe_scatter(Frame& F, int layer) {
    moe_tables(F, layer);
    const LAS int* rowbase = (const LAS int*)(F.lds + LDSCTL_OFF + LC_MOE);
    const bf16* ABF = (const bf16*)(F.ws + WS_ABF); bf16* XG = (bf16*)(F.ws + WS_XG); const int* TOKE = (const int*)(F.ws + WS_TOKE); int* ROWS = (int*)(F.ws + WS_ROWS);
    const int gw = F.bid * NWAVES + F.wave, NGW = F.G * NWAVES, lane = F.lane;
    for (int m = gw; m < NTOK; m += NGW) {
        const v4u a = *((const v4u*)(ABF + (size_t)m * DM) + lane), b = *((const v4u*)(ABF + (size_t)m * DM) + 64 + lane);
#pragma unroll
        for (int k = 0; k < 2; ++k) { const int te = TOKE[(size_t)m * 2 + k]; const int row = rowbase[te & 255] + (te >> 8);
            *((v4u*)(XG + (size_t)row * DM) + lane) = a; *((v4u*)(XG + (size_t)row * DM) + 64 + lane) = b;
            if (lane == 0) ROWS[(size_t)m * 2 + k] = row; }
    }
}
struct MoeOrder {
    int ntiles, nN, G, c; const LAS unsigned char* tile_e; size_t bstride;
    __device__ bool next(int i, pg8::Unit& u) const { const long L = (long)i * G + c; if (L >= (long)ntiles * nN) return false; u.pm = (int)(L / nN); u.pn = (int)(L % nN); u.aux = __builtin_amdgcn_readfirstlane((int)tile_e[u.pm]); return true; }
    __device__ __forceinline__ const char* a_base(const pg8::Gemm& g, const pg8::Unit& u) const { return (const char*)g.A + (size_t)u.pm * 256 * g.lda * 2; }
    __device__ __forceinline__ const char* b_base(const pg8::Gemm& g, const pg8::Unit& u) const { return (const char*)g.Bt + (size_t)u.aux * bstride + (size_t)u.pn * 256 * g.ldb * 2; }
};
struct MoeGatherOrder {
    int ntiles, nN, G, c; const LAS unsigned char* tile_e; const LAS int* rowbase; const int* p2t; size_t bstride;
    __device__ bool next(int i, pg8::Unit& u) const { const long L = (long)i * G + c; if (L >= (long)ntiles * nN) return false; u.pm = (int)(L / nN); u.pn = (int)(L % nN); u.aux = __builtin_amdgcn_readfirstlane((int)tile_e[u.pm]); return true; }
    __device__ __forceinline__ unsigned a_row(const pg8::Unit& u, int r) const { const int e = u.aux; const int pos = 256 * u.pm - rowbase[e] + r; const int cnt = rowbase[224 + e];
        return pos < cnt ? (unsigned)(p2t[(size_t)e * NTOK + pos] >> 1) : 0u; }
    __device__ __forceinline__ const char* b_base(const pg8::Gemm& g, const pg8::Unit& u) const { return (const char*)g.Bt + (size_t)u.aux * bstride + (size_t)u.pn * 256 * g.ldb * 2; }
};
__device__ __forceinline__ void phase_moe_combine(Frame& F, int layer, bool dry = false) {
    moe_tables(F, layer); const LAS int* rowbase = (const LAS int*)(F.lds + LDSCTL_OFF + LC_MOE); const int* TOKE = (const int*)(F.ws + WS_TOKE);
    const bf16* H = (const bf16*)(F.ws + WS_H16); bf16* Ho = dry ? (bf16*)(F.ws + WS_DUMMY) : (bf16*)(F.ws + WS_H16); bf16* ABF = (bf16*)(F.ws + WS_ABF); const bf16* Y2 = (const bf16*)(F.ws + WS_Y2);
    const float* TOKW = (const float*)(F.ws + WS_TOKW); const float* gain = kin(I_PLE_NORM) + layer * DM;
    const int gw = F.bid * NWAVES + F.wave, NGW = F.G * NWAVES, lane = F.lane;
    f32x4 gq[4];
#pragma unroll
    for (int j = 0; j < 2; ++j) { gq[2 * j] = *(const f32x4*)(gain + 512 * j + 8 * lane); gq[2 * j + 1] = *(const f32x4*)(gain + 512 * j + 8 * lane + 4); }
    int te0 = 0, te1 = 0; float w0 = 0.f, w1 = 0.f;
    if (gw < NTOK) { te0 = TOKE[(size_t)gw * 2]; te1 = TOKE[(size_t)gw * 2 + 1]; w0 = TOKW[(size_t)gw * 2]; w1 = TOKW[(size_t)gw * 2 + 1]; }
#pragma unroll 1
    for (int m = gw; m < NTOK; m += NGW) {
        const int r0 = rowbase[te0 & 255] + (te0 >> 8), r1 = rowbase[te1 & 255] + (te1 >> 8); const float cw0 = w0, cw1 = w1;
        const int mn = (m + NGW < NTOK) ? m + NGW : m;
        te0 = TOKE[(size_t)mn * 2]; te1 = TOKE[(size_t)mn * 2 + 1]; w0 = TOKW[(size_t)mn * 2]; w1 = TOKW[(size_t)mn * 2 + 1];
        v4u hx[2], ya[2], yb[2];
#pragma unroll
        for (int j = 0; j < 2; ++j) { hx[j] = ((const v4u*)(H + (size_t)m * DM) + lane)[64 * j]; ya[j] = ((const v4u*)(Y2 + (size_t)r0 * DM) + lane)[64 * j]; yb[j] = ((const v4u*)(Y2 + (size_t)r1 * DM) + lane)[64 * j]; }
        float v[16]; float s = 0.f;
#pragma unroll
        for (int j = 0; j < 2; ++j) {
            v[8 * j + 0] = bflo(hx[j].x) + cw0 * bflo(ya[j].x) + cw1 * bflo(yb[j].x); v[8 * j + 1] = bfhi(hx[j].x) + cw0 * bfhi(ya[j].x) + cw1 * bfhi(yb[j].x);
            v[8 * j + 2] = bflo(hx[j].y) + cw0 * bflo(ya[j].y) + cw1 * bflo(yb[j].y); v[8 * j + 3] = bfhi(hx[j].y) + cw0 * bfhi(ya[j].y) + cw1 * bfhi(yb[j].y);
            v[8 * j + 4] = bflo(hx[j].z) + cw0 * bflo(ya[j].z) + cw1 * bflo(yb[j].z); v[8 * j + 5] = bfhi(hx[j].z) + cw0 * bfhi(ya[j].z) + cw1 * bfhi(yb[j].z);
            v[8 * j + 6] = bflo(hx[j].w) + cw0 * bflo(ya[j].w) + cw1 * bflo(yb[j].w); v[8 * j + 7] = bfhi(hx[j].w) + cw0 * bfhi(ya[j].w) + cw1 * bfhi(yb[j].w); }
        v4u hw[2];
#pragma unroll
        for (int j = 0; j < 2; ++j) { hw[j].x = pk2(v[8 * j], v[8 * j + 1]); hw[j].y = pk2(v[8 * j + 2], v[8 * j + 3]); hw[j].z = pk2(v[8 * j + 4], v[8 * j + 5]); hw[j].w = pk2(v[8 * j + 6], v[8 * j + 7]);
            v[8 * j] = bflo(hw[j].x); v[8 * j + 1] = bfhi(hw[j].x); v[8 * j + 2] = bflo(hw[j].y); v[8 * j + 3] = bfhi(hw[j].y); v[8 * j + 4] = bflo(hw[j].z); v[8 * j + 5] = bfhi(hw[j].z); v[8 * j + 6] = bflo(hw[j].w); v[8 * j + 7] = bfhi(hw[j].w); }
#pragma unroll
        for (int i = 0; i < 16; ++i) s += v[i] * v[i];
        const float r = 1.0f / sqrtf(wave_sum(s) * (1.f / 1024.f) + RMS_EPS);
#pragma unroll
        for (int j = 0; j < 2; ++j) { ((v4u*)(Ho + (size_t)m * DM) + lane)[64 * j] = hw[j]; const f32x4 g0 = gq[2 * j], g1 = gq[2 * j + 1];
            v4u o; o.x = pk2(v[8 * j] * r * g0.x, v[8 * j + 1] * r * g0.y); o.y = pk2(v[8 * j + 2] * r * g0.z, v[8 * j + 3] * r * g0.w); o.z = pk2(v[8 * j + 4] * r * g1.x, v[8 * j + 5] * r * g1.y); o.w = pk2(v[8 * j + 6] * r * g1.z, v[8 * j + 7] * r * g1.w);
            ((v4u*)(ABF + (size_t)m * DM) + lane)[64 * j] = o; }
    }
}
namespace att {
using bf16x8 = __attribute__((ext_vector_type(8))) short;
using s16x4 = __attribute__((ext_vector_type(4))) short;
using f32x16 = __attribute__((ext_vector_type(16))) float;
using u32x4 = __attribute__((ext_vector_type(4))) unsigned;
typedef float f32x2_t __attribute__((ext_vector_type(2))); typedef __bf16 bf16x2_t __attribute__((ext_vector_type(2)));
constexpr int KSLOT = 16384, VSLOT = 8192;
constexpr int L_K = 0, L_V = 2 * KSLOT, L_B = L_V + 3 * VSLOT, L_WS = L_B + 1024, L_OST = L_WS + 8 * 256, L_BYTES = L_OST + 8 * 4096;
__device__ __forceinline__ int crow(int r, int hi) { return (r & 3) + 8 * (r >> 2) + 4 * hi; }
__device__ __forceinline__ void glds16(const void* gsrc, unsigned lds_dst) { unsigned keep;
    asm volatile("s_mov_b32 %0, m0\n\ts_mov_b32 m0, %2\n\ts_nop 0\n\tglobal_load_lds_dwordx4 %1, off\n\ts_mov_b32 m0, %0" : "=&s"(keep) : "v"(gsrc), "s"(lds_dst) : "memory"); }
__device__ __forceinline__ unsigned cvtpk(float lo, float hi) { f32x2_t v = {lo, hi}; bf16x2_t b = __builtin_convertvector(v, bf16x2_t); return __builtin_bit_cast(unsigned, b); }
__device__ __forceinline__ float max3f(float a, float b, float c) { float r; asm("v_max3_f32 %0, %1, %2, %3" : "=v"(r) : "v"(a), "v"(b), "v"(c)); return r; }
__device__ __forceinline__ float max2f(float a, float b) { float r; asm("v_max_f32_e32 %0, %1, %2" : "=v"(r) : "v"(a), "v"(b)); return r; }
#define ATT_SUBI(x, d) asm volatile("v_sub_f32_e32 %0, %0, %1" : "+v"(x) : "v"(d))
#define ATT_WAIT_BAR() asm volatile("s_waitcnt vmcnt(0) lgkmcnt(0)\n\ts_barrier" ::: "memory")

}

namespace att {
#define A2_SB() __builtin_amdgcn_sched_barrier(0)
#define A2_PIN(x) asm volatile("" : "+v"(x))
template <int K, int PER> __device__ __forceinline__ void a2_chunk(const f32x16& p0, const f32x16& p1, f32x2_t& s2, u32x4 (&pw)[4]) {
#pragma unroll
    for (int i = K * PER; i < (K + 1) * PER && i < 32; ++i) { const int j = i & 15;
        const float a = (j < 8) ? p0[2 * j] : p1[2 * (j - 8)], b = (j < 8) ? p0[2 * j + 1] : p1[2 * (j - 8) + 1];
        if (i < 16) { if (i == 0) { s2[0] = a; s2[1] = b; } else { s2[0] += a; s2[1] += b; } }
        else pw[j >> 2][j & 3] = cvtpk(a, b); }
}
template <int DK, bool BIAS>
__device__ __forceinline__ void attn_unit2(const int tid_in, const int qb, const bf16* Qh, const int qp, const bf16* Kh, const int kp, const bf16* Vh, const int vp, const float* cumh, bf16* Oh, char* shm, const float skip_margin) {
    constexpr int ND = DK / 16, KCH = DK / 8, NM = 2 * ND, PER = (32 + NM - 1) / NM;
    int tid = tid_in; asm volatile("" : "+v"(tid));
    const int lane = tid & 63, r32 = lane & 31, hi = lane >> 5; const int wid = __builtin_amdgcn_readfirstlane(tid >> 6);
    const int q0 = qb * 256;
    const unsigned lds0 = (unsigned)(uintptr_t)shm;
    float* wsf = (float*)(shm + L_WS) + wid * 64;
    float* Bs = (float*)(shm + L_B);
    const bf16* ksrc = Kh + (size_t)lane * kp + wid * 8;
    const bf16* vsrc = Vh + (size_t)(16 * (wid & 3) + (lane >> 2)) * vp + (wid >> 2) * 32 + (lane & 3) * 8;
    const unsigned kdst = lds0 + L_K + wid * 1024, vdst = lds0 + L_V + wid * 1024;
    const int NT = (q0 + 256) / 64;
    const float cref = BIAS ? cumh[(size_t)q0 * 8] : 0.f;
    int T0 = 0;
    if (BIAS) {
        float cend[4];
#pragma unroll
        for (int k = 0; k < 4; ++k) { const int tq = 64 * k + lane; cend[k] = cumh[(size_t)(64 * (tq < NT ? tq : NT - 1) + 63) * 8]; }
        T0 = NT - 4;
#pragma unroll
        for (int k = 3; k >= 0; --k) { const int tq = 64 * k + lane; const bool ok = (tq < NT) && ((cref - cend[k]) * 1.4426950408889634f + skip_margin >= -150.0f);
            const unsigned long long mk = __ballot(ok); if (mk) T0 = 64 * k + (int)__builtin_ctzll(mk); }
        T0 = __builtin_amdgcn_readfirstlane(T0); if (T0 > NT - 4) T0 = NT - 4; }
#define A2_DMAK(t) do { const int t_ = (t); glds16(ksrc + (size_t)t_ * 64 * kp, (unsigned)__builtin_amdgcn_readfirstlane(kdst + (t_ & 1) * KSLOT)); \
        if (KCH > 8 && wid < KCH - 8) glds16(ksrc + (size_t)t_ * 64 * kp + 64, (unsigned)__builtin_amdgcn_readfirstlane(kdst + (t_ & 1) * KSLOT + 8192)); } while (0)
#define A2_DMAV(t) do { const int t_ = (t); glds16(vsrc + (size_t)t_ * 64 * vp, (unsigned)__builtin_amdgcn_readfirstlane(vdst + (t_ % 3) * VSLOT)); } while (0)
#define A2_ISSUE(k) do { if ((k) + 1 < NT) A2_DMAK((k) + 1); A2_DMAV(k); } while (0)
    A2_DMAK(T0);
    if (BIAS && wid == 0) Bs[(T0 & 1) * 64 + lane] = (cref - cumh[(size_t)(T0 * 64 + lane) * 8]) * 1.4426950408889634f;
    bf16x8 qr[ND];
#pragma unroll
    for (int d0 = 0; d0 < ND; ++d0) qr[d0] = *reinterpret_cast<const bf16x8*>(Qh + (size_t)(q0 + wid * 32 + r32) * qp + d0 * 16 + hi * 8);
    bf16x8 kfa[4], kfb[4];
    float mhat = 0.f, l_reg = 0.f; f32x16 o[2]; o[0] = f32x16{}; o[1] = f32x16{}; f32x16 negm = f32x16{};
    f32x16 cA0 = f32x16{}, cA1 = f32x16{}, cB0 = f32x16{}, cB1 = f32x16{};
    const int qrel = wid * 32 + r32;
    const int vb0 = (int)(lds0 + L_V) + ((lane >> 4) & 1) * 32 + (lane & 3) * 8 + (4 * hi + ((lane & 15) >> 2)) * 64;
    ATT_WAIT_BAR();
#pragma unroll
    for (int d0 = 0; d0 < ND; ++d0) A2_PIN(qr[d0]);
#define A2_KRDB(dst, base, off) asm volatile("ds_read_b128 %0, %1 offset:%c2" : "=&v"(dst) : "v"(base), "i"(off) : "memory")
#define A2_KRD(dst, off) A2_KRDB(dst, ka_, off)
#define A2_POST(k) do { if ((k) + 1 < NT) { A2_ISSUE((k) + 1); const unsigned kn_ = lds0 + L_K + (((k) + 1) & 1) * KSLOT + hi * 1024 + r32 * 16; \
        A2_KRDB(kfa[0], kn_, 0); A2_KRDB(kfa[1], kn_, 512); A2_KRDB(kfa[2], kn_, 2048); A2_KRDB(kfa[3], kn_, 2560); \
        A2_KRDB(kfb[0], kn_, 4096); A2_KRDB(kfb[1], kn_, 4608); A2_KRDB(kfb[2], kn_, 6144); A2_KRDB(kfb[3], kn_, 6656); } } while (0)
#define A2_VRD(s, i) do { asm volatile("ds_read_b64_tr_b16 %0,%1 offset:%c2" : "=&v"(vlo[s]) : "v"(vb_), "i"(((i) >> 2) * 4096 + ((i) & 3) * 1024) : "memory"); \
        asm volatile("ds_read_b64_tr_b16 %0,%1 offset:%c2" : "=&v"(vhi[s]) : "v"(vb_), "i"(((i) >> 2) * 4096 + ((i) & 3) * 1024 + 512) : "memory"); } while (0)
#define A2_VFR(i) (bf16x8){vlo[i][0], vlo[i][1], vlo[i][2], vlo[i][3], vhi[i][0], vhi[i][1], vhi[i][2], vhi[i][3]}
#define A2_BMM(C0, C1, tt_, RM) do { const int tt = (tt_); \
        if (BIAS) { const float* bb = Bs + (tt & 1) * 64 + 4 * hi; \
            _Pragma("unroll") for (int g = 0; g < 4; ++g) { const f32x4 x0 = *(const f32x4*)(bb + 8 * g), x1 = *(const f32x4*)(bb + 32 + 8 * g); \
                _Pragma("unroll") for (int e = 0; e < 4; ++e) { C0[4 * g + e] += x0[e]; C1[4 * g + e] += x1[e]; } } } \
        if (tt >= NT - 4) { const int kb0 = 64 * (tt - (NT - 4)) + 4 * hi; \
            _Pragma("unroll") for (int r = 0; r < 16; ++r) { const int kv = kb0 + (r & 3) + 8 * (r >> 2); if (kv > qrel) C0[r] = -INFINITY; if (kv + 32 > qrel) C1[r] = -INFINITY; } } \
        { float a_ = max3f(C0[0], C0[1], C1[0]), b_ = max3f(C0[2], C0[3], C1[1]); a_ = max3f(a_, C1[2], C1[3]); \
          _Pragma("unroll") for (int r = 4; r < 16; r += 4) { a_ = max3f(a_, C0[r], C0[r + 1]); b_ = max3f(b_, C0[r + 2], C0[r + 3]); a_ = max3f(a_, C1[r], C1[r + 1]); b_ = max3f(b_, C1[r + 2], C1[r + 3]); } \
          RM = max2f(a_, b_); auto rr = __builtin_amdgcn_permlane32_swap(__float_as_uint(RM), __float_as_uint(RM), false, false); RM = max2f(__uint_as_float(rr[0]), __uint_as_float(rr[1])); } } while (0)
    { A2_ISSUE(T0);
      float bnext = 0.f; if (BIAS && wid == 0 && T0 + 1 < NT) bnext = cumh[(size_t)((T0 + 1) * 64 + lane) * 8];
      const unsigned ka_ = lds0 + L_K + (T0 & 1) * KSLOT + hi * 1024 + r32 * 16;
#pragma unroll
      for (int d0 = 0; d0 < ND; ++d0) { bf16x8 k0, k1; A2_KRD(k0, d0 * 2048); A2_KRD(k1, d0 * 2048 + 512); asm volatile("s_waitcnt lgkmcnt(0)" : "+v"(k0), "+v"(k1) :: "memory"); A2_SB();
          if (d0 == 0) { cA0 = __builtin_amdgcn_mfma_f32_32x32x16_bf16(k0, qr[0], negm, 0, 0, 0); cA1 = __builtin_amdgcn_mfma_f32_32x32x16_bf16(k1, qr[0], negm, 0, 0, 0); }
          else { cA0 = __builtin_amdgcn_mfma_f32_32x32x16_bf16(k0, qr[d0], cA0, 0, 0, 0); cA1 = __builtin_amdgcn_mfma_f32_32x32x16_bf16(k1, qr[d0], cA1, 0, 0, 0); } }
      asm volatile("s_nop 15\n\ts_nop 7" : "+v"(cA0), "+v"(cA1));
      float rm; A2_BMM(cA0, cA1, T0, rm);
      mhat = rm;
#pragma unroll
      for (int r = 0; r < 16; ++r) { ATT_SUBI(cA0[r], rm); ATT_SUBI(cA1[r], rm); }
#pragma unroll
      for (int r = 0; r < 16; ++r) negm[r] = -mhat;
#pragma unroll
      for (int r = 0; r < 16; ++r) { cA0[r] = __builtin_amdgcn_exp2f(cA0[r]); cA1[r] = __builtin_amdgcn_exp2f(cA1[r]); }
      if (BIAS && wid == 0 && T0 + 1 < NT) Bs[((T0 + 1) & 1) * 64 + lane] = (cref - bnext) * 1.4426950408889634f;
      ATT_WAIT_BAR(); A2_POST(T0); }
#define A2_STEP(C0, C1, P0, P1, t_) do { const int t = (t_); \
        float bnext = 0.f; if (BIAS && wid == 0 && t + 1 < NT) bnext = cumh[(size_t)((t + 1) * 64 + lane) * 8]; \
        const unsigned ka_ = lds0 + L_K + (t & 1) * KSLOT + hi * 1024 + r32 * 16; const int vb_ = vb0 + ((t - 1) % 3) * VSLOT; \
        s16x4 vlo[4], vhi[4]; u32x4 pw[4]; f32x2_t sacc = {0.f, 0.f}; \
          \
        asm volatile("s_waitcnt lgkmcnt(0)" : "+v"(kfa[0]), "+v"(kfa[1]), "+v"(kfa[2]), "+v"(kfa[3]) :: "memory"); asm volatile("" : "+v"(kfb[0]), "+v"(kfb[1]), "+v"(kfb[2]), "+v"(kfb[3])); A2_SB();     \
        C0 = __builtin_amdgcn_mfma_f32_32x32x16_bf16(kfa[0], qr[0], negm, 0, 0, 0); A2_VRD(0, 0); a2_chunk<0, PER>(P0, P1, sacc, pw); A2_PIN(sacc); A2_SB(); \
        C1 = __builtin_amdgcn_mfma_f32_32x32x16_bf16(kfa[1], qr[0], negm, 0, 0, 0); A2_VRD(1, 4); a2_chunk<1, PER>(P0, P1, sacc, pw); A2_PIN(sacc); A2_SB(); \
        C0 = __builtin_amdgcn_mfma_f32_32x32x16_bf16(kfa[2], qr[1], C0, 0, 0, 0);   A2_VRD(2, 1); a2_chunk<2, PER>(P0, P1, sacc, pw); A2_PIN(sacc); A2_SB(); \
        C1 = __builtin_amdgcn_mfma_f32_32x32x16_bf16(kfa[3], qr[1], C1, 0, 0, 0);                 a2_chunk<3, PER>(P0, P1, sacc, pw); A2_PIN(sacc); A2_SB(); \
        if (ND > 4) { A2_KRD(kfa[0], 8192); A2_KRD(kfa[1], 8704); A2_KRD(kfa[2], 10240); A2_KRD(kfa[3], 10752); } \
        asm volatile("s_waitcnt lgkmcnt(%c0)" :: "i"(ND > 4 ? 10 : 6) : "memory"); A2_SB();     \
        C0 = __builtin_amdgcn_mfma_f32_32x32x16_bf16(kfb[0], qr[2], C0, 0, 0, 0);   A2_VRD(3, 5); a2_chunk<4, PER>(P0, P1, sacc, pw); A2_PIN(sacc); A2_SB(); \
        C1 = __builtin_amdgcn_mfma_f32_32x32x16_bf16(kfb[1], qr[2], C1, 0, 0, 0);                 a2_chunk<5, PER>(P0, P1, sacc, pw); A2_PIN(sacc); A2_SB(); \
        C0 = __builtin_amdgcn_mfma_f32_32x32x16_bf16(kfb[2], qr[3], C0, 0, 0, 0);                 a2_chunk<6, PER>(P0, P1, sacc, pw); A2_PIN(sacc); A2_SB(); \
        C1 = __builtin_amdgcn_mfma_f32_32x32x16_bf16(kfb[3], qr[3], C1, 0, 0, 0);                 a2_chunk<7, PER>(P0, P1, sacc, pw); A2_PIN(sacc); A2_SB(); \
        if (ND > 4) { asm volatile("s_waitcnt lgkmcnt(2)" ::: "memory"); A2_SB();               \
            C0 = __builtin_amdgcn_mfma_f32_32x32x16_bf16(kfa[0], qr[ND > 4 ? 4 : 0], C0, 0, 0, 0); a2_chunk<8, PER>(P0, P1, sacc, pw); A2_PIN(sacc); A2_SB(); \
            C1 = __builtin_amdgcn_mfma_f32_32x32x16_bf16(kfa[1], qr[ND > 4 ? 4 : 0], C1, 0, 0, 0); a2_chunk<9, PER>(P0, P1, sacc, pw); A2_PIN(sacc); A2_SB(); \
            C0 = __builtin_amdgcn_mfma_f32_32x32x16_bf16(kfa[2], qr[ND > 4 ? 5 : 0], C0, 0, 0, 0); a2_chunk<10, PER>(P0, P1, sacc, pw); A2_PIN(sacc); A2_SB(); \
            C1 = __builtin_amdgcn_mfma_f32_32x32x16_bf16(kfa[3], qr[ND > 4 ? 5 : 0], C1, 0, 0, 0); a2_chunk<11, PER>(P0, P1, sacc, pw); A2_PIN(sacc); A2_SB(); } \
        l_reg += sacc[0] + sacc[1]; \
          \
        asm volatile("s_nop 15\n\ts_nop 7" : "+v"(C0), "+v"(C1));     \
        float rm; A2_BMM(C0, C1, t, rm); bool resc = false; \
        if (__any(rm > 8.0f)) { const float dl = fmaxf(rm, 0.f); mhat += dl; \
            _Pragma("unroll") for (int r = 0; r < 16; ++r) { ATT_SUBI(C0[r], dl); ATT_SUBI(C1[r], dl); } \
            _Pragma("unroll") for (int r = 0; r < 16; ++r) negm[r] = -mhat; \
            const float f = __builtin_amdgcn_exp2f(-dl); l_reg *= f; if (hi == 0) wsf[r32] = f; resc = true; } \
        if (BIAS && wid == 0 && t + 1 < NT) Bs[((t + 1) & 1) * 64 + lane] = (cref - bnext) * 1.4426950408889634f; \
        ATT_WAIT_BAR(); A2_SB(); A2_POST(t); A2_SB();     \
          \
          \
        o[0] = __builtin_amdgcn_mfma_f32_32x32x16_bf16(__builtin_bit_cast(bf16x8, pw[0]), A2_VFR(0), o[0], 0, 0, 0); A2_VRD(0, 2); C0[0] = __builtin_amdgcn_exp2f(C0[0]); C0[1] = __builtin_amdgcn_exp2f(C0[1]); C0[2] = __builtin_amdgcn_exp2f(C0[2]); C0[3] = __builtin_amdgcn_exp2f(C0[3]); A2_PIN(C0); A2_SB(); \
        o[1] = __builtin_amdgcn_mfma_f32_32x32x16_bf16(__builtin_bit_cast(bf16x8, pw[0]), A2_VFR(1), o[1], 0, 0, 0); A2_VRD(1, 6); C0[4] = __builtin_amdgcn_exp2f(C0[4]); C0[5] = __builtin_amdgcn_exp2f(C0[5]); C0[6] = __builtin_amdgcn_exp2f(C0[6]); C0[7] = __builtin_amdgcn_exp2f(C0[7]); A2_PIN(C0); A2_SB(); \
        o[0] = __builtin_amdgcn_mfma_f32_32x32x16_bf16(__builtin_bit_cast(bf16x8, pw[1]), A2_VFR(2), o[0], 0, 0, 0); A2_VRD(2, 3); C0[8] = __builtin_amdgcn_exp2f(C0[8]); C0[9] = __builtin_amdgcn_exp2f(C0[9]); C0[10] = __builtin_amdgcn_exp2f(C0[10]); C0[11] = __builtin_amdgcn_exp2f(C0[11]); A2_PIN(C0); A2_SB(); \
        o[1] = __builtin_amdgcn_mfma_f32_32x32x16_bf16(__builtin_bit_cast(bf16x8, pw[1]), A2_VFR(3), o[1], 0, 0, 0); asm volatile("s_waitcnt lgkmcnt(12)" ::: "memory"); A2_VRD(3, 7); C0[12] = __builtin_amdgcn_exp2f(C0[12]); C0[13] = __builtin_amdgcn_exp2f(C0[13]); C0[14] = __builtin_amdgcn_exp2f(C0[14]); C0[15] = __builtin_amdgcn_exp2f(C0[15]); A2_PIN(C0); A2_SB(); \
        asm volatile("s_waitcnt lgkmcnt(6)" ::: "memory"); A2_SB(); o[0] = __builtin_amdgcn_mfma_f32_32x32x16_bf16(__builtin_bit_cast(bf16x8, pw[2]), A2_VFR(0), o[0], 0, 0, 0); C1[0] = __builtin_amdgcn_exp2f(C1[0]); C1[1] = __builtin_amdgcn_exp2f(C1[1]); C1[2] = __builtin_amdgcn_exp2f(C1[2]); C1[3] = __builtin_amdgcn_exp2f(C1[3]); A2_PIN(C1); A2_SB(); \
        asm volatile("s_waitcnt lgkmcnt(4)" ::: "memory"); A2_SB(); o[1] = __builtin_amdgcn_mfma_f32_32x32x16_bf16(__builtin_bit_cast(bf16x8, pw[2]), A2_VFR(1), o[1], 0, 0, 0); C1[4] = __builtin_amdgcn_exp2f(C1[4]); C1[5] = __builtin_amdgcn_exp2f(C1[5]); C1[6] = __builtin_amdgcn_exp2f(C1[6]); C1[7] = __builtin_amdgcn_exp2f(C1[7]); A2_PIN(C1); A2_SB(); \
        asm volatile("s_waitcnt lgkmcnt(2)" ::: "memory"); A2_SB(); o[0] = __builtin_amdgcn_mfma_f32_32x32x16_bf16(__builtin_bit_cast(bf16x8, pw[3]), A2_VFR(2), o[0], 0, 0, 0); C1[8] = __builtin_amdgcn_exp2f(C1[8]); C1[9] = __builtin_amdgcn_exp2f(C1[9]); C1[10] = __builtin_amdgcn_exp2f(C1[10]); C1[11] = __builtin_amdgcn_exp2f(C1[11]); A2_PIN(C1); A2_SB(); \
        asm volatile("s_waitcnt lgkmcnt(0)" ::: "memory"); A2_SB(); o[1] = __builtin_amdgcn_mfma_f32_32x32x16_bf16(__builtin_bit_cast(bf16x8, pw[3]), A2_VFR(3), o[1], 0, 0, 0); C1[12] = __builtin_amdgcn_exp2f(C1[12]); C1[13] = __builtin_amdgcn_exp2f(C1[13]); C1[14] = __builtin_amdgcn_exp2f(C1[14]); C1[15] = __builtin_amdgcn_exp2f(C1[15]); A2_PIN(C1); A2_SB(); \
        if (resc) { asm volatile("s_waitcnt lgkmcnt(0)" ::: "memory"); \
            _Pragma("unroll") for (int d_ = 0; d_ < 2; ++d_) _Pragma("unroll") for (int r = 0; r < 16; ++r) o[d_][r] *= wsf[crow(r, hi)]; } \
        } while (0)
#define A2_DRAIN(P0, P1) do { const int vb_ = vb0 + ((NT - 1) % 3) * VSLOT; s16x4 vlo[4], vhi[4]; u32x4 pw[4]; f32x2_t sacc = {0.f, 0.f}; \
        A2_VRD(0, 0); A2_VRD(1, 4); A2_VRD(2, 1); A2_VRD(3, 5); \
        a2_chunk<0, 32>(P0, P1, sacc, pw); l_reg += sacc[0] + sacc[1]; \
        asm volatile("s_waitcnt lgkmcnt(0)" ::: "memory"); A2_SB(); \
        o[0] = __builtin_amdgcn_mfma_f32_32x32x16_bf16(__builtin_bit_cast(bf16x8, pw[0]), A2_VFR(0), o[0], 0, 0, 0); o[1] = __builtin_amdgcn_mfma_f32_32x32x16_bf16(__builtin_bit_cast(bf16x8, pw[0]), A2_VFR(1), o[1], 0, 0, 0); \
        o[0] = __builtin_amdgcn_mfma_f32_32x32x16_bf16(__builtin_bit_cast(bf16x8, pw[1]), A2_VFR(2), o[0], 0, 0, 0); o[1] = __builtin_amdgcn_mfma_f32_32x32x16_bf16(__builtin_bit_cast(bf16x8, pw[1]), A2_VFR(3), o[1], 0, 0, 0); A2_SB(); \
        A2_VRD(0, 2); A2_VRD(1, 6); A2_VRD(2, 3); A2_VRD(3, 7); asm volatile("s_waitcnt lgkmcnt(0)" ::: "memory"); A2_SB(); \
        o[0] = __builtin_amdgcn_mfma_f32_32x32x16_bf16(__builtin_bit_cast(bf16x8, pw[2]), A2_VFR(0), o[0], 0, 0, 0); o[1] = __builtin_amdgcn_mfma_f32_32x32x16_bf16(__builtin_bit_cast(bf16x8, pw[2]), A2_VFR(1), o[1], 0, 0, 0); \
        o[0] = __builtin_amdgcn_mfma_f32_32x32x16_bf16(__builtin_bit_cast(bf16x8, pw[3]), A2_VFR(2), o[0], 0, 0, 0); o[1] = __builtin_amdgcn_mfma_f32_32x32x16_bf16(__builtin_bit_cast(bf16x8, pw[3]), A2_VFR(3), o[1], 0, 0, 0); } while (0)
    { int tl = T0 + 1;
#pragma unroll 1
      for (; tl + 1 < NT; tl += 2) { A2_STEP(cB0, cB1, cA0, cA1, tl); A2_STEP(cA0, cA1, cB0, cB1, tl + 1); }
      if (tl < NT) { A2_STEP(cB0, cB1, cA0, cA1, tl); A2_DRAIN(cB0, cB1); } else { A2_DRAIN(cA0, cA1); } }
#undef A2_STEP
#undef A2_DRAIN
#undef A2_BMM
#undef A2_KRD
#undef A2_VRD
#undef A2_VFR
#undef A2_DMAK
#undef A2_DMAV
#undef A2_ISSUE
#undef A2_POST
#undef A2_KRDB
    { auto rr = __builtin_amdgcn_permlane32_swap(__float_as_uint(l_reg), __float_as_uint(l_reg), false, false); l_reg = __uint_as_float(rr[0]) + __uint_as_float(rr[1]); }
    if (hi == 0) wsf[32 + r32] = l_reg; asm volatile("s_waitcnt lgkmcnt(0)" ::: "memory");
    float rli[16];
#pragma unroll
    for (int r = 0; r < 16; ++r) rli[r] = __builtin_amdgcn_rcpf(wsf[32 + crow(r, hi)]);
    bf16* Ow = Oh + (size_t)(q0 + wid * 32) * DM;
    { bf16* stg = (bf16*)(shm + L_OST) + wid * 2048;
#pragma unroll
      for (int r = 0; r < 16; ++r) { const int orow = crow(r, hi);
#pragma unroll
        for (int d0 = 0; d0 < 2; ++d0) stg[orow * 64 + d0 * 32 + r32] = (bf16)f2bf(o[d0][r] * rli[r]); }
      asm volatile("s_waitcnt lgkmcnt(0)" ::: "memory");
#pragma unroll
      for (int i = 0; i < 4; ++i) { const int row = i * 8 + (lane >> 3), ch = lane & 7; const u32x4 v = *(const u32x4*)(stg + row * 64 + ch * 8); *(u32x4*)(Ow + (size_t)row * DM + ch * 8) = v; } }
    asm volatile("s_waitcnt lgkmcnt(0)\n\ts_barrier" ::: "memory");
}
#undef A2_SB
#undef A2_PIN
}
#ifndef ATTN_V2
#define ATT_UNIT att::attn_unit
#define ATT_UNIT_FOX att::attn_unit
#elif ATTN_V2 == 2
#define ATT_UNIT att::attn_unit2
#define ATT_UNIT_FOX att::attn_unit
#elif ATTN_V2 == 3
#define ATT_UNIT att::attn_unit
#define ATT_UNIT_FOX att::attn_unit2
#else
#define ATT_UNIT att::attn_unit2
#define ATT_UNIT_FOX att::attn_unit2
#endif
constexpr int CW_AQ = 2048;
__device__ __forceinline__ void phase_attn_mfma(Frame& F, int j) {
    const bf16* PROJ = (const bf16*)(F.ws + WS_PROJ); const bf16* QM = (const bf16*)(F.ws + WS_QM); const bf16* KVB = (const bf16*)(F.ws + WS_KVB); const bf16* KM = (const bf16*)(F.ws + WS_KM);
    const float* CUM = (const float*)(F.ws + WS_CUM); bf16* MIX = (bf16*)(F.ws + WS_MIX);
    char* shm = (char*)(F.lds + RING_OFF);
    LAS int* qslot = (LAS int*)(F.lds + LDSCTL_OFF + 64);
    { const int xcd0 = (int)(xb_xcc_id() & 7u);
#pragma unroll 1
      for (int dq = 0; dq < 8; ++dq) { const int xcd = (xcd0 + dq) & 7;
#pragma unroll 1
        for (;;) {
          if (F.tid == 0) *qslot = (int)__hip_atomic_fetch_add(F.ctl + CW_AQ + 1024 + (j * 8 + xcd) * 64, 1u, __ATOMIC_RELAXED, __HIP_MEMORY_SCOPE_AGENT);
          __syncthreads(); const int u = __builtin_amdgcn_readfirstlane(*qslot); __syncthreads();
          if (u >= 128) break;
          const int qb = 63 - (u >> 1), combo = 2 * xcd + (u & 1), b = combo >> 3, h = combo & 7; const size_t rb = (size_t)b * SEQ;
          ATT_UNIT<96, false>(F.tid, qb, QM + rb * 768 + h * 96, 768, KM + rb * 768 + h * 96, 768, KVB + rb * 1024 + h * 128 + 64, 1024, nullptr, MIX + rb * DM + 512 + h * 64, shm, 0.f);
        } } }
    float gq = fabsf(kin(I_FOX_QN)[j * 64 + F.lane]), gk = fabsf(kin(I_FOX_KN)[j * 64 + F.lane]);
#pragma unroll
    for (int o = 1; o < 64; o <<= 1) { gq = fmaxf(gq, __shfl_xor(gq, o)); gk = fmaxf(gk, __shfl_xor(gk, o)); }
    const float margin = 2.0f * 1.02f * 64.0f * gq * gk * C2_FOX;
#pragma unroll 1
    for (;;) {
        if (F.tid == 0) *qslot = (int)__hip_atomic_fetch_add(F.ctl + CW_AQ + 64 * j, 1u, __ATOMIC_RELAXED, __HIP_MEMORY_SCOPE_AGENT);
        __syncthreads(); const int u = __builtin_amdgcn_readfirstlane(*qslot); __syncthreads();
        if (u >= 1024) break;
        const int qb = 63 - (u >> 4), combo = u & 15, b = combo >> 3, h = combo & 7; const size_t rb = (size_t)b * SEQ;
        ATT_UNIT_FOX<64, true>(F.tid, qb, PROJ + rb * EVEN_INP + E_FQ + h * 64, EVEN_INP, PROJ + rb * EVEN_INP + E_FK + h * 64, EVEN_INP, PROJ + rb * EVEN_INP + E_FV + h * 64, EVEN_INP, CUM + rb * 8 + h, MIX + rb * DM + h * 64, shm, margin);
    }
}
constexpr size_t WS_S5_MT = WS_Y2;
constexpr size_t WS_S5_PT = WS_S5_MT + 72 * MiB;
constexpr size_t WS_S5_AX = WS_S5_PT + 16 * MiB;
constexpr size_t WS_S5_XLOC = WS_S5_AX + 36 * MiB;
static_assert(WS_S5_XLOC + 8 * MiB <= WS_Y2 + 144 * MiB, "s5 overlay");

__device__ __forceinline__ void s5_build(Frame& F, int j) {
    if (F.bid >= 256) return;
    const int g = F.bid >> 3, part = F.bid & 7, tid = F.tid, lane = F.lane, wave = F.wave;
    LAS float* pwr = (LAS float*)(F.lds + RING_OFF);
    LAS float* pwi = pwr + 65 * 64;
    LAS float* bbr = pwi + 65 * 64;
    LAS float* bbi = bbr + 1024;
    LAS float* crs = bbi + 1024;
    LAS float* cis = crs + 1024;
    LAS bf16* ktab = (LAS bf16*)(cis + 1024);
    const float dt = expf(kin(I_S5_LS)[j * 32 + g]);
    const float* are = kin(I_S5_ARE) + (size_t)(j * 32 + g) * 64; const float* aim = kin(I_S5_AIM) + (size_t)(j * 32 + g) * 64;
    for (int e = tid; e < 65 * 64; e += 512) { const int d = e >> 6, p = e & 63; const float lr = fminf(are[p], -1e-4f), li = aim[p];
        const float mag = expf(lr * dt * (float)d); float sn, cs; sincosf(li * dt * (float)d, &sn, &cs); pwr[e] = mag * cs; pwi[e] = mag * sn; }
    for (int e = tid; e < 1024; e += 512) { const int p = e >> 4, c = e & 15; const float lr = fminf(are[p], -1e-4f), li = aim[p];
        const float mag = expf(lr * dt); float sn, cs; sincosf(li * dt, &sn, &cs); const float abr = mag * cs, abi = mag * sn;
        const float den = lr * lr + li * li, nr = abr - 1.0f, ni = abi; const float gr = (nr * lr + ni * li) / den, gi = (ni * lr - nr * li) / den;
        const float br = kin(I_S5_BRE)[((size_t)(j * 32 + g) * 64 + p) * 16 + c], bi = kin(I_S5_BIM)[((size_t)(j * 32 + g) * 64 + p) * 16 + c];
        bbr[e] = gr * br - gi * bi; bbi[e] = gr * bi + gi * br; }
    for (int e = tid; e < 1024; e += 512) { crs[e] = kin(I_S5_CRE)[(size_t)(j * 32 + g) * 1024 + e]; cis[e] = kin(I_S5_CIM)[(size_t)(j * 32 + g) * 1024 + e]; }
    __syncthreads();
    { const int cc = tid >> 1, c = cc >> 4, c2 = cc & 15, ph = tid & 1;
      float er[32], ei[32];
#pragma unroll
      for (int pp = 0; pp < 32; ++pp) { const int p = 32 * ph + pp; const float xr = crs[c * 64 + p], xi = cis[c * 64 + p], yr = bbr[p * 16 + c2], yi = bbi[p * 16 + c2]; er[pp] = xr * yr - xi * yi; ei[pp] = xr * yi + xi * yr; }
#pragma unroll 1
      for (int d = 0; d < 64; ++d) { float s = 0.f; const LAS float* wr_ = pwr + d * 64 + 32 * ph; const LAS float* wi_ = pwi + d * 64 + 32 * ph;
#pragma unroll
          for (int pp = 0; pp < 32; ++pp) s += wr_[pp] * er[pp] - wi_[pp] * ei[pp];
          s += __shfl_xor(s, 1);
          if (ph == 0) ktab[(d * 16 + c) * 16 + c2] = (bf16)f2bf(s); } }
    __syncthreads();
    bf16* MT = (bf16*)(F.ws + WS_S5_MT) + (size_t)g * 1024 * 1152;
#pragma unroll 1
    for (int rr = wave; rr < 128; rr += 8) { const int i = part * 8 + (rr >> 4), c = rr & 15; bf16* row = MT + (size_t)(i * 16 + c) * 1152;
        v4u a = {0u, 0u, 0u, 0u}, b = {0u, 0u, 0u, 0u};
        if (lane <= i) { const LAS v4u* src = (const LAS v4u*)(ktab + ((i - lane) * 16 + c) * 16); a = src[0]; b = src[1]; }
        *(v4u*)(row + lane * 16) = a; *(v4u*)(row + lane * 16 + 8) = b;
        { const int p = lane; const float xr = crs[c * 64 + p], xi = cis[c * 64 + p], wr_ = pwr[(i + 1) * 64 + p], wi_ = pwi[(i + 1) * 64 + p];
          row[1024 + p] = (bf16)f2bf(xr * wr_ - xi * wi_); row[1088 + p] = (bf16)f2bf(-(xr * wi_ + xi * wr_)); } }
    bf16* PT = (bf16*)(F.ws + WS_S5_PT) + (size_t)g * 256 * 1024;
#pragma unroll 1
    for (int rr = wave; rr < 32; rr += 8) { const int n = part * 32 + rr; bf16* row = PT + (size_t)n * 1024 + lane * 16;
        unsigned o[8];
        if (n < 128) { const int p = n & 63, im = n >> 6; const float wr_ = pwr[(63 - lane) * 64 + p], wi_ = pwi[(63 - lane) * 64 + p];
#pragma unroll
            for (int q = 0; q < 8; ++q) { const float y0r = bbr[p * 16 + 2 * q], y0i = bbi[p * 16 + 2 * q], y1r = bbr[p * 16 + 2 * q + 1], y1i = bbi[p * 16 + 2 * q + 1];
                const float v0 = im ? (wr_ * y0i + wi_ * y0r) : (wr_ * y0r - wi_ * y0i), v1 = im ? (wr_ * y1i + wi_ * y1r) : (wr_ * y1r - wi_ * y1i); o[q] = pk2(v0, v1); }
        } else {
#pragma unroll
            for (int q = 0; q < 8; ++q) o[q] = 0u; }
        *(v4u*)row = (v4u){o[0], o[1], o[2], o[3]}; *(v4u*)(row + 8) = (v4u){o[4], o[5], o[6], o[7]}; }
    __syncthreads();
}
__device__ __forceinline__ void s5_repack(Frame& F) {
    const bf16* PROJ = (const bf16*)(F.ws + WS_PROJ); bf16* AX = (bf16*)(F.ws + WS_S5_AX);
    const int gt = F.bid * 512 + F.tid, NT = F.G * 512;
    for (int e = gt; e < NTOK * 32; e += NT) { const int m = e >> 5, g = e & 31; const int b = m / SEQ, t = m % SEQ, n = t >> 6, s = t & 63;
        const v4u* src = (const v4u*)(PROJ + (size_t)m * ODD_INP + O_U + g * 16); v4u* dst = (v4u*)(AX + ((size_t)g * 512 + b * 256 + n) * 1152 + s * 16);
        const v4u x0 = src[0], x1 = src[1]; dst[0] = x0; dst[1] = x1; }
}
struct S5POrder {
    int G, c;
    __device__ bool next(int i, pg8::Unit& u) const { const int L = i * G + c; if (L >= 64) return false; u.aux = L >> 1; u.pm = L & 1; u.pn = 0; return true; }
    __device__ __forceinline__ const char* a_base(const pg8::Gemm& g, const pg8::Unit& u) const { return (const char*)g.A + ((size_t)u.aux * 512 + u.pm * 256) * 1152 * 2; }
    __device__ __forceinline__ const char* b_base(const pg8::Gemm& g, const pg8::Unit& u) const { return (const char*)g.Bt + (size_t)u.aux * 256 * 1024 * 2; }
};
struct S5PEpi {
    static constexpr bool PERM = false;
    float* X;
    __device__ __forceinline__ void operator()(const pg8::f32x4 (&acc)[2][2][4][2], const pg8::Unit& u, int wr, int wc, int fr, int fq) const {
        const int row0 = u.pm * 256 + wr * 64 + fr; const int col0 = wc * 32 + 4 * fq;
#pragma unroll
        for (int ai = 0; ai < 2; ++ai)
#pragma unroll
            for (int m = 0; m < 4; ++m) { float* rowp = X + ((size_t)u.aux * 512 + row0 + ai * 128 + m * 16) * 128 + col0;
#pragma unroll
                for (int n = 0; n < 2; ++n) *(pg8::f32x4*)(rowp + n * 16) = acc[ai][0][m][n]; }
    }
};
__device__ __forceinline__ void s5_scan(Frame& F, int j, int gsel = -1) {
    int gw = F.bid * NWAVES + F.wave; if (gsel >= 0) { if (F.wave >= 2) return; gw = gsel * 2 + F.wave; } if (gw >= 64) return;
    const int g = gw >> 1, b = gw & 1, p = F.lane;
    const float lr = fminf(kin(I_S5_ARE)[(size_t)(j * 32 + g) * 64 + p], -1e-4f), li = kin(I_S5_AIM)[(size_t)(j * 32 + g) * 64 + p]; const float dt = expf(kin(I_S5_LS)[j * 32 + g]);
    const float mag = expf(lr * dt * 64.f); float sn, cs; sincosf(li * dt * 64.f, &sn, &cs); const float ar = mag * cs, ai = mag * sn;
    const float* X = (const float*)(F.ws + WS_S5_XLOC) + ((size_t)g * 512 + b * 256) * 128; bf16* AX = (bf16*)(F.ws + WS_S5_AX) + ((size_t)g * 512 + b * 256) * 1152 + 1024;
    float xr = 0.f, xi = 0.f; float cr[8], ci[8], nr[8], ni[8];
#pragma unroll
    for (int q = 0; q < 8; ++q) { cr[q] = X[(size_t)q * 128 + p]; ci[q] = X[(size_t)q * 128 + 64 + p]; }
    for (int n0 = 0; n0 < 256; n0 += 8) { const int nn = (n0 + 8 < 256) ? n0 + 8 : n0;
#pragma unroll
        for (int q = 0; q < 8; ++q) { nr[q] = X[(size_t)(nn + q) * 128 + p]; ni[q] = X[(size_t)(nn + q) * 128 + 64 + p]; }
#pragma unroll
        for (int q = 0; q < 8; ++q) { AX[(size_t)(n0 + q) * 1152 + p] = (bf16)f2bf(xr); AX[(size_t)(n0 + q) * 1152 + 64 + p] = (bf16)f2bf(xi);
            const float tr = ar * xr - ai * xi + cr[q], ti = ar * xi + ai * xr + ci[q]; xr = tr; xi = ti; }
#pragma unroll
        for (int q = 0; q < 8; ++q) { cr[q] = nr[q]; ci[q] = ni[q]; } }
}
struct S5MOrder {
    int G, c;
    __device__ bool next(int i, pg8::Unit& u) const { const int L = i * G + c; if (L >= 256) return false; u.aux = L >> 3; u.pm = (L >> 2) & 1; u.pn = L & 3; return true; }
    __device__ __forceinline__ const char* a_base(const pg8::Gemm& g, const pg8::Unit& u) const { return (const char*)g.A + ((size_t)u.aux * 512 + u.pm * 256) * 1152 * 2; }
    __device__ __forceinline__ const char* b_base(const pg8::Gemm& g, const pg8::Unit& u) const { return (const char*)g.Bt + ((size_t)u.aux * 1024 + u.pn * 256) * 1152 * 2; }
};
struct S5MEpi {
    static constexpr bool PERM = true;
    bf16* HG; const bf16* PROJ; const float* dsk;
    __device__ __forceinline__ void operator()(const pg8::f32x4 (&acc)[2][2][4][2], const pg8::Unit& u, int wr, int wc, int fr, int fq) const {
        const int g = u.aux; const int row0 = u.pm * 256 + wr * 64 + fr; const int col0 = u.pn * 256 + wc * 32 + 8 * fq;
        const pg8::f32x4 d0 = *(const pg8::f32x4*)(dsk + g * 16 + (col0 & 15)), d1 = *(const pg8::f32x4*)(dsk + g * 16 + (col0 & 15) + 4);
#pragma unroll
        for (int ai = 0; ai < 2; ++ai)
#pragma unroll
            for (int m = 0; m < 4; ++m) { const int rg = row0 + ai * 128 + m * 16; const int b = rg >> 8, n = rg & 255;
#pragma unroll
                for (int bj = 0; bj < 2; ++bj) { const int col = col0 + bj * 128; const int i = col >> 4, c0 = col & 15; const size_t tok = (size_t)b * SEQ + n * 64 + i;
                    const pg8::u32x4 uw = *(const pg8::u32x4*)(PROJ + tok * ODD_INP + O_U + g * 16 + c0); const pg8::f32x4 v0 = acc[ai][bj][m][0], v1 = acc[ai][bj][m][1];
                    pg8::u32x4 w; w.x = pk2(gelu_tanh(v0[0] + d0[0] * bflo(uw.x)), gelu_tanh(v0[1] + d0[1] * bfhi(uw.x))); w.y = pk2(gelu_tanh(v0[2] + d0[2] * bflo(uw.y)), gelu_tanh(v0[3] + d0[3] * bfhi(uw.y)));
                    w.z = pk2(gelu_tanh(v1[0] + d1[0] * bflo(uw.z)), gelu_tanh(v1[1] + d1[1] * bfhi(uw.z))); w.w = pk2(gelu_tanh(v1[2] + d1[2] * bflo(uw.w)), gelu_tanh(v1[3] + d1[3] * bfhi(uw.w)));
                    *(pg8::u32x4*)(HG + tok * 512 + g * 16 + c0) = w; } }
    }
};

struct S5GroupP { int g;
    __device__ bool next(int i, pg8::Unit& u) const { if (i >= 2) return false; u.aux = g; u.pm = i; u.pn = 0; return true; }
    __device__ __forceinline__ const char* a_base(const pg8::Gemm& gm, const pg8::Unit& u) const { return (const char*)gm.A + ((size_t)u.aux * 512 + u.pm * 256) * 1152 * 2; }
    __device__ __forceinline__ const char* b_base(const pg8::Gemm& gm, const pg8::Unit& u) const { return (const char*)gm.Bt + (size_t)u.aux * 256 * 1024 * 2; } };
struct S5GroupM { int g;
    __device__ bool next(int i, pg8::Unit& u) const { if (i >= 8) return false; u.aux = g; u.pm = i >> 2; u.pn = i & 3; return true; }
    __device__ __forceinline__ const char* a_base(const pg8::Gemm& gm, const pg8::Unit& u) const { return (const char*)gm.A + ((size_t)u.aux * 512 + u.pm * 256) * 1152 * 2; }
    __device__ __forceinline__ const char* b_base(const pg8::Gemm& gm, const pg8::Unit& u) const { return (const char*)gm.Bt + ((size_t)u.aux * 1024 + u.pn * 256) * 1152 * 2; } };
namespace gdn {
typedef short s16x4 __attribute__((ext_vector_type(4)));
#define GDN_MFMA(a, b, c) __builtin_amdgcn_mfma_f32_16x16x16bf16_1k(a, b, c, 0, 0, 0)
__device__ __forceinline__ float fsig(float x) { return __builtin_amdgcn_rcpf(1.0f + __expf(-x)); }
__device__ __forceinline__ float bperm(float v, int src_lane) { return __int_as_float(__builtin_amdgcn_ds_bpermute(src_lane << 2, __float_as_int(v))); }
__device__ __forceinline__ s16x4 pack4(float a, float b, float c, float d) { v2u w; w.x = pk2(a, b); w.y = pk2(c, d); return __builtin_bit_cast(s16x4, w); }
constexpr int NITEM = BATCH * 4 * (SEQ / 16);
constexpr int IMG_STRIDE = 144;
constexpr int WAVE_LDS = 1024 + 1024 + 3 * 16 * IMG_STRIDE * 2;
}
constexpr size_t WS_GDN_UB = WS_QG;
constexpr size_t WS_GDN_WT = WS_KG;
constexpr size_t WS_GDN_QD = WS_KG + 32 * MiB;
constexpr size_t WS_GDN_KD = WS_VG;
constexpr size_t WS_GDN_IT = WS_VG + 32 * MiB;

__device__ __forceinline__ void phase_gdn_g1(Frame& F, int j) {
    using namespace gdn;
    const bf16* PROJ = (const bf16*)(F.ws + WS_PROJ);
    const float* cw = kin(I_GDN_CONV) + (size_t)j * 4 * 1536;
    float* UB = (float*)(F.ws + WS_GDN_UB); bf16* WT = (bf16*)(F.ws + WS_GDN_WT); bf16* QD = (bf16*)(F.ws + WS_GDN_QD); bf16* KD = (bf16*)(F.ws + WS_GDN_KD); unsigned* ITE = (unsigned*)(F.ws + WS_GDN_IT);
    LAS float* Am = (LAS float*)(F.lds + RING_OFF + F.wave * WAVE_LDS); LAS float* Tm = Am + 256; LAS bf16* img = (LAS bf16*)(Tm + 256);
    const int gw = F.bid * NWAVES + F.wave, NGW = F.G * NWAVES;
#pragma unroll 1
    for (int item = gw; item < NITEM; item += NGW) {
        int lane = F.lane; asm volatile("" : "+v"(lane));
        const int tok = lane & 15, g4 = lane >> 4;
        const int b = item >> 12, h = (item >> 10) & 3, n = item & 1023; const int s0 = 16 * n + tok; const size_t m = (size_t)b * SEQ + s0;
        const size_t it = (size_t)item;
        const float gin = bf2f(PROJ[m * ODD_INP + O_GIN + h]), bin = bf2f(PROJ[m * ODD_INP + O_BETA + h]);
        const float gt = -expf(kin(I_GDN_ALOG)[j * 4 + h]) * softplusf_(gin + kin(I_GDN_DTB)[j * 4 + h]); const float beta = fsig(bin);
        float gc = gt;
#pragma unroll
        for (int off = 1; off < 16; off <<= 1) { const float t = bperm(gc, tok >= off ? lane - off : lane); if (tok >= off) gc += t; }
        const float glast = bperm(gc, lane | 15); const float eg = expf(gc), ekd = expf(glast - gc);
        LAS bf16* img2 = img + 16 * IMG_STRIDE; LAS bf16* img3 = img2 + 16 * IMG_STRIDE;
#define GDN_CONV(WSEL, X) do { _Pragma("unroll") for (int db = 0; db < 8; ++db) { const int ch = (WSEL) * 512 + h * 128 + 16 * db + 4 * g4; float a0 = 0.f, a1 = 0.f, a2 = 0.f, a3 = 0.f; \
            _Pragma("unroll") for (int tap = 0; tap < 4; ++tap) { if (s0 - 3 + tap >= 0) { const v2u x = *(const v2u*)(PROJ + (m - 3 + tap) * ODD_INP + O_Q + ch); const f32x4 wv = *(const f32x4*)(cw + tap * 1536 + ch); \
                a0 += wv.x * bflo(x.x); a1 += wv.y * bfhi(x.x); a2 += wv.z * bflo(x.y); a3 += wv.w * bfhi(x.y); } } \
            X[db][0] = a0 * fsig(a0); X[db][1] = a1 * fsig(a1); X[db][2] = a2 * fsig(a2); X[db][3] = a3 * fsig(a3); \
            if ((db & 3) == 3) asm volatile("" ::: "memory"); } } while (0)
        { float xv[8][4]; GDN_CONV(2, xv);
#pragma unroll
          for (int db = 0; db < 8; ++db) *(LAS s16x4*)(img + tok * IMG_STRIDE + 16 * db + 4 * g4) = pack4(xv[db][0] * beta, xv[db][1] * beta, xv[db][2] * beta, xv[db][3] * beta); }
        s16x4 Kf[8];
        { float xk[8][4]; GDN_CONV(1, xk); float sk = 0.f;
#pragma unroll
          for (int db = 0; db < 8; ++db)
#pragma unroll
              for (int e = 0; e < 4; ++e) sk += xk[db][e] * xk[db][e];
          sk += bperm(sk, lane ^ 16); sk += bperm(sk, lane ^ 32);
          const float rk = 1.0f / sqrtf(sk + RMS_EPS); const float s2 = rk * beta * eg, s3 = rk * ekd;
#pragma unroll
          for (int db = 0; db < 8; ++db) { const int o = tok * IMG_STRIDE + 16 * db + 4 * g4;
              *(LAS s16x4*)(img2 + o) = pack4(xk[db][0] * s2, xk[db][1] * s2, xk[db][2] * s2, xk[db][3] * s2);
              *(LAS s16x4*)(img3 + o) = pack4(xk[db][0] * s3, xk[db][1] * s3, xk[db][2] * s3, xk[db][3] * s3);
              Kf[db] = pack4(xk[db][0] * rk, xk[db][1] * rk, xk[db][2] * rk, xk[db][3] * rk); } }
        f32x4 Gacc = {0.f, 0.f, 0.f, 0.f}, Pacc = {0.f, 0.f, 0.f, 0.f};
        { float xqq[8][4]; GDN_CONV(0, xqq); float sq = 0.f;
#pragma unroll
          for (int db = 0; db < 8; ++db)
#pragma unroll
              for (int e = 0; e < 4; ++e) sq += xqq[db][e] * xqq[db][e];
          sq += bperm(sq, lane ^ 16); sq += bperm(sq, lane ^ 32);
          const float rq = (1.0f / sqrtf(sq + RMS_EPS)) * 0.08838834764831845f;
#pragma unroll
          for (int db = 0; db < 8; ++db) {
              *(s16x4*)(QD + ((it * 4 + (db >> 1)) * 64 + lane) * 8 + (db & 1) * 4) = pack4(xqq[db][0] * rq * eg, xqq[db][1] * rq * eg, xqq[db][2] * rq * eg, xqq[db][3] * rq * eg);
              const s16x4 Qf = pack4(xqq[db][0] * rq, xqq[db][1] * rq, xqq[db][2] * rq, xqq[db][3] * rq);
              Gacc = GDN_MFMA(Kf[db], Kf[db], Gacc); Pacc = GDN_MFMA(Kf[db], Qf, Pacc); } }
#undef GDN_CONV
        { float itv[4];
#pragma unroll
          for (int r = 0; r < 4; ++r) { const int i = 4 * g4 + r; const float gci = bperm(gc, i), bi = bperm(beta, i);
              const float da = (tok < i) ? expf(gci - gc) : 0.f;
              Am[i * 16 + tok] = bi * Gacc[r] * da;
              const float dp = (i <= tok) ? expf(gc - gci) : 0.f;
              itv[r] = Pacc[r] * dp; }
          v4u ite; ite.x = pk2(itv[0], itv[1]); ite.y = pk2(itv[2], itv[3]); ite.z = __float_as_uint(expf(glast)); ite.w = 0u;
          *(v4u*)(ITE + (it * 64 + lane) * 4) = ite; }
        LDS_WAIT();
        float Tc[16];
#pragma unroll
        for (int i = 0; i < 16; ++i) { float s = (i == tok) ? 1.f : 0.f;
#pragma unroll
            for (int jj = 0; jj < i; ++jj) s -= Am[i * 16 + jj] * Tc[jj];
            Tc[i] = s; }
#pragma unroll
        for (int r = 0; r < 4; ++r) Tm[(4 * g4 + r) * 16 + tok] = (g4 == 0) ? Tc[r] : (g4 == 1) ? Tc[4 + r] : (g4 == 2) ? Tc[8 + r] : Tc[12 + r];
        LDS_WAIT();
        const f32x4 trow = *(const LAS f32x4*)(Tm + tok * 16 + 4 * g4);
        const s16x4 Tf = pack4(trow.x, trow.y, trow.z, trow.w);
        const int traddr = (int)(uintptr_t)img + ((4 * g4 + ((lane & 15) >> 2)) * IMG_STRIDE + 4 * (lane & 3)) * 2;
#pragma unroll
        for (int cb = 0; cb < 8; ++cb) { s16x4 vf; asm volatile("ds_read_b64_tr_b16 %0, %1 offset:%c2\n\ts_waitcnt lgkmcnt(0)" : "=&v"(vf) : "v"(traddr), "i"(cb * 32) : "memory");
            const f32x4 z = {0.f, 0.f, 0.f, 0.f}; const f32x4 u = GDN_MFMA(Tf, vf, z);
            *(f32x4*)(UB + ((it * 8 + cb) * 64 + lane) * 4) = u; }
#pragma unroll
        for (int db = 0; db < 8; ++db) { s16x4 kf; asm volatile("ds_read_b64_tr_b16 %0, %1 offset:%c2\n\ts_waitcnt lgkmcnt(0)" : "=&v"(kf) : "v"(traddr), "i"(16 * IMG_STRIDE * 2 + db * 32) : "memory");
            const f32x4 z = {0.f, 0.f, 0.f, 0.f}; const f32x4 w = GDN_MFMA(kf, Tf, z);
            *(s16x4*)(WT + ((it * 4 + (db >> 1)) * 64 + lane) * 8 + (db & 1) * 4) = pack4(-w.x, -w.y, -w.z, -w.w); }
#pragma unroll
        for (int db = 0; db < 8; ++db) { s16x4 kf; asm volatile("ds_read_b64_tr_b16 %0, %1 offset:%c2\n\ts_waitcnt lgkmcnt(0)" : "=&v"(kf) : "v"(traddr), "i"(32 * IMG_STRIDE * 2 + db * 32) : "memory");
            *(s16x4*)(KD + ((it * 4 + (db >> 1)) * 64 + lane) * 8 + (db & 1) * 4) = kf; }
        LDS_WAIT();
    }
}

__device__ __forceinline__ void phase_gdn_g2(Frame& F) {
    using namespace gdn;
    if (F.bid >= 64) return;
    const char* UB = (const char*)(F.ws + WS_GDN_UB); const char* WT = (const char*)(F.ws + WS_GDN_WT); const char* QD = (const char*)(F.ws + WS_GDN_QD); const char* KD = (const char*)(F.ws + WS_GDN_KD);
    const char* ITE = (const char*)(F.ws + WS_GDN_IT); float* OGN = (float*)(F.ws + WS_OG);
    const int lane = F.lane, bh = F.bid & 7, sl = F.bid >> 3, wave = F.wave;
    constexpr int SLOT = 14 * 1024, NSLOT = 8, INFL = 6;
    volatile LAS int* ready = (volatile LAS int*)(F.lds + LDSCTL_OFF + 128);
    volatile LAS int* done = (volatile LAS int*)(F.lds + LDSCTL_OFF + 192);
    if (F.tid < 8) ready[F.tid] = 0; if (F.tid == 8) *done = 0;
    __syncthreads();
    const size_t it0 = (size_t)bh * 1024;
    if (wave != 0) {
        const unsigned ring = (unsigned)(uintptr_t)(F.lds + RING_OFF); const size_t lo16 = (size_t)lane * 16;
        const int p0 = 2 * (wave - 1);
#pragma unroll 1
        for (int s = 0; s < 1024; ++s) {
            if (s >= NSLOT) { unsigned sp_ = 0; while (*done < s - NSLOT + 1) { __builtin_amdgcn_s_sleep(1); if (++sp_ > (1u << 24)) break; } }
            const size_t i_ = it0 + s; const unsigned d_ = ring + (unsigned)((s % NSLOT) * SLOT);
#pragma unroll
            for (int k = 0; k < 2; ++k) { const int pc = p0 + k; const char* src;
                if (pc == 0) src = UB + ((i_ * 8 + sl) * 64) * 16; else if (pc <= 4) src = WT + ((i_ * 4 + (pc - 1)) * 64) * 16; else if (pc <= 8) src = QD + ((i_ * 4 + (pc - 5)) * 64) * 16;
                else if (pc <= 12) src = KD + ((i_ * 4 + (pc - 9)) * 64) * 16; else src = ITE + (i_ * 64) * 16;
                att::glds16(src + lo16, (unsigned)__builtin_amdgcn_readfirstlane(d_ + pc * 1024)); }
            asm volatile("s_waitcnt vmcnt(10)" ::: "memory");
            if (s >= INFL - 1 && lane == 0) ready[wave] = s - (INFL - 1) + 1;
        }
        asm volatile("s_waitcnt vmcnt(0)" ::: "memory"); if (lane == 0) ready[wave] = 1024;
        return;
    }
    f32x4 S[8];
#pragma unroll
    for (int db = 0; db < 8; ++db) S[db] = (f32x4){0.f, 0.f, 0.f, 0.f};
    int avail = 0;
    typedef short s16x8 __attribute__((ext_vector_type(8)));
    f32x4 uA, uB; v4u iteA, iteB, wtA[4], wtB[4], qdA[4], qdB[4], kdA[4], kdB[4];
#define G2_POLL(n_) do { if ((n_) >= avail) { unsigned sp_ = 0; for (;;) { const int r1 = ready[1], r2 = ready[2], r3 = ready[3], r4 = ready[4], r5 = ready[5], r6 = ready[6], r7 = ready[7]; \
        avail = min(min(min(r1, r2), min(r3, r4)), min(min(r5, r6), r7)); if (avail > (n_)) break; __builtin_amdgcn_s_sleep(1); if (++sp_ > (1u << 24)) break; } } } while (0)
#define G2_READ(U_, ITE_, WT_, QD_, KD_, n_) do { const LAS char* sp_ = (const LAS char*)(F.lds + RING_OFF) + ((n_) % NSLOT) * SLOT + lane * 16; \
        U_ = *(const LAS f32x4*)sp_; ITE_ = *(const LAS v4u*)(sp_ + 13 * 1024); \
        _Pragma("unroll") for (int q = 0; q < 4; ++q) { WT_[q] = *(const LAS v4u*)(sp_ + (1 + q) * 1024); QD_[q] = *(const LAS v4u*)(sp_ + (5 + q) * 1024); KD_[q] = *(const LAS v4u*)(sp_ + (9 + q) * 1024); } } while (0)
#define FR(v, h) __builtin_bit_cast(s16x4, (v2u){(h) ? (v).z : (v).x, (h) ? (v).w : (v).y})
#define SB8(q) (s16x8){Sb[2 * (q)][0], Sb[2 * (q)][1], Sb[2 * (q)][2], Sb[2 * (q)][3], Sb[2 * (q) + 1][0], Sb[2 * (q) + 1][1], Sb[2 * (q) + 1][2], Sb[2 * (q) + 1][3]}
#define G2_STEP(U_, ITE_, WT_, QD_, KD_, UN_, ITEN_, WTN_, QDN_, KDN_, n_) do { const int n = (n_); \
        if (n + 1 < 1024) { G2_POLL(n + 1); G2_READ(UN_, ITEN_, WTN_, QDN_, KDN_, n + 1); } \
        const float egl = __uint_as_float(ITE_.z); const s16x4 itf = __builtin_bit_cast(s16x4, (v2u){ITE_.x, ITE_.y}); \
        s16x4 Sb[8]; \
        _Pragma("unroll") for (int db = 0; db < 8; ++db) Sb[db] = pack4(S[db].x, S[db].y, S[db].z, S[db].w); \
        f32x4 va = U_, vb2 = {0.f, 0.f, 0.f, 0.f}; \
        va = __builtin_amdgcn_mfma_f32_16x16x32_bf16(__builtin_bit_cast(s16x8, WT_[0]), SB8(0), va, 0, 0, 0); vb2 = __builtin_amdgcn_mfma_f32_16x16x32_bf16(__builtin_bit_cast(s16x8, WT_[1]), SB8(1), vb2, 0, 0, 0); \
        va = __builtin_amdgcn_mfma_f32_16x16x32_bf16(__builtin_bit_cast(s16x8, WT_[2]), SB8(2), va, 0, 0, 0); vb2 = __builtin_amdgcn_mfma_f32_16x16x32_bf16(__builtin_bit_cast(s16x8, WT_[3]), SB8(3), vb2, 0, 0, 0); \
        va = va + vb2; \
        const s16x4 vb = pack4(va.x, va.y, va.z, va.w); \
        _Pragma("unroll") for (int q = 0; q < 4; ++q) { const f32x4 s0 = S[2 * q] * egl, s1 = S[2 * q + 1] * egl; S[2 * q] = GDN_MFMA(FR(KD_[q], 0), vb, s0); S[2 * q + 1] = GDN_MFMA(FR(KD_[q], 1), vb, s1); } \
        f32x4 oa = {0.f, 0.f, 0.f, 0.f}, ob = {0.f, 0.f, 0.f, 0.f}; \
        oa = GDN_MFMA(itf, vb, oa); \
        _Pragma("unroll") for (int q = 0; q < 4; ++q) { oa = GDN_MFMA(FR(QD_[q], 0), Sb[2 * q], oa); ob = GDN_MFMA(FR(QD_[q], 1), Sb[2 * q + 1], ob); } \
        oa = oa + ob; \
        *(f32x4*)(OGN + (((it0 + n) * 8 + sl) * 64 + lane) * 4) = oa; \
        asm volatile("s_waitcnt lgkmcnt(0)" ::: "memory"); \
        if (lane == 0) *done = (n + 2 < 1024) ? n + 2 : 1024;         \
    } while (0)
    G2_POLL(0); G2_READ(uA, iteA, wtA, qdA, kdA, 0);
#pragma unroll 1
    for (int n2 = 0; n2 < 1024; n2 += 2) {
        G2_STEP(uA, iteA, wtA, qdA, kdA, uB, iteB, wtB, qdB, kdB, n2);
        G2_STEP(uB, iteB, wtB, qdB, kdB, uA, iteA, wtA, qdA, kdA, n2 + 1);
    }
#undef G2_POLL
#undef G2_READ
#undef G2_STEP
#undef FR
#undef SB8
}
__device__ __forceinline__ void phase_gdn_out2(Frame& F, int j) {
    using namespace gdn;
    const float* OGN = (const float*)(F.ws + WS_OG); const bf16* PROJ = (const bf16*)(F.ws + WS_PROJ); bf16* MIX = (bf16*)(F.ws + WS_MIX);
    const float* on = kin(I_GDN_ONORM) + j * 128; const int lane = F.lane, c = lane & 15, g4 = lane >> 4;
    const int gw = F.bid * NWAVES + F.wave, NGW = F.G * NWAVES;
    float on8[8];
#pragma unroll
    for (int sl = 0; sl < 8; ++sl) on8[sl] = on[16 * sl + c];
#pragma unroll 1
    for (int item = gw; item < NITEM; item += NGW) { const int b = item >> 12, h = (item >> 10) & 3, n = item & 1023;
        f32x4 o[8]; float ss[4] = {0.f, 0.f, 0.f, 0.f}; bf16 zq[4][8];
#pragma unroll
        for (int sl = 0; sl < 8; ++sl) o[sl] = *(const f32x4*)(OGN + (((size_t)item * 8 + sl) * 64 + lane) * 4);
#pragma unroll
        for (int r = 0; r < 4; ++r) { const size_t tok = (size_t)b * SEQ + 16 * n + 4 * g4 + r;
#pragma unroll
            for (int sl = 0; sl < 8; ++sl) zq[r][sl] = PROJ[tok * ODD_INP + O_Z + h * 128 + 16 * sl + c]; }
#pragma unroll
        for (int sl = 0; sl < 8; ++sl) {
#pragma unroll
            for (int r = 0; r < 4; ++r) ss[r] += o[sl][r] * o[sl][r]; }
#pragma unroll
        for (int r = 0; r < 4; ++r) { ss[r] += __shfl_xor(ss[r], 1); ss[r] += __shfl_xor(ss[r], 2); ss[r] += __shfl_xor(ss[r], 4); ss[r] += __shfl_xor(ss[r], 8); ss[r] = 1.0f / sqrtf(ss[r] * (1.f / 128.f) + RMS_EPS); }
#pragma unroll
        for (int r = 0; r < 4; ++r) { const size_t tok = (size_t)b * SEQ + 16 * n + 4 * g4 + r;
#pragma unroll
            for (int sl = 0; sl < 8; ++sl) { const int col = 16 * sl + c; const float zz = bf2f(zq[r][sl]);
                MIX[tok * DM + 512 + h * 128 + col] = (bf16)f2bf(o[sl][r] * ss[r] * on8[sl] * (zz * fsig(zz))); } }
    }
}
constexpr size_t WS_WR = WS_W_EVIN - 1 * MiB;
static_assert(WS_WR >= CTL_ZERO_BYTES, "WR above the control words");
__device__ __forceinline__ void router_weights(Frame& F) {
    float* WR = (float*)(F.ws + WS_WR);
    const int gt = F.bid * 512 + F.tid, NT = F.G * 512;
    for (int e = gt; e < 4 * 1024 * 48; e += NT) { const int l = e / (1024 * 48), r = e % (1024 * 48), k = r / 48, c = r % 48;
        const float g = kin(I_NORM_FFN)[l * DM + k];
        float w = 0.f; if (c < 4) w = kin(I_MOE_WGRP)[((size_t)l * DM + k) * 4 + c]; else if (c < 36) w = kin(I_MOE_WEXP)[((size_t)l * DM + k) * 32 + (c - 4)];
        WR[e] = g * w; }
}
__device__ __forceinline__ void phase_router2(Frame& F, int layer, bool dry = false) {
    const bf16* H = (const bf16*)(F.ws + WS_H16); bf16* ABF = (bf16*)(F.ws + WS_ABF);
    const float* gain = kin(I_NORM_FFN) + layer * DM; const float* bgr = kin(I_MOE_BGRP) + layer * 4; const float* bex = kin(I_MOE_BEXP) + layer * 32;
    const float* WR = (const float*)(F.ws + WS_WR) + (size_t)layer * 1024 * 48;
    int* TOKE = (int*)(F.ws + WS_TOKE); float* TOKW = (float*)(F.ws + WS_TOKW);
    LAS int* lcnt = (LAS int*)(F.lds + LDSCTL_OFF + LC_MOE + 512); LAS int* gbase = (LAS int*)(F.lds + LDSCTL_OFF + LC_MOE + 640);
    const int lane = F.lane, tok = lane & 15, kq = lane >> 4; const int per = NTOK / F.G;
    LAS int* lasg = (LAS int*)(F.lds + RING_OFF);
    LAS float* lg = (LAS float*)(F.lds + RING_OFF + 4096) + F.wave * (16 * 52);
    if (F.tid < 32) lcnt[F.tid] = 0;
    __syncthreads();
    const int m0 = F.bid * per + F.wave * 16;
    const bf16* hrow = H + (size_t)(m0 + tok) * DM + 4 * kq;
    f32x4 acc0 = {0.f, 0.f, 0.f, 0.f}, acc1 = acc0, acc2 = acc0; float ss = 0.f;
#define RT_LDA(p_) ({ const v2u x_ = *(const v2u*)(p_); (f32x4){bflo(x_.x), bfhi(x_.x), bflo(x_.y), bfhi(x_.y)}; })
    f32x4 a_c = RT_LDA(hrow); float b_c[12]; ss = (a_c.x * a_c.x + a_c.y * a_c.y) + (a_c.z * a_c.z + a_c.w * a_c.w);
#pragma unroll
    for (int e = 0; e < 4; ++e)
#pragma unroll
        for (int nb = 0; nb < 3; ++nb) b_c[e * 3 + nb] = WR[(size_t)(4 * kq + e) * 48 + 16 * nb + tok];
#pragma unroll 1
    for (int S = 0; S < 64; ++S) {
        const int Sn = (S + 1 < 64) ? S + 1 : S;
        const f32x4 a_n = RT_LDA(hrow + 16 * Sn); float b_n[12];
#pragma unroll
        for (int e = 0; e < 4; ++e)
#pragma unroll
            for (int nb = 0; nb < 3; ++nb) b_n[e * 3 + nb] = WR[(size_t)(16 * Sn + 4 * kq + e) * 48 + 16 * nb + tok];
#pragma unroll
        for (int e = 0; e < 4; ++e) { const float a = a_c[e];
            acc0 = __builtin_amdgcn_mfma_f32_16x16x4f32(a, b_c[e * 3 + 0], acc0, 0, 0, 0); acc1 = __builtin_amdgcn_mfma_f32_16x16x4f32(a, b_c[e * 3 + 1], acc1, 0, 0, 0); acc2 = __builtin_amdgcn_mfma_f32_16x16x4f32(a, b_c[e * 3 + 2], acc2, 0, 0, 0); }
        if (S + 1 < 64) ss += (a_n.x * a_n.x + a_n.y * a_n.y) + (a_n.z * a_n.z + a_n.w * a_n.w);
        a_c = a_n;
#pragma unroll
        for (int q = 0; q < 12; ++q) b_c[q] = b_n[q];
    }
    ss += __shfl_xor(ss, 16); ss += __shfl_xor(ss, 32);
    const float rr = 1.0f / sqrtf(ss * (1.f / 1024.f) + RMS_EPS);
#pragma unroll
    for (int reg = 0; reg < 4; ++reg) { LAS float* row = lg + (4 * kq + reg) * 52; row[tok] = acc0[reg]; row[16 + tok] = acc1[reg]; row[32 + tok] = acc2[reg]; }
    if (kq == 0) lg[tok * 52 + 48] = rr;
    LDS_WAIT();
    if (lane < 16) { const LAS float* row = lg + lane * 52; const float r = row[48]; const int m = m0 + lane; const int tl = F.wave * 16 + lane;
        float l4[4];
#pragma unroll
        for (int g = 0; g < 4; ++g) l4[g] = row[g] * r + bgr[g];
        int gi = 0; float gm = l4[0];
#pragma unroll
        for (int g = 1; g < 4; ++g) if (l4[g] > gm) { gm = l4[g]; gi = g; }
        float gden = 0.f;
#pragma unroll
        for (int g = 0; g < 4; ++g) gden += expf(l4[g] - gm);
        const float gw_ = 1.0f / gden;
        float le[8];
#pragma unroll
        for (int e = 0; e < 8; ++e) le[e] = row[4 + gi * 8 + e] * r + bex[gi * 8 + e];
        int i0 = 0; float mx0 = le[0];
#pragma unroll
        for (int e = 1; e < 8; ++e) if (le[e] > mx0) { mx0 = le[e]; i0 = e; }
        int i1 = -1; float mx1 = -3.0e38f;
#pragma unroll
        for (int e = 0; e < 8; ++e) if (e != i0 && le[e] > mx1) { mx1 = le[e]; i1 = e; }
        const float e1 = expf(mx1 - mx0); const float w0 = gw_ / (1.0f + e1), w1 = gw_ * e1 / (1.0f + e1);
        if (!dry) { const int ea = gi * 8 + i0, eb = gi * 8 + i1;
            const int pa = __hip_atomic_fetch_add(lcnt + ea, 1, __ATOMIC_RELAXED, __HIP_MEMORY_SCOPE_WORKGROUP), pb = __hip_atomic_fetch_add(lcnt + eb, 1, __ATOMIC_RELAXED, __HIP_MEMORY_SCOPE_WORKGROUP);
            lasg[tl * 2] = ea | (pa << 8); lasg[tl * 2 + 1] = eb | (pb << 8);
            TOKW[(size_t)m * 2] = w0; TOKW[(size_t)m * 2 + 1] = w1; } }
#pragma unroll 1
    for (int t = 0; t < 16; ++t) { const float r = lg[t * 52 + 48];
#pragma unroll
        for (int q = 0; q < 2; ++q) { const v4u x = ((const v4u*)(H + (size_t)(m0 + t) * DM) + lane)[64 * q]; const float* g = gain + 512 * q + 8 * lane; const f32x4 g0 = *(const f32x4*)g, g1 = *(const f32x4*)(g + 4);
            v4u o; o.x = pk2(bflo(x.x) * r * g0.x, bfhi(x.x) * r * g0.y); o.y = pk2(bflo(x.y) * r * g0.z, bfhi(x.y) * r * g0.w); o.z = pk2(bflo(x.z) * r * g1.x, bfhi(x.z) * r * g1.y); o.w = pk2(bflo(x.w) * r * g1.z, bfhi(x.w) * r * g1.w);
            ((v4u*)(ABF + (size_t)(m0 + t) * DM) + lane)[64 * q] = o; } }
    __syncthreads();
    if (dry) return;
    if (F.tid < 32) gbase[F.tid] = (int)__hip_atomic_fetch_add(F.ctl + CW_CNT + 64 * layer + F.tid, (unsigned)lcnt[F.tid], __ATOMIC_RELAXED, __HIP_MEMORY_SCOPE_AGENT);
    __syncthreads();
    int* P2T = (int*)(F.ws + WS_P2T);
    for (int i = F.tid; i < per * 2; i += 512) { const int a = lasg[i], e = a & 255, lp = a >> 8; const int gp = gbase[e] + lp; TOKE[(size_t)F.bid * per * 2 + i] = e | (gp << 8); P2T[(size_t)e * NTOK + gp] = F.bid * per * 2 + i; }
    __syncthreads();
}
constexpr int LSTEPS = 16;
constexpr int STEP_END = 1 + DEPTH * LSTEPS;
struct KArgs { Args a; int li, pad; };

#define FRAME Frame F; { int wv_ = wave0; asm volatile("" : "+s"(wv_)); int t_ = wv_ * 64 + (int)__builtin_amdgcn_mbcnt_hi(~0u, __builtin_amdgcn_mbcnt_lo(~0u, 0u)); asm volatile("" : "+v"(t_)); unsigned char* w_ = kws(); F.lds = lds0; F.ws = w_; F.ctl = (unsigned*)(w_ + WS_CTL); \
        F.tid = t_; F.lane = t_ & 63; F.wave = __builtin_amdgcn_readfirstlane(t_ >> 6); { int g_ = gridDim.x, b_ = blockIdx.x; asm volatile("" : "+s"(g_), "+s"(b_)); F.G = g_; F.bid = b_; } } unsigned char* const ws = F.ws; (void)ws
#ifndef PH_MASK
#define PH_MASK 0xffffffffu
#endif
#define EN(k) (((PH_MASK) >> (k)) & 1u)
#ifndef DUP_E
#define DUP_E 0u
#endif
#ifndef DUP_O
#define DUP_O 0u
#endif
#define NREP(s) ((((s) >= 1) && (((((((s) - 1) / LSTEPS) & 1) ? (DUP_O) : (DUP_E)) >> (((s) + LSTEPS - 1) % LSTEPS)) & 1u)) ? 2 : 1)
#define STEP(s) if (lo <= (s) && (s) < hi) for (int rep_ = 0; rep_ < NREP(s); ++rep_)
#define DRY(s) (NREP(s) == 2 && rep_ == 0)
#ifdef TIME_K
#ifndef TIME_PAR
#define TIME_PAR 2
#endif
#define TMATCH(s) ((s) >= 1 && (((s) - 1) % LSTEPS) == (TIME_K) && ((TIME_PAR) == 2 || ((((s) - 1) / LSTEPS) & 1) == (TIME_PAR)))
#define TSTART(s) do { if (TMATCH(s)) tstart = __builtin_amdgcn_s_memrealtime(); } while (0)
#define TSTOP(s) do { if (TMATCH(s)) tacc += __builtin_amdgcn_s_memrealtime() - tstart; } while (0)
#else
#define TSTART(s) do {} while (0)
#define TSTOP(s) do {} while (0)
#endif
#define ENDSTEP(s) do { if ((s) + 1 < hi) xcd_barrier(bar); TSTOP(s); } while (0)
#define LAUNDER_WS do {} while (0)


template <int layer> __device__ __forceinline__ void layer_body(const XcdBarrier& bar, const int lo, const int hi, LAS unsigned char* const lds0, const int wave0, unsigned long long& tacc, unsigned long long& tstart) {
        constexpr int sb = 1 + layer * LSTEPS, j = layer >> 1; constexpr bool even = (layer & 1) == 0;
        STEP(sb + 0) if constexpr (EN(0)) { FRAME; TSTART(sb + 0);
            phase_norm(F, layer == 0 ? kin(I_X) : nullptr, kin(I_NORM_MIX) + layer * DM);
            if constexpr (even) moe_weights(F, layer);
            phase_pconv(F, layer);
            if constexpr (!even) { __syncthreads(); s5_build(F, j); }
            ENDSTEP(sb + 0);
        }
        STEP(sb + 1) if constexpr (EN(1)) { FRAME; TSTART(sb + 1);
            { LAUNDER_WS; const int NP = even ? EVEN_INP : ODD_INP; const bf16* W = even ? (const bf16*)(ws + WS_W_EVIN) + (size_t)j * EVEN_INP * 1024 : (const bf16*)(ws + WS_W_ODIN) + (size_t)j * ODD_INP * 1024;
              pg8::Gemm g{(const bf16*)(ws + WS_ABF), W, 1024, 1024, 1024}; pg8::StaticOrder S; S.init(NTOK, NP, F.G, F.bid); pg8::EpiBf16 E{(bf16*)(ws + WS_PROJ), NP};
              pg8::gemm_phase<pg8::EpiBf16, pg8::StaticOrder>(F.lds + RING_OFF, g, S, E, F.tid); }
            { LAUNDER_WS; pg8::Gemm g{(const bf16*)(ws + WS_PBF), (const bf16*)(ws + WS_W_PLEP) + (size_t)layer * 1024 * 256, 256, 256, 256}; pg8::StaticOrder S; S.init(NTOK, 1024, F.G, F.bid); pg8::EpiBf16 E{(bf16*)(ws + WS_PP), 1024};
              pg8::gemm_phase<pg8::EpiBf16, pg8::StaticOrder>(F.lds + RING_OFF, g, S, E, F.tid); }
            ENDSTEP(sb + 1);
        }
        if constexpr (even) {
            STEP(sb + 2) if constexpr (EN(2)) { FRAME; TSTART(sb + 2); phase_even_post(F, j, DRY(sb + 2)); ENDSTEP(sb + 2); }
            STEP(sb + 3) if constexpr (EN(3)) { FRAME; TSTART(sb + 3);
#ifndef NO_QUP
                { LAUNDER_WS; pg8::Gemm g{(const bf16*)(ws + WS_CQN), (const bf16*)(ws + WS_W_QUP) + (size_t)j * 768 * 384, 384, 384, 384}; pg8::StaticOrder S; S.init(NTOK, 768, F.G, F.bid); pg8::EpiBf16 E{(bf16*)(ws + WS_QM), 768};
                  pg8::gemm_phase<pg8::EpiBf16, pg8::StaticOrder>(F.lds + RING_OFF, g, S, E, F.tid); }
#endif
#ifndef NO_KVUP
                { LAUNDER_WS; pg8::Gemm g{(const bf16*)(ws + WS_CKVN), (const bf16*)(ws + WS_W_KVUP) + (size_t)j * 1024 * 256, 256, 256, 256}; pg8::StaticOrder S; S.init(NTOK, 1024, F.G, F.bid); pg8::EpiBf16 E{(bf16*)(ws + WS_KVB), 1024};
                  pg8::gemm_phase<pg8::EpiBf16, pg8::StaticOrder>(F.lds + RING_OFF, g, S, E, F.tid); }
#endif
#ifndef NO_CUMSUM
                phase_cumsum(F);
#endif
                ENDSTEP(sb + 3);
            }
            STEP(sb + 4) if constexpr (EN(4)) { FRAME; TSTART(sb + 4); phase_mla_post(F, j, DRY(sb + 4)); ENDSTEP(sb + 4); }
            STEP(sb + 5) if constexpr (EN(5)) { FRAME; TSTART(sb + 5);
#ifdef ATTN_NAIVE
                phase_attn_naive(F);
#else
                phase_attn_mfma(F, j);
#endif
                ENDSTEP(sb + 5); }
        } else {
            STEP(sb + 2) if constexpr (EN(2)) { FRAME; TSTART(sb + 2); s5_repack(F);
#ifdef GDN_NAIVE
                phase_gdn_prep(F, j);
#else
                phase_gdn_g1(F, j);
#ifdef DUP_G1
                phase_gdn_g1(F, j);
#endif
#ifdef DUP_REPACK
                s5_repack(F);
#endif
#endif
                ENDSTEP(sb + 2); }
            STEP(sb + 3) if constexpr (EN(3)) { FRAME; TSTART(sb + 3);
                if (F.bid < 64) { phase_gdn_g2(F); }
                else if (F.bid < 96) { const int grp = F.bid - 64;
                    { pg8::Gemm g{(const bf16*)(ws + WS_S5_AX), (const bf16*)(ws + WS_S5_PT), 1024, 1152, 1024}; S5GroupP S{grp}; S5PEpi E{(float*)(ws + WS_S5_XLOC)};
                      pg8::gemm_phase<S5PEpi, S5GroupP>(F.lds + RING_OFF, g, S, E, F.tid); }
                    VM_WAIT(); __syncthreads();
                    s5_scan(F, j, grp);
                    VM_WAIT(); __syncthreads();
                    { pg8::Gemm g{(const bf16*)(ws + WS_S5_AX), (const bf16*)(ws + WS_S5_MT), 1152, 1152, 1152}; S5GroupM S{grp}; S5MEpi E{(bf16*)(ws + WS_HG), (const bf16*)(ws + WS_PROJ), kin(I_S5_D) + j * 512};
                      pg8::gemm_phase<S5MEpi, S5GroupM>(F.lds + RING_OFF, g, S, E, F.tid); }
                } else { moe_weights(F, layer, 96, F.G - 96); }
                ENDSTEP(sb + 3);
            }
            STEP(sb + 6) if constexpr (EN(6)) { FRAME; TSTART(sb + 6);
                phase_gdn_out2(F, j);
                pg8::Gemm g{(const bf16*)(ws + WS_HG), (const bf16*)(ws + WS_W_GLU) + (size_t)j * 512 * 512, 512, 512, 512}; pg8::StaticOrder S; S.init(NTOK, 512, F.G, F.bid);
                pg8::EpiGlu E{(bf16*)(ws + WS_MIX), 1024, (const bf16*)(ws + WS_HG), 512, kin(I_S5_BGLU) + j * 512};
                pg8::gemm_phase<pg8::EpiGlu, pg8::StaticOrder>(F.lds + RING_OFF, g, S, E, F.tid);
                ENDSTEP(sb + 6);
            }
        }
        STEP(sb + 7) if constexpr (EN(7)) { FRAME; TSTART(sb + 7);
            LAUNDER_WS; const bf16* W = even ? (const bf16*)(ws + WS_W_EVOUT) + (size_t)j * 1024 * 1024 : (const bf16*)(ws + WS_W_ODOUT) + (size_t)j * 1024 * 1024;
            pg8::Gemm g{(const bf16*)(ws + WS_MIX), W, 1024, 1024, 1024}; pg8::StaticOrder S; S.init(NTOK, 1024, F.G, F.bid); pg8::EpiResAdd E{(bf16*)(ws + (DRY(sb + 7) ? WS_DUMMY : WS_H16)), 1024};
            pg8::gemm_phase<pg8::EpiResAdd, pg8::StaticOrder>(F.lds + RING_OFF, g, S, E, F.tid);
            ENDSTEP(sb + 7);
        }
        STEP(sb + 8) if constexpr (EN(8)) { FRAME; TSTART(sb + 8); phase_router2(F, layer, DRY(sb + 8)); ENDSTEP(sb + 8); }
        STEP(sb + 10) if constexpr (EN(10)) { FRAME; TSTART(sb + 10);
            LAUNDER_WS; moe_tables(F, layer);
            const LAS int* rowbase = (const LAS int*)(F.lds + LDSCTL_OFF + LC_MOE);
            MoeGatherOrder S{__builtin_amdgcn_readfirstlane(rowbase[34]), 4, F.G, F.bid, (const LAS unsigned char*)(F.lds + LDSCTL_OFF + LC_MOE + 192), rowbase, (const int*)(ws + WS_P2T), (size_t)1024 * 1024 * 2};
            pg8::Gemm g{(const bf16*)(ws + WS_ABF), (const bf16*)(ws + WS_W_MOEGU), 1024, 1024, 1024}; pg8::EpiSwiglu E{(bf16*)(ws + WS_HB), 512};
            pg8::gemm_phase_gather<pg8::EpiSwiglu, MoeGatherOrder>(F.lds + RING_OFF, g, S, E, F.tid);
            ENDSTEP(sb + 10);
        }
        STEP(sb + 11) if constexpr (EN(11)) { FRAME; TSTART(sb + 11);
            LAUNDER_WS; moe_tables(F, layer);
            const LAS int* rowbase = (const LAS int*)(F.lds + LDSCTL_OFF + LC_MOE);
            MoeOrder S{__builtin_amdgcn_readfirstlane(rowbase[34]), 4, F.G, F.bid, (const LAS unsigned char*)(F.lds + LDSCTL_OFF + LC_MOE + 192), (size_t)1024 * 512 * 2};
            pg8::Gemm g{(const bf16*)(ws + WS_HB), (const bf16*)(ws + WS_W_MOED), 512, 512, 512}; pg8::EpiBf16 E{(bf16*)(ws + WS_Y2), 1024};
            pg8::gemm_phase<pg8::EpiBf16, MoeOrder>(F.lds + RING_OFF, g, S, E, F.tid);
            ENDSTEP(sb + 11);
        }
        STEP(sb + 12) if constexpr (EN(12)) { FRAME; TSTART(sb + 12); phase_moe_combine(F, layer, DRY(sb + 12)); ENDSTEP(sb + 12); }
        STEP(sb + 13) if constexpr (EN(13)) { FRAME; TSTART(sb + 13);
            LAUNDER_WS; pg8::Gemm g{(const bf16*)(ws + WS_ABF), (const bf16*)(ws + WS_W_PLEG) + (size_t)layer * 1024 * 1024, 1024, 1024, 1024}; pg8::StaticOrder S; S.init(NTOK, 1024, F.G, F.bid);
            pg8::EpiPle E{(bf16*)(ws + (DRY(sb + 13) ? WS_DUMMY : WS_H16)), (const bf16*)(ws + WS_PP), kin(I_PLE_BG) + layer * DM, 1024, (layer == DEPTH - 1 && !DRY(sb + 13)) ? kout() : nullptr};
            pg8::gemm_phase<pg8::EpiPle, pg8::StaticOrder>(F.lds + RING_OFF, g, S, E, F.tid);
            ENDSTEP(sb + 13);
        }
    }
__global__ void __launch_bounds__(NWAVES * 64, 2) mega_fwd(KArgs ka) {
    extern __shared__ __attribute__((aligned(16))) unsigned char lds_raw[];
    const Args& args = ka.a;
    LAS unsigned char* const lds0 = (LAS unsigned char*)lds_raw;
    const int wave0 = __builtin_amdgcn_readfirstlane((int)threadIdx.x >> 6);
    for (int u = threadIdx.x; u < (LDS_BYTES - LDSCTL_OFF) / 4; u += NWAVES * 64) ((LAS unsigned*)(lds0 + LDSCTL_OFF))[u] = 0u;
    __syncthreads();
    XcdBarrier bar = xcd_barrier_post((unsigned*)(kws() + WS_CTL) + CW_BAR + ka.li * XCD_BAR_WORDS, (volatile LAS unsigned*)(lds0 + LDSCTL_OFF + LC_BARST));
    const int lo = args.ph_lo, hi = args.ph_hi;
    unsigned long long tacc = 0, tstart = 0;
    STEP(0) if constexpr (EN(15)) { FRAME; prologue_weights(F); router_weights(F);
#ifdef EXTRA_BARS
        for (int xb_ = 0; xb_ < EXTRA_BARS; ++xb_) xcd_barrier(bar);
#endif
        ENDSTEP(0); }
    layer_body<0>(bar, lo, hi, lds0, wave0, tacc, tstart); layer_body<1>(bar, lo, hi, lds0, wave0, tacc, tstart); layer_body<2>(bar, lo, hi, lds0, wave0, tacc, tstart); layer_body<3>(bar, lo, hi, lds0, wave0, tacc, tstart);
#ifdef TIME_G2WAIT
    if (blockIdx.x == 0 && threadIdx.x == 0) { const unsigned long long w_ = *(volatile LAS unsigned long long*)(lds0 + LDSCTL_OFF + 2048); const unsigned long long t_end = __builtin_amdgcn_s_memrealtime(); while (__builtin_amdgcn_s_memrealtime() - t_end < 10ull * w_) __builtin_amdgcn_s_sleep(8); }
#endif
#ifdef TIME_K
    if (blockIdx.x == 0) { const unsigned long long t_end = __builtin_amdgcn_s_memrealtime(); while (__builtin_amdgcn_s_memrealtime() - t_end < (unsigned long long)(TIME_AMP) * tacc) __builtin_amdgcn_s_sleep(8); }
#endif
#undef STEP
#undef ENDSTEP
}

#ifndef MK_MODE
#define MK_MODE 0
#endif
extern "C" void kernel_launch(void* const* d_in, const int* in_sizes, int n_in, void* d_out, int out_size, void* d_ws, size_t ws_size, hipStream_t stream) {
    static int ready = 0;
    if (ready == 0) {
        if (n_in != N_IN || out_size != NTOK * DM || ws_size < WS_END) { fprintf(stderr, "kernel_launch: unexpected shapes n_in %d out %d ws %zu (need %zu)\n", n_in, out_size, ws_size, (size_t)WS_END); ready = -1; return; }
        if (hipFuncSetAttribute((const void*)mega_fwd, hipFuncAttributeMaxDynamicSharedMemorySize, LDS_BYTES) != hipSuccess) { fprintf(stderr, "kernel_launch: hipFuncSetAttribute failed\n"); ready = -1; return; }
        int per_cu = 0; (void)hipOccupancyMaxActiveBlocksPerMultiprocessor(&per_cu, (const void*)mega_fwd, NWAVES * 64, LDS_BYTES); (void)hipGetLastError();
        ready = 1;
    }
    if (ready < 0) return;
    (void)hipMemsetAsync((char*)d_ws + WS_CTL, 0, CTL_ZERO_BYTES, stream);
    KArgs ka{};
    for (int i = 0; i < N_IN; ++i) ka.a.in[i] = (const float*)d_in[i];
    ka.a.out = (float*)d_out; ka.a.ws = (unsigned char*)d_ws; ka.li = 0; ka.pad = 0;
    const int grid = 256;
#if MK_MODE == 1
    ka.a.ph_lo = 0; ka.a.ph_hi = STEP_END;
    hipLaunchKernelGGL(mega_fwd, dim3(grid), dim3(NWAVES * 64), LDS_BYTES, stream, ka);
#else
    for (int s = 0; s < STEP_END; ++s) {
        if (s > 0) { const int k = (s - 1) % LSTEPS, layer = (s - 1) / LSTEPS; const bool even = (layer & 1) == 0;
            if (k > 13) continue; if (k == 6 && even) continue; if ((k == 4 || k == 5) && !even) continue; if (k == 9) continue; }
        ka.a.ph_lo = s; ka.a.ph_hi = s + 1;
        hipLaunchKernelGGL(mega_fwd, dim3(grid), dim3(NWAVES * 64), LDS_BYTES, stream, ka);
    }
#endif
}
```

```cpp
#include <hip/hip_runtime.h>
#include <cstdio>
#include <cstdint>
#define MK_MODE 1
#define ATTN_V2 1
namespace pg8 {
#define PG8_LAS __attribute__((address_space(3)))
typedef unsigned short bf16_t;
typedef short bf16x8 __attribute__((ext_vector_type(8)));
typedef float f32x4 __attribute__((ext_vector_type(4)));
typedef float f32x2 __attribute__((ext_vector_type(2)));
typedef unsigned u32x4 __attribute__((ext_vector_type(4)));
typedef unsigned u32x2 __attribute__((ext_vector_type(2)));
constexpr int BM = 256, BK = 64, HALF = 128, HTB = HALF * BK * 2  , STAGE_BYTES = 8 * HTB, NXCD = 8, WGM = 8;

__host__ __device__ __forceinline__ int lds_byte(int r, int c) { const int st = (r >> 4) * 2 + (c >> 5), rr = r & 15, cc = c & 31, ob = rr * 64 + cc * 2; return st * 1024 + (ob ^ (((ob >> 9) & 1) << 5)); }
__host__ __device__ __forceinline__ void stage_rc(int b, int& R, int& C) { const int st = b / 1024, sb = b % 1024, swz = sb ^ (((sb >> 9) & 1) << 5); R = (st >> 1) * 16 + swz / 64; C = (st & 1) * 32 + (swz % 64) / 2; }
__host__ __device__ __forceinline__ int perm32(int rho) { const int n = rho >> 4, i = rho & 15; return 8 * (i >> 2) + 4 * n + (i & 3); }

struct Unit { int pm, pn, aux; };
struct Gemm { const bf16_t* A; const bf16_t* Bt; int K, lda, ldb; };

struct StaticOrder {
    int nM, nN, nwg, G, c;
    __device__ void init(int M, int N, int G_, int c_) { nM = M / BM; nN = N / BM; nwg = nM * nN; G = G_; c = c_; }
    __device__ bool next(int i, Unit& u) const {
        const long L = (long)i * G + c; if (L >= nwg) return false;
        int wgid = (int)L; { const int q = nwg / NXCD, r = nwg % NXCD, xcd = wgid % NXCD, off = wgid / NXCD; wgid = (xcd < r ? xcd * (q + 1) : r * (q + 1) + (xcd - r) * q) + off; }
        const int nig = WGM * nN, gid = wgid / nig, fm = gid * WGM, gsz = (nM - fm) < WGM ? (nM - fm) : WGM;
        u.pm = fm + ((wgid % nig) % gsz); u.pn = (wgid % nig) / gsz; u.aux = 0; return true;
    }
    __device__ __forceinline__ const char* a_base(const Gemm& g, const Unit& u) const { return (const char*)g.A + (size_t)u.pm * BM * g.lda * 2; }
    __device__ __forceinline__ const char* b_base(const Gemm& g, const Unit& u) const { return (const char*)g.Bt + (size_t)u.pn * BM * g.ldb * 2; }
};

__device__ __forceinline__ unsigned cvt_pk_bf16(float lo, float hi) { unsigned r; asm volatile("v_cvt_pk_bf16_f32 %0, %1, %2" : "=v"(r) : "v"(lo), "v"(hi)); return r; }
__device__ __forceinline__ float bf_lo(unsigned w) { return __uint_as_float(w << 16); }
__device__ __forceinline__ float bf_hi(unsigned w) { return __uint_as_float(w & 0xffff0000u); }

struct EpiBf16 {
    static constexpr bool PERM = true;
    bf16_t* O; int ldc;
    __device__ __forceinline__ void operator()(const f32x4 (&acc)[2][2][4][2], const Unit& u, int wr, int wc, int fr, int fq) const {
        const int row0 = u.pm * BM + wr * 64 + fr; const int col0 = u.pn * BM + wc * 32 + 8 * fq;
#pragma unroll
        for (int ai = 0; ai < 2; ++ai)
#pragma unroll
            for (int m = 0; m < 4; ++m) { bf16_t* rowp = O + (size_t)(row0 + ai * HALF + m * 16) * ldc + col0;
#pragma unroll
                for (int bj = 0; bj < 2; ++bj) { const f32x4 v0 = acc[ai][bj][m][0], v1 = acc[ai][bj][m][1];
                    u32x4 w; w.x = cvt_pk_bf16(v0[0], v0[1]); w.y = cvt_pk_bf16(v0[2], v0[3]); w.z = cvt_pk_bf16(v1[0], v1[1]); w.w = cvt_pk_bf16(v1[2], v1[3]);
                    *(u32x4*)(rowp + bj * HALF) = w; } }
    }
};
struct EpiResAdd {
    static constexpr bool PERM = true;
    bf16_t* H; int ldc;
    __device__ __forceinline__ void operator()(const f32x4 (&acc)[2][2][4][2], const Unit& u, int wr, int wc, int fr, int fq) const {
        const int row0 = u.pm * BM + wr * 64 + fr; const int col0 = u.pn * BM + wc * 32 + 8 * fq;
#pragma unroll
        for (int ai = 0; ai < 2; ++ai) { u32x4 t[4][2];
#pragma unroll
            for (int m = 0; m < 4; ++m)
#pragma unroll
                for (int bj = 0; bj < 2; ++bj) t[m][bj] = *(const u32x4*)(H + (size_t)(row0 + ai * HALF + m * 16) * ldc + col0 + bj * HALF);
#pragma unroll
            for (int m = 0; m < 4; ++m)
#pragma unroll
                for (int bj = 0; bj < 2; ++bj) { const u32x4 h = t[m][bj]; const f32x4 v0 = acc[ai][bj][m][0], v1 = acc[ai][bj][m][1];
                    u32x4 w; w.x = cvt_pk_bf16(bf_lo(h.x) + v0[0], bf_hi(h.x) + v0[1]); w.y = cvt_pk_bf16(bf_lo(h.y) + v0[2], bf_hi(h.y) + v0[3]); w.z = cvt_pk_bf16(bf_lo(h.z) + v1[0], bf_hi(h.z) + v1[1]); w.w = cvt_pk_bf16(bf_lo(h.w) + v1[2], bf_hi(h.w) + v1[3]);
                    *(u32x4*)(H + (size_t)(row0 + ai * HALF + m * 16) * ldc + col0 + bj * HALF) = w; } }
    }
};
__device__ __forceinline__ float sigmoidf_(float x) { return __builtin_amdgcn_rcpf(1.0f + __expf(-x)); }
struct EpiPle {
    static constexpr bool PERM = true;
    bf16_t* H; const bf16_t* PP; const float* bias; int ldc; float* OUT;
    __device__ __forceinline__ void operator()(const f32x4 (&acc)[2][2][4][2], const Unit& u, int wr, int wc, int fr, int fq) const {
        const int row0 = u.pm * BM + wr * 64 + fr; const int col0 = u.pn * BM + wc * 32 + 8 * fq;
        f32x4 bv[2][2];
#pragma unroll
        for (int bj = 0; bj < 2; ++bj)
#pragma unroll
            for (int n = 0; n < 2; ++n) bv[bj][n] = *(const f32x4*)(bias + col0 + bj * HALF + 4 * n);
#pragma unroll
        for (int ai = 0; ai < 2; ++ai)
#pragma unroll
            for (int mp = 0; mp < 2; ++mp) { u32x4 th[2][2], tp[2][2];
#pragma unroll
                for (int mm = 0; mm < 2; ++mm)
#pragma unroll
                    for (int bj = 0; bj < 2; ++bj) { const size_t o = (size_t)(row0 + ai * HALF + (2 * mp + mm) * 16) * ldc + col0 + bj * HALF; th[mm][bj] = *(const u32x4*)(H + o); tp[mm][bj] = *(const u32x4*)(PP + o); }
#pragma unroll
                for (int mm = 0; mm < 2; ++mm)
#pragma unroll
                    for (int bj = 0; bj < 2; ++bj) { const size_t o = (size_t)(row0 + ai * HALF + (2 * mp + mm) * 16) * ldc + col0 + bj * HALF; const u32x4 h = th[mm][bj], q = tp[mm][bj];
                        const f32x4 a0 = acc[ai][bj][2 * mp + mm][0] + bv[bj][0], a1 = acc[ai][bj][2 * mp + mm][1] + bv[bj][1];
                        const float r0 = bf_lo(h.x) + sigmoidf_(a0[0]) * bf_lo(q.x), r1 = bf_hi(h.x) + sigmoidf_(a0[1]) * bf_hi(q.x), r2 = bf_lo(h.y) + sigmoidf_(a0[2]) * bf_lo(q.y), r3 = bf_hi(h.y) + sigmoidf_(a0[3]) * bf_hi(q.y);
                        const float r4 = bf_lo(h.z) + sigmoidf_(a1[0]) * bf_lo(q.z), r5 = bf_hi(h.z) + sigmoidf_(a1[1]) * bf_hi(q.z), r6 = bf_lo(h.w) + sigmoidf_(a1[2]) * bf_lo(q.w), r7 = bf_hi(h.w) + sigmoidf_(a1[3]) * bf_hi(q.w);
                        if (OUT) { *(f32x4*)(OUT + o) = (f32x4){r0, r1, r2, r3}; *(f32x4*)(OUT + o + 4) = (f32x4){r4, r5, r6, r7}; }
                        else { u32x4 w; w.x = cvt_pk_bf16(r0, r1); w.y = cvt_pk_bf16(r2, r3); w.z = cvt_pk_bf16(r4, r5); w.w = cvt_pk_bf16(r6, r7); *(u32x4*)(H + o) = w; } } }
    }
};
struct EpiGlu {
    static constexpr bool PERM = true;
    bf16_t* O; int ldo; const bf16_t* HG; int ldh; const float* bias;
    __device__ __forceinline__ void operator()(const f32x4 (&acc)[2][2][4][2], const Unit& u, int wr, int wc, int fr, int fq) const {
        const int row0 = u.pm * BM + wr * 64 + fr; const int col0 = u.pn * BM + wc * 32 + 8 * fq;
#pragma unroll
        for (int ai = 0; ai < 2; ++ai)
#pragma unroll
            for (int m = 0; m < 4; ++m) { const size_t r = (size_t)(row0 + ai * HALF + m * 16);
#pragma unroll
                for (int bj = 0; bj < 2; ++bj) { const int c = col0 + bj * HALF; const u32x4 hw = *(const u32x4*)(HG + r * ldh + c);
                    const f32x4 b0 = *(const f32x4*)(bias + c), b1 = *(const f32x4*)(bias + c + 4); const f32x4 v0 = acc[ai][bj][m][0] + b0, v1 = acc[ai][bj][m][1] + b1;
                    u32x4 w; w.x = cvt_pk_bf16(bf_lo(hw.x) * sigmoidf_(v0[0]), bf_hi(hw.x) * sigmoidf_(v0[1])); w.y = cvt_pk_bf16(bf_lo(hw.y) * sigmoidf_(v0[2]), bf_hi(hw.y) * sigmoidf_(v0[3]));
                    w.z = cvt_pk_bf16(bf_lo(hw.z) * sigmoidf_(v1[0]), bf_hi(hw.z) * sigmoidf_(v1[1])); w.w = cvt_pk_bf16(bf_lo(hw.w) * sigmoidf_(v1[2]), bf_hi(hw.w) * sigmoidf_(v1[3]));
                    *(u32x4*)(O + r * ldo + c) = w; } }
    }
};
struct EpiSwiglu {
    static constexpr bool PERM = true;
    bf16_t* HB; int ldc;
    __device__ __forceinline__ void operator()(const f32x4 (&acc)[2][2][4][2], const Unit& u, int wr, int wc, int fr, int fq) const {
        const int row0 = u.pm * BM + wr * 64 + fr; const int col0 = u.pn * HALF + wc * 32 + 8 * fq;
#pragma unroll
        for (int ai = 0; ai < 2; ++ai)
#pragma unroll
            for (int m = 0; m < 4; ++m) { bf16_t* rowp = HB + (size_t)(row0 + ai * HALF + m * 16) * ldc + col0;
                const f32x4 g0 = acc[ai][0][m][0], g1 = acc[ai][0][m][1], u0 = acc[ai][1][m][0], u1 = acc[ai][1][m][1];
                u32x4 w; w.x = cvt_pk_bf16(g0[0] * sigmoidf_(g0[0]) * u0[0], g0[1] * sigmoidf_(g0[1]) * u0[1]); w.y = cvt_pk_bf16(g0[2] * sigmoidf_(g0[2]) * u0[2], g0[3] * sigmoidf_(g0[3]) * u0[3]);
                w.z = cvt_pk_bf16(g1[0] * sigmoidf_(g1[0]) * u1[0], g1[1] * sigmoidf_(g1[1]) * u1[1]); w.w = cvt_pk_bf16(g1[2] * sigmoidf_(g1[2]) * u1[2], g1[3] * sigmoidf_(g1[3]) * u1[3]);
                *(u32x4*)rowp = w; }
    }
};

template <class Epi, class Sched, bool ALIGN_EPI = true, bool SP2 = true>
__device__ __forceinline__ void gemm_phase(PG8_LAS unsigned char* lds, const Gemm g, const Sched& S, const Epi& E, const int tid) {
    const int wid = __builtin_amdgcn_readfirstlane(tid >> 6), lane = tid & 63, wr = wid >> 2, wc = wid & 3, fr = lane & 15, fq = lane >> 4;
    int K = g.K; asm volatile("" : "+s"(K));
    const int nt = K / BK;
    unsigned voffA[2], voffB[2];
#pragma unroll
    for (int i = 0; i < 2; ++i) { int R, C; stage_rc(tid * 16 + i * 8192, R, C); const int Rb = Epi::PERM ? ((R & ~31) + perm32(R & 31)) : R;
        voffA[i] = (unsigned)(R * g.lda + C) * 2u; voffB[i] = (unsigned)(Rb * g.ldb + C) * 2u; }
    const size_t kstep = (size_t)(BK * 2);
    const size_t hstepA = (size_t)HALF * g.lda * 2, hstepB = (size_t)HALF * g.ldb * 2;
    const unsigned ldsw = (unsigned)wid * 1024u;
    const int aoff = lds_byte(wr * 64 + fr, fq * 8), boff = lds_byte(wc * 32 + fr, fq * 8);
#define PG8_SA(b, h) (((b) * 2 + (h)) * HTB)
#define PG8_SB(b, h) ((4 + (b) * 2 + (h)) * HTB)
#define PG8_STAGE(bufoff, gbase, voff) do { _Pragma("unroll") for (int _i = 0; _i < 2; ++_i) \
        __builtin_amdgcn_global_load_lds((const unsigned*)((const char*)(gbase) + (voff)[_i]), (PG8_LAS unsigned*)(lds + (bufoff) + ldsw + _i * 8192), 16, 0, 0); } while (0)
#define PG8_LDA(dst, b, h) do { _Pragma("unroll") for (int m = 0; m < 4; ++m) _Pragma("unroll") for (int k = 0; k < 2; ++k) dst[m][k] = *(const PG8_LAS bf16x8*)(lds + PG8_SA(b, h) + aoff + m * 2048 + k * 1024); } while (0)
#define PG8_LDB(dst, b, h) do { _Pragma("unroll") for (int n = 0; n < 2; ++n) _Pragma("unroll") for (int k = 0; k < 2; ++k) dst[n][k] = *(const PG8_LAS bf16x8*)(lds + PG8_SB(b, h) + boff + n * 2048 + k * 1024); } while (0)
#define PG8_MMA(ai, bj, At, Bt) do { __builtin_amdgcn_s_setprio(1); _Pragma("unroll") for (int m = 0; m < 4; ++m) _Pragma("unroll") for (int n = 0; n < 2; ++n) _Pragma("unroll") for (int k = 0; k < 2; ++k) \
        acc[ai][bj][m][n] = __builtin_amdgcn_mfma_f32_16x16x32_bf16(Bt[n][k], At[m][k], acc[ai][bj][m][n], 0, 0, 0); __builtin_amdgcn_s_setprio(0); } while (0)
#define PG8_WAIT_V(n) asm volatile("s_waitcnt vmcnt(" #n ")" ::: "memory")
#define PG8_WAIT_L(n) asm volatile("s_waitcnt lgkmcnt(" #n ")" ::: "memory")
#define PG8_BAR __builtin_amdgcn_s_barrier()
#define PG8_SCHED __builtin_amdgcn_sched_barrier(0)
    Unit cur, nxt; int ui = 0;
    if (!S.next(0, cur)) return;
    f32x4 acc[2][2][4][2];
#pragma unroll
    for (int a = 0; a < 2; ++a)
#pragma unroll
        for (int b = 0; b < 2; ++b)
#pragma unroll
            for (int m = 0; m < 4; ++m)
#pragma unroll
                for (int n = 0; n < 2; ++n) acc[a][b][m][n] = (f32x4){0.f, 0.f, 0.f, 0.f};
    bf16x8 At[4][2], B0[2][2], B1[2][2];
    const char* cA = S.a_base(g, cur); const char* cB = S.b_base(g, cur);
    if constexpr (SP2) {
        PG8_STAGE(PG8_SB(0, 0), cB, voffB); PG8_STAGE(PG8_SB(0, 1), cB + hstepB, voffB); PG8_STAGE(PG8_SA(0, 0), cA, voffA); PG8_STAGE(PG8_SA(0, 1), cA + hstepA, voffA);
        if (wr == 1) PG8_BAR;
        PG8_WAIT_V(2); PG8_BAR;
        PG8_STAGE(PG8_SB(1, 0), cB + kstep, voffB); PG8_STAGE(PG8_SA(1, 0), cA + kstep, voffA); PG8_STAGE(PG8_SB(1, 1), cB + hstepB + kstep, voffB);
        PG8_WAIT_V(6); PG8_BAR;
    } else {
        PG8_STAGE(PG8_SB(0, 0), cB, voffB); PG8_STAGE(PG8_SA(0, 0), cA, voffA); PG8_STAGE(PG8_SB(0, 1), cB + hstepB, voffB); PG8_STAGE(PG8_SA(0, 1), cA + hstepA, voffA);
        if (wr == 1) PG8_BAR;
        PG8_WAIT_V(4); PG8_BAR;
        PG8_STAGE(PG8_SB(1, 0), cB + kstep, voffB); PG8_STAGE(PG8_SA(1, 0), cA + kstep, voffA); PG8_STAGE(PG8_SB(1, 1), cB + hstepB + kstep, voffB);
        PG8_WAIT_V(6); PG8_BAR;
    }
    for (;;) {
        const bool has_next = S.next(ui + 1, nxt);
        const char* nA = has_next ? S.a_base(g, nxt) : cA; const char* nB = has_next ? S.b_base(g, nxt) : cB;
        for (int t = 0; t < nt; t += 2) {
            const bool last = (t == nt - 2);
            const char* a1 = cA + (size_t)(t + 1) * kstep;
            const char* a2 = last ? nA : cA + (size_t)(t + 2) * kstep; const char* b2 = last ? nB : cB + (size_t)(t + 2) * kstep;
            const char* a3 = a2 + kstep; const char* b3 = b2 + kstep;
            if constexpr (SP2) {
            PG8_LDB(B0, 0, 0); PG8_LDB(B1, 0, 1); PG8_SCHED; PG8_LDA(At, 0, 0); PG8_STAGE(PG8_SA(1, 1), a1 + hstepA, voffA);
            PG8_WAIT_V(8); PG8_WAIT_L(0); PG8_BAR; PG8_MMA(0, 0, At, B0); PG8_MMA(0, 1, At, B1); PG8_BAR; PG8_SCHED;
            PG8_LDA(At, 0, 1); PG8_STAGE(PG8_SB(0, 0), b2, voffB); PG8_STAGE(PG8_SB(0, 1), b2 + hstepB, voffB); PG8_STAGE(PG8_SA(0, 0), a2, voffA);
            PG8_WAIT_V(8); PG8_WAIT_L(0); PG8_BAR; PG8_MMA(1, 0, At, B0); PG8_MMA(1, 1, At, B1); PG8_BAR; PG8_SCHED;
            PG8_LDB(B0, 1, 0); PG8_LDB(B1, 1, 1); PG8_SCHED; PG8_LDA(At, 1, 0); PG8_STAGE(PG8_SA(0, 1), a2 + hstepA, voffA);
            PG8_WAIT_V(8); PG8_WAIT_L(0); PG8_BAR; PG8_MMA(0, 0, At, B0); PG8_MMA(0, 1, At, B1); PG8_BAR; PG8_SCHED;
            PG8_LDA(At, 1, 1); PG8_STAGE(PG8_SB(1, 0), b3, voffB); PG8_STAGE(PG8_SB(1, 1), b3 + hstepB, voffB); PG8_STAGE(PG8_SA(1, 0), a3, voffA);
            PG8_WAIT_V(8); PG8_WAIT_L(0); PG8_BAR; PG8_MMA(1, 0, At, B0); PG8_MMA(1, 1, At, B1); PG8_BAR; PG8_SCHED;
            } else {
            PG8_LDB(B0, 0, 0); PG8_SCHED; PG8_LDA(At, 0, 0); PG8_STAGE(PG8_SA(1, 1), a1 + hstepA, voffA);
            PG8_WAIT_L(8); PG8_BAR; PG8_WAIT_L(0); PG8_MMA(0, 0, At, B0); PG8_BAR; PG8_SCHED;
            PG8_LDB(B1, 0, 1); PG8_STAGE(PG8_SB(0, 0), b2, voffB);
            PG8_BAR; PG8_WAIT_L(0); PG8_MMA(0, 1, At, B1); PG8_BAR;
            PG8_LDA(At, 0, 1); PG8_STAGE(PG8_SA(0, 0), a2, voffA);
            PG8_BAR; PG8_WAIT_L(0); PG8_MMA(1, 0, At, B0); PG8_BAR; PG8_SCHED;
            PG8_STAGE(PG8_SB(0, 1), b2 + hstepB, voffB);
            PG8_WAIT_V(6); PG8_BAR; PG8_MMA(1, 1, At, B1); PG8_BAR;
            PG8_LDB(B0, 1, 0); PG8_SCHED; PG8_LDA(At, 1, 0); PG8_STAGE(PG8_SA(0, 1), a2 + hstepA, voffA);
            PG8_WAIT_L(8); PG8_BAR; PG8_WAIT_L(0); PG8_MMA(0, 0, At, B0); PG8_BAR; PG8_SCHED;
            PG8_LDB(B1, 1, 1); PG8_STAGE(PG8_SB(1, 0), b3, voffB);
            PG8_BAR; PG8_WAIT_L(0); PG8_MMA(0, 1, At, B1); PG8_BAR;
            PG8_LDA(At, 1, 1); PG8_STAGE(PG8_SA(1, 0), a3, voffA);
            PG8_BAR; PG8_WAIT_L(0); PG8_MMA(1, 0, At, B0); PG8_BAR; PG8_SCHED;
            PG8_STAGE(PG8_SB(1, 1), b3 + hstepB, voffB);
            PG8_WAIT_V(6); PG8_BAR; PG8_MMA(1, 1, At, B1); PG8_BAR;
            }
        }
        if constexpr (ALIGN_EPI) { if (wr == 0) PG8_BAR; }
        E(acc, cur, wr, wc, fr, fq);
        if (!has_next) break;
#pragma unroll
        for (int a = 0; a < 2; ++a)
#pragma unroll
            for (int b = 0; b < 2; ++b)
#pragma unroll
                for (int m = 0; m < 4; ++m)
#pragma unroll
                    for (int n = 0; n < 2; ++n) acc[a][b][m][n] = (f32x4){0.f, 0.f, 0.f, 0.f};
        cur = nxt; cA = nA; cB = nB; ++ui;
        if constexpr (ALIGN_EPI) { if (wr == 1) PG8_BAR; }
    }
    PG8_WAIT_V(0);
    if constexpr (!ALIGN_EPI) { if (wr == 0) PG8_BAR; }
    PG8_BAR;
#undef PG8_SA
#undef PG8_SB
#undef PG8_STAGE
#undef PG8_LDA
#undef PG8_LDB
#undef PG8_MMA
#undef PG8_WAIT_V
#undef PG8_WAIT_L
#undef PG8_BAR
#undef PG8_SCHED
}
template <class Epi, class Sched>
__device__ __forceinline__ void gemm_phase_gather(PG8_LAS unsigned char* lds, const Gemm g, const Sched& S, const Epi& E, const int tid) {
    const int wid = __builtin_amdgcn_readfirstlane(tid >> 6), lane = tid & 63, wr = wid >> 2, wc = wid & 3, fr = lane & 15, fq = lane >> 4;
    int K = g.K; asm volatile("" : "+s"(K));
    const int nt = K / BK;
    unsigned voffB[2]; int RA[2]; unsigned CA2[2];
#pragma unroll
    for (int i = 0; i < 2; ++i) { int R, C; stage_rc(tid * 16 + i * 8192, R, C); const int Rb = Epi::PERM ? ((R & ~31) + perm32(R & 31)) : R;
        RA[i] = R; CA2[i] = (unsigned)C * 2u; voffB[i] = (unsigned)(Rb * g.ldb + C) * 2u; }
    unsigned vA0[2], vA1[2], nA0[2], nA1[2];
#define PG8_ROWS(u_, d0, d1) do { _Pragma("unroll") for (int i_ = 0; i_ < 2; ++i_) { d0[i_] = S.a_row(u_, RA[i_]) * (unsigned)(g.lda * 2) + CA2[i_]; d1[i_] = S.a_row(u_, HALF + RA[i_]) * (unsigned)(g.lda * 2) + CA2[i_]; } } while (0)
    const size_t kstep = (size_t)(BK * 2);
    const size_t hstepA = (size_t)HALF * g.lda * 2, hstepB = (size_t)HALF * g.ldb * 2;
    const unsigned ldsw = (unsigned)wid * 1024u;
    const int aoff = lds_byte(wr * 64 + fr, fq * 8), boff = lds_byte(wc * 32 + fr, fq * 8);
#define PG8_SA(b, h) (((b) * 2 + (h)) * HTB)
#define PG8_SB(b, h) ((4 + (b) * 2 + (h)) * HTB)
#define PG8_STAGE(bufoff, gbase, voff) do { _Pragma("unroll") for (int _i = 0; _i < 2; ++_i) \
        __builtin_amdgcn_global_load_lds((const unsigned*)((const char*)(gbase) + (voff)[_i]), (PG8_LAS unsigned*)(lds + (bufoff) + ldsw + _i * 8192), 16, 0, 0); } while (0)
#define PG8_LDA(dst, b, h) do { _Pragma("unroll") for (int m = 0; m < 4; ++m) _Pragma("unroll") for (int k = 0; k < 2; ++k) dst[m][k] = *(const PG8_LAS bf16x8*)(lds + PG8_SA(b, h) + aoff + m * 2048 + k * 1024); } while (0)
#define PG8_LDB(dst, b, h) do { _Pragma("unroll") for (int n = 0; n < 2; ++n) _Pragma("unroll") for (int k = 0; k < 2; ++k) dst[n][k] = *(const PG8_LAS bf16x8*)(lds + PG8_SB(b, h) + boff + n * 2048 + k * 1024); } while (0)
#define PG8_MMA(ai, bj, At, Bt) do { __builtin_amdgcn_s_setprio(1); _Pragma("unroll") for (int m = 0; m < 4; ++m) _Pragma("unroll") for (int n = 0; n < 2; ++n) _Pragma("unroll") for (int k = 0; k < 2; ++k) \
        acc[ai][bj][m][n] = __builtin_amdgcn_mfma_f32_16x16x32_bf16(Bt[n][k], At[m][k], acc[ai][bj][m][n], 0, 0, 0); __builtin_amdgcn_s_setprio(0); } while (0)
#define PG8_WAIT_V(n) asm volatile("s_waitcnt vmcnt(" #n ")" ::: "memory")
#define PG8_WAIT_L(n) asm volatile("s_waitcnt lgkmcnt(" #n ")" ::: "memory")
#define PG8_BAR __builtin_amdgcn_s_barrier()
#define PG8_SCHED __builtin_amdgcn_sched_barrier(0)
    Unit cur, nxt; int ui = 0;
    if (!S.next(0, cur)) return;
    f32x4 acc[2][2][4][2];
#pragma unroll
    for (int a = 0; a < 2; ++a)
#pragma unroll
        for (int b = 0; b < 2; ++b)
#pragma unroll
            for (int m = 0; m < 4; ++m)
#pragma unroll
                for (int n = 0; n < 2; ++n) acc[a][b][m][n] = (f32x4){0.f, 0.f, 0.f, 0.f};
    bf16x8 At[4][2], B0[2][2], B1[2][2];
    const char* cA = (const char*)g.A; const char* cB = S.b_base(g, cur);
    PG8_ROWS(cur, vA0, vA1);
    if constexpr (true) {
        PG8_STAGE(PG8_SB(0, 0), cB, voffB); PG8_STAGE(PG8_SB(0, 1), cB + hstepB, voffB); PG8_STAGE(PG8_SA(0, 0), cA, vA0); PG8_STAGE(PG8_SA(0, 1), cA, vA1);
        if (wr == 1) PG8_BAR;
        PG8_WAIT_V(2); PG8_BAR;
        PG8_STAGE(PG8_SB(1, 0), cB + kstep, voffB); PG8_STAGE(PG8_SA(1, 0), cA + kstep, vA0); PG8_STAGE(PG8_SB(1, 1), cB + hstepB + kstep, voffB);
        PG8_WAIT_V(6); PG8_BAR;
    }
    for (;;) {
        const bool has_next = S.next(ui + 1, nxt);
        const char* nA = (const char*)g.A; const char* nB = has_next ? S.b_base(g, nxt) : cB;
        if (has_next) PG8_ROWS(nxt, nA0, nA1); else { nA0[0] = vA0[0]; nA0[1] = vA0[1]; nA1[0] = vA1[0]; nA1[1] = vA1[1]; }
        for (int t = 0; t < nt; t += 2) {
            const bool last = (t == nt - 2);
            const char* a1 = cA + (size_t)(t + 1) * kstep;
            const char* a2 = last ? nA : cA + (size_t)(t + 2) * kstep; const char* b2 = last ? nB : cB + (size_t)(t + 2) * kstep;
            const char* a3 = a2 + kstep; const char* b3 = b2 + kstep;
            unsigned sA0[2], sA1[2]; sA0[0] = last ? nA0[0] : vA0[0]; sA0[1] = last ? nA0[1] : vA0[1]; sA1[0] = last ? nA1[0] : vA1[0]; sA1[1] = last ? nA1[1] : vA1[1];
            if constexpr (true) {
            PG8_LDB(B0, 0, 0); PG8_LDB(B1, 0, 1); PG8_SCHED; PG8_LDA(At, 0, 0); PG8_STAGE(PG8_SA(1, 1), a1, vA1);
            PG8_WAIT_V(8); PG8_WAIT_L(0); PG8_BAR; PG8_MMA(0, 0, At, B0); PG8_MMA(0, 1, At, B1); PG8_BAR; PG8_SCHED;
            PG8_LDA(At, 0, 1); PG8_STAGE(PG8_SB(0, 0), b2, voffB); PG8_STAGE(PG8_SB(0, 1), b2 + hstepB, voffB); PG8_STAGE(PG8_SA(0, 0), a2, sA0);
            PG8_WAIT_V(8); PG8_WAIT_L(0); PG8_BAR; PG8_MMA(1, 0, At, B0); PG8_MMA(1, 1, At, B1); PG8_BAR; PG8_SCHED;
            PG8_LDB(B0, 1, 0); PG8_LDB(B1, 1, 1); PG8_SCHED; PG8_LDA(At, 1, 0); PG8_STAGE(PG8_SA(0, 1), a2, sA1);
            PG8_WAIT_V(8); PG8_WAIT_L(0); PG8_BAR; PG8_MMA(0, 0, At, B0); PG8_MMA(0, 1, At, B1); PG8_BAR; PG8_SCHED;
            PG8_LDA(At, 1, 1); PG8_STAGE(PG8_SB(1, 0), b3, voffB); PG8_STAGE(PG8_SB(1, 1), b3 + hstepB, voffB); PG8_STAGE(PG8_SA(1, 0), a3, sA0);
            PG8_WAIT_V(8); PG8_WAIT_L(0); PG8_BAR; PG8_MMA(1, 0, At, B0); PG8_MMA(1, 1, At, B1); PG8_BAR; PG8_SCHED;
            }
        }
        if constexpr (true) { if (wr == 0) PG8_BAR; }
        E(acc, cur, wr, wc, fr, fq);
        if (!has_next) break;
#pragma unroll
        for (int a = 0; a < 2; ++a)
#pragma unroll
            for (int b = 0; b < 2; ++b)
#pragma unroll
                for (int m = 0; m < 4; ++m)
#pragma unroll
                    for (int n = 0; n < 2; ++n) acc[a][b][m][n] = (f32x4){0.f, 0.f, 0.f, 0.f};
        cur = nxt; cB = nB; ++ui; vA0[0] = nA0[0]; vA0[1] = nA0[1]; vA1[0] = nA1[0]; vA1[1] = nA1[1];
        if constexpr (true) { if (wr == 1) PG8_BAR; }
    }
    PG8_WAIT_V(0);
    if constexpr (false) { if (wr == 0) PG8_BAR; }
    PG8_BAR;
#undef PG8_ROWS
#undef PG8_SA
#undef PG8_SB
#undef PG8_STAGE
#undef PG8_LDA
#undef PG8_LDB
#undef PG8_MMA
#undef PG8_WAIT_V
#undef PG8_WAIT_L
#undef PG8_BAR
#undef PG8_SCHED
}
}
#define LAS __attribute__((address_space(3)))
#define XB_TMO      128
#define XB_XCNT(j)  (256  + 64 * (j))
#define XB_XSUB(j)  (1280 + 64 * (j))
#define XB_XGEN(j)  (2304 + 64 * (j))
#define XB_TOP      3328
#define XB_TOPGEN   3392
#define XCD_BAR_WORDS 3456
#define XB_SPIN_CAP (1u << 22)

__device__ __forceinline__ unsigned xb_ld(unsigned* p)              { return __hip_atomic_load(p, __ATOMIC_RELAXED, __HIP_MEMORY_SCOPE_AGENT); }
__device__ __forceinline__ unsigned xb_add(unsigned* p, unsigned v) { return __hip_atomic_fetch_add(p, v, __ATOMIC_RELAXED, __HIP_MEMORY_SCOPE_AGENT); }
__device__ __forceinline__ unsigned xb_xcc_id() { return (unsigned)__builtin_amdgcn_s_getreg((3 << 11) | 20) & 0xFu; }
#define XB_SPIN(cond, bar) do { unsigned _sp = 0; while (cond) { __builtin_amdgcn_s_sleep(1); \
    if ((++_sp & 255u) == 0u) { if (xb_ld(&(bar)[XB_TMO])) break; if (_sp > XB_SPIN_CAP) { atomicAdd(&(bar)[XB_TMO], 1u); break; } } } } while (0)

struct XcdBarrier {
    unsigned* bar; unsigned x;
    volatile LAS unsigned* st;
};

__device__ __forceinline__ XcdBarrier xcd_barrier_post(unsigned* bar, volatile LAS unsigned* st) {
    XcdBarrier b; b.bar = bar; b.x = xb_xcc_id(); b.st = st;
    if (threadIdx.x == 0) (void)xb_add(&bar[XB_XCNT(b.x)], 1u);
    return b;
}
__device__ __forceinline__ void xcd_barrier_complete(unsigned* bar, unsigned x, unsigned& nloc, unsigned& nx) {
    const unsigned G = gridDim.x * gridDim.y * gridDim.z;
    unsigned sum, cnt, mine, sp = 0u;
    for (;;) {
        sum = 0u; cnt = 0u; mine = 0u;
#pragma unroll
        for (unsigned j = 0; j < 16; ++j) { const unsigned c = xb_ld(&bar[XB_XCNT(j)]); sum += c; cnt += (c > 0u) ? 1u : 0u; mine = (j == x) ? c : mine; }
        if (sum == G) break;
        __builtin_amdgcn_s_sleep(1);
        if ((++sp & 255u) == 0u) { if (xb_ld(&bar[XB_TMO])) break; if (sp > XB_SPIN_CAP) { atomicAdd(&bar[XB_TMO], 1u); break; } }
    }
    nloc = mine > 0u ? mine : 1u; nx = cnt > 0u ? cnt : 1u;
}

__device__ __forceinline__ void xcd_barrier(const XcdBarrier& b) {
    asm volatile("s_waitcnt vmcnt(0)" ::: "memory");
    __syncthreads();
    if (threadIdx.x == 0) {
        unsigned* bar = b.bar;
        __builtin_amdgcn_s_waitcnt(0);
        unsigned nloc = b.st[0], nx = b.st[1];
        if (nloc == 0u) { xcd_barrier_complete(bar, b.x, nloc, nx); b.st[0] = nloc; b.st[1] = nx; }
        const unsigned old = xb_add(&bar[XB_XSUB(b.x)], 1u);
        const unsigned gen = old / nloc;
        if (old + 1u == (gen + 1u) * nloc) {
            __builtin_amdgcn_fence(__ATOMIC_RELEASE, "agent");
            asm volatile("s_waitcnt vmcnt(0)" ::: "memory");
            const unsigned og = xb_add(&bar[XB_TOP], 1u);
            const unsigned tg = og / nx;
            if (og + 1u == (tg + 1u) * nx) xb_add(&bar[XB_TOPGEN], 1u);
            else XB_SPIN(xb_ld(&bar[XB_TOPGEN]) == tg, bar);
            __builtin_amdgcn_fence(__ATOMIC_ACQUIRE, "agent");
            xb_add(&bar[XB_XGEN(b.x)], 1u);
            asm volatile("s_waitcnt vmcnt(0)" ::: "memory");
        } else {
            XB_SPIN(xb_ld(&bar[XB_XGEN(b.x)]) == gen, bar);
            __builtin_amdgcn_fence(__ATOMIC_ACQUIRE, "agent");
            asm volatile("s_waitcnt vmcnt(0)" ::: "memory");
        }
    }
    __syncthreads();
}
#undef LAS
constexpr int NWAVES = 8;
constexpr int BATCH = 2, SEQ = 16384, NTOK = BATCH * SEQ, DM = 1024, DEPTH = 4, PLE = 256;
constexpr int EVEN_IN = 2216, EVEN_INP = 2304, ODD_IN = 2568, ODD_INP = 2816;
constexpr int E_FQ = 0, E_FK = 512, E_FV = 1024, E_FLOG = 1536, E_CQ = 1544, E_CKV = 1928, E_KROPE = 2184;
constexpr int O_U = 0, O_Q = 512, O_K = 1024, O_V = 1536, O_GIN = 2048, O_BETA = 2052, O_Z = 2056;
constexpr float RMS_EPS = 1e-6f;
constexpr float LOG2E = 1.4426950408889634f, LN2 = 0.6931471805599453f;
constexpr float C2_FOX = 0.125f * LOG2E, C2_MLA = 0.10206207261596575f * LOG2E;
constexpr int MOE_CAP = 65536 + 32 * 256;
constexpr int MOE_MAXT = MOE_CAP / 256;

enum { I_X = 0, I_P, I_POS, I_NORM_MIX, I_NORM_FFN, I_EV_W_IN, I_FOX_BF, I_FOX_QN, I_FOX_KN, I_MLA_QAN, I_MLA_WQUP, I_MLA_KVAN, I_MLA_WKVUP, I_MLA_QN, I_MLA_KN, I_EV_W_OUT,
       I_OD_W_IN, I_S5_ARE, I_S5_AIM, I_S5_BRE, I_S5_BIM, I_S5_CRE, I_S5_CIM, I_S5_D, I_S5_LS, I_S5_WGLU, I_S5_BGLU, I_GDN_CONV, I_GDN_ALOG, I_GDN_DTB, I_GDN_ONORM, I_OD_W_OUT,
       I_MOE_WGRP, I_MOE_BGRP, I_MOE_WEXP, I_MOE_BEXP, I_MOE_WG, I_MOE_WU, I_MOE_WD, I_PLE_WP, I_PLE_NORM, I_PLE_WG, I_PLE_BG, N_IN };

constexpr size_t MiB = 1u << 20;
constexpr size_t WS_CTL = 0, CTL_ZERO_BYTES = 1 * MiB;
constexpr size_t WS_W_EVIN = 4 * MiB;
constexpr size_t WS_W_ODIN = WS_W_EVIN + 9 * MiB;
constexpr size_t WS_W_QUP = WS_W_ODIN + 11 * MiB;
constexpr size_t WS_W_KVUP = WS_W_QUP + 2 * MiB;
constexpr size_t WS_W_EVOUT = WS_W_KVUP + 1 * MiB;
constexpr size_t WS_W_ODOUT = WS_W_EVOUT + 4 * MiB;
constexpr size_t WS_W_GLU = WS_W_ODOUT + 4 * MiB;
constexpr size_t WS_W_PLEP = WS_W_GLU + 1 * MiB;
constexpr size_t WS_W_PLEG = WS_W_PLEP + 2 * MiB;
constexpr size_t WS_W_MOEGU = WS_W_PLEG + 8 * MiB;
constexpr size_t WS_W_MOED = WS_W_MOEGU + 64 * MiB;
constexpr size_t WS_ABF = WS_W_MOED + 32 * MiB;
constexpr size_t WS_PP = WS_ABF + 64 * MiB;
constexpr size_t WS_PBF = WS_PP + 64 * MiB;
constexpr size_t WS_PROJ = WS_PBF + 16 * MiB;
constexpr size_t WS_MIX = WS_PROJ + 176 * MiB;
constexpr size_t WS_R1 = WS_MIX + 64 * MiB;
constexpr size_t WS_QM = WS_R1, WS_KVB = WS_QM + 48 * MiB, WS_KM = WS_KVB + 64 * MiB, WS_CQN = WS_KM + 48 * MiB, WS_CKVN = WS_CQN + 24 * MiB, WS_LOGF = WS_CKVN + 16 * MiB, WS_CUM = WS_LOGF + 1 * MiB;
constexpr size_t WS_HG = WS_R1, WS_QG = WS_HG + 32 * MiB, WS_KG = WS_QG + 64 * MiB, WS_VG = WS_KG + 64 * MiB, WS_OG = WS_VG + 64 * MiB;
constexpr size_t WS_R2 = WS_R1 + 288 * MiB;
constexpr size_t WS_GB = WS_R2, WS_BETA = WS_GB + 1 * MiB;
constexpr size_t WS_TOKE = WS_R2 + 2 * MiB, WS_TOKW = WS_TOKE + 1 * MiB, WS_ROWS = WS_TOKW + 1 * MiB;
constexpr size_t WS_P2T = WS_R2 + 4 * MiB;
constexpr size_t WS_XG = WS_R1;
constexpr size_t WS_HB = WS_XG + 144 * MiB;
constexpr size_t WS_Y2 = WS_R2 + 8 * MiB;
constexpr size_t WS_END = WS_Y2 + 144 * MiB;
static_assert(WS_HB + 72 * MiB <= WS_R2, "moe overlay");
static_assert(WS_OG + 64 * MiB <= WS_R2, "odd overlay");
constexpr size_t WS_H16 = WS_END;
constexpr size_t WS_DUMMY = WS_H16 + 64 * MiB;
static_assert(WS_DUMMY + 64 * MiB <= 1100 * MiB, "workspace budget");

constexpr int CW_BAR = 4096;
constexpr int CW_CNT = 1024;

constexpr int RING_OFF = 0, RING_BYTES = 131072;
constexpr int LDSCTL_OFF = RING_BYTES;
constexpr int LDS_BYTES = 147456;
constexpr int LC_BARST = 32;
constexpr int LC_MOE = 256;

#define GAS __attribute__((address_space(1)))
#define LAS __attribute__((address_space(3)))
typedef unsigned short bf16;
typedef unsigned v4u __attribute__((ext_vector_type(4)));
typedef unsigned v2u __attribute__((ext_vector_type(2)));
typedef float f32x4 __attribute__((ext_vector_type(4)));
#define LDS_WAIT() asm volatile("s_waitcnt lgkmcnt(0)" ::: "memory")
#define VM_WAIT() asm volatile("s_waitcnt vmcnt(0)" ::: "memory")
typedef float f32x2_pk __attribute__((ext_vector_type(2))); typedef __bf16 bf16x2_pk __attribute__((ext_vector_type(2)));
__device__ __forceinline__ unsigned pk2(float lo, float hi) { f32x2_pk v = {lo, hi}; bf16x2_pk b = __builtin_convertvector(v, bf16x2_pk); return __builtin_bit_cast(unsigned, b); }
__device__ __forceinline__ unsigned f2bf(float f) { return pk2(f, 0.f) & 0xffffu; }
__device__ __forceinline__ float bflo(unsigned w) { return __uint_as_float(w << 16); }
__device__ __forceinline__ float bfhi(unsigned w) { return __uint_as_float(w & 0xffff0000u); }
__device__ __forceinline__ float bf2f(bf16 h) { return __uint_as_float((unsigned)h << 16); }
__device__ __forceinline__ float wave_sum(float v) {
#pragma unroll
    for (int o = 1; o < 64; o <<= 1) v += __shfl_xor(v, o);
    return v;
}
__device__ __forceinline__ float sigm(float x) { return 1.0f / (1.0f + expf(-x)); }
__device__ __forceinline__ float softplusf_(float x) { return fmaxf(x, 0.f) + log1pf(expf(-fabsf(x))); }
__device__ __forceinline__ float gelu_tanh(float x) { return 0.5f * x * (1.0f + tanhf(0.7978845608028654f * (x + 0.044715f * x * x * x))); }

struct Args { const float* in[N_IN]; float* out; unsigned char* ws; int ph_lo, ph_hi; };
#define CAS __attribute__((address_space(4)))
__device__ __forceinline__ const float* kin(int i) { asm volatile("" : "+s"(i)); const CAS char* kp = (const CAS char*)__builtin_amdgcn_kernarg_segment_ptr(); return *(const float* const CAS*)(kp + 8 * i); }
__device__ __forceinline__ float* kout() { int i = N_IN; asm volatile("" : "+s"(i)); const CAS char* kp = (const CAS char*)__builtin_amdgcn_kernarg_segment_ptr(); return *(float* const CAS*)(kp + 8 * i); }
__device__ __forceinline__ unsigned char* kws() { int i = N_IN + 1; asm volatile("" : "+s"(i)); const CAS char* kp = (const CAS char*)__builtin_amdgcn_kernarg_segment_ptr(); return *(unsigned char* const CAS*)(kp + 8 * i); }

struct Frame {
    LAS unsigned char* lds;
    unsigned char* ws;
    unsigned* ctl;
    int tid, lane, wave, G, bid;
};

__device__ __forceinline__ void transpose_load(const float* W, int N, int k0, int n0, int lane, f32x4 (&v)[8]) {
    const int c4 = 4 * (lane & 7), rr = lane >> 3; const bool ok = n0 + c4 + 3 < N;
#pragma unroll
    for (int i = 0; i < 8; ++i) v[i] = ok ? __builtin_nontemporal_load((const f32x4*)(W + (size_t)(k0 + 8 * i + rr) * N + n0 + c4)) : (f32x4){0.f, 0.f, 0.f, 0.f};
}
__device__ __forceinline__ void transpose_store(const f32x4 (&v)[8], int K, bf16* WT, int drow0, LAS float* scr, int k0, int lane) {
    { const int c4 = 4 * (lane & 7), rr = lane >> 3;
#pragma unroll
      for (int i = 0; i < 8; ++i) { LAS float* d = scr + (8 * i + rr) * 33 + c4; d[0] = v[i][0]; d[1] = v[i][1]; d[2] = v[i][2]; d[3] = v[i][3]; } }
    LDS_WAIT(); asm volatile("" ::: "memory");
    const int c = lane & 7;
#pragma unroll
    for (int j = 0; j < 4; ++j) { const int n = (lane >> 3) + 8 * j; const LAS float* s = scr + (8 * c) * 33 + n;
        v4u o; o.x = pk2(s[0 * 33], s[1 * 33]); o.y = pk2(s[2 * 33], s[3 * 33]); o.z = pk2(s[4 * 33], s[5 * 33]); o.w = pk2(s[6 * 33], s[7 * 33]);
        *(v4u*)(WT + (size_t)(drow0 + n) * K + k0 + 8 * c) = o; }
    LDS_WAIT(); asm volatile("" ::: "memory");
}
__device__ __forceinline__ void transpose_item(const float* W, int K, int N, bf16* WT, int drow0, LAS float* scr, int k0, int n0, int lane) {
    f32x4 v[8]; transpose_load(W, N, k0, n0, lane, v); transpose_store(v, K, WT, drow0, scr, k0, lane);
}
__device__ __forceinline__ void transpose_set(Frame& F, const float* W, int nmat, int K, int N, int NP, bf16* WT, int& itbase) {
    LAS float* scr = (LAS float*)(F.lds + RING_OFF + F.wave * 16384);
    const int gw = F.bid * NWAVES + F.wave, NGW = F.G * NWAVES;
    const int nkb = K / 64, nnb = NP / 32, per = nkb * nnb, total = nmat * per;
    int first = (gw - (itbase % NGW) + NGW) % NGW;
    for (int it = first; it < total; it += NGW) { const int mi = it / per, r = it % per, kb = r / nnb, nb = r % nnb;
        transpose_item(W + (size_t)mi * K * N, K, N, WT + (size_t)mi * NP * K, nb * 32, scr, kb * 64, nb * 32, F.lane); }
    itbase += total;
}
__device__ __forceinline__ void prologue_weights(Frame& F) {
 int itb = 0;
    transpose_set(F, kin(I_EV_W_IN), 2, 1024, EVEN_IN, EVEN_INP, (bf16*)(F.ws + WS_W_EVIN), itb);
    transpose_set(F, kin(I_OD_W_IN), 2, 1024, ODD_IN, ODD_INP, (bf16*)(F.ws + WS_W_ODIN), itb);
    transpose_set(F, kin(I_MLA_WQUP), 2, 384, 768, 768, (bf16*)(F.ws + WS_W_QUP), itb);
    transpose_set(F, kin(I_MLA_WKVUP), 2, 256, 1024, 1024, (bf16*)(F.ws + WS_W_KVUP), itb);
    transpose_set(F, kin(I_EV_W_OUT), 2, 1024, 1024, 1024, (bf16*)(F.ws + WS_W_EVOUT), itb);
    transpose_set(F, kin(I_OD_W_OUT), 2, 1024, 1024, 1024, (bf16*)(F.ws + WS_W_ODOUT), itb);
    transpose_set(F, kin(I_S5_WGLU), 2, 512, 512, 512, (bf16*)(F.ws + WS_W_GLU), itb);
    transpose_set(F, kin(I_PLE_WP), 4, 256, 1024, 1024, (bf16*)(F.ws + WS_W_PLEP), itb);
    transpose_set(F, kin(I_PLE_WG), 4, 1024, 1024, 1024, (bf16*)(F.ws + WS_W_PLEG), itb);
}
__device__ __forceinline__ void moe_weights(Frame& F, int layer, int wg0 = 0, int nwg = -1) {
    if (nwg < 0) nwg = F.G; if (F.bid < wg0 || F.bid >= wg0 + nwg) return;
    LAS float* scr = (LAS float*)(F.lds + RING_OFF + F.wave * 16384);
    const int gw = (F.bid - wg0) * NWAVES + F.wave, NGW = nwg * NWAVES;
    const float* wg = kin(I_MOE_WG) + (size_t)layer * 32 * 1024 * 512; const float* wu = kin(I_MOE_WU) + (size_t)layer * 32 * 1024 * 512; const float* wd = kin(I_MOE_WD) + (size_t)layer * 32 * 512 * 1024;
    bf16* WGU = (bf16*)(F.ws + WS_W_MOEGU); bf16* WD = (bf16*)(F.ws + WS_W_MOED);
#define MW_GU(it_, W_, e_, kb_, n0_, drow_) const int which_ = (it_) / (32 * 256), r0_ = (it_) % (32 * 256), e_ = r0_ / 256, r_ = r0_ % 256, kb_ = r_ / 16, n0_ = (r_ % 16) * 32; \
        const int drow_ = 256 * (n0_ / 128) + (n0_ % 128) + which_ * 128; const float* W_ = (which_ ? wu : wg) + (size_t)e_ * 1024 * 512
    { f32x4 v[8]; int it = gw;
      if (it < 2 * 32 * 256) { MW_GU(it, W0, e0, kb0, n00, d0); (void)d0; transpose_load(W0, 512, kb0 * 64, n00, F.lane, v); }
#pragma unroll 1
      for (; it < 2 * 32 * 256; it += NGW) { f32x4 vn[8]; const int itn = it + NGW;
          if (itn < 2 * 32 * 256) { MW_GU(itn, W1, e1, kb1, n01, d1); (void)d1; transpose_load(W1, 512, kb1 * 64, n01, F.lane, vn); }
          { MW_GU(it, W2, e2, kb2, n02, d2); (void)W2; (void)n02; transpose_store(v, 1024, WGU + (size_t)e2 * 1024 * 1024, d2, scr, kb2 * 64, F.lane); }
#pragma unroll
          for (int i = 0; i < 8; ++i) v[i] = vn[i]; } }
#undef MW_GU
    { f32x4 v[8]; int it = gw;
      if (it < 32 * 256) { const int e = it / 256, r = it % 256; transpose_load(wd + (size_t)e * 512 * 1024, 1024, (r / 32) * 64, (r % 32) * 32, F.lane, v); }
#pragma unroll 1
      for (; it < 32 * 256; it += NGW) { f32x4 vn[8]; const int itn = it + NGW;
          if (itn < 32 * 256) { const int e = itn / 256, r = itn % 256; transpose_load(wd + (size_t)e * 512 * 1024, 1024, (r / 32) * 64, (r % 32) * 32, F.lane, vn); }
          { const int e = it / 256, r = it % 256; transpose_store(v, 512, WD + (size_t)e * 1024 * 512, (r % 32) * 32, scr, (r / 32) * 64, F.lane); }
#pragma unroll
          for (int i = 0; i < 8; ++i) v[i] = vn[i]; } }
}

__device__ __forceinline__ void rms_row_to_bf16(const float* xrow, const float* gain, bf16* orow, float* copy, int lane) {
    const f32x4* xr = (const f32x4*)xrow + lane; f32x4 v[4]; float s = 0.f;
#pragma unroll
    for (int j = 0; j < 4; ++j) { v[j] = xr[64 * j]; s += (v[j].x * v[j].x + v[j].y * v[j].y) + (v[j].z * v[j].z + v[j].w * v[j].w); }
    const float r = 1.0f / sqrtf(wave_sum(s) * (1.f / 1024.f) + RMS_EPS);
    if (copy) {
#pragma unroll
        for (int j = 0; j < 4; ++j) ((f32x4*)copy + lane)[64 * j] = v[j]; }
    unsigned long long* o8 = (unsigned long long*)orow + lane;
#pragma unroll
    for (int j = 0; j < 4; ++j) { const f32x4 g = ((const f32x4*)gain + lane)[64 * j];
        o8[64 * j] = (unsigned long long)pk2(v[j].x * r * g.x, v[j].y * r * g.y) | ((unsigned long long)pk2(v[j].z * r * g.z, v[j].w * r * g.w) << 32); }
}
__device__ __forceinline__ void rms_row16_to_bf16(const bf16* xrow, const float* gain, bf16* orow, int lane) {
    float f[16]; float s = 0.f;
#pragma unroll
    for (int j = 0; j < 2; ++j) { const v4u x = ((const v4u*)xrow + lane)[64 * j]; f[8 * j] = bflo(x.x); f[8 * j + 1] = bfhi(x.x); f[8 * j + 2] = bflo(x.y); f[8 * j + 3] = bfhi(x.y); f[8 * j + 4] = bflo(x.z); f[8 * j + 5] = bfhi(x.z); f[8 * j + 6] = bflo(x.w); f[8 * j + 7] = bfhi(x.w); }
#pragma unroll
    for (int i = 0; i < 16; ++i) s += f[i] * f[i];
    const float r = 1.0f / sqrtf(wave_sum(s) * (1.f / 1024.f) + RMS_EPS);
#pragma unroll
    for (int j = 0; j < 2; ++j) { const float* g = gain + 512 * j + 8 * lane; const f32x4 g0 = *(const f32x4*)g, g1 = *(const f32x4*)(g + 4);
        v4u o; o.x = pk2(f[8 * j] * r * g0.x, f[8 * j + 1] * r * g0.y); o.y = pk2(f[8 * j + 2] * r * g0.z, f[8 * j + 3] * r * g0.w); o.z = pk2(f[8 * j + 4] * r * g1.x, f[8 * j + 5] * r * g1.y); o.w = pk2(f[8 * j + 6] * r * g1.z, f[8 * j + 7] * r * g1.w);
        ((v4u*)orow + lane)[64 * j] = o; }
}
__device__ __forceinline__ void phase_norm(Frame& F, const float* x_or_null, const float* gain) {
    bf16* ABF = (bf16*)(F.ws + WS_ABF); bf16* H16 = (bf16*)(F.ws + WS_H16);
    const int gw = F.bid * NWAVES + F.wave, NGW = F.G * NWAVES, lane = F.lane;
    if (x_or_null) {
        for (int m = gw; m < NTOK; m += NGW) { const f32x4* xr = (const f32x4*)(x_or_null + (size_t)m * DM) + lane; f32x4 v[4]; float s = 0.f;
#pragma unroll
            for (int j = 0; j < 4; ++j) { v[j] = xr[64 * j]; s += (v[j].x * v[j].x + v[j].y * v[j].y) + (v[j].z * v[j].z + v[j].w * v[j].w); }
            const float r = 1.0f / sqrtf(wave_sum(s) * (1.f / 1024.f) + RMS_EPS);
            unsigned long long* o8 = (unsigned long long*)(ABF + (size_t)m * DM) + lane; unsigned long long* h8 = (unsigned long long*)(H16 + (size_t)m * DM) + lane;
#pragma unroll
            for (int j = 0; j < 4; ++j) { const f32x4 g = ((const f32x4*)gain + lane)[64 * j];
                h8[64 * j] = (unsigned long long)pk2(v[j].x, v[j].y) | ((unsigned long long)pk2(v[j].z, v[j].w) << 32);
                o8[64 * j] = (unsigned long long)pk2(v[j].x * r * g.x, v[j].y * r * g.y) | ((unsigned long long)pk2(v[j].z * r * g.z, v[j].w * r * g.w) << 32); } }
    } else {
        for (int m = gw; m < NTOK; m += NGW) rms_row16_to_bf16(H16 + (size_t)m * DM, gain, ABF + (size_t)m * DM, lane);
    }
}
__device__ __forceinline__ void phase_pconv(Frame& F, int layer) {
    const float* p = kin(I_P) + (size_t)layer * NTOK * PLE; bf16* PBF = (bf16*)(F.ws + WS_PBF);
    const size_t n4 = (size_t)NTOK * PLE / 4; const size_t gt = (size_t)F.bid * 512 + F.tid, NT = (size_t)F.G * 512;
#pragma unroll 1
    for (size_t i = gt; i < n4; i += 8 * NT) { f32x4 v[8];
#pragma unroll
        for (int q = 0; q < 8; ++q) { const size_t ix = i + q * NT; v[q] = __builtin_nontemporal_load((const f32x4*)p + (ix < n4 ? ix : i)); }
#pragma unroll
        for (int q = 0; q < 8; ++q) { const size_t ix = i + q * NT; if (ix < n4) { v2u o; o.x = pk2(v[q].x, v[q].y); o.y = pk2(v[q].z, v[q].w); ((v2u*)PBF)[ix] = o; } } }
}

__device__ __forceinline__ void phase_even_post(Frame& F, int j, bool dry = false) {

    bf16* PROJ = (bf16*)(F.ws + WS_PROJ); bf16* CQN = (bf16*)(F.ws + WS_CQN); bf16* CKVN = (bf16*)(F.ws + WS_CKVN); float* LOGF = (float*)(F.ws + WS_LOGF);
    const float* qn = kin(I_FOX_QN) + j * 64; const float* kn = kin(I_FOX_KN) + j * 64; const float* bfv = kin(I_FOX_BF) + j * 8;
    const float* qan = kin(I_MLA_QAN) + j * 384; const float* kvan = kin(I_MLA_KVAN) + j * 256;
    const int gw = F.bid * NWAVES + F.wave, NGW = F.G * NWAVES, lane = F.lane;
    float gq_[8], gk_[8], gqa[6], gkv[4];
#pragma unroll
    for (int i = 0; i < 8; ++i) { gq_[i] = qn[(lane & 7) * 8 + i]; gk_[i] = kn[(lane & 7) * 8 + i]; }
#pragma unroll
    for (int i = 0; i < 3; ++i) { gqa[2 * i] = qan[2 * (lane + 64 * i)]; gqa[2 * i + 1] = qan[2 * (lane + 64 * i) + 1]; }
#pragma unroll
    for (int i = 0; i < 2; ++i) { gkv[2 * i] = kvan[2 * (lane + 64 * i)]; gkv[2 * i + 1] = kvan[2 * (lane + 64 * i) + 1]; }
    const float bfl = bfv[lane & 7];
#pragma unroll 1
    for (int m = gw; m < NTOK; m += NGW) {
        bf16* row = PROJ + (size_t)m * EVEN_INP;
        v4u* pq = (v4u*)(row + E_FQ) + lane; v4u* pk = (v4u*)(row + E_FK) + lane;
        const v4u xq = *pq, xk = *pk; const bf16 zl = row[E_FLOG + (lane & 7)];
        unsigned xc[3], xv[2];
#pragma unroll
        for (int i = 0; i < 3; ++i) xc[i] = *((const unsigned*)(row + E_CQ) + lane + 64 * i);
#pragma unroll
        for (int i = 0; i < 2; ++i) xv[i] = *((const unsigned*)(row + E_CKV) + lane + 64 * i);
        asm volatile("" : "+v"(xc[0]), "+v"(xc[1]), "+v"(xc[2]), "+v"(xv[0]), "+v"(xv[1]));
#pragma unroll
        for (int w = 0; w < 2; ++w) {
            const v4u x = w ? xk : xq;
            float f[8] = {bflo(x.x), bfhi(x.x), bflo(x.y), bfhi(x.y), bflo(x.z), bfhi(x.z), bflo(x.w), bfhi(x.w)};
            float s = 0.f;
#pragma unroll
            for (int i = 0; i < 8; ++i) s += f[i] * f[i];
            s += __shfl_xor(s, 1); s += __shfl_xor(s, 2); s += __shfl_xor(s, 4);
            const float r = (1.0f / sqrtf(s * (1.f / 64.f) + RMS_EPS)) * (w ? 1.0f : C2_FOX); const float* g = w ? gk_ : gq_;
            v4u o; o.x = pk2(f[0] * r * g[0], f[1] * r * g[1]); o.y = pk2(f[2] * r * g[2], f[3] * r * g[3]); o.z = pk2(f[4] * r * g[4], f[5] * r * g[5]); o.w = pk2(f[6] * r * g[6], f[7] * r * g[7]);
            *(dry ? (v4u*)(F.ws + WS_DUMMY) + (size_t)m * 128 + w * 64 + lane : (w ? pk : pq)) = o;
        }
        if (lane < 8) { const float z = bf2f(zl) + bfl; LOGF[(size_t)m * 8 + lane] = -softplusf_(-z); }
        {
            float f[6]; float s = 0.f;
#pragma unroll
            for (int i = 0; i < 3; ++i) { const unsigned x = xc[i]; f[2 * i] = bflo(x); f[2 * i + 1] = bfhi(x); s += f[2 * i] * f[2 * i] + f[2 * i + 1] * f[2 * i + 1]; }
            const float r = 1.0f / sqrtf(wave_sum(s) * (1.f / 384.f) + RMS_EPS);
#pragma unroll
            for (int i = 0; i < 3; ++i) { *((unsigned*)(CQN + (size_t)m * 384) + lane + 64 * i) = pk2(f[2 * i] * r * gqa[2 * i], f[2 * i + 1] * r * gqa[2 * i + 1]); }
        }
        {
            float f[4]; float s = 0.f;
#pragma unroll
            for (int i = 0; i < 2; ++i) { const unsigned x = xv[i]; f[2 * i] = bflo(x); f[2 * i + 1] = bfhi(x); s += f[2 * i] * f[2 * i] + f[2 * i + 1] * f[2 * i + 1]; }
            const float r = 1.0f / sqrtf(wave_sum(s) * (1.f / 256.f) + RMS_EPS);
#pragma unroll
            for (int i = 0; i < 2; ++i) { *((unsigned*)(CKVN + (size_t)m * 256) + lane + 64 * i) = pk2(f[2 * i] * r * gkv[2 * i], f[2 * i + 1] * r * gkv[2 * i + 1]); }
        }
    }
}
__device__ __forceinline__ void phase_cumsum(Frame& F) {
    if (F.bid >= 16) return;
    const float* LOGF = (const float*)(F.ws + WS_LOGF); float* CUM = (float*)(F.ws + WS_CUM);
    const int b = F.bid >> 3, h = F.bid & 7, t0 = F.tid * 32;
    LAS double* part = (LAS double*)(F.lds + RING_OFF);
    float v[32]; double s = 0.0;
#pragma unroll
    for (int i = 0; i < 32; ++i) { v[i] = LOGF[((size_t)b * SEQ + t0 + i) * 8 + h]; s += (double)v[i]; }
    part[F.tid] = s; __syncthreads();
    if (F.wave == 0) { double loc[8], run = 0.0;
#pragma unroll
        for (int i = 0; i < 8; ++i) { loc[i] = part[F.lane * 8 + i]; run += loc[i]; }
        double inc = run;
#pragma unroll
        for (int off = 1; off < 64; off <<= 1) { const double t = __shfl_up(inc, off); if (F.lane >= off) inc += t; }
        double ex = inc - run;
#pragma unroll
        for (int i = 0; i < 8; ++i) { part[F.lane * 8 + i] = ex; ex += loc[i]; } }
    __syncthreads();
    double run = part[F.tid];
#pragma unroll
    for (int i = 0; i < 32; ++i) { run += (double)v[i]; CUM[((size_t)b * SEQ + t0 + i) * 8 + h] = (float)run; }
    __syncthreads();
}
__device__ __forceinline__ void phase_mla_post(Frame& F, int j, bool dry = false) {

    const bf16* PROJ = (const bf16*)(F.ws + WS_PROJ); bf16* QM = (bf16*)(F.ws + WS_QM); const bf16* KVB = (const bf16*)(F.ws + WS_KVB); bf16* KM = (bf16*)(F.ws + WS_KM);
    const float* qn = kin(I_MLA_QN) + j * 96; const float* kn = kin(I_MLA_KN) + j * 96; const int* pos = (const int*)kin(I_POS);
    const int gw = F.bid * NWAVES + F.wave, NGW = F.G * NWAVES, lane = F.lane, l32 = lane & 31, hh = lane >> 5;
    const int fi = l32 & 15; const float inv = expf(-(float)fi * (1.0f / 16.0f) * 9.210340371976184f);
    const float gq0 = qn[l32], gq1 = qn[l32 + 32], gq2 = qn[l32 + 64], gk0 = kn[l32], gk1 = kn[l32 + 32], gk2 = kn[l32 + 64];
#pragma unroll 1
    for (int m = gw; m < NTOK; m += NGW) {
        const int pm = pos[m];
        const bf16 kr = PROJ[(size_t)m * EVEN_INP + E_KROPE + l32];
        bf16 xq[4][3], xk[4][2];
#pragma unroll
        for (int hp = 0; hp < 4; ++hp) { const int h = hp * 2 + hh; const bf16* q = QM + (size_t)m * 768 + h * 96; const bf16* k = KVB + (size_t)m * 1024 + h * 128;
            xq[hp][0] = q[l32]; xq[hp][1] = q[l32 + 32]; xq[hp][2] = q[l32 + 64]; xk[hp][0] = k[l32]; xk[hp][1] = k[l32 + 32]; }
        const float ang = (float)pm * inv; float sn, cs; sincosf(ang, &sn, &cs);
        const float krope = bf2f(kr);
#pragma unroll
        for (int hp = 0; hp < 4; ++hp) { const int h = hp * 2 + hh;
#pragma unroll
            for (int w = 0; w < 2; ++w) {
                float f[3];
                if (w == 0) { f[0] = bf2f(xq[hp][0]); f[1] = bf2f(xq[hp][1]); f[2] = bf2f(xq[hp][2]); }
                else { f[0] = bf2f(xk[hp][0]); f[1] = bf2f(xk[hp][1]); f[2] = krope; }
                float s = f[0] * f[0] + f[1] * f[1] + f[2] * f[2];
                s += __shfl_xor(s, 1); s += __shfl_xor(s, 2); s += __shfl_xor(s, 4); s += __shfl_xor(s, 8); s += __shfl_xor(s, 16);
                const float r = 1.0f / sqrtf(s * (1.f / 96.f) + RMS_EPS);
                f[0] *= r * (w ? gk0 : gq0); f[1] *= r * (w ? gk1 : gq1); f[2] *= r * (w ? gk2 : gq2);
                const float other = __shfl_xor(f[2], 16);
                const float rot = (l32 < 16) ? (f[2] * cs - other * sn) : (other * sn + f[2] * cs);
                bf16* o = (w ? KM : (dry ? (bf16*)(F.ws + WS_DUMMY) : QM)) + (size_t)m * 768 + h * 96; const float qs = w ? 1.0f : C2_MLA;
                o[l32] = (bf16)f2bf(f[0] * qs); o[l32 + 32] = (bf16)f2bf(f[1] * qs); o[l32 + 64] = (bf16)f2bf(rot * qs);
            }
        }
    }
}
template <int DK> __device__ __forceinline__ void attn_naive_unit(Frame& F, const bf16* Qp, int qld, const bf16* Kp, int kld, const bf16* Vp, int vld, const float* cum  , float scale, bf16* Op, int qb) {
    LAS float* Ks = (LAS float*)(F.lds + RING_OFF); LAS float* Vs = Ks + 64 * DK; LAS float* Cs = Vs + 64 * 64;
    const int t = qb * 512 + F.wave * 64 + F.lane; const int tmax_w = qb * 512 + F.wave * 64 + 63;
    float q[DK];
#pragma unroll
    for (int d = 0; d < DK; d += 8) { const v4u x = *(const v4u*)(Qp + (size_t)t * qld + d);
        q[d] = bflo(x.x) * scale; q[d + 1] = bfhi(x.x) * scale; q[d + 2] = bflo(x.y) * scale; q[d + 3] = bfhi(x.y) * scale; q[d + 4] = bflo(x.z) * scale; q[d + 5] = bfhi(x.z) * scale; q[d + 6] = bflo(x.w) * scale; q[d + 7] = bfhi(x.w) * scale; }
    const float cq = cum ? cum[(size_t)t * 8] : 0.f;
    float acc[64];
#pragma unroll
    for (int d = 0; d < 64; ++d) acc[d] = 0.f;
    float mx = -1e30f, l = 0.f;
    const int nkb = (qb * 512 + 512) / 64;
    for (int kb = 0; kb < nkb; ++kb) {
        __syncthreads();
        for (int i = F.tid; i < 64 * DK / 8; i += 512) { const int key = i / (DK / 8), c = (i % (DK / 8)) * 8; const v4u x = *(const v4u*)(Kp + (size_t)(kb * 64 + key) * kld + c);
            LAS float* d = Ks + key * DK + c; d[0] = bflo(x.x); d[1] = bfhi(x.x); d[2] = bflo(x.y); d[3] = bfhi(x.y); d[4] = bflo(x.z); d[5] = bfhi(x.z); d[6] = bflo(x.w); d[7] = bfhi(x.w); }
        { const int i = F.tid; const int key = i / 8, c = (i % 8) * 8; const v4u x = *(const v4u*)(Vp + (size_t)(kb * 64 + key) * vld + c);
            LAS float* d = Vs + key * 64 + c; d[0] = bflo(x.x); d[1] = bfhi(x.x); d[2] = bflo(x.y); d[3] = bfhi(x.y); d[4] = bflo(x.z); d[5] = bfhi(x.z); d[6] = bflo(x.w); d[7] = bfhi(x.w); }
        if (F.tid < 64) Cs[F.tid] = cum ? cum[(size_t)(kb * 64 + F.tid) * 8] : 0.f;
        __syncthreads();
        if (kb * 64 > tmax_w) continue;
        for (int jk = 0; jk < 64; ++jk) {
            const int s = kb * 64 + jk; if (s > tmax_w) break;
            const LAS float* kr = Ks + jk * DK; float dot = 0.f;
#pragma unroll
            for (int d = 0; d < DK; d += 4) { const f32x4 kv = *(const LAS f32x4*)(kr + d); dot += q[d] * kv.x + q[d + 1] * kv.y + q[d + 2] * kv.z + q[d + 3] * kv.w; }
            float logit = dot + (cq - Cs[jk]); if (s > t) logit = -1e30f;
            if (__any(logit > mx)) { const float mn = fmaxf(mx, logit); const float corr = expf(mx - mn); l *= corr;
#pragma unroll
                for (int d = 0; d < 64; ++d) acc[d] *= corr;
                mx = mn; }
            const float p = (s > t) ? 0.f : expf(logit - mx); l += p;
            const LAS float* vr = Vs + jk * 64;
#pragma unroll
            for (int d = 0; d < 64; d += 4) { const f32x4 vv = *(const LAS f32x4*)(vr + d); acc[d] += p * vv.x; acc[d + 1] += p * vv.y; acc[d + 2] += p * vv.z; acc[d + 3] += p * vv.w; }
        }
    }
    const float il = 1.0f / l; bf16* o = Op + (size_t)t * DM;
#pragma unroll
    for (int d = 0; d < 64; d += 8) { v4u w; w.x = pk2(acc[d] * il, acc[d + 1] * il); w.y = pk2(acc[d + 2] * il, acc[d + 3] * il); w.z = pk2(acc[d + 4] * il, acc[d + 5] * il); w.w = pk2(acc[d + 6] * il, acc[d + 7] * il); *(v4u*)(o + d) = w; }
}
__device__ __forceinline__ void phase_attn_naive(Frame& F) {
    const bf16* PROJ = (const bf16*)(F.ws + WS_PROJ); const bf16* QM = (const bf16*)(F.ws + WS_QM); const bf16* KVB = (const bf16*)(F.ws + WS_KVB); const bf16* KM = (const bf16*)(F.ws + WS_KM);
    const float* CUM = (const float*)(F.ws + WS_CUM); bf16* MIX = (bf16*)(F.ws + WS_MIX);
    for (int p = F.bid; p < 512; p += F.G) {
        const int combo = p >> 4, qq = p & 15; const int type = combo >> 4, b = (combo >> 3) & 1, h = combo & 7;
#pragma unroll 1
        for (int half = 0; half < 2; ++half) { const int qb = half ? 31 - qq : qq; const size_t rb = (size_t)b * SEQ;
            if (type == 0) attn_naive_unit<64>(F, PROJ + rb * EVEN_INP + E_FQ + h * 64, EVEN_INP, PROJ + rb * EVEN_INP + E_FK + h * 64, EVEN_INP, PROJ + rb * EVEN_INP + E_FV + h * 64, EVEN_INP, CUM + rb * 8 + h, LN2, MIX + rb * DM + h * 64, qb);
            else attn_naive_unit<96>(F, QM + rb * 768 + h * 96, 768, KM + rb * 768 + h * 96, 768, KVB + rb * 1024 + h * 128 + 64, 1024, nullptr, LN2, MIX + rb * DM + 512 + h * 64, qb);
        }
    }
    __syncthreads();
}

__device__ __forceinline__ void s5_scan_wave(Frame& F, int j, int b, int g) {
 const int p = F.lane;
    const bf16* PROJ = (const bf16*)(F.ws + WS_PROJ); bf16* HG = (bf16*)(F.ws + WS_HG);
    const float lr = fminf(kin(I_S5_ARE)[(j * 32 + g) * 64 + p], -1e-4f), li = kin(I_S5_AIM)[(j * 32 + g) * 64 + p];
    const float dt = expf(kin(I_S5_LS)[j * 32 + g]);
    const float mag = expf(lr * dt); const float abr = mag * cosf(li * dt), abi = mag * sinf(li * dt);
    const float den = lr * lr + li * li, nr = abr - 1.0f, ni = abi;
    const float gr = (nr * lr + ni * li) / den, gi = (ni * lr - nr * li) / den;
    float bbr[16], bbi[16], cr[16], ci[16], dsk[16];
#pragma unroll
    for (int c = 0; c < 16; ++c) { const float br = kin(I_S5_BRE)[((size_t)(j * 32 + g) * 64 + p) * 16 + c], bi = kin(I_S5_BIM)[((size_t)(j * 32 + g) * 64 + p) * 16 + c];
        bbr[c] = gr * br - gi * bi; bbi[c] = gr * bi + gi * br;
        cr[c] = kin(I_S5_CRE)[((size_t)(j * 32 + g) * 16 + c) * 64 + p]; ci[c] = kin(I_S5_CIM)[((size_t)(j * 32 + g) * 16 + c) * 64 + p];
        dsk[c] = kin(I_S5_D)[j * 512 + g * 16 + c]; }
    float xr = 0.f, xi = 0.f;
    const bf16* up = PROJ + (size_t)b * SEQ * ODD_INP + O_U + g * 16;
    v4u cur0[4], cur1[4], nx0[4], nx1[4];
#pragma unroll
    for (int i = 0; i < 4; ++i) { cur0[i] = *(const v4u*)(up + (size_t)i * ODD_INP); cur1[i] = *(const v4u*)(up + (size_t)i * ODD_INP + 8); }
    for (int t0 = 0; t0 < SEQ; t0 += 4) {
        const int tn = (t0 + 4 < SEQ) ? t0 + 4 : t0;
#pragma unroll
        for (int i = 0; i < 4; ++i) { nx0[i] = *(const v4u*)(up + (size_t)(tn + i) * ODD_INP); nx1[i] = *(const v4u*)(up + (size_t)(tn + i) * ODD_INP + 8); }
#pragma unroll
        for (int i = 0; i < 4; ++i) {
            float u[16] = {bflo(cur0[i].x), bfhi(cur0[i].x), bflo(cur0[i].y), bfhi(cur0[i].y), bflo(cur0[i].z), bfhi(cur0[i].z), bflo(cur0[i].w), bfhi(cur0[i].w),
                           bflo(cur1[i].x), bfhi(cur1[i].x), bflo(cur1[i].y), bfhi(cur1[i].y), bflo(cur1[i].z), bfhi(cur1[i].z), bflo(cur1[i].w), bfhi(cur1[i].w)};
            float bur = 0.f, bui = 0.f;
#pragma unroll
            for (int c = 0; c < 16; ++c) { bur += bbr[c] * u[c]; bui += bbi[c] * u[c]; }
            const float nxr = abr * xr - abi * xi + bur, nxi = abr * xi + abi * xr + bui; xr = nxr; xi = nxi;
            float y[16];
#pragma unroll
            for (int c = 0; c < 16; ++c) y[c] = wave_sum(cr[c] * xr - ci[c] * xi);
            if (p < 16) { float yy = 0.f, uu = 0.f, dd = 0.f;
#pragma unroll
                for (int c = 0; c < 16; ++c) if (p == c) { yy = y[c]; uu = u[c]; dd = dsk[c]; }
                HG[((size_t)b * SEQ + t0 + i) * 512 + g * 16 + p] = (bf16)f2bf(gelu_tanh(yy + dd * uu)); }
        }
#pragma unroll
        for (int i = 0; i < 4; ++i) { cur0[i] = nx0[i]; cur1[i] = nx1[i]; }
    }
}
__device__ __forceinline__ void gdn_prep_token(Frame& F, int j, int m) {
 const int lane = F.lane;
    const bf16* PROJ = (const bf16*)(F.ws + WS_PROJ); float* QG = (float*)(F.ws + WS_QG); float* KG = (float*)(F.ws + WS_KG); float* VG = (float*)(F.ws + WS_VG);
    float* GB = (float*)(F.ws + WS_GB); float* BETA = (float*)(F.ws + WS_BETA);
    const float* cw = kin(I_GDN_CONV) + (size_t)j * 4 * 1536;
    const int s = m % SEQ;
#pragma unroll
    for (int w = 0; w < 3; ++w) {
        const int ch0 = w * 512 + lane * 8; float acc[8];
#pragma unroll
        for (int i = 0; i < 8; ++i) acc[i] = 0.f;
#pragma unroll
        for (int tap = 0; tap < 4; ++tap) { const int ss = s - 3 + tap; if (ss < 0) continue;
            const v4u x = *(const v4u*)(PROJ + (size_t)(m - 3 + tap) * ODD_INP + O_Q + ch0); const float* wv = cw + tap * 1536 + ch0;
            acc[0] += wv[0] * bflo(x.x); acc[1] += wv[1] * bfhi(x.x); acc[2] += wv[2] * bflo(x.y); acc[3] += wv[3] * bfhi(x.y); acc[4] += wv[4] * bflo(x.z); acc[5] += wv[5] * bfhi(x.z); acc[6] += wv[6] * bflo(x.w); acc[7] += wv[7] * bfhi(x.w); }
        float ss2 = 0.f;
#pragma unroll
        for (int i = 0; i < 8; ++i) { acc[i] = acc[i] * sigm(acc[i]); ss2 += acc[i] * acc[i]; }
        float sc = 1.0f;
        if (w < 2) { ss2 += __shfl_xor(ss2, 1); ss2 += __shfl_xor(ss2, 2); ss2 += __shfl_xor(ss2, 4); ss2 += __shfl_xor(ss2, 8); sc = 1.0f / sqrtf(ss2 + RMS_EPS); if (w == 0) sc *= 0.08838834764831845f; }
        float* dst = (w == 0 ? QG : (w == 1 ? KG : VG)) + (size_t)m * 512 + lane * 8;
        *(f32x4*)dst = (f32x4){acc[0] * sc, acc[1] * sc, acc[2] * sc, acc[3] * sc}; *(f32x4*)(dst + 4) = (f32x4){acc[4] * sc, acc[5] * sc, acc[6] * sc, acc[7] * sc};
    }
    if (lane < 4) { const float gin = bf2f(PROJ[(size_t)m * ODD_INP + O_GIN + lane]), bin = bf2f(PROJ[(size_t)m * ODD_INP + O_BETA + lane]);
        GB[(size_t)m * 4 + lane] = -expf(kin(I_GDN_ALOG)[j * 4 + lane]) * softplusf_(gin + kin(I_GDN_DTB)[j * 4 + lane]); BETA[(size_t)m * 4 + lane] = sigm(bin); }
}
__device__ __forceinline__ void phase_gdn_prep(Frame& F, int j) {
    const int gw = F.bid * NWAVES + F.wave, NGW = F.G * NWAVES;
    for (int m = gw; m < NTOK; m += NGW) gdn_prep_token(F, j, m);
}
__device__ __forceinline__ void phase_odd_a(Frame& F, int j) {
    if (F.wave == 0 && F.bid < 64) { s5_scan_wave(F, j, F.bid >> 5, F.bid & 31); return; }
    const int nbusy = (F.G < 64 ? F.G : 64);
    const int widx = (F.bid < 64) ? F.bid * 7 + (F.wave - 1) : nbusy * 7 + (F.bid - 64) * 8 + F.wave;
    const int nw = nbusy * 7 + (F.G > 64 ? (F.G - 64) * 8 : 0);
    for (int m = widx; m < NTOK; m += nw) gdn_prep_token(F, j, m);
}
__device__ __forceinline__ void phase_gdn_naive(Frame& F) {
    const float* QG = (const float*)(F.ws + WS_QG); const float* KG = (const float*)(F.ws + WS_KG); const float* VG = (const float*)(F.ws + WS_VG);
    const float* GB = (const float*)(F.ws + WS_GB); const float* BETA = (const float*)(F.ws + WS_BETA); float* OG = (float*)(F.ws + WS_OG);
    const int lane = F.lane; const int NGW = F.G * NWAVES;
    for (int u = F.wave * F.G + F.bid; u < 1024; u += NGW) {
        const int b = u >> 9, h = (u >> 7) & 3, c = u & 127; const size_t rb = (size_t)b * SEQ;
        const float* kq = KG + rb * 512 + h * 128 + lane; const float* qq = QG + rb * 512 + h * 128 + lane; const float* vq = VG + rb * 512 + h * 128 + c;
        const float* gq = GB + rb * 4 + h; const float* bq = BETA + rb * 4 + h; float* oq = OG + rb * 512 + h * 128 + c;
        float s0 = 0.f, s1 = 0.f;
        float k0[8], k1[8], q0[8], q1[8], vv[8], gg[8], bb[8], nk0[8], nk1[8], nq0[8], nq1[8], nv[8], ng[8], nb[8];
#pragma unroll
        for (int i = 0; i < 8; ++i) { k0[i] = kq[(size_t)i * 512]; k1[i] = kq[(size_t)i * 512 + 64]; q0[i] = qq[(size_t)i * 512]; q1[i] = qq[(size_t)i * 512 + 64]; vv[i] = vq[(size_t)i * 512]; gg[i] = gq[i * 4]; bb[i] = bq[i * 4]; }
        for (int t0 = 0; t0 < SEQ; t0 += 8) {
            const int tn = (t0 + 8 < SEQ) ? t0 + 8 : t0;
#pragma unroll
            for (int i = 0; i < 8; ++i) { const size_t o = (size_t)(tn + i) * 512; nk0[i] = kq[o]; nk1[i] = kq[o + 64]; nq0[i] = qq[o]; nq1[i] = qq[o + 64]; nv[i] = vq[o]; ng[i] = gq[(tn + i) * 4]; nb[i] = bq[(tn + i) * 4]; }
#pragma unroll
            for (int i = 0; i < 8; ++i) {
                const float ks = wave_sum(k0[i] * s0 + k1[i] * s1); const float eg = expf(gg[i]); const float be = bb[i];
                s0 = eg * (s0 - be * k0[i] * ks) + be * k0[i] * vv[i]; s1 = eg * (s1 - be * k1[i] * ks) + be * k1[i] * vv[i];
                const float o = wave_sum(q0[i] * s0 + q1[i] * s1);
                if (lane == 0) oq[(size_t)(t0 + i) * 512] = o;
            }
#pragma unroll
            for (int i = 0; i < 8; ++i) { k0[i] = nk0[i]; k1[i] = nk1[i]; q0[i] = nq0[i]; q1[i] = nq1[i]; vv[i] = nv[i]; gg[i] = ng[i]; bb[i] = nb[i]; }
        }
    }
}
__device__ __forceinline__ void phase_gdn_out(Frame& F, int j) {
 const float* OG = (const float*)(F.ws + WS_OG); const bf16* PROJ = (const bf16*)(F.ws + WS_PROJ); bf16* MIX = (bf16*)(F.ws + WS_MIX);
    const float* on = kin(I_GDN_ONORM) + j * 128; const int lane = F.lane;
    const int gw = F.bid * NWAVES + F.wave, NGW = F.G * NWAVES;
    for (int m = gw; m < NTOK; m += NGW) {
        const f32x4 a = *(const f32x4*)(OG + (size_t)m * 512 + lane * 8), b = *(const f32x4*)(OG + (size_t)m * 512 + lane * 8 + 4);
        float f[8] = {a.x, a.y, a.z, a.w, b.x, b.y, b.z, b.w}; float s = 0.f;
#pragma unroll
        for (int i = 0; i < 8; ++i) s += f[i] * f[i];
        s += __shfl_xor(s, 1); s += __shfl_xor(s, 2); s += __shfl_xor(s, 4); s += __shfl_xor(s, 8);
        const float r = 1.0f / sqrtf(s * (1.f / 128.f) + RMS_EPS);
        const bf16* z = PROJ + (size_t)m * ODD_INP + O_Z + lane * 8; const float* g = on + (lane & 15) * 8; float o[8];
#pragma unroll
        for (int i = 0; i < 8; ++i) { const float zz = bf2f(z[i]); o[i] = f[i] * r * g[i] * (zz * sigm(zz)); }
        v4u w; w.x = pk2(o[0], o[1]); w.y = pk2(o[2], o[3]); w.z = pk2(o[4], o[5]); w.w = pk2(o[6], o[7]);
        *(v4u*)(MIX + (size_t)m * DM + 512 + lane * 8) = w;
    }
}

__device__ __forceinline__ void phase_router(Frame& F, int layer, bool dry = false) {
 const float* H = kout(); bf16* ABF = (bf16*)(F.ws + WS_ABF);
    const float* gain = kin(I_NORM_FFN) + layer * DM; const float* wgr = kin(I_MOE_WGRP) + (size_t)layer * DM * 4; const float* bgr = kin(I_MOE_BGRP) + layer * 4;
    const float* wex = kin(I_MOE_WEXP) + (size_t)layer * DM * 32; const float* bex = kin(I_MOE_BEXP) + layer * 32;
    int* TOKE = (int*)(F.ws + WS_TOKE); float* TOKW = (float*)(F.ws + WS_TOKW);
    LAS int* lcnt = (LAS int*)(F.lds + LDSCTL_OFF + LC_MOE + 512); LAS int* gbase = (LAS int*)(F.lds + LDSCTL_OFF + LC_MOE + 640);
    const int lane = F.lane; const int per = NTOK / F.G;
    LAS int* lasg = (LAS int*)(F.lds + RING_OFF);
    if (F.tid < 32) lcnt[F.tid] = 0;
    __syncthreads();
    for (int tl = F.wave; tl < per; tl += NWAVES) {
        const int m = F.bid * per + tl;
        const f32x4* xr = (const f32x4*)(H + (size_t)m * DM) + lane; f32x4 v[4]; float s = 0.f;
#pragma unroll
        for (int q = 0; q < 4; ++q) { v[q] = xr[64 * q]; s += (v[q].x * v[q].x + v[q].y * v[q].y) + (v[q].z * v[q].z + v[q].w * v[q].w); }
        const float r = 1.0f / sqrtf(wave_sum(s) * (1.f / 1024.f) + RMS_EPS);
        unsigned long long* o8 = (unsigned long long*)(ABF + (size_t)m * DM) + lane;
#pragma unroll
        for (int q = 0; q < 4; ++q) { const f32x4 g = ((const f32x4*)gain + lane)[64 * q]; v[q].x *= r * g.x; v[q].y *= r * g.y; v[q].z *= r * g.z; v[q].w *= r * g.w;
            o8[64 * q] = (unsigned long long)pk2(v[q].x, v[q].y) | ((unsigned long long)pk2(v[q].z, v[q].w) << 32); }
        float lg[4] = {0.f, 0.f, 0.f, 0.f};
#pragma unroll
        for (int q = 0; q < 4; ++q) { const int k0 = 4 * lane + 256 * q;
#pragma unroll
            for (int e = 0; e < 4; ++e) { const f32x4 w = *(const f32x4*)(wgr + (size_t)(k0 + e) * 4); const float x = v[q][e]; lg[0] += x * w.x; lg[1] += x * w.y; lg[2] += x * w.z; lg[3] += x * w.w; } }
#pragma unroll
        for (int g = 0; g < 4; ++g) lg[g] = wave_sum(lg[g]) + bgr[g];
        int gi = 0; float gm = lg[0];
#pragma unroll
        for (int g = 1; g < 4; ++g) if (lg[g] > gm) { gm = lg[g]; gi = g; }
        float gden = 0.f;
#pragma unroll
        for (int g = 0; g < 4; ++g) gden += expf(lg[g] - gm);
        const float gw_ = 1.0f / gden;
        float le[8] = {0.f, 0.f, 0.f, 0.f, 0.f, 0.f, 0.f, 0.f};
#pragma unroll
        for (int q = 0; q < 4; ++q) { const int k0 = 4 * lane + 256 * q;
#pragma unroll
            for (int e = 0; e < 4; ++e) { const float* wp = wex + (size_t)(k0 + e) * 32 + gi * 8; const f32x4 w0 = *(const f32x4*)wp, w1 = *(const f32x4*)(wp + 4); const float x = v[q][e];
                le[0] += x * w0.x; le[1] += x * w0.y; le[2] += x * w0.z; le[3] += x * w0.w; le[4] += x * w1.x; le[5] += x * w1.y; le[6] += x * w1.z; le[7] += x * w1.w; } }
#pragma unroll
        for (int e = 0; e < 8; ++e) le[e] = wave_sum(le[e]) + bex[gi * 8 + e];
        int i0 = 0; float m0 = le[0];
#pragma unroll
        for (int e = 1; e < 8; ++e) if (le[e] > m0) { m0 = le[e]; i0 = e; }
        int i1 = -1; float m1 = -3.0e38f;
#pragma unroll
        for (int e = 0; e < 8; ++e) if (e != i0 && le[e] > m1) { m1 = le[e]; i1 = e; }
        const float e1 = expf(m1 - m0); const float w0 = gw_ / (1.0f + e1), w1 = gw_ * e1 / (1.0f + e1);
        if (lane == 0 && !dry) { const int ea = gi * 8 + i0, eb = gi * 8 + i1;
            const int pa = __hip_atomic_fetch_add(lcnt + ea, 1, __ATOMIC_RELAXED, __HIP_MEMORY_SCOPE_WORKGROUP), pb = __hip_atomic_fetch_add(lcnt + eb, 1, __ATOMIC_RELAXED, __HIP_MEMORY_SCOPE_WORKGROUP);
            lasg[tl * 2] = ea | (pa << 8); lasg[tl * 2 + 1] = eb | (pb << 8);
            TOKW[(size_t)m * 2] = w0; TOKW[(size_t)m * 2 + 1] = w1; }
    }
    __syncthreads();
    if (dry) return;
    if (F.tid < 32) gbase[F.tid] = (int)__hip_atomic_fetch_add(F.ctl + CW_CNT + 64 * layer + F.tid, (unsigned)lcnt[F.tid], __ATOMIC_RELAXED, __HIP_MEMORY_SCOPE_AGENT);
    __syncthreads();
    for (int i = F.tid; i < per * 2; i += 512) { const int a = lasg[i], e = a & 255, lp = a >> 8; TOKE[(size_t)F.bid * per * 2 + i] = e | ((gbase[e] + lp) << 8); }
    __syncthreads();
}
__device__ __forceinline__ void moe_tables(Frame& F, int layer) {
    LAS int* rowbase = (LAS int*)(F.lds + LDSCTL_OFF + LC_MOE); LAS unsigned char* tile_e = (LAS unsigned char*)(F.lds + LDSCTL_OFF + LC_MOE + 192);
    if (F.tid == 0) { int rb = 0;
#pragma unroll 1
        for (int e = 0; e < 32; ++e) { const int c = (int)__hip_atomic_load(F.ctl + CW_CNT + 64 * layer + e, __ATOMIC_RELAXED, __HIP_MEMORY_SCOPE_AGENT); rowbase[e] = rb; rowbase[224 + e] = c;   const int nt = (c + 255) >> 8;
            for (int i = 0; i < nt; ++i) tile_e[(rb >> 8) + i] = (unsigned char)e; rb += nt << 8; }
        rowbase[32] = rb; rowbase[34] = rb >> 8; }
    __syncthreads();
}
__device__ __forceinline__ void phase_moe_scatter(Frame& F, int layer) {
    moe_tables(F, layer);
    const LAS int* rowbase = (const LAS int*)(F.lds + LDSCTL_OFF + LC_MOE);
    const bf16* ABF = (const bf16*)(F.ws + WS_ABF); bf16* XG = (bf16*)(F.ws + WS_XG); const int* TOKE = (const int*)(F.ws + WS_TOKE); int* ROWS = (int*)(F.ws + WS_ROWS);
    const int gw = F.bid * NWAVES + F.wave, NGW = F.G * NWAVES, lane = F.lane;
    for (int m = gw; m < NTOK; m += NGW) {
        const v4u a = *((const v4u*)(ABF + (size_t)m * DM) + lane), b = *((const v4u*)(ABF + (size_t)m * DM) + 64 + lane);
#pragma unroll
        for (int k = 0; k < 2; ++k) { const int te = TOKE[(size_t)m * 2 + k]; const int row = rowbase[te & 255] + (te >> 8);
            *((v4u*)(XG + (size_t)row * DM) + lane) = a; *((v4u*)(XG + (size_t)row * DM) + 64 + lane) = b;
            if (lane == 0) ROWS[(size_t)m * 2 + k] = row; }
    }
}
struct MoeOrder {
    int ntiles, nN, G, c; const LAS unsigned char* tile_e; size_t bstride;
    __device__ bool next(int i, pg8::Unit& u) const { const long L = (long)i * G + c; if (L >= (long)ntiles * nN) return false; u.pm = (int)(L / nN); u.pn = (int)(L % nN); u.aux = __builtin_amdgcn_readfirstlane((int)tile_e[u.pm]); return true; }
    __device__ __forceinline__ const char* a_base(const pg8::Gemm& g, const pg8::Unit& u) const { return (const char*)g.A + (size_t)u.pm * 256 * g.lda * 2; }
    __device__ __forceinline__ const char* b_base(const pg8::Gemm& g, const pg8::Unit& u) const { return (const char*)g.Bt + (size_t)u.aux * bstride + (size_t)u.pn * 256 * g.ldb * 2; }
};
struct MoeGatherOrder {
    int ntiles, nN, G, c; const LAS unsigned char* tile_e; const LAS int* rowbase; const int* p2t; size_t bstride;
    __device__ bool next(int i, pg8::Unit& u) const { const long L = (long)i * G + c; if (L >= (long)ntiles * nN) return false; u.pm = (int)(L / nN); u.pn = (int)(L % nN); u.aux = __builtin_amdgcn_readfirstlane((int)tile_e[u.pm]); return true; }
    __device__ __forceinline__ unsigned a_row(const pg8::Unit& u, int r) const { const int e = u.aux; const int pos = 256 * u.pm - rowbase[e] + r; const int cnt = rowbase[224 + e];
        return pos < cnt ? (unsigned)(p2t[(size_t)e * NTOK + pos] >> 1) : 0u; }
    __device__ __forceinline__ const char* b_base(const pg8::Gemm& g, const pg8::Unit& u) const { return (const char*)g.Bt + (size_t)u.aux * bstride + (size_t)u.pn * 256 * g.ldb * 2; }
};
__device__ __forceinline__ void phase_moe_combine(Frame& F, int layer, bool dry = false) {
    moe_tables(F, layer); const LAS int* rowbase = (const LAS int*)(F.lds + LDSCTL_OFF + LC_MOE); const int* TOKE = (const int*)(F.ws + WS_TOKE);
    const bf16* H = (const bf16*)(F.ws + WS_H16); bf16* Ho = dry ? (bf16*)(F.ws + WS_DUMMY) : (bf16*)(F.ws + WS_H16); bf16* ABF = (bf16*)(F.ws + WS_ABF); const bf16* Y2 = (const bf16*)(F.ws + WS_Y2);
    const float* TOKW = (const float*)(F.ws + WS_TOKW); const float* gain = kin(I_PLE_NORM) + layer * DM;
    const int gw = F.bid * NWAVES + F.wave, NGW = F.G * NWAVES, lane = F.lane;
    f32x4 gq[4];
#pragma unroll
    for (int j = 0; j < 2; ++j) { gq[2 * j] = *(const f32x4*)(gain + 512 * j + 8 * lane); gq[2 * j + 1] = *(const f32x4*)(gain + 512 * j + 8 * lane + 4); }
    int te0 = 0, te1 = 0; float w0 = 0.f, w1 = 0.f;
    if (gw < NTOK) { te0 = TOKE[(size_t)gw * 2]; te1 = TOKE[(size_t)gw * 2 + 1]; w0 = TOKW[(size_t)gw * 2]; w1 = TOKW[(size_t)gw * 2 + 1]; }
#pragma unroll 1
    for (int m = gw; m < NTOK; m += NGW) {
        const int r0 = rowbase[te0 & 255] + (te0 >> 8), r1 = rowbase[te1 & 255] + (te1 >> 8); const float cw0 = w0, cw1 = w1;
        const int mn = (m + NGW < NTOK) ? m + NGW : m;
        te0 = TOKE[(size_t)mn * 2]; te1 = TOKE[(size_t)mn * 2 + 1]; w0 = TOKW[(size_t)mn * 2]; w1 = TOKW[(size_t)mn * 2 + 1];
        v4u hx[2], ya[2], yb[2];
#pragma unroll
        for (int j = 0; j < 2; ++j) { hx[j] = ((const v4u*)(H + (size_t)m * DM) + lane)[64 * j]; ya[j] = ((const v4u*)(Y2 + (size_t)r0 * DM) + lane)[64 * j]; yb[j] = ((const v4u*)(Y2 + (size_t)r1 * DM) + lane)[64 * j]; }
        float v[16]; float s = 0.f;
#pragma unroll
        for (int j = 0; j < 2; ++j) {
            v[8 * j + 0] = bflo(hx[j].x) + cw0 * bflo(ya[j].x) + cw1 * bflo(yb[j].x); v[8 * j + 1] = bfhi(hx[j].x) + cw0 * bfhi(ya[j].x) + cw1 * bfhi(yb[j].x);
            v[8 * j + 2] = bflo(hx[j].y) + cw0 * bflo(ya[j].y) + cw1 * bflo(yb[j].y); v[8 * j + 3] = bfhi(hx[j].y) + cw0 * bfhi(ya[j].y) + cw1 * bfhi(yb[j].y);
            v[8 * j + 4] = bflo(hx[j].z) + cw0 * bflo(ya[j].z) + cw1 * bflo(yb[j].z); v[8 * j + 5] = bfhi(hx[j].z) + cw0 * bfhi(ya[j].z) + cw1 * bfhi(yb[j].z);
            v[8 * j + 6] = bflo(hx[j].w) + cw0 * bflo(ya[j].w) + cw1 * bflo(yb[j].w); v[8 * j + 7] = bfhi(hx[j].w) + cw0 * bfhi(ya[j].w) + cw1 * bfhi(yb[j].w); }
        v4u hw[2];
#pragma unroll
        for (int j = 0; j < 2; ++j) { hw[j].x = pk2(v[8 * j], v[8 * j + 1]); hw[j].y = pk2(v[8 * j + 2], v[8 * j + 3]); hw[j].z = pk2(v[8 * j + 4], v[8 * j + 5]); hw[j].w = pk2(v[8 * j + 6], v[8 * j + 7]);
            v[8 * j] = bflo(hw[j].x); v[8 * j + 1] = bfhi(hw[j].x); v[8 * j + 2] = bflo(hw[j].y); v[8 * j + 3] = bfhi(hw[j].y); v[8 * j + 4] = bflo(hw[j].z); v[8 * j + 5] = bfhi(hw[j].z); v[8 * j + 6] = bflo(hw[j].w); v[8 * j + 7] = bfhi(hw[j].w); }
#pragma unroll
        for (int i = 0; i < 16; ++i) s += v[i] * v[i];
        const float r = 1.0f / sqrtf(wave_sum(s) * (1.f / 1024.f) + RMS_EPS);
#pragma unroll
        for (int j = 0; j < 2; ++j) { ((v4u*)(Ho + (size_t)m * DM) + lane)[64 * j] = hw[j]; const f32x4 g0 = gq[2 * j], g1 = gq[2 * j + 1];
            v4u o; o.x = pk2(v[8 * j] * r * g0.x, v[8 * j + 1] * r * g0.y); o.y = pk2(v[8 * j + 2] * r * g0.z, v[8 * j + 3] * r * g0.w); o.z = pk2(v[8 * j + 4] * r * g1.x, v[8 * j + 5] * r * g1.y); o.w = pk2(v[8 * j + 6] * r * g1.z, v[8 * j + 7] * r * g1.w);
            ((v4u*)(ABF + (size_t)m * DM) + lane)[64 * j] = o; }
    }
}
namespace att {
using bf16x8 = __attribute__((ext_vector_type(8))) short;
using s16x4 = __attribute__((ext_vector_type(4))) short;
using f32x16 = __attribute__((ext_vector_type(16))) float;
using u32x4 = __attribute__((ext_vector_type(4))) unsigned;
typedef float f32x2_t __attribute__((ext_vector_type(2))); typedef __bf16 bf16x2_t __attribute__((ext_vector_type(2)));
constexpr int KSLOT = 16384, VSLOT = 8192;
constexpr int L_K = 0, L_V = 2 * KSLOT, L_B = L_V + 3 * VSLOT, L_WS = L_B + 1024, L_OST = L_WS + 8 * 256, L_BYTES = L_OST + 8 * 4096;
__device__ __forceinline__ int crow(int r, int hi) { return (r & 3) + 8 * (r >> 2) + 4 * hi; }
__device__ __forceinline__ void glds16(const void* gsrc, unsigned lds_dst) { unsigned keep;
    asm volatile("s_mov_b32 %0, m0\n\ts_mov_b32 m0, %2\n\ts_nop 0\n\tglobal_load_lds_dwordx4 %1, off\n\ts_mov_b32 m0, %0" : "=&s"(keep) : "v"(gsrc), "s"(lds_dst) : "memory"); }
__device__ __forceinline__ unsigned cvtpk(float lo, float hi) { f32x2_t v = {lo, hi}; bf16x2_t b = __builtin_convertvector(v, bf16x2_t); return __builtin_bit_cast(unsigned, b); }
__device__ __forceinline__ float max3f(float a, float b, float c) { float r; asm("v_max3_f32 %0, %1, %2, %3" : "=v"(r) : "v"(a), "v"(b), "v"(c)); return r; }
__device__ __forceinline__ float max2f(float a, float b) { float r; asm("v_max_f32_e32 %0, %1, %2" : "=v"(r) : "v"(a), "v"(b)); return r; }
#define ATT_SUBI(x, d) asm volatile("v_sub_f32_e32 %0, %0, %1" : "+v"(x) : "v"(d))
#define ATT_WAIT_BAR() asm volatile("s_waitcnt vmcnt(0) lgkmcnt(0)\n\ts_barrier" ::: "memory")

}

namespace att {
#define A2_SB() __builtin_amdgcn_sched_barrier(0)
#define A2_PIN(x) asm volatile("" : "+v"(x))
template <int K, int PER> __device__ __forceinline__ void a2_chunk(const f32x16& p0, const f32x16& p1, f32x2_t& s2, u32x4 (&pw)[4]) {
#pragma unroll
    for (int i = K * PER; i < (K + 1) * PER && i < 32; ++i) { const int j = i & 15;
        const float a = (j < 8) ? p0[2 * j] : p1[2 * (j - 8)], b = (j < 8) ? p0[2 * j + 1] : p1[2 * (j - 8) + 1];
        if (i < 16) { if (i == 0) { s2[0] = a; s2[1] = b; } else { s2[0] += a; s2[1] += b; } }
        else pw[j >> 2][j & 3] = cvtpk(a, b); }
}
template <int DK, bool BIAS>
__device__ __forceinline__ void attn_unit2(const int tid_in, const int qb, const bf16* Qh, const int qp, const bf16* Kh, const int kp, const bf16* Vh, const int vp, const float* cumh, bf16* Oh, char* shm, const float skip_margin) {
    constexpr int ND = DK / 16, KCH = DK / 8, NM = 2 * ND, PER = (32 + NM - 1) / NM;
    int tid = tid_in; asm volatile("" : "+v"(tid));
    const int lane = tid & 63, r32 = lane & 31, hi = lane >> 5; const int wid = __builtin_amdgcn_readfirstlane(tid >> 6);
    const int q0 = qb * 256;
    const unsigned lds0 = (unsigned)(uintptr_t)shm;
    float* wsf = (float*)(shm + L_WS) + wid * 64;
    float* Bs = (float*)(shm + L_B);
    const bf16* ksrc = Kh + (size_t)lane * kp + wid * 8;
    const bf16* vsrc = Vh + (size_t)(16 * (wid & 3) + (lane >> 2)) * vp + (wid >> 2) * 32 + (lane & 3) * 8;
    const unsigned kdst = lds0 + L_K + wid * 1024, vdst = lds0 + L_V + wid * 1024;
    const int NT = (q0 + 256) / 64;
    const float cref = BIAS ? cumh[(size_t)q0 * 8] : 0.f;
    int T0 = 0;
    if (BIAS) {
        float cend[4];
#pragma unroll
        for (int k = 0; k < 4; ++k) { const int tq = 64 * k + lane; cend[k] = cumh[(size_t)(64 * (tq < NT ? tq : NT - 1) + 63) * 8]; }
        T0 = NT - 4;
#pragma unroll
        for (int k = 3; k >= 0; --k) { const int tq = 64 * k + lane; const bool ok = (tq < NT) && ((cref - cend[k]) * 1.4426950408889634f + skip_margin >= -150.0f);
            const unsigned long long mk = __ballot(ok); if (mk) T0 = 64 * k + (int)__builtin_ctzll(mk); }
        T0 = __builtin_amdgcn_readfirstlane(T0); if (T0 > NT - 4) T0 = NT - 4; }
#define A2_DMAK(t) do { const int t_ = (t); glds16(ksrc + (size_t)t_ * 64 * kp, (unsigned)__builtin_amdgcn_readfirstlane(kdst + (t_ & 1) * KSLOT)); \
        if (KCH > 8 && wid < KCH - 8) glds16(ksrc + (size_t)t_ * 64 * kp + 64, (unsigned)__builtin_amdgcn_readfirstlane(kdst + (t_ & 1) * KSLOT + 8192)); } while (0)
#define A2_DMAV(t) do { const int t_ = (t); glds16(vsrc + (size_t)t_ * 64 * vp, (unsigned)__builtin_amdgcn_readfirstlane(vdst + (t_ % 3) * VSLOT)); } while (0)
#define A2_ISSUE(k) do { if ((k) + 1 < NT) A2_DMAK((k) + 1); A2_DMAV(k); } while (0)
    A2_DMAK(T0);
    if (BIAS && wid == 0) Bs[(T0 & 1) * 64 + lane] = (cref - cumh[(size_t)(T0 * 64 + lane) * 8]) * 1.4426950408889634f;
    bf16x8 qr[ND];
#pragma unroll
    for (int d0 = 0; d0 < ND; ++d0) qr[d0] = *reinterpret_cast<const bf16x8*>(Qh + (size_t)(q0 + wid * 32 + r32) * qp + d0 * 16 + hi * 8);
    bf16x8 kfa[4], kfb[4];
    float mhat = 0.f, l_reg = 0.f; f32x16 o[2]; o[0] = f32x16{}; o[1] = f32x16{}; f32x16 negm = f32x16{};
    f32x16 cA0 = f32x16{}, cA1 = f32x16{}, cB0 = f32x16{}, cB1 = f32x16{};
    const int qrel = wid * 32 + r32;
    const int vb0 = (int)(lds0 + L_V) + ((lane >> 4) & 1) * 32 + (lane & 3) * 8 + (4 * hi + ((lane & 15) >> 2)) * 64;
    ATT_WAIT_BAR();
#pragma unroll
    for (int d0 = 0; d0 < ND; ++d0) A2_PIN(qr[d0]);
#define A2_KRDB(dst, base, off) asm volatile("ds_read_b128 %0, %1 offset:%c2" : "=&v"(dst) : "v"(base), "i"(off) : "memory")
#define A2_KRD(dst, off) A2_KRDB(dst, ka_, off)
#define A2_POST(k) do { if ((k) + 1 < NT) { A2_ISSUE((k) + 1); const unsigned kn_ = lds0 + L_K + (((k) + 1) & 1) * KSLOT + hi * 1024 + r32 * 16; \
        A2_KRDB(kfa[0], kn_, 0); A2_KRDB(kfa[1], kn_, 512); A2_KRDB(kfa[2], kn_, 2048); A2_KRDB(kfa[3], kn_, 2560); \
        A2_KRDB(kfb[0], kn_, 4096); A2_KRDB(kfb[1], kn_, 4608); A2_KRDB(kfb[2], kn_, 6144); A2_KRDB(kfb[3], kn_, 6656); } } while (0)
#define A2_VRD(s, i) do { asm volatile("ds_read_b64_tr_b16 %0,%1 offset:%c2" : "=&v"(vlo[s]) : "v"(vb_), "i"(((i) >> 2) * 4096 + ((i) & 3) * 1024) : "memory"); \
        asm volatile("ds_read_b64_tr_b16 %0,%1 offset:%c2" : "=&v"(vhi[s]) : "v"(vb_), "i"(((i) >> 2) * 4096 + ((i) & 3) * 1024 + 512) : "memory"); } while (0)
#define A2_VFR(i) (bf16x8){vlo[i][0], vlo[i][1], vlo[i][2], vlo[i][3], vhi[i][0], vhi[i][1], vhi[i][2], vhi[i][3]}
#define A2_BMM(C0, C1, tt_, RM) do { const int tt = (tt_); \
        if (BIAS) { const float* bb = Bs + (tt & 1) * 64 + 4 * hi; \
            _Pragma("unroll") for (int g = 0; g < 4; ++g) { const f32x4 x0 = *(const f32x4*)(bb + 8 * g), x1 = *(const f32x4*)(bb + 32 + 8 * g); \
                _Pragma("unroll") for (int e = 0; e < 4; ++e) { C0[4 * g + e] += x0[e]; C1[4 * g + e] += x1[e]; } } } \
        if (tt >= NT - 4) { const int kb0 = 64 * (tt - (NT - 4)) + 4 * hi; \
            _Pragma("unroll") for (int r = 0; r < 16; ++r) { const int kv = kb0 + (r & 3) + 8 * (r >> 2); if (kv > qrel) C0[r] = -INFINITY; if (kv + 32 > qrel) C1[r] = -INFINITY; } } \
        { float a_ = max3f(C0[0], C0[1], C1[0]), b_ = max3f(C0[2], C0[3], C1[1]); a_ = max3f(a_, C1[2], C1[3]); \
          _Pragma("unroll") for (int r = 4; r < 16; r += 4) { a_ = max3f(a_, C0[r], C0[r + 1]); b_ = max3f(b_, C0[r + 2], C0[r + 3]); a_ = max3f(a_, C1[r], C1[r + 1]); b_ = max3f(b_, C1[r + 2], C1[r + 3]); } \
          RM = max2f(a_, b_); auto rr = __builtin_amdgcn_permlane32_swap(__float_as_uint(RM), __float_as_uint(RM), false, false); RM = max2f(__uint_as_float(rr[0]), __uint_as_float(rr[1])); } } while (0)
    { A2_ISSUE(T0);
      float bnext = 0.f; if (BIAS && wid == 0 && T0 + 1 < NT) bnext = cumh[(size_t)((T0 + 1) * 64 + lane) * 8];
      const unsigned ka_ = lds0 + L_K + (T0 & 1) * KSLOT + hi * 1024 + r32 * 16;
#pragma unroll
      for (int d0 = 0; d0 < ND; ++d0) { bf16x8 k0, k1; A2_KRD(k0, d0 * 2048); A2_KRD(k1, d0 * 2048 + 512); asm volatile("s_waitcnt lgkmcnt(0)" : "+v"(k0), "+v"(k1) :: "memory"); A2_SB();
          if (d0 == 0) { cA0 = __builtin_amdgcn_mfma_f32_32x32x16_bf16(k0, qr[0], negm, 0, 0, 0); cA1 = __builtin_amdgcn_mfma_f32_32x32x16_bf16(k1, qr[0], negm, 0, 0, 0); }
          else { cA0 = __builtin_amdgcn_mfma_f32_32x32x16_bf16(k0, qr[d0], cA0, 0, 0, 0); cA1 = __builtin_amdgcn_mfma_f32_32x32x16_bf16(k1, qr[d0], cA1, 0, 0, 0); } }
      asm volatile("s_nop 15\n\ts_nop 7" : "+v"(cA0), "+v"(cA1));
      float rm; A2_BMM(cA0, cA1, T0, rm);
      mhat = rm;
#pragma unroll
      for (int r = 0; r < 16; ++r) { ATT_SUBI(cA0[r], rm); ATT_SUBI(cA1[r], rm); }
#pragma unroll
      for (int r = 0; r < 16; ++r) negm[r] = -mhat;
#pragma unroll
      for (int r = 0; r < 16; ++r) { cA0[r] = __builtin_amdgcn_exp2f(cA0[r]); cA1[r] = __builtin_amdgcn_exp2f(cA1[r]); }
      if (BIAS && wid == 0 && T0 + 1 < NT) Bs[((T0 + 1) & 1) * 64 + lane] = (cref - bnext) * 1.4426950408889634f;
      ATT_WAIT_BAR(); A2_POST(T0); }
#define A2_STEP(C0, C1, P0, P1, t_) do { const int t = (t_); \
        float bnext = 0.f; if (BIAS && wid == 0 && t + 1 < NT) bnext = cumh[(size_t)((t + 1) * 64 + lane) * 8]; \
        const unsigned ka_ = lds0 + L_K + (t & 1) * KSLOT + hi * 1024 + r32 * 16; const int vb_ = vb0 + ((t - 1) % 3) * VSLOT; \
        s16x4 vlo[4], vhi[4]; u32x4 pw[4]; f32x2_t sacc = {0.f, 0.f}; \
          \
        asm volatile("s_waitcnt lgkmcnt(0)" : "+v"(kfa[0]), "+v"(kfa[1]), "+v"(kfa[2]), "+v"(kfa[3]) :: "memory"); asm volatile("" : "+v"(kfb[0]), "+v"(kfb[1]), "+v"(kfb[2]), "+v"(kfb[3])); A2_SB();     \
        C0 = __builtin_amdgcn_mfma_f32_32x32x16_bf16(kfa[0], qr[0], negm, 0, 0, 0); A2_VRD(0, 0); a2_chunk<0, PER>(P0, P1, sacc, pw); A2_PIN(sacc); A2_SB(); \
        C1 = __builtin_amdgcn_mfma_f32_32x32x16_bf16(kfa[1], qr[0], negm, 0, 0, 0); A2_VRD(1, 4); a2_chunk<1, PER>(P0, P1, sacc, pw); A2_PIN(sacc); A2_SB(); \
        C0 = __builtin_amdgcn_mfma_f32_32x32x16_bf16(kfa[2], qr[1], C0, 0, 0, 0);   A2_VRD(2, 1); a2_chunk<2, PER>(P0, P1, sacc, pw); A2_PIN(sacc); A2_SB(); \
        C1 = __builtin_amdgcn_mfma_f32_32x32x16_bf16(kfa[3], qr[1], C1, 0, 0, 0);                 a2_chunk<3, PER>(P0, P1, sacc, pw); A2_PIN(sacc); A2_SB(); \
        if (ND > 4) { A2_KRD(kfa[0], 8192); A2_KRD(kfa[1], 8704); A2_KRD(kfa[2], 10240); A2_KRD(kfa[3], 10752); } \
        asm volatile("s_waitcnt lgkmcnt(%c0)" :: "i"(ND > 4 ? 10 : 6) : "memory"); A2_SB();     \
        C0 = __builtin_amdgcn_mfma_f32_32x32x16_bf16(kfb[0], qr[2], C0, 0, 0, 0);   A2_VRD(3, 5); a2_chunk<4, PER>(P0, P1, sacc, pw); A2_PIN(sacc); A2_SB(); \
        C1 = __builtin_amdgcn_mfma_f32_32x32x16_bf16(kfb[1], qr[2], C1, 0, 0, 0);                 a2_chunk<5, PER>(P0, P1, sacc, pw); A2_PIN(sacc); A2_SB(); \
        C0 = __builtin_amdgcn_mfma_f32_32x32x16_bf16(kfb[2], qr[3], C0, 0, 0, 0);                 a2_chunk<6, PER>(P0, P1, sacc, pw); A2_PIN(sacc); A2_SB(); \
        C1 = __builtin_amdgcn_mfma_f32_32x32x16_bf16(kfb[3], qr[3], C1, 0, 0, 0);                 a2_chunk<7, PER>(P0, P1, sacc, pw); A2_PIN(sacc); A2_SB(); \
        if (ND > 4) { asm volatile("s_waitcnt lgkmcnt(2)" ::: "memory"); A2_SB();               \
            C0 = __builtin_amdgcn_mfma_f32_32x32x16_bf16(kfa[0], qr[ND > 4 ? 4 : 0], C0, 0, 0, 0); a2_chunk<8, PER>(P0, P1, sacc, pw); A2_PIN(sacc); A2_SB(); \
            C1 = __builtin_amdgcn_mfma_f32_32x32x16_bf16(kfa[1], qr[ND > 4 ? 4 : 0], C1, 0, 0, 0); a2_chunk<9, PER>(P0, P1, sacc, pw); A2_PIN(sacc); A2_SB(); \
            C0 = __builtin_amdgcn_mfma_f32_32x32x16_bf16(kfa[2], qr[ND > 4 ? 5 : 0], C0, 0, 0, 0); a2_chunk<10, PER>(P0, P1, sacc, pw); A2_PIN(sacc); A2_SB(); \
            C1 = __builtin_amdgcn_mfma_f32_32x32x16_bf16(kfa[3], qr[ND > 4 ? 5 : 0], C1, 0, 0, 0); a2_chunk<11, PER>(P0, P1, sacc, pw); A2_PIN(sacc); A2_SB(); } \
        l_reg += sacc[0] + sacc[1]; \
          \
        asm volatile("s_nop 15\n\ts_nop 7" : "+v"(C0), "+v"(C1));     \
        float rm; A2_BMM(C0, C1, t, rm); bool resc = false; \
        if (__any(rm > 8.0f)) { const float dl = fmaxf(rm, 0.f); mhat += dl; \
            _Pragma("unroll") for (int r = 0; r < 16; ++r) { ATT_SUBI(C0[r], dl); ATT_SUBI(C1[r], dl); } \
            _Pragma("unroll") for (int r = 0; r < 16; ++r) negm[r] = -mhat; \
            const float f = __builtin_amdgcn_exp2f(-dl); l_reg *= f; if (hi == 0) wsf[r32] = f; resc = true; } \
        if (BIAS && wid == 0 && t + 1 < NT) Bs[((t + 1) & 1) * 64 + lane] = (cref - bnext) * 1.4426950408889634f; \
        ATT_WAIT_BAR(); A2_SB(); A2_POST(t); A2_SB();     \
          \
          \
        o[0] = __builtin_amdgcn_mfma_f32_32x32x16_bf16(__builtin_bit_cast(bf16x8, pw[0]), A2_VFR(0), o[0], 0, 0, 0); A2_VRD(0, 2); C0[0] = __builtin_amdgcn_exp2f(C0[0]); C0[1] = __builtin_amdgcn_exp2f(C0[1]); C0[2] = __builtin_amdgcn_exp2f(C0[2]); C0[3] = __builtin_amdgcn_exp2f(C0[3]); A2_PIN(C0); A2_SB(); \
        o[1] = __builtin_amdgcn_mfma_f32_32x32x16_bf16(__builtin_bit_cast(bf16x8, pw[0]), A2_VFR(1), o[1], 0, 0, 0); A2_VRD(1, 6); C0[4] = __builtin_amdgcn_exp2f(C0[4]); C0[5] = __builtin_amdgcn_exp2f(C0[5]); C0[6] = __builtin_amdgcn_exp2f(C0[6]); C0[7] = __builtin_amdgcn_exp2f(C0[7]); A2_PIN(C0); A2_SB(); \
        o[0] = __builtin_amdgcn_mfma_f32_32x32x16_bf16(__builtin_bit_cast(bf16x8, pw[1]), A2_VFR(2), o[0], 0, 0, 0); A2_VRD(2, 3); C0[8] = __builtin_amdgcn_exp2f(C0[8]); C0[9] = __builtin_amdgcn_exp2f(C0[9]); C0[10] = __builtin_amdgcn_exp2f(C0[10]); C0[11] = __builtin_amdgcn_exp2f(C0[11]); A2_PIN(C0); A2_SB(); \
        o[1] = __builtin_amdgcn_mfma_f32_32x32x16_bf16(__builtin_bit_cast(bf16x8, pw[1]), A2_VFR(3), o[1], 0, 0, 0); asm volatile("s_waitcnt lgkmcnt(12)" ::: "memory"); A2_VRD(3, 7); C0[12] = __builtin_amdgcn_exp2f(C0[12]); C0[13] = __builtin_amdgcn_exp2f(C0[13]); C0[14] = __builtin_amdgcn_exp2f(C0[14]); C0[15] = __builtin_amdgcn_exp2f(C0[15]); A2_PIN(C0); A2_SB(); \
        asm volatile("s_waitcnt lgkmcnt(6)" ::: "memory"); A2_SB(); o[0] = __builtin_amdgcn_mfma_f32_32x32x16_bf16(__builtin_bit_cast(bf16x8, pw[2]), A2_VFR(0), o[0], 0, 0, 0); C1[0] = __builtin_amdgcn_exp2f(C1[0]); C1[1] = __builtin_amdgcn_exp2f(C1[1]); C1[2] = __builtin_amdgcn_exp2f(C1[2]); C1[3] = __builtin_amdgcn_exp2f(C1[3]); A2_PIN(C1); A2_SB(); \
        asm volatile("s_waitcnt lgkmcnt(4)" ::: "memory"); A2_SB(); o[1] = __builtin_amdgcn_mfma_f32_32x32x16_bf16(__builtin_bit_cast(bf16x8, pw[2]), A2_VFR(1), o[1], 0, 0, 0); C1[4] = __builtin_amdgcn_exp2f(C1[4]); C1[5] = __builtin_amdgcn_exp2f(C1[5]); C1[6] = __builtin_amdgcn_exp2f(C1[6]); C1[7] = __builtin_amdgcn_exp2f(C1[7]); A2_PIN(C1); A2_SB(); \
        asm volatile("s_waitcnt lgkmcnt(2)" ::: "memory"); A2_SB(); o[0] = __builtin_amdgcn_mfma_f32_32x32x16_bf16(__builtin_bit_cast(bf16x8, pw[3]), A2_VFR(2), o[0], 0, 0, 0); C1[8] = __builtin_amdgcn_exp2f(C1[8]); C1[9] = __builtin_amdgcn_exp2f(C1[9]); C1[10] = __builtin_amdgcn_exp2f(C1[10]); C1[11] = __builtin_amdgcn_exp2f(C1[11]); A2_PIN(C1); A2_SB(); \
        asm volatile("s_waitcnt lgkmcnt(0)" ::: "memory"); A2_SB(); o[1] = __builtin_amdgcn_mfma_f32_32x32x16_bf16(__builtin_bit_cast(bf16x8, pw[3]), A2_VFR(3), o[1], 0, 0, 0); C1[12] = __builtin_amdgcn_exp2f(C1[12]); C1[13] = __builtin_amdgcn_exp2f(C1[13]); C1[14] = __builtin_amdgcn_exp2f(C1[14]); C1[15] = __builtin_amdgcn_exp2f(C1[15]); A2_PIN(C1); A2_SB(); \
        if (resc) { asm volatile("s_waitcnt lgkmcnt(0)" ::: "memory"); \
            _Pragma("unroll") for (int d_ = 0; d_ < 2; ++d_) _Pragma("unroll") for (int r = 0; r < 16; ++r) o[d_][r] *= wsf[crow(r, hi)]; } \
        } while (0)
#define A2_DRAIN(P0, P1) do { const int vb_ = vb0 + ((NT - 1) % 3) * VSLOT; s16x4 vlo[4], vhi[4]; u32x4 pw[4]; f32x2_t sacc = {0.f, 0.f}; \
        A2_VRD(0, 0); A2_VRD(1, 4); A2_VRD(2, 1); A2_VRD(3, 5); \
        a2_chunk<0, 32>(P0, P1, sacc, pw); l_reg += sacc[0] + sacc[1]; \
        asm volatile("s_waitcnt lgkmcnt(0)" ::: "memory"); A2_SB(); \
        o[0] = __builtin_amdgcn_mfma_f32_32x32x16_bf16(__builtin_bit_cast(bf16x8, pw[0]), A2_VFR(0), o[0], 0, 0, 0); o[1] = __builtin_amdgcn_mfma_f32_32x32x16_bf16(__builtin_bit_cast(bf16x8, pw[0]), A2_VFR(1), o[1], 0, 0, 0); \
        o[0] = __builtin_amdgcn_mfma_f32_32x32x16_bf16(__builtin_bit_cast(bf16x8, pw[1]), A2_VFR(2), o[0], 0, 0, 0); o[1] = __builtin_amdgcn_mfma_f32_32x32x16_bf16(__builtin_bit_cast(bf16x8, pw[1]), A2_VFR(3), o[1], 0, 0, 0); A2_SB(); \
        A2_VRD(0, 2); A2_VRD(1, 6); A2_VRD(2, 3); A2_VRD(3, 7); asm volatile("s_waitcnt lgkmcnt(0)" ::: "memory"); A2_SB(); \
        o[0] = __builtin_amdgcn_mfma_f32_32x32x16_bf16(__builtin_bit_cast(bf16x8, pw[2]), A2_VFR(0), o[0], 0, 0, 0); o[1] = __builtin_amdgcn_mfma_f32_32x32x16_bf16(__builtin_bit_cast(bf16x8, pw[2]), A2_VFR(1), o[1], 0, 0, 0); \
        o[0] = __builtin_amdgcn_mfma_f32_32x32x16_bf16(__builtin_bit_cast(bf16x8, pw[3]), A2_VFR(2), o[0], 0, 0, 0); o[1] = __builtin_amdgcn_mfma_f32_32x32x16_bf16(__builtin_bit_cast(bf16x8, pw[3]), A2_VFR(3), o[1], 0, 0, 0); } while (0)
    { int tl = T0 + 1;
#pragma unroll 1
      for (; tl + 1 < NT; tl += 2) { A2_STEP(cB0, cB1, cA0, cA1, tl); A2_STEP(cA0, cA1, cB0, cB1, tl + 1); }
      if (tl < NT) { A2_STEP(cB0, cB1, cA0, cA1, tl); A2_DRAIN(cB0, cB1); } else { A2_DRAIN(cA0, cA1); } }
#undef A2_STEP
#undef A2_DRAIN
#undef A2_BMM
#undef A2_KRD
#undef A2_VRD
#undef A2_VFR
#undef A2_DMAK
#undef A2_DMAV
#undef A2_ISSUE
#undef A2_POST
#undef A2_KRDB
    { auto rr = __builtin_amdgcn_permlane32_swap(__float_as_uint(l_reg), __float_as_uint(l_reg), false, false); l_reg = __uint_as_float(rr[0]) + __uint_as_float(rr[1]); }
    if (hi == 0) wsf[32 + r32] = l_reg; asm volatile("s_waitcnt lgkmcnt(0)" ::: "memory");
    float rli[16];
#pragma unroll
    for (int r = 0; r < 16; ++r) rli[r] = __builtin_amdgcn_rcpf(wsf[32 + crow(r, hi)]);
    bf16* Ow = Oh + (size_t)(q0 + wid * 32) * DM;
    { bf16* stg = (bf16*)(shm + L_OST) + wid * 2048;
#pragma unroll
      for (int r = 0; r < 16; ++r) { const int orow = crow(r, hi);
#pragma unroll
        for (int d0 = 0; d0 < 2; ++d0) stg[orow * 64 + d0 * 32 + r32] = (bf16)f2bf(o[d0][r] * rli[r]); }
      asm volatile("s_waitcnt lgkmcnt(0)" ::: "memory");
#pragma unroll
      for (int i = 0; i < 4; ++i) { const int row = i * 8 + (lane >> 3), ch = lane & 7; const u32x4 v = *(const u32x4*)(stg + row * 64 + ch * 8); *(u32x4*)(Ow + (size_t)row * DM + ch * 8) = v; } }
    asm volatile("s_waitcnt lgkmcnt(0)\n\ts_barrier" ::: "memory");
}
#undef A2_SB
#undef A2_PIN
}
#ifndef ATTN_V2
#define ATT_UNIT att::attn_unit
#define ATT_UNIT_FOX att::attn_unit
#elif ATTN_V2 == 2
#define ATT_UNIT att::attn_unit2
#define ATT_UNIT_FOX att::attn_unit
#elif ATTN_V2 == 3
#define ATT_UNIT att::attn_unit
#define ATT_UNIT_FOX att::attn_unit2
#else
#define ATT_UNIT att::attn_unit2
#define ATT_UNIT_FOX att::attn_unit2
#endif
constexpr int CW_AQ = 2048;
__device__ __forceinline__ void phase_attn_mfma(Frame& F, int j) {
    const bf16* PROJ = (const bf16*)(F.ws + WS_PROJ); const bf16* QM = (const bf16*)(F.ws + WS_QM); const bf16* KVB = (const bf16*)(F.ws + WS_KVB); const bf16* KM = (const bf16*)(F.ws + WS_KM);
    const float* CUM = (const float*)(F.ws + WS_CUM); bf16* MIX = (bf16*)(F.ws + WS_MIX);
    char* shm = (char*)(F.lds + RING_OFF);
    LAS int* qslot = (LAS int*)(F.lds + LDSCTL_OFF + 64);
    { const int xcd0 = (int)(xb_xcc_id() & 7u);
#pragma unroll 1
      for (int dq = 0; dq < 8; ++dq) { const int xcd = (xcd0 + dq) & 7;
#pragma unroll 1
        for (;;) {
          if (F.tid == 0) *qslot = (int)__hip_atomic_fetch_add(F.ctl + CW_AQ + 1024 + (j * 8 + xcd) * 64, 1u, __ATOMIC_RELAXED, __HIP_MEMORY_SCOPE_AGENT);
          __syncthreads(); const int u = __builtin_amdgcn_readfirstlane(*qslot); __syncthreads();
          if (u >= 128) break;
          const int qb = 63 - (u >> 1), combo = 2 * xcd + (u & 1), b = combo >> 3, h = combo & 7; const size_t rb = (size_t)b * SEQ;
          ATT_UNIT<96, false>(F.tid, qb, QM + rb * 768 + h * 96, 768, KM + rb * 768 + h * 96, 768, KVB + rb * 1024 + h * 128 + 64, 1024, nullptr, MIX + rb * DM + 512 + h * 64, shm, 0.f);
        } } }
    float gq = fabsf(kin(I_FOX_QN)[j * 64 + F.lane]), gk = fabsf(kin(I_FOX_KN)[j * 64 + F.lane]);
#pragma unroll
    for (int o = 1; o < 64; o <<= 1) { gq = fmaxf(gq, __shfl_xor(gq, o)); gk = fmaxf(gk, __shfl_xor(gk, o)); }
    const float margin = 2.0f * 1.02f * 64.0f * gq * gk * C2_FOX;
#pragma unroll 1
    for (;;) {
        if (F.tid == 0) *qslot = (int)__hip_atomic_fetch_add(F.ctl + CW_AQ + 64 * j, 1u, __ATOMIC_RELAXED, __HIP_MEMORY_SCOPE_AGENT);
        __syncthreads(); const int u = __builtin_amdgcn_readfirstlane(*qslot); __syncthreads();
        if (u >= 1024) break;
        const int qb = 63 - (u >> 4), combo = u & 15, b = combo >> 3, h = combo & 7; const size_t rb = (size_t)b * SEQ;
        ATT_UNIT_FOX<64, true>(F.tid, qb, PROJ + rb * EVEN_INP + E_FQ + h * 64, EVEN_INP, PROJ + rb * EVEN_INP + E_FK + h * 64, EVEN_INP, PROJ + rb * EVEN_INP + E_FV + h * 64, EVEN_INP, CUM + rb * 8 + h, MIX + rb * DM + h * 64, shm, margin);
    }
}
constexpr size_t WS_S5_MT = WS_Y2;
constexpr size_t WS_S5_PT = WS_S5_MT + 72 * MiB;
constexpr size_t WS_S5_AX = WS_S5_PT + 16 * MiB;
constexpr size_t WS_S5_XLOC = WS_S5_AX + 36 * MiB;
static_assert(WS_S5_XLOC + 8 * MiB <= WS_Y2 + 144 * MiB, "s5 overlay");

__device__ __forceinline__ void s5_build(Frame& F, int j) {
    if (F.bid >= 256) return;
    const int g = F.bid >> 3, part = F.bid & 7, tid = F.tid, lane = F.lane, wave = F.wave;
    LAS float* pwr = (LAS float*)(F.lds + RING_OFF);
    LAS float* pwi = pwr + 65 * 64;
    LAS float* bbr = pwi + 65 * 64;
    LAS float* bbi = bbr + 1024;
    LAS float* crs = bbi + 1024;
    LAS float* cis = crs + 1024;
    LAS bf16* ktab = (LAS bf16*)(cis + 1024);
    const float dt = expf(kin(I_S5_LS)[j * 32 + g]);
    const float* are = kin(I_S5_ARE) + (size_t)(j * 32 + g) * 64; const float* aim = kin(I_S5_AIM) + (size_t)(j * 32 + g) * 64;
    for (int e = tid; e < 65 * 64; e += 512) { const int d = e >> 6, p = e & 63; const float lr = fminf(are[p], -1e-4f), li = aim[p];
        const float mag = expf(lr * dt * (float)d); float sn, cs; sincosf(li * dt * (float)d, &sn, &cs); pwr[e] = mag * cs; pwi[e] = mag * sn; }
    for (int e = tid; e < 1024; e += 512) { const int p = e >> 4, c = e & 15; const float lr = fminf(are[p], -1e-4f), li = aim[p];
        const float mag = expf(lr * dt); float sn, cs; sincosf(li * dt, &sn, &cs); const float abr = mag * cs, abi = mag * sn;
        const float den = lr * lr + li * li, nr = abr - 1.0f, ni = abi; const float gr = (nr * lr + ni * li) / den, gi = (ni * lr - nr * li) / den;
        const float br = kin(I_S5_BRE)[((size_t)(j * 32 + g) * 64 + p) * 16 + c], bi = kin(I_S5_BIM)[((size_t)(j * 32 + g) * 64 + p) * 16 + c];
        bbr[e] = gr * br - gi * bi; bbi[e] = gr * bi + gi * br; }
    for (int e = tid; e < 1024; e += 512) { crs[e] = kin(I_S5_CRE)[(size_t)(j * 32 + g) * 1024 + e]; cis[e] = kin(I_S5_CIM)[(size_t)(j * 32 + g) * 1024 + e]; }
    __syncthreads();
    { const int cc = tid >> 1, c = cc >> 4, c2 = cc & 15, ph = tid & 1;
      float er[32], ei[32];
#pragma unroll
      for (int pp = 0; pp < 32; ++pp) { const int p = 32 * ph + pp; const float xr = crs[c * 64 + p], xi = cis[c * 64 + p], yr = bbr[p * 16 + c2], yi = bbi[p * 16 + c2]; er[pp] = xr * yr - xi * yi; ei[pp] = xr * yi + xi * yr; }
#pragma unroll 1
      for (int d = 0; d < 64; ++d) { float s = 0.f; const LAS float* wr_ = pwr + d * 64 + 32 * ph; const LAS float* wi_ = pwi + d * 64 + 32 * ph;
#pragma unroll
          for (int pp = 0; pp < 32; ++pp) s += wr_[pp] * er[pp] - wi_[pp] * ei[pp];
          s += __shfl_xor(s, 1);
          if (ph == 0) ktab[(d * 16 + c) * 16 + c2] = (bf16)f2bf(s); } }
    __syncthreads();
    bf16* MT = (bf16*)(F.ws + WS_S5_MT) + (size_t)g * 1024 * 1152;
#pragma unroll 1
    for (int rr = wave; rr < 128; rr += 8) { const int i = part * 8 + (rr >> 4), c = rr & 15; bf16* row = MT + (size_t)(i * 16 + c) * 1152;
        v4u a = {0u, 0u, 0u, 0u}, b = {0u, 0u, 0u, 0u};
        if (lane <= i) { const LAS v4u* src = (const LAS v4u*)(ktab + ((i - lane) * 16 + c) * 16); a = src[0]; b = src[1]; }
        *(v4u*)(row + lane * 16) = a; *(v4u*)(row + lane * 16 + 8) = b;
        { const int p = lane; const float xr = crs[c * 64 + p], xi = cis[c * 64 + p], wr_ = pwr[(i + 1) * 64 + p], wi_ = pwi[(i + 1) * 64 + p];
          row[1024 + p] = (bf16)f2bf(xr * wr_ - xi * wi_); row[1088 + p] = (bf16)f2bf(-(xr * wi_ + xi * wr_)); } }
    bf16* PT = (bf16*)(F.ws + WS_S5_PT) + (size_t)g * 256 * 1024;
#pragma unroll 1
    for (int rr = wave; rr < 32; rr += 8) { const int n = part * 32 + rr; bf16* row = PT + (size_t)n * 1024 + lane * 16;
        unsigned o[8];
        if (n < 128) { const int p = n & 63, im = n >> 6; const float wr_ = pwr[(63 - lane) * 64 + p], wi_ = pwi[(63 - lane) * 64 + p];
#pragma unroll
            for (int q = 0; q < 8; ++q) { const float y0r = bbr[p * 16 + 2 * q], y0i = bbi[p * 16 + 2 * q], y1r = bbr[p * 16 + 2 * q + 1], y1i = bbi[p * 16 + 2 * q + 1];
                const float v0 = im ? (wr_ * y0i + wi_ * y0r) : (wr_ * y0r - wi_ * y0i), v1 = im ? (wr_ * y1i + wi_ * y1r) : (wr_ * y1r - wi_ * y1i); o[q] = pk2(v0, v1); }
        } else {
#pragma unroll
            for (int q = 0; q < 8; ++q) o[q] = 0u; }
        *(v4u*)row = (v4u){o[0], o[1], o[2], o[3]}; *(v4u*)(row + 8) = (v4u){o[4], o[5], o[6], o[7]}; }
    __syncthreads();
}
__device__ __forceinline__ void s5_repack(Frame& F) {
    const bf16* PROJ = (const bf16*)(F.ws + WS_PROJ); bf16* AX = (bf16*)(F.ws + WS_S5_AX);
    const int gt = F.bid * 512 + F.tid, NT = F.G * 512;
    for (int e = gt; e < NTOK * 32; e += NT) { const int m = e >> 5, g = e & 31; const int b = m / SEQ, t = m % SEQ, n = t >> 6, s = t & 63;
        const v4u* src = (const v4u*)(PROJ + (size_t)m * ODD_INP + O_U + g * 16); v4u* dst = (v4u*)(AX + ((size_t)g * 512 + b * 256 + n) * 1152 + s * 16);
        const v4u x0 = src[0], x1 = src[1]; dst[0] = x0; dst[1] = x1; }
}
struct S5POrder {
    int G, c;
    __device__ bool next(int i, pg8::Unit& u) const { const int L = i * G + c; if (L >= 64) return false; u.aux = L >> 1; u.pm = L & 1; u.pn = 0; return true; }
    __device__ __forceinline__ const char* a_base(const pg8::Gemm& g, const pg8::Unit& u) const { return (const char*)g.A + ((size_t)u.aux * 512 + u.pm * 256) * 1152 * 2; }
    __device__ __forceinline__ const char* b_base(const pg8::Gemm& g, const pg8::Unit& u) const { return (const char*)g.Bt + (size_t)u.aux * 256 * 1024 * 2; }
};
struct S5PEpi {
    static constexpr bool PERM = false;
    float* X;
    __device__ __forceinline__ void operator()(const pg8::f32x4 (&acc)[2][2][4][2], const pg8::Unit& u, int wr, int wc, int fr, int fq) const {
        const int row0 = u.pm * 256 + wr * 64 + fr; const int col0 = wc * 32 + 4 * fq;
#pragma unroll
        for (int ai = 0; ai < 2; ++ai)
#pragma unroll
            for (int m = 0; m < 4; ++m) { float* rowp = X + ((size_t)u.aux * 512 + row0 + ai * 128 + m * 16) * 128 + col0;
#pragma unroll
                for (int n = 0; n < 2; ++n) *(pg8::f32x4*)(rowp + n * 16) = acc[ai][0][m][n]; }
    }
};
__device__ __forceinline__ void s5_scan(Frame& F, int j, int gsel = -1) {
    int gw = F.bid * NWAVES + F.wave; if (gsel >= 0) { if (F.wave >= 2) return; gw = gsel * 2 + F.wave; } if (gw >= 64) return;
    const int g = gw >> 1, b = gw & 1, p = F.lane;
    const float lr = fminf(kin(I_S5_ARE)[(size_t)(j * 32 + g) * 64 + p], -1e-4f), li = kin(I_S5_AIM)[(size_t)(j * 32 + g) * 64 + p]; const float dt = expf(kin(I_S5_LS)[j * 32 + g]);
    const float mag = expf(lr * dt * 64.f); float sn, cs; sincosf(li * dt * 64.f, &sn, &cs); const float ar = mag * cs, ai = mag * sn;
    const float* X = (const float*)(F.ws + WS_S5_XLOC) + ((size_t)g * 512 + b * 256) * 128; bf16* AX = (bf16*)(F.ws + WS_S5_AX) + ((size_t)g * 512 + b * 256) * 1152 + 1024;
    float xr = 0.f, xi = 0.f; float cr[8], ci[8], nr[8], ni[8];
#pragma unroll
    for (int q = 0; q < 8; ++q) { cr[q] = X[(size_t)q * 128 + p]; ci[q] = X[(size_t)q * 128 + 64 + p]; }
    for (int n0 = 0; n0 < 256; n0 += 8) { const int nn = (n0 + 8 < 256) ? n0 + 8 : n0;
#pragma unroll
        for (int q = 0; q < 8; ++q) { nr[q] = X[(size_t)(nn + q) * 128 + p]; ni[q] = X[(size_t)(nn + q) * 128 + 64 + p]; }
#pragma unroll
        for (int q = 0; q < 8; ++q) { AX[(size_t)(n0 + q) * 1152 + p] = (bf16)f2bf(xr); AX[(size_t)(n0 + q) * 1152 + 64 + p] = (bf16)f2bf(xi);
            const float tr = ar * xr - ai * xi + cr[q], ti = ar * xi + ai * xr + ci[q]; xr = tr; xi = ti; }
#pragma unroll
        for (int q = 0; q < 8; ++q) { cr[q] = nr[q]; ci[q] = ni[q]; } }
}
struct S5MOrder {
    int G, c;
    __device__ bool next(int i, pg8::Unit& u) const { const int L = i * G + c; if (L >= 256) return false; u.aux = L >> 3; u.pm = (L >> 2) & 1; u.pn = L & 3; return true; }
    __device__ __forceinline__ const char* a_base(const pg8::Gemm& g, const pg8::Unit& u) const { return (const char*)g.A + ((size_t)u.aux * 512 + u.pm * 256) * 1152 * 2; }
    __device__ __forceinline__ const char* b_base(const pg8::Gemm& g, const pg8::Unit& u) const { return (const char*)g.Bt + ((size_t)u.aux * 1024 + u.pn * 256) * 1152 * 2; }
};
struct S5MEpi {
    static constexpr bool PERM = true;
    bf16* HG; const bf16* PROJ; const float* dsk;
    __device__ __forceinline__ void operator()(const pg8::f32x4 (&acc)[2][2][4][2], const pg8::Unit& u, int wr, int wc, int fr, int fq) const {
        const int g = u.aux; const int row0 = u.pm * 256 + wr * 64 + fr; const int col0 = u.pn * 256 + wc * 32 + 8 * fq;
        const pg8::f32x4 d0 = *(const pg8::f32x4*)(dsk + g * 16 + (col0 & 15)), d1 = *(const pg8::f32x4*)(dsk + g * 16 + (col0 & 15) + 4);
#pragma unroll
        for (int ai = 0; ai < 2; ++ai)
#pragma unroll
            for (int m = 0; m < 4; ++m) { const int rg = row0 + ai * 128 + m * 16; const int b = rg >> 8, n = rg & 255;
#pragma unroll
                for (int bj = 0; bj < 2; ++bj) { const int col = col0 + bj * 128; const int i = col >> 4, c0 = col & 15; const size_t tok = (size_t)b * SEQ + n * 64 + i;
                    const pg8::u32x4 uw = *(const pg8::u32x4*)(PROJ + tok * ODD_INP + O_U + g * 16 + c0); const pg8::f32x4 v0 = acc[ai][bj][m][0], v1 = acc[ai][bj][m][1];
                    pg8::u32x4 w; w.x = pk2(gelu_tanh(v0[0] + d0[0] * bflo(uw.x)), gelu_tanh(v0[1] + d0[1] * bfhi(uw.x))); w.y = pk2(gelu_tanh(v0[2] + d0[2] * bflo(uw.y)), gelu_tanh(v0[3] + d0[3] * bfhi(uw.y)));
                    w.z = pk2(gelu_tanh(v1[0] + d1[0] * bflo(uw.z)), gelu_tanh(v1[1] + d1[1] * bfhi(uw.z))); w.w = pk2(gelu_tanh(v1[2] + d1[2] * bflo(uw.w)), gelu_tanh(v1[3] + d1[3] * bfhi(uw.w)));
                    *(pg8::u32x4*)(HG + tok * 512 + g * 16 + c0) = w; } }
    }
};

struct S5GroupP { int g;
    __device__ bool next(int i, pg8::Unit& u) const { if (i >= 2) return false; u.aux = g; u.pm = i; u.pn = 0; return true; }
    __device__ __forceinline__ const char* a_base(const pg8::Gemm& gm, const pg8::Unit& u) const { return (const char*)gm.A + ((size_t)u.aux * 512 + u.pm * 256) * 1152 * 2; }
    __device__ __forceinline__ const char* b_base(const pg8::Gemm& gm, const pg8::Unit& u) const { return (const char*)gm.Bt + (size_t)u.aux * 256 * 1024 * 2; } };
struct S5GroupM { int g;
    __device__ bool next(int i, pg8::Unit& u) const { if (i >= 8) return false; u.aux = g; u.pm = i >> 2; u.pn = i & 3; return true; }
    __device__ __forceinline__ const char* a_base(const pg8::Gemm& gm, const pg8::Unit& u) const { return (const char*)gm.A + ((size_t)u.aux * 512 + u.pm * 256) * 1152 * 2; }
    __device__ __forceinline__ const char* b_base(const pg8::Gemm& gm, const pg8::Unit& u) const { return (const char*)gm.Bt + ((size_t)u.aux * 1024 + u.pn * 256) * 1152 * 2; } };
namespace gdn {
typedef short s16x4 __attribute__((ext_vector_type(4)));
#define GDN_MFMA(a, b, c) __builtin_amdgcn_mfma_f32_16x16x16bf16_1k(a, b, c, 0, 0, 0)
__device__ __forceinline__ float fsig(float x) { return __builtin_amdgcn_rcpf(1.0f + __expf(-x)); }
__device__ __forceinline__ float bperm(float v, int src_lane) { return __int_as_float(__builtin_amdgcn_ds_bpermute(src_lane << 2, __float_as_int(v))); }
__device__ __forceinline__ s16x4 pack4(float a, float b, float c, float d) { v2u w; w.x = pk2(a, b); w.y = pk2(c, d); return __builtin_bit_cast(s16x4, w); }
constexpr int NITEM = BATCH * 4 * (SEQ / 16);
constexpr int IMG_STRIDE = 144;
constexpr int WAVE_LDS = 1024 + 1024 + 3 * 16 * IMG_STRIDE * 2;
}
constexpr size_t WS_GDN_UB = WS_QG;
constexpr size_t WS_GDN_WT = WS_KG;
constexpr size_t WS_GDN_QD = WS_KG + 32 * MiB;
constexpr size_t WS_GDN_KD = WS_VG;
constexpr size_t WS_GDN_IT = WS_VG + 32 * MiB;

__device__ __forceinline__ void phase_gdn_g1(Frame& F, int j) {
    using namespace gdn;
    const bf16* PROJ = (const bf16*)(F.ws + WS_PROJ);
    const float* cw = kin(I_GDN_CONV) + (size_t)j * 4 * 1536;
    float* UB = (float*)(F.ws + WS_GDN_UB); bf16* WT = (bf16*)(F.ws + WS_GDN_WT); bf16* QD = (bf16*)(F.ws + WS_GDN_QD); bf16* KD = (bf16*)(F.ws + WS_GDN_KD); unsigned* ITE = (unsigned*)(F.ws + WS_GDN_IT);
    LAS float* Am = (LAS float*)(F.lds + RING_OFF + F.wave * WAVE_LDS); LAS float* Tm = Am + 256; LAS bf16* img = (LAS bf16*)(Tm + 256);
    const int gw = F.bid * NWAVES + F.wave, NGW = F.G * NWAVES;
#pragma unroll 1
    for (int item = gw; item < NITEM; item += NGW) {
        int lane = F.lane; asm volatile("" : "+v"(lane));
        const int tok = lane & 15, g4 = lane >> 4;
        const int b = item >> 12, h = (item >> 10) & 3, n = item & 1023; const int s0 = 16 * n + tok; const size_t m = (size_t)b * SEQ + s0;
        const size_t it = (size_t)item;
        const float gin = bf2f(PROJ[m * ODD_INP + O_GIN + h]), bin = bf2f(PROJ[m * ODD_INP + O_BETA + h]);
        const float gt = -expf(kin(I_GDN_ALOG)[j * 4 + h]) * softplusf_(gin + kin(I_GDN_DTB)[j * 4 + h]); const float beta = fsig(bin);
        float gc = gt;
#pragma unroll
        for (int off = 1; off < 16; off <<= 1) { const float t = bperm(gc, tok >= off ? lane - off : lane); if (tok >= off) gc += t; }
        const float glast = bperm(gc, lane | 15); const float eg = expf(gc), ekd = expf(glast - gc);
        LAS bf16* img2 = img + 16 * IMG_STRIDE; LAS bf16* img3 = img2 + 16 * IMG_STRIDE;
#define GDN_CONV(WSEL, X) do { _Pragma("unroll") for (int db = 0; db < 8; ++db) { const int ch = (WSEL) * 512 + h * 128 + 16 * db + 4 * g4; float a0 = 0.f, a1 = 0.f, a2 = 0.f, a3 = 0.f; \
            _Pragma("unroll") for (int tap = 0; tap < 4; ++tap) { if (s0 - 3 + tap >= 0) { const v2u x = *(const v2u*)(PROJ + (m - 3 + tap) * ODD_INP + O_Q + ch); const f32x4 wv = *(const f32x4*)(cw + tap * 1536 + ch); \
                a0 += wv.x * bflo(x.x); a1 += wv.y * bfhi(x.x); a2 += wv.z * bflo(x.y); a3 += wv.w * bfhi(x.y); } } \
            X[db][0] = a0 * fsig(a0); X[db][1] = a1 * fsig(a1); X[db][2] = a2 * fsig(a2); X[db][3] = a3 * fsig(a3); \
            if ((db & 3) == 3) asm volatile("" ::: "memory"); } } while (0)
        { float xv[8][4]; GDN_CONV(2, xv);
#pragma unroll
          for (int db = 0; db < 8; ++db) *(LAS s16x4*)(img + tok * IMG_STRIDE + 16 * db + 4 * g4) = pack4(xv[db][0] * beta, xv[db][1] * beta, xv[db][2] * beta, xv[db][3] * beta); }
        s16x4 Kf[8];
        { float xk[8][4]; GDN_CONV(1, xk); float sk = 0.f;
#pragma unroll
          for (int db = 0; db < 8; ++db)
#pragma unroll
              for (int e = 0; e < 4; ++e) sk += xk[db][e] * xk[db][e];
          sk += bperm(sk, lane ^ 16); sk += bperm(sk, lane ^ 32);
          const float rk = 1.0f / sqrtf(sk + RMS_EPS); const float s2 = rk * beta * eg, s3 = rk * ekd;
#pragma unroll
          for (int db = 0; db < 8; ++db) { const int o = tok * IMG_STRIDE + 16 * db + 4 * g4;
              *(LAS s16x4*)(img2 + o) = pack4(xk[db][0] * s2, xk[db][1] * s2, xk[db][2] * s2, xk[db][3] * s2);
              *(LAS s16x4*)(img3 + o) = pack4(xk[db][0] * s3, xk[db][1] * s3, xk[db][2] * s3, xk[db][3] * s3);
              Kf[db] = pack4(xk[db][0] * rk, xk[db][1] * rk, xk[db][2] * rk, xk[db][3] * rk); } }
        f32x4 Gacc = {0.f, 0.f, 0.f, 0.f}, Pacc = {0.f, 0.f, 0.f, 0.f};
        { float xqq[8][4]; GDN_CONV(0, xqq); float sq = 0.f;
#pragma unroll
          for (int db = 0; db < 8; ++db)
#pragma unroll
              for (int e = 0; e < 4; ++e) sq += xqq[db][e] * xqq[db][e];
          sq += bperm(sq, lane ^ 16); sq += bperm(sq, lane ^ 32);
          const float rq = (1.0f / sqrtf(sq + RMS_EPS)) * 0.08838834764831845f;
#pragma unroll
          for (int db = 0; db < 8; ++db) {
              *(s16x4*)(QD + ((it * 4 + (db >> 1)) * 64 + lane) * 8 + (db & 1) * 4) = pack4(xqq[db][0] * rq * eg, xqq[db][1] * rq * eg, xqq[db][2] * rq * eg, xqq[db][3] * rq * eg);
              const s16x4 Qf = pack4(xqq[db][0] * rq, xqq[db][1] * rq, xqq[db][2] * rq, xqq[db][3] * rq);
              Gacc = GDN_MFMA(Kf[db], Kf[db], Gacc); Pacc = GDN_MFMA(Kf[db], Qf, Pacc); } }
#undef GDN_CONV
        { float itv[4];
#pragma unroll
          for (int r = 0; r < 4; ++r) { const int i = 4 * g4 + r; const float gci = bperm(gc, i), bi = bperm(beta, i);
              const float da = (tok < i) ? expf(gci - gc) : 0.f;
              Am[i * 16 + tok] = bi * Gacc[r] * da;
              const float dp = (i <= tok) ? expf(gc - gci) : 0.f;
              itv[r] = Pacc[r] * dp; }
          v4u ite; ite.x = pk2(itv[0], itv[1]); ite.y = pk2(itv[2], itv[3]); ite.z = __float_as_uint(expf(glast)); ite.w = 0u;
          *(v4u*)(ITE + (it * 64 + lane) * 4) = ite; }
        LDS_WAIT();
        float Tc[16];
#pragma unroll
        for (int i = 0; i < 16; ++i) { float s = (i == tok) ? 1.f : 0.f;
#pragma unroll
            for (int jj = 0; jj < i; ++jj) s -= Am[i * 16 + jj] * Tc[jj];
            Tc[i] = s; }
#pragma unroll
        for (int r = 0; r < 4; ++r) Tm[(4 * g4 + r) * 16 + tok] = (g4 == 0) ? Tc[r] : (g4 == 1) ? Tc[4 + r] : (g4 == 2) ? Tc[8 + r] : Tc[12 + r];
        LDS_WAIT();
        const f32x4 trow = *(const LAS f32x4*)(Tm + tok * 16 + 4 * g4);
        const s16x4 Tf = pack4(trow.x, trow.y, trow.z, trow.w);
        const int traddr = (int)(uintptr_t)img + ((4 * g4 + ((lane & 15) >> 2)) * IMG_STRIDE + 4 * (lane & 3)) * 2;
#pragma unroll
        for (int cb = 0; cb < 8; ++cb) { s16x4 vf; asm volatile("ds_read_b64_tr_b16 %0, %1 offset:%c2\n\ts_waitcnt lgkmcnt(0)" : "=&v"(vf) : "v"(traddr), "i"(cb * 32) : "memory");
            const f32x4 z = {0.f, 0.f, 0.f, 0.f}; const f32x4 u = GDN_MFMA(Tf, vf, z);
            *(f32x4*)(UB + ((it * 8 + cb) * 64 + lane) * 4) = u; }
#pragma unroll
        for (int db = 0; db < 8; ++db) { s16x4 kf; asm volatile("ds_read_b64_tr_b16 %0, %1 offset:%c2\n\ts_waitcnt lgkmcnt(0)" : "=&v"(kf) : "v"(traddr), "i"(16 * IMG_STRIDE * 2 + db * 32) : "memory");
            const f32x4 z = {0.f, 0.f, 0.f, 0.f}; const f32x4 w = GDN_MFMA(kf, Tf, z);
            *(s16x4*)(WT + ((it * 4 + (db >> 1)) * 64 + lane) * 8 + (db & 1) * 4) = pack4(-w.x, -w.y, -w.z, -w.w); }
#pragma unroll
        for (int db = 0; db < 8; ++db) { s16x4 kf; asm volatile("ds_read_b64_tr_b16 %0, %1 offset:%c2\n\ts_waitcnt lgkmcnt(0)" : "=&v"(kf) : "v"(traddr), "i"(32 * IMG_STRIDE * 2 + db * 32) : "memory");
            *(s16x4*)(KD + ((it * 4 + (db >> 1)) * 64 + lane) * 8 + (db & 1) * 4) = kf; }
        LDS_WAIT();
    }
}

__device__ __forceinline__ void phase_gdn_g2(Frame& F) {
    using namespace gdn;
    if (F.bid >= 64) return;
    const char* UB = (const char*)(F.ws + WS_GDN_UB); const char* WT = (const char*)(F.ws + WS_GDN_WT); const char* QD = (const char*)(F.ws + WS_GDN_QD); const char* KD = (const char*)(F.ws + WS_GDN_KD);
    const char* ITE = (const char*)(F.ws + WS_GDN_IT); float* OGN = (float*)(F.ws + WS_OG);
    const int lane = F.lane, bh = F.bid & 7, sl = F.bid >> 3, wave = F.wave;
    constexpr int SLOT = 14 * 1024, NSLOT = 8, INFL = 6;
    volatile LAS int* ready = (volatile LAS int*)(F.lds + LDSCTL_OFF + 128);
    volatile LAS int* done = (volatile LAS int*)(F.lds + LDSCTL_OFF + 192);
    if (F.tid < 8) ready[F.tid] = 0; if (F.tid == 8) *done = 0;
    __syncthreads();
    const size_t it0 = (size_t)bh * 1024;
    if (wave != 0) {
        const unsigned ring = (unsigned)(uintptr_t)(F.lds + RING_OFF); const size_t lo16 = (size_t)lane * 16;
        const int p0 = 2 * (wave - 1);
#pragma unroll 1
        for (int s = 0; s < 1024; ++s) {
            if (s >= NSLOT) { unsigned sp_ = 0; while (*done < s - NSLOT + 1) { __builtin_amdgcn_s_sleep(1); if (++sp_ > (1u << 24)) break; } }
            const size_t i_ = it0 + s; const unsigned d_ = ring + (unsigned)((s % NSLOT) * SLOT);
#pragma unroll
            for (int k = 0; k < 2; ++k) { const int pc = p0 + k; const char* src;
                if (pc == 0) src = UB + ((i_ * 8 + sl) * 64) * 16; else if (pc <= 4) src = WT + ((i_ * 4 + (pc - 1)) * 64) * 16; else if (pc <= 8) src = QD + ((i_ * 4 + (pc - 5)) * 64) * 16;
                else if (pc <= 12) src = KD + ((i_ * 4 + (pc - 9)) * 64) * 16; else src = ITE + (i_ * 64) * 16;
                att::glds16(src + lo16, (unsigned)__builtin_amdgcn_readfirstlane(d_ + pc * 1024)); }
            asm volatile("s_waitcnt vmcnt(10)" ::: "memory");
            if (s >= INFL - 1 && lane == 0) ready[wave] = s - (INFL - 1) + 1;
        }
        asm volatile("s_waitcnt vmcnt(0)" ::: "memory"); if (lane == 0) ready[wave] = 1024;
        return;
    }
    f32x4 S[8];
#pragma unroll
    for (int db = 0; db < 8; ++db) S[db] = (f32x4){0.f, 0.f, 0.f, 0.f};
    int avail = 0;
    typedef short s16x8 __attribute__((ext_vector_type(8)));
    f32x4 uA, uB; v4u iteA, iteB, wtA[4], wtB[4], qdA[4], qdB[4], kdA[4], kdB[4];
#define G2_POLL(n_) do { if ((n_) >= avail) { unsigned sp_ = 0; for (;;) { const int r1 = ready[1], r2 = ready[2], r3 = ready[3], r4 = ready[4], r5 = ready[5], r6 = ready[6], r7 = ready[7]; \
        avail = min(min(min(r1, r2), min(r3, r4)), min(min(r5, r6), r7)); if (avail > (n_)) break; __builtin_amdgcn_s_sleep(1); if (++sp_ > (1u << 24)) break; } } } while (0)
#define G2_READ(U_, ITE_, WT_, QD_, KD_, n_) do { const LAS char* sp_ = (const LAS char*)(F.lds + RING_OFF) + ((n_) % NSLOT) * SLOT + lane * 16; \
        U_ = *(const LAS f32x4*)sp_; ITE_ = *(const LAS v4u*)(sp_ + 13 * 1024); \
        _Pragma("unroll") for (int q = 0; q < 4; ++q) { WT_[q] = *(const LAS v4u*)(sp_ + (1 + q) * 1024); QD_[q] = *(const LAS v4u*)(sp_ + (5 + q) * 1024); KD_[q] = *(const LAS v4u*)(sp_ + (9 + q) * 1024); } } while (0)
#define FR(v, h) __builtin_bit_cast(s16x4, (v2u){(h) ? (v).z : (v).x, (h) ? (v).w : (v).y})
#define SB8(q) (s16x8){Sb[2 * (q)][0], Sb[2 * (q)][1], Sb[2 * (q)][2], Sb[2 * (q)][3], Sb[2 * (q) + 1][0], Sb[2 * (q) + 1][1], Sb[2 * (q) + 1][2], Sb[2 * (q) + 1][3]}
#define G2_STEP(U_, ITE_, WT_, QD_, KD_, UN_, ITEN_, WTN_, QDN_, KDN_, n_) do { const int n = (n_); \
        if (n + 1 < 1024) { G2_POLL(n + 1); G2_READ(UN_, ITEN_, WTN_, QDN_, KDN_, n + 1); } \
        const float egl = __uint_as_float(ITE_.z); const s16x4 itf = __builtin_bit_cast(s16x4, (v2u){ITE_.x, ITE_.y}); \
        s16x4 Sb[8]; \
        _Pragma("unroll") for (int db = 0; db < 8; ++db) Sb[db] = pack4(S[db].x, S[db].y, S[db].z, S[db].w); \
        f32x4 va = U_, vb2 = {0.f, 0.f, 0.f, 0.f}; \
        va = __builtin_amdgcn_mfma_f32_16x16x32_bf16(__builtin_bit_cast(s16x8, WT_[0]), SB8(0), va, 0, 0, 0); vb2 = __builtin_amdgcn_mfma_f32_16x16x32_bf16(__builtin_bit_cast(s16x8, WT_[1]), SB8(1), vb2, 0, 0, 0); \
        va = __builtin_amdgcn_mfma_f32_16x16x32_bf16(__builtin_bit_cast(s16x8, WT_[2]), SB8(2), va, 0, 0, 0); vb2 = __builtin_amdgcn_mfma_f32_16x16x32_bf16(__builtin_bit_cast(s16x8, WT_[3]), SB8(3), vb2, 0, 0, 0); \
        va = va + vb2; \
        const s16x4 vb = pack4(va.x, va.y, va.z, va.w); \
        _Pragma("unroll") for (int q = 0; q < 4; ++q) { const f32x4 s0 = S[2 * q] * egl, s1 = S[2 * q + 1] * egl; S[2 * q] = GDN_MFMA(FR(KD_[q], 0), vb, s0); S[2 * q + 1] = GDN_MFMA(FR(KD_[q], 1), vb, s1); } \
        f32x4 oa = {0.f, 0.f, 0.f, 0.f}, ob = {0.f, 0.f, 0.f, 0.f}; \
        oa = GDN_MFMA(itf, vb, oa); \
        _Pragma("unroll") for (int q = 0; q < 4; ++q) { oa = GDN_MFMA(FR(QD_[q], 0), Sb[2 * q], oa); ob = GDN_MFMA(FR(QD_[q], 1), Sb[2 * q + 1], ob); } \
        oa = oa + ob; \
        *(f32x4*)(OGN + (((it0 + n) * 8 + sl) * 64 + lane) * 4) = oa; \
        asm volatile("s_waitcnt lgkmcnt(0)" ::: "memory"); \
        if (lane == 0) *done = (n + 2 < 1024) ? n + 2 : 1024;         \
    } while (0)
    G2_POLL(0); G2_READ(uA, iteA, wtA, qdA, kdA, 0);
#pragma unroll 1
    for (int n2 = 0; n2 < 1024; n2 += 2) {
        G2_STEP(uA, iteA, wtA, qdA, kdA, uB, iteB, wtB, qdB, kdB, n2);
        G2_STEP(uB, iteB, wtB, qdB, kdB, uA, iteA, wtA, qdA, kdA, n2 + 1);
    }
#undef G2_POLL
#undef G2_READ
#undef G2_STEP
#undef FR
#undef SB8
}
__device__ __forceinline__ void phase_gdn_out2(Frame& F, int j) {
    using namespace gdn;
    const float* OGN = (const float*)(F.ws + WS_OG); const bf16* PROJ = (const bf16*)(F.ws + WS_PROJ); bf16* MIX = (bf16*)(F.ws + WS_MIX);
    const float* on = kin(I_GDN_ONORM) + j * 128; const int lane = F.lane, c = lane & 15, g4 = lane >> 4;
    const int gw = F.bid * NWAVES + F.wave, NGW = F.G * NWAVES;
#pragma unroll 1
    for (int item = gw; item < NITEM; item += NGW) { const int b = item >> 12, h = (item >> 10) & 3, n = item & 1023;
        f32x4 o[8]; float ss[4] = {0.f, 0.f, 0.f, 0.f};
#pragma unroll
        for (int sl = 0; sl < 8; ++sl) { o[sl] = *(const f32x4*)(OGN + (((size_t)item * 8 + sl) * 64 + lane) * 4);
#pragma unroll
            for (int r = 0; r < 4; ++r) ss[r] += o[sl][r] * o[sl][r]; }
#pragma unroll
        for (int r = 0; r < 4; ++r) { ss[r] += __shfl_xor(ss[r], 1); ss[r] += __shfl_xor(ss[r], 2); ss[r] += __shfl_xor(ss[r], 4); ss[r] += __shfl_xor(ss[r], 8); ss[r] = 1.0f / sqrtf(ss[r] * (1.f / 128.f) + RMS_EPS); }
#pragma unroll
        for (int r = 0; r < 4; ++r) { const size_t tok = (size_t)b * SEQ + 16 * n + 4 * g4 + r;
#pragma unroll
            for (int sl = 0; sl < 8; ++sl) { const int col = 16 * sl + c; const float zz = bf2f(PROJ[tok * ODD_INP + O_Z + h * 128 + col]);
                MIX[tok * DM + 512 + h * 128 + col] = (bf16)f2bf(o[sl][r] * ss[r] * on[col] * (zz * fsig(zz))); } }
    }
}
constexpr size_t WS_WR = WS_W_EVIN - 1 * MiB;
static_assert(WS_WR >= CTL_ZERO_BYTES, "WR above the control words");
__device__ __forceinline__ void router_weights(Frame& F) {
    float* WR = (float*)(F.ws + WS_WR);
    const int gt = F.bid * 512 + F.tid, NT = F.G * 512;
    for (int e = gt; e < 4 * 1024 * 48; e += NT) { const int l = e / (1024 * 48), r = e % (1024 * 48), k = r / 48, c = r % 48;
        const float g = kin(I_NORM_FFN)[l * DM + k];
        float w = 0.f; if (c < 4) w = kin(I_MOE_WGRP)[((size_t)l * DM + k) * 4 + c]; else if (c < 36) w = kin(I_MOE_WEXP)[((size_t)l * DM + k) * 32 + (c - 4)];
        WR[e] = g * w; }
}
__device__ __forceinline__ void phase_router2(Frame& F, int layer, bool dry = false) {
    const bf16* H = (const bf16*)(F.ws + WS_H16); bf16* ABF = (bf16*)(F.ws + WS_ABF);
    const float* gain = kin(I_NORM_FFN) + layer * DM; const float* bgr = kin(I_MOE_BGRP) + layer * 4; const float* bex = kin(I_MOE_BEXP) + layer * 32;
    const float* WR = (const float*)(F.ws + WS_WR) + (size_t)layer * 1024 * 48;
    int* TOKE = (int*)(F.ws + WS_TOKE); float* TOKW = (float*)(F.ws + WS_TOKW);
    LAS int* lcnt = (LAS int*)(F.lds + LDSCTL_OFF + LC_MOE + 512); LAS int* gbase = (LAS int*)(F.lds + LDSCTL_OFF + LC_MOE + 640);
    const int lane = F.lane, tok = lane & 15, kq = lane >> 4; const int per = NTOK / F.G;
    LAS int* lasg = (LAS int*)(F.lds + RING_OFF);
    LAS float* lg = (LAS float*)(F.lds + RING_OFF + 4096) + F.wave * (16 * 52);
    if (F.tid < 32) lcnt[F.tid] = 0;
    __syncthreads();
    const int m0 = F.bid * per + F.wave * 16;
    const bf16* hrow = H + (size_t)(m0 + tok) * DM + 4 * kq;
    f32x4 acc0 = {0.f, 0.f, 0.f, 0.f}, acc1 = acc0, acc2 = acc0; float ss = 0.f;
#define RT_LDA(p_) ({ const v2u x_ = *(const v2u*)(p_); (f32x4){bflo(x_.x), bfhi(x_.x), bflo(x_.y), bfhi(x_.y)}; })
#define RT_LOAD(a_, b_, S_) do { const int s_ = ((S_) < 64) ? (S_) : 63; a_ = *(const v2u*)(hrow + 16 * s_); \
        _Pragma("unroll") for (int e = 0; e < 4; ++e) _Pragma("unroll") for (int nb = 0; nb < 3; ++nb) b_[e * 3 + nb] = WR[(size_t)(16 * s_ + 4 * kq + e) * 48 + 16 * nb + tok]; } while (0)
#define RT_MMA(a_, b_) do { const f32x4 af_ = {bflo(a_.x), bfhi(a_.x), bflo(a_.y), bfhi(a_.y)};     \
        ss += (af_.x * af_.x + af_.y * af_.y) + (af_.z * af_.z + af_.w * af_.w); \
        _Pragma("unroll") for (int e = 0; e < 4; ++e) { const float a = af_[e]; \
            acc0 = __builtin_amdgcn_mfma_f32_16x16x4f32(a, b_[e * 3 + 0], acc0, 0, 0, 0); acc1 = __builtin_amdgcn_mfma_f32_16x16x4f32(a, b_[e * 3 + 1], acc1, 0, 0, 0); acc2 = __builtin_amdgcn_mfma_f32_16x16x4f32(a, b_[e * 3 + 2], acc2, 0, 0, 0); } } while (0)
    v2u a0, a1, a2, a3; float b0[12], b1[12], b2[12], b3[12];
    RT_LOAD(a0, b0, 0); RT_LOAD(a1, b1, 1); RT_LOAD(a2, b2, 2);
#pragma unroll 1
    for (int S = 0; S < 64; S += 4) {
        RT_LOAD(a3, b3, S + 3); __builtin_amdgcn_sched_barrier(0); RT_MMA(a0, b0); __builtin_amdgcn_sched_barrier(0);
        RT_LOAD(a0, b0, S + 4); __builtin_amdgcn_sched_barrier(0); RT_MMA(a1, b1); __builtin_amdgcn_sched_barrier(0);
        RT_LOAD(a1, b1, S + 5); __builtin_amdgcn_sched_barrier(0); RT_MMA(a2, b2); __builtin_amdgcn_sched_barrier(0);
        RT_LOAD(a2, b2, S + 6); __builtin_amdgcn_sched_barrier(0); RT_MMA(a3, b3); __builtin_amdgcn_sched_barrier(0);
    }
#undef RT_LOAD
#undef RT_MMA
    ss += __shfl_xor(ss, 16); ss += __shfl_xor(ss, 32);
    const float rr = 1.0f / sqrtf(ss * (1.f / 1024.f) + RMS_EPS);
#pragma unroll
    for (int reg = 0; reg < 4; ++reg) { LAS float* row = lg + (4 * kq + reg) * 52; row[tok] = acc0[reg]; row[16 + tok] = acc1[reg]; row[32 + tok] = acc2[reg]; }
    if (kq == 0) lg[tok * 52 + 48] = rr;
    LDS_WAIT();
    if (lane < 16) { const LAS float* row = lg + lane * 52; const float r = row[48]; const int m = m0 + lane; const int tl = F.wave * 16 + lane;
        float l4[4];
#pragma unroll
        for (int g = 0; g < 4; ++g) l4[g] = row[g] * r + bgr[g];
        int gi = 0; float gm = l4[0];
#pragma unroll
        for (int g = 1; g < 4; ++g) if (l4[g] > gm) { gm = l4[g]; gi = g; }
        float gden = 0.f;
#pragma unroll
        for (int g = 0; g < 4; ++g) gden += expf(l4[g] - gm);
        const float gw_ = 1.0f / gden;
        float le[8];
#pragma unroll
        for (int e = 0; e < 8; ++e) le[e] = row[4 + gi * 8 + e] * r + bex[gi * 8 + e];
        int i0 = 0; float mx0 = le[0];
#pragma unroll
        for (int e = 1; e < 8; ++e) if (le[e] > mx0) { mx0 = le[e]; i0 = e; }
        int i1 = -1; float mx1 = -3.0e38f;
#pragma unroll
        for (int e = 0; e < 8; ++e) if (e != i0 && le[e] > mx1) { mx1 = le[e]; i1 = e; }
        const float e1 = expf(mx1 - mx0); const float w0 = gw_ / (1.0f + e1), w1 = gw_ * e1 / (1.0f + e1);
        if (!dry) { const int ea = gi * 8 + i0, eb = gi * 8 + i1;
            const int pa = __hip_atomic_fetch_add(lcnt + ea, 1, __ATOMIC_RELAXED, __HIP_MEMORY_SCOPE_WORKGROUP), pb = __hip_atomic_fetch_add(lcnt + eb, 1, __ATOMIC_RELAXED, __HIP_MEMORY_SCOPE_WORKGROUP);
            lasg[tl * 2] = ea | (pa << 8); lasg[tl * 2 + 1] = eb | (pb << 8);
            TOKW[(size_t)m * 2] = w0; TOKW[(size_t)m * 2 + 1] = w1; } }
#pragma unroll 1
    for (int t = 0; t < 16; ++t) { const float r = lg[t * 52 + 48];
#pragma unroll
        for (int q = 0; q < 2; ++q) { const v4u x = ((const v4u*)(H + (size_t)(m0 + t) * DM) + lane)[64 * q]; const float* g = gain + 512 * q + 8 * lane; const f32x4 g0 = *(const f32x4*)g, g1 = *(const f32x4*)(g + 4);
            v4u o; o.x = pk2(bflo(x.x) * r * g0.x, bfhi(x.x) * r * g0.y); o.y = pk2(bflo(x.y) * r * g0.z, bfhi(x.y) * r * g0.w); o.z = pk2(bflo(x.z) * r * g1.x, bfhi(x.z) * r * g1.y); o.w = pk2(bflo(x.w) * r * g1.z, bfhi(x.w) * r * g1.w);
            ((v4u*)(ABF + (size_t)(m0 + t) * DM) + lane)[64 * q] = o; } }
    __syncthreads();
    if (dry) return;
    if (F.tid < 32) gbase[F.tid] = (int)__hip_atomic_fetch_add(F.ctl + CW_CNT + 64 * layer + F.tid, (unsigned)lcnt[F.tid], __ATOMIC_RELAXED, __HIP_MEMORY_SCOPE_AGENT);
    __syncthreads();
    int* P2T = (int*)(F.ws + WS_P2T);
    for (int i = F.tid; i < per * 2; i += 512) { const int a = lasg[i], e = a & 255, lp = a >> 8; const int gp = gbase[e] + lp; TOKE[(size_t)F.bid * per * 2 + i] = e | (gp << 8); P2T[(size_t)e * NTOK + gp] = F.bid * per * 2 + i; }
    __syncthreads();
}
constexpr int LSTEPS = 16;
constexpr int STEP_END = 1 + DEPTH * LSTEPS;
struct KArgs { Args a; int li, pad; };

#define FRAME Frame F; { int wv_ = wave0; asm volatile("" : "+s"(wv_)); int t_ = wv_ * 64 + (int)__builtin_amdgcn_mbcnt_hi(~0u, __builtin_amdgcn_mbcnt_lo(~0u, 0u)); asm volatile("" : "+v"(t_)); unsigned char* w_ = kws(); F.lds = lds0; F.ws = w_; F.ctl = (unsigned*)(w_ + WS_CTL); \
        F.tid = t_; F.lane = t_ & 63; F.wave = __builtin_amdgcn_readfirstlane(t_ >> 6); { int g_ = gridDim.x, b_ = blockIdx.x; asm volatile("" : "+s"(g_), "+s"(b_)); F.G = g_; F.bid = b_; } } unsigned char* const ws = F.ws; (void)ws
#ifndef PH_MASK
#define PH_MASK 0xffffffffu
#endif
#define EN(k) (((PH_MASK) >> (k)) & 1u)
#ifndef DUP_E
#define DUP_E 0u
#endif
#ifndef DUP_O
#define DUP_O 0u
#endif
#define NREP(s) ((((s) >= 1) && (((((((s) - 1) / LSTEPS) & 1) ? (DUP_O) : (DUP_E)) >> (((s) + LSTEPS - 1) % LSTEPS)) & 1u)) ? 2 : 1)
#define STEP(s) if (lo <= (s) && (s) < hi) for (int rep_ = 0; rep_ < NREP(s); ++rep_)
#define DRY(s) (NREP(s) == 2 && rep_ == 0)
#ifdef TIME_K
#ifndef TIME_PAR
#define TIME_PAR 2
#endif
#define TMATCH(s) ((s) >= 1 && (((s) - 1) % LSTEPS) == (TIME_K) && ((TIME_PAR) == 2 || ((((s) - 1) / LSTEPS) & 1) == (TIME_PAR)))
#define TSTART(s) do { if (TMATCH(s)) tstart = __builtin_amdgcn_s_memrealtime(); } while (0)
#define TSTOP(s) do { if (TMATCH(s)) tacc += __builtin_amdgcn_s_memrealtime() - tstart; } while (0)
#else
#define TSTART(s) do {} while (0)
#define TSTOP(s) do {} while (0)
#endif
#define ENDSTEP(s) do { if ((s) + 1 < hi) xcd_barrier(bar); TSTOP(s); } while (0)
#define LAUNDER_WS do {} while (0)


template <int layer> __device__ __forceinline__ void layer_body(const XcdBarrier& bar, const int lo, const int hi, LAS unsigned char* const lds0, const int wave0, unsigned long long& tacc, unsigned long long& tstart) {
        constexpr int sb = 1 + layer * LSTEPS, j = layer >> 1; constexpr bool even = (layer & 1) == 0;
        STEP(sb + 0) if constexpr (EN(0)) { FRAME; TSTART(sb + 0);
            phase_norm(F, layer == 0 ? kin(I_X) : nullptr, kin(I_NORM_MIX) + layer * DM);
            if constexpr (even) moe_weights(F, layer);
            phase_pconv(F, layer);
            if constexpr (!even) { __syncthreads(); s5_build(F, j); }
            ENDSTEP(sb + 0);
        }
        STEP(sb + 1) if constexpr (EN(1)) { FRAME; TSTART(sb + 1);
            { LAUNDER_WS; const int NP = even ? EVEN_INP : ODD_INP; const bf16* W = even ? (const bf16*)(ws + WS_W_EVIN) + (size_t)j * EVEN_INP * 1024 : (const bf16*)(ws + WS_W_ODIN) + (size_t)j * ODD_INP * 1024;
              pg8::Gemm g{(const bf16*)(ws + WS_ABF), W, 1024, 1024, 1024}; pg8::StaticOrder S; S.init(NTOK, NP, F.G, F.bid); pg8::EpiBf16 E{(bf16*)(ws + WS_PROJ), NP};
              pg8::gemm_phase<pg8::EpiBf16, pg8::StaticOrder>(F.lds + RING_OFF, g, S, E, F.tid); }
            { LAUNDER_WS; pg8::Gemm g{(const bf16*)(ws + WS_PBF), (const bf16*)(ws + WS_W_PLEP) + (size_t)layer * 1024 * 256, 256, 256, 256}; pg8::StaticOrder S; S.init(NTOK, 1024, F.G, F.bid); pg8::EpiBf16 E{(bf16*)(ws + WS_PP), 1024};
              pg8::gemm_phase<pg8::EpiBf16, pg8::StaticOrder>(F.lds + RING_OFF, g, S, E, F.tid); }
            ENDSTEP(sb + 1);
        }
        if constexpr (even) {
            STEP(sb + 2) if constexpr (EN(2)) { FRAME; TSTART(sb + 2); phase_even_post(F, j, DRY(sb + 2)); ENDSTEP(sb + 2); }
            STEP(sb + 3) if constexpr (EN(3)) { FRAME; TSTART(sb + 3);
#ifndef NO_QUP
                { LAUNDER_WS; pg8::Gemm g{(const bf16*)(ws + WS_CQN), (const bf16*)(ws + WS_W_QUP) + (size_t)j * 768 * 384, 384, 384, 384}; pg8::StaticOrder S; S.init(NTOK, 768, F.G, F.bid); pg8::EpiBf16 E{(bf16*)(ws + WS_QM), 768};
                  pg8::gemm_phase<pg8::EpiBf16, pg8::StaticOrder>(F.lds + RING_OFF, g, S, E, F.tid); }
#endif
#ifndef NO_KVUP
                { LAUNDER_WS; pg8::Gemm g{(const bf16*)(ws + WS_CKVN), (const bf16*)(ws + WS_W_KVUP) + (size_t)j * 1024 * 256, 256, 256, 256}; pg8::StaticOrder S; S.init(NTOK, 1024, F.G, F.bid); pg8::EpiBf16 E{(bf16*)(ws + WS_KVB), 1024};
                  pg8::gemm_phase<pg8::EpiBf16, pg8::StaticOrder>(F.lds + RING_OFF, g, S, E, F.tid); }
#endif
#ifndef NO_CUMSUM
                phase_cumsum(F);
#endif
                ENDSTEP(sb + 3);
            }
            STEP(sb + 4) if constexpr (EN(4)) { FRAME; TSTART(sb + 4); phase_mla_post(F, j, DRY(sb + 4)); ENDSTEP(sb + 4); }
            STEP(sb + 5) if constexpr (EN(5)) { FRAME; TSTART(sb + 5);
#ifdef ATTN_NAIVE
                phase_attn_naive(F);
#else
                phase_attn_mfma(F, j);
#endif
                ENDSTEP(sb + 5); }
        } else {
            STEP(sb + 2) if constexpr (EN(2)) { FRAME; TSTART(sb + 2); s5_repack(F);
#ifdef GDN_NAIVE
                phase_gdn_prep(F, j);
#else
                phase_gdn_g1(F, j);
#ifdef DUP_G1
                phase_gdn_g1(F, j);
#endif
#ifdef DUP_REPACK
                s5_repack(F);
#endif
#endif
                ENDSTEP(sb + 2); }
            STEP(sb + 3) if constexpr (EN(3)) { FRAME; TSTART(sb + 3);
                if (F.bid < 64) { phase_gdn_g2(F); }
                else if (F.bid < 96) { const int grp = F.bid - 64;
                    { pg8::Gemm g{(const bf16*)(ws + WS_S5_AX), (const bf16*)(ws + WS_S5_PT), 1024, 1152, 1024}; S5GroupP S{grp}; S5PEpi E{(float*)(ws + WS_S5_XLOC)};
                      pg8::gemm_phase<S5PEpi, S5GroupP>(F.lds + RING_OFF, g, S, E, F.tid); }
                    VM_WAIT(); __syncthreads();
                    s5_scan(F, j, grp);
                    VM_WAIT(); __syncthreads();
                    { pg8::Gemm g{(const bf16*)(ws + WS_S5_AX), (const bf16*)(ws + WS_S5_MT), 1152, 1152, 1152}; S5GroupM S{grp}; S5MEpi E{(bf16*)(ws + WS_HG), (const bf16*)(ws + WS_PROJ), kin(I_S5_D) + j * 512};
                      pg8::gemm_phase<S5MEpi, S5GroupM>(F.lds + RING_OFF, g, S, E, F.tid); }
                } else { moe_weights(F, layer, 96, F.G - 96); }
                ENDSTEP(sb + 3);
            }
            STEP(sb + 6) if constexpr (EN(6)) { FRAME; TSTART(sb + 6);
                phase_gdn_out2(F, j);
                pg8::Gemm g{(const bf16*)(ws + WS_HG), (const bf16*)(ws + WS_W_GLU) + (size_t)j * 512 * 512, 512, 512, 512}; pg8::StaticOrder S; S.init(NTOK, 512, F.G, F.bid);
                pg8::EpiGlu E{(bf16*)(ws + WS_MIX), 1024, (const bf16*)(ws + WS_HG), 512, kin(I_S5_BGLU) + j * 512};
                pg8::gemm_phase<pg8::EpiGlu, pg8::StaticOrder>(F.lds + RING_OFF, g, S, E, F.tid);
                ENDSTEP(sb + 6);
            }
        }
        STEP(sb + 7) if constexpr (EN(7)) { FRAME; TSTART(sb + 7);
            LAUNDER_WS; const bf16* W = even ? (const bf16*)(ws + WS_W_EVOUT) + (size_t)j * 1024 * 1024 : (const bf16*)(ws + WS_W_ODOUT) + (size_t)j * 1024 * 1024;
            pg8::Gemm g{(const bf16*)(ws + WS_MIX), W, 1024, 1024, 1024}; pg8::StaticOrder S; S.init(NTOK, 1024, F.G, F.bid); pg8::EpiResAdd E{(bf16*)(ws + (DRY(sb + 7) ? WS_DUMMY : WS_H16)), 1024};
            pg8::gemm_phase<pg8::EpiResAdd, pg8::StaticOrder>(F.lds + RING_OFF, g, S, E, F.tid);
            ENDSTEP(sb + 7);
        }
        STEP(sb + 8) if constexpr (EN(8)) { FRAME; TSTART(sb + 8); phase_router2(F, layer, DRY(sb + 8)); ENDSTEP(sb + 8); }
        STEP(sb + 10) if constexpr (EN(10)) { FRAME; TSTART(sb + 10);
            LAUNDER_WS; moe_tables(F, layer);
            const LAS int* rowbase = (const LAS int*)(F.lds + LDSCTL_OFF + LC_MOE);
            MoeGatherOrder S{__builtin_amdgcn_readfirstlane(rowbase[34]), 4, F.G, F.bid, (const LAS unsigned char*)(F.lds + LDSCTL_OFF + LC_MOE + 192), rowbase, (const int*)(ws + WS_P2T), (size_t)1024 * 1024 * 2};
            pg8::Gemm g{(const bf16*)(ws + WS_ABF), (const bf16*)(ws + WS_W_MOEGU), 1024, 1024, 1024}; pg8::EpiSwiglu E{(bf16*)(ws + WS_HB), 512};
            pg8::gemm_phase_gather<pg8::EpiSwiglu, MoeGatherOrder>(F.lds + RING_OFF, g, S, E, F.tid);
            ENDSTEP(sb + 10);
        }
        STEP(sb + 11) if constexpr (EN(11)) { FRAME; TSTART(sb + 11);
            LAUNDER_WS; moe_tables(F, layer);
            const LAS int* rowbase = (const LAS int*)(F.lds + LDSCTL_OFF + LC_MOE);
            MoeOrder S{__builtin_amdgcn_readfirstlane(rowbase[34]), 4, F.G, F.bid, (const LAS unsigned char*)(F.lds + LDSCTL_OFF + LC_MOE + 192), (size_t)1024 * 512 * 2};
            pg8::Gemm g{(const bf16*)(ws + WS_HB), (const bf16*)(ws + WS_W_MOED), 512, 512, 512}; pg8::EpiBf16 E{(bf16*)(ws + WS_Y2), 1024};
            pg8::gemm_phase<pg8::EpiBf16, MoeOrder>(F.lds + RING_OFF, g, S, E, F.tid);
            ENDSTEP(sb + 11);
        }
        STEP(sb + 12) if constexpr (EN(12)) { FRAME; TSTART(sb + 12); phase_moe_combine(F, layer, DRY(sb + 12)); ENDSTEP(sb + 12); }
        STEP(sb + 13) if constexpr (EN(13)) { FRAME; TSTART(sb + 13);
            LAUNDER_WS; pg8::Gemm g{(const bf16*)(ws + WS_ABF), (const bf16*)(ws + WS_W_PLEG) + (size_t)layer * 1024 * 1024, 1024, 1024, 1024}; pg8::StaticOrder S; S.init(NTOK, 1024, F.G, F.bid);
            pg8::EpiPle E{(bf16*)(ws + (DRY(sb + 13) ? WS_DUMMY : WS_H16)), (const bf16*)(ws + WS_PP), kin(I_PLE_BG) + layer * DM, 1024, (layer == DEPTH - 1 && !DRY(sb + 13)) ? kout() : nullptr};
            pg8::gemm_phase<pg8::EpiPle, pg8::StaticOrder>(F.lds + RING_OFF, g, S, E, F.tid);
            ENDSTEP(sb + 13);
        }
    }
__global__ void __launch_bounds__(NWAVES * 64, 2) mega_fwd(KArgs ka) {
    extern __shared__ __attribute__((aligned(16))) unsigned char lds_raw[];
    const Args& args = ka.a;
    LAS unsigned char* const lds0 = (LAS unsigned char*)lds_raw;
    const int wave0 = __builtin_amdgcn_readfirstlane((int)threadIdx.x >> 6);
    for (int u = threadIdx.x; u < (LDS_BYTES - LDSCTL_OFF) / 4; u += NWAVES * 64) ((LAS unsigned*)(lds0 + LDSCTL_OFF))[u] = 0u;
    __syncthreads();
    XcdBarrier bar = xcd_barrier_post((unsigned*)(kws() + WS_CTL) + CW_BAR + ka.li * XCD_BAR_WORDS, (volatile LAS unsigned*)(lds0 + LDSCTL_OFF + LC_BARST));
    const int lo = args.ph_lo, hi = args.ph_hi;
    unsigned long long tacc = 0, tstart = 0;
    STEP(0) if constexpr (EN(15)) { FRAME; prologue_weights(F); router_weights(F);
#ifdef EXTRA_BARS
        for (int xb_ = 0; xb_ < EXTRA_BARS; ++xb_) xcd_barrier(bar);
#endif
        ENDSTEP(0); }
    layer_body<0>(bar, lo, hi, lds0, wave0, tacc, tstart); layer_body<1>(bar, lo, hi, lds0, wave0, tacc, tstart); layer_body<2>(bar, lo, hi, lds0, wave0, tacc, tstart); layer_body<3>(bar, lo, hi, lds0, wave0, tacc, tstart);
#ifdef TIME_G2WAIT
    if (blockIdx.x == 0 && threadIdx.x == 0) { const unsigned long long w_ = *(volatile LAS unsigned long long*)(lds0 + LDSCTL_OFF + 2048); const unsigned long long t_end = __builtin_amdgcn_s_memrealtime(); while (__builtin_amdgcn_s_memrealtime() - t_end < 10ull * w_) __builtin_amdgcn_s_sleep(8); }
#endif
#ifdef TIME_K
    if (blockIdx.x == 0) { const unsigned long long t_end = __builtin_amdgcn_s_memrealtime(); while (__builtin_amdgcn_s_memrealtime() - t_end < (unsigned long long)(TIME_AMP) * tacc) __builtin_amdgcn_s_sleep(8); }
#endif
#undef STEP
#undef ENDSTEP
}

#ifndef MK_MODE
#define MK_MODE 0
#endif
extern "C" void kernel_launch(void* const* d_in, const int* in_sizes, int n_in, void* d_out, int out_size, void* d_ws, size_t ws_size, hipStream_t stream) {
    static int ready = 0;
    if (ready == 0) {
        if (n_in != N_IN || out_size != NTOK * DM || ws_size < WS_END) { fprintf(stderr, "kernel_launch: unexpected shapes n_in %d out %d ws %zu (need %zu)\n", n_in, out_size, ws_size, (size_t)WS_END); ready = -1; return; }
        if (hipFuncSetAttribute((const void*)mega_fwd, hipFuncAttributeMaxDynamicSharedMemorySize, LDS_BYTES) != hipSuccess) { fprintf(stderr, "kernel_launch: hipFuncSetAttribute failed\n"); ready = -1; return; }
        int per_cu = 0; (void)hipOccupancyMaxActiveBlocksPerMultiprocessor(&per_cu, (const void*)mega_fwd, NWAVES * 64, LDS_BYTES); (void)hipGetLastError();
        ready = 1;
    }
    if (ready < 0) return;
    (void)hipMemsetAsync((char*)d_ws + WS_CTL, 0, CTL_ZERO_BYTES, stream);
    KArgs ka{};
    for (int i = 0; i < N_IN; ++i) ka.a.in[i] = (const float*)d_in[i];
    ka.a.out = (float*)d_out; ka.a.ws = (unsigned char*)d_ws; ka.li = 0; ka.pad = 0;
    const int grid = 256;
#if MK_MODE == 1
    ka.a.ph_lo = 0; ka.a.ph_hi = STEP_END;
    hipLaunchKernelGGL(mega_fwd, dim3(grid), dim3(NWAVES * 64), LDS_BYTES, stream, ka);
#else
    for (int s = 0; s < STEP_END; ++s) {
        if (s > 0) { const int k = (s - 1) % LSTEPS, layer = (s - 1) / LSTEPS; const bool even = (layer & 1) == 0;
            if (k > 13) continue; if (k == 6 && even) continue; if ((k == 4 || k == 5) && !even) continue; if (k == 9) continue; }
        ka.a.ph_lo = s; ka.a.ph_hi = s + 1;
        hipLaunchKernelGGL(mega_fwd, dim3(grid), dim3(NWAVES * 64), LDS_BYTES, stream, ka);
    }
#endif
}
```

```cpp
#include <hip/hip_runtime.h>
#include <cstdio>
#include <cstdint>
#define MK_MODE 1
#define ATTN_V2 1
namespace pg8 {
#define PG8_LAS __attribute__((address_space(3)))
typedef unsigned short bf16_t;
typedef short bf16x8 __attribute__((ext_vector_type(8)));
typedef float f32x4 __attribute__((ext_vector_type(4)));
typedef float f32x2 __attribute__((ext_vector_type(2)));
typedef unsigned u32x4 __attribute__((ext_vector_type(4)));
typedef unsigned u32x2 __attribute__((ext_vector_type(2)));
constexpr int BM = 256, BK = 64, HALF = 128, HTB = HALF * BK * 2  , STAGE_BYTES = 8 * HTB, NXCD = 8, WGM = 8;

__host__ __device__ __forceinline__ int lds_byte(int r, int c) { const int st = (r >> 4) * 2 + (c >> 5), rr = r & 15, cc = c & 31, ob = rr * 64 + cc * 2; return st * 1024 + (ob ^ (((ob >> 9) & 1) << 5)); }
__host__ __device__ __forceinline__ void stage_rc(int b, int& R, int& C) { const int st = b / 1024, sb = b % 1024, swz = sb ^ (((sb >> 9) & 1) << 5); R = (st >> 1) * 16 + swz / 64; C = (st & 1) * 32 + (swz % 64) / 2; }
__host__ __device__ __forceinline__ int perm32(int rho) { const int n = rho >> 4, i = rho & 15; return 8 * (i >> 2) + 4 * n + (i & 3); }

struct Unit { int pm, pn, aux; };
struct Gemm { const bf16_t* A; const bf16_t* Bt; int K, lda, ldb; };

struct StaticOrder {
    int nM, nN, nwg, G, c;
    __device__ void init(int M, int N, int G_, int c_) { nM = M / BM; nN = N / BM; nwg = nM * nN; G = G_; c = c_; }
    __device__ bool next(int i, Unit& u) const {
        const long L = (long)i * G + c; if (L >= nwg) return false;
        int wgid = (int)L; { const int q = nwg / NXCD, r = nwg % NXCD, xcd = wgid % NXCD, off = wgid / NXCD; wgid = (xcd < r ? xcd * (q + 1) : r * (q + 1) + (xcd - r) * q) + off; }
        const int nig = WGM * nN, gid = wgid / nig, fm = gid * WGM, gsz = (nM - fm) < WGM ? (nM - fm) : WGM;
        u.pm = fm + ((wgid % nig) % gsz); u.pn = (wgid % nig) / gsz; u.aux = 0; return true;
    }
    __device__ __forceinline__ const char* a_base(const Gemm& g, const Unit& u) const { return (const char*)g.A + (size_t)u.pm * BM * g.lda * 2; }
    __device__ __forceinline__ const char* b_base(const Gemm& g, const Unit& u) const { return (const char*)g.Bt + (size_t)u.pn * BM * g.ldb * 2; }
};

__device__ __forceinline__ unsigned cvt_pk_bf16(float lo, float hi) { unsigned r; asm volatile("v_cvt_pk_bf16_f32 %0, %1, %2" : "=v"(r) : "v"(lo), "v"(hi)); return r; }
__device__ __forceinline__ float bf_lo(unsigned w) { return __uint_as_float(w << 16); }
__device__ __forceinline__ float bf_hi(unsigned w) { return __uint_as_float(w & 0xffff0000u); }

struct EpiBf16 {
    static constexpr bool PERM = true;
    bf16_t* O; int ldc;
    __device__ __forceinline__ void operator()(const f32x4 (&acc)[2][2][4][2], const Unit& u, int wr, int wc, int fr, int fq) const {
        const int row0 = u.pm * BM + wr * 64 + fr; const int col0 = u.pn * BM + wc * 32 + 8 * fq;
#pragma unroll
        for (int ai = 0; ai < 2; ++ai)
#pragma unroll
            for (int m = 0; m < 4; ++m) { bf16_t* rowp = O + (size_t)(row0 + ai * HALF + m * 16) * ldc + col0;
#pragma unroll
                for (int bj = 0; bj < 2; ++bj) { const f32x4 v0 = acc[ai][bj][m][0], v1 = acc[ai][bj][m][1];
                    u32x4 w; w.x = cvt_pk_bf16(v0[0], v0[1]); w.y = cvt_pk_bf16(v0[2], v0[3]); w.z = cvt_pk_bf16(v1[0], v1[1]); w.w = cvt_pk_bf16(v1[2], v1[3]);
                    *(u32x4*)(rowp + bj * HALF) = w; } }
    }
};
struct EpiResAdd {
    static constexpr bool PERM = true;
    bf16_t* H; int ldc;
    __device__ __forceinline__ void operator()(const f32x4 (&acc)[2][2][4][2], const Unit& u, int wr, int wc, int fr, int fq) const {
        const int row0 = u.pm * BM + wr * 64 + fr; const int col0 = u.pn * BM + wc * 32 + 8 * fq;
#pragma unroll
        for (int ai = 0; ai < 2; ++ai) { u32x4 t[4][2];
#pragma unroll
            for (int m = 0; m < 4; ++m)
#pragma unroll
                for (int bj = 0; bj < 2; ++bj) t[m][bj] = *(const u32x4*)(H + (size_t)(row0 + ai * HALF + m * 16) * ldc + col0 + bj * HALF);
#pragma unroll
            for (int m = 0; m < 4; ++m)
#pragma unroll
                for (int bj = 0; bj < 2; ++bj) { const u32x4 h = t[m][bj]; const f32x4 v0 = acc[ai][bj][m][0], v1 = acc[ai][bj][m][1];
                    u32x4 w; w.x = cvt_pk_bf16(bf_lo(h.x) + v0[0], bf_hi(h.x) + v0[1]); w.y = cvt_pk_bf16(bf_lo(h.y) + v0[2], bf_hi(h.y) + v0[3]); w.z = cvt_pk_bf16(bf_lo(h.z) + v1[0], bf_hi(h.z) + v1[1]); w.w = cvt_pk_bf16(bf_lo(h.w) + v1[2], bf_hi(h.w) + v1[3]);
                    *(u32x4*)(H + (size_t)(row0 + ai * HALF + m * 16) * ldc + col0 + bj * HALF) = w; } }
    }
};
__device__ __forceinline__ float sigmoidf_(float x) { return __builtin_amdgcn_rcpf(1.0f + __expf(-x)); }
struct EpiPle {
    static constexpr bool PERM = true;
    bf16_t* H; const bf16_t* PP; const float* bias; int ldc; float* OUT;
    __device__ __forceinline__ void operator()(const f32x4 (&acc)[2][2][4][2], const Unit& u, int wr, int wc, int fr, int fq) const {
        const int row0 = u.pm * BM + wr * 64 + fr; const int col0 = u.pn * BM + wc * 32 + 8 * fq;
        f32x4 bv[2][2];
#pragma unroll
        for (int bj = 0; bj < 2; ++bj)
#pragma unroll
            for (int n = 0; n < 2; ++n) bv[bj][n] = *(const f32x4*)(bias + col0 + bj * HALF + 4 * n);
#pragma unroll
        for (int ai = 0; ai < 2; ++ai)
#pragma unroll
            for (int mp = 0; mp < 2; ++mp) { u32x4 th[2][2], tp[2][2];
#pragma unroll
                for (int mm = 0; mm < 2; ++mm)
#pragma unroll
                    for (int bj = 0; bj < 2; ++bj) { const size_t o = (size_t)(row0 + ai * HALF + (2 * mp + mm) * 16) * ldc + col0 + bj * HALF; th[mm][bj] = *(const u32x4*)(H + o); tp[mm][bj] = *(const u32x4*)(PP + o); }
#pragma unroll
                for (int mm = 0; mm < 2; ++mm)
#pragma unroll
                    for (int bj = 0; bj < 2; ++bj) { const size_t o = (size_t)(row0 + ai * HALF + (2 * mp + mm) * 16) * ldc + col0 + bj * HALF; const u32x4 h = th[mm][bj], q = tp[mm][bj];
                        const f32x4 a0 = acc[ai][bj][2 * mp + mm][0] + bv[bj][0], a1 = acc[ai][bj][2 * mp + mm][1] + bv[bj][1];
                        const float r0 = bf_lo(h.x) + sigmoidf_(a0[0]) * bf_lo(q.x), r1 = bf_hi(h.x) + sigmoidf_(a0[1]) * bf_hi(q.x), r2 = bf_lo(h.y) + sigmoidf_(a0[2]) * bf_lo(q.y), r3 = bf_hi(h.y) + sigmoidf_(a0[3]) * bf_hi(q.y);
                        const float r4 = bf_lo(h.z) + sigmoidf_(a1[0]) * bf_lo(q.z), r5 = bf_hi(h.z) + sigmoidf_(a1[1]) * bf_hi(q.z), r6 = bf_lo(h.w) + sigmoidf_(a1[2]) * bf_lo(q.w), r7 = bf_hi(h.w) + sigmoidf_(a1[3]) * bf_hi(q.w);
                        if (OUT) { *(f32x4*)(OUT + o) = (f32x4){r0, r1, r2, r3}; *(f32x4*)(OUT + o + 4) = (f32x4){r4, r5, r6, r7}; }
                        else { u32x4 w; w.x = cvt_pk_bf16(r0, r1); w.y = cvt_pk_bf16(r2, r3); w.z = cvt_pk_bf16(r4, r5); w.w = cvt_pk_bf16(r6, r7); *(u32x4*)(H + o) = w; } } }
    }
};
struct EpiGlu {
    static constexpr bool PERM = true;
    bf16_t* O; int ldo; const bf16_t* HG; int ldh; const float* bias;
    __device__ __forceinline__ void operator()(const f32x4 (&acc)[2][2][4][2], const Unit& u, int wr, int wc, int fr, int fq) const {
        const int row0 = u.pm * BM + wr * 64 + fr; const int col0 = u.pn * BM + wc * 32 + 8 * fq;
#pragma unroll
        for (int ai = 0; ai < 2; ++ai)
#pragma unroll
            for (int m = 0; m < 4; ++m) { const size_t r = (size_t)(row0 + ai * HALF + m * 16);
#pragma unroll
                for (int bj = 0; bj < 2; ++bj) { const int c = col0 + bj * HALF; const u32x4 hw = *(const u32x4*)(HG + r * ldh + c);
                    const f32x4 b0 = *(const f32x4*)(bias + c), b1 = *(const f32x4*)(bias + c + 4); const f32x4 v0 = acc[ai][bj][m][0] + b0, v1 = acc[ai][bj][m][1] + b1;
                    u32x4 w; w.x = cvt_pk_bf16(bf_lo(hw.x) * sigmoidf_(v0[0]), bf_hi(hw.x) * sigmoidf_(v0[1])); w.y = cvt_pk_bf16(bf_lo(hw.y) * sigmoidf_(v0[2]), bf_hi(hw.y) * sigmoidf_(v0[3]));
                    w.z = cvt_pk_bf16(bf_lo(hw.z) * sigmoidf_(v1[0]), bf_hi(hw.z) * sigmoidf_(v1[1])); w.w = cvt_pk_bf16(bf_lo(hw.w) * sigmoidf_(v1[2]), bf_hi(hw.w) * sigmoidf_(v1[3]));
                    *(u32x4*)(O + r * ldo + c) = w; } }
    }
};
struct EpiSwiglu {
    static constexpr bool PERM = true;
    bf16_t* HB; int ldc;
    __device__ __forceinline__ void operator()(const f32x4 (&acc)[2][2][4][2], const Unit& u, int wr, int wc, int fr, int fq) const {
        const int row0 = u.pm * BM + wr * 64 + fr; const int col0 = u.pn * HALF + wc * 32 + 8 * fq;
#pragma unroll
        for (int ai = 0; ai < 2; ++ai)
#pragma unroll
            for (int m = 0; m < 4; ++m) { bf16_t* rowp = HB + (size_t)(row0 + ai * HALF + m * 16) * ldc + col0;
                const f32x4 g0 = acc[ai][0][m][0], g1 = acc[ai][0][m][1], u0 = acc[ai][1][m][0], u1 = acc[ai][1][m][1];
                u32x4 w; w.x = cvt_pk_bf16(g0[0] * sigmoidf_(g0[0]) * u0[0], g0[1] * sigmoidf_(g0[1]) * u0[1]); w.y = cvt_pk_bf16(g0[2] * sigmoidf_(g0[2]) * u0[2], g0[3] * sigmoidf_(g0[3]) * u0[3]);
                w.z = cvt_pk_bf16(g1[0] * sigmoidf_(g1[0]) * u1[0], g1[1] * sigmoidf_(g1[1]) * u1[1]); w.w = cvt_pk_bf16(g1[2] * sigmoidf_(g1[2]) * u1[2], g1[3] * sigmoidf_(g1[3]) * u1[3]);
                *(u32x4*)rowp = w; }
    }
};

template <class Epi, class Sched, bool ALIGN_EPI = true, bool SP2 = true>
__device__ __forceinline__ void gemm_phase(PG8_LAS unsigned char* lds, const Gemm g, const Sched& S, const Epi& E, const int tid) {
    const int wid = __builtin_amdgcn_readfirstlane(tid >> 6), lane = tid & 63, wr = wid >> 2, wc = wid & 3, fr = lane & 15, fq = lane >> 4;
    int K = g.K; asm volatile("" : "+s"(K));
    const int nt = K / BK;
    unsigned voffA[2], voffB[2];
#pragma unroll
    for (int i = 0; i < 2; ++i) { int R, C; stage_rc(tid * 16 + i * 8192, R, C); const int Rb = Epi::PERM ? ((R & ~31) + perm32(R & 31)) : R;
        voffA[i] = (unsigned)(R * g.lda + C) * 2u; voffB[i] = (unsigned)(Rb * g.ldb + C) * 2u; }
    const size_t kstep = (size_t)(BK * 2);
    const size_t hstepA = (size_t)HALF * g.lda * 2, hstepB = (size_t)HALF * g.ldb * 2;
    const unsigned ldsw = (unsigned)wid * 1024u;
    const int aoff = lds_byte(wr * 64 + fr, fq * 8), boff = lds_byte(wc * 32 + fr, fq * 8);
#define PG8_SA(b, h) (((b) * 2 + (h)) * HTB)
#define PG8_SB(b, h) ((4 + (b) * 2 + (h)) * HTB)
#define PG8_STAGE(bufoff, gbase, voff) do { _Pragma("unroll") for (int _i = 0; _i < 2; ++_i) \
        __builtin_amdgcn_global_load_lds((const unsigned*)((const char*)(gbase) + (voff)[_i]), (PG8_LAS unsigned*)(lds + (bufoff) + ldsw + _i * 8192), 16, 0, 0); } while (0)
#define PG8_LDA(dst, b, h) do { _Pragma("unroll") for (int m = 0; m < 4; ++m) _Pragma("unroll") for (int k = 0; k < 2; ++k) dst[m][k] = *(const PG8_LAS bf16x8*)(lds + PG8_SA(b, h) + aoff + m * 2048 + k * 1024); } while (0)
#define PG8_LDB(dst, b, h) do { _Pragma("unroll") for (int n = 0; n < 2; ++n) _Pragma("unroll") for (int k = 0; k < 2; ++k) dst[n][k] = *(const PG8_LAS bf16x8*)(lds + PG8_SB(b, h) + boff + n * 2048 + k * 1024); } while (0)
#define PG8_MMA(ai, bj, At, Bt) do { __builtin_amdgcn_s_setprio(1); _Pragma("unroll") for (int m = 0; m < 4; ++m) _Pragma("unroll") for (int n = 0; n < 2; ++n) _Pragma("unroll") for (int k = 0; k < 2; ++k) \
        acc[ai][bj][m][n] = __builtin_amdgcn_mfma_f32_16x16x32_bf16(Bt[n][k], At[m][k], acc[ai][bj][m][n], 0, 0, 0); __builtin_amdgcn_s_setprio(0); } while (0)
#define PG8_WAIT_V(n) asm volatile("s_waitcnt vmcnt(" #n ")" ::: "memory")
#define PG8_WAIT_L(n) asm volatile("s_waitcnt lgkmcnt(" #n ")" ::: "memory")
#define PG8_BAR __builtin_amdgcn_s_barrier()
#define PG8_SCHED __builtin_amdgcn_sched_barrier(0)
    Unit cur, nxt; int ui = 0;
    if (!S.next(0, cur)) return;
    f32x4 acc[2][2][4][2];
#pragma unroll
    for (int a = 0; a < 2; ++a)
#pragma unroll
        for (int b = 0; b < 2; ++b)
#pragma unroll
            for (int m = 0; m < 4; ++m)
#pragma unroll
                for (int n = 0; n < 2; ++n) acc[a][b][m][n] = (f32x4){0.f, 0.f, 0.f, 0.f};
    bf16x8 At[4][2], B0[2][2], B1[2][2];
    const char* cA = S.a_base(g, cur); const char* cB = S.b_base(g, cur);
    if constexpr (SP2) {
        PG8_STAGE(PG8_SB(0, 0), cB, voffB); PG8_STAGE(PG8_SB(0, 1), cB + hstepB, voffB); PG8_STAGE(PG8_SA(0, 0), cA, voffA); PG8_STAGE(PG8_SA(0, 1), cA + hstepA, voffA);
        if (wr == 1) PG8_BAR;
        PG8_WAIT_V(2); PG8_BAR;
        PG8_STAGE(PG8_SB(1, 0), cB + kstep, voffB); PG8_STAGE(PG8_SA(1, 0), cA + kstep, voffA); PG8_STAGE(PG8_SB(1, 1), cB + hstepB + kstep, voffB);
        PG8_WAIT_V(6); PG8_BAR;
    } else {
        PG8_STAGE(PG8_SB(0, 0), cB, voffB); PG8_STAGE(PG8_SA(0, 0), cA, voffA); PG8_STAGE(PG8_SB(0, 1), cB + hstepB, voffB); PG8_STAGE(PG8_SA(0, 1), cA + hstepA, voffA);
        if (wr == 1) PG8_BAR;
        PG8_WAIT_V(4); PG8_BAR;
        PG8_STAGE(PG8_SB(1, 0), cB + kstep, voffB); PG8_STAGE(PG8_SA(1, 0), cA + kstep, voffA); PG8_STAGE(PG8_SB(1, 1), cB + hstepB + kstep, voffB);
        PG8_WAIT_V(6); PG8_BAR;
    }
    for (;;) {
        const bool has_next = S.next(ui + 1, nxt);
        const char* nA = has_next ? S.a_base(g, nxt) : cA; const char* nB = has_next ? S.b_base(g, nxt) : cB;
        for (int t = 0; t < nt; t += 2) {
            const bool last = (t == nt - 2);
            const char* a1 = cA + (size_t)(t + 1) * kstep;
            const char* a2 = last ? nA : cA + (size_t)(t + 2) * kstep; const char* b2 = last ? nB : cB + (size_t)(t + 2) * kstep;
            const char* a3 = a2 + kstep; const char* b3 = b2 + kstep;
            if constexpr (SP2) {
            PG8_LDB(B0, 0, 0); PG8_LDB(B1, 0, 1); PG8_SCHED; PG8_LDA(At, 0, 0); PG8_STAGE(PG8_SA(1, 1), a1 + hstepA, voffA);
            PG8_WAIT_V(8); PG8_WAIT_L(0); PG8_BAR; PG8_MMA(0, 0, At, B0); PG8_MMA(0, 1, At, B1); PG8_BAR; PG8_SCHED;
            PG8_LDA(At, 0, 1); PG8_STAGE(PG8_SB(0, 0), b2, voffB); PG8_STAGE(PG8_SB(0, 1), b2 + hstepB, voffB); PG8_STAGE(PG8_SA(0, 0), a2, voffA);
            PG8_WAIT_V(8); PG8_WAIT_L(0); PG8_BAR; PG8_MMA(1, 0, At, B0); PG8_MMA(1, 1, At, B1); PG8_BAR; PG8_SCHED;
            PG8_LDB(B0, 1, 0); PG8_LDB(B1, 1, 1); PG8_SCHED; PG8_LDA(At, 1, 0); PG8_STAGE(PG8_SA(0, 1), a2 + hstepA, voffA);
            PG8_WAIT_V(8); PG8_WAIT_L(0); PG8_BAR; PG8_MMA(0, 0, At, B0); PG8_MMA(0, 1, At, B1); PG8_BAR; PG8_SCHED;
            PG8_LDA(At, 1, 1); PG8_STAGE(PG8_SB(1, 0), b3, voffB); PG8_STAGE(PG8_SB(1, 1), b3 + hstepB, voffB); PG8_STAGE(PG8_SA(1, 0), a3, voffA);
            PG8_WAIT_V(8); PG8_WAIT_L(0); PG8_BAR; PG8_MMA(1, 0, At, B0); PG8_MMA(1, 1, At, B1); PG8_BAR; PG8_SCHED;
            } else {
            PG8_LDB(B0, 0, 0); PG8_SCHED; PG8_LDA(At, 0, 0); PG8_STAGE(PG8_SA(1, 1), a1 + hstepA, voffA);
            PG8_WAIT_L(8); PG8_BAR; PG8_WAIT_L(0); PG8_MMA(0, 0, At, B0); PG8_BAR; PG8_SCHED;
            PG8_LDB(B1, 0, 1); PG8_STAGE(PG8_SB(0, 0), b2, voffB);
            PG8_BAR; PG8_WAIT_L(0); PG8_MMA(0, 1, At, B1); PG8_BAR;
            PG8_LDA(At, 0, 1); PG8_STAGE(PG8_SA(0, 0), a2, voffA);
            PG8_BAR; PG8_WAIT_L(0); PG8_MMA(1, 0, At, B0); PG8_BAR; PG8_SCHED;
            PG8_STAGE(PG8_SB(0, 1), b2 + hstepB, voffB);
            PG8_WAIT_V(6); PG8_BAR; PG8_MMA(1, 1, At, B1); PG8_BAR;
            PG8_LDB(B0, 1, 0); PG8_SCHED; PG8_LDA(At, 1, 0); PG8_STAGE(PG8_SA(0, 1), a2 + hstepA, voffA);
            PG8_WAIT_L(8); PG8_BAR; PG8_WAIT_L(0); PG8_MMA(0, 0, At, B0); PG8_BAR; PG8_SCHED;
            PG8_LDB(B1, 1, 1); PG8_STAGE(PG8_SB(1, 0), b3, voffB);
            PG8_BAR; PG8_WAIT_L(0); PG8_MMA(0, 1, At, B1); PG8_BAR;
            PG8_LDA(At, 1, 1); PG8_STAGE(PG8_SA(1, 0), a3, voffA);
            PG8_BAR; PG8_WAIT_L(0); PG8_MMA(1, 0, At, B0); PG8_BAR; PG8_SCHED;
            PG8_STAGE(PG8_SB(1, 1), b3 + hstepB, voffB);
            PG8_WAIT_V(6); PG8_BAR; PG8_MMA(1, 1, At, B1); PG8_BAR;
            }
        }
        if constexpr (ALIGN_EPI) { if (wr == 0) PG8_BAR; }
        E(acc, cur, wr, wc, fr, fq);
        if (!has_next) break;
#pragma unroll
        for (int a = 0; a < 2; ++a)
#pragma unroll
            for (int b = 0; b < 2; ++b)
#pragma unroll
                for (int m = 0; m < 4; ++m)
#pragma unroll
                    for (int n = 0; n < 2; ++n) acc[a][b][m][n] = (f32x4){0.f, 0.f, 0.f, 0.f};
        cur = nxt; cA = nA; cB = nB; ++ui;
        if constexpr (ALIGN_EPI) { if (wr == 1) PG8_BAR; }
    }
    PG8_WAIT_V(0);
    if constexpr (!ALIGN_EPI) { if (wr == 0) PG8_BAR; }
    PG8_BAR;
#undef PG8_SA
#undef PG8_SB
#undef PG8_STAGE
#undef PG8_LDA
#undef PG8_LDB
#undef PG8_MMA
#undef PG8_WAIT_V
#undef PG8_WAIT_L
#undef PG8_BAR
#undef PG8_SCHED
}
template <class Epi, class Sched>
__device__ __forceinline__ void gemm_phase_gather(PG8_LAS unsigned char* lds, const Gemm g, const Sched& S, const Epi& E, const int tid) {
    const int wid = __builtin_amdgcn_readfirstlane(tid >> 6), lane = tid & 63, wr = wid >> 2, wc = wid & 3, fr = lane & 15, fq = lane >> 4;
    int K = g.K; asm volatile("" : "+s"(K));
    const int nt = K / BK;
    unsigned voffB[2]; int RA[2]; unsigned CA2[2];
#pragma unroll
    for (int i = 0; i < 2; ++i) { int R, C; stage_rc(tid * 16 + i * 8192, R, C); const int Rb = Epi::PERM ? ((R & ~31) + perm32(R & 31)) : R;
        RA[i] = R; CA2[i] = (unsigned)C * 2u; voffB[i] = (unsigned)(Rb * g.ldb + C) * 2u; }
    unsigned vA0[2], vA1[2], nA0[2], nA1[2];
#define PG8_ROWS(u_, d0, d1) do { _Pragma("unroll") for (int i_ = 0; i_ < 2; ++i_) { d0[i_] = S.a_row(u_, RA[i_]) * (unsigned)(g.lda * 2) + CA2[i_]; d1[i_] = S.a_row(u_, HALF + RA[i_]) * (unsigned)(g.lda * 2) + CA2[i_]; } } while (0)
    const size_t kstep = (size_t)(BK * 2);
    const size_t hstepA = (size_t)HALF * g.lda * 2, hstepB = (size_t)HALF * g.ldb * 2;
    const unsigned ldsw = (unsigned)wid * 1024u;
    const int aoff = lds_byte(wr * 64 + fr, fq * 8), boff = lds_byte(wc * 32 + fr, fq * 8);
#define PG8_SA(b, h) (((b) * 2 + (h)) * HTB)
#define PG8_SB(b, h) ((4 + (b) * 2 + (h)) * HTB)
#define PG8_STAGE(bufoff, gbase, voff) do { _Pragma("unroll") for (int _i = 0; _i < 2; ++_i) \
        __builtin_amdgcn_global_load_lds((const unsigned*)((const char*)(gbase) + (voff)[_i]), (PG8_LAS unsigned*)(lds + (bufoff) + ldsw + _i * 8192), 16, 0, 0); } while (0)
#define PG8_LDA(dst, b, h) do { _Pragma("unroll") for (int m = 0; m < 4; ++m) _Pragma("unroll") for (int k = 0; k < 2; ++k) dst[m][k] = *(const PG8_LAS bf16x8*)(lds + PG8_SA(b, h) + aoff + m * 2048 + k * 1024); } while (0)
#define PG8_LDB(dst, b, h) do { _Pragma("unroll") for (int n = 0; n < 2; ++n) _Pragma("unroll") for (int k = 0; k < 2; ++k) dst[n][k] = *(const PG8_LAS bf16x8*)(lds + PG8_SB(b, h) + boff + n * 2048 + k * 1024); } while (0)
#define PG8_MMA(ai, bj, At, Bt) do { __builtin_amdgcn_s_setprio(1); _Pragma("unroll") for (int m = 0; m < 4; ++m) _Pragma("unroll") for (int n = 0; n < 2; ++n) _Pragma("unroll") for (int k = 0; k < 2; ++k) \
        acc[ai][bj][m][n] = __builtin_amdgcn_mfma_f32_16x16x32_bf16(Bt[n][k], At[m][k], acc[ai][bj][m][n], 0, 0, 0); __builtin_amdgcn_s_setprio(0); } while (0)
#define PG8_WAIT_V(n) asm volatile("s_waitcnt vmcnt(" #n ")" ::: "memory")
#define PG8_WAIT_L(n) asm volatile("s_waitcnt lgkmcnt(" #n ")" ::: "memory")
#define PG8_BAR __builtin_amdgcn_s_barrier()
#define PG8_SCHED __builtin_amdgcn_sched_barrier(0)
    Unit cur, nxt; int ui = 0;
    if (!S.next(0, cur)) return;
    f32x4 acc[2][2][4][2];
#pragma unroll
    for (int a = 0; a < 2; ++a)
#pragma unroll
        for (int b = 0; b < 2; ++b)
#pragma unroll
            for (int m = 0; m < 4; ++m)
#pragma unroll
                for (int n = 0; n < 2; ++n) acc[a][b][m][n] = (f32x4){0.f, 0.f, 0.f, 0.f};
    bf16x8 At[4][2], B0[2][2], B1[2][2];
    const char* cA = (const char*)g.A; const char* cB = S.b_base(g, cur);
    PG8_ROWS(cur, vA0, vA1);
    if constexpr (true) {
        PG8_STAGE(PG8_SB(0, 0), cB, voffB); PG8_STAGE(PG8_SB(0, 1), cB + hstepB, voffB); PG8_STAGE(PG8_SA(0, 0), cA, vA0); PG8_STAGE(PG8_SA(0, 1), cA, vA1);
        if (wr == 1) PG8_BAR;
        PG8_WAIT_V(2); PG8_BAR;
        PG8_STAGE(PG8_SB(1, 0), cB + kstep, voffB); PG8_STAGE(PG8_SA(1, 0), cA + kstep, vA0); PG8_STAGE(PG8_SB(1, 1), cB + hstepB + kstep, voffB);
        PG8_WAIT_V(6); PG8_BAR;
    }
    for (;;) {
        const bool has_next = S.next(ui + 1, nxt);
        const char* nA = (const char*)g.A; const char* nB = has_next ? S.b_base(g, nxt) : cB;
        if (has_next) PG8_ROWS(nxt, nA0, nA1); else { nA0[0] = vA0[0]; nA0[1] = vA0[1]; nA1[0] = vA1[0]; nA1[1] = vA1[1]; }
        for (int t = 0; t < nt; t += 2) {
            const bool last = (t == nt - 2);
            const char* a1 = cA + (size_t)(t + 1) * kstep;
            const char* a2 = last ? nA : cA + (size_t)(t + 2) * kstep; const char* b2 = last ? nB : cB + (size_t)(t + 2) * kstep;
            const char* a3 = a2 + kstep; const char* b3 = b2 + kstep;
            unsigned sA0[2], sA1[2]; sA0[0] = last ? nA0[0] : vA0[0]; sA0[1] = last ? nA0[1] : vA0[1]; sA1[0] = last ? nA1[0] : vA1[0]; sA1[1] = last ? nA1[1] : vA1[1];
            if constexpr (true) {
            PG8_LDB(B0, 0, 0); PG8_LDB(B1, 0, 1); PG8_SCHED; PG8_LDA(At, 0, 0); PG8_STAGE(PG8_SA(1, 1), a1, vA1);
            PG8_WAIT_V(8); PG8_WAIT_L(0); PG8_BAR; PG8_MMA(0, 0, At, B0); PG8_MMA(0, 1, At, B1); PG8_BAR; PG8_SCHED;
            PG8_LDA(At, 0, 1); PG8_STAGE(PG8_SB(0, 0), b2, voffB); PG8_STAGE(PG8_SB(0, 1), b2 + hstepB, voffB); PG8_STAGE(PG8_SA(0, 0), a2, sA0);
            PG8_WAIT_V(8); PG8_WAIT_L(0); PG8_BAR; PG8_MMA(1, 0, At, B0); PG8_MMA(1, 1, At, B1); PG8_BAR; PG8_SCHED;
            PG8_LDB(B0, 1, 0); PG8_LDB(B1, 1, 1); PG8_SCHED; PG8_LDA(At, 1, 0); PG8_STAGE(PG8_SA(0, 1), a2, sA1);
            PG8_WAIT_V(8); PG8_WAIT_L(0); PG8_BAR; PG8_MMA(0, 0, At, B0); PG8_MMA(0, 1, At, B1); PG8_BAR; PG8_SCHED;
            PG8_LDA(At, 1, 1); PG8_STAGE(PG8_SB(1, 0), b3, voffB); PG8_STAGE(PG8_SB(1, 1), b3 + hstepB, voffB); PG8_STAGE(PG8_SA(1, 0), a3, sA0);
            PG8_WAIT_V(8); PG8_WAIT_L(0); PG8_BAR; PG8_MMA(1, 0, At, B0); PG8_MMA(1, 1, At, B1); PG8_BAR; PG8_SCHED;
            }
        }
        if constexpr (true) { if (wr == 0) PG8_BAR; }
        E(acc, cur, wr, wc, fr, fq);
        if (!has_next) break;
#pragma unroll
        for (int a = 0; a < 2; ++a)
#pragma unroll
            for (int b = 0; b < 2; ++b)
#pragma unroll
                for (int m = 0; m < 4; ++m)
#pragma unroll
                    for (int n = 0; n < 2; ++n) acc[a][b][m][n] = (f32x4){0.f, 0.f, 0.f, 0.f};
        cur = nxt; cB = nB; ++ui; vA0[0] = nA0[0]; vA0[1] = nA0[1]; vA1[0] = nA1[0]; vA1[1] = nA1[1];
        if constexpr (true) { if (wr == 1) PG8_BAR; }
    }
    PG8_WAIT_V(0);
    if constexpr (false) { if (wr == 0) PG8_BAR; }
    PG8_BAR;
#undef PG8_ROWS
#undef PG8_SA
#undef PG8_SB
#undef PG8_STAGE
#undef PG8_LDA
#undef PG8_LDB
#undef PG8_MMA
#undef PG8_WAIT_V
#undef PG8_WAIT_L
#undef PG8_BAR
#undef PG8_SCHED
}
}
#define LAS __attribute__((address_space(3)))
#define XB_TMO      128
#define XB_XCNT(j)  (256  + 64 * (j))
#define XB_XSUB(j)  (1280 + 64 * (j))
#define XB_XGEN(j)  (2304 + 64 * (j))
#define XB_TOP      3328
#define XB_TOPGEN   3392
#define XCD_BAR_WORDS 3456
#define XB_SPIN_CAP (1u << 22)

__device__ __forceinline__ unsigned xb_ld(unsigned* p)              { return __hip_atomic_load(p, __ATOMIC_RELAXED, __HIP_MEMORY_SCOPE_AGENT); }
__device__ __forceinline__ unsigned xb_add(unsigned* p, unsigned v) { return __hip_atomic_fetch_add(p, v, __ATOMIC_RELAXED, __HIP_MEMORY_SCOPE_AGENT); }
__device__ __forceinline__ unsigned xb_xcc_id() { return (unsigned)__builtin_amdgcn_s_getreg((3 << 11) | 20) & 0xFu; }
#define XB_SPIN(cond, bar) do { unsigned _sp = 0; while (cond) { __builtin_amdgcn_s_sleep(1); \
    if ((++_sp & 255u) == 0u) { if (xb_ld(&(bar)[XB_TMO])) break; if (_sp > XB_SPIN_CAP) { atomicAdd(&(bar)[XB_TMO], 1u); break; } } } } while (0)

struct XcdBarrier {
    unsigned* bar; unsigned x;
    volatile LAS unsigned* st;
};

__device__ __forceinline__ XcdBarrier xcd_barrier_post(unsigned* bar, volatile LAS unsigned* st) {
    XcdBarrier b; b.bar = bar; b.x = xb_xcc_id(); b.st = st;
    if (threadIdx.x == 0) (void)xb_add(&bar[XB_XCNT(b.x)], 1u);
    return b;
}
__device__ __forceinline__ void xcd_barrier_complete(unsigned* bar, unsigned x, unsigned& nloc, unsigned& nx) {
    const unsigned G = gridDim.x * gridDim.y * gridDim.z;
    unsigned sum, cnt, mine, sp = 0u;
    for (;;) {
        sum = 0u; cnt = 0u; mine = 0u;
#pragma unroll
        for (unsigned j = 0; j < 16; ++j) { const unsigned c = xb_ld(&bar[XB_XCNT(j)]); sum += c; cnt += (c > 0u) ? 1u : 0u; mine = (j == x) ? c : mine; }
        if (sum == G) break;
        __builtin_amdgcn_s_sleep(1);
        if ((++sp & 255u) == 0u) { if (xb_ld(&bar[XB_TMO])) break; if (sp > XB_SPIN_CAP) { atomicAdd(&bar[XB_TMO], 1u); break; } }
    }
    nloc = mine > 0u ? mine : 1u; nx = cnt > 0u ? cnt : 1u;
}

__device__ __forceinline__ void xcd_barrier(const XcdBarrier& b) {
    asm volatile("s_waitcnt vmcnt(0)" ::: "memory");
    __syncthreads();
    if (threadIdx.x == 0) {
        unsigned* bar = b.bar;
        __builtin_amdgcn_s_waitcnt(0);
        unsigned nloc = b.st[0], nx = b.st[1];
        if (nloc == 0u) { xcd_barrier_complete(bar, b.x, nloc, nx); b.st[0] = nloc; b.st[1] = nx; }
        const unsigned old = xb_add(&bar[XB_XSUB(b.x)], 1u);
        const unsigned gen = old / nloc;
        if (old + 1u == (gen + 1u) * nloc) {
            __builtin_amdgcn_fence(__ATOMIC_RELEASE, "agent");
            asm volatile("s_waitcnt vmcnt(0)" ::: "memory");
            const unsigned og = xb_add(&bar[XB_TOP], 1u);
            const unsigned tg = og / nx;
            if (og + 1u == (tg + 1u) * nx) xb_add(&bar[XB_TOPGEN], 1u);
            else XB_SPIN(xb_ld(&bar[XB_TOPGEN]) == tg, bar);
            __builtin_amdgcn_fence(__ATOMIC_ACQUIRE, "agent");
            xb_add(&bar[XB_XGEN(b.x)], 1u);
            asm volatile("s_waitcnt vmcnt(0)" ::: "memory");
        } else {
            XB_SPIN(xb_ld(&bar[XB_XGEN(b.x)]) == gen, bar);
            __builtin_amdgcn_fence(__ATOMIC_ACQUIRE, "agent");
            asm volatile("s_waitcnt vmcnt(0)" ::: "memory");
        }
    }
    __syncthreads();
}
#undef LAS
constexpr int NWAVES = 8;
constexpr int BATCH = 2, SEQ = 16384, NTOK = BATCH * SEQ, DM = 1024, DEPTH = 4, PLE = 256;
constexpr int EVEN_IN = 2216, EVEN_INP = 2304, ODD_IN = 2568, ODD_INP = 2816;
constexpr int E_FQ = 0, E_FK = 512, E_FV = 1024, E_FLOG = 1536, E_CQ = 1544, E_CKV = 1928, E_KROPE = 2184;
constexpr int O_U = 0, O_Q = 512, O_K = 1024, O_V = 1536, O_GIN = 2048, O_BETA = 2052, O_Z = 2056;
constexpr float RMS_EPS = 1e-6f;
constexpr float LOG2E = 1.4426950408889634f, LN2 = 0.6931471805599453f;
constexpr float C2_FOX = 0.125f * LOG2E, C2_MLA = 0.10206207261596575f * LOG2E;
constexpr int MOE_CAP = 65536 + 32 * 256;
constexpr int MOE_MAXT = MOE_CAP / 256;

enum { I_X = 0, I_P, I_POS, I_NORM_MIX, I_NORM_FFN, I_EV_W_IN, I_FOX_BF, I_FOX_QN, I_FOX_KN, I_MLA_QAN, I_MLA_WQUP, I_MLA_KVAN, I_MLA_WKVUP, I_MLA_QN, I_MLA_KN, I_EV_W_OUT,
       I_OD_W_IN, I_S5_ARE, I_S5_AIM, I_S5_BRE, I_S5_BIM, I_S5_CRE, I_S5_CIM, I_S5_D, I_S5_LS, I_S5_WGLU, I_S5_BGLU, I_GDN_CONV, I_GDN_ALOG, I_GDN_DTB, I_GDN_ONORM, I_OD_W_OUT,
       I_MOE_WGRP, I_MOE_BGRP, I_MOE_WEXP, I_MOE_BEXP, I_MOE_WG, I_MOE_WU, I_MOE_WD, I_PLE_WP, I_PLE_NORM, I_PLE_WG, I_PLE_BG, N_IN };

constexpr size_t MiB = 1u << 20;
constexpr size_t WS_CTL = 0, CTL_ZERO_BYTES = 1 * MiB;
constexpr size_t WS_W_EVIN = 4 * MiB;
constexpr size_t WS_W_ODIN = WS_W_EVIN + 9 * MiB;
constexpr size_t WS_W_QUP = WS_W_ODIN + 11 * MiB;
constexpr size_t WS_W_KVUP = WS_W_QUP + 2 * MiB;
constexpr size_t WS_W_EVOUT = WS_W_KVUP + 1 * MiB;
constexpr size_t WS_W_ODOUT = WS_W_EVOUT + 4 * MiB;
constexpr size_t WS_W_GLU = WS_W_ODOUT + 4 * MiB;
constexpr size_t WS_W_PLEP = WS_W_GLU + 1 * MiB;
constexpr size_t WS_W_PLEG = WS_W_PLEP + 2 * MiB;
constexpr size_t WS_W_MOEGU = WS_W_PLEG + 8 * MiB;
constexpr size_t WS_W_MOED = WS_W_MOEGU + 64 * MiB;
constexpr size_t WS_ABF = WS_W_MOED + 32 * MiB;
constexpr size_t WS_PP = WS_ABF + 64 * MiB;
constexpr size_t WS_PBF = WS_PP + 64 * MiB;
constexpr size_t WS_PROJ = WS_PBF + 16 * MiB;
constexpr size_t WS_MIX = WS_PROJ + 176 * MiB;
constexpr size_t WS_R1 = WS_MIX + 64 * MiB;
constexpr size_t WS_QM = WS_R1, WS_KVB = WS_QM + 48 * MiB, WS_KM = WS_KVB + 64 * MiB, WS_CQN = WS_KM + 48 * MiB, WS_CKVN = WS_CQN + 24 * MiB, WS_LOGF = WS_CKVN + 16 * MiB, WS_CUM = WS_LOGF + 1 * MiB;
constexpr size_t WS_HG = WS_R1, WS_QG = WS_HG + 32 * MiB, WS_KG = WS_QG + 64 * MiB, WS_VG = WS_KG + 64 * MiB, WS_OG = WS_VG + 64 * MiB;
constexpr size_t WS_R2 = WS_R1 + 288 * MiB;
constexpr size_t WS_GB = WS_R2, WS_BETA = WS_GB + 1 * MiB;
constexpr size_t WS_TOKE = WS_R2 + 2 * MiB, WS_TOKW = WS_TOKE + 1 * MiB, WS_ROWS = WS_TOKW + 1 * MiB;
constexpr size_t WS_P2T = WS_R2 + 4 * MiB;
constexpr size_t WS_XG = WS_R1;
constexpr size_t WS_HB = WS_XG + 144 * MiB;
constexpr size_t WS_Y2 = WS_R2 + 8 * MiB;
constexpr size_t WS_END = WS_Y2 + 144 * MiB;
static_assert(WS_HB + 72 * MiB <= WS_R2, "moe overlay");
static_assert(WS_OG + 64 * MiB <= WS_R2, "odd overlay");
constexpr size_t WS_H16 = WS_END;
constexpr size_t WS_DUMMY = WS_H16 + 64 * MiB;
static_assert(WS_DUMMY + 64 * MiB <= 1100 * MiB, "workspace budget");

constexpr int CW_BAR = 4096;
constexpr int CW_CNT = 1024;

constexpr int RING_OFF = 0, RING_BYTES = 131072;
constexpr int LDSCTL_OFF = RING_BYTES;
constexpr int LDS_BYTES = 147456;
constexpr int LC_BARST = 32;
constexpr int LC_MOE = 256;

#define GAS __attribute__((address_space(1)))
#define LAS __attribute__((address_space(3)))
typedef unsigned short bf16;
typedef unsigned v4u __attribute__((ext_vector_type(4)));
typedef unsigned v2u __attribute__((ext_vector_type(2)));
typedef float f32x4 __attribute__((ext_vector_type(4)));
#define LDS_WAIT() asm volatile("s_waitcnt lgkmcnt(0)" ::: "memory")
#define VM_WAIT() asm volatile("s_waitcnt vmcnt(0)" ::: "memory")
typedef float f32x2_pk __attribute__((ext_vector_type(2))); typedef __bf16 bf16x2_pk __attribute__((ext_vector_type(2)));
__device__ __forceinline__ unsigned pk2(float lo, float hi) { f32x2_pk v = {lo, hi}; bf16x2_pk b = __builtin_convertvector(v, bf16x2_pk); return __builtin_bit_cast(unsigned, b); }
__device__ __forceinline__ unsigned f2bf(float f) { return pk2(f, 0.f) & 0xffffu; }
__device__ __forceinline__ float bflo(unsigned w) { return __uint_as_float(w << 16); }
__device__ __forceinline__ float bfhi(unsigned w) { return __uint_as_float(w & 0xffff0000u); }
__device__ __forceinline__ float bf2f(bf16 h) { return __uint_as_float((unsigned)h << 16); }
__device__ __forceinline__ float wave_sum(float v) {
#pragma unroll
    for (int o = 1; o < 64; o <<= 1) v += __shfl_xor(v, o);
    return v;
}
__device__ __forceinline__ float sigm(float x) { return 1.0f / (1.0f + expf(-x)); }
__device__ __forceinline__ float softplusf_(float x) { return fmaxf(x, 0.f) + log1pf(expf(-fabsf(x))); }
__device__ __forceinline__ float gelu_tanh(float x) { return 0.5f * x * (1.0f + tanhf(0.7978845608028654f * (x + 0.044715f * x * x * x))); }

struct Args { const float* in[N_IN]; float* out; unsigned char* ws; int ph_lo, ph_hi; };
#define CAS __attribute__((address_space(4)))
__device__ __forceinline__ const float* kin(int i) { asm volatile("" : "+s"(i)); const CAS char* kp = (const CAS char*)__builtin_amdgcn_kernarg_segment_ptr(); return *(const float* const CAS*)(kp + 8 * i); }
__device__ __forceinline__ float* kout() { int i = N_IN; asm volatile("" : "+s"(i)); const CAS char* kp = (const CAS char*)__builtin_amdgcn_kernarg_segment_ptr(); return *(float* const CAS*)(kp + 8 * i); }
__device__ __forceinline__ unsigned char* kws() { int i = N_IN + 1; asm volatile("" : "+s"(i)); const CAS char* kp = (const CAS char*)__builtin_amdgcn_kernarg_segment_ptr(); return *(unsigned char* const CAS*)(kp + 8 * i); }

struct Frame {
    LAS unsigned char* lds;
    unsigned char* ws;
    unsigned* ctl;
    int tid, lane, wave, G, bid;
};

__device__ __forceinline__ void transpose_load(const float* W, int N, int k0, int n0, int lane, f32x4 (&v)[8]) {
    const int c4 = 4 * (lane & 7), rr = lane >> 3; const bool ok = n0 + c4 + 3 < N;
#pragma unroll
    for (int i = 0; i < 8; ++i) v[i] = ok ? __builtin_nontemporal_load((const f32x4*)(W + (size_t)(k0 + 8 * i + rr) * N + n0 + c4)) : (f32x4){0.f, 0.f, 0.f, 0.f};
}
__device__ __forceinline__ void transpose_store(const f32x4 (&v)[8], int K, bf16* WT, int drow0, LAS float* scr, int k0, int lane) {
    { const int c4 = 4 * (lane & 7), rr = lane >> 3;
#pragma unroll
      for (int i = 0; i < 8; ++i) { LAS float* d = scr + (8 * i + rr) * 33 + c4; d[0] = v[i][0]; d[1] = v[i][1]; d[2] = v[i][2]; d[3] = v[i][3]; } }
    LDS_WAIT(); asm volatile("" ::: "memory");
    const int c = lane & 7;
#pragma unroll
    for (int j = 0; j < 4; ++j) { const int n = (lane >> 3) + 8 * j; const LAS float* s = scr + (8 * c) * 33 + n;
        v4u o; o.x = pk2(s[0 * 33], s[1 * 33]); o.y = pk2(s[2 * 33], s[3 * 33]); o.z = pk2(s[4 * 33], s[5 * 33]); o.w = pk2(s[6 * 33], s[7 * 33]);
        *(v4u*)(WT + (size_t)(drow0 + n) * K + k0 + 8 * c) = o; }
    LDS_WAIT(); asm volatile("" ::: "memory");
}
__device__ __forceinline__ void transpose_item(const float* W, int K, int N, bf16* WT, int drow0, LAS float* scr, int k0, int n0, int lane) {
    f32x4 v[8]; transpose_load(W, N, k0, n0, lane, v); transpose_store(v, K, WT, drow0, scr, k0, lane);
}
__device__ __forceinline__ void transpose_set(Frame& F, const float* W, int nmat, int K, int N, int NP, bf16* WT, int& itbase) {
    LAS float* scr = (LAS float*)(F.lds + RING_OFF + F.wave * 16384);
    const int gw = F.bid * NWAVES + F.wave, NGW = F.G * NWAVES;
    const int nkb = K / 64, nnb = NP / 32, per = nkb * nnb, total = nmat * per;
    int first = (gw - (itbase % NGW) + NGW) % NGW;
    for (int it = first; it < total; it += NGW) { const int mi = it / per, r = it % per, kb = r / nnb, nb = r % nnb;
        transpose_item(W + (size_t)mi * K * N, K, N, WT + (size_t)mi * NP * K, nb * 32, scr, kb * 64, nb * 32, F.lane); }
    itbase += total;
}
__device__ __forceinline__ void prologue_weights(Frame& F) {
 int itb = 0;
    transpose_set(F, kin(I_EV_W_IN), 2, 1024, EVEN_IN, EVEN_INP, (bf16*)(F.ws + WS_W_EVIN), itb);
    transpose_set(F, kin(I_OD_W_IN), 2, 1024, ODD_IN, ODD_INP, (bf16*)(F.ws + WS_W_ODIN), itb);
    transpose_set(F, kin(I_MLA_WQUP), 2, 384, 768, 768, (bf16*)(F.ws + WS_W_QUP), itb);
    transpose_set(F, kin(I_MLA_WKVUP), 2, 256, 1024, 1024, (bf16*)(F.ws + WS_W_KVUP), itb);
    transpose_set(F, kin(I_EV_W_OUT), 2, 1024, 1024, 1024, (bf16*)(F.ws + WS_W_EVOUT), itb);
    transpose_set(F, kin(I_OD_W_OUT), 2, 1024, 1024, 1024, (bf16*)(F.ws + WS_W_ODOUT), itb);
    transpose_set(F, kin(I_S5_WGLU), 2, 512, 512, 512, (bf16*)(F.ws + WS_W_GLU), itb);
    transpose_set(F, kin(I_PLE_WP), 4, 256, 1024, 1024, (bf16*)(F.ws + WS_W_PLEP), itb);
    transpose_set(F, kin(I_PLE_WG), 4, 1024, 1024, 1024, (bf16*)(F.ws + WS_W_PLEG), itb);
}
__device__ __forceinline__ void moe_weights(Frame& F, int layer, int wg0 = 0, int nwg = -1) {
    if (nwg < 0) nwg = F.G; if (F.bid < wg0 || F.bid >= wg0 + nwg) return;
    LAS float* scr = (LAS float*)(F.lds + RING_OFF + F.wave * 16384);
    const int gw = (F.bid - wg0) * NWAVES + F.wave, NGW = nwg * NWAVES;
    const float* wg = kin(I_MOE_WG) + (size_t)layer * 32 * 1024 * 512; const float* wu = kin(I_MOE_WU) + (size_t)layer * 32 * 1024 * 512; const float* wd = kin(I_MOE_WD) + (size_t)layer * 32 * 512 * 1024;
    bf16* WGU = (bf16*)(F.ws + WS_W_MOEGU); bf16* WD = (bf16*)(F.ws + WS_W_MOED);
#define MW_GU(it_, W_, e_, kb_, n0_, drow_) const int which_ = (it_) / (32 * 256), r0_ = (it_) % (32 * 256), e_ = r0_ / 256, r_ = r0_ % 256, kb_ = r_ / 16, n0_ = (r_ % 16) * 32; \
        const int drow_ = 256 * (n0_ / 128) + (n0_ % 128) + which_ * 128; const float* W_ = (which_ ? wu : wg) + (size_t)e_ * 1024 * 512
    { f32x4 v[8]; int it = gw;
      if (it < 2 * 32 * 256) { MW_GU(it, W0, e0, kb0, n00, d0); (void)d0; transpose_load(W0, 512, kb0 * 64, n00, F.lane, v); }
#pragma unroll 1
      for (; it < 2 * 32 * 256; it += NGW) { f32x4 vn[8]; const int itn = it + NGW;
          if (itn < 2 * 32 * 256) { MW_GU(itn, W1, e1, kb1, n01, d1); (void)d1; transpose_load(W1, 512, kb1 * 64, n01, F.lane, vn); }
          { MW_GU(it, W2, e2, kb2, n02, d2); (void)W2; (void)n02; transpose_store(v, 1024, WGU + (size_t)e2 * 1024 * 1024, d2, scr, kb2 * 64, F.lane); }
#pragma unroll
          for (int i = 0; i < 8; ++i) v[i] = vn[i]; } }
#undef MW_GU
    { f32x4 v[8]; int it = gw;
      if (it < 32 * 256) { const int e = it / 256, r = it % 256; transpose_load(wd + (size_t)e * 512 * 1024, 1024, (r / 32) * 64, (r % 32) * 32, F.lane, v); }
#pragma unroll 1
      for (; it < 32 * 256; it += NGW) { f32x4 vn[8]; const int itn = it + NGW;
          if (itn < 32 * 256) { const int e = itn / 256, r = itn % 256; transpose_load(wd + (size_t)e * 512 * 1024, 1024, (r / 32) * 64, (r % 32) * 32, F.lane, vn); }
          { const int e = it / 256, r = it % 256; transpose_store(v, 512, WD + (size_t)e * 1024 * 512, (r % 32) * 32, scr, (r / 32) * 64, F.lane); }
#pragma unroll
          for (int i = 0; i < 8; ++i) v[i] = vn[i]; } }
}

__device__ __forceinline__ void rms_row_to_bf16(const float* xrow, const float* gain, bf16* orow, float* copy, int lane) {
    const f32x4* xr = (const f32x4*)xrow + lane; f32x4 v[4]; float s = 0.f;
#pragma unroll
    for (int j = 0; j < 4; ++j) { v[j] = xr[64 * j]; s += (v[j].x * v[j].x + v[j].y * v[j].y) + (v[j].z * v[j].z + v[j].w * v[j].w); }
    const float r = 1.0f / sqrtf(wave_sum(s) * (1.f / 1024.f) + RMS_EPS);
    if (copy) {
#pragma unroll
        for (int j = 0; j < 4; ++j) ((f32x4*)copy + lane)[64 * j] = v[j]; }
    unsigned long long* o8 = (unsigned long long*)orow + lane;
#pragma unroll
    for (int j = 0; j < 4; ++j) { const f32x4 g = ((const f32x4*)gain + lane)[64 * j];
        o8[64 * j] = (unsigned long long)pk2(v[j].x * r * g.x, v[j].y * r * g.y) | ((unsigned long long)pk2(v[j].z * r * g.z, v[j].w * r * g.w) << 32); }
}
__device__ __forceinline__ void rms_row16_to_bf16(const bf16* xrow, const float* gain, bf16* orow, int lane) {
    float f[16]; float s = 0.f;
#pragma unroll
    for (int j = 0; j < 2; ++j) { const v4u x = ((const v4u*)xrow + lane)[64 * j]; f[8 * j] = bflo(x.x); f[8 * j + 1] = bfhi(x.x); f[8 * j + 2] = bflo(x.y); f[8 * j + 3] = bfhi(x.y); f[8 * j + 4] = bflo(x.z); f[8 * j + 5] = bfhi(x.z); f[8 * j + 6] = bflo(x.w); f[8 * j + 7] = bfhi(x.w); }
#pragma unroll
    for (int i = 0; i < 16; ++i) s += f[i] * f[i];
    const float r = 1.0f / sqrtf(wave_sum(s) * (1.f / 1024.f) + RMS_EPS);
#pragma unroll
    for (int j = 0; j < 2; ++j) { const float* g = gain + 512 * j + 8 * lane; const f32x4 g0 = *(const f32x4*)g, g1 = *(const f32x4*)(g + 4);
        v4u o; o.x = pk2(f[8 * j] * r * g0.x, f[8 * j + 1] * r * g0.y); o.y = pk2(f[8 * j + 2] * r * g0.z, f[8 * j + 3] * r * g0.w); o.z = pk2(f[8 * j + 4] * r * g1.x, f[8 * j + 5] * r * g1.y); o.w = pk2(f[8 * j + 6] * r * g1.z, f[8 * j + 7] * r * g1.w);
        ((v4u*)orow + lane)[64 * j] = o; }
}
__device__ __forceinline__ void phase_norm(Frame& F, const float* x_or_null, const float* gain) {
    bf16* ABF = (bf16*)(F.ws + WS_ABF); bf16* H16 = (bf16*)(F.ws + WS_H16);
    const int gw = F.bid * NWAVES + F.wave, NGW = F.G * NWAVES, lane = F.lane;
    if (x_or_null) {
        for (int m = gw; m < NTOK; m += NGW) { const f32x4* xr = (const f32x4*)(x_or_null + (size_t)m * DM) + lane; f32x4 v[4]; float s = 0.f;
#pragma unroll
            for (int j = 0; j < 4; ++j) { v[j] = xr[64 * j]; s += (v[j].x * v[j].x + v[j].y * v[j].y) + (v[j].z * v[j].z + v[j].w * v[j].w); }
            const float r = 1.0f / sqrtf(wave_sum(s) * (1.f / 1024.f) + RMS_EPS);
            unsigned long long* o8 = (unsigned long long*)(ABF + (size_t)m * DM) + lane; unsigned long long* h8 = (unsigned long long*)(H16 + (size_t)m * DM) + lane;
#pragma unroll
            for (int j = 0; j < 4; ++j) { const f32x4 g = ((const f32x4*)gain + lane)[64 * j];
                h8[64 * j] = (unsigned long long)pk2(v[j].x, v[j].y) | ((unsigned long long)pk2(v[j].z, v[j].w) << 32);
                o8[64 * j] = (unsigned long long)pk2(v[j].x * r * g.x, v[j].y * r * g.y) | ((unsigned long long)pk2(v[j].z * r * g.z, v[j].w * r * g.w) << 32); } }
    } else {
        for (int m = gw; m < NTOK; m += NGW) rms_row16_to_bf16(H16 + (size_t)m * DM, gain, ABF + (size_t)m * DM, lane);
    }
}
__device__ __forceinline__ void phase_pconv(Frame& F, int layer) {
    const float* p = kin(I_P) + (size_t)layer * NTOK * PLE; bf16* PBF = (bf16*)(F.ws + WS_PBF);
    const size_t n4 = (size_t)NTOK * PLE / 4; const size_t gt = (size_t)F.bid * 512 + F.tid, NT = (size_t)F.G * 512;
#pragma unroll 1
    for (size_t i = gt; i < n4; i += 8 * NT) { f32x4 v[8];
#pragma unroll
        for (int q = 0; q < 8; ++q) { const size_t ix = i + q * NT; v[q] = __builtin_nontemporal_load((const f32x4*)p + (ix < n4 ? ix : i)); }
#pragma unroll
        for (int q = 0; q < 8; ++q) { const size_t ix = i + q * NT; if (ix < n4) { v2u o; o.x = pk2(v[q].x, v[q].y); o.y = pk2(v[q].z, v[q].w); ((v2u*)PBF)[ix] = o; } } }
}

__device__ __forceinline__ void phase_even_post(Frame& F, int j, bool dry = false) {

    bf16* PROJ = (bf16*)(F.ws + WS_PROJ); bf16* CQN = (bf16*)(F.ws + WS_CQN); bf16* CKVN = (bf16*)(F.ws + WS_CKVN); float* LOGF = (float*)(F.ws + WS_LOGF);
    const float* qn = kin(I_FOX_QN) + j * 64; const float* kn = kin(I_FOX_KN) + j * 64; const float* bfv = kin(I_FOX_BF) + j * 8;
    const float* qan = kin(I_MLA_QAN) + j * 384; const float* kvan = kin(I_MLA_KVAN) + j * 256;
    const int gw = F.bid * NWAVES + F.wave, NGW = F.G * NWAVES, lane = F.lane;
    float gq_[8], gk_[8], gqa[6], gkv[4];
#pragma unroll
    for (int i = 0; i < 8; ++i) { gq_[i] = qn[(lane & 7) * 8 + i]; gk_[i] = kn[(lane & 7) * 8 + i]; }
#pragma unroll
    for (int i = 0; i < 3; ++i) { gqa[2 * i] = qan[2 * (lane + 64 * i)]; gqa[2 * i + 1] = qan[2 * (lane + 64 * i) + 1]; }
#pragma unroll
    for (int i = 0; i < 2; ++i) { gkv[2 * i] = kvan[2 * (lane + 64 * i)]; gkv[2 * i + 1] = kvan[2 * (lane + 64 * i) + 1]; }
    const float bfl = bfv[lane & 7];
#pragma unroll 1
    for (int m = gw; m < NTOK; m += NGW) {
        bf16* row = PROJ + (size_t)m * EVEN_INP;
        v4u* pq = (v4u*)(row + E_FQ) + lane; v4u* pk = (v4u*)(row + E_FK) + lane;
        const v4u xq = *pq, xk = *pk; const bf16 zl = row[E_FLOG + (lane & 7)];
        unsigned xc[3], xv[2];
#pragma unroll
        for (int i = 0; i < 3; ++i) xc[i] = *((const unsigned*)(row + E_CQ) + lane + 64 * i);
#pragma unroll
        for (int i = 0; i < 2; ++i) xv[i] = *((const unsigned*)(row + E_CKV) + lane + 64 * i);
        asm volatile("" : "+v"(xc[0]), "+v"(xc[1]), "+v"(xc[2]), "+v"(xv[0]), "+v"(xv[1]));
#pragma unroll
        for (int w = 0; w < 2; ++w) {
            const v4u x = w ? xk : xq;
            float f[8] = {bflo(x.x), bfhi(x.x), bflo(x.y), bfhi(x.y), bflo(x.z), bfhi(x.z), bflo(x.w), bfhi(x.w)};
            float s = 0.f;
#pragma unroll
            for (int i = 0; i < 8; ++i) s += f[i] * f[i];
            s += __shfl_xor(s, 1); s += __shfl_xor(s, 2); s += __shfl_xor(s, 4);
            const float r = (1.0f / sqrtf(s * (1.f / 64.f) + RMS_EPS)) * (w ? 1.0f : C2_FOX); const float* g = w ? gk_ : gq_;
            v4u o; o.x = pk2(f[0] * r * g[0], f[1] * r * g[1]); o.y = pk2(f[2] * r * g[2], f[3] * r * g[3]); o.z = pk2(f[4] * r * g[4], f[5] * r * g[5]); o.w = pk2(f[6] * r * g[6], f[7] * r * g[7]);
            *(dry ? (v4u*)(F.ws + WS_DUMMY) + (size_t)m * 128 + w * 64 + lane : (w ? pk : pq)) = o;
        }
        if (lane < 8) { const float z = bf2f(zl) + bfl; LOGF[(size_t)m * 8 + lane] = -softplusf_(-z); }
        {
            float f[6]; float s = 0.f;
#pragma unroll
            for (int i = 0; i < 3; ++i) { const unsigned x = xc[i]; f[2 * i] = bflo(x); f[2 * i + 1] = bfhi(x); s += f[2 * i] * f[2 * i] + f[2 * i + 1] * f[2 * i + 1]; }
            const float r = 1.0f / sqrtf(wave_sum(s) * (1.f / 384.f) + RMS_EPS);
#pragma unroll
            for (int i = 0; i < 3; ++i) { *((unsigned*)(CQN + (size_t)m * 384) + lane + 64 * i) = pk2(f[2 * i] * r * gqa[2 * i], f[2 * i + 1] * r * gqa[2 * i + 1]); }
        }
        {
            float f[4]; float s = 0.f;
#pragma unroll
            for (int i = 0; i < 2; ++i) { const unsigned x = xv[i]; f[2 * i] = bflo(x); f[2 * i + 1] = bfhi(x); s += f[2 * i] * f[2 * i] + f[2 * i + 1] * f[2 * i + 1]; }
            const float r = 1.0f / sqrtf(wave_sum(s) * (1.f / 256.f) + RMS_EPS);
#pragma unroll
            for (int i = 0; i < 2; ++i) { *((unsigned*)(CKVN + (size_t)m * 256) + lane + 64 * i) = pk2(f[2 * i] * r * gkv[2 * i], f[2 * i + 1] * r * gkv[2 * i + 1]); }
        }
    }
}
__device__ __forceinline__ void phase_cumsum(Frame& F) {
    if (F.bid >= 16) return;
    const float* LOGF = (const float*)(F.ws + WS_LOGF); float* CUM = (float*)(F.ws + WS_CUM);
    const int b = F.bid >> 3, h = F.bid & 7, t0 = F.tid * 32;
    LAS double* part = (LAS double*)(F.lds + RING_OFF);
    float v[32]; double s = 0.0;
#pragma unroll
    for (int i = 0; i < 32; ++i) { v[i] = LOGF[((size_t)b * SEQ + t0 + i) * 8 + h]; s += (double)v[i]; }
    part[F.tid] = s; __syncthreads();
    if (F.wave == 0) { double loc[8], run = 0.0;
#pragma unroll
        for (int i = 0; i < 8; ++i) { loc[i] = part[F.lane * 8 + i]; run += loc[i]; }
        double inc = run;
#pragma unroll
        for (int off = 1; off < 64; off <<= 1) { const double t = __shfl_up(inc, off); if (F.lane >= off) inc += t; }
        double ex = inc - run;
#pragma unroll
        for (int i = 0; i < 8; ++i) { part[F.lane * 8 + i] = ex; ex += loc[i]; } }
    __syncthreads();
    double run = part[F.tid];
#pragma unroll
    for (int i = 0; i < 32; ++i) { run += (double)v[i]; CUM[((size_t)b * SEQ + t0 + i) * 8 + h] = (float)run; }
    __syncthreads();
}
__device__ __forceinline__ void phase_mla_post(Frame& F, int j, bool dry = false) {

    const bf16* PROJ = (const bf16*)(F.ws + WS_PROJ); bf16* QM = (bf16*)(F.ws + WS_QM); const bf16* KVB = (const bf16*)(F.ws + WS_KVB); bf16* KM = (bf16*)(F.ws + WS_KM);
    const float* qn = kin(I_MLA_QN) + j * 96; const float* kn = kin(I_MLA_KN) + j * 96; const int* pos = (const int*)kin(I_POS);
    const int gw = F.bid * NWAVES + F.wave, NGW = F.G * NWAVES, lane = F.lane, l32 = lane & 31, hh = lane >> 5;
    const int fi = l32 & 15; const float inv = expf(-(float)fi * (1.0f / 16.0f) * 9.210340371976184f);
    const float gq0 = qn[l32], gq1 = qn[l32 + 32], gq2 = qn[l32 + 64], gk0 = kn[l32], gk1 = kn[l32 + 32], gk2 = kn[l32 + 64];
#pragma unroll 1
    for (int m = gw; m < NTOK; m += NGW) {
        const int pm = pos[m];
        const bf16 kr = PROJ[(size_t)m * EVEN_INP + E_KROPE + l32];
        bf16 xq[4][3], xk[4][2];
#pragma unroll
        for (int hp = 0; hp < 4; ++hp) { const int h = hp * 2 + hh; const bf16* q = QM + (size_t)m * 768 + h * 96; const bf16* k = KVB + (size_t)m * 1024 + h * 128;
            xq[hp][0] = q[l32]; xq[hp][1] = q[l32 + 32]; xq[hp][2] = q[l32 + 64]; xk[hp][0] = k[l32]; xk[hp][1] = k[l32 + 32]; }
        const float ang = (float)pm * inv; float sn, cs; sincosf(ang, &sn, &cs);
        const float krope = bf2f(kr);
#pragma unroll
        for (int hp = 0; hp < 4; ++hp) { const int h = hp * 2 + hh;
#pragma unroll
            for (int w = 0; w < 2; ++w) {
                float f[3];
                if (w == 0) { f[0] = bf2f(xq[hp][0]); f[1] = bf2f(xq[hp][1]); f[2] = bf2f(xq[hp][2]); }
                else { f[0] = bf2f(xk[hp][0]); f[1] = bf2f(xk[hp][1]); f[2] = krope; }
                float s = f[0] * f[0] + f[1] * f[1] + f[2] * f[2];
                s += __shfl_xor(s, 1); s += __shfl_xor(s, 2); s += __shfl_xor(s, 4); s += __shfl_xor(s, 8); s += __shfl_xor(s, 16);
                const float r = 1.0f / sqrtf(s * (1.f / 96.f) + RMS_EPS);
                f[0] *= r * (w ? gk0 : gq0); f[1] *= r * (w ? gk1 : gq1); f[2] *= r * (w ? gk2 : gq2);
                const float other = __shfl_xor(f[2], 16);
                const float rot = (l32 < 16) ? (f[2] * cs - other * sn) : (other * sn + f[2] * cs);
                bf16* o = (w ? KM : (dry ? (bf16*)(F.ws + WS_DUMMY) : QM)) + (size_t)m * 768 + h * 96; const float qs = w ? 1.0f : C2_MLA;
                o[l32] = (bf16)f2bf(f[0] * qs); o[l32 + 32] = (bf16)f2bf(f[1] * qs); o[l32 + 64] = (bf16)f2bf(rot * qs);
            }
        }
    }
}
template <int DK> __device__ __forceinline__ void attn_naive_unit(Frame& F, const bf16* Qp, int qld, const bf16* Kp, int kld, const bf16* Vp, int vld, const float* cum  , float scale, bf16* Op, int qb) {
    LAS float* Ks = (LAS float*)(F.lds + RING_OFF); LAS float* Vs = Ks + 64 * DK; LAS float* Cs = Vs + 64 * 64;
    const int t = qb * 512 + F.wave * 64 + F.lane; const int tmax_w = qb * 512 + F.wave * 64 + 63;
    float q[DK];
#pragma unroll
    for (int d = 0; d < DK; d += 8) { const v4u x = *(const v4u*)(Qp + (size_t)t * qld + d);
        q[d] = bflo(x.x) * scale; q[d + 1] = bfhi(x.x) * scale; q[d + 2] = bflo(x.y) * scale; q[d + 3] = bfhi(x.y) * scale; q[d + 4] = bflo(x.z) * scale; q[d + 5] = bfhi(x.z) * scale; q[d + 6] = bflo(x.w) * scale; q[d + 7] = bfhi(x.w) * scale; }
    const float cq = cum ? cum[(size_t)t * 8] : 0.f;
    float acc[64];
#pragma unroll
    for (int d = 0; d < 64; ++d) acc[d] = 0.f;
    float mx = -1e30f, l = 0.f;
    const int nkb = (qb * 512 + 512) / 64;
    for (int kb = 0; kb < nkb; ++kb) {
        __syncthreads();
        for (int i = F.tid; i < 64 * DK / 8; i += 512) { const int key = i / (DK / 8), c = (i % (DK / 8)) * 8; const v4u x = *(const v4u*)(Kp + (size_t)(kb * 64 + key) * kld + c);
            LAS float* d = Ks + key * DK + c; d[0] = bflo(x.x); d[1] = bfhi(x.x); d[2] = bflo(x.y); d[3] = bfhi(x.y); d[4] = bflo(x.z); d[5] = bfhi(x.z); d[6] = bflo(x.w); d[7] = bfhi(x.w); }
        { const int i = F.tid; const int key = i / 8, c = (i % 8) * 8; const v4u x = *(const v4u*)(Vp + (size_t)(kb * 64 + key) * vld + c);
            LAS float* d = Vs + key * 64 + c; d[0] = bflo(x.x); d[1] = bfhi(x.x); d[2] = bflo(x.y); d[3] = bfhi(x.y); d[4] = bflo(x.z); d[5] = bfhi(x.z); d[6] = bflo(x.w); d[7] = bfhi(x.w); }
        if (F.tid < 64) Cs[F.tid] = cum ? cum[(size_t)(kb * 64 + F.tid) * 8] : 0.f;
        __syncthreads();
        if (kb * 64 > tmax_w) continue;
        for (int jk = 0; jk < 64; ++jk) {
            const int s = kb * 64 + jk; if (s > tmax_w) break;
            const LAS float* kr = Ks + jk * DK; float dot = 0.f;
#pragma unroll
            for (int d = 0; d < DK; d += 4) { const f32x4 kv = *(const LAS f32x4*)(kr + d); dot += q[d] * kv.x + q[d + 1] * kv.y + q[d + 2] * kv.z + q[d + 3] * kv.w; }
            float logit = dot + (cq - Cs[jk]); if (s > t) logit = -1e30f;
            if (__any(logit > mx)) { const float mn = fmaxf(mx, logit); const float corr = expf(mx - mn); l *= corr;
#pragma unroll
                for (int d = 0; d < 64; ++d) acc[d] *= corr;
                mx = mn; }
            const float p = (s > t) ? 0.f : expf(logit - mx); l += p;
            const LAS float* vr = Vs + jk * 64;
#pragma unroll
            for (int d = 0; d < 64; d += 4) { const f32x4 vv = *(const LAS f32x4*)(vr + d); acc[d] += p * vv.x; acc[d + 1] += p * vv.y; acc[d + 2] += p * vv.z; acc[d + 3] += p * vv.w; }
        }
    }
    const float il = 1.0f / l; bf16* o = Op + (size_t)t * DM;
#pragma unroll
    for (int d = 0; d < 64; d += 8) { v4u w; w.x = pk2(acc[d] * il, acc[d + 1] * il); w.y = pk2(acc[d + 2] * il, acc[d + 3] * il); w.z = pk2(acc[d + 4] * il, acc[d + 5] * il); w.w = pk2(acc[d + 6] * il, acc[d + 7] * il); *(v4u*)(o + d) = w; }
}
__device__ __forceinline__ void phase_attn_naive(Frame& F) {
    const bf16* PROJ = (const bf16*)(F.ws + WS_PROJ); const bf16* QM = (const bf16*)(F.ws + WS_QM); const bf16* KVB = (const bf16*)(F.ws + WS_KVB); const bf16* KM = (const bf16*)(F.ws + WS_KM);
    const float* CUM = (const float*)(F.ws + WS_CUM); bf16* MIX = (bf16*)(F.ws + WS_MIX);
    for (int p = F.bid; p < 512; p += F.G) {
        const int combo = p >> 4, qq = p & 15; const int type = combo >> 4, b = (combo >> 3) & 1, h = combo & 7;
#pragma unroll 1
        for (int half = 0; half < 2; ++half) { const int qb = half ? 31 - qq : qq; const size_t rb = (size_t)b * SEQ;
            if (type == 0) attn_naive_unit<64>(F, PROJ + rb * EVEN_INP + E_FQ + h * 64, EVEN_INP, PROJ + rb * EVEN_INP + E_FK + h * 64, EVEN_INP, PROJ + rb * EVEN_INP + E_FV + h * 64, EVEN_INP, CUM + rb * 8 + h, LN2, MIX + rb * DM + h * 64, qb);
            else attn_naive_unit<96>(F, QM + rb * 768 + h * 96, 768, KM + rb * 768 + h * 96, 768, KVB + rb * 1024 + h * 128 + 64, 1024, nullptr, LN2, MIX + rb * DM + 512 + h * 64, qb);
        }
    }
    __syncthreads();
}

__device__ __forceinline__ void s5_scan_wave(Frame& F, int j, int b, int g) {
 const int p = F.lane;
    const bf16* PROJ = (const bf16*)(F.ws + WS_PROJ); bf16* HG = (bf16*)(F.ws + WS_HG);
    const float lr = fminf(kin(I_S5_ARE)[(j * 32 + g) * 64 + p], -1e-4f), li = kin(I_S5_AIM)[(j * 32 + g) * 64 + p];
    const float dt = expf(kin(I_S5_LS)[j * 32 + g]);
    const float mag = expf(lr * dt); const float abr = mag * cosf(li * dt), abi = mag * sinf(li * dt);
    const float den = lr * lr + li * li, nr = abr - 1.0f, ni = abi;
    const float gr = (nr * lr + ni * li) / den, gi = (ni * lr - nr * li) / den;
    float bbr[16], bbi[16], cr[16], ci[16], dsk[16];
#pragma unroll
    for (int c = 0; c < 16; ++c) { const float br = kin(I_S5_BRE)[((size_t)(j * 32 + g) * 64 + p) * 16 + c], bi = kin(I_S5_BIM)[((size_t)(j * 32 + g) * 64 + p) * 16 + c];
        bbr[c] = gr * br - gi * bi; bbi[c] = gr * bi + gi * br;
        cr[c] = kin(I_S5_CRE)[((size_t)(j * 32 + g) * 16 + c) * 64 + p]; ci[c] = kin(I_S5_CIM)[((size_t)(j * 32 + g) * 16 + c) * 64 + p];
        dsk[c] = kin(I_S5_D)[j * 512 + g * 16 + c]; }
    float xr = 0.f, xi = 0.f;
    const bf16* up = PROJ + (size_t)b * SEQ * ODD_INP + O_U + g * 16;
    v4u cur0[4], cur1[4], nx0[4], nx1[4];
#pragma unroll
    for (int i = 0; i < 4; ++i) { cur0[i] = *(const v4u*)(up + (size_t)i * ODD_INP); cur1[i] = *(const v4u*)(up + (size_t)i * ODD_INP + 8); }
    for (int t0 = 0; t0 < SEQ; t0 += 4) {
        const int tn = (t0 + 4 < SEQ) ? t0 + 4 : t0;
#pragma unroll
        for (int i = 0; i < 4; ++i) { nx0[i] = *(const v4u*)(up + (size_t)(tn + i) * ODD_INP); nx1[i] = *(const v4u*)(up + (size_t)(tn + i) * ODD_INP + 8); }
#pragma unroll
        for (int i = 0; i < 4; ++i) {
            float u[16] = {bflo(cur0[i].x), bfhi(cur0[i].x), bflo(cur0[i].y), bfhi(cur0[i].y), bflo(cur0[i].z), bfhi(cur0[i].z), bflo(cur0[i].w), bfhi(cur0[i].w),
                           bflo(cur1[i].x), bfhi(cur1[i].x), bflo(cur1[i].y), bfhi(cur1[i].y), bflo(cur1[i].z), bfhi(cur1[i].z), bflo(cur1[i].w), bfhi(cur1[i].w)};
            float bur = 0.f, bui = 0.f;
#pragma unroll
            for (int c = 0; c < 16; ++c) { bur += bbr[c] * u[c]; bui += bbi[c] * u[c]; }
            const float nxr = abr * xr - abi * xi + bur, nxi = abr * xi + abi * xr + bui; xr = nxr; xi = nxi;
            float y[16];
#pragma unroll
            for (int c = 0; c < 16; ++c) y[c] = wave_sum(cr[c] * xr - ci[c] * xi);
            if (p < 16) { float yy = 0.f, uu = 0.f, dd = 0.f;
#pragma unroll
                for (int c = 0; c < 16; ++c) if (p == c) { yy = y[c]; uu = u[c]; dd = dsk[c]; }
                HG[((size_t)b * SEQ + t0 + i) * 512 + g * 16 + p] = (bf16)f2bf(gelu_tanh(yy + dd * uu)); }
        }
#pragma unroll
        for (int i = 0; i < 4; ++i) { cur0[i] = nx0[i]; cur1[i] = nx1[i]; }
    }
}
__device__ __forceinline__ void gdn_prep_token(Frame& F, int j, int m) {
 const int lane = F.lane;
    const bf16* PROJ = (const bf16*)(F.ws + WS_PROJ); float* QG = (float*)(F.ws + WS_QG); float* KG = (float*)(F.ws + WS_KG); float* VG = (float*)(F.ws + WS_VG);
    float* GB = (float*)(F.ws + WS_GB); float* BETA = (float*)(F.ws + WS_BETA);
    const float* cw = kin(I_GDN_CONV) + (size_t)j * 4 * 1536;
    const int s = m % SEQ;
#pragma unroll
    for (int w = 0; w < 3; ++w) {
        const int ch0 = w * 512 + lane * 8; float acc[8];
#pragma unroll
        for (int i = 0; i < 8; ++i) acc[i] = 0.f;
#pragma unroll
        for (int tap = 0; tap < 4; ++tap) { const int ss = s - 3 + tap; if (ss < 0) continue;
            const v4u x = *(const v4u*)(PROJ + (size_t)(m - 3 + tap) * ODD_INP + O_Q + ch0); const float* wv = cw + tap * 1536 + ch0;
            acc[0] += wv[0] * bflo(x.x); acc[1] += wv[1] * bfhi(x.x); acc[2] += wv[2] * bflo(x.y); acc[3] += wv[3] * bfhi(x.y); acc[4] += wv[4] * bflo(x.z); acc[5] += wv[5] * bfhi(x.z); acc[6] += wv[6] * bflo(x.w); acc[7] += wv[7] * bfhi(x.w); }
        float ss2 = 0.f;
#pragma unroll
        for (int i = 0; i < 8; ++i) { acc[i] = acc[i] * sigm(acc[i]); ss2 += acc[i] * acc[i]; }
        float sc = 1.0f;
        if (w < 2) { ss2 += __shfl_xor(ss2, 1); ss2 += __shfl_xor(ss2, 2); ss2 += __shfl_xor(ss2, 4); ss2 += __shfl_xor(ss2, 8); sc = 1.0f / sqrtf(ss2 + RMS_EPS); if (w == 0) sc *= 0.08838834764831845f; }
        float* dst = (w == 0 ? QG : (w == 1 ? KG : VG)) + (size_t)m * 512 + lane * 8;
        *(f32x4*)dst = (f32x4){acc[0] * sc, acc[1] * sc, acc[2] * sc, acc[3] * sc}; *(f32x4*)(dst + 4) = (f32x4){acc[4] * sc, acc[5] * sc, acc[6] * sc, acc[7] * sc};
    }
    if (lane < 4) { const float gin = bf2f(PROJ[(size_t)m * ODD_INP + O_GIN + lane]), bin = bf2f(PROJ[(size_t)m * ODD_INP + O_BETA + lane]);
        GB[(size_t)m * 4 + lane] = -expf(kin(I_GDN_ALOG)[j * 4 + lane]) * softplusf_(gin + kin(I_GDN_DTB)[j * 4 + lane]); BETA[(size_t)m * 4 + lane] = sigm(bin); }
}
__device__ __forceinline__ void phase_gdn_prep(Frame& F, int j) {
    const int gw = F.bid * NWAVES + F.wave, NGW = F.G * NWAVES;
    for (int m = gw; m < NTOK; m += NGW) gdn_prep_token(F, j, m);
}
__device__ __forceinline__ void phase_odd_a(Frame& F, int j) {
    if (F.wave == 0 && F.bid < 64) { s5_scan_wave(F, j, F.bid >> 5, F.bid & 31); return; }
    const int nbusy = (F.G < 64 ? F.G : 64);
    const int widx = (F.bid < 64) ? F.bid * 7 + (F.wave - 1) : nbusy * 7 + (F.bid - 64) * 8 + F.wave;
    const int nw = nbusy * 7 + (F.G > 64 ? (F.G - 64) * 8 : 0);
    for (int m = widx; m < NTOK; m += nw) gdn_prep_token(F, j, m);
}
__device__ __forceinline__ void phase_gdn_naive(Frame& F) {
    const float* QG = (const float*)(F.ws + WS_QG); const float* KG = (const float*)(F.ws + WS_KG); const float* VG = (const float*)(F.ws + WS_VG);
    const float* GB = (const float*)(F.ws + WS_GB); const float* BETA = (const float*)(F.ws + WS_BETA); float* OG = (float*)(F.ws + WS_OG);
    const int lane = F.lane; const int NGW = F.G * NWAVES;
    for (int u = F.wave * F.G + F.bid; u < 1024; u += NGW) {
        const int b = u >> 9, h = (u >> 7) & 3, c = u & 127; const size_t rb = (size_t)b * SEQ;
        const float* kq = KG + rb * 512 + h * 128 + lane; const float* qq = QG + rb * 512 + h * 128 + lane; const float* vq = VG + rb * 512 + h * 128 + c;
        const float* gq = GB + rb * 4 + h; const float* bq = BETA + rb * 4 + h; float* oq = OG + rb * 512 + h * 128 + c;
        float s0 = 0.f, s1 = 0.f;
        float k0[8], k1[8], q0[8], q1[8], vv[8], gg[8], bb[8], nk0[8], nk1[8], nq0[8], nq1[8], nv[8], ng[8], nb[8];
#pragma unroll
        for (int i = 0; i < 8; ++i) { k0[i] = kq[(size_t)i * 512]; k1[i] = kq[(size_t)i * 512 + 64]; q0[i] = qq[(size_t)i * 512]; q1[i] = qq[(size_t)i * 512 + 64]; vv[i] = vq[(size_t)i * 512]; gg[i] = gq[i * 4]; bb[i] = bq[i * 4]; }
        for (int t0 = 0; t0 < SEQ; t0 += 8) {
            const int tn = (t0 + 8 < SEQ) ? t0 + 8 : t0;
#pragma unroll
            for (int i = 0; i < 8; ++i) { const size_t o = (size_t)(tn + i) * 512; nk0[i] = kq[o]; nk1[i] = kq[o + 64]; nq0[i] = qq[o]; nq1[i] = qq[o + 64]; nv[i] = vq[o]; ng[i] = gq[(tn + i) * 4]; nb[i] = bq[(tn + i) * 4]; }
#pragma unroll
            for (int i = 0; i < 8; ++i) {
                const float ks = wave_sum(k0[i] * s0 + k1[i] * s1); const float eg = expf(gg[i]); const float be = bb[i];
                s0 = eg * (s0 - be * k0[i] * ks) + be * k0[i] * vv[i]; s1 = eg * (s1 - be * k1[i] * ks) + be * k1[i] * vv[i];
                const float o = wave_sum(q0[i] * s0 + q1[i] * s1);
                if (lane == 0) oq[(size_t)(t0 + i) * 512] = o;
            }
#pragma unroll
            for (int i = 0; i < 8; ++i) { k0[i] = nk0[i]; k1[i] = nk1[i]; q0[i] = nq0[i]; q1[i] = nq1[i]; vv[i] = nv[i]; gg[i] = ng[i]; bb[i] = nb[i]; }
        }
    }
}
__device__ __forceinline__ void phase_gdn_out(Frame& F, int j) {
 const float* OG = (const float*)(F.ws + WS_OG); const bf16* PROJ = (const bf16*)(F.ws + WS_PROJ); bf16* MIX = (bf16*)(F.ws + WS_MIX);
    const float* on = kin(I_GDN_ONORM) + j * 128; const int lane = F.lane;
    const int gw = F.bid * NWAVES + F.wave, NGW = F.G * NWAVES;
    for (int m = gw; m < NTOK; m += NGW) {
        const f32x4 a = *(const f32x4*)(OG + (size_t)m * 512 + lane * 8), b = *(const f32x4*)(OG + (size_t)m * 512 + lane * 8 + 4);
        float f[8] = {a.x, a.y, a.z, a.w, b.x, b.y, b.z, b.w}; float s = 0.f;
#pragma unroll
        for (int i = 0; i < 8; ++i) s += f[i] * f[i];
        s += __shfl_xor(s, 1); s += __shfl_xor(s, 2); s += __shfl_xor(s, 4); s += __shfl_xor(s, 8);
        const float r = 1.0f / sqrtf(s * (1.f / 128.f) + RMS_EPS);
        const bf16* z = PROJ + (size_t)m * ODD_INP + O_Z + lane * 8; const float* g = on + (lane & 15) * 8; float o[8];
#pragma unroll
        for (int i = 0; i < 8; ++i) { const float zz = bf2f(z[i]); o[i] = f[i] * r * g[i] * (zz * sigm(zz)); }
        v4u w; w.x = pk2(o[0], o[1]); w.y = pk2(o[2], o[3]); w.z = pk2(o[4], o[5]); w.w = pk2(o[6], o[7]);
        *(v4u*)(MIX + (size_t)m * DM + 512 + lane * 8) = w;
    }
}

__device__ __forceinline__ void phase_router(Frame& F, int layer, bool dry = false) {
 const float* H = kout(); bf16* ABF = (bf16*)(F.ws + WS_ABF);
    const float* gain = kin(I_NORM_FFN) + layer * DM; const float* wgr = kin(I_MOE_WGRP) + (size_t)layer * DM * 4; const float* bgr = kin(I_MOE_BGRP) + layer * 4;
    const float* wex = kin(I_MOE_WEXP) + (size_t)layer * DM * 32; const float* bex = kin(I_MOE_BEXP) + layer * 32;
    int* TOKE = (int*)(F.ws + WS_TOKE); float* TOKW = (float*)(F.ws + WS_TOKW);
    LAS int* lcnt = (LAS int*)(F.lds + LDSCTL_OFF + LC_MOE + 512); LAS int* gbase = (LAS int*)(F.lds + LDSCTL_OFF + LC_MOE + 640);
    const int lane = F.lane; const int per = NTOK / F.G;
    LAS int* lasg = (LAS int*)(F.lds + RING_OFF);
    if (F.tid < 32) lcnt[F.tid] = 0;
    __syncthreads();
    for (int tl = F.wave; tl < per; tl += NWAVES) {
        const int m = F.bid * per + tl;
        const f32x4* xr = (const f32x4*)(H + (size_t)m * DM) + lane; f32x4 v[4]; float s = 0.f;
#pragma unroll
        for (int q = 0; q < 4; ++q) { v[q] = xr[64 * q]; s += (v[q].x * v[q].x + v[q].y * v[q].y) + (v[q].z * v[q].z + v[q].w * v[q].w); }
        const float r = 1.0f / sqrtf(wave_sum(s) * (1.f / 1024.f) + RMS_EPS);
        unsigned long long* o8 = (unsigned long long*)(ABF + (size_t)m * DM) + lane;
#pragma unroll
        for (int q = 0; q < 4; ++q) { const f32x4 g = ((const f32x4*)gain + lane)[64 * q]; v[q].x *= r * g.x; v[q].y *= r * g.y; v[q].z *= r * g.z; v[q].w *= r * g.w;
            o8[64 * q] = (unsigned long long)pk2(v[q].x, v[q].y) | ((unsigned long long)pk2(v[q].z, v[q].w) << 32); }
        float lg[4] = {0.f, 0.f, 0.f, 0.f};
#pragma unroll
        for (int q = 0; q < 4; ++q) { const int k0 = 4 * lane + 256 * q;
#pragma unroll
            for (int e = 0; e < 4; ++e) { const f32x4 w = *(const f32x4*)(wgr + (size_t)(k0 + e) * 4); const float x = v[q][e]; lg[0] += x * w.x; lg[1] += x * w.y; lg[2] += x * w.z; lg[3] += x * w.w; } }
#pragma unroll
        for (int g = 0; g < 4; ++g) lg[g] = wave_sum(lg[g]) + bgr[g];
        int gi = 0; float gm = lg[0];
#pragma unroll
        for (int g = 1; g < 4; ++g) if (lg[g] > gm) { gm = lg[g]; gi = g; }
        float gden = 0.f;
#pragma unroll
        for (int g = 0; g < 4; ++g) gden += expf(lg[g] - gm);
        const float gw_ = 1.0f / gden;
        float le[8] = {0.f, 0.f, 0.f, 0.f, 0.f, 0.f, 0.f, 0.f};
#pragma unroll
        for (int q = 0; q < 4; ++q) { const int k0 = 4 * lane + 256 * q;
#pragma unroll
            for (int e = 0; e < 4; ++e) { const float* wp = wex + (size_t)(k0 + e) * 32 + gi * 8; const f32x4 w0 = *(const f32x4*)wp, w1 = *(const f32x4*)(wp + 4); const float x = v[q][e];
                le[0] += x * w0.x; le[1] += x * w0.y; le[2] += x * w0.z; le[3] += x * w0.w; le[4] += x * w1.x; le[5] += x * w1.y; le[6] += x * w1.z; le[7] += x * w1.w; } }
#pragma unroll
        for (int e = 0; e < 8; ++e) le[e] = wave_sum(le[e]) + bex[gi * 8 + e];
        int i0 = 0; float m0 = le[0];
#pragma unroll
        for (int e = 1; e < 8; ++e) if (le[e] > m0) { m0 = le[e]; i0 = e; }
        int i1 = -1; float m1 = -3.0e38f;
#pragma unroll
        for (int e = 0; e < 8; ++e) if (e != i0 && le[e] > m1) { m1 = le[e]; i1 = e; }
        const float e1 = expf(m1 - m0); const float w0 = gw_ / (1.0f + e1), w1 = gw_ * e1 / (1.0f + e1);
        if (lane == 0 && !dry) { const int ea = gi * 8 + i0, eb = gi * 8 + i1;
            const int pa = __hip_atomic_fetch_add(lcnt + ea, 1, __ATOMIC_RELAXED, __HIP_MEMORY_SCOPE_WORKGROUP), pb = __hip_atomic_fetch_add(lcnt + eb, 1, __ATOMIC_RELAXED, __HIP_MEMORY_SCOPE_WORKGROUP);
            lasg[tl * 2] = ea | (pa << 8); lasg[tl * 2 + 1] = eb | (pb << 8);
            TOKW[(size_t)m * 2] = w0; TOKW[(size_t)m * 2 + 1] = w1; }
    }
    __syncthreads();
    if (dry) return;
    if (F.tid < 32) gbase[F.tid] = (int)__hip_atomic_fetch_add(F.ctl + CW_CNT + 64 * layer + F.tid, (unsigned)lcnt[F.tid], __ATOMIC_RELAXED, __HIP_MEMORY_SCOPE_AGENT);
    __syncthreads();
    for (int i = F.tid; i < per * 2; i += 512) { const int a = lasg[i], e = a & 255, lp = a >> 8; TOKE[(size_t)F.bid * per * 2 + i] = e | ((gbase[e] + lp) << 8); }
    __syncthreads();
}
__device__ __forceinline__ void moe_tables(Frame& F, int layer) {
    LAS int* rowbase = (LAS int*)(F.lds + LDSCTL_OFF + LC_MOE); LAS unsigned char* tile_e = (LAS unsigned char*)(F.lds + LDSCTL_OFF + LC_MOE + 192);
    if (F.tid == 0) { int rb = 0;
#pragma unroll 1
        for (int e = 0; e < 32; ++e) { const int c = (int)__hip_atomic_load(F.ctl + CW_CNT + 64 * layer + e, __ATOMIC_RELAXED, __HIP_MEMORY_SCOPE_AGENT); rowbase[e] = rb; rowbase[224 + e] = c;   const int nt = (c + 255) >> 8;
            for (int i = 0; i < nt; ++i) tile_e[(rb >> 8) + i] = (unsigned char)e; rb += nt << 8; }
        rowbase[32] = rb; rowbase[34] = rb >> 8; }
    __syncthreads();
}
__device__ __forceinline__ void phase_moe_scatter(Frame& F, int layer) {
    moe_tables(F, layer);
    const LAS int* rowbase = (const LAS int*)(F.lds + LDSCTL_OFF + LC_MOE);
    const bf16* ABF = (const bf16*)(F.ws + WS_ABF); bf16* XG = (bf16*)(F.ws + WS_XG); const int* TOKE = (const int*)(F.ws + WS_TOKE); int* ROWS = (int*)(F.ws + WS_ROWS);
    const int gw = F.bid * NWAVES + F.wave, NGW = F.G * NWAVES, lane = F.lane;
    for (int m = gw; m < NTOK; m += NGW) {
        const v4u a = *((const v4u*)(ABF + (size_t)m * DM) + lane), b = *((const v4u*)(ABF + (size_t)m * DM) + 64 + lane);
#pragma unroll
        for (int k = 0; k < 2; ++k) { const int te = TOKE[(size_t)m * 2 + k]; const int row = rowbase[te & 255] + (te >> 8);
            *((v4u*)(XG + (size_t)row * DM) + lane) = a; *((v4u*)(XG + (size_t)row * DM) + 64 + lane) = b;
            if (lane == 0) ROWS[(size_t)m * 2 + k] = row; }
    }
}
struct MoeOrder {
    int ntiles, nN, G, c; const LAS unsigned char* tile_e; size_t bstride;
    __device__ bool next(int i, pg8::Unit& u) const { const long L = (long)i * G + c; if (L >= (long)ntiles * nN) return false; u.pm = (int)(L / nN); u.pn = (int)(L % nN); u.aux = __builtin_amdgcn_readfirstlane((int)tile_e[u.pm]); return true; }
    __device__ __forceinline__ const char* a_base(const pg8::Gemm& g, const pg8::Unit& u) const { return (const char*)g.A + (size_t)u.pm * 256 * g.lda * 2; }
    __device__ __forceinline__ const char* b_base(const pg8::Gemm& g, const pg8::Unit& u) const { return (const char*)g.Bt + (size_t)u.aux * bstride + (size_t)u.pn * 256 * g.ldb * 2; }
};
struct MoeGatherOrder {
    int ntiles, nN, G, c; const LAS unsigned char* tile_e; const LAS int* rowbase; const int* p2t; size_t bstride;
    __device__ bool next(int i, pg8::Unit& u) const { const long L = (long)i * G + c; if (L >= (long)ntiles * nN) return false; u.pm = (int)(L / nN); u.pn = (int)(L % nN); u.aux = __builtin_amdgcn_readfirstlane((int)tile_e[u.pm]); return true; }
    __device__ __forceinline__ unsigned a_row(const pg8::Unit& u, int r) const { const int e = u.aux; const int pos = 256 * u.pm - rowbase[e] + r; const int cnt = rowbase[224 + e];
        return pos < cnt ? (unsigned)(p2t[(size_t)e * NTOK + pos] >> 1) : 0u; }
    __device__ __forceinline__ const char* b_base(const pg8::Gemm& g, const pg8::Unit& u) const { return (const char*)g.Bt + (size_t)u.aux * bstride + (size_t)u.pn * 256 * g.ldb * 2; }
};
__device__ __forceinline__ void phase_moe_combine(Frame& F, int layer, bool dry = false) {
    moe_tables(F, layer); const LAS int* rowbase = (const LAS int*)(F.lds + LDSCTL_OFF + LC_MOE); const int* TOKE = (const int*)(F.ws + WS_TOKE);
    const bf16* H = (const bf16*)(F.ws + WS_H16); bf16* Ho = dry ? (bf16*)(F.ws + WS_DUMMY) : (bf16*)(F.ws + WS_H16); bf16* ABF = (bf16*)(F.ws + WS_ABF); const bf16* Y2 = (const bf16*)(F.ws + WS_Y2);
    const float* TOKW = (const float*)(F.ws + WS_TOKW); const float* gain = kin(I_PLE_NORM) + layer * DM;
    const int gw = F.bid * NWAVES + F.wave, NGW = F.G * NWAVES, lane = F.lane;
    f32x4 gq[4];
#pragma unroll
    for (int j = 0; j < 2; ++j) { gq[2 * j] = *(const f32x4*)(gain + 512 * j + 8 * lane); gq[2 * j + 1] = *(const f32x4*)(gain + 512 * j + 8 * lane + 4); }
    int te0 = 0, te1 = 0; float w0 = 0.f, w1 = 0.f;
    if (gw < NTOK) { te0 = TOKE[(size_t)gw * 2]; te1 = TOKE[(size_t)gw * 2 + 1]; w0 = TOKW[(size_t)gw * 2]; w1 = TOKW[(size_t)gw * 2 + 1]; }
#pragma unroll 1
    for (int m = gw; m < NTOK; m += NGW) {
        const int r0 = rowbase[te0 & 255] + (te0 >> 8), r1 = rowbase[te1 & 255] + (te1 >> 8); const float cw0 = w0, cw1 = w1;
        const int mn = (m + NGW < NTOK) ? m + NGW : m;
        te0 = TOKE[(size_t)mn * 2]; te1 = TOKE[(size_t)mn * 2 + 1]; w0 = TOKW[(size_t)mn * 2]; w1 = TOKW[(size_t)mn * 2 + 1];
        v4u hx[2], ya[2], yb[2];
#pragma unroll
        for (int j = 0; j < 2; ++j) { hx[j] = ((const v4u*)(H + (size_t)m * DM) + lane)[64 * j]; ya[j] = ((const v4u*)(Y2 + (size_t)r0 * DM) + lane)[64 * j]; yb[j] = ((const v4u*)(Y2 + (size_t)r1 * DM) + lane)[64 * j]; }
        float v[16]; float s = 0.f;
#pragma unroll
        for (int j = 0; j < 2; ++j) {
            v[8 * j + 0] = bflo(hx[j].x) + cw0 * bflo(ya[j].x) + cw1 * bflo(yb[j].x); v[8 * j + 1] = bfhi(hx[j].x) + cw0 * bfhi(ya[j].x) + cw1 * bfhi(yb[j].x);
            v[8 * j + 2] = bflo(hx[j].y) + cw0 * bflo(ya[j].y) + cw1 * bflo(yb[j].y); v[8 * j + 3] = bfhi(hx[j].y) + cw0 * bfhi(ya[j].y) + cw1 * bfhi(yb[j].y);
            v[8 * j + 4] = bflo(hx[j].z) + cw0 * bflo(ya[j].z) + cw1 * bflo(yb[j].z); v[8 * j + 5] = bfhi(hx[j].z) + cw0 * bfhi(ya[j].z) + cw1 * bfhi(yb[j].z);
            v[8 * j + 6] = bflo(hx[j].w) + cw0 * bflo(ya[j].w) + cw1 * bflo(yb[j].w); v[8 * j + 7] = bfhi(hx[j].w) + cw0 * bfhi(ya[j].w) + cw1 * bfhi(yb[j].w); }
        v4u hw[2];
#pragma unroll
        for (int j = 0; j < 2; ++j) { hw[j].x = pk2(v[8 * j], v[8 * j + 1]); hw[j].y = pk2(v[8 * j + 2], v[8 * j + 3]); hw[j].z = pk2(v[8 * j + 4], v[8 * j + 5]); hw[j].w = pk2(v[8 * j + 6], v[8 * j + 7]);
            v[8 * j] = bflo(hw[j].x); v[8 * j + 1] = bfhi(hw[j].x); v[8 * j + 2] = bflo(hw[j].y); v[8 * j + 3] = bfhi(hw[j].y); v[8 * j + 4] = bflo(hw[j].z); v[8 * j + 5] = bfhi(hw[j].z); v[8 * j + 6] = bflo(hw[j].w); v[8 * j + 7] = bfhi(hw[j].w); }
#pragma unroll
        for (int i = 0; i < 16; ++i) s += v[i] * v[i];
        const float r = 1.0f / sqrtf(wave_sum(s) * (1.f / 1024.f) + RMS_EPS);
#pragma unroll
        for (int j = 0; j < 2; ++j) { ((v4u*)(Ho + (size_t)m * DM) + lane)[64 * j] = hw[j]; const f32x4 g0 = gq[2 * j], g1 = gq[2 * j + 1];
            v4u o; o.x = pk2(v[8 * j] * r * g0.x, v[8 * j + 1] * r * g0.y); o.y = pk2(v[8 * j + 2] * r * g0.z, v[8 * j + 3] * r * g0.w); o.z = pk2(v[8 * j + 4] * r * g1.x, v[8 * j + 5] * r * g1.y); o.w = pk2(v[8 * j + 6] * r * g1.z, v[8 * j + 7] * r * g1.w);
            ((v4u*)(ABF + (size_t)m * DM) + lane)[64 * j] = o; }
    }
}
namespace att {
using bf16x8 = __attribute__((ext_vector_type(8))) short;
using s16x4 = __attribute__((ext_vector_type(4))) short;
using f32x16 = __attribute__((ext_vector_type(16))) float;
using u32x4 = __attribute__((ext_vector_type(4))) unsigned;
typedef float f32x2_t __attribute__((ext_vector_type(2))); typedef __bf16 bf16x2_t __attribute__((ext_vector_type(2)));
constexpr int KSLOT = 16384, VSLOT = 8192;
constexpr int L_K = 0, L_V = 2 * KSLOT, L_B = L_V + 3 * VSLOT, L_WS = L_B + 1024, L_OST = L_WS + 8 * 256, L_BYTES = L_OST + 8 * 4096;
__device__ __forceinline__ int crow(int r, int hi) { return (r & 3) + 8 * (r >> 2) + 4 * hi; }
__device__ __forceinline__ void glds16(const void* gsrc, unsigned lds_dst) { unsigned keep;
    asm volatile("s_mov_b32 %0, m0\n\ts_mov_b32 m0, %2\n\ts_nop 0\n\tglobal_load_lds_dwordx4 %1, off\n\ts_mov_b32 m0, %0" : "=&s"(keep) : "v"(gsrc), "s"(lds_dst) : "memory"); }
__device__ __forceinline__ unsigned cvtpk(float lo, float hi) { f32x2_t v = {lo, hi}; bf16x2_t b = __builtin_convertvector(v, bf16x2_t); return __builtin_bit_cast(unsigned, b); }
__device__ __forceinline__ float max3f(float a, float b, float c) { float r; asm("v_max3_f32 %0, %1, %2, %3" : "=v"(r) : "v"(a), "v"(b), "v"(c)); return r; }
__device__ __forceinline__ float max2f(float a, float b) { float r; asm("v_max_f32_e32 %0, %1, %2" : "=v"(r) : "v"(a), "v"(b)); return r; }
#define ATT_SUBI(x, d) asm volatile("v_sub_f32_e32 %0, %0, %1" : "+v"(x) : "v"(d))
#define ATT_WAIT_BAR() asm volatile("s_waitcnt vmcnt(0) lgkmcnt(0)\n\ts_barrier" ::: "memory")

}

namespace att {
#define A2_SB() __builtin_amdgcn_sched_barrier(0)
#define A2_PIN(x) asm volatile("" : "+v"(x))
template <int K, int PER> __device__ __forceinline__ void a2_chunk(const f32x16& p0, const f32x16& p1, f32x2_t& s2, u32x4 (&pw)[4]) {
#pragma unroll
    for (int i = K * PER; i < (K + 1) * PER && i < 32; ++i) { const int j = i & 15;
        const float a = (j < 8) ? p0[2 * j] : p1[2 * (j - 8)], b = (j < 8) ? p0[2 * j + 1] : p1[2 * (j - 8) + 1];
        if (i < 16) { if (i == 0) { s2[0] = a; s2[1] = b; } else { s2[0] += a; s2[1] += b; } }
        else pw[j >> 2][j & 3] = cvtpk(a, b); }
}
template <int DK, bool BIAS>
__device__ __forceinline__ void attn_unit2(const int tid_in, const int qb, const bf16* Qh, const int qp, const bf16* Kh, const int kp, const bf16* Vh, const int vp, const float* cumh, bf16* Oh, char* shm, const float skip_margin) {
    constexpr int ND = DK / 16, KCH = DK / 8, NM = 2 * ND, PER = (32 + NM - 1) / NM;
    int tid = tid_in; asm volatile("" : "+v"(tid));
    const int lane = tid & 63, r32 = lane & 31, hi = lane >> 5; const int wid = __builtin_amdgcn_readfirstlane(tid >> 6);
    const int q0 = qb * 256;
    const unsigned lds0 = (unsigned)(uintptr_t)shm;
    float* wsf = (float*)(shm + L_WS) + wid * 64;
    float* Bs = (float*)(shm + L_B);
    const bf16* ksrc = Kh + (size_t)lane * kp + wid * 8;
    const bf16* vsrc = Vh + (size_t)(16 * (wid & 3) + (lane >> 2)) * vp + (wid >> 2) * 32 + (lane & 3) * 8;
    const unsigned kdst = lds0 + L_K + wid * 1024, vdst = lds0 + L_V + wid * 1024;
    const int NT = (q0 + 256) / 64;
    const float cref = BIAS ? cumh[(size_t)q0 * 8] : 0.f;
    int T0 = 0;
    if (BIAS) {
        float cend[4];
#pragma unroll
        for (int k = 0; k < 4; ++k) { const int tq = 64 * k + lane; cend[k] = cumh[(size_t)(64 * (tq < NT ? tq : NT - 1) + 63) * 8]; }
        T0 = NT - 4;
#pragma unroll
        for (int k = 3; k >= 0; --k) { const int tq = 64 * k + lane; const bool ok = (tq < NT) && ((cref - cend[k]) * 1.4426950408889634f + skip_margin >= -150.0f);
            const unsigned long long mk = __ballot(ok); if (mk) T0 = 64 * k + (int)__builtin_ctzll(mk); }
        T0 = __builtin_amdgcn_readfirstlane(T0); if (T0 > NT - 4) T0 = NT - 4; }
#define A2_DMAK(t) do { const int t_ = (t); glds16(ksrc + (size_t)t_ * 64 * kp, (unsigned)__builtin_amdgcn_readfirstlane(kdst + (t_ & 1) * KSLOT)); \
        if (KCH > 8 && wid < KCH - 8) glds16(ksrc + (size_t)t_ * 64 * kp + 64, (unsigned)__builtin_amdgcn_readfirstlane(kdst + (t_ & 1) * KSLOT + 8192)); } while (0)
#define A2_DMAV(t) do { const int t_ = (t); glds16(vsrc + (size_t)t_ * 64 * vp, (unsigned)__builtin_amdgcn_readfirstlane(vdst + (t_ % 3) * VSLOT)); } while (0)
#define A2_ISSUE(k) do { if ((k) + 1 < NT) A2_DMAK((k) + 1); A2_DMAV(k); } while (0)
    A2_DMAK(T0);
    if (BIAS && wid == 0) Bs[(T0 & 1) * 64 + lane] = (cref - cumh[(size_t)(T0 * 64 + lane) * 8]) * 1.4426950408889634f;
    bf16x8 qr[ND];
#pragma unroll
    for (int d0 = 0; d0 < ND; ++d0) qr[d0] = *reinterpret_cast<const bf16x8*>(Qh + (size_t)(q0 + wid * 32 + r32) * qp + d0 * 16 + hi * 8);
    bf16x8 kfa[4], kfb[4];
    float mhat = 0.f, l_reg = 0.f; f32x16 o[2]; o[0] = f32x16{}; o[1] = f32x16{}; f32x16 negm = f32x16{};
    f32x16 cA0 = f32x16{}, cA1 = f32x16{}, cB0 = f32x16{}, cB1 = f32x16{};
    const int qrel = wid * 32 + r32;
    const int vb0 = (int)(lds0 + L_V) + ((lane >> 4) & 1) * 32 + (lane & 3) * 8 + (4 * hi + ((lane & 15) >> 2)) * 64;
    ATT_WAIT_BAR();
#pragma unroll
    for (int d0 = 0; d0 < ND; ++d0) A2_PIN(qr[d0]);
#define A2_KRDB(dst, base, off) asm volatile("ds_read_b128 %0, %1 offset:%c2" : "=&v"(dst) : "v"(base), "i"(off) : "memory")
#define A2_KRD(dst, off) A2_KRDB(dst, ka_, off)
#define A2_POST(k) do { if ((k) + 1 < NT) { A2_ISSUE((k) + 1); const unsigned kn_ = lds0 + L_K + (((k) + 1) & 1) * KSLOT + hi * 1024 + r32 * 16; \
        A2_KRDB(kfa[0], kn_, 0); A2_KRDB(kfa[1], kn_, 512); A2_KRDB(kfa[2], kn_, 2048); A2_KRDB(kfa[3], kn_, 2560); \
        A2_KRDB(kfb[0], kn_, 4096); A2_KRDB(kfb[1], kn_, 4608); A2_KRDB(kfb[2], kn_, 6144); A2_KRDB(kfb[3], kn_, 6656); } } while (0)
#define A2_VRD(s, i) do { asm volatile("ds_read_b64_tr_b16 %0,%1 offset:%c2" : "=&v"(vlo[s]) : "v"(vb_), "i"(((i) >> 2) * 4096 + ((i) & 3) * 1024) : "memory"); \
        asm volatile("ds_read_b64_tr_b16 %0,%1 offset:%c2" : "=&v"(vhi[s]) : "v"(vb_), "i"(((i) >> 2) * 4096 + ((i) & 3) * 1024 + 512) : "memory"); } while (0)
#define A2_VFR(i) (bf16x8){vlo[i][0], vlo[i][1], vlo[i][2], vlo[i][3], vhi[i][0], vhi[i][1], vhi[i][2], vhi[i][3]}
#define A2_BMM(C0, C1, tt_, RM) do { const int tt = (tt_); \
        if (BIAS) { const float* bb = Bs + (tt & 1) * 64 + 4 * hi; \
            _Pragma("unroll") for (int g = 0; g < 4; ++g) { const f32x4 x0 = *(const f32x4*)(bb + 8 * g), x1 = *(const f32x4*)(bb + 32 + 8 * g); \
                _Pragma("unroll") for (int e = 0; e < 4; ++e) { C0[4 * g + e] += x0[e]; C1[4 * g + e] += x1[e]; } } } \
        if (tt >= NT - 4) { const int kb0 = 64 * (tt - (NT - 4)) + 4 * hi; \
            _Pragma("unroll") for (int r = 0; r < 16; ++r) { const int kv = kb0 + (r & 3) + 8 * (r >> 2); if (kv > qrel) C0[r] = -INFINITY; if (kv + 32 > qrel) C1[r] = -INFINITY; } } \
        { float a_ = max3f(C0[0], C0[1], C1[0]), b_ = max3f(C0[2], C0[3], C1[1]); a_ = max3f(a_, C1[2], C1[3]); \
          _Pragma("unroll") for (int r = 4; r < 16; r += 4) { a_ = max3f(a_, C0[r], C0[r + 1]); b_ = max3f(b_, C0[r + 2], C0[r + 3]); a_ = max3f(a_, C1[r], C1[r + 1]); b_ = max3f(b_, C1[r + 2], C1[r + 3]); } \
          RM = max2f(a_, b_); auto rr = __builtin_amdgcn_permlane32_swap(__float_as_uint(RM), __float_as_uint(RM), false, false); RM = max2f(__uint_as_float(rr[0]), __uint_as_float(rr[1])); } } while (0)
    { A2_ISSUE(T0);
      float bnext = 0.f; if (BIAS && wid == 0 && T0 + 1 < NT) bnext = cumh[(size_t)((T0 + 1) * 64 + lane) * 8];
      const unsigned ka_ = lds0 + L_K + (T0 & 1) * KSLOT + hi * 1024 + r32 * 16;
#pragma unroll
      for (int d0 = 0; d0 < ND; ++d0) { bf16x8 k0, k1; A2_KRD(k0, d0 * 2048); A2_KRD(k1, d0 * 2048 + 512); asm volatile("s_waitcnt lgkmcnt(0)" : "+v"(k0), "+v"(k1) :: "memory"); A2_SB();
          if (d0 == 0) { cA0 = __builtin_amdgcn_mfma_f32_32x32x16_bf16(k0, qr[0], negm, 0, 0, 0); cA1 = __builtin_amdgcn_mfma_f32_32x32x16_bf16(k1, qr[0], negm, 0, 0, 0); }
          else { cA0 = __builtin_amdgcn_mfma_f32_32x32x16_bf16(k0, qr[d0], cA0, 0, 0, 0); cA1 = __builtin_amdgcn_mfma_f32_32x32x16_bf16(k1, qr[d0], cA1, 0, 0, 0); } }
      asm volatile("s_nop 15\n\ts_nop 7" : "+v"(cA0), "+v"(cA1));
      float rm; A2_BMM(cA0, cA1, T0, rm);
      mhat = rm;
#pragma unroll
      for (int r = 0; r < 16; ++r) { ATT_SUBI(cA0[r], rm); ATT_SUBI(cA1[r], rm); }
#pragma unroll
      for (int r = 0; r < 16; ++r) negm[r] = -mhat;
#pragma unroll
      for (int r = 0; r < 16; ++r) { cA0[r] = __builtin_amdgcn_exp2f(cA0[r]); cA1[r] = __builtin_amdgcn_exp2f(cA1[r]); }
      if (BIAS && wid == 0 && T0 + 1 < NT) Bs[((T0 + 1) & 1) * 64 + lane] = (cref - bnext) * 1.4426950408889634f;
      ATT_WAIT_BAR(); A2_POST(T0); }
#define A2_STEP(C0, C1, P0, P1, t_) do { const int t = (t_); \
        float bnext = 0.f; if (BIAS && wid == 0 && t + 1 < NT) bnext = cumh[(size_t)((t + 1) * 64 + lane) * 8]; \
        const unsigned ka_ = lds0 + L_K + (t & 1) * KSLOT + hi * 1024 + r32 * 16; const int vb_ = vb0 + ((t - 1) % 3) * VSLOT; \
        s16x4 vlo[4], vhi[4]; u32x4 pw[4]; f32x2_t sacc = {0.f, 0.f}; \
          \
        asm volatile("s_waitcnt lgkmcnt(0)" : "+v"(kfa[0]), "+v"(kfa[1]), "+v"(kfa[2]), "+v"(kfa[3]) :: "memory"); asm volatile("" : "+v"(kfb[0]), "+v"(kfb[1]), "+v"(kfb[2]), "+v"(kfb[3])); A2_SB();     \
        C0 = __builtin_amdgcn_mfma_f32_32x32x16_bf16(kfa[0], qr[0], negm, 0, 0, 0); A2_VRD(0, 0); a2_chunk<0, PER>(P0, P1, sacc, pw); A2_PIN(sacc); A2_SB(); \
        C1 = __builtin_amdgcn_mfma_f32_32x32x16_bf16(kfa[1], qr[0], negm, 0, 0, 0); A2_VRD(1, 4); a2_chunk<1, PER>(P0, P1, sacc, pw); A2_PIN(sacc); A2_SB(); \
        C0 = __builtin_amdgcn_mfma_f32_32x32x16_bf16(kfa[2], qr[1], C0, 0, 0, 0);   A2_VRD(2, 1); a2_chunk<2, PER>(P0, P1, sacc, pw); A2_PIN(sacc); A2_SB(); \
        C1 = __builtin_amdgcn_mfma_f32_32x32x16_bf16(kfa[3], qr[1], C1, 0, 0, 0);                 a2_chunk<3, PER>(P0, P1, sacc, pw); A2_PIN(sacc); A2_SB(); \
        if (ND > 4) { A2_KRD(kfa[0], 8192); A2_KRD(kfa[1], 8704); A2_KRD(kfa[2], 10240); A2_KRD(kfa[3], 10752); } \
        asm volatile("s_waitcnt lgkmcnt(%c0)" :: "i"(ND > 4 ? 10 : 6) : "memory"); A2_SB();     \
        C0 = __builtin_amdgcn_mfma_f32_32x32x16_bf16(kfb[0], qr[2], C0, 0, 0, 0);   A2_VRD(3, 5); a2_chunk<4, PER>(P0, P1, sacc, pw); A2_PIN(sacc); A2_SB(); \
        C1 = __builtin_amdgcn_mfma_f32_32x32x16_bf16(kfb[1], qr[2], C1, 0, 0, 0);                 a2_chunk<5, PER>(P0, P1, sacc, pw); A2_PIN(sacc); A2_SB(); \
        C0 = __builtin_amdgcn_mfma_f32_32x32x16_bf16(kfb[2], qr[3], C0, 0, 0, 0);                 a2_chunk<6, PER>(P0, P1, sacc, pw); A2_PIN(sacc); A2_SB(); \
        C1 = __builtin_amdgcn_mfma_f32_32x32x16_bf16(kfb[3], qr[3], C1, 0, 0, 0);                 a2_chunk<7, PER>(P0, P1, sacc, pw); A2_PIN(sacc); A2_SB(); \
        if (ND > 4) { asm volatile("s_waitcnt lgkmcnt(2)" ::: "memory"); A2_SB();               \
            C0 = __builtin_amdgcn_mfma_f32_32x32x16_bf16(kfa[0], qr[ND > 4 ? 4 : 0], C0, 0, 0, 0); a2_chunk<8, PER>(P0, P1, sacc, pw); A2_PIN(sacc); A2_SB(); \
            C1 = __builtin_amdgcn_mfma_f32_32x32x16_bf16(kfa[1], qr[ND > 4 ? 4 : 0], C1, 0, 0, 0); a2_chunk<9, PER>(P0, P1, sacc, pw); A2_PIN(sacc); A2_SB(); \
            C0 = __builtin_amdgcn_mfma_f32_32x32x16_bf16(kfa[2], qr[ND > 4 ? 5 : 0], C0, 0, 0, 0); a2_chunk<10, PER>(P0, P1, sacc, pw); A2_PIN(sacc); A2_SB(); \
            C1 = __builtin_amdgcn_mfma_f32_32x32x16_bf16(kfa[3], qr[ND > 4 ? 5 : 0], C1, 0, 0, 0); a2_chunk<11, PER>(P0, P1, sacc, pw); A2_PIN(sacc); A2_SB(); } \
        l_reg += sacc[0] + sacc[1]; \
          \
        asm volatile("s_nop 15\n\ts_nop 7" : "+v"(C0), "+v"(C1));     \
        float rm; A2_BMM(C0, C1, t, rm); bool resc = false; \
        if (__any(rm > 8.0f)) { const float dl = fmaxf(rm, 0.f); mhat += dl; \
            _Pragma("unroll") for (int r = 0; r < 16; ++r) { ATT_SUBI(C0[r], dl); ATT_SUBI(C1[r], dl); } \
            _Pragma("unroll") for (int r = 0; r < 16; ++r) negm[r] = -mhat; \
            const float f = __builtin_amdgcn_exp2f(-dl); l_reg *= f; if (hi == 0) wsf[r32] = f; resc = true; } \
        if (BIAS && wid == 0 && t + 1 < NT) Bs[((t + 1) & 1) * 64 + lane] = (cref - bnext) * 1.4426950408889634f; \
        ATT_WAIT_BAR(); A2_SB(); A2_POST(t); A2_SB();     \
          \
          \
        o[0] = __builtin_amdgcn_mfma_f32_32x32x16_bf16(__builtin_bit_cast(bf16x8, pw[0]), A2_VFR(0), o[0], 0, 0, 0); A2_VRD(0, 2); C0[0] = __builtin_amdgcn_exp2f(C0[0]); C0[1] = __builtin_amdgcn_exp2f(C0[1]); C0[2] = __builtin_amdgcn_exp2f(C0[2]); C0[3] = __builtin_amdgcn_exp2f(C0[3]); A2_PIN(C0); A2_SB(); \
        o[1] = __builtin_amdgcn_mfma_f32_32x32x16_bf16(__builtin_bit_cast(bf16x8, pw[0]), A2_VFR(1), o[1], 0, 0, 0); A2_VRD(1, 6); C0[4] = __builtin_amdgcn_exp2f(C0[4]); C0[5] = __builtin_amdgcn_exp2f(C0[5]); C0[6] = __builtin_amdgcn_exp2f(C0[6]); C0[7] = __builtin_amdgcn_exp2f(C0[7]); A2_PIN(C0); A2_SB(); \
        o[0] = __builtin_amdgcn_mfma_f32_32x32x16_bf16(__builtin_bit_cast(bf16x8, pw[1]), A2_VFR(2), o[0], 0, 0, 0); A2_VRD(2, 3); C0[8] = __builtin_amdgcn_exp2f(C0[8]); C0[9] = __builtin_amdgcn_exp2f(C0[9]); C0[10] = __builtin_amdgcn_exp2f(C0[10]); C0[11] = __builtin_amdgcn_exp2f(C0[11]); A2_PIN(C0); A2_SB(); \
        o[1] = __builtin_amdgcn_mfma_f32_32x32x16_bf16(__builtin_bit_cast(bf16x8, pw[1]), A2_VFR(3), o[1], 0, 0, 0); asm volatile("s_waitcnt lgkmcnt(12)" ::: "memory"); A2_VRD(3, 7); C0[12] = __builtin_amdgcn_exp2f(C0[12]); C0[13] = __builtin_amdgcn_exp2f(C0[13]); C0[14] = __builtin_amdgcn_exp2f(C0[14]); C0[15] = __builtin_amdgcn_exp2f(C0[15]); A2_PIN(C0); A2_SB(); \
        asm volatile("s_waitcnt lgkmcnt(6)" ::: "memory"); A2_SB(); o[0] = __builtin_amdgcn_mfma_f32_32x32x16_bf16(__builtin_bit_cast(bf16x8, pw[2]), A2_VFR(0), o[0], 0, 0, 0); C1[0] = __builtin_amdgcn_exp2f(C1[0]); C1[1] = __builtin_amdgcn_exp2f(C1[1]); C1[2] = __builtin_amdgcn_exp2f(C1[2]); C1[3] = __builtin_amdgcn_exp2f(C1[3]); A2_PIN(C1); A2_SB(); \
        asm volatile("s_waitcnt lgkmcnt(4)" ::: "memory"); A2_SB(); o[1] = __builtin_amdgcn_mfma_f32_32x32x16_bf16(__builtin_bit_cast(bf16x8, pw[2]), A2_VFR(1), o[1], 0, 0, 0); C1[4] = __builtin_amdgcn_exp2f(C1[4]); C1[5] = __builtin_amdgcn_exp2f(C1[5]); C1[6] = __builtin_amdgcn_exp2f(C1[6]); C1[7] = __builtin_amdgcn_exp2f(C1[7]); A2_PIN(C1); A2_SB(); \
        asm volatile("s_waitcnt lgkmcnt(2)" ::: "memory"); A2_SB(); o[0] = __builtin_amdgcn_mfma_f32_32x32x16_bf16(__builtin_bit_cast(bf16x8, pw[3]), A2_VFR(2), o[0], 0, 0, 0); C1[8] = __builtin_amdgcn_exp2f(C1[8]); C1[9] = __builtin_amdgcn_exp2f(C1[9]); C1[10] = __builtin_amdgcn_exp2f(C1[10]); C1[11] = __builtin_amdgcn_exp2f(C1[11]); A2_PIN(C1); A2_SB(); \
        asm volatile("s_waitcnt lgkmcnt(0)" ::: "memory"); A2_SB(); o[1] = __builtin_amdgcn_mfma_f32_32x32x16_bf16(__builtin_bit_cast(bf16x8, pw[3]), A2_VFR(3), o[1], 0, 0, 0); C1[12] = __builtin_amdgcn_exp2f(C1[12]); C1[13] = __builtin_amdgcn_exp2f(C1[13]); C1[14] = __builtin_amdgcn_exp2f(C1[14]); C1[15] = __builtin_amdgcn_exp2f(C1[15]); A2_PIN(C1); A2_SB(); \
        if (resc) { asm volatile("s_waitcnt lgkmcnt(0)" ::: "memory"); \
            _Pragma("unroll") for (int d_ = 0; d_ < 2; ++d_) _Pragma("unroll") for (int r = 0; r < 16; ++r) o[d_][r] *= wsf[crow(r, hi)]; } \
        } while (0)
#define A2_DRAIN(P0, P1) do { const int vb_ = vb0 + ((NT - 1) % 3) * VSLOT; s16x4 vlo[4], vhi[4]; u32x4 pw[4]; f32x2_t sacc = {0.f, 0.f}; \
        A2_VRD(0, 0); A2_VRD(1, 4); A2_VRD(2, 1); A2_VRD(3, 5); \
        a2_chunk<0, 32>(P0, P1, sacc, pw); l_reg += sacc[0] + sacc[1]; \
        asm volatile("s_waitcnt lgkmcnt(0)" ::: "memory"); A2_SB(); \
        o[0] = __builtin_amdgcn_mfma_f32_32x32x16_bf16(__builtin_bit_cast(bf16x8, pw[0]), A2_VFR(0), o[0], 0, 0, 0); o[1] = __builtin_amdgcn_mfma_f32_32x32x16_bf16(__builtin_bit_cast(bf16x8, pw[0]), A2_VFR(1), o[1], 0, 0, 0); \
        o[0] = __builtin_amdgcn_mfma_f32_32x32x16_bf16(__builtin_bit_cast(bf16x8, pw[1]), A2_VFR(2), o[0], 0, 0, 0); o[1] = __builtin_amdgcn_mfma_f32_32x32x16_bf16(__builtin_bit_cast(bf16x8, pw[1]), A2_VFR(3), o[1], 0, 0, 0); A2_SB(); \
        A2_VRD(0, 2); A2_VRD(1, 6); A2_VRD(2, 3); A2_VRD(3, 7); asm volatile("s_waitcnt lgkmcnt(0)" ::: "memory"); A2_SB(); \
        o[0] = __builtin_amdgcn_mfma_f32_32x32x16_bf16(__builtin_bit_cast(bf16x8, pw[2]), A2_VFR(0), o[0], 0, 0, 0); o[1] = __builtin_amdgcn_mfma_f32_32x32x16_bf16(__builtin_bit_cast(bf16x8, pw[2]), A2_VFR(1), o[1], 0, 0, 0); \
        o[0] = __builtin_amdgcn_mfma_f32_32x32x16_bf16(__builtin_bit_cast(bf16x8, pw[3]), A2_VFR(2), o[0], 0, 0, 0); o[1] = __builtin_amdgcn_mfma_f32_32x32x16_bf16(__builtin_bit_cast(bf16x8, pw[3]), A2_VFR(3), o[1], 0, 0, 0); } while (0)
    { int tl = T0 + 1;
#pragma unroll 1
      for (; tl + 1 < NT; tl += 2) { A2_STEP(cB0, cB1, cA0, cA1, tl); A2_STEP(cA0, cA1, cB0, cB1, tl + 1); }
      if (tl < NT) { A2_STEP(cB0, cB1, cA0, cA1, tl); A2_DRAIN(cB0, cB1); } else { A2_DRAIN(cA0, cA1); } }
#undef A2_STEP
#undef A2_DRAIN
#undef A2_BMM
#undef A2_KRD
#undef A2_VRD
#undef A2_VFR
#undef A2_DMAK
#undef A2_DMAV
#undef A2_ISSUE
#undef A2_POST
#undef A2_KRDB
    { auto rr = __builtin_amdgcn_permlane32_swap(__float_as_uint(l_reg), __float_as_uint(l_reg), false, false); l_reg = __uint_as_float(rr[0]) + __uint_as_float(rr[1]); }
    if (hi == 0) wsf[32 + r32] = l_reg; asm volatile("s_waitcnt lgkmcnt(0)" ::: "memory");
    float rli[16];
#pragma unroll
    for (int r = 0; r < 16; ++r) rli[r] = __builtin_amdgcn_rcpf(wsf[32 + crow(r, hi)]);
    bf16* Ow = Oh + (size_t)(q0 + wid * 32) * DM;
    { bf16* stg = (bf16*)(shm + L_OST) + wid * 2048;
#pragma unroll
      for (int r = 0; r < 16; ++r) { const int orow = crow(r, hi);
#pragma unroll
        for (int d0 = 0; d0 < 2; ++d0) stg[orow * 64 + d0 * 32 + r32] = (bf16)f2bf(o[d0][r] * rli[r]); }
      asm volatile("s_waitcnt lgkmcnt(0)" ::: "memory");
#pragma unroll
      for (int i = 0; i < 4; ++i) { const int row = i * 8 + (lane >> 3), ch = lane & 7; const u32x4 v = *(const u32x4*)(stg + row * 64 + ch * 8); *(u32x4*)(Ow + (size_t)row * DM + ch * 8) = v; } }
    asm volatile("s_waitcnt lgkmcnt(0)\n\ts_barrier" ::: "memory");
}
#undef A2_SB
#undef A2_PIN
}
#ifndef ATTN_V2
#define ATT_UNIT att::attn_unit
#define ATT_UNIT_FOX att::attn_unit
#elif ATTN_V2 == 2
#define ATT_UNIT att::attn_unit2
#define ATT_UNIT_FOX att::attn_unit
#elif ATTN_V2 == 3
#define ATT_UNIT att::attn_unit
#define ATT_UNIT_FOX att::attn_unit2
#else
#define ATT_UNIT att::attn_unit2
#define ATT_UNIT_FOX att::attn_unit2
#endif
constexpr int CW_AQ = 2048;
__device__ __forceinline__ void phase_attn_mfma(Frame& F, int j) {
    const bf16* PROJ = (const bf16*)(F.ws + WS_PROJ); const bf16* QM = (const bf16*)(F.ws + WS_QM); const bf16* KVB = (const bf16*)(F.ws + WS_KVB); const bf16* KM = (const bf16*)(F.ws + WS_KM);
    const float* CUM = (const float*)(F.ws + WS_CUM); bf16* MIX = (bf16*)(F.ws + WS_MIX);
    char* shm = (char*)(F.lds + RING_OFF);
    LAS int* qslot = (LAS int*)(F.lds + LDSCTL_OFF + 64);
    { const int xcd0 = (int)(xb_xcc_id() & 7u);
#pragma unroll 1
      for (int dq = 0; dq < 8; ++dq) { const int xcd = (xcd0 + dq) & 7;
#pragma unroll 1
        for (;;) {
          if (F.tid == 0) *qslot = (int)__hip_atomic_fetch_add(F.ctl + CW_AQ + 1024 + (j * 8 + xcd) * 64, 1u, __ATOMIC_RELAXED, __HIP_MEMORY_SCOPE_AGENT);
          __syncthreads(); const int u = __builtin_amdgcn_readfirstlane(*qslot); __syncthreads();
          if (u >= 128) break;
          const int qb = 63 - (u >> 1), combo = 2 * xcd + (u & 1), b = combo >> 3, h = combo & 7; const size_t rb = (size_t)b * SEQ;
          ATT_UNIT<96, false>(F.tid, qb, QM + rb * 768 + h * 96, 768, KM + rb * 768 + h * 96, 768, KVB + rb * 1024 + h * 128 + 64, 1024, nullptr, MIX + rb * DM + 512 + h * 64, shm, 0.f);
        } } }
    float gq = fabsf(kin(I_FOX_QN)[j * 64 + F.lane]), gk = fabsf(kin(I_FOX_KN)[j * 64 + F.lane]);
#pragma unroll
    for (int o = 1; o < 64; o <<= 1) { gq = fmaxf(gq, __shfl_xor(gq, o)); gk = fmaxf(gk, __shfl_xor(gk, o)); }
    const float margin = 2.0f * 1.02f * 64.0f * gq * gk * C2_FOX;
#pragma unroll 1
    for (;;) {
        if (F.tid == 0) *qslot = (int)__hip_atomic_fetch_add(F.ctl + CW_AQ + 64 * j, 1u, __ATOMIC_RELAXED, __HIP_MEMORY_SCOPE_AGENT);
        __syncthreads(); const int u = __builtin_amdgcn_readfirstlane(*qslot); __syncthreads();
        if (u >= 1024) break;
        const int qb = 63 - (u >> 4), combo = u & 15, b = combo >> 3, h = combo & 7; const size_t rb = (size_t)b * SEQ;
        ATT_UNIT_FOX<64, true>(F.tid, qb, PROJ + rb * EVEN_INP + E_FQ + h * 64, EVEN_INP, PROJ + rb * EVEN_INP + E_FK + h * 64, EVEN_INP, PROJ + rb * EVEN_INP + E_FV + h * 64, EVEN_INP, CUM + rb * 8 + h, MIX + rb * DM + h * 64, shm, margin);
    }
}
constexpr size_t WS_S5_MT = WS_Y2;
constexpr size_t WS_S5_PT = WS_S5_MT + 72 * MiB;
constexpr size_t WS_S5_AX = WS_S5_PT + 16 * MiB;
constexpr size_t WS_S5_XLOC = WS_S5_AX + 36 * MiB;
static_assert(WS_S5_XLOC + 8 * MiB <= WS_Y2 + 144 * MiB, "s5 overlay");

__device__ __forceinline__ void s5_build(Frame& F, int j) {
    if (F.bid >= 256) return;
    const int g = F.bid >> 3, part = F.bid & 7, tid = F.tid, lane = F.lane, wave = F.wave;
    LAS float* pwr = (LAS float*)(F.lds + RING_OFF);
    LAS float* pwi = pwr + 65 * 64;
    LAS float* bbr = pwi + 65 * 64;
    LAS float* bbi = bbr + 1024;
    LAS float* crs = bbi + 1024;
    LAS float* cis = crs + 1024;
    LAS bf16* ktab = (LAS bf16*)(cis + 1024);
    const float dt = expf(kin(I_S5_LS)[j * 32 + g]);
    const float* are = kin(I_S5_ARE) + (size_t)(j * 32 + g) * 64; const float* aim = kin(I_S5_AIM) + (size_t)(j * 32 + g) * 64;
    for (int e = tid; e < 65 * 64; e += 512) { const int d = e >> 6, p = e & 63; const float lr = fminf(are[p], -1e-4f), li = aim[p];
        const float mag = expf(lr * dt * (float)d); float sn, cs; sincosf(li * dt * (float)d, &sn, &cs); pwr[e] = mag * cs; pwi[e] = mag * sn; }
    for (int e = tid; e < 1024; e += 512) { const int p = e >> 4, c = e & 15; const float lr = fminf(are[p], -1e-4f), li = aim[p];
        const float mag = expf(lr * dt); float sn, cs; sincosf(li * dt, &sn, &cs); const float abr = mag * cs, abi = mag * sn;
        const float den = lr * lr + li * li, nr = abr - 1.0f, ni = abi; const float gr = (nr * lr + ni * li) / den, gi = (ni * lr - nr * li) / den;
        const float br = kin(I_S5_BRE)[((size_t)(j * 32 + g) * 64 + p) * 16 + c], bi = kin(I_S5_BIM)[((size_t)(j * 32 + g) * 64 + p) * 16 + c];
        bbr[e] = gr * br - gi * bi; bbi[e] = gr * bi + gi * br; }
    for (int e = tid; e < 1024; e += 512) { crs[e] = kin(I_S5_CRE)[(size_t)(j * 32 + g) * 1024 + e]; cis[e] = kin(I_S5_CIM)[(size_t)(j * 32 + g) * 1024 + e]; }
    __syncthreads();
    { const int cc = tid >> 1, c = cc >> 4, c2 = cc & 15, ph = tid & 1;
      float er[32], ei[32];
#pragma unroll
      for (int pp = 0; pp < 32; ++pp) { const int p = 32 * ph + pp; const float xr = crs[c * 64 + p], xi = cis[c * 64 + p], yr = bbr[p * 16 + c2], yi = bbi[p * 16 + c2]; er[pp] = xr * yr - xi * yi; ei[pp] = xr * yi + xi * yr; }
#pragma unroll 1
      for (int d = 0; d < 64; ++d) { float s = 0.f; const LAS float* wr_ = pwr + d * 64 + 32 * ph; const LAS float* wi_ = pwi + d * 64 + 32 * ph;
#pragma unroll
          for (int pp = 0; pp < 32; ++pp) s += wr_[pp] * er[pp] - wi_[pp] * ei[pp];
          s += __shfl_xor(s, 1);
          if (ph == 0) ktab[(d * 16 + c) * 16 + c2] = (bf16)f2bf(s); } }
    __syncthreads();
    bf16* MT = (bf16*)(F.ws + WS_S5_MT) + (size_t)g * 1024 * 1152;
#pragma unroll 1
    for (int rr = wave; rr < 128; rr += 8) { const int i = part * 8 + (rr >> 4), c = rr & 15; bf16* row = MT + (size_t)(i * 16 + c) * 1152;
        v4u a = {0u, 0u, 0u, 0u}, b = {0u, 0u, 0u, 0u};
        if (lane <= i) { const LAS v4u* src = (const LAS v4u*)(ktab + ((i - lane) * 16 + c) * 16); a = src[0]; b = src[1]; }
        *(v4u*)(row + lane * 16) = a; *(v4u*)(row + lane * 16 + 8) = b;
        { const int p = lane; const float xr = crs[c * 64 + p], xi = cis[c * 64 + p], wr_ = pwr[(i + 1) * 64 + p], wi_ = pwi[(i + 1) * 64 + p];
          row[1024 + p] = (bf16)f2bf(xr * wr_ - xi * wi_); row[1088 + p] = (bf16)f2bf(-(xr * wi_ + xi * wr_)); } }
    bf16* PT = (bf16*)(F.ws + WS_S5_PT) + (size_t)g * 256 * 1024;
#pragma unroll 1
    for (int rr = wave; rr < 32; rr += 8) { const int n = part * 32 + rr; bf16* row = PT + (size_t)n * 1024 + lane * 16;
        unsigned o[8];
        if (n < 128) { const int p = n & 63, im = n >> 6; const float wr_ = pwr[(63 - lane) * 64 + p], wi_ = pwi[(63 - lane) * 64 + p];
#pragma unroll
            for (int q = 0; q < 8; ++q) { const float y0r = bbr[p * 16 + 2 * q], y0i = bbi[p * 16 + 2 * q], y1r = bbr[p * 16 + 2 * q + 1], y1i = bbi[p * 16 + 2 * q + 1];
                const float v0 = im ? (wr_ * y0i + wi_ * y0r) : (wr_ * y0r - wi_ * y0i), v1 = im ? (wr_ * y1i + wi_ * y1r) : (wr_ * y1r - wi_ * y1i); o[q] = pk2(v0, v1); }
        } else {
#pragma unroll
            for (int q = 0; q < 8; ++q) o[q] = 0u; }
        *(v4u*)row = (v4u){o[0], o[1], o[2], o[3]}; *(v4u*)(row + 8) = (v4u){o[4], o[5], o[6], o[7]}; }
    __syncthreads();
}
__device__ __forceinline__ void s5_repack(Frame& F) {
    const bf16* PROJ = (const bf16*)(F.ws + WS_PROJ); bf16* AX = (bf16*)(F.ws + WS_S5_AX);
    const int gt = F.bid * 512 + F.tid, NT = F.G * 512;
    for (int e = gt; e < NTOK * 32; e += NT) { const int m = e >> 5, g = e & 31; const int b = m / SEQ, t = m % SEQ, n = t >> 6, s = t & 63;
        const v4u* src = (const v4u*)(PROJ + (size_t)m * ODD_INP + O_U + g * 16); v4u* dst = (v4u*)(AX + ((size_t)g * 512 + b * 256 + n) * 1152 + s * 16);
        const v4u x0 = src[0], x1 = src[1]; dst[0] = x0; dst[1] = x1; }
}
struct S5POrder {
    int G, c;
    __device__ bool next(int i, pg8::Unit& u) const { const int L = i * G + c; if (L >= 64) return false; u.aux = L >> 1; u.pm = L & 1; u.pn = 0; return true; }
    __device__ __forceinline__ const char* a_base(const pg8::Gemm& g, const pg8::Unit& u) const { return (const char*)g.A + ((size_t)u.aux * 512 + u.pm * 256) * 1152 * 2; }
    __device__ __forceinline__ const char* b_base(const pg8::Gemm& g, const pg8::Unit& u) const { return (const char*)g.Bt + (size_t)u.aux * 256 * 1024 * 2; }
};
struct S5PEpi {
    static constexpr bool PERM = false;
    float* X;
    __device__ __forceinline__ void operator()(const pg8::f32x4 (&acc)[2][2][4][2], const pg8::Unit& u, int wr, int wc, int fr, int fq) const {
        const int row0 = u.pm * 256 + wr * 64 + fr; const int col0 = wc * 32 + 4 * fq;
#pragma unroll
        for (int ai = 0; ai < 2; ++ai)
#pragma unroll
            for (int m = 0; m < 4; ++m) { float* rowp = X + ((size_t)u.aux * 512 + row0 + ai * 128 + m * 16) * 128 + col0;
#pragma unroll
                for (int n = 0; n < 2; ++n) *(pg8::f32x4*)(rowp + n * 16) = acc[ai][0][m][n]; }
    }
};
__device__ __forceinline__ void s5_scan(Frame& F, int j, int gsel = -1) {
    int gw = F.bid * NWAVES + F.wave; if (gsel >= 0) { if (F.wave >= 2) return; gw = gsel * 2 + F.wave; } if (gw >= 64) return;
    const int g = gw >> 1, b = gw & 1, p = F.lane;
    const float lr = fminf(kin(I_S5_ARE)[(size_t)(j * 32 + g) * 64 + p], -1e-4f), li = kin(I_S5_AIM)[(size_t)(j * 32 + g) * 64 + p]; const float dt = expf(kin(I_S5_LS)[j * 32 + g]);
    const float mag = expf(lr * dt * 64.f); float sn, cs; sincosf(li * dt * 64.f, &sn, &cs); const float ar = mag * cs, ai = mag * sn;
    const float* X = (const float*)(F.ws + WS_S5_XLOC) + ((size_t)g * 512 + b * 256) * 128; bf16* AX = (bf16*)(F.ws + WS_S5_AX) + ((size_t)g * 512 + b * 256) * 1152 + 1024;
    float xr = 0.f, xi = 0.f; float cr[8], ci[8], nr[8], ni[8];
#pragma unroll
    for (int q = 0; q < 8; ++q) { cr[q] = X[(size_t)q * 128 + p]; ci[q] = X[(size_t)q * 128 + 64 + p]; }
    for (int n0 = 0; n0 < 256; n0 += 8) { const int nn = (n0 + 8 < 256) ? n0 + 8 : n0;
#pragma unroll
        for (int q = 0; q < 8; ++q) { nr[q] = X[(size_t)(nn + q) * 128 + p]; ni[q] = X[(size_t)(nn + q) * 128 + 64 + p]; }
#pragma unroll
        for (int q = 0; q < 8; ++q) { AX[(size_t)(n0 + q) * 1152 + p] = (bf16)f2bf(xr); AX[(size_t)(n0 + q) * 1152 + 64 + p] = (bf16)f2bf(xi);
            const float tr = ar * xr - ai * xi + cr[q], ti = ar * xi + ai * xr + ci[q]; xr = tr; xi = ti; }
#pragma unroll
        for (int q = 0; q < 8; ++q) { cr[q] = nr[q]; ci[q] = ni[q]; } }
}
struct S5MOrder {
    int G, c;
    __device__ bool next(int i, pg8::Unit& u) const { const int L = i * G + c; if (L >= 256) return false; u.aux = L >> 3; u.pm = (L >> 2) & 1; u.pn = L & 3; return true; }
    __device__ __forceinline__ const char* a_base(const pg8::Gemm& g, const pg8::Unit& u) const { return (const char*)g.A + ((size_t)u.aux * 512 + u.pm * 256) * 1152 * 2; }
    __device__ __forceinline__ const char* b_base(const pg8::Gemm& g, const pg8::Unit& u) const { return (const char*)g.Bt + ((size_t)u.aux * 1024 + u.pn * 256) * 1152 * 2; }
};
struct S5MEpi {
    static constexpr bool PERM = true;
    bf16* HG; const bf16* PROJ; const float* dsk;
    __device__ __forceinline__ void operator()(const pg8::f32x4 (&acc)[2][2][4][2], const pg8::Unit& u, int wr, int wc, int fr, int fq) const {
        const int g = u.aux; const int row0 = u.pm * 256 + wr * 64 + fr; const int col0 = u.pn * 256 + wc * 32 + 8 * fq;
        const pg8::f32x4 d0 = *(const pg8::f32x4*)(dsk + g * 16 + (col0 & 15)), d1 = *(const pg8::f32x4*)(dsk + g * 16 + (col0 & 15) + 4);
#pragma unroll
        for (int ai = 0; ai < 2; ++ai)
#pragma unroll
            for (int m = 0; m < 4; ++m) { const int rg = row0 + ai * 128 + m * 16; const int b = rg >> 8, n = rg & 255;
#pragma unroll
                for (int bj = 0; bj < 2; ++bj) { const int col = col0 + bj * 128; const int i = col >> 4, c0 = col & 15; const size_t tok = (size_t)b * SEQ + n * 64 + i;
                    const pg8::u32x4 uw = *(const pg8::u32x4*)(PROJ + tok * ODD_INP + O_U + g * 16 + c0); const pg8::f32x4 v0 = acc[ai][bj][m][0], v1 = acc[ai][bj][m][1];
                    pg8::u32x4 w; w.x = pk2(gelu_tanh(v0[0] + d0[0] * bflo(uw.x)), gelu_tanh(v0[1] + d0[1] * bfhi(uw.x))); w.y = pk2(gelu_tanh(v0[2] + d0[2] * bflo(uw.y)), gelu_tanh(v0[3] + d0[3] * bfhi(uw.y)));
                    w.z = pk2(gelu_tanh(v1[0] + d1[0] * bflo(uw.z)), gelu_tanh(v1[1] + d1[1] * bfhi(uw.z))); w.w = pk2(gelu_tanh(v1[2] + d1[2] * bflo(uw.w)), gelu_tanh(v1[3] + d1[3] * bfhi(uw.w)));
                    *(pg8::u32x4*)(HG + tok * 512 + g * 16 + c0) = w; } }
    }
};

struct S5GroupP { int g;
    __device__ bool next(int i, pg8::Unit& u) const { if (i >= 2) return false; u.aux = g; u.pm = i; u.pn = 0; return true; }
    __device__ __forceinline__ const char* a_base(const pg8::Gemm& gm, const pg8::Unit& u) const { return (const char*)gm.A + ((size_t)u.aux * 512 + u.pm * 256) * 1152 * 2; }
    __device__ __forceinline__ const char* b_base(const pg8::Gemm& gm, const pg8::Unit& u) const { return (const char*)gm.Bt + (size_t)u.aux * 256 * 1024 * 2; } };
struct S5GroupM { int g;
    __device__ bool next(int i, pg8::Unit& u) const { if (i >= 8) return false; u.aux = g; u.pm = i >> 2; u.pn = i & 3; return true; }
    __device__ __forceinline__ const char* a_base(const pg8::Gemm& gm, const pg8::Unit& u) const { return (const char*)gm.A + ((size_t)u.aux * 512 + u.pm * 256) * 1152 * 2; }
    __device__ __forceinline__ const char* b_base(const pg8::Gemm& gm, const pg8::Unit& u) const { return (const char*)gm.Bt + ((size_t)u.aux * 1024 + u.pn * 256) * 1152 * 2; } };
namespace gdn {
typedef short s16x4 __attribute__((ext_vector_type(4)));
#define GDN_MFMA(a, b, c) __builtin_amdgcn_mfma_f32_16x16x16bf16_1k(a, b, c, 0, 0, 0)
__device__ __forceinline__ float fsig(float x) { return __builtin_amdgcn_rcpf(1.0f + __expf(-x)); }
__device__ __forceinline__ float bperm(float v, int src_lane) { return __int_as_float(__builtin_amdgcn_ds_bpermute(src_lane << 2, __float_as_int(v))); }
__device__ __forceinline__ s16x4 pack4(float a, float b, float c, float d) { v2u w; w.x = pk2(a, b); w.y = pk2(c, d); return __builtin_bit_cast(s16x4, w); }
constexpr int NITEM = BATCH * 4 * (SEQ / 16);
constexpr int IMG_STRIDE = 144;
constexpr int WAVE_LDS = 1024 + 1024 + 3 * 16 * IMG_STRIDE * 2;
}
constexpr size_t WS_GDN_UB = WS_QG;
constexpr size_t WS_GDN_WT = WS_KG;
constexpr size_t WS_GDN_QD = WS_KG + 32 * MiB;
constexpr size_t WS_GDN_KD = WS_VG;
constexpr size_t WS_GDN_IT = WS_VG + 32 * MiB;

__device__ __forceinline__ void phase_gdn_g1(Frame& F, int j) {
    using namespace gdn;
    const bf16* PROJ = (const bf16*)(F.ws + WS_PROJ);
    const float* cw = kin(I_GDN_CONV) + (size_t)j * 4 * 1536;
    float* UB = (float*)(F.ws + WS_GDN_UB); bf16* WT = (bf16*)(F.ws + WS_GDN_WT); bf16* QD = (bf16*)(F.ws + WS_GDN_QD); bf16* KD = (bf16*)(F.ws + WS_GDN_KD); unsigned* ITE = (unsigned*)(F.ws + WS_GDN_IT);
    LAS float* Am = (LAS float*)(F.lds + RING_OFF + F.wave * WAVE_LDS); LAS float* Tm = Am + 256; LAS bf16* img = (LAS bf16*)(Tm + 256);
    const int gw = F.bid * NWAVES + F.wave, NGW = F.G * NWAVES;
#pragma unroll 1
    for (int item = gw; item < NITEM; item += NGW) {
        int lane = F.lane; asm volatile("" : "+v"(lane));
        const int tok = lane & 15, g4 = lane >> 4;
        const int b = item >> 12, h = (item >> 10) & 3, n = item & 1023; const int s0 = 16 * n + tok; const size_t m = (size_t)b * SEQ + s0;
        const size_t it = (size_t)item;
        const float gin = bf2f(PROJ[m * ODD_INP + O_GIN + h]), bin = bf2f(PROJ[m * ODD_INP + O_BETA + h]);
        const float gt = -expf(kin(I_GDN_ALOG)[j * 4 + h]) * softplusf_(gin + kin(I_GDN_DTB)[j * 4 + h]); const float beta = fsig(bin);
        float gc = gt;
#pragma unroll
        for (int off = 1; off < 16; off <<= 1) { const float t = bperm(gc, tok >= off ? lane - off : lane); if (tok >= off) gc += t; }
        const float glast = bperm(gc, lane | 15); const float eg = expf(gc), ekd = expf(glast - gc);
        LAS bf16* img2 = img + 16 * IMG_STRIDE; LAS bf16* img3 = img2 + 16 * IMG_STRIDE;
#define GDN_CONV(WSEL, X) do { _Pragma("unroll") for (int db = 0; db < 8; ++db) { const int ch = (WSEL) * 512 + h * 128 + 16 * db + 4 * g4; float a0 = 0.f, a1 = 0.f, a2 = 0.f, a3 = 0.f; \
            _Pragma("unroll") for (int tap = 0; tap < 4; ++tap) { if (s0 - 3 + tap >= 0) { const v2u x = *(const v2u*)(PROJ + (m - 3 + tap) * ODD_INP + O_Q + ch); const f32x4 wv = *(const f32x4*)(cw + tap * 1536 + ch); \
                a0 += wv.x * bflo(x.x); a1 += wv.y * bfhi(x.x); a2 += wv.z * bflo(x.y); a3 += wv.w * bfhi(x.y); } } \
            X[db][0] = a0 * fsig(a0); X[db][1] = a1 * fsig(a1); X[db][2] = a2 * fsig(a2); X[db][3] = a3 * fsig(a3); \
            if ((db & 3) == 3) asm volatile("" ::: "memory"); } } while (0)
        { float xv[8][4]; GDN_CONV(2, xv);
#pragma unroll
          for (int db = 0; db < 8; ++db) *(LAS s16x4*)(img + tok * IMG_STRIDE + 16 * db + 4 * g4) = pack4(xv[db][0] * beta, xv[db][1] * beta, xv[db][2] * beta, xv[db][3] * beta); }
        s16x4 Kf[8];
        { float xk[8][4]; GDN_CONV(1, xk); float sk = 0.f;
#pragma unroll
          for (int db = 0; db < 8; ++db)
#pragma unroll
              for (int e = 0; e < 4; ++e) sk += xk[db][e] * xk[db][e];
          sk += bperm(sk, lane ^ 16); sk += bperm(sk, lane ^ 32);
          const float rk = 1.0f / sqrtf(sk + RMS_EPS); const float s2 = rk * beta * eg, s3 = rk * ekd;
#pragma unroll
          for (int db = 0; db < 8; ++db) { const int o = tok * IMG_STRIDE + 16 * db + 4 * g4;
              *(LAS s16x4*)(img2 + o) = pack4(xk[db][0] * s2, xk[db][1] * s2, xk[db][2] * s2, xk[db][3] * s2);
              *(LAS s16x4*)(img3 + o) = pack4(xk[db][0] * s3, xk[db][1] * s3, xk[db][2] * s3, xk[db][3] * s3);
              Kf[db] = pack4(xk[db][0] * rk, xk[db][1] * rk, xk[db][2] * rk, xk[db][3] * rk); } }
        f32x4 Gacc = {0.f, 0.f, 0.f, 0.f}, Pacc = {0.f, 0.f, 0.f, 0.f};
        { float xqq[8][4]; GDN_CONV(0, xqq); float sq = 0.f;
#pragma unroll
          for (int db = 0; db < 8; ++db)
#pragma unroll
              for (int e = 0; e < 4; ++e) sq += xqq[db][e] * xqq[db][e];
          sq += bperm(sq, lane ^ 16); sq += bperm(sq, lane ^ 32);
          const float rq = (1.0f / sqrtf(sq + RMS_EPS)) * 0.08838834764831845f;
#pragma unroll
          for (int db = 0; db < 8; ++db) {
              *(s16x4*)(QD + ((it * 4 + (db >> 1)) * 64 + lane) * 8 + (db & 1) * 4) = pack4(xqq[db][0] * rq * eg, xqq[db][1] * rq * eg, xqq[db][2] * rq * eg, xqq[db][3] * rq * eg);
              const s16x4 Qf = pack4(xqq[db][0] * rq, xqq[db][1] * rq, xqq[db][2] * rq, xqq[db][3] * rq);
              Gacc = GDN_MFMA(Kf[db], Kf[db], Gacc); Pacc = GDN_MFMA(Kf[db], Qf, Pacc); } }
#undef GDN_CONV
        { float itv[4];
#pragma unroll
          for (int r = 0; r < 4; ++r) { const int i = 4 * g4 + r; const float gci = bperm(gc, i), bi = bperm(beta, i);
              const float da = (tok < i) ? expf(gci - gc) : 0.f;
              Am[i * 16 + tok] = bi * Gacc[r] * da;
              const float dp = (i <= tok) ? expf(gc - gci) : 0.f;
              itv[r] = Pacc[r] * dp; }
          v4u ite; ite.x = pk2(itv[0], itv[1]); ite.y = pk2(itv[2], itv[3]); ite.z = __float_as_uint(expf(glast)); ite.w = 0u;
          *(v4u*)(ITE + (it * 64 + lane) * 4) = ite; }
        LDS_WAIT();
        float Tc[16];
#pragma unroll
        for (int i = 0; i < 16; ++i) { float s = (i == tok) ? 1.f : 0.f;
#pragma unroll
            for (int jj = 0; jj < i; ++jj) s -= Am[i * 16 + jj] * Tc[jj];
            Tc[i] = s; }
#pragma unroll
        for (int r = 0; r < 4; ++r) Tm[(4 * g4 + r) * 16 + tok] = (g4 == 0) ? Tc[r] : (g4 == 1) ? Tc[4 + r] : (g4 == 2) ? Tc[8 + r] : Tc[12 + r];
        LDS_WAIT();
        const f32x4 trow = *(const LAS f32x4*)(Tm + tok * 16 + 4 * g4);
        const s16x4 Tf = pack4(trow.x, trow.y, trow.z, trow.w);
        const int traddr = (int)(uintptr_t)img + ((4 * g4 + ((lane & 15) >> 2)) * IMG_STRIDE + 4 * (lane & 3)) * 2;
#pragma unroll
        for (int cb = 0; cb < 8; ++cb) { s16x4 vf; asm volatile("ds_read_b64_tr_b16 %0, %1 offset:%c2\n\ts_waitcnt lgkmcnt(0)" : "=&v"(vf) : "v"(traddr), "i"(cb * 32) : "memory");
            const f32x4 z = {0.f, 0.f, 0.f, 0.f}; const f32x4 u = GDN_MFMA(Tf, vf, z);
            *(f32x4*)(UB + ((it * 8 + cb) * 64 + lane) * 4) = u; }
#pragma unroll
        for (int db = 0; db < 8; ++db) { s16x4 kf; asm volatile("ds_read_b64_tr_b16 %0, %1 offset:%c2\n\ts_waitcnt lgkmcnt(0)" : "=&v"(kf) : "v"(traddr), "i"(16 * IMG_STRIDE * 2 + db * 32) : "memory");
            const f32x4 z = {0.f, 0.f, 0.f, 0.f}; const f32x4 w = GDN_MFMA(kf, Tf, z);
            *(s16x4*)(WT + ((it * 4 + (db >> 1)) * 64 + lane) * 8 + (db & 1) * 4) = pack4(-w.x, -w.y, -w.z, -w.w); }
#pragma unroll
        for (int db = 0; db < 8; ++db) { s16x4 kf; asm volatile("ds_read_b64_tr_b16 %0, %1 offset:%c2\n\ts_waitcnt lgkmcnt(0)" : "=&v"(kf) : "v"(traddr), "i"(32 * IMG_STRIDE * 2 + db * 32) : "memory");
            *(s16x4*)(KD + ((it * 4 + (db >> 1)) * 64 + lane) * 8 + (db & 1) * 4) = kf; }
        LDS_WAIT();
    }
}

__device__ __forceinline__ void phase_gdn_g2(Frame& F) {
    using namespace gdn;
    if (F.bid >= 64) return;
    const char* UB = (const char*)(F.ws + WS_GDN_UB); const char* WT = (const char*)(F.ws + WS_GDN_WT); const char* QD = (const char*)(F.ws + WS_GDN_QD); const char* KD = (const char*)(F.ws + WS_GDN_KD);
    const char* ITE = (const char*)(F.ws + WS_GDN_IT); float* OGN = (float*)(F.ws + WS_OG);
    const int lane = F.lane, bh = F.bid & 7, sl = F.bid >> 3, wave = F.wave;
    constexpr int SLOT = 14 * 1024, NSLOT = 8, INFL = 6;
    volatile LAS int* ready = (volatile LAS int*)(F.lds + LDSCTL_OFF + 128);
    volatile LAS int* done = (volatile LAS int*)(F.lds + LDSCTL_OFF + 192);
    if (F.tid < 8) ready[F.tid] = 0; if (F.tid == 8) *done = 0;
    __syncthreads();
    const size_t it0 = (size_t)bh * 1024;
    if (wave != 0) {
        const unsigned ring = (unsigned)(uintptr_t)(F.lds + RING_OFF); const size_t lo16 = (size_t)lane * 16;
        const int p0 = 2 * (wave - 1);
#pragma unroll 1
        for (int s = 0; s < 1024; ++s) {
            if (s >= NSLOT) { unsigned sp_ = 0; while (*done < s - NSLOT + 1) { __builtin_amdgcn_s_sleep(1); if (++sp_ > (1u << 24)) break; } }
            const size_t i_ = it0 + s; const unsigned d_ = ring + (unsigned)((s % NSLOT) * SLOT);
#pragma unroll
            for (int k = 0; k < 2; ++k) { const int pc = p0 + k; const char* src;
                if (pc == 0) src = UB + ((i_ * 8 + sl) * 64) * 16; else if (pc <= 4) src = WT + ((i_ * 4 + (pc - 1)) * 64) * 16; else if (pc <= 8) src = QD + ((i_ * 4 + (pc - 5)) * 64) * 16;
                else if (pc <= 12) src = KD + ((i_ * 4 + (pc - 9)) * 64) * 16; else src = ITE + (i_ * 64) * 16;
                att::glds16(src + lo16, (unsigned)__builtin_amdgcn_readfirstlane(d_ + pc * 1024)); }
            asm volatile("s_waitcnt vmcnt(10)" ::: "memory");
            if (s >= INFL - 1 && lane == 0) ready[wave] = s - (INFL - 1) + 1;
        }
        asm volatile("s_waitcnt vmcnt(0)" ::: "memory"); if (lane == 0) ready[wave] = 1024;
        return;
    }
    f32x4 S[8];
#pragma unroll
    for (int db = 0; db < 8; ++db) S[db] = (f32x4){0.f, 0.f, 0.f, 0.f};
    int avail = 0;
    typedef short s16x8 __attribute__((ext_vector_type(8)));
    f32x4 uA, uB; v4u iteA, iteB, wtA[4], wtB[4], qdA[4], qdB[4], kdA[4], kdB[4];
#define G2_POLL(n_) do { if ((n_) >= avail) { unsigned sp_ = 0; for (;;) { const int r1 = ready[1], r2 = ready[2], r3 = ready[3], r4 = ready[4], r5 = ready[5], r6 = ready[6], r7 = ready[7]; \
        avail = min(min(min(r1, r2), min(r3, r4)), min(min(r5, r6), r7)); if (avail > (n_)) break; __builtin_amdgcn_s_sleep(1); if (++sp_ > (1u << 24)) break; } } } while (0)
#define G2_READ(U_, ITE_, WT_, QD_, KD_, n_) do { const LAS char* sp_ = (const LAS char*)(F.lds + RING_OFF) + ((n_) % NSLOT) * SLOT + lane * 16; \
        U_ = *(const LAS f32x4*)sp_; ITE_ = *(const LAS v4u*)(sp_ + 13 * 1024); \
        _Pragma("unroll") for (int q = 0; q < 4; ++q) { WT_[q] = *(const LAS v4u*)(sp_ + (1 + q) * 1024); QD_[q] = *(const LAS v4u*)(sp_ + (5 + q) * 1024); KD_[q] = *(const LAS v4u*)(sp_ + (9 + q) * 1024); } } while (0)
#define FR(v, h) __builtin_bit_cast(s16x4, (v2u){(h) ? (v).z : (v).x, (h) ? (v).w : (v).y})
#define SB8(q) (s16x8){Sb[2 * (q)][0], Sb[2 * (q)][1], Sb[2 * (q)][2], Sb[2 * (q)][3], Sb[2 * (q) + 1][0], Sb[2 * (q) + 1][1], Sb[2 * (q) + 1][2], Sb[2 * (q) + 1][3]}
#define G2_STEP(U_, ITE_, WT_, QD_, KD_, UN_, ITEN_, WTN_, QDN_, KDN_, n_) do { const int n = (n_); \
        if (n + 1 < 1024) { G2_POLL(n + 1); G2_READ(UN_, ITEN_, WTN_, QDN_, KDN_, n + 1); } \
        const float egl = __uint_as_float(ITE_.z); const s16x4 itf = __builtin_bit_cast(s16x4, (v2u){ITE_.x, ITE_.y}); \
        s16x4 Sb[8]; \
        _Pragma("unroll") for (int db = 0; db < 8; ++db) Sb[db] = pack4(S[db].x, S[db].y, S[db].z, S[db].w); \
        f32x4 va = U_, vb2 = {0.f, 0.f, 0.f, 0.f}; \
        va = __builtin_amdgcn_mfma_f32_16x16x32_bf16(__builtin_bit_cast(s16x8, WT_[0]), SB8(0), va, 0, 0, 0); vb2 = __builtin_amdgcn_mfma_f32_16x16x32_bf16(__builtin_bit_cast(s16x8, WT_[1]), SB8(1), vb2, 0, 0, 0); \
        va = __builtin_amdgcn_mfma_f32_16x16x32_bf16(__builtin_bit_cast(s16x8, WT_[2]), SB8(2), va, 0, 0, 0); vb2 = __builtin_amdgcn_mfma_f32_16x16x32_bf16(__builtin_bit_cast(s16x8, WT_[3]), SB8(3), vb2, 0, 0, 0); \
        va = va + vb2; \
        const s16x4 vb = pack4(va.x, va.y, va.z, va.w); \
        _Pragma("unroll") for (int q = 0; q < 4; ++q) { const f32x4 s0 = S[2 * q] * egl, s1 = S[2 * q + 1] * egl; S[2 * q] = GDN_MFMA(FR(KD_[q], 0), vb, s0); S[2 * q + 1] = GDN_MFMA(FR(KD_[q], 1), vb, s1); } \
        f32x4 oa = {0.f, 0.f, 0.f, 0.f}, ob = {0.f, 0.f, 0.f, 0.f}; \
        oa = GDN_MFMA(itf, vb, oa); \
        _Pragma("unroll") for (int q = 0; q < 4; ++q) { oa = GDN_MFMA(FR(QD_[q], 0), Sb[2 * q], oa); ob = GDN_MFMA(FR(QD_[q], 1), Sb[2 * q + 1], ob); } \
        oa = oa + ob; \
        *(f32x4*)(OGN + (((it0 + n) * 8 + sl) * 64 + lane) * 4) = oa; \
        asm volatile("s_waitcnt lgkmcnt(0)" ::: "memory"); \
        if (lane == 0) *done = (n + 2 < 1024) ? n + 2 : 1024;         \
    } while (0)
    G2_POLL(0); G2_READ(uA, iteA, wtA, qdA, kdA, 0);
#pragma unroll 1
    for (int n2 = 0; n2 < 1024; n2 += 2) {
        G2_STEP(uA, iteA, wtA, qdA, kdA, uB, iteB, wtB, qdB, kdB, n2);
        G2_STEP(uB, iteB, wtB, qdB, kdB, uA, iteA, wtA, qdA, kdA, n2 + 1);
    }
#undef G2_POLL
#undef G2_READ
#undef G2_STEP
#undef FR
#undef SB8
}
__device__ __forceinline__ void phase_gdn_out2(Frame& F, int j) {
    using namespace gdn;
    const float* OGN = (const float*)(F.ws + WS_OG); const bf16* PROJ = (const bf16*)(F.ws + WS_PROJ); bf16* MIX = (bf16*)(F.ws + WS_MIX);
    const float* on = kin(I_GDN_ONORM) + j * 128; const int lane = F.lane, c = lane & 15, g4 = lane >> 4;
    const int gw = F.bid * NWAVES + F.wave, NGW = F.G * NWAVES;
#pragma unroll 1
    for (int item = gw; item < NITEM; item += NGW) { const int b = item >> 12, h = (item >> 10) & 3, n = item & 1023;
        f32x4 o[8]; float ss[4] = {0.f, 0.f, 0.f, 0.f};
#pragma unroll
        for (int sl = 0; sl < 8; ++sl) { o[sl] = *(const f32x4*)(OGN + (((size_t)item * 8 + sl) * 64 + lane) * 4);
#pragma unroll
            for (int r = 0; r < 4; ++r) ss[r] += o[sl][r] * o[sl][r]; }
#pragma unroll
        for (int r = 0; r < 4; ++r) { ss[r] += __shfl_xor(ss[r], 1); ss[r] += __shfl_xor(ss[r], 2); ss[r] += __shfl_xor(ss[r], 4); ss[r] += __shfl_xor(ss[r], 8); ss[r] = 1.0f / sqrtf(ss[r] * (1.f / 128.f) + RMS_EPS); }
#pragma unroll
        for (int r = 0; r < 4; ++r) { const size_t tok = (size_t)b * SEQ + 16 * n + 4 * g4 + r;
#pragma unroll
            for (int sl = 0; sl < 8; ++sl) { const int col = 16 * sl + c; const float zz = bf2f(PROJ[tok * ODD_INP + O_Z + h * 128 + col]);
                MIX[tok * DM + 512 + h * 128 + col] = (bf16)f2bf(o[sl][r] * ss[r] * on[col] * (zz * fsig(zz))); } }
    }
}
constexpr size_t WS_WR = WS_W_EVIN - 1 * MiB;
static_assert(WS_WR >= CTL_ZERO_BYTES, "WR above the control words");
__device__ __forceinline__ void router_weights(Frame& F) {
    float* WR = (float*)(F.ws + WS_WR);
    const int gt = F.bid * 512 + F.tid, NT = F.G * 512;
    for (int e = gt; e < 4 * 1024 * 48; e += NT) { const int l = e / (1024 * 48), r = e % (1024 * 48), k = r / 48, c = r % 48;
        const float g = kin(I_NORM_FFN)[l * DM + k];
        float w = 0.f; if (c < 4) w = kin(I_MOE_WGRP)[((size_t)l * DM + k) * 4 + c]; else if (c < 36) w = kin(I_MOE_WEXP)[((size_t)l * DM + k) * 32 + (c - 4)];
        WR[e] = g * w; }
}
__device__ __forceinline__ void phase_router2(Frame& F, int layer, bool dry = false) {
    const bf16* H = (const bf16*)(F.ws + WS_H16); bf16* ABF = (bf16*)(F.ws + WS_ABF);
    const float* gain = kin(I_NORM_FFN) + layer * DM; const float* bgr = kin(I_MOE_BGRP) + layer * 4; const float* bex = kin(I_MOE_BEXP) + layer * 32;
    const float* WR = (const float*)(F.ws + WS_WR) + (size_t)layer * 1024 * 48;
    int* TOKE = (int*)(F.ws + WS_TOKE); float* TOKW = (float*)(F.ws + WS_TOKW);
    LAS int* lcnt = (LAS int*)(F.lds + LDSCTL_OFF + LC_MOE + 512); LAS int* gbase = (LAS int*)(F.lds + LDSCTL_OFF + LC_MOE + 640);
    const int lane = F.lane, tok = lane & 15, kq = lane >> 4; const int per = NTOK / F.G;
    LAS int* lasg = (LAS int*)(F.lds + RING_OFF);
    LAS float* lg = (LAS float*)(F.lds + RING_OFF + 4096) + F.wave * (16 * 52);
    if (F.tid < 32) lcnt[F.tid] = 0;
    __syncthreads();
    const int m0 = F.bid * per + F.wave * 16;
    const bf16* hrow = H + (size_t)(m0 + tok) * DM + 4 * kq;
    f32x4 acc0 = {0.f, 0.f, 0.f, 0.f}, acc1 = acc0, acc2 = acc0; float ss = 0.f;
#define RT_LDA(p_) ({ const v2u x_ = *(const v2u*)(p_); (f32x4){bflo(x_.x), bfhi(x_.x), bflo(x_.y), bfhi(x_.y)}; })
#define RT_LOAD(a_, b_, S_) do { const int s_ = ((S_) < 64) ? (S_) : 63; a_ = *(const v2u*)(hrow + 16 * s_); \
        _Pragma("unroll") for (int e = 0; e < 4; ++e) _Pragma("unroll") for (int nb = 0; nb < 3; ++nb) b_[e * 3 + nb] = WR[(size_t)(16 * s_ + 4 * kq + e) * 48 + 16 * nb + tok]; } while (0)
#define RT_MMA(a_, b_) do { const f32x4 af_ = {bflo(a_.x), bfhi(a_.x), bflo(a_.y), bfhi(a_.y)};     \
        ss += (af_.x * af_.x + af_.y * af_.y) + (af_.z * af_.z + af_.w * af_.w); \
        _Pragma("unroll") for (int e = 0; e < 4; ++e) { const float a = af_[e]; \
            acc0 = __builtin_amdgcn_mfma_f32_16x16x4f32(a, b_[e * 3 + 0], acc0, 0, 0, 0); acc1 = __builtin_amdgcn_mfma_f32_16x16x4f32(a, b_[e * 3 + 1], acc1, 0, 0, 0); acc2 = __builtin_amdgcn_mfma_f32_16x16x4f32(a, b_[e * 3 + 2], acc2, 0, 0, 0); } } while (0)
    v2u a0, a1, a2, a3, a4, a5, a6, a7; float b0[12], b1[12], b2[12], b3[12], b4[12], b5[12], b6[12], b7[12];
    RT_LOAD(a0, b0, 0); RT_LOAD(a1, b1, 1); RT_LOAD(a2, b2, 2); RT_LOAD(a3, b3, 3); RT_LOAD(a4, b4, 4); RT_LOAD(a5, b5, 5); RT_LOAD(a6, b6, 6);
#define RT_SB() __builtin_amdgcn_sched_barrier(0)
#pragma unroll 1
    for (int S = 0; S < 64; S += 8) {
        RT_LOAD(a7, b7, S + 7); RT_SB(); RT_MMA(a0, b0); RT_SB();
        RT_LOAD(a0, b0, S + 8); RT_SB(); RT_MMA(a1, b1); RT_SB();
        RT_LOAD(a1, b1, S + 9); RT_SB(); RT_MMA(a2, b2); RT_SB();
        RT_LOAD(a2, b2, S + 10); RT_SB(); RT_MMA(a3, b3); RT_SB();
        RT_LOAD(a3, b3, S + 11); RT_SB(); RT_MMA(a4, b4); RT_SB();
        RT_LOAD(a4, b4, S + 12); RT_SB(); RT_MMA(a5, b5); RT_SB();
        RT_LOAD(a5, b5, S + 13); RT_SB(); RT_MMA(a6, b6); RT_SB();
        RT_LOAD(a6, b6, S + 14); RT_SB(); RT_MMA(a7, b7); RT_SB();
    }
#undef RT_SB
#undef RT_LOAD
#undef RT_MMA
    ss += __shfl_xor(ss, 16); ss += __shfl_xor(ss, 32);
    const float rr = 1.0f / sqrtf(ss * (1.f / 1024.f) + RMS_EPS);
#pragma unroll
    for (int reg = 0; reg < 4; ++reg) { LAS float* row = lg + (4 * kq + reg) * 52; row[tok] = acc0[reg]; row[16 + tok] = acc1[reg]; row[32 + tok] = acc2[reg]; }
    if (kq == 0) lg[tok * 52 + 48] = rr;
    LDS_WAIT();
    if (lane < 16) { const LAS float* row = lg + lane * 52; const float r = row[48]; const int m = m0 + lane; const int tl = F.wave * 16 + lane;
        float l4[4];
#pragma unroll
        for (int g = 0; g < 4; ++g) l4[g] = row[g] * r + bgr[g];
        int gi = 0; float gm = l4[0];
#pragma unroll
        for (int g = 1; g < 4; ++g) if (l4[g] > gm) { gm = l4[g]; gi = g; }
        float gden = 0.f;
#pragma unroll
        for (int g = 0; g < 4; ++g) gden += expf(l4[g] - gm);
        const float gw_ = 1.0f / gden;
        float le[8];
#pragma unroll
        for (int e = 0; e < 8; ++e) le[e] = row[4 + gi * 8 + e] * r + bex[gi * 8 + e];
        int i0 = 0; float mx0 = le[0];
#pragma unroll
        for (int e = 1; e < 8; ++e) if (le[e] > mx0) { mx0 = le[e]; i0 = e; }
        int i1 = -1; float mx1 = -3.0e38f;
#pragma unroll
        for (int e = 0; e < 8; ++e) if (e != i0 && le[e] > mx1) { mx1 = le[e]; i1 = e; }
        const float e1 = expf(mx1 - mx0); const float w0 = gw_ / (1.0f + e1), w1 = gw_ * e1 / (1.0f + e1);
        if (!dry) { const int ea = gi * 8 + i0, eb = gi * 8 + i1;
            const int pa = __hip_atomic_fetch_add(lcnt + ea, 1, __ATOMIC_RELAXED, __HIP_MEMORY_SCOPE_WORKGROUP), pb = __hip_atomic_fetch_add(lcnt + eb, 1, __ATOMIC_RELAXED, __HIP_MEMORY_SCOPE_WORKGROUP);
            lasg[tl * 2] = ea | (pa << 8); lasg[tl * 2 + 1] = eb | (pb << 8);
            TOKW[(size_t)m * 2] = w0; TOKW[(size_t)m * 2 + 1] = w1; } }
#pragma unroll 1
    for (int t = 0; t < 16; ++t) { const float r = lg[t * 52 + 48];
#pragma unroll
        for (int q = 0; q < 2; ++q) { const v4u x = ((const v4u*)(H + (size_t)(m0 + t) * DM) + lane)[64 * q]; const float* g = gain + 512 * q + 8 * lane; const f32x4 g0 = *(const f32x4*)g, g1 = *(const f32x4*)(g + 4);
            v4u o; o.x = pk2(bflo(x.x) * r * g0.x, bfhi(x.x) * r * g0.y); o.y = pk2(bflo(x.y) * r * g0.z, bfhi(x.y) * r * g0.w); o.z = pk2(bflo(x.z) * r * g1.x, bfhi(x.z) * r * g1.y); o.w = pk2(bflo(x.w) * r * g1.z, bfhi(x.w) * r * g1.w);
            ((v4u*)(ABF + (size_t)(m0 + t) * DM) + lane)[64 * q] = o; } }
    __syncthreads();
    if (dry) return;
    if (F.tid < 32) gbase[F.tid] = (int)__hip_atomic_fetch_add(F.ctl + CW_CNT + 64 * layer + F.tid, (unsigned)lcnt[F.tid], __ATOMIC_RELAXED, __HIP_MEMORY_SCOPE_AGENT);
    __syncthreads();
    int* P2T = (int*)(F.ws + WS_P2T);
    for (int i = F.tid; i < per * 2; i += 512) { const int a = lasg[i], e = a & 255, lp = a >> 8; const int gp = gbase[e] + lp; TOKE[(size_t)F.bid * per * 2 + i] = e | (gp << 8); P2T[(size_t)e * NTOK + gp] = F.bid * per * 2 + i; }
    __syncthreads();
}
constexpr int LSTEPS = 16;
constexpr int STEP_END = 1 + DEPTH * LSTEPS;
struct KArgs { Args a; int li, pad; };

#define FRAME Frame F; { int wv_ = wave0; asm volatile("" : "+s"(wv_)); int t_ = wv_ * 64 + (int)__builtin_amdgcn_mbcnt_hi(~0u, __builtin_amdgcn_mbcnt_lo(~0u, 0u)); asm volatile("" : "+v"(t_)); unsigned char* w_ = kws(); F.lds = lds0; F.ws = w_; F.ctl = (unsigned*)(w_ + WS_CTL); \
        F.tid = t_; F.lane = t_ & 63; F.wave = __builtin_amdgcn_readfirstlane(t_ >> 6); { int g_ = gridDim.x, b_ = blockIdx.x; asm volatile("" : "+s"(g_), "+s"(b_)); F.G = g_; F.bid = b_; } } unsigned char* const ws = F.ws; (void)ws
#ifndef PH_MASK
#define PH_MASK 0xffffffffu
#endif
#define EN(k) (((PH_MASK) >> (k)) & 1u)
#ifndef DUP_E
#define DUP_E 0u
#endif
#ifndef DUP_O
#define DUP_O 0u
#endif
#define NREP(s) ((((s) >= 1) && (((((((s) - 1) / LSTEPS) & 1) ? (DUP_O) : (DUP_E)) >> (((s) + LSTEPS - 1) % LSTEPS)) & 1u)) ? 2 : 1)
#define STEP(s) if (lo <= (s) && (s) < hi) for (int rep_ = 0; rep_ < NREP(s); ++rep_)
#define DRY(s) (NREP(s) == 2 && rep_ == 0)
#ifdef TIME_K
#ifndef TIME_PAR
#define TIME_PAR 2
#endif
#define TMATCH(s) ((s) >= 1 && (((s) - 1) % LSTEPS) == (TIME_K) && ((TIME_PAR) == 2 || ((((s) - 1) / LSTEPS) & 1) == (TIME_PAR)))
#define TSTART(s) do { if (TMATCH(s)) tstart = __builtin_amdgcn_s_memrealtime(); } while (0)
#define TSTOP(s) do { if (TMATCH(s)) tacc += __builtin_amdgcn_s_memrealtime() - tstart; } while (0)
#else
#define TSTART(s) do {} while (0)
#define TSTOP(s) do {} while (0)
#endif
#define ENDSTEP(s) do { if ((s) + 1 < hi) xcd_barrier(bar); TSTOP(s); } while (0)
#define LAUNDER_WS do {} while (0)


template <int layer> __device__ __forceinline__ void layer_body(const XcdBarrier& bar, const int lo, const int hi, LAS unsigned char* const lds0, const int wave0, unsigned long long& tacc, unsigned long long& tstart) {
        constexpr int sb = 1 + layer * LSTEPS, j = layer >> 1; constexpr bool even = (layer & 1) == 0;
        STEP(sb + 0) if constexpr (EN(0)) { FRAME; TSTART(sb + 0);
            phase_norm(F, layer == 0 ? kin(I_X) : nullptr, kin(I_NORM_MIX) + layer * DM);
            if constexpr (even) moe_weights(F, layer);
            phase_pconv(F, layer);
            if constexpr (!even) { __syncthreads(); s5_build(F, j); }
            ENDSTEP(sb + 0);
        }
        STEP(sb + 1) if constexpr (EN(1)) { FRAME; TSTART(sb + 1);
            { LAUNDER_WS; const int NP = even ? EVEN_INP : ODD_INP; const bf16* W = even ? (const bf16*)(ws + WS_W_EVIN) + (size_t)j * EVEN_INP * 1024 : (const bf16*)(ws + WS_W_ODIN) + (size_t)j * ODD_INP * 1024;
              pg8::Gemm g{(const bf16*)(ws + WS_ABF), W, 1024, 1024, 1024}; pg8::StaticOrder S; S.init(NTOK, NP, F.G, F.bid); pg8::EpiBf16 E{(bf16*)(ws + WS_PROJ), NP};
              pg8::gemm_phase<pg8::EpiBf16, pg8::StaticOrder>(F.lds + RING_OFF, g, S, E, F.tid); }
            { LAUNDER_WS; pg8::Gemm g{(const bf16*)(ws + WS_PBF), (const bf16*)(ws + WS_W_PLEP) + (size_t)layer * 1024 * 256, 256, 256, 256}; pg8::StaticOrder S; S.init(NTOK, 1024, F.G, F.bid); pg8::EpiBf16 E{(bf16*)(ws + WS_PP), 1024};
              pg8::gemm_phase<pg8::EpiBf16, pg8::StaticOrder>(F.lds + RING_OFF, g, S, E, F.tid); }
            ENDSTEP(sb + 1);
        }
        if constexpr (even) {
            STEP(sb + 2) if constexpr (EN(2)) { FRAME; TSTART(sb + 2); phase_even_post(F, j, DRY(sb + 2)); ENDSTEP(sb + 2); }
            STEP(sb + 3) if constexpr (EN(3)) { FRAME; TSTART(sb + 3);
#ifndef NO_QUP
                { LAUNDER_WS; pg8::Gemm g{(const bf16*)(ws + WS_CQN), (const bf16*)(ws + WS_W_QUP) + (size_t)j * 768 * 384, 384, 384, 384}; pg8::StaticOrder S; S.init(NTOK, 768, F.G, F.bid); pg8::EpiBf16 E{(bf16*)(ws + WS_QM), 768};
                  pg8::gemm_phase<pg8::EpiBf16, pg8::StaticOrder>(F.lds + RING_OFF, g, S, E, F.tid); }
#endif
#ifndef NO_KVUP
                { LAUNDER_WS; pg8::Gemm g{(const bf16*)(ws + WS_CKVN), (const bf16*)(ws + WS_W_KVUP) + (size_t)j * 1024 * 256, 256, 256, 256}; pg8::StaticOrder S; S.init(NTOK, 1024, F.G, F.bid); pg8::EpiBf16 E{(bf16*)(ws + WS_KVB), 1024};
                  pg8::gemm_phase<pg8::EpiBf16, pg8::StaticOrder>(F.lds + RING_OFF, g, S, E, F.tid); }
#endif
#ifndef NO_CUMSUM
                phase_cumsum(F);
#endif
                ENDSTEP(sb + 3);
            }
            STEP(sb + 4) if constexpr (EN(4)) { FRAME; TSTART(sb + 4); phase_mla_post(F, j, DRY(sb + 4)); ENDSTEP(sb + 4); }
            STEP(sb + 5) if constexpr (EN(5)) { FRAME; TSTART(sb + 5);
#ifdef ATTN_NAIVE
                phase_attn_naive(F);
#else
                phase_attn_mfma(F, j);
#endif
                ENDSTEP(sb + 5); }
        } else {
            STEP(sb + 2) if constexpr (EN(2)) { FRAME; TSTART(sb + 2); s5_repack(F);
#ifdef GDN_NAIVE
                phase_gdn_prep(F, j);
#else
                phase_gdn_g1(F, j);
#ifdef DUP_G1
                phase_gdn_g1(F, j);
#endif
#ifdef DUP_REPACK
                s5_repack(F);
#endif
#endif
                ENDSTEP(sb + 2); }
            STEP(sb + 3) if constexpr (EN(3)) { FRAME; TSTART(sb + 3);
                if (F.bid < 64) { phase_gdn_g2(F); }
                else if (F.bid < 96) { const int grp = F.bid - 64;
                    { pg8::Gemm g{(const bf16*)(ws + WS_S5_AX), (const bf16*)(ws + WS_S5_PT), 1024, 1152, 1024}; S5GroupP S{grp}; S5PEpi E{(float*)(ws + WS_S5_XLOC)};
                      pg8::gemm_phase<S5PEpi, S5GroupP>(F.lds + RING_OFF, g, S, E, F.tid); }
                    VM_WAIT(); __syncthreads();
                    s5_scan(F, j, grp);
                    VM_WAIT(); __syncthreads();
                    { pg8::Gemm g{(const bf16*)(ws + WS_S5_AX), (const bf16*)(ws + WS_S5_MT), 1152, 1152, 1152}; S5GroupM S{grp}; S5MEpi E{(bf16*)(ws + WS_HG), (const bf16*)(ws + WS_PROJ), kin(I_S5_D) + j * 512};
                      pg8::gemm_phase<S5MEpi, S5GroupM>(F.lds + RING_OFF, g, S, E, F.tid); }
                } else { moe_weights(F, layer, 96, F.G - 96); }
                ENDSTEP(sb + 3);
            }
            STEP(sb + 6) if constexpr (EN(6)) { FRAME; TSTART(sb + 6);
                phase_gdn_out2(F, j);
                pg8::Gemm g{(const bf16*)(ws + WS_HG), (const bf16*)(ws + WS_W_GLU) + (size_t)j * 512 * 512, 512, 512, 512}; pg8::StaticOrder S; S.init(NTOK, 512, F.G, F.bid);
                pg8::EpiGlu E{(bf16*)(ws + WS_MIX), 1024, (const bf16*)(ws + WS_HG), 512, kin(I_S5_BGLU) + j * 512};
                pg8::gemm_phase<pg8::EpiGlu, pg8::StaticOrder>(F.lds + RING_OFF, g, S, E, F.tid);
                ENDSTEP(sb + 6);
            }
        }
        STEP(sb + 7) if constexpr (EN(7)) { FRAME; TSTART(sb + 7);
            LAUNDER_WS; const bf16* W = even ? (const bf16*)(ws + WS_W_EVOUT) + (size_t)j * 1024 * 1024 : (const bf16*)(ws + WS_W_ODOUT) + (size_t)j * 1024 * 1024;
            pg8::Gemm g{(const bf16*)(ws + WS_MIX), W, 1024, 1024, 1024}; pg8::StaticOrder S; S.init(NTOK, 1024, F.G, F.bid); pg8::EpiResAdd E{(bf16*)(ws + (DRY(sb + 7) ? WS_DUMMY : WS_H16)), 1024};
            pg8::gemm_phase<pg8::EpiResAdd, pg8::StaticOrder>(F.lds + RING_OFF, g, S, E, F.tid);
            ENDSTEP(sb + 7);
        }
        STEP(sb + 8) if constexpr (EN(8)) { FRAME; TSTART(sb + 8); phase_router2(F, layer, DRY(sb + 8)); ENDSTEP(sb + 8); }
        STEP(sb + 10) if constexpr (EN(10)) { FRAME; TSTART(sb + 10);
            LAUNDER_WS; moe_tables(F, layer);
            const LAS int* rowbase = (const LAS int*)(F.lds + LDSCTL_OFF + LC_MOE);
            MoeGatherOrder S{__builtin_amdgcn_readfirstlane(rowbase[34]), 4, F.G, F.bid, (const LAS unsigned char*)(F.lds + LDSCTL_OFF + LC_MOE + 192), rowbase, (const int*)(ws + WS_P2T), (size_t)1024 * 1024 * 2};
            pg8::Gemm g{(const bf16*)(ws + WS_ABF), (const bf16*)(ws + WS_W_MOEGU), 1024, 1024, 1024}; pg8::EpiSwiglu E{(bf16*)(ws + WS_HB), 512};
            pg8::gemm_phase_gather<pg8::EpiSwiglu, MoeGatherOrder>(F.lds + RING_OFF, g, S, E, F.tid);
            ENDSTEP(sb + 10);
        }
        STEP(sb + 11) if constexpr (EN(11)) { FRAME; TSTART(sb + 11);
            LAUNDER_WS; moe_tables(F, layer);
            const LAS int* rowbase = (const LAS int*)(F.lds + LDSCTL_OFF + LC_MOE);
            MoeOrder S{__builtin_amdgcn_readfirstlane(rowbase[34]), 4, F.G, F.bid, (const LAS unsigned char*)(F.lds + LDSCTL_OFF + LC_MOE + 192), (size_t)1024 * 512 * 2};
            pg8::Gemm g{(const bf16*)(ws + WS_HB), (const bf16*)(ws + WS_W_MOED), 512, 512, 512}; pg8::EpiBf16 E{(bf16*)(ws + WS_Y2), 1024};
            pg8::gemm_phase<pg8::EpiBf16, MoeOrder>(F.lds + RING_OFF, g, S, E, F.tid);
            ENDSTEP(sb + 11);
        }
        STEP(sb + 12) if constexpr (EN(12)) { FRAME; TSTART(sb + 12); phase_moe_combine(F, layer, DRY(sb + 12)); ENDSTEP(sb + 12); }
        STEP(sb + 13) if constexpr (EN(13)) { FRAME; TSTART(sb + 13);
            LAUNDER_WS; pg8::Gemm g{(const bf16*)(ws + WS_ABF), (const bf16*)(ws + WS_W_PLEG) + (size_t)layer * 1024 * 1024, 1024, 1024, 1024}; pg8::StaticOrder S; S.init(NTOK, 1024, F.G, F.bid);
            pg8::EpiPle E{(bf16*)(ws + (DRY(sb + 13) ? WS_DUMMY : WS_H16)), (const bf16*)(ws + WS_PP), kin(I_PLE_BG) + layer * DM, 1024, (layer == DEPTH - 1 && !DRY(sb + 13)) ? kout() : nullptr};
            pg8::gemm_phase<pg8::EpiPle, pg8::StaticOrder>(F.lds + RING_OFF, g, S, E, F.tid);
            ENDSTEP(sb + 13);
        }
    }
__global__ void __launch_bounds__(NWAVES * 64, 2) mega_fwd(KArgs ka) {
    extern __shared__ __attribute__((aligned(16))) unsigned char lds_raw[];
    const Args& args = ka.a;
    LAS unsigned char* const lds0 = (LAS unsigned char*)lds_raw;
    const int wave0 = __builtin_amdgcn_readfirstlane((int)threadIdx.x >> 6);
    for (int u = threadIdx.x; u < (LDS_BYTES - LDSCTL_OFF) / 4; u += NWAVES * 64) ((LAS unsigned*)(lds0 + LDSCTL_OFF))[u] = 0u;
    __syncthreads();
    XcdBarrier bar = xcd_barrier_post((unsigned*)(kws() + WS_CTL) + CW_BAR + ka.li * XCD_BAR_WORDS, (volatile LAS unsigned*)(lds0 + LDSCTL_OFF + LC_BARST));
    const int lo = args.ph_lo, hi = args.ph_hi;
    unsigned long long tacc = 0, tstart = 0;
    STEP(0) if constexpr (EN(15)) { FRAME; prologue_weights(F); router_weights(F);
#ifdef EXTRA_BARS
        for (int xb_ = 0; xb_ < EXTRA_BARS; ++xb_) xcd_barrier(bar);
#endif
        ENDSTEP(0); }
    layer_body<0>(bar, lo, hi, lds0, wave0, tacc, tstart); layer_body<1>(bar, lo, hi, lds0, wave0, tacc, tstart); layer_body<2>(bar, lo, hi, lds0, wave0, tacc, tstart); layer_body<3>(bar, lo, hi, lds0, wave0, tacc, tstart);
#ifdef TIME_G2WAIT
    if (blockIdx.x == 0 && threadIdx.x == 0) { const unsigned long long w_ = *(volatile LAS unsigned long long*)(lds0 + LDSCTL_OFF + 2048); const unsigned long long t_end = __builtin_amdgcn_s_memrealtime(); while (__builtin_amdgcn_s_memrealtime() - t_end < 10ull * w_) __builtin_amdgcn_s_sleep(8); }
#endif
#ifdef TIME_K
    if (blockIdx.x == 0) { const unsigned long long t_end = __builtin_amdgcn_s_memrealtime(); while (__builtin_amdgcn_s_memrealtime() - t_end < (unsigned long long)(TIME_AMP) * tacc) __builtin_amdgcn_s_sleep(8); }
#endif
#undef STEP
#undef ENDSTEP
}

#ifndef MK_MODE
#define MK_MODE 0
#endif
extern "C" void kernel_launch(void* const* d_in, const int* in_sizes, int n_in, void* d_out, int out_size, void* d_ws, size_t ws_size, hipStream_t stream) {
    static int ready = 0;
    if (ready == 0) {
        if (n_in != N_IN || out_size != NTOK * DM || ws_size < WS_END) { fprintf(stderr, "kernel_launch: unexpected shapes n_in %d out %d ws %zu (need %zu)\n", n_in, out_size, ws_size, (size_t)WS_END); ready = -1; return; }
        if (hipFuncSetAttribute((const void*)mega_fwd, hipFuncAttributeMaxDynamicSharedMemorySize, LDS_BYTES) != hipSuccess) { fprintf(stderr, "kernel_launch: hipFuncSetAttribute failed\n"); ready = -1; return; }
        int per_cu = 0; (void)hipOccupancyMaxActiveBlocksPerMultiprocessor(&per_cu, (const void*)mega_fwd, NWAVES * 64, LDS_BYTES); (void)hipGetLastError();
        ready = 1;
    }
    if (ready < 0) return;
    (void)hipMemsetAsync((char*)d_ws + WS_CTL, 0, CTL_ZERO_BYTES, stream);
    KArgs ka{};
    for (int i = 0; i < N_IN; ++i) ka.a.in[i] = (const float*)d_in[i];
    ka.a.out = (float*)d_out; ka.a.ws = (unsigned char*)d_ws; ka.li = 0; ka.pad = 0;
    const int grid = 256;
#if MK_MODE == 1
    ka.a.ph_lo = 0; ka.a.ph_hi = STEP_END;
    hipLaunchKernelGGL(mega_fwd, dim3(grid), dim3(NWAVES * 64), LDS_BYTES, stream, ka);
#else
    for (int s = 0; s < STEP_END; ++s) {
        if (s > 0) { const int k = (s - 1) % LSTEPS, layer = (s - 1) / LSTEPS; const bool even = (layer & 1) == 0;
            if (k > 13) continue; if (k == 6 && even) continue; if ((k == 4 || k == 5) && !even) continue; if (k == 9) continue; }
        ka.a.ph_lo = s; ka.a.ph_hi = s + 1;
        hipLaunchKernelGGL(mega_fwd, dim3(grid), dim3(NWAVES * 64), LDS_BYTES, stream, ka);
    }
#endif
}
```
